# Optimizing an MI355X kernel written in HIP

```python
import jax, jax.numpy as jnp
from jax import lax
import numpy as np

D_MODEL = 1024
BATCH = 8
SEQ = 4096
DEPTH = 4

CTX_LEN = 256
GRID_W = 64
N_MIXERS = 3
NORM_EPS = 1e-6
ROPE_THETA = 10000.0
Q_BLOCK = 128
FOURIER_GROUPS = 8
FOURIER_GROUP_DIM = D_MODEL // FOURIER_GROUPS
MLA_HEADS = 16
MLA_Q_LORA = 384
MLA_KV_LORA = 256
MLA_NOPE = 64
MLA_ROPE = 32
MLA_V = 64
GQA_HEADS = 16
GQA_KV_HEADS = 4
GQA_HEAD_DIM = 64
N_EXPERTS = 32
TOP_K = 4
D_EXPERT = 1024
SWIGLU_LIMIT = 7.0
SWIGLU_ALPHA = 1.702
EXPERT_BLOCK = 256
N_MOD = 6

kernel_name = "hybrid_fourier_mla_gqa_moe_dit"


def rms_norm(x, g):
    xf = x.astype(jnp.float32)
    y = xf * lax.rsqrt(jnp.mean(xf * xf, axis=-1, keepdims=True) + NORM_EPS)
    return (y * g.astype(jnp.float32)).astype(x.dtype)


def modulate(h, shift, scale):
    return h * (1 + scale) + shift


def axial_rope_angles(n_tok, rot_dim):
    rows = n_tok // GRID_W
    row = jnp.repeat(jnp.arange(rows, dtype=jnp.float32), GRID_W)
    col = jnp.tile(jnp.arange(GRID_W, dtype=jnp.float32), rows)
    n_freq = rot_dim // 4
    inv_freq = ROPE_THETA ** (-jnp.arange(n_freq, dtype=jnp.float32) / n_freq)
    ang = jnp.stack([row[:, None] * inv_freq, col[:, None] * inv_freq], axis=1)
    return jnp.cos(ang), jnp.sin(ang)


def apply_axial_rope(x, cos, sin):
    B, L, H, R = x.shape
    xf = x.astype(jnp.float32).reshape(B, L, H, 2, 2, R // 4)
    x1, x2 = xf[..., 0, :], xf[..., 1, :]
    cs, sn = cos[None, :, None], sin[None, :, None]
    out = jnp.stack([x1 * cs - x2 * sn, x2 * cs + x1 * sn], axis=-2)
    return out.reshape(B, L, H, R).astype(x.dtype)


def block_attention(q, k, v, scale):
    B, Lq, H, dk = q.shape
    Hkv, dv = k.shape[2], v.shape[3]
    grp = H // Hkv
    nb = Lq // Q_BLOCK
    kf = k.astype(jnp.float32)
    vf = v.astype(jnp.float32)
    qb = jnp.moveaxis(q.reshape(B, nb, Q_BLOCK, Hkv, grp, dk), 1, 0)

    def one_block(qblk):
        s = jnp.einsum("bqhgd,bkhd->bhgqk", qblk.astype(jnp.float32), kf) * scale
        p = jax.nn.softmax(s, axis=-1)
        return jnp.einsum("bhgqk,bkhd->bqhgd", p, vf)

    o = lax.map(one_block, qb)
    return jnp.moveaxis(o, 0, 1).reshape(B, Lq, H, dv).astype(q.dtype)


def fourier_mixer(h, w_in, w_out):
    B, L, D = h.shape
    u = (h @ w_in).astype(jnp.float32).reshape(B, L, FOURIER_GROUPS, FOURIER_GROUP_DIM)
    f = jnp.fft.fft2(u, axes=(1, 3), norm="ortho").real
    return f.reshape(B, L, D).astype(h.dtype) @ w_out


def mla_q(a, g_qa, w_qb, rope):
    B, L = a.shape[:2]
    q = (rms_norm(a[..., :MLA_Q_LORA], g_qa) @ w_qb).reshape(B, L, MLA_HEADS, MLA_NOPE + MLA_ROPE)
    q_nope, q_pe = q[..., :MLA_NOPE], q[..., MLA_NOPE:]
    if rope is not None:
        q_pe = apply_axial_rope(q_pe, rope[0], rope[1])
    return jnp.concatenate([q_nope, q_pe], axis=-1)


def mla_kv(a, g_kva, w_kvb, rope):
    B, L = a.shape[:2]
    c_kv = rms_norm(a[..., MLA_Q_LORA:MLA_Q_LORA + MLA_KV_LORA], g_kva)
    kv = (c_kv @ w_kvb).reshape(B, L, MLA_HEADS, MLA_NOPE + MLA_V)
    k_pe = a[..., MLA_Q_LORA + MLA_KV_LORA:][:, :, None, :]
    if rope is not None:
        k_pe = apply_axial_rope(k_pe, rope[0], rope[1])
    k = jnp.concatenate([kv[..., :MLA_NOPE], jnp.broadcast_to(k_pe, (B, L, MLA_HEADS, MLA_ROPE))], axis=-1)
    return k, kv[..., MLA_NOPE:]


def mla_mixer(h_ctx, h_lat, need_ctx_out, w_in, g_qa, w_qb, g_kva, w_kvb, w_o):
    B, L, _ = h_lat.shape
    rope = axial_rope_angles(L, MLA_ROPE)
    a_c = h_ctx @ w_in
    a_l = h_lat @ w_in
    k_c, v_c = mla_kv(a_c, g_kva, w_kvb, None)
    k_l, v_l = mla_kv(a_l, g_kva, w_kvb, rope)
    q_l = mla_q(a_l, g_qa, w_qb, rope)
    scale = (MLA_NOPE + MLA_ROPE) ** -0.5
    o_l = block_attention(q_l, jnp.concatenate([k_c, k_l], axis=1), jnp.concatenate([v_c, v_l], axis=1), scale)
    out_l = o_l.reshape(B, L, MLA_HEADS * MLA_V) @ w_o
    out_c = None
    if need_ctx_out:
        o_c = block_attention(mla_q(a_c, g_qa, w_qb, None), k_c, v_c, scale)
        out_c = o_c.reshape(B, h_ctx.shape[1], MLA_HEADS * MLA_V) @ w_o
    return out_c, out_l


GQA_NQ = GQA_HEADS * GQA_HEAD_DIM
GQA_NKV = GQA_KV_HEADS * GQA_HEAD_DIM


def gqa_q(a, g_q):
    B, L = a.shape[:2]
    return rms_norm(a[..., :GQA_NQ].reshape(B, L, GQA_HEADS, GQA_HEAD_DIM), g_q)


def gqa_kv(a, g_k):
    B, L = a.shape[:2]
    k = rms_norm(a[..., GQA_NQ:GQA_NQ + GQA_NKV].reshape(B, L, GQA_KV_HEADS, GQA_HEAD_DIM), g_k)
    v = a[..., GQA_NQ + GQA_NKV:].reshape(B, L, GQA_KV_HEADS, GQA_HEAD_DIM)
    return k, v


def gqa_mixer(h_ctx, h_lat, need_ctx_out, w_qkv, g_q, g_k, w_o):
    B, L, _ = h_lat.shape
    cos, sin = axial_rope_angles(L, GQA_HEAD_DIM)
    a_c = h_ctx @ w_qkv
    a_l = h_lat @ w_qkv
    k_c, v_c = gqa_kv(a_c, g_k)
    k_l, v_l = gqa_kv(a_l, g_k)
    k_l = apply_axial_rope(k_l, cos, sin)
    q_l = apply_axial_rope(gqa_q(a_l, g_q), cos, sin)
    scale = GQA_HEAD_DIM ** -0.5
    o_l = block_attention(q_l, jnp.concatenate([k_c, k_l], axis=1), jnp.concatenate([v_c, v_l], axis=1), scale)
    out_l = o_l.reshape(B, L, GQA_NQ) @ w_o
    out_c = None
    if need_ctx_out:
        o_c = block_attention(gqa_q(a_c, g_q), k_c, v_c, scale)
        out_c = o_c.reshape(B, h_ctx.shape[1], GQA_NQ) @ w_o
    return out_c, out_l


def moe_ffn(h, w_router, b_router, w_gu, b_gu, w_down, b_down):
    N, D = h.shape
    logits = h.astype(jnp.float32) @ w_router.astype(jnp.float32) + b_router.astype(jnp.float32)
    top_logit, top_idx = lax.top_k(logits, TOP_K)
    top_w = jax.nn.softmax(top_logit, axis=-1)
    n_assign = N * TOP_K
    flat_e = top_idx.reshape(-1)
    flat_tok = jnp.arange(n_assign, dtype=jnp.int32) // TOP_K
    flat_w = top_w.reshape(-1)
    order = jnp.argsort(flat_e)
    e_sorted = flat_e[order]
    counts = jnp.bincount(flat_e, length=N_EXPERTS)
    padded = (counts + EXPERT_BLOCK - 1) // EXPERT_BLOCK * EXPERT_BLOCK
    pad_end = jnp.cumsum(padded)
    pad_start = pad_end - padded
    grp_start = jnp.cumsum(counts) - counts
    rank = jnp.arange(n_assign, dtype=jnp.int32) - grp_start[e_sorted]
    dest = pad_start[e_sorted] + rank
    n_blocks = (n_assign + N_EXPERTS * (EXPERT_BLOCK - 1) + EXPERT_BLOCK - 1) // EXPERT_BLOCK
    n_slots = n_blocks * EXPERT_BLOCK
    slot_tok = jnp.full((n_slots,), N, jnp.int32).at[dest].set(flat_tok[order])
    slot_w = jnp.zeros((n_slots,), jnp.float32).at[dest].set(flat_w[order])
    block_start = jnp.arange(n_blocks, dtype=pad_end.dtype) * EXPERT_BLOCK
    block_expert = jnp.minimum(jnp.searchsorted(pad_end, block_start, side="right"), N_EXPERTS - 1)
    h_pad = jnp.concatenate([h, jnp.zeros((1, D), h.dtype)], axis=0)

    def expert_block(args):
        tok, wt, e = args
        gu = h_pad[tok] @ w_gu[e] + b_gu[e]
        gate = jnp.minimum(gu[..., ::2], SWIGLU_LIMIT)
        up = jnp.clip(gu[..., 1::2], -SWIGLU_LIMIT, SWIGLU_LIMIT)
        glu = gate * jax.nn.sigmoid(SWIGLU_ALPHA * gate)
        y = ((up + 1) * glu) @ w_down[e] + b_down[e]
        return y.astype(jnp.float32) * wt[:, None]

    y = lax.map(expert_block, (slot_tok.reshape(n_blocks, EXPERT_BLOCK),
                               slot_w.reshape(n_blocks, EXPERT_BLOCK), block_expert))
    out = jax.ops.segment_sum(y.reshape(n_slots, D), slot_tok, num_segments=N + 1)[:N]
    return out.astype(h.dtype)


def setup_inputs(seed: int = 0) -> dict:
    key = jax.random.key(seed)
    keys = jax.random.split(key, 32)
    ctr = iter(range(32))
    D = D_MODEL
    n_f = len(range(0, DEPTH, N_MIXERS))
    n_m = len(range(1, DEPTH, N_MIXERS))
    n_g = len(range(2, DEPTH, N_MIXERS))

    def nrm(shape, s):
        return jax.random.normal(keys[next(ctr)], shape, jnp.float32) * s

    def gain(shape):
        return 1.0 + nrm(shape, 0.02)

    return {
        "x": nrm((BATCH, SEQ, D), 1.0),
        "c": nrm((BATCH, D), 1.0),
        "ctx": nrm((BATCH, CTX_LEN, D), 1.0),
        "c_ctx": nrm((D,), 1.0),
        "w_mod": nrm((DEPTH, D, N_MOD * D), 0.5 * D ** -0.5),
        "b_mod": nrm((DEPTH, N_MOD * D), 0.01),
        "g_mix": gain((DEPTH, D)),
        "g_ffn": gain((DEPTH, D)),
        "g_final": gain((D,)),
        "f_w_in": nrm((n_f, D, D), D ** -0.5),
        "f_w_out": nrm((n_f, D, D), D ** -0.5),
        "mla_w_in": nrm((n_m, D, MLA_Q_LORA + MLA_KV_LORA + MLA_ROPE), D ** -0.5),
        "mla_g_qa": gain((n_m, MLA_Q_LORA)),
        "mla_w_qb": nrm((n_m, MLA_Q_LORA, MLA_HEADS * (MLA_NOPE + MLA_ROPE)), MLA_Q_LORA ** -0.5),
        "mla_g_kva": gain((n_m, MLA_KV_LORA)),
        "mla_w_kvb": nrm((n_m, MLA_KV_LORA, MLA_HEADS * (MLA_NOPE + MLA_V)), MLA_KV_LORA ** -0.5),
        "mla_w_o": nrm((n_m, MLA_HEADS * MLA_V, D), (MLA_HEADS * MLA_V) ** -0.5),
        "gqa_w_qkv": nrm((n_g, D, GQA_NQ + 2 * GQA_NKV), D ** -0.5),
        "gqa_g_q": gain((n_g, GQA_HEAD_DIM)),
        "gqa_g_k": gain((n_g, GQA_HEAD_DIM)),
        "gqa_w_o": nrm((n_g, GQA_NQ, D), GQA_NQ ** -0.5),
        "moe_w_router": nrm((DEPTH, D, N_EXPERTS), D ** -0.5),
        "moe_b_router": nrm((DEPTH, N_EXPERTS), 0.01),
        "moe_w_gu": nrm((DEPTH, N_EXPERTS, D, 2 * D_EXPERT), D ** -0.5),
        "moe_b_gu": nrm((DEPTH, N_EXPERTS, 2 * D_EXPERT), 0.01),
        "moe_w_down": nrm((DEPTH, N_EXPERTS, D_EXPERT, D), D_EXPERT ** -0.5),
        "moe_b_down": nrm((DEPTH, N_EXPERTS, D), 0.01),
    }


def reference(x, c, ctx, c_ctx, w_mod, b_mod, g_mix, g_ffn, g_final, f_w_in, f_w_out,
              mla_w_in, mla_g_qa, mla_w_qb, mla_g_kva, mla_w_kvb, mla_w_o,
              gqa_w_qkv, gqa_g_q, gqa_g_k, gqa_w_o,
              moe_w_router, moe_b_router, moe_w_gu, moe_b_gu, moe_w_down, moe_b_down):
    D = x.shape[-1]
    lat, cx = x, ctx
    for i in range(DEPTH):
        kind, j = i % N_MIXERS, i // N_MIXERS
        last = i == DEPTH - 1
        B, L, _ = lat.shape
        n_c = cx.shape[1]
        m_l = (jax.nn.silu(c) @ w_mod[i] + b_mod[i]).reshape(B, N_MOD, 1, D)
        h_l = modulate(rms_norm(lat, g_mix[i]), m_l[:, 0], m_l[:, 1])
        ctx_used = (kind != 0) or (not last)
        if ctx_used:
            m_c = (jax.nn.silu(c_ctx) @ w_mod[i] + b_mod[i]).reshape(N_MOD, D)
            h_c = modulate(rms_norm(cx, g_mix[i]), m_c[0], m_c[1])
        if kind == 0:
            o_l = fourier_mixer(h_l, f_w_in[j], f_w_out[j])
            o_c = None if last else fourier_mixer(h_c, f_w_in[j], f_w_out[j])
        elif kind == 1:
            o_c, o_l = mla_mixer(h_c, h_l, not last, mla_w_in[j], mla_g_qa[j], mla_w_qb[j],
                                 mla_g_kva[j], mla_w_kvb[j], mla_w_o[j])
        else:
            o_c, o_l = gqa_mixer(h_c, h_l, not last, gqa_w_qkv[j], gqa_g_q[j], gqa_g_k[j], gqa_w_o[j])
        lat = lat + m_l[:, 2] * o_l
        h2_l = modulate(rms_norm(lat, g_ffn[i]), m_l[:, 3], m_l[:, 4]).reshape(B * L, D)
        moe_p = (moe_w_router[i], moe_b_router[i], moe_w_gu[i], moe_b_gu[i], moe_w_down[i], moe_b_down[i])
        if last:
            f_l = moe_ffn(h2_l, *moe_p)
        else:
            cx = cx + m_c[2] * o_c
            h2_c = modulate(rms_norm(cx, g_ffn[i]), m_c[3], m_c[4]).reshape(B * n_c, D)
            f_all = moe_ffn(jnp.concatenate([h2_c, h2_l], axis=0), *moe_p)
            cx = cx + m_c[5] * f_all[:B * n_c].reshape(B, n_c, D)
            f_l = f_all[B * n_c:]
        lat = lat + m_l[:, 5] * f_l.reshape(B, L, D)
    return rms_norm(lat, g_final)
```

```cpp
#include <hip/hip_runtime.h>
#include <cstdio>
#include <cstdint>

#ifndef MK_PER_PHASE
#define MK_PER_PHASE 0
#endif
#ifndef MK_N2V2
#define MK_N2V2 1
#endif
#ifndef MK_CBV2
#define MK_CBV2 1
#endif
#ifndef MK_N2AGG
#define MK_N2AGG 1
#endif
#ifndef MK_MASK
#define MK_MASK 0xFFFFFFFFu
#endif
#define EN(id) (((MK_MASK) >> (id)) & 1u)
#ifndef MK_REPMASK
#define MK_REPMASK 0u
#endif
#define REP(id) for (int rep_ = 0; rep_ < ((((MK_REPMASK) >> (id)) & 1u) ? 2 : 1); ++rep_)

constexpr int D = 1024, NB = 8, SEQ = 4096, LCTX = 256, DEPTH = 4;
constexpr int NC = NB * LCTX;
constexpr int NL = NB * SEQ;
constexpr int NT = NC + NL;
constexpr int NMOD = 6, NE = 32, TOPK = 4, DFF = 1024;
constexpr int MLA_QL = 384, MLA_KVL = 256, MLA_ROPE = 32, MLA_NOPE = 64, MLA_V = 64, MLA_IN = 672, MLA_IN_PAD = 768, MLA_QD = 96;
constexpr int GQA_NQ = 1024, GQA_NKV = 256, GQA_QKV = 1536;
constexpr int CAP = NT;
constexpr int MAXTILES = 576;
constexpr float EPS = 1e-6f;
constexpr float LOG2E = 1.4426950408889634f;

constexpr size_t MiB = 1u << 20;
constexpr size_t WS_CTL = 0, CTL_ZERO_BYTES = 96 * 1024;
constexpr size_t WS_MOD = 1 * MiB;
constexpr size_t WS_ROPE = 2 * MiB;
constexpr size_t WS_WRT = 2 * MiB + 65536;
constexpr size_t WS_BGU = 3 * MiB;
constexpr size_t WS_MA = 4 * MiB;
constexpr size_t WS_DC = 4 * MiB + 262144;
constexpr size_t WS_MC = 5 * MiB;
constexpr size_t WS_WFIN = 9 * MiB;
constexpr size_t WS_WFOUT = 17 * MiB;
constexpr size_t WS_WMIN = 21 * MiB;
constexpr size_t WS_WMQB = 23 * MiB;
constexpr size_t WS_WMKVB = 25 * MiB;
constexpr size_t WS_WMO = 26 * MiB;
constexpr size_t WS_WGQKV = 28 * MiB;
constexpr size_t WS_WGO = 31 * MiB;
constexpr size_t WS_TE = 34 * MiB;
constexpr size_t WS_TRANK = 35 * MiB;
constexpr size_t WS_STOK = 36 * MiB;
constexpr size_t WS_SW = 41 * MiB;
constexpr size_t WS_X = 64 * MiB;
constexpr size_t WS_H = 200 * MiB;
constexpr size_t WS_RA = 272 * MiB;
constexpr size_t WS_RB = 400 * MiB;
constexpr size_t WS_RC = 528 * MiB;
constexpr size_t WS_RD = 600 * MiB;
constexpr size_t WS_RE = 672 * MiB;
constexpr size_t WS_RF = 728 * MiB;
constexpr size_t WS_RG = 756 * MiB;
constexpr size_t WS_RH = 776 * MiB;
constexpr size_t WS_ACT = 784 * MiB;
constexpr size_t WS_Y = 1072 * MiB;
constexpr size_t WS_WGU = 1360 * MiB;
constexpr size_t WS_WDN = 1872 * MiB;
constexpr size_t WS_END = 2128 * MiB;
constexpr int CW_TMO = 0;
constexpr int CW_BAR = 4096;
constexpr int CW_CNT = 16384;

constexpr int RING_BYTES = 131072;
constexpr int LDS_MISC = 135168;
constexpr int LDS_TT = LDS_MISC;
constexpr int LDS_XB = LDS_MISC + 512;
constexpr int LDS_TE = LDS_MISC + 768;
constexpr int LDS_BYTES = 147456;

#define GAS __attribute__((address_space(1)))
#define LAS __attribute__((address_space(3)))
typedef unsigned short bf16;
typedef unsigned v4u __attribute__((ext_vector_type(4)));
typedef unsigned v2u __attribute__((ext_vector_type(2)));
typedef float f32x4 __attribute__((ext_vector_type(4)));
typedef float f32x2 __attribute__((ext_vector_type(2)));
typedef float f32x16 __attribute__((ext_vector_type(16)));
typedef short bf16x8 __attribute__((ext_vector_type(8)));
typedef short s16x4 __attribute__((ext_vector_type(4)));
typedef __bf16 bf16x2_t __attribute__((ext_vector_type(2)));
typedef GAS unsigned gu32;
#define RLX_AGENT __ATOMIC_RELAXED, __HIP_MEMORY_SCOPE_AGENT
#define LDS_WAIT() asm volatile("s_waitcnt lgkmcnt(0)" ::: "memory")
#define VM_WAIT() asm volatile("s_waitcnt vmcnt(0)" ::: "memory")
__device__ __forceinline__ unsigned pk2(float lo, float hi) { f32x2 v = {lo, hi}; bf16x2_t b = __builtin_convertvector(v, bf16x2_t); return __builtin_bit_cast(unsigned, b); }
__device__ __forceinline__ float bf_lo(unsigned u) { return __builtin_bit_cast(float, u << 16); }
__device__ __forceinline__ float bf_hi(unsigned u) { return __builtin_bit_cast(float, u & 0xffff0000u); }
__device__ __forceinline__ float wave_sum(float v) {
#pragma unroll
    for (int o = 1; o < 64; o <<= 1) v += __shfl_xor(v, o);
    return v;
}
__device__ __forceinline__ int lane_id_v() { int t; asm volatile("v_mbcnt_lo_u32_b32 %0, -1, 0\n\tv_mbcnt_hi_u32_b32 %0, -1, %0" : "=v"(t)); return t; }
__device__ __forceinline__ int launder_s(int x) { asm volatile("" : "+s"(x)); return x; }
__device__ __forceinline__ int lthread_w(int wave) { return wave * 64 + lane_id_v(); }
__device__ __forceinline__ int modrow_of(int row) { return row < NC ? NB : ((row - NC) >> 12); }

#define XB_TMO      128
#define XB_XCNT(j)  (256  + 64 * (j))
#define XB_XSUB(j)  (1280 + 64 * (j))
#define XB_XGEN(j)  (2304 + 64 * (j))
#define XB_TOP      3328
#define XB_TOPGEN   3392
#define XCD_BAR_WORDS 3456
#define XB_SPIN_CAP (1u << 18)
__device__ __forceinline__ unsigned xb_ld(unsigned* p)              { return __hip_atomic_load(p, __ATOMIC_RELAXED, __HIP_MEMORY_SCOPE_AGENT); }
__device__ __forceinline__ unsigned xb_add(unsigned* p, unsigned v) { return __hip_atomic_fetch_add(p, v, __ATOMIC_RELAXED, __HIP_MEMORY_SCOPE_AGENT); }
__device__ __forceinline__ unsigned xb_xcc_id() { return (unsigned)__builtin_amdgcn_s_getreg((3 << 11) | 20) & 0xFu; }
#define XB_SPIN(cond, bar) do { unsigned _sp = 0; while (cond) { __builtin_amdgcn_s_sleep(1); \
    if ((++_sp & 255u) == 0u) { if (xb_ld(&(bar)[XB_TMO])) break; if (_sp > XB_SPIN_CAP) { atomicAdd(&(bar)[XB_TMO], 1u); break; } } } } while (0)
struct XcdBarrier { unsigned* bar; unsigned x; volatile LAS unsigned* st; int wave; };
__device__ __forceinline__ bool xb_thread0(int wave) { return wave == 0 && lane_id_v() == 0; }
__device__ __forceinline__ XcdBarrier xcd_barrier_post(unsigned* bar, volatile LAS unsigned* st, int wave) {
    XcdBarrier b; b.bar = bar; b.x = xb_xcc_id(); b.st = st; b.wave = wave;
    if (xb_thread0(wave)) (void)xb_add(&bar[XB_XCNT(b.x)], 1u);
    return b;
}
__device__ __forceinline__ void xcd_barrier_complete(unsigned* bar, unsigned x, unsigned& nloc, unsigned& nx) {
    const unsigned G = gridDim.x * gridDim.y * gridDim.z;
    unsigned sum, cnt, mine, sp = 0u;
    for (;;) {
        sum = 0u; cnt = 0u; mine = 0u;
#pragma unroll
        for (unsigned j = 0; j < 16; ++j) { const unsigned c = xb_ld(&bar[XB_XCNT(j)]); sum += c; cnt += (c > 0u) ? 1u : 0u; mine = (j == x) ? c : mine; }
        if (sum == G) break;
        __builtin_amdgcn_s_sleep(1);
        if ((++sp & 255u) == 0u) { if (xb_ld(&bar[XB_TMO])) break; if (sp > XB_SPIN_CAP) { atomicAdd(&bar[XB_TMO], 1u); break; } }
    }
    nloc = mine > 0u ? mine : 1u; nx = cnt > 0u ? cnt : 1u;
}
__device__ __forceinline__ void xcd_barrier(const XcdBarrier& b) {
    asm volatile("s_waitcnt vmcnt(0)" ::: "memory");
    __syncthreads();
    if (xb_thread0(b.wave)) {
        unsigned* bar = b.bar;
        __builtin_amdgcn_s_waitcnt(0);
        unsigned nloc = b.st[0], nx = b.st[1];
        if (nloc == 0u) { xcd_barrier_complete(bar, b.x, nloc, nx); b.st[0] = nloc; b.st[1] = nx; }
        const unsigned old = xb_add(&bar[XB_XSUB(b.x)], 1u);
        const unsigned gen = old / nloc;
        if (old + 1u == (gen + 1u) * nloc) {
            __builtin_amdgcn_fence(__ATOMIC_RELEASE, "agent");
            asm volatile("s_waitcnt vmcnt(0)" ::: "memory");
            const unsigned og = xb_add(&bar[XB_TOP], 1u);
            const unsigned tg = og / nx;
            if (og + 1u == (tg + 1u) * nx) xb_add(&bar[XB_TOPGEN], 1u);
            else XB_SPIN(xb_ld(&bar[XB_TOPGEN]) == tg, bar);
            __builtin_amdgcn_fence(__ATOMIC_ACQUIRE, "agent");
            xb_add(&bar[XB_XGEN(b.x)], 1u);
            asm volatile("s_waitcnt vmcnt(0)" ::: "memory");
        } else {
            XB_SPIN(xb_ld(&bar[XB_XGEN(b.x)]) == gen, bar);
            __builtin_amdgcn_fence(__ATOMIC_ACQUIRE, "agent");
            asm volatile("s_waitcnt vmcnt(0)" ::: "memory");
        }
    }
    __syncthreads();
}

namespace pg8 {
#define PG8_LAS __attribute__((address_space(3)))
constexpr int BM = 256, BK = 64, HALF = 128, HTB = HALF * BK * 2, STAGE_BYTES = 8 * HTB, NXCD = 8, WGM = 8;
__device__ __forceinline__ int lds_byte(int r, int c) { const int st = (r >> 4) * 2 + (c >> 5), rr = r & 15, cc = c & 31, ob = rr * 64 + cc * 2; return st * 1024 + (ob ^ (((ob >> 9) & 1) << 5)); }
__device__ __forceinline__ void stage_rc(int b, int& R, int& C) { const int st = b / 1024, sb = b % 1024, swz = sb ^ (((sb >> 9) & 1) << 5); R = (st >> 1) * 16 + swz / 64; C = (st & 1) * 32 + (swz % 64) / 2; }
__device__ __forceinline__ int perm32(int rho) { const int n = rho >> 4, i = rho & 15; return 8 * (i >> 2) + 4 * n + (i & 3); }
struct Unit { int pm, pn, aux; };
typedef f32x4 Acc[2][2][4][2];

__device__ __forceinline__ bool static_next(int i, int G, int c, int nM, int nN, int& pm, int& pn) {
    const int nwg = nM * nN; const long L = (long)i * G + c; if (L >= nwg) return false;
    int wgid = (int)L; { const int q = nwg / NXCD, r = nwg % NXCD, xcd = wgid % NXCD, off = wgid / NXCD; wgid = (xcd < r ? xcd * (q + 1) : r * (q + 1) + (xcd - r) * q) + off; }
    const int nig = WGM * nN, gid = wgid / nig, fm = gid * WGM, gsz = (nM - fm) < WGM ? (nM - fm) : WGM;
    pm = fm + ((wgid % nig) % gsz); pn = (wgid % nig) / gsz; return true;
}

template <class P>
__device__ __forceinline__ void gemm_phase(PG8_LAS unsigned char* lds, const P& p, int wave_id) {
    wave_id = launder_s(wave_id); int tid_l = lthread_w(wave_id);
    const int tid = tid_l, wid = wave_id, lane = tid & 63, wr = wid >> 2, wc = wid & 3, fr = lane & 15, fq = lane >> 4;
    const int nt = p.nt;
    int R[2], Rb[2], C[2];
#pragma unroll
    for (int i = 0; i < 2; ++i) { stage_rc(tid * 16 + i * 8192, R[i], C[i]); Rb[i] = P::PERM ? ((R[i] & ~31) + perm32(R[i] & 31)) : R[i]; }
    const unsigned ldsw = (unsigned)wid * 1024u;
    const int aoff = lds_byte(wr * 64 + fr, fq * 8), boff = lds_byte(wc * 32 + fr, fq * 8);
    const char* const gA = p.A; const char* const gB = p.B;
#define PG8_SA(b, h) (((b) * 2 + (h)) * HTB)
#define PG8_SB(b, h) ((4 + (b) * 2 + (h)) * HTB)
#define PG8_STAGE(bufoff, gbase, off2, kofs) do { _Pragma("unroll") for (int _i = 0; _i < 2; ++_i) \
        __builtin_amdgcn_global_load_lds((const unsigned*)((gbase) + (size_t)(off2)[_i] + (size_t)(kofs)), (PG8_LAS unsigned*)(lds + (bufoff) + ldsw + _i * 8192), 16, 0, 0); } while (0)
#define PG8_LDA(dst, b, h) do { _Pragma("unroll") for (int m = 0; m < 4; ++m) _Pragma("unroll") for (int k = 0; k < 2; ++k) dst[m][k] = *(const PG8_LAS bf16x8*)(lds + PG8_SA(b, h) + aoff + m * 2048 + k * 1024); } while (0)
#define PG8_LDB(dst, b, h) do { _Pragma("unroll") for (int n = 0; n < 2; ++n) _Pragma("unroll") for (int k = 0; k < 2; ++k) dst[n][k] = *(const PG8_LAS bf16x8*)(lds + PG8_SB(b, h) + boff + n * 2048 + k * 1024); } while (0)
#define PG8_MMA(ai, bj, At, Bt) do { __builtin_amdgcn_s_setprio(1); _Pragma("unroll") for (int m = 0; m < 4; ++m) _Pragma("unroll") for (int n = 0; n < 2; ++n) _Pragma("unroll") for (int k = 0; k < 2; ++k) \
        acc[ai][bj][m][n] = __builtin_amdgcn_mfma_f32_16x16x32_bf16(Bt[n][k], At[m][k], acc[ai][bj][m][n], 0, 0, 0); __builtin_amdgcn_s_setprio(0); } while (0)
#define PG8_WAIT_V(n) asm volatile("s_waitcnt vmcnt(" #n ")" ::: "memory")
#define PG8_WAIT_L(n) asm volatile("s_waitcnt lgkmcnt(" #n ")" ::: "memory")
#define PG8_BAR __builtin_amdgcn_s_barrier()
#define PG8_SCHED __builtin_amdgcn_sched_barrier(0)
#define PG8_KEYS(u) do { if (P::KEYS && wid < 4) __builtin_amdgcn_global_load_lds((const unsigned*)p.key_ptr(u, wid * 64 + lane), (PG8_LAS unsigned*)(keybuf + wid * 256), 4, 0, 0); } while (0)
#define PG8_OFFS(u, oA, oB) do { _Pragma("unroll") for (int _h = 0; _h < 2; ++_h) _Pragma("unroll") for (int _i = 0; _i < 2; ++_i) { \
        const int key_ = P::KEYS ? ((const PG8_LAS int*)keybuf)[_h * HALF + R[_i]] : 0; \
        oA[_h][_i] = p.a_row(u, _h * HALF + R[_i], key_) + (unsigned)(C[_i] * 2); oB[_h][_i] = p.b_row(u, _h * HALF + Rb[_i]) + (unsigned)(C[_i] * 2); } } while (0)
    PG8_LAS unsigned char* const keybuf = lds + STAGE_BYTES;
    Unit cur, nxt; int ui = 0;
    if (!p.next(0, cur)) return;
    f32x4 acc[2][2][4][2];
#pragma unroll
    for (int a = 0; a < 2; ++a)
#pragma unroll
        for (int b = 0; b < 2; ++b)
#pragma unroll
            for (int m = 0; m < 4; ++m)
#pragma unroll
                for (int n = 0; n < 2; ++n) acc[a][b][m][n] = (f32x4){0.f, 0.f, 0.f, 0.f};
    bf16x8 At[4][2], B0[2][2], B1[2][2];
    unsigned oAc[2][2], oBc[2][2];
    if (P::KEYS) { PG8_KEYS(cur); PG8_WAIT_V(0); PG8_BAR; }
    PG8_OFFS(cur, oAc, oBc);
    PG8_STAGE(PG8_SB(0, 0), gB, oBc[0], 0); PG8_STAGE(PG8_SB(0, 1), gB, oBc[1], 0); PG8_STAGE(PG8_SA(0, 0), gA, oAc[0], 0); PG8_STAGE(PG8_SA(0, 1), gA, oAc[1], 0);
    if (wr == 1) PG8_BAR;
    PG8_WAIT_V(2); PG8_BAR;
    PG8_STAGE(PG8_SB(1, 0), gB, oBc[0], 128); PG8_STAGE(PG8_SA(1, 0), gA, oAc[0], 128); PG8_STAGE(PG8_SB(1, 1), gB, oBc[1], 128);
    PG8_WAIT_V(6); PG8_BAR;
    for (;;) {
        const bool has_next = p.next(ui + 1, nxt);
        if (has_next) { PG8_KEYS(nxt); }
        for (int t = 0; t < nt; t += 2) {
            const bool last = (t == nt - 2);
            const unsigned k1 = (unsigned)(t + 1) * 128u;
            const unsigned k2 = last ? 0u : (unsigned)(t + 2) * 128u, k3 = k2 + 128u;
            PG8_LDB(B0, 0, 0); PG8_LDB(B1, 0, 1); PG8_SCHED; PG8_LDA(At, 0, 0); PG8_STAGE(PG8_SA(1, 1), gA, oAc[1], k1);
            if (last && has_next) { PG8_OFFS(nxt, oAc, oBc); }
            PG8_WAIT_V(8); PG8_WAIT_L(0); PG8_BAR; PG8_MMA(0, 0, At, B0); PG8_MMA(0, 1, At, B1); PG8_BAR; PG8_SCHED;
            PG8_LDA(At, 0, 1); PG8_STAGE(PG8_SB(0, 0), gB, oBc[0], k2); PG8_STAGE(PG8_SB(0, 1), gB, oBc[1], k2); PG8_STAGE(PG8_SA(0, 0), gA, oAc[0], k2);
            PG8_WAIT_V(8); PG8_WAIT_L(0); PG8_BAR; PG8_MMA(1, 0, At, B0); PG8_MMA(1, 1, At, B1); PG8_BAR; PG8_SCHED;
            PG8_LDB(B0, 1, 0); PG8_LDB(B1, 1, 1); PG8_SCHED; PG8_LDA(At, 1, 0); PG8_STAGE(PG8_SA(0, 1), gA, oAc[1], k2);
            PG8_WAIT_V(8); PG8_WAIT_L(0); PG8_BAR; PG8_MMA(0, 0, At, B0); PG8_MMA(0, 1, At, B1); PG8_BAR; PG8_SCHED;
            PG8_LDA(At, 1, 1); PG8_STAGE(PG8_SB(1, 0), gB, oBc[0], k3); PG8_STAGE(PG8_SB(1, 1), gB, oBc[1], k3); PG8_STAGE(PG8_SA(1, 0), gA, oAc[0], k3);
            PG8_WAIT_V(8); PG8_WAIT_L(0); PG8_BAR; PG8_MMA(1, 0, At, B0); PG8_MMA(1, 1, At, B1); PG8_BAR; PG8_SCHED;
        }
        if (wr == 0) PG8_BAR;
        { int fr_e = fr, fq_e = fq; asm volatile("" : "+v"(fr_e), "+v"(fq_e));
          p.epi(acc, cur, wr, wc, fr_e, fq_e); }
        if (!has_next) break;
#pragma unroll
        for (int a = 0; a < 2; ++a)
#pragma unroll
            for (int b = 0; b < 2; ++b)
#pragma unroll
                for (int m = 0; m < 4; ++m)
#pragma unroll
                    for (int n = 0; n < 2; ++n) acc[a][b][m][n] = (f32x4){0.f, 0.f, 0.f, 0.f};
        cur = nxt; ++ui;
        if (wr == 1) PG8_BAR;
    }
    PG8_WAIT_V(0);
    PG8_BAR;
#undef PG8_SA
#undef PG8_SB
#undef PG8_STAGE
#undef PG8_LDA
#undef PG8_LDB
#undef PG8_MMA
#undef PG8_WAIT_V
#undef PG8_WAIT_L
#undef PG8_BAR
#undef PG8_SCHED
#undef PG8_OFFS
#undef PG8_KEYS
}
}
using pg8::Unit;

#define TROW(ai, wr, m, fr) (128 * (ai) + 64 * (wr) + 16 * (m) + (fr))
#define TCOLP(bj, wc, fq) (128 * (bj) + 32 * (wc) + 8 * (fq))
#define TCOLN(bj, wc, n, fq) (128 * (bj) + 32 * (wc) + 16 * (n) + 4 * (fq))
__device__ __forceinline__ v4u pack8(const f32x4 a, const f32x4 b) { v4u w; w.x = pk2(a[0], a[1]); w.y = pk2(a[2], a[3]); w.z = pk2(b[0], b[1]); w.w = pk2(b[2], b[3]); return w; }

struct PolDenseBf16 {
    static constexpr bool PERM = true;
    static constexpr bool KEYS = false;
    __device__ __forceinline__ const int* key_ptr(const Unit&, int) const { return nullptr; }
    const char* A; const char* B; int nt; int nM, nN, pm0, G, c; unsigned pitchA, pitchB; bf16* O; int ldo;
    __device__ __forceinline__ bool next(int i, Unit& u) const { int pm, pn; if (!pg8::static_next(i, G, c, nM, nN, pm, pn)) return false; u.pm = pm + pm0; u.pn = pn; u.aux = 0; return true; }
    __device__ __forceinline__ unsigned a_row(const Unit& u, int r, int) const { return (unsigned)(u.pm * 256 + r) * pitchA; }
    __device__ __forceinline__ unsigned b_row(const Unit& u, int r) const { return (unsigned)(u.pn * 256 + r) * pitchB; }
    __device__ __forceinline__ void epi(const pg8::Acc& acc, const Unit& u, int wr, int wc, int fr, int fq) const {
#pragma unroll
        for (int ai = 0; ai < 2; ++ai)
#pragma unroll
            for (int m = 0; m < 4; ++m) { const size_t row = (size_t)u.pm * 256 + TROW(ai, wr, m, fr);
#pragma unroll
                for (int bj = 0; bj < 2; ++bj) { const int col = u.pn * 256 + TCOLP(bj, wc, fq); *(v4u*)(O + row * ldo + col) = pack8(acc[ai][bj][m][0], acc[ai][bj][m][1]); } }
    }
};

struct PolOut {
    static constexpr bool PERM = true;
    static constexpr bool KEYS = false;
    __device__ __forceinline__ const int* key_ptr(const Unit&, int) const { return nullptr; }
    const char* A; const char* B; int nt; int nM, nN, pm0, G, c; bf16* X; const float* mod;
    int chunk; const float* XinC; const float* XinL;
    __device__ __forceinline__ bool next(int i, Unit& u) const { int pm, pn; if (!pg8::static_next(i, G, c, nM, nN, pm, pn)) return false; u.pm = pm + pm0; u.pn = pn; u.aux = 0; return true; }
    __device__ __forceinline__ unsigned a_row(const Unit& u, int r, int) const { return (unsigned)(u.pm * 256 + r) * 2048u; }
    __device__ __forceinline__ unsigned b_row(const Unit& u, int r) const { return (unsigned)(u.pn * 256 + r) * 2048u; }
    __device__ __forceinline__ void epi(const pg8::Acc& acc, const Unit& u, int wr, int wc, int fr, int fq) const {
        const int mr = modrow_of(u.pm * 256);
        const float* g = mod + (size_t)mr * (NMOD * D) + chunk * D;
        const float* xin = XinC ? (u.pm < 8 ? XinC : XinL) : nullptr;
#pragma unroll
        for (int bj = 0; bj < 2; ++bj) { const int col = u.pn * 256 + TCOLP(bj, wc, fq); const f32x4 g0 = *(const f32x4*)(g + col), g1 = *(const f32x4*)(g + col + 4);
#pragma unroll
            for (int ai = 0; ai < 2; ++ai)
#pragma unroll
                for (int m = 0; m < 4; ++m) { const size_t off = ((size_t)u.pm * 256 + TROW(ai, wr, m, fr)) * D + col; f32x4 x0, x1;
                    if (xin) { x0 = *(const f32x4*)(xin + off); x1 = *(const f32x4*)(xin + off + 4); }
                    else { const v4u w = *(const v4u*)(X + off); x0 = (f32x4){bf_lo(w.x), bf_hi(w.x), bf_lo(w.y), bf_hi(w.y)}; x1 = (f32x4){bf_lo(w.z), bf_hi(w.z), bf_lo(w[3]), bf_hi(w[3])}; }
                    *(v4u*)(X + off) = pack8(x0 + g0 * acc[ai][bj][m][0], x1 + g1 * acc[ai][bj][m][1]); } }
    }
};

struct PolFP {
    static constexpr bool PERM = true;
    static constexpr bool KEYS = false;
    __device__ __forceinline__ const int* key_ptr(const Unit&, int) const { return nullptr; }
    const char* A; const char* B; int nt; int nN, G, c; bf16* Z; bf16* Zc;
    __device__ __forceinline__ bool next(int i, Unit& u) const { int pm, pn; if (!pg8::static_next(i, G, c, 8, nN, pm, pn)) return false; u.pm = pm; u.pn = pn; u.aux = 0; return true; }
    __device__ __forceinline__ unsigned a_row(const Unit& u, int r, int) const { return (unsigned)(u.pm * 256 + r) * 2048u; }
    __device__ __forceinline__ unsigned b_row(const Unit& u, int r) const {
        int hrow;
        if (u.pn < 128) { const int n = u.pn * 256 + r, b = n >> 12, l2 = (n >> 6) & 63, l1 = n & 63; hrow = NC + b * SEQ + 64 * l1 + l2; }
        else hrow = (u.pn - 128) * 256 + r;
        return (unsigned)hrow * 2048u;
    }
    __device__ __forceinline__ void epi(const pg8::Acc& acc, const Unit& u, int wr, int wc, int fr, int fq) const {
#pragma unroll
        for (int ai = 0; ai < 2; ++ai)
#pragma unroll
            for (int m = 0; m < 4; ++m) { const int cp = u.pm * 256 + TROW(ai, wr, m, fr);
#pragma unroll
                for (int bj = 0; bj < 2; ++bj) { const int n0 = u.pn * 256 + TCOLP(bj, wc, fq); const v4u w = pack8(acc[ai][bj][m][0], acc[ai][bj][m][1]);
                    if (u.pn < 128) *(v4u*)(Z + ((size_t)(n0 >> 6) * 2048 + cp) * 64 + (n0 & 63)) = w;
                    else { const int b = u.pn - 128, l = n0 - 32768 - b * 256; *(v4u*)(Zc + ((size_t)b * 2048 + cp) * 256 + l) = w; } } }
    }
};

struct PolFA {
    static constexpr bool PERM = true;
    static constexpr bool KEYS = false;
    __device__ __forceinline__ const int* key_ptr(const Unit&, int) const { return nullptr; }
    const char* A; const char* B; int nt; int G, c; bf16* Y;
    __device__ __forceinline__ bool next(int i, Unit& u) const { const int L = i * G + c; if (L >= 1024) return false; u.pm = 0; u.pn = L & 127; u.aux = L >> 7; return true; }
    __device__ __forceinline__ unsigned a_row(const Unit&, int r, int) const { return (unsigned)r * 512u; }
    __device__ __forceinline__ unsigned b_row(const Unit& u, int r) const { const int l2 = r & 63, cp = u.pn * 4 + (r >> 6); return (unsigned)((u.aux * 64 + l2) * 512 + cp) * 512u; }
    __device__ __forceinline__ void epi(const pg8::Acc& acc, const Unit& u, int wr, int wc, int fr, int fq) const {
        const int b = u.aux;
#pragma unroll
        for (int ai = 0; ai < 2; ++ai)
#pragma unroll
            for (int m = 0; m < 4; ++m) { const int rr = TROW(ai, wr, m, fr), jp = rr >> 7, pp = (rr >> 6) & 1, k1 = rr & 63;
#pragma unroll
                for (int bj = 0; bj < 2; ++bj) { const int n0 = u.pn * 256 + TCOLP(bj, wc, fq), cp = n0 >> 6, l2 = n0 & 63, cc = 2 * cp + jp;
                    const size_t idx = ((((size_t)(b * 16 + (k1 >> 2)) * 1024 + cc) * 4 + (k1 & 3)) * 2 + pp) * 64 + l2;
                    *(v4u*)(Y + idx) = pack8(acc[ai][bj][m][0], acc[ai][bj][m][1]); } }
    }
};

struct PolFC {
    static constexpr bool PERM = true;
    static constexpr bool KEYS = false;
    __device__ __forceinline__ const int* key_ptr(const Unit&, int) const { return nullptr; }
    const char* A; const char* B; int nt; int G, c; int nunits; unsigned offMC, offZc; bf16* F;
    __device__ __forceinline__ bool next(int i, Unit& u) const { const int L = i * G + c; if (L >= nunits) return false;
        if (L < 512) { u.pm = 0; u.pn = L & 3; u.aux = L >> 2; } else { const int q = L - 512; u.pm = 0; u.pn = q & 3; u.aux = 256 + (q >> 2); } return true; }
    __device__ __forceinline__ unsigned a_row(const Unit& u, int r, int) const {
        if (u.aux < 256) return offMC + (unsigned)((u.aux & 15) * 256 + r) * 1024u;
        return (unsigned)r * 1024u; }
    __device__ __forceinline__ unsigned b_row(const Unit& u, int r) const {
        if (u.aux < 256) return (unsigned)(u.aux * 1024 + u.pn * 256 + r) * 1024u;
        return offZc + (unsigned)((u.aux - 256) * 1024 + u.pn * 256 + r) * 1024u; }
    __device__ __forceinline__ void epi(const pg8::Acc& acc, const Unit& u, int wr, int wc, int fr, int fq) const {
#pragma unroll
        for (int ai = 0; ai < 2; ++ai)
#pragma unroll
            for (int m = 0; m < 4; ++m) { const int rr = TROW(ai, wr, m, fr); size_t frow;
                if (u.aux < 256) { const int b = u.aux >> 4, kq = u.aux & 15, k = 4 * kq + (rr >> 6) + 64 * (rr & 63); frow = (size_t)NC + b * SEQ + k; }
                else frow = (size_t)(u.aux - 256) * LCTX + rr;
#pragma unroll
                for (int bj = 0; bj < 2; ++bj) { const int col = u.pn * 256 + TCOLP(bj, wc, fq); *(v4u*)(F + frow * D + col) = pack8(acc[ai][bj][m][0], acc[ai][bj][m][1]); } }
    }
};

struct PolMlaQ {
    static constexpr bool PERM = true;
    static constexpr bool KEYS = false;
    __device__ __forceinline__ const int* key_ptr(const Unit&, int) const { return nullptr; }
    const char* A; const char* B; int nt; int nM, nN, G, c; bf16* Q; const float* rope; float c2;
    __device__ __forceinline__ bool next(int i, Unit& u) const { int pm, pn; if (!pg8::static_next(i, G, c, nM, nN, pm, pn)) return false; u.pm = pm; u.pn = pn; u.aux = 0; return true; }
    __device__ __forceinline__ unsigned a_row(const Unit& u, int r, int) const { return (unsigned)(u.pm * 256 + r) * (unsigned)(MLA_QL * 2); }
    __device__ __forceinline__ unsigned b_row(const Unit& u, int r) const { return (unsigned)(u.pn * 256 + r) * (unsigned)(MLA_QL * 2); }
    __device__ __forceinline__ void epi(const pg8::Acc& acc, const Unit& u, int wr, int wc, int fr, int fq) const {
        const bool lat = u.pm >= 8;
#pragma unroll
        for (int bj = 0; bj < 2; ++bj) { const int col = u.pn * 256 + TCOLP(bj, wc, fq); const bool isrope = lat && (((col >> 5) % 3) == 2);
#pragma unroll
            for (int ai = 0; ai < 2; ++ai)
#pragma unroll
                for (int m = 0; m < 4; ++m) { const int row = u.pm * 256 + TROW(ai, wr, m, fr); f32x4 v0 = acc[ai][bj][m][0], v1 = acc[ai][bj][m][1];
                    if (isrope) { const int t = (row - NC) & 4095, pos = (fq & 2) ? (t & 63) : (t >> 6);
                        const f32x4* rp = (const f32x4*)(rope + (size_t)pos * 16);
                        const f32x4 r0 = rp[0], r1 = rp[1], r2 = rp[2], r3 = rp[3];
                        f32x4 p0, p1;
#pragma unroll
                        for (int e = 0; e < 4; ++e) { p0[e] = __shfl_xor(v0[e], 16); p1[e] = __shfl_xor(v1[e], 16); }
                        const float sg = (fq & 1) ? 1.f : -1.f;
                        v0[0] = v0[0] * r0[0] + sg * p0[0] * r0[1]; v0[1] = v0[1] * r0[2] + sg * p0[1] * r0[3];
                        v0[2] = v0[2] * r1[0] + sg * p0[2] * r1[1]; v0[3] = v0[3] * r1[2] + sg * p0[3] * r1[3];
                        v1[0] = v1[0] * r2[0] + sg * p1[0] * r2[1]; v1[1] = v1[1] * r2[2] + sg * p1[1] * r2[3];
                        v1[2] = v1[2] * r3[0] + sg * p1[2] * r3[1]; v1[3] = v1[3] * r3[2] + sg * p1[3] * r3[3]; }
                    *(v4u*)(Q + (size_t)row * 1536 + col) = pack8(v0 * c2, v1 * c2); } }
    }
};

struct PolMlaKV {
    static constexpr bool PERM = true;
    static constexpr bool KEYS = false;
    __device__ __forceinline__ const int* key_ptr(const Unit&, int) const { return nullptr; }
    const char* A; const char* B; int nt; int nM, nN, G, c; bf16* Kb; bf16* Vb;
    __device__ __forceinline__ bool next(int i, Unit& u) const { int pm, pn; if (!pg8::static_next(i, G, c, nM, nN, pm, pn)) return false; u.pm = pm; u.pn = pn; u.aux = 0; return true; }
    __device__ __forceinline__ unsigned a_row(const Unit& u, int r, int) const { return (unsigned)(u.pm * 256 + r) * 512u; }
    __device__ __forceinline__ unsigned b_row(const Unit& u, int r) const { return (unsigned)(u.pn * 256 + r) * 512u; }
    __device__ __forceinline__ void epi(const pg8::Acc& acc, const Unit& u, int wr, int wc, int fr, int fq) const {
#pragma unroll
        for (int bj = 0; bj < 2; ++bj) { const int col = u.pn * 256 + TCOLP(bj, wc, fq), h = col >> 7, j = col & 127;
#pragma unroll
            for (int ai = 0; ai < 2; ++ai)
#pragma unroll
                for (int m = 0; m < 4; ++m) { const size_t row = (size_t)u.pm * 256 + TROW(ai, wr, m, fr); const v4u w = pack8(acc[ai][bj][m][0], acc[ai][bj][m][1]);
                    if (j < 64) *(v4u*)(Kb + row * 1536 + 96 * h + j) = w; else *(v4u*)(Vb + row * 1024 + 64 * h + (j - 64)) = w; } }
    }
};

struct MoeTab { const LAS int* TT; const LAS int* CN; const LAS int* TE; };
__device__ __forceinline__ bool moe_next(int i, int G, int c, int NP, const MoeTab& T, Unit& u) {
    const int ttot = T.TT[32];
    int lo, hi, j;
    if ((G & 7) == 0) { const int x = c & 7, q = c >> 3, g8 = G >> 3; lo = (x * ttot) >> 3; hi = ((x + 1) * ttot) >> 3; j = i * g8 + q; }
    else { lo = 0; hi = ttot; j = i * G + c; }
    if (j >= (hi - lo) * NP) return false;
    const int tile = lo + j / NP; u.pn = j % NP; u.pm = tile;
    const int e = T.TE[tile];
    u.aux = e | ((tile - T.TT[e]) << 8);
    return true;
}
struct PolMoe1 {
    static constexpr bool PERM = true;
    const char* A; const char* B; int nt; int G, c; MoeTab T; const int* stok; const float* bgu; bf16* act;
    __device__ __forceinline__ bool next(int i, Unit& u) const { return moe_next(i, G, c, 8, T, u); }
    static constexpr bool KEYS = true;
    __device__ __forceinline__ const int* key_ptr(const Unit& u, int r) const { const int e = u.aux & 255, idx = (u.aux >> 8) * 256 + r; const int cn = T.CN[e]; return stok + (size_t)e * CAP + (idx < cn ? idx : 0); }
    __device__ __forceinline__ unsigned a_row(const Unit&, int, int key) const { return (unsigned)key * 2048u; }
    __device__ __forceinline__ unsigned b_row(const Unit& u, int r) const { return (unsigned)((u.aux & 255) * 2048 + u.pn * 256 + r) * 2048u; }
    __device__ __forceinline__ void epi(const pg8::Acc& acc, const Unit& u, int wr, int wc, int fr, int fq) const {
        const int e = u.aux & 255; const int jl = 32 * wc + 8 * fq;
        const float* bg = bgu + (size_t)e * 2048 + u.pn * 256 + jl;
        const f32x4 bg0 = *(const f32x4*)(bg), bg1 = *(const f32x4*)(bg + 4), bu0 = *(const f32x4*)(bg + 128), bu1 = *(const f32x4*)(bg + 132);
#pragma unroll
        for (int ai = 0; ai < 2; ++ai)
#pragma unroll
            for (int m = 0; m < 4; ++m) { const size_t slot = (size_t)u.pm * 256 + TROW(ai, wr, m, fr);
                f32x4 g0 = acc[ai][0][m][0] + bg0, g1 = acc[ai][0][m][1] + bg1, u0 = acc[ai][1][m][0] + bu0, u1 = acc[ai][1][m][1] + bu1, o0, o1;
#pragma unroll
                for (int q = 0; q < 4; ++q) {
                    float ga = fminf(g0[q], 7.f), ua = fminf(fmaxf(u0[q], -7.f), 7.f); o0[q] = (ua + 1.f) * ga * __builtin_amdgcn_rcpf(1.f + __builtin_amdgcn_exp2f(-1.702f * LOG2E * ga));
                    float gb = fminf(g1[q], 7.f), ub = fminf(fmaxf(u1[q], -7.f), 7.f); o1[q] = (ub + 1.f) * gb * __builtin_amdgcn_rcpf(1.f + __builtin_amdgcn_exp2f(-1.702f * LOG2E * gb)); }
                *(v4u*)(act + slot * 1024 + u.pn * 128 + jl) = pack8(o0, o1); }
    }
};
struct PolMoe2 {
    static constexpr bool PERM = true;
    static constexpr bool KEYS = false;
    __device__ __forceinline__ const int* key_ptr(const Unit&, int) const { return nullptr; }
    const char* A; const char* B; int nt; int G, c; MoeTab T; const float* sw; const float* bdn; bf16* Y;
    __device__ __forceinline__ bool next(int i, Unit& u) const { return moe_next(i, G, c, 4, T, u); }
    __device__ __forceinline__ unsigned a_row(const Unit& u, int r, int) const { return (unsigned)(u.pm * 256 + r) * 2048u; }
    __device__ __forceinline__ unsigned b_row(const Unit& u, int r) const { return (unsigned)((u.aux & 255) * 1024 + u.pn * 256 + r) * 2048u; }
    __device__ __forceinline__ void epi(const pg8::Acc& acc, const Unit& u, int wr, int wc, int fr, int fq) const {
        const int e = u.aux & 255, mt = u.aux >> 8, cn = T.CN[e];
        f32x4 bv[2][2];
#pragma unroll
        for (int bj = 0; bj < 2; ++bj) { const float* bp = bdn + (size_t)e * 1024 + u.pn * 256 + TCOLP(bj, wc, fq); bv[bj][0] = *(const f32x4*)bp; bv[bj][1] = *(const f32x4*)(bp + 4); }
#pragma unroll
        for (int ai = 0; ai < 2; ++ai)
#pragma unroll
            for (int m = 0; m < 4; ++m) { const int rr = TROW(ai, wr, m, fr), idx = mt * 256 + rr; const size_t slot = (size_t)u.pm * 256 + rr;
                const float w = sw[(size_t)e * CAP + (idx < cn ? idx : 0)];
#pragma unroll
                for (int bj = 0; bj < 2; ++bj) { const int col = u.pn * 256 + TCOLP(bj, wc, fq);
                    *(v4u*)(Y + slot * 1024 + col) = pack8((acc[ai][bj][m][0] + bv[bj][0]) * w, (acc[ai][bj][m][1] + bv[bj][1]) * w); } }
    }
};

namespace att {
__device__ __forceinline__ int crow(int r, int hi) { return (r & 3) + 8 * (r >> 2) + 4 * hi; }
__device__ __forceinline__ float max3f(float a, float b, float c) { return fmaxf(fmaxf(a, b), c); }
typedef LAS const char* lds_cptr;
constexpr int LK = 0, LV = 49152, LWS = 90112, LOST = 92160, LBYTES = 124928;
constexpr int PD = 3;
struct Tens { const bf16* Q; int qpitch; const bf16* K; int kpitch; const bf16* V; int vpitch; bf16* O; };
#define ATT_WAITV(n) asm volatile("s_waitcnt vmcnt(" #n ")" ::: "memory")
struct Pend { f32x16 o0, o1; float l; int qrow0, oc0; bool valid; };
__device__ __forceinline__ void finish_unit(const Pend& P, bf16* O, LAS unsigned char* lds, int wid, int lane) {
    const int r32 = lane & 31, hi = lane >> 5;
    LAS float* wsf = (LAS float*)(lds + LWS) + wid * 64;
    float lrun = P.l;
    { auto rr = __builtin_amdgcn_permlane32_swap(__float_as_uint(lrun), __float_as_uint(lrun), false, false); lrun = __uint_as_float(rr[0]) + __uint_as_float(rr[1]); }
    if (hi == 0) wsf[32 + r32] = lrun;
    LDS_WAIT();
    LAS bf16* stg = (LAS bf16*)(lds + LOST) + wid * 2048;
#pragma unroll
    for (int r = 0; r < 16; ++r) { const int orow = crow(r, hi); const float rl = __builtin_amdgcn_rcpf(wsf[32 + orow]);
        stg[orow * 64 + r32] = (bf16)(pk2(P.o0[r] * rl, 0.f) & 0xffffu); stg[orow * 64 + 32 + r32] = (bf16)(pk2(P.o1[r] * rl, 0.f) & 0xffffu); }
    LDS_WAIT();
    bf16* Ow = O + (size_t)(P.qrow0 + wid * 32) * 1024 + P.oc0;
#pragma unroll
    for (int i = 0; i < 4; ++i) { const int row = i * 8 + (lane >> 3), ch = lane & 7; const v4u v = *(const LAS v4u*)(stg + row * 64 + ch * 8); *(v4u*)(Ow + (size_t)row * 1024 + ch * 8) = v; }
    LDS_WAIT();
}
template <int DK>
__device__ __forceinline__ void unit(const Tens& T, int qrow0, int qc0, int kc0, int vc0, int oc0, int kctx0, int klat0, int NTL, LAS unsigned char* lds, int wave_id, Pend& pend) {
    constexpr int ND = DK / 16;
    wave_id = launder_s(wave_id); const int tid = lthread_w(wave_id), lane = tid & 63, r32 = lane & 31, hi = lane >> 5; const int wid = wave_id;
    LAS float* wsf = (LAS float*)(lds + LWS) + wid * 64;
    const bf16* ksrc = T.K + (size_t)lane * T.kpitch + kc0 + wid * 8;
    const bf16* ksrc2 = T.K + (size_t)lane * T.kpitch + kc0 + (8 + (wid & 3)) * 8;
    const bf16* vsrc = T.V + (size_t)(16 * (wid & 3) + (lane >> 2)) * T.vpitch + vc0 + (wid >> 2) * 32 + (lane & 3) * 8;
#define ATT_DMA(t, ks_, vs_) do { const size_t row0_ = (size_t)((t) < 4 ? kctx0 + 64 * (t) : klat0 + 64 * ((t) - 4)); \
        __builtin_amdgcn_global_load_lds((const unsigned*)(ksrc + row0_ * T.kpitch), (LAS unsigned*)(lds + LK + (ks_) * 12288 + wid * 1024), 16, 0, 0); \
        if (DK > 64) __builtin_amdgcn_global_load_lds((const unsigned*)(ksrc2 + row0_ * T.kpitch), (LAS unsigned*)(lds + LK + (ks_) * 12288 + 8192 + (wid & 3) * 1024), 16, 0, 0); \
        __builtin_amdgcn_global_load_lds((const unsigned*)(vsrc + row0_ * T.vpitch), (LAS unsigned*)(lds + LV + (vs_) * 8192 + wid * 1024), 16, 0, 0); } while (0)
#define ATT_WAIT_TILES(n_tiles) do { if (DK > 64) { if ((n_tiles) >= 2) ATT_WAITV(6); else if ((n_tiles) == 1) ATT_WAITV(3); else ATT_WAITV(0); } \
        else { if ((n_tiles) >= 2) ATT_WAITV(4); else if ((n_tiles) == 1) ATT_WAITV(2); else ATT_WAITV(0); } } while (0)
    bf16x8 qr[ND];
    { const bf16* qp = T.Q + (size_t)(qrow0 + wid * 32 + r32) * T.qpitch + qc0 + hi * 8;
#pragma unroll
      for (int d0 = 0; d0 < ND; ++d0) qr[d0] = *(const bf16x8*)(qp + d0 * 16); }
    asm volatile("" ::: "memory");
    constexpr float THR = 8.f;
    const int half = wid >> 2;
    float mhat = 0.f, lrun = 0.f; f32x16 o[2]; o[0] = f32x16{}; o[1] = f32x16{}; f32x16 negm = f32x16{};
    f32x16 p0 = f32x16{}, p1 = f32x16{}; v4u pw[4]; pw[0] = pw[1] = pw[2] = pw[3] = (v4u){0u, 0u, 0u, 0u};
    ATT_DMA(0, 0, 0); ATT_DMA(1, 1, 1); ATT_DMA(2, 2, 2);
    if (pend.valid) finish_unit(pend, T.O, lds, wid, lane);
    ATT_WAIT_TILES(2);
    __builtin_amdgcn_s_barrier(); asm volatile("" ::: "memory");
    if (half == 1) __builtin_amdgcn_s_barrier();
    int vs_prev = 0, vs_cur = 0, vs_iss = 3;
    for (int t = 0; t <= NTL; ++t) {
        {
            s16x4 lo[2][4], hh[2][4]; bf16x8 kf[2 * ND];
            if (t >= 1) {
                const unsigned vb = (unsigned)(uintptr_t)(lds + LV + vs_prev * 8192) + ((lane >> 4) & 1) * 32 + (lane & 3) * 8 + (4 * hi + ((lane & 15) >> 2)) * 64;
#pragma unroll
                for (int d0 = 0; d0 < 2; ++d0)
#pragma unroll
                    for (int ks = 0; ks < 4; ++ks) {
                        asm volatile("ds_read_b64_tr_b16 %0,%1 offset:%c2" : "=&v"(lo[d0][ks]) : "v"(vb), "i"(d0 * 4096 + ks * 1024) : "memory");
                        asm volatile("ds_read_b64_tr_b16 %0,%1 offset:%c2" : "=&v"(hh[d0][ks]) : "v"(vb), "i"(d0 * 4096 + ks * 1024 + 512) : "memory"); }
            }
            if (t < NTL) {
                const lds_cptr kb = (lds_cptr)(lds + LK + (t & 3) * 12288) + hi * 1024 + r32 * 16;
#pragma unroll
                for (int d0 = 0; d0 < ND; ++d0) { kf[2 * d0] = *(const LAS bf16x8*)(kb + d0 * 2048); kf[2 * d0 + 1] = *(const LAS bf16x8*)(kb + d0 * 2048 + 512); }
            }
            asm volatile("s_waitcnt lgkmcnt(0)" ::: "memory"); __builtin_amdgcn_sched_barrier(0);
            if (t >= 1) {
#pragma unroll
                for (int ks = 0; ks < 4; ++ks)
#pragma unroll
                    for (int d0 = 0; d0 < 2; ++d0) { const bf16x8 vf = (bf16x8){lo[d0][ks][0], lo[d0][ks][1], lo[d0][ks][2], lo[d0][ks][3], hh[d0][ks][0], hh[d0][ks][1], hh[d0][ks][2], hh[d0][ks][3]};
                        o[d0] = __builtin_amdgcn_mfma_f32_32x32x16_bf16(__builtin_bit_cast(bf16x8, pw[ks]), vf, o[d0], 0, 0, 0); }
            }
            if (t < NTL) {
#pragma unroll
                for (int d0 = 0; d0 < ND; ++d0) {
                    if (d0 == 0) { p0 = __builtin_amdgcn_mfma_f32_32x32x16_bf16(kf[0], qr[0], negm, 0, 0, 0); p1 = __builtin_amdgcn_mfma_f32_32x32x16_bf16(kf[1], qr[0], negm, 0, 0, 0); }
                    else { p0 = __builtin_amdgcn_mfma_f32_32x32x16_bf16(kf[2 * d0], qr[d0], p0, 0, 0, 0); p1 = __builtin_amdgcn_mfma_f32_32x32x16_bf16(kf[2 * d0 + 1], qr[d0], p1, 0, 0, 0); } }
            }
        }
        if (half == 1) {
            const int last_iss = (t + PD - 1 < NTL - 1) ? t + PD - 1 : NTL - 1; const int allow = last_iss - (t + 1);
            if (allow >= 1) ATT_WAIT_TILES(1); else ATT_WAIT_TILES(0); }
        asm volatile("s_waitcnt lgkmcnt(0)" ::: "memory"); __builtin_amdgcn_s_barrier(); asm volatile("" ::: "memory");
        if (t < NTL) {
            float rm = max3f(p0[0], p0[1], p1[0]);
#pragma unroll
            for (int r = 0; r < 16; ++r) rm = max3f(rm, p0[r], p1[r]);
            { auto rr = __builtin_amdgcn_permlane32_swap(__float_as_uint(rm), __float_as_uint(rm), false, false); rm = fmaxf(__uint_as_float(rr[0]), __uint_as_float(rr[1])); }
            if (t == 0 || __any(rm > THR)) {
                const float dl = (t == 0) ? rm : fmaxf(rm, 0.f);
                mhat += dl;
#pragma unroll
                for (int r = 0; r < 16; ++r) { p0[r] -= dl; p1[r] -= dl; negm[r] = -mhat; }
                const float f = (t == 0) ? 1.f : __builtin_amdgcn_exp2f(-dl); lrun *= f;
                if (hi == 0) wsf[r32] = f;
                LDS_WAIT();
#pragma unroll
                for (int r = 0; r < 16; ++r) { const float a = wsf[crow(r, hi)]; o[0][r] *= a; o[1][r] *= a; }
            }
            float rs = 0.f;
#pragma unroll
            for (int r = 0; r < 16; ++r) { p0[r] = __builtin_amdgcn_exp2f(p0[r]); p1[r] = __builtin_amdgcn_exp2f(p1[r]); rs += p0[r] + p1[r]; }
            lrun += rs;
            pw[0] = (v4u){pk2(p0[0], p0[1]), pk2(p0[2], p0[3]), pk2(p0[4], p0[5]), pk2(p0[6], p0[7])};
            pw[1] = (v4u){pk2(p0[8], p0[9]), pk2(p0[10], p0[11]), pk2(p0[12], p0[13]), pk2(p0[14], p0[15])};
            pw[2] = (v4u){pk2(p1[0], p1[1]), pk2(p1[2], p1[3]), pk2(p1[4], p1[5]), pk2(p1[6], p1[7])};
            pw[3] = (v4u){pk2(p1[8], p1[9]), pk2(p1[10], p1[11]), pk2(p1[12], p1[13]), pk2(p1[14], p1[15])};
        }
        if (t + PD < NTL) { ATT_DMA(t + PD, (t + PD) & 3, vs_iss); vs_iss = (vs_iss == 4) ? 0 : vs_iss + 1; }
        if (half == 0) {
            const int last_iss = (t + PD < NTL - 1) ? t + PD : NTL - 1; const int allow = last_iss - (t + 1);
            if (allow >= 2) ATT_WAIT_TILES(2); else if (allow == 1) ATT_WAIT_TILES(1); else ATT_WAIT_TILES(0); }
        vs_prev = vs_cur; vs_cur = (vs_cur == 4) ? 0 : vs_cur + 1;
        asm volatile("s_waitcnt lgkmcnt(0)" ::: "memory"); __builtin_amdgcn_s_barrier(); asm volatile("" ::: "memory");
    }
    if (half == 0) __builtin_amdgcn_s_barrier();
#undef ATT_DMA
#undef ATT_WAIT_TILES
    pend.o0 = o[0]; pend.o1 = o[1]; pend.l = lrun; pend.qrow0 = qrow0; pend.oc0 = oc0; pend.valid = true;
}
#undef ATT_WAITV
}

struct Args { const float* in[27]; float* out; unsigned char* ws; int ph_lo, ph_hi; };
struct Frame {
    LAS unsigned char* lds; unsigned char* ws; gu32* ctl; int wave, G, gw, NGW;
};
__device__ __forceinline__ int lthread(int wave) { return wave * 64 + lane_id_v(); }

template <int MODE>
__device__ __forceinline__ void conv_item(const float* W, int K, int N, bf16* WT, LAS float* scr, int item, int lane) {
    const int nblk = (N + 63) / 64, kb = item / nblk, nb = item % nblk, k0 = 64 * kb, n0 = 64 * nb;
    f32x4 v[16];
    const int cc = (lane & 15) * 4, rk = lane >> 4;
    const bool ok = (n0 + cc) < N;
#pragma unroll
    for (int i = 0; i < 16; ++i) v[i] = ok ? *(const f32x4*)(W + (size_t)(k0 + 4 * i + rk) * N + n0 + cc) : (f32x4){0.f, 0.f, 0.f, 0.f};
#pragma unroll
    for (int i = 0; i < 16; ++i) { LAS float* s = scr + (4 * i + rk) * 65 + cc; s[0] = v[i][0]; s[1] = v[i][1]; s[2] = v[i][2]; s[3] = v[i][3]; }
    LDS_WAIT(); asm volatile("" ::: "memory");
    const int c = lane & 7;
#pragma unroll
    for (int j = 0; j < 8; ++j) { const int n = (lane >> 3) + 8 * j; const LAS float* s = scr + (8 * c) * 65 + n;
        v4u o; o.x = pk2(s[0], s[65]); o.y = pk2(s[2 * 65], s[3 * 65]); o.z = pk2(s[4 * 65], s[5 * 65]); o.w = pk2(s[6 * 65], s[7 * 65]);
        const int ng = n0 + n; if (ng < N) { const int dr = (MODE == 1) ? ((ng >> 8) * 256 + (ng & 1) * 128 + ((ng >> 1) & 127)) : ng; *(v4u*)(WT + (size_t)dr * K + k0 + 8 * c) = o; } }
    LDS_WAIT(); asm volatile("" ::: "memory");
}

__device__ __forceinline__ void prologue(Frame& F, const Args& a) {
    const int f_tid = lthread(F.wave), f_lane = f_tid & 63;
    unsigned char* ws = F.ws;
    {
        LAS float* scr = (LAS float*)(F.lds + F.wave * 16640);
        struct M { const float* src; int K, N; size_t dst; };
        const int I_FO = 16 * 16, I_MIN = 16 * 11, I_QB = 6 * 24, I_KVB = 4 * 32, I_MO = 256, I_GQKV = 16 * 24, I_GO = 256;
        const int NSMALL = 2 * I_FO + I_MIN + I_QB + I_KVB + I_MO + I_GQKV + I_GO;
        for (int it = F.gw; it < NSMALL; it += F.NGW) {
            int r = it;
            if (r < 2 * I_FO) { const int j = r / I_FO; conv_item<0>(a.in[10] + (size_t)j * D * D, D, D, (bf16*)(ws + WS_WFOUT) + (size_t)j * D * D, scr, r % I_FO, f_lane); continue; } r -= 2 * I_FO;
            if (r < I_MIN) { conv_item<0>(a.in[11], D, MLA_IN, (bf16*)(ws + WS_WMIN), scr, r, f_lane); continue; } r -= I_MIN;
            if (r < I_QB) { conv_item<0>(a.in[13], MLA_QL, 1536, (bf16*)(ws + WS_WMQB), scr, r, f_lane); continue; } r -= I_QB;
            if (r < I_KVB) { conv_item<0>(a.in[15], MLA_KVL, 2048, (bf16*)(ws + WS_WMKVB), scr, r, f_lane); continue; } r -= I_KVB;
            if (r < I_MO) { conv_item<0>(a.in[16], D, D, (bf16*)(ws + WS_WMO), scr, r, f_lane); continue; } r -= I_MO;
            if (r < I_GQKV) { conv_item<0>(a.in[17], D, GQA_QKV, (bf16*)(ws + WS_WGQKV), scr, r, f_lane); continue; } r -= I_GQKV;
            conv_item<0>(a.in[20], D, D, (bf16*)(ws + WS_WGO), scr, r, f_lane);
        }
        const int I_GU = 16 * 32, I_DN = 16 * 16, I_E = I_GU + I_DN, NMOE = DEPTH * NE * I_E;
        for (int it = F.gw; it < NMOE; it += F.NGW) {
            const int le = it / I_E, r = it % I_E;
            if (r < I_GU) conv_item<1>(a.in[23] + (size_t)le * D * 2048, D, 2048, (bf16*)(ws + WS_WGU) + (size_t)le * 2048 * D, scr, r, f_lane);
            else conv_item<0>(a.in[25] + (size_t)le * DFF * D, DFF, D, (bf16*)(ws + WS_WDN) + (size_t)le * D * DFF, scr, r - I_GU, f_lane);
        }
    }
    const int gtid = blockIdx.x * 512 + f_tid, gthreads = F.G * 512;
    for (int i = gtid; i < (MLA_IN_PAD - MLA_IN) * D / 8; i += gthreads) ((v4u*)((bf16*)(ws + WS_WMIN) + (size_t)MLA_IN * D))[i] = (v4u){0u, 0u, 0u, 0u};
    {
        bf16* MA = (bf16*)(ws + WS_MA);
        for (int i = gtid; i < 256 * 256; i += gthreads) { const int row = i >> 8, col = i & 255, jp = row >> 7, pp = (row >> 6) & 1, k1 = row & 63, j = col >> 7, pt = (col >> 6) & 1, l1 = col & 63;
            float v = 0.f; if (j == jp) { const float x = 2.f * (float)((k1 * l1) & 63) / 64.f; const float cs = cospif(x), sn = sinpif(x); v = (pp == 0) ? (pt == 0 ? cs : sn) : (pt == 0 ? -sn : cs); }
            MA[i] = (bf16)(pk2(v, 0.f) & 0xffffu); }
        bf16* DC = (bf16*)(ws + WS_DC); const float sc = 1.0f / sqrtf(256.f * 128.f);
        for (int i = gtid; i < 256 * 512; i += gthreads) { const int k = i >> 9, col = i & 511, pt = col >> 8, l = col & 255; const float x = 2.f * (float)((k * l) & 255) / 256.f;
            const float v = (pt == 0 ? cospif(x) : sinpif(x)) * sc; DC[i] = (bf16)(pk2(v, 0.f) & 0xffffu); }
        bf16* MC = (bf16*)(ws + WS_MC); const float sl = 1.0f / sqrtf(4096.f * 128.f);
        for (int i = gtid; i < 16 * 256 * 512; i += gthreads) { const int kq = i >> 17, row = (i >> 9) & 255, col = i & 511, kkp = row >> 6, k2 = row & 63, kk = col >> 7, pp = (col >> 6) & 1, l2 = col & 63;
            float v = 0.f; if (kk == kkp) { const int k = 4 * kq + kkp + 64 * k2; const float x = 2.f * (float)((l2 * k) & 4095) / 4096.f; v = (pp == 0 ? cospif(x) : sinpif(x)) * sl; }
            MC[i] = (bf16)(pk2(v, 0.f) & 0xffffu); }
        float* RM = (float*)(ws + WS_ROPE); float* RG = RM + 2048;
        for (int i = gtid; i < 64 * 8; i += gthreads) { const int pos = i >> 3, f = i & 7; const float inv = powf(10000.f, -(float)f / 8.f); float s, c; sincosf((float)pos * inv, &s, &c); RM[2 * i] = c; RM[2 * i + 1] = s; }
        for (int i = gtid; i < 64 * 16; i += gthreads) { const int pos = i >> 4, f = i & 15; const float inv = powf(10000.f, -(float)f / 16.f); float s, c; sincosf((float)pos * inv, &s, &c); RG[2 * i] = c; RG[2 * i + 1] = s; }
        float* WRT = (float*)(ws + WS_WRT);
        for (int i = gtid; i < DEPTH * NE * D; i += gthreads) { const int l = i >> 15, e = (i >> 10) & 31, k = i & 1023; WRT[i] = a.in[21][((size_t)l * D + k) * NE + e]; }
        float* BG = (float*)(ws + WS_BGU);
        for (int i = gtid; i < DEPTH * NE * 2048; i += gthreads) { const int le = i >> 11, q = i & 2047, pn = q >> 8, s = (q >> 7) & 1, jj = q & 127; BG[i] = a.in[24][(size_t)le * 2048 + 2 * (pn * 128 + jj) + s]; }
    }
    __syncthreads();
    {
        LAS float* wl = (LAS float*)F.lds;
        LAS float* tc = wl + 2048; LAS float* ts = tc + 128;
        if (f_tid < 128) { const float x = 2.f * (float)f_tid / 128.f; tc[f_tid] = cospif(x); ts[f_tid] = -sinpif(x); }
        for (int it = blockIdx.x; it < 2 * 8 * 64; it += F.G) { const int j = it >> 9, g = (it >> 6) & 7, kb = it & 63;
            __syncthreads();
            { const int kk = f_tid >> 5, c4 = (f_tid & 31) * 4; const f32x4 w = *(const f32x4*)(a.in[9] + ((size_t)j * D + kb * 16 + kk) * D + g * 128 + c4);
              LAS float* d = wl + c4 * 16 + kk; d[0] = w[0]; d[16] = w[1]; d[32] = w[2]; d[48] = w[3]; }
            __syncthreads();
            const int cl = f_tid & 255, m = cl >> 1, part = cl & 1, kh = f_tid >> 8; const LAS float* tw = part ? ts : tc;
            float accv[8];
#pragma unroll
            for (int q = 0; q < 8; ++q) accv[q] = 0.f;
            for (int jj = 0; jj < 128; ++jj) { const float t = tw[(m * jj) & 127]; const f32x4 wa = *(const LAS f32x4*)(wl + jj * 16 + kh * 8), wb = *(const LAS f32x4*)(wl + jj * 16 + kh * 8 + 4);
                accv[0] += wa[0] * t; accv[1] += wa[1] * t; accv[2] += wa[2] * t; accv[3] += wa[3] * t; accv[4] += wb[0] * t; accv[5] += wb[1] * t; accv[6] += wb[2] * t; accv[7] += wb[3] * t; }
            v4u o; o.x = pk2(accv[0], accv[1]); o.y = pk2(accv[2], accv[3]); o.z = pk2(accv[4], accv[5]); o.w = pk2(accv[6], accv[7]);
            *(v4u*)((bf16*)(ws + WS_WFIN) + ((size_t)j * 2048 + g * 256 + cl) * D + kb * 16 + kh * 8) = o;
        }
        __syncthreads();
    }
    {
        LAS float* S = (LAS float*)F.lds;
        LAS float* red = S + 9 * 1024;
        for (int i = f_tid; i < 9 * 1024; i += 512) { const int r = i >> 10, k = i & 1023; const float v = (r < 8) ? a.in[1][r * D + k] : a.in[3][k]; S[i] = v / (1.f + __expf(-v)); }
        __syncthreads();
        for (int it = blockIdx.x; it < DEPTH * 96; it += F.G) { const int l = it / 96, n0 = (it % 96) * 64;
            const float* wp = a.in[4] + ((size_t)l * D + F.wave * 128) * (NMOD * D) + n0 + f_lane;
            float accv[9];
#pragma unroll
            for (int r = 0; r < 9; ++r) accv[r] = 0.f;
            for (int k0 = 0; k0 < 128; k0 += 32) { float wv[32];
#pragma unroll
                for (int k = 0; k < 32; ++k) wv[k] = wp[(size_t)(k0 + k) * (NMOD * D)];
#pragma unroll
                for (int k = 0; k < 32; ++k)
#pragma unroll
                    for (int r = 0; r < 9; ++r) accv[r] += S[r * 1024 + F.wave * 128 + k0 + k] * wv[k]; }
#pragma unroll
            for (int r = 0; r < 9; ++r) red[(F.wave * 9 + r) * 64 + f_lane] = accv[r];
            __syncthreads();
            for (int i = f_tid; i < 9 * 64; i += 512) { const int r = i >> 6, ln = i & 63; float s = a.in[5][(size_t)l * (NMOD * D) + n0 + ln];
#pragma unroll
                for (int w = 0; w < 8; ++w) s += red[(w * 9 + r) * 64 + ln];
                ((float*)(ws + WS_MOD))[((size_t)l * 9 + r) * (NMOD * D) + n0 + ln] = s; }
            __syncthreads();
        }
    }
}

__device__ __forceinline__ void load_row(const float* p, int lane, f32x4 (&v)[4]) {
#pragma unroll
    for (int j = 0; j < 4; ++j) v[j] = ((const f32x4*)p)[lane + 64 * j];
}
__device__ __forceinline__ void load_row_bf(const bf16* p, int lane, f32x4 (&v)[4]) {
#pragma unroll
    for (int j = 0; j < 4; ++j) { const v2u w = ((const v2u*)p)[lane + 64 * j]; v[j] = (f32x4){bf_lo(w.x), bf_hi(w.x), bf_lo(w.y), bf_hi(w.y)}; }
}
__device__ __forceinline__ void norm_mod(f32x4 (&v)[4], const float* g, const float* shift, const float* scale, int lane) {
    float s = 0.f;
#pragma unroll
    for (int j = 0; j < 4; ++j) s += (v[j][0] * v[j][0] + v[j][1] * v[j][1]) + (v[j][2] * v[j][2] + v[j][3] * v[j][3]);
    const float rstd = rsqrtf(wave_sum(s) * (1.f / D) + EPS);
#pragma unroll
    for (int j = 0; j < 4; ++j) { const f32x4 gv = ((const f32x4*)g)[lane + 64 * j], sh = ((const f32x4*)shift)[lane + 64 * j], sc = ((const f32x4*)scale)[lane + 64 * j];
        v[j] = (v[j] * rstd * gv) * (sc + 1.f) + sh; }
}
__device__ __forceinline__ void store_row_bf16(bf16* p, int lane, const f32x4 (&v)[4]) {
#pragma unroll
    for (int j = 0; j < 4; ++j) { v2u w; w.x = pk2(v[j][0], v[j][1]); w.y = pk2(v[j][2], v[j][3]); ((v2u*)p)[lane + 64 * j] = w; }
}

__device__ __forceinline__ void rp_norm1(Frame& F, const Args& a, int l, int row_lo) {
    const int f_tid = lthread(F.wave), f_lane = f_tid & 63;
    const bf16* X = (const bf16*)(F.ws + WS_X); bf16* H = (bf16*)(F.ws + WS_H); const float* MOD = (const float*)(F.ws + WS_MOD) + (size_t)l * 9 * (NMOD * D);
    for (int row = row_lo + F.gw; row < NT; row += F.NGW) { f32x4 v[4];
        if (l == 0) load_row(row < NC ? a.in[2] + (size_t)row * D : a.in[0] + (size_t)(row - NC) * D, f_lane, v);
        else load_row_bf(X + (size_t)row * D, f_lane, v);
        const float* m = MOD + (size_t)modrow_of(row) * (NMOD * D);
        norm_mod(v, a.in[6] + (size_t)l * D, m, m + D, f_lane); store_row_bf16(H + (size_t)row * D, f_lane, v); }
}

#if MK_N2V2
constexpr int LDS_LIST = LDS_MISC + 768;
__device__ __forceinline__ unsigned row16_max(unsigned k) {
    unsigned t;
    t = (unsigned)__builtin_amdgcn_mov_dpp((int)k, 0xb1, 0xf, 0xf, false); k = k > t ? k : t;
    t = (unsigned)__builtin_amdgcn_mov_dpp((int)k, 0x4e, 0xf, 0xf, false); k = k > t ? k : t;
    t = (unsigned)__builtin_amdgcn_mov_dpp((int)k, 0x124, 0xf, 0xf, false); k = k > t ? k : t;
    t = (unsigned)__builtin_amdgcn_mov_dpp((int)k, 0x128, 0xf, 0xf, false); k = k > t ? k : t;
    return k;
}
__device__ __forceinline__ unsigned wave_max_u(unsigned k) {
    k = row16_max(k);
    const unsigned a = (unsigned)__builtin_amdgcn_readlane((int)k, 0), b = (unsigned)__builtin_amdgcn_readlane((int)k, 16), c = (unsigned)__builtin_amdgcn_readlane((int)k, 32), d = (unsigned)__builtin_amdgcn_readlane((int)k, 48);
    const unsigned ab = a > b ? a : b, cd = c > d ? c : d; return ab > cd ? ab : cd;
}
__device__ __forceinline__ float key_val(unsigned m) { const unsigned u = m & ~31u; return __builtin_bit_cast(float, (u & 0x80000000u) ? (u ^ 0x80000000u) : ~u); }
__device__ __forceinline__ void rp_norm2_router(Frame& F, const Args& a, int l, int row_lo) {
    const int f_tid = lthread(F.wave), f_lane = f_tid & 63;
    const bf16* X = (const bf16*)(F.ws + WS_X); bf16* H = (bf16*)(F.ws + WS_H); const float* MOD = (const float*)(F.ws + WS_MOD) + (size_t)l * 9 * (NMOD * D);
    LAS float* wt = (LAS float*)F.lds;
    { const f32x4* src = (const f32x4*)((const float*)(F.ws + WS_WRT) + (size_t)l * NE * D); f32x4 tv[16];
#pragma unroll
      for (int i = 0; i < 16; ++i) tv[i] = src[f_tid + 512 * i];
#pragma unroll
      for (int i = 0; i < 16; ++i) ((LAS f32x4*)wt)[f_tid + 512 * i] = tv[i]; }
    LAS int* lcnt = (LAS int*)(F.lds + LDS_TT); LAS int* lbase = lcnt + 32;
    LAS v4u* list = (LAS v4u*)(F.lds + LDS_LIST) + F.wave * 68;
    if (f_tid < 32) lcnt[f_tid] = 0;
    __syncthreads();
    const float* gf = a.in[7] + (size_t)l * D;
    f32x4 gv[4];
#pragma unroll
    for (int j = 0; j < 4; ++j) gv[j] = ((const f32x4*)gf)[f_lane + 64 * j];
    const int my_e = f_lane >> 1;
    const float my_b = a.in[22][(size_t)l * NE + my_e];
    int row = row_lo + F.gw, it = 0;
    f32x4 vn[4];
    if (row < NT) load_row_bf(X + (size_t)row * D, f_lane, vn);
    for (; row < NT; row += F.NGW, ++it) {
        f32x4 v[4], sh[4], sc[4];
        const float* m = MOD + (size_t)modrow_of(row) * (NMOD * D);
#pragma unroll
        for (int j = 0; j < 4; ++j) { sh[j] = ((const f32x4*)(m + 3 * D))[f_lane + 64 * j]; sc[j] = ((const f32x4*)(m + 4 * D))[f_lane + 64 * j]; }
        asm volatile("" ::: "memory");
#pragma unroll
        for (int j = 0; j < 4; ++j) v[j] = vn[j];
        { const int nrow = row + F.NGW; if (nrow < NT) load_row_bf(X + (size_t)nrow * D, f_lane, vn); }
        float ssq = 0.f;
#pragma unroll
        for (int j = 0; j < 4; ++j) ssq += (v[j][0] * v[j][0] + v[j][1] * v[j][1]) + (v[j][2] * v[j][2] + v[j][3] * v[j][3]);
        const float rstd = rsqrtf(wave_sum(ssq) * (1.f / D) + EPS);
#pragma unroll
        for (int j = 0; j < 4; ++j) v[j] = (v[j] * rstd * gv[j]) * (sc[j] + 1.f) + sh[j];
        store_row_bf16(H + (size_t)row * D, f_lane, v);
        float p[32];
#pragma unroll
        for (int e = 0; e < 32; ++e) { f32x2 s2 = (f32x2){0.f, 0.f};
#pragma unroll
            for (int j = 0; j < 4; ++j) { const f32x4 w = ((const LAS f32x4*)(wt + e * 1024))[f_lane + 64 * j];
                s2 = __builtin_elementwise_fma((f32x2){v[j][0], v[j][1]}, (f32x2){w[0], w[1]}, s2); s2 = __builtin_elementwise_fma((f32x2){v[j][2], v[j][3]}, (f32x2){w[2], w[3]}, s2); }
            p[e] = s2[0] + s2[1]; }
#pragma unroll
        for (int i = 0; i < 16; ++i) { auto rr = __builtin_amdgcn_permlane32_swap(__float_as_uint(p[i]), __float_as_uint(p[i + 16]), false, false); p[i] = __uint_as_float(rr[0]) + __uint_as_float(rr[1]); }
#pragma unroll
        for (int i = 0; i < 8; ++i) { auto rr = __builtin_amdgcn_permlane16_swap(__float_as_uint(p[i]), __float_as_uint(p[i + 8]), false, false); p[i] = __uint_as_float(rr[0]) + __uint_as_float(rr[1]); }
#pragma unroll
        for (int s = 2; s < 5; ++s) { const int half = 16 >> s, msk = 32 >> s; const bool up = (f_lane & msk) != 0;
#pragma unroll
            for (int i = 0; i < half; ++i) { const float keep = up ? p[i + half] : p[i], send = up ? p[i] : p[i + half]; p[i] = keep + __shfl_xor(send, msk); } }
        const float lgt = p[0] + __shfl_xor(p[0], 1) + my_b;
        unsigned key; { const unsigned u = __builtin_bit_cast(unsigned, lgt); const unsigned o = (u & 0x80000000u) ? ~u : (u | 0x80000000u); key = (o & ~31u) | (unsigned)(31 - my_e); }
        unsigned mk[4];
#pragma unroll
        for (int k = 0; k < 4; ++k) { mk[k] = wave_max_u(key); key = (key == mk[k]) ? 0u : key; }
        const float b0 = key_val(mk[0]);
        const float e1 = __expf(key_val(mk[1]) - b0), e2 = __expf(key_val(mk[2]) - b0), e3 = __expf(key_val(mk[3]) - b0); const float inv = 1.f / (1.f + e1 + e2 + e3);
        if (f_lane < 4) { const unsigned mm = f_lane == 0 ? mk[0] : f_lane == 1 ? mk[1] : f_lane == 2 ? mk[2] : mk[3]; const int me = 31 - (int)(mm & 31u);
            const float mw = (f_lane == 0 ? 1.f : f_lane == 1 ? e1 : f_lane == 2 ? e2 : e3) * inv;
            const int lr = __hip_atomic_fetch_add(lcnt + me, 1, __ATOMIC_RELAXED, __HIP_MEMORY_SCOPE_WORKGROUP);
            LAS unsigned* ep = (LAS unsigned*)(list + it * 4 + f_lane); ep[0] = (unsigned)(row * 4 + f_lane); ep[1] = (unsigned)me; ep[2] = (unsigned)lr; ep[3] = __builtin_bit_cast(unsigned, mw); }
    }
    __syncthreads();
    if (f_tid < 32) { const int c = lcnt[f_tid]; lbase[f_tid] = c ? (int)__hip_atomic_fetch_add((unsigned*)(F.ctl + CW_CNT + (l * 32 + f_tid) * 16), (unsigned)c, RLX_AGENT) : 0; }
    __syncthreads();
    int* te = (int*)(F.ws + WS_TE); int* trank = (int*)(F.ws + WS_TRANK); int* stok = (int*)(F.ws + WS_STOK); float* sw = (float*)(F.ws + WS_SW);
    for (int i = f_lane; i < it * 4; i += 64) { const LAS unsigned* ep = (const LAS unsigned*)(list + i); const unsigned rowk = ep[0], ex = ep[1], lr = ep[2]; const float wv = __builtin_bit_cast(float, ep[3]);
        const int rk = lbase[ex] + (int)lr;
        stok[(size_t)ex * CAP + rk] = (int)(rowk >> 2); sw[(size_t)ex * CAP + rk] = wv; te[rowk] = (int)ex; trank[rowk] = rk; }
}

#endif
__device__ __forceinline__ void moe_table(Frame& F, int l) {
    const int f_tid = lthread(F.wave), f_lane = f_tid & 63;
    LAS int* TT = (LAS int*)(F.lds + LDS_TT); LAS int* CN = TT + 64; LAS int* TE = (LAS int*)(F.lds + LDS_TE);
    __syncthreads();
    if (f_tid < 64) {
        const int c = (f_lane < 32) ? (int)__hip_atomic_load((unsigned*)(F.ctl + CW_CNT + (l * 32 + (f_lane & 31)) * 16), RLX_AGENT) : 0;
        const int tl = (c + 255) >> 8; int v = tl;
#pragma unroll
        for (int o = 1; o < 32; o <<= 1) { const int n = __shfl_up(v, o); if (f_lane >= o) v += n; }
        if (f_lane < 32) { CN[f_lane] = c; TT[f_lane] = v - tl; if (f_lane == 31) TT[32] = v; }
    }
    __syncthreads();
    for (int t = f_tid; t < MAXTILES; t += 512) { int lo = 0, hi = 32;
#pragma unroll
        for (int k = 0; k < 5; ++k) { const int mid = (lo + hi) >> 1; if (TT[mid] <= t) lo = mid; else hi = mid; }
        TE[t] = lo; }
    __syncthreads();
}

#if MK_CBV2
struct CombRow { v2u x[4]; v2u y[4][4]; };
__device__ __forceinline__ void comb_issue(CombRow& R, const bf16* X, const bf16* Y, const LAS int* TT, int row, const v4u te4, const v4u tr4, int lane) {
    const unsigned ee[4] = {te4[0], te4[1], te4[2], te4[3]}, rr[4] = {tr4[0], tr4[1], tr4[2], tr4[3]};
#pragma unroll
    for (int k = 0; k < 4; ++k) { const size_t slot = (size_t)TT[ee[k]] * 256 + rr[k]; const v2u* yp = (const v2u*)(Y + slot * 1024);
#pragma unroll
        for (int j = 0; j < 4; ++j) R.y[k][j] = yp[lane + 64 * j]; }
#pragma unroll
    for (int j = 0; j < 4; ++j) R.x[j] = ((const v2u*)(X + (size_t)row * D))[lane + 64 * j];
}
__device__ __forceinline__ void comb_finish(const CombRow& R, Frame& F, const Args& a, int l, int row, int lane, const float* MOD, const float* MODN, bool lastl) {
    bf16* X = (bf16*)(F.ws + WS_X); bf16* H = (bf16*)(F.ws + WS_H);
    const int mr = modrow_of(row); const float* g5 = MOD + (size_t)mr * (NMOD * D) + 5 * D;
    f32x4 v[4];
#pragma unroll
    for (int j = 0; j < 4; ++j) { f32x4 s = (f32x4){0.f, 0.f, 0.f, 0.f};
#pragma unroll
        for (int k = 0; k < 4; ++k) { const v2u w = R.y[k][j]; s[0] += bf_lo(w.x); s[1] += bf_hi(w.x); s[2] += bf_lo(w.y); s[3] += bf_hi(w.y); }
        const f32x4 gv = ((const f32x4*)g5)[lane + 64 * j]; const v2u xw = R.x[j]; v[j] = (f32x4){bf_lo(xw.x), bf_hi(xw.x), bf_lo(xw.y), bf_hi(xw.y)} + gv * s; }
    if (!lastl) {
        store_row_bf16(X + (size_t)row * D, lane, v);
        const float* m = MODN + (size_t)mr * (NMOD * D);
        norm_mod(v, a.in[6] + (size_t)(l + 1) * D, m, m + D, lane); store_row_bf16(H + (size_t)row * D, lane, v);
    } else {
        float ss = 0.f;
#pragma unroll
        for (int j = 0; j < 4; ++j) ss += (v[j][0] * v[j][0] + v[j][1] * v[j][1]) + (v[j][2] * v[j][2] + v[j][3] * v[j][3]);
        const float rstd = rsqrtf(wave_sum(ss) * (1.f / D) + EPS);
        float* op = a.out + (size_t)(row - NC) * D;
#pragma unroll
        for (int j = 0; j < 4; ++j) { const f32x4 gv = ((const f32x4*)a.in[8])[lane + 64 * j]; ((f32x4*)op)[lane + 64 * j] = v[j] * rstd * gv; }
    }
}
__device__ __forceinline__ void rp_combine(Frame& F, const Args& a, int l, int row_lo) {
    const int f_tid = lthread(F.wave), f_lane = f_tid & 63;
    const bf16* X = (const bf16*)(F.ws + WS_X); const bf16* Y = (const bf16*)(F.ws + WS_Y);
    const float* MOD = (const float*)(F.ws + WS_MOD) + (size_t)l * 9 * (NMOD * D); const float* MODN = MOD + 9 * (NMOD * D);
    const v4u* te = (const v4u*)(F.ws + WS_TE); const v4u* trank = (const v4u*)(F.ws + WS_TRANK);
    const LAS int* TT = (const LAS int*)(F.lds + LDS_TT);
    const bool lastl = (l == DEPTH - 1);
    const int st = F.NGW;
    int row = row_lo + F.gw;
    if (row >= NT) return;
    CombRow RA, RB;
    v4u te1 = te[row], tr1 = trank[row];
    comb_issue(RA, X, Y, TT, row, te1, tr1, f_lane);
    if (row + st < NT) { te1 = te[row + st]; tr1 = trank[row + st]; }
    for (;;) {
        const bool h1 = row + st < NT;
        if (h1) comb_issue(RB, X, Y, TT, row + st, te1, tr1, f_lane);
        if (row + 2 * st < NT) { te1 = te[row + 2 * st]; tr1 = trank[row + 2 * st]; }
        comb_finish(RA, F, a, l, row, f_lane, MOD, MODN, lastl);
        if (!h1) break;
        row += st;
        const bool h2 = row + st < NT;
        if (h2) comb_issue(RA, X, Y, TT, row + st, te1, tr1, f_lane);
        if (row + 2 * st < NT) { te1 = te[row + 2 * st]; tr1 = trank[row + 2 * st]; }
        comb_finish(RB, F, a, l, row, f_lane, MOD, MODN, lastl);
        if (!h2) break;
        row += st;
    }
}

#endif
__device__ __forceinline__ void rp_mla(Frame& F, const Args& a) {
    const int f_tid = lthread(F.wave), f_lane = f_tid & 63;
    const bf16* A = (const bf16*)(F.ws + WS_RE); bf16* QA = (bf16*)(F.ws + WS_RF); bf16* CKV = (bf16*)(F.ws + WS_RG); bf16* Kb = (bf16*)(F.ws + WS_RB);
    const float* rope = (const float*)(F.ws + WS_ROPE); const float* gq = a.in[12]; const float* gk = a.in[14];
    for (int row = F.gw; row < NT; row += F.NGW) {
        const unsigned* ap = (const unsigned*)(A + (size_t)row * MLA_IN_PAD);
        unsigned q[3], c[2];
#pragma unroll
        for (int j = 0; j < 3; ++j) q[j] = ap[f_lane + 64 * j];
#pragma unroll
        for (int j = 0; j < 2; ++j) c[j] = ap[192 + f_lane + 64 * j];
        const unsigned pe = ap[320 + (f_lane & 15)];
        float sq = 0.f, sc = 0.f;
#pragma unroll
        for (int j = 0; j < 3; ++j) { const float x0 = bf_lo(q[j]), x1 = bf_hi(q[j]); sq += x0 * x0 + x1 * x1; }
#pragma unroll
        for (int j = 0; j < 2; ++j) { const float x0 = bf_lo(c[j]), x1 = bf_hi(c[j]); sc += x0 * x0 + x1 * x1; }
        const float rq = rsqrtf(wave_sum(sq) * (1.f / MLA_QL) + EPS), rc = rsqrtf(wave_sum(sc) * (1.f / MLA_KVL) + EPS);
#pragma unroll
        for (int j = 0; j < 3; ++j) { const int e0 = 2 * (f_lane + 64 * j); ((unsigned*)(QA + (size_t)row * MLA_QL))[f_lane + 64 * j] = pk2(bf_lo(q[j]) * rq * gq[e0], bf_hi(q[j]) * rq * gq[e0 + 1]); }
#pragma unroll
        for (int j = 0; j < 2; ++j) { const int e0 = 2 * (f_lane + 64 * j); ((unsigned*)(CKV + (size_t)row * MLA_KVL))[f_lane + 64 * j] = pk2(bf_lo(c[j]) * rc * gk[e0], bf_hi(c[j]) * rc * gk[e0 + 1]); }
        float x0 = bf_lo(pe), x1 = bf_hi(pe);
        if (row >= NC) { const int t = (row - NC) & 4095, i = f_lane & 15, d = 2 * i, pos = (d & 16) ? (t & 63) : (t >> 6), f = d & 7;
            const float p0 = __shfl_xor(x0, 4), p1 = __shfl_xor(x1, 4); const float sg = (d & 8) ? 1.f : -1.f;
            const float* rp = rope + (size_t)pos * 16 + 2 * f; x0 = x0 * rp[0] + sg * p0 * rp[1]; x1 = x1 * rp[2] + sg * p1 * rp[3]; }
        const unsigned w = pk2(x0, x1);
        { const int i = f_lane & 15, hb = f_lane >> 4;
#pragma unroll
          for (int hh = 0; hh < 4; ++hh) { const int h = hb * 4 + hh; ((unsigned*)(Kb + (size_t)row * 1536 + 96 * h + 64))[i] = w; } }
    }
}

__device__ __forceinline__ void rp_gqa(Frame& F, const Args& a) {
    const int f_tid = lthread(F.wave), f_lane = f_tid & 63;
    const bf16* A = (const bf16*)(F.ws + WS_RA); bf16* Q = (bf16*)(F.ws + WS_RB); bf16* Kb = Q + (size_t)NT * 1024;
    const float* rope = (const float*)(F.ws + WS_ROPE) + 2048; const float* gq = a.in[18]; const float* gk = a.in[19];
    const float c2 = 0.125f * LOG2E;
    for (int row = F.gw; row < NT; row += F.NGW) {
        const bool lat = row >= NC; const int t = (row - NC) & 4095;
#pragma unroll
        for (int part = 0; part < 2; ++part) {
            const int ln = part ? (f_lane & 15) : f_lane; const bf16* src = A + (size_t)row * GQA_QKV + (part ? 1024 : 0) + ln * 16;
            const v4u w0 = *(const v4u*)src, w1 = *(const v4u*)(src + 8);
            float x[16]; const unsigned ww[8] = {w0.x, w0.y, w0.z, w0.w, w1.x, w1.y, w1.z, w1.w};
#pragma unroll
            for (int i = 0; i < 8; ++i) { x[2 * i] = bf_lo(ww[i]); x[2 * i + 1] = bf_hi(ww[i]); }
            float ss = 0.f;
#pragma unroll
            for (int i = 0; i < 16; ++i) ss += x[i] * x[i];
            ss += __shfl_xor(ss, 1); ss += __shfl_xor(ss, 2);
            const float rs = rsqrtf(ss * (1.f / 64.f) + EPS); const float* g = (part ? gk : gq) + (ln & 3) * 16;
#pragma unroll
            for (int i = 0; i < 16; ++i) x[i] = x[i] * rs * g[i];
            if (lat) { const int sec = (ln >> 1) & 1, pos = sec ? (t & 63) : (t >> 6); const float sg = (ln & 1) ? 1.f : -1.f; const float* rp = rope + (size_t)pos * 32;
#pragma unroll
                for (int i = 0; i < 16; ++i) { const float pr = __shfl_xor(x[i], 1); x[i] = x[i] * rp[2 * i] + sg * pr * rp[2 * i + 1]; } }
            const float scl = part ? 1.f : c2;
            v4u o0, o1; o0.x = pk2(x[0] * scl, x[1] * scl); o0.y = pk2(x[2] * scl, x[3] * scl); o0.z = pk2(x[4] * scl, x[5] * scl); o0.w = pk2(x[6] * scl, x[7] * scl);
            o1.x = pk2(x[8] * scl, x[9] * scl); o1.y = pk2(x[10] * scl, x[11] * scl); o1.z = pk2(x[12] * scl, x[13] * scl); o1.w = pk2(x[14] * scl, x[15] * scl);
            if (part == 0) { bf16* d = Q + (size_t)row * 1024 + ln * 16; *(v4u*)d = o0; *(v4u*)(d + 8) = o1; }
            else if (f_lane < 16) { bf16* d = Kb + (size_t)row * 256 + ln * 16; *(v4u*)d = o0; *(v4u*)(d + 8) = o1; }
        }
    }
}

template <int DK>
__device__ __forceinline__ void attn_phase(Frame& F, const att::Tens& T, int kvshift  , int kstride, int vstride, int vbase) {
    const int vcu = (F.G % 8 == 0) ? (blockIdx.x % 8) * (F.G / 8) + blockIdx.x / 8 : blockIdx.x;
    att::Pend pend; pend.valid = false; pend.o0 = f32x16{}; pend.o1 = f32x16{}; pend.l = 1.f; pend.qrow0 = 0; pend.oc0 = 0;
    for (int u = vcu; u < 2048 + 128; u += F.G) {
        if (u < 2048) { const int b = u >> 8, h = (u >> 4) & 15, qb = u & 15, kvh = h >> kvshift;
            att::unit<DK>(T, NC + b * SEQ + qb * 256, h * DK, kvh * kstride, vbase + kvh * vstride, h * 64, b * LCTX, NC + b * SEQ, 68, F.lds, F.wave, pend); }
        else { const int q = u - 2048, b = q >> 4, h = q & 15, kvh = h >> kvshift;
            att::unit<DK>(T, b * LCTX, h * DK, kvh * kstride, vbase + kvh * vstride, h * 64, b * LCTX, 0, 4, F.lds, F.wave, pend); }
    }
    if (pend.valid) att::finish_unit(pend, T.O, F.lds, F.wave, lthread(F.wave) & 63);
    __syncthreads();
}

constexpr int PH_PER_LAYER = 9, PH_TOTAL = 2 + DEPTH * PH_PER_LAYER;
__global__ void __launch_bounds__(512, 2) mk_fwd(Args args) {
    extern __shared__ __attribute__((aligned(16))) unsigned char lds_raw[];
    Frame F;
    F.lds = (LAS unsigned char*)lds_raw; F.ws = args.ws; F.ctl = (gu32*)(args.ws + WS_CTL);
    F.wave = __builtin_amdgcn_readfirstlane(threadIdx.x >> 6); F.G = gridDim.x;
    F.gw = blockIdx.x * 8 + F.wave; F.NGW = F.G * 8;
    if (threadIdx.x < 4) ((LAS unsigned*)(F.lds + LDS_XB))[threadIdx.x] = 0u;
    __syncthreads();
    const int lo = args.ph_lo, hi = args.ph_hi;
    const bool multi = (hi - lo) > 1;
    XcdBarrier bar; bar.bar = (unsigned*)(F.ctl + CW_BAR); bar.x = 0; bar.st = nullptr; bar.wave = F.wave;
    if (multi) bar = xcd_barrier_post((unsigned*)(F.ctl + CW_BAR), (volatile LAS unsigned*)(F.lds + LDS_XB), F.wave);
#define IN(k) (lo <= (k) && (k) < hi)
#define SEAM(k) do { if (IN(k) && IN((k) + 1)) xcd_barrier(bar); } while (0)
    unsigned char* ws0 = args.ws;
#define PH_WS size_t zofs_ = 0; asm volatile("" : "+s"(zofs_)); unsigned char* ws = ws0 + zofs_; F.ws = ws; F.ctl = (gu32*)ws;
    const int G = F.G, cidx = (int)blockIdx.x;

    if (IN(0) && EN(0)) { PH_WS REP(0) { prologue(F, args); SEAM(0); } }
    if (IN(1) && EN(1)) { PH_WS rp_norm1(F, args, 0, 0); SEAM(1); }

    for (int l = 0; l < DEPTH; ++l) {
        const int kind = l % 3, j = l / 3, base = 2 + l * PH_PER_LAYER;
        const bool lastl = (l == DEPTH - 1);

        size_t outB = 0;
        if (kind == 0) {
            if (IN(base + 0) && EN(2)) { PH_WS REP(2) { PolFP p; p.A = (const char*)(ws + WS_WFIN) + (size_t)j * 2048 * D * 2; p.B = (const char*)(ws + WS_H); p.nt = 16; p.nN = lastl ? 128 : 136; p.G = G; p.c = cidx;
                p.Z = (bf16*)(ws + WS_RA); p.Zc = (bf16*)(ws + WS_RH); pg8::gemm_phase(F.lds, p, F.wave); } }
            SEAM(base + 0);
            if (IN(base + 1) && EN(3)) { PH_WS REP(3) { PolFA p; p.A = (const char*)(ws + WS_MA); p.B = (const char*)(ws + WS_RA); p.nt = 4; p.G = G; p.c = cidx; p.Y = (bf16*)(ws + WS_RB); pg8::gemm_phase(F.lds, p, F.wave); } }
            SEAM(base + 1);
            if (IN(base + 2) && EN(4)) { PH_WS REP(4) { PolFC p; p.A = (const char*)(ws + WS_DC); p.B = (const char*)(ws + WS_RB); p.nt = 8; p.G = G; p.c = cidx; p.nunits = lastl ? 512 : 544;
                p.offMC = (unsigned)(WS_MC - WS_DC); p.offZc = (unsigned)(WS_RH - WS_RB); p.F = (bf16*)(ws + WS_RC); pg8::gemm_phase(F.lds, p, F.wave); } }
            SEAM(base + 2);
            outB = WS_WFOUT + (size_t)j * D * D * 2;
        } else if (kind == 1) {
            if (IN(base + 0) && EN(5)) { PH_WS REP(5) { PolDenseBf16 p; p.A = (const char*)(ws + WS_H); p.B = (const char*)(ws + WS_WMIN); p.nt = 16; p.nM = NT / 256; p.nN = 3; p.pm0 = 0; p.G = G; p.c = cidx; p.pitchA = 2048; p.pitchB = 2048;
                p.O = (bf16*)(ws + WS_RE); p.ldo = MLA_IN_PAD; pg8::gemm_phase(F.lds, p, F.wave); } }
            SEAM(base + 0);
            if (IN(base + 1) && EN(6)) { PH_WS REP(6) { rp_mla(F, args); } }
            SEAM(base + 1);
            if (IN(base + 2)) { PH_WS REP(7) {
                if (EN(7)) { PolMlaQ p; p.A = (const char*)(ws + WS_RF); p.B = (const char*)(ws + WS_WMQB); p.nt = 6; p.nM = NT / 256; p.nN = 6; p.G = G; p.c = cidx; p.Q = (bf16*)(ws + WS_RA);
                  p.rope = (const float*)(ws + WS_ROPE); p.c2 = 0.10206207261596575f * LOG2E; pg8::gemm_phase(F.lds, p, F.wave); }
                if (EN(8)) { PolMlaKV p; p.A = (const char*)(ws + WS_RG); p.B = (const char*)(ws + WS_WMKVB); p.nt = 4; p.nM = NT / 256; p.nN = 8; p.G = G; p.c = cidx; p.Kb = (bf16*)(ws + WS_RB); p.Vb = (bf16*)(ws + WS_RD);
                  pg8::gemm_phase(F.lds, p, F.wave); }
            } }
            SEAM(base + 2);
            if (IN(base + 3) && EN(9)) { PH_WS REP(9) { att::Tens T{(const bf16*)(ws + WS_RA), 1536, (const bf16*)(ws + WS_RB), 1536, (const bf16*)(ws + WS_RD), 1024, (bf16*)(ws + WS_RC)}; attn_phase<96>(F, T, 0, 96, 64, 0); } }
            SEAM(base + 3);
            outB = WS_WMO;
        } else {
            if (IN(base + 0) && EN(10)) { PH_WS REP(10) { PolDenseBf16 p; p.A = (const char*)(ws + WS_H); p.B = (const char*)(ws + WS_WGQKV); p.nt = 16; p.nM = NT / 256; p.nN = 6; p.pm0 = 0; p.G = G; p.c = cidx; p.pitchA = 2048; p.pitchB = 2048;
                p.O = (bf16*)(ws + WS_RA); p.ldo = GQA_QKV; pg8::gemm_phase(F.lds, p, F.wave); } }
            SEAM(base + 0);
            if (IN(base + 1) && EN(11)) { PH_WS REP(11) { rp_gqa(F, args); } }
            SEAM(base + 1);
            if (IN(base + 2) && EN(12)) { PH_WS REP(12) { att::Tens T{(const bf16*)(ws + WS_RB), 1024, (const bf16*)(ws + WS_RB) + (size_t)NT * 1024, 256, (const bf16*)(ws + WS_RA), 1536, (bf16*)(ws + WS_RC)}; attn_phase<64>(F, T, 2, 64, 64, 1280); } }
            SEAM(base + 2);
            outB = WS_WGO;
        }
        if (IN(base + 4) && EN(13)) { PH_WS PolOut p; p.A = (const char*)(ws + WS_RC); p.B = (const char*)(ws + outB); p.nt = 16; p.nM = lastl ? NL / 256 : NT / 256; p.nN = 4; p.pm0 = lastl ? 8 : 0; p.G = G; p.c = cidx; p.X = (bf16*)(ws + WS_X); p.mod = (const float*)(ws + WS_MOD) + (size_t)l * 9 * (NMOD * D); p.chunk = 2;
            p.XinC = (l == 0) ? args.in[2] : nullptr; p.XinL = (l == 0) ? args.in[0] - (size_t)NC * D : nullptr;
            pg8::gemm_phase(F.lds, p, F.wave); }
        SEAM(base + 4);
        if (IN(base + 5) && EN(14)) { PH_WS rp_norm2_router(F, args, l, lastl ? NC : 0); }
        SEAM(base + 5);
        if (IN(base + 6) && EN(15)) { PH_WS REP(15) { moe_table(F, l);
            PolMoe1 p; p.A = (const char*)(ws + WS_H); p.B = (const char*)(ws + WS_WGU) + (size_t)l * NE * 2048 * D * 2; p.nt = 16; p.G = G; p.c = cidx;
            p.T.TT = (const LAS int*)(F.lds + LDS_TT); p.T.CN = p.T.TT + 64; p.T.TE = (const LAS int*)(F.lds + LDS_TE); p.stok = (const int*)(ws + WS_STOK); p.bgu = (const float*)(ws + WS_BGU) + (size_t)l * NE * 2048; p.act = (bf16*)(ws + WS_ACT);
            pg8::gemm_phase(F.lds, p, F.wave); } }
        SEAM(base + 6);
        if (IN(base + 7) && EN(16)) { PH_WS REP(16) { moe_table(F, l);
            PolMoe2 p; p.A = (const char*)(ws + WS_ACT); p.B = (const char*)(ws + WS_WDN) + (size_t)l * NE * D * DFF * 2; p.nt = 16; p.G = G; p.c = cidx;
            p.T.TT = (const LAS int*)(F.lds + LDS_TT); p.T.CN = p.T.TT + 64; p.T.TE = (const LAS int*)(F.lds + LDS_TE); p.sw = (const float*)(ws + WS_SW); p.bdn = args.in[26] + (size_t)l * NE * D; p.Y = (bf16*)(ws + WS_Y);
            pg8::gemm_phase(F.lds, p, F.wave); } }
        SEAM(base + 7);
        if (IN(base + 8) && EN(17)) { PH_WS moe_table(F, l); rp_combine(F, args, l, lastl ? NC : 0); }
        SEAM(base + 8);
    }
#undef PH_WS
#undef IN
#undef SEAM
}

extern "C" void kernel_launch(void* const* d_in, const int* in_sizes, int n_in, void* d_out, int out_size, void* d_ws, size_t ws_size, hipStream_t stream) {
    static int grid = 0;
    if (grid == 0) {
        if (n_in != 27 || out_size != NL * D || ws_size < WS_END) { fprintf(stderr, "kernel_launch: unexpected problem (n_in %d, out %d, ws %zu < %zu)\n", n_in, out_size, ws_size, (size_t)WS_END); grid = -1; return; }
        int dev = 0, cus = 0, per_cu = 0;
        if (hipGetDevice(&dev) != hipSuccess || hipDeviceGetAttribute(&cus, hipDeviceAttributeMultiprocessorCount, dev) != hipSuccess) { grid = -1; return; }
        if (hipFuncSetAttribute((const void*)mk_fwd, hipFuncAttributeMaxDynamicSharedMemorySize, LDS_BYTES) != hipSuccess) { fprintf(stderr, "kernel_launch: hipFuncSetAttribute failed\n"); grid = -1; return; }
        if (hipOccupancyMaxActiveBlocksPerMultiprocessor(&per_cu, (const void*)mk_fwd, 512, LDS_BYTES) != hipSuccess || per_cu < 1) fprintf(stderr, "kernel_launch: occupancy query says %d\n", per_cu);
        (void)hipGetLastError();
        grid = cus;
    }
    if (grid < 0) return;
    (void)hipMemsetAsync((char*)d_ws + WS_CTL, 0, CTL_ZERO_BYTES, stream);
    Args a{};
    for (int i = 0; i < 27; ++i) a.in[i] = (const float*)d_in[i];
    a.out = (float*)d_out; a.ws = (unsigned char*)d_ws;
#if MK_PER_PHASE
    for (int ph = 0; ph < PH_TOTAL; ++ph) {
        const int l = (ph - 2) / PH_PER_LAYER, s = (ph - 2) % PH_PER_LAYER, kind = l % 3;
        if (ph >= 2) { if (s == 3 && kind != 1) continue; }
        a.ph_lo = ph; a.ph_hi = ph + 1;
        hipLaunchKernelGGL(mk_fwd, dim3(grid), dim3(512), LDS_BYTES, stream, a);
    }
#else
    a.ph_lo = 0; a.ph_hi = PH_TOTAL;
    hipLaunchKernelGGL(mk_fwd, dim3(grid), dim3(512), LDS_BYTES, stream, a);
#endif
}
```

```cpp
#include <hip/hip_runtime.h>
#include <cstdio>
#include <cstdint>

#ifndef MK_PER_PHASE
#define MK_PER_PHASE 0
#endif
#ifndef MK_N2V2
#define MK_N2V2 1
#endif
#ifndef MK_CBV2
#define MK_CBV2 1
#endif
#ifndef MK_N2AGG
#define MK_N2AGG 1
#endif
#ifndef MK_MASK
#define MK_MASK 0xFFFFFFFFu
#endif
#define EN(id) (((MK_MASK) >> (id)) & 1u)
#ifndef MK_REPMASK
#define MK_REPMASK 0u
#endif
#define REP(id) for (int rep_ = 0; rep_ < ((((MK_REPMASK) >> (id)) & 1u) ? 2 : 1); ++rep_)

constexpr int D = 1024, NB = 8, SEQ = 4096, LCTX = 256, DEPTH = 4;
constexpr int NC = NB * LCTX;
constexpr int NL = NB * SEQ;
constexpr int NT = NC + NL;
constexpr int NMOD = 6, NE = 32, TOPK = 4, DFF = 1024;
constexpr int MLA_QL = 384, MLA_KVL = 256, MLA_ROPE = 32, MLA_NOPE = 64, MLA_V = 64, MLA_IN = 672, MLA_IN_PAD = 768, MLA_QD = 96;
constexpr int GQA_NQ = 1024, GQA_NKV = 256, GQA_QKV = 1536;
constexpr int CAP = NT;
constexpr int MAXTILES = 576;
constexpr float EPS = 1e-6f;
constexpr float LOG2E = 1.4426950408889634f;

constexpr size_t MiB = 1u << 20;
constexpr size_t WS_CTL = 0, CTL_ZERO_BYTES = 96 * 1024;
constexpr size_t WS_MOD = 1 * MiB;
constexpr size_t WS_ROPE = 2 * MiB;
constexpr size_t WS_WRT = 2 * MiB + 65536;
constexpr size_t WS_BGU = 3 * MiB;
constexpr size_t WS_MA = 4 * MiB;
constexpr size_t WS_DC = 4 * MiB + 262144;
constexpr size_t WS_MC = 5 * MiB;
constexpr size_t WS_WFIN = 9 * MiB;
constexpr size_t WS_WFOUT = 17 * MiB;
constexpr size_t WS_WMIN = 21 * MiB;
constexpr size_t WS_WMQB = 23 * MiB;
constexpr size_t WS_WMKVB = 25 * MiB;
constexpr size_t WS_WMO = 26 * MiB;
constexpr size_t WS_WGQKV = 28 * MiB;
constexpr size_t WS_WGO = 31 * MiB;
constexpr size_t WS_TE = 34 * MiB;
constexpr size_t WS_TRANK = 35 * MiB;
constexpr size_t WS_STOK = 36 * MiB;
constexpr size_t WS_SW = 41 * MiB;
constexpr size_t WS_X = 64 * MiB;
constexpr size_t WS_H = 200 * MiB;
constexpr size_t WS_RA = 272 * MiB;
constexpr size_t WS_RB = 400 * MiB;
constexpr size_t WS_RC = 528 * MiB;
constexpr size_t WS_RD = 600 * MiB;
constexpr size_t WS_RE = 672 * MiB;
constexpr size_t WS_RF = 728 * MiB;
constexpr size_t WS_RG = 756 * MiB;
constexpr size_t WS_RH = 776 * MiB;
constexpr size_t WS_ACT = 784 * MiB;
constexpr size_t WS_Y = 1072 * MiB;
constexpr size_t WS_WGU = 1360 * MiB;
constexpr size_t WS_WDN = 1872 * MiB;
constexpr size_t WS_END = 2128 * MiB;
constexpr int CW_TMO = 0;
constexpr int CW_BAR = 4096;
constexpr int CW_CNT = 16384;

constexpr int RING_BYTES = 131072;
constexpr int LDS_MISC = 135168;
constexpr int LDS_TT = LDS_MISC;
constexpr int LDS_XB = LDS_MISC + 512;
constexpr int LDS_TE = LDS_MISC + 768;
constexpr int LDS_BYTES = 147456;

#define GAS __attribute__((address_space(1)))
#define LAS __attribute__((address_space(3)))
typedef unsigned short bf16;
typedef unsigned v4u __attribute__((ext_vector_type(4)));
typedef unsigned v2u __attribute__((ext_vector_type(2)));
typedef float f32x4 __attribute__((ext_vector_type(4)));
typedef float f32x2 __attribute__((ext_vector_type(2)));
typedef float f32x16 __attribute__((ext_vector_type(16)));
typedef short bf16x8 __attribute__((ext_vector_type(8)));
typedef short s16x4 __attribute__((ext_vector_type(4)));
typedef __bf16 bf16x2_t __attribute__((ext_vector_type(2)));
typedef GAS unsigned gu32;
#define RLX_AGENT __ATOMIC_RELAXED, __HIP_MEMORY_SCOPE_AGENT
#define LDS_WAIT() asm volatile("s_waitcnt lgkmcnt(0)" ::: "memory")
#define VM_WAIT() asm volatile("s_waitcnt vmcnt(0)" ::: "memory")
__device__ __forceinline__ unsigned pk2(float lo, float hi) { f32x2 v = {lo, hi}; bf16x2_t b = __builtin_convertvector(v, bf16x2_t); return __builtin_bit_cast(unsigned, b); }
__device__ __forceinline__ float bf_lo(unsigned u) { return __builtin_bit_cast(float, u << 16); }
__device__ __forceinline__ float bf_hi(unsigned u) { return __builtin_bit_cast(float, u & 0xffff0000u); }
__device__ __forceinline__ float wave_sum(float v) {
#pragma unroll
    for (int o = 1; o < 64; o <<= 1) v += __shfl_xor(v, o);
    return v;
}
__device__ __forceinline__ int lane_id_v() { int t; asm volatile("v_mbcnt_lo_u32_b32 %0, -1, 0\n\tv_mbcnt_hi_u32_b32 %0, -1, %0" : "=v"(t)); return t; }
__device__ __forceinline__ int launder_s(int x) { asm volatile("" : "+s"(x)); return x; }
__device__ __forceinline__ int lthread_w(int wave) { return wave * 64 + lane_id_v(); }
__device__ __forceinline__ int modrow_of(int row) { return row < NC ? NB : ((row - NC) >> 12); }

#define XB_TMO      128
#define XB_XCNT(j)  (256  + 64 * (j))
#define XB_XSUB(j)  (1280 + 64 * (j))
#define XB_XGEN(j)  (2304 + 64 * (j))
#define XB_TOP      3328
#define XB_TOPGEN   3392
#define XCD_BAR_WORDS 3456
#define XB_SPIN_CAP (1u << 18)
__device__ __forceinline__ unsigned xb_ld(unsigned* p)              { return __hip_atomic_load(p, __ATOMIC_RELAXED, __HIP_MEMORY_SCOPE_AGENT); }
__device__ __forceinline__ unsigned xb_add(unsigned* p, unsigned v) { return __hip_atomic_fetch_add(p, v, __ATOMIC_RELAXED, __HIP_MEMORY_SCOPE_AGENT); }
__device__ __forceinline__ unsigned xb_xcc_id() { return (unsigned)__builtin_amdgcn_s_getreg((3 << 11) | 20) & 0xFu; }
#define XB_SPIN(cond, bar) do { unsigned _sp = 0; while (cond) { __builtin_amdgcn_s_sleep(1); \
    if ((++_sp & 255u) == 0u) { if (xb_ld(&(bar)[XB_TMO])) break; if (_sp > XB_SPIN_CAP) { atomicAdd(&(bar)[XB_TMO], 1u); break; } } } } while (0)
struct XcdBarrier { unsigned* bar; unsigned x; volatile LAS unsigned* st; int wave; };
__device__ __forceinline__ bool xb_thread0(int wave) { return wave == 0 && lane_id_v() == 0; }
__device__ __forceinline__ XcdBarrier xcd_barrier_post(unsigned* bar, volatile LAS unsigned* st, int wave) {
    XcdBarrier b; b.bar = bar; b.x = xb_xcc_id(); b.st = st; b.wave = wave;
    if (xb_thread0(wave)) (void)xb_add(&bar[XB_XCNT(b.x)], 1u);
    return b;
}
__device__ __forceinline__ void xcd_barrier_complete(unsigned* bar, unsigned x, unsigned& nloc, unsigned& nx) {
    const unsigned G = gridDim.x * gridDim.y * gridDim.z;
    unsigned sum, cnt, mine, sp = 0u;
    for (;;) {
        sum = 0u; cnt = 0u; mine = 0u;
#pragma unroll
        for (unsigned j = 0; j < 16; ++j) { const unsigned c = xb_ld(&bar[XB_XCNT(j)]); sum += c; cnt += (c > 0u) ? 1u : 0u; mine = (j == x) ? c : mine; }
        if (sum == G) break;
        __builtin_amdgcn_s_sleep(1);
        if ((++sp & 255u) == 0u) { if (xb_ld(&bar[XB_TMO])) break; if (sp > XB_SPIN_CAP) { atomicAdd(&bar[XB_TMO], 1u); break; } }
    }
    nloc = mine > 0u ? mine : 1u; nx = cnt > 0u ? cnt : 1u;
}
__device__ __forceinline__ void xcd_barrier(const XcdBarrier& b) {
    asm volatile("s_waitcnt vmcnt(0)" ::: "memory");
    __syncthreads();
    if (xb_thread0(b.wave)) {
        unsigned* bar = b.bar;
        __builtin_amdgcn_s_waitcnt(0);
        unsigned nloc = b.st[0], nx = b.st[1];
        if (nloc == 0u) { xcd_barrier_complete(bar, b.x, nloc, nx); b.st[0] = nloc; b.st[1] = nx; }
        const unsigned old = xb_add(&bar[XB_XSUB(b.x)], 1u);
        const unsigned gen = old / nloc;
        if (old + 1u == (gen + 1u) * nloc) {
            __builtin_amdgcn_fence(__ATOMIC_RELEASE, "agent");
            asm volatile("s_waitcnt vmcnt(0)" ::: "memory");
            const unsigned og = xb_add(&bar[XB_TOP], 1u);
            const unsigned tg = og / nx;
            if (og + 1u == (tg + 1u) * nx) xb_add(&bar[XB_TOPGEN], 1u);
            else XB_SPIN(xb_ld(&bar[XB_TOPGEN]) == tg, bar);
            __builtin_amdgcn_fence(__ATOMIC_ACQUIRE, "agent");
            xb_add(&bar[XB_XGEN(b.x)], 1u);
            asm volatile("s_waitcnt vmcnt(0)" ::: "memory");
        } else {
            XB_SPIN(xb_ld(&bar[XB_XGEN(b.x)]) == gen, bar);
            __builtin_amdgcn_fence(__ATOMIC_ACQUIRE, "agent");
            asm volatile("s_waitcnt vmcnt(0)" ::: "memory");
        }
    }
    __syncthreads();
}

namespace pg8 {
#define PG8_LAS __attribute__((address_space(3)))
constexpr int BM = 256, BK = 64, HALF = 128, HTB = HALF * BK * 2, STAGE_BYTES = 8 * HTB, NXCD = 8, WGM = 8;
__device__ __forceinline__ int lds_byte(int r, int c) { const int st = (r >> 4) * 2 + (c >> 5), rr = r & 15, cc = c & 31, ob = rr * 64 + cc * 2; return st * 1024 + (ob ^ (((ob >> 9) & 1) << 5)); }
__device__ __forceinline__ void stage_rc(int b, int& R, int& C) { const int st = b / 1024, sb = b % 1024, swz = sb ^ (((sb >> 9) & 1) << 5); R = (st >> 1) * 16 + swz / 64; C = (st & 1) * 32 + (swz % 64) / 2; }
__device__ __forceinline__ int perm32(int rho) { const int n = rho >> 4, i = rho & 15; return 8 * (i >> 2) + 4 * n + (i & 3); }
struct Unit { int pm, pn, aux; };
typedef f32x4 Acc[2][2][4][2];

__device__ __forceinline__ bool static_next(int i, int G, int c, int nM, int nN, int& pm, int& pn) {
    const int nwg = nM * nN; const long L = (long)i * G + c; if (L >= nwg) return false;
    int wgid = (int)L; { const int q = nwg / NXCD, r = nwg % NXCD, xcd = wgid % NXCD, off = wgid / NXCD; wgid = (xcd < r ? xcd * (q + 1) : r * (q + 1) + (xcd - r) * q) + off; }
    const int nig = WGM * nN, gid = wgid / nig, fm = gid * WGM, gsz = (nM - fm) < WGM ? (nM - fm) : WGM;
    pm = fm + ((wgid % nig) % gsz); pn = (wgid % nig) / gsz; return true;
}

template <class P>
__device__ __forceinline__ void gemm_phase(PG8_LAS unsigned char* lds, const P& p, int wave_id) {
    wave_id = launder_s(wave_id); int tid_l = lthread_w(wave_id);
    const int tid = tid_l, wid = wave_id, lane = tid & 63, wr = wid >> 2, wc = wid & 3, fr = lane & 15, fq = lane >> 4;
    const int nt = p.nt;
    int R[2], Rb[2], C[2];
#pragma unroll
    for (int i = 0; i < 2; ++i) { stage_rc(tid * 16 + i * 8192, R[i], C[i]); Rb[i] = P::PERM ? ((R[i] & ~31) + perm32(R[i] & 31)) : R[i]; }
    const unsigned ldsw = (unsigned)wid * 1024u;
    const int aoff = lds_byte(wr * 64 + fr, fq * 8), boff = lds_byte(wc * 32 + fr, fq * 8);
    const char* const gA = p.A; const char* const gB = p.B;
#define PG8_SA(b, h) (((b) * 2 + (h)) * HTB)
#define PG8_SB(b, h) ((4 + (b) * 2 + (h)) * HTB)
#define PG8_STAGE(bufoff, gbase, off2, kofs) do { _Pragma("unroll") for (int _i = 0; _i < 2; ++_i) \
        __builtin_amdgcn_global_load_lds((const unsigned*)((gbase) + (size_t)(off2)[_i] + (size_t)(kofs)), (PG8_LAS unsigned*)(lds + (bufoff) + ldsw + _i * 8192), 16, 0, 0); } while (0)
#define PG8_LDA(dst, b, h) do { _Pragma("unroll") for (int m = 0; m < 4; ++m) _Pragma("unroll") for (int k = 0; k < 2; ++k) dst[m][k] = *(const PG8_LAS bf16x8*)(lds + PG8_SA(b, h) + aoff + m * 2048 + k * 1024); } while (0)
#define PG8_LDB(dst, b, h) do { _Pragma("unroll") for (int n = 0; n < 2; ++n) _Pragma("unroll") for (int k = 0; k < 2; ++k) dst[n][k] = *(const PG8_LAS bf16x8*)(lds + PG8_SB(b, h) + boff + n * 2048 + k * 1024); } while (0)
#define PG8_MMA(ai, bj, At, Bt) do { __builtin_amdgcn_s_setprio(1); _Pragma("unroll") for (int m = 0; m < 4; ++m) _Pragma("unroll") for (int n = 0; n < 2; ++n) _Pragma("unroll") for (int k = 0; k < 2; ++k) \
        acc[ai][bj][m][n] = __builtin_amdgcn_mfma_f32_16x16x32_bf16(Bt[n][k], At[m][k], acc[ai][bj][m][n], 0, 0, 0); __builtin_amdgcn_s_setprio(0); } while (0)
#define PG8_WAIT_V(n) asm volatile("s_waitcnt vmcnt(" #n ")" ::: "memory")
#define PG8_WAIT_L(n) asm volatile("s_waitcnt lgkmcnt(" #n ")" ::: "memory")
#define PG8_BAR __builtin_amdgcn_s_barrier()
#define PG8_SCHED __builtin_amdgcn_sched_barrier(0)
#define PG8_KEYS(u) do { if (P::KEYS && wid < 4) __builtin_amdgcn_global_load_lds((const unsigned*)p.key_ptr(u, wid * 64 + lane), (PG8_LAS unsigned*)(keybuf + wid * 256), 4, 0, 0); } while (0)
#define PG8_OFFS(u, oA, oB) do { _Pragma("unroll") for (int _h = 0; _h < 2; ++_h) _Pragma("unroll") for (int _i = 0; _i < 2; ++_i) { \
        const int key_ = P::KEYS ? ((const PG8_LAS int*)keybuf)[_h * HALF + R[_i]] : 0; \
        oA[_h][_i] = p.a_row(u, _h * HALF + R[_i], key_) + (unsigned)(C[_i] * 2); oB[_h][_i] = p.b_row(u, _h * HALF + Rb[_i]) + (unsigned)(C[_i] * 2); } } while (0)
    PG8_LAS unsigned char* const keybuf = lds + STAGE_BYTES;
    Unit cur, nxt; int ui = 0;
    if (!p.next(0, cur)) return;
    f32x4 acc[2][2][4][2];
#pragma unroll
    for (int a = 0; a < 2; ++a)
#pragma unroll
        for (int b = 0; b < 2; ++b)
#pragma unroll
            for (int m = 0; m < 4; ++m)
#pragma unroll
                for (int n = 0; n < 2; ++n) acc[a][b][m][n] = (f32x4){0.f, 0.f, 0.f, 0.f};
    bf16x8 At[4][2], B0[2][2], B1[2][2];
    unsigned oAc[2][2], oBc[2][2];
    if (P::KEYS) { PG8_KEYS(cur); PG8_WAIT_V(0); PG8_BAR; }
    PG8_OFFS(cur, oAc, oBc);
    PG8_STAGE(PG8_SB(0, 0), gB, oBc[0], 0); PG8_STAGE(PG8_SB(0, 1), gB, oBc[1], 0); PG8_STAGE(PG8_SA(0, 0), gA, oAc[0], 0); PG8_STAGE(PG8_SA(0, 1), gA, oAc[1], 0);
    if (wr == 1) PG8_BAR;
    PG8_WAIT_V(2); PG8_BAR;
    PG8_STAGE(PG8_SB(1, 0), gB, oBc[0], 128); PG8_STAGE(PG8_SA(1, 0), gA, oAc[0], 128); PG8_STAGE(PG8_SB(1, 1), gB, oBc[1], 128);
    PG8_WAIT_V(6); PG8_BAR;
    for (;;) {
        const bool has_next = p.next(ui + 1, nxt);
        if (has_next) { PG8_KEYS(nxt); }
        for (int t = 0; t < nt; t += 2) {
            const bool last = (t == nt - 2);
            const unsigned k1 = (unsigned)(t + 1) * 128u;
            const unsigned k2 = last ? 0u : (unsigned)(t + 2) * 128u, k3 = k2 + 128u;
            PG8_LDB(B0, 0, 0); PG8_LDB(B1, 0, 1); PG8_SCHED; PG8_LDA(At, 0, 0); PG8_STAGE(PG8_SA(1, 1), gA, oAc[1], k1);
            if (last && has_next) { PG8_OFFS(nxt, oAc, oBc); }
            PG8_WAIT_V(8); PG8_WAIT_L(0); PG8_BAR; PG8_MMA(0, 0, At, B0); PG8_MMA(0, 1, At, B1); PG8_BAR; PG8_SCHED;
            PG8_LDA(At, 0, 1); PG8_STAGE(PG8_SB(0, 0), gB, oBc[0], k2); PG8_STAGE(PG8_SB(0, 1), gB, oBc[1], k2); PG8_STAGE(PG8_SA(0, 0), gA, oAc[0], k2);
            PG8_WAIT_V(8); PG8_WAIT_L(0); PG8_BAR; PG8_MMA(1, 0, At, B0); PG8_MMA(1, 1, At, B1); PG8_BAR; PG8_SCHED;
            PG8_LDB(B0, 1, 0); PG8_LDB(B1, 1, 1); PG8_SCHED; PG8_LDA(At, 1, 0); PG8_STAGE(PG8_SA(0, 1), gA, oAc[1], k2);
            PG8_WAIT_V(8); PG8_WAIT_L(0); PG8_BAR; PG8_MMA(0, 0, At, B0); PG8_MMA(0, 1, At, B1); PG8_BAR; PG8_SCHED;
            PG8_LDA(At, 1, 1); PG8_STAGE(PG8_SB(1, 0), gB, oBc[0], k3); PG8_STAGE(PG8_SB(1, 1), gB, oBc[1], k3); PG8_STAGE(PG8_SA(1, 0), gA, oAc[0], k3);
            PG8_WAIT_V(8); PG8_WAIT_L(0); PG8_BAR; PG8_MMA(1, 0, At, B0); PG8_MMA(1, 1, At, B1); PG8_BAR; PG8_SCHED;
        }
        if (wr == 0) PG8_BAR;
        { int fr_e = fr, fq_e = fq; asm volatile("" : "+v"(fr_e), "+v"(fq_e));
          p.epi(acc, cur, wr, wc, fr_e, fq_e); }
        if (!has_next) break;
#pragma unroll
        for (int a = 0; a < 2; ++a)
#pragma unroll
            for (int b = 0; b < 2; ++b)
#pragma unroll
                for (int m = 0; m < 4; ++m)
#pragma unroll
                    for (int n = 0; n < 2; ++n) acc[a][b][m][n] = (f32x4){0.f, 0.f, 0.f, 0.f};
        cur = nxt; ++ui;
        if (wr == 1) PG8_BAR;
    }
    PG8_WAIT_V(0);
    PG8_BAR;
#undef PG8_SA
#undef PG8_SB
#undef PG8_STAGE
#undef PG8_LDA
#undef PG8_LDB
#undef PG8_MMA
#undef PG8_WAIT_V
#undef PG8_WAIT_L
#undef PG8_BAR
#undef PG8_SCHED
#undef PG8_OFFS
#undef PG8_KEYS
}
}
using pg8::Unit;

#define TROW(ai, wr, m, fr) (128 * (ai) + 64 * (wr) + 16 * (m) + (fr))
#define TCOLP(bj, wc, fq) (128 * (bj) + 32 * (wc) + 8 * (fq))
#define TCOLN(bj, wc, n, fq) (128 * (bj) + 32 * (wc) + 16 * (n) + 4 * (fq))
__device__ __forceinline__ v4u pack8(const f32x4 a, const f32x4 b) { v4u w; w.x = pk2(a[0], a[1]); w.y = pk2(a[2], a[3]); w.z = pk2(b[0], b[1]); w.w = pk2(b[2], b[3]); return w; }

struct PolDenseBf16 {
    static constexpr bool PERM = true;
    static constexpr bool KEYS = false;
    __device__ __forceinline__ const int* key_ptr(const Unit&, int) const { return nullptr; }
    const char* A; const char* B; int nt; int nM, nN, pm0, G, c; unsigned pitchA, pitchB; bf16* O; int ldo;
    __device__ __forceinline__ bool next(int i, Unit& u) const { int pm, pn; if (!pg8::static_next(i, G, c, nM, nN, pm, pn)) return false; u.pm = pm + pm0; u.pn = pn; u.aux = 0; return true; }
    __device__ __forceinline__ unsigned a_row(const Unit& u, int r, int) const { return (unsigned)(u.pm * 256 + r) * pitchA; }
    __device__ __forceinline__ unsigned b_row(const Unit& u, int r) const { return (unsigned)(u.pn * 256 + r) * pitchB; }
    __device__ __forceinline__ void epi(const pg8::Acc& acc, const Unit& u, int wr, int wc, int fr, int fq) const {
#pragma unroll
        for (int ai = 0; ai < 2; ++ai)
#pragma unroll
            for (int m = 0; m < 4; ++m) { const size_t row = (size_t)u.pm * 256 + TROW(ai, wr, m, fr);
#pragma unroll
                for (int bj = 0; bj < 2; ++bj) { const int col = u.pn * 256 + TCOLP(bj, wc, fq); *(v4u*)(O + row * ldo + col) = pack8(acc[ai][bj][m][0], acc[ai][bj][m][1]); } }
    }
};

struct PolOut {
    static constexpr bool PERM = true;
    static constexpr bool KEYS = false;
    __device__ __forceinline__ const int* key_ptr(const Unit&, int) const { return nullptr; }
    const char* A; const char* B; int nt; int nM, nN, pm0, G, c; bf16* X; const float* mod;
    int chunk; const float* XinC; const float* XinL;
    __device__ __forceinline__ bool next(int i, Unit& u) const { int pm, pn; if (!pg8::static_next(i, G, c, nM, nN, pm, pn)) return false; u.pm = pm + pm0; u.pn = pn; u.aux = 0; return true; }
    __device__ __forceinline__ unsigned a_row(const Unit& u, int r, int) const { return (unsigned)(u.pm * 256 + r) * 2048u; }
    __device__ __forceinline__ unsigned b_row(const Unit& u, int r) const { return (unsigned)(u.pn * 256 + r) * 2048u; }
    __device__ __forceinline__ void epi(const pg8::Acc& acc, const Unit& u, int wr, int wc, int fr, int fq) const {
        const int mr = modrow_of(u.pm * 256);
        const float* g = mod + (size_t)mr * (NMOD * D) + chunk * D;
        const float* xin = XinC ? (u.pm < 8 ? XinC : XinL) : nullptr;
#pragma unroll
        for (int bj = 0; bj < 2; ++bj) { const int col = u.pn * 256 + TCOLP(bj, wc, fq); const f32x4 g0 = *(const f32x4*)(g + col), g1 = *(const f32x4*)(g + col + 4);
#pragma unroll
            for (int ai = 0; ai < 2; ++ai)
#pragma unroll
                for (int m = 0; m < 4; ++m) { const size_t off = ((size_t)u.pm * 256 + TROW(ai, wr, m, fr)) * D + col; f32x4 x0, x1;
                    if (xin) { x0 = *(const f32x4*)(xin + off); x1 = *(const f32x4*)(xin + off + 4); }
                    else { const v4u w = *(const v4u*)(X + off); x0 = (f32x4){bf_lo(w.x), bf_hi(w.x), bf_lo(w.y), bf_hi(w.y)}; x1 = (f32x4){bf_lo(w.z), bf_hi(w.z), bf_lo(w[3]), bf_hi(w[3])}; }
                    *(v4u*)(X + off) = pack8(x0 + g0 * acc[ai][bj][m][0], x1 + g1 * acc[ai][bj][m][1]); } }
    }
};

struct PolFP {
    static constexpr bool PERM = true;
    static constexpr bool KEYS = false;
    __device__ __forceinline__ const int* key_ptr(const Unit&, int) const { return nullptr; }
    const char* A; const char* B; int nt; int nN, G, c; bf16* Z; bf16* Zc;
    __device__ __forceinline__ bool next(int i, Unit& u) const { int pm, pn; if (!pg8::static_next(i, G, c, 8, nN, pm, pn)) return false; u.pm = pm; u.pn = pn; u.aux = 0; return true; }
    __device__ __forceinline__ unsigned a_row(const Unit& u, int r, int) const { return (unsigned)(u.pm * 256 + r) * 2048u; }
    __device__ __forceinline__ unsigned b_row(const Unit& u, int r) const {
        int hrow;
        if (u.pn < 128) { const int n = u.pn * 256 + r, b = n >> 12, l2 = (n >> 6) & 63, l1 = n & 63; hrow = NC + b * SEQ + 64 * l1 + l2; }
        else hrow = (u.pn - 128) * 256 + r;
        return (unsigned)hrow * 2048u;
    }
    __device__ __forceinline__ void epi(const pg8::Acc& acc, const Unit& u, int wr, int wc, int fr, int fq) const {
#pragma unroll
        for (int ai = 0; ai < 2; ++ai)
#pragma unroll
            for (int m = 0; m < 4; ++m) { const int cp = u.pm * 256 + TROW(ai, wr, m, fr);
#pragma unroll
                for (int bj = 0; bj < 2; ++bj) { const int n0 = u.pn * 256 + TCOLP(bj, wc, fq); const v4u w = pack8(acc[ai][bj][m][0], acc[ai][bj][m][1]);
                    if (u.pn < 128) *(v4u*)(Z + ((size_t)(n0 >> 6) * 2048 + cp) * 64 + (n0 & 63)) = w;
                    else { const int b = u.pn - 128, l = n0 - 32768 - b * 256; *(v4u*)(Zc + ((size_t)b * 2048 + cp) * 256 + l) = w; } } }
    }
};

struct PolFA {
    static constexpr bool PERM = true;
    static constexpr bool KEYS = false;
    __device__ __forceinline__ const int* key_ptr(const Unit&, int) const { return nullptr; }
    const char* A; const char* B; int nt; int G, c; bf16* Y;
    __device__ __forceinline__ bool next(int i, Unit& u) const { const int L = i * G + c; if (L >= 1024) return false; u.pm = 0; u.pn = L & 127; u.aux = L >> 7; return true; }
    __device__ __forceinline__ unsigned a_row(const Unit&, int r, int) const { return (unsigned)r * 512u; }
    __device__ __forceinline__ unsigned b_row(const Unit& u, int r) const { const int l2 = r & 63, cp = u.pn * 4 + (r >> 6); return (unsigned)((u.aux * 64 + l2) * 512 + cp) * 512u; }
    __device__ __forceinline__ void epi(const pg8::Acc& acc, const Unit& u, int wr, int wc, int fr, int fq) const {
        const int b = u.aux;
#pragma unroll
        for (int ai = 0; ai < 2; ++ai)
#pragma unroll
            for (int m = 0; m < 4; ++m) { const int rr = TROW(ai, wr, m, fr), jp = rr >> 7, pp = (rr >> 6) & 1, k1 = rr & 63;
#pragma unroll
                for (int bj = 0; bj < 2; ++bj) { const int n0 = u.pn * 256 + TCOLP(bj, wc, fq), cp = n0 >> 6, l2 = n0 & 63, cc = 2 * cp + jp;
                    const size_t idx = ((((size_t)(b * 16 + (k1 >> 2)) * 1024 + cc) * 4 + (k1 & 3)) * 2 + pp) * 64 + l2;
                    *(v4u*)(Y + idx) = pack8(acc[ai][bj][m][0], acc[ai][bj][m][1]); } }
    }
};

struct PolFC {
    static constexpr bool PERM = true;
    static constexpr bool KEYS = false;
    __device__ __forceinline__ const int* key_ptr(const Unit&, int) const { return nullptr; }
    const char* A; const char* B; int nt; int G, c; int nunits; unsigned offMC, offZc; bf16* F;
    __device__ __forceinline__ bool next(int i, Unit& u) const { const int L = i * G + c; if (L >= nunits) return false;
        if (L < 512) { u.pm = 0; u.pn = L & 3; u.aux = L >> 2; } else { const int q = L - 512; u.pm = 0; u.pn = q & 3; u.aux = 256 + (q >> 2); } return true; }
    __device__ __forceinline__ unsigned a_row(const Unit& u, int r, int) const {
        if (u.aux < 256) return offMC + (unsigned)((u.aux & 15) * 256 + r) * 1024u;
        return (unsigned)r * 1024u; }
    __device__ __forceinline__ unsigned b_row(const Unit& u, int r) const {
        if (u.aux < 256) return (unsigned)(u.aux * 1024 + u.pn * 256 + r) * 1024u;
        return offZc + (unsigned)((u.aux - 256) * 1024 + u.pn * 256 + r) * 1024u; }
    __device__ __forceinline__ void epi(const pg8::Acc& acc, const Unit& u, int wr, int wc, int fr, int fq) const {
#pragma unroll
        for (int ai = 0; ai < 2; ++ai)
#pragma unroll
            for (int m = 0; m < 4; ++m) { const int rr = TROW(ai, wr, m, fr); size_t frow;
                if (u.aux < 256) { const int b = u.aux >> 4, kq = u.aux & 15, k = 4 * kq + (rr >> 6) + 64 * (rr & 63); frow = (size_t)NC + b * SEQ + k; }
                else frow = (size_t)(u.aux - 256) * LCTX + rr;
#pragma unroll
                for (int bj = 0; bj < 2; ++bj) { const int col = u.pn * 256 + TCOLP(bj, wc, fq); *(v4u*)(F + frow * D + col) = pack8(acc[ai][bj][m][0], acc[ai][bj][m][1]); } }
    }
};

struct PolMlaQ {
    static constexpr bool PERM = true;
    static constexpr bool KEYS = false;
    __device__ __forceinline__ const int* key_ptr(const Unit&, int) const { return nullptr; }
    const char* A; const char* B; int nt; int nM, nN, G, c; bf16* Q; const float* rope; float c2;
    __device__ __forceinline__ bool next(int i, Unit& u) const { int pm, pn; if (!pg8::static_next(i, G, c, nM, nN, pm, pn)) return false; u.pm = pm; u.pn = pn; u.aux = 0; return true; }
    __device__ __forceinline__ unsigned a_row(const Unit& u, int r, int) const { return (unsigned)(u.pm * 256 + r) * (unsigned)(MLA_QL * 2); }
    __device__ __forceinline__ unsigned b_row(const Unit& u, int r) const { return (unsigned)(u.pn * 256 + r) * (unsigned)(MLA_QL * 2); }
    __device__ __forceinline__ void epi(const pg8::Acc& acc, const Unit& u, int wr, int wc, int fr, int fq) const {
        const bool lat = u.pm >= 8;
#pragma unroll
        for (int bj = 0; bj < 2; ++bj) { const int col = u.pn * 256 + TCOLP(bj, wc, fq); const bool isrope = lat && (((col >> 5) % 3) == 2);
#pragma unroll
            for (int ai = 0; ai < 2; ++ai)
#pragma unroll
                for (int m = 0; m < 4; ++m) { const int row = u.pm * 256 + TROW(ai, wr, m, fr); f32x4 v0 = acc[ai][bj][m][0], v1 = acc[ai][bj][m][1];
                    if (isrope) { const int t = (row - NC) & 4095, pos = (fq & 2) ? (t & 63) : (t >> 6);
                        const f32x4* rp = (const f32x4*)(rope + (size_t)pos * 16);
                        const f32x4 r0 = rp[0], r1 = rp[1], r2 = rp[2], r3 = rp[3];
                        f32x4 p0, p1;
#pragma unroll
                        for (int e = 0; e < 4; ++e) { p0[e] = __shfl_xor(v0[e], 16); p1[e] = __shfl_xor(v1[e], 16); }
                        const float sg = (fq & 1) ? 1.f : -1.f;
                        v0[0] = v0[0] * r0[0] + sg * p0[0] * r0[1]; v0[1] = v0[1] * r0[2] + sg * p0[1] * r0[3];
                        v0[2] = v0[2] * r1[0] + sg * p0[2] * r1[1]; v0[3] = v0[3] * r1[2] + sg * p0[3] * r1[3];
                        v1[0] = v1[0] * r2[0] + sg * p1[0] * r2[1]; v1[1] = v1[1] * r2[2] + sg * p1[1] * r2[3];
                        v1[2] = v1[2] * r3[0] + sg * p1[2] * r3[1]; v1[3] = v1[3] * r3[2] + sg * p1[3] * r3[3]; }
                    *(v4u*)(Q + (size_t)row * 1536 + col) = pack8(v0 * c2, v1 * c2); } }
    }
};

struct PolMlaKV {
    static constexpr bool PERM = true;
    static constexpr bool KEYS = false;
    __device__ __forceinline__ const int* key_ptr(const Unit&, int) const { return nullptr; }
    const char* A; const char* B; int nt; int nM, nN, G, c; bf16* Kb; bf16* Vb;
    __device__ __forceinline__ bool next(int i, Unit& u) const { int pm, pn; if (!pg8::static_next(i, G, c, nM, nN, pm, pn)) return false; u.pm = pm; u.pn = pn; u.aux = 0; return true; }
    __device__ __forceinline__ unsigned a_row(const Unit& u, int r, int) const { return (unsigned)(u.pm * 256 + r) * 512u; }
    __device__ __forceinline__ unsigned b_row(const Unit& u, int r) const { return (unsigned)(u.pn * 256 + r) * 512u; }
    __device__ __forceinline__ void epi(const pg8::Acc& acc, const Unit& u, int wr, int wc, int fr, int fq) const {
#pragma unroll
        for (int bj = 0; bj < 2; ++bj) { const int col = u.pn * 256 + TCOLP(bj, wc, fq), h = col >> 7, j = col & 127;
#pragma unroll
            for (int ai = 0; ai < 2; ++ai)
#pragma unroll
                for (int m = 0; m < 4; ++m) { const size_t row = (size_t)u.pm * 256 + TROW(ai, wr, m, fr); const v4u w = pack8(acc[ai][bj][m][0], acc[ai][bj][m][1]);
                    if (j < 64) *(v4u*)(Kb + row * 1536 + 96 * h + j) = w; else *(v4u*)(Vb + row * 1024 + 64 * h + (j - 64)) = w; } }
    }
};

struct MoeTab { const LAS int* TT; const LAS int* CN; const LAS int* TE; };
__device__ __forceinline__ bool moe_next(int i, int G, int c, int NP, const MoeTab& T, Unit& u) {
    const int ttot = T.TT[32];
    int lo, hi, j;
    if ((G & 7) == 0) { const int x = c & 7, q = c >> 3, g8 = G >> 3; lo = (x * ttot) >> 3; hi = ((x + 1) * ttot) >> 3; j = i * g8 + q; }
    else { lo = 0; hi = ttot; j = i * G + c; }
    if (j >= (hi - lo) * NP) return false;
    const int tile = lo + j / NP; u.pn = j % NP; u.pm = tile;
    const int e = T.TE[tile];
    u.aux = e | ((tile - T.TT[e]) << 8);
    return true;
}
struct PolMoe1 {
    static constexpr bool PERM = true;
    const char* A; const char* B; int nt; int G, c; MoeTab T; const int* stok; const float* bgu; bf16* act;
    __device__ __forceinline__ bool next(int i, Unit& u) const { return moe_next(i, G, c, 8, T, u); }
    static constexpr bool KEYS = true;
    __device__ __forceinline__ const int* key_ptr(const Unit& u, int r) const { const int e = u.aux & 255, idx = (u.aux >> 8) * 256 + r; const int cn = T.CN[e]; return stok + (size_t)e * CAP + (idx < cn ? idx : 0); }
    __device__ __forceinline__ unsigned a_row(const Unit&, int, int key) const { return (unsigned)key * 2048u; }
    __device__ __forceinline__ unsigned b_row(const Unit& u, int r) const { return (unsigned)((u.aux & 255) * 2048 + u.pn * 256 + r) * 2048u; }
    __device__ __forceinline__ void epi(const pg8::Acc& acc, const Unit& u, int wr, int wc, int fr, int fq) const {
        const int e = u.aux & 255; const int jl = 32 * wc + 8 * fq;
        const float* bg = bgu + (size_t)e * 2048 + u.pn * 256 + jl;
        const f32x4 bg0 = *(const f32x4*)(bg), bg1 = *(const f32x4*)(bg + 4), bu0 = *(const f32x4*)(bg + 128), bu1 = *(const f32x4*)(bg + 132);
#pragma unroll
        for (int ai = 0; ai < 2; ++ai)
#pragma unroll
            for (int m = 0; m < 4; ++m) { const size_t slot = (size_t)u.pm * 256 + TROW(ai, wr, m, fr);
                f32x4 g0 = acc[ai][0][m][0] + bg0, g1 = acc[ai][0][m][1] + bg1, u0 = acc[ai][1][m][0] + bu0, u1 = acc[ai][1][m][1] + bu1, o0, o1;
#pragma unroll
                for (int q = 0; q < 4; ++q) {
                    float ga = fminf(g0[q], 7.f), ua = fminf(fmaxf(u0[q], -7.f), 7.f); o0[q] = (ua + 1.f) * ga * __builtin_amdgcn_rcpf(1.f + __builtin_amdgcn_exp2f(-1.702f * LOG2E * ga));
                    float gb = fminf(g1[q], 7.f), ub = fminf(fmaxf(u1[q], -7.f), 7.f); o1[q] = (ub + 1.f) * gb * __builtin_amdgcn_rcpf(1.f + __builtin_amdgcn_exp2f(-1.702f * LOG2E * gb)); }
                *(v4u*)(act + slot * 1024 + u.pn * 128 + jl) = pack8(o0, o1); }
    }
};
struct PolMoe2 {
    static constexpr bool PERM = true;
    static constexpr bool KEYS = false;
    __device__ __forceinline__ const int* key_ptr(const Unit&, int) const { return nullptr; }
    const char* A; const char* B; int nt; int G, c; MoeTab T; const float* sw; const float* bdn; bf16* Y;
    __device__ __forceinline__ bool next(int i, Unit& u) const { return moe_next(i, G, c, 4, T, u); }
    __device__ __forceinline__ unsigned a_row(const Unit& u, int r, int) const { return (unsigned)(u.pm * 256 + r) * 2048u; }
    __device__ __forceinline__ unsigned b_row(const Unit& u, int r) const { return (unsigned)((u.aux & 255) * 1024 + u.pn * 256 + r) * 2048u; }
    __device__ __forceinline__ void epi(const pg8::Acc& acc, const Unit& u, int wr, int wc, int fr, int fq) const {
        const int e = u.aux & 255, mt = u.aux >> 8, cn = T.CN[e];
        f32x4 bv[2][2];
#pragma unroll
        for (int bj = 0; bj < 2; ++bj) { const float* bp = bdn + (size_t)e * 1024 + u.pn * 256 + TCOLP(bj, wc, fq); bv[bj][0] = *(const f32x4*)bp; bv[bj][1] = *(const f32x4*)(bp + 4); }
#pragma unroll
        for (int ai = 0; ai < 2; ++ai)
#pragma unroll
            for (int m = 0; m < 4; ++m) { const int rr = TROW(ai, wr, m, fr), idx = mt * 256 + rr; const size_t slot = (size_t)u.pm * 256 + rr;
                const float w = sw[(size_t)e * CAP + (idx < cn ? idx : 0)];
#pragma unroll
                for (int bj = 0; bj < 2; ++bj) { const int col = u.pn * 256 + TCOLP(bj, wc, fq);
                    *(v4u*)(Y + slot * 1024 + col) = pack8((acc[ai][bj][m][0] + bv[bj][0]) * w, (acc[ai][bj][m][1] + bv[bj][1]) * w); } }
    }
};

namespace att {
__device__ __forceinline__ int crow(int r, int hi) { return (r & 3) + 8 * (r >> 2) + 4 * hi; }
__device__ __forceinline__ float max3f(float a, float b, float c) { return fmaxf(fmaxf(a, b), c); }
typedef LAS const char* lds_cptr;
constexpr int LK = 0, LV = 49152, LWS = 90112, LOST = 92160, LBYTES = 124928;
constexpr int PD = 3;
struct Tens { const bf16* Q; int qpitch; const bf16* K; int kpitch; const bf16* V; int vpitch; bf16* O; };
#define ATT_WAITV(n) asm volatile("s_waitcnt vmcnt(" #n ")" ::: "memory")
struct Pend { f32x16 o0, o1; float l; int qrow0, oc0; bool valid; };
__device__ __forceinline__ void finish_unit(const Pend& P, bf16* O, LAS unsigned char* lds, int wid, int lane) {
    const int r32 = lane & 31, hi = lane >> 5;
    LAS float* wsf = (LAS float*)(lds + LWS) + wid * 64;
    float lrun = P.l;
    { auto rr = __builtin_amdgcn_permlane32_swap(__float_as_uint(lrun), __float_as_uint(lrun), false, false); lrun = __uint_as_float(rr[0]) + __uint_as_float(rr[1]); }
    if (hi == 0) wsf[32 + r32] = lrun;
    LDS_WAIT();
    LAS bf16* stg = (LAS bf16*)(lds + LOST) + wid * 2048;
#pragma unroll
    for (int r = 0; r < 16; ++r) { const int orow = crow(r, hi); const float rl = __builtin_amdgcn_rcpf(wsf[32 + orow]);
        stg[orow * 64 + r32] = (bf16)(pk2(P.o0[r] * rl, 0.f) & 0xffffu); stg[orow * 64 + 32 + r32] = (bf16)(pk2(P.o1[r] * rl, 0.f) & 0xffffu); }
    LDS_WAIT();
    bf16* Ow = O + (size_t)(P.qrow0 + wid * 32) * 1024 + P.oc0;
#pragma unroll
    for (int i = 0; i < 4; ++i) { const int row = i * 8 + (lane >> 3), ch = lane & 7; const v4u v = *(const LAS v4u*)(stg + row * 64 + ch * 8); *(v4u*)(Ow + (size_t)row * 1024 + ch * 8) = v; }
    LDS_WAIT();
}
template <int DK>
__device__ __forceinline__ void unit(const Tens& T, int qrow0, int qc0, int kc0, int vc0, int oc0, int kctx0, int klat0, int NTL, LAS unsigned char* lds, int wave_id, Pend& pend) {
    constexpr int ND = DK / 16;
    wave_id = launder_s(wave_id); const int tid = lthread_w(wave_id), lane = tid & 63, r32 = lane & 31, hi = lane >> 5; const int wid = wave_id;
    LAS float* wsf = (LAS float*)(lds + LWS) + wid * 64;
    const bf16* ksrc = T.K + (size_t)lane * T.kpitch + kc0 + wid * 8;
    const bf16* ksrc2 = T.K + (size_t)lane * T.kpitch + kc0 + (8 + (wid & 3)) * 8;
    const bf16* vsrc = T.V + (size_t)(16 * (wid & 3) + (lane >> 2)) * T.vpitch + vc0 + (wid >> 2) * 32 + (lane & 3) * 8;
#define ATT_DMA(t, ks_, vs_) do { const size_t row0_ = (size_t)((t) < 4 ? kctx0 + 64 * (t) : klat0 + 64 * ((t) - 4)); \
        __builtin_amdgcn_global_load_lds((const unsigned*)(ksrc + row0_ * T.kpitch), (LAS unsigned*)(lds + LK + (ks_) * 12288 + wid * 1024), 16, 0, 0); \
        if (DK > 64) __builtin_amdgcn_global_load_lds((const unsigned*)(ksrc2 + row0_ * T.kpitch), (LAS unsigned*)(lds + LK + (ks_) * 12288 + 8192 + (wid & 3) * 1024), 16, 0, 0); \
        __builtin_amdgcn_global_load_lds((const unsigned*)(vsrc + row0_ * T.vpitch), (LAS unsigned*)(lds + LV + (vs_) * 8192 + wid * 1024), 16, 0, 0); } while (0)
#define ATT_WAIT_TILES(n_tiles) do { if (DK > 64) { if ((n_tiles) >= 2) ATT_WAITV(6); else if ((n_tiles) == 1) ATT_WAITV(3); else ATT_WAITV(0); } \
        else { if ((n_tiles) >= 2) ATT_WAITV(4); else if ((n_tiles) == 1) ATT_WAITV(2); else ATT_WAITV(0); } } while (0)
    bf16x8 qr[ND];
    { const bf16* qp = T.Q + (size_t)(qrow0 + wid * 32 + r32) * T.qpitch + qc0 + hi * 8;
#pragma unroll
      for (int d0 = 0; d0 < ND; ++d0) qr[d0] = *(const bf16x8*)(qp + d0 * 16); }
    asm volatile("" ::: "memory");
    constexpr float THR = 8.f;
    const int half = wid >> 2;
    float mhat = 0.f, lrun = 0.f; f32x16 o[2]; o[0] = f32x16{}; o[1] = f32x16{}; f32x16 negm = f32x16{};
    f32x16 p0 = f32x16{}, p1 = f32x16{}; v4u pw[4]; pw[0] = pw[1] = pw[2] = pw[3] = (v4u){0u, 0u, 0u, 0u};
    ATT_DMA(0, 0, 0); ATT_DMA(1, 1, 1); ATT_DMA(2, 2, 2);
    if (pend.valid) finish_unit(pend, T.O, lds, wid, lane);
    ATT_WAIT_TILES(2);
    __builtin_amdgcn_s_barrier(); asm volatile("" ::: "memory");
    if (half == 1) __builtin_amdgcn_s_barrier();
    int vs_prev = 0, vs_cur = 0, vs_iss = 3;
    for (int t = 0; t <= NTL; ++t) {
        {
            s16x4 lo[2][4], hh[2][4]; bf16x8 kf[2 * ND];
            if (t >= 1) {
                const unsigned vb = (unsigned)(uintptr_t)(lds + LV + vs_prev * 8192) + ((lane >> 4) & 1) * 32 + (lane & 3) * 8 + (4 * hi + ((lane & 15) >> 2)) * 64;
#pragma unroll
                for (int d0 = 0; d0 < 2; ++d0)
#pragma unroll
                    for (int ks = 0; ks < 4; ++ks) {
                        asm volatile("ds_read_b64_tr_b16 %0,%1 offset:%c2" : "=&v"(lo[d0][ks]) : "v"(vb), "i"(d0 * 4096 + ks * 1024) : "memory");
                        asm volatile("ds_read_b64_tr_b16 %0,%1 offset:%c2" : "=&v"(hh[d0][ks]) : "v"(vb), "i"(d0 * 4096 + ks * 1024 + 512) : "memory"); }
            }
            if (t < NTL) {
                const lds_cptr kb = (lds_cptr)(lds + LK + (t & 3) * 12288) + hi * 1024 + r32 * 16;
#pragma unroll
                for (int d0 = 0; d0 < ND; ++d0) { kf[2 * d0] = *(const LAS bf16x8*)(kb + d0 * 2048); kf[2 * d0 + 1] = *(const LAS bf16x8*)(kb + d0 * 2048 + 512); }
            }
            asm volatile("s_waitcnt lgkmcnt(0)" ::: "memory"); __builtin_amdgcn_sched_barrier(0);
            if (t >= 1) {
#pragma unroll
                for (int ks = 0; ks < 4; ++ks)
#pragma unroll
                    for (int d0 = 0; d0 < 2; ++d0) { const bf16x8 vf = (bf16x8){lo[d0][ks][0], lo[d0][ks][1], lo[d0][ks][2], lo[d0][ks][3], hh[d0][ks][0], hh[d0][ks][1], hh[d0][ks][2], hh[d0][ks][3]};
                        o[d0] = __builtin_amdgcn_mfma_f32_32x32x16_bf16(__builtin_bit_cast(bf16x8, pw[ks]), vf, o[d0], 0, 0, 0); }
            }
            if (t < NTL) {
#pragma unroll
                for (int d0 = 0; d0 < ND; ++d0) {
                    if (d0 == 0) { p0 = __builtin_amdgcn_mfma_f32_32x32x16_bf16(kf[0], qr[0], negm, 0, 0, 0); p1 = __builtin_amdgcn_mfma_f32_32x32x16_bf16(kf[1], qr[0], negm, 0, 0, 0); }
                    else { p0 = __builtin_amdgcn_mfma_f32_32x32x16_bf16(kf[2 * d0], qr[d0], p0, 0, 0, 0); p1 = __builtin_amdgcn_mfma_f32_32x32x16_bf16(kf[2 * d0 + 1], qr[d0], p1, 0, 0, 0); } }
            }
        }
        if (half == 1) {
            const int last_iss = (t + PD - 1 < NTL - 1) ? t + PD - 1 : NTL - 1; const int allow = last_iss - (t + 1);
            if (allow >= 1) ATT_WAIT_TILES(1); else ATT_WAIT_TILES(0); }
        asm volatile("s_waitcnt lgkmcnt(0)" ::: "memory"); __builtin_amdgcn_s_barrier(); asm volatile("" ::: "memory");
        if (t < NTL) {
            float rm = max3f(p0[0], p0[1], p1[0]);
#pragma unroll
            for (int r = 0; r < 16; ++r) rm = max3f(rm, p0[r], p1[r]);
            { auto rr = __builtin_amdgcn_permlane32_swap(__float_as_uint(rm), __float_as_uint(rm), false, false); rm = fmaxf(__uint_as_float(rr[0]), __uint_as_float(rr[1])); }
            if (t == 0 || __any(rm > THR)) {
                const float dl = (t == 0) ? rm : fmaxf(rm, 0.f);
                mhat += dl;
#pragma unroll
                for (int r = 0; r < 16; ++r) { p0[r] -= dl; p1[r] -= dl; negm[r] = -mhat; }
                const float f = (t == 0) ? 1.f : __builtin_amdgcn_exp2f(-dl); lrun *= f;
                if (hi == 0) wsf[r32] = f;
                LDS_WAIT();
#pragma unroll
                for (int r = 0; r < 16; ++r) { const float a = wsf[crow(r, hi)]; o[0][r] *= a; o[1][r] *= a; }
            }
            float rs = 0.f;
#pragma unroll
            for (int r = 0; r < 16; ++r) { p0[r] = __builtin_amdgcn_exp2f(p0[r]); p1[r] = __builtin_amdgcn_exp2f(p1[r]); rs += p0[r] + p1[r]; }
            lrun += rs;
            pw[0] = (v4u){pk2(p0[0], p0[1]), pk2(p0[2], p0[3]), pk2(p0[4], p0[5]), pk2(p0[6], p0[7])};
            pw[1] = (v4u){pk2(p0[8], p0[9]), pk2(p0[10], p0[11]), pk2(p0[12], p0[13]), pk2(p0[14], p0[15])};
            pw[2] = (v4u){pk2(p1[0], p1[1]), pk2(p1[2], p1[3]), pk2(p1[4], p1[5]), pk2(p1[6], p1[7])};
            pw[3] = (v4u){pk2(p1[8], p1[9]), pk2(p1[10], p1[11]), pk2(p1[12], p1[13]), pk2(p1[14], p1[15])};
        }
        if (t + PD < NTL) { ATT_DMA(t + PD, (t + PD) & 3, vs_iss); vs_iss = (vs_iss == 4) ? 0 : vs_iss + 1; }
        if (half == 0) {
            const int last_iss = (t + PD < NTL - 1) ? t + PD : NTL - 1; const int allow = last_iss - (t + 1);
            if (allow >= 2) ATT_WAIT_TILES(2); else if (allow == 1) ATT_WAIT_TILES(1); else ATT_WAIT_TILES(0); }
        vs_prev = vs_cur; vs_cur = (vs_cur == 4) ? 0 : vs_cur + 1;
        asm volatile("s_waitcnt lgkmcnt(0)" ::: "memory"); __builtin_amdgcn_s_barrier(); asm volatile("" ::: "memory");
    }
    if (half == 0) __builtin_amdgcn_s_barrier();
#undef ATT_DMA
#undef ATT_WAIT_TILES
    pend.o0 = o[0]; pend.o1 = o[1]; pend.l = lrun; pend.qrow0 = qrow0; pend.oc0 = oc0; pend.valid = true;
}
#undef ATT_WAITV
}

struct Args { const float* in[27]; float* out; unsigned char* ws; int ph_lo, ph_hi; };
struct Frame {
    LAS unsigned char* lds; unsigned char* ws; gu32* ctl; int wave, G, gw, NGW;
};
__device__ __forceinline__ int lthread(int wave) { return wave * 64 + lane_id_v(); }

template <int MODE>
__device__ __forceinline__ void conv_item(const float* W, int K, int N, bf16* WT, LAS float* scr, int item, int lane) {
    const int nblk = (N + 63) / 64, kb = item / nblk, nb = item % nblk, k0 = 64 * kb, n0 = 64 * nb;
    f32x4 v[16];
    const int cc = (lane & 15) * 4, rk = lane >> 4;
    const bool ok = (n0 + cc) < N;
#pragma unroll
    for (int i = 0; i < 16; ++i) v[i] = ok ? *(const f32x4*)(W + (size_t)(k0 + 4 * i + rk) * N + n0 + cc) : (f32x4){0.f, 0.f, 0.f, 0.f};
#pragma unroll
    for (int i = 0; i < 16; ++i) { LAS float* s = scr + (4 * i + rk) * 65 + cc; s[0] = v[i][0]; s[1] = v[i][1]; s[2] = v[i][2]; s[3] = v[i][3]; }
    LDS_WAIT(); asm volatile("" ::: "memory");
    const int c = lane & 7;
#pragma unroll
    for (int j = 0; j < 8; ++j) { const int n = (lane >> 3) + 8 * j; const LAS float* s = scr + (8 * c) * 65 + n;
        v4u o; o.x = pk2(s[0], s[65]); o.y = pk2(s[2 * 65], s[3 * 65]); o.z = pk2(s[4 * 65], s[5 * 65]); o.w = pk2(s[6 * 65], s[7 * 65]);
        const int ng = n0 + n; if (ng < N) { const int dr = (MODE == 1) ? ((ng >> 8) * 256 + (ng & 1) * 128 + ((ng >> 1) & 127)) : ng; *(v4u*)(WT + (size_t)dr * K + k0 + 8 * c) = o; } }
    LDS_WAIT(); asm volatile("" ::: "memory");
}

__device__ __forceinline__ void prologue(Frame& F, const Args& a) {
    const int f_tid = lthread(F.wave), f_lane = f_tid & 63;
    unsigned char* ws = F.ws;
    {
        LAS float* scr = (LAS float*)(F.lds + F.wave * 16640);
        struct M { const float* src; int K, N; size_t dst; };
        const int I_FO = 16 * 16, I_MIN = 16 * 11, I_QB = 6 * 24, I_KVB = 4 * 32, I_MO = 256, I_GQKV = 16 * 24, I_GO = 256;
        const int NSMALL = 2 * I_FO + I_MIN + I_QB + I_KVB + I_MO + I_GQKV + I_GO;
        for (int it = F.gw; it < NSMALL; it += F.NGW) {
            int r = it;
            if (r < 2 * I_FO) { const int j = r / I_FO; conv_item<0>(a.in[10] + (size_t)j * D * D, D, D, (bf16*)(ws + WS_WFOUT) + (size_t)j * D * D, scr, r % I_FO, f_lane); continue; } r -= 2 * I_FO;
            if (r < I_MIN) { conv_item<0>(a.in[11], D, MLA_IN, (bf16*)(ws + WS_WMIN), scr, r, f_lane); continue; } r -= I_MIN;
            if (r < I_QB) { conv_item<0>(a.in[13], MLA_QL, 1536, (bf16*)(ws + WS_WMQB), scr, r, f_lane); continue; } r -= I_QB;
            if (r < I_KVB) { conv_item<0>(a.in[15], MLA_KVL, 2048, (bf16*)(ws + WS_WMKVB), scr, r, f_lane); continue; } r -= I_KVB;
            if (r < I_MO) { conv_item<0>(a.in[16], D, D, (bf16*)(ws + WS_WMO), scr, r, f_lane); continue; } r -= I_MO;
            if (r < I_GQKV) { conv_item<0>(a.in[17], D, GQA_QKV, (bf16*)(ws + WS_WGQKV), scr, r, f_lane); continue; } r -= I_GQKV;
            conv_item<0>(a.in[20], D, D, (bf16*)(ws + WS_WGO), scr, r, f_lane);
        }
        const int I_GU = 16 * 32, I_DN = 16 * 16, I_E = I_GU + I_DN, NMOE = DEPTH * NE * I_E;
        for (int it = F.gw; it < NMOE; it += F.NGW) {
            const int le = it / I_E, r = it % I_E;
            if (r < I_GU) conv_item<1>(a.in[23] + (size_t)le * D * 2048, D, 2048, (bf16*)(ws + WS_WGU) + (size_t)le * 2048 * D, scr, r, f_lane);
            else conv_item<0>(a.in[25] + (size_t)le * DFF * D, DFF, D, (bf16*)(ws + WS_WDN) + (size_t)le * D * DFF, scr, r - I_GU, f_lane);
        }
    }
    const int gtid = blockIdx.x * 512 + f_tid, gthreads = F.G * 512;
    for (int i = gtid; i < (MLA_IN_PAD - MLA_IN) * D / 8; i += gthreads) ((v4u*)((bf16*)(ws + WS_WMIN) + (size_t)MLA_IN * D))[i] = (v4u){0u, 0u, 0u, 0u};
    {
        bf16* MA = (bf16*)(ws + WS_MA);
        for (int i = gtid; i < 256 * 256; i += gthreads) { const int row = i >> 8, col = i & 255, jp = row >> 7, pp = (row >> 6) & 1, k1 = row & 63, j = col >> 7, pt = (col >> 6) & 1, l1 = col & 63;
            float v = 0.f; if (j == jp) { const float x = 2.f * (float)((k1 * l1) & 63) / 64.f; const float cs = cospif(x), sn = sinpif(x); v = (pp == 0) ? (pt == 0 ? cs : sn) : (pt == 0 ? -sn : cs); }
            MA[i] = (bf16)(pk2(v, 0.f) & 0xffffu); }
        bf16* DC = (bf16*)(ws + WS_DC); const float sc = 1.0f / sqrtf(256.f * 128.f);
        for (int i = gtid; i < 256 * 512; i += gthreads) { const int k = i >> 9, col = i & 511, pt = col >> 8, l = col & 255; const float x = 2.f * (float)((k * l) & 255) / 256.f;
            const float v = (pt == 0 ? cospif(x) : sinpif(x)) * sc; DC[i] = (bf16)(pk2(v, 0.f) & 0xffffu); }
        bf16* MC = (bf16*)(ws + WS_MC); const float sl = 1.0f / sqrtf(4096.f * 128.f);
        for (int i = gtid; i < 16 * 256 * 512; i += gthreads) { const int kq = i >> 17, row = (i >> 9) & 255, col = i & 511, kkp = row >> 6, k2 = row & 63, kk = col >> 7, pp = (col >> 6) & 1, l2 = col & 63;
            float v = 0.f; if (kk == kkp) { const int k = 4 * kq + kkp + 64 * k2; const float x = 2.f * (float)((l2 * k) & 4095) / 4096.f; v = (pp == 0 ? cospif(x) : sinpif(x)) * sl; }
            MC[i] = (bf16)(pk2(v, 0.f) & 0xffffu); }
        float* RM = (float*)(ws + WS_ROPE); float* RG = RM + 2048;
        for (int i = gtid; i < 64 * 8; i += gthreads) { const int pos = i >> 3, f = i & 7; const float inv = powf(10000.f, -(float)f / 8.f); float s, c; sincosf((float)pos * inv, &s, &c); RM[2 * i] = c; RM[2 * i + 1] = s; }
        for (int i = gtid; i < 64 * 16; i += gthreads) { const int pos = i >> 4, f = i & 15; const float inv = powf(10000.f, -(float)f / 16.f); float s, c; sincosf((float)pos * inv, &s, &c); RG[2 * i] = c; RG[2 * i + 1] = s; }
        float* WRT = (float*)(ws + WS_WRT);
        for (int i = gtid; i < DEPTH * NE * D; i += gthreads) { const int l = i >> 15, e = (i >> 10) & 31, k = i & 1023; WRT[i] = a.in[21][((size_t)l * D + k) * NE + e]; }
        float* BG = (float*)(ws + WS_BGU);
        for (int i = gtid; i < DEPTH * NE * 2048; i += gthreads) { const int le = i >> 11, q = i & 2047, pn = q >> 8, s = (q >> 7) & 1, jj = q & 127; BG[i] = a.in[24][(size_t)le * 2048 + 2 * (pn * 128 + jj) + s]; }
    }
    __syncthreads();
    {
        LAS float* wl = (LAS float*)F.lds;
        LAS float* tc = wl + 2048; LAS float* ts = tc + 128;
        if (f_tid < 128) { const float x = 2.f * (float)f_tid / 128.f; tc[f_tid] = cospif(x); ts[f_tid] = -sinpif(x); }
        for (int it = blockIdx.x; it < 2 * 8 * 64; it += F.G) { const int j = it >> 9, g = (it >> 6) & 7, kb = it & 63;
            __syncthreads();
            { const int kk = f_tid >> 5, c4 = (f_tid & 31) * 4; const f32x4 w = *(const f32x4*)(a.in[9] + ((size_t)j * D + kb * 16 + kk) * D + g * 128 + c4);
              LAS float* d = wl + c4 * 16 + kk; d[0] = w[0]; d[16] = w[1]; d[32] = w[2]; d[48] = w[3]; }
            __syncthreads();
            const int cl = f_tid & 255, m = cl >> 1, part = cl & 1, kh = f_tid >> 8; const LAS float* tw = part ? ts : tc;
            float accv[8];
#pragma unroll
            for (int q = 0; q < 8; ++q) accv[q] = 0.f;
            for (int jj = 0; jj < 128; ++jj) { const float t = tw[(m * jj) & 127]; const f32x4 wa = *(const LAS f32x4*)(wl + jj * 16 + kh * 8), wb = *(const LAS f32x4*)(wl + jj * 16 + kh * 8 + 4);
                accv[0] += wa[0] * t; accv[1] += wa[1] * t; accv[2] += wa[2] * t; accv[3] += wa[3] * t; accv[4] += wb[0] * t; accv[5] += wb[1] * t; accv[6] += wb[2] * t; accv[7] += wb[3] * t; }
            v4u o; o.x = pk2(accv[0], accv[1]); o.y = pk2(accv[2], accv[3]); o.z = pk2(accv[4], accv[5]); o.w = pk2(accv[6], accv[7]);
            *(v4u*)((bf16*)(ws + WS_WFIN) + ((size_t)j * 2048 + g * 256 + cl) * D + kb * 16 + kh * 8) = o;
        }
        __syncthreads();
    }
    {
        LAS float* S = (LAS float*)F.lds;
        LAS float* red = S + 9 * 1024;
        for (int i = f_tid; i < 9 * 1024; i += 512) { const int r = i >> 10, k = i & 1023; const float v = (r < 8) ? a.in[1][r * D + k] : a.in[3][k]; S[i] = v / (1.f + __expf(-v)); }
        __syncthreads();
        for (int it = blockIdx.x; it < DEPTH * 96; it += F.G) { const int l = it / 96, n0 = (it % 96) * 64;
            const float* wp = a.in[4] + ((size_t)l * D + F.wave * 128) * (NMOD * D) + n0 + f_lane;
            float accv[9];
#pragma unroll
            for (int r = 0; r < 9; ++r) accv[r] = 0.f;
            for (int k0 = 0; k0 < 128; k0 += 32) { float wv[32];
#pragma unroll
                for (int k = 0; k < 32; ++k) wv[k] = wp[(size_t)(k0 + k) * (NMOD * D)];
#pragma unroll
                for (int k = 0; k < 32; ++k)
#pragma unroll
                    for (int r = 0; r < 9; ++r) accv[r] += S[r * 1024 + F.wave * 128 + k0 + k] * wv[k]; }
#pragma unroll
            for (int r = 0; r < 9; ++r) red[(F.wave * 9 + r) * 64 + f_lane] = accv[r];
            __syncthreads();
            for (int i = f_tid; i < 9 * 64; i += 512) { const int r = i >> 6, ln = i & 63; float s = a.in[5][(size_t)l * (NMOD * D) + n0 + ln];
#pragma unroll
                for (int w = 0; w < 8; ++w) s += red[(w * 9 + r) * 64 + ln];
                ((float*)(ws + WS_MOD))[((size_t)l * 9 + r) * (NMOD * D) + n0 + ln] = s; }
            __syncthreads();
        }
    }
}

__device__ __forceinline__ void load_row(const float* p, int lane, f32x4 (&v)[4]) {
#pragma unroll
    for (int j = 0; j < 4; ++j) v[j] = ((const f32x4*)p)[lane + 64 * j];
}
__device__ __forceinline__ void load_row_bf(const bf16* p, int lane, f32x4 (&v)[4]) {
#pragma unroll
    for (int j = 0; j < 4; ++j) { const v2u w = ((const v2u*)p)[lane + 64 * j]; v[j] = (f32x4){bf_lo(w.x), bf_hi(w.x), bf_lo(w.y), bf_hi(w.y)}; }
}
__device__ __forceinline__ void norm_mod(f32x4 (&v)[4], const float* g, const float* shift, const float* scale, int lane) {
    float s = 0.f;
#pragma unroll
    for (int j = 0; j < 4; ++j) s += (v[j][0] * v[j][0] + v[j][1] * v[j][1]) + (v[j][2] * v[j][2] + v[j][3] * v[j][3]);
    const float rstd = rsqrtf(wave_sum(s) * (1.f / D) + EPS);
#pragma unroll
    for (int j = 0; j < 4; ++j) { const f32x4 gv = ((const f32x4*)g)[lane + 64 * j], sh = ((const f32x4*)shift)[lane + 64 * j], sc = ((const f32x4*)scale)[lane + 64 * j];
        v[j] = (v[j] * rstd * gv) * (sc + 1.f) + sh; }
}
__device__ __forceinline__ void store_row_bf16(bf16* p, int lane, const f32x4 (&v)[4]) {
#pragma unroll
    for (int j = 0; j < 4; ++j) { v2u w; w.x = pk2(v[j][0], v[j][1]); w.y = pk2(v[j][2], v[j][3]); ((v2u*)p)[lane + 64 * j] = w; }
}

__device__ __forceinline__ void rp_norm1(Frame& F, const Args& a, int l, int row_lo) {
    const int f_tid = lthread(F.wave), f_lane = f_tid & 63;
    const bf16* X = (const bf16*)(F.ws + WS_X); bf16* H = (bf16*)(F.ws + WS_H); const float* MOD = (const float*)(F.ws + WS_MOD) + (size_t)l * 9 * (NMOD * D);
    for (int row = row_lo + F.gw; row < NT; row += F.NGW) { f32x4 v[4];
        if (l == 0) load_row(row < NC ? a.in[2] + (size_t)row * D : a.in[0] + (size_t)(row - NC) * D, f_lane, v);
        else load_row_bf(X + (size_t)row * D, f_lane, v);
        const float* m = MOD + (size_t)modrow_of(row) * (NMOD * D);
        norm_mod(v, a.in[6] + (size_t)l * D, m, m + D, f_lane); store_row_bf16(H + (size_t)row * D, f_lane, v); }
}

#if MK_N2V2
constexpr int LDS_LIST = LDS_MISC + 768;
__device__ __forceinline__ unsigned row16_max(unsigned k) {
    unsigned t;
    t = (unsigned)__builtin_amdgcn_mov_dpp((int)k, 0xb1, 0xf, 0xf, false); k = k > t ? k : t;
    t = (unsigned)__builtin_amdgcn_mov_dpp((int)k, 0x4e, 0xf, 0xf, false); k = k > t ? k : t;
    t = (unsigned)__builtin_amdgcn_mov_dpp((int)k, 0x124, 0xf, 0xf, false); k = k > t ? k : t;
    t = (unsigned)__builtin_amdgcn_mov_dpp((int)k, 0x128, 0xf, 0xf, false); k = k > t ? k : t;
    return k;
}
__device__ __forceinline__ unsigned wave_max_u(unsigned k) {
    k = row16_max(k);
    const unsigned a = (unsigned)__builtin_amdgcn_readlane((int)k, 0), b = (unsigned)__builtin_amdgcn_readlane((int)k, 16), c = (unsigned)__builtin_amdgcn_readlane((int)k, 32), d = (unsigned)__builtin_amdgcn_readlane((int)k, 48);
    const unsigned ab = a > b ? a : b, cd = c > d ? c : d; return ab > cd ? ab : cd;
}
__device__ __forceinline__ float key_val(unsigned m) { const unsigned u = m & ~31u; return __builtin_bit_cast(float, (u & 0x80000000u) ? (u ^ 0x80000000u) : ~u); }
__device__ __forceinline__ void rp_norm2_router(Frame& F, const Args& a, int l, int row_lo) {
    const int f_tid = lthread(F.wave), f_lane = f_tid & 63;
    const bf16* X = (const bf16*)(F.ws + WS_X); bf16* H = (bf16*)(F.ws + WS_H); const float* MOD = (const float*)(F.ws + WS_MOD) + (size_t)l * 9 * (NMOD * D);
    LAS float* wt = (LAS float*)F.lds;
    { const f32x4* src = (const f32x4*)((const float*)(F.ws + WS_WRT) + (size_t)l * NE * D); f32x4 tv[16];
#pragma unroll
      for (int i = 0; i < 16; ++i) tv[i] = src[f_tid + 512 * i];
#pragma unroll
      for (int i = 0; i < 16; ++i) ((LAS f32x4*)wt)[f_tid + 512 * i] = tv[i]; }
    LAS int* lcnt = (LAS int*)(F.lds + LDS_TT); LAS int* lbase = lcnt + 32;
    LAS v4u* list = (LAS v4u*)(F.lds + LDS_LIST) + F.wave * 68;
    if (f_tid < 32) lcnt[f_tid] = 0;
    __syncthreads();
    const float* gf = a.in[7] + (size_t)l * D;
    f32x4 gv[4];
#pragma unroll
    for (int j = 0; j < 4; ++j) gv[j] = ((const f32x4*)gf)[f_lane + 64 * j];
    const int my_e = f_lane >> 1;
    const float my_b = a.in[22][(size_t)l * NE + my_e];
    int row = row_lo + F.gw, it = 0;
    f32x4 vn[4];
    if (row < NT) load_row_bf(X + (size_t)row * D, f_lane, vn);
    for (; row < NT; row += F.NGW, ++it) {
        f32x4 v[4], sh[4], sc[4];
        const float* m = MOD + (size_t)modrow_of(row) * (NMOD * D);
#pragma unroll
        for (int j = 0; j < 4; ++j) { sh[j] = ((const f32x4*)(m + 3 * D))[f_lane + 64 * j]; sc[j] = ((const f32x4*)(m + 4 * D))[f_lane + 64 * j]; }
        asm volatile("" ::: "memory");
#pragma unroll
        for (int j = 0; j < 4; ++j) v[j] = vn[j];
        { const int nrow = row + F.NGW; if (nrow < NT) load_row_bf(X + (size_t)nrow * D, f_lane, vn); }
        float ssq = 0.f;
#pragma unroll
        for (int j = 0; j < 4; ++j) ssq += (v[j][0] * v[j][0] + v[j][1] * v[j][1]) + (v[j][2] * v[j][2] + v[j][3] * v[j][3]);
        const float rstd = rsqrtf(wave_sum(ssq) * (1.f / D) + EPS);
#pragma unroll
        for (int j = 0; j < 4; ++j) v[j] = (v[j] * rstd * gv[j]) * (sc[j] + 1.f) + sh[j];
        store_row_bf16(H + (size_t)row * D, f_lane, v);
        float p[32];
#pragma unroll
        for (int e = 0; e < 32; ++e) { f32x2 s2 = (f32x2){0.f, 0.f};
#pragma unroll
            for (int j = 0; j < 4; ++j) { const f32x4 w = ((const LAS f32x4*)(wt + e * 1024))[f_lane + 64 * j];
                s2 = __builtin_elementwise_fma((f32x2){v[j][0], v[j][1]}, (f32x2){w[0], w[1]}, s2); s2 = __builtin_elementwise_fma((f32x2){v[j][2], v[j][3]}, (f32x2){w[2], w[3]}, s2); }
            p[e] = s2[0] + s2[1]; }
#pragma unroll
        for (int s = 0; s < 5; ++s) { const int half = 16 >> s, msk = 32 >> s; const bool up = (f_lane & msk) != 0;
#pragma unroll
            for (int i = 0; i < half; ++i) { const float keep = up ? p[i + half] : p[i], send = up ? p[i] : p[i + half]; p[i] = keep + __shfl_xor(send, msk); } }
        const float lgt = p[0] + __shfl_xor(p[0], 1) + my_b;
        unsigned key; { const unsigned u = __builtin_bit_cast(unsigned, lgt); const unsigned o = (u & 0x80000000u) ? ~u : (u | 0x80000000u); key = (o & ~31u) | (unsigned)(31 - my_e); }
        unsigned mk[4];
#pragma unroll
        for (int k = 0; k < 4; ++k) { mk[k] = wave_max_u(key); key = (key == mk[k]) ? 0u : key; }
        const float b0 = key_val(mk[0]);
        const float e1 = __expf(key_val(mk[1]) - b0), e2 = __expf(key_val(mk[2]) - b0), e3 = __expf(key_val(mk[3]) - b0); const float inv = 1.f / (1.f + e1 + e2 + e3);
        if (f_lane < 4) { const unsigned mm = f_lane == 0 ? mk[0] : f_lane == 1 ? mk[1] : f_lane == 2 ? mk[2] : mk[3]; const int me = 31 - (int)(mm & 31u);
            const float mw = (f_lane == 0 ? 1.f : f_lane == 1 ? e1 : f_lane == 2 ? e2 : e3) * inv;
            const int lr = __hip_atomic_fetch_add(lcnt + me, 1, __ATOMIC_RELAXED, __HIP_MEMORY_SCOPE_WORKGROUP);
            LAS unsigned* ep = (LAS unsigned*)(list + it * 4 + f_lane); ep[0] = (unsigned)(row * 4 + f_lane); ep[1] = (unsigned)me; ep[2] = (unsigned)lr; ep[3] = __builtin_bit_cast(unsigned, mw); }
    }
    __syncthreads();
    if (f_tid < 32) { const int c = lcnt[f_tid]; lbase[f_tid] = c ? (int)__hip_atomic_fetch_add((unsigned*)(F.ctl + CW_CNT + (l * 32 + f_tid) * 16), (unsigned)c, RLX_AGENT) : 0; }
    __syncthreads();
    int* te = (int*)(F.ws + WS_TE); int* trank = (int*)(F.ws + WS_TRANK); int* stok = (int*)(F.ws + WS_STOK); float* sw = (float*)(F.ws + WS_SW);
    for (int i = f_lane; i < it * 4; i += 64) { const LAS unsigned* ep = (const LAS unsigned*)(list + i); const unsigned rowk = ep[0], ex = ep[1], lr = ep[2]; const float wv = __builtin_bit_cast(float, ep[3]);
        const int rk = lbase[ex] + (int)lr;
        stok[(size_t)ex * CAP + rk] = (int)(rowk >> 2); sw[(size_t)ex * CAP + rk] = wv; te[rowk] = (int)ex; trank[rowk] = rk; }
}

#endif
__device__ __forceinline__ void moe_table(Frame& F, int l) {
    const int f_tid = lthread(F.wave), f_lane = f_tid & 63;
    LAS int* TT = (LAS int*)(F.lds + LDS_TT); LAS int* CN = TT + 64; LAS int* TE = (LAS int*)(F.lds + LDS_TE);
    __syncthreads();
    if (f_tid < 64) {
        const int c = (f_lane < 32) ? (int)__hip_atomic_load((unsigned*)(F.ctl + CW_CNT + (l * 32 + (f_lane & 31)) * 16), RLX_AGENT) : 0;
        const int tl = (c + 255) >> 8; int v = tl;
#pragma unroll
        for (int o = 1; o < 32; o <<= 1) { const int n = __shfl_up(v, o); if (f_lane >= o) v += n; }
        if (f_lane < 32) { CN[f_lane] = c; TT[f_lane] = v - tl; if (f_lane == 31) TT[32] = v; }
    }
    __syncthreads();
    for (int t = f_tid; t < MAXTILES; t += 512) { int lo = 0, hi = 32;
#pragma unroll
        for (int k = 0; k < 5; ++k) { const int mid = (lo + hi) >> 1; if (TT[mid] <= t) lo = mid; else hi = mid; }
        TE[t] = lo; }
    __syncthreads();
}

#if MK_CBV2
struct CombRow { v2u x[4]; v2u y[4][4]; };
__device__ __forceinline__ void comb_issue(CombRow& R, const bf16* X, const bf16* Y, const LAS int* TT, int row, const v4u te4, const v4u tr4, int lane) {
    const unsigned ee[4] = {te4[0], te4[1], te4[2], te4[3]}, rr[4] = {tr4[0], tr4[1], tr4[2], tr4[3]};
#pragma unroll
    for (int k = 0; k < 4; ++k) { const size_t slot = (size_t)TT[ee[k]] * 256 + rr[k]; const v2u* yp = (const v2u*)(Y + slot * 1024);
#pragma unroll
        for (int j = 0; j < 4; ++j) R.y[k][j] = yp[lane + 64 * j]; }
#pragma unroll
    for (int j = 0; j < 4; ++j) R.x[j] = ((const v2u*)(X + (size_t)row * D))[lane + 64 * j];
}
__device__ __forceinline__ void comb_finish(const CombRow& R, Frame& F, const Args& a, int l, int row, int lane, const float* MOD, const float* MODN, bool lastl) {
    bf16* X = (bf16*)(F.ws + WS_X); bf16* H = (bf16*)(F.ws + WS_H);
    const int mr = modrow_of(row); const float* g5 = MOD + (size_t)mr * (NMOD * D) + 5 * D;
    f32x4 v[4];
#pragma unroll
    for (int j = 0; j < 4; ++j) { f32x4 s = (f32x4){0.f, 0.f, 0.f, 0.f};
#pragma unroll
        for (int k = 0; k < 4; ++k) { const v2u w = R.y[k][j]; s[0] += bf_lo(w.x); s[1] += bf_hi(w.x); s[2] += bf_lo(w.y); s[3] += bf_hi(w.y); }
        const f32x4 gv = ((const f32x4*)g5)[lane + 64 * j]; const v2u xw = R.x[j]; v[j] = (f32x4){bf_lo(xw.x), bf_hi(xw.x), bf_lo(xw.y), bf_hi(xw.y)} + gv * s; }
    if (!lastl) {
        store_row_bf16(X + (size_t)row * D, lane, v);
        const float* m = MODN + (size_t)mr * (NMOD * D);
        norm_mod(v, a.in[6] + (size_t)(l + 1) * D, m, m + D, lane); store_row_bf16(H + (size_t)row * D, lane, v);
    } else {
        float ss = 0.f;
#pragma unroll
        for (int j = 0; j < 4; ++j) ss += (v[j][0] * v[j][0] + v[j][1] * v[j][1]) + (v[j][2] * v[j][2] + v[j][3] * v[j][3]);
        const float rstd = rsqrtf(wave_sum(ss) * (1.f / D) + EPS);
        float* op = a.out + (size_t)(row - NC) * D;
#pragma unroll
        for (int j = 0; j < 4; ++j) { const f32x4 gv = ((const f32x4*)a.in[8])[lane + 64 * j]; ((f32x4*)op)[lane + 64 * j] = v[j] * rstd * gv; }
    }
}
__device__ __forceinline__ void rp_combine(Frame& F, const Args& a, int l, int row_lo) {
    const int f_tid = lthread(F.wave), f_lane = f_tid & 63;
    const bf16* X = (const bf16*)(F.ws + WS_X); const bf16* Y = (const bf16*)(F.ws + WS_Y);
    const float* MOD = (const float*)(F.ws + WS_MOD) + (size_t)l * 9 * (NMOD * D); const float* MODN = MOD + 9 * (NMOD * D);
    const v4u* te = (const v4u*)(F.ws + WS_TE); const v4u* trank = (const v4u*)(F.ws + WS_TRANK);
    const LAS int* TT = (const LAS int*)(F.lds + LDS_TT);
    const bool lastl = (l == DEPTH - 1);
    const int st = F.NGW;
    int row = row_lo + F.gw;
    if (row >= NT) return;
    CombRow RA, RB;
    v4u te1 = te[row], tr1 = trank[row];
    comb_issue(RA, X, Y, TT, row, te1, tr1, f_lane);
    if (row + st < NT) { te1 = te[row + st]; tr1 = trank[row + st]; }
    for (;;) {
        const bool h1 = row + st < NT;
        if (h1) comb_issue(RB, X, Y, TT, row + st, te1, tr1, f_lane);
        if (row + 2 * st < NT) { te1 = te[row + 2 * st]; tr1 = trank[row + 2 * st]; }
        comb_finish(RA, F, a, l, row, f_lane, MOD, MODN, lastl);
        if (!h1) break;
        row += st;
        const bool h2 = row + st < NT;
        if (h2) comb_issue(RA, X, Y, TT, row + st, te1, tr1, f_lane);
        if (row + 2 * st < NT) { te1 = te[row + 2 * st]; tr1 = trank[row + 2 * st]; }
        comb_finish(RB, F, a, l, row, f_lane, MOD, MODN, lastl);
        if (!h2) break;
        row += st;
    }
}

#endif
__device__ __forceinline__ void rp_mla(Frame& F, const Args& a) {
    const int f_tid = lthread(F.wave), f_lane = f_tid & 63;
    const bf16* A = (const bf16*)(F.ws + WS_RE); bf16* QA = (bf16*)(F.ws + WS_RF); bf16* CKV = (bf16*)(F.ws + WS_RG); bf16* Kb = (bf16*)(F.ws + WS_RB);
    const float* rope = (const float*)(F.ws + WS_ROPE); const float* gq = a.in[12]; const float* gk = a.in[14];
    for (int row = F.gw; row < NT; row += F.NGW) {
        const unsigned* ap = (const unsigned*)(A + (size_t)row * MLA_IN_PAD);
        unsigned q[3], c[2];
#pragma unroll
        for (int j = 0; j < 3; ++j) q[j] = ap[f_lane + 64 * j];
#pragma unroll
        for (int j = 0; j < 2; ++j) c[j] = ap[192 + f_lane + 64 * j];
        const unsigned pe = ap[320 + (f_lane & 15)];
        float sq = 0.f, sc = 0.f;
#pragma unroll
        for (int j = 0; j < 3; ++j) { const float x0 = bf_lo(q[j]), x1 = bf_hi(q[j]); sq += x0 * x0 + x1 * x1; }
#pragma unroll
        for (int j = 0; j < 2; ++j) { const float x0 = bf_lo(c[j]), x1 = bf_hi(c[j]); sc += x0 * x0 + x1 * x1; }
        const float rq = rsqrtf(wave_sum(sq) * (1.f / MLA_QL) + EPS), rc = rsqrtf(wave_sum(sc) * (1.f / MLA_KVL) + EPS);
#pragma unroll
        for (int j = 0; j < 3; ++j) { const int e0 = 2 * (f_lane + 64 * j); ((unsigned*)(QA + (size_t)row * MLA_QL))[f_lane + 64 * j] = pk2(bf_lo(q[j]) * rq * gq[e0], bf_hi(q[j]) * rq * gq[e0 + 1]); }
#pragma unroll
        for (int j = 0; j < 2; ++j) { const int e0 = 2 * (f_lane + 64 * j); ((unsigned*)(CKV + (size_t)row * MLA_KVL))[f_lane + 64 * j] = pk2(bf_lo(c[j]) * rc * gk[e0], bf_hi(c[j]) * rc * gk[e0 + 1]); }
        float x0 = bf_lo(pe), x1 = bf_hi(pe);
        if (row >= NC) { const int t = (row - NC) & 4095, i = f_lane & 15, d = 2 * i, pos = (d & 16) ? (t & 63) : (t >> 6), f = d & 7;
            const float p0 = __shfl_xor(x0, 4), p1 = __shfl_xor(x1, 4); const float sg = (d & 8) ? 1.f : -1.f;
            const float* rp = rope + (size_t)pos * 16 + 2 * f; x0 = x0 * rp[0] + sg * p0 * rp[1]; x1 = x1 * rp[2] + sg * p1 * rp[3]; }
        const unsigned w = pk2(x0, x1);
        { const int i = f_lane & 15, hb = f_lane >> 4;
#pragma unroll
          for (int hh = 0; hh < 4; ++hh) { const int h = hb * 4 + hh; ((unsigned*)(Kb + (size_t)row * 1536 + 96 * h + 64))[i] = w; } }
    }
}

__device__ __forceinline__ void rp_gqa(Frame& F, const Args& a) {
    const int f_tid = lthread(F.wave), f_lane = f_tid & 63;
    const bf16* A = (const bf16*)(F.ws + WS_RA); bf16* Q = (bf16*)(F.ws + WS_RB); bf16* Kb = Q + (size_t)NT * 1024;
    const float* rope = (const float*)(F.ws + WS_ROPE) + 2048; const float* gq = a.in[18]; const float* gk = a.in[19];
    const float c2 = 0.125f * LOG2E;
    for (int row = F.gw; row < NT; row += F.NGW) {
        const bool lat = row >= NC; const int t = (row - NC) & 4095;
#pragma unroll
        for (int part = 0; part < 2; ++part) {
            const int ln = part ? (f_lane & 15) : f_lane; const bf16* src = A + (size_t)row * GQA_QKV + (part ? 1024 : 0) + ln * 16;
            const v4u w0 = *(const v4u*)src, w1 = *(const v4u*)(src + 8);
            float x[16]; const unsigned ww[8] = {w0.x, w0.y, w0.z, w0.w, w1.x, w1.y, w1.z, w1.w};
#pragma unroll
            for (int i = 0; i < 8; ++i) { x[2 * i] = bf_lo(ww[i]); x[2 * i + 1] = bf_hi(ww[i]); }
            float ss = 0.f;
#pragma unroll
            for (int i = 0; i < 16; ++i) ss += x[i] * x[i];
            ss += __shfl_xor(ss, 1); ss += __shfl_xor(ss, 2);
            const float rs = rsqrtf(ss * (1.f / 64.f) + EPS); const float* g = (part ? gk : gq) + (ln & 3) * 16;
#pragma unroll
            for (int i = 0; i < 16; ++i) x[i] = x[i] * rs * g[i];
            if (lat) { const int sec = (ln >> 1) & 1, pos = sec ? (t & 63) : (t >> 6); const float sg = (ln & 1) ? 1.f : -1.f; const float* rp = rope + (size_t)pos * 32;
#pragma unroll
                for (int i = 0; i < 16; ++i) { const float pr = __shfl_xor(x[i], 1); x[i] = x[i] * rp[2 * i] + sg * pr * rp[2 * i + 1]; } }
            const float scl = part ? 1.f : c2;
            v4u o0, o1; o0.x = pk2(x[0] * scl, x[1] * scl); o0.y = pk2(x[2] * scl, x[3] * scl); o0.z = pk2(x[4] * scl, x[5] * scl); o0.w = pk2(x[6] * scl, x[7] * scl);
            o1.x = pk2(x[8] * scl, x[9] * scl); o1.y = pk2(x[10] * scl, x[11] * scl); o1.z = pk2(x[12] * scl, x[13] * scl); o1.w = pk2(x[14] * scl, x[15] * scl);
            if (part == 0) { bf16* d = Q + (size_t)row * 1024 + ln * 16; *(v4u*)d = o0; *(v4u*)(d + 8) = o1; }
            else if (f_lane < 16) { bf16* d = Kb + (size_t)row * 256 + ln * 16; *(v4u*)d = o0; *(v4u*)(d + 8) = o1; }
        }
    }
}

template <int DK>
__device__ __forceinline__ void attn_phase(Frame& F, const att::Tens& T, int kvshift  , int kstride, int vstride, int vbase) {
    const int vcu = (F.G % 8 == 0) ? (blockIdx.x % 8) * (F.G / 8) + blockIdx.x / 8 : blockIdx.x;
    att::Pend pend; pend.valid = false; pend.o0 = f32x16{}; pend.o1 = f32x16{}; pend.l = 1.f; pend.qrow0 = 0; pend.oc0 = 0;
    for (int u = vcu; u < 2048 + 128; u += F.G) {
        if (u < 2048) { const int b = u >> 8, h = (u >> 4) & 15, qb = u & 15, kvh = h >> kvshift;
            att::unit<DK>(T, NC + b * SEQ + qb * 256, h * DK, kvh * kstride, vbase + kvh * vstride, h * 64, b * LCTX, NC + b * SEQ, 68, F.lds, F.wave, pend); }
        else { const int q = u - 2048, b = q >> 4, h = q & 15, kvh = h >> kvshift;
            att::unit<DK>(T, b * LCTX, h * DK, kvh * kstride, vbase + kvh * vstride, h * 64, b * LCTX, 0, 4, F.lds, F.wave, pend); }
    }
    if (pend.valid) att::finish_unit(pend, T.O, F.lds, F.wave, lthread(F.wave) & 63);
    __syncthreads();
}

constexpr int PH_PER_LAYER = 9, PH_TOTAL = 2 + DEPTH * PH_PER_LAYER;
__global__ void __launch_bounds__(512, 2) mk_fwd(Args args) {
    extern __shared__ __attribute__((aligned(16))) unsigned char lds_raw[];
    Frame F;
    F.lds = (LAS unsigned char*)lds_raw; F.ws = args.ws; F.ctl = (gu32*)(args.ws + WS_CTL);
    F.wave = __builtin_amdgcn_readfirstlane(threadIdx.x >> 6); F.G = gridDim.x;
    F.gw = blockIdx.x * 8 + F.wave; F.NGW = F.G * 8;
    if (threadIdx.x < 4) ((LAS unsigned*)(F.lds + LDS_XB))[threadIdx.x] = 0u;
    __syncthreads();
    const int lo = args.ph_lo, hi = args.ph_hi;
    const bool multi = (hi - lo) > 1;
    XcdBarrier bar; bar.bar = (unsigned*)(F.ctl + CW_BAR); bar.x = 0; bar.st = nullptr; bar.wave = F.wave;
    if (multi) bar = xcd_barrier_post((unsigned*)(F.ctl + CW_BAR), (volatile LAS unsigned*)(F.lds + LDS_XB), F.wave);
#define IN(k) (lo <= (k) && (k) < hi)
#define SEAM(k) do { if (IN(k) && IN((k) + 1)) xcd_barrier(bar); } while (0)
    unsigned char* ws0 = args.ws;
#define PH_WS size_t zofs_ = 0; asm volatile("" : "+s"(zofs_)); unsigned char* ws = ws0 + zofs_; F.ws = ws; F.ctl = (gu32*)ws;
    const int G = F.G, cidx = (int)blockIdx.x;

    if (IN(0) && EN(0)) { PH_WS REP(0) { prologue(F, args); SEAM(0); } }
    if (IN(1) && EN(1)) { PH_WS rp_norm1(F, args, 0, 0); SEAM(1); }

    for (int l = 0; l < DEPTH; ++l) {
        const int kind = l % 3, j = l / 3, base = 2 + l * PH_PER_LAYER;
        const bool lastl = (l == DEPTH - 1);

        size_t outB = 0;
        if (kind == 0) {
            if (IN(base + 0) && EN(2)) { PH_WS REP(2) { PolFP p; p.A = (const char*)(ws + WS_WFIN) + (size_t)j * 2048 * D * 2; p.B = (const char*)(ws + WS_H); p.nt = 16; p.nN = lastl ? 128 : 136; p.G = G; p.c = cidx;
                p.Z = (bf16*)(ws + WS_RA); p.Zc = (bf16*)(ws + WS_RH); pg8::gemm_phase(F.lds, p, F.wave); } }
            SEAM(base + 0);
            if (IN(base + 1) && EN(3)) { PH_WS REP(3) { PolFA p; p.A = (const char*)(ws + WS_MA); p.B = (const char*)(ws + WS_RA); p.nt = 4; p.G = G; p.c = cidx; p.Y = (bf16*)(ws + WS_RB); pg8::gemm_phase(F.lds, p, F.wave); } }
            SEAM(base + 1);
            if (IN(base + 2) && EN(4)) { PH_WS REP(4) { PolFC p; p.A = (const char*)(ws + WS_DC); p.B = (const char*)(ws + WS_RB); p.nt = 8; p.G = G; p.c = cidx; p.nunits = lastl ? 512 : 544;
                p.offMC = (unsigned)(WS_MC - WS_DC); p.offZc = (unsigned)(WS_RH - WS_RB); p.F = (bf16*)(ws + WS_RC); pg8::gemm_phase(F.lds, p, F.wave); } }
            SEAM(base + 2);
            outB = WS_WFOUT + (size_t)j * D * D * 2;
        } else if (kind == 1) {
            if (IN(base + 0) && EN(5)) { PH_WS REP(5) { PolDenseBf16 p; p.A = (const char*)(ws + WS_H); p.B = (const char*)(ws + WS_WMIN); p.nt = 16; p.nM = NT / 256; p.nN = 3; p.pm0 = 0; p.G = G; p.c = cidx; p.pitchA = 2048; p.pitchB = 2048;
                p.O = (bf16*)(ws + WS_RE); p.ldo = MLA_IN_PAD; pg8::gemm_phase(F.lds, p, F.wave); } }
            SEAM(base + 0);
            if (IN(base + 1) && EN(6)) { PH_WS REP(6) { rp_mla(F, args); } }
            SEAM(base + 1);
            if (IN(base + 2)) { PH_WS REP(7) {
                if (EN(7)) { PolMlaQ p; p.A = (const char*)(ws + WS_RF); p.B = (const char*)(ws + WS_WMQB); p.nt = 6; p.nM = NT / 256; p.nN = 6; p.G = G; p.c = cidx; p.Q = (bf16*)(ws + WS_RA);
                  p.rope = (const float*)(ws + WS_ROPE); p.c2 = 0.10206207261596575f * LOG2E; pg8::gemm_phase(F.lds, p, F.wave); }
                if (EN(8)) { PolMlaKV p; p.A = (const char*)(ws + WS_RG); p.B = (const char*)(ws + WS_WMKVB); p.nt = 4; p.nM = NT / 256; p.nN = 8; p.G = G; p.c = cidx; p.Kb = (bf16*)(ws + WS_RB); p.Vb = (bf16*)(ws + WS_RD);
                  pg8::gemm_phase(F.lds, p, F.wave); }
            } }
            SEAM(base + 2);
            if (IN(base + 3) && EN(9)) { PH_WS REP(9) { att::Tens T{(const bf16*)(ws + WS_RA), 1536, (const bf16*)(ws + WS_RB), 1536, (const bf16*)(ws + WS_RD), 1024, (bf16*)(ws + WS_RC)}; attn_phase<96>(F, T, 0, 96, 64, 0); } }
            SEAM(base + 3);
            outB = WS_WMO;
        } else {
            if (IN(base + 0) && EN(10)) { PH_WS REP(10) { PolDenseBf16 p; p.A = (const char*)(ws + WS_H); p.B = (const char*)(ws + WS_WGQKV); p.nt = 16; p.nM = NT / 256; p.nN = 6; p.pm0 = 0; p.G = G; p.c = cidx; p.pitchA = 2048; p.pitchB = 2048;
                p.O = (bf16*)(ws + WS_RA); p.ldo = GQA_QKV; pg8::gemm_phase(F.lds, p, F.wave); } }
            SEAM(base + 0);
            if (IN(base + 1) && EN(11)) { PH_WS REP(11) { rp_gqa(F, args); } }
            SEAM(base + 1);
            if (IN(base + 2) && EN(12)) { PH_WS REP(12) { att::Tens T{(const bf16*)(ws + WS_RB), 1024, (const bf16*)(ws + WS_RB) + (size_t)NT * 1024, 256, (const bf16*)(ws + WS_RA), 1536, (bf16*)(ws + WS_RC)}; attn_phase<64>(F, T, 2, 64, 64, 1280); } }
            SEAM(base + 2);
            outB = WS_WGO;
        }
        if (IN(base + 4) && EN(13)) { PH_WS PolOut p; p.A = (const char*)(ws + WS_RC); p.B = (const char*)(ws + outB); p.nt = 16; p.nM = lastl ? NL / 256 : NT / 256; p.nN = 4; p.pm0 = lastl ? 8 : 0; p.G = G; p.c = cidx; p.X = (bf16*)(ws + WS_X); p.mod = (const float*)(ws + WS_MOD) + (size_t)l * 9 * (NMOD * D); p.chunk = 2;
            p.XinC = (l == 0) ? args.in[2] : nullptr; p.XinL = (l == 0) ? args.in[0] - (size_t)NC * D : nullptr;
            pg8::gemm_phase(F.lds, p, F.wave); }
        SEAM(base + 4);
        if (IN(base + 5) && EN(14)) { PH_WS rp_norm2_router(F, args, l, lastl ? NC : 0); }
        SEAM(base + 5);
        if (IN(base + 6) && EN(15)) { PH_WS REP(15) { moe_table(F, l);
            PolMoe1 p; p.A = (const char*)(ws + WS_H); p.B = (const char*)(ws + WS_WGU) + (size_t)l * NE * 2048 * D * 2; p.nt = 16; p.G = G; p.c = cidx;
            p.T.TT = (const LAS int*)(F.lds + LDS_TT); p.T.CN = p.T.TT + 64; p.T.TE = (const LAS int*)(F.lds + LDS_TE); p.stok = (const int*)(ws + WS_STOK); p.bgu = (const float*)(ws + WS_BGU) + (size_t)l * NE * 2048; p.act = (bf16*)(ws + WS_ACT);
            pg8::gemm_phase(F.lds, p, F.wave); } }
        SEAM(base + 6);
        if (IN(base + 7) && EN(16)) { PH_WS REP(16) { moe_table(F, l);
            PolMoe2 p; p.A = (const char*)(ws + WS_ACT); p.B = (const char*)(ws + WS_WDN) + (size_t)l * NE * D * DFF * 2; p.nt = 16; p.G = G; p.c = cidx;
            p.T.TT = (const LAS int*)(F.lds + LDS_TT); p.T.CN = p.T.TT + 64; p.T.TE = (const LAS int*)(F.lds + LDS_TE); p.sw = (const float*)(ws + WS_SW); p.bdn = args.in[26] + (size_t)l * NE * D; p.Y = (bf16*)(ws + WS_Y);
            pg8::gemm_phase(F.lds, p, F.wave); } }
        SEAM(base + 7);
        if (IN(base + 8) && EN(17)) { PH_WS moe_table(F, l); rp_combine(F, args, l, lastl ? NC : 0); }
        SEAM(base + 8);
    }
#undef PH_WS
#undef IN
#undef SEAM
}

extern "C" void kernel_launch(void* const* d_in, const int* in_sizes, int n_in, void* d_out, int out_size, void* d_ws, size_t ws_size, hipStream_t stream) {
    static int grid = 0;
    if (grid == 0) {
        if (n_in != 27 || out_size != NL * D || ws_size < WS_END) { fprintf(stderr, "kernel_launch: unexpected problem (n_in %d, out %d, ws %zu < %zu)\n", n_in, out_size, ws_size, (size_t)WS_END); grid = -1; return; }
        int dev = 0, cus = 0, per_cu = 0;
        if (hipGetDevice(&dev) != hipSuccess || hipDeviceGetAttribute(&cus, hipDeviceAttributeMultiprocessorCount, dev) != hipSuccess) { grid = -1; return; }
        if (hipFuncSetAttribute((const void*)mk_fwd, hipFuncAttributeMaxDynamicSharedMemorySize, LDS_BYTES) != hipSuccess) { fprintf(stderr, "kernel_launch: hipFuncSetAttribute failed\n"); grid = -1; return; }
        if (hipOccupancyMaxActiveBlocksPerMultiprocessor(&per_cu, (const void*)mk_fwd, 512, LDS_BYTES) != hipSuccess || per_cu < 1) fprintf(stderr, "kernel_launch: occupancy query says %d\n", per_cu);
        (void)hipGetLastError();
        grid = cus;
    }
    if (grid < 0) return;
    (void)hipMemsetAsync((char*)d_ws + WS_CTL, 0, CTL_ZERO_BYTES, stream);
    Args a{};
    for (int i = 0; i < 27; ++i) a.in[i] = (const float*)d_in[i];
    a.out = (float*)d_out; a.ws = (unsigned char*)d_ws;
#if MK_PER_PHASE
    for (int ph = 0; ph < PH_TOTAL; ++ph) {
        const int l = (ph - 2) / PH_PER_LAYER, s = (ph - 2) % PH_PER_LAYER, kind = l % 3;
        if (ph >= 2) { if (s == 3 && kind != 1) continue; }
        a.ph_lo = ph; a.ph_hi = ph + 1;
        hipLaunchKernelGGL(mk_fwd, dim3(grid), dim3(512), LDS_BYTES, stream, a);
    }
#else
    a.ph_lo = 0; a.ph_hi = PH_TOTAL;
    hipLaunchKernelGGL(mk_fwd, dim3(grid), dim3(512), LDS_BYTES, stream, a);
#endif
}
```

```cpp
#include <hip/hip_runtime.h>
#include <cstdio>
#include <cstdint>

#ifndef MK_PER_PHASE
#define MK_PER_PHASE 0
#endif
#ifndef MK_N2V2
#define MK_N2V2 1
#endif
#ifndef MK_CBV2
#define MK_CBV2 1
#endif
#ifndef MK_N2AGG
#define MK_N2AGG 1
#endif
#ifndef MK_MASK
#define MK_MASK 0xFFFFFFFFu
#endif
#define EN(id) (((MK_MASK) >> (id)) & 1u)
#ifndef MK_REPMASK
#define MK_REPMASK 0u
#endif
#define REP(id) for (int rep_ = 0; rep_ < ((((MK_REPMASK) >> (id)) & 1u) ? 2 : 1); ++rep_)

constexpr int D = 1024, NB = 8, SEQ = 4096, LCTX = 256, DEPTH = 4;
constexpr int NC = NB * LCTX;
constexpr int NL = NB * SEQ;
constexpr int NT = NC + NL;
constexpr int NMOD = 6, NE = 32, TOPK = 4, DFF = 1024;
constexpr int MLA_QL = 384, MLA_KVL = 256, MLA_ROPE = 32, MLA_NOPE = 64, MLA_V = 64, MLA_IN = 672, MLA_IN_PAD = 768, MLA_QD = 96;
constexpr int GQA_NQ = 1024, GQA_NKV = 256, GQA_QKV = 1536;
constexpr int CAP = NT;
constexpr int MAXTILES = 576;
constexpr float EPS = 1e-6f;
constexpr float LOG2E = 1.4426950408889634f;

constexpr size_t MiB = 1u << 20;
constexpr size_t WS_CTL = 0, CTL_ZERO_BYTES = 96 * 1024;
constexpr size_t WS_MOD = 1 * MiB;
constexpr size_t WS_ROPE = 2 * MiB;
constexpr size_t WS_WRT = 2 * MiB + 65536;
constexpr size_t WS_BGU = 3 * MiB;
constexpr size_t WS_MA = 4 * MiB;
constexpr size_t WS_DC = 4 * MiB + 262144;
constexpr size_t WS_MC = 5 * MiB;
constexpr size_t WS_WFIN = 9 * MiB;
constexpr size_t WS_WFOUT = 17 * MiB;
constexpr size_t WS_WMIN = 21 * MiB;
constexpr size_t WS_WMQB = 23 * MiB;
constexpr size_t WS_WMKVB = 25 * MiB;
constexpr size_t WS_WMO = 26 * MiB;
constexpr size_t WS_WGQKV = 28 * MiB;
constexpr size_t WS_WGO = 31 * MiB;
constexpr size_t WS_TE = 34 * MiB;
constexpr size_t WS_TRANK = 35 * MiB;
constexpr size_t WS_STOK = 36 * MiB;
constexpr size_t WS_SW = 41 * MiB;
constexpr size_t WS_X = 64 * MiB;
constexpr size_t WS_H = 200 * MiB;
constexpr size_t WS_RA = 272 * MiB;
constexpr size_t WS_RB = 400 * MiB;
constexpr size_t WS_RC = 528 * MiB;
constexpr size_t WS_RD = 600 * MiB;
constexpr size_t WS_RE = 672 * MiB;
constexpr size_t WS_RF = 728 * MiB;
constexpr size_t WS_RG = 756 * MiB;
constexpr size_t WS_RH = 776 * MiB;
constexpr size_t WS_ACT = 784 * MiB;
constexpr size_t WS_Y = 1072 * MiB;
constexpr size_t WS_WGU = 1360 * MiB;
constexpr size_t WS_SWGU = 1360 * MiB + 256 * MiB;
constexpr size_t WS_SSC = 1360 * MiB + 260 * MiB;
constexpr size_t WS_WDN = 1872 * MiB;
constexpr size_t WS_END = 2128 * MiB;
constexpr int CW_TMO = 0;
constexpr int CW_BAR = 4096;
constexpr int CW_CNT = 16384;

constexpr int RING_BYTES = 131072;
constexpr int LDS_MISC = 135168;
constexpr int LDS_TT = LDS_MISC;
constexpr int LDS_XB = LDS_MISC + 512;
constexpr int LDS_TE = LDS_MISC + 768;
constexpr int LDS_BYTES = 147456;

#define GAS __attribute__((address_space(1)))
#define LAS __attribute__((address_space(3)))
typedef unsigned short bf16;
typedef unsigned v4u __attribute__((ext_vector_type(4)));
typedef unsigned v2u __attribute__((ext_vector_type(2)));
typedef float f32x4 __attribute__((ext_vector_type(4)));
typedef float f32x2 __attribute__((ext_vector_type(2)));
typedef float f32x16 __attribute__((ext_vector_type(16)));
typedef short bf16x8 __attribute__((ext_vector_type(8)));
typedef short s16x4 __attribute__((ext_vector_type(4)));
typedef __bf16 bf16x2_t __attribute__((ext_vector_type(2)));
typedef GAS unsigned gu32;
#define RLX_AGENT __ATOMIC_RELAXED, __HIP_MEMORY_SCOPE_AGENT
#define LDS_WAIT() asm volatile("s_waitcnt lgkmcnt(0)" ::: "memory")
#define VM_WAIT() asm volatile("s_waitcnt vmcnt(0)" ::: "memory")
__device__ __forceinline__ unsigned pk2(float lo, float hi) { f32x2 v = {lo, hi}; bf16x2_t b = __builtin_convertvector(v, bf16x2_t); return __builtin_bit_cast(unsigned, b); }
__device__ __forceinline__ float bf_lo(unsigned u) { return __builtin_bit_cast(float, u << 16); }
__device__ __forceinline__ float bf_hi(unsigned u) { return __builtin_bit_cast(float, u & 0xffff0000u); }
__device__ __forceinline__ float wave_sum(float v) {
#pragma unroll
    for (int o = 1; o < 64; o <<= 1) v += __shfl_xor(v, o);
    return v;
}
__device__ __forceinline__ int lane_id_v() { int t; asm volatile("v_mbcnt_lo_u32_b32 %0, -1, 0\n\tv_mbcnt_hi_u32_b32 %0, -1, %0" : "=v"(t)); return t; }
__device__ __forceinline__ int launder_s(int x) { asm volatile("" : "+s"(x)); return x; }
__device__ __forceinline__ int lthread_w(int wave) { return wave * 64 + lane_id_v(); }
__device__ __forceinline__ int modrow_of(int row) { return row < NC ? NB : ((row - NC) >> 12); }

#define XB_TMO      128
#define XB_XCNT(j)  (256  + 64 * (j))
#define XB_XSUB(j)  (1280 + 64 * (j))
#define XB_XGEN(j)  (2304 + 64 * (j))
#define XB_TOP      3328
#define XB_TOPGEN   3392
#define XCD_BAR_WORDS 3456
#define XB_SPIN_CAP (1u << 18)
__device__ __forceinline__ unsigned xb_ld(unsigned* p)              { return __hip_atomic_load(p, __ATOMIC_RELAXED, __HIP_MEMORY_SCOPE_AGENT); }
__device__ __forceinline__ unsigned xb_add(unsigned* p, unsigned v) { return __hip_atomic_fetch_add(p, v, __ATOMIC_RELAXED, __HIP_MEMORY_SCOPE_AGENT); }
__device__ __forceinline__ unsigned xb_xcc_id() { return (unsigned)__builtin_amdgcn_s_getreg((3 << 11) | 20) & 0xFu; }
#define XB_SPIN(cond, bar) do { unsigned _sp = 0; while (cond) { __builtin_amdgcn_s_sleep(1); \
    if ((++_sp & 255u) == 0u) { if (xb_ld(&(bar)[XB_TMO])) break; if (_sp > XB_SPIN_CAP) { atomicAdd(&(bar)[XB_TMO], 1u); break; } } } } while (0)
struct XcdBarrier { unsigned* bar; unsigned x; volatile LAS unsigned* st; int wave; };
__device__ __forceinline__ bool xb_thread0(int wave) { return wave == 0 && lane_id_v() == 0; }
__device__ __forceinline__ XcdBarrier xcd_barrier_post(unsigned* bar, volatile LAS unsigned* st, int wave) {
    XcdBarrier b; b.bar = bar; b.x = xb_xcc_id(); b.st = st; b.wave = wave;
    if (xb_thread0(wave)) (void)xb_add(&bar[XB_XCNT(b.x)], 1u);
    return b;
}
__device__ __forceinline__ void xcd_barrier_complete(unsigned* bar, unsigned x, unsigned& nloc, unsigned& nx) {
    const unsigned G = gridDim.x * gridDim.y * gridDim.z;
    unsigned sum, cnt, mine, sp = 0u;
    for (;;) {
        sum = 0u; cnt = 0u; mine = 0u;
#pragma unroll
        for (unsigned j = 0; j < 16; ++j) { const unsigned c = xb_ld(&bar[XB_XCNT(j)]); sum += c; cnt += (c > 0u) ? 1u : 0u; mine = (j == x) ? c : mine; }
        if (sum == G) break;
        __builtin_amdgcn_s_sleep(1);
        if ((++sp & 255u) == 0u) { if (xb_ld(&bar[XB_TMO])) break; if (sp > XB_SPIN_CAP) { atomicAdd(&bar[XB_TMO], 1u); break; } }
    }
    nloc = mine > 0u ? mine : 1u; nx = cnt > 0u ? cnt : 1u;
}
__device__ __forceinline__ void xcd_barrier(const XcdBarrier& b) {
    asm volatile("s_waitcnt vmcnt(0)" ::: "memory");
    __syncthreads();
    if (xb_thread0(b.wave)) {
        unsigned* bar = b.bar;
        __builtin_amdgcn_s_waitcnt(0);
        unsigned nloc = b.st[0], nx = b.st[1];
        if (nloc == 0u) { xcd_barrier_complete(bar, b.x, nloc, nx); b.st[0] = nloc; b.st[1] = nx; }
        const unsigned old = xb_add(&bar[XB_XSUB(b.x)], 1u);
        const unsigned gen = old / nloc;
        if (old + 1u == (gen + 1u) * nloc) {
            __builtin_amdgcn_fence(__ATOMIC_RELEASE, "agent");
            asm volatile("s_waitcnt vmcnt(0)" ::: "memory");
            const unsigned og = xb_add(&bar[XB_TOP], 1u);
            const unsigned tg = og / nx;
            if (og + 1u == (tg + 1u) * nx) xb_add(&bar[XB_TOPGEN], 1u);
            else XB_SPIN(xb_ld(&bar[XB_TOPGEN]) == tg, bar);
            __builtin_amdgcn_fence(__ATOMIC_ACQUIRE, "agent");
            xb_add(&bar[XB_XGEN(b.x)], 1u);
            asm volatile("s_waitcnt vmcnt(0)" ::: "memory");
        } else {
            XB_SPIN(xb_ld(&bar[XB_XGEN(b.x)]) == gen, bar);
            __builtin_amdgcn_fence(__ATOMIC_ACQUIRE, "agent");
            asm volatile("s_waitcnt vmcnt(0)" ::: "memory");
        }
    }
    __syncthreads();
}

namespace pg8 {
#define PG8_LAS __attribute__((address_space(3)))
constexpr int BM = 256, BK = 64, HALF = 128, HTB = HALF * BK * 2, STAGE_BYTES = 8 * HTB, NXCD = 8, WGM = 8;
__device__ __forceinline__ int lds_byte(int r, int c) { const int st = (r >> 4) * 2 + (c >> 5), rr = r & 15, cc = c & 31, ob = rr * 64 + cc * 2; return st * 1024 + (ob ^ (((ob >> 9) & 1) << 5)); }
__device__ __forceinline__ void stage_rc(int b, int& R, int& C) { const int st = b / 1024, sb = b % 1024, swz = sb ^ (((sb >> 9) & 1) << 5); R = (st >> 1) * 16 + swz / 64; C = (st & 1) * 32 + (swz % 64) / 2; }
__device__ __forceinline__ int perm32(int rho) { const int n = rho >> 4, i = rho & 15; return 8 * (i >> 2) + 4 * n + (i & 3); }
struct Unit { int pm, pn, aux; };
typedef f32x4 Acc[2][2][4][2];
typedef int i32x4 __attribute__((ext_vector_type(4)));
typedef i32x4 AccI[2][2][4][2];
template <bool I8> struct AccSel { typedef f32x4 T; };
template <> struct AccSel<true> { typedef i32x4 T; };
__device__ __forceinline__ f32x4 mma1(bf16x8 b, bf16x8 a, f32x4 c) { return __builtin_amdgcn_mfma_f32_16x16x32_bf16(b, a, c, 0, 0, 0); }
__device__ __forceinline__ i32x4 mma1(bf16x8 b, bf16x8 a, i32x4 c) { return __builtin_amdgcn_mfma_i32_16x16x64_i8(__builtin_bit_cast(i32x4, b), __builtin_bit_cast(i32x4, a), c, 0, 0, 0); }

__device__ __forceinline__ bool static_next(int i, int G, int c, int nM, int nN, int& pm, int& pn) {
    const int nwg = nM * nN; const long L = (long)i * G + c; if (L >= nwg) return false;
    int wgid = (int)L; { const int q = nwg / NXCD, r = nwg % NXCD, xcd = wgid % NXCD, off = wgid / NXCD; wgid = (xcd < r ? xcd * (q + 1) : r * (q + 1) + (xcd - r) * q) + off; }
    const int nig = WGM * nN, gid = wgid / nig, fm = gid * WGM, gsz = (nM - fm) < WGM ? (nM - fm) : WGM;
    pm = fm + ((wgid % nig) % gsz); pn = (wgid % nig) / gsz; return true;
}

template <class P>
__device__ __forceinline__ void gemm_phase(PG8_LAS unsigned char* lds, const P& p, int wave_id) {
    wave_id = launder_s(wave_id); int tid_l = lthread_w(wave_id);
    const int tid = tid_l, wid = wave_id, lane = tid & 63, wr = wid >> 2, wc = wid & 3, fr = lane & 15, fq = lane >> 4;
    const int nt = p.nt;
    int R[2], Rb[2], C[2];
#pragma unroll
    for (int i = 0; i < 2; ++i) { stage_rc(tid * 16 + i * 8192, R[i], C[i]); Rb[i] = P::PERM ? ((R[i] & ~31) + perm32(R[i] & 31)) : R[i]; }
    const unsigned ldsw = (unsigned)wid * 1024u;
    const int aoff = lds_byte(wr * 64 + fr, fq * 8), boff = lds_byte(wc * 32 + fr, fq * 8);
    const char* const gA = p.A; const char* const gB = p.B;
#define PG8_SA(b, h) (((b) * 2 + (h)) * HTB)
#define PG8_SB(b, h) ((4 + (b) * 2 + (h)) * HTB)
#define PG8_STAGE(bufoff, gbase, off2, kofs) do { _Pragma("unroll") for (int _i = 0; _i < 2; ++_i) \
        __builtin_amdgcn_global_load_lds((const unsigned*)((gbase) + (size_t)(off2)[_i] + (size_t)(kofs)), (PG8_LAS unsigned*)(lds + (bufoff) + ldsw + _i * 8192), 16, 0, 0); } while (0)
#define PG8_LDA(dst, b, h) do { _Pragma("unroll") for (int m = 0; m < 4; ++m) _Pragma("unroll") for (int k = 0; k < 2; ++k) dst[m][k] = *(const PG8_LAS bf16x8*)(lds + PG8_SA(b, h) + aoff + m * 2048 + k * 1024); } while (0)
#define PG8_LDB(dst, b, h) do { _Pragma("unroll") for (int n = 0; n < 2; ++n) _Pragma("unroll") for (int k = 0; k < 2; ++k) dst[n][k] = *(const PG8_LAS bf16x8*)(lds + PG8_SB(b, h) + boff + n * 2048 + k * 1024); } while (0)
#define PG8_MMA(ai, bj, At, Bt) do { __builtin_amdgcn_s_setprio(1); _Pragma("unroll") for (int m = 0; m < 4; ++m) _Pragma("unroll") for (int n = 0; n < 2; ++n) _Pragma("unroll") for (int k = 0; k < 2; ++k) \
        acc[ai][bj][m][n] = mma1(Bt[n][k], At[m][k], acc[ai][bj][m][n]); __builtin_amdgcn_s_setprio(0); } while (0)
#define PG8_WAIT_V(n) asm volatile("s_waitcnt vmcnt(" #n ")" ::: "memory")
#define PG8_WAIT_L(n) asm volatile("s_waitcnt lgkmcnt(" #n ")" ::: "memory")
#define PG8_BAR __builtin_amdgcn_s_barrier()
#define PG8_SCHED __builtin_amdgcn_sched_barrier(0)
#define PG8_KEYS(u) do { if (P::KEYS && wid < 4) __builtin_amdgcn_global_load_lds((const unsigned*)p.key_ptr(u, wid * 64 + lane), (PG8_LAS unsigned*)(keybuf + wid * 256), 4, 0, 0); } while (0)
#define PG8_OFFS(u, oA, oB) do { _Pragma("unroll") for (int _h = 0; _h < 2; ++_h) _Pragma("unroll") for (int _i = 0; _i < 2; ++_i) { \
        const int key_ = P::KEYS ? ((const PG8_LAS int*)keybuf)[_h * HALF + R[_i]] : 0; \
        oA[_h][_i] = p.a_row(u, _h * HALF + R[_i], key_) + (unsigned)(C[_i] * 2); oB[_h][_i] = p.b_row(u, _h * HALF + Rb[_i]) + (unsigned)(C[_i] * 2); } } while (0)
    PG8_LAS unsigned char* const keybuf = lds + STAGE_BYTES;
    Unit cur, nxt; int ui = 0;
    if (!p.next(0, cur)) return;
    typedef typename AccSel<P::I8>::T AccT;
    AccT acc[2][2][4][2];
#pragma unroll
    for (int a = 0; a < 2; ++a)
#pragma unroll
        for (int b = 0; b < 2; ++b)
#pragma unroll
            for (int m = 0; m < 4; ++m)
#pragma unroll
                for (int n = 0; n < 2; ++n) acc[a][b][m][n] = (AccT){0, 0, 0, 0};
    bf16x8 At[4][2], B0[2][2], B1[2][2];
    unsigned oAc[2][2], oBc[2][2];
    if (P::KEYS) { PG8_KEYS(cur); PG8_WAIT_V(0); PG8_BAR; }
    PG8_OFFS(cur, oAc, oBc);
    PG8_STAGE(PG8_SB(0, 0), gB, oBc[0], 0); PG8_STAGE(PG8_SB(0, 1), gB, oBc[1], 0); PG8_STAGE(PG8_SA(0, 0), gA, oAc[0], 0); PG8_STAGE(PG8_SA(0, 1), gA, oAc[1], 0);
    if (wr == 1) PG8_BAR;
    PG8_WAIT_V(2); PG8_BAR;
    PG8_STAGE(PG8_SB(1, 0), gB, oBc[0], 128); PG8_STAGE(PG8_SA(1, 0), gA, oAc[0], 128); PG8_STAGE(PG8_SB(1, 1), gB, oBc[1], 128);
    PG8_WAIT_V(6); PG8_BAR;
    for (;;) {
        const bool has_next = p.next(ui + 1, nxt);
        if (has_next) { PG8_KEYS(nxt); }
        for (int t = 0; t < nt; t += 2) {
            const bool last = (t == nt - 2);
            const unsigned k1 = (unsigned)(t + 1) * 128u;
            const unsigned k2 = last ? 0u : (unsigned)(t + 2) * 128u, k3 = k2 + 128u;
            PG8_LDB(B0, 0, 0); PG8_LDB(B1, 0, 1); PG8_SCHED; PG8_LDA(At, 0, 0); PG8_STAGE(PG8_SA(1, 1), gA, oAc[1], k1);
            if (last && has_next) { PG8_OFFS(nxt, oAc, oBc); }
            PG8_WAIT_V(8); PG8_WAIT_L(0); PG8_BAR; PG8_MMA(0, 0, At, B0); PG8_MMA(0, 1, At, B1); PG8_BAR; PG8_SCHED;
            PG8_LDA(At, 0, 1); PG8_STAGE(PG8_SB(0, 0), gB, oBc[0], k2); PG8_STAGE(PG8_SB(0, 1), gB, oBc[1], k2); PG8_STAGE(PG8_SA(0, 0), gA, oAc[0], k2);
            PG8_WAIT_V(8); PG8_WAIT_L(0); PG8_BAR; PG8_MMA(1, 0, At, B0); PG8_MMA(1, 1, At, B1); PG8_BAR; PG8_SCHED;
            PG8_LDB(B0, 1, 0); PG8_LDB(B1, 1, 1); PG8_SCHED; PG8_LDA(At, 1, 0); PG8_STAGE(PG8_SA(0, 1), gA, oAc[1], k2);
            PG8_WAIT_V(8); PG8_WAIT_L(0); PG8_BAR; PG8_MMA(0, 0, At, B0); PG8_MMA(0, 1, At, B1); PG8_BAR; PG8_SCHED;
            PG8_LDA(At, 1, 1); PG8_STAGE(PG8_SB(1, 0), gB, oBc[0], k3); PG8_STAGE(PG8_SB(1, 1), gB, oBc[1], k3); PG8_STAGE(PG8_SA(1, 0), gA, oAc[0], k3);
            PG8_WAIT_V(8); PG8_WAIT_L(0); PG8_BAR; PG8_MMA(1, 0, At, B0); PG8_MMA(1, 1, At, B1); PG8_BAR; PG8_SCHED;
        }
        if (wr == 0) PG8_BAR;
        { int fr_e = fr, fq_e = fq; asm volatile("" : "+v"(fr_e), "+v"(fq_e));
          p.epi(acc, cur, wr, wc, fr_e, fq_e); }
        if (!has_next) break;
#pragma unroll
        for (int a = 0; a < 2; ++a)
#pragma unroll
            for (int b = 0; b < 2; ++b)
#pragma unroll
                for (int m = 0; m < 4; ++m)
#pragma unroll
                    for (int n = 0; n < 2; ++n) acc[a][b][m][n] = (AccT){0, 0, 0, 0};
        cur = nxt; ++ui;
        if (wr == 1) PG8_BAR;
    }
    PG8_WAIT_V(0);
    PG8_BAR;
#undef PG8_SA
#undef PG8_SB
#undef PG8_STAGE
#undef PG8_LDA
#undef PG8_LDB
#undef PG8_MMA
#undef PG8_WAIT_V
#undef PG8_WAIT_L
#undef PG8_BAR
#undef PG8_SCHED
#undef PG8_OFFS
#undef PG8_KEYS
}
}
using pg8::Unit;

#define TROW(ai, wr, m, fr) (128 * (ai) + 64 * (wr) + 16 * (m) + (fr))
#define TCOLP(bj, wc, fq) (128 * (bj) + 32 * (wc) + 8 * (fq))
#define TCOLN(bj, wc, n, fq) (128 * (bj) + 32 * (wc) + 16 * (n) + 4 * (fq))
__device__ __forceinline__ v4u pack8(const f32x4 a, const f32x4 b) { v4u w; w.x = pk2(a[0], a[1]); w.y = pk2(a[2], a[3]); w.z = pk2(b[0], b[1]); w.w = pk2(b[2], b[3]); return w; }

struct PolDenseBf16 {
    static constexpr bool PERM = true;
    static constexpr bool KEYS = false;
    static constexpr bool I8 = false;
    __device__ __forceinline__ const int* key_ptr(const Unit&, int) const { return nullptr; }
    const char* A; const char* B; int nt; int nM, nN, pm0, G, c; unsigned pitchA, pitchB; bf16* O; int ldo;
    __device__ __forceinline__ bool next(int i, Unit& u) const { int pm, pn; if (!pg8::static_next(i, G, c, nM, nN, pm, pn)) return false; u.pm = pm + pm0; u.pn = pn; u.aux = 0; return true; }
    __device__ __forceinline__ unsigned a_row(const Unit& u, int r, int) const { return (unsigned)(u.pm * 256 + r) * pitchA; }
    __device__ __forceinline__ unsigned b_row(const Unit& u, int r) const { return (unsigned)(u.pn * 256 + r) * pitchB; }
    __device__ __forceinline__ void epi(const pg8::Acc& acc, const Unit& u, int wr, int wc, int fr, int fq) const {
#pragma unroll
        for (int ai = 0; ai < 2; ++ai)
#pragma unroll
            for (int m = 0; m < 4; ++m) { const size_t row = (size_t)u.pm * 256 + TROW(ai, wr, m, fr);
#pragma unroll
                for (int bj = 0; bj < 2; ++bj) { const int col = u.pn * 256 + TCOLP(bj, wc, fq); *(v4u*)(O + row * ldo + col) = pack8(acc[ai][bj][m][0], acc[ai][bj][m][1]); } }
    }
};

struct PolOut {
    static constexpr bool PERM = true;
    static constexpr bool KEYS = false;
    static constexpr bool I8 = false;
    __device__ __forceinline__ const int* key_ptr(const Unit&, int) const { return nullptr; }
    const char* A; const char* B; int nt; int nM, nN, pm0, G, c; bf16* X; const float* mod;
    int chunk; const float* XinC; const float* XinL;
    __device__ __forceinline__ bool next(int i, Unit& u) const { int pm, pn; if (!pg8::static_next(i, G, c, nM, nN, pm, pn)) return false; u.pm = pm + pm0; u.pn = pn; u.aux = 0; return true; }
    __device__ __forceinline__ unsigned a_row(const Unit& u, int r, int) const { return (unsigned)(u.pm * 256 + r) * 2048u; }
    __device__ __forceinline__ unsigned b_row(const Unit& u, int r) const { return (unsigned)(u.pn * 256 + r) * 2048u; }
    __device__ __forceinline__ void epi(const pg8::Acc& acc, const Unit& u, int wr, int wc, int fr, int fq) const {
        const int mr = modrow_of(u.pm * 256);
        const float* g = mod + (size_t)mr * (NMOD * D) + chunk * D;
        const float* xin = XinC ? (u.pm < 8 ? XinC : XinL) : nullptr;
#pragma unroll
        for (int bj = 0; bj < 2; ++bj) { const int col = u.pn * 256 + TCOLP(bj, wc, fq); const f32x4 g0 = *(const f32x4*)(g + col), g1 = *(const f32x4*)(g + col + 4);
#pragma unroll
            for (int ai = 0; ai < 2; ++ai)
#pragma unroll
                for (int m = 0; m < 4; ++m) { const size_t off = ((size_t)u.pm * 256 + TROW(ai, wr, m, fr)) * D + col; f32x4 x0, x1;
                    if (xin) { x0 = *(const f32x4*)(xin + off); x1 = *(const f32x4*)(xin + off + 4); }
                    else { const v4u w = *(const v4u*)(X + off); x0 = (f32x4){bf_lo(w.x), bf_hi(w.x), bf_lo(w.y), bf_hi(w.y)}; x1 = (f32x4){bf_lo(w.z), bf_hi(w.z), bf_lo(w[3]), bf_hi(w[3])}; }
                    *(v4u*)(X + off) = pack8(x0 + g0 * acc[ai][bj][m][0], x1 + g1 * acc[ai][bj][m][1]); } }
    }
};

struct PolFP {
    static constexpr bool PERM = true;
    static constexpr bool KEYS = false;
    static constexpr bool I8 = false;
    __device__ __forceinline__ const int* key_ptr(const Unit&, int) const { return nullptr; }
    const char* A; const char* B; int nt; int nN, G, c; bf16* Z; bf16* Zc;
    __device__ __forceinline__ bool next(int i, Unit& u) const { int pm, pn; if (!pg8::static_next(i, G, c, 8, nN, pm, pn)) return false; u.pm = pm; u.pn = pn; u.aux = 0; return true; }
    __device__ __forceinline__ unsigned a_row(const Unit& u, int r, int) const { return (unsigned)(u.pm * 256 + r) * 2048u; }
    __device__ __forceinline__ unsigned b_row(const Unit& u, int r) const {
        int hrow;
        if (u.pn < 128) { const int n = u.pn * 256 + r, b = n >> 12, l2 = (n >> 6) & 63, l1 = n & 63; hrow = NC + b * SEQ + 64 * l1 + l2; }
        else hrow = (u.pn - 128) * 256 + r;
        return (unsigned)hrow * 2048u;
    }
    __device__ __forceinline__ void epi(const pg8::Acc& acc, const Unit& u, int wr, int wc, int fr, int fq) const {
#pragma unroll
        for (int ai = 0; ai < 2; ++ai)
#pragma unroll
            for (int m = 0; m < 4; ++m) { const int cp = u.pm * 256 + TROW(ai, wr, m, fr);
#pragma unroll
                for (int bj = 0; bj < 2; ++bj) { const int n0 = u.pn * 256 + TCOLP(bj, wc, fq); const v4u w = pack8(acc[ai][bj][m][0], acc[ai][bj][m][1]);
                    if (u.pn < 128) *(v4u*)(Z + ((size_t)(n0 >> 6) * 2048 + cp) * 64 + (n0 & 63)) = w;
                    else { const int b = u.pn - 128, l = n0 - 32768 - b * 256; *(v4u*)(Zc + ((size_t)b * 2048 + cp) * 256 + l) = w; } } }
    }
};

struct PolFA {
    static constexpr bool PERM = true;
    static constexpr bool KEYS = false;
    static constexpr bool I8 = false;
    __device__ __forceinline__ const int* key_ptr(const Unit&, int) const { return nullptr; }
    const char* A; const char* B; int nt; int G, c; bf16* Y;
    __device__ __forceinline__ bool next(int i, Unit& u) const { const int L = i * G + c; if (L >= 1024) return false; u.pm = 0; u.pn = L & 127; u.aux = L >> 7; return true; }
    __device__ __forceinline__ unsigned a_row(const Unit&, int r, int) const { return (unsigned)r * 512u; }
    __device__ __forceinline__ unsigned b_row(const Unit& u, int r) const { const int l2 = r & 63, cp = u.pn * 4 + (r >> 6); return (unsigned)((u.aux * 64 + l2) * 512 + cp) * 512u; }
    __device__ __forceinline__ void epi(const pg8::Acc& acc, const Unit& u, int wr, int wc, int fr, int fq) const {
        const int b = u.aux;
#pragma unroll
        for (int ai = 0; ai < 2; ++ai)
#pragma unroll
            for (int m = 0; m < 4; ++m) { const int rr = TROW(ai, wr, m, fr), jp = rr >> 7, pp = (rr >> 6) & 1, k1 = rr & 63;
#pragma unroll
                for (int bj = 0; bj < 2; ++bj) { const int n0 = u.pn * 256 + TCOLP(bj, wc, fq), cp = n0 >> 6, l2 = n0 & 63, cc = 2 * cp + jp;
                    const size_t idx = ((((size_t)(b * 16 + (k1 >> 2)) * 1024 + cc) * 4 + (k1 & 3)) * 2 + pp) * 64 + l2;
                    *(v4u*)(Y + idx) = pack8(acc[ai][bj][m][0], acc[ai][bj][m][1]); } }
    }
};

struct PolFC {
    static constexpr bool PERM = true;
    static constexpr bool KEYS = false;
    static constexpr bool I8 = false;
    __device__ __forceinline__ const int* key_ptr(const Unit&, int) const { return nullptr; }
    const char* A; const char* B; int nt; int G, c; int nunits; unsigned offMC, offZc; bf16* F;
    __device__ __forceinline__ bool next(int i, Unit& u) const { const int L = i * G + c; if (L >= nunits) return false;
        if (L < 512) { u.pm = 0; u.pn = L & 3; u.aux = L >> 2; } else { const int q = L - 512; u.pm = 0; u.pn = q & 3; u.aux = 256 + (q >> 2); } return true; }
    __device__ __forceinline__ unsigned a_row(const Unit& u, int r, int) const {
        if (u.aux < 256) return offMC + (unsigned)((u.aux & 15) * 256 + r) * 1024u;
        return (unsigned)r * 1024u; }
    __device__ __forceinline__ unsigned b_row(const Unit& u, int r) const {
        if (u.aux < 256) return (unsigned)(u.aux * 1024 + u.pn * 256 + r) * 1024u;
        return offZc + (unsigned)((u.aux - 256) * 1024 + u.pn * 256 + r) * 1024u; }
    __device__ __forceinline__ void epi(const pg8::Acc& acc, const Unit& u, int wr, int wc, int fr, int fq) const {
#pragma unroll
        for (int ai = 0; ai < 2; ++ai)
#pragma unroll
            for (int m = 0; m < 4; ++m) { const int rr = TROW(ai, wr, m, fr); size_t frow;
                if (u.aux < 256) { const int b = u.aux >> 4, kq = u.aux & 15, k = 4 * kq + (rr >> 6) + 64 * (rr & 63); frow = (size_t)NC + b * SEQ + k; }
                else frow = (size_t)(u.aux - 256) * LCTX + rr;
#pragma unroll
                for (int bj = 0; bj < 2; ++bj) { const int col = u.pn * 256 + TCOLP(bj, wc, fq); *(v4u*)(F + frow * D + col) = pack8(acc[ai][bj][m][0], acc[ai][bj][m][1]); } }
    }
};

struct PolMlaQ {
    static constexpr bool PERM = true;
    static constexpr bool KEYS = false;
    static constexpr bool I8 = false;
    __device__ __forceinline__ const int* key_ptr(const Unit&, int) const { return nullptr; }
    const char* A; const char* B; int nt; int nM, nN, G, c; bf16* Q; const float* rope; float c2;
    __device__ __forceinline__ bool next(int i, Unit& u) const { int pm, pn; if (!pg8::static_next(i, G, c, nM, nN, pm, pn)) return false; u.pm = pm; u.pn = pn; u.aux = 0; return true; }
    __device__ __forceinline__ unsigned a_row(const Unit& u, int r, int) const { return (unsigned)(u.pm * 256 + r) * (unsigned)(MLA_QL * 2); }
    __device__ __forceinline__ unsigned b_row(const Unit& u, int r) const { return (unsigned)(u.pn * 256 + r) * (unsigned)(MLA_QL * 2); }
    __device__ __forceinline__ void epi(const pg8::Acc& acc, const Unit& u, int wr, int wc, int fr, int fq) const {
        const bool lat = u.pm >= 8;
#pragma unroll
        for (int bj = 0; bj < 2; ++bj) { const int col = u.pn * 256 + TCOLP(bj, wc, fq); const bool isrope = lat && (((col >> 5) % 3) == 2);
#pragma unroll
            for (int ai = 0; ai < 2; ++ai)
#pragma unroll
                for (int m = 0; m < 4; ++m) { const int row = u.pm * 256 + TROW(ai, wr, m, fr); f32x4 v0 = acc[ai][bj][m][0], v1 = acc[ai][bj][m][1];
                    if (isrope) { const int t = (row - NC) & 4095, pos = (fq & 2) ? (t & 63) : (t >> 6);
                        const f32x4* rp = (const f32x4*)(rope + (size_t)pos * 16);
                        const f32x4 r0 = rp[0], r1 = rp[1], r2 = rp[2], r3 = rp[3];
                        f32x4 p0, p1;
#pragma unroll
                        for (int e = 0; e < 4; ++e) { p0[e] = __shfl_xor(v0[e], 16); p1[e] = __shfl_xor(v1[e], 16); }
                        const float sg = (fq & 1) ? 1.f : -1.f;
                        v0[0] = v0[0] * r0[0] + sg * p0[0] * r0[1]; v0[1] = v0[1] * r0[2] + sg * p0[1] * r0[3];
                        v0[2] = v0[2] * r1[0] + sg * p0[2] * r1[1]; v0[3] = v0[3] * r1[2] + sg * p0[3] * r1[3];
                        v1[0] = v1[0] * r2[0] + sg * p1[0] * r2[1]; v1[1] = v1[1] * r2[2] + sg * p1[1] * r2[3];
                        v1[2] = v1[2] * r3[0] + sg * p1[2] * r3[1]; v1[3] = v1[3] * r3[2] + sg * p1[3] * r3[3]; }
                    *(v4u*)(Q + (size_t)row * 1536 + col) = pack8(v0 * c2, v1 * c2); } }
    }
};

struct PolMlaKV {
    static constexpr bool PERM = true;
    static constexpr bool KEYS = false;
    static constexpr bool I8 = false;
    __device__ __forceinline__ const int* key_ptr(const Unit&, int) const { return nullptr; }
    const char* A; const char* B; int nt; int nM, nN, G, c; bf16* Kb; bf16* Vb;
    __device__ __forceinline__ bool next(int i, Unit& u) const { int pm, pn; if (!pg8::static_next(i, G, c, nM, nN, pm, pn)) return false; u.pm = pm; u.pn = pn; u.aux = 0; return true; }
    __device__ __forceinline__ unsigned a_row(const Unit& u, int r, int) const { return (unsigned)(u.pm * 256 + r) * 512u; }
    __device__ __forceinline__ unsigned b_row(const Unit& u, int r) const { return (unsigned)(u.pn * 256 + r) * 512u; }
    __device__ __forceinline__ void epi(const pg8::Acc& acc, const Unit& u, int wr, int wc, int fr, int fq) const {
#pragma unroll
        for (int bj = 0; bj < 2; ++bj) { const int col = u.pn * 256 + TCOLP(bj, wc, fq), h = col >> 7, j = col & 127;
#pragma unroll
            for (int ai = 0; ai < 2; ++ai)
#pragma unroll
                for (int m = 0; m < 4; ++m) { const size_t row = (size_t)u.pm * 256 + TROW(ai, wr, m, fr); const v4u w = pack8(acc[ai][bj][m][0], acc[ai][bj][m][1]);
                    if (j < 64) *(v4u*)(Kb + row * 1536 + 96 * h + j) = w; else *(v4u*)(Vb + row * 1024 + 64 * h + (j - 64)) = w; } }
    }
};

struct MoeTab { const LAS int* TT; const LAS int* CN; const LAS int* TE; };
__device__ __forceinline__ bool moe_next(int i, int G, int c, int NP, const MoeTab& T, Unit& u) {
    const int ttot = T.TT[32];
    int lo, hi, j;
    if ((G & 7) == 0) { const int x = c & 7, q = c >> 3, g8 = G >> 3; lo = (x * ttot) >> 3; hi = ((x + 1) * ttot) >> 3; j = i * g8 + q; }
    else { lo = 0; hi = ttot; j = i * G + c; }
    if (j >= (hi - lo) * NP) return false;
    const int tile = lo + j / NP; u.pn = j % NP; u.pm = tile;
    const int e = T.TE[tile];
    u.aux = e | ((tile - T.TT[e]) << 8);
    return true;
}
struct PolMoe1 {
    static constexpr bool PERM = true;
    static constexpr bool I8 = true;
    const char* A; const char* B; int nt; int G, c; MoeTab T; const int* stok; const float* bgu; const float* swgu; const float* ssc; bf16* act;
    __device__ __forceinline__ bool next(int i, Unit& u) const { return moe_next(i, G, c, 8, T, u); }
    static constexpr bool KEYS = true;
    __device__ __forceinline__ const int* key_ptr(const Unit& u, int r) const { const int e = u.aux & 255, idx = (u.aux >> 8) * 256 + r; const int cn = T.CN[e]; return stok + (size_t)e * CAP + (idx < cn ? idx : 0); }
    __device__ __forceinline__ unsigned a_row(const Unit&, int, int key) const { return (unsigned)key * 1024u; }
    __device__ __forceinline__ unsigned b_row(const Unit& u, int r) const { return (unsigned)((u.aux & 255) * 2048 + u.pn * 256 + r) * 1024u; }
    __device__ __forceinline__ void epi(const pg8::AccI& acc, const Unit& u, int wr, int wc, int fr, int fq) const {
        const int e = u.aux & 255, mt = u.aux >> 8, cn = T.CN[e]; const int jl = 32 * wc + 8 * fq;
        const float* bg = bgu + (size_t)e * 2048 + u.pn * 256 + jl;
        const float* sg = swgu + (size_t)e * 2048 + u.pn * 256 + jl;
        const f32x4 bg0 = *(const f32x4*)(bg), bg1 = *(const f32x4*)(bg + 4), bu0 = *(const f32x4*)(bg + 128), bu1 = *(const f32x4*)(bg + 132);
        const f32x4 sg0 = *(const f32x4*)(sg), sg1 = *(const f32x4*)(sg + 4), su0 = *(const f32x4*)(sg + 128), su1 = *(const f32x4*)(sg + 132);
#pragma unroll
        for (int ai = 0; ai < 2; ++ai)
#pragma unroll
            for (int m = 0; m < 4; ++m) { const int rr = TROW(ai, wr, m, fr), idx = mt * 256 + rr; const size_t slot = (size_t)u.pm * 256 + rr;
                const float sa = ssc[(size_t)e * CAP + (idx < cn ? idx : 0)];
                f32x4 g0, g1, u0, u1, o0, o1;
#pragma unroll
                for (int q = 0; q < 4; ++q) { g0[q] = (float)acc[ai][0][m][0][q] * (sa * sg0[q]) + bg0[q]; g1[q] = (float)acc[ai][0][m][1][q] * (sa * sg1[q]) + bg1[q];
                    u0[q] = (float)acc[ai][1][m][0][q] * (sa * su0[q]) + bu0[q]; u1[q] = (float)acc[ai][1][m][1][q] * (sa * su1[q]) + bu1[q]; }
#pragma unroll
                for (int q = 0; q < 4; ++q) {
                    float ga = fminf(g0[q], 7.f), ua = fminf(fmaxf(u0[q], -7.f), 7.f); o0[q] = (ua + 1.f) * ga * __builtin_amdgcn_rcpf(1.f + __builtin_amdgcn_exp2f(-1.702f * LOG2E * ga));
                    float gb = fminf(g1[q], 7.f), ub = fminf(fmaxf(u1[q], -7.f), 7.f); o1[q] = (ub + 1.f) * gb * __builtin_amdgcn_rcpf(1.f + __builtin_amdgcn_exp2f(-1.702f * LOG2E * gb)); }
                *(v4u*)(act + slot * 1024 + u.pn * 128 + jl) = pack8(o0, o1); }
    }
};
struct PolMoe2 {
    static constexpr bool PERM = true;
    static constexpr bool KEYS = false;
    static constexpr bool I8 = false;
    __device__ __forceinline__ const int* key_ptr(const Unit&, int) const { return nullptr; }
    const char* A; const char* B; int nt; int G, c; MoeTab T; const float* sw; const float* bdn; bf16* Y;
    __device__ __forceinline__ bool next(int i, Unit& u) const { return moe_next(i, G, c, 4, T, u); }
    __device__ __forceinline__ unsigned a_row(const Unit& u, int r, int) const { return (unsigned)(u.pm * 256 + r) * 2048u; }
    __device__ __forceinline__ unsigned b_row(const Unit& u, int r) const { return (unsigned)((u.aux & 255) * 1024 + u.pn * 256 + r) * 2048u; }
    __device__ __forceinline__ void epi(const pg8::Acc& acc, const Unit& u, int wr, int wc, int fr, int fq) const {
        const int e = u.aux & 255, mt = u.aux >> 8, cn = T.CN[e];
        f32x4 bv[2][2];
#pragma unroll
        for (int bj = 0; bj < 2; ++bj) { const float* bp = bdn + (size_t)e * 1024 + u.pn * 256 + TCOLP(bj, wc, fq); bv[bj][0] = *(const f32x4*)bp; bv[bj][1] = *(const f32x4*)(bp + 4); }
#pragma unroll
        for (int ai = 0; ai < 2; ++ai)
#pragma unroll
            for (int m = 0; m < 4; ++m) { const int rr = TROW(ai, wr, m, fr), idx = mt * 256 + rr; const size_t slot = (size_t)u.pm * 256 + rr;
                const float w = sw[(size_t)e * CAP + (idx < cn ? idx : 0)];
#pragma unroll
                for (int bj = 0; bj < 2; ++bj) { const int col = u.pn * 256 + TCOLP(bj, wc, fq);
                    *(v4u*)(Y + slot * 1024 + col) = pack8((acc[ai][bj][m][0] + bv[bj][0]) * w, (acc[ai][bj][m][1] + bv[bj][1]) * w); } }
    }
};

namespace att {
__device__ __forceinline__ int crow(int r, int hi) { return (r & 3) + 8 * (r >> 2) + 4 * hi; }
__device__ __forceinline__ float max3f(float a, float b, float c) { return fmaxf(fmaxf(a, b), c); }
typedef LAS const char* lds_cptr;
constexpr int LK = 0, LV = 49152, LWS = 90112, LOST = 92160, LBYTES = 124928;
constexpr int PD = 3;
struct Tens { const bf16* Q; int qpitch; const bf16* K; int kpitch; const bf16* V; int vpitch; bf16* O; };
#define ATT_WAITV(n) asm volatile("s_waitcnt vmcnt(" #n ")" ::: "memory")
struct Pend { f32x16 o0, o1; float l; int qrow0, oc0; bool valid; };
__device__ __forceinline__ void finish_unit(const Pend& P, bf16* O, LAS unsigned char* lds, int wid, int lane) {
    const int r32 = lane & 31, hi = lane >> 5;
    LAS float* wsf = (LAS float*)(lds + LWS) + wid * 64;
    float lrun = P.l;
    { auto rr = __builtin_amdgcn_permlane32_swap(__float_as_uint(lrun), __float_as_uint(lrun), false, false); lrun = __uint_as_float(rr[0]) + __uint_as_float(rr[1]); }
    if (hi == 0) wsf[32 + r32] = lrun;
    LDS_WAIT();
    LAS bf16* stg = (LAS bf16*)(lds + LOST) + wid * 2048;
#pragma unroll
    for (int r = 0; r < 16; ++r) { const int orow = crow(r, hi); const float rl = __builtin_amdgcn_rcpf(wsf[32 + orow]);
        stg[orow * 64 + r32] = (bf16)(pk2(P.o0[r] * rl, 0.f) & 0xffffu); stg[orow * 64 + 32 + r32] = (bf16)(pk2(P.o1[r] * rl, 0.f) & 0xffffu); }
    LDS_WAIT();
    bf16* Ow = O + (size_t)(P.qrow0 + wid * 32) * 1024 + P.oc0;
#pragma unroll
    for (int i = 0; i < 4; ++i) { const int row = i * 8 + (lane >> 3), ch = lane & 7; const v4u v = *(const LAS v4u*)(stg + row * 64 + ch * 8); *(v4u*)(Ow + (size_t)row * 1024 + ch * 8) = v; }
    LDS_WAIT();
}
template <int DK>
__device__ __forceinline__ void unit(const Tens& T, int qrow0, int qc0, int kc0, int vc0, int oc0, int kctx0, int klat0, int NTL, LAS unsigned char* lds, int wave_id, Pend& pend) {
    constexpr int ND = DK / 16;
    wave_id = launder_s(wave_id); const int tid = lthread_w(wave_id), lane = tid & 63, r32 = lane & 31, hi = lane >> 5; const int wid = wave_id;
    LAS float* wsf = (LAS float*)(lds + LWS) + wid * 64;
    const bf16* ksrc = T.K + (size_t)lane * T.kpitch + kc0 + wid * 8;
    const bf16* ksrc2 = T.K + (size_t)lane * T.kpitch + kc0 + (8 + (wid & 3)) * 8;
    const bf16* vsrc = T.V + (size_t)(16 * (wid & 3) + (lane >> 2)) * T.vpitch + vc0 + (wid >> 2) * 32 + (lane & 3) * 8;
#define ATT_DMA(t, ks_, vs_) do { const size_t row0_ = (size_t)((t) < 4 ? kctx0 + 64 * (t) : klat0 + 64 * ((t) - 4)); \
        __builtin_amdgcn_global_load_lds((const unsigned*)(ksrc + row0_ * T.kpitch), (LAS unsigned*)(lds + LK + (ks_) * 12288 + wid * 1024), 16, 0, 0); \
        if (DK > 64) __builtin_amdgcn_global_load_lds((const unsigned*)(ksrc2 + row0_ * T.kpitch), (LAS unsigned*)(lds + LK + (ks_) * 12288 + 8192 + (wid & 3) * 1024), 16, 0, 0); \
        __builtin_amdgcn_global_load_lds((const unsigned*)(vsrc + row0_ * T.vpitch), (LAS unsigned*)(lds + LV + (vs_) * 8192 + wid * 1024), 16, 0, 0); } while (0)
#define ATT_WAIT_TILES(n_tiles) do { if (DK > 64) { if ((n_tiles) >= 2) ATT_WAITV(6); else if ((n_tiles) == 1) ATT_WAITV(3); else ATT_WAITV(0); } \
        else { if ((n_tiles) >= 2) ATT_WAITV(4); else if ((n_tiles) == 1) ATT_WAITV(2); else ATT_WAITV(0); } } while (0)
    bf16x8 qr[ND];
    { const bf16* qp = T.Q + (size_t)(qrow0 + wid * 32 + r32) * T.qpitch + qc0 + hi * 8;
#pragma unroll
      for (int d0 = 0; d0 < ND; ++d0) qr[d0] = *(const bf16x8*)(qp + d0 * 16); }
    asm volatile("" ::: "memory");
    constexpr float THR = 8.f;
    const int half = wid >> 2;
    float mhat = 0.f, lrun = 0.f; f32x16 o[2]; o[0] = f32x16{}; o[1] = f32x16{}; f32x16 negm = f32x16{};
    f32x16 p0 = f32x16{}, p1 = f32x16{}; v4u pw[4]; pw[0] = pw[1] = pw[2] = pw[3] = (v4u){0u, 0u, 0u, 0u};
    ATT_DMA(0, 0, 0); ATT_DMA(1, 1, 1); ATT_DMA(2, 2, 2);
    if (pend.valid) finish_unit(pend, T.O, lds, wid, lane);
    ATT_WAIT_TILES(2);
    __builtin_amdgcn_s_barrier(); asm volatile("" ::: "memory");
    if (half == 1) __builtin_amdgcn_s_barrier();
    int vs_prev = 0, vs_cur = 0, vs_iss = 3;
    for (int t = 0; t <= NTL; ++t) {
        {
            s16x4 lo[2][4], hh[2][4]; bf16x8 kf[2 * ND];
            if (t >= 1) {
                const unsigned vb = (unsigned)(uintptr_t)(lds + LV + vs_prev * 8192) + ((lane >> 4) & 1) * 32 + (lane & 3) * 8 + (4 * hi + ((lane & 15) >> 2)) * 64;
#pragma unroll
                for (int d0 = 0; d0 < 2; ++d0)
#pragma unroll
                    for (int ks = 0; ks < 4; ++ks) {
                        asm volatile("ds_read_b64_tr_b16 %0,%1 offset:%c2" : "=&v"(lo[d0][ks]) : "v"(vb), "i"(d0 * 4096 + ks * 1024) : "memory");
                        asm volatile("ds_read_b64_tr_b16 %0,%1 offset:%c2" : "=&v"(hh[d0][ks]) : "v"(vb), "i"(d0 * 4096 + ks * 1024 + 512) : "memory"); }
            }
            if (t < NTL) {
                const lds_cptr kb = (lds_cptr)(lds + LK + (t & 3) * 12288) + hi * 1024 + r32 * 16;
#pragma unroll
                for (int d0 = 0; d0 < ND; ++d0) { kf[2 * d0] = *(const LAS bf16x8*)(kb + d0 * 2048); kf[2 * d0 + 1] = *(const LAS bf16x8*)(kb + d0 * 2048 + 512); }
            }
            asm volatile("s_waitcnt lgkmcnt(0)" ::: "memory"); __builtin_amdgcn_sched_barrier(0);
            if (t >= 1) {
#pragma unroll
                for (int ks = 0; ks < 4; ++ks)
#pragma unroll
                    for (int d0 = 0; d0 < 2; ++d0) { const bf16x8 vf = (bf16x8){lo[d0][ks][0], lo[d0][ks][1], lo[d0][ks][2], lo[d0][ks][3], hh[d0][ks][0], hh[d0][ks][1], hh[d0][ks][2], hh[d0][ks][3]};
                        o[d0] = __builtin_amdgcn_mfma_f32_32x32x16_bf16(__builtin_bit_cast(bf16x8, pw[ks]), vf, o[d0], 0, 0, 0); }
            }
            if (t < NTL) {
#pragma unroll
                for (int d0 = 0; d0 < ND; ++d0) {
                    if (d0 == 0) { p0 = __builtin_amdgcn_mfma_f32_32x32x16_bf16(kf[0], qr[0], negm, 0, 0, 0); p1 = __builtin_amdgcn_mfma_f32_32x32x16_bf16(kf[1], qr[0], negm, 0, 0, 0); }
                    else { p0 = __builtin_amdgcn_mfma_f32_32x32x16_bf16(kf[2 * d0], qr[d0], p0, 0, 0, 0); p1 = __builtin_amdgcn_mfma_f32_32x32x16_bf16(kf[2 * d0 + 1], qr[d0], p1, 0, 0, 0); } }
            }
        }
        if (half == 1) {
            const int last_iss = (t + PD - 1 < NTL - 1) ? t + PD - 1 : NTL - 1; const int allow = last_iss - (t + 1);
            if (allow >= 1) ATT_WAIT_TILES(1); else ATT_WAIT_TILES(0); }
        asm volatile("s_waitcnt lgkmcnt(0)" ::: "memory"); __builtin_amdgcn_s_barrier(); asm volatile("" ::: "memory");
        if (t < NTL) {
            float rm = max3f(p0[0], p0[1], p1[0]);
#pragma unroll
            for (int r = 0; r < 16; ++r) rm = max3f(rm, p0[r], p1[r]);
            { auto rr = __builtin_amdgcn_permlane32_swap(__float_as_uint(rm), __float_as_uint(rm), false, false); rm = fmaxf(__uint_as_float(rr[0]), __uint_as_float(rr[1])); }
            if (t == 0 || __any(rm > THR)) {
                const float dl = (t == 0) ? rm : fmaxf(rm, 0.f);
                mhat += dl;
#pragma unroll
                for (int r = 0; r < 16; ++r) { p0[r] -= dl; p1[r] -= dl; negm[r] = -mhat; }
                const float f = (t == 0) ? 1.f : __builtin_amdgcn_exp2f(-dl); lrun *= f;
                if (hi == 0) wsf[r32] = f;
                LDS_WAIT();
#pragma unroll
                for (int r = 0; r < 16; ++r) { const float a = wsf[crow(r, hi)]; o[0][r] *= a; o[1][r] *= a; }
            }
            float rs = 0.f;
#pragma unroll
            for (int r = 0; r < 16; ++r) { p0[r] = __builtin_amdgcn_exp2f(p0[r]); p1[r] = __builtin_amdgcn_exp2f(p1[r]); rs += p0[r] + p1[r]; }
            lrun += rs;
            pw[0] = (v4u){pk2(p0[0], p0[1]), pk2(p0[2], p0[3]), pk2(p0[4], p0[5]), pk2(p0[6], p0[7])};
            pw[1] = (v4u){pk2(p0[8], p0[9]), pk2(p0[10], p0[11]), pk2(p0[12], p0[13]), pk2(p0[14], p0[15])};
            pw[2] = (v4u){pk2(p1[0], p1[1]), pk2(p1[2], p1[3]), pk2(p1[4], p1[5]), pk2(p1[6], p1[7])};
            pw[3] = (v4u){pk2(p1[8], p1[9]), pk2(p1[10], p1[11]), pk2(p1[12], p1[13]), pk2(p1[14], p1[15])};
        }
        if (t + PD < NTL) { ATT_DMA(t + PD, (t + PD) & 3, vs_iss); vs_iss = (vs_iss == 4) ? 0 : vs_iss + 1; }
        if (half == 0) {
            const int last_iss = (t + PD < NTL - 1) ? t + PD : NTL - 1; const int allow = last_iss - (t + 1);
            if (allow >= 2) ATT_WAIT_TILES(2); else if (allow == 1) ATT_WAIT_TILES(1); else ATT_WAIT_TILES(0); }
        vs_prev = vs_cur; vs_cur = (vs_cur == 4) ? 0 : vs_cur + 1;
        asm volatile("s_waitcnt lgkmcnt(0)" ::: "memory"); __builtin_amdgcn_s_barrier(); asm volatile("" ::: "memory");
    }
    if (half == 0) __builtin_amdgcn_s_barrier();
#undef ATT_DMA
#undef ATT_WAIT_TILES
    pend.o0 = o[0]; pend.o1 = o[1]; pend.l = lrun; pend.qrow0 = qrow0; pend.oc0 = oc0; pend.valid = true;
}
#undef ATT_WAITV
}

struct Args { const float* in[27]; float* out; unsigned char* ws; int ph_lo, ph_hi; };
struct Frame {
    LAS unsigned char* lds; unsigned char* ws; gu32* ctl; int wave, G, gw, NGW;
};
__device__ __forceinline__ int lthread(int wave) { return wave * 64 + lane_id_v(); }

template <int MODE>
__device__ __forceinline__ void conv_item(const float* W, int K, int N, bf16* WT, LAS float* scr, int item, int lane) {
    const int nblk = (N + 63) / 64, kb = item / nblk, nb = item % nblk, k0 = 64 * kb, n0 = 64 * nb;
    f32x4 v[16];
    const int cc = (lane & 15) * 4, rk = lane >> 4;
    const bool ok = (n0 + cc) < N;
#pragma unroll
    for (int i = 0; i < 16; ++i) v[i] = ok ? *(const f32x4*)(W + (size_t)(k0 + 4 * i + rk) * N + n0 + cc) : (f32x4){0.f, 0.f, 0.f, 0.f};
#pragma unroll
    for (int i = 0; i < 16; ++i) { LAS float* s = scr + (4 * i + rk) * 65 + cc; s[0] = v[i][0]; s[1] = v[i][1]; s[2] = v[i][2]; s[3] = v[i][3]; }
    LDS_WAIT(); asm volatile("" ::: "memory");
    const int c = lane & 7;
#pragma unroll
    for (int j = 0; j < 8; ++j) { const int n = (lane >> 3) + 8 * j; const LAS float* s = scr + (8 * c) * 65 + n;
        v4u o; o.x = pk2(s[0], s[65]); o.y = pk2(s[2 * 65], s[3 * 65]); o.z = pk2(s[4 * 65], s[5 * 65]); o.w = pk2(s[6 * 65], s[7 * 65]);
        const int ng = n0 + n; if (ng < N) { const int dr = (MODE == 1) ? ((ng >> 8) * 256 + (ng & 1) * 128 + ((ng >> 1) & 127)) : ng; *(v4u*)(WT + (size_t)dr * K + k0 + 8 * c) = o; } }
    LDS_WAIT(); asm volatile("" ::: "memory");
}

__device__ __forceinline__ void prologue(Frame& F, const Args& a) {
    const int f_tid = lthread(F.wave), f_lane = f_tid & 63;
    unsigned char* ws = F.ws;
    {
        LAS float* scr = (LAS float*)(F.lds + F.wave * 16640);
        struct M { const float* src; int K, N; size_t dst; };
        const int I_FO = 16 * 16, I_MIN = 16 * 11, I_QB = 6 * 24, I_KVB = 4 * 32, I_MO = 256, I_GQKV = 16 * 24, I_GO = 256;
        const int NSMALL = 2 * I_FO + I_MIN + I_QB + I_KVB + I_MO + I_GQKV + I_GO;
        for (int it = F.gw; it < NSMALL; it += F.NGW) {
            int r = it;
            if (r < 2 * I_FO) { const int j = r / I_FO; conv_item<0>(a.in[10] + (size_t)j * D * D, D, D, (bf16*)(ws + WS_WFOUT) + (size_t)j * D * D, scr, r % I_FO, f_lane); continue; } r -= 2 * I_FO;
            if (r < I_MIN) { conv_item<0>(a.in[11], D, MLA_IN, (bf16*)(ws + WS_WMIN), scr, r, f_lane); continue; } r -= I_MIN;
            if (r < I_QB) { conv_item<0>(a.in[13], MLA_QL, 1536, (bf16*)(ws + WS_WMQB), scr, r, f_lane); continue; } r -= I_QB;
            if (r < I_KVB) { conv_item<0>(a.in[15], MLA_KVL, 2048, (bf16*)(ws + WS_WMKVB), scr, r, f_lane); continue; } r -= I_KVB;
            if (r < I_MO) { conv_item<0>(a.in[16], D, D, (bf16*)(ws + WS_WMO), scr, r, f_lane); continue; } r -= I_MO;
            if (r < I_GQKV) { conv_item<0>(a.in[17], D, GQA_QKV, (bf16*)(ws + WS_WGQKV), scr, r, f_lane); continue; } r -= I_GQKV;
            conv_item<0>(a.in[20], D, D, (bf16*)(ws + WS_WGO), scr, r, f_lane);
        }
        const int I_DN = 16 * 16, NMOE = DEPTH * NE * I_DN;
        for (int it = F.gw; it < NMOE; it += F.NGW) { const int le = it / I_DN, r = it % I_DN;
            conv_item<0>(a.in[25] + (size_t)le * DFF * D, DFF, D, (bf16*)(ws + WS_WDN) + (size_t)le * D * DFF, scr, r, f_lane); }
    }
    __syncthreads();
    {
        LAS float* cmax = (LAS float*)F.lds;
        LAS float* cinv = cmax + 512;
        LAS unsigned* scr8 = (LAS unsigned*)(F.lds + 4096) + F.wave * (64 * 33);
        const int cc = (f_lane & 15) * 4, rk = f_lane >> 4;
        for (int it = blockIdx.x; it < DEPTH * NE * 32; it += F.G) { const int le = it >> 5, strip = it & 31;
            const float* W = a.in[23] + (size_t)le * D * 2048 + strip * 64 + cc;
            f32x4 v[32];
#pragma unroll
            for (int i = 0; i < 32; ++i) v[i] = *(const f32x4*)(W + (size_t)(F.wave * 128 + 16 * (i >> 2) + 4 * rk + (i & 3)) * 2048);
            f32x4 mx = (f32x4){0.f, 0.f, 0.f, 0.f};
#pragma unroll
            for (int i = 0; i < 32; ++i) { mx[0] = fmaxf(mx[0], fabsf(v[i][0])); mx[1] = fmaxf(mx[1], fabsf(v[i][1])); mx[2] = fmaxf(mx[2], fabsf(v[i][2])); mx[3] = fmaxf(mx[3], fabsf(v[i][3])); }
#pragma unroll
            for (int q = 0; q < 4; ++q) { mx[q] = fmaxf(mx[q], __shfl_xor(mx[q], 16)); mx[q] = fmaxf(mx[q], __shfl_xor(mx[q], 32)); }
            __syncthreads();
            if (rk == 0) { LAS float* d = cmax + F.wave * 64 + cc; d[0] = mx[0]; d[1] = mx[1]; d[2] = mx[2]; d[3] = mx[3]; }
            __syncthreads();
            if (f_tid < 64) { float m8 = 0.f;
#pragma unroll
                for (int w = 0; w < 8; ++w) m8 = fmaxf(m8, cmax[w * 64 + f_tid]);
                const int ng = strip * 64 + f_tid, dr = (ng >> 8) * 256 + (ng & 1) * 128 + ((ng >> 1) & 127);
                ((float*)(ws + WS_SWGU))[(size_t)le * 2048 + dr] = (m8 > 0.f) ? m8 * (1.f / 127.f) : 1.f;
                cinv[f_tid] = (m8 > 0.f) ? 127.f / m8 : 0.f; }
            __syncthreads();
            const f32x4 iv = *(const LAS f32x4*)(cinv + cc);
#pragma unroll
            for (int ip = 0; ip < 8; ++ip) {
#pragma unroll
                for (int q = 0; q < 4; ++q) { unsigned w = 0;
#pragma unroll
                    for (int j = 0; j < 4; ++j) { int qi = __float2int_rn(v[4 * ip + j][q] * iv[q]); qi = qi > 127 ? 127 : (qi < -127 ? -127 : qi); w |= ((unsigned)qi & 255u) << (8 * j); }
                    scr8[(cc + q) * 33 + 4 * ip + rk] = w; } }
            LDS_WAIT(); asm volatile("" ::: "memory");
            { const int c8 = f_lane & 7;
#pragma unroll
              for (int jp = 0; jp < 8; ++jp) { const int n = (f_lane >> 3) + 8 * jp; const LAS unsigned* sp = scr8 + n * 33 + 4 * c8;
                  v4u o; o.x = sp[0]; o.y = sp[1]; o.z = sp[2]; o[3] = sp[3];
                  const int ng = strip * 64 + n, dr = (ng >> 8) * 256 + (ng & 1) * 128 + ((ng >> 1) & 127);
                  *(v4u*)((unsigned char*)(ws + WS_WGU) + ((size_t)le * 2048 + dr) * 1024 + F.wave * 128 + 16 * c8) = o; } }
            LDS_WAIT(); asm volatile("" ::: "memory");
        }
        __syncthreads();
    }
    const int gtid = blockIdx.x * 512 + f_tid, gthreads = F.G * 512;
    for (int i = gtid; i < (MLA_IN_PAD - MLA_IN) * D / 8; i += gthreads) ((v4u*)((bf16*)(ws + WS_WMIN) + (size_t)MLA_IN * D))[i] = (v4u){0u, 0u, 0u, 0u};
    {
        bf16* MA = (bf16*)(ws + WS_MA);
        for (int i = gtid; i < 256 * 256; i += gthreads) { const int row = i >> 8, col = i & 255, jp = row >> 7, pp = (row >> 6) & 1, k1 = row & 63, j = col >> 7, pt = (col >> 6) & 1, l1 = col & 63;
            float v = 0.f; if (j == jp) { const float x = 2.f * (float)((k1 * l1) & 63) / 64.f; const float cs = cospif(x), sn = sinpif(x); v = (pp == 0) ? (pt == 0 ? cs : sn) : (pt == 0 ? -sn : cs); }
            MA[i] = (bf16)(pk2(v, 0.f) & 0xffffu); }
        bf16* DC = (bf16*)(ws + WS_DC); const float sc = 1.0f / sqrtf(256.f * 128.f);
        for (int i = gtid; i < 256 * 512; i += gthreads) { const int k = i >> 9, col = i & 511, pt = col >> 8, l = col & 255; const float x = 2.f * (float)((k * l) & 255) / 256.f;
            const float v = (pt == 0 ? cospif(x) : sinpif(x)) * sc; DC[i] = (bf16)(pk2(v, 0.f) & 0xffffu); }
        bf16* MC = (bf16*)(ws + WS_MC); const float sl = 1.0f / sqrtf(4096.f * 128.f);
        for (int i = gtid; i < 16 * 256 * 512; i += gthreads) { const int kq = i >> 17, row = (i >> 9) & 255, col = i & 511, kkp = row >> 6, k2 = row & 63, kk = col >> 7, pp = (col >> 6) & 1, l2 = col & 63;
            float v = 0.f; if (kk == kkp) { const int k = 4 * kq + kkp + 64 * k2; const float x = 2.f * (float)((l2 * k) & 4095) / 4096.f; v = (pp == 0 ? cospif(x) : sinpif(x)) * sl; }
            MC[i] = (bf16)(pk2(v, 0.f) & 0xffffu); }
        float* RM = (float*)(ws + WS_ROPE); float* RG = RM + 2048;
        for (int i = gtid; i < 64 * 8; i += gthreads) { const int pos = i >> 3, f = i & 7; const float inv = powf(10000.f, -(float)f / 8.f); float s, c; sincosf((float)pos * inv, &s, &c); RM[2 * i] = c; RM[2 * i + 1] = s; }
        for (int i = gtid; i < 64 * 16; i += gthreads) { const int pos = i >> 4, f = i & 15; const float inv = powf(10000.f, -(float)f / 16.f); float s, c; sincosf((float)pos * inv, &s, &c); RG[2 * i] = c; RG[2 * i + 1] = s; }
        float* WRT = (float*)(ws + WS_WRT);
        for (int i = gtid; i < DEPTH * NE * D; i += gthreads) { const int l = i >> 15, e = (i >> 10) & 31, k = i & 1023; WRT[i] = a.in[21][((size_t)l * D + k) * NE + e]; }
        float* BG = (float*)(ws + WS_BGU);
        for (int i = gtid; i < DEPTH * NE * 2048; i += gthreads) { const int le = i >> 11, q = i & 2047, pn = q >> 8, s = (q >> 7) & 1, jj = q & 127; BG[i] = a.in[24][(size_t)le * 2048 + 2 * (pn * 128 + jj) + s]; }
    }
    __syncthreads();
    {
        LAS float* wl = (LAS float*)F.lds;
        LAS float* tc = wl + 2048; LAS float* ts = tc + 128;
        if (f_tid < 128) { const float x = 2.f * (float)f_tid / 128.f; tc[f_tid] = cospif(x); ts[f_tid] = -sinpif(x); }
        for (int it = blockIdx.x; it < 2 * 8 * 64; it += F.G) { const int j = it >> 9, g = (it >> 6) & 7, kb = it & 63;
            __syncthreads();
            { const int kk = f_tid >> 5, c4 = (f_tid & 31) * 4; const f32x4 w = *(const f32x4*)(a.in[9] + ((size_t)j * D + kb * 16 + kk) * D + g * 128 + c4);
              LAS float* d = wl + c4 * 16 + kk; d[0] = w[0]; d[16] = w[1]; d[32] = w[2]; d[48] = w[3]; }
            __syncthreads();
            const int cl = f_tid & 255, m = cl >> 1, part = cl & 1, kh = f_tid >> 8; const LAS float* tw = part ? ts : tc;
            float accv[8];
#pragma unroll
            for (int q = 0; q < 8; ++q) accv[q] = 0.f;
            for (int jj = 0; jj < 128; ++jj) { const float t = tw[(m * jj) & 127]; const f32x4 wa = *(const LAS f32x4*)(wl + jj * 16 + kh * 8), wb = *(const LAS f32x4*)(wl + jj * 16 + kh * 8 + 4);
                accv[0] += wa[0] * t; accv[1] += wa[1] * t; accv[2] += wa[2] * t; accv[3] += wa[3] * t; accv[4] += wb[0] * t; accv[5] += wb[1] * t; accv[6] += wb[2] * t; accv[7] += wb[3] * t; }
            v4u o; o.x = pk2(accv[0], accv[1]); o.y = pk2(accv[2], accv[3]); o.z = pk2(accv[4], accv[5]); o.w = pk2(accv[6], accv[7]);
            *(v4u*)((bf16*)(ws + WS_WFIN) + ((size_t)j * 2048 + g * 256 + cl) * D + kb * 16 + kh * 8) = o;
        }
        __syncthreads();
    }
    {
        LAS float* S = (LAS float*)F.lds;
        LAS float* red = S + 9 * 1024;
        for (int i = f_tid; i < 9 * 1024; i += 512) { const int r = i >> 10, k = i & 1023; const float v = (r < 8) ? a.in[1][r * D + k] : a.in[3][k]; S[i] = v / (1.f + __expf(-v)); }
        __syncthreads();
        for (int it = blockIdx.x; it < DEPTH * 96; it += F.G) { const int l = it / 96, n0 = (it % 96) * 64;
            const float* wp = a.in[4] + ((size_t)l * D + F.wave * 128) * (NMOD * D) + n0 + f_lane;
            float accv[9];
#pragma unroll
            for (int r = 0; r < 9; ++r) accv[r] = 0.f;
            for (int k0 = 0; k0 < 128; k0 += 32) { float wv[32];
#pragma unroll
                for (int k = 0; k < 32; ++k) wv[k] = wp[(size_t)(k0 + k) * (NMOD * D)];
#pragma unroll
                for (int k = 0; k < 32; ++k)
#pragma unroll
                    for (int r = 0; r < 9; ++r) accv[r] += S[r * 1024 + F.wave * 128 + k0 + k] * wv[k]; }
#pragma unroll
            for (int r = 0; r < 9; ++r) red[(F.wave * 9 + r) * 64 + f_lane] = accv[r];
            __syncthreads();
            for (int i = f_tid; i < 9 * 64; i += 512) { const int r = i >> 6, ln = i & 63; float s = a.in[5][(size_t)l * (NMOD * D) + n0 + ln];
#pragma unroll
                for (int w = 0; w < 8; ++w) s += red[(w * 9 + r) * 64 + ln];
                ((float*)(ws + WS_MOD))[((size_t)l * 9 + r) * (NMOD * D) + n0 + ln] = s; }
            __syncthreads();
        }
    }
}

__device__ __forceinline__ void load_row(const float* p, int lane, f32x4 (&v)[4]) {
#pragma unroll
    for (int j = 0; j < 4; ++j) v[j] = ((const f32x4*)p)[lane + 64 * j];
}
__device__ __forceinline__ void load_row_bf(const bf16* p, int lane, f32x4 (&v)[4]) {
#pragma unroll
    for (int j = 0; j < 4; ++j) { const v2u w = ((const v2u*)p)[lane + 64 * j]; v[j] = (f32x4){bf_lo(w.x), bf_hi(w.x), bf_lo(w.y), bf_hi(w.y)}; }
}
__device__ __forceinline__ void norm_mod(f32x4 (&v)[4], const float* g, const float* shift, const float* scale, int lane) {
    float s = 0.f;
#pragma unroll
    for (int j = 0; j < 4; ++j) s += (v[j][0] * v[j][0] + v[j][1] * v[j][1]) + (v[j][2] * v[j][2] + v[j][3] * v[j][3]);
    const float rstd = rsqrtf(wave_sum(s) * (1.f / D) + EPS);
#pragma unroll
    for (int j = 0; j < 4; ++j) { const f32x4 gv = ((const f32x4*)g)[lane + 64 * j], sh = ((const f32x4*)shift)[lane + 64 * j], sc = ((const f32x4*)scale)[lane + 64 * j];
        v[j] = (v[j] * rstd * gv) * (sc + 1.f) + sh; }
}
__device__ __forceinline__ void store_row_bf16(bf16* p, int lane, const f32x4 (&v)[4]) {
#pragma unroll
    for (int j = 0; j < 4; ++j) { v2u w; w.x = pk2(v[j][0], v[j][1]); w.y = pk2(v[j][2], v[j][3]); ((v2u*)p)[lane + 64 * j] = w; }
}

__device__ __forceinline__ void rp_norm1(Frame& F, const Args& a, int l, int row_lo) {
    const int f_tid = lthread(F.wave), f_lane = f_tid & 63;
    const bf16* X = (const bf16*)(F.ws + WS_X); bf16* H = (bf16*)(F.ws + WS_H); const float* MOD = (const float*)(F.ws + WS_MOD) + (size_t)l * 9 * (NMOD * D);
    for (int row = row_lo + F.gw; row < NT; row += F.NGW) { f32x4 v[4];
        if (l == 0) load_row(row < NC ? a.in[2] + (size_t)row * D : a.in[0] + (size_t)(row - NC) * D, f_lane, v);
        else load_row_bf(X + (size_t)row * D, f_lane, v);
        const float* m = MOD + (size_t)modrow_of(row) * (NMOD * D);
        norm_mod(v, a.in[6] + (size_t)l * D, m, m + D, f_lane); store_row_bf16(H + (size_t)row * D, f_lane, v); }
}

#if MK_N2V2
constexpr int LDS_LIST = LDS_MISC + 768;
__device__ __forceinline__ unsigned row16_max(unsigned k) {
    unsigned t;
    t = (unsigned)__builtin_amdgcn_mov_dpp((int)k, 0xb1, 0xf, 0xf, false); k = k > t ? k : t;
    t = (unsigned)__builtin_amdgcn_mov_dpp((int)k, 0x4e, 0xf, 0xf, false); k = k > t ? k : t;
    t = (unsigned)__builtin_amdgcn_mov_dpp((int)k, 0x124, 0xf, 0xf, false); k = k > t ? k : t;
    t = (unsigned)__builtin_amdgcn_mov_dpp((int)k, 0x128, 0xf, 0xf, false); k = k > t ? k : t;
    return k;
}
__device__ __forceinline__ unsigned wave_max_u(unsigned k) {
    k = row16_max(k);
    const unsigned a = (unsigned)__builtin_amdgcn_readlane((int)k, 0), b = (unsigned)__builtin_amdgcn_readlane((int)k, 16), c = (unsigned)__builtin_amdgcn_readlane((int)k, 32), d = (unsigned)__builtin_amdgcn_readlane((int)k, 48);
    const unsigned ab = a > b ? a : b, cd = c > d ? c : d; return ab > cd ? ab : cd;
}
__device__ __forceinline__ float key_val(unsigned m) { const unsigned u = m & ~31u; return __builtin_bit_cast(float, (u & 0x80000000u) ? (u ^ 0x80000000u) : ~u); }
__device__ __forceinline__ void rp_norm2_router(Frame& F, const Args& a, int l, int row_lo) {
    const int f_tid = lthread(F.wave), f_lane = f_tid & 63;
    const bf16* X = (const bf16*)(F.ws + WS_X); bf16* H = (bf16*)(F.ws + WS_H); const float* MOD = (const float*)(F.ws + WS_MOD) + (size_t)l * 9 * (NMOD * D);
    LAS float* wt = (LAS float*)F.lds;
    { const f32x4* src = (const f32x4*)((const float*)(F.ws + WS_WRT) + (size_t)l * NE * D); f32x4 tv[16];
#pragma unroll
      for (int i = 0; i < 16; ++i) tv[i] = src[f_tid + 512 * i];
#pragma unroll
      for (int i = 0; i < 16; ++i) ((LAS f32x4*)wt)[f_tid + 512 * i] = tv[i]; }
    LAS int* lcnt = (LAS int*)(F.lds + LDS_TT); LAS int* lbase = lcnt + 32;
    LAS v4u* list = (LAS v4u*)(F.lds + LDS_LIST) + F.wave * 68;
    LAS float* lsc = (LAS float*)(F.lds + LDS_LIST + 8 * 68 * 16) + F.wave * 68;
    if (f_tid < 32) lcnt[f_tid] = 0;
    __syncthreads();
    const float* gf = a.in[7] + (size_t)l * D;
    f32x4 gv[4];
#pragma unroll
    for (int j = 0; j < 4; ++j) gv[j] = ((const f32x4*)gf)[f_lane + 64 * j];
    const int my_e = f_lane >> 1;
    const float my_b = a.in[22][(size_t)l * NE + my_e];
    int row = row_lo + F.gw, it = 0;
    f32x4 vn[4];
    if (row < NT) load_row_bf(X + (size_t)row * D, f_lane, vn);
    for (; row < NT; row += F.NGW, ++it) {
        f32x4 v[4], sh[4], sc[4];
        const float* m = MOD + (size_t)modrow_of(row) * (NMOD * D);
#pragma unroll
        for (int j = 0; j < 4; ++j) { sh[j] = ((const f32x4*)(m + 3 * D))[f_lane + 64 * j]; sc[j] = ((const f32x4*)(m + 4 * D))[f_lane + 64 * j]; }
        asm volatile("" ::: "memory");
#pragma unroll
        for (int j = 0; j < 4; ++j) v[j] = vn[j];
        { const int nrow = row + F.NGW; if (nrow < NT) load_row_bf(X + (size_t)nrow * D, f_lane, vn); }
        float ssq = 0.f;
#pragma unroll
        for (int j = 0; j < 4; ++j) ssq += (v[j][0] * v[j][0] + v[j][1] * v[j][1]) + (v[j][2] * v[j][2] + v[j][3] * v[j][3]);
        const float rstd = rsqrtf(wave_sum(ssq) * (1.f / D) + EPS);
#pragma unroll
        for (int j = 0; j < 4; ++j) v[j] = (v[j] * rstd * gv[j]) * (sc[j] + 1.f) + sh[j];
        float am = 0.f;
#pragma unroll
        for (int j = 0; j < 4; ++j) am = fmaxf(fmaxf(am, fmaxf(fabsf(v[j][0]), fabsf(v[j][1]))), fmaxf(fabsf(v[j][2]), fabsf(v[j][3])));
        const float amax = __uint_as_float(wave_max_u(__float_as_uint(am)));
        const float qscale = amax > 0.f ? amax * (1.f / 127.f) : 1.f, qinv = amax > 0.f ? 127.f / amax : 0.f;
#pragma unroll
        for (int j = 0; j < 4; ++j) { unsigned w = 0;
#pragma unroll
            for (int q = 0; q < 4; ++q) { int qi = __float2int_rn(v[j][q] * qinv); qi = qi > 127 ? 127 : (qi < -127 ? -127 : qi); w |= ((unsigned)qi & 255u) << (8 * q); }
            ((unsigned*)((unsigned char*)H + (size_t)row * D))[f_lane + 64 * j] = w; }
        float p[32];
#pragma unroll
        for (int e = 0; e < 32; ++e) { f32x2 s2 = (f32x2){0.f, 0.f};
#pragma unroll
            for (int j = 0; j < 4; ++j) { const f32x4 w = ((const LAS f32x4*)(wt + e * 1024))[f_lane + 64 * j];
                s2 = __builtin_elementwise_fma((f32x2){v[j][0], v[j][1]}, (f32x2){w[0], w[1]}, s2); s2 = __builtin_elementwise_fma((f32x2){v[j][2], v[j][3]}, (f32x2){w[2], w[3]}, s2); }
            p[e] = s2[0] + s2[1]; }
#pragma unroll
        for (int s = 0; s < 5; ++s) { const int half = 16 >> s, msk = 32 >> s; const bool up = (f_lane & msk) != 0;
#pragma unroll
            for (int i = 0; i < half; ++i) { const float keep = up ? p[i + half] : p[i], send = up ? p[i] : p[i + half]; p[i] = keep + __shfl_xor(send, msk); } }
        const float lgt = p[0] + __shfl_xor(p[0], 1) + my_b;
        unsigned key; { const unsigned u = __builtin_bit_cast(unsigned, lgt); const unsigned o = (u & 0x80000000u) ? ~u : (u | 0x80000000u); key = (o & ~31u) | (unsigned)(31 - my_e); }
        unsigned mk[4];
#pragma unroll
        for (int k = 0; k < 4; ++k) { mk[k] = wave_max_u(key); key = (key == mk[k]) ? 0u : key; }
        const float b0 = key_val(mk[0]);
        const float e1 = __expf(key_val(mk[1]) - b0), e2 = __expf(key_val(mk[2]) - b0), e3 = __expf(key_val(mk[3]) - b0); const float inv = 1.f / (1.f + e1 + e2 + e3);
        if (f_lane < 4) { const unsigned mm = f_lane == 0 ? mk[0] : f_lane == 1 ? mk[1] : f_lane == 2 ? mk[2] : mk[3]; const int me = 31 - (int)(mm & 31u);
            const float mw = (f_lane == 0 ? 1.f : f_lane == 1 ? e1 : f_lane == 2 ? e2 : e3) * inv;
            const int lr = __hip_atomic_fetch_add(lcnt + me, 1, __ATOMIC_RELAXED, __HIP_MEMORY_SCOPE_WORKGROUP);
            LAS unsigned* ep = (LAS unsigned*)(list + it * 4 + f_lane); ep[0] = (unsigned)(row * 4 + f_lane); ep[1] = (unsigned)me; ep[2] = (unsigned)lr; ep[3] = __builtin_bit_cast(unsigned, mw);
            lsc[it * 4 + f_lane] = qscale; }
    }
    __syncthreads();
    if (f_tid < 32) { const int c = lcnt[f_tid]; lbase[f_tid] = c ? (int)__hip_atomic_fetch_add((unsigned*)(F.ctl + CW_CNT + (l * 32 + f_tid) * 16), (unsigned)c, RLX_AGENT) : 0; }
    __syncthreads();
    int* te = (int*)(F.ws + WS_TE); int* trank = (int*)(F.ws + WS_TRANK); int* stok = (int*)(F.ws + WS_STOK); float* sw = (float*)(F.ws + WS_SW); float* ssc = (float*)(F.ws + WS_SSC);
    for (int i = f_lane; i < it * 4; i += 64) { const LAS unsigned* ep = (const LAS unsigned*)(list + i); const unsigned rowk = ep[0], ex = ep[1], lr = ep[2]; const float wv = __builtin_bit_cast(float, ep[3]);
        const int rk = lbase[ex] + (int)lr;
        stok[(size_t)ex * CAP + rk] = (int)(rowk >> 2); sw[(size_t)ex * CAP + rk] = wv; ssc[(size_t)ex * CAP + rk] = lsc[i]; te[rowk] = (int)ex; trank[rowk] = rk; }
}

#endif
__device__ __forceinline__ void moe_table(Frame& F, int l) {
    const int f_tid = lthread(F.wave), f_lane = f_tid & 63;
    LAS int* TT = (LAS int*)(F.lds + LDS_TT); LAS int* CN = TT + 64; LAS int* TE = (LAS int*)(F.lds + LDS_TE);
    __syncthreads();
    if (f_tid < 64) {
        const int c = (f_lane < 32) ? (int)__hip_atomic_load((unsigned*)(F.ctl + CW_CNT + (l * 32 + (f_lane & 31)) * 16), RLX_AGENT) : 0;
        const int tl = (c + 255) >> 8; int v = tl;
#pragma unroll
        for (int o = 1; o < 32; o <<= 1) { const int n = __shfl_up(v, o); if (f_lane >= o) v += n; }
        if (f_lane < 32) { CN[f_lane] = c; TT[f_lane] = v - tl; if (f_lane == 31) TT[32] = v; }
    }
    __syncthreads();
    for (int t = f_tid; t < MAXTILES; t += 512) { int lo = 0, hi = 32;
#pragma unroll
        for (int k = 0; k < 5; ++k) { const int mid = (lo + hi) >> 1; if (TT[mid] <= t) lo = mid; else hi = mid; }
        TE[t] = lo; }
    __syncthreads();
}

#if MK_CBV2
struct CombRow { v2u x[4]; v2u y[4][4]; };
__device__ __forceinline__ void comb_issue(CombRow& R, const bf16* X, const bf16* Y, const LAS int* TT, int row, const v4u te4, const v4u tr4, int lane) {
    const unsigned ee[4] = {te4[0], te4[1], te4[2], te4[3]}, rr[4] = {tr4[0], tr4[1], tr4[2], tr4[3]};
#pragma unroll
    for (int k = 0; k < 4; ++k) { const size_t slot = (size_t)TT[ee[k]] * 256 + rr[k]; const v2u* yp = (const v2u*)(Y + slot * 1024);
#pragma unroll
        for (int j = 0; j < 4; ++j) R.y[k][j] = yp[lane + 64 * j]; }
#pragma unroll
    for (int j = 0; j < 4; ++j) R.x[j] = ((const v2u*)(X + (size_t)row * D))[lane + 64 * j];
}
__device__ __forceinline__ void comb_finish(const CombRow& R, Frame& F, const Args& a, int l, int row, int lane, const float* MOD, const float* MODN, bool lastl) {
    bf16* X = (bf16*)(F.ws + WS_X); bf16* H = (bf16*)(F.ws + WS_H);
    const int mr = modrow_of(row); const float* g5 = MOD + (size_t)mr * (NMOD * D) + 5 * D;
    f32x4 v[4];
#pragma unroll
    for (int j = 0; j < 4; ++j) { f32x4 s = (f32x4){0.f, 0.f, 0.f, 0.f};
#pragma unroll
        for (int k = 0; k < 4; ++k) { const v2u w = R.y[k][j]; s[0] += bf_lo(w.x); s[1] += bf_hi(w.x); s[2] += bf_lo(w.y); s[3] += bf_hi(w.y); }
        const f32x4 gv = ((const f32x4*)g5)[lane + 64 * j]; const v2u xw = R.x[j]; v[j] = (f32x4){bf_lo(xw.x), bf_hi(xw.x), bf_lo(xw.y), bf_hi(xw.y)} + gv * s; }
    if (!lastl) {
        store_row_bf16(X + (size_t)row * D, lane, v);
        const float* m = MODN + (size_t)mr * (NMOD * D);
        norm_mod(v, a.in[6] + (size_t)(l + 1) * D, m, m + D, lane); store_row_bf16(H + (size_t)row * D, lane, v);
    } else {
        float ss = 0.f;
#pragma unroll
        for (int j = 0; j < 4; ++j) ss += (v[j][0] * v[j][0] + v[j][1] * v[j][1]) + (v[j][2] * v[j][2] + v[j][3] * v[j][3]);
        const float rstd = rsqrtf(wave_sum(ss) * (1.f / D) + EPS);
        float* op = a.out + (size_t)(row - NC) * D;
#pragma unroll
        for (int j = 0; j < 4; ++j) { const f32x4 gv = ((const f32x4*)a.in[8])[lane + 64 * j]; ((f32x4*)op)[lane + 64 * j] = v[j] * rstd * gv; }
    }
}
__device__ __forceinline__ void rp_combine(Frame& F, const Args& a, int l, int row_lo) {
    const int f_tid = lthread(F.wave), f_lane = f_tid & 63;
    const bf16* X = (const bf16*)(F.ws + WS_X); const bf16* Y = (const bf16*)(F.ws + WS_Y);
    const float* MOD = (const float*)(F.ws + WS_MOD) + (size_t)l * 9 * (NMOD * D); const float* MODN = MOD + 9 * (NMOD * D);
    const v4u* te = (const v4u*)(F.ws + WS_TE); const v4u* trank = (const v4u*)(F.ws + WS_TRANK);
    const LAS int* TT = (const LAS int*)(F.lds + LDS_TT);
    const bool lastl = (l == DEPTH - 1);
    const int st = F.NGW;
    int row = row_lo + F.gw;
    if (row >= NT) return;
    CombRow RA, RB;
    v4u te1 = te[row], tr1 = trank[row];
    comb_issue(RA, X, Y, TT, row, te1, tr1, f_lane);
    if (row + st < NT) { te1 = te[row + st]; tr1 = trank[row + st]; }
    for (;;) {
        const bool h1 = row + st < NT;
        if (h1) comb_issue(RB, X, Y, TT, row + st, te1, tr1, f_lane);
        if (row + 2 * st < NT) { te1 = te[row + 2 * st]; tr1 = trank[row + 2 * st]; }
        comb_finish(RA, F, a, l, row, f_lane, MOD, MODN, lastl);
        if (!h1) break;
        row += st;
        const bool h2 = row + st < NT;
        if (h2) comb_issue(RA, X, Y, TT, row + st, te1, tr1, f_lane);
        if (row + 2 * st < NT) { te1 = te[row + 2 * st]; tr1 = trank[row + 2 * st]; }
        comb_finish(RB, F, a, l, row, f_lane, MOD, MODN, lastl);
        if (!h2) break;
        row += st;
    }
}

#endif
__device__ __forceinline__ void rp_mla(Frame& F, const Args& a) {
    const int f_tid = lthread(F.wave), f_lane = f_tid & 63;
    const bf16* A = (const bf16*)(F.ws + WS_RE); bf16* QA = (bf16*)(F.ws + WS_RF); bf16* CKV = (bf16*)(F.ws + WS_RG); bf16* Kb = (bf16*)(F.ws + WS_RB);
    const float* rope = (const float*)(F.ws + WS_ROPE); const float* gq = a.in[12]; const float* gk = a.in[14];
    for (int row = F.gw; row < NT; row += F.NGW) {
        const unsigned* ap = (const unsigned*)(A + (size_t)row * MLA_IN_PAD);
        unsigned q[3], c[2];
#pragma unroll
        for (int j = 0; j < 3; ++j) q[j] = ap[f_lane + 64 * j];
#pragma unroll
        for (int j = 0; j < 2; ++j) c[j] = ap[192 + f_lane + 64 * j];
        const unsigned pe = ap[320 + (f_lane & 15)];
        float sq = 0.f, sc = 0.f;
#pragma unroll
        for (int j = 0; j < 3; ++j) { const float x0 = bf_lo(q[j]), x1 = bf_hi(q[j]); sq += x0 * x0 + x1 * x1; }
#pragma unroll
        for (int j = 0; j < 2; ++j) { const float x0 = bf_lo(c[j]), x1 = bf_hi(c[j]); sc += x0 * x0 + x1 * x1; }
        const float rq = rsqrtf(wave_sum(sq) * (1.f / MLA_QL) + EPS), rc = rsqrtf(wave_sum(sc) * (1.f / MLA_KVL) + EPS);
#pragma unroll
        for (int j = 0; j < 3; ++j) { const int e0 = 2 * (f_lane + 64 * j); ((unsigned*)(QA + (size_t)row * MLA_QL))[f_lane + 64 * j] = pk2(bf_lo(q[j]) * rq * gq[e0], bf_hi(q[j]) * rq * gq[e0 + 1]); }
#pragma unroll
        for (int j = 0; j < 2; ++j) { const int e0 = 2 * (f_lane + 64 * j); ((unsigned*)(CKV + (size_t)row * MLA_KVL))[f_lane + 64 * j] = pk2(bf_lo(c[j]) * rc * gk[e0], bf_hi(c[j]) * rc * gk[e0 + 1]); }
        float x0 = bf_lo(pe), x1 = bf_hi(pe);
        if (row >= NC) { const int t = (row - NC) & 4095, i = f_lane & 15, d = 2 * i, pos = (d & 16) ? (t & 63) : (t >> 6), f = d & 7;
            const float p0 = __shfl_xor(x0, 4), p1 = __shfl_xor(x1, 4); const float sg = (d & 8) ? 1.f : -1.f;
            const float* rp = rope + (size_t)pos * 16 + 2 * f; x0 = x0 * rp[0] + sg * p0 * rp[1]; x1 = x1 * rp[2] + sg * p1 * rp[3]; }
        const unsigned w = pk2(x0, x1);
        { const int i = f_lane & 15, hb = f_lane >> 4;
#pragma unroll
          for (int hh = 0; hh < 4; ++hh) { const int h = hb * 4 + hh; ((unsigned*)(Kb + (size_t)row * 1536 + 96 * h + 64))[i] = w; } }
    }
}

__device__ __forceinline__ void rp_gqa(Frame& F, const Args& a) {
    const int f_tid = lthread(F.wave), f_lane = f_tid & 63;
    const bf16* A = (const bf16*)(F.ws + WS_RA); bf16* Q = (bf16*)(F.ws + WS_RB); bf16* Kb = Q + (size_t)NT * 1024;
    const float* rope = (const float*)(F.ws + WS_ROPE) + 2048; const float* gq = a.in[18]; const float* gk = a.in[19];
    const float c2 = 0.125f * LOG2E;
    for (int row = F.gw; row < NT; row += F.NGW) {
        const bool lat = row >= NC; const int t = (row - NC) & 4095;
#pragma unroll
        for (int part = 0; part < 2; ++part) {
            const int ln = part ? (f_lane & 15) : f_lane; const bf16* src = A + (size_t)row * GQA_QKV + (part ? 1024 : 0) + ln * 16;
            const v4u w0 = *(const v4u*)src, w1 = *(const v4u*)(src + 8);
            float x[16]; const unsigned ww[8] = {w0.x, w0.y, w0.z, w0.w, w1.x, w1.y, w1.z, w1.w};
#pragma unroll
            for (int i = 0; i < 8; ++i) { x[2 * i] = bf_lo(ww[i]); x[2 * i + 1] = bf_hi(ww[i]); }
            float ss = 0.f;
#pragma unroll
            for (int i = 0; i < 16; ++i) ss += x[i] * x[i];
            ss += __shfl_xor(ss, 1); ss += __shfl_xor(ss, 2);
            const float rs = rsqrtf(ss * (1.f / 64.f) + EPS); const float* g = (part ? gk : gq) + (ln & 3) * 16;
#pragma unroll
            for (int i = 0; i < 16; ++i) x[i] = x[i] * rs * g[i];
            if (lat) { const int sec = (ln >> 1) & 1, pos = sec ? (t & 63) : (t >> 6); const float sg = (ln & 1) ? 1.f : -1.f; const float* rp = rope + (size_t)pos * 32;
#pragma unroll
                for (int i = 0; i < 16; ++i) { const float pr = __shfl_xor(x[i], 1); x[i] = x[i] * rp[2 * i] + sg * pr * rp[2 * i + 1]; } }
            const float scl = part ? 1.f : c2;
            v4u o0, o1; o0.x = pk2(x[0] * scl, x[1] * scl); o0.y = pk2(x[2] * scl, x[3] * scl); o0.z = pk2(x[4] * scl, x[5] * scl); o0.w = pk2(x[6] * scl, x[7] * scl);
            o1.x = pk2(x[8] * scl, x[9] * scl); o1.y = pk2(x[10] * scl, x[11] * scl); o1.z = pk2(x[12] * scl, x[13] * scl); o1.w = pk2(x[14] * scl, x[15] * scl);
            if (part == 0) { bf16* d = Q + (size_t)row * 1024 + ln * 16; *(v4u*)d = o0; *(v4u*)(d + 8) = o1; }
            else if (f_lane < 16) { bf16* d = Kb + (size_t)row * 256 + ln * 16; *(v4u*)d = o0; *(v4u*)(d + 8) = o1; }
        }
    }
}

template <int DK>
__device__ __forceinline__ void attn_phase(Frame& F, const att::Tens& T, int kvshift  , int kstride, int vstride, int vbase) {
    const int vcu = (F.G % 8 == 0) ? (blockIdx.x % 8) * (F.G / 8) + blockIdx.x / 8 : blockIdx.x;
    att::Pend pend; pend.valid = false; pend.o0 = f32x16{}; pend.o1 = f32x16{}; pend.l = 1.f; pend.qrow0 = 0; pend.oc0 = 0;
    for (int u = vcu; u < 2048 + 128; u += F.G) {
        if (u < 2048) { const int b = u >> 8, h = (u >> 4) & 15, qb = u & 15, kvh = h >> kvshift;
            att::unit<DK>(T, NC + b * SEQ + qb * 256, h * DK, kvh * kstride, vbase + kvh * vstride, h * 64, b * LCTX, NC + b * SEQ, 68, F.lds, F.wave, pend); }
        else { const int q = u - 2048, b = q >> 4, h = q & 15, kvh = h >> kvshift;
            att::unit<DK>(T, b * LCTX, h * DK, kvh * kstride, vbase + kvh * vstride, h * 64, b * LCTX, 0, 4, F.lds, F.wave, pend); }
    }
    if (pend.valid) att::finish_unit(pend, T.O, F.lds, F.wave, lthread(F.wave) & 63);
    __syncthreads();
}

constexpr int PH_PER_LAYER = 9, PH_TOTAL = 2 + DEPTH * PH_PER_LAYER;
__global__ void __launch_bounds__(512, 2) mk_fwd(Args args) {
    extern __shared__ __attribute__((aligned(16))) unsigned char lds_raw[];
    Frame F;
    F.lds = (LAS unsigned char*)lds_raw; F.ws = args.ws; F.ctl = (gu32*)(args.ws + WS_CTL);
    F.wave = __builtin_amdgcn_readfirstlane(threadIdx.x >> 6); F.G = gridDim.x;
    F.gw = blockIdx.x * 8 + F.wave; F.NGW = F.G * 8;
    if (threadIdx.x < 4) ((LAS unsigned*)(F.lds + LDS_XB))[threadIdx.x] = 0u;
    __syncthreads();
    const int lo = args.ph_lo, hi = args.ph_hi;
    const bool multi = (hi - lo) > 1;
    XcdBarrier bar; bar.bar = (unsigned*)(F.ctl + CW_BAR); bar.x = 0; bar.st = nullptr; bar.wave = F.wave;
    if (multi) bar = xcd_barrier_post((unsigned*)(F.ctl + CW_BAR), (volatile LAS unsigned*)(F.lds + LDS_XB), F.wave);
#define IN(k) (lo <= (k) && (k) < hi)
#define SEAM(k) do { if (IN(k) && IN((k) + 1)) xcd_barrier(bar); } while (0)
    unsigned char* ws0 = args.ws;
#define PH_WS size_t zofs_ = 0; asm volatile("" : "+s"(zofs_)); unsigned char* ws = ws0 + zofs_; F.ws = ws; F.ctl = (gu32*)ws;
    const int G = F.G, cidx = (int)blockIdx.x;

    if (IN(0) && EN(0)) { PH_WS REP(0) { prologue(F, args); SEAM(0); } }
    if (IN(1) && EN(1)) { PH_WS rp_norm1(F, args, 0, 0); SEAM(1); }

    for (int l = 0; l < DEPTH; ++l) {
        const int kind = l % 3, j = l / 3, base = 2 + l * PH_PER_LAYER;
        const bool lastl = (l == DEPTH - 1);

        size_t outB = 0;
        if (kind == 0) {
            if (IN(base + 0) && EN(2)) { PH_WS REP(2) { PolFP p; p.A = (const char*)(ws + WS_WFIN) + (size_t)j * 2048 * D * 2; p.B = (const char*)(ws + WS_H); p.nt = 16; p.nN = lastl ? 128 : 136; p.G = G; p.c = cidx;
                p.Z = (bf16*)(ws + WS_RA); p.Zc = (bf16*)(ws + WS_RH); pg8::gemm_phase(F.lds, p, F.wave); } }
            SEAM(base + 0);
            if (IN(base + 1) && EN(3)) { PH_WS REP(3) { PolFA p; p.A = (const char*)(ws + WS_MA); p.B = (const char*)(ws + WS_RA); p.nt = 4; p.G = G; p.c = cidx; p.Y = (bf16*)(ws + WS_RB); pg8::gemm_phase(F.lds, p, F.wave); } }
            SEAM(base + 1);
            if (IN(base + 2) && EN(4)) { PH_WS REP(4) { PolFC p; p.A = (const char*)(ws + WS_DC); p.B = (const char*)(ws + WS_RB); p.nt = 8; p.G = G; p.c = cidx; p.nunits = lastl ? 512 : 544;
                p.offMC = (unsigned)(WS_MC - WS_DC); p.offZc = (unsigned)(WS_RH - WS_RB); p.F = (bf16*)(ws + WS_RC); pg8::gemm_phase(F.lds, p, F.wave); } }
            SEAM(base + 2);
            outB = WS_WFOUT + (size_t)j * D * D * 2;
        } else if (kind == 1) {
            if (IN(base + 0) && EN(5)) { PH_WS REP(5) { PolDenseBf16 p; p.A = (const char*)(ws + WS_H); p.B = (const char*)(ws + WS_WMIN); p.nt = 16; p.nM = NT / 256; p.nN = 3; p.pm0 = 0; p.G = G; p.c = cidx; p.pitchA = 2048; p.pitchB = 2048;
                p.O = (bf16*)(ws + WS_RE); p.ldo = MLA_IN_PAD; pg8::gemm_phase(F.lds, p, F.wave); } }
            SEAM(base + 0);
            if (IN(base + 1) && EN(6)) { PH_WS REP(6) { rp_mla(F, args); } }
            SEAM(base + 1);
            if (IN(base + 2)) { PH_WS REP(7) {
                if (EN(7)) { PolMlaQ p; p.A = (const char*)(ws + WS_RF); p.B = (const char*)(ws + WS_WMQB); p.nt = 6; p.nM = NT / 256; p.nN = 6; p.G = G; p.c = cidx; p.Q = (bf16*)(ws + WS_RA);
                  p.rope = (const float*)(ws + WS_ROPE); p.c2 = 0.10206207261596575f * LOG2E; pg8::gemm_phase(F.lds, p, F.wave); }
                if (EN(8)) { PolMlaKV p; p.A = (const char*)(ws + WS_RG); p.B = (const char*)(ws + WS_WMKVB); p.nt = 4; p.nM = NT / 256; p.nN = 8; p.G = G; p.c = cidx; p.Kb = (bf16*)(ws + WS_RB); p.Vb = (bf16*)(ws + WS_RD);
                  pg8::gemm_phase(F.lds, p, F.wave); }
            } }
            SEAM(base + 2);
            if (IN(base + 3) && EN(9)) { PH_WS REP(9) { att::Tens T{(const bf16*)(ws + WS_RA), 1536, (const bf16*)(ws + WS_RB), 1536, (const bf16*)(ws + WS_RD), 1024, (bf16*)(ws + WS_RC)}; attn_phase<96>(F, T, 0, 96, 64, 0); } }
            SEAM(base + 3);
            outB = WS_WMO;
        } else {
            if (IN(base + 0) && EN(10)) { PH_WS REP(10) { PolDenseBf16 p; p.A = (const char*)(ws + WS_H); p.B = (const char*)(ws + WS_WGQKV); p.nt = 16; p.nM = NT / 256; p.nN = 6; p.pm0 = 0; p.G = G; p.c = cidx; p.pitchA = 2048; p.pitchB = 2048;
                p.O = (bf16*)(ws + WS_RA); p.ldo = GQA_QKV; pg8::gemm_phase(F.lds, p, F.wave); } }
            SEAM(base + 0);
            if (IN(base + 1) && EN(11)) { PH_WS REP(11) { rp_gqa(F, args); } }
            SEAM(base + 1);
            if (IN(base + 2) && EN(12)) { PH_WS REP(12) { att::Tens T{(const bf16*)(ws + WS_RB), 1024, (const bf16*)(ws + WS_RB) + (size_t)NT * 1024, 256, (const bf16*)(ws + WS_RA), 1536, (bf16*)(ws + WS_RC)}; attn_phase<64>(F, T, 2, 64, 64, 1280); } }
            SEAM(base + 2);
            outB = WS_WGO;
        }
        if (IN(base + 4) && EN(13)) { PH_WS PolOut p; p.A = (const char*)(ws + WS_RC); p.B = (const char*)(ws + outB); p.nt = 16; p.nM = lastl ? NL / 256 : NT / 256; p.nN = 4; p.pm0 = lastl ? 8 : 0; p.G = G; p.c = cidx; p.X = (bf16*)(ws + WS_X); p.mod = (const float*)(ws + WS_MOD) + (size_t)l * 9 * (NMOD * D); p.chunk = 2;
            p.XinC = (l == 0) ? args.in[2] : nullptr; p.XinL = (l == 0) ? args.in[0] - (size_t)NC * D : nullptr;
            pg8::gemm_phase(F.lds, p, F.wave); }
        SEAM(base + 4);
        if (IN(base + 5) && EN(14)) { PH_WS rp_norm2_router(F, args, l, lastl ? NC : 0); }
        SEAM(base + 5);
        if (IN(base + 6) && EN(15)) { PH_WS REP(15) { moe_table(F, l);
            PolMoe1 p; p.A = (const char*)(ws + WS_H); p.B = (const char*)(ws + WS_WGU) + (size_t)l * NE * 2048 * D; p.nt = 8; p.G = G; p.c = cidx;
            p.swgu = (const float*)(ws + WS_SWGU) + (size_t)l * NE * 2048; p.ssc = (const float*)(ws + WS_SSC);
            p.T.TT = (const LAS int*)(F.lds + LDS_TT); p.T.CN = p.T.TT + 64; p.T.TE = (const LAS int*)(F.lds + LDS_TE); p.stok = (const int*)(ws + WS_STOK); p.bgu = (const float*)(ws + WS_BGU) + (size_t)l * NE * 2048; p.act = (bf16*)(ws + WS_ACT);
            pg8::gemm_phase(F.lds, p, F.wave); } }
        SEAM(base + 6);
        if (IN(base + 7) && EN(16)) { PH_WS REP(16) { moe_table(F, l);
            PolMoe2 p; p.A = (const char*)(ws + WS_ACT); p.B = (const char*)(ws + WS_WDN) + (size_t)l * NE * D * DFF * 2; p.nt = 16; p.G = G; p.c = cidx;
            p.T.TT = (const LAS int*)(F.lds + LDS_TT); p.T.CN = p.T.TT + 64; p.T.TE = (const LAS int*)(F.lds + LDS_TE); p.sw = (const float*)(ws + WS_SW); p.bdn = args.in[26] + (size_t)l * NE * D; p.Y = (bf16*)(ws + WS_Y);
            pg8::gemm_phase(F.lds, p, F.wave); } }
        SEAM(base + 7);
        if (IN(base + 8) && EN(17)) { PH_WS moe_table(F, l); rp_combine(F, args, l, lastl ? NC : 0); }
        SEAM(base + 8);
    }
#undef PH_WS
#undef IN
#undef SEAM
}

extern "C" void kernel_launch(void* const* d_in, const int* in_sizes, int n_in, void* d_out, int out_size, void* d_ws, size_t ws_size, hipStream_t stream) {
    static int grid = 0;
    if (grid == 0) {
        if (n_in != 27 || out_size != NL * D || ws_size < WS_END) { fprintf(stderr, "kernel_launch: unexpected problem (n_in %d, out %d, ws %zu < %zu)\n", n_in, out_size, ws_size, (size_t)WS_END); grid = -1; return; }
        int dev = 0, cus = 0, per_cu = 0;
        if (hipGetDevice(&dev) != hipSuccess || hipDeviceGetAttribute(&cus, hipDeviceAttributeMultiprocessorCount, dev) != hipSuccess) { grid = -1; return; }
        if (hipFuncSetAttribute((const void*)mk_fwd, hipFuncAttributeMaxDynamicSharedMemorySize, LDS_BYTES) != hipSuccess) { fprintf(stderr, "kernel_launch: hipFuncSetAttribute failed\n"); grid = -1; return; }
        if (hipOccupancyMaxActiveBlocksPerMultiprocessor(&per_cu, (const void*)mk_fwd, 512, LDS_BYTES) != hipSuccess || per_cu < 1) fprintf(stderr, "kernel_launch: occupancy query says %d\n", per_cu);
        (void)hipGetLastError();
        grid = cus;
    }
    if (grid < 0) return;
    (void)hipMemsetAsync((char*)d_ws + WS_CTL, 0, CTL_ZERO_BYTES, stream);
    Args a{};
    for (int i = 0; i < 27; ++i) a.in[i] = (const float*)d_in[i];
    a.out = (float*)d_out; a.ws = (unsigned char*)d_ws;
#if MK_PER_PHASE
    for (int ph = 0; ph < PH_TOTAL; ++ph) {
        const int l = (ph - 2) / PH_PER_LAYER, s = (ph - 2) % PH_PER_LAYER, kind = l % 3;
        if (ph >= 2) { if (s == 3 && kind != 1) continue; }
        a.ph_lo = ph; a.ph_hi = ph + 1;
        hipLaunchKernelGGL(mk_fwd, dim3(grid), dim3(512), LDS_BYTES, stream, a);
    }
#else
    a.ph_lo = 0; a.ph_hi = PH_TOTAL;
    hipLaunchKernelGGL(mk_fwd, dim3(grid), dim3(512), LDS_BYTES, stream, a);
#endif
}
```

```cpp
#include <hip/hip_runtime.h>
#include <cstdio>
#include <cstdint>

#ifndef MK_PER_PHASE
#define MK_PER_PHASE 0
#endif
#ifndef MK_N2V2
#define MK_N2V2 1
#endif
#ifndef MK_CBV2
#define MK_CBV2 1
#endif
#ifndef MK_N2AGG
#define MK_N2AGG 1
#endif
#ifndef MK_MASK
#define MK_MASK 0xFFFFFFFFu
#endif
#define EN(id) (((MK_MASK) >> (id)) & 1u)
#ifndef MK_REPMASK
#define MK_REPMASK 0u
#endif
#define REP(id) for (int rep_ = 0; rep_ < ((((MK_REPMASK) >> (id)) & 1u) ? 2 : 1); ++rep_)

constexpr int D = 1024, NB = 8, SEQ = 4096, LCTX = 256, DEPTH = 4;
constexpr int NC = NB * LCTX;
constexpr int NL = NB * SEQ;
constexpr int NT = NC + NL;
constexpr int NMOD = 6, NE = 32, TOPK = 4, DFF = 1024;
constexpr int MLA_QL = 384, MLA_KVL = 256, MLA_ROPE = 32, MLA_NOPE = 64, MLA_V = 64, MLA_IN = 672, MLA_IN_PAD = 768, MLA_QD = 96;
constexpr int GQA_NQ = 1024, GQA_NKV = 256, GQA_QKV = 1536;
constexpr int CAP = NT;
constexpr int MAXTILES = 576;
constexpr float EPS = 1e-6f;
constexpr float LOG2E = 1.4426950408889634f;

constexpr size_t MiB = 1u << 20;
constexpr size_t WS_CTL = 0, CTL_ZERO_BYTES = 96 * 1024;
constexpr size_t WS_MOD = 1 * MiB;
constexpr size_t WS_ROPE = 2 * MiB;
constexpr size_t WS_WRT = 2 * MiB + 65536;
constexpr size_t WS_BGU = 3 * MiB;
constexpr size_t WS_MA = 4 * MiB;
constexpr size_t WS_DC = 4 * MiB + 262144;
constexpr size_t WS_MC = 5 * MiB;
constexpr size_t WS_WFIN = 9 * MiB;
constexpr size_t WS_WFOUT = 17 * MiB;
constexpr size_t WS_WMIN = 21 * MiB;
constexpr size_t WS_WMQB = 23 * MiB;
constexpr size_t WS_WMKVB = 25 * MiB;
constexpr size_t WS_WMO = 26 * MiB;
constexpr size_t WS_WGQKV = 28 * MiB;
constexpr size_t WS_WGO = 31 * MiB;
constexpr size_t WS_TE = 34 * MiB;
constexpr size_t WS_TRANK = 35 * MiB;
constexpr size_t WS_STOK = 36 * MiB;
constexpr size_t WS_SW = 41 * MiB;
constexpr size_t WS_X = 64 * MiB;
constexpr size_t WS_H = 200 * MiB;
constexpr size_t WS_RA = 272 * MiB;
constexpr size_t WS_RB = 400 * MiB;
constexpr size_t WS_RC = 528 * MiB;
constexpr size_t WS_RD = 600 * MiB;
constexpr size_t WS_RE = 672 * MiB;
constexpr size_t WS_RF = 728 * MiB;
constexpr size_t WS_RG = 756 * MiB;
constexpr size_t WS_RH = 776 * MiB;
constexpr size_t WS_ACT = 784 * MiB;
constexpr size_t WS_Y = 1072 * MiB;
constexpr size_t WS_WGU = 1360 * MiB;
constexpr size_t WS_SWGU = 1360 * MiB + 256 * MiB;
constexpr size_t WS_SSC = 1360 * MiB + 260 * MiB;
constexpr size_t WS_WDN = 1872 * MiB;
constexpr size_t WS_SWDN = 1872 * MiB + 128 * MiB;
constexpr size_t WS_END = 2128 * MiB;
constexpr int CW_TMO = 0;
constexpr int CW_BAR = 4096;
constexpr int CW_CNT = 16384;

constexpr int RING_BYTES = 131072;
constexpr int LDS_MISC = 135168;
constexpr int LDS_TT = LDS_MISC;
constexpr int LDS_XB = LDS_MISC + 512;
constexpr int LDS_TE = LDS_MISC + 768;
constexpr int LDS_BYTES = 147456;

#define GAS __attribute__((address_space(1)))
#define LAS __attribute__((address_space(3)))
typedef unsigned short bf16;
typedef unsigned v4u __attribute__((ext_vector_type(4)));
typedef unsigned v2u __attribute__((ext_vector_type(2)));
typedef float f32x4 __attribute__((ext_vector_type(4)));
typedef float f32x2 __attribute__((ext_vector_type(2)));
typedef float f32x16 __attribute__((ext_vector_type(16)));
typedef short bf16x8 __attribute__((ext_vector_type(8)));
typedef short s16x4 __attribute__((ext_vector_type(4)));
typedef __bf16 bf16x2_t __attribute__((ext_vector_type(2)));
typedef GAS unsigned gu32;
#define RLX_AGENT __ATOMIC_RELAXED, __HIP_MEMORY_SCOPE_AGENT
#define LDS_WAIT() asm volatile("s_waitcnt lgkmcnt(0)" ::: "memory")
#define VM_WAIT() asm volatile("s_waitcnt vmcnt(0)" ::: "memory")
__device__ __forceinline__ unsigned pk2(float lo, float hi) { f32x2 v = {lo, hi}; bf16x2_t b = __builtin_convertvector(v, bf16x2_t); return __builtin_bit_cast(unsigned, b); }
__device__ __forceinline__ float bf_lo(unsigned u) { return __builtin_bit_cast(float, u << 16); }
__device__ __forceinline__ float bf_hi(unsigned u) { return __builtin_bit_cast(float, u & 0xffff0000u); }
__device__ __forceinline__ float shx(float v, int mask, int lane) { return __int_as_float(__builtin_amdgcn_ds_bpermute((lane ^ mask) << 2, __float_as_int(v))); }
__device__ __forceinline__ float wave_sum(float v, int lane) {
#pragma unroll
    for (int o = 1; o < 64; o <<= 1) v += shx(v, o, lane);
    return v;
}
__device__ __forceinline__ int lane_id_v() { int t; asm volatile("v_mbcnt_lo_u32_b32 %0, -1, 0\n\tv_mbcnt_hi_u32_b32 %0, -1, %0" : "=v"(t)); return t; }
__device__ __forceinline__ int launder_s(int x) { asm volatile("" : "+s"(x)); return x; }
__device__ __forceinline__ int lthread_w(int wave) { return wave * 64 + lane_id_v(); }
__device__ __forceinline__ int modrow_of(int row) { return row < NC ? NB : ((row - NC) >> 12); }

#define XB_TMO      128
#define XB_XCNT(j)  (256  + 64 * (j))
#define XB_XSUB(j)  (1280 + 64 * (j))
#define XB_XGEN(j)  (2304 + 64 * (j))
#define XB_TOP      3328
#define XB_TOPGEN   3392
#define XCD_BAR_WORDS 3456
#define XB_SPIN_CAP (1u << 18)
__device__ __forceinline__ unsigned xb_ld(unsigned* p)              { return __hip_atomic_load(p, __ATOMIC_RELAXED, __HIP_MEMORY_SCOPE_AGENT); }
__device__ __forceinline__ unsigned xb_add(unsigned* p, unsigned v) { return __hip_atomic_fetch_add(p, v, __ATOMIC_RELAXED, __HIP_MEMORY_SCOPE_AGENT); }
__device__ __forceinline__ unsigned xb_xcc_id() { return (unsigned)__builtin_amdgcn_s_getreg((3 << 11) | 20) & 0xFu; }
#define XB_SPIN(cond, bar) do { unsigned _sp = 0; while (cond) { __builtin_amdgcn_s_sleep(1); \
    if ((++_sp & 255u) == 0u) { if (xb_ld(&(bar)[XB_TMO])) break; if (_sp > XB_SPIN_CAP) { atomicAdd(&(bar)[XB_TMO], 1u); break; } } } } while (0)
struct XcdBarrier { unsigned* bar; unsigned x; volatile LAS unsigned* st; int wave; };
__device__ __forceinline__ bool xb_thread0(int wave) { return wave == 0 && lane_id_v() == 0; }
__device__ __forceinline__ XcdBarrier xcd_barrier_post(unsigned* bar, volatile LAS unsigned* st, int wave) {
    XcdBarrier b; b.bar = bar; b.x = xb_xcc_id(); b.st = st; b.wave = wave;
    if (xb_thread0(wave)) (void)xb_add(&bar[XB_XCNT(b.x)], 1u);
    return b;
}
__device__ __forceinline__ void xcd_barrier_complete(unsigned* bar, unsigned x, unsigned& nloc, unsigned& nx) {
    const unsigned G = gridDim.x * gridDim.y * gridDim.z;
    unsigned sum, cnt, mine, sp = 0u;
    for (;;) {
        sum = 0u; cnt = 0u; mine = 0u;
#pragma unroll
        for (unsigned j = 0; j < 16; ++j) { const unsigned c = xb_ld(&bar[XB_XCNT(j)]); sum += c; cnt += (c > 0u) ? 1u : 0u; mine = (j == x) ? c : mine; }
        if (sum == G) break;
        __builtin_amdgcn_s_sleep(1);
        if ((++sp & 255u) == 0u) { if (xb_ld(&bar[XB_TMO])) break; if (sp > XB_SPIN_CAP) { atomicAdd(&bar[XB_TMO], 1u); break; } }
    }
    nloc = mine > 0u ? mine : 1u; nx = cnt > 0u ? cnt : 1u;
}
__device__ __forceinline__ void xcd_barrier(const XcdBarrier& b) {
    asm volatile("s_waitcnt vmcnt(0)" ::: "memory");
    __syncthreads();
    if (xb_thread0(b.wave)) {
        unsigned* bar = b.bar;
        __builtin_amdgcn_s_waitcnt(0);
        unsigned nloc = b.st[0], nx = b.st[1];
        if (nloc == 0u) { xcd_barrier_complete(bar, b.x, nloc, nx); b.st[0] = nloc; b.st[1] = nx; }
        const unsigned old = xb_add(&bar[XB_XSUB(b.x)], 1u);
        const unsigned gen = old / nloc;
        if (old + 1u == (gen + 1u) * nloc) {
            __builtin_amdgcn_fence(__ATOMIC_RELEASE, "agent");
            asm volatile("s_waitcnt vmcnt(0)" ::: "memory");
            const unsigned og = xb_add(&bar[XB_TOP], 1u);
            const unsigned tg = og / nx;
            if (og + 1u == (tg + 1u) * nx) xb_add(&bar[XB_TOPGEN], 1u);
            else XB_SPIN(xb_ld(&bar[XB_TOPGEN]) == tg, bar);
            __builtin_amdgcn_fence(__ATOMIC_ACQUIRE, "agent");
            xb_add(&bar[XB_XGEN(b.x)], 1u);
            asm volatile("s_waitcnt vmcnt(0)" ::: "memory");
        } else {
            XB_SPIN(xb_ld(&bar[XB_XGEN(b.x)]) == gen, bar);
            __builtin_amdgcn_fence(__ATOMIC_ACQUIRE, "agent");
            asm volatile("s_waitcnt vmcnt(0)" ::: "memory");
        }
    }
    __syncthreads();
}

namespace pg8 {
#define PG8_LAS __attribute__((address_space(3)))
constexpr int BM = 256, BK = 64, HALF = 128, HTB = HALF * BK * 2, STAGE_BYTES = 8 * HTB, NXCD = 8, WGM = 8;
__device__ __forceinline__ int lds_byte(int r, int c) { const int st = (r >> 4) * 2 + (c >> 5), rr = r & 15, cc = c & 31, ob = rr * 64 + cc * 2; return st * 1024 + (ob ^ (((ob >> 9) & 1) << 5)); }
__device__ __forceinline__ void stage_rc(int b, int& R, int& C) { const int st = b / 1024, sb = b % 1024, swz = sb ^ (((sb >> 9) & 1) << 5); R = (st >> 1) * 16 + swz / 64; C = (st & 1) * 32 + (swz % 64) / 2; }
__device__ __forceinline__ int perm32(int rho) { const int n = rho >> 4, i = rho & 15; return 8 * (i >> 2) + 4 * n + (i & 3); }
struct Unit { int pm, pn, aux; };
typedef f32x4 Acc[2][2][4][2];
typedef int i32x4 __attribute__((ext_vector_type(4)));
typedef i32x4 AccI[2][2][4][2];
template <bool I8> struct AccSel { typedef f32x4 T; };
template <> struct AccSel<true> { typedef i32x4 T; };
__device__ __forceinline__ f32x4 mma1(bf16x8 b, bf16x8 a, f32x4 c) { return __builtin_amdgcn_mfma_f32_16x16x32_bf16(b, a, c, 0, 0, 0); }
typedef int i32x8 __attribute__((ext_vector_type(8)));
typedef short bf16x16 __attribute__((ext_vector_type(16)));
__device__ __forceinline__ f32x4 mma_f8(bf16x8 b0, bf16x8 b1, bf16x8 a0, bf16x8 a1, f32x4 c) {
    const i32x8 B = __builtin_bit_cast(i32x8, __builtin_shufflevector(b0, b1, 0, 1, 2, 3, 4, 5, 6, 7, 8, 9, 10, 11, 12, 13, 14, 15));
    const i32x8 A = __builtin_bit_cast(i32x8, __builtin_shufflevector(a0, a1, 0, 1, 2, 3, 4, 5, 6, 7, 8, 9, 10, 11, 12, 13, 14, 15));
    return __builtin_amdgcn_mfma_scale_f32_16x16x128_f8f6f4(B, A, c, 0, 0, 0, 0x7F7F7F7F, 0, 0x7F7F7F7F); }
__device__ __forceinline__ i32x4 mma1(bf16x8 b, bf16x8 a, i32x4 c) { return __builtin_amdgcn_mfma_i32_16x16x64_i8(__builtin_bit_cast(i32x4, b), __builtin_bit_cast(i32x4, a), c, 0, 0, 0); }

__device__ __forceinline__ bool static_next(int i, int G, int c, int nM, int nN, int& pm, int& pn) {
    const int nwg = nM * nN; const long L = (long)i * G + c; if (L >= nwg) return false;
    int wgid = (int)L; { const int q = nwg / NXCD, r = nwg % NXCD, xcd = wgid % NXCD, off = wgid / NXCD; wgid = (xcd < r ? xcd * (q + 1) : r * (q + 1) + (xcd - r) * q) + off; }
    const int nig = WGM * nN, gid = wgid / nig, fm = gid * WGM, gsz = (nM - fm) < WGM ? (nM - fm) : WGM;
    pm = fm + ((wgid % nig) % gsz); pn = (wgid % nig) / gsz; return true;
}

template <class P>
__device__ __forceinline__ void gemm_phase(PG8_LAS unsigned char* lds, const P& p, int wave_id) {
    wave_id = launder_s(wave_id); int tid_l = lthread_w(wave_id);
    const int tid = tid_l, wid = wave_id, lane = tid & 63, wr = wid >> 2, wc = wid & 3, fr = lane & 15, fq = lane >> 4;
    const int nt = p.nt;
    const unsigned ldsw = (unsigned)wid * 1024u;
    const int aoff = lds_byte(wr * 64 + fr, fq * 8), boff = lds_byte(wc * 32 + fr, fq * 8);
    const char* const gA = p.A; const char* const gB = p.B;
#define PG8_SA(b, h) (((b) * 2 + (h)) * HTB)
#define PG8_SB(b, h) ((4 + (b) * 2 + (h)) * HTB)
#define PG8_STAGE(bufoff, gbase, off2, kofs) do { _Pragma("unroll") for (int _i = 0; _i < 2; ++_i) \
        __builtin_amdgcn_global_load_lds((const unsigned*)((gbase) + (size_t)(off2)[_i] + (size_t)(kofs)), (PG8_LAS unsigned*)(lds + (bufoff) + ldsw + _i * 8192), 16, 0, 0); } while (0)
#define PG8_LDA(dst, b, h) do { _Pragma("unroll") for (int m = 0; m < 4; ++m) _Pragma("unroll") for (int k = 0; k < 2; ++k) dst[m][k] = *(const PG8_LAS bf16x8*)(lds + PG8_SA(b, h) + aoff + m * 2048 + k * 1024); } while (0)
#define PG8_LDB(dst, b, h) do { _Pragma("unroll") for (int n = 0; n < 2; ++n) _Pragma("unroll") for (int k = 0; k < 2; ++k) dst[n][k] = *(const PG8_LAS bf16x8*)(lds + PG8_SB(b, h) + boff + n * 2048 + k * 1024); } while (0)
#define PG8_MMA(ai, bj, At, Bt) do { __builtin_amdgcn_s_setprio(1); _Pragma("unroll") for (int m = 0; m < 4; ++m) _Pragma("unroll") for (int n = 0; n < 2; ++n) { \
        if constexpr (P::F8) acc[ai][bj][m][n] = mma_f8(Bt[n][0], Bt[n][1], At[m][0], At[m][1], acc[ai][bj][m][n]); \
        else { _Pragma("unroll") for (int k = 0; k < 2; ++k) acc[ai][bj][m][n] = mma1(Bt[n][k], At[m][k], acc[ai][bj][m][n]); } } __builtin_amdgcn_s_setprio(0); } while (0)
#define PG8_WAIT_V(n) asm volatile("s_waitcnt vmcnt(" #n ")" ::: "memory")
#define PG8_WAIT_L(n) asm volatile("s_waitcnt lgkmcnt(" #n ")" ::: "memory")
#define PG8_BAR __builtin_amdgcn_s_barrier()
#define PG8_SCHED __builtin_amdgcn_sched_barrier(0)
#define PG8_KEYS(u) do { if (P::KEYS && wid < 4) __builtin_amdgcn_global_load_lds((const unsigned*)p.key_ptr(u, wid * 64 + lane), (PG8_LAS unsigned*)(keybuf + wid * 256), 4, 0, 0); } while (0)
#define PG8_OFFS(u, oA, oB) do { int tid2_ = tid; asm volatile("" : "+v"(tid2_));     \
    _Pragma("unroll") for (int _i = 0; _i < 2; ++_i) { int R_, C_; stage_rc(tid2_ * 16 + _i * 8192, R_, C_); const int Rb_ = P::PERM ? ((R_ & ~31) + perm32(R_ & 31)) : R_; \
      _Pragma("unroll") for (int _h = 0; _h < 2; ++_h) { \
        const int key_ = P::KEYS ? ((const PG8_LAS int*)keybuf)[_h * HALF + R_] : 0; \
        oA[_h][_i] = p.a_row(u, _h * HALF + R_, key_) + (unsigned)(C_ * 2); oB[_h][_i] = p.b_row(u, _h * HALF + Rb_) + (unsigned)(C_ * 2); } } } while (0)
    PG8_LAS unsigned char* const keybuf = lds + STAGE_BYTES;
    Unit cur, nxt; int ui = 0;
    if (!p.next(0, cur)) return;
    typedef typename AccSel<P::I8>::T AccT;
    AccT acc[2][2][4][2];
#pragma unroll
    for (int a = 0; a < 2; ++a)
#pragma unroll
        for (int b = 0; b < 2; ++b)
#pragma unroll
            for (int m = 0; m < 4; ++m)
#pragma unroll
                for (int n = 0; n < 2; ++n) acc[a][b][m][n] = (AccT){0, 0, 0, 0};
    bf16x8 At[4][2], B0[2][2], B1[2][2];
    unsigned oAc[2][2], oBc[2][2];
    if (P::KEYS) { PG8_KEYS(cur); PG8_WAIT_V(0); PG8_BAR; }
    PG8_OFFS(cur, oAc, oBc);
    PG8_STAGE(PG8_SB(0, 0), gB, oBc[0], 0); PG8_STAGE(PG8_SB(0, 1), gB, oBc[1], 0); PG8_STAGE(PG8_SA(0, 0), gA, oAc[0], 0); PG8_STAGE(PG8_SA(0, 1), gA, oAc[1], 0);
    if (wr == 1) PG8_BAR;
    PG8_WAIT_V(2); PG8_BAR;
    PG8_STAGE(PG8_SB(1, 0), gB, oBc[0], 128); PG8_STAGE(PG8_SA(1, 0), gA, oAc[0], 128); PG8_STAGE(PG8_SB(1, 1), gB, oBc[1], 128);
    PG8_WAIT_V(6); PG8_BAR;
    for (;;) {
        const bool has_next = p.next(ui + 1, nxt);
        if (has_next) { PG8_KEYS(nxt); }
        for (int t = 0; t < nt; t += 2) {
            const bool last = (t == nt - 2);
            const unsigned k1 = (unsigned)(t + 1) * 128u;
            const unsigned k2 = last ? 0u : (unsigned)(t + 2) * 128u, k3 = k2 + 128u;
            PG8_LDB(B0, 0, 0); PG8_LDB(B1, 0, 1); PG8_SCHED; PG8_LDA(At, 0, 0); PG8_STAGE(PG8_SA(1, 1), gA, oAc[1], k1);
            if (last && has_next) { PG8_OFFS(nxt, oAc, oBc); }
            PG8_WAIT_V(8); PG8_WAIT_L(0); PG8_BAR; PG8_MMA(0, 0, At, B0); PG8_MMA(0, 1, At, B1); PG8_BAR; PG8_SCHED;
            PG8_LDA(At, 0, 1); PG8_STAGE(PG8_SB(0, 0), gB, oBc[0], k2); PG8_STAGE(PG8_SB(0, 1), gB, oBc[1], k2); PG8_STAGE(PG8_SA(0, 0), gA, oAc[0], k2);
            PG8_WAIT_V(8); PG8_WAIT_L(0); PG8_BAR; PG8_MMA(1, 0, At, B0); PG8_MMA(1, 1, At, B1); PG8_BAR; PG8_SCHED;
            PG8_LDB(B0, 1, 0); PG8_LDB(B1, 1, 1); PG8_SCHED; PG8_LDA(At, 1, 0); PG8_STAGE(PG8_SA(0, 1), gA, oAc[1], k2);
            PG8_WAIT_V(8); PG8_WAIT_L(0); PG8_BAR; PG8_MMA(0, 0, At, B0); PG8_MMA(0, 1, At, B1); PG8_BAR; PG8_SCHED;
            PG8_LDA(At, 1, 1); PG8_STAGE(PG8_SB(1, 0), gB, oBc[0], k3); PG8_STAGE(PG8_SB(1, 1), gB, oBc[1], k3); PG8_STAGE(PG8_SA(1, 0), gA, oAc[0], k3);
            PG8_WAIT_V(8); PG8_WAIT_L(0); PG8_BAR; PG8_MMA(1, 0, At, B0); PG8_MMA(1, 1, At, B1); PG8_BAR; PG8_SCHED;
        }
        if (wr == 0) PG8_BAR;
        { const int le_ = lane_id_v(); int fr_e = le_ & 15, fq_e = le_ >> 4;
          p.epi(acc, cur, wr, wc, fr_e, fq_e); }
        if (!has_next) break;
#pragma unroll
        for (int a = 0; a < 2; ++a)
#pragma unroll
            for (int b = 0; b < 2; ++b)
#pragma unroll
                for (int m = 0; m < 4; ++m)
#pragma unroll
                    for (int n = 0; n < 2; ++n) acc[a][b][m][n] = (AccT){0, 0, 0, 0};
        cur = nxt; ++ui;
        if (wr == 1) PG8_BAR;
    }
    PG8_WAIT_V(0);
    PG8_BAR;
#undef PG8_SA
#undef PG8_SB
#undef PG8_STAGE
#undef PG8_LDA
#undef PG8_LDB
#undef PG8_MMA
#undef PG8_WAIT_V
#undef PG8_WAIT_L
#undef PG8_BAR
#undef PG8_SCHED
#undef PG8_OFFS
#undef PG8_KEYS
}
}
using pg8::Unit;

#define TROW(ai, wr, m, fr) (128 * (ai) + 64 * (wr) + 16 * (m) + (fr))
#define TCOLP(bj, wc, fq) (128 * (bj) + 32 * (wc) + 8 * (fq))
#define TCOLN(bj, wc, n, fq) (128 * (bj) + 32 * (wc) + 16 * (n) + 4 * (fq))
__device__ __forceinline__ v4u pack8(const f32x4 a, const f32x4 b) { v4u w; w.x = pk2(a[0], a[1]); w.y = pk2(a[2], a[3]); w.z = pk2(b[0], b[1]); w.w = pk2(b[2], b[3]); return w; }

struct PolDenseBf16 {
    static constexpr bool PERM = true;
    static constexpr bool KEYS = false;
    static constexpr bool I8 = false;
    static constexpr bool F8 = false;
    __device__ __forceinline__ const int* key_ptr(const Unit&, int) const { return nullptr; }
    const char* A; const char* B; int nt; int nM, nN, pm0, G, c; unsigned pitchA, pitchB; bf16* O; int ldo;
    __device__ __forceinline__ bool next(int i, Unit& u) const { int pm, pn; if (!pg8::static_next(i, G, c, nM, nN, pm, pn)) return false; u.pm = pm + pm0; u.pn = pn; u.aux = 0; return true; }
    __device__ __forceinline__ unsigned a_row(const Unit& u, int r, int) const { return (unsigned)(u.pm * 256 + r) * pitchA; }
    __device__ __forceinline__ unsigned b_row(const Unit& u, int r) const { return (unsigned)(u.pn * 256 + r) * pitchB; }
    __device__ __forceinline__ void epi(const pg8::Acc& acc, const Unit& u, int wr, int wc, int fr, int fq) const {
#pragma unroll
        for (int ai = 0; ai < 2; ++ai)
#pragma unroll
            for (int m = 0; m < 4; ++m) { const size_t row = (size_t)u.pm * 256 + TROW(ai, wr, m, fr);
#pragma unroll
                for (int bj = 0; bj < 2; ++bj) { const int col = u.pn * 256 + TCOLP(bj, wc, fq); *(v4u*)(O + row * ldo + col) = pack8(acc[ai][bj][m][0], acc[ai][bj][m][1]); } }
    }
};

struct PolOut {
    static constexpr bool PERM = true;
    static constexpr bool KEYS = false;
    static constexpr bool I8 = false;
    static constexpr bool F8 = false;
    __device__ __forceinline__ const int* key_ptr(const Unit&, int) const { return nullptr; }
    const char* A; const char* B; int nt; int nM, nN, pm0, G, c; bf16* X; const float* mod;
    int chunk; const float* XinC; const float* XinL;
    __device__ __forceinline__ bool next(int i, Unit& u) const { int pm, pn; if (!pg8::static_next(i, G, c, nM, nN, pm, pn)) return false; u.pm = pm + pm0; u.pn = pn; u.aux = 0; return true; }
    __device__ __forceinline__ unsigned a_row(const Unit& u, int r, int) const { return (unsigned)(u.pm * 256 + r) * 2048u; }
    __device__ __forceinline__ unsigned b_row(const Unit& u, int r) const { return (unsigned)(u.pn * 256 + r) * 2048u; }
    __device__ __forceinline__ void epi(const pg8::Acc& acc, const Unit& u, int wr, int wc, int fr, int fq) const {
        const int mr = modrow_of(u.pm * 256);
        const float* g = mod + (size_t)mr * (NMOD * D) + chunk * D;
        const float* xin = XinC ? (u.pm < 8 ? XinC : XinL) : nullptr;
#pragma unroll
        for (int bj = 0; bj < 2; ++bj) { const int col = u.pn * 256 + TCOLP(bj, wc, fq); const f32x4 g0 = *(const f32x4*)(g + col), g1 = *(const f32x4*)(g + col + 4);
#pragma unroll
            for (int ai = 0; ai < 2; ++ai)
#pragma unroll
                for (int m = 0; m < 4; ++m) { const size_t off = ((size_t)u.pm * 256 + TROW(ai, wr, m, fr)) * D + col; f32x4 x0, x1;
                    if (xin) { x0 = *(const f32x4*)(xin + off); x1 = *(const f32x4*)(xin + off + 4); }
                    else { const v4u w = *(const v4u*)(X + off); x0 = (f32x4){bf_lo(w.x), bf_hi(w.x), bf_lo(w.y), bf_hi(w.y)}; x1 = (f32x4){bf_lo(w.z), bf_hi(w.z), bf_lo(w[3]), bf_hi(w[3])}; }
                    *(v4u*)(X + off) = pack8(x0 + g0 * acc[ai][bj][m][0], x1 + g1 * acc[ai][bj][m][1]); } }
    }
};

struct PolFP {
    static constexpr bool PERM = true;
    static constexpr bool KEYS = false;
    static constexpr bool I8 = false;
    static constexpr bool F8 = false;
    __device__ __forceinline__ const int* key_ptr(const Unit&, int) const { return nullptr; }
    const char* A; const char* B; int nt; int nN, G, c; bf16* Z; bf16* Zc;
    __device__ __forceinline__ bool next(int i, Unit& u) const { int pm, pn; if (!pg8::static_next(i, G, c, 8, nN, pm, pn)) return false; u.pm = pm; u.pn = pn; u.aux = 0; return true; }
    __device__ __forceinline__ unsigned a_row(const Unit& u, int r, int) const { return (unsigned)(u.pm * 256 + r) * 2048u; }
    __device__ __forceinline__ unsigned b_row(const Unit& u, int r) const {
        int hrow;
        if (u.pn < 128) { const int n = u.pn * 256 + r, b = n >> 12, l2 = (n >> 6) & 63, l1 = n & 63; hrow = NC + b * SEQ + 64 * l1 + l2; }
        else hrow = (u.pn - 128) * 256 + r;
        return (unsigned)hrow * 2048u;
    }
    __device__ __forceinline__ void epi(const pg8::Acc& acc, const Unit& u, int wr, int wc, int fr, int fq) const {
#pragma unroll
        for (int ai = 0; ai < 2; ++ai)
#pragma unroll
            for (int m = 0; m < 4; ++m) { const int cp = u.pm * 256 + TROW(ai, wr, m, fr);
#pragma unroll
                for (int bj = 0; bj < 2; ++bj) { const int n0 = u.pn * 256 + TCOLP(bj, wc, fq); const v4u w = pack8(acc[ai][bj][m][0], acc[ai][bj][m][1]);
                    if (u.pn < 128) *(v4u*)(Z + ((size_t)(n0 >> 6) * 2048 + cp) * 64 + (n0 & 63)) = w;
                    else { const int b = u.pn - 128, l = n0 - 32768 - b * 256; *(v4u*)(Zc + ((size_t)b * 2048 + cp) * 256 + l) = w; } } }
    }
};

struct PolFA {
    static constexpr bool PERM = true;
    static constexpr bool KEYS = false;
    static constexpr bool I8 = false;
    static constexpr bool F8 = false;
    __device__ __forceinline__ const int* key_ptr(const Unit&, int) const { return nullptr; }
    const char* A; const char* B; int nt; int G, c; bf16* Y;
    __device__ __forceinline__ bool next(int i, Unit& u) const { const int L = i * G + c; if (L >= 1024) return false; u.pm = 0; u.pn = L & 127; u.aux = L >> 7; return true; }
    __device__ __forceinline__ unsigned a_row(const Unit&, int r, int) const { return (unsigned)r * 512u; }
    __device__ __forceinline__ unsigned b_row(const Unit& u, int r) const { const int l2 = r & 63, cp = u.pn * 4 + (r >> 6); return (unsigned)((u.aux * 64 + l2) * 512 + cp) * 512u; }
    __device__ __forceinline__ void epi(const pg8::Acc& acc, const Unit& u, int wr, int wc, int fr, int fq) const {
        const int b = u.aux;
#pragma unroll
        for (int ai = 0; ai < 2; ++ai)
#pragma unroll
            for (int m = 0; m < 4; ++m) { const int rr = TROW(ai, wr, m, fr), jp = rr >> 7, pp = (rr >> 6) & 1, k1 = rr & 63;
#pragma unroll
                for (int bj = 0; bj < 2; ++bj) { const int n0 = u.pn * 256 + TCOLP(bj, wc, fq), cp = n0 >> 6, l2 = n0 & 63, cc = 2 * cp + jp;
                    const size_t idx = ((((size_t)(b * 16 + (k1 >> 2)) * 1024 + cc) * 4 + (k1 & 3)) * 2 + pp) * 64 + l2;
                    *(v4u*)(Y + idx) = pack8(acc[ai][bj][m][0], acc[ai][bj][m][1]); } }
    }
};

struct PolFC {
    static constexpr bool PERM = true;
    static constexpr bool KEYS = false;
    static constexpr bool I8 = false;
    static constexpr bool F8 = false;
    __device__ __forceinline__ const int* key_ptr(const Unit&, int) const { return nullptr; }
    const char* A; const char* B; int nt; int G, c; int nunits; unsigned offMC, offZc; bf16* F;
    __device__ __forceinline__ bool next(int i, Unit& u) const { const int L = i * G + c; if (L >= nunits) return false;
        if (L < 512) { u.pm = 0; u.pn = L & 3; u.aux = L >> 2; } else { const int q = L - 512; u.pm = 0; u.pn = q & 3; u.aux = 256 + (q >> 2); } return true; }
    __device__ __forceinline__ unsigned a_row(const Unit& u, int r, int) const {
        if (u.aux < 256) return offMC + (unsigned)((u.aux & 15) * 256 + r) * 1024u;
        return (unsigned)r * 1024u; }
    __device__ __forceinline__ unsigned b_row(const Unit& u, int r) const {
        if (u.aux < 256) return (unsigned)(u.aux * 1024 + u.pn * 256 + r) * 1024u;
        return offZc + (unsigned)((u.aux - 256) * 1024 + u.pn * 256 + r) * 1024u; }
    __device__ __forceinline__ void epi(const pg8::Acc& acc, const Unit& u, int wr, int wc, int fr, int fq) const {
#pragma unroll
        for (int ai = 0; ai < 2; ++ai)
#pragma unroll
            for (int m = 0; m < 4; ++m) { const int rr = TROW(ai, wr, m, fr); size_t frow;
                if (u.aux < 256) { const int b = u.aux >> 4, kq = u.aux & 15, k = 4 * kq + (rr >> 6) + 64 * (rr & 63); frow = (size_t)NC + b * SEQ + k; }
                else frow = (size_t)(u.aux - 256) * LCTX + rr;
#pragma unroll
                for (int bj = 0; bj < 2; ++bj) { const int col = u.pn * 256 + TCOLP(bj, wc, fq); *(v4u*)(F + frow * D + col) = pack8(acc[ai][bj][m][0], acc[ai][bj][m][1]); } }
    }
};

struct PolMlaQ {
    static constexpr bool PERM = true;
    static constexpr bool KEYS = false;
    static constexpr bool I8 = false;
    static constexpr bool F8 = false;
    __device__ __forceinline__ const int* key_ptr(const Unit&, int) const { return nullptr; }
    const char* A; const char* B; int nt; int nM, nN, G, c; bf16* Q; const float* rope; float c2;
    __device__ __forceinline__ bool next(int i, Unit& u) const { int pm, pn; if (!pg8::static_next(i, G, c, nM, nN, pm, pn)) return false; u.pm = pm; u.pn = pn; u.aux = 0; return true; }
    __device__ __forceinline__ unsigned a_row(const Unit& u, int r, int) const { return (unsigned)(u.pm * 256 + r) * (unsigned)(MLA_QL * 2); }
    __device__ __forceinline__ unsigned b_row(const Unit& u, int r) const { return (unsigned)(u.pn * 256 + r) * (unsigned)(MLA_QL * 2); }
    __device__ __forceinline__ void epi(const pg8::Acc& acc, const Unit& u, int wr, int wc, int fr, int fq) const {
        const bool lat = u.pm >= 8;
#pragma unroll
        for (int bj = 0; bj < 2; ++bj) { const int col = u.pn * 256 + TCOLP(bj, wc, fq); const bool isrope = lat && (((col >> 5) % 3) == 2);
#pragma unroll
            for (int ai = 0; ai < 2; ++ai)
#pragma unroll
                for (int m = 0; m < 4; ++m) { const int row = u.pm * 256 + TROW(ai, wr, m, fr); f32x4 v0 = acc[ai][bj][m][0], v1 = acc[ai][bj][m][1];
                    if (isrope) { const int t = (row - NC) & 4095, pos = (fq & 2) ? (t & 63) : (t >> 6);
                        const f32x4* rp = (const f32x4*)(rope + (size_t)pos * 16);
                        const f32x4 r0 = rp[0], r1 = rp[1], r2 = rp[2], r3 = rp[3];
                        f32x4 p0, p1;
#pragma unroll
                        for (int e = 0; e < 4; ++e) { p0[e] = shx(v0[e], 16, fq * 16 + fr); p1[e] = shx(v1[e], 16, fq * 16 + fr); }
                        const float sg = (fq & 1) ? 1.f : -1.f;
                        v0[0] = v0[0] * r0[0] + sg * p0[0] * r0[1]; v0[1] = v0[1] * r0[2] + sg * p0[1] * r0[3];
                        v0[2] = v0[2] * r1[0] + sg * p0[2] * r1[1]; v0[3] = v0[3] * r1[2] + sg * p0[3] * r1[3];
                        v1[0] = v1[0] * r2[0] + sg * p1[0] * r2[1]; v1[1] = v1[1] * r2[2] + sg * p1[1] * r2[3];
                        v1[2] = v1[2] * r3[0] + sg * p1[2] * r3[1]; v1[3] = v1[3] * r3[2] + sg * p1[3] * r3[3]; }
                    *(v4u*)(Q + (size_t)row * 1536 + col) = pack8(v0 * c2, v1 * c2); } }
    }
};

struct PolMlaKV {
    static constexpr bool PERM = true;
    static constexpr bool KEYS = false;
    static constexpr bool I8 = false;
    static constexpr bool F8 = false;
    __device__ __forceinline__ const int* key_ptr(const Unit&, int) const { return nullptr; }
    const char* A; const char* B; int nt; int nM, nN, G, c; bf16* Kb; bf16* Vb;
    __device__ __forceinline__ bool next(int i, Unit& u) const { int pm, pn; if (!pg8::static_next(i, G, c, nM, nN, pm, pn)) return false; u.pm = pm; u.pn = pn; u.aux = 0; return true; }
    __device__ __forceinline__ unsigned a_row(const Unit& u, int r, int) const { return (unsigned)(u.pm * 256 + r) * 512u; }
    __device__ __forceinline__ unsigned b_row(const Unit& u, int r) const { return (unsigned)(u.pn * 256 + r) * 512u; }
    __device__ __forceinline__ void epi(const pg8::Acc& acc, const Unit& u, int wr, int wc, int fr, int fq) const {
#pragma unroll
        for (int bj = 0; bj < 2; ++bj) { const int col = u.pn * 256 + TCOLP(bj, wc, fq), h = col >> 7, j = col & 127;
#pragma unroll
            for (int ai = 0; ai < 2; ++ai)
#pragma unroll
                for (int m = 0; m < 4; ++m) { const size_t row = (size_t)u.pm * 256 + TROW(ai, wr, m, fr); const v4u w = pack8(acc[ai][bj][m][0], acc[ai][bj][m][1]);
                    if (j < 64) *(v4u*)(Kb + row * 1536 + 96 * h + j) = w; else *(v4u*)(Vb + row * 1024 + 64 * h + (j - 64)) = w; } }
    }
};

struct MoeTab { const LAS int* TT; const LAS int* CN; const LAS int* TE; };
__device__ __forceinline__ bool moe_next(int i, int G, int c, int NP, const MoeTab& T, Unit& u) {
    const int ttot = T.TT[32];
    int lo, hi, j;
    if ((G & 7) == 0) { const int x = c & 7, q = c >> 3, g8 = G >> 3; lo = (x * ttot) >> 3; hi = ((x + 1) * ttot) >> 3; j = i * g8 + q; }
    else { lo = 0; hi = ttot; j = i * G + c; }
    if (j >= (hi - lo) * NP) return false;
    const int tile = lo + j / NP; u.pn = j % NP; u.pm = tile;
    const int e = T.TE[tile];
    u.aux = e | ((tile - T.TT[e]) << 8);
    return true;
}
struct PolMoe1 {
    static constexpr bool PERM = true;
    static constexpr bool I8 = true;
    static constexpr bool F8 = false;
    const char* A; const char* B; int nt; int G, c; MoeTab T; const int* stok; const float* bgu; const float* swgu; const float* ssc; unsigned char* act;
    __device__ __forceinline__ bool next(int i, Unit& u) const { return moe_next(i, G, c, 8, T, u); }
    static constexpr bool KEYS = true;
    __device__ __forceinline__ const int* key_ptr(const Unit& u, int r) const { const int e = u.aux & 255, idx = (u.aux >> 8) * 256 + r; const int cn = T.CN[e]; return stok + (size_t)e * CAP + (idx < cn ? idx : 0); }
    __device__ __forceinline__ unsigned a_row(const Unit&, int, int key) const { return (unsigned)key * 1024u; }
    __device__ __forceinline__ unsigned b_row(const Unit& u, int r) const { return (unsigned)((u.aux & 255) * 2048 + u.pn * 256 + r) * 1024u; }
    __device__ __forceinline__ void epi(const pg8::AccI& acc, const Unit& u, int wr, int wc, int fr, int fq) const {
        const int e = u.aux & 255, mt = u.aux >> 8, cn = T.CN[e]; const int jl = 32 * wc + 8 * fq;
        const float* bg = bgu + (size_t)e * 2048 + u.pn * 256 + jl;
        const float* sg = swgu + (size_t)e * 2048 + u.pn * 256 + jl;
        const f32x4 bg0 = *(const f32x4*)(bg), bg1 = *(const f32x4*)(bg + 4), bu0 = *(const f32x4*)(bg + 128), bu1 = *(const f32x4*)(bg + 132);
        const f32x4 sg0 = *(const f32x4*)(sg), sg1 = *(const f32x4*)(sg + 4), su0 = *(const f32x4*)(sg + 128), su1 = *(const f32x4*)(sg + 132);
#pragma unroll
        for (int ai = 0; ai < 2; ++ai)
#pragma unroll
            for (int m = 0; m < 4; ++m) { const int rr = TROW(ai, wr, m, fr), idx = mt * 256 + rr; const size_t slot = (size_t)u.pm * 256 + rr;
                const float sa = ssc[(size_t)e * CAP + (idx < cn ? idx : 0)];
                f32x4 g0, g1, u0, u1, o0, o1;
#pragma unroll
                for (int q = 0; q < 4; ++q) { g0[q] = (float)acc[ai][0][m][0][q] * (sa * sg0[q]) + bg0[q]; g1[q] = (float)acc[ai][0][m][1][q] * (sa * sg1[q]) + bg1[q];
                    u0[q] = (float)acc[ai][1][m][0][q] * (sa * su0[q]) + bu0[q]; u1[q] = (float)acc[ai][1][m][1][q] * (sa * su1[q]) + bu1[q]; }
#pragma unroll
                for (int q = 0; q < 4; ++q) {
                    float ga = fminf(g0[q], 7.f), ua = fminf(fmaxf(u0[q], -7.f), 7.f); o0[q] = (ua + 1.f) * ga * __builtin_amdgcn_rcpf(1.f + __builtin_amdgcn_exp2f(-1.702f * LOG2E * ga));
                    float gb = fminf(g1[q], 7.f), ub = fminf(fmaxf(u1[q], -7.f), 7.f); o1[q] = (ub + 1.f) * gb * __builtin_amdgcn_rcpf(1.f + __builtin_amdgcn_exp2f(-1.702f * LOG2E * gb)); }
                v2u w8; { int t0 = __builtin_amdgcn_cvt_pk_fp8_f32(o0[0], o0[1], 0, false); t0 = __builtin_amdgcn_cvt_pk_fp8_f32(o0[2], o0[3], t0, true);
                          int t1 = __builtin_amdgcn_cvt_pk_fp8_f32(o1[0], o1[1], 0, false); t1 = __builtin_amdgcn_cvt_pk_fp8_f32(o1[2], o1[3], t1, true); w8.x = (unsigned)t0; w8.y = (unsigned)t1; }
                *(v2u*)(act + slot * 1024 + u.pn * 128 + jl) = w8; }
    }
};
struct PolMoe2 {
    static constexpr bool PERM = true;
    static constexpr bool KEYS = false;
    static constexpr bool I8 = false;
    static constexpr bool F8 = true;
    __device__ __forceinline__ const int* key_ptr(const Unit&, int) const { return nullptr; }
    const char* A; const char* B; int nt; int G, c; MoeTab T; const float* sw; const float* bdn; const float* swd; bf16* Y;
    __device__ __forceinline__ bool next(int i, Unit& u) const { return moe_next(i, G, c, 4, T, u); }
    __device__ __forceinline__ unsigned a_row(const Unit& u, int r, int) const { return (unsigned)(u.pm * 256 + r) * 1024u; }
    __device__ __forceinline__ unsigned b_row(const Unit& u, int r) const { return (unsigned)((u.aux & 255) * 1024 + u.pn * 256 + r) * 1024u; }
    __device__ __forceinline__ void epi(const pg8::Acc& acc, const Unit& u, int wr, int wc, int fr, int fq) const {
        const int e = u.aux & 255, mt = u.aux >> 8, cn = T.CN[e];
#pragma unroll
        for (int bj = 0; bj < 2; ++bj) { const int col = u.pn * 256 + TCOLP(bj, wc, fq); const size_t ci = (size_t)e * 1024 + col;
            const f32x4 b0 = *(const f32x4*)(bdn + ci), b1 = *(const f32x4*)(bdn + ci + 4), s0 = *(const f32x4*)(swd + ci), s1 = *(const f32x4*)(swd + ci + 4);
#pragma unroll
            for (int ai = 0; ai < 2; ++ai)
#pragma unroll
                for (int m = 0; m < 4; ++m) { const int rr = TROW(ai, wr, m, fr), idx = mt * 256 + rr; const size_t slot = (size_t)u.pm * 256 + rr; const float w = sw[(size_t)e * CAP + (idx < cn ? idx : 0)];
                    *(v4u*)(Y + slot * 1024 + col) = pack8((acc[ai][bj][m][0] * s0 + b0) * w, (acc[ai][bj][m][1] * s1 + b1) * w); } }
    }
};

namespace att {
__device__ __forceinline__ int crow(int r, int hi) { return (r & 3) + 8 * (r >> 2) + 4 * hi; }
__device__ __forceinline__ float max3f(float a, float b, float c) { return fmaxf(fmaxf(a, b), c); }
typedef LAS const char* lds_cptr;
constexpr int LK = 0, LV = 49152, LWS = 90112, LOST = 92160, LBYTES = 124928;
constexpr int PD = 3;
struct Tens { const bf16* Q; int qpitch; const bf16* K; int kpitch; const bf16* V; int vpitch; bf16* O; };
#define ATT_WAITV(n) asm volatile("s_waitcnt vmcnt(" #n ")" ::: "memory")
struct Pend { f32x16 o0, o1; float l; int qrow0, oc0; bool valid; };
__device__ __forceinline__ void finish_unit(const Pend& P, bf16* O, LAS unsigned char* lds, int wid, int lane) {
    const int r32 = lane & 31, hi = lane >> 5;
    LAS float* wsf = (LAS float*)(lds + LWS) + wid * 64;
    float lrun = P.l;
    { auto rr = __builtin_amdgcn_permlane32_swap(__float_as_uint(lrun), __float_as_uint(lrun), false, false); lrun = __uint_as_float(rr[0]) + __uint_as_float(rr[1]); }
    if (hi == 0) wsf[32 + r32] = lrun;
    LDS_WAIT();
    LAS bf16* stg = (LAS bf16*)(lds + LOST) + wid * 2048;
#pragma unroll
    for (int r = 0; r < 16; ++r) { const int orow = crow(r, hi); const float rl = __builtin_amdgcn_rcpf(wsf[32 + orow]);
        stg[orow * 64 + r32] = (bf16)(pk2(P.o0[r] * rl, 0.f) & 0xffffu); stg[orow * 64 + 32 + r32] = (bf16)(pk2(P.o1[r] * rl, 0.f) & 0xffffu); }
    LDS_WAIT();
    bf16* Ow = O + (size_t)(P.qrow0 + wid * 32) * 1024 + P.oc0;
#pragma unroll
    for (int i = 0; i < 4; ++i) { const int row = i * 8 + (lane >> 3), ch = lane & 7; const v4u v = *(const LAS v4u*)(stg + row * 64 + ch * 8); *(v4u*)(Ow + (size_t)row * 1024 + ch * 8) = v; }
    LDS_WAIT();
}
template <int DK>
__device__ __forceinline__ void unit(const Tens& T, int qrow0, int qc0, int kc0, int vc0, int oc0, int kctx0, int klat0, int NTL, LAS unsigned char* lds, int wave_id, Pend& pend) {
    constexpr int ND = DK / 16;
    wave_id = launder_s(wave_id); const int tid = lthread_w(wave_id), lane = tid & 63, r32 = lane & 31, hi = lane >> 5; const int wid = wave_id;
    LAS float* wsf = (LAS float*)(lds + LWS) + wid * 64;
    const bf16* ksrc = T.K + (size_t)lane * T.kpitch + kc0 + wid * 8;
    const int k2off = (8 + (wid & 3) - wid) * 8;
    const bf16* vsrc = T.V + (size_t)(16 * (wid & 3) + (lane >> 2)) * T.vpitch + vc0 + (wid >> 2) * 32 + (lane & 3) * 8;
#define ATT_DMA(t, ks_, vs_) do { const size_t row0_ = (size_t)((t) < 4 ? kctx0 + 64 * (t) : klat0 + 64 * ((t) - 4)); \
        __builtin_amdgcn_global_load_lds((const unsigned*)(ksrc + row0_ * T.kpitch), (LAS unsigned*)(lds + LK + (ks_) * 12288 + wid * 1024), 16, 0, 0); \
        if (DK > 64) __builtin_amdgcn_global_load_lds((const unsigned*)(ksrc + row0_ * T.kpitch + k2off), (LAS unsigned*)(lds + LK + (ks_) * 12288 + 8192 + (wid & 3) * 1024), 16, 0, 0); \
        __builtin_amdgcn_global_load_lds((const unsigned*)(vsrc + row0_ * T.vpitch), (LAS unsigned*)(lds + LV + (vs_) * 8192 + wid * 1024), 16, 0, 0); } while (0)
#define ATT_WAIT_TILES(n_tiles) do { if (DK > 64) { if ((n_tiles) >= 2) ATT_WAITV(6); else if ((n_tiles) == 1) ATT_WAITV(3); else ATT_WAITV(0); } \
        else { if ((n_tiles) >= 2) ATT_WAITV(4); else if ((n_tiles) == 1) ATT_WAITV(2); else ATT_WAITV(0); } } while (0)
    bf16x8 qr[ND];
    { const bf16* qp = T.Q + (size_t)(qrow0 + wid * 32 + r32) * T.qpitch + qc0 + hi * 8;
#pragma unroll
      for (int d0 = 0; d0 < ND; ++d0) qr[d0] = *(const bf16x8*)(qp + d0 * 16); }
    asm volatile("" ::: "memory");
    constexpr float THR = 8.f;
    const int half = wid >> 2;
    float mhat = 0.f, lrun = 0.f; f32x16 o[2]; o[0] = f32x16{}; o[1] = f32x16{}; f32x16 negm = f32x16{};
    f32x16 p0 = f32x16{}, p1 = f32x16{}; v4u pw[4]; pw[0] = pw[1] = pw[2] = pw[3] = (v4u){0u, 0u, 0u, 0u};
    ATT_DMA(0, 0, 0); ATT_DMA(1, 1, 1); ATT_DMA(2, 2, 2);
    if (pend.valid) finish_unit(pend, T.O, lds, wid, lane);
    ATT_WAIT_TILES(2);
    __builtin_amdgcn_s_barrier(); asm volatile("" ::: "memory");
    if (half == 1) __builtin_amdgcn_s_barrier();
    int vs_prev = 0, vs_cur = 0, vs_iss = 3;
    for (int t = 0; t <= NTL; ++t) {
        if (t >= 1) {
            s16x4 lo[2][4], hh[2][4];
            const unsigned vb = (unsigned)(uintptr_t)(lds + LV + vs_prev * 8192) + ((lane >> 4) & 1) * 32 + (lane & 3) * 8 + (4 * hi + ((lane & 15) >> 2)) * 64;
#pragma unroll
            for (int d0 = 0; d0 < 2; ++d0)
#pragma unroll
                for (int ks = 0; ks < 4; ++ks) {
                    asm volatile("ds_read_b64_tr_b16 %0,%1 offset:%c2" : "=&v"(lo[d0][ks]) : "v"(vb), "i"(d0 * 4096 + ks * 1024) : "memory");
                    asm volatile("ds_read_b64_tr_b16 %0,%1 offset:%c2" : "=&v"(hh[d0][ks]) : "v"(vb), "i"(d0 * 4096 + ks * 1024 + 512) : "memory"); }
            asm volatile("s_waitcnt lgkmcnt(0)" ::: "memory"); __builtin_amdgcn_sched_barrier(0);
#pragma unroll
            for (int ks = 0; ks < 4; ++ks)
#pragma unroll
                for (int d0 = 0; d0 < 2; ++d0) { const bf16x8 vf = (bf16x8){lo[d0][ks][0], lo[d0][ks][1], lo[d0][ks][2], lo[d0][ks][3], hh[d0][ks][0], hh[d0][ks][1], hh[d0][ks][2], hh[d0][ks][3]};
                    o[d0] = __builtin_amdgcn_mfma_f32_32x32x16_bf16(__builtin_bit_cast(bf16x8, pw[ks]), vf, o[d0], 0, 0, 0); }
        }
        if (t < NTL) {
            bf16x8 kf[2 * ND];
            const lds_cptr kb = (lds_cptr)(lds + LK + (t & 3) * 12288) + hi * 1024 + r32 * 16;
#pragma unroll
            for (int d0 = 0; d0 < ND; ++d0) { kf[2 * d0] = *(const LAS bf16x8*)(kb + d0 * 2048); kf[2 * d0 + 1] = *(const LAS bf16x8*)(kb + d0 * 2048 + 512); }
            asm volatile("s_waitcnt lgkmcnt(0)" ::: "memory"); __builtin_amdgcn_sched_barrier(0);
#pragma unroll
            for (int d0 = 0; d0 < ND; ++d0) {
                if (d0 == 0) { p0 = __builtin_amdgcn_mfma_f32_32x32x16_bf16(kf[0], qr[0], negm, 0, 0, 0); p1 = __builtin_amdgcn_mfma_f32_32x32x16_bf16(kf[1], qr[0], negm, 0, 0, 0); }
                else { p0 = __builtin_amdgcn_mfma_f32_32x32x16_bf16(kf[2 * d0], qr[d0], p0, 0, 0, 0); p1 = __builtin_amdgcn_mfma_f32_32x32x16_bf16(kf[2 * d0 + 1], qr[d0], p1, 0, 0, 0); } }
        }
        if (half == 1) {
            const int last_iss = (t + PD - 1 < NTL - 1) ? t + PD - 1 : NTL - 1; const int allow = last_iss - (t + 1);
            if (allow >= 1) ATT_WAIT_TILES(1); else ATT_WAIT_TILES(0); }
        asm volatile("s_waitcnt lgkmcnt(0)" ::: "memory"); __builtin_amdgcn_s_barrier(); asm volatile("" ::: "memory");
        if (t < NTL) {
            float rm = max3f(p0[0], p0[1], p1[0]);
#pragma unroll
            for (int r = 0; r < 16; ++r) rm = max3f(rm, p0[r], p1[r]);
            { auto rr = __builtin_amdgcn_permlane32_swap(__float_as_uint(rm), __float_as_uint(rm), false, false); rm = fmaxf(__uint_as_float(rr[0]), __uint_as_float(rr[1])); }
            if (t == 0 || __any(rm > THR)) {
                const float dl = (t == 0) ? rm : fmaxf(rm, 0.f);
                mhat += dl;
#pragma unroll
                for (int r = 0; r < 16; ++r) { p0[r] -= dl; p1[r] -= dl; negm[r] = -mhat; }
                const float f = (t == 0) ? 1.f : __builtin_amdgcn_exp2f(-dl); lrun *= f;
                if (hi == 0) wsf[r32] = f;
                LDS_WAIT();
#pragma unroll
                for (int r = 0; r < 16; ++r) { const float a = wsf[crow(r, hi)]; o[0][r] *= a; o[1][r] *= a; }
            }
            float rs = 0.f;
#pragma unroll
            for (int r = 0; r < 16; ++r) { p0[r] = __builtin_amdgcn_exp2f(p0[r]); p1[r] = __builtin_amdgcn_exp2f(p1[r]); rs += p0[r] + p1[r]; }
            lrun += rs;
            pw[0] = (v4u){pk2(p0[0], p0[1]), pk2(p0[2], p0[3]), pk2(p0[4], p0[5]), pk2(p0[6], p0[7])};
            pw[1] = (v4u){pk2(p0[8], p0[9]), pk2(p0[10], p0[11]), pk2(p0[12], p0[13]), pk2(p0[14], p0[15])};
            pw[2] = (v4u){pk2(p1[0], p1[1]), pk2(p1[2], p1[3]), pk2(p1[4], p1[5]), pk2(p1[6], p1[7])};
            pw[3] = (v4u){pk2(p1[8], p1[9]), pk2(p1[10], p1[11]), pk2(p1[12], p1[13]), pk2(p1[14], p1[15])};
        }
        if (t + PD < NTL) { ATT_DMA(t + PD, (t + PD) & 3, vs_iss); vs_iss = (vs_iss == 4) ? 0 : vs_iss + 1; }
        if (half == 0) {
            const int last_iss = (t + PD < NTL - 1) ? t + PD : NTL - 1; const int allow = last_iss - (t + 1);
            if (allow >= 2) ATT_WAIT_TILES(2); else if (allow == 1) ATT_WAIT_TILES(1); else ATT_WAIT_TILES(0); }
        vs_prev = vs_cur; vs_cur = (vs_cur == 4) ? 0 : vs_cur + 1;
        asm volatile("s_waitcnt lgkmcnt(0)" ::: "memory"); __builtin_amdgcn_s_barrier(); asm volatile("" ::: "memory");
    }
    if (half == 0) __builtin_amdgcn_s_barrier();
#undef ATT_DMA
#undef ATT_WAIT_TILES
    pend.o0 = o[0]; pend.o1 = o[1]; pend.l = lrun; pend.qrow0 = qrow0; pend.oc0 = oc0; pend.valid = true;
}
#undef ATT_WAITV
}

struct Args { const float* in[27]; float* out; unsigned char* ws; int ph_lo, ph_hi; };
struct Frame {
    LAS unsigned char* lds; unsigned char* ws; gu32* ctl; int wave, G, gw, NGW;
};
__device__ __forceinline__ int lthread(int wave) { return wave * 64 + lane_id_v(); }

template <int MODE>
__device__ __forceinline__ void conv_item(const float* W, int K, int N, bf16* WT, LAS float* scr, int item, int lane) {
    const int nblk = (N + 63) / 64, kb = item / nblk, nb = item % nblk, k0 = 64 * kb, n0 = 64 * nb;
    f32x4 v[16];
    const int cc = (lane & 15) * 4, rk = lane >> 4;
    const bool ok = (n0 + cc) < N;
#pragma unroll
    for (int i = 0; i < 16; ++i) v[i] = ok ? *(const f32x4*)(W + (size_t)(k0 + 4 * i + rk) * N + n0 + cc) : (f32x4){0.f, 0.f, 0.f, 0.f};
#pragma unroll
    for (int i = 0; i < 16; ++i) { LAS float* s = scr + (4 * i + rk) * 65 + cc; s[0] = v[i][0]; s[1] = v[i][1]; s[2] = v[i][2]; s[3] = v[i][3]; }
    LDS_WAIT(); asm volatile("" ::: "memory");
    const int c = lane & 7;
#pragma unroll
    for (int j = 0; j < 8; ++j) { const int n = (lane >> 3) + 8 * j; const LAS float* s = scr + (8 * c) * 65 + n;
        v4u o; o.x = pk2(s[0], s[65]); o.y = pk2(s[2 * 65], s[3 * 65]); o.z = pk2(s[4 * 65], s[5 * 65]); o.w = pk2(s[6 * 65], s[7 * 65]);
        const int ng = n0 + n; if (ng < N) { const int dr = (MODE == 1) ? ((ng >> 8) * 256 + (ng & 1) * 128 + ((ng >> 1) & 127)) : ng; *(v4u*)(WT + (size_t)dr * K + k0 + 8 * c) = o; } }
    LDS_WAIT(); asm volatile("" ::: "memory");
}

__device__ __forceinline__ void prologue(Frame& F, const Args& a) {
    const int f_tid = lthread(F.wave), f_lane = f_tid & 63;
    unsigned char* ws = F.ws;
    {
        LAS float* scr = (LAS float*)(F.lds + F.wave * 16640);
        struct M { const float* src; int K, N; size_t dst; };
        const int I_FO = 16 * 16, I_MIN = 16 * 11, I_QB = 6 * 24, I_KVB = 4 * 32, I_MO = 256, I_GQKV = 16 * 24, I_GO = 256;
        const int NSMALL = 2 * I_FO + I_MIN + I_QB + I_KVB + I_MO + I_GQKV + I_GO;
        for (int it = F.gw; it < NSMALL; it += F.NGW) {
            int r = it;
            if (r < 2 * I_FO) { const int j = r / I_FO; conv_item<0>(a.in[10] + (size_t)j * D * D, D, D, (bf16*)(ws + WS_WFOUT) + (size_t)j * D * D, scr, r % I_FO, f_lane); continue; } r -= 2 * I_FO;
            if (r < I_MIN) { conv_item<0>(a.in[11], D, MLA_IN, (bf16*)(ws + WS_WMIN), scr, r, f_lane); continue; } r -= I_MIN;
            if (r < I_QB) { conv_item<0>(a.in[13], MLA_QL, 1536, (bf16*)(ws + WS_WMQB), scr, r, f_lane); continue; } r -= I_QB;
            if (r < I_KVB) { conv_item<0>(a.in[15], MLA_KVL, 2048, (bf16*)(ws + WS_WMKVB), scr, r, f_lane); continue; } r -= I_KVB;
            if (r < I_MO) { conv_item<0>(a.in[16], D, D, (bf16*)(ws + WS_WMO), scr, r, f_lane); continue; } r -= I_MO;
            if (r < I_GQKV) { conv_item<0>(a.in[17], D, GQA_QKV, (bf16*)(ws + WS_WGQKV), scr, r, f_lane); continue; } r -= I_GQKV;
            conv_item<0>(a.in[20], D, D, (bf16*)(ws + WS_WGO), scr, r, f_lane);
        }
    }
    __syncthreads();
    {
        LAS float* cmax = (LAS float*)F.lds;
        LAS float* cinv = cmax + 512;
        LAS unsigned* scr8 = (LAS unsigned*)(F.lds + 4096) + F.wave * (64 * 33);
        const int cc = (f_lane & 15) * 4, rk = f_lane >> 4;
        constexpr int NGU = DEPTH * NE * 32, NDN = DEPTH * NE * 16;
        for (int it = blockIdx.x; it < NGU + NDN; it += F.G) {
            const bool dn = it >= NGU; const int q_ = dn ? it - NGU : it; const int le = dn ? (q_ >> 4) : (q_ >> 5), strip = dn ? (q_ & 15) : (q_ & 31);
            const int N = dn ? 1024 : 2048;
            const float* W = (dn ? a.in[25] + (size_t)le * DFF * D : a.in[23] + (size_t)le * D * 2048) + strip * 64 + cc;
            f32x4 v[32];
#pragma unroll
            for (int i = 0; i < 32; ++i) v[i] = *(const f32x4*)(W + (size_t)(F.wave * 128 + 16 * (i >> 2) + 4 * rk + (i & 3)) * N);
            f32x4 mx = (f32x4){0.f, 0.f, 0.f, 0.f};
#pragma unroll
            for (int i = 0; i < 32; ++i) { mx[0] = fmaxf(mx[0], fabsf(v[i][0])); mx[1] = fmaxf(mx[1], fabsf(v[i][1])); mx[2] = fmaxf(mx[2], fabsf(v[i][2])); mx[3] = fmaxf(mx[3], fabsf(v[i][3])); }
#pragma unroll
            for (int q = 0; q < 4; ++q) { mx[q] = fmaxf(mx[q], shx(mx[q], 16, f_lane)); mx[q] = fmaxf(mx[q], shx(mx[q], 32, f_lane)); }
            __syncthreads();
            if (rk == 0) { LAS float* d = cmax + F.wave * 64 + cc; d[0] = mx[0]; d[1] = mx[1]; d[2] = mx[2]; d[3] = mx[3]; }
            __syncthreads();
            const float target = dn ? 240.f : 127.f;
            if (f_tid < 64) { float m8 = 0.f;
#pragma unroll
                for (int w = 0; w < 8; ++w) m8 = fmaxf(m8, cmax[w * 64 + f_tid]);
                const int ng = strip * 64 + f_tid, dr = dn ? ng : (ng >> 8) * 256 + (ng & 1) * 128 + ((ng >> 1) & 127);
                float* sc = dn ? (float*)(ws + WS_SWDN) + (size_t)le * 1024 : (float*)(ws + WS_SWGU) + (size_t)le * 2048;
                sc[dr] = (m8 > 0.f) ? m8 / target : 1.f;
                cinv[f_tid] = (m8 > 0.f) ? target / m8 : 0.f; }
            __syncthreads();
            const f32x4 iv = *(const LAS f32x4*)(cinv + cc);
#pragma unroll
            for (int ip = 0; ip < 8; ++ip) {
#pragma unroll
                for (int q = 0; q < 4; ++q) { unsigned w = 0;
                    if (dn) { int t = __builtin_amdgcn_cvt_pk_fp8_f32(v[4 * ip][q] * iv[q], v[4 * ip + 1][q] * iv[q], 0, false); t = __builtin_amdgcn_cvt_pk_fp8_f32(v[4 * ip + 2][q] * iv[q], v[4 * ip + 3][q] * iv[q], t, true); w = (unsigned)t; }
                    else {
#pragma unroll
                        for (int j = 0; j < 4; ++j) { int qi = __float2int_rn(v[4 * ip + j][q] * iv[q]); qi = qi > 127 ? 127 : (qi < -127 ? -127 : qi); w |= ((unsigned)qi & 255u) << (8 * j); } }
                    scr8[(cc + q) * 33 + 4 * ip + rk] = w; } }
            LDS_WAIT(); asm volatile("" ::: "memory");
            { const int c8 = f_lane & 7;
              unsigned char* dst = dn ? (unsigned char*)(ws + WS_WDN) + (size_t)le * 1024 * 1024 : (unsigned char*)(ws + WS_WGU) + (size_t)le * 2048 * 1024;
#pragma unroll
              for (int jp = 0; jp < 8; ++jp) { const int n = (f_lane >> 3) + 8 * jp; const LAS unsigned* sp = scr8 + n * 33 + 4 * c8;
                  v4u o; o.x = sp[0]; o.y = sp[1]; o.z = sp[2]; o[3] = sp[3];
                  const int ng = strip * 64 + n, dr = dn ? ng : (ng >> 8) * 256 + (ng & 1) * 128 + ((ng >> 1) & 127);
                  *(v4u*)(dst + (size_t)dr * 1024 + F.wave * 128 + 16 * c8) = o; } }
            LDS_WAIT(); asm volatile("" ::: "memory");
        }
        __syncthreads();
    }
    const int gtid = blockIdx.x * 512 + f_tid, gthreads = F.G * 512;
    for (int i = gtid; i < (MLA_IN_PAD - MLA_IN) * D / 8; i += gthreads) ((v4u*)((bf16*)(ws + WS_WMIN) + (size_t)MLA_IN * D))[i] = (v4u){0u, 0u, 0u, 0u};
    {
        bf16* MA = (bf16*)(ws + WS_MA);
        for (int i = gtid; i < 256 * 256; i += gthreads) { const int row = i >> 8, col = i & 255, jp = row >> 7, pp = (row >> 6) & 1, k1 = row & 63, j = col >> 7, pt = (col >> 6) & 1, l1 = col & 63;
            float v = 0.f; if (j == jp) { const float x = 2.f * (float)((k1 * l1) & 63) / 64.f; const float cs = cospif(x), sn = sinpif(x); v = (pp == 0) ? (pt == 0 ? cs : sn) : (pt == 0 ? -sn : cs); }
            MA[i] = (bf16)(pk2(v, 0.f) & 0xffffu); }
        bf16* DC = (bf16*)(ws + WS_DC); const float sc = 1.0f / sqrtf(256.f * 128.f);
        for (int i = gtid; i < 256 * 512; i += gthreads) { const int k = i >> 9, col = i & 511, pt = col >> 8, l = col & 255; const float x = 2.f * (float)((k * l) & 255) / 256.f;
            const float v = (pt == 0 ? cospif(x) : sinpif(x)) * sc; DC[i] = (bf16)(pk2(v, 0.f) & 0xffffu); }
        bf16* MC = (bf16*)(ws + WS_MC); const float sl = 1.0f / sqrtf(4096.f * 128.f);
        for (int i = gtid; i < 16 * 256 * 512; i += gthreads) { const int kq = i >> 17, row = (i >> 9) & 255, col = i & 511, kkp = row >> 6, k2 = row & 63, kk = col >> 7, pp = (col >> 6) & 1, l2 = col & 63;
            float v = 0.f; if (kk == kkp) { const int k = 4 * kq + kkp + 64 * k2; const float x = 2.f * (float)((l2 * k) & 4095) / 4096.f; v = (pp == 0 ? cospif(x) : sinpif(x)) * sl; }
            MC[i] = (bf16)(pk2(v, 0.f) & 0xffffu); }
        float* RM = (float*)(ws + WS_ROPE); float* RG = RM + 2048;
        for (int i = gtid; i < 64 * 8; i += gthreads) { const int pos = i >> 3, f = i & 7; const float inv = powf(10000.f, -(float)f / 8.f); float s, c; sincosf((float)pos * inv, &s, &c); RM[2 * i] = c; RM[2 * i + 1] = s; }
        for (int i = gtid; i < 64 * 16; i += gthreads) { const int pos = i >> 4, f = i & 15; const float inv = powf(10000.f, -(float)f / 16.f); float s, c; sincosf((float)pos * inv, &s, &c); RG[2 * i] = c; RG[2 * i + 1] = s; }
        float* WRT = (float*)(ws + WS_WRT);
        for (int i = gtid; i < DEPTH * NE * D; i += gthreads) { const int l = i >> 15, e = (i >> 10) & 31, k = i & 1023; WRT[i] = a.in[21][((size_t)l * D + k) * NE + e]; }
        float* BG = (float*)(ws + WS_BGU);
        for (int i = gtid; i < DEPTH * NE * 2048; i += gthreads) { const int le = i >> 11, q = i & 2047, pn = q >> 8, s = (q >> 7) & 1, jj = q & 127; BG[i] = a.in[24][(size_t)le * 2048 + 2 * (pn * 128 + jj) + s]; }
    }
    __syncthreads();
    {
        LAS float* wl = (LAS float*)F.lds;
        LAS float* tc = wl + 2048; LAS float* ts = tc + 128;
        if (f_tid < 128) { const float x = 2.f * (float)f_tid / 128.f; tc[f_tid] = cospif(x); ts[f_tid] = -sinpif(x); }
        for (int it = blockIdx.x; it < 2 * 8 * 64; it += F.G) { const int j = it >> 9, g = (it >> 6) & 7, kb = it & 63;
            __syncthreads();
            { const int kk = f_tid >> 5, c4 = (f_tid & 31) * 4; const f32x4 w = *(const f32x4*)(a.in[9] + ((size_t)j * D + kb * 16 + kk) * D + g * 128 + c4);
              LAS float* d = wl + c4 * 16 + kk; d[0] = w[0]; d[16] = w[1]; d[32] = w[2]; d[48] = w[3]; }
            __syncthreads();
            const int cl = f_tid & 255, m = cl >> 1, part = cl & 1, kh = f_tid >> 8; const LAS float* tw = part ? ts : tc;
            float accv[8];
#pragma unroll
            for (int q = 0; q < 8; ++q) accv[q] = 0.f;
            for (int jj = 0; jj < 128; ++jj) { const float t = tw[(m * jj) & 127]; const f32x4 wa = *(const LAS f32x4*)(wl + jj * 16 + kh * 8), wb = *(const LAS f32x4*)(wl + jj * 16 + kh * 8 + 4);
                accv[0] += wa[0] * t; accv[1] += wa[1] * t; accv[2] += wa[2] * t; accv[3] += wa[3] * t; accv[4] += wb[0] * t; accv[5] += wb[1] * t; accv[6] += wb[2] * t; accv[7] += wb[3] * t; }
            v4u o; o.x = pk2(accv[0], accv[1]); o.y = pk2(accv[2], accv[3]); o.z = pk2(accv[4], accv[5]); o.w = pk2(accv[6], accv[7]);
            *(v4u*)((bf16*)(ws + WS_WFIN) + ((size_t)j * 2048 + g * 256 + cl) * D + kb * 16 + kh * 8) = o;
        }
        __syncthreads();
    }
    {
        LAS float* S = (LAS float*)F.lds;
        LAS float* red = S + 9 * 1024;
        for (int i = f_tid; i < 9 * 1024; i += 512) { const int r = i >> 10, k = i & 1023; const float v = (r < 8) ? a.in[1][r * D + k] : a.in[3][k]; S[i] = v / (1.f + __expf(-v)); }
        __syncthreads();
        for (int it = blockIdx.x; it < DEPTH * 96; it += F.G) { const int l = it / 96, n0 = (it % 96) * 64;
            const float* wp = a.in[4] + ((size_t)l * D + F.wave * 128) * (NMOD * D) + n0 + f_lane;
            float accv[9];
#pragma unroll
            for (int r = 0; r < 9; ++r) accv[r] = 0.f;
            for (int k0 = 0; k0 < 128; k0 += 32) { float wv[32];
#pragma unroll
                for (int k = 0; k < 32; ++k) wv[k] = wp[(size_t)(k0 + k) * (NMOD * D)];
#pragma unroll
                for (int k = 0; k < 32; ++k)
#pragma unroll
                    for (int r = 0; r < 9; ++r) accv[r] += S[r * 1024 + F.wave * 128 + k0 + k] * wv[k]; }
#pragma unroll
            for (int r = 0; r < 9; ++r) red[(F.wave * 9 + r) * 64 + f_lane] = accv[r];
            __syncthreads();
            for (int i = f_tid; i < 9 * 64; i += 512) { const int r = i >> 6, ln = i & 63; float s = a.in[5][(size_t)l * (NMOD * D) + n0 + ln];
#pragma unroll
                for (int w = 0; w < 8; ++w) s += red[(w * 9 + r) * 64 + ln];
                ((float*)(ws + WS_MOD))[((size_t)l * 9 + r) * (NMOD * D) + n0 + ln] = s; }
            __syncthreads();
        }
    }
}

__device__ __forceinline__ void load_row(const float* p, int lane, f32x4 (&v)[4]) {
#pragma unroll
    for (int j = 0; j < 4; ++j) v[j] = ((const f32x4*)p)[lane + 64 * j];
}
__device__ __forceinline__ void load_row_bf(const bf16* p, int lane, f32x4 (&v)[4]) {
#pragma unroll
    for (int j = 0; j < 4; ++j) { const v2u w = ((const v2u*)p)[lane + 64 * j]; v[j] = (f32x4){bf_lo(w.x), bf_hi(w.x), bf_lo(w.y), bf_hi(w.y)}; }
}
__device__ __forceinline__ void norm_mod(f32x4 (&v)[4], const float* g, const float* shift, const float* scale, int lane) {
    float s = 0.f;
#pragma unroll
    for (int j = 0; j < 4; ++j) s += (v[j][0] * v[j][0] + v[j][1] * v[j][1]) + (v[j][2] * v[j][2] + v[j][3] * v[j][3]);
    const float rstd = rsqrtf(wave_sum(s, lane) * (1.f / D) + EPS);
#pragma unroll
    for (int j = 0; j < 4; ++j) { const f32x4 gv = ((const f32x4*)g)[lane + 64 * j], sh = ((const f32x4*)shift)[lane + 64 * j], sc = ((const f32x4*)scale)[lane + 64 * j];
        v[j] = (v[j] * rstd * gv) * (sc + 1.f) + sh; }
}
__device__ __forceinline__ void store_row_bf16(bf16* p, int lane, const f32x4 (&v)[4]) {
#pragma unroll
    for (int j = 0; j < 4; ++j) { v2u w; w.x = pk2(v[j][0], v[j][1]); w.y = pk2(v[j][2], v[j][3]); ((v2u*)p)[lane + 64 * j] = w; }
}

__device__ __forceinline__ void rp_norm1(Frame& F, const Args& a, int l, int row_lo) {
    const int f_tid = lthread(F.wave), f_lane = f_tid & 63;
    const bf16* X = (const bf16*)(F.ws + WS_X); bf16* H = (bf16*)(F.ws + WS_H); const float* MOD = (const float*)(F.ws + WS_MOD) + (size_t)l * 9 * (NMOD * D);
    for (int row = row_lo + F.gw; row < NT; row += F.NGW) { f32x4 v[4];
        if (l == 0) load_row(row < NC ? a.in[2] + (size_t)row * D : a.in[0] + (size_t)(row - NC) * D, f_lane, v);
        else load_row_bf(X + (size_t)row * D, f_lane, v);
        const float* m = MOD + (size_t)modrow_of(row) * (NMOD * D);
        norm_mod(v, a.in[6] + (size_t)l * D, m, m + D, f_lane); store_row_bf16(H + (size_t)row * D, f_lane, v); }
}

#if MK_N2V2
constexpr int LDS_LIST = LDS_MISC + 768;
__device__ __forceinline__ unsigned row16_max(unsigned k) {
    unsigned t;
    t = (unsigned)__builtin_amdgcn_mov_dpp((int)k, 0xb1, 0xf, 0xf, false); k = k > t ? k : t;
    t = (unsigned)__builtin_amdgcn_mov_dpp((int)k, 0x4e, 0xf, 0xf, false); k = k > t ? k : t;
    t = (unsigned)__builtin_amdgcn_mov_dpp((int)k, 0x124, 0xf, 0xf, false); k = k > t ? k : t;
    t = (unsigned)__builtin_amdgcn_mov_dpp((int)k, 0x128, 0xf, 0xf, false); k = k > t ? k : t;
    return k;
}
__device__ __forceinline__ unsigned wave_max_u(unsigned k) {
    k = row16_max(k);
    const unsigned a = (unsigned)__builtin_amdgcn_readlane((int)k, 0), b = (unsigned)__builtin_amdgcn_readlane((int)k, 16), c = (unsigned)__builtin_amdgcn_readlane((int)k, 32), d = (unsigned)__builtin_amdgcn_readlane((int)k, 48);
    const unsigned ab = a > b ? a : b, cd = c > d ? c : d; return ab > cd ? ab : cd;
}
__device__ __forceinline__ float key_val(unsigned m) { const unsigned u = m & ~31u; return __builtin_bit_cast(float, (u & 0x80000000u) ? (u ^ 0x80000000u) : ~u); }
__device__ __forceinline__ void rp_norm2_router(Frame& F, const Args& a, int l, int row_lo) {
    const int f_tid = lthread(F.wave), f_lane = f_tid & 63;
    const bf16* X = (const bf16*)(F.ws + WS_X); bf16* H = (bf16*)(F.ws + WS_H); const float* MOD = (const float*)(F.ws + WS_MOD) + (size_t)l * 9 * (NMOD * D);
    LAS float* wt = (LAS float*)F.lds;
    { const f32x4* src = (const f32x4*)((const float*)(F.ws + WS_WRT) + (size_t)l * NE * D); f32x4 tv[16];
#pragma unroll
      for (int i = 0; i < 16; ++i) tv[i] = src[f_tid + 512 * i];
#pragma unroll
      for (int i = 0; i < 16; ++i) ((LAS f32x4*)wt)[f_tid + 512 * i] = tv[i]; }
    LAS int* lcnt = (LAS int*)(F.lds + LDS_TT); LAS int* lbase = lcnt + 32;
    LAS v4u* list = (LAS v4u*)(F.lds + LDS_LIST) + F.wave * 68;
    LAS float* lsc = (LAS float*)(F.lds + LDS_LIST + 8 * 68 * 16) + F.wave * 68;
    if (f_tid < 32) lcnt[f_tid] = 0;
    __syncthreads();
    const float* gf = a.in[7] + (size_t)l * D;
    f32x4 gv[4];
#pragma unroll
    for (int j = 0; j < 4; ++j) gv[j] = ((const f32x4*)gf)[f_lane + 64 * j];
    const int my_e = f_lane >> 1;
    const float my_b = a.in[22][(size_t)l * NE + my_e];
    int row = row_lo + F.gw, it = 0;
    f32x4 vn[4];
    if (row < NT) load_row_bf(X + (size_t)row * D, f_lane, vn);
    for (; row < NT; row += F.NGW, ++it) {
        f32x4 v[4], sh[4], sc[4];
        const float* m = MOD + (size_t)modrow_of(row) * (NMOD * D);
#pragma unroll
        for (int j = 0; j < 4; ++j) { sh[j] = ((const f32x4*)(m + 3 * D))[f_lane + 64 * j]; sc[j] = ((const f32x4*)(m + 4 * D))[f_lane + 64 * j]; }
        asm volatile("" ::: "memory");
#pragma unroll
        for (int j = 0; j < 4; ++j) v[j] = vn[j];
        { const int nrow = row + F.NGW; if (nrow < NT) load_row_bf(X + (size_t)nrow * D, f_lane, vn); }
        float ssq = 0.f;
#pragma unroll
        for (int j = 0; j < 4; ++j) ssq += (v[j][0] * v[j][0] + v[j][1] * v[j][1]) + (v[j][2] * v[j][2] + v[j][3] * v[j][3]);
        const float rstd = rsqrtf(wave_sum(ssq, f_lane) * (1.f / D) + EPS);
#pragma unroll
        for (int j = 0; j < 4; ++j) v[j] = (v[j] * rstd * gv[j]) * (sc[j] + 1.f) + sh[j];
        float am = 0.f;
#pragma unroll
        for (int j = 0; j < 4; ++j) am = fmaxf(fmaxf(am, fmaxf(fabsf(v[j][0]), fabsf(v[j][1]))), fmaxf(fabsf(v[j][2]), fabsf(v[j][3])));
        const float amax = __uint_as_float(wave_max_u(__float_as_uint(am)));
        const float qscale = amax > 0.f ? amax * (1.f / 127.f) : 1.f, qinv = amax > 0.f ? 127.f / amax : 0.f;
#pragma unroll
        for (int j = 0; j < 4; ++j) { unsigned w = 0;
#pragma unroll
            for (int q = 0; q < 4; ++q) { int qi = __float2int_rn(v[j][q] * qinv); qi = qi > 127 ? 127 : (qi < -127 ? -127 : qi); w |= ((unsigned)qi & 255u) << (8 * q); }
            ((unsigned*)((unsigned char*)H + (size_t)row * D))[f_lane + 64 * j] = w; }
        float p[32];
#pragma unroll
        for (int e = 0; e < 32; ++e) { f32x2 s2 = (f32x2){0.f, 0.f};
#pragma unroll
            for (int j = 0; j < 4; ++j) { const f32x4 w = ((const LAS f32x4*)(wt + e * 1024))[f_lane + 64 * j];
                s2 = __builtin_elementwise_fma((f32x2){v[j][0], v[j][1]}, (f32x2){w[0], w[1]}, s2); s2 = __builtin_elementwise_fma((f32x2){v[j][2], v[j][3]}, (f32x2){w[2], w[3]}, s2); }
            p[e] = s2[0] + s2[1]; }
#pragma unroll
        for (int s = 0; s < 5; ++s) { const int half = 16 >> s, msk = 32 >> s; const bool up = (f_lane & msk) != 0;
#pragma unroll
            for (int i = 0; i < half; ++i) { const float keep = up ? p[i + half] : p[i], send = up ? p[i] : p[i + half]; p[i] = keep + shx(send, msk, f_lane); } }
        const float lgt = p[0] + shx(p[0], 1, f_lane) + my_b;
        unsigned key; { const unsigned u = __builtin_bit_cast(unsigned, lgt); const unsigned o = (u & 0x80000000u) ? ~u : (u | 0x80000000u); key = (o & ~31u) | (unsigned)(31 - my_e); }
        unsigned mk[4];
#pragma unroll
        for (int k = 0; k < 4; ++k) { mk[k] = wave_max_u(key); key = (key == mk[k]) ? 0u : key; }
        const float b0 = key_val(mk[0]);
        const float e1 = __expf(key_val(mk[1]) - b0), e2 = __expf(key_val(mk[2]) - b0), e3 = __expf(key_val(mk[3]) - b0); const float inv = 1.f / (1.f + e1 + e2 + e3);
        if (f_lane < 4) { const unsigned mm = f_lane == 0 ? mk[0] : f_lane == 1 ? mk[1] : f_lane == 2 ? mk[2] : mk[3]; const int me = 31 - (int)(mm & 31u);
            const float mw = (f_lane == 0 ? 1.f : f_lane == 1 ? e1 : f_lane == 2 ? e2 : e3) * inv;
            const int lr = __hip_atomic_fetch_add(lcnt + me, 1, __ATOMIC_RELAXED, __HIP_MEMORY_SCOPE_WORKGROUP);
            LAS unsigned* ep = (LAS unsigned*)(list + it * 4 + f_lane); ep[0] = (unsigned)(row * 4 + f_lane); ep[1] = (unsigned)me; ep[2] = (unsigned)lr; ep[3] = __builtin_bit_cast(unsigned, mw);
            lsc[it * 4 + f_lane] = qscale; }
    }
    __syncthreads();
    if (f_tid < 32) { const int c = lcnt[f_tid]; lbase[f_tid] = c ? (int)__hip_atomic_fetch_add((unsigned*)(F.ctl + CW_CNT + (l * 32 + f_tid) * 16), (unsigned)c, RLX_AGENT) : 0; }
    __syncthreads();
    int* te = (int*)(F.ws + WS_TE); int* trank = (int*)(F.ws + WS_TRANK); int* stok = (int*)(F.ws + WS_STOK); float* sw = (float*)(F.ws + WS_SW); float* ssc = (float*)(F.ws + WS_SSC);
    for (int i = f_lane; i < it * 4; i += 64) { const LAS unsigned* ep = (const LAS unsigned*)(list + i); const unsigned rowk = ep[0], ex = ep[1], lr = ep[2]; const float wv = __builtin_bit_cast(float, ep[3]);
        const int rk = lbase[ex] + (int)lr;
        stok[(size_t)ex * CAP + rk] = (int)(rowk >> 2); sw[(size_t)ex * CAP + rk] = wv; ssc[(size_t)ex * CAP + rk] = lsc[i]; te[rowk] = (int)ex; trank[rowk] = rk; }
}

#endif
__device__ __forceinline__ void moe_table(Frame& F, int l) {
    const int f_tid = lthread(F.wave), f_lane = f_tid & 63;
    LAS int* TT = (LAS int*)(F.lds + LDS_TT); LAS int* CN = TT + 64; LAS int* TE = (LAS int*)(F.lds + LDS_TE);
    __syncthreads();
    if (f_tid < 64) {
        const int c = (f_lane < 32) ? (int)__hip_atomic_load((unsigned*)(F.ctl + CW_CNT + (l * 32 + (f_lane & 31)) * 16), RLX_AGENT) : 0;
        const int tl = (c + 255) >> 8; int v = tl;
#pragma unroll
        for (int o = 1; o < 32; o <<= 1) { const int n = __builtin_amdgcn_ds_bpermute((f_lane >= o ? f_lane - o : f_lane) << 2, v); if (f_lane >= o) v += n; }
        if (f_lane < 32) { CN[f_lane] = c; TT[f_lane] = v - tl; if (f_lane == 31) TT[32] = v; }
    }
    __syncthreads();
    for (int t = f_tid; t < MAXTILES; t += 512) { int lo = 0, hi = 32;
#pragma unroll
        for (int k = 0; k < 5; ++k) { const int mid = (lo + hi) >> 1; if (TT[mid] <= t) lo = mid; else hi = mid; }
        TE[t] = lo; }
    __syncthreads();
}

#if MK_CBV2
struct CombRow { v2u x[4]; v2u y[4][4]; };
__device__ __forceinline__ void comb_issue(CombRow& R, const bf16* X, const bf16* Y, const LAS int* TT, int row, const v4u te4, const v4u tr4, int lane) {
    const unsigned ee[4] = {te4[0], te4[1], te4[2], te4[3]}, rr[4] = {tr4[0], tr4[1], tr4[2], tr4[3]};
#pragma unroll
    for (int k = 0; k < 4; ++k) { const size_t slot = (size_t)TT[ee[k]] * 256 + rr[k]; const v2u* yp = (const v2u*)(Y + slot * 1024);
#pragma unroll
        for (int j = 0; j < 4; ++j) R.y[k][j] = yp[lane + 64 * j]; }
#pragma unroll
    for (int j = 0; j < 4; ++j) R.x[j] = ((const v2u*)(X + (size_t)row * D))[lane + 64 * j];
}
__device__ __forceinline__ void comb_finish(const CombRow& R, Frame& F, const Args& a, int l, int row, int lane, const float* MOD, const float* MODN, bool lastl) {
    bf16* X = (bf16*)(F.ws + WS_X); bf16* H = (bf16*)(F.ws + WS_H);
    const int mr = modrow_of(row); const float* g5 = MOD + (size_t)mr * (NMOD * D) + 5 * D;
    f32x4 v[4];
#pragma unroll
    for (int j = 0; j < 4; ++j) { f32x4 s = (f32x4){0.f, 0.f, 0.f, 0.f};
#pragma unroll
        for (int k = 0; k < 4; ++k) { const v2u w = R.y[k][j]; s[0] += bf_lo(w.x); s[1] += bf_hi(w.x); s[2] += bf_lo(w.y); s[3] += bf_hi(w.y); }
        const f32x4 gv = ((const f32x4*)g5)[lane + 64 * j]; const v2u xw = R.x[j]; v[j] = (f32x4){bf_lo(xw.x), bf_hi(xw.x), bf_lo(xw.y), bf_hi(xw.y)} + gv * s; }
    if (!lastl) {
        store_row_bf16(X + (size_t)row * D, lane, v);
        const float* m = MODN + (size_t)mr * (NMOD * D);
        norm_mod(v, a.in[6] + (size_t)(l + 1) * D, m, m + D, lane); store_row_bf16(H + (size_t)row * D, lane, v);
    } else {
        float ss = 0.f;
#pragma unroll
        for (int j = 0; j < 4; ++j) ss += (v[j][0] * v[j][0] + v[j][1] * v[j][1]) + (v[j][2] * v[j][2] + v[j][3] * v[j][3]);
        const float rstd = rsqrtf(wave_sum(ss, lane) * (1.f / D) + EPS);
        float* op = a.out + (size_t)(row - NC) * D;
#pragma unroll
        for (int j = 0; j < 4; ++j) { const f32x4 gv = ((const f32x4*)a.in[8])[lane + 64 * j]; ((f32x4*)op)[lane + 64 * j] = v[j] * rstd * gv; }
    }
}
__device__ __forceinline__ void rp_combine(Frame& F, const Args& a, int l, int row_lo) {
    const int f_tid = lthread(F.wave), f_lane = f_tid & 63;
    const bf16* X = (const bf16*)(F.ws + WS_X); const bf16* Y = (const bf16*)(F.ws + WS_Y);
    const float* MOD = (const float*)(F.ws + WS_MOD) + (size_t)l * 9 * (NMOD * D); const float* MODN = MOD + 9 * (NMOD * D);
    const v4u* te = (const v4u*)(F.ws + WS_TE); const v4u* trank = (const v4u*)(F.ws + WS_TRANK);
    const LAS int* TT = (const LAS int*)(F.lds + LDS_TT);
    const bool lastl = (l == DEPTH - 1);
    const int st = F.NGW;
    int row = row_lo + F.gw;
    if (row >= NT) return;
    CombRow RA, RB;
    v4u te1 = te[row], tr1 = trank[row];
    comb_issue(RA, X, Y, TT, row, te1, tr1, f_lane);
    if (row + st < NT) { te1 = te[row + st]; tr1 = trank[row + st]; }
    for (;;) {
        const bool h1 = row + st < NT;
        if (h1) comb_issue(RB, X, Y, TT, row + st, te1, tr1, f_lane);
        if (row + 2 * st < NT) { te1 = te[row + 2 * st]; tr1 = trank[row + 2 * st]; }
        comb_finish(RA, F, a, l, row, f_lane, MOD, MODN, lastl);
        if (!h1) break;
        row += st;
        const bool h2 = row + st < NT;
        if (h2) comb_issue(RA, X, Y, TT, row + st, te1, tr1, f_lane);
        if (row + 2 * st < NT) { te1 = te[row + 2 * st]; tr1 = trank[row + 2 * st]; }
        comb_finish(RB, F, a, l, row, f_lane, MOD, MODN, lastl);
        if (!h2) break;
        row += st;
    }
}

#endif
__device__ __forceinline__ void rp_mla(Frame& F, const Args& a) {
    const int f_tid = lthread(F.wave), f_lane = f_tid & 63;
    const bf16* A = (const bf16*)(F.ws + WS_RE); bf16* QA = (bf16*)(F.ws + WS_RF); bf16* CKV = (bf16*)(F.ws + WS_RG); bf16* Kb = (bf16*)(F.ws + WS_RB);
    const float* rope = (const float*)(F.ws + WS_ROPE); const float* gq = a.in[12]; const float* gk = a.in[14];
    for (int row = F.gw; row < NT; row += F.NGW) {
        const unsigned* ap = (const unsigned*)(A + (size_t)row * MLA_IN_PAD);
        unsigned q[3], c[2];
#pragma unroll
        for (int j = 0; j < 3; ++j) q[j] = ap[f_lane + 64 * j];
#pragma unroll
        for (int j = 0; j < 2; ++j) c[j] = ap[192 + f_lane + 64 * j];
        const unsigned pe = ap[320 + (f_lane & 15)];
        float sq = 0.f, sc = 0.f;
#pragma unroll
        for (int j = 0; j < 3; ++j) { const float x0 = bf_lo(q[j]), x1 = bf_hi(q[j]); sq += x0 * x0 + x1 * x1; }
#pragma unroll
        for (int j = 0; j < 2; ++j) { const float x0 = bf_lo(c[j]), x1 = bf_hi(c[j]); sc += x0 * x0 + x1 * x1; }
        const float rq = rsqrtf(wave_sum(sq, f_lane) * (1.f / MLA_QL) + EPS), rc = rsqrtf(wave_sum(sc, f_lane) * (1.f / MLA_KVL) + EPS);
#pragma unroll
        for (int j = 0; j < 3; ++j) { const int e0 = 2 * (f_lane + 64 * j); ((unsigned*)(QA + (size_t)row * MLA_QL))[f_lane + 64 * j] = pk2(bf_lo(q[j]) * rq * gq[e0], bf_hi(q[j]) * rq * gq[e0 + 1]); }
#pragma unroll
        for (int j = 0; j < 2; ++j) { const int e0 = 2 * (f_lane + 64 * j); ((unsigned*)(CKV + (size_t)row * MLA_KVL))[f_lane + 64 * j] = pk2(bf_lo(c[j]) * rc * gk[e0], bf_hi(c[j]) * rc * gk[e0 + 1]); }
        float x0 = bf_lo(pe), x1 = bf_hi(pe);
        if (row >= NC) { const int t = (row - NC) & 4095, i = f_lane & 15, d = 2 * i, pos = (d & 16) ? (t & 63) : (t >> 6), f = d & 7;
            const float p0 = shx(x0, 4, f_lane), p1 = shx(x1, 4, f_lane); const float sg = (d & 8) ? 1.f : -1.f;
            const float* rp = rope + (size_t)pos * 16 + 2 * f; x0 = x0 * rp[0] + sg * p0 * rp[1]; x1 = x1 * rp[2] + sg * p1 * rp[3]; }
        const unsigned w = pk2(x0, x1);
        { const int i = f_lane & 15, hb = f_lane >> 4;
#pragma unroll
          for (int hh = 0; hh < 4; ++hh) { const int h = hb * 4 + hh; ((unsigned*)(Kb + (size_t)row * 1536 + 96 * h + 64))[i] = w; } }
    }
}

__device__ __forceinline__ void rp_gqa(Frame& F, const Args& a) {
    const int f_tid = lthread(F.wave), f_lane = f_tid & 63;
    const bf16* A = (const bf16*)(F.ws + WS_RA); bf16* Q = (bf16*)(F.ws + WS_RB); bf16* Kb = Q + (size_t)NT * 1024;
    const float* rope = (const float*)(F.ws + WS_ROPE) + 2048; const float* gq = a.in[18]; const float* gk = a.in[19];
    const float c2 = 0.125f * LOG2E;
    for (int row = F.gw; row < NT; row += F.NGW) {
        const bool lat = row >= NC; const int t = (row - NC) & 4095;
#pragma unroll
        for (int part = 0; part < 2; ++part) {
            const int ln = part ? (f_lane & 15) : f_lane; const bf16* src = A + (size_t)row * GQA_QKV + (part ? 1024 : 0) + ln * 16;
            const v4u w0 = *(const v4u*)src, w1 = *(const v4u*)(src + 8);
            float x[16]; const unsigned ww[8] = {w0.x, w0.y, w0.z, w0.w, w1.x, w1.y, w1.z, w1.w};
#pragma unroll
            for (int i = 0; i < 8; ++i) { x[2 * i] = bf_lo(ww[i]); x[2 * i + 1] = bf_hi(ww[i]); }
            float ss = 0.f;
#pragma unroll
            for (int i = 0; i < 16; ++i) ss += x[i] * x[i];
            ss += shx(ss, 1, f_lane); ss += shx(ss, 2, f_lane);
            const float rs = rsqrtf(ss * (1.f / 64.f) + EPS); const float* g = (part ? gk : gq) + (ln & 3) * 16;
#pragma unroll
            for (int i = 0; i < 16; ++i) x[i] = x[i] * rs * g[i];
            if (lat) { const int sec = (ln >> 1) & 1, pos = sec ? (t & 63) : (t >> 6); const float sg = (ln & 1) ? 1.f : -1.f; const float* rp = rope + (size_t)pos * 32;
#pragma unroll
                for (int i = 0; i < 16; ++i) { const float pr = shx(x[i], 1, f_lane); x[i] = x[i] * rp[2 * i] + sg * pr * rp[2 * i + 1]; } }
            const float scl = part ? 1.f : c2;
            v4u o0, o1; o0.x = pk2(x[0] * scl, x[1] * scl); o0.y = pk2(x[2] * scl, x[3] * scl); o0.z = pk2(x[4] * scl, x[5] * scl); o0.w = pk2(x[6] * scl, x[7] * scl);
            o1.x = pk2(x[8] * scl, x[9] * scl); o1.y = pk2(x[10] * scl, x[11] * scl); o1.z = pk2(x[12] * scl, x[13] * scl); o1.w = pk2(x[14] * scl, x[15] * scl);
            if (part == 0) { bf16* d = Q + (size_t)row * 1024 + ln * 16; *(v4u*)d = o0; *(v4u*)(d + 8) = o1; }
            else if (f_lane < 16) { bf16* d = Kb + (size_t)row * 256 + ln * 16; *(v4u*)d = o0; *(v4u*)(d + 8) = o1; }
        }
    }
}

template <int DK>
__device__ __forceinline__ void attn_phase(Frame& F, const att::Tens& T, int kvshift  , int kstride, int vstride, int vbase) {
    const int vcu = (F.G % 8 == 0) ? (blockIdx.x % 8) * (F.G / 8) + blockIdx.x / 8 : blockIdx.x;
    att::Pend pend; pend.valid = false; pend.o0 = f32x16{}; pend.o1 = f32x16{}; pend.l = 1.f; pend.qrow0 = 0; pend.oc0 = 0;
    for (int u = vcu; u < 2048 + 128; u += F.G) {
        if (u < 2048) { const int b = u >> 8, h = (u >> 4) & 15, qb = u & 15, kvh = h >> kvshift;
            att::unit<DK>(T, NC + b * SEQ + qb * 256, h * DK, kvh * kstride, vbase + kvh * vstride, h * 64, b * LCTX, NC + b * SEQ, 68, F.lds, F.wave, pend); }
        else { const int q = u - 2048, b = q >> 4, h = q & 15, kvh = h >> kvshift;
            att::unit<DK>(T, b * LCTX, h * DK, kvh * kstride, vbase + kvh * vstride, h * 64, b * LCTX, 0, 4, F.lds, F.wave, pend); }
    }
    if (pend.valid) att::finish_unit(pend, T.O, F.lds, F.wave, lthread(F.wave) & 63);
    __syncthreads();
}

constexpr int PH_PER_LAYER = 9, PH_TOTAL = 2 + DEPTH * PH_PER_LAYER;
__global__ void __launch_bounds__(512, 2) mk_fwd(Args args) {
    extern __shared__ __attribute__((aligned(16))) unsigned char lds_raw[];
    Frame F;
    F.lds = (LAS unsigned char*)lds_raw; F.ws = args.ws; F.ctl = (gu32*)(args.ws + WS_CTL);
    F.wave = __builtin_amdgcn_readfirstlane(threadIdx.x >> 6); F.G = gridDim.x;
    F.gw = blockIdx.x * 8 + F.wave; F.NGW = F.G * 8;
    if (threadIdx.x < 4) ((LAS unsigned*)(F.lds + LDS_XB))[threadIdx.x] = 0u;
    __syncthreads();
    const int lo = args.ph_lo, hi = args.ph_hi;
    const bool multi = (hi - lo) > 1;
    XcdBarrier bar; bar.bar = (unsigned*)(F.ctl + CW_BAR); bar.x = 0; bar.st = nullptr; bar.wave = F.wave;
    if (multi) bar = xcd_barrier_post((unsigned*)(F.ctl + CW_BAR), (volatile LAS unsigned*)(F.lds + LDS_XB), F.wave);
#define IN(k) (lo <= (k) && (k) < hi)
#define SEAM(k) do { if (IN(k) && IN((k) + 1)) xcd_barrier(bar); } while (0)
    unsigned char* ws0 = args.ws;
#define PH_WS size_t zofs_ = 0; asm volatile("" : "+s"(zofs_)); unsigned char* ws = ws0 + zofs_; F.ws = ws; F.ctl = (gu32*)ws;
    const int G = F.G, cidx = (int)blockIdx.x;

    if (IN(0) && EN(0)) { PH_WS REP(0) { prologue(F, args); SEAM(0); } }
    if (IN(1) && EN(1)) { PH_WS rp_norm1(F, args, 0, 0); SEAM(1); }

    for (int l = 0; l < DEPTH; ++l) {
        const int kind = l % 3, j = l / 3, base = 2 + l * PH_PER_LAYER;
        const bool lastl = (l == DEPTH - 1);

        size_t outB = 0;
        if (kind == 0) {
            if (IN(base + 0) && EN(2)) { PH_WS REP(2) { PolFP p; p.A = (const char*)(ws + WS_WFIN) + (size_t)j * 2048 * D * 2; p.B = (const char*)(ws + WS_H); p.nt = 16; p.nN = lastl ? 128 : 136; p.G = G; p.c = cidx;
                p.Z = (bf16*)(ws + WS_RA); p.Zc = (bf16*)(ws + WS_RH); pg8::gemm_phase(F.lds, p, F.wave); } }
            SEAM(base + 0);
            if (IN(base + 1) && EN(3)) { PH_WS REP(3) { PolFA p; p.A = (const char*)(ws + WS_MA); p.B = (const char*)(ws + WS_RA); p.nt = 4; p.G = G; p.c = cidx; p.Y = (bf16*)(ws + WS_RB); pg8::gemm_phase(F.lds, p, F.wave); } }
            SEAM(base + 1);
            if (IN(base + 2) && EN(4)) { PH_WS REP(4) { PolFC p; p.A = (const char*)(ws + WS_DC); p.B = (const char*)(ws + WS_RB); p.nt = 8; p.G = G; p.c = cidx; p.nunits = lastl ? 512 : 544;
                p.offMC = (unsigned)(WS_MC - WS_DC); p.offZc = (unsigned)(WS_RH - WS_RB); p.F = (bf16*)(ws + WS_RC); pg8::gemm_phase(F.lds, p, F.wave); } }
            SEAM(base + 2);
            outB = WS_WFOUT + (size_t)j * D * D * 2;
        } else if (kind == 1) {
            if (IN(base + 0) && EN(5)) { PH_WS REP(5) { PolDenseBf16 p; p.A = (const char*)(ws + WS_H); p.B = (const char*)(ws + WS_WMIN); p.nt = 16; p.nM = NT / 256; p.nN = 3; p.pm0 = 0; p.G = G; p.c = cidx; p.pitchA = 2048; p.pitchB = 2048;
                p.O = (bf16*)(ws + WS_RE); p.ldo = MLA_IN_PAD; pg8::gemm_phase(F.lds, p, F.wave); } }
            SEAM(base + 0);
            if (IN(base + 1) && EN(6)) { PH_WS REP(6) { rp_mla(F, args); } }
            SEAM(base + 1);
            if (IN(base + 2)) { PH_WS REP(7) {
                if (EN(7)) { PolMlaQ p; p.A = (const char*)(ws + WS_RF); p.B = (const char*)(ws + WS_WMQB); p.nt = 6; p.nM = NT / 256; p.nN = 6; p.G = G; p.c = cidx; p.Q = (bf16*)(ws + WS_RA);
                  p.rope = (const float*)(ws + WS_ROPE); p.c2 = 0.10206207261596575f * LOG2E; pg8::gemm_phase(F.lds, p, F.wave); }
                if (EN(8)) { PolMlaKV p; p.A = (const char*)(ws + WS_RG); p.B = (const char*)(ws + WS_WMKVB); p.nt = 4; p.nM = NT / 256; p.nN = 8; p.G = G; p.c = cidx; p.Kb = (bf16*)(ws + WS_RB); p.Vb = (bf16*)(ws + WS_RD);
                  pg8::gemm_phase(F.lds, p, F.wave); }
            } }
            SEAM(base + 2);
            if (IN(base + 3) && EN(9)) { PH_WS REP(9) { att::Tens T{(const bf16*)(ws + WS_RA), 1536, (const bf16*)(ws + WS_RB), 1536, (const bf16*)(ws + WS_RD), 1024, (bf16*)(ws + WS_RC)}; attn_phase<96>(F, T, 0, 96, 64, 0); } }
            SEAM(base + 3);
            outB = WS_WMO;
        } else {
            if (IN(base + 0) && EN(10)) { PH_WS REP(10) { PolDenseBf16 p; p.A = (const char*)(ws + WS_H); p.B = (const char*)(ws + WS_WGQKV); p.nt = 16; p.nM = NT / 256; p.nN = 6; p.pm0 = 0; p.G = G; p.c = cidx; p.pitchA = 2048; p.pitchB = 2048;
                p.O = (bf16*)(ws + WS_RA); p.ldo = GQA_QKV; pg8::gemm_phase(F.lds, p, F.wave); } }
            SEAM(base + 0);
            if (IN(base + 1) && EN(11)) { PH_WS REP(11) { rp_gqa(F, args); } }
            SEAM(base + 1);
            if (IN(base + 2) && EN(12)) { PH_WS REP(12) { att::Tens T{(const bf16*)(ws + WS_RB), 1024, (const bf16*)(ws + WS_RB) + (size_t)NT * 1024, 256, (const bf16*)(ws + WS_RA), 1536, (bf16*)(ws + WS_RC)}; attn_phase<64>(F, T, 2, 64, 64, 1280); } }
            SEAM(base + 2);
            outB = WS_WGO;
        }
        if (IN(base + 4) && EN(13)) { PH_WS PolOut p; p.A = (const char*)(ws + WS_RC); p.B = (const char*)(ws + outB); p.nt = 16; p.nM = lastl ? NL / 256 : NT / 256; p.nN = 4; p.pm0 = lastl ? 8 : 0; p.G = G; p.c = cidx; p.X = (bf16*)(ws + WS_X); p.mod = (const float*)(ws + WS_MOD) + (size_t)l * 9 * (NMOD * D); p.chunk = 2;
            p.XinC = (l == 0) ? args.in[2] : nullptr; p.XinL = (l == 0) ? args.in[0] - (size_t)NC * D : nullptr;
            pg8::gemm_phase(F.lds, p, F.wave); }
        SEAM(base + 4);
        if (IN(base + 5) && EN(14)) { PH_WS rp_norm2_router(F, args, l, lastl ? NC : 0); }
        SEAM(base + 5);
        if (IN(base + 6) && EN(15)) { PH_WS REP(15) { moe_table(F, l);
            PolMoe1 p; p.A = (const char*)(ws + WS_H); p.B = (const char*)(ws + WS_WGU) + (size_t)l * NE * 2048 * D; p.nt = 8; p.G = G; p.c = cidx;
            p.swgu = (const float*)(ws + WS_SWGU) + (size_t)l * NE * 2048; p.ssc = (const float*)(ws + WS_SSC);
            p.T.TT = (const LAS int*)(F.lds + LDS_TT); p.T.CN = p.T.TT + 64; p.T.TE = (const LAS int*)(F.lds + LDS_TE); p.stok = (const int*)(ws + WS_STOK); p.bgu = (const float*)(ws + WS_BGU) + (size_t)l * NE * 2048; p.act = (unsigned char*)(ws + WS_ACT);
            pg8::gemm_phase(F.lds, p, F.wave); } }
        SEAM(base + 6);
        if (IN(base + 7) && EN(16)) { PH_WS REP(16) { moe_table(F, l);
            PolMoe2 p; p.A = (const char*)(ws + WS_ACT); p.B = (const char*)(ws + WS_WDN) + (size_t)l * NE * D * DFF; p.nt = 8; p.G = G; p.c = cidx; p.swd = (const float*)(ws + WS_SWDN) + (size_t)l * NE * D;
            p.T.TT = (const LAS int*)(F.lds + LDS_TT); p.T.CN = p.T.TT + 64; p.T.TE = (const LAS int*)(F.lds + LDS_TE); p.sw = (const float*)(ws + WS_SW); p.bdn = args.in[26] + (size_t)l * NE * D; p.Y = (bf16*)(ws + WS_Y);
            pg8::gemm_phase(F.lds, p, F.wave); } }
        SEAM(base + 7);
        if (IN(base + 8) && EN(17)) { PH_WS moe_table(F, l); rp_combine(F, args, l, lastl ? NC : 0); }
        SEAM(base + 8);
    }
#undef PH_WS
#undef IN
#undef SEAM
}

extern "C" void kernel_launch(void* const* d_in, const int* in_sizes, int n_in, void* d_out, int out_size, void* d_ws, size_t ws_size, hipStream_t stream) {
    static int grid = 0;
    if (grid == 0) {
        if (n_in != 27 || out_size != NL * D || ws_size < WS_END) { fprintf(stderr, "kernel_launch: unexpected problem (n_in %d, out %d, ws %zu < %zu)\n", n_in, out_size, ws_size, (size_t)WS_END); grid = -1; return; }
        int dev = 0, cus = 0, per_cu = 0;
        if (hipGetDevice(&dev) != hipSuccess || hipDeviceGetAttribute(&cus, hipDeviceAttributeMultiprocessorCount, dev) != hipSuccess) { grid = -1; return; }
        if (hipFuncSetAttribute((const void*)mk_fwd, hipFuncAttributeMaxDynamicSharedMemorySize, LDS_BYTES) != hipSuccess) { fprintf(stderr, "kernel_launch: hipFuncSetAttribute failed\n"); grid = -1; return; }
        if (hipOccupancyMaxActiveBlocksPerMultiprocessor(&per_cu, (const void*)mk_fwd, 512, LDS_BYTES) != hipSuccess || per_cu < 1) fprintf(stderr, "kernel_launch: occupancy query says %d\n", per_cu);
        (void)hipGetLastError();
        grid = cus;
    }
    if (grid < 0) return;
    (void)hipMemsetAsync((char*)d_ws + WS_CTL, 0, CTL_ZERO_BYTES, stream);
    Args a{};
    for (int i = 0; i < 27; ++i) a.in[i] = (const float*)d_in[i];
    a.out = (float*)d_out; a.ws = (unsigned char*)d_ws;
#if MK_PER_PHASE
    for (int ph = 0; ph < PH_TOTAL; ++ph) {
        const int l = (ph - 2) / PH_PER_LAYER, s = (ph - 2) % PH_PER_LAYER, kind = l % 3;
        if (ph >= 2) { if (s == 3 && kind != 1) continue; }
        a.ph_lo = ph; a.ph_hi = ph + 1;
        hipLaunchKernelGGL(mk_fwd, dim3(grid), dim3(512), LDS_BYTES, stream, a);
    }
#else
    a.ph_lo = 0; a.ph_hi = PH_TOTAL;
    hipLaunchKernelGGL(mk_fwd, dim3(grid), dim3(512), LDS_BYTES, stream, a);
#endif
}
```

```cpp
#include <hip/hip_runtime.h>
#include <cstdio>
#include <cstdint>

#ifndef MK_PER_PHASE
#define MK_PER_PHASE 0
#endif
#ifndef MK_N2V2
#define MK_N2V2 1
#endif
#ifndef MK_CBV2
#define MK_CBV2 1
#endif
#ifndef MK_N2AGG
#define MK_N2AGG 1
#endif
#ifndef MK_MASK
#define MK_MASK 0xFFFFFFFFu
#endif
#define EN(id) (((MK_MASK) >> (id)) & 1u)
#ifndef MK_REPMASK
#define MK_REPMASK 0u
#endif
#define REP(id) for (int rep_ = 0; rep_ < ((((MK_REPMASK) >> (id)) & 1u) ? 2 : 1); ++rep_)

constexpr int D = 1024, NB = 8, SEQ = 4096, LCTX = 256, DEPTH = 4;
constexpr int NC = NB * LCTX;
constexpr int NL = NB * SEQ;
constexpr int NT = NC + NL;
constexpr int NMOD = 6, NE = 32, TOPK = 4, DFF = 1024;
constexpr int MLA_QL = 384, MLA_KVL = 256, MLA_ROPE = 32, MLA_NOPE = 64, MLA_V = 64, MLA_IN = 672, MLA_IN_PAD = 768, MLA_QD = 96;
constexpr int GQA_NQ = 1024, GQA_NKV = 256, GQA_QKV = 1536;
constexpr int CAP = NT;
constexpr int MAXTILES = 576;
constexpr float EPS = 1e-6f;
constexpr float LOG2E = 1.4426950408889634f;

constexpr size_t MiB = 1u << 20;
constexpr size_t WS_CTL = 0, CTL_ZERO_BYTES = 96 * 1024;
constexpr size_t WS_MOD = 1 * MiB;
constexpr size_t WS_ROPE = 2 * MiB;
constexpr size_t WS_WRT = 2 * MiB + 65536;
constexpr size_t WS_BGU = 3 * MiB;
constexpr size_t WS_MA = 4 * MiB;
constexpr size_t WS_DC = 4 * MiB + 262144;
constexpr size_t WS_MC = 5 * MiB;
constexpr size_t WS_WFIN = 9 * MiB;
constexpr size_t WS_WFOUT = 17 * MiB;
constexpr size_t WS_WMIN = 21 * MiB;
constexpr size_t WS_WMQB = 23 * MiB;
constexpr size_t WS_WMKVB = 25 * MiB;
constexpr size_t WS_WMO = 26 * MiB;
constexpr size_t WS_WGQKV = 28 * MiB;
constexpr size_t WS_WGO = 31 * MiB;
constexpr size_t WS_TE = 34 * MiB;
constexpr size_t WS_TRANK = 35 * MiB;
constexpr size_t WS_STOK = 36 * MiB;
constexpr size_t WS_SW = 41 * MiB;
constexpr size_t WS_X = 64 * MiB;
constexpr size_t WS_H = 200 * MiB;
constexpr size_t WS_RA = 272 * MiB;
constexpr size_t WS_RB = 400 * MiB;
constexpr size_t WS_RC = 528 * MiB;
constexpr size_t WS_RD = 600 * MiB;
constexpr size_t WS_RE = 672 * MiB;
constexpr size_t WS_RF = 728 * MiB;
constexpr size_t WS_RG = 756 * MiB;
constexpr size_t WS_RH = 776 * MiB;
constexpr size_t WS_ACT = 784 * MiB;
constexpr size_t WS_Y = 1072 * MiB;
constexpr size_t WS_WGU = 1360 * MiB;
constexpr size_t WS_SWGU = 1360 * MiB + 256 * MiB;
constexpr size_t WS_SH = 1360 * MiB + 259 * MiB;
constexpr size_t WS_SWP = 1360 * MiB + 259 * MiB + 256 * 1024;
constexpr size_t WS_W8 = 1360 * MiB + 266 * MiB;
constexpr size_t WS_SSC = 1360 * MiB + 260 * MiB;
constexpr size_t WS_WDN = 1872 * MiB;
constexpr size_t WS_SWDN = 1872 * MiB + 128 * MiB;
constexpr size_t WS_END = 2128 * MiB;
constexpr int CW_TMO = 0;
constexpr int CW_BAR = 4096;
constexpr int CW_CNT = 16384;

constexpr int RING_BYTES = 131072;
constexpr int LDS_MISC = 135168;
constexpr int LDS_TT = LDS_MISC;
constexpr int LDS_XB = LDS_MISC + 512;
constexpr int LDS_TE = LDS_MISC + 768;
constexpr int LDS_BYTES = 147456;

#define GAS __attribute__((address_space(1)))
#define LAS __attribute__((address_space(3)))
typedef unsigned short bf16;
typedef unsigned v4u __attribute__((ext_vector_type(4)));
typedef unsigned v2u __attribute__((ext_vector_type(2)));
typedef float f32x4 __attribute__((ext_vector_type(4)));
typedef float f32x2 __attribute__((ext_vector_type(2)));
typedef float f32x16 __attribute__((ext_vector_type(16)));
typedef short bf16x8 __attribute__((ext_vector_type(8)));
typedef short s16x4 __attribute__((ext_vector_type(4)));
typedef __bf16 bf16x2_t __attribute__((ext_vector_type(2)));
typedef GAS unsigned gu32;
#define RLX_AGENT __ATOMIC_RELAXED, __HIP_MEMORY_SCOPE_AGENT
#define LDS_WAIT() asm volatile("s_waitcnt lgkmcnt(0)" ::: "memory")
#define VM_WAIT() asm volatile("s_waitcnt vmcnt(0)" ::: "memory")
__device__ __forceinline__ unsigned pk2(float lo, float hi) { f32x2 v = {lo, hi}; bf16x2_t b = __builtin_convertvector(v, bf16x2_t); return __builtin_bit_cast(unsigned, b); }
__device__ __forceinline__ float bf_lo(unsigned u) { return __builtin_bit_cast(float, u << 16); }
__device__ __forceinline__ float bf_hi(unsigned u) { return __builtin_bit_cast(float, u & 0xffff0000u); }
__device__ __forceinline__ float shx(float v, int mask, int lane) { return __int_as_float(__builtin_amdgcn_ds_bpermute((lane ^ mask) << 2, __float_as_int(v))); }
__device__ __forceinline__ float wave_sum(float v, int lane) {
#pragma unroll
    for (int o = 1; o < 64; o <<= 1) v += shx(v, o, lane);
    return v;
}
__device__ __forceinline__ int lane_id_v() { int t; asm volatile("v_mbcnt_lo_u32_b32 %0, -1, 0\n\tv_mbcnt_hi_u32_b32 %0, -1, %0" : "=v"(t)); return t; }
__device__ __forceinline__ int launder_s(int x) { asm volatile("" : "+s"(x)); return x; }
__device__ __forceinline__ int lthread_w(int wave) { return wave * 64 + lane_id_v(); }
__device__ __forceinline__ int modrow_of(int row) { return row < NC ? NB : ((row - NC) >> 12); }

#define XB_TMO      128
#define XB_XCNT(j)  (256  + 64 * (j))
#define XB_XSUB(j)  (1280 + 64 * (j))
#define XB_XGEN(j)  (2304 + 64 * (j))
#define XB_TOP      3328
#define XB_TOPGEN   3392
#define XCD_BAR_WORDS 3456
#define XB_SPIN_CAP (1u << 18)
__device__ __forceinline__ unsigned xb_ld(unsigned* p)              { return __hip_atomic_load(p, __ATOMIC_RELAXED, __HIP_MEMORY_SCOPE_AGENT); }
__device__ __forceinline__ unsigned xb_add(unsigned* p, unsigned v) { return __hip_atomic_fetch_add(p, v, __ATOMIC_RELAXED, __HIP_MEMORY_SCOPE_AGENT); }
__device__ __forceinline__ unsigned xb_xcc_id() { return (unsigned)__builtin_amdgcn_s_getreg((3 << 11) | 20) & 0xFu; }
#define XB_SPIN(cond, bar) do { unsigned _sp = 0; while (cond) { __builtin_amdgcn_s_sleep(1); \
    if ((++_sp & 255u) == 0u) { if (xb_ld(&(bar)[XB_TMO])) break; if (_sp > XB_SPIN_CAP) { atomicAdd(&(bar)[XB_TMO], 1u); break; } } } } while (0)
struct XcdBarrier { unsigned* bar; unsigned x; volatile LAS unsigned* st; int wave; };
__device__ __forceinline__ bool xb_thread0(int wave) { return wave == 0 && lane_id_v() == 0; }
__device__ __forceinline__ XcdBarrier xcd_barrier_post(unsigned* bar, volatile LAS unsigned* st, int wave) {
    XcdBarrier b; b.bar = bar; b.x = xb_xcc_id(); b.st = st; b.wave = wave;
    if (xb_thread0(wave)) (void)xb_add(&bar[XB_XCNT(b.x)], 1u);
    return b;
}
__device__ __forceinline__ void xcd_barrier_complete(unsigned* bar, unsigned x, unsigned& nloc, unsigned& nx) {
    const unsigned G = gridDim.x * gridDim.y * gridDim.z;
    unsigned sum, cnt, mine, sp = 0u;
    for (;;) {
        sum = 0u; cnt = 0u; mine = 0u;
#pragma unroll
        for (unsigned j = 0; j < 16; ++j) { const unsigned c = xb_ld(&bar[XB_XCNT(j)]); sum += c; cnt += (c > 0u) ? 1u : 0u; mine = (j == x) ? c : mine; }
        if (sum == G) break;
        __builtin_amdgcn_s_sleep(1);
        if ((++sp & 255u) == 0u) { if (xb_ld(&bar[XB_TMO])) break; if (sp > XB_SPIN_CAP) { atomicAdd(&bar[XB_TMO], 1u); break; } }
    }
    nloc = mine > 0u ? mine : 1u; nx = cnt > 0u ? cnt : 1u;
}
__device__ __forceinline__ void xcd_barrier(const XcdBarrier& b) {
    asm volatile("s_waitcnt vmcnt(0)" ::: "memory");
    __syncthreads();
    if (xb_thread0(b.wave)) {
        unsigned* bar = b.bar;
        __builtin_amdgcn_s_waitcnt(0);
        unsigned nloc = b.st[0], nx = b.st[1];
        if (nloc == 0u) { xcd_barrier_complete(bar, b.x, nloc, nx); b.st[0] = nloc; b.st[1] = nx; }
        const unsigned old = xb_add(&bar[XB_XSUB(b.x)], 1u);
        const unsigned gen = old / nloc;
        if (old + 1u == (gen + 1u) * nloc) {
            __builtin_amdgcn_fence(__ATOMIC_RELEASE, "agent");
            asm volatile("s_waitcnt vmcnt(0)" ::: "memory");
            const unsigned og = xb_add(&bar[XB_TOP], 1u);
            const unsigned tg = og / nx;
            if (og + 1u == (tg + 1u) * nx) xb_add(&bar[XB_TOPGEN], 1u);
            else XB_SPIN(xb_ld(&bar[XB_TOPGEN]) == tg, bar);
            __builtin_amdgcn_fence(__ATOMIC_ACQUIRE, "agent");
            xb_add(&bar[XB_XGEN(b.x)], 1u);
            asm volatile("s_waitcnt vmcnt(0)" ::: "memory");
        } else {
            XB_SPIN(xb_ld(&bar[XB_XGEN(b.x)]) == gen, bar);
            __builtin_amdgcn_fence(__ATOMIC_ACQUIRE, "agent");
            asm volatile("s_waitcnt vmcnt(0)" ::: "memory");
        }
    }
    __syncthreads();
}

namespace pg8 {
#define PG8_LAS __attribute__((address_space(3)))
constexpr int BM = 256, BK = 64, HALF = 128, HTB = HALF * BK * 2, STAGE_BYTES = 8 * HTB, NXCD = 8, WGM = 8;
__device__ __forceinline__ int lds_byte(int r, int c) { const int st = (r >> 4) * 2 + (c >> 5), rr = r & 15, cc = c & 31, ob = rr * 64 + cc * 2; return st * 1024 + (ob ^ (((ob >> 9) & 1) << 5)); }
__device__ __forceinline__ void stage_rc(int b, int& R, int& C) { const int st = b / 1024, sb = b % 1024, swz = sb ^ (((sb >> 9) & 1) << 5); R = (st >> 1) * 16 + swz / 64; C = (st & 1) * 32 + (swz % 64) / 2; }
__device__ __forceinline__ int perm32(int rho) { const int n = rho >> 4, i = rho & 15; return 8 * (i >> 2) + 4 * n + (i & 3); }
struct Unit { int pm, pn, aux; };
typedef f32x4 Acc[2][2][4][2];
typedef int i32x4 __attribute__((ext_vector_type(4)));
typedef i32x4 AccI[2][2][4][2];
template <bool I8> struct AccSel { typedef f32x4 T; };
template <> struct AccSel<true> { typedef i32x4 T; };
__device__ __forceinline__ f32x4 mma1(bf16x8 b, bf16x8 a, f32x4 c) { return __builtin_amdgcn_mfma_f32_16x16x32_bf16(b, a, c, 0, 0, 0); }
typedef int i32x8 __attribute__((ext_vector_type(8)));
typedef short bf16x16 __attribute__((ext_vector_type(16)));
__device__ __forceinline__ f32x4 mma_f8(bf16x8 b0, bf16x8 b1, bf16x8 a0, bf16x8 a1, f32x4 c) {
    const i32x8 B = __builtin_bit_cast(i32x8, __builtin_shufflevector(b0, b1, 0, 1, 2, 3, 4, 5, 6, 7, 8, 9, 10, 11, 12, 13, 14, 15));
    const i32x8 A = __builtin_bit_cast(i32x8, __builtin_shufflevector(a0, a1, 0, 1, 2, 3, 4, 5, 6, 7, 8, 9, 10, 11, 12, 13, 14, 15));
    return __builtin_amdgcn_mfma_scale_f32_16x16x128_f8f6f4(B, A, c, 0, 0, 0, 0x7F7F7F7F, 0, 0x7F7F7F7F); }
__device__ __forceinline__ i32x4 mma1(bf16x8 b, bf16x8 a, i32x4 c) { return __builtin_amdgcn_mfma_i32_16x16x64_i8(__builtin_bit_cast(i32x4, b), __builtin_bit_cast(i32x4, a), c, 0, 0, 0); }

__device__ __forceinline__ bool static_next(int i, int G, int c, int nM, int nN, int& pm, int& pn) {
    const int nwg = nM * nN; const long L = (long)i * G + c; if (L >= nwg) return false;
    int wgid = (int)L; { const int q = nwg / NXCD, r = nwg % NXCD, xcd = wgid % NXCD, off = wgid / NXCD; wgid = (xcd < r ? xcd * (q + 1) : r * (q + 1) + (xcd - r) * q) + off; }
    const int nig = WGM * nN, gid = wgid / nig, fm = gid * WGM, gsz = (nM - fm) < WGM ? (nM - fm) : WGM;
    pm = fm + ((wgid % nig) % gsz); pn = (wgid % nig) / gsz; return true;
}

template <class P>
__device__ __forceinline__ void gemm_phase(PG8_LAS unsigned char* lds, const P& p, int wave_id) {
    wave_id = launder_s(wave_id); int tid_l = lthread_w(wave_id);
    const int tid = tid_l, wid = wave_id, lane = tid & 63, wr = wid >> 2, wc = wid & 3, fr = lane & 15, fq = lane >> 4;
    const int nt = p.nt;
    const unsigned ldsw = (unsigned)wid * 1024u;
    const int aoff = lds_byte(wr * 64 + fr, fq * 8), boff = lds_byte(wc * 32 + fr, fq * 8);
    const char* const gA = p.A; const char* const gB = p.B;
#define PG8_SA(b, h) (((b) * 2 + (h)) * HTB)
#define PG8_SB(b, h) ((4 + (b) * 2 + (h)) * HTB)
#define PG8_STAGE(bufoff, gbase, off2, kofs) do { _Pragma("unroll") for (int _i = 0; _i < 2; ++_i) \
        __builtin_amdgcn_global_load_lds((const unsigned*)((gbase) + (size_t)(off2)[_i] + (size_t)(kofs)), (PG8_LAS unsigned*)(lds + (bufoff) + ldsw + _i * 8192), 16, 0, 0); } while (0)
#define PG8_LDA(dst, b, h) do { _Pragma("unroll") for (int m = 0; m < 4; ++m) _Pragma("unroll") for (int k = 0; k < 2; ++k) dst[m][k] = *(const PG8_LAS bf16x8*)(lds + PG8_SA(b, h) + aoff + m * 2048 + k * 1024); } while (0)
#define PG8_LDB(dst, b, h) do { _Pragma("unroll") for (int n = 0; n < 2; ++n) _Pragma("unroll") for (int k = 0; k < 2; ++k) dst[n][k] = *(const PG8_LAS bf16x8*)(lds + PG8_SB(b, h) + boff + n * 2048 + k * 1024); } while (0)
#define PG8_MMA(ai, bj, At, Bt) do { __builtin_amdgcn_s_setprio(1); _Pragma("unroll") for (int m = 0; m < 4; ++m) _Pragma("unroll") for (int n = 0; n < 2; ++n) { \
        if constexpr (P::F8) acc[ai][bj][m][n] = mma_f8(Bt[n][0], Bt[n][1], At[m][0], At[m][1], acc[ai][bj][m][n]); \
        else { _Pragma("unroll") for (int k = 0; k < 2; ++k) acc[ai][bj][m][n] = mma1(Bt[n][k], At[m][k], acc[ai][bj][m][n]); } } __builtin_amdgcn_s_setprio(0); } while (0)
#define PG8_WAIT_V(n) asm volatile("s_waitcnt vmcnt(" #n ")" ::: "memory")
#define PG8_WAIT_L(n) asm volatile("s_waitcnt lgkmcnt(" #n ")" ::: "memory")
#define PG8_BAR __builtin_amdgcn_s_barrier()
#define PG8_SCHED __builtin_amdgcn_sched_barrier(0)
#define PG8_KEYS(u) do { if (P::KEYS && wid < 4) __builtin_amdgcn_global_load_lds((const unsigned*)p.key_ptr(u, wid * 64 + lane), (PG8_LAS unsigned*)(keybuf + wid * 256), 4, 0, 0); } while (0)
#define PG8_OFFS(u, oA, oB) do { int tid2_ = tid; asm volatile("" : "+v"(tid2_));     \
    _Pragma("unroll") for (int _i = 0; _i < 2; ++_i) { int R_, C_; stage_rc(tid2_ * 16 + _i * 8192, R_, C_); const int Rb_ = P::PERM ? ((R_ & ~31) + perm32(R_ & 31)) : R_; \
      _Pragma("unroll") for (int _h = 0; _h < 2; ++_h) { \
        const int key_ = P::KEYS ? ((const PG8_LAS int*)keybuf)[_h * HALF + R_] : 0; \
        oA[_h][_i] = p.a_row(u, _h * HALF + R_, key_) + (unsigned)(C_ * 2); oB[_h][_i] = p.b_row(u, _h * HALF + Rb_) + (unsigned)(C_ * 2); } } } while (0)
    PG8_LAS unsigned char* const keybuf = lds + STAGE_BYTES;
    Unit cur, nxt; int ui = 0;
    if (!p.next(0, cur)) return;
    typedef typename AccSel<P::I8>::T AccT;
    AccT acc[2][2][4][2];
#pragma unroll
    for (int a = 0; a < 2; ++a)
#pragma unroll
        for (int b = 0; b < 2; ++b)
#pragma unroll
            for (int m = 0; m < 4; ++m)
#pragma unroll
                for (int n = 0; n < 2; ++n) acc[a][b][m][n] = (AccT){0, 0, 0, 0};
    bf16x8 At[4][2], B0[2][2], B1[2][2];
    unsigned oAc[2][2], oBc[2][2];
    if (P::KEYS) { PG8_KEYS(cur); PG8_WAIT_V(0); PG8_BAR; }
    PG8_OFFS(cur, oAc, oBc);
    PG8_STAGE(PG8_SB(0, 0), gB, oBc[0], 0); PG8_STAGE(PG8_SB(0, 1), gB, oBc[1], 0); PG8_STAGE(PG8_SA(0, 0), gA, oAc[0], 0); PG8_STAGE(PG8_SA(0, 1), gA, oAc[1], 0);
    if (wr == 1) PG8_BAR;
    PG8_WAIT_V(2); PG8_BAR;
    PG8_STAGE(PG8_SB(1, 0), gB, oBc[0], 128); PG8_STAGE(PG8_SA(1, 0), gA, oAc[0], 128); PG8_STAGE(PG8_SB(1, 1), gB, oBc[1], 128);
    PG8_WAIT_V(6); PG8_BAR;
    for (;;) {
        const bool has_next = p.next(ui + 1, nxt);
        if (has_next) { PG8_KEYS(nxt); }
        for (int t = 0; t < nt; t += 2) {
            const bool last = (t == nt - 2);
            const unsigned k1 = (unsigned)(t + 1) * 128u;
            const unsigned k2 = last ? 0u : (unsigned)(t + 2) * 128u, k3 = k2 + 128u;
            PG8_LDB(B0, 0, 0); PG8_LDB(B1, 0, 1); PG8_SCHED; PG8_LDA(At, 0, 0); PG8_STAGE(PG8_SA(1, 1), gA, oAc[1], k1);
            if (last && has_next) { PG8_OFFS(nxt, oAc, oBc); }
            PG8_WAIT_V(8); PG8_WAIT_L(0); PG8_BAR; PG8_MMA(0, 0, At, B0); PG8_MMA(0, 1, At, B1); PG8_BAR; PG8_SCHED;
            PG8_LDA(At, 0, 1); PG8_STAGE(PG8_SB(0, 0), gB, oBc[0], k2); PG8_STAGE(PG8_SB(0, 1), gB, oBc[1], k2); PG8_STAGE(PG8_SA(0, 0), gA, oAc[0], k2);
            PG8_WAIT_V(8); PG8_WAIT_L(0); PG8_BAR; PG8_MMA(1, 0, At, B0); PG8_MMA(1, 1, At, B1); PG8_BAR; PG8_SCHED;
            PG8_LDB(B0, 1, 0); PG8_LDB(B1, 1, 1); PG8_SCHED; PG8_LDA(At, 1, 0); PG8_STAGE(PG8_SA(0, 1), gA, oAc[1], k2);
            PG8_WAIT_V(8); PG8_WAIT_L(0); PG8_BAR; PG8_MMA(0, 0, At, B0); PG8_MMA(0, 1, At, B1); PG8_BAR; PG8_SCHED;
            PG8_LDA(At, 1, 1); PG8_STAGE(PG8_SB(1, 0), gB, oBc[0], k3); PG8_STAGE(PG8_SB(1, 1), gB, oBc[1], k3); PG8_STAGE(PG8_SA(1, 0), gA, oAc[0], k3);
            PG8_WAIT_V(8); PG8_WAIT_L(0); PG8_BAR; PG8_MMA(1, 0, At, B0); PG8_MMA(1, 1, At, B1); PG8_BAR; PG8_SCHED;
        }
        if (wr == 0) PG8_BAR;
        { const int le_ = lane_id_v(); int fr_e = le_ & 15, fq_e = le_ >> 4;
          p.epi(acc, cur, wr, wc, fr_e, fq_e); }
        if (!has_next) break;
#pragma unroll
        for (int a = 0; a < 2; ++a)
#pragma unroll
            for (int b = 0; b < 2; ++b)
#pragma unroll
                for (int m = 0; m < 4; ++m)
#pragma unroll
                    for (int n = 0; n < 2; ++n) acc[a][b][m][n] = (AccT){0, 0, 0, 0};
        cur = nxt; ++ui;
        if (wr == 1) PG8_BAR;
    }
    PG8_WAIT_V(0);
    PG8_BAR;
#undef PG8_SA
#undef PG8_SB
#undef PG8_STAGE
#undef PG8_LDA
#undef PG8_LDB
#undef PG8_MMA
#undef PG8_WAIT_V
#undef PG8_WAIT_L
#undef PG8_BAR
#undef PG8_SCHED
#undef PG8_OFFS
#undef PG8_KEYS
}
}
using pg8::Unit;

#define TROW(ai, wr, m, fr) (128 * (ai) + 64 * (wr) + 16 * (m) + (fr))
#define TCOLP(bj, wc, fq) (128 * (bj) + 32 * (wc) + 8 * (fq))
#define TCOLN(bj, wc, n, fq) (128 * (bj) + 32 * (wc) + 16 * (n) + 4 * (fq))
__device__ __forceinline__ v4u pack8(const f32x4 a, const f32x4 b) { v4u w; w.x = pk2(a[0], a[1]); w.y = pk2(a[2], a[3]); w.z = pk2(b[0], b[1]); w.w = pk2(b[2], b[3]); return w; }

struct PolDenseBf16 {
    static constexpr bool PERM = true;
    static constexpr bool KEYS = false;
    static constexpr bool I8 = false;
    static constexpr bool F8 = false;
    __device__ __forceinline__ const int* key_ptr(const Unit&, int) const { return nullptr; }
    const char* A; const char* B; int nt; int nM, nN, pm0, G, c; unsigned pitchA, pitchB; bf16* O; int ldo;
    __device__ __forceinline__ bool next(int i, Unit& u) const { int pm, pn; if (!pg8::static_next(i, G, c, nM, nN, pm, pn)) return false; u.pm = pm + pm0; u.pn = pn; u.aux = 0; return true; }
    __device__ __forceinline__ unsigned a_row(const Unit& u, int r, int) const { return (unsigned)(u.pm * 256 + r) * pitchA; }
    __device__ __forceinline__ unsigned b_row(const Unit& u, int r) const { return (unsigned)(u.pn * 256 + r) * pitchB; }
    __device__ __forceinline__ void epi(const pg8::Acc& acc, const Unit& u, int wr, int wc, int fr, int fq) const {
#pragma unroll
        for (int ai = 0; ai < 2; ++ai)
#pragma unroll
            for (int m = 0; m < 4; ++m) { const size_t row = (size_t)u.pm * 256 + TROW(ai, wr, m, fr);
#pragma unroll
                for (int bj = 0; bj < 2; ++bj) { const int col = u.pn * 256 + TCOLP(bj, wc, fq); *(v4u*)(O + row * ldo + col) = pack8(acc[ai][bj][m][0], acc[ai][bj][m][1]); } }
    }
};

struct PolDenseI8 {
    static constexpr bool PERM = true;
    static constexpr bool KEYS = false;
    static constexpr bool I8 = true;
    static constexpr bool F8 = false;
    __device__ __forceinline__ const int* key_ptr(const Unit&, int) const { return nullptr; }
    const char* A; const char* B; int nt; int nM, nN, pm0, G, c; const float* sA; const float* sB; bf16* O; int ldo;
    __device__ __forceinline__ bool next(int i, Unit& u) const { int pm, pn; if (!pg8::static_next(i, G, c, nM, nN, pm, pn)) return false; u.pm = pm + pm0; u.pn = pn; u.aux = 0; return true; }
    __device__ __forceinline__ unsigned a_row(const Unit& u, int r, int) const { return (unsigned)(u.pm * 256 + r) * 1024u; }
    __device__ __forceinline__ unsigned b_row(const Unit& u, int r) const { return (unsigned)(u.pn * 256 + r) * 1024u; }
    __device__ __forceinline__ void epi(const pg8::AccI& acc, const Unit& u, int wr, int wc, int fr, int fq) const {
#pragma unroll
        for (int bj = 0; bj < 2; ++bj) { const int col = u.pn * 256 + TCOLP(bj, wc, fq); const f32x4 s0 = *(const f32x4*)(sB + col), s1 = *(const f32x4*)(sB + col + 4);
#pragma unroll
            for (int ai = 0; ai < 2; ++ai)
#pragma unroll
                for (int m = 0; m < 4; ++m) { const size_t row = (size_t)u.pm * 256 + TROW(ai, wr, m, fr); const float sa = sA[row]; f32x4 v0, v1;
#pragma unroll
                    for (int q = 0; q < 4; ++q) { v0[q] = (float)acc[ai][bj][m][0][q] * (sa * s0[q]); v1[q] = (float)acc[ai][bj][m][1][q] * (sa * s1[q]); }
                    *(v4u*)(O + row * ldo + col) = pack8(v0, v1); } }
    }
};

struct PolOut {
    static constexpr bool PERM = true;
    static constexpr bool KEYS = false;
    static constexpr bool I8 = false;
    static constexpr bool F8 = false;
    __device__ __forceinline__ const int* key_ptr(const Unit&, int) const { return nullptr; }
    const char* A; const char* B; int nt; int nM, nN, pm0, G, c; bf16* X; const float* mod;
    int chunk; const float* XinC; const float* XinL;
    __device__ __forceinline__ bool next(int i, Unit& u) const { int pm, pn; if (!pg8::static_next(i, G, c, nM, nN, pm, pn)) return false; u.pm = pm + pm0; u.pn = pn; u.aux = 0; return true; }
    __device__ __forceinline__ unsigned a_row(const Unit& u, int r, int) const { return (unsigned)(u.pm * 256 + r) * 2048u; }
    __device__ __forceinline__ unsigned b_row(const Unit& u, int r) const { return (unsigned)(u.pn * 256 + r) * 2048u; }
    __device__ __forceinline__ void epi(const pg8::Acc& acc, const Unit& u, int wr, int wc, int fr, int fq) const {
        const int mr = modrow_of(u.pm * 256);
        const float* g = mod + (size_t)mr * (NMOD * D) + chunk * D;
        const float* xin = XinC ? (u.pm < 8 ? XinC : XinL) : nullptr;
#pragma unroll
        for (int bj = 0; bj < 2; ++bj) { const int col = u.pn * 256 + TCOLP(bj, wc, fq); const f32x4 g0 = *(const f32x4*)(g + col), g1 = *(const f32x4*)(g + col + 4);
#pragma unroll
            for (int ai = 0; ai < 2; ++ai)
#pragma unroll
                for (int m = 0; m < 4; ++m) { const size_t off = ((size_t)u.pm * 256 + TROW(ai, wr, m, fr)) * D + col; f32x4 x0, x1;
                    if (xin) { x0 = *(const f32x4*)(xin + off); x1 = *(const f32x4*)(xin + off + 4); }
                    else { const v4u w = *(const v4u*)(X + off); x0 = (f32x4){bf_lo(w.x), bf_hi(w.x), bf_lo(w.y), bf_hi(w.y)}; x1 = (f32x4){bf_lo(w.z), bf_hi(w.z), bf_lo(w[3]), bf_hi(w[3])}; }
                    *(v4u*)(X + off) = pack8(x0 + g0 * acc[ai][bj][m][0], x1 + g1 * acc[ai][bj][m][1]); } }
    }
};

struct PolFP {
    static constexpr bool PERM = true;
    static constexpr bool KEYS = false;
    static constexpr bool I8 = true;
    static constexpr bool F8 = false;
    __device__ __forceinline__ const int* key_ptr(const Unit&, int) const { return nullptr; }
    const char* A; const char* B; int nt; int nN, G, c; const float* sW; const float* sH; bf16* Z; bf16* Zc;
    __device__ __forceinline__ bool next(int i, Unit& u) const { int pm, pn; if (!pg8::static_next(i, G, c, 8, nN, pm, pn)) return false; u.pm = pm; u.pn = pn; u.aux = 0; return true; }
    __device__ __forceinline__ unsigned a_row(const Unit& u, int r, int) const { return (unsigned)(u.pm * 256 + r) * 1024u; }
    __device__ __forceinline__ int tok_row(int pn, int n) const { if (pn < 128) { const int b = n >> 12, l2 = (n >> 6) & 63, l1 = n & 63; return NC + b * SEQ + 64 * l1 + l2; } return n - 32768; }
    __device__ __forceinline__ unsigned b_row(const Unit& u, int r) const { return (unsigned)tok_row(u.pn, u.pn * 256 + r) * 1024u; }
    __device__ __forceinline__ void epi(const pg8::AccI& acc, const Unit& u, int wr, int wc, int fr, int fq) const {
#pragma unroll
        for (int bj = 0; bj < 2; ++bj) { const int n0 = u.pn * 256 + TCOLP(bj, wc, fq);
            f32x4 h0, h1;
#pragma unroll
            for (int q = 0; q < 4; ++q) { h0[q] = sH[tok_row(u.pn, n0 + q)]; h1[q] = sH[tok_row(u.pn, n0 + 4 + q)]; }
#pragma unroll
            for (int ai = 0; ai < 2; ++ai)
#pragma unroll
                for (int m = 0; m < 4; ++m) { const int cp = u.pm * 256 + TROW(ai, wr, m, fr); const float sw = sW[cp]; f32x4 v0, v1;
#pragma unroll
                    for (int q = 0; q < 4; ++q) { v0[q] = (float)acc[ai][bj][m][0][q] * (sw * h0[q]); v1[q] = (float)acc[ai][bj][m][1][q] * (sw * h1[q]); }
                    const v4u w = pack8(v0, v1);
                    if (u.pn < 128) *(v4u*)(Z + ((size_t)(n0 >> 6) * 2048 + cp) * 64 + (n0 & 63)) = w;
                    else { const int b = u.pn - 128, l = n0 - 32768 - b * 256; *(v4u*)(Zc + ((size_t)b * 2048 + cp) * 256 + l) = w; } } }
    }
};

struct PolFA {
    static constexpr bool PERM = true;
    static constexpr bool KEYS = false;
    static constexpr bool I8 = false;
    static constexpr bool F8 = false;
    __device__ __forceinline__ const int* key_ptr(const Unit&, int) const { return nullptr; }
    const char* A; const char* B; int nt; int G, c; bf16* Y;
    __device__ __forceinline__ bool next(int i, Unit& u) const { const int L = i * G + c; if (L >= 1024) return false; u.pm = 0; u.pn = L & 127; u.aux = L >> 7; return true; }
    __device__ __forceinline__ unsigned a_row(const Unit&, int r, int) const { return (unsigned)r * 512u; }
    __device__ __forceinline__ unsigned b_row(const Unit& u, int r) const { const int l2 = r & 63, cp = u.pn * 4 + (r >> 6); return (unsigned)((u.aux * 64 + l2) * 512 + cp) * 512u; }
    __device__ __forceinline__ void epi(const pg8::Acc& acc, const Unit& u, int wr, int wc, int fr, int fq) const {
        const int b = u.aux;
#pragma unroll
        for (int ai = 0; ai < 2; ++ai)
#pragma unroll
            for (int m = 0; m < 4; ++m) { const int rr = TROW(ai, wr, m, fr), jp = rr >> 7, pp = (rr >> 6) & 1, k1 = rr & 63;
#pragma unroll
                for (int bj = 0; bj < 2; ++bj) { const int n0 = u.pn * 256 + TCOLP(bj, wc, fq), cp = n0 >> 6, l2 = n0 & 63, cc = 2 * cp + jp;
                    const size_t idx = ((((size_t)(b * 16 + (k1 >> 2)) * 1024 + cc) * 4 + (k1 & 3)) * 2 + pp) * 64 + l2;
                    *(v4u*)(Y + idx) = pack8(acc[ai][bj][m][0], acc[ai][bj][m][1]); } }
    }
};

struct PolFC {
    static constexpr bool PERM = true;
    static constexpr bool KEYS = false;
    static constexpr bool I8 = false;
    static constexpr bool F8 = false;
    __device__ __forceinline__ const int* key_ptr(const Unit&, int) const { return nullptr; }
    const char* A; const char* B; int nt; int G, c; int nunits; unsigned offMC, offZc; bf16* F;
    __device__ __forceinline__ bool next(int i, Unit& u) const { const int L = i * G + c; if (L >= nunits) return false;
        if (L < 512) { u.pm = 0; u.pn = L & 3; u.aux = L >> 2; } else { const int q = L - 512; u.pm = 0; u.pn = q & 3; u.aux = 256 + (q >> 2); } return true; }
    __device__ __forceinline__ unsigned a_row(const Unit& u, int r, int) const {
        if (u.aux < 256) return offMC + (unsigned)((u.aux & 15) * 256 + r) * 1024u;
        return (unsigned)r * 1024u; }
    __device__ __forceinline__ unsigned b_row(const Unit& u, int r) const {
        if (u.aux < 256) return (unsigned)(u.aux * 1024 + u.pn * 256 + r) * 1024u;
        return offZc + (unsigned)((u.aux - 256) * 1024 + u.pn * 256 + r) * 1024u; }
    __device__ __forceinline__ void epi(const pg8::Acc& acc, const Unit& u, int wr, int wc, int fr, int fq) const {
#pragma unroll
        for (int ai = 0; ai < 2; ++ai)
#pragma unroll
            for (int m = 0; m < 4; ++m) { const int rr = TROW(ai, wr, m, fr); size_t frow;
                if (u.aux < 256) { const int b = u.aux >> 4, kq = u.aux & 15, k = 4 * kq + (rr >> 6) + 64 * (rr & 63); frow = (size_t)NC + b * SEQ + k; }
                else frow = (size_t)(u.aux - 256) * LCTX + rr;
#pragma unroll
                for (int bj = 0; bj < 2; ++bj) { const int col = u.pn * 256 + TCOLP(bj, wc, fq); *(v4u*)(F + frow * D + col) = pack8(acc[ai][bj][m][0], acc[ai][bj][m][1]); } }
    }
};

struct PolMlaQ {
    static constexpr bool PERM = true;
    static constexpr bool KEYS = false;
    static constexpr bool I8 = false;
    static constexpr bool F8 = false;
    __device__ __forceinline__ const int* key_ptr(const Unit&, int) const { return nullptr; }
    const char* A; const char* B; int nt; int nM, nN, G, c; bf16* Q; const float* rope; float c2;
    __device__ __forceinline__ bool next(int i, Unit& u) const { int pm, pn; if (!pg8::static_next(i, G, c, nM, nN, pm, pn)) return false; u.pm = pm; u.pn = pn; u.aux = 0; return true; }
    __device__ __forceinline__ unsigned a_row(const Unit& u, int r, int) const { return (unsigned)(u.pm * 256 + r) * (unsigned)(MLA_QL * 2); }
    __device__ __forceinline__ unsigned b_row(const Unit& u, int r) const { return (unsigned)(u.pn * 256 + r) * (unsigned)(MLA_QL * 2); }
    __device__ __forceinline__ void epi(const pg8::Acc& acc, const Unit& u, int wr, int wc, int fr, int fq) const {
        const bool lat = u.pm >= 8;
#pragma unroll
        for (int bj = 0; bj < 2; ++bj) { const int col = u.pn * 256 + TCOLP(bj, wc, fq); const bool isrope = lat && (((col >> 5) % 3) == 2);
#pragma unroll
            for (int ai = 0; ai < 2; ++ai)
#pragma unroll
                for (int m = 0; m < 4; ++m) { const int row = u.pm * 256 + TROW(ai, wr, m, fr); f32x4 v0 = acc[ai][bj][m][0], v1 = acc[ai][bj][m][1];
                    if (isrope) { const int t = (row - NC) & 4095, pos = (fq & 2) ? (t & 63) : (t >> 6);
                        const f32x4* rp = (const f32x4*)(rope + (size_t)pos * 16);
                        const f32x4 r0 = rp[0], r1 = rp[1], r2 = rp[2], r3 = rp[3];
                        f32x4 p0, p1;
#pragma unroll
                        for (int e = 0; e < 4; ++e) { p0[e] = shx(v0[e], 16, fq * 16 + fr); p1[e] = shx(v1[e], 16, fq * 16 + fr); }
                        const float sg = (fq & 1) ? 1.f : -1.f;
                        v0[0] = v0[0] * r0[0] + sg * p0[0] * r0[1]; v0[1] = v0[1] * r0[2] + sg * p0[1] * r0[3];
                        v0[2] = v0[2] * r1[0] + sg * p0[2] * r1[1]; v0[3] = v0[3] * r1[2] + sg * p0[3] * r1[3];
                        v1[0] = v1[0] * r2[0] + sg * p1[0] * r2[1]; v1[1] = v1[1] * r2[2] + sg * p1[1] * r2[3];
                        v1[2] = v1[2] * r3[0] + sg * p1[2] * r3[1]; v1[3] = v1[3] * r3[2] + sg * p1[3] * r3[3]; }
                    *(v4u*)(Q + (size_t)row * 1536 + col) = pack8(v0 * c2, v1 * c2); } }
    }
};

struct PolMlaKV {
    static constexpr bool PERM = true;
    static constexpr bool KEYS = false;
    static constexpr bool I8 = false;
    static constexpr bool F8 = false;
    __device__ __forceinline__ const int* key_ptr(const Unit&, int) const { return nullptr; }
    const char* A; const char* B; int nt; int nM, nN, G, c; bf16* Kb; bf16* Vb;
    __device__ __forceinline__ bool next(int i, Unit& u) const { int pm, pn; if (!pg8::static_next(i, G, c, nM, nN, pm, pn)) return false; u.pm = pm; u.pn = pn; u.aux = 0; return true; }
    __device__ __forceinline__ unsigned a_row(const Unit& u, int r, int) const { return (unsigned)(u.pm * 256 + r) * 512u; }
    __device__ __forceinline__ unsigned b_row(const Unit& u, int r) const { return (unsigned)(u.pn * 256 + r) * 512u; }
    __device__ __forceinline__ void epi(const pg8::Acc& acc, const Unit& u, int wr, int wc, int fr, int fq) const {
#pragma unroll
        for (int bj = 0; bj < 2; ++bj) { const int col = u.pn * 256 + TCOLP(bj, wc, fq), h = col >> 7, j = col & 127;
#pragma unroll
            for (int ai = 0; ai < 2; ++ai)
#pragma unroll
                for (int m = 0; m < 4; ++m) { const size_t row = (size_t)u.pm * 256 + TROW(ai, wr, m, fr); const v4u w = pack8(acc[ai][bj][m][0], acc[ai][bj][m][1]);
                    if (j < 64) *(v4u*)(Kb + row * 1536 + 96 * h + j) = w; else *(v4u*)(Vb + row * 1024 + 64 * h + (j - 64)) = w; } }
    }
};

struct MoeTab { const LAS int* TT; const LAS int* CN; const LAS int* TE; };
__device__ __forceinline__ bool moe_next(int i, int G, int c, int NP, const MoeTab& T, Unit& u) {
    const int ttot = T.TT[32];
    int lo, hi, j;
    if ((G & 7) == 0) { const int x = c & 7, q = c >> 3, g8 = G >> 3; lo = (x * ttot) >> 3; hi = ((x + 1) * ttot) >> 3; j = i * g8 + q; }
    else { lo = 0; hi = ttot; j = i * G + c; }
    if (j >= (hi - lo) * NP) return false;
    const int tile = lo + j / NP; u.pn = j % NP; u.pm = tile;
    const int e = T.TE[tile];
    u.aux = e | ((tile - T.TT[e]) << 8);
    return true;
}
struct PolMoe1 {
    static constexpr bool PERM = true;
    static constexpr bool I8 = true;
    static constexpr bool F8 = false;
    const char* A; const char* B; int nt; int G, c; MoeTab T; const int* stok; const float* bgu; const float* swgu; const float* ssc; unsigned char* act;
    __device__ __forceinline__ bool next(int i, Unit& u) const { return moe_next(i, G, c, 8, T, u); }
    static constexpr bool KEYS = true;
    __device__ __forceinline__ const int* key_ptr(const Unit& u, int r) const { const int e = u.aux & 255, idx = (u.aux >> 8) * 256 + r; const int cn = T.CN[e]; return stok + (size_t)e * CAP + (idx < cn ? idx : 0); }
    __device__ __forceinline__ unsigned a_row(const Unit&, int, int key) const { return (unsigned)key * 1024u; }
    __device__ __forceinline__ unsigned b_row(const Unit& u, int r) const { return (unsigned)((u.aux & 255) * 2048 + u.pn * 256 + r) * 1024u; }
    __device__ __forceinline__ void epi(const pg8::AccI& acc, const Unit& u, int wr, int wc, int fr, int fq) const {
        const int e = u.aux & 255, mt = u.aux >> 8, cn = T.CN[e]; const int jl = 32 * wc + 8 * fq;
        const float* bg = bgu + (size_t)e * 2048 + u.pn * 256 + jl;
        const float* sg = swgu + (size_t)e * 2048 + u.pn * 256 + jl;
        const f32x4 bg0 = *(const f32x4*)(bg), bg1 = *(const f32x4*)(bg + 4), bu0 = *(const f32x4*)(bg + 128), bu1 = *(const f32x4*)(bg + 132);
        const f32x4 sg0 = *(const f32x4*)(sg), sg1 = *(const f32x4*)(sg + 4), su0 = *(const f32x4*)(sg + 128), su1 = *(const f32x4*)(sg + 132);
#pragma unroll
        for (int ai = 0; ai < 2; ++ai)
#pragma unroll
            for (int m = 0; m < 4; ++m) { const int rr = TROW(ai, wr, m, fr), idx = mt * 256 + rr; const size_t slot = (size_t)u.pm * 256 + rr;
                const float sa = ssc[(size_t)e * CAP + (idx < cn ? idx : 0)];
                f32x4 g0, g1, u0, u1, o0, o1;
#pragma unroll
                for (int q = 0; q < 4; ++q) { g0[q] = (float)acc[ai][0][m][0][q] * (sa * sg0[q]) + bg0[q]; g1[q] = (float)acc[ai][0][m][1][q] * (sa * sg1[q]) + bg1[q];
                    u0[q] = (float)acc[ai][1][m][0][q] * (sa * su0[q]) + bu0[q]; u1[q] = (float)acc[ai][1][m][1][q] * (sa * su1[q]) + bu1[q]; }
#pragma unroll
                for (int q = 0; q < 4; ++q) {
                    float ga = fminf(g0[q], 7.f), ua = fminf(fmaxf(u0[q], -7.f), 7.f); o0[q] = (ua + 1.f) * ga * __builtin_amdgcn_rcpf(1.f + __builtin_amdgcn_exp2f(-1.702f * LOG2E * ga));
                    float gb = fminf(g1[q], 7.f), ub = fminf(fmaxf(u1[q], -7.f), 7.f); o1[q] = (ub + 1.f) * gb * __builtin_amdgcn_rcpf(1.f + __builtin_amdgcn_exp2f(-1.702f * LOG2E * gb)); }
                v2u w8; { int t0 = __builtin_amdgcn_cvt_pk_fp8_f32(o0[0], o0[1], 0, false); t0 = __builtin_amdgcn_cvt_pk_fp8_f32(o0[2], o0[3], t0, true);
                          int t1 = __builtin_amdgcn_cvt_pk_fp8_f32(o1[0], o1[1], 0, false); t1 = __builtin_amdgcn_cvt_pk_fp8_f32(o1[2], o1[3], t1, true); w8.x = (unsigned)t0; w8.y = (unsigned)t1; }
                *(v2u*)(act + slot * 1024 + u.pn * 128 + jl) = w8; }
    }
};
struct PolMoe2 {
    static constexpr bool PERM = true;
    static constexpr bool KEYS = false;
    static constexpr bool I8 = false;
    static constexpr bool F8 = true;
    __device__ __forceinline__ const int* key_ptr(const Unit&, int) const { return nullptr; }
    const char* A; const char* B; int nt; int G, c; MoeTab T; const float* sw; const float* bdn; const float* swd; bf16* Y;
    __device__ __forceinline__ bool next(int i, Unit& u) const { return moe_next(i, G, c, 4, T, u); }
    __device__ __forceinline__ unsigned a_row(const Unit& u, int r, int) const { return (unsigned)(u.pm * 256 + r) * 1024u; }
    __device__ __forceinline__ unsigned b_row(const Unit& u, int r) const { return (unsigned)((u.aux & 255) * 1024 + u.pn * 256 + r) * 1024u; }
    __device__ __forceinline__ void epi(const pg8::Acc& acc, const Unit& u, int wr, int wc, int fr, int fq) const {
        const int e = u.aux & 255, mt = u.aux >> 8, cn = T.CN[e];
#pragma unroll
        for (int bj = 0; bj < 2; ++bj) { const int col = u.pn * 256 + TCOLP(bj, wc, fq); const size_t ci = (size_t)e * 1024 + col;
            const f32x4 b0 = *(const f32x4*)(bdn + ci), b1 = *(const f32x4*)(bdn + ci + 4), s0 = *(const f32x4*)(swd + ci), s1 = *(const f32x4*)(swd + ci + 4);
#pragma unroll
            for (int ai = 0; ai < 2; ++ai)
#pragma unroll
                for (int m = 0; m < 4; ++m) { const int rr = TROW(ai, wr, m, fr), idx = mt * 256 + rr; const size_t slot = (size_t)u.pm * 256 + rr; const float w = sw[(size_t)e * CAP + (idx < cn ? idx : 0)];
                    *(v4u*)(Y + slot * 1024 + col) = pack8((acc[ai][bj][m][0] * s0 + b0) * w, (acc[ai][bj][m][1] * s1 + b1) * w); } }
    }
};

namespace att {
__device__ __forceinline__ int crow(int r, int hi) { return (r & 3) + 8 * (r >> 2) + 4 * hi; }
__device__ __forceinline__ float max3f(float a, float b, float c) { return fmaxf(fmaxf(a, b), c); }
typedef LAS const char* lds_cptr;
constexpr int LK = 0, LV = 49152, LWS = 90112, LOST = 92160, LBYTES = 124928;
constexpr int PD = 3;
struct Tens { const bf16* Q; int qpitch; const bf16* K; int kpitch; const bf16* V; int vpitch; bf16* O; };
#define ATT_WAITV(n) asm volatile("s_waitcnt vmcnt(" #n ")" ::: "memory")
struct Pend { f32x16 o0, o1; float l; int qrow0, oc0; bool valid; };
__device__ __forceinline__ void finish_unit(const Pend& P, bf16* O, LAS unsigned char* lds, int wid, int lane) {
    const int r32 = lane & 31, hi = lane >> 5;
    LAS float* wsf = (LAS float*)(lds + LWS) + wid * 64;
    float lrun = P.l;
    { auto rr = __builtin_amdgcn_permlane32_swap(__float_as_uint(lrun), __float_as_uint(lrun), false, false); lrun = __uint_as_float(rr[0]) + __uint_as_float(rr[1]); }
    if (hi == 0) wsf[32 + r32] = lrun;
    LDS_WAIT();
    LAS bf16* stg = (LAS bf16*)(lds + LOST) + wid * 2048;
#pragma unroll
    for (int r = 0; r < 16; ++r) { const int orow = crow(r, hi); const float rl = __builtin_amdgcn_rcpf(wsf[32 + orow]);
        stg[orow * 64 + r32] = (bf16)(pk2(P.o0[r] * rl, 0.f) & 0xffffu); stg[orow * 64 + 32 + r32] = (bf16)(pk2(P.o1[r] * rl, 0.f) & 0xffffu); }
    LDS_WAIT();
    bf16* Ow = O + (size_t)(P.qrow0 + wid * 32) * 1024 + P.oc0;
#pragma unroll
    for (int i = 0; i < 4; ++i) { const int row = i * 8 + (lane >> 3), ch = lane & 7; const v4u v = *(const LAS v4u*)(stg + row * 64 + ch * 8); *(v4u*)(Ow + (size_t)row * 1024 + ch * 8) = v; }
    LDS_WAIT();
}
template <int DK>
__device__ __forceinline__ void unit(const Tens& T, int qrow0, int qc0, int kc0, int vc0, int oc0, int kctx0, int klat0, int NTL, LAS unsigned char* lds, int wave_id, Pend& pend) {
    constexpr int ND = DK / 16;
    wave_id = launder_s(wave_id); const int tid = lthread_w(wave_id), lane = tid & 63, r32 = lane & 31, hi = lane >> 5; const int wid = wave_id;
    LAS float* wsf = (LAS float*)(lds + LWS) + wid * 64;
    const bf16* ksrc = T.K + (size_t)lane * T.kpitch + kc0 + wid * 8;
    const int k2off = (8 + (wid & 3) - wid) * 8;
    const bf16* vsrc = T.V + (size_t)(16 * (wid & 3) + (lane >> 2)) * T.vpitch + vc0 + (wid >> 2) * 32 + (lane & 3) * 8;
#define ATT_DMA(t, ks_, vs_) do { const size_t row0_ = (size_t)((t) < 4 ? kctx0 + 64 * (t) : klat0 + 64 * ((t) - 4)); \
        __builtin_amdgcn_global_load_lds((const unsigned*)(ksrc + row0_ * T.kpitch), (LAS unsigned*)(lds + LK + (ks_) * 12288 + wid * 1024), 16, 0, 0); \
        if (DK > 64) __builtin_amdgcn_global_load_lds((const unsigned*)(ksrc + row0_ * T.kpitch + k2off), (LAS unsigned*)(lds + LK + (ks_) * 12288 + 8192 + (wid & 3) * 1024), 16, 0, 0); \
        __builtin_amdgcn_global_load_lds((const unsigned*)(vsrc + row0_ * T.vpitch), (LAS unsigned*)(lds + LV + (vs_) * 8192 + wid * 1024), 16, 0, 0); } while (0)
#define ATT_WAIT_TILES(n_tiles) do { if (DK > 64) { if ((n_tiles) >= 2) ATT_WAITV(6); else if ((n_tiles) == 1) ATT_WAITV(3); else ATT_WAITV(0); } \
        else { if ((n_tiles) >= 2) ATT_WAITV(4); else if ((n_tiles) == 1) ATT_WAITV(2); else ATT_WAITV(0); } } while (0)
    bf16x8 qr[ND];
    { const bf16* qp = T.Q + (size_t)(qrow0 + wid * 32 + r32) * T.qpitch + qc0 + hi * 8;
#pragma unroll
      for (int d0 = 0; d0 < ND; ++d0) qr[d0] = *(const bf16x8*)(qp + d0 * 16); }
    asm volatile("" ::: "memory");
    constexpr float THR = 8.f;
    const int half = wid >> 2;
    float mhat = 0.f, lrun = 0.f; f32x16 o[2]; o[0] = f32x16{}; o[1] = f32x16{}; f32x16 negm = f32x16{};
    f32x16 p0 = f32x16{}, p1 = f32x16{}; v4u pw[4]; pw[0] = pw[1] = pw[2] = pw[3] = (v4u){0u, 0u, 0u, 0u};
    ATT_DMA(0, 0, 0); ATT_DMA(1, 1, 1); ATT_DMA(2, 2, 2);
    if (pend.valid) finish_unit(pend, T.O, lds, wid, lane);
    ATT_WAIT_TILES(2);
    __builtin_amdgcn_s_barrier(); asm volatile("" ::: "memory");
    if (half == 1) __builtin_amdgcn_s_barrier();
    int vs_prev = 0, vs_cur = 0, vs_iss = 3;
    for (int t = 0; t <= NTL; ++t) {
        if (t >= 1) {
            s16x4 lo[2][4], hh[2][4];
            const unsigned vb = (unsigned)(uintptr_t)(lds + LV + vs_prev * 8192) + ((lane >> 4) & 1) * 32 + (lane & 3) * 8 + (4 * hi + ((lane & 15) >> 2)) * 64;
#pragma unroll
            for (int d0 = 0; d0 < 2; ++d0)
#pragma unroll
                for (int ks = 0; ks < 4; ++ks) {
                    asm volatile("ds_read_b64_tr_b16 %0,%1 offset:%c2" : "=&v"(lo[d0][ks]) : "v"(vb), "i"(d0 * 4096 + ks * 1024) : "memory");
                    asm volatile("ds_read_b64_tr_b16 %0,%1 offset:%c2" : "=&v"(hh[d0][ks]) : "v"(vb), "i"(d0 * 4096 + ks * 1024 + 512) : "memory"); }
            asm volatile("s_waitcnt lgkmcnt(0)" ::: "memory"); __builtin_amdgcn_sched_barrier(0);
#pragma unroll
            for (int ks = 0; ks < 4; ++ks)
#pragma unroll
                for (int d0 = 0; d0 < 2; ++d0) { const bf16x8 vf = (bf16x8){lo[d0][ks][0], lo[d0][ks][1], lo[d0][ks][2], lo[d0][ks][3], hh[d0][ks][0], hh[d0][ks][1], hh[d0][ks][2], hh[d0][ks][3]};
                    o[d0] = __builtin_amdgcn_mfma_f32_32x32x16_bf16(__builtin_bit_cast(bf16x8, pw[ks]), vf, o[d0], 0, 0, 0); }
        }
        if (t < NTL) {
            bf16x8 kf[2 * ND];
            const lds_cptr kb = (lds_cptr)(lds + LK + (t & 3) * 12288) + hi * 1024 + r32 * 16;
#pragma unroll
            for (int d0 = 0; d0 < ND; ++d0) { kf[2 * d0] = *(const LAS bf16x8*)(kb + d0 * 2048); kf[2 * d0 + 1] = *(const LAS bf16x8*)(kb + d0 * 2048 + 512); }
            asm volatile("s_waitcnt lgkmcnt(0)" ::: "memory"); __builtin_amdgcn_sched_barrier(0);
#pragma unroll
            for (int d0 = 0; d0 < ND; ++d0) {
                if (d0 == 0) { p0 = __builtin_amdgcn_mfma_f32_32x32x16_bf16(kf[0], qr[0], negm, 0, 0, 0); p1 = __builtin_amdgcn_mfma_f32_32x32x16_bf16(kf[1], qr[0], negm, 0, 0, 0); }
                else { p0 = __builtin_amdgcn_mfma_f32_32x32x16_bf16(kf[2 * d0], qr[d0], p0, 0, 0, 0); p1 = __builtin_amdgcn_mfma_f32_32x32x16_bf16(kf[2 * d0 + 1], qr[d0], p1, 0, 0, 0); } }
        }
        if (half == 1) {
            const int last_iss = (t + PD - 1 < NTL - 1) ? t + PD - 1 : NTL - 1; const int allow = last_iss - (t + 1);
            if (allow >= 1) ATT_WAIT_TILES(1); else ATT_WAIT_TILES(0); }
        asm volatile("s_waitcnt lgkmcnt(0)" ::: "memory"); __builtin_amdgcn_s_barrier(); asm volatile("" ::: "memory");
        if (t < NTL) {
            float rm = max3f(p0[0], p0[1], p1[0]);
#pragma unroll
            for (int r = 0; r < 16; ++r) rm = max3f(rm, p0[r], p1[r]);
            { auto rr = __builtin_amdgcn_permlane32_swap(__float_as_uint(rm), __float_as_uint(rm), false, false); rm = fmaxf(__uint_as_float(rr[0]), __uint_as_float(rr[1])); }
            if (t == 0 || __any(rm > THR)) {
                const float dl = (t == 0) ? rm : fmaxf(rm, 0.f);
                mhat += dl;
#pragma unroll
                for (int r = 0; r < 16; ++r) { p0[r] -= dl; p1[r] -= dl; negm[r] = -mhat; }
                const float f = (t == 0) ? 1.f : __builtin_amdgcn_exp2f(-dl); lrun *= f;
                if (hi == 0) wsf[r32] = f;
                LDS_WAIT();
#pragma unroll
                for (int r = 0; r < 16; ++r) { const float a = wsf[crow(r, hi)]; o[0][r] *= a; o[1][r] *= a; }
            }
            float rs = 0.f;
#pragma unroll
            for (int r = 0; r < 16; ++r) { p0[r] = __builtin_amdgcn_exp2f(p0[r]); p1[r] = __builtin_amdgcn_exp2f(p1[r]); rs += p0[r] + p1[r]; }
            lrun += rs;
            pw[0] = (v4u){pk2(p0[0], p0[1]), pk2(p0[2], p0[3]), pk2(p0[4], p0[5]), pk2(p0[6], p0[7])};
            pw[1] = (v4u){pk2(p0[8], p0[9]), pk2(p0[10], p0[11]), pk2(p0[12], p0[13]), pk2(p0[14], p0[15])};
            pw[2] = (v4u){pk2(p1[0], p1[1]), pk2(p1[2], p1[3]), pk2(p1[4], p1[5]), pk2(p1[6], p1[7])};
            pw[3] = (v4u){pk2(p1[8], p1[9]), pk2(p1[10], p1[11]), pk2(p1[12], p1[13]), pk2(p1[14], p1[15])};
        }
        if (t + PD < NTL) { ATT_DMA(t + PD, (t + PD) & 3, vs_iss); vs_iss = (vs_iss == 4) ? 0 : vs_iss + 1; }
        if (half == 0) {
            const int last_iss = (t + PD < NTL - 1) ? t + PD : NTL - 1; const int allow = last_iss - (t + 1);
            if (allow >= 2) ATT_WAIT_TILES(2); else if (allow == 1) ATT_WAIT_TILES(1); else ATT_WAIT_TILES(0); }
        vs_prev = vs_cur; vs_cur = (vs_cur == 4) ? 0 : vs_cur + 1;
        asm volatile("s_waitcnt lgkmcnt(0)" ::: "memory"); __builtin_amdgcn_s_barrier(); asm volatile("" ::: "memory");
    }
    if (half == 0) __builtin_amdgcn_s_barrier();
#undef ATT_DMA
#undef ATT_WAIT_TILES
    pend.o0 = o[0]; pend.o1 = o[1]; pend.l = lrun; pend.qrow0 = qrow0; pend.oc0 = oc0; pend.valid = true;
}
#undef ATT_WAITV
}

struct Args { const float* in[27]; float* out; unsigned char* ws; int ph_lo, ph_hi; };
struct Frame {
    LAS unsigned char* lds; unsigned char* ws; gu32* ctl; int wave, G, gw, NGW;
};
__device__ __forceinline__ int lthread(int wave) { return wave * 64 + lane_id_v(); }

template <int MODE>
__device__ __forceinline__ void conv_item(const float* W, int K, int N, bf16* WT, LAS float* scr, int item, int lane) {
    const int nblk = (N + 63) / 64, kb = item / nblk, nb = item % nblk, k0 = 64 * kb, n0 = 64 * nb;
    f32x4 v[16];
    const int cc = (lane & 15) * 4, rk = lane >> 4;
    const bool ok = (n0 + cc) < N;
#pragma unroll
    for (int i = 0; i < 16; ++i) v[i] = ok ? *(const f32x4*)(W + (size_t)(k0 + 4 * i + rk) * N + n0 + cc) : (f32x4){0.f, 0.f, 0.f, 0.f};
#pragma unroll
    for (int i = 0; i < 16; ++i) { LAS float* s = scr + (4 * i + rk) * 65 + cc; s[0] = v[i][0]; s[1] = v[i][1]; s[2] = v[i][2]; s[3] = v[i][3]; }
    LDS_WAIT(); asm volatile("" ::: "memory");
    const int c = lane & 7;
#pragma unroll
    for (int j = 0; j < 8; ++j) { const int n = (lane >> 3) + 8 * j; const LAS float* s = scr + (8 * c) * 65 + n;
        v4u o; o.x = pk2(s[0], s[65]); o.y = pk2(s[2 * 65], s[3 * 65]); o.z = pk2(s[4 * 65], s[5 * 65]); o.w = pk2(s[6 * 65], s[7 * 65]);
        const int ng = n0 + n; if (ng < N) { const int dr = (MODE == 1) ? ((ng >> 8) * 256 + (ng & 1) * 128 + ((ng >> 1) & 127)) : ng; *(v4u*)(WT + (size_t)dr * K + k0 + 8 * c) = o; } }
    LDS_WAIT(); asm volatile("" ::: "memory");
}

__device__ __forceinline__ void prologue(Frame& F, const Args& a) {
    const int f_tid = lthread(F.wave), f_lane = f_tid & 63;
    unsigned char* ws = F.ws;
    {
        LAS float* scr = (LAS float*)(F.lds + F.wave * 16640);
        struct M { const float* src; int K, N; size_t dst; };
        const int I_FO = 16 * 16, I_MIN = 16 * 11, I_QB = 6 * 24, I_KVB = 4 * 32, I_MO = 256, I_GQKV = 16 * 24, I_GO = 256;
        const int NSMALL = 2 * I_FO + I_MIN + I_QB + I_KVB + I_MO + I_GQKV + I_GO;
        for (int it = F.gw; it < NSMALL; it += F.NGW) {
            int r = it;
            if (r < 2 * I_FO) { const int j = r / I_FO; conv_item<0>(a.in[10] + (size_t)j * D * D, D, D, (bf16*)(ws + WS_WFOUT) + (size_t)j * D * D, scr, r % I_FO, f_lane); continue; } r -= 2 * I_FO;
            if (r < I_MIN) { conv_item<0>(a.in[11], D, MLA_IN, (bf16*)(ws + WS_WMIN), scr, r, f_lane); continue; } r -= I_MIN;
            if (r < I_QB) { conv_item<0>(a.in[13], MLA_QL, 1536, (bf16*)(ws + WS_WMQB), scr, r, f_lane); continue; } r -= I_QB;
            if (r < I_KVB) { conv_item<0>(a.in[15], MLA_KVL, 2048, (bf16*)(ws + WS_WMKVB), scr, r, f_lane); continue; } r -= I_KVB;
            if (r < I_MO) { conv_item<0>(a.in[16], D, D, (bf16*)(ws + WS_WMO), scr, r, f_lane); continue; } r -= I_MO;
            if (r < I_GQKV) { conv_item<0>(a.in[17], D, GQA_QKV, (bf16*)(ws + WS_WGQKV), scr, r, f_lane); continue; } r -= I_GQKV;
            conv_item<0>(a.in[20], D, D, (bf16*)(ws + WS_WGO), scr, r, f_lane);
        }
    }
    __syncthreads();
    {
        LAS float* cmax = (LAS float*)F.lds;
        LAS float* cinv = cmax + 512;
        LAS unsigned* scr8 = (LAS unsigned*)(F.lds + 4096) + F.wave * (64 * 33);
        const int cc = (f_lane & 15) * 4, rk = f_lane >> 4;
        constexpr int NGU = DEPTH * NE * 32, NDN = DEPTH * NE * 16;
        for (int it = blockIdx.x; it < NGU + NDN; it += F.G) {
            const bool dn = it >= NGU; const int q_ = dn ? it - NGU : it; const int le = dn ? (q_ >> 4) : (q_ >> 5), strip = dn ? (q_ & 15) : (q_ & 31);
            const int N = dn ? 1024 : 2048;
            const float* W = (dn ? a.in[25] + (size_t)le * DFF * D : a.in[23] + (size_t)le * D * 2048) + strip * 64 + cc;
            f32x4 v[32];
#pragma unroll
            for (int i = 0; i < 32; ++i) v[i] = *(const f32x4*)(W + (size_t)(F.wave * 128 + 16 * (i >> 2) + 4 * rk + (i & 3)) * N);
            f32x4 mx = (f32x4){0.f, 0.f, 0.f, 0.f};
#pragma unroll
            for (int i = 0; i < 32; ++i) { mx[0] = fmaxf(mx[0], fabsf(v[i][0])); mx[1] = fmaxf(mx[1], fabsf(v[i][1])); mx[2] = fmaxf(mx[2], fabsf(v[i][2])); mx[3] = fmaxf(mx[3], fabsf(v[i][3])); }
#pragma unroll
            for (int q = 0; q < 4; ++q) { mx[q] = fmaxf(mx[q], shx(mx[q], 16, f_lane)); mx[q] = fmaxf(mx[q], shx(mx[q], 32, f_lane)); }
            __syncthreads();
            if (rk == 0) { LAS float* d = cmax + F.wave * 64 + cc; d[0] = mx[0]; d[1] = mx[1]; d[2] = mx[2]; d[3] = mx[3]; }
            __syncthreads();
            const float target = dn ? 240.f : 127.f;
            if (f_tid < 64) { float m8 = 0.f;
#pragma unroll
                for (int w = 0; w < 8; ++w) m8 = fmaxf(m8, cmax[w * 64 + f_tid]);
                const int ng = strip * 64 + f_tid, dr = dn ? ng : (ng >> 8) * 256 + (ng & 1) * 128 + ((ng >> 1) & 127);
                float* sc = dn ? (float*)(ws + WS_SWDN) + (size_t)le * 1024 : (float*)(ws + WS_SWGU) + (size_t)le * 2048;
                sc[dr] = (m8 > 0.f) ? m8 / target : 1.f;
                cinv[f_tid] = (m8 > 0.f) ? target / m8 : 0.f; }
            __syncthreads();
            const f32x4 iv = *(const LAS f32x4*)(cinv + cc);
#pragma unroll
            for (int ip = 0; ip < 8; ++ip) {
#pragma unroll
                for (int q = 0; q < 4; ++q) { unsigned w = 0;
                    if (dn) { int t = __builtin_amdgcn_cvt_pk_fp8_f32(v[4 * ip][q] * iv[q], v[4 * ip + 1][q] * iv[q], 0, false); t = __builtin_amdgcn_cvt_pk_fp8_f32(v[4 * ip + 2][q] * iv[q], v[4 * ip + 3][q] * iv[q], t, true); w = (unsigned)t; }
                    else {
#pragma unroll
                        for (int j = 0; j < 4; ++j) { int qi = __float2int_rn(v[4 * ip + j][q] * iv[q]); qi = qi > 127 ? 127 : (qi < -127 ? -127 : qi); w |= ((unsigned)qi & 255u) << (8 * j); } }
                    scr8[(cc + q) * 33 + 4 * ip + rk] = w; } }
            LDS_WAIT(); asm volatile("" ::: "memory");
            { const int c8 = f_lane & 7;
              unsigned char* dst = dn ? (unsigned char*)(ws + WS_WDN) + (size_t)le * 1024 * 1024 : (unsigned char*)(ws + WS_WGU) + (size_t)le * 2048 * 1024;
#pragma unroll
              for (int jp = 0; jp < 8; ++jp) { const int n = (f_lane >> 3) + 8 * jp; const LAS unsigned* sp = scr8 + n * 33 + 4 * c8;
                  v4u o; o.x = sp[0]; o.y = sp[1]; o.z = sp[2]; o[3] = sp[3];
                  const int ng = strip * 64 + n, dr = dn ? ng : (ng >> 8) * 256 + (ng & 1) * 128 + ((ng >> 1) & 127);
                  *(v4u*)(dst + (size_t)dr * 1024 + F.wave * 128 + 16 * c8) = o; } }
            LDS_WAIT(); asm volatile("" ::: "memory");
        }
        __syncthreads();
    }
    const int gtid = blockIdx.x * 512 + f_tid, gthreads = F.G * 512;
    for (int i = gtid; i < (MLA_IN_PAD - MLA_IN) * D / 8; i += gthreads) ((v4u*)((bf16*)(ws + WS_WMIN) + (size_t)MLA_IN * D))[i] = (v4u){0u, 0u, 0u, 0u};
    {
        bf16* MA = (bf16*)(ws + WS_MA);
        for (int i = gtid; i < 256 * 256; i += gthreads) { const int row = i >> 8, col = i & 255, jp = row >> 7, pp = (row >> 6) & 1, k1 = row & 63, j = col >> 7, pt = (col >> 6) & 1, l1 = col & 63;
            float v = 0.f; if (j == jp) { const float x = 2.f * (float)((k1 * l1) & 63) / 64.f; const float cs = cospif(x), sn = sinpif(x); v = (pp == 0) ? (pt == 0 ? cs : sn) : (pt == 0 ? -sn : cs); }
            MA[i] = (bf16)(pk2(v, 0.f) & 0xffffu); }
        bf16* DC = (bf16*)(ws + WS_DC); const float sc = 1.0f / sqrtf(256.f * 128.f);
        for (int i = gtid; i < 256 * 512; i += gthreads) { const int k = i >> 9, col = i & 511, pt = col >> 8, l = col & 255; const float x = 2.f * (float)((k * l) & 255) / 256.f;
            const float v = (pt == 0 ? cospif(x) : sinpif(x)) * sc; DC[i] = (bf16)(pk2(v, 0.f) & 0xffffu); }
        bf16* MC = (bf16*)(ws + WS_MC); const float sl = 1.0f / sqrtf(4096.f * 128.f);
        for (int i = gtid; i < 16 * 256 * 512; i += gthreads) { const int kq = i >> 17, row = (i >> 9) & 255, col = i & 511, kkp = row >> 6, k2 = row & 63, kk = col >> 7, pp = (col >> 6) & 1, l2 = col & 63;
            float v = 0.f; if (kk == kkp) { const int k = 4 * kq + kkp + 64 * k2; const float x = 2.f * (float)((l2 * k) & 4095) / 4096.f; v = (pp == 0 ? cospif(x) : sinpif(x)) * sl; }
            MC[i] = (bf16)(pk2(v, 0.f) & 0xffffu); }
        float* RM = (float*)(ws + WS_ROPE); float* RG = RM + 2048;
        for (int i = gtid; i < 64 * 8; i += gthreads) { const int pos = i >> 3, f = i & 7; const float inv = powf(10000.f, -(float)f / 8.f); float s, c; sincosf((float)pos * inv, &s, &c); RM[2 * i] = c; RM[2 * i + 1] = s; }
        for (int i = gtid; i < 64 * 16; i += gthreads) { const int pos = i >> 4, f = i & 15; const float inv = powf(10000.f, -(float)f / 16.f); float s, c; sincosf((float)pos * inv, &s, &c); RG[2 * i] = c; RG[2 * i + 1] = s; }
        float* WRT = (float*)(ws + WS_WRT);
        for (int i = gtid; i < DEPTH * NE * D; i += gthreads) { const int l = i >> 15, e = (i >> 10) & 31, k = i & 1023; WRT[i] = a.in[21][((size_t)l * D + k) * NE + e]; }
        float* BG = (float*)(ws + WS_BGU);
        for (int i = gtid; i < DEPTH * NE * 2048; i += gthreads) { const int le = i >> 11, q = i & 2047, pn = q >> 8, s = (q >> 7) & 1, jj = q & 127; BG[i] = a.in[24][(size_t)le * 2048 + 2 * (pn * 128 + jj) + s]; }
    }
    __syncthreads();
    {
        LAS float* wl = (LAS float*)F.lds;
        LAS float* tc = wl + 2048; LAS float* ts = tc + 128;
        if (f_tid < 128) { const float x = 2.f * (float)f_tid / 128.f; tc[f_tid] = cospif(x); ts[f_tid] = -sinpif(x); }
        for (int it = blockIdx.x; it < 2 * 8 * 64; it += F.G) { const int j = it >> 9, g = (it >> 6) & 7, kb = it & 63;
            __syncthreads();
            { const int kk = f_tid >> 5, c4 = (f_tid & 31) * 4; const f32x4 w = *(const f32x4*)(a.in[9] + ((size_t)j * D + kb * 16 + kk) * D + g * 128 + c4);
              LAS float* d = wl + c4 * 16 + kk; d[0] = w[0]; d[16] = w[1]; d[32] = w[2]; d[48] = w[3]; }
            __syncthreads();
            const int cl = f_tid & 255, m = cl >> 1, part = cl & 1, kh = f_tid >> 8; const LAS float* tw = part ? ts : tc;
            float accv[8];
#pragma unroll
            for (int q = 0; q < 8; ++q) accv[q] = 0.f;
            for (int jj = 0; jj < 128; ++jj) { const float t = tw[(m * jj) & 127]; const f32x4 wa = *(const LAS f32x4*)(wl + jj * 16 + kh * 8), wb = *(const LAS f32x4*)(wl + jj * 16 + kh * 8 + 4);
                accv[0] += wa[0] * t; accv[1] += wa[1] * t; accv[2] += wa[2] * t; accv[3] += wa[3] * t; accv[4] += wb[0] * t; accv[5] += wb[1] * t; accv[6] += wb[2] * t; accv[7] += wb[3] * t; }
            v4u o; o.x = pk2(accv[0], accv[1]); o.y = pk2(accv[2], accv[3]); o.z = pk2(accv[4], accv[5]); o.w = pk2(accv[6], accv[7]);
            *(v4u*)((bf16*)(ws + WS_WFIN) + ((size_t)j * 2048 + g * 256 + cl) * D + kb * 16 + kh * 8) = o;
        }
        __syncthreads();
    }
    {
        LAS float* S = (LAS float*)F.lds;
        LAS float* red = S + 9 * 1024;
        for (int i = f_tid; i < 9 * 1024; i += 512) { const int r = i >> 10, k = i & 1023; const float v = (r < 8) ? a.in[1][r * D + k] : a.in[3][k]; S[i] = v / (1.f + __expf(-v)); }
        __syncthreads();
        for (int it = blockIdx.x; it < DEPTH * 96; it += F.G) { const int l = it / 96, n0 = (it % 96) * 64;
            const float* wp = a.in[4] + ((size_t)l * D + F.wave * 128) * (NMOD * D) + n0 + f_lane;
            float accv[9];
#pragma unroll
            for (int r = 0; r < 9; ++r) accv[r] = 0.f;
            for (int k0 = 0; k0 < 128; k0 += 32) { float wv[32];
#pragma unroll
                for (int k = 0; k < 32; ++k) wv[k] = wp[(size_t)(k0 + k) * (NMOD * D)];
#pragma unroll
                for (int k = 0; k < 32; ++k)
#pragma unroll
                    for (int r = 0; r < 9; ++r) accv[r] += S[r * 1024 + F.wave * 128 + k0 + k] * wv[k]; }
#pragma unroll
            for (int r = 0; r < 9; ++r) red[(F.wave * 9 + r) * 64 + f_lane] = accv[r];
            __syncthreads();
            for (int i = f_tid; i < 9 * 64; i += 512) { const int r = i >> 6, ln = i & 63; float s = a.in[5][(size_t)l * (NMOD * D) + n0 + ln];
#pragma unroll
                for (int w = 0; w < 8; ++w) s += red[(w * 9 + r) * 64 + ln];
                ((float*)(ws + WS_MOD))[((size_t)l * 9 + r) * (NMOD * D) + n0 + ln] = s; }
            __syncthreads();
        }
    }
}

__device__ __forceinline__ void load_row(const float* p, int lane, f32x4 (&v)[4]) {
#pragma unroll
    for (int j = 0; j < 4; ++j) v[j] = ((const f32x4*)p)[lane + 64 * j];
}
__device__ __forceinline__ void load_row_bf(const bf16* p, int lane, f32x4 (&v)[4]) {
#pragma unroll
    for (int j = 0; j < 4; ++j) { const v2u w = ((const v2u*)p)[lane + 64 * j]; v[j] = (f32x4){bf_lo(w.x), bf_hi(w.x), bf_lo(w.y), bf_hi(w.y)}; }
}
__device__ __forceinline__ void norm_mod(f32x4 (&v)[4], const float* g, const float* shift, const float* scale, int lane) {
    float s = 0.f;
#pragma unroll
    for (int j = 0; j < 4; ++j) s += (v[j][0] * v[j][0] + v[j][1] * v[j][1]) + (v[j][2] * v[j][2] + v[j][3] * v[j][3]);
    const float rstd = rsqrtf(wave_sum(s, lane) * (1.f / D) + EPS);
#pragma unroll
    for (int j = 0; j < 4; ++j) { const f32x4 gv = ((const f32x4*)g)[lane + 64 * j], sh = ((const f32x4*)shift)[lane + 64 * j], sc = ((const f32x4*)scale)[lane + 64 * j];
        v[j] = (v[j] * rstd * gv) * (sc + 1.f) + sh; }
}
__device__ __forceinline__ void store_row_bf16(bf16* p, int lane, const f32x4 (&v)[4]) {
#pragma unroll
    for (int j = 0; j < 4; ++j) { v2u w; w.x = pk2(v[j][0], v[j][1]); w.y = pk2(v[j][2], v[j][3]); ((v2u*)p)[lane + 64 * j] = w; }
}

__device__ __forceinline__ float store_row_i8(unsigned char* p, int lane, const f32x4 (&v)[4]) {
    float am = 0.f;
#pragma unroll
    for (int j = 0; j < 4; ++j) am = fmaxf(fmaxf(am, fmaxf(fabsf(v[j][0]), fabsf(v[j][1]))), fmaxf(fabsf(v[j][2]), fabsf(v[j][3])));
    unsigned k = __float_as_uint(am);
    { unsigned t;
      t = (unsigned)__builtin_amdgcn_mov_dpp((int)k, 0xb1, 0xf, 0xf, false); k = k > t ? k : t;
      t = (unsigned)__builtin_amdgcn_mov_dpp((int)k, 0x4e, 0xf, 0xf, false); k = k > t ? k : t;
      t = (unsigned)__builtin_amdgcn_mov_dpp((int)k, 0x124, 0xf, 0xf, false); k = k > t ? k : t;
      t = (unsigned)__builtin_amdgcn_mov_dpp((int)k, 0x128, 0xf, 0xf, false); k = k > t ? k : t;
      const unsigned a = (unsigned)__builtin_amdgcn_readlane((int)k, 0), b = (unsigned)__builtin_amdgcn_readlane((int)k, 16), c = (unsigned)__builtin_amdgcn_readlane((int)k, 32), d = (unsigned)__builtin_amdgcn_readlane((int)k, 48);
      const unsigned ab = a > b ? a : b, cd = c > d ? c : d; k = ab > cd ? ab : cd; }
    const float amax = __uint_as_float(k);
    const float qscale = amax > 0.f ? amax * (1.f / 127.f) : 1.f, qinv = amax > 0.f ? 127.f / amax : 0.f;
#pragma unroll
    for (int j = 0; j < 4; ++j) { unsigned w = 0;
#pragma unroll
        for (int q = 0; q < 4; ++q) { int qi = __float2int_rn(v[j][q] * qinv); qi = qi > 127 ? 127 : (qi < -127 ? -127 : qi); w |= ((unsigned)qi & 255u) << (8 * q); }
        ((unsigned*)p)[lane + 64 * j] = w; }
    return qscale;
}
__device__ __forceinline__ void quant_rows(Frame& F, const bf16* src, unsigned char* dst, float* scale, int R) {
    const int f_lane = lthread(F.wave) & 63;
    for (int r = F.gw; r < R; r += F.NGW) { f32x4 v[4]; load_row_bf(src + (size_t)r * 1024, f_lane, v);
        const float sc = store_row_i8(dst + (size_t)r * 1024, f_lane, v); if (f_lane == 0) scale[r] = sc; }
}
__device__ __forceinline__ void rp_norm1(Frame& F, const Args& a, int l, int row_lo) {
    const int f_tid = lthread(F.wave), f_lane = f_tid & 63;
    const bf16* X = (const bf16*)(F.ws + WS_X); bf16* H = (bf16*)(F.ws + WS_H); const float* MOD = (const float*)(F.ws + WS_MOD) + (size_t)l * 9 * (NMOD * D);
    for (int row = row_lo + F.gw; row < NT; row += F.NGW) { f32x4 v[4];
        if (l == 0) load_row(row < NC ? a.in[2] + (size_t)row * D : a.in[0] + (size_t)(row - NC) * D, f_lane, v);
        else load_row_bf(X + (size_t)row * D, f_lane, v);
        const float* m = MOD + (size_t)modrow_of(row) * (NMOD * D);
        norm_mod(v, a.in[6] + (size_t)l * D, m, m + D, f_lane);
        const float sc = store_row_i8((unsigned char*)H + (size_t)row * D, f_lane, v); if (f_lane == 0) ((float*)(F.ws + WS_SH))[row] = sc; }
}

#if MK_N2V2
constexpr int LDS_LIST = LDS_MISC + 768;
__device__ __forceinline__ unsigned row16_max(unsigned k) {
    unsigned t;
    t = (unsigned)__builtin_amdgcn_mov_dpp((int)k, 0xb1, 0xf, 0xf, false); k = k > t ? k : t;
    t = (unsigned)__builtin_amdgcn_mov_dpp((int)k, 0x4e, 0xf, 0xf, false); k = k > t ? k : t;
    t = (unsigned)__builtin_amdgcn_mov_dpp((int)k, 0x124, 0xf, 0xf, false); k = k > t ? k : t;
    t = (unsigned)__builtin_amdgcn_mov_dpp((int)k, 0x128, 0xf, 0xf, false); k = k > t ? k : t;
    return k;
}
__device__ __forceinline__ unsigned wave_max_u(unsigned k) {
    k = row16_max(k);
    const unsigned a = (unsigned)__builtin_amdgcn_readlane((int)k, 0), b = (unsigned)__builtin_amdgcn_readlane((int)k, 16), c = (unsigned)__builtin_amdgcn_readlane((int)k, 32), d = (unsigned)__builtin_amdgcn_readlane((int)k, 48);
    const unsigned ab = a > b ? a : b, cd = c > d ? c : d; return ab > cd ? ab : cd;
}
__device__ __forceinline__ float key_val(unsigned m) { const unsigned u = m & ~31u; return __builtin_bit_cast(float, (u & 0x80000000u) ? (u ^ 0x80000000u) : ~u); }
__device__ __forceinline__ void rp_norm2_router(Frame& F, const Args& a, int l, int row_lo) {
    const int f_tid = lthread(F.wave), f_lane = f_tid & 63;
    const bf16* X = (const bf16*)(F.ws + WS_X); bf16* H = (bf16*)(F.ws + WS_H); const float* MOD = (const float*)(F.ws + WS_MOD) + (size_t)l * 9 * (NMOD * D);
    LAS float* wt = (LAS float*)F.lds;
    { const f32x4* src = (const f32x4*)((const float*)(F.ws + WS_WRT) + (size_t)l * NE * D); f32x4 tv[16];
#pragma unroll
      for (int i = 0; i < 16; ++i) tv[i] = src[f_tid + 512 * i];
#pragma unroll
      for (int i = 0; i < 16; ++i) ((LAS f32x4*)wt)[f_tid + 512 * i] = tv[i]; }
    LAS int* lcnt = (LAS int*)(F.lds + LDS_TT); LAS int* lbase = lcnt + 32;
    LAS v4u* list = (LAS v4u*)(F.lds + LDS_LIST) + F.wave * 68;
    LAS float* lsc = (LAS float*)(F.lds + LDS_LIST + 8 * 68 * 16) + F.wave * 68;
    if (f_tid < 32) lcnt[f_tid] = 0;
    __syncthreads();
    const float* gf = a.in[7] + (size_t)l * D;
    f32x4 gv[4];
#pragma unroll
    for (int j = 0; j < 4; ++j) gv[j] = ((const f32x4*)gf)[f_lane + 64 * j];
    const int my_e = f_lane >> 1;
    const float my_b = a.in[22][(size_t)l * NE + my_e];
    int row = row_lo + F.gw, it = 0;
    f32x4 vn[4];
    if (row < NT) load_row_bf(X + (size_t)row * D, f_lane, vn);
    for (; row < NT; row += F.NGW, ++it) {
        f32x4 v[4], sh[4], sc[4];
        const float* m = MOD + (size_t)modrow_of(row) * (NMOD * D);
#pragma unroll
        for (int j = 0; j < 4; ++j) { sh[j] = ((const f32x4*)(m + 3 * D))[f_lane + 64 * j]; sc[j] = ((const f32x4*)(m + 4 * D))[f_lane + 64 * j]; }
        asm volatile("" ::: "memory");
#pragma unroll
        for (int j = 0; j < 4; ++j) v[j] = vn[j];
        { const int nrow = row + F.NGW; if (nrow < NT) load_row_bf(X + (size_t)nrow * D, f_lane, vn); }
        float ssq = 0.f;
#pragma unroll
        for (int j = 0; j < 4; ++j) ssq += (v[j][0] * v[j][0] + v[j][1] * v[j][1]) + (v[j][2] * v[j][2] + v[j][3] * v[j][3]);
        const float rstd = rsqrtf(wave_sum(ssq, f_lane) * (1.f / D) + EPS);
#pragma unroll
        for (int j = 0; j < 4; ++j) v[j] = (v[j] * rstd * gv[j]) * (sc[j] + 1.f) + sh[j];
        const float qscale = store_row_i8((unsigned char*)H + (size_t)row * D, f_lane, v);
        float p[32];
#pragma unroll
        for (int e = 0; e < 32; ++e) { f32x2 s2 = (f32x2){0.f, 0.f};
#pragma unroll
            for (int j = 0; j < 4; ++j) { const f32x4 w = ((const LAS f32x4*)(wt + e * 1024))[f_lane + 64 * j];
                s2 = __builtin_elementwise_fma((f32x2){v[j][0], v[j][1]}, (f32x2){w[0], w[1]}, s2); s2 = __builtin_elementwise_fma((f32x2){v[j][2], v[j][3]}, (f32x2){w[2], w[3]}, s2); }
            p[e] = s2[0] + s2[1]; }
#pragma unroll
        for (int s = 0; s < 5; ++s) { const int half = 16 >> s, msk = 32 >> s; const bool up = (f_lane & msk) != 0;
#pragma unroll
            for (int i = 0; i < half; ++i) { const float keep = up ? p[i + half] : p[i], send = up ? p[i] : p[i + half]; p[i] = keep + shx(send, msk, f_lane); } }
        const float lgt = p[0] + shx(p[0], 1, f_lane) + my_b;
        unsigned key; { const unsigned u = __builtin_bit_cast(unsigned, lgt); const unsigned o = (u & 0x80000000u) ? ~u : (u | 0x80000000u); key = (o & ~31u) | (unsigned)(31 - my_e); }
        unsigned mk[4];
#pragma unroll
        for (int k = 0; k < 4; ++k) { mk[k] = wave_max_u(key); key = (key == mk[k]) ? 0u : key; }
        const float b0 = key_val(mk[0]);
        const float e1 = __expf(key_val(mk[1]) - b0), e2 = __expf(key_val(mk[2]) - b0), e3 = __expf(key_val(mk[3]) - b0); const float inv = 1.f / (1.f + e1 + e2 + e3);
        if (f_lane < 4) { const unsigned mm = f_lane == 0 ? mk[0] : f_lane == 1 ? mk[1] : f_lane == 2 ? mk[2] : mk[3]; const int me = 31 - (int)(mm & 31u);
            const float mw = (f_lane == 0 ? 1.f : f_lane == 1 ? e1 : f_lane == 2 ? e2 : e3) * inv;
            const int lr = __hip_atomic_fetch_add(lcnt + me, 1, __ATOMIC_RELAXED, __HIP_MEMORY_SCOPE_WORKGROUP);
            LAS unsigned* ep = (LAS unsigned*)(list + it * 4 + f_lane); ep[0] = (unsigned)(row * 4 + f_lane); ep[1] = (unsigned)me; ep[2] = (unsigned)lr; ep[3] = __builtin_bit_cast(unsigned, mw);
            lsc[it * 4 + f_lane] = qscale; }
    }
    __syncthreads();
    if (f_tid < 32) { const int c = lcnt[f_tid]; lbase[f_tid] = c ? (int)__hip_atomic_fetch_add((unsigned*)(F.ctl + CW_CNT + (l * 32 + f_tid) * 16), (unsigned)c, RLX_AGENT) : 0; }
    __syncthreads();
    int* te = (int*)(F.ws + WS_TE); int* trank = (int*)(F.ws + WS_TRANK); int* stok = (int*)(F.ws + WS_STOK); float* sw = (float*)(F.ws + WS_SW); float* ssc = (float*)(F.ws + WS_SSC);
    for (int i = f_lane; i < it * 4; i += 64) { const LAS unsigned* ep = (const LAS unsigned*)(list + i); const unsigned rowk = ep[0], ex = ep[1], lr = ep[2]; const float wv = __builtin_bit_cast(float, ep[3]);
        const int rk = lbase[ex] + (int)lr;
        stok[(size_t)ex * CAP + rk] = (int)(rowk >> 2); sw[(size_t)ex * CAP + rk] = wv; ssc[(size_t)ex * CAP + rk] = lsc[i]; te[rowk] = (int)ex; trank[rowk] = rk; }
}

#endif
__device__ __forceinline__ void moe_table(Frame& F, int l) {
    const int f_tid = lthread(F.wave), f_lane = f_tid & 63;
    LAS int* TT = (LAS int*)(F.lds + LDS_TT); LAS int* CN = TT + 64; LAS int* TE = (LAS int*)(F.lds + LDS_TE);
    __syncthreads();
    if (f_tid < 64) {
        const int c = (f_lane < 32) ? (int)__hip_atomic_load((unsigned*)(F.ctl + CW_CNT + (l * 32 + (f_lane & 31)) * 16), RLX_AGENT) : 0;
        const int tl = (c + 255) >> 8; int v = tl;
#pragma unroll
        for (int o = 1; o < 32; o <<= 1) { const int n = __builtin_amdgcn_ds_bpermute((f_lane >= o ? f_lane - o : f_lane) << 2, v); if (f_lane >= o) v += n; }
        if (f_lane < 32) { CN[f_lane] = c; TT[f_lane] = v - tl; if (f_lane == 31) TT[32] = v; }
    }
    __syncthreads();
    for (int t = f_tid; t < MAXTILES; t += 512) { int lo = 0, hi = 32;
#pragma unroll
        for (int k = 0; k < 5; ++k) { const int mid = (lo + hi) >> 1; if (TT[mid] <= t) lo = mid; else hi = mid; }
        TE[t] = lo; }
    __syncthreads();
}

#if MK_CBV2
struct CombRow { v2u x[4]; v2u y[4][4]; };
__device__ __forceinline__ void comb_issue(CombRow& R, const bf16* X, const bf16* Y, const LAS int* TT, int row, const v4u te4, const v4u tr4, int lane) {
    const unsigned ee[4] = {te4[0], te4[1], te4[2], te4[3]}, rr[4] = {tr4[0], tr4[1], tr4[2], tr4[3]};
#pragma unroll
    for (int k = 0; k < 4; ++k) { const size_t slot = (size_t)TT[ee[k]] * 256 + rr[k]; const v2u* yp = (const v2u*)(Y + slot * 1024);
#pragma unroll
        for (int j = 0; j < 4; ++j) R.y[k][j] = yp[lane + 64 * j]; }
#pragma unroll
    for (int j = 0; j < 4; ++j) R.x[j] = ((const v2u*)(X + (size_t)row * D))[lane + 64 * j];
}
__device__ __forceinline__ void comb_finish(const CombRow& R, Frame& F, const Args& a, int l, int row, int lane, const float* MOD, const float* MODN, bool lastl) {
    bf16* X = (bf16*)(F.ws + WS_X); bf16* H = (bf16*)(F.ws + WS_H);
    const int mr = modrow_of(row); const float* g5 = MOD + (size_t)mr * (NMOD * D) + 5 * D;
    f32x4 v[4];
#pragma unroll
    for (int j = 0; j < 4; ++j) { f32x4 s = (f32x4){0.f, 0.f, 0.f, 0.f};
#pragma unroll
        for (int k = 0; k < 4; ++k) { const v2u w = R.y[k][j]; s[0] += bf_lo(w.x); s[1] += bf_hi(w.x); s[2] += bf_lo(w.y); s[3] += bf_hi(w.y); }
        const f32x4 gv = ((const f32x4*)g5)[lane + 64 * j]; const v2u xw = R.x[j]; v[j] = (f32x4){bf_lo(xw.x), bf_hi(xw.x), bf_lo(xw.y), bf_hi(xw.y)} + gv * s; }
    if (!lastl) {
        store_row_bf16(X + (size_t)row * D, lane, v);
        const float* m = MODN + (size_t)mr * (NMOD * D);
        norm_mod(v, a.in[6] + (size_t)(l + 1) * D, m, m + D, lane);
        const float sc = store_row_i8((unsigned char*)H + (size_t)row * D, lane, v); if (lane == 0) ((float*)(F.ws + WS_SH))[row] = sc;
    } else {
        float ss = 0.f;
#pragma unroll
        for (int j = 0; j < 4; ++j) ss += (v[j][0] * v[j][0] + v[j][1] * v[j][1]) + (v[j][2] * v[j][2] + v[j][3] * v[j][3]);
        const float rstd = rsqrtf(wave_sum(ss, lane) * (1.f / D) + EPS);
        float* op = a.out + (size_t)(row - NC) * D;
#pragma unroll
        for (int j = 0; j < 4; ++j) { const f32x4 gv = ((const f32x4*)a.in[8])[lane + 64 * j]; ((f32x4*)op)[lane + 64 * j] = v[j] * rstd * gv; }
    }
}
__device__ __forceinline__ void rp_combine(Frame& F, const Args& a, int l, int row_lo) {
    const int f_tid = lthread(F.wave), f_lane = f_tid & 63;
    const bf16* X = (const bf16*)(F.ws + WS_X); const bf16* Y = (const bf16*)(F.ws + WS_Y);
    const float* MOD = (const float*)(F.ws + WS_MOD) + (size_t)l * 9 * (NMOD * D); const float* MODN = MOD + 9 * (NMOD * D);
    const v4u* te = (const v4u*)(F.ws + WS_TE); const v4u* trank = (const v4u*)(F.ws + WS_TRANK);
    const LAS int* TT = (const LAS int*)(F.lds + LDS_TT);
    const bool lastl = (l == DEPTH - 1);
    const int st = F.NGW;
    int row = row_lo + F.gw;
    if (row >= NT) return;
    CombRow RA, RB;
    v4u te1 = te[row], tr1 = trank[row];
    comb_issue(RA, X, Y, TT, row, te1, tr1, f_lane);
    if (row + st < NT) { te1 = te[row + st]; tr1 = trank[row + st]; }
    for (;;) {
        const bool h1 = row + st < NT;
        if (h1) comb_issue(RB, X, Y, TT, row + st, te1, tr1, f_lane);
        if (row + 2 * st < NT) { te1 = te[row + 2 * st]; tr1 = trank[row + 2 * st]; }
        comb_finish(RA, F, a, l, row, f_lane, MOD, MODN, lastl);
        if (!h1) break;
        row += st;
        const bool h2 = row + st < NT;
        if (h2) comb_issue(RA, X, Y, TT, row + st, te1, tr1, f_lane);
        if (row + 2 * st < NT) { te1 = te[row + 2 * st]; tr1 = trank[row + 2 * st]; }
        comb_finish(RB, F, a, l, row, f_lane, MOD, MODN, lastl);
        if (!h2) break;
        row += st;
    }
}

#endif
__device__ __forceinline__ void rp_mla(Frame& F, const Args& a) {
    const int f_tid = lthread(F.wave), f_lane = f_tid & 63;
    const bf16* A = (const bf16*)(F.ws + WS_RE); bf16* QA = (bf16*)(F.ws + WS_RF); bf16* CKV = (bf16*)(F.ws + WS_RG); bf16* Kb = (bf16*)(F.ws + WS_RB);
    const float* rope = (const float*)(F.ws + WS_ROPE); const float* gq = a.in[12]; const float* gk = a.in[14];
    for (int row = F.gw; row < NT; row += F.NGW) {
        const unsigned* ap = (const unsigned*)(A + (size_t)row * MLA_IN_PAD);
        unsigned q[3], c[2];
#pragma unroll
        for (int j = 0; j < 3; ++j) q[j] = ap[f_lane + 64 * j];
#pragma unroll
        for (int j = 0; j < 2; ++j) c[j] = ap[192 + f_lane + 64 * j];
        const unsigned pe = ap[320 + (f_lane & 15)];
        float sq = 0.f, sc = 0.f;
#pragma unroll
        for (int j = 0; j < 3; ++j) { const float x0 = bf_lo(q[j]), x1 = bf_hi(q[j]); sq += x0 * x0 + x1 * x1; }
#pragma unroll
        for (int j = 0; j < 2; ++j) { const float x0 = bf_lo(c[j]), x1 = bf_hi(c[j]); sc += x0 * x0 + x1 * x1; }
        const float rq = rsqrtf(wave_sum(sq, f_lane) * (1.f / MLA_QL) + EPS), rc = rsqrtf(wave_sum(sc, f_lane) * (1.f / MLA_KVL) + EPS);
#pragma unroll
        for (int j = 0; j < 3; ++j) { const int e0 = 2 * (f_lane + 64 * j); ((unsigned*)(QA + (size_t)row * MLA_QL))[f_lane + 64 * j] = pk2(bf_lo(q[j]) * rq * gq[e0], bf_hi(q[j]) * rq * gq[e0 + 1]); }
#pragma unroll
        for (int j = 0; j < 2; ++j) { const int e0 = 2 * (f_lane + 64 * j); ((unsigned*)(CKV + (size_t)row * MLA_KVL))[f_lane + 64 * j] = pk2(bf_lo(c[j]) * rc * gk[e0], bf_hi(c[j]) * rc * gk[e0 + 1]); }
        float x0 = bf_lo(pe), x1 = bf_hi(pe);
        if (row >= NC) { const int t = (row - NC) & 4095, i = f_lane & 15, d = 2 * i, pos = (d & 16) ? (t & 63) : (t >> 6), f = d & 7;
            const float p0 = shx(x0, 4, f_lane), p1 = shx(x1, 4, f_lane); const float sg = (d & 8) ? 1.f : -1.f;
            const float* rp = rope + (size_t)pos * 16 + 2 * f; x0 = x0 * rp[0] + sg * p0 * rp[1]; x1 = x1 * rp[2] + sg * p1 * rp[3]; }
        const unsigned w = pk2(x0, x1);
        { const int i = f_lane & 15, hb = f_lane >> 4;
#pragma unroll
          for (int hh = 0; hh < 4; ++hh) { const int h = hb * 4 + hh; ((unsigned*)(Kb + (size_t)row * 1536 + 96 * h + 64))[i] = w; } }
    }
}

__device__ __forceinline__ void rp_gqa(Frame& F, const Args& a) {
    const int f_tid = lthread(F.wave), f_lane = f_tid & 63;
    const bf16* A = (const bf16*)(F.ws + WS_RA); bf16* Q = (bf16*)(F.ws + WS_RB); bf16* Kb = Q + (size_t)NT * 1024;
    const float* rope = (const float*)(F.ws + WS_ROPE) + 2048; const float* gq = a.in[18]; const float* gk = a.in[19];
    const float c2 = 0.125f * LOG2E;
    for (int row = F.gw; row < NT; row += F.NGW) {
        const bool lat = row >= NC; const int t = (row - NC) & 4095;
#pragma unroll
        for (int part = 0; part < 2; ++part) {
            const int ln = part ? (f_lane & 15) : f_lane; const bf16* src = A + (size_t)row * GQA_QKV + (part ? 1024 : 0) + ln * 16;
            const v4u w0 = *(const v4u*)src, w1 = *(const v4u*)(src + 8);
            float x[16]; const unsigned ww[8] = {w0.x, w0.y, w0.z, w0.w, w1.x, w1.y, w1.z, w1.w};
#pragma unroll
            for (int i = 0; i < 8; ++i) { x[2 * i] = bf_lo(ww[i]); x[2 * i + 1] = bf_hi(ww[i]); }
            float ss = 0.f;
#pragma unroll
            for (int i = 0; i < 16; ++i) ss += x[i] * x[i];
            ss += shx(ss, 1, f_lane); ss += shx(ss, 2, f_lane);
            const float rs = rsqrtf(ss * (1.f / 64.f) + EPS); const float* g = (part ? gk : gq) + (ln & 3) * 16;
#pragma unroll
            for (int i = 0; i < 16; ++i) x[i] = x[i] * rs * g[i];
            if (lat) { const int sec = (ln >> 1) & 1, pos = sec ? (t & 63) : (t >> 6); const float sg = (ln & 1) ? 1.f : -1.f; const float* rp = rope + (size_t)pos * 32;
#pragma unroll
                for (int i = 0; i < 16; ++i) { const float pr = shx(x[i], 1, f_lane); x[i] = x[i] * rp[2 * i] + sg * pr * rp[2 * i + 1]; } }
            const float scl = part ? 1.f : c2;
            v4u o0, o1; o0.x = pk2(x[0] * scl, x[1] * scl); o0.y = pk2(x[2] * scl, x[3] * scl); o0.z = pk2(x[4] * scl, x[5] * scl); o0.w = pk2(x[6] * scl, x[7] * scl);
            o1.x = pk2(x[8] * scl, x[9] * scl); o1.y = pk2(x[10] * scl, x[11] * scl); o1.z = pk2(x[12] * scl, x[13] * scl); o1.w = pk2(x[14] * scl, x[15] * scl);
            if (part == 0) { bf16* d = Q + (size_t)row * 1024 + ln * 16; *(v4u*)d = o0; *(v4u*)(d + 8) = o1; }
            else if (f_lane < 16) { bf16* d = Kb + (size_t)row * 256 + ln * 16; *(v4u*)d = o0; *(v4u*)(d + 8) = o1; }
        }
    }
}

template <int DK>
__device__ __forceinline__ void attn_phase(Frame& F, const att::Tens& T, int kvshift  , int kstride, int vstride, int vbase) {
    const int vcu = (F.G % 8 == 0) ? (blockIdx.x % 8) * (F.G / 8) + blockIdx.x / 8 : blockIdx.x;
    att::Pend pend; pend.valid = false; pend.o0 = f32x16{}; pend.o1 = f32x16{}; pend.l = 1.f; pend.qrow0 = 0; pend.oc0 = 0;
    for (int u = vcu; u < 2048 + 128; u += F.G) {
        if (u < 2048) { const int b = u >> 8, h = (u >> 4) & 15, qb = u & 15, kvh = h >> kvshift;
            att::unit<DK>(T, NC + b * SEQ + qb * 256, h * DK, kvh * kstride, vbase + kvh * vstride, h * 64, b * LCTX, NC + b * SEQ, 68, F.lds, F.wave, pend); }
        else { const int q = u - 2048, b = q >> 4, h = q & 15, kvh = h >> kvshift;
            att::unit<DK>(T, b * LCTX, h * DK, kvh * kstride, vbase + kvh * vstride, h * 64, b * LCTX, 0, 4, F.lds, F.wave, pend); }
    }
    if (pend.valid) att::finish_unit(pend, T.O, F.lds, F.wave, lthread(F.wave) & 63);
    __syncthreads();
}

constexpr int PH_PER_LAYER = 9, PH_TOTAL = 2 + DEPTH * PH_PER_LAYER;
__global__ void __launch_bounds__(512, 2) mk_fwd(Args args) {
    extern __shared__ __attribute__((aligned(16))) unsigned char lds_raw[];
    Frame F;
    F.lds = (LAS unsigned char*)lds_raw; F.ws = args.ws; F.ctl = (gu32*)(args.ws + WS_CTL);
    F.wave = __builtin_amdgcn_readfirstlane(threadIdx.x >> 6); F.G = gridDim.x;
    F.gw = blockIdx.x * 8 + F.wave; F.NGW = F.G * 8;
    if (threadIdx.x < 4) ((LAS unsigned*)(F.lds + LDS_XB))[threadIdx.x] = 0u;
    __syncthreads();
    const int lo = args.ph_lo, hi = args.ph_hi;
    const bool multi = (hi - lo) > 1;
    XcdBarrier bar; bar.bar = (unsigned*)(F.ctl + CW_BAR); bar.x = 0; bar.st = nullptr; bar.wave = F.wave;
    if (multi) bar = xcd_barrier_post((unsigned*)(F.ctl + CW_BAR), (volatile LAS unsigned*)(F.lds + LDS_XB), F.wave);
#define IN(k) (lo <= (k) && (k) < hi)
#define SEAM(k) do { if (IN(k) && IN((k) + 1)) xcd_barrier(bar); } while (0)
    unsigned char* ws0 = args.ws;
#define PH_WS size_t zofs_ = 0; asm volatile("" : "+s"(zofs_)); unsigned char* ws = ws0 + zofs_; F.ws = ws; F.ctl = (gu32*)ws;
    const int G = F.G, cidx = (int)blockIdx.x;

    if (IN(0) && EN(0)) { PH_WS REP(0) { prologue(F, args); SEAM(0); } }
    if (IN(1) && EN(1)) { PH_WS rp_norm1(F, args, 0, 0);
        quant_rows(F, (const bf16*)(ws + WS_WFIN), (unsigned char*)(ws + WS_W8), (float*)(ws + WS_SWP), 2 * 2048);
        quant_rows(F, (const bf16*)(ws + WS_WMIN), (unsigned char*)(ws + WS_W8) + 4 * MiB, (float*)(ws + WS_SWP) + 4096, MLA_IN_PAD);
        quant_rows(F, (const bf16*)(ws + WS_WGQKV), (unsigned char*)(ws + WS_W8) + 5 * MiB, (float*)(ws + WS_SWP) + 4864, GQA_QKV); SEAM(1); }

    for (int l = 0; l < DEPTH; ++l) {
        const int kind = l % 3, j = l / 3, base = 2 + l * PH_PER_LAYER;
        const bool lastl = (l == DEPTH - 1);

        size_t outB = 0;
        if (kind == 0) {
            if (IN(base + 0) && EN(2)) { PH_WS REP(2) { PolFP p; p.A = (const char*)(ws + WS_W8) + (size_t)j * 2048 * D; p.B = (const char*)(ws + WS_H); p.nt = 8; p.sW = (const float*)(ws + WS_SWP) + j * 2048; p.sH = (const float*)(ws + WS_SH); p.nN = lastl ? 128 : 136; p.G = G; p.c = cidx;
                p.Z = (bf16*)(ws + WS_RA); p.Zc = (bf16*)(ws + WS_RH); pg8::gemm_phase(F.lds, p, F.wave); } }
            SEAM(base + 0);
            if (IN(base + 1) && EN(3)) { PH_WS REP(3) { PolFA p; p.A = (const char*)(ws + WS_MA); p.B = (const char*)(ws + WS_RA); p.nt = 4; p.G = G; p.c = cidx; p.Y = (bf16*)(ws + WS_RB); pg8::gemm_phase(F.lds, p, F.wave); } }
            SEAM(base + 1);
            if (IN(base + 2) && EN(4)) { PH_WS REP(4) { PolFC p; p.A = (const char*)(ws + WS_DC); p.B = (const char*)(ws + WS_RB); p.nt = 8; p.G = G; p.c = cidx; p.nunits = lastl ? 512 : 544;
                p.offMC = (unsigned)(WS_MC - WS_DC); p.offZc = (unsigned)(WS_RH - WS_RB); p.F = (bf16*)(ws + WS_RC); pg8::gemm_phase(F.lds, p, F.wave); } }
            SEAM(base + 2);
            outB = WS_WFOUT + (size_t)j * D * D * 2;
        } else if (kind == 1) {
            if (IN(base + 0) && EN(5)) { PH_WS REP(5) { PolDenseI8 p; p.A = (const char*)(ws + WS_H); p.B = (const char*)(ws + WS_W8) + 4 * MiB; p.nt = 8; p.nM = NT / 256; p.nN = 3; p.pm0 = 0; p.G = G; p.c = cidx; p.sA = (const float*)(ws + WS_SH); p.sB = (const float*)(ws + WS_SWP) + 4096;
                p.O = (bf16*)(ws + WS_RE); p.ldo = MLA_IN_PAD; pg8::gemm_phase(F.lds, p, F.wave); } }
            SEAM(base + 0);
            if (IN(base + 1) && EN(6)) { PH_WS REP(6) { rp_mla(F, args); } }
            SEAM(base + 1);
            if (IN(base + 2)) { PH_WS REP(7) {
                if (EN(7)) { PolMlaQ p; p.A = (const char*)(ws + WS_RF); p.B = (const char*)(ws + WS_WMQB); p.nt = 6; p.nM = NT / 256; p.nN = 6; p.G = G; p.c = cidx; p.Q = (bf16*)(ws + WS_RA);
                  p.rope = (const float*)(ws + WS_ROPE); p.c2 = 0.10206207261596575f * LOG2E; pg8::gemm_phase(F.lds, p, F.wave); }
                if (EN(8)) { PolMlaKV p; p.A = (const char*)(ws + WS_RG); p.B = (const char*)(ws + WS_WMKVB); p.nt = 4; p.nM = NT / 256; p.nN = 8; p.G = G; p.c = cidx; p.Kb = (bf16*)(ws + WS_RB); p.Vb = (bf16*)(ws + WS_RD);
                  pg8::gemm_phase(F.lds, p, F.wave); }
            } }
            SEAM(base + 2);
            if (IN(base + 3) && EN(9)) { PH_WS REP(9) { att::Tens T{(const bf16*)(ws + WS_RA), 1536, (const bf16*)(ws + WS_RB), 1536, (const bf16*)(ws + WS_RD), 1024, (bf16*)(ws + WS_RC)}; attn_phase<96>(F, T, 0, 96, 64, 0); } }
            SEAM(base + 3);
            outB = WS_WMO;
        } else {
            if (IN(base + 0) && EN(10)) { PH_WS REP(10) { PolDenseI8 p; p.A = (const char*)(ws + WS_H); p.B = (const char*)(ws + WS_W8) + 5 * MiB; p.nt = 8; p.nM = NT / 256; p.nN = 6; p.pm0 = 0; p.G = G; p.c = cidx; p.sA = (const float*)(ws + WS_SH); p.sB = (const float*)(ws + WS_SWP) + 4864;
                p.O = (bf16*)(ws + WS_RA); p.ldo = GQA_QKV; pg8::gemm_phase(F.lds, p, F.wave); } }
            SEAM(base + 0);
            if (IN(base + 1) && EN(11)) { PH_WS REP(11) { rp_gqa(F, args); } }
            SEAM(base + 1);
            if (IN(base + 2) && EN(12)) { PH_WS REP(12) { att::Tens T{(const bf16*)(ws + WS_RB), 1024, (const bf16*)(ws + WS_RB) + (size_t)NT * 1024, 256, (const bf16*)(ws + WS_RA), 1536, (bf16*)(ws + WS_RC)}; attn_phase<64>(F, T, 2, 64, 64, 1280); } }
            SEAM(base + 2);
            outB = WS_WGO;
        }
        if (IN(base + 4) && EN(13)) { PH_WS PolOut p; p.A = (const char*)(ws + WS_RC); p.B = (const char*)(ws + outB); p.nt = 16; p.nM = lastl ? NL / 256 : NT / 256; p.nN = 4; p.pm0 = lastl ? 8 : 0; p.G = G; p.c = cidx; p.X = (bf16*)(ws + WS_X); p.mod = (const float*)(ws + WS_MOD) + (size_t)l * 9 * (NMOD * D); p.chunk = 2;
            p.XinC = (l == 0) ? args.in[2] : nullptr; p.XinL = (l == 0) ? args.in[0] - (size_t)NC * D : nullptr;
            pg8::gemm_phase(F.lds, p, F.wave); }
        SEAM(base + 4);
        if (IN(base + 5) && EN(14)) { PH_WS rp_norm2_router(F, args, l, lastl ? NC : 0); }
        SEAM(base + 5);
        if (IN(base + 6) && EN(15)) { PH_WS REP(15) { moe_table(F, l);
            PolMoe1 p; p.A = (const char*)(ws + WS_H); p.B = (const char*)(ws + WS_WGU) + (size_t)l * NE * 2048 * D; p.nt = 8; p.G = G; p.c = cidx;
            p.swgu = (const float*)(ws + WS_SWGU) + (size_t)l * NE * 2048; p.ssc = (const float*)(ws + WS_SSC);
            p.T.TT = (const LAS int*)(F.lds + LDS_TT); p.T.CN = p.T.TT + 64; p.T.TE = (const LAS int*)(F.lds + LDS_TE); p.stok = (const int*)(ws + WS_STOK); p.bgu = (const float*)(ws + WS_BGU) + (size_t)l * NE * 2048; p.act = (unsigned char*)(ws + WS_ACT);
            pg8::gemm_phase(F.lds, p, F.wave); } }
        SEAM(base + 6);
        if (IN(base + 7) && EN(16)) { PH_WS REP(16) { moe_table(F, l);
            PolMoe2 p; p.A = (const char*)(ws + WS_ACT); p.B = (const char*)(ws + WS_WDN) + (size_t)l * NE * D * DFF; p.nt = 8; p.G = G; p.c = cidx; p.swd = (const float*)(ws + WS_SWDN) + (size_t)l * NE * D;
            p.T.TT = (const LAS int*)(F.lds + LDS_TT); p.T.CN = p.T.TT + 64; p.T.TE = (const LAS int*)(F.lds + LDS_TE); p.sw = (const float*)(ws + WS_SW); p.bdn = args.in[26] + (size_t)l * NE * D; p.Y = (bf16*)(ws + WS_Y);
            pg8::gemm_phase(F.lds, p, F.wave); } }
        SEAM(base + 7);
        if (IN(base + 8) && EN(17)) { PH_WS moe_table(F, l); rp_combine(F, args, l, lastl ? NC : 0); }
        SEAM(base + 8);
    }
#undef PH_WS
#undef IN
#undef SEAM
}

extern "C" void kernel_launch(void* const* d_in, const int* in_sizes, int n_in, void* d_out, int out_size, void* d_ws, size_t ws_size, hipStream_t stream) {
    static int grid = 0;
    if (grid == 0) {
        if (n_in != 27 || out_size != NL * D || ws_size < WS_END) { fprintf(stderr, "kernel_launch: unexpected problem (n_in %d, out %d, ws %zu < %zu)\n", n_in, out_size, ws_size, (size_t)WS_END); grid = -1; return; }
        int dev = 0, cus = 0, per_cu = 0;
        if (hipGetDevice(&dev) != hipSuccess || hipDeviceGetAttribute(&cus, hipDeviceAttributeMultiprocessorCount, dev) != hipSuccess) { grid = -1; return; }
        if (hipFuncSetAttribute((const void*)mk_fwd, hipFuncAttributeMaxDynamicSharedMemorySize, LDS_BYTES) != hipSuccess) { fprintf(stderr, "kernel_launch: hipFuncSetAttribute failed\n"); grid = -1; return; }
        if (hipOccupancyMaxActiveBlocksPerMultiprocessor(&per_cu, (const void*)mk_fwd, 512, LDS_BYTES) != hipSuccess || per_cu < 1) fprintf(stderr, "kernel_launch: occupancy query says %d\n", per_cu);
        (void)hipGetLastError();
        grid = cus;
    }
    if (grid < 0) return;
    (void)hipMemsetAsync((char*)d_ws + WS_CTL, 0, CTL_ZERO_BYTES, stream);
    Args a{};
    for (int i = 0; i < 27; ++i) a.in[i] = (const float*)d_in[i];
    a.out = (float*)d_out; a.ws = (unsigned char*)d_ws;
#if MK_PER_PHASE
    for (int ph = 0; ph < PH_TOTAL; ++ph) {
        const int l = (ph - 2) / PH_PER_LAYER, s = (ph - 2) % PH_PER_LAYER, kind = l % 3;
        if (ph >= 2) { if (s == 3 && kind != 1) continue; }
        a.ph_lo = ph; a.ph_hi = ph + 1;
        hipLaunchKernelGGL(mk_fwd, dim3(grid), dim3(512), LDS_BYTES, stream, a);
    }
#else
    a.ph_lo = 0; a.ph_hi = PH_TOTAL;
    hipLaunchKernelGGL(mk_fwd, dim3(grid), dim3(512), LDS_BYTES, stream, a);
#endif
}
```

```cpp
#include <hip/hip_runtime.h>
#include <cstdio>
#include <cstdint>

#ifndef MK_PER_PHASE
#define MK_PER_PHASE 0
#endif
#ifndef MK_N2V2
#define MK_N2V2 1
#endif
#ifndef MK_CBV2
#define MK_CBV2 1
#endif
#ifndef MK_N2AGG
#define MK_N2AGG 1
#endif
#ifndef MK_MASK
#define MK_MASK 0xFFFFFFFFu
#endif
#define EN(id) (((MK_MASK) >> (id)) & 1u)
#ifndef MK_REPMASK
#define MK_REPMASK 0u
#endif
#define REP(id) for (int rep_ = 0; rep_ < ((((MK_REPMASK) >> (id)) & 1u) ? 2 : 1); ++rep_)

constexpr int D = 1024, NB = 8, SEQ = 4096, LCTX = 256, DEPTH = 4;
constexpr int NC = NB * LCTX;
constexpr int NL = NB * SEQ;
constexpr int NT = NC + NL;
constexpr int NMOD = 6, NE = 32, TOPK = 4, DFF = 1024;
constexpr int MLA_QL = 384, MLA_KVL = 256, MLA_ROPE = 32, MLA_NOPE = 64, MLA_V = 64, MLA_IN = 672, MLA_IN_PAD = 768, MLA_QD = 96;
constexpr int GQA_NQ = 1024, GQA_NKV = 256, GQA_QKV = 1536;
constexpr int CAP = NT;
constexpr int MAXTILES = 576;
constexpr float EPS = 1e-6f;
constexpr float LOG2E = 1.4426950408889634f;

constexpr size_t MiB = 1u << 20;
constexpr size_t WS_CTL = 0, CTL_ZERO_BYTES = 96 * 1024;
constexpr size_t WS_MOD = 1 * MiB;
constexpr size_t WS_ROPE = 2 * MiB;
constexpr size_t WS_WRT = 2 * MiB + 65536;
constexpr size_t WS_BGU = 3 * MiB;
constexpr size_t WS_MA = 4 * MiB;
constexpr size_t WS_DC = 4 * MiB + 262144;
constexpr size_t WS_MC = 5 * MiB;
constexpr size_t WS_WFIN = 9 * MiB;
constexpr size_t WS_WFOUT = 17 * MiB;
constexpr size_t WS_WMIN = 21 * MiB;
constexpr size_t WS_WMQB = 23 * MiB;
constexpr size_t WS_WMKVB = 25 * MiB;
constexpr size_t WS_WMO = 26 * MiB;
constexpr size_t WS_WGQKV = 28 * MiB;
constexpr size_t WS_WGO = 31 * MiB;
constexpr size_t WS_TE = 34 * MiB;
constexpr size_t WS_TRANK = 35 * MiB;
constexpr size_t WS_STOK = 36 * MiB;
constexpr size_t WS_SW = 41 * MiB;
constexpr size_t WS_X = 64 * MiB;
constexpr size_t WS_H = 200 * MiB;
constexpr size_t WS_RA = 272 * MiB;
constexpr size_t WS_RB = 400 * MiB;
constexpr size_t WS_RC = 528 * MiB;
constexpr size_t WS_RD = 600 * MiB;
constexpr size_t WS_RE = 672 * MiB;
constexpr size_t WS_RF = 728 * MiB;
constexpr size_t WS_RG = 756 * MiB;
constexpr size_t WS_RH = 776 * MiB;
constexpr size_t WS_ACT = 784 * MiB;
constexpr size_t WS_Y = 1072 * MiB;
constexpr size_t WS_WGU = 1360 * MiB;
constexpr size_t WS_SWGU = 1360 * MiB + 256 * MiB;
constexpr size_t WS_SH = 1360 * MiB + 259 * MiB;
constexpr size_t WS_SWP = 1360 * MiB + 259 * MiB + 256 * 1024;
constexpr size_t WS_W8 = 1360 * MiB + 266 * MiB;
constexpr size_t WS_SSC = 1360 * MiB + 260 * MiB;
constexpr size_t WS_WDN = 1872 * MiB;
constexpr size_t WS_SWDN = 1872 * MiB + 128 * MiB;
constexpr size_t WS_END = 2128 * MiB;
constexpr int CW_TMO = 0;
constexpr int CW_BAR = 4096;
constexpr int CW_CNT = 16384;

constexpr int RING_BYTES = 131072;
constexpr int LDS_MISC = 135168;
constexpr int LDS_TT = LDS_MISC;
constexpr int LDS_XB = LDS_MISC + 512;
constexpr int LDS_TE = LDS_MISC + 768;
constexpr int LDS_BYTES = 147456;

#define GAS __attribute__((address_space(1)))
#define LAS __attribute__((address_space(3)))
typedef unsigned short bf16;
typedef unsigned v4u __attribute__((ext_vector_type(4)));
typedef unsigned v2u __attribute__((ext_vector_type(2)));
typedef float f32x4 __attribute__((ext_vector_type(4)));
typedef float f32x2 __attribute__((ext_vector_type(2)));
typedef float f32x16 __attribute__((ext_vector_type(16)));
typedef short bf16x8 __attribute__((ext_vector_type(8)));
typedef short s16x4 __attribute__((ext_vector_type(4)));
typedef __bf16 bf16x2_t __attribute__((ext_vector_type(2)));
typedef GAS unsigned gu32;
#define RLX_AGENT __ATOMIC_RELAXED, __HIP_MEMORY_SCOPE_AGENT
#define LDS_WAIT() asm volatile("s_waitcnt lgkmcnt(0)" ::: "memory")
#define VM_WAIT() asm volatile("s_waitcnt vmcnt(0)" ::: "memory")
__device__ __forceinline__ unsigned pk2(float lo, float hi) { f32x2 v = {lo, hi}; bf16x2_t b = __builtin_convertvector(v, bf16x2_t); return __builtin_bit_cast(unsigned, b); }
__device__ __forceinline__ float bf_lo(unsigned u) { return __builtin_bit_cast(float, u << 16); }
__device__ __forceinline__ float bf_hi(unsigned u) { return __builtin_bit_cast(float, u & 0xffff0000u); }
__device__ __forceinline__ float shx(float v, int mask, int lane) { return __int_as_float(__builtin_amdgcn_ds_bpermute((lane ^ mask) << 2, __float_as_int(v))); }
__device__ __forceinline__ float wave_sum(float v, int lane) {
#pragma unroll
    for (int o = 1; o < 64; o <<= 1) v += shx(v, o, lane);
    return v;
}
__device__ __forceinline__ int lane_id_v() { int t; asm volatile("v_mbcnt_lo_u32_b32 %0, -1, 0\n\tv_mbcnt_hi_u32_b32 %0, -1, %0" : "=v"(t)); return t; }
__device__ __forceinline__ int launder_s(int x) { asm volatile("" : "+s"(x)); return x; }
__device__ __forceinline__ int lthread_w(int wave) { return wave * 64 + lane_id_v(); }
__device__ __forceinline__ int modrow_of(int row) { return row < NC ? NB : ((row - NC) >> 12); }

#define XB_TMO      128
#define XB_XCNT(j)  (256  + 64 * (j))
#define XB_XSUB(j)  (1280 + 64 * (j))
#define XB_XGEN(j)  (2304 + 64 * (j))
#define XB_TOP      3328
#define XB_TOPGEN   3392
#define XCD_BAR_WORDS 3456
#define XB_SPIN_CAP (1u << 18)
__device__ __forceinline__ unsigned xb_ld(unsigned* p)              { return __hip_atomic_load(p, __ATOMIC_RELAXED, __HIP_MEMORY_SCOPE_AGENT); }
__device__ __forceinline__ unsigned xb_add(unsigned* p, unsigned v) { return __hip_atomic_fetch_add(p, v, __ATOMIC_RELAXED, __HIP_MEMORY_SCOPE_AGENT); }
__device__ __forceinline__ unsigned xb_xcc_id() { return (unsigned)__builtin_amdgcn_s_getreg((3 << 11) | 20) & 0xFu; }
#define XB_SPIN(cond, bar) do { unsigned _sp = 0; while (cond) { __builtin_amdgcn_s_sleep(1); \
    if ((++_sp & 255u) == 0u) { if (xb_ld(&(bar)[XB_TMO])) break; if (_sp > XB_SPIN_CAP) { atomicAdd(&(bar)[XB_TMO], 1u); break; } } } } while (0)
struct XcdBarrier { unsigned* bar; unsigned x; volatile LAS unsigned* st; int wave; };
__device__ __forceinline__ bool xb_thread0(int wave) { return wave == 0 && lane_id_v() == 0; }
__device__ __forceinline__ XcdBarrier xcd_barrier_post(unsigned* bar, volatile LAS unsigned* st, int wave) {
    XcdBarrier b; b.bar = bar; b.x = xb_xcc_id(); b.st = st; b.wave = wave;
    if (xb_thread0(wave)) (void)xb_add(&bar[XB_XCNT(b.x)], 1u);
    return b;
}
__device__ __forceinline__ void xcd_barrier_complete(unsigned* bar, unsigned x, unsigned& nloc, unsigned& nx) {
    const unsigned G = gridDim.x * gridDim.y * gridDim.z;
    unsigned sum, cnt, mine, sp = 0u;
    for (;;) {
        sum = 0u; cnt = 0u; mine = 0u;
#pragma unroll
        for (unsigned j = 0; j < 16; ++j) { const unsigned c = xb_ld(&bar[XB_XCNT(j)]); sum += c; cnt += (c > 0u) ? 1u : 0u; mine = (j == x) ? c : mine; }
        if (sum == G) break;
        __builtin_amdgcn_s_sleep(1);
        if ((++sp & 255u) == 0u) { if (xb_ld(&bar[XB_TMO])) break; if (sp > XB_SPIN_CAP) { atomicAdd(&bar[XB_TMO], 1u); break; } }
    }
    nloc = mine > 0u ? mine : 1u; nx = cnt > 0u ? cnt : 1u;
}
__device__ __forceinline__ void xcd_barrier(const XcdBarrier& b) {
    asm volatile("s_waitcnt vmcnt(0)" ::: "memory");
    __syncthreads();
    if (xb_thread0(b.wave)) {
        unsigned* bar = b.bar;
        __builtin_amdgcn_s_waitcnt(0);
        unsigned nloc = b.st[0], nx = b.st[1];
        if (nloc == 0u) { xcd_barrier_complete(bar, b.x, nloc, nx); b.st[0] = nloc; b.st[1] = nx; }
        const unsigned old = xb_add(&bar[XB_XSUB(b.x)], 1u);
        const unsigned gen = old / nloc;
        if (old + 1u == (gen + 1u) * nloc) {
            __builtin_amdgcn_fence(__ATOMIC_RELEASE, "agent");
            asm volatile("s_waitcnt vmcnt(0)" ::: "memory");
            const unsigned og = xb_add(&bar[XB_TOP], 1u);
            const unsigned tg = og / nx;
            if (og + 1u == (tg + 1u) * nx) xb_add(&bar[XB_TOPGEN], 1u);
            else XB_SPIN(xb_ld(&bar[XB_TOPGEN]) == tg, bar);
            __builtin_amdgcn_fence(__ATOMIC_ACQUIRE, "agent");
            xb_add(&bar[XB_XGEN(b.x)], 1u);
            asm volatile("s_waitcnt vmcnt(0)" ::: "memory");
        } else {
            XB_SPIN(xb_ld(&bar[XB_XGEN(b.x)]) == gen, bar);
            __builtin_amdgcn_fence(__ATOMIC_ACQUIRE, "agent");
            asm volatile("s_waitcnt vmcnt(0)" ::: "memory");
        }
    }
    __syncthreads();
}

namespace pg8 {
#define PG8_LAS __attribute__((address_space(3)))
constexpr int BM = 256, BK = 64, HALF = 128, HTB = HALF * BK * 2, STAGE_BYTES = 8 * HTB, NXCD = 8, WGM = 8;
__device__ __forceinline__ int lds_byte(int r, int c) { const int st = (r >> 4) * 2 + (c >> 5), rr = r & 15, cc = c & 31, ob = rr * 64 + cc * 2; return st * 1024 + (ob ^ (((ob >> 9) & 1) << 5)); }
__device__ __forceinline__ void stage_rc(int b, int& R, int& C) { const int st = b / 1024, sb = b % 1024, swz = sb ^ (((sb >> 9) & 1) << 5); R = (st >> 1) * 16 + swz / 64; C = (st & 1) * 32 + (swz % 64) / 2; }
__device__ __forceinline__ int perm32(int rho) { const int n = rho >> 4, i = rho & 15; return 8 * (i >> 2) + 4 * n + (i & 3); }
struct Unit { int pm, pn, aux; };
typedef f32x4 Acc[2][2][4][2];
typedef int i32x4 __attribute__((ext_vector_type(4)));
typedef i32x4 AccI[2][2][4][2];
template <bool I8> struct AccSel { typedef f32x4 T; };
template <> struct AccSel<true> { typedef i32x4 T; };
__device__ __forceinline__ f32x4 mma1(bf16x8 b, bf16x8 a, f32x4 c) { return __builtin_amdgcn_mfma_f32_16x16x32_bf16(b, a, c, 0, 0, 0); }
typedef int i32x8 __attribute__((ext_vector_type(8)));
typedef short bf16x16 __attribute__((ext_vector_type(16)));
__device__ __forceinline__ f32x4 mma_f8(bf16x8 b0, bf16x8 b1, bf16x8 a0, bf16x8 a1, f32x4 c) {
    const i32x8 B = __builtin_bit_cast(i32x8, __builtin_shufflevector(b0, b1, 0, 1, 2, 3, 4, 5, 6, 7, 8, 9, 10, 11, 12, 13, 14, 15));
    const i32x8 A = __builtin_bit_cast(i32x8, __builtin_shufflevector(a0, a1, 0, 1, 2, 3, 4, 5, 6, 7, 8, 9, 10, 11, 12, 13, 14, 15));
    return __builtin_amdgcn_mfma_scale_f32_16x16x128_f8f6f4(B, A, c, 0, 0, 0, 0x7F7F7F7F, 0, 0x7F7F7F7F); }
__device__ __forceinline__ i32x4 mma1(bf16x8 b, bf16x8 a, i32x4 c) { return __builtin_amdgcn_mfma_i32_16x16x64_i8(__builtin_bit_cast(i32x4, b), __builtin_bit_cast(i32x4, a), c, 0, 0, 0); }

__device__ __forceinline__ bool static_next(int i, int G, int c, int nM, int nN, int& pm, int& pn) {
    const int nwg = nM * nN; const long L = (long)i * G + c; if (L >= nwg) return false;
    int wgid = (int)L; { const int q = nwg / NXCD, r = nwg % NXCD, xcd = wgid % NXCD, off = wgid / NXCD; wgid = (xcd < r ? xcd * (q + 1) : r * (q + 1) + (xcd - r) * q) + off; }
    const int nig = WGM * nN, gid = wgid / nig, fm = gid * WGM, gsz = (nM - fm) < WGM ? (nM - fm) : WGM;
    pm = fm + ((wgid % nig) % gsz); pn = (wgid % nig) / gsz; return true;
}

template <class P>
__device__ __forceinline__ void gemm_phase(PG8_LAS unsigned char* lds, const P& p, int wave_id) {
    wave_id = launder_s(wave_id); int tid_l = lthread_w(wave_id);
    const int tid = tid_l, wid = wave_id, lane = tid & 63, wr = wid >> 2, wc = wid & 3, fr = lane & 15, fq = lane >> 4;
    const int nt = p.nt;
    const unsigned ldsw = (unsigned)wid * 1024u;
    const int aoff = lds_byte(wr * 64 + fr, fq * 8), boff = lds_byte(wc * 32 + fr, fq * 8);
    const char* const gA = p.A; const char* const gB = p.B;
#define PG8_SA(b, h) (((b) * 2 + (h)) * HTB)
#define PG8_SB(b, h) ((4 + (b) * 2 + (h)) * HTB)
#define PG8_STAGE(bufoff, gbase, off2, kofs) do { _Pragma("unroll") for (int _i = 0; _i < 2; ++_i) \
        __builtin_amdgcn_global_load_lds((const unsigned*)((gbase) + (size_t)(off2)[_i] + (size_t)(kofs)), (PG8_LAS unsigned*)(lds + (bufoff) + ldsw + _i * 8192), 16, 0, 0); } while (0)
#define PG8_LDA(dst, b, h) do { _Pragma("unroll") for (int m = 0; m < 4; ++m) _Pragma("unroll") for (int k = 0; k < 2; ++k) dst[m][k] = *(const PG8_LAS bf16x8*)(lds + PG8_SA(b, h) + aoff + m * 2048 + k * 1024); } while (0)
#define PG8_LDB(dst, b, h) do { _Pragma("unroll") for (int n = 0; n < 2; ++n) _Pragma("unroll") for (int k = 0; k < 2; ++k) dst[n][k] = *(const PG8_LAS bf16x8*)(lds + PG8_SB(b, h) + boff + n * 2048 + k * 1024); } while (0)
#define PG8_MMA(ai, bj, At, Bt) do { __builtin_amdgcn_s_setprio(1); _Pragma("unroll") for (int m = 0; m < 4; ++m) _Pragma("unroll") for (int n = 0; n < 2; ++n) { \
        if constexpr (P::F8) acc[ai][bj][m][n] = mma_f8(Bt[n][0], Bt[n][1], At[m][0], At[m][1], acc[ai][bj][m][n]); \
        else { _Pragma("unroll") for (int k = 0; k < 2; ++k) acc[ai][bj][m][n] = mma1(Bt[n][k], At[m][k], acc[ai][bj][m][n]); } } __builtin_amdgcn_s_setprio(0); } while (0)
#define PG8_WAIT_V(n) asm volatile("s_waitcnt vmcnt(" #n ")" ::: "memory")
#define PG8_WAIT_L(n) asm volatile("s_waitcnt lgkmcnt(" #n ")" ::: "memory")
#define PG8_BAR __builtin_amdgcn_s_barrier()
#define PG8_SCHED __builtin_amdgcn_sched_barrier(0)
#define PG8_KEYS(u) do { if (P::KEYS && wid < 4) __builtin_amdgcn_global_load_lds((const unsigned*)p.key_ptr(u, wid * 64 + lane), (PG8_LAS unsigned*)(keybuf + wid * 256), 4, 0, 0); } while (0)
#define PG8_OFFS(u, oA, oB) do { int tid2_ = tid; asm volatile("" : "+v"(tid2_));     \
    _Pragma("unroll") for (int _i = 0; _i < 2; ++_i) { int R_, C_; stage_rc(tid2_ * 16 + _i * 8192, R_, C_); const int Rb_ = P::PERM ? ((R_ & ~31) + perm32(R_ & 31)) : R_; \
      _Pragma("unroll") for (int _h = 0; _h < 2; ++_h) { \
        const int key_ = P::KEYS ? ((const PG8_LAS int*)keybuf)[_h * HALF + R_] : 0; \
        oA[_h][_i] = p.a_row(u, _h * HALF + R_, key_) + (unsigned)(C_ * 2); oB[_h][_i] = p.b_row(u, _h * HALF + Rb_) + (unsigned)(C_ * 2); } } } while (0)
    PG8_LAS unsigned char* const keybuf = lds + STAGE_BYTES;
    Unit cur, nxt; int ui = 0;
    if (!p.next(0, cur)) return;
    typedef typename AccSel<P::I8>::T AccT;
    AccT acc[2][2][4][2];
#pragma unroll
    for (int a = 0; a < 2; ++a)
#pragma unroll
        for (int b = 0; b < 2; ++b)
#pragma unroll
            for (int m = 0; m < 4; ++m)
#pragma unroll
                for (int n = 0; n < 2; ++n) acc[a][b][m][n] = (AccT){0, 0, 0, 0};
    bf16x8 At[4][2], B0[2][2], B1[2][2];
    unsigned oAc[2][2], oBc[2][2];
    if (P::KEYS) { PG8_KEYS(cur); PG8_WAIT_V(0); PG8_BAR; }
    PG8_OFFS(cur, oAc, oBc);
    PG8_STAGE(PG8_SB(0, 0), gB, oBc[0], 0); PG8_STAGE(PG8_SB(0, 1), gB, oBc[1], 0); PG8_STAGE(PG8_SA(0, 0), gA, oAc[0], 0); PG8_STAGE(PG8_SA(0, 1), gA, oAc[1], 0);
    if (wr == 1) PG8_BAR;
    PG8_WAIT_V(2); PG8_BAR;
    PG8_STAGE(PG8_SB(1, 0), gB, oBc[0], 128); PG8_STAGE(PG8_SA(1, 0), gA, oAc[0], 128); PG8_STAGE(PG8_SB(1, 1), gB, oBc[1], 128);
    PG8_WAIT_V(6); PG8_BAR;
    for (;;) {
        const bool has_next = p.next(ui + 1, nxt);
        if (has_next) { PG8_KEYS(nxt); }
        for (int t = 0; t < nt; t += 2) {
            const bool last = (t == nt - 2);
            const unsigned k1 = (unsigned)(t + 1) * 128u;
            const unsigned k2 = last ? 0u : (unsigned)(t + 2) * 128u, k3 = k2 + 128u;
            PG8_LDB(B0, 0, 0); PG8_LDB(B1, 0, 1); PG8_SCHED; PG8_LDA(At, 0, 0); PG8_STAGE(PG8_SA(1, 1), gA, oAc[1], k1);
            if (last && has_next) { PG8_OFFS(nxt, oAc, oBc); }
            PG8_WAIT_V(8); PG8_WAIT_L(0); PG8_BAR; PG8_MMA(0, 0, At, B0); PG8_MMA(0, 1, At, B1); PG8_BAR; PG8_SCHED;
            PG8_LDA(At, 0, 1); PG8_STAGE(PG8_SB(0, 0), gB, oBc[0], k2); PG8_STAGE(PG8_SB(0, 1), gB, oBc[1], k2); PG8_STAGE(PG8_SA(0, 0), gA, oAc[0], k2);
            PG8_WAIT_V(8); PG8_WAIT_L(0); PG8_BAR; PG8_MMA(1, 0, At, B0); PG8_MMA(1, 1, At, B1); PG8_BAR; PG8_SCHED;
            PG8_LDB(B0, 1, 0); PG8_LDB(B1, 1, 1); PG8_SCHED; PG8_LDA(At, 1, 0); PG8_STAGE(PG8_SA(0, 1), gA, oAc[1], k2);
            PG8_WAIT_V(8); PG8_WAIT_L(0); PG8_BAR; PG8_MMA(0, 0, At, B0); PG8_MMA(0, 1, At, B1); PG8_BAR; PG8_SCHED;
            PG8_LDA(At, 1, 1); PG8_STAGE(PG8_SB(1, 0), gB, oBc[0], k3); PG8_STAGE(PG8_SB(1, 1), gB, oBc[1], k3); PG8_STAGE(PG8_SA(1, 0), gA, oAc[0], k3);
            PG8_WAIT_V(8); PG8_WAIT_L(0); PG8_BAR; PG8_MMA(1, 0, At, B0); PG8_MMA(1, 1, At, B1); PG8_BAR; PG8_SCHED;
        }
        if (wr == 0) PG8_BAR;
        { const int le_ = lane_id_v(); int fr_e = le_ & 15, fq_e = le_ >> 4;
          p.epi(acc, cur, wr, wc, fr_e, fq_e); }
        if (!has_next) break;
#pragma unroll
        for (int a = 0; a < 2; ++a)
#pragma unroll
            for (int b = 0; b < 2; ++b)
#pragma unroll
                for (int m = 0; m < 4; ++m)
#pragma unroll
                    for (int n = 0; n < 2; ++n) acc[a][b][m][n] = (AccT){0, 0, 0, 0};
        cur = nxt; ++ui;
        if (wr == 1) PG8_BAR;
    }
    PG8_WAIT_V(0);
    PG8_BAR;
#undef PG8_SA
#undef PG8_SB
#undef PG8_STAGE
#undef PG8_LDA
#undef PG8_LDB
#undef PG8_MMA
#undef PG8_WAIT_V
#undef PG8_WAIT_L
#undef PG8_BAR
#undef PG8_SCHED
#undef PG8_OFFS
#undef PG8_KEYS
}
}
using pg8::Unit;

#define TROW(ai, wr, m, fr) (128 * (ai) + 64 * (wr) + 16 * (m) + (fr))
#define TCOLP(bj, wc, fq) (128 * (bj) + 32 * (wc) + 8 * (fq))
#define TCOLN(bj, wc, n, fq) (128 * (bj) + 32 * (wc) + 16 * (n) + 4 * (fq))
__device__ __forceinline__ v4u pack8(const f32x4 a, const f32x4 b) { v4u w; w.x = pk2(a[0], a[1]); w.y = pk2(a[2], a[3]); w.z = pk2(b[0], b[1]); w.w = pk2(b[2], b[3]); return w; }

struct PolDenseBf16 {
    static constexpr bool PERM = true;
    static constexpr bool KEYS = false;
    static constexpr bool I8 = false;
    static constexpr bool F8 = false;
    __device__ __forceinline__ const int* key_ptr(const Unit&, int) const { return nullptr; }
    const char* A; const char* B; int nt; int nM, nN, pm0, G, c; unsigned pitchA, pitchB; bf16* O; int ldo;
    __device__ __forceinline__ bool next(int i, Unit& u) const { int pm, pn; if (!pg8::static_next(i, G, c, nM, nN, pm, pn)) return false; u.pm = pm + pm0; u.pn = pn; u.aux = 0; return true; }
    __device__ __forceinline__ unsigned a_row(const Unit& u, int r, int) const { return (unsigned)(u.pm * 256 + r) * pitchA; }
    __device__ __forceinline__ unsigned b_row(const Unit& u, int r) const { return (unsigned)(u.pn * 256 + r) * pitchB; }
    __device__ __forceinline__ void epi(const pg8::Acc& acc, const Unit& u, int wr, int wc, int fr, int fq) const {
#pragma unroll
        for (int ai = 0; ai < 2; ++ai)
#pragma unroll
            for (int m = 0; m < 4; ++m) { const size_t row = (size_t)u.pm * 256 + TROW(ai, wr, m, fr);
#pragma unroll
                for (int bj = 0; bj < 2; ++bj) { const int col = u.pn * 256 + TCOLP(bj, wc, fq); *(v4u*)(O + row * ldo + col) = pack8(acc[ai][bj][m][0], acc[ai][bj][m][1]); } }
    }
};

struct PolDenseI8 {
    static constexpr bool PERM = true;
    static constexpr bool KEYS = false;
    static constexpr bool I8 = true;
    static constexpr bool F8 = false;
    __device__ __forceinline__ const int* key_ptr(const Unit&, int) const { return nullptr; }
    const char* A; const char* B; int nt; int nM, nN, pm0, G, c; const float* sA; const float* sB; bf16* O; int ldo;
    __device__ __forceinline__ bool next(int i, Unit& u) const { int pm, pn; if (!pg8::static_next(i, G, c, nM, nN, pm, pn)) return false; u.pm = pm + pm0; u.pn = pn; u.aux = 0; return true; }
    __device__ __forceinline__ unsigned a_row(const Unit& u, int r, int) const { return (unsigned)(u.pm * 256 + r) * 1024u; }
    __device__ __forceinline__ unsigned b_row(const Unit& u, int r) const { return (unsigned)(u.pn * 256 + r) * 1024u; }
    __device__ __forceinline__ void epi(const pg8::AccI& acc, const Unit& u, int wr, int wc, int fr, int fq) const {
#pragma unroll
        for (int bj = 0; bj < 2; ++bj) { const int col = u.pn * 256 + TCOLP(bj, wc, fq); const f32x4 s0 = *(const f32x4*)(sB + col), s1 = *(const f32x4*)(sB + col + 4);
#pragma unroll
            for (int ai = 0; ai < 2; ++ai)
#pragma unroll
                for (int m = 0; m < 4; ++m) { const size_t row = (size_t)u.pm * 256 + TROW(ai, wr, m, fr); const float sa = sA[row]; f32x4 v0, v1;
#pragma unroll
                    for (int q = 0; q < 4; ++q) { v0[q] = (float)acc[ai][bj][m][0][q] * (sa * s0[q]); v1[q] = (float)acc[ai][bj][m][1][q] * (sa * s1[q]); }
                    *(v4u*)(O + row * ldo + col) = pack8(v0, v1); } }
    }
};

struct PolOut {
    static constexpr bool PERM = true;
    static constexpr bool KEYS = false;
    static constexpr bool I8 = false;
    static constexpr bool F8 = false;
    __device__ __forceinline__ const int* key_ptr(const Unit&, int) const { return nullptr; }
    const char* A; const char* B; int nt; int nM, nN, pm0, G, c; bf16* X; const float* mod;
    int chunk; const float* XinC; const float* XinL;
    __device__ __forceinline__ bool next(int i, Unit& u) const { int pm, pn; if (!pg8::static_next(i, G, c, nM, nN, pm, pn)) return false; u.pm = pm + pm0; u.pn = pn; u.aux = 0; return true; }
    __device__ __forceinline__ unsigned a_row(const Unit& u, int r, int) const { return (unsigned)(u.pm * 256 + r) * 2048u; }
    __device__ __forceinline__ unsigned b_row(const Unit& u, int r) const { return (unsigned)(u.pn * 256 + r) * 2048u; }
    __device__ __forceinline__ void epi(const pg8::Acc& acc, const Unit& u, int wr, int wc, int fr, int fq) const {
        const int mr = modrow_of(u.pm * 256);
        const float* g = mod + (size_t)mr * (NMOD * D) + chunk * D;
        const float* xin = XinC ? (u.pm < 8 ? XinC : XinL) : nullptr;
#pragma unroll
        for (int bj = 0; bj < 2; ++bj) { const int col = u.pn * 256 + TCOLP(bj, wc, fq); const f32x4 g0 = *(const f32x4*)(g + col), g1 = *(const f32x4*)(g + col + 4);
#pragma unroll
            for (int ai = 0; ai < 2; ++ai)
#pragma unroll
                for (int m = 0; m < 4; ++m) { const size_t off = ((size_t)u.pm * 256 + TROW(ai, wr, m, fr)) * D + col; f32x4 x0, x1;
                    if (xin) { x0 = *(const f32x4*)(xin + off); x1 = *(const f32x4*)(xin + off + 4); }
                    else { const v4u w = *(const v4u*)(X + off); x0 = (f32x4){bf_lo(w.x), bf_hi(w.x), bf_lo(w.y), bf_hi(w.y)}; x1 = (f32x4){bf_lo(w.z), bf_hi(w.z), bf_lo(w[3]), bf_hi(w[3])}; }
                    *(v4u*)(X + off) = pack8(x0 + g0 * acc[ai][bj][m][0], x1 + g1 * acc[ai][bj][m][1]); } }
    }
};

struct PolFP {
    static constexpr bool PERM = true;
    static constexpr bool KEYS = false;
    static constexpr bool I8 = true;
    static constexpr bool F8 = false;
    __device__ __forceinline__ const int* key_ptr(const Unit&, int) const { return nullptr; }
    const char* A; const char* B; int nt; int nN, G, c; const float* sW; const float* sH; bf16* Z; bf16* Zc;
    __device__ __forceinline__ bool next(int i, Unit& u) const { int pm, pn; if (!pg8::static_next(i, G, c, 8, nN, pm, pn)) return false; u.pm = pm; u.pn = pn; u.aux = 0; return true; }
    __device__ __forceinline__ unsigned a_row(const Unit& u, int r, int) const { return (unsigned)(u.pm * 256 + r) * 1024u; }
    __device__ __forceinline__ int tok_row(int pn, int n) const { if (pn < 128) { const int b = n >> 12, l2 = (n >> 6) & 63, l1 = n & 63; return NC + b * SEQ + 64 * l1 + l2; } return n - 32768; }
    __device__ __forceinline__ unsigned b_row(const Unit& u, int r) const { return (unsigned)tok_row(u.pn, u.pn * 256 + r) * 1024u; }
    __device__ __forceinline__ void epi(const pg8::AccI& acc, const Unit& u, int wr, int wc, int fr, int fq) const {
#pragma unroll
        for (int bj = 0; bj < 2; ++bj) { const int n0 = u.pn * 256 + TCOLP(bj, wc, fq);
            f32x4 h0, h1;
#pragma unroll
            for (int q = 0; q < 4; ++q) { h0[q] = sH[tok_row(u.pn, n0 + q)]; h1[q] = sH[tok_row(u.pn, n0 + 4 + q)]; }
#pragma unroll
            for (int ai = 0; ai < 2; ++ai)
#pragma unroll
                for (int m = 0; m < 4; ++m) { const int cp = u.pm * 256 + TROW(ai, wr, m, fr); const float sw = sW[cp]; f32x4 v0, v1;
#pragma unroll
                    for (int q = 0; q < 4; ++q) { v0[q] = (float)acc[ai][bj][m][0][q] * (sw * h0[q]); v1[q] = (float)acc[ai][bj][m][1][q] * (sw * h1[q]); }
                    const v4u w = pack8(v0, v1);
                    if (u.pn < 128) *(v4u*)(Z + ((size_t)(n0 >> 6) * 2048 + cp) * 64 + (n0 & 63)) = w;
                    else { const int b = u.pn - 128, l = n0 - 32768 - b * 256; *(v4u*)(Zc + ((size_t)b * 2048 + cp) * 256 + l) = w; } } }
    }
};

struct PolFA {
    static constexpr bool PERM = true;
    static constexpr bool KEYS = false;
    static constexpr bool I8 = false;
    static constexpr bool F8 = false;
    __device__ __forceinline__ const int* key_ptr(const Unit&, int) const { return nullptr; }
    const char* A; const char* B; int nt; int G, c; bf16* Y;
    __device__ __forceinline__ bool next(int i, Unit& u) const { const int L = i * G + c; if (L >= 1024) return false; u.pm = 0; u.pn = L & 127; u.aux = L >> 7; return true; }
    __device__ __forceinline__ unsigned a_row(const Unit&, int r, int) const { return (unsigned)r * 512u; }
    __device__ __forceinline__ unsigned b_row(const Unit& u, int r) const { const int l2 = r & 63, cp = u.pn * 4 + (r >> 6); return (unsigned)((u.aux * 64 + l2) * 512 + cp) * 512u; }
    __device__ __forceinline__ void epi(const pg8::Acc& acc, const Unit& u, int wr, int wc, int fr, int fq) const {
        const int b = u.aux;
#pragma unroll
        for (int ai = 0; ai < 2; ++ai)
#pragma unroll
            for (int m = 0; m < 4; ++m) { const int rr = TROW(ai, wr, m, fr), jp = rr >> 7, pp = (rr >> 6) & 1, k1 = rr & 63;
#pragma unroll
                for (int bj = 0; bj < 2; ++bj) { const int n0 = u.pn * 256 + TCOLP(bj, wc, fq), cp = n0 >> 6, l2 = n0 & 63, cc = 2 * cp + jp;
                    const size_t idx = ((((size_t)(b * 16 + (k1 >> 2)) * 1024 + cc) * 4 + (k1 & 3)) * 2 + pp) * 64 + l2;
                    *(v4u*)(Y + idx) = pack8(acc[ai][bj][m][0], acc[ai][bj][m][1]); } }
    }
};

struct PolFC {
    static constexpr bool PERM = true;
    static constexpr bool KEYS = false;
    static constexpr bool I8 = false;
    static constexpr bool F8 = false;
    __device__ __forceinline__ const int* key_ptr(const Unit&, int) const { return nullptr; }
    const char* A; const char* B; int nt; int G, c; int nunits; unsigned offMC, offZc; bf16* F;
    __device__ __forceinline__ bool next(int i, Unit& u) const { const int L = i * G + c; if (L >= nunits) return false;
        if (L < 512) { u.pm = 0; u.pn = L & 3; u.aux = L >> 2; } else { const int q = L - 512; u.pm = 0; u.pn = q & 3; u.aux = 256 + (q >> 2); } return true; }
    __device__ __forceinline__ unsigned a_row(const Unit& u, int r, int) const {
        if (u.aux < 256) return offMC + (unsigned)((u.aux & 15) * 256 + r) * 1024u;
        return (unsigned)r * 1024u; }
    __device__ __forceinline__ unsigned b_row(const Unit& u, int r) const {
        if (u.aux < 256) return (unsigned)(u.aux * 1024 + u.pn * 256 + r) * 1024u;
        return offZc + (unsigned)((u.aux - 256) * 1024 + u.pn * 256 + r) * 1024u; }
    __device__ __forceinline__ void epi(const pg8::Acc& acc, const Unit& u, int wr, int wc, int fr, int fq) const {
#pragma unroll
        for (int ai = 0; ai < 2; ++ai)
#pragma unroll
            for (int m = 0; m < 4; ++m) { const int rr = TROW(ai, wr, m, fr); size_t frow;
                if (u.aux < 256) { const int b = u.aux >> 4, kq = u.aux & 15, k = 4 * kq + (rr >> 6) + 64 * (rr & 63); frow = (size_t)NC + b * SEQ + k; }
                else frow = (size_t)(u.aux - 256) * LCTX + rr;
#pragma unroll
                for (int bj = 0; bj < 2; ++bj) { const int col = u.pn * 256 + TCOLP(bj, wc, fq); *(v4u*)(F + frow * D + col) = pack8(acc[ai][bj][m][0], acc[ai][bj][m][1]); } }
    }
};

struct PolMlaQ {
    static constexpr bool PERM = true;
    static constexpr bool KEYS = false;
    static constexpr bool I8 = false;
    static constexpr bool F8 = false;
    __device__ __forceinline__ const int* key_ptr(const Unit&, int) const { return nullptr; }
    const char* A; const char* B; int nt; int nM, nN, G, c; bf16* Q; const float* rope; float c2;
    __device__ __forceinline__ bool next(int i, Unit& u) const { int pm, pn; if (!pg8::static_next(i, G, c, nM, nN, pm, pn)) return false; u.pm = pm; u.pn = pn; u.aux = 0; return true; }
    __device__ __forceinline__ unsigned a_row(const Unit& u, int r, int) const { return (unsigned)(u.pm * 256 + r) * (unsigned)(MLA_QL * 2); }
    __device__ __forceinline__ unsigned b_row(const Unit& u, int r) const { return (unsigned)(u.pn * 256 + r) * (unsigned)(MLA_QL * 2); }
    __device__ __forceinline__ void epi(const pg8::Acc& acc, const Unit& u, int wr, int wc, int fr, int fq) const {
        const bool lat = u.pm >= 8;
#pragma unroll
        for (int bj = 0; bj < 2; ++bj) { const int col = u.pn * 256 + TCOLP(bj, wc, fq); const bool isrope = lat && (((col >> 5) % 3) == 2);
#pragma unroll
            for (int ai = 0; ai < 2; ++ai)
#pragma unroll
                for (int m = 0; m < 4; ++m) { const int row = u.pm * 256 + TROW(ai, wr, m, fr); f32x4 v0 = acc[ai][bj][m][0], v1 = acc[ai][bj][m][1];
                    if (isrope) { const int t = (row - NC) & 4095, pos = (fq & 2) ? (t & 63) : (t >> 6);
                        const f32x4* rp = (const f32x4*)(rope + (size_t)pos * 16);
                        const f32x4 r0 = rp[0], r1 = rp[1], r2 = rp[2], r3 = rp[3];
                        f32x4 p0, p1;
#pragma unroll
                        for (int e = 0; e < 4; ++e) { p0[e] = shx(v0[e], 16, fq * 16 + fr); p1[e] = shx(v1[e], 16, fq * 16 + fr); }
                        const float sg = (fq & 1) ? 1.f : -1.f;
                        v0[0] = v0[0] * r0[0] + sg * p0[0] * r0[1]; v0[1] = v0[1] * r0[2] + sg * p0[1] * r0[3];
                        v0[2] = v0[2] * r1[0] + sg * p0[2] * r1[1]; v0[3] = v0[3] * r1[2] + sg * p0[3] * r1[3];
                        v1[0] = v1[0] * r2[0] + sg * p1[0] * r2[1]; v1[1] = v1[1] * r2[2] + sg * p1[1] * r2[3];
                        v1[2] = v1[2] * r3[0] + sg * p1[2] * r3[1]; v1[3] = v1[3] * r3[2] + sg * p1[3] * r3[3]; }
                    *(v4u*)(Q + (size_t)row * 1536 + col) = pack8(v0 * c2, v1 * c2); } }
    }
};

struct PolMlaKV {
    static constexpr bool PERM = true;
    static constexpr bool KEYS = false;
    static constexpr bool I8 = false;
    static constexpr bool F8 = false;
    __device__ __forceinline__ const int* key_ptr(const Unit&, int) const { return nullptr; }
    const char* A; const char* B; int nt; int nM, nN, G, c; bf16* Kb; bf16* Vb;
    __device__ __forceinline__ bool next(int i, Unit& u) const { int pm, pn; if (!pg8::static_next(i, G, c, nM, nN, pm, pn)) return false; u.pm = pm; u.pn = pn; u.aux = 0; return true; }
    __device__ __forceinline__ unsigned a_row(const Unit& u, int r, int) const { return (unsigned)(u.pm * 256 + r) * 512u; }
    __device__ __forceinline__ unsigned b_row(const Unit& u, int r) const { return (unsigned)(u.pn * 256 + r) * 512u; }
    __device__ __forceinline__ void epi(const pg8::Acc& acc, const Unit& u, int wr, int wc, int fr, int fq) const {
#pragma unroll
        for (int bj = 0; bj < 2; ++bj) { const int col = u.pn * 256 + TCOLP(bj, wc, fq), h = col >> 7, j = col & 127;
#pragma unroll
            for (int ai = 0; ai < 2; ++ai)
#pragma unroll
                for (int m = 0; m < 4; ++m) { const size_t row = (size_t)u.pm * 256 + TROW(ai, wr, m, fr); const v4u w = pack8(acc[ai][bj][m][0], acc[ai][bj][m][1]);
                    if (j < 64) *(v4u*)(Kb + row * 1536 + 96 * h + j) = w; else *(v4u*)(Vb + row * 1024 + 64 * h + (j - 64)) = w; } }
    }
};

struct MoeTab { const LAS int* TT; const LAS int* CN; const LAS int* TE; };
__device__ __forceinline__ bool moe_next(int i, int G, int c, int NP, const MoeTab& T, Unit& u) {
    const int ttot = T.TT[32];
    int lo, hi, j;
    if ((G & 7) == 0) { const int x = c & 7, q = c >> 3, g8 = G >> 3; lo = (x * ttot) >> 3; hi = ((x + 1) * ttot) >> 3; j = i * g8 + q; }
    else { lo = 0; hi = ttot; j = i * G + c; }
    if (j >= (hi - lo) * NP) return false;
    const int tile = lo + j / NP; u.pn = j % NP; u.pm = tile;
    const int e = T.TE[tile];
    u.aux = e | ((tile - T.TT[e]) << 8);
    return true;
}
struct PolMoe1 {
    static constexpr bool PERM = true;
    static constexpr bool I8 = true;
    static constexpr bool F8 = false;
    const char* A; const char* B; int nt; int G, c; MoeTab T; const int* stok; const float* bgu; const float* swgu; const float* ssc; unsigned char* act;
    __device__ __forceinline__ bool next(int i, Unit& u) const { return moe_next(i, G, c, 8, T, u); }
    static constexpr bool KEYS = true;
    __device__ __forceinline__ const int* key_ptr(const Unit& u, int r) const { const int e = u.aux & 255, idx = (u.aux >> 8) * 256 + r; const int cn = T.CN[e]; return stok + (size_t)e * CAP + (idx < cn ? idx : 0); }
    __device__ __forceinline__ unsigned a_row(const Unit&, int, int key) const { return (unsigned)key * 1024u; }
    __device__ __forceinline__ unsigned b_row(const Unit& u, int r) const { return (unsigned)((u.aux & 255) * 2048 + u.pn * 256 + r) * 1024u; }
    __device__ __forceinline__ void epi(const pg8::AccI& acc, const Unit& u, int wr, int wc, int fr, int fq) const {
        const int e = u.aux & 255, mt = u.aux >> 8, cn = T.CN[e]; const int jl = 32 * wc + 8 * fq;
        const float* bg = bgu + (size_t)e * 2048 + u.pn * 256 + jl;
        const float* sg = swgu + (size_t)e * 2048 + u.pn * 256 + jl;
        const f32x4 bg0 = *(const f32x4*)(bg), bg1 = *(const f32x4*)(bg + 4), bu0 = *(const f32x4*)(bg + 128), bu1 = *(const f32x4*)(bg + 132);
        const f32x4 sg0 = *(const f32x4*)(sg), sg1 = *(const f32x4*)(sg + 4), su0 = *(const f32x4*)(sg + 128), su1 = *(const f32x4*)(sg + 132);
#pragma unroll
        for (int ai = 0; ai < 2; ++ai)
#pragma unroll
            for (int m = 0; m < 4; ++m) { const int rr = TROW(ai, wr, m, fr), idx = mt * 256 + rr; const size_t slot = (size_t)u.pm * 256 + rr;
                const float sa = ssc[(size_t)e * CAP + (idx < cn ? idx : 0)];
                f32x4 g0, g1, u0, u1, o0, o1;
#pragma unroll
                for (int q = 0; q < 4; ++q) { g0[q] = (float)acc[ai][0][m][0][q] * (sa * sg0[q]) + bg0[q]; g1[q] = (float)acc[ai][0][m][1][q] * (sa * sg1[q]) + bg1[q];
                    u0[q] = (float)acc[ai][1][m][0][q] * (sa * su0[q]) + bu0[q]; u1[q] = (float)acc[ai][1][m][1][q] * (sa * su1[q]) + bu1[q]; }
#pragma unroll
                for (int q = 0; q < 4; ++q) {
                    float ga = fminf(g0[q], 7.f), ua = fminf(fmaxf(u0[q], -7.f), 7.f); o0[q] = (ua + 1.f) * ga * __builtin_amdgcn_rcpf(1.f + __builtin_amdgcn_exp2f(-1.702f * LOG2E * ga));
                    float gb = fminf(g1[q], 7.f), ub = fminf(fmaxf(u1[q], -7.f), 7.f); o1[q] = (ub + 1.f) * gb * __builtin_amdgcn_rcpf(1.f + __builtin_amdgcn_exp2f(-1.702f * LOG2E * gb)); }
                v2u w8; { int t0 = __builtin_amdgcn_cvt_pk_fp8_f32(o0[0], o0[1], 0, false); t0 = __builtin_amdgcn_cvt_pk_fp8_f32(o0[2], o0[3], t0, true);
                          int t1 = __builtin_amdgcn_cvt_pk_fp8_f32(o1[0], o1[1], 0, false); t1 = __builtin_amdgcn_cvt_pk_fp8_f32(o1[2], o1[3], t1, true); w8.x = (unsigned)t0; w8.y = (unsigned)t1; }
                *(v2u*)(act + slot * 1024 + u.pn * 128 + jl) = w8; }
    }
};
struct PolMoe2 {
    static constexpr bool PERM = true;
    static constexpr bool KEYS = false;
    static constexpr bool I8 = false;
    static constexpr bool F8 = true;
    __device__ __forceinline__ const int* key_ptr(const Unit&, int) const { return nullptr; }
    const char* A; const char* B; int nt; int G, c; MoeTab T; const float* sw; const float* bdn; const float* swd; bf16* Y;
    __device__ __forceinline__ bool next(int i, Unit& u) const { return moe_next(i, G, c, 4, T, u); }
    __device__ __forceinline__ unsigned a_row(const Unit& u, int r, int) const { return (unsigned)(u.pm * 256 + r) * 1024u; }
    __device__ __forceinline__ unsigned b_row(const Unit& u, int r) const { return (unsigned)((u.aux & 255) * 1024 + u.pn * 256 + r) * 1024u; }
    __device__ __forceinline__ void epi(const pg8::Acc& acc, const Unit& u, int wr, int wc, int fr, int fq) const {
        const int e = u.aux & 255, mt = u.aux >> 8, cn = T.CN[e];
#pragma unroll
        for (int bj = 0; bj < 2; ++bj) { const int col = u.pn * 256 + TCOLP(bj, wc, fq); const size_t ci = (size_t)e * 1024 + col;
            const f32x4 b0 = *(const f32x4*)(bdn + ci), b1 = *(const f32x4*)(bdn + ci + 4), s0 = *(const f32x4*)(swd + ci), s1 = *(const f32x4*)(swd + ci + 4);
#pragma unroll
            for (int ai = 0; ai < 2; ++ai)
#pragma unroll
                for (int m = 0; m < 4; ++m) { const int rr = TROW(ai, wr, m, fr), idx = mt * 256 + rr; const size_t slot = (size_t)u.pm * 256 + rr; const float w = sw[(size_t)e * CAP + (idx < cn ? idx : 0)];
                    *(v4u*)(Y + slot * 1024 + col) = pack8((acc[ai][bj][m][0] * s0 + b0) * w, (acc[ai][bj][m][1] * s1 + b1) * w); } }
    }
};

namespace att {
__device__ __forceinline__ int crow(int r, int hi) { return (r & 3) + 8 * (r >> 2) + 4 * hi; }
__device__ __forceinline__ float max3f(float a, float b, float c) { return fmaxf(fmaxf(a, b), c); }
typedef LAS const char* lds_cptr;
constexpr int LK = 0, LV = 49152, LWS = 90112, LOST = 92160, LBYTES = 124928;
constexpr int PD = 3;
struct Tens { const bf16* Q; int qpitch; const bf16* K; int kpitch; const bf16* V; int vpitch; bf16* O; };
#define ATT_WAITV(n) asm volatile("s_waitcnt vmcnt(" #n ")" ::: "memory")
struct Pend { f32x16 o0, o1; float l; int qrow0, oc0; bool valid; };
__device__ __forceinline__ void finish_unit(const Pend& P, bf16* O, LAS unsigned char* lds, int wid, int lane) {
    const int r32 = lane & 31, hi = lane >> 5;
    LAS float* wsf = (LAS float*)(lds + LWS) + wid * 64;
    float lrun = P.l;
    { auto rr = __builtin_amdgcn_permlane32_swap(__float_as_uint(lrun), __float_as_uint(lrun), false, false); lrun = __uint_as_float(rr[0]) + __uint_as_float(rr[1]); }
    if (hi == 0) wsf[32 + r32] = lrun;
    LDS_WAIT();
    LAS bf16* stg = (LAS bf16*)(lds + LOST) + wid * 2048;
#pragma unroll
    for (int r = 0; r < 16; ++r) { const int orow = crow(r, hi); const float rl = __builtin_amdgcn_rcpf(wsf[32 + orow]);
        stg[orow * 64 + r32] = (bf16)(pk2(P.o0[r] * rl, 0.f) & 0xffffu); stg[orow * 64 + 32 + r32] = (bf16)(pk2(P.o1[r] * rl, 0.f) & 0xffffu); }
    LDS_WAIT();
    bf16* Ow = O + (size_t)(P.qrow0 + wid * 32) * 1024 + P.oc0;
#pragma unroll
    for (int i = 0; i < 4; ++i) { const int row = i * 8 + (lane >> 3), ch = lane & 7; const v4u v = *(const LAS v4u*)(stg + row * 64 + ch * 8); *(v4u*)(Ow + (size_t)row * 1024 + ch * 8) = v; }
    LDS_WAIT();
}
template <int DK>
__device__ __forceinline__ void unit(const Tens& T, int qrow0, int qc0, int kc0, int vc0, int oc0, int kctx0, int klat0, int NTL, LAS unsigned char* lds, int wave_id, Pend& pend) {
    constexpr int ND = DK / 16;
    wave_id = launder_s(wave_id); const int tid = lthread_w(wave_id), lane = tid & 63, r32 = lane & 31, hi = lane >> 5; const int wid = wave_id;
    LAS float* wsf = (LAS float*)(lds + LWS) + wid * 64;
    const bf16* ksrc = T.K + (size_t)lane * T.kpitch + kc0 + wid * 8;
    const int k2off = (8 + (wid & 3) - wid) * 8;
    const bf16* vsrc = T.V + (size_t)(16 * (wid & 3) + (lane >> 2)) * T.vpitch + vc0 + (wid >> 2) * 32 + (lane & 3) * 8;
#define ATT_DMA(t, ks_, vs_) do { const size_t row0_ = (size_t)((t) < 4 ? kctx0 + 64 * (t) : klat0 + 64 * ((t) - 4)); \
        __builtin_amdgcn_global_load_lds((const unsigned*)(ksrc + row0_ * T.kpitch), (LAS unsigned*)(lds + LK + (ks_) * 12288 + wid * 1024), 16, 0, 0); \
        if (DK > 64) __builtin_amdgcn_global_load_lds((const unsigned*)(ksrc + row0_ * T.kpitch + k2off), (LAS unsigned*)(lds + LK + (ks_) * 12288 + 8192 + (wid & 3) * 1024), 16, 0, 0); \
        __builtin_amdgcn_global_load_lds((const unsigned*)(vsrc + row0_ * T.vpitch), (LAS unsigned*)(lds + LV + (vs_) * 8192 + wid * 1024), 16, 0, 0); } while (0)
#define ATT_WAIT_TILES(n_tiles) do { if (DK > 64) { if ((n_tiles) >= 2) ATT_WAITV(6); else if ((n_tiles) == 1) ATT_WAITV(3); else ATT_WAITV(0); } \
        else { if ((n_tiles) >= 2) ATT_WAITV(4); else if ((n_tiles) == 1) ATT_WAITV(2); else ATT_WAITV(0); } } while (0)
    bf16x8 qr[ND];
    { const bf16* qp = T.Q + (size_t)(qrow0 + wid * 32 + r32) * T.qpitch + qc0 + hi * 8;
#pragma unroll
      for (int d0 = 0; d0 < ND; ++d0) qr[d0] = *(const bf16x8*)(qp + d0 * 16); }
    asm volatile("" ::: "memory");
    constexpr float THR = 8.f;
    const int half = wid >> 2;
    float mhat = 0.f, lrun = 0.f; f32x16 o[2]; o[0] = f32x16{}; o[1] = f32x16{}; f32x16 negm = f32x16{};
    f32x16 p0 = f32x16{}, p1 = f32x16{}; v4u pw[4]; pw[0] = pw[1] = pw[2] = pw[3] = (v4u){0u, 0u, 0u, 0u};
    ATT_DMA(0, 0, 0); ATT_DMA(1, 1, 1); ATT_DMA(2, 2, 2);
    if (pend.valid) finish_unit(pend, T.O, lds, wid, lane);
    ATT_WAIT_TILES(2);
    __builtin_amdgcn_s_barrier(); asm volatile("" ::: "memory");
    if (half == 1) __builtin_amdgcn_s_barrier();
    int vs_prev = 0, vs_cur = 0, vs_iss = 3;
    for (int t = 0; t <= NTL; ++t) {
        if (t >= 1) {
            s16x4 lo[2][4], hh[2][4];
            const unsigned vb = (unsigned)(uintptr_t)(lds + LV + vs_prev * 8192) + ((lane >> 4) & 1) * 32 + (lane & 3) * 8 + (4 * hi + ((lane & 15) >> 2)) * 64;
#pragma unroll
            for (int d0 = 0; d0 < 2; ++d0)
#pragma unroll
                for (int ks = 0; ks < 4; ++ks) {
                    asm volatile("ds_read_b64_tr_b16 %0,%1 offset:%c2" : "=&v"(lo[d0][ks]) : "v"(vb), "i"(d0 * 4096 + ks * 1024) : "memory");
                    asm volatile("ds_read_b64_tr_b16 %0,%1 offset:%c2" : "=&v"(hh[d0][ks]) : "v"(vb), "i"(d0 * 4096 + ks * 1024 + 512) : "memory"); }
            asm volatile("s_waitcnt lgkmcnt(0)" ::: "memory"); __builtin_amdgcn_sched_barrier(0);
#pragma unroll
            for (int ks = 0; ks < 4; ++ks)
#pragma unroll
                for (int d0 = 0; d0 < 2; ++d0) { const bf16x8 vf = (bf16x8){lo[d0][ks][0], lo[d0][ks][1], lo[d0][ks][2], lo[d0][ks][3], hh[d0][ks][0], hh[d0][ks][1], hh[d0][ks][2], hh[d0][ks][3]};
                    o[d0] = __builtin_amdgcn_mfma_f32_32x32x16_bf16(__builtin_bit_cast(bf16x8, pw[ks]), vf, o[d0], 0, 0, 0); }
        }
        if (t < NTL) {
            bf16x8 kf[2 * ND];
            const lds_cptr kb = (lds_cptr)(lds + LK + (t & 3) * 12288) + hi * 1024 + r32 * 16;
#pragma unroll
            for (int d0 = 0; d0 < ND; ++d0) { kf[2 * d0] = *(const LAS bf16x8*)(kb + d0 * 2048); kf[2 * d0 + 1] = *(const LAS bf16x8*)(kb + d0 * 2048 + 512); }
            asm volatile("s_waitcnt lgkmcnt(0)" ::: "memory"); __builtin_amdgcn_sched_barrier(0);
#pragma unroll
            for (int d0 = 0; d0 < ND; ++d0) {
                if (d0 == 0) { p0 = __builtin_amdgcn_mfma_f32_32x32x16_bf16(kf[0], qr[0], negm, 0, 0, 0); p1 = __builtin_amdgcn_mfma_f32_32x32x16_bf16(kf[1], qr[0], negm, 0, 0, 0); }
                else { p0 = __builtin_amdgcn_mfma_f32_32x32x16_bf16(kf[2 * d0], qr[d0], p0, 0, 0, 0); p1 = __builtin_amdgcn_mfma_f32_32x32x16_bf16(kf[2 * d0 + 1], qr[d0], p1, 0, 0, 0); } }
        }
        if (half == 1) {
            const int last_iss = (t + PD - 1 < NTL - 1) ? t + PD - 1 : NTL - 1; const int allow = last_iss - (t + 1);
            if (allow >= 1) ATT_WAIT_TILES(1); else ATT_WAIT_TILES(0); }
        asm volatile("s_waitcnt lgkmcnt(0)" ::: "memory"); __builtin_amdgcn_s_barrier(); asm volatile("" ::: "memory");
        if (t < NTL) {
            float rm = max3f(p0[0], p0[1], p1[0]);
#pragma unroll
            for (int r = 0; r < 16; ++r) rm = max3f(rm, p0[r], p1[r]);
            { auto rr = __builtin_amdgcn_permlane32_swap(__float_as_uint(rm), __float_as_uint(rm), false, false); rm = fmaxf(__uint_as_float(rr[0]), __uint_as_float(rr[1])); }
            if (t == 0 || __any(rm > THR)) {
                const float dl = (t == 0) ? rm : fmaxf(rm, 0.f);
                mhat += dl;
#pragma unroll
                for (int r = 0; r < 16; ++r) { p0[r] -= dl; p1[r] -= dl; negm[r] = -mhat; }
                const float f = (t == 0) ? 1.f : __builtin_amdgcn_exp2f(-dl); lrun *= f;
                if (hi == 0) wsf[r32] = f;
                LDS_WAIT();
#pragma unroll
                for (int r = 0; r < 16; ++r) { const float a = wsf[crow(r, hi)]; o[0][r] *= a; o[1][r] *= a; }
            }
            float rs = 0.f;
#pragma unroll
            for (int r = 0; r < 16; ++r) { p0[r] = __builtin_amdgcn_exp2f(p0[r]); p1[r] = __builtin_amdgcn_exp2f(p1[r]); rs += p0[r] + p1[r]; }
            lrun += rs;
            pw[0] = (v4u){pk2(p0[0], p0[1]), pk2(p0[2], p0[3]), pk2(p0[4], p0[5]), pk2(p0[6], p0[7])};
            pw[1] = (v4u){pk2(p0[8], p0[9]), pk2(p0[10], p0[11]), pk2(p0[12], p0[13]), pk2(p0[14], p0[15])};
            pw[2] = (v4u){pk2(p1[0], p1[1]), pk2(p1[2], p1[3]), pk2(p1[4], p1[5]), pk2(p1[6], p1[7])};
            pw[3] = (v4u){pk2(p1[8], p1[9]), pk2(p1[10], p1[11]), pk2(p1[12], p1[13]), pk2(p1[14], p1[15])};
        }
        if (t + PD < NTL) { ATT_DMA(t + PD, (t + PD) & 3, vs_iss); vs_iss = (vs_iss == 4) ? 0 : vs_iss + 1; }
        if (half == 0) {
            const int last_iss = (t + PD < NTL - 1) ? t + PD : NTL - 1; const int allow = last_iss - (t + 1);
            if (allow >= 2) ATT_WAIT_TILES(2); else if (allow == 1) ATT_WAIT_TILES(1); else ATT_WAIT_TILES(0); }
        vs_prev = vs_cur; vs_cur = (vs_cur == 4) ? 0 : vs_cur + 1;
        asm volatile("s_waitcnt lgkmcnt(0)" ::: "memory"); __builtin_amdgcn_s_barrier(); asm volatile("" ::: "memory");
    }
    if (half == 0) __builtin_amdgcn_s_barrier();
#undef ATT_DMA
#undef ATT_WAIT_TILES
    pend.o0 = o[0]; pend.o1 = o[1]; pend.l = lrun; pend.qrow0 = qrow0; pend.oc0 = oc0; pend.valid = true;
}
#undef ATT_WAITV
}

namespace att64 {
typedef unsigned short bf16;
using bf16x8=__attribute__((ext_vector_type(8)))short;
using s16x4=__attribute__((ext_vector_type(4)))short;
using f32x16=__attribute__((ext_vector_type(16)))float;
using u32x4=__attribute__((ext_vector_type(4)))unsigned;
constexpr int D=64;
constexpr int NW=8,QBLK=32,QB=QBLK*NW,KVBLK=64;
__device__ __forceinline__ int crow(int r,int hi){return (r&3)+8*(r>>2)+4*hi;}
#define SBAR() __builtin_amdgcn_sched_barrier(0)
constexpr int NSLOT=3, SLOTB=8192;
constexpr int LDS_K=0, LDS_V=NSLOT*SLOTB, LDS_WS=2*NSLOT*SLOTB, LDS_OST=LDS_WS+NW*64*4, LDS_BYTES=LDS_OST+NW*4096;
constexpr float C2=0.125f*1.4426950408889634f;
__device__ __forceinline__ void glds16(const void*gsrc,unsigned lds_dst){unsigned keep;
  asm volatile("s_mov_b32 %0, m0\n\ts_mov_b32 m0, %2\n\ts_nop 0\n\tglobal_load_lds_dwordx4 %1, off\n\ts_mov_b32 m0, %0":"=&s"(keep):"v"(gsrc),"s"(lds_dst):"memory");}
__device__ __forceinline__ float max3f(float a,float b,float c){float r;asm("v_max3_f32 %0, %1, %2, %3":"=v"(r):"v"(a),"v"(b),"v"(c));return r;}
__device__ __forceinline__ float max2f(float a,float b){float r;asm("v_max_f32_e32 %0, %1, %2":"=v"(r):"v"(a),"v"(b));return r;}
__device__ __forceinline__ float fadd_s(float a,float b){float r;asm("v_add_f32_e32 %0, %1, %2":"=v"(r):"v"(a),"v"(b));return r;}
__device__ __forceinline__ float fsub_s(float a,float b){float r;asm("v_sub_f32_e32 %0, %1, %2":"=v"(r):"v"(a),"v"(b));return r;}
typedef float f32x2_t __attribute__((ext_vector_type(2))); typedef __bf16 bf16x2_t __attribute__((ext_vector_type(2)));
__device__ __forceinline__ unsigned cvtpk_s(float lo,float hi){f32x2_t v={lo,hi};bf16x2_t b=__builtin_convertvector(v,bf16x2_t);return __builtin_bit_cast(unsigned,b);}
#define WAIT_BAR(N) asm volatile("s_waitcnt vmcnt(" #N ") lgkmcnt(0)\n\ts_barrier":::"memory")

__device__ __forceinline__ void qkt(f32x16&p0,f32x16&p1,const char*Kslot,const bf16x8*qr,const f32x16&negm,int r32,int hi){
  const char*kb=Kslot+hi*1024+r32*16;
  #pragma unroll
  for(int d0=0;d0<4;++d0){
    const bf16x8 b0=*reinterpret_cast<const bf16x8*>(kb+d0*2048);
    const bf16x8 b1=*reinterpret_cast<const bf16x8*>(kb+d0*2048+512);
    if(d0==0){p0=__builtin_amdgcn_mfma_f32_32x32x16_bf16(b0,qr[0],negm,0,0,0);p1=__builtin_amdgcn_mfma_f32_32x32x16_bf16(b1,qr[0],negm,0,0,0);}
    else{p0=__builtin_amdgcn_mfma_f32_32x32x16_bf16(b0,qr[d0],p0,0,0,0);p1=__builtin_amdgcn_mfma_f32_32x32x16_bf16(b1,qr[d0],p1,0,0,0);}}
}
typedef __attribute__((address_space(3))) const char* lds_cptr;
typedef short v4i16_t __attribute__((ext_vector_type(4)));
__device__ __forceinline__ void kload8(bf16x8*kf,lds_cptr kp){
  kf[0]=*(const __attribute__((address_space(3))) bf16x8*)(kp);      kf[1]=*(const __attribute__((address_space(3))) bf16x8*)(kp+512);
  kf[2]=*(const __attribute__((address_space(3))) bf16x8*)(kp+2048); kf[3]=*(const __attribute__((address_space(3))) bf16x8*)(kp+2560);
  kf[4]=*(const __attribute__((address_space(3))) bf16x8*)(kp+4096); kf[5]=*(const __attribute__((address_space(3))) bf16x8*)(kp+4608);
  kf[6]=*(const __attribute__((address_space(3))) bf16x8*)(kp+6144); kf[7]=*(const __attribute__((address_space(3))) bf16x8*)(kp+6656);
}
__device__ __forceinline__ void kload2(bf16x8*kf,lds_cptr kp,int j){ kf[2*j]=*(const __attribute__((address_space(3))) bf16x8*)(kp+j*2048); kf[2*j+1]=*(const __attribute__((address_space(3))) bf16x8*)(kp+j*2048+512); }
__device__ __forceinline__ s16x4 vtr(lds_cptr p){ return __builtin_bit_cast(s16x4,__builtin_amdgcn_ds_read_tr16_b64_v4i16((__attribute__((address_space(3))) v4i16_t*)p)); }
__device__ __forceinline__ float rowmax(const f32x16&p0,const f32x16&p1){
  float a=max3f(p0[0],p0[1],p1[0]),b=max3f(p0[2],p0[3],p1[1]);a=max3f(a,p1[2],p1[3]);
  #pragma unroll
  for(int r=4;r<16;r+=4){a=max3f(a,p0[r],p0[r+1]);b=max3f(b,p0[r+2],p0[r+3]);a=max3f(a,p1[r],p1[r+1]);b=max3f(b,p1[r+2],p1[r+3]);}
  const float m=max2f(a,b);
  auto rr=__builtin_amdgcn_permlane32_swap(__float_as_uint(m),__float_as_uint(m),false,false);
  return max2f(__uint_as_float(rr[0]),__uint_as_float(rr[1]));
}
__device__ __forceinline__ void pv(f32x16*o,int vb,bf16x8 pa0,bf16x8 pa1,bf16x8 pa2,bf16x8 pa3){
  #pragma unroll
  for(int d0=0;d0<2;++d0){s16x4 lo[4],hi[4];
    #pragma unroll
    for(int ks=0;ks<4;++ks){
      asm volatile("ds_read_b64_tr_b16 %0,%1 offset:%c2":"=&v"(lo[ks]):"v"(vb),"i"(d0*4096+ks*1024):"memory");
      asm volatile("ds_read_b64_tr_b16 %0,%1 offset:%c2":"=&v"(hi[ks]):"v"(vb),"i"(d0*4096+ks*1024+512):"memory");}
    asm volatile("s_waitcnt lgkmcnt(0)":::"memory");SBAR();
    #define PK(k) (bf16x8){lo[k][0],lo[k][1],lo[k][2],lo[k][3],hi[k][0],hi[k][1],hi[k][2],hi[k][3]}
    o[d0]=__builtin_amdgcn_mfma_f32_32x32x16_bf16(pa0,PK(0),o[d0],0,0,0);
    o[d0]=__builtin_amdgcn_mfma_f32_32x32x16_bf16(pa1,PK(1),o[d0],0,0,0);
    o[d0]=__builtin_amdgcn_mfma_f32_32x32x16_bf16(pa2,PK(2),o[d0],0,0,0);
    o[d0]=__builtin_amdgcn_mfma_f32_32x32x16_bf16(pa3,PK(3),o[d0],0,0,0);
    #undef PK
  }
}

#ifndef ATTN_STORE16
#define ATTN_STORE16(p,v) (*(u32x4*)(p)=(v))
#endif
template<int THRL> __device__ __forceinline__ void attn_unit(const bf16*Q,int qp,int qrow0,int qc0,const bf16*__restrict__ K,int kp,int kc0,const bf16*__restrict__ V,int vp,int vc0,bf16*O,int oc0,int kctx0,int klat0,int NT,char*shm,int wave_id){
  wave_id=launder_s(wave_id); const int lane=lane_id_v(),r32=lane&31,hi=lane>>5; const int wid=wave_id;
  const bf16*Qw=Q+(long)(qrow0+wid*QBLK)*qp+qc0;
  const bf16*Kh=K+kc0,*Vh=V+vc0;
  const unsigned lds0=(unsigned)(uintptr_t)shm;
  float*wsf=(float*)(shm+LDS_WS)+wid*64;
  const bf16*ksrc=Kh+(long)lane*kp+wid*8;
  const bf16*vsrc=Vh+(long)(16*(wid&3)+(lane>>2))*vp+(wid>>2)*32+(lane&3)*8;
  #define TROW0(t) ((long)((t)<4?kctx0+64*(t):klat0+64*((t)-4)))
  const unsigned kdst=lds0+LDS_K+wid*1024, vdst=lds0+LDS_V+wid*1024;
  #define DMA_K(t,slot) glds16(ksrc+TROW0(t)*kp,(unsigned)__builtin_amdgcn_readfirstlane(kdst+(slot)))
  #define DMA_V(t,slot) glds16(vsrc+TROW0(t)*vp,(unsigned)__builtin_amdgcn_readfirstlane(vdst+(slot)))
  const int vb0=(int)(lds0+LDS_V)+((lane>>4)&1)*32+(lane&3)*8+(4*hi+((lane&15)>>2))*64;
  const char*Kbase=shm+LDS_K; bf16x8 kf[8];
  const lds_cptr shm3=(lds_cptr)shm; const lds_cptr kp0=shm3+LDS_K+hi*1024+r32*16; const lds_cptr vp0=shm3+LDS_V+((lane>>4)&1)*32+(lane&3)*8+(4*hi+((lane&15)>>2))*64;
  DMA_K(0,0);DMA_V(0,0);DMA_K(1,SLOTB);
  bf16x8 qr[4];
  #pragma unroll
  for(int d0=0;d0<4;++d0)qr[d0]=*reinterpret_cast<const bf16x8*>(&Qw[(long)r32*qp+d0*16+hi*8]);
  float mhat=0.f,l_reg=0.f;f32x16 o[2];o[0]=f32x16{};o[1]=f32x16{};f32x16 negm=f32x16{};asm volatile("":"+v"(negm));
  #define CMASK(P0,P1,t) do{}while(0)
  bool resc=false;
  #define START(P0,P1) do{ const float rm=rowmax(P0,P1); resc=false; \
    { const float dl=rm; mhat=fadd_s(mhat,dl); \
      _Pragma("unroll") for(int r=0;r<16;++r){P0[r]=fsub_s(P0[r],dl);P1[r]=fsub_s(P1[r],dl);} \
      _Pragma("unroll") for(int r=0;r<16;++r)negm[r]=-mhat; asm volatile("":"+v"(negm)); } \
    _Pragma("unroll") for(int r=0;r<16;++r)P0[r]=__builtin_amdgcn_exp2f(P0[r]); }while(0)
  #define RESC() do{ if(resc){ asm volatile("s_waitcnt lgkmcnt(0)":::"memory"); \
      _Pragma("unroll") for(int d_=0;d_<2;++d_) _Pragma("unroll") for(int r=0;r<16;++r)o[d_][r]*=wsf[crow(r,hi)]; } }while(0)
  f32x16 pA0,pA1,pB0,pB1;
  int sl_prev=0,sl_cur=0,sl_next=SLOTB;
  #define ROT() do{sl_prev=sl_cur;sl_cur=sl_next;sl_next=(sl_next==(NSLOT-1)*SLOTB)?0:sl_next+SLOTB;}while(0)
  DMA_K(2,2*SLOTB);
  WAIT_BAR(3);
  qkt(pA0,pA1,Kbase,qr,negm,r32,hi);asm volatile("s_nop 15\n\ts_nop 7":"+v"(pA0),"+v"(pA1));CMASK(pA0,pA1,0);
  START(pA0,pA1);
  _Pragma("unroll") for(int r=0;r<16;++r)pA1[r]=__builtin_amdgcn_exp2f(pA1[r]);
  WAIT_BAR(0);
  DMA_K(3,0);DMA_V(1,SLOTB);
  ROT();
  kload8(kf,kp0+sl_cur);
  WAIT_BAR(2);
  s16x4 vlo[8],vhi[8]; u32x4 pw0,pw1,pw2,pw3;
  #define PKW(P,B) cvtpk_s(P[B],P[B+1])
  #define PAF(k) __builtin_bit_cast(bf16x8,pw##k)
  #define VFR(i) (bf16x8){vlo[i][0],vlo[i][1],vlo[i][2],vlo[i][3],vhi[i][0],vhi[i][1],vhi[i][2],vhi[i][3]}
  #define PIN(x) asm volatile("":"+v"(x))
  #define MX3(a,b,c) __builtin_fmaxf(__builtin_fmaxf((a),(b)),(c))
  #define GAPA(MF,A0,A1,A2,A3,W0,W1,PW) do{ MF; sacc+=A0; sacc+=A1; sacc+=A2; sacc+=A3; PIN(sacc); W0; W1; PIN(PW); SBAR(); }while(0)
  #define EX(v) __builtin_amdgcn_exp2f(v)
  #define GAPB(MF,X,B) do{ MF; X[B]=EX(X[B]); X[B+1]=EX(X[B+1]); X[B+2]=EX(X[B+2]); X[B+3]=EX(X[B+3]); PIN(X); SBAR(); }while(0)
  #define VRD(i) do{ vlo[i]=vtr(vp_+(((i)>>2)*4096+((i)&3)*1024)); vhi[i]=vtr(vp_+(((i)>>2)*4096+((i)&3)*1024+512)); }while(0)
  #define KRD(G,j) do{ if(G){ kload2(kf,kp0+sl_next,j); SBAR(); } }while(0)
  #define STEP(C0,C1,P0,P1,t,GK,GV,GL) do{ SBAR(); \
    const lds_cptr vp_=vp0+sl_prev; \
    VRD(0); SBAR(); float sacc=(P0[0]+P0[1]); \
    GAPA(C0=__builtin_amdgcn_mfma_f32_32x32x16_bf16(kf[0],qr[0],negm,0,0,0), P0[2],P0[3],P0[4],P0[5],     pw0[0]=PKW(P0,0), pw0[1]=PKW(P0,2), pw0); \
    VRD(4); SBAR(); GAPA(C1=__builtin_amdgcn_mfma_f32_32x32x16_bf16(kf[1],qr[0],negm,0,0,0), P0[6],P0[7],P0[8],P0[9],     pw0[2]=PKW(P0,4), pw0[3]=PKW(P0,6), pw0); \
    VRD(1); SBAR(); GAPA(C0=__builtin_amdgcn_mfma_f32_32x32x16_bf16(kf[2],qr[1],C0,0,0,0),   P0[10],P0[11],P0[12],P0[13], pw1[0]=PKW(P0,8), pw1[1]=PKW(P0,10), pw1); \
    VRD(5); SBAR(); GAPA(C1=__builtin_amdgcn_mfma_f32_32x32x16_bf16(kf[3],qr[1],C1,0,0,0),   P0[14],P0[15],P1[0],P1[1],   pw1[2]=PKW(P0,12),pw1[3]=PKW(P0,14), pw1); \
    VRD(2); SBAR(); GAPA(C0=__builtin_amdgcn_mfma_f32_32x32x16_bf16(kf[4],qr[2],C0,0,0,0),   P1[2],P1[3],P1[4],P1[5],     pw2[0]=PKW(P1,0), pw2[1]=PKW(P1,2), pw2); \
    VRD(6); SBAR(); GAPA(C1=__builtin_amdgcn_mfma_f32_32x32x16_bf16(kf[5],qr[2],C1,0,0,0),   P1[6],P1[7],P1[8],P1[9],     pw2[2]=PKW(P1,4), pw2[3]=PKW(P1,6), pw2); \
    VRD(3); SBAR(); GAPA(C0=__builtin_amdgcn_mfma_f32_32x32x16_bf16(kf[6],qr[3],C0,0,0,0),   P1[10],P1[11],P1[12],P1[13], pw3[0]=PKW(P1,8), pw3[1]=PKW(P1,10), pw3); \
    VRD(7); SBAR(); GAPA(C1=__builtin_amdgcn_mfma_f32_32x32x16_bf16(kf[7],qr[3],C1,0,0,0),   P1[14],P1[15],0.f,0.f,       pw3[2]=PKW(P1,12),pw3[3]=PKW(P1,14), pw3); \
    l_reg+=sacc; \
    if(GK){DMA_K((t)+3,sl_cur);} if(GV){DMA_V((t)+1,sl_next);} \
    CMASK(C0,C1,t); \
    { float a=MX3(C0[0],C0[1],C1[0]),b=MX3(C0[2],C0[3],C1[1]); a=MX3(a,C1[2],C1[3]); \
      _Pragma("unroll") for(int r=4;r<16;r+=4){a=MX3(a,C0[r],C0[r+1]);b=MX3(b,C0[r+2],C0[r+3]);a=MX3(a,C1[r],C1[r+1]);b=MX3(b,C1[r+2],C1[r+3]);} \
      float rm=__builtin_fmaxf(a,b); { auto rr=__builtin_amdgcn_permlane32_swap(__float_as_uint(rm),__float_as_uint(rm),false,false); rm=__builtin_fmaxf(__uint_as_float(rr[0]),__uint_as_float(rr[1])); } \
      resc=false; \
      if(__builtin_expect(__any(rm>(float)THRL),0)){ const float dl=__builtin_fmaxf(rm,0.f); mhat+=dl; \
        _Pragma("unroll") for(int r=0;r<16;++r){C0[r]-=dl;C1[r]-=dl;} \
        _Pragma("unroll") for(int r=0;r<16;++r)negm[r]=-mhat; asm volatile("":"+v"(negm)); \
        const float f=__builtin_amdgcn_exp2f(-dl); l_reg*=f; if(hi==0)wsf[r32]=f; resc=true; } } \
    SBAR(); \
    GAPB(o[0]=__builtin_amdgcn_mfma_f32_32x32x16_bf16(PAF(0),VFR(0),o[0],0,0,0), C0,0); \
    GAPB(o[1]=__builtin_amdgcn_mfma_f32_32x32x16_bf16(PAF(0),VFR(4),o[1],0,0,0), C0,4); \
    KRD(GL,0); GAPB(o[0]=__builtin_amdgcn_mfma_f32_32x32x16_bf16(PAF(1),VFR(1),o[0],0,0,0), C0,8); \
    KRD(GL,1); GAPB(o[1]=__builtin_amdgcn_mfma_f32_32x32x16_bf16(PAF(1),VFR(5),o[1],0,0,0), C0,12); \
    KRD(GL,2); GAPB(o[0]=__builtin_amdgcn_mfma_f32_32x32x16_bf16(PAF(2),VFR(2),o[0],0,0,0), C1,0); \
    KRD(GL,3); GAPB(o[1]=__builtin_amdgcn_mfma_f32_32x32x16_bf16(PAF(2),VFR(6),o[1],0,0,0), C1,4); \
    GAPB(o[0]=__builtin_amdgcn_mfma_f32_32x32x16_bf16(PAF(3),VFR(3),o[0],0,0,0), C1,8); \
    GAPB(o[1]=__builtin_amdgcn_mfma_f32_32x32x16_bf16(PAF(3),VFR(7),o[1],0,0,0), C1,12); \
    }while(0)
  int t=1;
  for(;t+5<NT;t+=2){
    STEP(pB0,pB1,pA0,pA1,t,true,true,true);     WAIT_BAR(2); RESC(); ROT();
    STEP(pA0,pA1,pB0,pB1,t+1,true,true,true);   WAIT_BAR(2); RESC(); ROT();
  }
  #define ENDW(tt) do{ if((tt)+3<NT){WAIT_BAR(2);} else if((tt)+2<NT){WAIT_BAR(1);} else {WAIT_BAR(0);} }while(0)
  for(;t+1<NT;t+=2){
    STEP(pB0,pB1,pA0,pA1,t,(t+3<NT),(t+1<NT),(t+1<NT));       ENDW(t);   RESC(); ROT();
    STEP(pA0,pA1,pB0,pB1,t+1,(t+4<NT),(t+2<NT),(t+2<NT));     ENDW(t+1); RESC(); ROT();
  }
  STEP(pB0,pB1,pA0,pA1,NT-1,false,false,false); RESC();
  { float sacc=pB0[0]+pB0[1]; _Pragma("unroll") for(int r=2;r<16;++r)sacc+=pB0[r]; _Pragma("unroll") for(int r=0;r<16;++r)sacc+=pB1[r]; l_reg+=sacc;
    pw0=(u32x4){PKW(pB0,0),PKW(pB0,2),PKW(pB0,4),PKW(pB0,6)};pw1=(u32x4){PKW(pB0,8),PKW(pB0,10),PKW(pB0,12),PKW(pB0,14)};pw2=(u32x4){PKW(pB1,0),PKW(pB1,2),PKW(pB1,4),PKW(pB1,6)};pw3=(u32x4){PKW(pB1,8),PKW(pB1,10),PKW(pB1,12),PKW(pB1,14)};
    SBAR(); pv(o,vb0+sl_cur,PAF(0),PAF(1),PAF(2),PAF(3)); }
  #undef PKW
  #undef PAF
  #undef VFR
  #undef PIN
  #undef MX3
  #undef GAPA
  #undef GAPB
  #undef EX
  #undef VRD
  #undef KRD
  #undef STEP
  #undef ENDW
  {auto rr=__builtin_amdgcn_permlane32_swap(__float_as_uint(l_reg),__float_as_uint(l_reg),false,false);l_reg=__uint_as_float(rr[0])+__uint_as_float(rr[1]);}
  if(hi==0)wsf[32+r32]=l_reg;asm volatile("s_waitcnt lgkmcnt(0)":::"memory");
  float rli[16];
  #pragma unroll
  for(int r=0;r<16;++r)rli[r]=__builtin_amdgcn_rcpf(wsf[32+crow(r,hi)]);
  bf16*Ow=O+(long)(qrow0+wid*QBLK)*1024+oc0;
  { bf16*stg=(bf16*)(shm+LDS_OST)+wid*2048;
    #pragma unroll
    for(int r=0;r<16;++r){const int orow=crow(r,hi);
      #pragma unroll
      for(int d0=0;d0<2;++d0)stg[orow*64+d0*32+r32]=(bf16)(cvtpk_s(o[d0][r]*rli[r],0.f)&0xffffu);}
    asm volatile("s_waitcnt lgkmcnt(0)":::"memory");
    #pragma unroll
    for(int i=0;i<4;++i){const int row=i*8+(lane>>3),ch=lane&7; const u32x4 v=*(const u32x4*)(stg+row*64+ch*8); ATTN_STORE16(Ow+(long)row*1024+ch*8,v);} }
  asm volatile("s_waitcnt lgkmcnt(0)\n\ts_barrier":::"memory");
  #undef DMA_K
  #undef DMA_V
  #undef TROW0
  #undef CMASK
  #undef START
  #undef RESC
  #undef ROT
}
#undef SBAR
#undef WAIT_BAR
}

struct Args { const float* in[27]; float* out; unsigned char* ws; int ph_lo, ph_hi; };
struct Frame {
    LAS unsigned char* lds; unsigned char* ws; gu32* ctl; int wave, G, gw, NGW;
};
__device__ __forceinline__ int lthread(int wave) { return wave * 64 + lane_id_v(); }

template <int MODE>
__device__ __forceinline__ void conv_item(const float* W, int K, int N, bf16* WT, LAS float* scr, int item, int lane) {
    const int nblk = (N + 63) / 64, kb = item / nblk, nb = item % nblk, k0 = 64 * kb, n0 = 64 * nb;
    f32x4 v[16];
    const int cc = (lane & 15) * 4, rk = lane >> 4;
    const bool ok = (n0 + cc) < N;
#pragma unroll
    for (int i = 0; i < 16; ++i) v[i] = ok ? *(const f32x4*)(W + (size_t)(k0 + 4 * i + rk) * N + n0 + cc) : (f32x4){0.f, 0.f, 0.f, 0.f};
#pragma unroll
    for (int i = 0; i < 16; ++i) { LAS float* s = scr + (4 * i + rk) * 65 + cc; s[0] = v[i][0]; s[1] = v[i][1]; s[2] = v[i][2]; s[3] = v[i][3]; }
    LDS_WAIT(); asm volatile("" ::: "memory");
    const int c = lane & 7;
#pragma unroll
    for (int j = 0; j < 8; ++j) { const int n = (lane >> 3) + 8 * j; const LAS float* s = scr + (8 * c) * 65 + n;
        v4u o; o.x = pk2(s[0], s[65]); o.y = pk2(s[2 * 65], s[3 * 65]); o.z = pk2(s[4 * 65], s[5 * 65]); o.w = pk2(s[6 * 65], s[7 * 65]);
        const int ng = n0 + n; if (ng < N) { const int dr = (MODE == 1) ? ((ng >> 8) * 256 + (ng & 1) * 128 + ((ng >> 1) & 127)) : ng; *(v4u*)(WT + (size_t)dr * K + k0 + 8 * c) = o; } }
    LDS_WAIT(); asm volatile("" ::: "memory");
}

__device__ __forceinline__ void prologue(Frame& F, const Args& a) {
    const int f_tid = lthread(F.wave), f_lane = f_tid & 63;
    unsigned char* ws = F.ws;
    {
        LAS float* scr = (LAS float*)(F.lds + F.wave * 16640);
        struct M { const float* src; int K, N; size_t dst; };
        const int I_FO = 16 * 16, I_MIN = 16 * 11, I_QB = 6 * 24, I_KVB = 4 * 32, I_MO = 256, I_GQKV = 16 * 24, I_GO = 256;
        const int NSMALL = 2 * I_FO + I_MIN + I_QB + I_KVB + I_MO + I_GQKV + I_GO;
        for (int it = F.gw; it < NSMALL; it += F.NGW) {
            int r = it;
            if (r < 2 * I_FO) { const int j = r / I_FO; conv_item<0>(a.in[10] + (size_t)j * D * D, D, D, (bf16*)(ws + WS_WFOUT) + (size_t)j * D * D, scr, r % I_FO, f_lane); continue; } r -= 2 * I_FO;
            if (r < I_MIN) { conv_item<0>(a.in[11], D, MLA_IN, (bf16*)(ws + WS_WMIN), scr, r, f_lane); continue; } r -= I_MIN;
            if (r < I_QB) { conv_item<0>(a.in[13], MLA_QL, 1536, (bf16*)(ws + WS_WMQB), scr, r, f_lane); continue; } r -= I_QB;
            if (r < I_KVB) { conv_item<0>(a.in[15], MLA_KVL, 2048, (bf16*)(ws + WS_WMKVB), scr, r, f_lane); continue; } r -= I_KVB;
            if (r < I_MO) { conv_item<0>(a.in[16], D, D, (bf16*)(ws + WS_WMO), scr, r, f_lane); continue; } r -= I_MO;
            if (r < I_GQKV) { conv_item<0>(a.in[17], D, GQA_QKV, (bf16*)(ws + WS_WGQKV), scr, r, f_lane); continue; } r -= I_GQKV;
            conv_item<0>(a.in[20], D, D, (bf16*)(ws + WS_WGO), scr, r, f_lane);
        }
    }
    __syncthreads();
    {
        LAS float* cmax = (LAS float*)F.lds;
        LAS float* cinv = cmax + 512;
        LAS unsigned* scr8 = (LAS unsigned*)(F.lds + 4096) + F.wave * (64 * 33);
        const int cc = (f_lane & 15) * 4, rk = f_lane >> 4;
        constexpr int NGU = DEPTH * NE * 32, NDN = DEPTH * NE * 16;
        for (int it = blockIdx.x; it < NGU + NDN; it += F.G) {
            const bool dn = it >= NGU; const int q_ = dn ? it - NGU : it; const int le = dn ? (q_ >> 4) : (q_ >> 5), strip = dn ? (q_ & 15) : (q_ & 31);
            const int N = dn ? 1024 : 2048;
            const float* W = (dn ? a.in[25] + (size_t)le * DFF * D : a.in[23] + (size_t)le * D * 2048) + strip * 64 + cc;
            f32x4 v[32];
#pragma unroll
            for (int i = 0; i < 32; ++i) v[i] = *(const f32x4*)(W + (size_t)(F.wave * 128 + 16 * (i >> 2) + 4 * rk + (i & 3)) * N);
            f32x4 mx = (f32x4){0.f, 0.f, 0.f, 0.f};
#pragma unroll
            for (int i = 0; i < 32; ++i) { mx[0] = fmaxf(mx[0], fabsf(v[i][0])); mx[1] = fmaxf(mx[1], fabsf(v[i][1])); mx[2] = fmaxf(mx[2], fabsf(v[i][2])); mx[3] = fmaxf(mx[3], fabsf(v[i][3])); }
#pragma unroll
            for (int q = 0; q < 4; ++q) { mx[q] = fmaxf(mx[q], shx(mx[q], 16, f_lane)); mx[q] = fmaxf(mx[q], shx(mx[q], 32, f_lane)); }
            __syncthreads();
            if (rk == 0) { LAS float* d = cmax + F.wave * 64 + cc; d[0] = mx[0]; d[1] = mx[1]; d[2] = mx[2]; d[3] = mx[3]; }
            __syncthreads();
            const float target = dn ? 240.f : 127.f;
            if (f_tid < 64) { float m8 = 0.f;
#pragma unroll
                for (int w = 0; w < 8; ++w) m8 = fmaxf(m8, cmax[w * 64 + f_tid]);
                const int ng = strip * 64 + f_tid, dr = dn ? ng : (ng >> 8) * 256 + (ng & 1) * 128 + ((ng >> 1) & 127);
                float* sc = dn ? (float*)(ws + WS_SWDN) + (size_t)le * 1024 : (float*)(ws + WS_SWGU) + (size_t)le * 2048;
                sc[dr] = (m8 > 0.f) ? m8 / target : 1.f;
                cinv[f_tid] = (m8 > 0.f) ? target / m8 : 0.f; }
            __syncthreads();
            const f32x4 iv = *(const LAS f32x4*)(cinv + cc);
#pragma unroll
            for (int ip = 0; ip < 8; ++ip) {
#pragma unroll
                for (int q = 0; q < 4; ++q) { unsigned w = 0;
                    if (dn) { int t = __builtin_amdgcn_cvt_pk_fp8_f32(v[4 * ip][q] * iv[q], v[4 * ip + 1][q] * iv[q], 0, false); t = __builtin_amdgcn_cvt_pk_fp8_f32(v[4 * ip + 2][q] * iv[q], v[4 * ip + 3][q] * iv[q], t, true); w = (unsigned)t; }
                    else {
#pragma unroll
                        for (int j = 0; j < 4; ++j) { int qi = __float2int_rn(v[4 * ip + j][q] * iv[q]); qi = qi > 127 ? 127 : (qi < -127 ? -127 : qi); w |= ((unsigned)qi & 255u) << (8 * j); } }
                    scr8[(cc + q) * 33 + 4 * ip + rk] = w; } }
            LDS_WAIT(); asm volatile("" ::: "memory");
            { const int c8 = f_lane & 7;
              unsigned char* dst = dn ? (unsigned char*)(ws + WS_WDN) + (size_t)le * 1024 * 1024 : (unsigned char*)(ws + WS_WGU) + (size_t)le * 2048 * 1024;
#pragma unroll
              for (int jp = 0; jp < 8; ++jp) { const int n = (f_lane >> 3) + 8 * jp; const LAS unsigned* sp = scr8 + n * 33 + 4 * c8;
                  v4u o; o.x = sp[0]; o.y = sp[1]; o.z = sp[2]; o[3] = sp[3];
                  const int ng = strip * 64 + n, dr = dn ? ng : (ng >> 8) * 256 + (ng & 1) * 128 + ((ng >> 1) & 127);
                  *(v4u*)(dst + (size_t)dr * 1024 + F.wave * 128 + 16 * c8) = o; } }
            LDS_WAIT(); asm volatile("" ::: "memory");
        }
        __syncthreads();
    }
    const int gtid = blockIdx.x * 512 + f_tid, gthreads = F.G * 512;
    for (int i = gtid; i < (MLA_IN_PAD - MLA_IN) * D / 8; i += gthreads) ((v4u*)((bf16*)(ws + WS_WMIN) + (size_t)MLA_IN * D))[i] = (v4u){0u, 0u, 0u, 0u};
    {
        bf16* MA = (bf16*)(ws + WS_MA);
        for (int i = gtid; i < 256 * 256; i += gthreads) { const int row = i >> 8, col = i & 255, jp = row >> 7, pp = (row >> 6) & 1, k1 = row & 63, j = col >> 7, pt = (col >> 6) & 1, l1 = col & 63;
            float v = 0.f; if (j == jp) { const float x = 2.f * (float)((k1 * l1) & 63) / 64.f; const float cs = cospif(x), sn = sinpif(x); v = (pp == 0) ? (pt == 0 ? cs : sn) : (pt == 0 ? -sn : cs); }
            MA[i] = (bf16)(pk2(v, 0.f) & 0xffffu); }
        bf16* DC = (bf16*)(ws + WS_DC); const float sc = 1.0f / sqrtf(256.f * 128.f);
        for (int i = gtid; i < 256 * 512; i += gthreads) { const int k = i >> 9, col = i & 511, pt = col >> 8, l = col & 255; const float x = 2.f * (float)((k * l) & 255) / 256.f;
            const float v = (pt == 0 ? cospif(x) : sinpif(x)) * sc; DC[i] = (bf16)(pk2(v, 0.f) & 0xffffu); }
        bf16* MC = (bf16*)(ws + WS_MC); const float sl = 1.0f / sqrtf(4096.f * 128.f);
        for (int i = gtid; i < 16 * 256 * 512; i += gthreads) { const int kq = i >> 17, row = (i >> 9) & 255, col = i & 511, kkp = row >> 6, k2 = row & 63, kk = col >> 7, pp = (col >> 6) & 1, l2 = col & 63;
            float v = 0.f; if (kk == kkp) { const int k = 4 * kq + kkp + 64 * k2; const float x = 2.f * (float)((l2 * k) & 4095) / 4096.f; v = (pp == 0 ? cospif(x) : sinpif(x)) * sl; }
            MC[i] = (bf16)(pk2(v, 0.f) & 0xffffu); }
        float* RM = (float*)(ws + WS_ROPE); float* RG = RM + 2048;
        for (int i = gtid; i < 64 * 8; i += gthreads) { const int pos = i >> 3, f = i & 7; const float inv = powf(10000.f, -(float)f / 8.f); float s, c; sincosf((float)pos * inv, &s, &c); RM[2 * i] = c; RM[2 * i + 1] = s; }
        for (int i = gtid; i < 64 * 16; i += gthreads) { const int pos = i >> 4, f = i & 15; const float inv = powf(10000.f, -(float)f / 16.f); float s, c; sincosf((float)pos * inv, &s, &c); RG[2 * i] = c; RG[2 * i + 1] = s; }
        float* WRT = (float*)(ws + WS_WRT);
        for (int i = gtid; i < DEPTH * NE * D; i += gthreads) { const int l = i >> 15, e = (i >> 10) & 31, k = i & 1023; WRT[i] = a.in[21][((size_t)l * D + k) * NE + e]; }
        float* BG = (float*)(ws + WS_BGU);
        for (int i = gtid; i < DEPTH * NE * 2048; i += gthreads) { const int le = i >> 11, q = i & 2047, pn = q >> 8, s = (q >> 7) & 1, jj = q & 127; BG[i] = a.in[24][(size_t)le * 2048 + 2 * (pn * 128 + jj) + s]; }
    }
    __syncthreads();
    {
        LAS float* wl = (LAS float*)F.lds;
        LAS float* tc = wl + 2048; LAS float* ts = tc + 128;
        if (f_tid < 128) { const float x = 2.f * (float)f_tid / 128.f; tc[f_tid] = cospif(x); ts[f_tid] = -sinpif(x); }
        for (int it = blockIdx.x; it < 2 * 8 * 64; it += F.G) { const int j = it >> 9, g = (it >> 6) & 7, kb = it & 63;
            __syncthreads();
            { const int kk = f_tid >> 5, c4 = (f_tid & 31) * 4; const f32x4 w = *(const f32x4*)(a.in[9] + ((size_t)j * D + kb * 16 + kk) * D + g * 128 + c4);
              LAS float* d = wl + c4 * 16 + kk; d[0] = w[0]; d[16] = w[1]; d[32] = w[2]; d[48] = w[3]; }
            __syncthreads();
            const int cl = f_tid & 255, m = cl >> 1, part = cl & 1, kh = f_tid >> 8; const LAS float* tw = part ? ts : tc;
            float accv[8];
#pragma unroll
            for (int q = 0; q < 8; ++q) accv[q] = 0.f;
            for (int jj = 0; jj < 128; ++jj) { const float t = tw[(m * jj) & 127]; const f32x4 wa = *(const LAS f32x4*)(wl + jj * 16 + kh * 8), wb = *(const LAS f32x4*)(wl + jj * 16 + kh * 8 + 4);
                accv[0] += wa[0] * t; accv[1] += wa[1] * t; accv[2] += wa[2] * t; accv[3] += wa[3] * t; accv[4] += wb[0] * t; accv[5] += wb[1] * t; accv[6] += wb[2] * t; accv[7] += wb[3] * t; }
            v4u o; o.x = pk2(accv[0], accv[1]); o.y = pk2(accv[2], accv[3]); o.z = pk2(accv[4], accv[5]); o.w = pk2(accv[6], accv[7]);
            *(v4u*)((bf16*)(ws + WS_WFIN) + ((size_t)j * 2048 + g * 256 + cl) * D + kb * 16 + kh * 8) = o;
        }
        __syncthreads();
    }
    {
        LAS float* S = (LAS float*)F.lds;
        LAS float* red = S + 9 * 1024;
        for (int i = f_tid; i < 9 * 1024; i += 512) { const int r = i >> 10, k = i & 1023; const float v = (r < 8) ? a.in[1][r * D + k] : a.in[3][k]; S[i] = v / (1.f + __expf(-v)); }
        __syncthreads();
        for (int it = blockIdx.x; it < DEPTH * 96; it += F.G) { const int l = it / 96, n0 = (it % 96) * 64;
            const float* wp = a.in[4] + ((size_t)l * D + F.wave * 128) * (NMOD * D) + n0 + f_lane;
            float accv[9];
#pragma unroll
            for (int r = 0; r < 9; ++r) accv[r] = 0.f;
            for (int k0 = 0; k0 < 128; k0 += 32) { float wv[32];
#pragma unroll
                for (int k = 0; k < 32; ++k) wv[k] = wp[(size_t)(k0 + k) * (NMOD * D)];
#pragma unroll
                for (int k = 0; k < 32; ++k)
#pragma unroll
                    for (int r = 0; r < 9; ++r) accv[r] += S[r * 1024 + F.wave * 128 + k0 + k] * wv[k]; }
#pragma unroll
            for (int r = 0; r < 9; ++r) red[(F.wave * 9 + r) * 64 + f_lane] = accv[r];
            __syncthreads();
            for (int i = f_tid; i < 9 * 64; i += 512) { const int r = i >> 6, ln = i & 63; float s = a.in[5][(size_t)l * (NMOD * D) + n0 + ln];
#pragma unroll
                for (int w = 0; w < 8; ++w) s += red[(w * 9 + r) * 64 + ln];
                ((float*)(ws + WS_MOD))[((size_t)l * 9 + r) * (NMOD * D) + n0 + ln] = s; }
            __syncthreads();
        }
    }
}

__device__ __forceinline__ void load_row(const float* p, int lane, f32x4 (&v)[4]) {
#pragma unroll
    for (int j = 0; j < 4; ++j) v[j] = ((const f32x4*)p)[lane + 64 * j];
}
__device__ __forceinline__ void load_row_bf(const bf16* p, int lane, f32x4 (&v)[4]) {
#pragma unroll
    for (int j = 0; j < 4; ++j) { const v2u w = ((const v2u*)p)[lane + 64 * j]; v[j] = (f32x4){bf_lo(w.x), bf_hi(w.x), bf_lo(w.y), bf_hi(w.y)}; }
}
__device__ __forceinline__ void norm_mod(f32x4 (&v)[4], const float* g, const float* shift, const float* scale, int lane) {
    float s = 0.f;
#pragma unroll
    for (int j = 0; j < 4; ++j) s += (v[j][0] * v[j][0] + v[j][1] * v[j][1]) + (v[j][2] * v[j][2] + v[j][3] * v[j][3]);
    const float rstd = rsqrtf(wave_sum(s, lane) * (1.f / D) + EPS);
#pragma unroll
    for (int j = 0; j < 4; ++j) { const f32x4 gv = ((const f32x4*)g)[lane + 64 * j], sh = ((const f32x4*)shift)[lane + 64 * j], sc = ((const f32x4*)scale)[lane + 64 * j];
        v[j] = (v[j] * rstd * gv) * (sc + 1.f) + sh; }
}
__device__ __forceinline__ void store_row_bf16(bf16* p, int lane, const f32x4 (&v)[4]) {
#pragma unroll
    for (int j = 0; j < 4; ++j) { v2u w; w.x = pk2(v[j][0], v[j][1]); w.y = pk2(v[j][2], v[j][3]); ((v2u*)p)[lane + 64 * j] = w; }
}

__device__ __forceinline__ float store_row_i8(unsigned char* p, int lane, const f32x4 (&v)[4]) {
    float am = 0.f;
#pragma unroll
    for (int j = 0; j < 4; ++j) am = fmaxf(fmaxf(am, fmaxf(fabsf(v[j][0]), fabsf(v[j][1]))), fmaxf(fabsf(v[j][2]), fabsf(v[j][3])));
    unsigned k = __float_as_uint(am);
    { unsigned t;
      t = (unsigned)__builtin_amdgcn_mov_dpp((int)k, 0xb1, 0xf, 0xf, false); k = k > t ? k : t;
      t = (unsigned)__builtin_amdgcn_mov_dpp((int)k, 0x4e, 0xf, 0xf, false); k = k > t ? k : t;
      t = (unsigned)__builtin_amdgcn_mov_dpp((int)k, 0x124, 0xf, 0xf, false); k = k > t ? k : t;
      t = (unsigned)__builtin_amdgcn_mov_dpp((int)k, 0x128, 0xf, 0xf, false); k = k > t ? k : t;
      const unsigned a = (unsigned)__builtin_amdgcn_readlane((int)k, 0), b = (unsigned)__builtin_amdgcn_readlane((int)k, 16), c = (unsigned)__builtin_amdgcn_readlane((int)k, 32), d = (unsigned)__builtin_amdgcn_readlane((int)k, 48);
      const unsigned ab = a > b ? a : b, cd = c > d ? c : d; k = ab > cd ? ab : cd; }
    const float amax = __uint_as_float(k);
    const float qscale = amax > 0.f ? amax * (1.f / 127.f) : 1.f, qinv = amax > 0.f ? 127.f / amax : 0.f;
#pragma unroll
    for (int j = 0; j < 4; ++j) { unsigned w = 0;
#pragma unroll
        for (int q = 0; q < 4; ++q) { int qi = __float2int_rn(v[j][q] * qinv); qi = qi > 127 ? 127 : (qi < -127 ? -127 : qi); w |= ((unsigned)qi & 255u) << (8 * q); }
        ((unsigned*)p)[lane + 64 * j] = w; }
    return qscale;
}
__device__ __forceinline__ void quant_rows(Frame& F, const bf16* src, unsigned char* dst, float* scale, int R) {
    const int f_lane = lthread(F.wave) & 63;
    for (int r = F.gw; r < R; r += F.NGW) { f32x4 v[4]; load_row_bf(src + (size_t)r * 1024, f_lane, v);
        const float sc = store_row_i8(dst + (size_t)r * 1024, f_lane, v); if (f_lane == 0) scale[r] = sc; }
}
__device__ __forceinline__ void rp_norm1(Frame& F, const Args& a, int l, int row_lo) {
    const int f_tid = lthread(F.wave), f_lane = f_tid & 63;
    const bf16* X = (const bf16*)(F.ws + WS_X); bf16* H = (bf16*)(F.ws + WS_H); const float* MOD = (const float*)(F.ws + WS_MOD) + (size_t)l * 9 * (NMOD * D);
    for (int row = row_lo + F.gw; row < NT; row += F.NGW) { f32x4 v[4];
        if (l == 0) load_row(row < NC ? a.in[2] + (size_t)row * D : a.in[0] + (size_t)(row - NC) * D, f_lane, v);
        else load_row_bf(X + (size_t)row * D, f_lane, v);
        const float* m = MOD + (size_t)modrow_of(row) * (NMOD * D);
        norm_mod(v, a.in[6] + (size_t)l * D, m, m + D, f_lane);
        const float sc = store_row_i8((unsigned char*)H + (size_t)row * D, f_lane, v); if (f_lane == 0) ((float*)(F.ws + WS_SH))[row] = sc; }
}

#if MK_N2V2
constexpr int LDS_LIST = LDS_MISC + 768;
__device__ __forceinline__ unsigned row16_max(unsigned k) {
    unsigned t;
    t = (unsigned)__builtin_amdgcn_mov_dpp((int)k, 0xb1, 0xf, 0xf, false); k = k > t ? k : t;
    t = (unsigned)__builtin_amdgcn_mov_dpp((int)k, 0x4e, 0xf, 0xf, false); k = k > t ? k : t;
    t = (unsigned)__builtin_amdgcn_mov_dpp((int)k, 0x124, 0xf, 0xf, false); k = k > t ? k : t;
    t = (unsigned)__builtin_amdgcn_mov_dpp((int)k, 0x128, 0xf, 0xf, false); k = k > t ? k : t;
    return k;
}
__device__ __forceinline__ unsigned wave_max_u(unsigned k) {
    k = row16_max(k);
    const unsigned a = (unsigned)__builtin_amdgcn_readlane((int)k, 0), b = (unsigned)__builtin_amdgcn_readlane((int)k, 16), c = (unsigned)__builtin_amdgcn_readlane((int)k, 32), d = (unsigned)__builtin_amdgcn_readlane((int)k, 48);
    const unsigned ab = a > b ? a : b, cd = c > d ? c : d; return ab > cd ? ab : cd;
}
__device__ __forceinline__ float key_val(unsigned m) { const unsigned u = m & ~31u; return __builtin_bit_cast(float, (u & 0x80000000u) ? (u ^ 0x80000000u) : ~u); }
__device__ __forceinline__ void rp_norm2_router(Frame& F, const Args& a, int l, int row_lo) {
    const int f_tid = lthread(F.wave), f_lane = f_tid & 63;
    const bf16* X = (const bf16*)(F.ws + WS_X); bf16* H = (bf16*)(F.ws + WS_H); const float* MOD = (const float*)(F.ws + WS_MOD) + (size_t)l * 9 * (NMOD * D);
    LAS float* wt = (LAS float*)F.lds;
    { const f32x4* src = (const f32x4*)((const float*)(F.ws + WS_WRT) + (size_t)l * NE * D); f32x4 tv[16];
#pragma unroll
      for (int i = 0; i < 16; ++i) tv[i] = src[f_tid + 512 * i];
#pragma unroll
      for (int i = 0; i < 16; ++i) ((LAS f32x4*)wt)[f_tid + 512 * i] = tv[i]; }
    LAS int* lcnt = (LAS int*)(F.lds + LDS_TT); LAS int* lbase = lcnt + 32;
    LAS v4u* list = (LAS v4u*)(F.lds + LDS_LIST) + F.wave * 68;
    LAS float* lsc = (LAS float*)(F.lds + LDS_LIST + 8 * 68 * 16) + F.wave * 68;
    if (f_tid < 32) lcnt[f_tid] = 0;
    __syncthreads();
    const float* gf = a.in[7] + (size_t)l * D;
    f32x4 gv[4];
#pragma unroll
    for (int j = 0; j < 4; ++j) gv[j] = ((const f32x4*)gf)[f_lane + 64 * j];
    const int my_e = f_lane >> 1;
    const float my_b = a.in[22][(size_t)l * NE + my_e];
    int row = row_lo + F.gw, it = 0;
    f32x4 vn[4];
    if (row < NT) load_row_bf(X + (size_t)row * D, f_lane, vn);
    for (; row < NT; row += F.NGW, ++it) {
        f32x4 v[4], sh[4], sc[4];
        const float* m = MOD + (size_t)modrow_of(row) * (NMOD * D);
#pragma unroll
        for (int j = 0; j < 4; ++j) { sh[j] = ((const f32x4*)(m + 3 * D))[f_lane + 64 * j]; sc[j] = ((const f32x4*)(m + 4 * D))[f_lane + 64 * j]; }
        asm volatile("" ::: "memory");
#pragma unroll
        for (int j = 0; j < 4; ++j) v[j] = vn[j];
        { const int nrow = row + F.NGW; if (nrow < NT) load_row_bf(X + (size_t)nrow * D, f_lane, vn); }
        float ssq = 0.f;
#pragma unroll
        for (int j = 0; j < 4; ++j) ssq += (v[j][0] * v[j][0] + v[j][1] * v[j][1]) + (v[j][2] * v[j][2] + v[j][3] * v[j][3]);
        const float rstd = rsqrtf(wave_sum(ssq, f_lane) * (1.f / D) + EPS);
#pragma unroll
        for (int j = 0; j < 4; ++j) v[j] = (v[j] * rstd * gv[j]) * (sc[j] + 1.f) + sh[j];
        const float qscale = store_row_i8((unsigned char*)H + (size_t)row * D, f_lane, v);
        float p[32];
#pragma unroll
        for (int e = 0; e < 32; ++e) { f32x2 s2 = (f32x2){0.f, 0.f};
#pragma unroll
            for (int j = 0; j < 4; ++j) { const f32x4 w = ((const LAS f32x4*)(wt + e * 1024))[f_lane + 64 * j];
                s2 = __builtin_elementwise_fma((f32x2){v[j][0], v[j][1]}, (f32x2){w[0], w[1]}, s2); s2 = __builtin_elementwise_fma((f32x2){v[j][2], v[j][3]}, (f32x2){w[2], w[3]}, s2); }
            p[e] = s2[0] + s2[1]; }
#pragma unroll
        for (int s = 0; s < 5; ++s) { const int half = 16 >> s, msk = 32 >> s; const bool up = (f_lane & msk) != 0;
#pragma unroll
            for (int i = 0; i < half; ++i) { const float keep = up ? p[i + half] : p[i], send = up ? p[i] : p[i + half]; p[i] = keep + shx(send, msk, f_lane); } }
        const float lgt = p[0] + shx(p[0], 1, f_lane) + my_b;
        unsigned key; { const unsigned u = __builtin_bit_cast(unsigned, lgt); const unsigned o = (u & 0x80000000u) ? ~u : (u | 0x80000000u); key = (o & ~31u) | (unsigned)(31 - my_e); }
        unsigned mk[4];
#pragma unroll
        for (int k = 0; k < 4; ++k) { mk[k] = wave_max_u(key); key = (key == mk[k]) ? 0u : key; }
        const float b0 = key_val(mk[0]);
        const float e1 = __expf(key_val(mk[1]) - b0), e2 = __expf(key_val(mk[2]) - b0), e3 = __expf(key_val(mk[3]) - b0); const float inv = 1.f / (1.f + e1 + e2 + e3);
        if (f_lane < 4) { const unsigned mm = f_lane == 0 ? mk[0] : f_lane == 1 ? mk[1] : f_lane == 2 ? mk[2] : mk[3]; const int me = 31 - (int)(mm & 31u);
            const float mw = (f_lane == 0 ? 1.f : f_lane == 1 ? e1 : f_lane == 2 ? e2 : e3) * inv;
            const int lr = __hip_atomic_fetch_add(lcnt + me, 1, __ATOMIC_RELAXED, __HIP_MEMORY_SCOPE_WORKGROUP);
            LAS unsigned* ep = (LAS unsigned*)(list + it * 4 + f_lane); ep[0] = (unsigned)(row * 4 + f_lane); ep[1] = (unsigned)me; ep[2] = (unsigned)lr; ep[3] = __builtin_bit_cast(unsigned, mw);
            lsc[it * 4 + f_lane] = qscale; }
    }
    __syncthreads();
    if (f_tid < 32) { const int c = lcnt[f_tid]; lbase[f_tid] = c ? (int)__hip_atomic_fetch_add((unsigned*)(F.ctl + CW_CNT + (l * 32 + f_tid) * 16), (unsigned)c, RLX_AGENT) : 0; }
    __syncthreads();
    int* te = (int*)(F.ws + WS_TE); int* trank = (int*)(F.ws + WS_TRANK); int* stok = (int*)(F.ws + WS_STOK); float* sw = (float*)(F.ws + WS_SW); float* ssc = (float*)(F.ws + WS_SSC);
    for (int i = f_lane; i < it * 4; i += 64) { const LAS unsigned* ep = (const LAS unsigned*)(list + i); const unsigned rowk = ep[0], ex = ep[1], lr = ep[2]; const float wv = __builtin_bit_cast(float, ep[3]);
        const int rk = lbase[ex] + (int)lr;
        stok[(size_t)ex * CAP + rk] = (int)(rowk >> 2); sw[(size_t)ex * CAP + rk] = wv; ssc[(size_t)ex * CAP + rk] = lsc[i]; te[rowk] = (int)ex; trank[rowk] = rk; }
}

#endif
__device__ __forceinline__ void moe_table(Frame& F, int l) {
    const int f_tid = lthread(F.wave), f_lane = f_tid & 63;
    LAS int* TT = (LAS int*)(F.lds + LDS_TT); LAS int* CN = TT + 64; LAS int* TE = (LAS int*)(F.lds + LDS_TE);
    __syncthreads();
    if (f_tid < 64) {
        const int c = (f_lane < 32) ? (int)__hip_atomic_load((unsigned*)(F.ctl + CW_CNT + (l * 32 + (f_lane & 31)) * 16), RLX_AGENT) : 0;
        const int tl = (c + 255) >> 8; int v = tl;
#pragma unroll
        for (int o = 1; o < 32; o <<= 1) { const int n = __builtin_amdgcn_ds_bpermute((f_lane >= o ? f_lane - o : f_lane) << 2, v); if (f_lane >= o) v += n; }
        if (f_lane < 32) { CN[f_lane] = c; TT[f_lane] = v - tl; if (f_lane == 31) TT[32] = v; }
    }
    __syncthreads();
    for (int t = f_tid; t < MAXTILES; t += 512) { int lo = 0, hi = 32;
#pragma unroll
        for (int k = 0; k < 5; ++k) { const int mid = (lo + hi) >> 1; if (TT[mid] <= t) lo = mid; else hi = mid; }
        TE[t] = lo; }
    __syncthreads();
}

#if MK_CBV2
struct CombRow { v2u x[4]; v2u y[4][4]; };
__device__ __forceinline__ void comb_issue(CombRow& R, const bf16* X, const bf16* Y, const LAS int* TT, int row, const v4u te4, const v4u tr4, int lane) {
    const unsigned ee[4] = {te4[0], te4[1], te4[2], te4[3]}, rr[4] = {tr4[0], tr4[1], tr4[2], tr4[3]};
#pragma unroll
    for (int k = 0; k < 4; ++k) { const size_t slot = (size_t)TT[ee[k]] * 256 + rr[k]; const v2u* yp = (const v2u*)(Y + slot * 1024);
#pragma unroll
        for (int j = 0; j < 4; ++j) R.y[k][j] = yp[lane + 64 * j]; }
#pragma unroll
    for (int j = 0; j < 4; ++j) R.x[j] = ((const v2u*)(X + (size_t)row * D))[lane + 64 * j];
}
__device__ __forceinline__ void comb_finish(const CombRow& R, Frame& F, const Args& a, int l, int row, int lane, const float* MOD, const float* MODN, bool lastl) {
    bf16* X = (bf16*)(F.ws + WS_X); bf16* H = (bf16*)(F.ws + WS_H);
    const int mr = modrow_of(row); const float* g5 = MOD + (size_t)mr * (NMOD * D) + 5 * D;
    f32x4 v[4];
#pragma unroll
    for (int j = 0; j < 4; ++j) { f32x4 s = (f32x4){0.f, 0.f, 0.f, 0.f};
#pragma unroll
        for (int k = 0; k < 4; ++k) { const v2u w = R.y[k][j]; s[0] += bf_lo(w.x); s[1] += bf_hi(w.x); s[2] += bf_lo(w.y); s[3] += bf_hi(w.y); }
        const f32x4 gv = ((const f32x4*)g5)[lane + 64 * j]; const v2u xw = R.x[j]; v[j] = (f32x4){bf_lo(xw.x), bf_hi(xw.x), bf_lo(xw.y), bf_hi(xw.y)} + gv * s; }
    if (!lastl) {
        store_row_bf16(X + (size_t)row * D, lane, v);
        const float* m = MODN + (size_t)mr * (NMOD * D);
        norm_mod(v, a.in[6] + (size_t)(l + 1) * D, m, m + D, lane);
        const float sc = store_row_i8((unsigned char*)H + (size_t)row * D, lane, v); if (lane == 0) ((float*)(F.ws + WS_SH))[row] = sc;
    } else {
        float ss = 0.f;
#pragma unroll
        for (int j = 0; j < 4; ++j) ss += (v[j][0] * v[j][0] + v[j][1] * v[j][1]) + (v[j][2] * v[j][2] + v[j][3] * v[j][3]);
        const float rstd = rsqrtf(wave_sum(ss, lane) * (1.f / D) + EPS);
        float* op = a.out + (size_t)(row - NC) * D;
#pragma unroll
        for (int j = 0; j < 4; ++j) { const f32x4 gv = ((const f32x4*)a.in[8])[lane + 64 * j]; ((f32x4*)op)[lane + 64 * j] = v[j] * rstd * gv; }
    }
}
__device__ __forceinline__ void rp_combine(Frame& F, const Args& a, int l, int row_lo) {
    const int f_tid = lthread(F.wave), f_lane = f_tid & 63;
    const bf16* X = (const bf16*)(F.ws + WS_X); const bf16* Y = (const bf16*)(F.ws + WS_Y);
    const float* MOD = (const float*)(F.ws + WS_MOD) + (size_t)l * 9 * (NMOD * D); const float* MODN = MOD + 9 * (NMOD * D);
    const v4u* te = (const v4u*)(F.ws + WS_TE); const v4u* trank = (const v4u*)(F.ws + WS_TRANK);
    const LAS int* TT = (const LAS int*)(F.lds + LDS_TT);
    const bool lastl = (l == DEPTH - 1);
    const int st = F.NGW;
    int row = row_lo + F.gw;
    if (row >= NT) return;
    CombRow RA, RB;
    v4u te1 = te[row], tr1 = trank[row];
    comb_issue(RA, X, Y, TT, row, te1, tr1, f_lane);
    if (row + st < NT) { te1 = te[row + st]; tr1 = trank[row + st]; }
    for (;;) {
        const bool h1 = row + st < NT;
        if (h1) comb_issue(RB, X, Y, TT, row + st, te1, tr1, f_lane);
        if (row + 2 * st < NT) { te1 = te[row + 2 * st]; tr1 = trank[row + 2 * st]; }
        comb_finish(RA, F, a, l, row, f_lane, MOD, MODN, lastl);
        if (!h1) break;
        row += st;
        const bool h2 = row + st < NT;
        if (h2) comb_issue(RA, X, Y, TT, row + st, te1, tr1, f_lane);
        if (row + 2 * st < NT) { te1 = te[row + 2 * st]; tr1 = trank[row + 2 * st]; }
        comb_finish(RB, F, a, l, row, f_lane, MOD, MODN, lastl);
        if (!h2) break;
        row += st;
    }
}

#endif
__device__ __forceinline__ void rp_mla(Frame& F, const Args& a) {
    const int f_tid = lthread(F.wave), f_lane = f_tid & 63;
    const bf16* A = (const bf16*)(F.ws + WS_RE); bf16* QA = (bf16*)(F.ws + WS_RF); bf16* CKV = (bf16*)(F.ws + WS_RG); bf16* Kb = (bf16*)(F.ws + WS_RB);
    const float* rope = (const float*)(F.ws + WS_ROPE); const float* gq = a.in[12]; const float* gk = a.in[14];
    for (int row = F.gw; row < NT; row += F.NGW) {
        const unsigned* ap = (const unsigned*)(A + (size_t)row * MLA_IN_PAD);
        unsigned q[3], c[2];
#pragma unroll
        for (int j = 0; j < 3; ++j) q[j] = ap[f_lane + 64 * j];
#pragma unroll
        for (int j = 0; j < 2; ++j) c[j] = ap[192 + f_lane + 64 * j];
        const unsigned pe = ap[320 + (f_lane & 15)];
        float sq = 0.f, sc = 0.f;
#pragma unroll
        for (int j = 0; j < 3; ++j) { const float x0 = bf_lo(q[j]), x1 = bf_hi(q[j]); sq += x0 * x0 + x1 * x1; }
#pragma unroll
        for (int j = 0; j < 2; ++j) { const float x0 = bf_lo(c[j]), x1 = bf_hi(c[j]); sc += x0 * x0 + x1 * x1; }
        const float rq = rsqrtf(wave_sum(sq, f_lane) * (1.f / MLA_QL) + EPS), rc = rsqrtf(wave_sum(sc, f_lane) * (1.f / MLA_KVL) + EPS);
#pragma unroll
        for (int j = 0; j < 3; ++j) { const int e0 = 2 * (f_lane + 64 * j); ((unsigned*)(QA + (size_t)row * MLA_QL))[f_lane + 64 * j] = pk2(bf_lo(q[j]) * rq * gq[e0], bf_hi(q[j]) * rq * gq[e0 + 1]); }
#pragma unroll
        for (int j = 0; j < 2; ++j) { const int e0 = 2 * (f_lane + 64 * j); ((unsigned*)(CKV + (size_t)row * MLA_KVL))[f_lane + 64 * j] = pk2(bf_lo(c[j]) * rc * gk[e0], bf_hi(c[j]) * rc * gk[e0 + 1]); }
        float x0 = bf_lo(pe), x1 = bf_hi(pe);
        if (row >= NC) { const int t = (row - NC) & 4095, i = f_lane & 15, d = 2 * i, pos = (d & 16) ? (t & 63) : (t >> 6), f = d & 7;
            const float p0 = shx(x0, 4, f_lane), p1 = shx(x1, 4, f_lane); const float sg = (d & 8) ? 1.f : -1.f;
            const float* rp = rope + (size_t)pos * 16 + 2 * f; x0 = x0 * rp[0] + sg * p0 * rp[1]; x1 = x1 * rp[2] + sg * p1 * rp[3]; }
        const unsigned w = pk2(x0, x1);
        { const int i = f_lane & 15, hb = f_lane >> 4;
#pragma unroll
          for (int hh = 0; hh < 4; ++hh) { const int h = hb * 4 + hh; ((unsigned*)(Kb + (size_t)row * 1536 + 96 * h + 64))[i] = w; } }
    }
}

__device__ __forceinline__ void rp_gqa(Frame& F, const Args& a) {
    const int f_tid = lthread(F.wave), f_lane = f_tid & 63;
    const bf16* A = (const bf16*)(F.ws + WS_RA); bf16* Q = (bf16*)(F.ws + WS_RB); bf16* Kb = Q + (size_t)NT * 1024;
    const float* rope = (const float*)(F.ws + WS_ROPE) + 2048; const float* gq = a.in[18]; const float* gk = a.in[19];
    const float c2 = 0.125f * LOG2E;
    for (int row = F.gw; row < NT; row += F.NGW) {
        const bool lat = row >= NC; const int t = (row - NC) & 4095;
#pragma unroll
        for (int part = 0; part < 2; ++part) {
            const int ln = part ? (f_lane & 15) : f_lane; const bf16* src = A + (size_t)row * GQA_QKV + (part ? 1024 : 0) + ln * 16;
            const v4u w0 = *(const v4u*)src, w1 = *(const v4u*)(src + 8);
            float x[16]; const unsigned ww[8] = {w0.x, w0.y, w0.z, w0.w, w1.x, w1.y, w1.z, w1.w};
#pragma unroll
            for (int i = 0; i < 8; ++i) { x[2 * i] = bf_lo(ww[i]); x[2 * i + 1] = bf_hi(ww[i]); }
            float ss = 0.f;
#pragma unroll
            for (int i = 0; i < 16; ++i) ss += x[i] * x[i];
            ss += shx(ss, 1, f_lane); ss += shx(ss, 2, f_lane);
            const float rs = rsqrtf(ss * (1.f / 64.f) + EPS); const float* g = (part ? gk : gq) + (ln & 3) * 16;
#pragma unroll
            for (int i = 0; i < 16; ++i) x[i] = x[i] * rs * g[i];
            if (lat) { const int sec = (ln >> 1) & 1, pos = sec ? (t & 63) : (t >> 6); const float sg = (ln & 1) ? 1.f : -1.f; const float* rp = rope + (size_t)pos * 32;
#pragma unroll
                for (int i = 0; i < 16; ++i) { const float pr = shx(x[i], 1, f_lane); x[i] = x[i] * rp[2 * i] + sg * pr * rp[2 * i + 1]; } }
            const float scl = part ? 1.f : c2;
            v4u o0, o1; o0.x = pk2(x[0] * scl, x[1] * scl); o0.y = pk2(x[2] * scl, x[3] * scl); o0.z = pk2(x[4] * scl, x[5] * scl); o0.w = pk2(x[6] * scl, x[7] * scl);
            o1.x = pk2(x[8] * scl, x[9] * scl); o1.y = pk2(x[10] * scl, x[11] * scl); o1.z = pk2(x[12] * scl, x[13] * scl); o1.w = pk2(x[14] * scl, x[15] * scl);
            if (part == 0) { bf16* d = Q + (size_t)row * 1024 + ln * 16; *(v4u*)d = o0; *(v4u*)(d + 8) = o1; }
            else if (f_lane < 16) { bf16* d = Kb + (size_t)row * 256 + ln * 16; *(v4u*)d = o0; *(v4u*)(d + 8) = o1; }
        }
    }
}

template <int DK>
__device__ __forceinline__ void attn_phase(Frame& F, const att::Tens& T, int kvshift  , int kstride, int vstride, int vbase) {
    const int vcu = (F.G % 8 == 0) ? (blockIdx.x % 8) * (F.G / 8) + blockIdx.x / 8 : blockIdx.x;
    if constexpr (DK == 64) {
        for (int u = vcu; u < 2048 + 128; u += F.G) {
            if (u < 2048) { const int b = u >> 8, h = (u >> 4) & 15, qb = u & 15, kvh = h >> kvshift;
                att64::attn_unit<8>(T.Q, T.qpitch, NC + b * SEQ + qb * 256, h * 64, T.K, T.kpitch, kvh * kstride, T.V, T.vpitch, vbase + kvh * vstride, T.O, h * 64, b * LCTX, NC + b * SEQ, 68, (char*)F.lds, F.wave); }
            else { const int q = u - 2048, b = q >> 4, h = q & 15, kvh = h >> kvshift;
                att64::attn_unit<8>(T.Q, T.qpitch, b * LCTX, h * 64, T.K, T.kpitch, kvh * kstride, T.V, T.vpitch, vbase + kvh * vstride, T.O, h * 64, b * LCTX, 0, 4, (char*)F.lds, F.wave); }
        }
        __syncthreads();
    } else {
        att::Pend pend; pend.valid = false; pend.o0 = f32x16{}; pend.o1 = f32x16{}; pend.l = 1.f; pend.qrow0 = 0; pend.oc0 = 0;
        for (int u = vcu; u < 2048 + 128; u += F.G) {
            if (u < 2048) { const int b = u >> 8, h = (u >> 4) & 15, qb = u & 15, kvh = h >> kvshift;
                att::unit<DK>(T, NC + b * SEQ + qb * 256, h * DK, kvh * kstride, vbase + kvh * vstride, h * 64, b * LCTX, NC + b * SEQ, 68, F.lds, F.wave, pend); }
            else { const int q = u - 2048, b = q >> 4, h = q & 15, kvh = h >> kvshift;
                att::unit<DK>(T, b * LCTX, h * DK, kvh * kstride, vbase + kvh * vstride, h * 64, b * LCTX, 0, 4, F.lds, F.wave, pend); }
        }
        if (pend.valid) att::finish_unit(pend, T.O, F.lds, F.wave, lthread(F.wave) & 63);
        __syncthreads();
    }
}

constexpr int PH_PER_LAYER = 9, PH_TOTAL = 2 + DEPTH * PH_PER_LAYER;
__global__ void __launch_bounds__(512, 2) mk_fwd(Args args) {
    extern __shared__ __attribute__((aligned(16))) unsigned char lds_raw[];
    Frame F;
    F.lds = (LAS unsigned char*)lds_raw; F.ws = args.ws; F.ctl = (gu32*)(args.ws + WS_CTL);
    F.wave = __builtin_amdgcn_readfirstlane(threadIdx.x >> 6); F.G = gridDim.x;
    F.gw = blockIdx.x * 8 + F.wave; F.NGW = F.G * 8;
    if (threadIdx.x < 4) ((LAS unsigned*)(F.lds + LDS_XB))[threadIdx.x] = 0u;
    __syncthreads();
    const int lo = args.ph_lo, hi = args.ph_hi;
    const bool multi = (hi - lo) > 1;
    XcdBarrier bar; bar.bar = (unsigned*)(F.ctl + CW_BAR); bar.x = 0; bar.st = nullptr; bar.wave = F.wave;
    if (multi) bar = xcd_barrier_post((unsigned*)(F.ctl + CW_BAR), (volatile LAS unsigned*)(F.lds + LDS_XB), F.wave);
#define IN(k) (lo <= (k) && (k) < hi)
#define SEAM(k) do { if (IN(k) && IN((k) + 1)) xcd_barrier(bar); } while (0)
    unsigned char* ws0 = args.ws;
#define PH_WS size_t zofs_ = 0; asm volatile("" : "+s"(zofs_)); unsigned char* ws = ws0 + zofs_; F.ws = ws; F.ctl = (gu32*)ws;
    const int G = F.G, cidx = (int)blockIdx.x;

    if (IN(0) && EN(0)) { PH_WS REP(0) { prologue(F, args); SEAM(0); } }
    if (IN(1) && EN(1)) { PH_WS rp_norm1(F, args, 0, 0);
        quant_rows(F, (const bf16*)(ws + WS_WFIN), (unsigned char*)(ws + WS_W8), (float*)(ws + WS_SWP), 2 * 2048);
        quant_rows(F, (const bf16*)(ws + WS_WMIN), (unsigned char*)(ws + WS_W8) + 4 * MiB, (float*)(ws + WS_SWP) + 4096, MLA_IN_PAD);
        quant_rows(F, (const bf16*)(ws + WS_WGQKV), (unsigned char*)(ws + WS_W8) + 5 * MiB, (float*)(ws + WS_SWP) + 4864, GQA_QKV); SEAM(1); }

    for (int l = 0; l < DEPTH; ++l) {
        const int kind = l % 3, j = l / 3, base = 2 + l * PH_PER_LAYER;
        const bool lastl = (l == DEPTH - 1);

        size_t outB = 0;
        if (kind == 0) {
            if (IN(base + 0) && EN(2)) { PH_WS REP(2) { PolFP p; p.A = (const char*)(ws + WS_W8) + (size_t)j * 2048 * D; p.B = (const char*)(ws + WS_H); p.nt = 8; p.sW = (const float*)(ws + WS_SWP) + j * 2048; p.sH = (const float*)(ws + WS_SH); p.nN = lastl ? 128 : 136; p.G = G; p.c = cidx;
                p.Z = (bf16*)(ws + WS_RA); p.Zc = (bf16*)(ws + WS_RH); pg8::gemm_phase(F.lds, p, F.wave); } }
            SEAM(base + 0);
            if (IN(base + 1) && EN(3)) { PH_WS REP(3) { PolFA p; p.A = (const char*)(ws + WS_MA); p.B = (const char*)(ws + WS_RA); p.nt = 4; p.G = G; p.c = cidx; p.Y = (bf16*)(ws + WS_RB); pg8::gemm_phase(F.lds, p, F.wave); } }
            SEAM(base + 1);
            if (IN(base + 2) && EN(4)) { PH_WS REP(4) { PolFC p; p.A = (const char*)(ws + WS_DC); p.B = (const char*)(ws + WS_RB); p.nt = 8; p.G = G; p.c = cidx; p.nunits = lastl ? 512 : 544;
                p.offMC = (unsigned)(WS_MC - WS_DC); p.offZc = (unsigned)(WS_RH - WS_RB); p.F = (bf16*)(ws + WS_RC); pg8::gemm_phase(F.lds, p, F.wave); } }
            SEAM(base + 2);
            outB = WS_WFOUT + (size_t)j * D * D * 2;
        } else if (kind == 1) {
            if (IN(base + 0) && EN(5)) { PH_WS REP(5) { PolDenseI8 p; p.A = (const char*)(ws + WS_H); p.B = (const char*)(ws + WS_W8) + 4 * MiB; p.nt = 8; p.nM = NT / 256; p.nN = 3; p.pm0 = 0; p.G = G; p.c = cidx; p.sA = (const float*)(ws + WS_SH); p.sB = (const float*)(ws + WS_SWP) + 4096;
                p.O = (bf16*)(ws + WS_RE); p.ldo = MLA_IN_PAD; pg8::gemm_phase(F.lds, p, F.wave); } }
            SEAM(base + 0);
            if (IN(base + 1) && EN(6)) { PH_WS REP(6) { rp_mla(F, args); } }
            SEAM(base + 1);
            if (IN(base + 2)) { PH_WS REP(7) {
                if (EN(7)) { PolMlaQ p; p.A = (const char*)(ws + WS_RF); p.B = (const char*)(ws + WS_WMQB); p.nt = 6; p.nM = NT / 256; p.nN = 6; p.G = G; p.c = cidx; p.Q = (bf16*)(ws + WS_RA);
                  p.rope = (const float*)(ws + WS_ROPE); p.c2 = 0.10206207261596575f * LOG2E; pg8::gemm_phase(F.lds, p, F.wave); }
                if (EN(8)) { PolMlaKV p; p.A = (const char*)(ws + WS_RG); p.B = (const char*)(ws + WS_WMKVB); p.nt = 4; p.nM = NT / 256; p.nN = 8; p.G = G; p.c = cidx; p.Kb = (bf16*)(ws + WS_RB); p.Vb = (bf16*)(ws + WS_RD);
                  pg8::gemm_phase(F.lds, p, F.wave); }
            } }
            SEAM(base + 2);
            if (IN(base + 3) && EN(9)) { PH_WS REP(9) { att::Tens T{(const bf16*)(ws + WS_RA), 1536, (const bf16*)(ws + WS_RB), 1536, (const bf16*)(ws + WS_RD), 1024, (bf16*)(ws + WS_RC)}; attn_phase<96>(F, T, 0, 96, 64, 0); } }
            SEAM(base + 3);
            outB = WS_WMO;
        } else {
            if (IN(base + 0) && EN(10)) { PH_WS REP(10) { PolDenseI8 p; p.A = (const char*)(ws + WS_H); p.B = (const char*)(ws + WS_W8) + 5 * MiB; p.nt = 8; p.nM = NT / 256; p.nN = 6; p.pm0 = 0; p.G = G; p.c = cidx; p.sA = (const float*)(ws + WS_SH); p.sB = (const float*)(ws + WS_SWP) + 4864;
                p.O = (bf16*)(ws + WS_RA); p.ldo = GQA_QKV; pg8::gemm_phase(F.lds, p, F.wave); } }
            SEAM(base + 0);
            if (IN(base + 1) && EN(11)) { PH_WS REP(11) { rp_gqa(F, args); } }
            SEAM(base + 1);
            if (IN(base + 2) && EN(12)) { PH_WS REP(12) { att::Tens T{(const bf16*)(ws + WS_RB), 1024, (const bf16*)(ws + WS_RB) + (size_t)NT * 1024, 256, (const bf16*)(ws + WS_RA), 1536, (bf16*)(ws + WS_RC)}; attn_phase<64>(F, T, 2, 64, 64, 1280); } }
            SEAM(base + 2);
            outB = WS_WGO;
        }
        if (IN(base + 4) && EN(13)) { PH_WS PolOut p; p.A = (const char*)(ws + WS_RC); p.B = (const char*)(ws + outB); p.nt = 16; p.nM = lastl ? NL / 256 : NT / 256; p.nN = 4; p.pm0 = lastl ? 8 : 0; p.G = G; p.c = cidx; p.X = (bf16*)(ws + WS_X); p.mod = (const float*)(ws + WS_MOD) + (size_t)l * 9 * (NMOD * D); p.chunk = 2;
            p.XinC = (l == 0) ? args.in[2] : nullptr; p.XinL = (l == 0) ? args.in[0] - (size_t)NC * D : nullptr;
            pg8::gemm_phase(F.lds, p, F.wave); }
        SEAM(base + 4);
        if (IN(base + 5) && EN(14)) { PH_WS rp_norm2_router(F, args, l, lastl ? NC : 0); }
        SEAM(base + 5);
        if (IN(base + 6) && EN(15)) { PH_WS REP(15) { moe_table(F, l);
            PolMoe1 p; p.A = (const char*)(ws + WS_H); p.B = (const char*)(ws + WS_WGU) + (size_t)l * NE * 2048 * D; p.nt = 8; p.G = G; p.c = cidx;
            p.swgu = (const float*)(ws + WS_SWGU) + (size_t)l * NE * 2048; p.ssc = (const float*)(ws + WS_SSC);
            p.T.TT = (const LAS int*)(F.lds + LDS_TT); p.T.CN = p.T.TT + 64; p.T.TE = (const LAS int*)(F.lds + LDS_TE); p.stok = (const int*)(ws + WS_STOK); p.bgu = (const float*)(ws + WS_BGU) + (size_t)l * NE * 2048; p.act = (unsigned char*)(ws + WS_ACT);
            pg8::gemm_phase(F.lds, p, F.wave); } }
        SEAM(base + 6);
        if (IN(base + 7) && EN(16)) { PH_WS REP(16) { moe_table(F, l);
            PolMoe2 p; p.A = (const char*)(ws + WS_ACT); p.B = (const char*)(ws + WS_WDN) + (size_t)l * NE * D * DFF; p.nt = 8; p.G = G; p.c = cidx; p.swd = (const float*)(ws + WS_SWDN) + (size_t)l * NE * D;
            p.T.TT = (const LAS int*)(F.lds + LDS_TT); p.T.CN = p.T.TT + 64; p.T.TE = (const LAS int*)(F.lds + LDS_TE); p.sw = (const float*)(ws + WS_SW); p.bdn = args.in[26] + (size_t)l * NE * D; p.Y = (bf16*)(ws + WS_Y);
            pg8::gemm_phase(F.lds, p, F.wave); } }
        SEAM(base + 7);
        if (IN(base + 8) && EN(17)) { PH_WS moe_table(F, l); rp_combine(F, args, l, lastl ? NC : 0); }
        SEAM(base + 8);
    }
#undef PH_WS
#undef IN
#undef SEAM
}

extern "C" void kernel_launch(void* const* d_in, const int* in_sizes, int n_in, void* d_out, int out_size, void* d_ws, size_t ws_size, hipStream_t stream) {
    static int grid = 0;
    if (grid == 0) {
        if (n_in != 27 || out_size != NL * D || ws_size < WS_END) { fprintf(stderr, "kernel_launch: unexpected problem (n_in %d, out %d, ws %zu < %zu)\n", n_in, out_size, ws_size, (size_t)WS_END); grid = -1; return; }
        int dev = 0, cus = 0, per_cu = 0;
        if (hipGetDevice(&dev) != hipSuccess || hipDeviceGetAttribute(&cus, hipDeviceAttributeMultiprocessorCount, dev) != hipSuccess) { grid = -1; return; }
        if (hipFuncSetAttribute((const void*)mk_fwd, hipFuncAttributeMaxDynamicSharedMemorySize, LDS_BYTES) != hipSuccess) { fprintf(stderr, "kernel_launch: hipFuncSetAttribute failed\n"); grid = -1; return; }
        if (hipOccupancyMaxActiveBlocksPerMultiprocessor(&per_cu, (const void*)mk_fwd, 512, LDS_BYTES) != hipSuccess || per_cu < 1) fprintf(stderr, "kernel_launch: occupancy query says %d\n", per_cu);
        (void)hipGetLastError();
        grid = cus;
    }
    if (grid < 0) return;
    (void)hipMemsetAsync((char*)d_ws + WS_CTL, 0, CTL_ZERO_BYTES, stream);
    Args a{};
    for (int i = 0; i < 27; ++i) a.in[i] = (const float*)d_in[i];
    a.out = (float*)d_out; a.ws = (unsigned char*)d_ws;
#if MK_PER_PHASE
    for (int ph = 0; ph < PH_TOTAL; ++ph) {
        const int l = (ph - 2) / PH_PER_LAYER, s = (ph - 2) % PH_PER_LAYER, kind = l % 3;
        if (ph >= 2) { if (s == 3 && kind != 1) continue; }
        a.ph_lo = ph; a.ph_hi = ph + 1;
        hipLaunchKernelGGL(mk_fwd, dim3(grid), dim3(512), LDS_BYTES, stream, a);
    }
#else
    a.ph_lo = 0; a.ph_hi = PH_TOTAL;
    hipLaunchKernelGGL(mk_fwd, dim3(grid), dim3(512), LDS_BYTES, stream, a);
#endif
}
```

```cpp
#include <hip/hip_runtime.h>
#include <cstdio>
#include <cstdint>

#ifndef MK_PER_PHASE
#define MK_PER_PHASE 0
#endif
#ifndef MK_N2V2
#define MK_N2V2 1
#endif
#ifndef MK_CBV2
#define MK_CBV2 1
#endif
#ifndef MK_N2AGG
#define MK_N2AGG 1
#endif
#ifndef MK_MASK
#define MK_MASK 0xFFFFFFFFu
#endif
#define EN(id) (((MK_MASK) >> (id)) & 1u)
#ifndef MK_REPMASK
#define MK_REPMASK 0u
#endif
#define REP(id) for (int rep_ = 0; rep_ < ((((MK_REPMASK) >> (id)) & 1u) ? 2 : 1); ++rep_)

constexpr int D = 1024, NB = 8, SEQ = 4096, LCTX = 256, DEPTH = 4;
constexpr int NC = NB * LCTX;
constexpr int NL = NB * SEQ;
constexpr int NT = NC + NL;
constexpr int NMOD = 6, NE = 32, TOPK = 4, DFF = 1024;
constexpr int MLA_QL = 384, MLA_KVL = 256, MLA_ROPE = 32, MLA_NOPE = 64, MLA_V = 64, MLA_IN = 672, MLA_IN_PAD = 768, MLA_QD = 96;
constexpr int GQA_NQ = 1024, GQA_NKV = 256, GQA_QKV = 1536;
constexpr int CAP = NT;
constexpr int MAXTILES = 576;
constexpr float EPS = 1e-6f;
constexpr float LOG2E = 1.4426950408889634f;

constexpr size_t MiB = 1u << 20;
constexpr size_t WS_CTL = 0, CTL_ZERO_BYTES = 96 * 1024;
constexpr size_t WS_MOD = 1 * MiB;
constexpr size_t WS_ROPE = 2 * MiB;
constexpr size_t WS_WRT = 2 * MiB + 65536;
constexpr size_t WS_BGU = 3 * MiB;
constexpr size_t WS_MA = 4 * MiB;
constexpr size_t WS_DC = 4 * MiB + 262144;
constexpr size_t WS_MC = 5 * MiB;
constexpr size_t WS_WFIN = 9 * MiB;
constexpr size_t WS_WFOUT = 17 * MiB;
constexpr size_t WS_WMIN = 21 * MiB;
constexpr size_t WS_WMQB = 23 * MiB;
constexpr size_t WS_WMKVB = 25 * MiB;
constexpr size_t WS_WMO = 26 * MiB;
constexpr size_t WS_WGQKV = 28 * MiB;
constexpr size_t WS_WGO = 31 * MiB;
constexpr size_t WS_TE = 34 * MiB;
constexpr size_t WS_TRANK = 35 * MiB;
constexpr size_t WS_STOK = 36 * MiB;
constexpr size_t WS_SW = 41 * MiB;
constexpr size_t WS_X = 64 * MiB;
constexpr size_t WS_H = 200 * MiB;
constexpr size_t WS_RA = 272 * MiB;
constexpr size_t WS_RB = 400 * MiB;
constexpr size_t WS_RC = 528 * MiB;
constexpr size_t WS_RD = 600 * MiB;
constexpr size_t WS_RE = 672 * MiB;
constexpr size_t WS_RF = 728 * MiB;
constexpr size_t WS_RG = 756 * MiB;
constexpr size_t WS_RH = 776 * MiB;
constexpr size_t WS_ACT = 784 * MiB;
constexpr size_t WS_Y = 1072 * MiB;
constexpr size_t WS_WGU = 1360 * MiB;
constexpr size_t WS_SWGU = 1360 * MiB + 256 * MiB;
constexpr size_t WS_SH = 1360 * MiB + 259 * MiB;
constexpr size_t WS_SWP = 1360 * MiB + 259 * MiB + 256 * 1024;
constexpr size_t WS_W8 = 1360 * MiB + 266 * MiB;
constexpr size_t WS_SSC = 1360 * MiB + 260 * MiB;
constexpr size_t WS_WDN = 1872 * MiB;
constexpr size_t WS_SWDN = 1872 * MiB + 128 * MiB;
constexpr size_t WS_END = 2128 * MiB;
constexpr int CW_TMO = 0;
constexpr int CW_BAR = 4096;
constexpr int CW_CNT = 16384;

constexpr int RING_BYTES = 131072;
constexpr int LDS_MISC = 135168;
constexpr int LDS_TT = LDS_MISC;
constexpr int LDS_XB = LDS_MISC + 512;
constexpr int LDS_TE = LDS_MISC + 768;
constexpr int LDS_BYTES = 147456;

#define GAS __attribute__((address_space(1)))
#define LAS __attribute__((address_space(3)))
typedef unsigned short bf16;
typedef unsigned v4u __attribute__((ext_vector_type(4)));
typedef unsigned v2u __attribute__((ext_vector_type(2)));
typedef float f32x4 __attribute__((ext_vector_type(4)));
typedef float f32x2 __attribute__((ext_vector_type(2)));
typedef float f32x16 __attribute__((ext_vector_type(16)));
typedef short bf16x8 __attribute__((ext_vector_type(8)));
typedef short s16x4 __attribute__((ext_vector_type(4)));
typedef __bf16 bf16x2_t __attribute__((ext_vector_type(2)));
typedef GAS unsigned gu32;
#define RLX_AGENT __ATOMIC_RELAXED, __HIP_MEMORY_SCOPE_AGENT
#define LDS_WAIT() asm volatile("s_waitcnt lgkmcnt(0)" ::: "memory")
#define VM_WAIT() asm volatile("s_waitcnt vmcnt(0)" ::: "memory")
__device__ __forceinline__ unsigned pk2(float lo, float hi) { f32x2 v = {lo, hi}; bf16x2_t b = __builtin_convertvector(v, bf16x2_t); return __builtin_bit_cast(unsigned, b); }
__device__ __forceinline__ float bf_lo(unsigned u) { return __builtin_bit_cast(float, u << 16); }
__device__ __forceinline__ float bf_hi(unsigned u) { return __builtin_bit_cast(float, u & 0xffff0000u); }
__device__ __forceinline__ float shx(float v, int mask, int lane) { return __int_as_float(__builtin_amdgcn_ds_bpermute((lane ^ mask) << 2, __float_as_int(v))); }
__device__ __forceinline__ float wave_sum(float v, int lane) {
#pragma unroll
    for (int o = 1; o < 64; o <<= 1) v += shx(v, o, lane);
    return v;
}
__device__ __forceinline__ int lane_id_v() { int t; asm volatile("v_mbcnt_lo_u32_b32 %0, -1, 0\n\tv_mbcnt_hi_u32_b32 %0, -1, %0" : "=v"(t)); return t; }
__device__ __forceinline__ int launder_s(int x) { asm volatile("" : "+s"(x)); return x; }
__device__ __forceinline__ int lthread_w(int wave) { return wave * 64 + lane_id_v(); }
__device__ __forceinline__ int modrow_of(int row) { return row < NC ? NB : ((row - NC) >> 12); }

#define XB_TMO      128
#define XB_XCNT(j)  (256  + 64 * (j))
#define XB_XSUB(j)  (1280 + 64 * (j))
#define XB_XGEN(j)  (2304 + 64 * (j))
#define XB_TOP      3328
#define XB_TOPGEN   3392
#define XCD_BAR_WORDS 3456
#define XB_SPIN_CAP (1u << 18)
__device__ __forceinline__ unsigned xb_ld(unsigned* p)              { return __hip_atomic_load(p, __ATOMIC_RELAXED, __HIP_MEMORY_SCOPE_AGENT); }
__device__ __forceinline__ unsigned xb_add(unsigned* p, unsigned v) { return __hip_atomic_fetch_add(p, v, __ATOMIC_RELAXED, __HIP_MEMORY_SCOPE_AGENT); }
__device__ __forceinline__ unsigned xb_xcc_id() { return (unsigned)__builtin_amdgcn_s_getreg((3 << 11) | 20) & 0xFu; }
#define XB_SPIN(cond, bar) do { unsigned _sp = 0; while (cond) { __builtin_amdgcn_s_sleep(1); \
    if ((++_sp & 255u) == 0u) { if (xb_ld(&(bar)[XB_TMO])) break; if (_sp > XB_SPIN_CAP) { atomicAdd(&(bar)[XB_TMO], 1u); break; } } } } while (0)
struct XcdBarrier { unsigned* bar; unsigned x; volatile LAS unsigned* st; int wave; };
__device__ __forceinline__ bool xb_thread0(int wave) { return wave == 0 && lane_id_v() == 0; }
__device__ __forceinline__ XcdBarrier xcd_barrier_post(unsigned* bar, volatile LAS unsigned* st, int wave) {
    XcdBarrier b; b.bar = bar; b.x = xb_xcc_id(); b.st = st; b.wave = wave;
    if (xb_thread0(wave)) (void)xb_add(&bar[XB_XCNT(b.x)], 1u);
    return b;
}
__device__ __forceinline__ void xcd_barrier_complete(unsigned* bar, unsigned x, unsigned& nloc, unsigned& nx) {
    const unsigned G = gridDim.x * gridDim.y * gridDim.z;
    unsigned sum, cnt, mine, sp = 0u;
    for (;;) {
        sum = 0u; cnt = 0u; mine = 0u;
#pragma unroll
        for (unsigned j = 0; j < 16; ++j) { const unsigned c = xb_ld(&bar[XB_XCNT(j)]); sum += c; cnt += (c > 0u) ? 1u : 0u; mine = (j == x) ? c : mine; }
        if (sum == G) break;
        __builtin_amdgcn_s_sleep(1);
        if ((++sp & 255u) == 0u) { if (xb_ld(&bar[XB_TMO])) break; if (sp > XB_SPIN_CAP) { atomicAdd(&bar[XB_TMO], 1u); break; } }
    }
    nloc = mine > 0u ? mine : 1u; nx = cnt > 0u ? cnt : 1u;
}
__device__ __forceinline__ void xcd_barrier(const XcdBarrier& b) {
    asm volatile("s_waitcnt vmcnt(0)" ::: "memory");
    __syncthreads();
    if (xb_thread0(b.wave)) {
        unsigned* bar = b.bar;
        __builtin_amdgcn_s_waitcnt(0);
        unsigned nloc = b.st[0], nx = b.st[1];
        if (nloc == 0u) { xcd_barrier_complete(bar, b.x, nloc, nx); b.st[0] = nloc; b.st[1] = nx; }
        const unsigned old = xb_add(&bar[XB_XSUB(b.x)], 1u);
        const unsigned gen = old / nloc;
        if (old + 1u == (gen + 1u) * nloc) {
            __builtin_amdgcn_fence(__ATOMIC_RELEASE, "agent");
            asm volatile("s_waitcnt vmcnt(0)" ::: "memory");
            const unsigned og = xb_add(&bar[XB_TOP], 1u);
            const unsigned tg = og / nx;
            if (og + 1u == (tg + 1u) * nx) xb_add(&bar[XB_TOPGEN], 1u);
            else XB_SPIN(xb_ld(&bar[XB_TOPGEN]) == tg, bar);
            __builtin_amdgcn_fence(__ATOMIC_ACQUIRE, "agent");
            xb_add(&bar[XB_XGEN(b.x)], 1u);
            asm volatile("s_waitcnt vmcnt(0)" ::: "memory");
        } else {
            XB_SPIN(xb_ld(&bar[XB_XGEN(b.x)]) == gen, bar);
            __builtin_amdgcn_fence(__ATOMIC_ACQUIRE, "agent");
            asm volatile("s_waitcnt vmcnt(0)" ::: "memory");
        }
    }
    __syncthreads();
}

namespace pg8 {
#define PG8_LAS __attribute__((address_space(3)))
constexpr int BM = 256, BK = 64, HALF = 128, HTB = HALF * BK * 2, STAGE_BYTES = 8 * HTB, NXCD = 8, WGM = 8;
__device__ __forceinline__ int lds_byte(int r, int c) { const int st = (r >> 4) * 2 + (c >> 5), rr = r & 15, cc = c & 31, ob = rr * 64 + cc * 2; return st * 1024 + (ob ^ (((ob >> 9) & 1) << 5)); }
__device__ __forceinline__ void stage_rc(int b, int& R, int& C) { const int st = b / 1024, sb = b % 1024, swz = sb ^ (((sb >> 9) & 1) << 5); R = (st >> 1) * 16 + swz / 64; C = (st & 1) * 32 + (swz % 64) / 2; }
__device__ __forceinline__ int perm32(int rho) { const int n = rho >> 4, i = rho & 15; return 8 * (i >> 2) + 4 * n + (i & 3); }
struct Unit { int pm, pn, aux; };
typedef f32x4 Acc[2][2][4][2];
typedef int i32x4 __attribute__((ext_vector_type(4)));
typedef i32x4 AccI[2][2][4][2];
template <bool I8> struct AccSel { typedef f32x4 T; };
template <> struct AccSel<true> { typedef i32x4 T; };
__device__ __forceinline__ f32x4 mma1(bf16x8 b, bf16x8 a, f32x4 c) { return __builtin_amdgcn_mfma_f32_16x16x32_bf16(b, a, c, 0, 0, 0); }
typedef int i32x8 __attribute__((ext_vector_type(8)));
typedef short bf16x16 __attribute__((ext_vector_type(16)));
__device__ __forceinline__ f32x4 mma_f8(bf16x8 b0, bf16x8 b1, bf16x8 a0, bf16x8 a1, f32x4 c) {
    const i32x8 B = __builtin_bit_cast(i32x8, __builtin_shufflevector(b0, b1, 0, 1, 2, 3, 4, 5, 6, 7, 8, 9, 10, 11, 12, 13, 14, 15));
    const i32x8 A = __builtin_bit_cast(i32x8, __builtin_shufflevector(a0, a1, 0, 1, 2, 3, 4, 5, 6, 7, 8, 9, 10, 11, 12, 13, 14, 15));
    return __builtin_amdgcn_mfma_scale_f32_16x16x128_f8f6f4(B, A, c, 0, 0, 0, 0x7F7F7F7F, 0, 0x7F7F7F7F); }
__device__ __forceinline__ i32x4 mma1(bf16x8 b, bf16x8 a, i32x4 c) { return __builtin_amdgcn_mfma_i32_16x16x64_i8(__builtin_bit_cast(i32x4, b), __builtin_bit_cast(i32x4, a), c, 0, 0, 0); }

__device__ __forceinline__ bool static_next(int i, int G, int c, int nM, int nN, int& pm, int& pn) {
    const int nwg = nM * nN; const long L = (long)i * G + c; if (L >= nwg) return false;
    int wgid = (int)L; { const int q = nwg / NXCD, r = nwg % NXCD, xcd = wgid % NXCD, off = wgid / NXCD; wgid = (xcd < r ? xcd * (q + 1) : r * (q + 1) + (xcd - r) * q) + off; }
    const int nig = WGM * nN, gid = wgid / nig, fm = gid * WGM, gsz = (nM - fm) < WGM ? (nM - fm) : WGM;
    pm = fm + ((wgid % nig) % gsz); pn = (wgid % nig) / gsz; return true;
}

template <class P>
__device__ __forceinline__ void gemm_phase(PG8_LAS unsigned char* lds, const P& p, int wave_id) {
    wave_id = launder_s(wave_id); int tid_l = lthread_w(wave_id);
    const int tid = tid_l, wid = wave_id, lane = tid & 63, wr = wid >> 2, wc = wid & 3, fr = lane & 15, fq = lane >> 4;
    const int nt = p.nt;
    const unsigned ldsw = (unsigned)wid * 1024u;
    const int aoff = lds_byte(wr * 64 + fr, fq * 8), boff = lds_byte(wc * 32 + fr, fq * 8);
    const char* const gA = p.A; const char* const gB = p.B;
#define PG8_SA(b, h) (((b) * 2 + (h)) * HTB)
#define PG8_SB(b, h) ((4 + (b) * 2 + (h)) * HTB)
#define PG8_STAGE(bufoff, gbase, off2, kofs) do { _Pragma("unroll") for (int _i = 0; _i < 2; ++_i) \
        __builtin_amdgcn_global_load_lds((const unsigned*)((gbase) + (size_t)(off2)[_i] + (size_t)(kofs)), (PG8_LAS unsigned*)(lds + (bufoff) + ldsw + _i * 8192), 16, 0, 0); } while (0)
#define PG8_LDA(dst, b, h) do { _Pragma("unroll") for (int m = 0; m < 4; ++m) _Pragma("unroll") for (int k = 0; k < 2; ++k) dst[m][k] = *(const PG8_LAS bf16x8*)(lds + PG8_SA(b, h) + aoff + m * 2048 + k * 1024); } while (0)
#define PG8_LDB(dst, b, h) do { _Pragma("unroll") for (int n = 0; n < 2; ++n) _Pragma("unroll") for (int k = 0; k < 2; ++k) dst[n][k] = *(const PG8_LAS bf16x8*)(lds + PG8_SB(b, h) + boff + n * 2048 + k * 1024); } while (0)
#define PG8_MMA(ai, bj, At, Bt) do { __builtin_amdgcn_s_setprio(1); _Pragma("unroll") for (int m = 0; m < 4; ++m) _Pragma("unroll") for (int n = 0; n < 2; ++n) { \
        if constexpr (P::F8) acc[ai][bj][m][n] = mma_f8(Bt[n][0], Bt[n][1], At[m][0], At[m][1], acc[ai][bj][m][n]); \
        else { _Pragma("unroll") for (int k = 0; k < 2; ++k) acc[ai][bj][m][n] = mma1(Bt[n][k], At[m][k], acc[ai][bj][m][n]); } } __builtin_amdgcn_s_setprio(0); } while (0)
#define PG8_WAIT_V(n) asm volatile("s_waitcnt vmcnt(" #n ")" ::: "memory")
#define PG8_WAIT_L(n) asm volatile("s_waitcnt lgkmcnt(" #n ")" ::: "memory")
#define PG8_BAR __builtin_amdgcn_s_barrier()
#define PG8_SCHED __builtin_amdgcn_sched_barrier(0)
#define PG8_KEYS(u) do { if (P::KEYS && wid < 4) __builtin_amdgcn_global_load_lds((const unsigned*)p.key_ptr(u, wid * 64 + lane), (PG8_LAS unsigned*)(keybuf + wid * 256), 4, 0, 0); } while (0)
#define PG8_OFFS(u, oA, oB) do { int tid2_ = tid; asm volatile("" : "+v"(tid2_));     \
    _Pragma("unroll") for (int _i = 0; _i < 2; ++_i) { int R_, C_; stage_rc(tid2_ * 16 + _i * 8192, R_, C_); const int Rb_ = P::PERM ? ((R_ & ~31) + perm32(R_ & 31)) : R_; \
      _Pragma("unroll") for (int _h = 0; _h < 2; ++_h) { \
        const int key_ = P::KEYS ? ((const PG8_LAS int*)keybuf)[_h * HALF + R_] : 0; \
        oA[_h][_i] = p.a_row(u, _h * HALF + R_, key_) + (unsigned)(C_ * 2); oB[_h][_i] = p.b_row(u, _h * HALF + Rb_) + (unsigned)(C_ * 2); } } } while (0)
    PG8_LAS unsigned char* const keybuf = lds + STAGE_BYTES;
    Unit cur, nxt; int ui = 0;
    if (!p.next(0, cur)) return;
    typedef typename AccSel<P::I8>::T AccT;
    AccT acc[2][2][4][2];
#pragma unroll
    for (int a = 0; a < 2; ++a)
#pragma unroll
        for (int b = 0; b < 2; ++b)
#pragma unroll
            for (int m = 0; m < 4; ++m)
#pragma unroll
                for (int n = 0; n < 2; ++n) acc[a][b][m][n] = (AccT){0, 0, 0, 0};
    bf16x8 At[4][2], B0[2][2], B1[2][2];
    unsigned oAc[2][2], oBc[2][2];
    if (P::KEYS) { PG8_KEYS(cur); PG8_WAIT_V(0); PG8_BAR; }
    PG8_OFFS(cur, oAc, oBc);
    PG8_STAGE(PG8_SB(0, 0), gB, oBc[0], 0); PG8_STAGE(PG8_SB(0, 1), gB, oBc[1], 0); PG8_STAGE(PG8_SA(0, 0), gA, oAc[0], 0); PG8_STAGE(PG8_SA(0, 1), gA, oAc[1], 0);
    if (wr == 1) PG8_BAR;
    PG8_WAIT_V(2); PG8_BAR;
    PG8_STAGE(PG8_SB(1, 0), gB, oBc[0], 128); PG8_STAGE(PG8_SA(1, 0), gA, oAc[0], 128); PG8_STAGE(PG8_SB(1, 1), gB, oBc[1], 128);
    PG8_WAIT_V(6); PG8_BAR;
    for (;;) {
        const bool has_next = p.next(ui + 1, nxt);
        if (has_next) { PG8_KEYS(nxt); }
        for (int t = 0; t < nt; t += 2) {
            const bool last = (t == nt - 2);
            const unsigned k1 = (unsigned)(t + 1) * 128u;
            const unsigned k2 = last ? 0u : (unsigned)(t + 2) * 128u, k3 = k2 + 128u;
            PG8_LDB(B0, 0, 0); PG8_LDB(B1, 0, 1); PG8_SCHED; PG8_LDA(At, 0, 0); PG8_STAGE(PG8_SA(1, 1), gA, oAc[1], k1);
            if (last && has_next) { PG8_OFFS(nxt, oAc, oBc); }
            PG8_WAIT_V(8); PG8_WAIT_L(0); PG8_BAR; PG8_MMA(0, 0, At, B0); PG8_MMA(0, 1, At, B1); PG8_BAR; PG8_SCHED;
            PG8_LDA(At, 0, 1); PG8_STAGE(PG8_SB(0, 0), gB, oBc[0], k2); PG8_STAGE(PG8_SB(0, 1), gB, oBc[1], k2); PG8_STAGE(PG8_SA(0, 0), gA, oAc[0], k2);
            PG8_WAIT_V(8); PG8_WAIT_L(0); PG8_BAR; PG8_MMA(1, 0, At, B0); PG8_MMA(1, 1, At, B1); PG8_BAR; PG8_SCHED;
            PG8_LDB(B0, 1, 0); PG8_LDB(B1, 1, 1); PG8_SCHED; PG8_LDA(At, 1, 0); PG8_STAGE(PG8_SA(0, 1), gA, oAc[1], k2);
            PG8_WAIT_V(8); PG8_WAIT_L(0); PG8_BAR; PG8_MMA(0, 0, At, B0); PG8_MMA(0, 1, At, B1); PG8_BAR; PG8_SCHED;
            PG8_LDA(At, 1, 1); PG8_STAGE(PG8_SB(1, 0), gB, oBc[0], k3); PG8_STAGE(PG8_SB(1, 1), gB, oBc[1], k3); PG8_STAGE(PG8_SA(1, 0), gA, oAc[0], k3);
            PG8_WAIT_V(8); PG8_WAIT_L(0); PG8_BAR; PG8_MMA(1, 0, At, B0); PG8_MMA(1, 1, At, B1); PG8_BAR; PG8_SCHED;
        }
        if (wr == 0) PG8_BAR;
        { const int le_ = lane_id_v(); int fr_e = le_ & 15, fq_e = le_ >> 4;
          p.epi(acc, cur, wr, wc, fr_e, fq_e); }
        if (!has_next) break;
#pragma unroll
        for (int a = 0; a < 2; ++a)
#pragma unroll
            for (int b = 0; b < 2; ++b)
#pragma unroll
                for (int m = 0; m < 4; ++m)
#pragma unroll
                    for (int n = 0; n < 2; ++n) acc[a][b][m][n] = (AccT){0, 0, 0, 0};
        cur = nxt; ++ui;
        if (wr == 1) PG8_BAR;
    }
    PG8_WAIT_V(0);
    PG8_BAR;
#undef PG8_SA
#undef PG8_SB
#undef PG8_STAGE
#undef PG8_LDA
#undef PG8_LDB
#undef PG8_MMA
#undef PG8_WAIT_V
#undef PG8_WAIT_L
#undef PG8_BAR
#undef PG8_SCHED
#undef PG8_OFFS
#undef PG8_KEYS
}
}
using pg8::Unit;

#define TROW(ai, wr, m, fr) (128 * (ai) + 64 * (wr) + 16 * (m) + (fr))
#define TCOLP(bj, wc, fq) (128 * (bj) + 32 * (wc) + 8 * (fq))
#define TCOLN(bj, wc, n, fq) (128 * (bj) + 32 * (wc) + 16 * (n) + 4 * (fq))
__device__ __forceinline__ v4u pack8(const f32x4 a, const f32x4 b) { v4u w; w.x = pk2(a[0], a[1]); w.y = pk2(a[2], a[3]); w.z = pk2(b[0], b[1]); w.w = pk2(b[2], b[3]); return w; }

struct PolDenseBf16 {
    static constexpr bool PERM = true;
    static constexpr bool KEYS = false;
    static constexpr bool I8 = false;
    static constexpr bool F8 = false;
    __device__ __forceinline__ const int* key_ptr(const Unit&, int) const { return nullptr; }
    const char* A; const char* B; int nt; int nM, nN, pm0, G, c; unsigned pitchA, pitchB; bf16* O; int ldo;
    __device__ __forceinline__ bool next(int i, Unit& u) const { int pm, pn; if (!pg8::static_next(i, G, c, nM, nN, pm, pn)) return false; u.pm = pm + pm0; u.pn = pn; u.aux = 0; return true; }
    __device__ __forceinline__ unsigned a_row(const Unit& u, int r, int) const { return (unsigned)(u.pm * 256 + r) * pitchA; }
    __device__ __forceinline__ unsigned b_row(const Unit& u, int r) const { return (unsigned)(u.pn * 256 + r) * pitchB; }
    __device__ __forceinline__ void epi(const pg8::Acc& acc, const Unit& u, int wr, int wc, int fr, int fq) const {
#pragma unroll
        for (int ai = 0; ai < 2; ++ai)
#pragma unroll
            for (int m = 0; m < 4; ++m) { const size_t row = (size_t)u.pm * 256 + TROW(ai, wr, m, fr);
#pragma unroll
                for (int bj = 0; bj < 2; ++bj) { const int col = u.pn * 256 + TCOLP(bj, wc, fq); *(v4u*)(O + row * ldo + col) = pack8(acc[ai][bj][m][0], acc[ai][bj][m][1]); } }
    }
};

struct PolDenseI8 {
    static constexpr bool PERM = true;
    static constexpr bool KEYS = false;
    static constexpr bool I8 = true;
    static constexpr bool F8 = false;
    __device__ __forceinline__ const int* key_ptr(const Unit&, int) const { return nullptr; }
    const char* A; const char* B; int nt; int nM, nN, pm0, G, c; const float* sA; const float* sB; bf16* O; int ldo;
    __device__ __forceinline__ bool next(int i, Unit& u) const { int pm, pn; if (!pg8::static_next(i, G, c, nM, nN, pm, pn)) return false; u.pm = pm + pm0; u.pn = pn; u.aux = 0; return true; }
    __device__ __forceinline__ unsigned a_row(const Unit& u, int r, int) const { return (unsigned)(u.pm * 256 + r) * 1024u; }
    __device__ __forceinline__ unsigned b_row(const Unit& u, int r) const { return (unsigned)(u.pn * 256 + r) * 1024u; }
    __device__ __forceinline__ void epi(const pg8::AccI& acc, const Unit& u, int wr, int wc, int fr, int fq) const {
#pragma unroll
        for (int bj = 0; bj < 2; ++bj) { const int col = u.pn * 256 + TCOLP(bj, wc, fq); const f32x4 s0 = *(const f32x4*)(sB + col), s1 = *(const f32x4*)(sB + col + 4);
#pragma unroll
            for (int ai = 0; ai < 2; ++ai)
#pragma unroll
                for (int m = 0; m < 4; ++m) { const size_t row = (size_t)u.pm * 256 + TROW(ai, wr, m, fr); const float sa = sA[row]; f32x4 v0, v1;
#pragma unroll
                    for (int q = 0; q < 4; ++q) { v0[q] = (float)acc[ai][bj][m][0][q] * (sa * s0[q]); v1[q] = (float)acc[ai][bj][m][1][q] * (sa * s1[q]); }
                    *(v4u*)(O + row * ldo + col) = pack8(v0, v1); } }
    }
};

struct PolOut {
    static constexpr bool PERM = true;
    static constexpr bool KEYS = false;
    static constexpr bool I8 = false;
    static constexpr bool F8 = false;
    __device__ __forceinline__ const int* key_ptr(const Unit&, int) const { return nullptr; }
    const char* A; const char* B; int nt; int nM, nN, pm0, G, c; bf16* X; const float* mod;
    int chunk; const float* XinC; const float* XinL;
    __device__ __forceinline__ bool next(int i, Unit& u) const { int pm, pn; if (!pg8::static_next(i, G, c, nM, nN, pm, pn)) return false; u.pm = pm + pm0; u.pn = pn; u.aux = 0; return true; }
    __device__ __forceinline__ unsigned a_row(const Unit& u, int r, int) const { return (unsigned)(u.pm * 256 + r) * 2048u; }
    __device__ __forceinline__ unsigned b_row(const Unit& u, int r) const { return (unsigned)(u.pn * 256 + r) * 2048u; }
    __device__ __forceinline__ void epi(const pg8::Acc& acc, const Unit& u, int wr, int wc, int fr, int fq) const {
        const int mr = modrow_of(u.pm * 256);
        const float* g = mod + (size_t)mr * (NMOD * D) + chunk * D;
        const float* xin = XinC ? (u.pm < 8 ? XinC : XinL) : nullptr;
#pragma unroll
        for (int bj = 0; bj < 2; ++bj) { const int col = u.pn * 256 + TCOLP(bj, wc, fq); const f32x4 g0 = *(const f32x4*)(g + col), g1 = *(const f32x4*)(g + col + 4);
#pragma unroll
            for (int ai = 0; ai < 2; ++ai)
#pragma unroll
                for (int m = 0; m < 4; ++m) { const size_t off = ((size_t)u.pm * 256 + TROW(ai, wr, m, fr)) * D + col; f32x4 x0, x1;
                    if (xin) { x0 = *(const f32x4*)(xin + off); x1 = *(const f32x4*)(xin + off + 4); }
                    else { const v4u w = *(const v4u*)(X + off); x0 = (f32x4){bf_lo(w.x), bf_hi(w.x), bf_lo(w.y), bf_hi(w.y)}; x1 = (f32x4){bf_lo(w.z), bf_hi(w.z), bf_lo(w[3]), bf_hi(w[3])}; }
                    *(v4u*)(X + off) = pack8(x0 + g0 * acc[ai][bj][m][0], x1 + g1 * acc[ai][bj][m][1]); } }
    }
};

struct PolFP {
    static constexpr bool PERM = true;
    static constexpr bool KEYS = false;
    static constexpr bool I8 = true;
    static constexpr bool F8 = false;
    __device__ __forceinline__ const int* key_ptr(const Unit&, int) const { return nullptr; }
    const char* A; const char* B; int nt; int nN, G, c; const float* sW; const float* sH; bf16* Z; bf16* Zc;
    __device__ __forceinline__ bool next(int i, Unit& u) const { int pm, pn; if (!pg8::static_next(i, G, c, 8, nN, pm, pn)) return false; u.pm = pm; u.pn = pn; u.aux = 0; return true; }
    __device__ __forceinline__ unsigned a_row(const Unit& u, int r, int) const { return (unsigned)(u.pm * 256 + r) * 1024u; }
    __device__ __forceinline__ int tok_row(int pn, int n) const { if (pn < 128) { const int b = n >> 12, l2 = (n >> 6) & 63, l1 = n & 63; return NC + b * SEQ + 64 * l1 + l2; } return n - 32768; }
    __device__ __forceinline__ unsigned b_row(const Unit& u, int r) const { return (unsigned)tok_row(u.pn, u.pn * 256 + r) * 1024u; }
    __device__ __forceinline__ void epi(const pg8::AccI& acc, const Unit& u, int wr, int wc, int fr, int fq) const {
#pragma unroll
        for (int bj = 0; bj < 2; ++bj) { const int n0 = u.pn * 256 + TCOLP(bj, wc, fq);
            f32x4 h0, h1;
#pragma unroll
            for (int q = 0; q < 4; ++q) { h0[q] = sH[tok_row(u.pn, n0 + q)]; h1[q] = sH[tok_row(u.pn, n0 + 4 + q)]; }
#pragma unroll
            for (int ai = 0; ai < 2; ++ai)
#pragma unroll
                for (int m = 0; m < 4; ++m) { const int cp = u.pm * 256 + TROW(ai, wr, m, fr); const float sw = sW[cp]; f32x4 v0, v1;
#pragma unroll
                    for (int q = 0; q < 4; ++q) { v0[q] = (float)acc[ai][bj][m][0][q] * (sw * h0[q]); v1[q] = (float)acc[ai][bj][m][1][q] * (sw * h1[q]); }
                    const v4u w = pack8(v0, v1);
                    if (u.pn < 128) *(v4u*)(Z + ((size_t)(n0 >> 6) * 2048 + cp) * 64 + (n0 & 63)) = w;
                    else { const int b = u.pn - 128, l = n0 - 32768 - b * 256; *(v4u*)(Zc + ((size_t)b * 2048 + cp) * 256 + l) = w; } } }
    }
};

struct PolFA {
    static constexpr bool PERM = true;
    static constexpr bool KEYS = false;
    static constexpr bool I8 = false;
    static constexpr bool F8 = false;
    __device__ __forceinline__ const int* key_ptr(const Unit&, int) const { return nullptr; }
    const char* A; const char* B; int nt; int G, c; bf16* Y;
    __device__ __forceinline__ bool next(int i, Unit& u) const { const int L = i * G + c; if (L >= 1024) return false; u.pm = 0; u.pn = L & 127; u.aux = L >> 7; return true; }
    __device__ __forceinline__ unsigned a_row(const Unit&, int r, int) const { return (unsigned)r * 512u; }
    __device__ __forceinline__ unsigned b_row(const Unit& u, int r) const { const int l2 = r & 63, cp = u.pn * 4 + (r >> 6); return (unsigned)((u.aux * 64 + l2) * 512 + cp) * 512u; }
    __device__ __forceinline__ void epi(const pg8::Acc& acc, const Unit& u, int wr, int wc, int fr, int fq) const {
        const int b = u.aux;
#pragma unroll
        for (int ai = 0; ai < 2; ++ai)
#pragma unroll
            for (int m = 0; m < 4; ++m) { const int rr = TROW(ai, wr, m, fr), jp = rr >> 7, pp = (rr >> 6) & 1, k1 = rr & 63;
#pragma unroll
                for (int bj = 0; bj < 2; ++bj) { const int n0 = u.pn * 256 + TCOLP(bj, wc, fq), cp = n0 >> 6, l2 = n0 & 63, cc = 2 * cp + jp;
                    const size_t idx = ((((size_t)(b * 16 + (k1 >> 2)) * 1024 + cc) * 4 + (k1 & 3)) * 2 + pp) * 64 + l2;
                    *(v4u*)(Y + idx) = pack8(acc[ai][bj][m][0], acc[ai][bj][m][1]); } }
    }
};

struct PolFC {
    static constexpr bool PERM = true;
    static constexpr bool KEYS = false;
    static constexpr bool I8 = false;
    static constexpr bool F8 = false;
    __device__ __forceinline__ const int* key_ptr(const Unit&, int) const { return nullptr; }
    const char* A; const char* B; int nt; int G, c; int nunits; unsigned offMC, offZc; bf16* F;
    __device__ __forceinline__ bool next(int i, Unit& u) const { const int L = i * G + c; if (L >= nunits) return false;
        if (L < 512) { u.pm = 0; u.pn = L & 3; u.aux = L >> 2; } else { const int q = L - 512; u.pm = 0; u.pn = q & 3; u.aux = 256 + (q >> 2); } return true; }
    __device__ __forceinline__ unsigned a_row(const Unit& u, int r, int) const {
        if (u.aux < 256) return offMC + (unsigned)((u.aux & 15) * 256 + r) * 1024u;
        return (unsigned)r * 1024u; }
    __device__ __forceinline__ unsigned b_row(const Unit& u, int r) const {
        if (u.aux < 256) return (unsigned)(u.aux * 1024 + u.pn * 256 + r) * 1024u;
        return offZc + (unsigned)((u.aux - 256) * 1024 + u.pn * 256 + r) * 1024u; }
    __device__ __forceinline__ void epi(const pg8::Acc& acc, const Unit& u, int wr, int wc, int fr, int fq) const {
#pragma unroll
        for (int ai = 0; ai < 2; ++ai)
#pragma unroll
            for (int m = 0; m < 4; ++m) { const int rr = TROW(ai, wr, m, fr); size_t frow;
                if (u.aux < 256) { const int b = u.aux >> 4, kq = u.aux & 15, k = 4 * kq + (rr >> 6) + 64 * (rr & 63); frow = (size_t)NC + b * SEQ + k; }
                else frow = (size_t)(u.aux - 256) * LCTX + rr;
#pragma unroll
                for (int bj = 0; bj < 2; ++bj) { const int col = u.pn * 256 + TCOLP(bj, wc, fq); *(v4u*)(F + frow * D + col) = pack8(acc[ai][bj][m][0], acc[ai][bj][m][1]); } }
    }
};

struct PolMlaQ {
    static constexpr bool PERM = true;
    static constexpr bool KEYS = false;
    static constexpr bool I8 = false;
    static constexpr bool F8 = false;
    __device__ __forceinline__ const int* key_ptr(const Unit&, int) const { return nullptr; }
    const char* A; const char* B; int nt; int nM, nN, G, c; bf16* Q; const float* rope; float c2;
    __device__ __forceinline__ bool next(int i, Unit& u) const { int pm, pn; if (!pg8::static_next(i, G, c, nM, nN, pm, pn)) return false; u.pm = pm; u.pn = pn; u.aux = 0; return true; }
    __device__ __forceinline__ unsigned a_row(const Unit& u, int r, int) const { return (unsigned)(u.pm * 256 + r) * (unsigned)(MLA_QL * 2); }
    __device__ __forceinline__ unsigned b_row(const Unit& u, int r) const { return (unsigned)(u.pn * 256 + r) * (unsigned)(MLA_QL * 2); }
    __device__ __forceinline__ void epi(const pg8::Acc& acc, const Unit& u, int wr, int wc, int fr, int fq) const {
        const bool lat = u.pm >= 8;
#pragma unroll
        for (int bj = 0; bj < 2; ++bj) { const int col = u.pn * 256 + TCOLP(bj, wc, fq); const bool isrope = lat && (((col >> 5) % 3) == 2);
#pragma unroll
            for (int ai = 0; ai < 2; ++ai)
#pragma unroll
                for (int m = 0; m < 4; ++m) { const int row = u.pm * 256 + TROW(ai, wr, m, fr); f32x4 v0 = acc[ai][bj][m][0], v1 = acc[ai][bj][m][1];
                    if (isrope) { const int t = (row - NC) & 4095, pos = (fq & 2) ? (t & 63) : (t >> 6);
                        const f32x4* rp = (const f32x4*)(rope + (size_t)pos * 16);
                        const f32x4 r0 = rp[0], r1 = rp[1], r2 = rp[2], r3 = rp[3];
                        f32x4 p0, p1;
#pragma unroll
                        for (int e = 0; e < 4; ++e) { p0[e] = shx(v0[e], 16, fq * 16 + fr); p1[e] = shx(v1[e], 16, fq * 16 + fr); }
                        const float sg = (fq & 1) ? 1.f : -1.f;
                        v0[0] = v0[0] * r0[0] + sg * p0[0] * r0[1]; v0[1] = v0[1] * r0[2] + sg * p0[1] * r0[3];
                        v0[2] = v0[2] * r1[0] + sg * p0[2] * r1[1]; v0[3] = v0[3] * r1[2] + sg * p0[3] * r1[3];
                        v1[0] = v1[0] * r2[0] + sg * p1[0] * r2[1]; v1[1] = v1[1] * r2[2] + sg * p1[1] * r2[3];
                        v1[2] = v1[2] * r3[0] + sg * p1[2] * r3[1]; v1[3] = v1[3] * r3[2] + sg * p1[3] * r3[3]; }
                    *(v4u*)(Q + (size_t)row * 1536 + col) = pack8(v0 * c2, v1 * c2); } }
    }
};

struct PolMlaKV {
    static constexpr bool PERM = true;
    static constexpr bool KEYS = false;
    static constexpr bool I8 = false;
    static constexpr bool F8 = false;
    __device__ __forceinline__ const int* key_ptr(const Unit&, int) const { return nullptr; }
    const char* A; const char* B; int nt; int nM, nN, G, c; bf16* Kb; bf16* Vb;
    __device__ __forceinline__ bool next(int i, Unit& u) const { int pm, pn; if (!pg8::static_next(i, G, c, nM, nN, pm, pn)) return false; u.pm = pm; u.pn = pn; u.aux = 0; return true; }
    __device__ __forceinline__ unsigned a_row(const Unit& u, int r, int) const { return (unsigned)(u.pm * 256 + r) * 512u; }
    __device__ __forceinline__ unsigned b_row(const Unit& u, int r) const { return (unsigned)(u.pn * 256 + r) * 512u; }
    __device__ __forceinline__ void epi(const pg8::Acc& acc, const Unit& u, int wr, int wc, int fr, int fq) const {
#pragma unroll
        for (int bj = 0; bj < 2; ++bj) { const int col = u.pn * 256 + TCOLP(bj, wc, fq), h = col >> 7, j = col & 127;
#pragma unroll
            for (int ai = 0; ai < 2; ++ai)
#pragma unroll
                for (int m = 0; m < 4; ++m) { const size_t row = (size_t)u.pm * 256 + TROW(ai, wr, m, fr); const v4u w = pack8(acc[ai][bj][m][0], acc[ai][bj][m][1]);
                    if (j < 64) *(v4u*)(Kb + row * 1536 + 96 * h + j) = w; else *(v4u*)(Vb + row * 1024 + 64 * h + (j - 64)) = w; } }
    }
};

struct MoeTab { const LAS int* TT; const LAS int* CN; const LAS int* TE; };
__device__ __forceinline__ bool moe_next(int i, int G, int c, int NP, const MoeTab& T, Unit& u) {
    const int ttot = T.TT[32];
    int lo, hi, j;
    if ((G & 7) == 0) { const int x = c & 7, q = c >> 3, g8 = G >> 3; lo = (x * ttot) >> 3; hi = ((x + 1) * ttot) >> 3; j = i * g8 + q; }
    else { lo = 0; hi = ttot; j = i * G + c; }
    if (j >= (hi - lo) * NP) return false;
    const int tile = lo + j / NP; u.pn = j % NP; u.pm = tile;
    const int e = T.TE[tile];
    u.aux = e | ((tile - T.TT[e]) << 8);
    return true;
}
struct PolMoe1 {
    static constexpr bool PERM = true;
    static constexpr bool I8 = true;
    static constexpr bool F8 = false;
    const char* A; const char* B; int nt; int G, c; MoeTab T; const int* stok; const float* bgu; const float* swgu; const float* ssc; unsigned char* act;
    __device__ __forceinline__ bool next(int i, Unit& u) const { return moe_next(i, G, c, 8, T, u); }
    static constexpr bool KEYS = true;
    __device__ __forceinline__ const int* key_ptr(const Unit& u, int r) const { const int e = u.aux & 255, idx = (u.aux >> 8) * 256 + r; const int cn = T.CN[e]; return stok + (size_t)e * CAP + (idx < cn ? idx : 0); }
    __device__ __forceinline__ unsigned a_row(const Unit&, int, int key) const { return (unsigned)key * 1024u; }
    __device__ __forceinline__ unsigned b_row(const Unit& u, int r) const { return (unsigned)((u.aux & 255) * 2048 + u.pn * 256 + r) * 1024u; }
    __device__ __forceinline__ void epi(const pg8::AccI& acc, const Unit& u, int wr, int wc, int fr, int fq) const {
        const int e = u.aux & 255, mt = u.aux >> 8, cn = T.CN[e]; const int jl = 32 * wc + 8 * fq;
        const float* bg = bgu + (size_t)e * 2048 + u.pn * 256 + jl;
        const float* sg = swgu + (size_t)e * 2048 + u.pn * 256 + jl;
        const f32x4 bg0 = *(const f32x4*)(bg), bg1 = *(const f32x4*)(bg + 4), bu0 = *(const f32x4*)(bg + 128), bu1 = *(const f32x4*)(bg + 132);
        const f32x4 sg0 = *(const f32x4*)(sg), sg1 = *(const f32x4*)(sg + 4), su0 = *(const f32x4*)(sg + 128), su1 = *(const f32x4*)(sg + 132);
#pragma unroll
        for (int ai = 0; ai < 2; ++ai)
#pragma unroll
            for (int m = 0; m < 4; ++m) { const int rr = TROW(ai, wr, m, fr), idx = mt * 256 + rr; const size_t slot = (size_t)u.pm * 256 + rr;
                const float sa = ssc[(size_t)e * CAP + (idx < cn ? idx : 0)];
                f32x4 g0, g1, u0, u1, o0, o1;
#pragma unroll
                for (int q = 0; q < 4; ++q) { g0[q] = (float)acc[ai][0][m][0][q] * (sa * sg0[q]) + bg0[q]; g1[q] = (float)acc[ai][0][m][1][q] * (sa * sg1[q]) + bg1[q];
                    u0[q] = (float)acc[ai][1][m][0][q] * (sa * su0[q]) + bu0[q]; u1[q] = (float)acc[ai][1][m][1][q] * (sa * su1[q]) + bu1[q]; }
#pragma unroll
                for (int q = 0; q < 4; ++q) {
                    float ga = fminf(g0[q], 7.f), ua = fminf(fmaxf(u0[q], -7.f), 7.f); o0[q] = (ua + 1.f) * ga * __builtin_amdgcn_rcpf(1.f + __builtin_amdgcn_exp2f(-1.702f * LOG2E * ga));
                    float gb = fminf(g1[q], 7.f), ub = fminf(fmaxf(u1[q], -7.f), 7.f); o1[q] = (ub + 1.f) * gb * __builtin_amdgcn_rcpf(1.f + __builtin_amdgcn_exp2f(-1.702f * LOG2E * gb)); }
                v2u w8; { int t0 = __builtin_amdgcn_cvt_pk_fp8_f32(o0[0], o0[1], 0, false); t0 = __builtin_amdgcn_cvt_pk_fp8_f32(o0[2], o0[3], t0, true);
                          int t1 = __builtin_amdgcn_cvt_pk_fp8_f32(o1[0], o1[1], 0, false); t1 = __builtin_amdgcn_cvt_pk_fp8_f32(o1[2], o1[3], t1, true); w8.x = (unsigned)t0; w8.y = (unsigned)t1; }
                *(v2u*)(act + slot * 1024 + u.pn * 128 + jl) = w8; }
    }
};
struct PolMoe2 {
    static constexpr bool PERM = true;
    static constexpr bool KEYS = false;
    static constexpr bool I8 = false;
    static constexpr bool F8 = true;
    __device__ __forceinline__ const int* key_ptr(const Unit&, int) const { return nullptr; }
    const char* A; const char* B; int nt; int G, c; MoeTab T; const float* sw; const float* bdn; const float* swd; unsigned char* Y;
    __device__ __forceinline__ bool next(int i, Unit& u) const { return moe_next(i, G, c, 4, T, u); }
    __device__ __forceinline__ unsigned a_row(const Unit& u, int r, int) const { return (unsigned)(u.pm * 256 + r) * 1024u; }
    __device__ __forceinline__ unsigned b_row(const Unit& u, int r) const { return (unsigned)((u.aux & 255) * 1024 + u.pn * 256 + r) * 1024u; }
    __device__ __forceinline__ void epi(const pg8::Acc& acc, const Unit& u, int wr, int wc, int fr, int fq) const {
        const int e = u.aux & 255, mt = u.aux >> 8, cn = T.CN[e];
#pragma unroll
        for (int bj = 0; bj < 2; ++bj) { const int col = u.pn * 256 + TCOLP(bj, wc, fq); const size_t ci = (size_t)e * 1024 + col;
            const f32x4 b0 = *(const f32x4*)(bdn + ci), b1 = *(const f32x4*)(bdn + ci + 4), s0 = *(const f32x4*)(swd + ci), s1 = *(const f32x4*)(swd + ci + 4);
#pragma unroll
            for (int ai = 0; ai < 2; ++ai)
#pragma unroll
                for (int m = 0; m < 4; ++m) { const int rr = TROW(ai, wr, m, fr), idx = mt * 256 + rr; const size_t slot = (size_t)u.pm * 256 + rr; const float w = sw[(size_t)e * CAP + (idx < cn ? idx : 0)];
                    const float w8 = w * 8.f; f32x4 y0 = (acc[ai][bj][m][0] * s0 + b0) * w8, y1 = (acc[ai][bj][m][1] * s1 + b1) * w8;
#pragma unroll
                    for (int q = 0; q < 4; ++q) { y0[q] = __builtin_amdgcn_fmed3f(y0[q], -448.f, 448.f); y1[q] = __builtin_amdgcn_fmed3f(y1[q], -448.f, 448.f); }
                    v2u o8; { int t0 = __builtin_amdgcn_cvt_pk_fp8_f32(y0[0], y0[1], 0, false); t0 = __builtin_amdgcn_cvt_pk_fp8_f32(y0[2], y0[3], t0, true);
                              int t1 = __builtin_amdgcn_cvt_pk_fp8_f32(y1[0], y1[1], 0, false); t1 = __builtin_amdgcn_cvt_pk_fp8_f32(y1[2], y1[3], t1, true); o8.x = (unsigned)t0; o8.y = (unsigned)t1; }
                    *(v2u*)(Y + slot * 1024 + col) = o8; } }
    }
};

namespace att {
__device__ __forceinline__ int crow(int r, int hi) { return (r & 3) + 8 * (r >> 2) + 4 * hi; }
__device__ __forceinline__ float max3f(float a, float b, float c) { return fmaxf(fmaxf(a, b), c); }
typedef LAS const char* lds_cptr;
constexpr int LK = 0, LV = 49152, LWS = 90112, LOST = 92160, LBYTES = 124928;
constexpr int PD = 3;
struct Tens { const bf16* Q; int qpitch; const bf16* K; int kpitch; const bf16* V; int vpitch; bf16* O; };
#define ATT_WAITV(n) asm volatile("s_waitcnt vmcnt(" #n ")" ::: "memory")
struct Pend { f32x16 o0, o1; float l; int qrow0, oc0; bool valid; };
__device__ __forceinline__ void finish_unit(const Pend& P, bf16* O, LAS unsigned char* lds, int wid, int lane) {
    const int r32 = lane & 31, hi = lane >> 5;
    LAS float* wsf = (LAS float*)(lds + LWS) + wid * 64;
    float lrun = P.l;
    { auto rr = __builtin_amdgcn_permlane32_swap(__float_as_uint(lrun), __float_as_uint(lrun), false, false); lrun = __uint_as_float(rr[0]) + __uint_as_float(rr[1]); }
    if (hi == 0) wsf[32 + r32] = lrun;
    LDS_WAIT();
    LAS bf16* stg = (LAS bf16*)(lds + LOST) + wid * 2048;
#pragma unroll
    for (int r = 0; r < 16; ++r) { const int orow = crow(r, hi); const float rl = __builtin_amdgcn_rcpf(wsf[32 + orow]);
        stg[orow * 64 + r32] = (bf16)(pk2(P.o0[r] * rl, 0.f) & 0xffffu); stg[orow * 64 + 32 + r32] = (bf16)(pk2(P.o1[r] * rl, 0.f) & 0xffffu); }
    LDS_WAIT();
    bf16* Ow = O + (size_t)(P.qrow0 + wid * 32) * 1024 + P.oc0;
#pragma unroll
    for (int i = 0; i < 4; ++i) { const int row = i * 8 + (lane >> 3), ch = lane & 7; const v4u v = *(const LAS v4u*)(stg + row * 64 + ch * 8); *(v4u*)(Ow + (size_t)row * 1024 + ch * 8) = v; }
    LDS_WAIT();
}
template <int DK>
__device__ __forceinline__ void unit(const Tens& T, int qrow0, int qc0, int kc0, int vc0, int oc0, int kctx0, int klat0, int NTL, LAS unsigned char* lds, int wave_id, Pend& pend) {
    constexpr int ND = DK / 16;
    wave_id = launder_s(wave_id); const int tid = lthread_w(wave_id), lane = tid & 63, r32 = lane & 31, hi = lane >> 5; const int wid = wave_id;
    LAS float* wsf = (LAS float*)(lds + LWS) + wid * 64;
    const bf16* ksrc = T.K + (size_t)lane * T.kpitch + kc0 + wid * 8;
    const int k2off = (8 + (wid & 3) - wid) * 8;
    const bf16* vsrc = T.V + (size_t)(16 * (wid & 3) + (lane >> 2)) * T.vpitch + vc0 + (wid >> 2) * 32 + (lane & 3) * 8;
#define ATT_DMA(t, ks_, vs_) do { const size_t row0_ = (size_t)((t) < 4 ? kctx0 + 64 * (t) : klat0 + 64 * ((t) - 4)); \
        __builtin_amdgcn_global_load_lds((const unsigned*)(ksrc + row0_ * T.kpitch), (LAS unsigned*)(lds + LK + (ks_) * 12288 + wid * 1024), 16, 0, 0); \
        if (DK > 64) __builtin_amdgcn_global_load_lds((const unsigned*)(ksrc + row0_ * T.kpitch + k2off), (LAS unsigned*)(lds + LK + (ks_) * 12288 + 8192 + (wid & 3) * 1024), 16, 0, 0); \
        __builtin_amdgcn_global_load_lds((const unsigned*)(vsrc + row0_ * T.vpitch), (LAS unsigned*)(lds + LV + (vs_) * 8192 + wid * 1024), 16, 0, 0); } while (0)
#define ATT_WAIT_TILES(n_tiles) do { if (DK > 64) { if ((n_tiles) >= 2) ATT_WAITV(6); else if ((n_tiles) == 1) ATT_WAITV(3); else ATT_WAITV(0); } \
        else { if ((n_tiles) >= 2) ATT_WAITV(4); else if ((n_tiles) == 1) ATT_WAITV(2); else ATT_WAITV(0); } } while (0)
    bf16x8 qr[ND];
    { const bf16* qp = T.Q + (size_t)(qrow0 + wid * 32 + r32) * T.qpitch + qc0 + hi * 8;
#pragma unroll
      for (int d0 = 0; d0 < ND; ++d0) qr[d0] = *(const bf16x8*)(qp + d0 * 16); }
    asm volatile("" ::: "memory");
    constexpr float THR = 8.f;
    const int half = wid >> 2;
    float mhat = 0.f, lrun = 0.f; f32x16 o[2]; o[0] = f32x16{}; o[1] = f32x16{}; f32x16 negm = f32x16{};
    f32x16 p0 = f32x16{}, p1 = f32x16{}; v4u pw[4]; pw[0] = pw[1] = pw[2] = pw[3] = (v4u){0u, 0u, 0u, 0u};
    ATT_DMA(0, 0, 0); ATT_DMA(1, 1, 1); ATT_DMA(2, 2, 2);
    if (pend.valid) finish_unit(pend, T.O, lds, wid, lane);
    ATT_WAIT_TILES(2);
    __builtin_amdgcn_s_barrier(); asm volatile("" ::: "memory");
    if (half == 1) __builtin_amdgcn_s_barrier();
    int vs_prev = 0, vs_cur = 0, vs_iss = 3;
    for (int t = 0; t <= NTL; ++t) {
        if (t >= 1) {
            s16x4 lo[2][4], hh[2][4];
            const unsigned vb = (unsigned)(uintptr_t)(lds + LV + vs_prev * 8192) + ((lane >> 4) & 1) * 32 + (lane & 3) * 8 + (4 * hi + ((lane & 15) >> 2)) * 64;
#pragma unroll
            for (int d0 = 0; d0 < 2; ++d0)
#pragma unroll
                for (int ks = 0; ks < 4; ++ks) {
                    asm volatile("ds_read_b64_tr_b16 %0,%1 offset:%c2" : "=&v"(lo[d0][ks]) : "v"(vb), "i"(d0 * 4096 + ks * 1024) : "memory");
                    asm volatile("ds_read_b64_tr_b16 %0,%1 offset:%c2" : "=&v"(hh[d0][ks]) : "v"(vb), "i"(d0 * 4096 + ks * 1024 + 512) : "memory"); }
            asm volatile("s_waitcnt lgkmcnt(0)" ::: "memory"); __builtin_amdgcn_sched_barrier(0);
#pragma unroll
            for (int ks = 0; ks < 4; ++ks)
#pragma unroll
                for (int d0 = 0; d0 < 2; ++d0) { const bf16x8 vf = (bf16x8){lo[d0][ks][0], lo[d0][ks][1], lo[d0][ks][2], lo[d0][ks][3], hh[d0][ks][0], hh[d0][ks][1], hh[d0][ks][2], hh[d0][ks][3]};
                    o[d0] = __builtin_amdgcn_mfma_f32_32x32x16_bf16(__builtin_bit_cast(bf16x8, pw[ks]), vf, o[d0], 0, 0, 0); }
        }
        if (t < NTL) {
            bf16x8 kf[2 * ND];
            const lds_cptr kb = (lds_cptr)(lds + LK + (t & 3) * 12288) + hi * 1024 + r32 * 16;
#pragma unroll
            for (int d0 = 0; d0 < ND; ++d0) { kf[2 * d0] = *(const LAS bf16x8*)(kb + d0 * 2048); kf[2 * d0 + 1] = *(const LAS bf16x8*)(kb + d0 * 2048 + 512); }
            asm volatile("s_waitcnt lgkmcnt(0)" ::: "memory"); __builtin_amdgcn_sched_barrier(0);
#pragma unroll
            for (int d0 = 0; d0 < ND; ++d0) {
                if (d0 == 0) { p0 = __builtin_amdgcn_mfma_f32_32x32x16_bf16(kf[0], qr[0], negm, 0, 0, 0); p1 = __builtin_amdgcn_mfma_f32_32x32x16_bf16(kf[1], qr[0], negm, 0, 0, 0); }
                else { p0 = __builtin_amdgcn_mfma_f32_32x32x16_bf16(kf[2 * d0], qr[d0], p0, 0, 0, 0); p1 = __builtin_amdgcn_mfma_f32_32x32x16_bf16(kf[2 * d0 + 1], qr[d0], p1, 0, 0, 0); } }
        }
        if (half == 1) {
            const int last_iss = (t + PD - 1 < NTL - 1) ? t + PD - 1 : NTL - 1; const int allow = last_iss - (t + 1);
            if (allow >= 1) ATT_WAIT_TILES(1); else ATT_WAIT_TILES(0); }
        asm volatile("s_waitcnt lgkmcnt(0)" ::: "memory"); __builtin_amdgcn_s_barrier(); asm volatile("" ::: "memory");
        if (t < NTL) {
            float rm = max3f(p0[0], p0[1], p1[0]);
#pragma unroll
            for (int r = 0; r < 16; ++r) rm = max3f(rm, p0[r], p1[r]);
            { auto rr = __builtin_amdgcn_permlane32_swap(__float_as_uint(rm), __float_as_uint(rm), false, false); rm = fmaxf(__uint_as_float(rr[0]), __uint_as_float(rr[1])); }
            if (t == 0 || __any(rm > THR)) {
                const float dl = (t == 0) ? rm : fmaxf(rm, 0.f);
                mhat += dl;
#pragma unroll
                for (int r = 0; r < 16; ++r) { p0[r] -= dl; p1[r] -= dl; negm[r] = -mhat; }
                const float f = (t == 0) ? 1.f : __builtin_amdgcn_exp2f(-dl); lrun *= f;
                if (hi == 0) wsf[r32] = f;
                LDS_WAIT();
#pragma unroll
                for (int r = 0; r < 16; ++r) { const float a = wsf[crow(r, hi)]; o[0][r] *= a; o[1][r] *= a; }
            }
            float rs = 0.f;
#pragma unroll
            for (int r = 0; r < 16; ++r) { p0[r] = __builtin_amdgcn_exp2f(p0[r]); p1[r] = __builtin_amdgcn_exp2f(p1[r]); rs += p0[r] + p1[r]; }
            lrun += rs;
            pw[0] = (v4u){pk2(p0[0], p0[1]), pk2(p0[2], p0[3]), pk2(p0[4], p0[5]), pk2(p0[6], p0[7])};
            pw[1] = (v4u){pk2(p0[8], p0[9]), pk2(p0[10], p0[11]), pk2(p0[12], p0[13]), pk2(p0[14], p0[15])};
            pw[2] = (v4u){pk2(p1[0], p1[1]), pk2(p1[2], p1[3]), pk2(p1[4], p1[5]), pk2(p1[6], p1[7])};
            pw[3] = (v4u){pk2(p1[8], p1[9]), pk2(p1[10], p1[11]), pk2(p1[12], p1[13]), pk2(p1[14], p1[15])};
        }
        if (t + PD < NTL) { ATT_DMA(t + PD, (t + PD) & 3, vs_iss); vs_iss = (vs_iss == 4) ? 0 : vs_iss + 1; }
        if (half == 0) {
            const int last_iss = (t + PD < NTL - 1) ? t + PD : NTL - 1; const int allow = last_iss - (t + 1);
            if (allow >= 2) ATT_WAIT_TILES(2); else if (allow == 1) ATT_WAIT_TILES(1); else ATT_WAIT_TILES(0); }
        vs_prev = vs_cur; vs_cur = (vs_cur == 4) ? 0 : vs_cur + 1;
        asm volatile("s_waitcnt lgkmcnt(0)" ::: "memory"); __builtin_amdgcn_s_barrier(); asm volatile("" ::: "memory");
    }
    if (half == 0) __builtin_amdgcn_s_barrier();
#undef ATT_DMA
#undef ATT_WAIT_TILES
    pend.o0 = o[0]; pend.o1 = o[1]; pend.l = lrun; pend.qrow0 = qrow0; pend.oc0 = oc0; pend.valid = true;
}
#undef ATT_WAITV
}

namespace att64 {
typedef unsigned short bf16;
using bf16x8=__attribute__((ext_vector_type(8)))short;
using s16x4=__attribute__((ext_vector_type(4)))short;
using f32x16=__attribute__((ext_vector_type(16)))float;
using u32x4=__attribute__((ext_vector_type(4)))unsigned;
constexpr int D=64;
constexpr int NW=8,QBLK=32,QB=QBLK*NW,KVBLK=64;
__device__ __forceinline__ int crow(int r,int hi){return (r&3)+8*(r>>2)+4*hi;}
#define SBAR() __builtin_amdgcn_sched_barrier(0)
constexpr int NSLOT=3, SLOTB=8192;
constexpr int LDS_K=0, LDS_V=NSLOT*SLOTB, LDS_WS=2*NSLOT*SLOTB, LDS_OST=LDS_WS+NW*64*4, LDS_BYTES=LDS_OST+NW*4096;
constexpr float C2=0.125f*1.4426950408889634f;
__device__ __forceinline__ void glds16(const void*gsrc,unsigned lds_dst){unsigned keep;
  asm volatile("s_mov_b32 %0, m0\n\ts_mov_b32 m0, %2\n\ts_nop 0\n\tglobal_load_lds_dwordx4 %1, off\n\ts_mov_b32 m0, %0":"=&s"(keep):"v"(gsrc),"s"(lds_dst):"memory");}
__device__ __forceinline__ float max3f(float a,float b,float c){float r;asm("v_max3_f32 %0, %1, %2, %3":"=v"(r):"v"(a),"v"(b),"v"(c));return r;}
__device__ __forceinline__ float max2f(float a,float b){float r;asm("v_max_f32_e32 %0, %1, %2":"=v"(r):"v"(a),"v"(b));return r;}
__device__ __forceinline__ float fadd_s(float a,float b){float r;asm("v_add_f32_e32 %0, %1, %2":"=v"(r):"v"(a),"v"(b));return r;}
__device__ __forceinline__ float fsub_s(float a,float b){float r;asm("v_sub_f32_e32 %0, %1, %2":"=v"(r):"v"(a),"v"(b));return r;}
typedef float f32x2_t __attribute__((ext_vector_type(2))); typedef __bf16 bf16x2_t __attribute__((ext_vector_type(2)));
__device__ __forceinline__ unsigned cvtpk_s(float lo,float hi){f32x2_t v={lo,hi};bf16x2_t b=__builtin_convertvector(v,bf16x2_t);return __builtin_bit_cast(unsigned,b);}
#define WAIT_BAR(N) asm volatile("s_waitcnt vmcnt(" #N ") lgkmcnt(0)\n\ts_barrier":::"memory")

__device__ __forceinline__ void qkt(f32x16&p0,f32x16&p1,const char*Kslot,const bf16x8*qr,const f32x16&negm,int r32,int hi){
  const char*kb=Kslot+hi*1024+r32*16;
  #pragma unroll
  for(int d0=0;d0<4;++d0){
    const bf16x8 b0=*reinterpret_cast<const bf16x8*>(kb+d0*2048);
    const bf16x8 b1=*reinterpret_cast<const bf16x8*>(kb+d0*2048+512);
    if(d0==0){p0=__builtin_amdgcn_mfma_f32_32x32x16_bf16(b0,qr[0],negm,0,0,0);p1=__builtin_amdgcn_mfma_f32_32x32x16_bf16(b1,qr[0],negm,0,0,0);}
    else{p0=__builtin_amdgcn_mfma_f32_32x32x16_bf16(b0,qr[d0],p0,0,0,0);p1=__builtin_amdgcn_mfma_f32_32x32x16_bf16(b1,qr[d0],p1,0,0,0);}}
}
typedef __attribute__((address_space(3))) const char* lds_cptr;
typedef short v4i16_t __attribute__((ext_vector_type(4)));
__device__ __forceinline__ void kload8(bf16x8*kf,lds_cptr kp){
  kf[0]=*(const __attribute__((address_space(3))) bf16x8*)(kp);      kf[1]=*(const __attribute__((address_space(3))) bf16x8*)(kp+512);
  kf[2]=*(const __attribute__((address_space(3))) bf16x8*)(kp+2048); kf[3]=*(const __attribute__((address_space(3))) bf16x8*)(kp+2560);
  kf[4]=*(const __attribute__((address_space(3))) bf16x8*)(kp+4096); kf[5]=*(const __attribute__((address_space(3))) bf16x8*)(kp+4608);
  kf[6]=*(const __attribute__((address_space(3))) bf16x8*)(kp+6144); kf[7]=*(const __attribute__((address_space(3))) bf16x8*)(kp+6656);
}
__device__ __forceinline__ void kload2(bf16x8*kf,lds_cptr kp,int j){ kf[2*j]=*(const __attribute__((address_space(3))) bf16x8*)(kp+j*2048); kf[2*j+1]=*(const __attribute__((address_space(3))) bf16x8*)(kp+j*2048+512); }
__device__ __forceinline__ s16x4 vtr(lds_cptr p){ return __builtin_bit_cast(s16x4,__builtin_amdgcn_ds_read_tr16_b64_v4i16((__attribute__((address_space(3))) v4i16_t*)p)); }
__device__ __forceinline__ float rowmax(const f32x16&p0,const f32x16&p1){
  float a=max3f(p0[0],p0[1],p1[0]),b=max3f(p0[2],p0[3],p1[1]);a=max3f(a,p1[2],p1[3]);
  #pragma unroll
  for(int r=4;r<16;r+=4){a=max3f(a,p0[r],p0[r+1]);b=max3f(b,p0[r+2],p0[r+3]);a=max3f(a,p1[r],p1[r+1]);b=max3f(b,p1[r+2],p1[r+3]);}
  const float m=max2f(a,b);
  auto rr=__builtin_amdgcn_permlane32_swap(__float_as_uint(m),__float_as_uint(m),false,false);
  return max2f(__uint_as_float(rr[0]),__uint_as_float(rr[1]));
}
__device__ __forceinline__ void pv(f32x16*o,int vb,bf16x8 pa0,bf16x8 pa1,bf16x8 pa2,bf16x8 pa3){
  #pragma unroll
  for(int d0=0;d0<2;++d0){s16x4 lo[4],hi[4];
    #pragma unroll
    for(int ks=0;ks<4;++ks){
      asm volatile("ds_read_b64_tr_b16 %0,%1 offset:%c2":"=&v"(lo[ks]):"v"(vb),"i"(d0*4096+ks*1024):"memory");
      asm volatile("ds_read_b64_tr_b16 %0,%1 offset:%c2":"=&v"(hi[ks]):"v"(vb),"i"(d0*4096+ks*1024+512):"memory");}
    asm volatile("s_waitcnt lgkmcnt(0)":::"memory");SBAR();
    #define PK(k) (bf16x8){lo[k][0],lo[k][1],lo[k][2],lo[k][3],hi[k][0],hi[k][1],hi[k][2],hi[k][3]}
    o[d0]=__builtin_amdgcn_mfma_f32_32x32x16_bf16(pa0,PK(0),o[d0],0,0,0);
    o[d0]=__builtin_amdgcn_mfma_f32_32x32x16_bf16(pa1,PK(1),o[d0],0,0,0);
    o[d0]=__builtin_amdgcn_mfma_f32_32x32x16_bf16(pa2,PK(2),o[d0],0,0,0);
    o[d0]=__builtin_amdgcn_mfma_f32_32x32x16_bf16(pa3,PK(3),o[d0],0,0,0);
    #undef PK
  }
}

#ifndef ATTN_STORE16
#define ATTN_STORE16(p,v) (*(u32x4*)(p)=(v))
#endif
template<int THRL> __device__ __forceinline__ void attn_unit(const bf16*Q,int qp,int qrow0,int qc0,const bf16*__restrict__ K,int kp,int kc0,const bf16*__restrict__ V,int vp,int vc0,bf16*O,int oc0,int kctx0,int klat0,int NT,char*shm,int wave_id){
  wave_id=launder_s(wave_id); const int lane=lane_id_v(),r32=lane&31,hi=lane>>5; const int wid=wave_id;
  const bf16*Qw=Q+(long)(qrow0+wid*QBLK)*qp+qc0;
  const bf16*Kh=K+kc0,*Vh=V+vc0;
  const unsigned lds0=(unsigned)(uintptr_t)shm;
  float*wsf=(float*)(shm+LDS_WS)+wid*64;
  const bf16*ksrc=Kh+(long)lane*kp+wid*8;
  const bf16*vsrc=Vh+(long)(16*(wid&3)+(lane>>2))*vp+(wid>>2)*32+(lane&3)*8;
  #define TROW0(t) ((long)((t)<4?kctx0+64*(t):klat0+64*((t)-4)))
  const unsigned kdst=lds0+LDS_K+wid*1024, vdst=lds0+LDS_V+wid*1024;
  #define DMA_K(t,slot) glds16(ksrc+TROW0(t)*kp,(unsigned)__builtin_amdgcn_readfirstlane(kdst+(slot)))
  #define DMA_V(t,slot) glds16(vsrc+TROW0(t)*vp,(unsigned)__builtin_amdgcn_readfirstlane(vdst+(slot)))
  const int vb0=(int)(lds0+LDS_V)+((lane>>4)&1)*32+(lane&3)*8+(4*hi+((lane&15)>>2))*64;
  const char*Kbase=shm+LDS_K; bf16x8 kf[8];
  const lds_cptr shm3=(lds_cptr)shm; const lds_cptr kp0=shm3+LDS_K+hi*1024+r32*16; const lds_cptr vp0=shm3+LDS_V+((lane>>4)&1)*32+(lane&3)*8+(4*hi+((lane&15)>>2))*64;
  DMA_K(0,0);DMA_V(0,0);DMA_K(1,SLOTB);
  bf16x8 qr[4];
  #pragma unroll
  for(int d0=0;d0<4;++d0)qr[d0]=*reinterpret_cast<const bf16x8*>(&Qw[(long)r32*qp+d0*16+hi*8]);
  float mhat=0.f,l_reg=0.f;f32x16 o[2];o[0]=f32x16{};o[1]=f32x16{};f32x16 negm=f32x16{};asm volatile("":"+v"(negm));
  #define CMASK(P0,P1,t) do{}while(0)
  bool resc=false;
  #define START(P0,P1) do{ const float rm=rowmax(P0,P1); resc=false; \
    { const float dl=rm; mhat=fadd_s(mhat,dl); \
      _Pragma("unroll") for(int r=0;r<16;++r){P0[r]=fsub_s(P0[r],dl);P1[r]=fsub_s(P1[r],dl);} \
      _Pragma("unroll") for(int r=0;r<16;++r)negm[r]=-mhat; asm volatile("":"+v"(negm)); } \
    _Pragma("unroll") for(int r=0;r<16;++r)P0[r]=__builtin_amdgcn_exp2f(P0[r]); }while(0)
  #define RESC() do{ if(resc){ asm volatile("s_waitcnt lgkmcnt(0)":::"memory"); \
      _Pragma("unroll") for(int d_=0;d_<2;++d_) _Pragma("unroll") for(int r=0;r<16;++r)o[d_][r]*=wsf[crow(r,hi)]; } }while(0)
  f32x16 pA0,pA1,pB0,pB1;
  int sl_prev=0,sl_cur=0,sl_next=SLOTB;
  #define ROT() do{sl_prev=sl_cur;sl_cur=sl_next;sl_next=(sl_next==(NSLOT-1)*SLOTB)?0:sl_next+SLOTB;}while(0)
  DMA_K(2,2*SLOTB);
  WAIT_BAR(3);
  qkt(pA0,pA1,Kbase,qr,negm,r32,hi);asm volatile("s_nop 15\n\ts_nop 7":"+v"(pA0),"+v"(pA1));CMASK(pA0,pA1,0);
  START(pA0,pA1);
  _Pragma("unroll") for(int r=0;r<16;++r)pA1[r]=__builtin_amdgcn_exp2f(pA1[r]);
  WAIT_BAR(0);
  DMA_K(3,0);DMA_V(1,SLOTB);
  ROT();
  kload8(kf,kp0+sl_cur);
  WAIT_BAR(2);
  s16x4 vlo[8],vhi[8]; u32x4 pw0,pw1,pw2,pw3;
  #define PKW(P,B) cvtpk_s(P[B],P[B+1])
  #define PAF(k) __builtin_bit_cast(bf16x8,pw##k)
  #define VFR(i) (bf16x8){vlo[i][0],vlo[i][1],vlo[i][2],vlo[i][3],vhi[i][0],vhi[i][1],vhi[i][2],vhi[i][3]}
  #define PIN(x) asm volatile("":"+v"(x))
  #define MX3(a,b,c) __builtin_fmaxf(__builtin_fmaxf((a),(b)),(c))
  #define GAPA(MF,A0,A1,A2,A3,W0,W1,PW) do{ MF; sacc+=A0; sacc+=A1; sacc+=A2; sacc+=A3; PIN(sacc); W0; W1; PIN(PW); SBAR(); }while(0)
  #define EX(v) __builtin_amdgcn_exp2f(v)
  #define GAPB(MF,X,B) do{ MF; X[B]=EX(X[B]); X[B+1]=EX(X[B+1]); X[B+2]=EX(X[B+2]); X[B+3]=EX(X[B+3]); PIN(X); SBAR(); }while(0)
  #define VRD(i) do{ vlo[i]=vtr(vp_+(((i)>>2)*4096+((i)&3)*1024)); vhi[i]=vtr(vp_+(((i)>>2)*4096+((i)&3)*1024+512)); }while(0)
  #define KRD(G,j) do{ if(G){ kload2(kf,kp0+sl_next,j); SBAR(); } }while(0)
  #define STEP(C0,C1,P0,P1,t,GK,GV,GL) do{ SBAR(); \
    const lds_cptr vp_=vp0+sl_prev; \
    VRD(0); SBAR(); float sacc=(P0[0]+P0[1]); \
    GAPA(C0=__builtin_amdgcn_mfma_f32_32x32x16_bf16(kf[0],qr[0],negm,0,0,0), P0[2],P0[3],P0[4],P0[5],     pw0[0]=PKW(P0,0), pw0[1]=PKW(P0,2), pw0); \
    VRD(4); SBAR(); GAPA(C1=__builtin_amdgcn_mfma_f32_32x32x16_bf16(kf[1],qr[0],negm,0,0,0), P0[6],P0[7],P0[8],P0[9],     pw0[2]=PKW(P0,4), pw0[3]=PKW(P0,6), pw0); \
    VRD(1); SBAR(); GAPA(C0=__builtin_amdgcn_mfma_f32_32x32x16_bf16(kf[2],qr[1],C0,0,0,0),   P0[10],P0[11],P0[12],P0[13], pw1[0]=PKW(P0,8), pw1[1]=PKW(P0,10), pw1); \
    VRD(5); SBAR(); GAPA(C1=__builtin_amdgcn_mfma_f32_32x32x16_bf16(kf[3],qr[1],C1,0,0,0),   P0[14],P0[15],P1[0],P1[1],   pw1[2]=PKW(P0,12),pw1[3]=PKW(P0,14), pw1); \
    VRD(2); SBAR(); GAPA(C0=__builtin_amdgcn_mfma_f32_32x32x16_bf16(kf[4],qr[2],C0,0,0,0),   P1[2],P1[3],P1[4],P1[5],     pw2[0]=PKW(P1,0), pw2[1]=PKW(P1,2), pw2); \
    VRD(6); SBAR(); GAPA(C1=__builtin_amdgcn_mfma_f32_32x32x16_bf16(kf[5],qr[2],C1,0,0,0),   P1[6],P1[7],P1[8],P1[9],     pw2[2]=PKW(P1,4), pw2[3]=PKW(P1,6), pw2); \
    VRD(3); SBAR(); GAPA(C0=__builtin_amdgcn_mfma_f32_32x32x16_bf16(kf[6],qr[3],C0,0,0,0),   P1[10],P1[11],P1[12],P1[13], pw3[0]=PKW(P1,8), pw3[1]=PKW(P1,10), pw3); \
    VRD(7); SBAR(); GAPA(C1=__builtin_amdgcn_mfma_f32_32x32x16_bf16(kf[7],qr[3],C1,0,0,0),   P1[14],P1[15],0.f,0.f,       pw3[2]=PKW(P1,12),pw3[3]=PKW(P1,14), pw3); \
    l_reg+=sacc; \
    if(GK){DMA_K((t)+3,sl_cur);} if(GV){DMA_V((t)+1,sl_next);} \
    CMASK(C0,C1,t); \
    { float a=MX3(C0[0],C0[1],C1[0]),b=MX3(C0[2],C0[3],C1[1]); a=MX3(a,C1[2],C1[3]); \
      _Pragma("unroll") for(int r=4;r<16;r+=4){a=MX3(a,C0[r],C0[r+1]);b=MX3(b,C0[r+2],C0[r+3]);a=MX3(a,C1[r],C1[r+1]);b=MX3(b,C1[r+2],C1[r+3]);} \
      float rm=__builtin_fmaxf(a,b); { auto rr=__builtin_amdgcn_permlane32_swap(__float_as_uint(rm),__float_as_uint(rm),false,false); rm=__builtin_fmaxf(__uint_as_float(rr[0]),__uint_as_float(rr[1])); } \
      resc=false; \
      if(__builtin_expect(__any(rm>(float)THRL),0)){ const float dl=__builtin_fmaxf(rm,0.f); mhat+=dl; \
        _Pragma("unroll") for(int r=0;r<16;++r){C0[r]-=dl;C1[r]-=dl;} \
        _Pragma("unroll") for(int r=0;r<16;++r)negm[r]=-mhat; asm volatile("":"+v"(negm)); \
        const float f=__builtin_amdgcn_exp2f(-dl); l_reg*=f; if(hi==0)wsf[r32]=f; resc=true; } } \
    SBAR(); \
    GAPB(o[0]=__builtin_amdgcn_mfma_f32_32x32x16_bf16(PAF(0),VFR(0),o[0],0,0,0), C0,0); \
    GAPB(o[1]=__builtin_amdgcn_mfma_f32_32x32x16_bf16(PAF(0),VFR(4),o[1],0,0,0), C0,4); \
    KRD(GL,0); GAPB(o[0]=__builtin_amdgcn_mfma_f32_32x32x16_bf16(PAF(1),VFR(1),o[0],0,0,0), C0,8); \
    KRD(GL,1); GAPB(o[1]=__builtin_amdgcn_mfma_f32_32x32x16_bf16(PAF(1),VFR(5),o[1],0,0,0), C0,12); \
    KRD(GL,2); GAPB(o[0]=__builtin_amdgcn_mfma_f32_32x32x16_bf16(PAF(2),VFR(2),o[0],0,0,0), C1,0); \
    KRD(GL,3); GAPB(o[1]=__builtin_amdgcn_mfma_f32_32x32x16_bf16(PAF(2),VFR(6),o[1],0,0,0), C1,4); \
    GAPB(o[0]=__builtin_amdgcn_mfma_f32_32x32x16_bf16(PAF(3),VFR(3),o[0],0,0,0), C1,8); \
    GAPB(o[1]=__builtin_amdgcn_mfma_f32_32x32x16_bf16(PAF(3),VFR(7),o[1],0,0,0), C1,12); \
    }while(0)
  int t=1;
  for(;t+5<NT;t+=2){
    STEP(pB0,pB1,pA0,pA1,t,true,true,true);     WAIT_BAR(2); RESC(); ROT();
    STEP(pA0,pA1,pB0,pB1,t+1,true,true,true);   WAIT_BAR(2); RESC(); ROT();
  }
  #define ENDW(tt) do{ if((tt)+3<NT){WAIT_BAR(2);} else if((tt)+2<NT){WAIT_BAR(1);} else {WAIT_BAR(0);} }while(0)
  for(;t+1<NT;t+=2){
    STEP(pB0,pB1,pA0,pA1,t,(t+3<NT),(t+1<NT),(t+1<NT));       ENDW(t);   RESC(); ROT();
    STEP(pA0,pA1,pB0,pB1,t+1,(t+4<NT),(t+2<NT),(t+2<NT));     ENDW(t+1); RESC(); ROT();
  }
  STEP(pB0,pB1,pA0,pA1,NT-1,false,false,false); RESC();
  { float sacc=pB0[0]+pB0[1]; _Pragma("unroll") for(int r=2;r<16;++r)sacc+=pB0[r]; _Pragma("unroll") for(int r=0;r<16;++r)sacc+=pB1[r]; l_reg+=sacc;
    pw0=(u32x4){PKW(pB0,0),PKW(pB0,2),PKW(pB0,4),PKW(pB0,6)};pw1=(u32x4){PKW(pB0,8),PKW(pB0,10),PKW(pB0,12),PKW(pB0,14)};pw2=(u32x4){PKW(pB1,0),PKW(pB1,2),PKW(pB1,4),PKW(pB1,6)};pw3=(u32x4){PKW(pB1,8),PKW(pB1,10),PKW(pB1,12),PKW(pB1,14)};
    SBAR(); pv(o,vb0+sl_cur,PAF(0),PAF(1),PAF(2),PAF(3)); }
  #undef PKW
  #undef PAF
  #undef VFR
  #undef PIN
  #undef MX3
  #undef GAPA
  #undef GAPB
  #undef EX
  #undef VRD
  #undef KRD
  #undef STEP
  #undef ENDW
  {auto rr=__builtin_amdgcn_permlane32_swap(__float_as_uint(l_reg),__float_as_uint(l_reg),false,false);l_reg=__uint_as_float(rr[0])+__uint_as_float(rr[1]);}
  if(hi==0)wsf[32+r32]=l_reg;asm volatile("s_waitcnt lgkmcnt(0)":::"memory");
  float rli[16];
  #pragma unroll
  for(int r=0;r<16;++r)rli[r]=__builtin_amdgcn_rcpf(wsf[32+crow(r,hi)]);
  bf16*Ow=O+(long)(qrow0+wid*QBLK)*1024+oc0;
  { bf16*stg=(bf16*)(shm+LDS_OST)+wid*2048;
    #pragma unroll
    for(int r=0;r<16;++r){const int orow=crow(r,hi);
      #pragma unroll
      for(int d0=0;d0<2;++d0)stg[orow*64+d0*32+r32]=(bf16)(cvtpk_s(o[d0][r]*rli[r],0.f)&0xffffu);}
    asm volatile("s_waitcnt lgkmcnt(0)":::"memory");
    #pragma unroll
    for(int i=0;i<4;++i){const int row=i*8+(lane>>3),ch=lane&7; const u32x4 v=*(const u32x4*)(stg+row*64+ch*8); ATTN_STORE16(Ow+(long)row*1024+ch*8,v);} }
  asm volatile("s_waitcnt lgkmcnt(0)\n\ts_barrier":::"memory");
  #undef DMA_K
  #undef DMA_V
  #undef TROW0
  #undef CMASK
  #undef START
  #undef RESC
  #undef ROT
}
#undef SBAR
#undef WAIT_BAR
}

struct Args { const float* in[27]; float* out; unsigned char* ws; int ph_lo, ph_hi; };
struct Frame {
    LAS unsigned char* lds; unsigned char* ws; gu32* ctl; int wave, G, gw, NGW;
};
__device__ __forceinline__ int lthread(int wave) { return wave * 64 + lane_id_v(); }

template <int MODE>
__device__ __forceinline__ void conv_item(const float* W, int K, int N, bf16* WT, LAS float* scr, int item, int lane) {
    const int nblk = (N + 63) / 64, kb = item / nblk, nb = item % nblk, k0 = 64 * kb, n0 = 64 * nb;
    f32x4 v[16];
    const int cc = (lane & 15) * 4, rk = lane >> 4;
    const bool ok = (n0 + cc) < N;
#pragma unroll
    for (int i = 0; i < 16; ++i) v[i] = ok ? *(const f32x4*)(W + (size_t)(k0 + 4 * i + rk) * N + n0 + cc) : (f32x4){0.f, 0.f, 0.f, 0.f};
#pragma unroll
    for (int i = 0; i < 16; ++i) { LAS float* s = scr + (4 * i + rk) * 65 + cc; s[0] = v[i][0]; s[1] = v[i][1]; s[2] = v[i][2]; s[3] = v[i][3]; }
    LDS_WAIT(); asm volatile("" ::: "memory");
    const int c = lane & 7;
#pragma unroll
    for (int j = 0; j < 8; ++j) { const int n = (lane >> 3) + 8 * j; const LAS float* s = scr + (8 * c) * 65 + n;
        v4u o; o.x = pk2(s[0], s[65]); o.y = pk2(s[2 * 65], s[3 * 65]); o.z = pk2(s[4 * 65], s[5 * 65]); o.w = pk2(s[6 * 65], s[7 * 65]);
        const int ng = n0 + n; if (ng < N) { const int dr = (MODE == 1) ? ((ng >> 8) * 256 + (ng & 1) * 128 + ((ng >> 1) & 127)) : ng; *(v4u*)(WT + (size_t)dr * K + k0 + 8 * c) = o; } }
    LDS_WAIT(); asm volatile("" ::: "memory");
}

__device__ __forceinline__ void prologue(Frame& F, const Args& a) {
    const int f_tid = lthread(F.wave), f_lane = f_tid & 63;
    unsigned char* ws = F.ws;
    {
        LAS float* scr = (LAS float*)(F.lds + F.wave * 16640);
        struct M { const float* src; int K, N; size_t dst; };
        const int I_FO = 16 * 16, I_MIN = 16 * 11, I_QB = 6 * 24, I_KVB = 4 * 32, I_MO = 256, I_GQKV = 16 * 24, I_GO = 256;
        const int NSMALL = 2 * I_FO + I_MIN + I_QB + I_KVB + I_MO + I_GQKV + I_GO;
        for (int it = F.gw; it < NSMALL; it += F.NGW) {
            int r = it;
            if (r < 2 * I_FO) { const int j = r / I_FO; conv_item<0>(a.in[10] + (size_t)j * D * D, D, D, (bf16*)(ws + WS_WFOUT) + (size_t)j * D * D, scr, r % I_FO, f_lane); continue; } r -= 2 * I_FO;
            if (r < I_MIN) { conv_item<0>(a.in[11], D, MLA_IN, (bf16*)(ws + WS_WMIN), scr, r, f_lane); continue; } r -= I_MIN;
            if (r < I_QB) { conv_item<0>(a.in[13], MLA_QL, 1536, (bf16*)(ws + WS_WMQB), scr, r, f_lane); continue; } r -= I_QB;
            if (r < I_KVB) { conv_item<0>(a.in[15], MLA_KVL, 2048, (bf16*)(ws + WS_WMKVB), scr, r, f_lane); continue; } r -= I_KVB;
            if (r < I_MO) { conv_item<0>(a.in[16], D, D, (bf16*)(ws + WS_WMO), scr, r, f_lane); continue; } r -= I_MO;
            if (r < I_GQKV) { conv_item<0>(a.in[17], D, GQA_QKV, (bf16*)(ws + WS_WGQKV), scr, r, f_lane); continue; } r -= I_GQKV;
            conv_item<0>(a.in[20], D, D, (bf16*)(ws + WS_WGO), scr, r, f_lane);
        }
    }
    __syncthreads();
    {
        LAS float* cmax = (LAS float*)F.lds;
        LAS float* cinv = cmax + 512;
        LAS unsigned* scr8 = (LAS unsigned*)(F.lds + 4096) + F.wave * (64 * 33);
        const int cc = (f_lane & 15) * 4, rk = f_lane >> 4;
        constexpr int NGU = DEPTH * NE * 32, NDN = DEPTH * NE * 16;
        for (int it = blockIdx.x; it < NGU + NDN; it += F.G) {
            const bool dn = it >= NGU; const int q_ = dn ? it - NGU : it; const int le = dn ? (q_ >> 4) : (q_ >> 5), strip = dn ? (q_ & 15) : (q_ & 31);
            const int N = dn ? 1024 : 2048;
            const float* W = (dn ? a.in[25] + (size_t)le * DFF * D : a.in[23] + (size_t)le * D * 2048) + strip * 64 + cc;
            f32x4 v[32];
#pragma unroll
            for (int i = 0; i < 32; ++i) v[i] = *(const f32x4*)(W + (size_t)(F.wave * 128 + 16 * (i >> 2) + 4 * rk + (i & 3)) * N);
            f32x4 mx = (f32x4){0.f, 0.f, 0.f, 0.f};
#pragma unroll
            for (int i = 0; i < 32; ++i) { mx[0] = fmaxf(mx[0], fabsf(v[i][0])); mx[1] = fmaxf(mx[1], fabsf(v[i][1])); mx[2] = fmaxf(mx[2], fabsf(v[i][2])); mx[3] = fmaxf(mx[3], fabsf(v[i][3])); }
#pragma unroll
            for (int q = 0; q < 4; ++q) { mx[q] = fmaxf(mx[q], shx(mx[q], 16, f_lane)); mx[q] = fmaxf(mx[q], shx(mx[q], 32, f_lane)); }
            __syncthreads();
            if (rk == 0) { LAS float* d = cmax + F.wave * 64 + cc; d[0] = mx[0]; d[1] = mx[1]; d[2] = mx[2]; d[3] = mx[3]; }
            __syncthreads();
            const float target = dn ? 240.f : 127.f;
            if (f_tid < 64) { float m8 = 0.f;
#pragma unroll
                for (int w = 0; w < 8; ++w) m8 = fmaxf(m8, cmax[w * 64 + f_tid]);
                const int ng = strip * 64 + f_tid, dr = dn ? ng : (ng >> 8) * 256 + (ng & 1) * 128 + ((ng >> 1) & 127);
                float* sc = dn ? (float*)(ws + WS_SWDN) + (size_t)le * 1024 : (float*)(ws + WS_SWGU) + (size_t)le * 2048;
                sc[dr] = (m8 > 0.f) ? m8 / target : 1.f;
                cinv[f_tid] = (m8 > 0.f) ? target / m8 : 0.f; }
            __syncthreads();
            const f32x4 iv = *(const LAS f32x4*)(cinv + cc);
#pragma unroll
            for (int ip = 0; ip < 8; ++ip) {
#pragma unroll
                for (int q = 0; q < 4; ++q) { unsigned w = 0;
                    if (dn) { int t = __builtin_amdgcn_cvt_pk_fp8_f32(v[4 * ip][q] * iv[q], v[4 * ip + 1][q] * iv[q], 0, false); t = __builtin_amdgcn_cvt_pk_fp8_f32(v[4 * ip + 2][q] * iv[q], v[4 * ip + 3][q] * iv[q], t, true); w = (unsigned)t; }
                    else {
#pragma unroll
                        for (int j = 0; j < 4; ++j) { int qi = __float2int_rn(v[4 * ip + j][q] * iv[q]); qi = qi > 127 ? 127 : (qi < -127 ? -127 : qi); w |= ((unsigned)qi & 255u) << (8 * j); } }
                    scr8[(cc + q) * 33 + 4 * ip + rk] = w; } }
            LDS_WAIT(); asm volatile("" ::: "memory");
            { const int c8 = f_lane & 7;
              unsigned char* dst = dn ? (unsigned char*)(ws + WS_WDN) + (size_t)le * 1024 * 1024 : (unsigned char*)(ws + WS_WGU) + (size_t)le * 2048 * 1024;
#pragma unroll
              for (int jp = 0; jp < 8; ++jp) { const int n = (f_lane >> 3) + 8 * jp; const LAS unsigned* sp = scr8 + n * 33 + 4 * c8;
                  v4u o; o.x = sp[0]; o.y = sp[1]; o.z = sp[2]; o[3] = sp[3];
                  const int ng = strip * 64 + n, dr = dn ? ng : (ng >> 8) * 256 + (ng & 1) * 128 + ((ng >> 1) & 127);
                  *(v4u*)(dst + (size_t)dr * 1024 + F.wave * 128 + 16 * c8) = o; } }
            LDS_WAIT(); asm volatile("" ::: "memory");
        }
        __syncthreads();
    }
    const int gtid = blockIdx.x * 512 + f_tid, gthreads = F.G * 512;
    for (int i = gtid; i < (MLA_IN_PAD - MLA_IN) * D / 8; i += gthreads) ((v4u*)((bf16*)(ws + WS_WMIN) + (size_t)MLA_IN * D))[i] = (v4u){0u, 0u, 0u, 0u};
    {
        bf16* MA = (bf16*)(ws + WS_MA);
        for (int i = gtid; i < 256 * 256; i += gthreads) { const int row = i >> 8, col = i & 255, jp = row >> 7, pp = (row >> 6) & 1, k1 = row & 63, j = col >> 7, pt = (col >> 6) & 1, l1 = col & 63;
            float v = 0.f; if (j == jp) { const float x = 2.f * (float)((k1 * l1) & 63) / 64.f; const float cs = cospif(x), sn = sinpif(x); v = (pp == 0) ? (pt == 0 ? cs : sn) : (pt == 0 ? -sn : cs); }
            MA[i] = (bf16)(pk2(v, 0.f) & 0xffffu); }
        bf16* DC = (bf16*)(ws + WS_DC); const float sc = 1.0f / sqrtf(256.f * 128.f);
        for (int i = gtid; i < 256 * 512; i += gthreads) { const int k = i >> 9, col = i & 511, pt = col >> 8, l = col & 255; const float x = 2.f * (float)((k * l) & 255) / 256.f;
            const float v = (pt == 0 ? cospif(x) : sinpif(x)) * sc; DC[i] = (bf16)(pk2(v, 0.f) & 0xffffu); }
        bf16* MC = (bf16*)(ws + WS_MC); const float sl = 1.0f / sqrtf(4096.f * 128.f);
        for (int i = gtid; i < 16 * 256 * 512; i += gthreads) { const int kq = i >> 17, row = (i >> 9) & 255, col = i & 511, kkp = row >> 6, k2 = row & 63, kk = col >> 7, pp = (col >> 6) & 1, l2 = col & 63;
            float v = 0.f; if (kk == kkp) { const int k = 4 * kq + kkp + 64 * k2; const float x = 2.f * (float)((l2 * k) & 4095) / 4096.f; v = (pp == 0 ? cospif(x) : sinpif(x)) * sl; }
            MC[i] = (bf16)(pk2(v, 0.f) & 0xffffu); }
        float* RM = (float*)(ws + WS_ROPE); float* RG = RM + 2048;
        for (int i = gtid; i < 64 * 8; i += gthreads) { const int pos = i >> 3, f = i & 7; const float inv = powf(10000.f, -(float)f / 8.f); float s, c; sincosf((float)pos * inv, &s, &c); RM[2 * i] = c; RM[2 * i + 1] = s; }
        for (int i = gtid; i < 64 * 16; i += gthreads) { const int pos = i >> 4, f = i & 15; const float inv = powf(10000.f, -(float)f / 16.f); float s, c; sincosf((float)pos * inv, &s, &c); RG[2 * i] = c; RG[2 * i + 1] = s; }
        float* WRT = (float*)(ws + WS_WRT);
        for (int i = gtid; i < DEPTH * NE * D; i += gthreads) { const int l = i >> 15, e = (i >> 10) & 31, k = i & 1023; WRT[i] = a.in[21][((size_t)l * D + k) * NE + e]; }
        float* BG = (float*)(ws + WS_BGU);
        for (int i = gtid; i < DEPTH * NE * 2048; i += gthreads) { const int le = i >> 11, q = i & 2047, pn = q >> 8, s = (q >> 7) & 1, jj = q & 127; BG[i] = a.in[24][(size_t)le * 2048 + 2 * (pn * 128 + jj) + s]; }
    }
    __syncthreads();
    {
        LAS float* wl = (LAS float*)F.lds;
        LAS float* tc = wl + 2048; LAS float* ts = tc + 128;
        if (f_tid < 128) { const float x = 2.f * (float)f_tid / 128.f; tc[f_tid] = cospif(x); ts[f_tid] = -sinpif(x); }
        for (int it = blockIdx.x; it < 2 * 8 * 64; it += F.G) { const int j = it >> 9, g = (it >> 6) & 7, kb = it & 63;
            __syncthreads();
            { const int kk = f_tid >> 5, c4 = (f_tid & 31) * 4; const f32x4 w = *(const f32x4*)(a.in[9] + ((size_t)j * D + kb * 16 + kk) * D + g * 128 + c4);
              LAS float* d = wl + c4 * 16 + kk; d[0] = w[0]; d[16] = w[1]; d[32] = w[2]; d[48] = w[3]; }
            __syncthreads();
            const int cl = f_tid & 255, m = cl >> 1, part = cl & 1, kh = f_tid >> 8; const LAS float* tw = part ? ts : tc;
            float accv[8];
#pragma unroll
            for (int q = 0; q < 8; ++q) accv[q] = 0.f;
            for (int jj = 0; jj < 128; ++jj) { const float t = tw[(m * jj) & 127]; const f32x4 wa = *(const LAS f32x4*)(wl + jj * 16 + kh * 8), wb = *(const LAS f32x4*)(wl + jj * 16 + kh * 8 + 4);
                accv[0] += wa[0] * t; accv[1] += wa[1] * t; accv[2] += wa[2] * t; accv[3] += wa[3] * t; accv[4] += wb[0] * t; accv[5] += wb[1] * t; accv[6] += wb[2] * t; accv[7] += wb[3] * t; }
            v4u o; o.x = pk2(accv[0], accv[1]); o.y = pk2(accv[2], accv[3]); o.z = pk2(accv[4], accv[5]); o.w = pk2(accv[6], accv[7]);
            *(v4u*)((bf16*)(ws + WS_WFIN) + ((size_t)j * 2048 + g * 256 + cl) * D + kb * 16 + kh * 8) = o;
        }
        __syncthreads();
    }
    {
        LAS float* S = (LAS float*)F.lds;
        LAS float* red = S + 9 * 1024;
        for (int i = f_tid; i < 9 * 1024; i += 512) { const int r = i >> 10, k = i & 1023; const float v = (r < 8) ? a.in[1][r * D + k] : a.in[3][k]; S[i] = v / (1.f + __expf(-v)); }
        __syncthreads();
        for (int it = blockIdx.x; it < DEPTH * 96; it += F.G) { const int l = it / 96, n0 = (it % 96) * 64;
            const float* wp = a.in[4] + ((size_t)l * D + F.wave * 128) * (NMOD * D) + n0 + f_lane;
            float accv[9];
#pragma unroll
            for (int r = 0; r < 9; ++r) accv[r] = 0.f;
            for (int k0 = 0; k0 < 128; k0 += 32) { float wv[32];
#pragma unroll
                for (int k = 0; k < 32; ++k) wv[k] = wp[(size_t)(k0 + k) * (NMOD * D)];
#pragma unroll
                for (int k = 0; k < 32; ++k)
#pragma unroll
                    for (int r = 0; r < 9; ++r) accv[r] += S[r * 1024 + F.wave * 128 + k0 + k] * wv[k]; }
#pragma unroll
            for (int r = 0; r < 9; ++r) red[(F.wave * 9 + r) * 64 + f_lane] = accv[r];
            __syncthreads();
            for (int i = f_tid; i < 9 * 64; i += 512) { const int r = i >> 6, ln = i & 63; float s = a.in[5][(size_t)l * (NMOD * D) + n0 + ln];
#pragma unroll
                for (int w = 0; w < 8; ++w) s += red[(w * 9 + r) * 64 + ln];
                ((float*)(ws + WS_MOD))[((size_t)l * 9 + r) * (NMOD * D) + n0 + ln] = s; }
            __syncthreads();
        }
    }
}

__device__ __forceinline__ void load_row(const float* p, int lane, f32x4 (&v)[4]) {
#pragma unroll
    for (int j = 0; j < 4; ++j) v[j] = ((const f32x4*)p)[lane + 64 * j];
}
__device__ __forceinline__ void load_row_bf(const bf16* p, int lane, f32x4 (&v)[4]) {
#pragma unroll
    for (int j = 0; j < 4; ++j) { const v2u w = ((const v2u*)p)[lane + 64 * j]; v[j] = (f32x4){bf_lo(w.x), bf_hi(w.x), bf_lo(w.y), bf_hi(w.y)}; }
}
__device__ __forceinline__ void norm_mod(f32x4 (&v)[4], const float* g, const float* shift, const float* scale, int lane) {
    float s = 0.f;
#pragma unroll
    for (int j = 0; j < 4; ++j) s += (v[j][0] * v[j][0] + v[j][1] * v[j][1]) + (v[j][2] * v[j][2] + v[j][3] * v[j][3]);
    const float rstd = rsqrtf(wave_sum(s, lane) * (1.f / D) + EPS);
#pragma unroll
    for (int j = 0; j < 4; ++j) { const f32x4 gv = ((const f32x4*)g)[lane + 64 * j], sh = ((const f32x4*)shift)[lane + 64 * j], sc = ((const f32x4*)scale)[lane + 64 * j];
        v[j] = (v[j] * rstd * gv) * (sc + 1.f) + sh; }
}
__device__ __forceinline__ void store_row_bf16(bf16* p, int lane, const f32x4 (&v)[4]) {
#pragma unroll
    for (int j = 0; j < 4; ++j) { v2u w; w.x = pk2(v[j][0], v[j][1]); w.y = pk2(v[j][2], v[j][3]); ((v2u*)p)[lane + 64 * j] = w; }
}

__device__ __forceinline__ float store_row_i8(unsigned char* p, int lane, const f32x4 (&v)[4]) {
    float am = 0.f;
#pragma unroll
    for (int j = 0; j < 4; ++j) am = fmaxf(fmaxf(am, fmaxf(fabsf(v[j][0]), fabsf(v[j][1]))), fmaxf(fabsf(v[j][2]), fabsf(v[j][3])));
    unsigned k = __float_as_uint(am);
    { unsigned t;
      t = (unsigned)__builtin_amdgcn_mov_dpp((int)k, 0xb1, 0xf, 0xf, false); k = k > t ? k : t;
      t = (unsigned)__builtin_amdgcn_mov_dpp((int)k, 0x4e, 0xf, 0xf, false); k = k > t ? k : t;
      t = (unsigned)__builtin_amdgcn_mov_dpp((int)k, 0x124, 0xf, 0xf, false); k = k > t ? k : t;
      t = (unsigned)__builtin_amdgcn_mov_dpp((int)k, 0x128, 0xf, 0xf, false); k = k > t ? k : t;
      const unsigned a = (unsigned)__builtin_amdgcn_readlane((int)k, 0), b = (unsigned)__builtin_amdgcn_readlane((int)k, 16), c = (unsigned)__builtin_amdgcn_readlane((int)k, 32), d = (unsigned)__builtin_amdgcn_readlane((int)k, 48);
      const unsigned ab = a > b ? a : b, cd = c > d ? c : d; k = ab > cd ? ab : cd; }
    const float amax = __uint_as_float(k);
    const float qscale = amax > 0.f ? amax * (1.f / 127.f) : 1.f, qinv = amax > 0.f ? 127.f / amax : 0.f;
#pragma unroll
    for (int j = 0; j < 4; ++j) { unsigned w = 0;
#pragma unroll
        for (int q = 0; q < 4; ++q) { int qi = __float2int_rn(v[j][q] * qinv); qi = qi > 127 ? 127 : (qi < -127 ? -127 : qi); w |= ((unsigned)qi & 255u) << (8 * q); }
        ((unsigned*)p)[lane + 64 * j] = w; }
    return qscale;
}
__device__ __forceinline__ void quant_rows(Frame& F, const bf16* src, unsigned char* dst, float* scale, int R) {
    const int f_lane = lthread(F.wave) & 63;
    for (int r = F.gw; r < R; r += F.NGW) { f32x4 v[4]; load_row_bf(src + (size_t)r * 1024, f_lane, v);
        const float sc = store_row_i8(dst + (size_t)r * 1024, f_lane, v); if (f_lane == 0) scale[r] = sc; }
}
__device__ __forceinline__ void rp_norm1(Frame& F, const Args& a, int l, int row_lo) {
    const int f_tid = lthread(F.wave), f_lane = f_tid & 63;
    const bf16* X = (const bf16*)(F.ws + WS_X); bf16* H = (bf16*)(F.ws + WS_H); const float* MOD = (const float*)(F.ws + WS_MOD) + (size_t)l * 9 * (NMOD * D);
    for (int row = row_lo + F.gw; row < NT; row += F.NGW) { f32x4 v[4];
        if (l == 0) load_row(row < NC ? a.in[2] + (size_t)row * D : a.in[0] + (size_t)(row - NC) * D, f_lane, v);
        else load_row_bf(X + (size_t)row * D, f_lane, v);
        const float* m = MOD + (size_t)modrow_of(row) * (NMOD * D);
        norm_mod(v, a.in[6] + (size_t)l * D, m, m + D, f_lane);
        const float sc = store_row_i8((unsigned char*)H + (size_t)row * D, f_lane, v); if (f_lane == 0) ((float*)(F.ws + WS_SH))[row] = sc; }
}

#if MK_N2V2
constexpr int LDS_LIST = LDS_MISC + 768;
__device__ __forceinline__ unsigned row16_max(unsigned k) {
    unsigned t;
    t = (unsigned)__builtin_amdgcn_mov_dpp((int)k, 0xb1, 0xf, 0xf, false); k = k > t ? k : t;
    t = (unsigned)__builtin_amdgcn_mov_dpp((int)k, 0x4e, 0xf, 0xf, false); k = k > t ? k : t;
    t = (unsigned)__builtin_amdgcn_mov_dpp((int)k, 0x124, 0xf, 0xf, false); k = k > t ? k : t;
    t = (unsigned)__builtin_amdgcn_mov_dpp((int)k, 0x128, 0xf, 0xf, false); k = k > t ? k : t;
    return k;
}
__device__ __forceinline__ unsigned wave_max_u(unsigned k) {
    k = row16_max(k);
    const unsigned a = (unsigned)__builtin_amdgcn_readlane((int)k, 0), b = (unsigned)__builtin_amdgcn_readlane((int)k, 16), c = (unsigned)__builtin_amdgcn_readlane((int)k, 32), d = (unsigned)__builtin_amdgcn_readlane((int)k, 48);
    const unsigned ab = a > b ? a : b, cd = c > d ? c : d; return ab > cd ? ab : cd;
}
__device__ __forceinline__ float key_val(unsigned m) { const unsigned u = m & ~31u; return __builtin_bit_cast(float, (u & 0x80000000u) ? (u ^ 0x80000000u) : ~u); }
__device__ __forceinline__ void rp_norm2_router(Frame& F, const Args& a, int l, int row_lo) {
    const int f_tid = lthread(F.wave), f_lane = f_tid & 63;
    const bf16* X = (const bf16*)(F.ws + WS_X); bf16* H = (bf16*)(F.ws + WS_H); const float* MOD = (const float*)(F.ws + WS_MOD) + (size_t)l * 9 * (NMOD * D);
    LAS float* wt = (LAS float*)F.lds;
    { const f32x4* src = (const f32x4*)((const float*)(F.ws + WS_WRT) + (size_t)l * NE * D); f32x4 tv[16];
#pragma unroll
      for (int i = 0; i < 16; ++i) tv[i] = src[f_tid + 512 * i];
#pragma unroll
      for (int i = 0; i < 16; ++i) ((LAS f32x4*)wt)[f_tid + 512 * i] = tv[i]; }
    LAS int* lcnt = (LAS int*)(F.lds + LDS_TT); LAS int* lbase = lcnt + 32;
    LAS v4u* list = (LAS v4u*)(F.lds + LDS_LIST) + F.wave * 68;
    LAS float* lsc = (LAS float*)(F.lds + LDS_LIST + 8 * 68 * 16) + F.wave * 68;
    if (f_tid < 32) lcnt[f_tid] = 0;
    __syncthreads();
    const float* gf = a.in[7] + (size_t)l * D;
    f32x4 gv[4];
#pragma unroll
    for (int j = 0; j < 4; ++j) gv[j] = ((const f32x4*)gf)[f_lane + 64 * j];
    const int my_e = f_lane >> 1;
    const float my_b = a.in[22][(size_t)l * NE + my_e];
    int row = row_lo + F.gw, it = 0;
    f32x4 vn[4];
    if (row < NT) load_row_bf(X + (size_t)row * D, f_lane, vn);
    for (; row < NT; row += F.NGW, ++it) {
        f32x4 v[4], sh[4], sc[4];
        const float* m = MOD + (size_t)modrow_of(row) * (NMOD * D);
#pragma unroll
        for (int j = 0; j < 4; ++j) { sh[j] = ((const f32x4*)(m + 3 * D))[f_lane + 64 * j]; sc[j] = ((const f32x4*)(m + 4 * D))[f_lane + 64 * j]; }
        asm volatile("" ::: "memory");
#pragma unroll
        for (int j = 0; j < 4; ++j) v[j] = vn[j];
        { const int nrow = row + F.NGW; if (nrow < NT) load_row_bf(X + (size_t)nrow * D, f_lane, vn); }
        float ssq = 0.f;
#pragma unroll
        for (int j = 0; j < 4; ++j) ssq += (v[j][0] * v[j][0] + v[j][1] * v[j][1]) + (v[j][2] * v[j][2] + v[j][3] * v[j][3]);
        const float rstd = rsqrtf(wave_sum(ssq, f_lane) * (1.f / D) + EPS);
#pragma unroll
        for (int j = 0; j < 4; ++j) v[j] = (v[j] * rstd * gv[j]) * (sc[j] + 1.f) + sh[j];
        const float qscale = store_row_i8((unsigned char*)H + (size_t)row * D, f_lane, v);
        float p[32];
#pragma unroll
        for (int e = 0; e < 32; ++e) { f32x2 s2 = (f32x2){0.f, 0.f};
#pragma unroll
            for (int j = 0; j < 4; ++j) { const f32x4 w = ((const LAS f32x4*)(wt + e * 1024))[f_lane + 64 * j];
                s2 = __builtin_elementwise_fma((f32x2){v[j][0], v[j][1]}, (f32x2){w[0], w[1]}, s2); s2 = __builtin_elementwise_fma((f32x2){v[j][2], v[j][3]}, (f32x2){w[2], w[3]}, s2); }
            p[e] = s2[0] + s2[1]; }
#pragma unroll
        for (int s = 0; s < 5; ++s) { const int half = 16 >> s, msk = 32 >> s; const bool up = (f_lane & msk) != 0;
#pragma unroll
            for (int i = 0; i < half; ++i) { const float keep = up ? p[i + half] : p[i], send = up ? p[i] : p[i + half]; p[i] = keep + shx(send, msk, f_lane); } }
        const float lgt = p[0] + shx(p[0], 1, f_lane) + my_b;
        unsigned key; { const unsigned u = __builtin_bit_cast(unsigned, lgt); const unsigned o = (u & 0x80000000u) ? ~u : (u | 0x80000000u); key = (o & ~31u) | (unsigned)(31 - my_e); }
        unsigned mk[4];
#pragma unroll
        for (int k = 0; k < 4; ++k) { mk[k] = wave_max_u(key); key = (key == mk[k]) ? 0u : key; }
        const float b0 = key_val(mk[0]);
        const float e1 = __expf(key_val(mk[1]) - b0), e2 = __expf(key_val(mk[2]) - b0), e3 = __expf(key_val(mk[3]) - b0); const float inv = 1.f / (1.f + e1 + e2 + e3);
        if (f_lane < 4) { const unsigned mm = f_lane == 0 ? mk[0] : f_lane == 1 ? mk[1] : f_lane == 2 ? mk[2] : mk[3]; const int me = 31 - (int)(mm & 31u);
            const float mw = (f_lane == 0 ? 1.f : f_lane == 1 ? e1 : f_lane == 2 ? e2 : e3) * inv;
            const int lr = __hip_atomic_fetch_add(lcnt + me, 1, __ATOMIC_RELAXED, __HIP_MEMORY_SCOPE_WORKGROUP);
            LAS unsigned* ep = (LAS unsigned*)(list + it * 4 + f_lane); ep[0] = (unsigned)(row * 4 + f_lane); ep[1] = (unsigned)me; ep[2] = (unsigned)lr; ep[3] = __builtin_bit_cast(unsigned, mw);
            lsc[it * 4 + f_lane] = qscale; }
    }
    __syncthreads();
    if (f_tid < 32) { const int c = lcnt[f_tid]; lbase[f_tid] = c ? (int)__hip_atomic_fetch_add((unsigned*)(F.ctl + CW_CNT + (l * 32 + f_tid) * 16), (unsigned)c, RLX_AGENT) : 0; }
    __syncthreads();
    int* te = (int*)(F.ws + WS_TE); int* trank = (int*)(F.ws + WS_TRANK); int* stok = (int*)(F.ws + WS_STOK); float* sw = (float*)(F.ws + WS_SW); float* ssc = (float*)(F.ws + WS_SSC);
    for (int i = f_lane; i < it * 4; i += 64) { const LAS unsigned* ep = (const LAS unsigned*)(list + i); const unsigned rowk = ep[0], ex = ep[1], lr = ep[2]; const float wv = __builtin_bit_cast(float, ep[3]);
        const int rk = lbase[ex] + (int)lr;
        stok[(size_t)ex * CAP + rk] = (int)(rowk >> 2); sw[(size_t)ex * CAP + rk] = wv; ssc[(size_t)ex * CAP + rk] = lsc[i]; te[rowk] = (int)ex; trank[rowk] = rk; }
}

#endif
__device__ __forceinline__ void moe_table(Frame& F, int l) {
    const int f_tid = lthread(F.wave), f_lane = f_tid & 63;
    LAS int* TT = (LAS int*)(F.lds + LDS_TT); LAS int* CN = TT + 64; LAS int* TE = (LAS int*)(F.lds + LDS_TE);
    __syncthreads();
    if (f_tid < 64) {
        const int c = (f_lane < 32) ? (int)__hip_atomic_load((unsigned*)(F.ctl + CW_CNT + (l * 32 + (f_lane & 31)) * 16), RLX_AGENT) : 0;
        const int tl = (c + 255) >> 8; int v = tl;
#pragma unroll
        for (int o = 1; o < 32; o <<= 1) { const int n = __builtin_amdgcn_ds_bpermute((f_lane >= o ? f_lane - o : f_lane) << 2, v); if (f_lane >= o) v += n; }
        if (f_lane < 32) { CN[f_lane] = c; TT[f_lane] = v - tl; if (f_lane == 31) TT[32] = v; }
    }
    __syncthreads();
    for (int t = f_tid; t < MAXTILES; t += 512) { int lo = 0, hi = 32;
#pragma unroll
        for (int k = 0; k < 5; ++k) { const int mid = (lo + hi) >> 1; if (TT[mid] <= t) lo = mid; else hi = mid; }
        TE[t] = lo; }
    __syncthreads();
}

#if MK_CBV2
struct CombRow { v2u x[4]; unsigned y[4][4]; };
__device__ __forceinline__ void comb_issue(CombRow& R, const bf16* X, const unsigned char* Y, const LAS int* TT, int row, const v4u te4, const v4u tr4, int lane) {
    const unsigned ee[4] = {te4[0], te4[1], te4[2], te4[3]}, rr[4] = {tr4[0], tr4[1], tr4[2], tr4[3]};
#pragma unroll
    for (int k = 0; k < 4; ++k) { const size_t slot = (size_t)TT[ee[k]] * 256 + rr[k]; const unsigned* yp = (const unsigned*)(Y + slot * 1024);
#pragma unroll
        for (int j = 0; j < 4; ++j) R.y[k][j] = yp[lane + 64 * j]; }
#pragma unroll
    for (int j = 0; j < 4; ++j) R.x[j] = ((const v2u*)(X + (size_t)row * D))[lane + 64 * j];
}
__device__ __forceinline__ void comb_finish(const CombRow& R, Frame& F, const Args& a, int l, int row, int lane, const float* MOD, const float* MODN, bool lastl) {
    bf16* X = (bf16*)(F.ws + WS_X); bf16* H = (bf16*)(F.ws + WS_H);
    const int mr = modrow_of(row); const float* g5 = MOD + (size_t)mr * (NMOD * D) + 5 * D;
    f32x4 v[4];
#pragma unroll
    for (int j = 0; j < 4; ++j) { f32x4 s = (f32x4){0.f, 0.f, 0.f, 0.f};
#pragma unroll
        for (int k = 0; k < 4; ++k) { const int w = (int)R.y[k][j]; const f32x2 lo = __builtin_amdgcn_cvt_pk_f32_fp8(w, false), hi = __builtin_amdgcn_cvt_pk_f32_fp8(w, true); s[0] += lo[0]; s[1] += lo[1]; s[2] += hi[0]; s[3] += hi[1]; }
        s = s * 0.125f;
        const f32x4 gv = ((const f32x4*)g5)[lane + 64 * j]; const v2u xw = R.x[j]; v[j] = (f32x4){bf_lo(xw.x), bf_hi(xw.x), bf_lo(xw.y), bf_hi(xw.y)} + gv * s; }
    if (!lastl) {
        store_row_bf16(X + (size_t)row * D, lane, v);
        const float* m = MODN + (size_t)mr * (NMOD * D);
        norm_mod(v, a.in[6] + (size_t)(l + 1) * D, m, m + D, lane);
        const float sc = store_row_i8((unsigned char*)H + (size_t)row * D, lane, v); if (lane == 0) ((float*)(F.ws + WS_SH))[row] = sc;
    } else {
        float ss = 0.f;
#pragma unroll
        for (int j = 0; j < 4; ++j) ss += (v[j][0] * v[j][0] + v[j][1] * v[j][1]) + (v[j][2] * v[j][2] + v[j][3] * v[j][3]);
        const float rstd = rsqrtf(wave_sum(ss, lane) * (1.f / D) + EPS);
        float* op = a.out + (size_t)(row - NC) * D;
#pragma unroll
        for (int j = 0; j < 4; ++j) { const f32x4 gv = ((const f32x4*)a.in[8])[lane + 64 * j]; ((f32x4*)op)[lane + 64 * j] = v[j] * rstd * gv; }
    }
}
__device__ __forceinline__ void rp_combine(Frame& F, const Args& a, int l, int row_lo) {
    const int f_tid = lthread(F.wave), f_lane = f_tid & 63;
    const bf16* X = (const bf16*)(F.ws + WS_X); const unsigned char* Y = (const unsigned char*)(F.ws + WS_Y);
    const float* MOD = (const float*)(F.ws + WS_MOD) + (size_t)l * 9 * (NMOD * D); const float* MODN = MOD + 9 * (NMOD * D);
    const v4u* te = (const v4u*)(F.ws + WS_TE); const v4u* trank = (const v4u*)(F.ws + WS_TRANK);
    const LAS int* TT = (const LAS int*)(F.lds + LDS_TT);
    const bool lastl = (l == DEPTH - 1);
    const int st = F.NGW;
    int row = row_lo + F.gw;
    if (row >= NT) return;
    CombRow RA, RB;
    v4u te1 = te[row], tr1 = trank[row];
    comb_issue(RA, X, Y, TT, row, te1, tr1, f_lane);
    if (row + st < NT) { te1 = te[row + st]; tr1 = trank[row + st]; }
    for (;;) {
        const bool h1 = row + st < NT;
        if (h1) comb_issue(RB, X, Y, TT, row + st, te1, tr1, f_lane);
        if (row + 2 * st < NT) { te1 = te[row + 2 * st]; tr1 = trank[row + 2 * st]; }
        comb_finish(RA, F, a, l, row, f_lane, MOD, MODN, lastl);
        if (!h1) break;
        row += st;
        const bool h2 = row + st < NT;
        if (h2) comb_issue(RA, X, Y, TT, row + st, te1, tr1, f_lane);
        if (row + 2 * st < NT) { te1 = te[row + 2 * st]; tr1 = trank[row + 2 * st]; }
        comb_finish(RB, F, a, l, row, f_lane, MOD, MODN, lastl);
        if (!h2) break;
        row += st;
    }
}

#endif
__device__ __forceinline__ void rp_mla(Frame& F, const Args& a) {
    const int f_tid = lthread(F.wave), f_lane = f_tid & 63;
    const bf16* A = (const bf16*)(F.ws + WS_RE); bf16* QA = (bf16*)(F.ws + WS_RF); bf16* CKV = (bf16*)(F.ws + WS_RG); bf16* Kb = (bf16*)(F.ws + WS_RB);
    const float* rope = (const float*)(F.ws + WS_ROPE); const float* gq = a.in[12]; const float* gk = a.in[14];
    for (int row = F.gw; row < NT; row += F.NGW) {
        const unsigned* ap = (const unsigned*)(A + (size_t)row * MLA_IN_PAD);
        unsigned q[3], c[2];
#pragma unroll
        for (int j = 0; j < 3; ++j) q[j] = ap[f_lane + 64 * j];
#pragma unroll
        for (int j = 0; j < 2; ++j) c[j] = ap[192 + f_lane + 64 * j];
        const unsigned pe = ap[320 + (f_lane & 15)];
        float sq = 0.f, sc = 0.f;
#pragma unroll
        for (int j = 0; j < 3; ++j) { const float x0 = bf_lo(q[j]), x1 = bf_hi(q[j]); sq += x0 * x0 + x1 * x1; }
#pragma unroll
        for (int j = 0; j < 2; ++j) { const float x0 = bf_lo(c[j]), x1 = bf_hi(c[j]); sc += x0 * x0 + x1 * x1; }
        const float rq = rsqrtf(wave_sum(sq, f_lane) * (1.f / MLA_QL) + EPS), rc = rsqrtf(wave_sum(sc, f_lane) * (1.f / MLA_KVL) + EPS);
#pragma unroll
        for (int j = 0; j < 3; ++j) { const int e0 = 2 * (f_lane + 64 * j); ((unsigned*)(QA + (size_t)row * MLA_QL))[f_lane + 64 * j] = pk2(bf_lo(q[j]) * rq * gq[e0], bf_hi(q[j]) * rq * gq[e0 + 1]); }
#pragma unroll
        for (int j = 0; j < 2; ++j) { const int e0 = 2 * (f_lane + 64 * j); ((unsigned*)(CKV + (size_t)row * MLA_KVL))[f_lane + 64 * j] = pk2(bf_lo(c[j]) * rc * gk[e0], bf_hi(c[j]) * rc * gk[e0 + 1]); }
        float x0 = bf_lo(pe), x1 = bf_hi(pe);
        if (row >= NC) { const int t = (row - NC) & 4095, i = f_lane & 15, d = 2 * i, pos = (d & 16) ? (t & 63) : (t >> 6), f = d & 7;
            const float p0 = shx(x0, 4, f_lane), p1 = shx(x1, 4, f_lane); const float sg = (d & 8) ? 1.f : -1.f;
            const float* rp = rope + (size_t)pos * 16 + 2 * f; x0 = x0 * rp[0] + sg * p0 * rp[1]; x1 = x1 * rp[2] + sg * p1 * rp[3]; }
        const unsigned w = pk2(x0, x1);
        { const int i = f_lane & 15, hb = f_lane >> 4;
#pragma unroll
          for (int hh = 0; hh < 4; ++hh) { const int h = hb * 4 + hh; ((unsigned*)(Kb + (size_t)row * 1536 + 96 * h + 64))[i] = w; } }
    }
}

__device__ __forceinline__ void rp_gqa(Frame& F, const Args& a) {
    const int f_tid = lthread(F.wave), f_lane = f_tid & 63;
    const bf16* A = (const bf16*)(F.ws + WS_RA); bf16* Q = (bf16*)(F.ws + WS_RB); bf16* Kb = Q + (size_t)NT * 1024;
    const float* rope = (const float*)(F.ws + WS_ROPE) + 2048; const float* gq = a.in[18]; const float* gk = a.in[19];
    const float c2 = 0.125f * LOG2E;
    for (int row = F.gw; row < NT; row += F.NGW) {
        const bool lat = row >= NC; const int t = (row - NC) & 4095;
#pragma unroll
        for (int part = 0; part < 2; ++part) {
            const int ln = part ? (f_lane & 15) : f_lane; const bf16* src = A + (size_t)row * GQA_QKV + (part ? 1024 : 0) + ln * 16;
            const v4u w0 = *(const v4u*)src, w1 = *(const v4u*)(src + 8);
            float x[16]; const unsigned ww[8] = {w0.x, w0.y, w0.z, w0.w, w1.x, w1.y, w1.z, w1.w};
#pragma unroll
            for (int i = 0; i < 8; ++i) { x[2 * i] = bf_lo(ww[i]); x[2 * i + 1] = bf_hi(ww[i]); }
            float ss = 0.f;
#pragma unroll
            for (int i = 0; i < 16; ++i) ss += x[i] * x[i];
            ss += shx(ss, 1, f_lane); ss += shx(ss, 2, f_lane);
            const float rs = rsqrtf(ss * (1.f / 64.f) + EPS); const float* g = (part ? gk : gq) + (ln & 3) * 16;
#pragma unroll
            for (int i = 0; i < 16; ++i) x[i] = x[i] * rs * g[i];
            if (lat) { const int sec = (ln >> 1) & 1, pos = sec ? (t & 63) : (t >> 6); const float sg = (ln & 1) ? 1.f : -1.f; const float* rp = rope + (size_t)pos * 32;
#pragma unroll
                for (int i = 0; i < 16; ++i) { const float pr = shx(x[i], 1, f_lane); x[i] = x[i] * rp[2 * i] + sg * pr * rp[2 * i + 1]; } }
            const float scl = part ? 1.f : c2;
            v4u o0, o1; o0.x = pk2(x[0] * scl, x[1] * scl); o0.y = pk2(x[2] * scl, x[3] * scl); o0.z = pk2(x[4] * scl, x[5] * scl); o0.w = pk2(x[6] * scl, x[7] * scl);
            o1.x = pk2(x[8] * scl, x[9] * scl); o1.y = pk2(x[10] * scl, x[11] * scl); o1.z = pk2(x[12] * scl, x[13] * scl); o1.w = pk2(x[14] * scl, x[15] * scl);
            if (part == 0) { bf16* d = Q + (size_t)row * 1024 + ln * 16; *(v4u*)d = o0; *(v4u*)(d + 8) = o1; }
            else if (f_lane < 16) { bf16* d = Kb + (size_t)row * 256 + ln * 16; *(v4u*)d = o0; *(v4u*)(d + 8) = o1; }
        }
    }
}

template <int DK>
__device__ __forceinline__ void attn_phase(Frame& F, const att::Tens& T, int kvshift  , int kstride, int vstride, int vbase) {
    const int vcu = (F.G % 8 == 0) ? (blockIdx.x % 8) * (F.G / 8) + blockIdx.x / 8 : blockIdx.x;
    if constexpr (DK == 64) {
        for (int u = vcu; u < 2048 + 128; u += F.G) {
            if (u < 2048) { const int b = u >> 8, h = (u >> 4) & 15, qb = u & 15, kvh = h >> kvshift;
                att64::attn_unit<8>(T.Q, T.qpitch, NC + b * SEQ + qb * 256, h * 64, T.K, T.kpitch, kvh * kstride, T.V, T.vpitch, vbase + kvh * vstride, T.O, h * 64, b * LCTX, NC + b * SEQ, 68, (char*)F.lds, F.wave); }
            else { const int q = u - 2048, b = q >> 4, h = q & 15, kvh = h >> kvshift;
                att64::attn_unit<8>(T.Q, T.qpitch, b * LCTX, h * 64, T.K, T.kpitch, kvh * kstride, T.V, T.vpitch, vbase + kvh * vstride, T.O, h * 64, b * LCTX, 0, 4, (char*)F.lds, F.wave); }
        }
        __syncthreads();
    } else {
        att::Pend pend; pend.valid = false; pend.o0 = f32x16{}; pend.o1 = f32x16{}; pend.l = 1.f; pend.qrow0 = 0; pend.oc0 = 0;
        for (int u = vcu; u < 2048 + 128; u += F.G) {
            if (u < 2048) { const int b = u >> 8, h = (u >> 4) & 15, qb = u & 15, kvh = h >> kvshift;
                att::unit<DK>(T, NC + b * SEQ + qb * 256, h * DK, kvh * kstride, vbase + kvh * vstride, h * 64, b * LCTX, NC + b * SEQ, 68, F.lds, F.wave, pend); }
            else { const int q = u - 2048, b = q >> 4, h = q & 15, kvh = h >> kvshift;
                att::unit<DK>(T, b * LCTX, h * DK, kvh * kstride, vbase + kvh * vstride, h * 64, b * LCTX, 0, 4, F.lds, F.wave, pend); }
        }
        if (pend.valid) att::finish_unit(pend, T.O, F.lds, F.wave, lthread(F.wave) & 63);
        __syncthreads();
    }
}

constexpr int PH_PER_LAYER = 9, PH_TOTAL = 2 + DEPTH * PH_PER_LAYER;
__global__ void __launch_bounds__(512, 2) mk_fwd(Args args) {
    extern __shared__ __attribute__((aligned(16))) unsigned char lds_raw[];
    Frame F;
    F.lds = (LAS unsigned char*)lds_raw; F.ws = args.ws; F.ctl = (gu32*)(args.ws + WS_CTL);
    F.wave = __builtin_amdgcn_readfirstlane(threadIdx.x >> 6); F.G = gridDim.x;
    F.gw = blockIdx.x * 8 + F.wave; F.NGW = F.G * 8;
    if (threadIdx.x < 4) ((LAS unsigned*)(F.lds + LDS_XB))[threadIdx.x] = 0u;
    __syncthreads();
    const int lo = args.ph_lo, hi = args.ph_hi;
    const bool multi = (hi - lo) > 1;
    XcdBarrier bar; bar.bar = (unsigned*)(F.ctl + CW_BAR); bar.x = 0; bar.st = nullptr; bar.wave = F.wave;
    if (multi) bar = xcd_barrier_post((unsigned*)(F.ctl + CW_BAR), (volatile LAS unsigned*)(F.lds + LDS_XB), F.wave);
#define IN(k) (lo <= (k) && (k) < hi)
#define SEAM(k) do { if (IN(k) && IN((k) + 1)) xcd_barrier(bar); } while (0)
    unsigned char* ws0 = args.ws;
#define PH_WS size_t zofs_ = 0; asm volatile("" : "+s"(zofs_)); unsigned char* ws = ws0 + zofs_; F.ws = ws; F.ctl = (gu32*)ws;
    const int G = F.G, cidx = (int)blockIdx.x;

    if (IN(0) && EN(0)) { PH_WS REP(0) { prologue(F, args); SEAM(0); } }
    if (IN(1) && EN(1)) { PH_WS rp_norm1(F, args, 0, 0);
        quant_rows(F, (const bf16*)(ws + WS_WFIN), (unsigned char*)(ws + WS_W8), (float*)(ws + WS_SWP), 2 * 2048);
        quant_rows(F, (const bf16*)(ws + WS_WMIN), (unsigned char*)(ws + WS_W8) + 4 * MiB, (float*)(ws + WS_SWP) + 4096, MLA_IN_PAD);
        quant_rows(F, (const bf16*)(ws + WS_WGQKV), (unsigned char*)(ws + WS_W8) + 5 * MiB, (float*)(ws + WS_SWP) + 4864, GQA_QKV); SEAM(1); }

    for (int l = 0; l < DEPTH; ++l) {
        const int kind = l % 3, j = l / 3, base = 2 + l * PH_PER_LAYER;
        const bool lastl = (l == DEPTH - 1);

        size_t outB = 0;
        if (kind == 0) {
            if (IN(base + 0) && EN(2)) { PH_WS REP(2) { PolFP p; p.A = (const char*)(ws + WS_W8) + (size_t)j * 2048 * D; p.B = (const char*)(ws + WS_H); p.nt = 8; p.sW = (const float*)(ws + WS_SWP) + j * 2048; p.sH = (const float*)(ws + WS_SH); p.nN = lastl ? 128 : 136; p.G = G; p.c = cidx;
                p.Z = (bf16*)(ws + WS_RA); p.Zc = (bf16*)(ws + WS_RH); pg8::gemm_phase(F.lds, p, F.wave); } }
            SEAM(base + 0);
            if (IN(base + 1) && EN(3)) { PH_WS REP(3) { PolFA p; p.A = (const char*)(ws + WS_MA); p.B = (const char*)(ws + WS_RA); p.nt = 4; p.G = G; p.c = cidx; p.Y = (bf16*)(ws + WS_RB); pg8::gemm_phase(F.lds, p, F.wave); } }
            SEAM(base + 1);
            if (IN(base + 2) && EN(4)) { PH_WS REP(4) { PolFC p; p.A = (const char*)(ws + WS_DC); p.B = (const char*)(ws + WS_RB); p.nt = 8; p.G = G; p.c = cidx; p.nunits = lastl ? 512 : 544;
                p.offMC = (unsigned)(WS_MC - WS_DC); p.offZc = (unsigned)(WS_RH - WS_RB); p.F = (bf16*)(ws + WS_RC); pg8::gemm_phase(F.lds, p, F.wave); } }
            SEAM(base + 2);
            outB = WS_WFOUT + (size_t)j * D * D * 2;
        } else if (kind == 1) {
            if (IN(base + 0) && EN(5)) { PH_WS REP(5) { PolDenseI8 p; p.A = (const char*)(ws + WS_H); p.B = (const char*)(ws + WS_W8) + 4 * MiB; p.nt = 8; p.nM = NT / 256; p.nN = 3; p.pm0 = 0; p.G = G; p.c = cidx; p.sA = (const float*)(ws + WS_SH); p.sB = (const float*)(ws + WS_SWP) + 4096;
                p.O = (bf16*)(ws + WS_RE); p.ldo = MLA_IN_PAD; pg8::gemm_phase(F.lds, p, F.wave); } }
            SEAM(base + 0);
            if (IN(base + 1) && EN(6)) { PH_WS REP(6) { rp_mla(F, args); } }
            SEAM(base + 1);
            if (IN(base + 2)) { PH_WS REP(7) {
                if (EN(7)) { PolMlaQ p; p.A = (const char*)(ws + WS_RF); p.B = (const char*)(ws + WS_WMQB); p.nt = 6; p.nM = NT / 256; p.nN = 6; p.G = G; p.c = cidx; p.Q = (bf16*)(ws + WS_RA);
                  p.rope = (const float*)(ws + WS_ROPE); p.c2 = 0.10206207261596575f * LOG2E; pg8::gemm_phase(F.lds, p, F.wave); }
                if (EN(8)) { PolMlaKV p; p.A = (const char*)(ws + WS_RG); p.B = (const char*)(ws + WS_WMKVB); p.nt = 4; p.nM = NT / 256; p.nN = 8; p.G = G; p.c = cidx; p.Kb = (bf16*)(ws + WS_RB); p.Vb = (bf16*)(ws + WS_RD);
                  pg8::gemm_phase(F.lds, p, F.wave); }
            } }
            SEAM(base + 2);
            if (IN(base + 3) && EN(9)) { PH_WS REP(9) { att::Tens T{(const bf16*)(ws + WS_RA), 1536, (const bf16*)(ws + WS_RB), 1536, (const bf16*)(ws + WS_RD), 1024, (bf16*)(ws + WS_RC)}; attn_phase<96>(F, T, 0, 96, 64, 0); } }
            SEAM(base + 3);
            outB = WS_WMO;
        } else {
            if (IN(base + 0) && EN(10)) { PH_WS REP(10) { PolDenseI8 p; p.A = (const char*)(ws + WS_H); p.B = (const char*)(ws + WS_W8) + 5 * MiB; p.nt = 8; p.nM = NT / 256; p.nN = 6; p.pm0 = 0; p.G = G; p.c = cidx; p.sA = (const float*)(ws + WS_SH); p.sB = (const float*)(ws + WS_SWP) + 4864;
                p.O = (bf16*)(ws + WS_RA); p.ldo = GQA_QKV; pg8::gemm_phase(F.lds, p, F.wave); } }
            SEAM(base + 0);
            if (IN(base + 1) && EN(11)) { PH_WS REP(11) { rp_gqa(F, args); } }
            SEAM(base + 1);
            if (IN(base + 2) && EN(12)) { PH_WS REP(12) { att::Tens T{(const bf16*)(ws + WS_RB), 1024, (const bf16*)(ws + WS_RB) + (size_t)NT * 1024, 256, (const bf16*)(ws + WS_RA), 1536, (bf16*)(ws + WS_RC)}; attn_phase<64>(F, T, 2, 64, 64, 1280); } }
            SEAM(base + 2);
            outB = WS_WGO;
        }
        if (IN(base + 4) && EN(13)) { PH_WS PolOut p; p.A = (const char*)(ws + WS_RC); p.B = (const char*)(ws + outB); p.nt = 16; p.nM = lastl ? NL / 256 : NT / 256; p.nN = 4; p.pm0 = lastl ? 8 : 0; p.G = G; p.c = cidx; p.X = (bf16*)(ws + WS_X); p.mod = (const float*)(ws + WS_MOD) + (size_t)l * 9 * (NMOD * D); p.chunk = 2;
            p.XinC = (l == 0) ? args.in[2] : nullptr; p.XinL = (l == 0) ? args.in[0] - (size_t)NC * D : nullptr;
            pg8::gemm_phase(F.lds, p, F.wave); }
        SEAM(base + 4);
        if (IN(base + 5) && EN(14)) { PH_WS rp_norm2_router(F, args, l, lastl ? NC : 0); }
        SEAM(base + 5);
        if (IN(base + 6) && EN(15)) { PH_WS REP(15) { moe_table(F, l);
            PolMoe1 p; p.A = (const char*)(ws + WS_H); p.B = (const char*)(ws + WS_WGU) + (size_t)l * NE * 2048 * D; p.nt = 8; p.G = G; p.c = cidx;
            p.swgu = (const float*)(ws + WS_SWGU) + (size_t)l * NE * 2048; p.ssc = (const float*)(ws + WS_SSC);
            p.T.TT = (const LAS int*)(F.lds + LDS_TT); p.T.CN = p.T.TT + 64; p.T.TE = (const LAS int*)(F.lds + LDS_TE); p.stok = (const int*)(ws + WS_STOK); p.bgu = (const float*)(ws + WS_BGU) + (size_t)l * NE * 2048; p.act = (unsigned char*)(ws + WS_ACT);
            pg8::gemm_phase(F.lds, p, F.wave); } }
        SEAM(base + 6);
        if (IN(base + 7) && EN(16)) { PH_WS REP(16) { moe_table(F, l);
            PolMoe2 p; p.A = (const char*)(ws + WS_ACT); p.B = (const char*)(ws + WS_WDN) + (size_t)l * NE * D * DFF; p.nt = 8; p.G = G; p.c = cidx; p.swd = (const float*)(ws + WS_SWDN) + (size_t)l * NE * D;
            p.T.TT = (const LAS int*)(F.lds + LDS_TT); p.T.CN = p.T.TT + 64; p.T.TE = (const LAS int*)(F.lds + LDS_TE); p.sw = (const float*)(ws + WS_SW); p.bdn = args.in[26] + (size_t)l * NE * D; p.Y = (unsigned char*)(ws + WS_Y);
            pg8::gemm_phase(F.lds, p, F.wave); } }
        SEAM(base + 7);
        if (IN(base + 8) && EN(17)) { PH_WS moe_table(F, l); rp_combine(F, args, l, lastl ? NC : 0); }
        SEAM(base + 8);
    }
#undef PH_WS
#undef IN
#undef SEAM
}

extern "C" void kernel_launch(void* const* d_in, const int* in_sizes, int n_in, void* d_out, int out_size, void* d_ws, size_t ws_size, hipStream_t stream) {
    static int grid = 0;
    if (grid == 0) {
        if (n_in != 27 || out_size != NL * D || ws_size < WS_END) { fprintf(stderr, "kernel_launch: unexpected problem (n_in %d, out %d, ws %zu < %zu)\n", n_in, out_size, ws_size, (size_t)WS_END); grid = -1; return; }
        int dev = 0, cus = 0, per_cu = 0;
        if (hipGetDevice(&dev) != hipSuccess || hipDeviceGetAttribute(&cus, hipDeviceAttributeMultiprocessorCount, dev) != hipSuccess) { grid = -1; return; }
        if (hipFuncSetAttribute((const void*)mk_fwd, hipFuncAttributeMaxDynamicSharedMemorySize, LDS_BYTES) != hipSuccess) { fprintf(stderr, "kernel_launch: hipFuncSetAttribute failed\n"); grid = -1; return; }
        if (hipOccupancyMaxActiveBlocksPerMultiprocessor(&per_cu, (const void*)mk_fwd, 512, LDS_BYTES) != hipSuccess || per_cu < 1) fprintf(stderr, "kernel_launch: occupancy query says %d\n", per_cu);
        (void)hipGetLastError();
        grid = cus;
    }
    if (grid < 0) return;
    (void)hipMemsetAsync((char*)d_ws + WS_CTL, 0, CTL_ZERO_BYTES, stream);
    Args a{};
    for (int i = 0; i < 27; ++i) a.in[i] = (const float*)d_in[i];
    a.out = (float*)d_out; a.ws = (unsigned char*)d_ws;
#if MK_PER_PHASE
    for (int ph = 0; ph < PH_TOTAL; ++ph) {
        const int l = (ph - 2) / PH_PER_LAYER, s = (ph - 2) % PH_PER_LAYER, kind = l % 3;
        if (ph >= 2) { if (s == 3 && kind != 1) continue; }
        a.ph_lo = ph; a.ph_hi = ph + 1;
        hipLaunchKernelGGL(mk_fwd, dim3(grid), dim3(512), LDS_BYTES, stream, a);
    }
#else
    a.ph_lo = 0; a.ph_hi = PH_TOTAL;
    hipLaunchKernelGGL(mk_fwd, dim3(grid), dim3(512), LDS_BYTES, stream, a);
#endif
}
```

```cpp
#include <hip/hip_runtime.h>
#include <cstdio>
#include <cstdint>

#ifndef MK_PER_PHASE
#define MK_PER_PHASE 0
#endif
#ifndef MK_N2V2
#define MK_N2V2 1
#endif
#ifndef MK_CBV2
#define MK_CBV2 1
#endif
#ifndef MK_N2AGG
#define MK_N2AGG 1
#endif
#ifndef MK_MASK
#define MK_MASK 0xFFFFFFFFu
#endif
#define EN(id) (((MK_MASK) >> (id)) & 1u)
#ifndef MK_REPMASK
#define MK_REPMASK 0u
#endif
#define REP(id) for (int rep_ = 0; rep_ < ((((MK_REPMASK) >> (id)) & 1u) ? 2 : 1); ++rep_)

constexpr int D = 1024, NB = 8, SEQ = 4096, LCTX = 256, DEPTH = 4;
constexpr int NC = NB * LCTX;
constexpr int NL = NB * SEQ;
constexpr int NT = NC + NL;
constexpr int NMOD = 6, NE = 32, TOPK = 4, DFF = 1024;
constexpr int MLA_QL = 384, MLA_KVL = 256, MLA_ROPE = 32, MLA_NOPE = 64, MLA_V = 64, MLA_IN = 672, MLA_IN_PAD = 768, MLA_QD = 96;
constexpr int GQA_NQ = 1024, GQA_NKV = 256, GQA_QKV = 1536;
constexpr int CAP = NT;
constexpr int MAXTILES = 576;
constexpr float EPS = 1e-6f;
constexpr float LOG2E = 1.4426950408889634f;

constexpr size_t MiB = 1u << 20;
constexpr size_t WS_CTL = 0, CTL_ZERO_BYTES = 96 * 1024;
constexpr size_t WS_MOD = 1 * MiB;
constexpr size_t WS_ROPE = 2 * MiB;
constexpr size_t WS_WRT = 2 * MiB + 65536;
constexpr size_t WS_BGU = 3 * MiB;
constexpr size_t WS_MA = 4 * MiB;
constexpr size_t WS_DC = 4 * MiB + 262144;
constexpr size_t WS_MC = 5 * MiB;
constexpr size_t WS_WFIN = 9 * MiB;
constexpr size_t WS_WFOUT = 17 * MiB;
constexpr size_t WS_WMIN = 21 * MiB;
constexpr size_t WS_WMQB = 23 * MiB;
constexpr size_t WS_WMKVB = 25 * MiB;
constexpr size_t WS_WMO = 26 * MiB;
constexpr size_t WS_WGQKV = 28 * MiB;
constexpr size_t WS_WGO = 31 * MiB;
constexpr size_t WS_TE = 34 * MiB;
constexpr size_t WS_TRANK = 35 * MiB;
constexpr size_t WS_STOK = 36 * MiB;
constexpr size_t WS_SW = 41 * MiB;
constexpr size_t WS_X = 64 * MiB;
constexpr size_t WS_H = 200 * MiB;
constexpr size_t WS_RA = 272 * MiB;
constexpr size_t WS_RB = 400 * MiB;
constexpr size_t WS_RC = 528 * MiB;
constexpr size_t WS_RD = 600 * MiB;
constexpr size_t WS_RE = 672 * MiB;
constexpr size_t WS_RF = 728 * MiB;
constexpr size_t WS_RG = 756 * MiB;
constexpr size_t WS_RH = 776 * MiB;
constexpr size_t WS_ACT = 784 * MiB;
constexpr size_t WS_Y = 1072 * MiB;
constexpr size_t WS_WGU = 1360 * MiB;
constexpr size_t WS_SWGU = 1360 * MiB + 256 * MiB;
constexpr size_t WS_SH = 1360 * MiB + 259 * MiB;
constexpr size_t WS_SWP = 1360 * MiB + 259 * MiB + 256 * 1024;
constexpr size_t WS_W8 = 1360 * MiB + 266 * MiB;
constexpr size_t WS_SSC = 1360 * MiB + 260 * MiB;
constexpr size_t WS_WDN = 1872 * MiB;
constexpr size_t WS_SWDN = 1872 * MiB + 128 * MiB;
constexpr size_t WS_END = 2128 * MiB;
constexpr int CW_TMO = 0;
constexpr int CW_BAR = 4096;
constexpr int CW_CNT = 16384;

constexpr int RING_BYTES = 131072;
constexpr int LDS_MISC = 135168;
constexpr int LDS_TT = LDS_MISC;
constexpr int LDS_XB = LDS_MISC + 512;
constexpr int LDS_TE = LDS_MISC + 768;
constexpr int LDS_BYTES = 147456;

#define GAS __attribute__((address_space(1)))
#define LAS __attribute__((address_space(3)))
typedef unsigned short bf16;
typedef unsigned v4u __attribute__((ext_vector_type(4)));
typedef unsigned v2u __attribute__((ext_vector_type(2)));
typedef float f32x4 __attribute__((ext_vector_type(4)));
typedef float f32x2 __attribute__((ext_vector_type(2)));
typedef float f32x16 __attribute__((ext_vector_type(16)));
typedef short bf16x8 __attribute__((ext_vector_type(8)));
typedef short s16x4 __attribute__((ext_vector_type(4)));
typedef __bf16 bf16x2_t __attribute__((ext_vector_type(2)));
typedef GAS unsigned gu32;
#define RLX_AGENT __ATOMIC_RELAXED, __HIP_MEMORY_SCOPE_AGENT
#define LDS_WAIT() asm volatile("s_waitcnt lgkmcnt(0)" ::: "memory")
#define VM_WAIT() asm volatile("s_waitcnt vmcnt(0)" ::: "memory")
__device__ __forceinline__ unsigned pk2(float lo, float hi) { f32x2 v = {lo, hi}; bf16x2_t b = __builtin_convertvector(v, bf16x2_t); return __builtin_bit_cast(unsigned, b); }
__device__ __forceinline__ float bf_lo(unsigned u) { return __builtin_bit_cast(float, u << 16); }
__device__ __forceinline__ float bf_hi(unsigned u) { return __builtin_bit_cast(float, u & 0xffff0000u); }
__device__ __forceinline__ float shx(float v, int mask, int lane) { return __int_as_float(__builtin_amdgcn_ds_bpermute((lane ^ mask) << 2, __float_as_int(v))); }
__device__ __forceinline__ float wave_sum(float v, int lane) {
#pragma unroll
    for (int o = 1; o < 64; o <<= 1) v += shx(v, o, lane);
    return v;
}
__device__ __forceinline__ int lane_id_v() { int t; asm volatile("v_mbcnt_lo_u32_b32 %0, -1, 0\n\tv_mbcnt_hi_u32_b32 %0, -1, %0" : "=v"(t)); return t; }
__device__ __forceinline__ int launder_s(int x) { asm volatile("" : "+s"(x)); return x; }
__device__ __forceinline__ int lthread_w(int wave) { return wave * 64 + lane_id_v(); }
__device__ __forceinline__ int modrow_of(int row) { return row < NC ? NB : ((row - NC) >> 12); }

#define XB_TMO      128
#define XB_XCNT(j)  (256  + 64 * (j))
#define XB_XSUB(j)  (1280 + 64 * (j))
#define XB_XGEN(j)  (2304 + 64 * (j))
#define XB_TOP      3328
#define XB_TOPGEN   3392
#define XCD_BAR_WORDS 3456
#define XB_SPIN_CAP (1u << 18)
__device__ __forceinline__ unsigned xb_ld(unsigned* p)              { return __hip_atomic_load(p, __ATOMIC_RELAXED, __HIP_MEMORY_SCOPE_AGENT); }
__device__ __forceinline__ unsigned xb_add(unsigned* p, unsigned v) { return __hip_atomic_fetch_add(p, v, __ATOMIC_RELAXED, __HIP_MEMORY_SCOPE_AGENT); }
__device__ __forceinline__ unsigned xb_xcc_id() { return (unsigned)__builtin_amdgcn_s_getreg((3 << 11) | 20) & 0xFu; }
#define XB_SPIN(cond, bar) do { unsigned _sp = 0; while (cond) { __builtin_amdgcn_s_sleep(1); \
    if ((++_sp & 255u) == 0u) { if (xb_ld(&(bar)[XB_TMO])) break; if (_sp > XB_SPIN_CAP) { atomicAdd(&(bar)[XB_TMO], 1u); break; } } } } while (0)
struct XcdBarrier { unsigned* bar; unsigned x; volatile LAS unsigned* st; int wave; };
__device__ __forceinline__ bool xb_thread0(int wave) { return wave == 0 && lane_id_v() == 0; }
__device__ __forceinline__ XcdBarrier xcd_barrier_post(unsigned* bar, volatile LAS unsigned* st, int wave) {
    XcdBarrier b; b.bar = bar; b.x = xb_xcc_id(); b.st = st; b.wave = wave;
    if (xb_thread0(wave)) (void)xb_add(&bar[XB_XCNT(b.x)], 1u);
    return b;
}
__device__ __forceinline__ void xcd_barrier_complete(unsigned* bar, unsigned x, unsigned& nloc, unsigned& nx) {
    const unsigned G = gridDim.x * gridDim.y * gridDim.z;
    unsigned sum, cnt, mine, sp = 0u;
    for (;;) {
        sum = 0u; cnt = 0u; mine = 0u;
#pragma unroll
        for (unsigned j = 0; j < 16; ++j) { const unsigned c = xb_ld(&bar[XB_XCNT(j)]); sum += c; cnt += (c > 0u) ? 1u : 0u; mine = (j == x) ? c : mine; }
        if (sum == G) break;
        __builtin_amdgcn_s_sleep(1);
        if ((++sp & 255u) == 0u) { if (xb_ld(&bar[XB_TMO])) break; if (sp > XB_SPIN_CAP) { atomicAdd(&bar[XB_TMO], 1u); break; } }
    }
    nloc = mine > 0u ? mine : 1u; nx = cnt > 0u ? cnt : 1u;
}
__device__ __forceinline__ void xcd_barrier(const XcdBarrier& b) {
    asm volatile("s_waitcnt vmcnt(0)" ::: "memory");
    __syncthreads();
    if (xb_thread0(b.wave)) {
        unsigned* bar = b.bar;
        __builtin_amdgcn_s_waitcnt(0);
        unsigned nloc = b.st[0], nx = b.st[1];
        if (nloc == 0u) { xcd_barrier_complete(bar, b.x, nloc, nx); b.st[0] = nloc; b.st[1] = nx; }
        const unsigned old = xb_add(&bar[XB_XSUB(b.x)], 1u);
        const unsigned gen = old / nloc;
        if (old + 1u == (gen + 1u) * nloc) {
            __builtin_amdgcn_fence(__ATOMIC_RELEASE, "agent");
            asm volatile("s_waitcnt vmcnt(0)" ::: "memory");
            const unsigned og = xb_add(&bar[XB_TOP], 1u);
            const unsigned tg = og / nx;
            if (og + 1u == (tg + 1u) * nx) xb_add(&bar[XB_TOPGEN], 1u);
            else XB_SPIN(xb_ld(&bar[XB_TOPGEN]) == tg, bar);
            __builtin_amdgcn_fence(__ATOMIC_ACQUIRE, "agent");
            xb_add(&bar[XB_XGEN(b.x)], 1u);
            asm volatile("s_waitcnt vmcnt(0)" ::: "memory");
        } else {
            XB_SPIN(xb_ld(&bar[XB_XGEN(b.x)]) == gen, bar);
            __builtin_amdgcn_fence(__ATOMIC_ACQUIRE, "agent");
            asm volatile("s_waitcnt vmcnt(0)" ::: "memory");
        }
    }
    __syncthreads();
}

namespace pg8 {
#define PG8_LAS __attribute__((address_space(3)))
constexpr int BM = 256, BK = 64, HALF = 128, HTB = HALF * BK * 2, STAGE_BYTES = 8 * HTB, NXCD = 8, WGM = 8;
__device__ __forceinline__ int lds_byte(int r, int c) { const int st = (r >> 4) * 2 + (c >> 5), rr = r & 15, cc = c & 31, ob = rr * 64 + cc * 2; return st * 1024 + (ob ^ (((ob >> 9) & 1) << 5)); }
__device__ __forceinline__ void stage_rc(int b, int& R, int& C) { const int st = b / 1024, sb = b % 1024, swz = sb ^ (((sb >> 9) & 1) << 5); R = (st >> 1) * 16 + swz / 64; C = (st & 1) * 32 + (swz % 64) / 2; }
__device__ __forceinline__ int perm32(int rho) { const int n = rho >> 4, i = rho & 15; return 8 * (i >> 2) + 4 * n + (i & 3); }
struct Unit { int pm, pn, aux; };
typedef f32x4 Acc[2][2][4][2];
typedef int i32x4 __attribute__((ext_vector_type(4)));
typedef i32x4 AccI[2][2][4][2];
template <bool I8> struct AccSel { typedef f32x4 T; };
template <> struct AccSel<true> { typedef i32x4 T; };
__device__ __forceinline__ f32x4 mma1(bf16x8 b, bf16x8 a, f32x4 c) { return __builtin_amdgcn_mfma_f32_16x16x32_bf16(b, a, c, 0, 0, 0); }
typedef int i32x8 __attribute__((ext_vector_type(8)));
typedef short bf16x16 __attribute__((ext_vector_type(16)));
__device__ __forceinline__ f32x4 mma_f8(bf16x8 b0, bf16x8 b1, bf16x8 a0, bf16x8 a1, f32x4 c) {
    const i32x8 B = __builtin_bit_cast(i32x8, __builtin_shufflevector(b0, b1, 0, 1, 2, 3, 4, 5, 6, 7, 8, 9, 10, 11, 12, 13, 14, 15));
    const i32x8 A = __builtin_bit_cast(i32x8, __builtin_shufflevector(a0, a1, 0, 1, 2, 3, 4, 5, 6, 7, 8, 9, 10, 11, 12, 13, 14, 15));
    return __builtin_amdgcn_mfma_scale_f32_16x16x128_f8f6f4(B, A, c, 0, 0, 0, 0, 0, 0); }
__device__ __forceinline__ i32x4 mma1(bf16x8 b, bf16x8 a, i32x4 c) { return __builtin_amdgcn_mfma_i32_16x16x64_i8(__builtin_bit_cast(i32x4, b), __builtin_bit_cast(i32x4, a), c, 0, 0, 0); }

__device__ __forceinline__ bool static_next(int i, int G, int c, int nM, int nN, int& pm, int& pn) {
    const int nwg = nM * nN; const long L = (long)i * G + c; if (L >= nwg) return false;
    int wgid = (int)L; { const int q = nwg / NXCD, r = nwg % NXCD, xcd = wgid % NXCD, off = wgid / NXCD; wgid = (xcd < r ? xcd * (q + 1) : r * (q + 1) + (xcd - r) * q) + off; }
    const int nig = WGM * nN, gid = wgid / nig, fm = gid * WGM, gsz = (nM - fm) < WGM ? (nM - fm) : WGM;
    pm = fm + ((wgid % nig) % gsz); pn = (wgid % nig) / gsz; return true;
}

template <class P>
__device__ __forceinline__ void gemm_phase(PG8_LAS unsigned char* lds, const P& p, int wave_id) {
    wave_id = launder_s(wave_id); int tid_l = lthread_w(wave_id);
    const int tid = tid_l, wid = wave_id, lane = tid & 63, wr = wid >> 2, wc = wid & 3, fr = lane & 15, fq = lane >> 4;
    const int nt = p.nt;
    const unsigned ldsw = (unsigned)wid * 1024u;
    const int aoff = lds_byte(wr * 64 + fr, fq * 8), boff = lds_byte(wc * 32 + fr, fq * 8);
    const char* const gA = p.A; const char* const gB = p.B;
#define PG8_SA(b, h) (((b) * 2 + (h)) * HTB)
#define PG8_SB(b, h) ((4 + (b) * 2 + (h)) * HTB)
#define PG8_STAGE(bufoff, gbase, off2, kofs) do { _Pragma("unroll") for (int _i = 0; _i < 2; ++_i) \
        __builtin_amdgcn_global_load_lds((const unsigned*)((gbase) + (size_t)(off2)[_i] + (size_t)(kofs)), (PG8_LAS unsigned*)(lds + (bufoff) + ldsw + _i * 8192), 16, 0, 0); } while (0)
#define PG8_LDA(dst, b, h) do { _Pragma("unroll") for (int m = 0; m < 4; ++m) _Pragma("unroll") for (int k = 0; k < 2; ++k) dst[m][k] = *(const PG8_LAS bf16x8*)(lds + PG8_SA(b, h) + aoff + m * 2048 + k * 1024); } while (0)
#define PG8_LDB(dst, b, h) do { _Pragma("unroll") for (int n = 0; n < 2; ++n) _Pragma("unroll") for (int k = 0; k < 2; ++k) dst[n][k] = *(const PG8_LAS bf16x8*)(lds + PG8_SB(b, h) + boff + n * 2048 + k * 1024); } while (0)
#define PG8_MMA(ai, bj, At, Bt) do { __builtin_amdgcn_s_setprio(1); _Pragma("unroll") for (int m = 0; m < 4; ++m) _Pragma("unroll") for (int n = 0; n < 2; ++n) { \
        if constexpr (P::F8) acc[ai][bj][m][n] = mma_f8(Bt[n][0], Bt[n][1], At[m][0], At[m][1], acc[ai][bj][m][n]); \
        else { _Pragma("unroll") for (int k = 0; k < 2; ++k) acc[ai][bj][m][n] = mma1(Bt[n][k], At[m][k], acc[ai][bj][m][n]); } } __builtin_amdgcn_s_setprio(0); } while (0)
#define PG8_WAIT_V(n) asm volatile("s_waitcnt vmcnt(" #n ")" ::: "memory")
#define PG8_WAIT_L(n) asm volatile("s_waitcnt lgkmcnt(" #n ")" ::: "memory")
#define PG8_BAR __builtin_amdgcn_s_barrier()
#define PG8_SCHED __builtin_amdgcn_sched_barrier(0)
#define PG8_KEYS(u) do { if (P::KEYS && wid < 4) __builtin_amdgcn_global_load_lds((const unsigned*)p.key_ptr(u, wid * 64 + lane_id_v()), (PG8_LAS unsigned*)(keybuf + wid * 256), 4, 0, 0); } while (0)
#define PG8_OFFS(u, oA, oB) do { const int tid2_ = wid * 64 + lane_id_v();     \
    _Pragma("unroll") for (int _i = 0; _i < 2; ++_i) { int R_, C_; stage_rc(tid2_ * 16 + _i * 8192, R_, C_); const int Rb_ = P::PERM ? ((R_ & ~31) + perm32(R_ & 31)) : R_; \
      _Pragma("unroll") for (int _h = 0; _h < 2; ++_h) { \
        const int key_ = P::KEYS ? ((const PG8_LAS int*)keybuf)[_h * HALF + R_] : 0; \
        oA[_h][_i] = p.a_row(u, _h * HALF + R_, key_) + (unsigned)(C_ * 2); oB[_h][_i] = p.b_row(u, _h * HALF + Rb_) + (unsigned)(C_ * 2); } } } while (0)
    PG8_LAS unsigned char* const keybuf = lds + STAGE_BYTES;
    Unit cur, nxt; int ui = 0;
    if (!p.next(0, cur)) return;
    typedef typename AccSel<P::I8>::T AccT;
    AccT acc[2][2][4][2];
#pragma unroll
    for (int a = 0; a < 2; ++a)
#pragma unroll
        for (int b = 0; b < 2; ++b)
#pragma unroll
            for (int m = 0; m < 4; ++m)
#pragma unroll
                for (int n = 0; n < 2; ++n) acc[a][b][m][n] = (AccT){0, 0, 0, 0};
    bf16x8 At[4][2], B0[2][2], B1[2][2];
    unsigned oAc[2][2], oBc[2][2];
    if (P::KEYS) { PG8_KEYS(cur); PG8_WAIT_V(0); PG8_BAR; }
    PG8_OFFS(cur, oAc, oBc);
    PG8_STAGE(PG8_SB(0, 0), gB, oBc[0], 0); PG8_STAGE(PG8_SB(0, 1), gB, oBc[1], 0); PG8_STAGE(PG8_SA(0, 0), gA, oAc[0], 0); PG8_STAGE(PG8_SA(0, 1), gA, oAc[1], 0);
    if (wr == 1) PG8_BAR;
    PG8_WAIT_V(2); PG8_BAR;
    PG8_STAGE(PG8_SB(1, 0), gB, oBc[0], 128); PG8_STAGE(PG8_SA(1, 0), gA, oAc[0], 128); PG8_STAGE(PG8_SB(1, 1), gB, oBc[1], 128);
    PG8_WAIT_V(6); PG8_BAR;
    for (;;) {
        const bool has_next = p.next(ui + 1, nxt);
        if (has_next) { PG8_KEYS(nxt); }
        for (int t = 0; t < nt; t += 2) {
            const bool last = (t == nt - 2);
            const unsigned k1 = (unsigned)(t + 1) * 128u;
            const unsigned k2 = last ? 0u : (unsigned)(t + 2) * 128u, k3 = k2 + 128u;
            PG8_LDB(B0, 0, 0); PG8_LDB(B1, 0, 1); PG8_SCHED; PG8_LDA(At, 0, 0); PG8_STAGE(PG8_SA(1, 1), gA, oAc[1], k1);
            if (last && has_next) { PG8_OFFS(nxt, oAc, oBc); }
            PG8_WAIT_V(8); PG8_WAIT_L(0); PG8_BAR; PG8_MMA(0, 0, At, B0); PG8_MMA(0, 1, At, B1); PG8_BAR; PG8_SCHED;
            PG8_LDA(At, 0, 1); PG8_STAGE(PG8_SB(0, 0), gB, oBc[0], k2); PG8_STAGE(PG8_SB(0, 1), gB, oBc[1], k2); PG8_STAGE(PG8_SA(0, 0), gA, oAc[0], k2);
            PG8_WAIT_V(8); PG8_WAIT_L(0); PG8_BAR; PG8_MMA(1, 0, At, B0); PG8_MMA(1, 1, At, B1); PG8_BAR; PG8_SCHED;
            PG8_LDB(B0, 1, 0); PG8_LDB(B1, 1, 1); PG8_SCHED; PG8_LDA(At, 1, 0); PG8_STAGE(PG8_SA(0, 1), gA, oAc[1], k2);
            PG8_WAIT_V(8); PG8_WAIT_L(0); PG8_BAR; PG8_MMA(0, 0, At, B0); PG8_MMA(0, 1, At, B1); PG8_BAR; PG8_SCHED;
            PG8_LDA(At, 1, 1); PG8_STAGE(PG8_SB(1, 0), gB, oBc[0], k3); PG8_STAGE(PG8_SB(1, 1), gB, oBc[1], k3); PG8_STAGE(PG8_SA(1, 0), gA, oAc[0], k3);
            PG8_WAIT_V(8); PG8_WAIT_L(0); PG8_BAR; PG8_MMA(1, 0, At, B0); PG8_MMA(1, 1, At, B1); PG8_BAR; PG8_SCHED;
        }
        if (wr == 0) PG8_BAR;
        { const int le_ = lane_id_v(); int fr_e = le_ & 15, fq_e = le_ >> 4;
          p.epi(acc, cur, wr, wc, fr_e, fq_e); }
        if (!has_next) break;
#pragma unroll
        for (int a = 0; a < 2; ++a)
#pragma unroll
            for (int b = 0; b < 2; ++b)
#pragma unroll
                for (int m = 0; m < 4; ++m)
#pragma unroll
                    for (int n = 0; n < 2; ++n) acc[a][b][m][n] = (AccT){0, 0, 0, 0};
        cur = nxt; ++ui;
        if (wr == 1) PG8_BAR;
    }
    PG8_WAIT_V(0);
    PG8_BAR;
#undef PG8_SA
#undef PG8_SB
#undef PG8_STAGE
#undef PG8_LDA
#undef PG8_LDB
#undef PG8_MMA
#undef PG8_WAIT_V
#undef PG8_WAIT_L
#undef PG8_BAR
#undef PG8_SCHED
#undef PG8_OFFS
#undef PG8_KEYS
}
}
using pg8::Unit;

#define TROW(ai, wr, m, fr) (128 * (ai) + 64 * (wr) + 16 * (m) + (fr))
#define TCOLP(bj, wc, fq) (128 * (bj) + 32 * (wc) + 8 * (fq))
#define TCOLN(bj, wc, n, fq) (128 * (bj) + 32 * (wc) + 16 * (n) + 4 * (fq))
__device__ __forceinline__ v4u pack8(const f32x4 a, const f32x4 b) { v4u w; w.x = pk2(a[0], a[1]); w.y = pk2(a[2], a[3]); w.z = pk2(b[0], b[1]); w.w = pk2(b[2], b[3]); return w; }

struct PolDenseBf16 {
    static constexpr bool PERM = true;
    static constexpr bool KEYS = false;
    static constexpr bool I8 = false;
    static constexpr bool F8 = false;
    __device__ __forceinline__ const int* key_ptr(const Unit&, int) const { return nullptr; }
    const char* A; const char* B; int nt; int nM, nN, pm0, G, c; unsigned pitchA, pitchB; bf16* O; int ldo;
    __device__ __forceinline__ bool next(int i, Unit& u) const { int pm, pn; if (!pg8::static_next(i, G, c, nM, nN, pm, pn)) return false; u.pm = pm + pm0; u.pn = pn; u.aux = 0; return true; }
    __device__ __forceinline__ unsigned a_row(const Unit& u, int r, int) const { return (unsigned)(u.pm * 256 + r) * pitchA; }
    __device__ __forceinline__ unsigned b_row(const Unit& u, int r) const { return (unsigned)(u.pn * 256 + r) * pitchB; }
    __device__ __forceinline__ void epi(const pg8::Acc& acc, const Unit& u, int wr, int wc, int fr, int fq) const {
#pragma unroll
        for (int ai = 0; ai < 2; ++ai)
#pragma unroll
            for (int m = 0; m < 4; ++m) { const size_t row = (size_t)u.pm * 256 + TROW(ai, wr, m, fr);
#pragma unroll
                for (int bj = 0; bj < 2; ++bj) { const int col = u.pn * 256 + TCOLP(bj, wc, fq); *(v4u*)(O + row * ldo + col) = pack8(acc[ai][bj][m][0], acc[ai][bj][m][1]); } }
    }
};

struct PolDenseI8 {
    static constexpr bool PERM = true;
    static constexpr bool KEYS = false;
    static constexpr bool I8 = true;
    static constexpr bool F8 = false;
    __device__ __forceinline__ const int* key_ptr(const Unit&, int) const { return nullptr; }
    const char* A; const char* B; int nt; int nM, nN, pm0, G, c; const float* sA; const float* sB; bf16* O; int ldo;
    __device__ __forceinline__ bool next(int i, Unit& u) const { int pm, pn; if (!pg8::static_next(i, G, c, nM, nN, pm, pn)) return false; u.pm = pm + pm0; u.pn = pn; u.aux = 0; return true; }
    __device__ __forceinline__ unsigned a_row(const Unit& u, int r, int) const { return (unsigned)(u.pm * 256 + r) * 1024u; }
    __device__ __forceinline__ unsigned b_row(const Unit& u, int r) const { return (unsigned)(u.pn * 256 + r) * 1024u; }
    __device__ __forceinline__ void epi(const pg8::AccI& acc, const Unit& u, int wr, int wc, int fr, int fq) const {
#pragma unroll
        for (int bj = 0; bj < 2; ++bj) { const int col = u.pn * 256 + TCOLP(bj, wc, fq); const f32x4 s0 = *(const f32x4*)(sB + col), s1 = *(const f32x4*)(sB + col + 4);
#pragma unroll
            for (int ai = 0; ai < 2; ++ai)
#pragma unroll
                for (int m = 0; m < 4; ++m) { const size_t row = (size_t)u.pm * 256 + TROW(ai, wr, m, fr); const float sa = sA[row]; f32x4 v0, v1;
#pragma unroll
                    for (int q = 0; q < 4; ++q) { v0[q] = (float)acc[ai][bj][m][0][q] * (sa * s0[q]); v1[q] = (float)acc[ai][bj][m][1][q] * (sa * s1[q]); }
                    *(v4u*)(O + row * ldo + col) = pack8(v0, v1); } }
    }
};

struct PolOut {
    static constexpr bool PERM = true;
    static constexpr bool KEYS = false;
    static constexpr bool I8 = false;
    static constexpr bool F8 = false;
    __device__ __forceinline__ const int* key_ptr(const Unit&, int) const { return nullptr; }
    const char* A; const char* B; int nt; int nM, nN, pm0, G, c; bf16* X; const float* mod;
    int chunk; const float* XinC; const float* XinL;
    __device__ __forceinline__ bool next(int i, Unit& u) const { int pm, pn; if (!pg8::static_next(i, G, c, nM, nN, pm, pn)) return false; u.pm = pm + pm0; u.pn = pn; u.aux = 0; return true; }
    __device__ __forceinline__ unsigned a_row(const Unit& u, int r, int) const { return (unsigned)(u.pm * 256 + r) * 2048u; }
    __device__ __forceinline__ unsigned b_row(const Unit& u, int r) const { return (unsigned)(u.pn * 256 + r) * 2048u; }
    __device__ __forceinline__ void epi(const pg8::Acc& acc, const Unit& u, int wr, int wc, int fr, int fq) const {
        const int mr = modrow_of(u.pm * 256);
        const float* g = mod + (size_t)mr * (NMOD * D) + chunk * D;
        const float* xin = XinC ? (u.pm < 8 ? XinC : XinL) : nullptr;
#pragma unroll
        for (int bj = 0; bj < 2; ++bj) { const int col = u.pn * 256 + TCOLP(bj, wc, fq); const f32x4 g0 = *(const f32x4*)(g + col), g1 = *(const f32x4*)(g + col + 4);
#pragma unroll
            for (int ai = 0; ai < 2; ++ai)
#pragma unroll
                for (int m = 0; m < 4; ++m) { const size_t off = ((size_t)u.pm * 256 + TROW(ai, wr, m, fr)) * D + col; f32x4 x0, x1;
                    if (xin) { x0 = *(const f32x4*)(xin + off); x1 = *(const f32x4*)(xin + off + 4); }
                    else { const v4u w = *(const v4u*)(X + off); x0 = (f32x4){bf_lo(w.x), bf_hi(w.x), bf_lo(w.y), bf_hi(w.y)}; x1 = (f32x4){bf_lo(w.z), bf_hi(w.z), bf_lo(w[3]), bf_hi(w[3])}; }
                    *(v4u*)(X + off) = pack8(x0 + g0 * acc[ai][bj][m][0], x1 + g1 * acc[ai][bj][m][1]); } }
    }
};

struct PolFP {
    static constexpr bool PERM = true;
    static constexpr bool KEYS = false;
    static constexpr bool I8 = true;
    static constexpr bool F8 = false;
    __device__ __forceinline__ const int* key_ptr(const Unit&, int) const { return nullptr; }
    const char* A; const char* B; int nt; int nN, G, c; const float* sW; const float* sH; bf16* Z; bf16* Zc;
    __device__ __forceinline__ bool next(int i, Unit& u) const { int pm, pn; if (!pg8::static_next(i, G, c, 8, nN, pm, pn)) return false; u.pm = pm; u.pn = pn; u.aux = 0; return true; }
    __device__ __forceinline__ unsigned a_row(const Unit& u, int r, int) const { return (unsigned)(u.pm * 256 + r) * 1024u; }
    __device__ __forceinline__ int tok_row(int pn, int n) const { if (pn < 128) { const int b = n >> 12, l2 = (n >> 6) & 63, l1 = n & 63; return NC + b * SEQ + 64 * l1 + l2; } return n - 32768; }
    __device__ __forceinline__ unsigned b_row(const Unit& u, int r) const { return (unsigned)tok_row(u.pn, u.pn * 256 + r) * 1024u; }
    __device__ __forceinline__ void epi(const pg8::AccI& acc, const Unit& u, int wr, int wc, int fr, int fq) const {
#pragma unroll
        for (int bj = 0; bj < 2; ++bj) { const int n0 = u.pn * 256 + TCOLP(bj, wc, fq);
            f32x4 h0, h1;
#pragma unroll
            for (int q = 0; q < 4; ++q) { h0[q] = sH[tok_row(u.pn, n0 + q)]; h1[q] = sH[tok_row(u.pn, n0 + 4 + q)]; }
#pragma unroll
            for (int ai = 0; ai < 2; ++ai)
#pragma unroll
                for (int m = 0; m < 4; ++m) { const int cp = u.pm * 256 + TROW(ai, wr, m, fr); const float sw = sW[cp]; f32x4 v0, v1;
#pragma unroll
                    for (int q = 0; q < 4; ++q) { v0[q] = (float)acc[ai][bj][m][0][q] * (sw * h0[q]); v1[q] = (float)acc[ai][bj][m][1][q] * (sw * h1[q]); }
                    const v4u w = pack8(v0, v1);
                    if (u.pn < 128) *(v4u*)(Z + ((size_t)(n0 >> 6) * 2048 + cp) * 64 + (n0 & 63)) = w;
                    else { const int b = u.pn - 128, l = n0 - 32768 - b * 256; *(v4u*)(Zc + ((size_t)b * 2048 + cp) * 256 + l) = w; } } }
    }
};

struct PolFA {
    static constexpr bool PERM = true;
    static constexpr bool KEYS = false;
    static constexpr bool I8 = false;
    static constexpr bool F8 = false;
    __device__ __forceinline__ const int* key_ptr(const Unit&, int) const { return nullptr; }
    const char* A; const char* B; int nt; int G, c; bf16* Y;
    __device__ __forceinline__ bool next(int i, Unit& u) const { const int L = i * G + c; if (L >= 1024) return false; u.pm = 0; u.pn = L & 127; u.aux = L >> 7; return true; }
    __device__ __forceinline__ unsigned a_row(const Unit&, int r, int) const { return (unsigned)r * 512u; }
    __device__ __forceinline__ unsigned b_row(const Unit& u, int r) const { const int l2 = r & 63, cp = u.pn * 4 + (r >> 6); return (unsigned)((u.aux * 64 + l2) * 512 + cp) * 512u; }
    __device__ __forceinline__ void epi(const pg8::Acc& acc, const Unit& u, int wr, int wc, int fr, int fq) const {
        const int b = u.aux;
#pragma unroll
        for (int ai = 0; ai < 2; ++ai)
#pragma unroll
            for (int m = 0; m < 4; ++m) { const int rr = TROW(ai, wr, m, fr), jp = rr >> 7, pp = (rr >> 6) & 1, k1 = rr & 63;
#pragma unroll
                for (int bj = 0; bj < 2; ++bj) { const int n0 = u.pn * 256 + TCOLP(bj, wc, fq), cp = n0 >> 6, l2 = n0 & 63, cc = 2 * cp + jp;
                    const size_t idx = ((((size_t)(b * 16 + (k1 >> 2)) * 1024 + cc) * 4 + (k1 & 3)) * 2 + pp) * 64 + l2;
                    *(v4u*)(Y + idx) = pack8(acc[ai][bj][m][0], acc[ai][bj][m][1]); } }
    }
};

struct PolFC {
    static constexpr bool PERM = true;
    static constexpr bool KEYS = false;
    static constexpr bool I8 = false;
    static constexpr bool F8 = false;
    __device__ __forceinline__ const int* key_ptr(const Unit&, int) const { return nullptr; }
    const char* A; const char* B; int nt; int G, c; int nunits; unsigned offMC, offZc; bf16* F;
    __device__ __forceinline__ bool next(int i, Unit& u) const { const int L = i * G + c; if (L >= nunits) return false;
        if (L < 512) { u.pm = 0; u.pn = L & 3; u.aux = L >> 2; } else { const int q = L - 512; u.pm = 0; u.pn = q & 3; u.aux = 256 + (q >> 2); } return true; }
    __device__ __forceinline__ unsigned a_row(const Unit& u, int r, int) const {
        if (u.aux < 256) return offMC + (unsigned)((u.aux & 15) * 256 + r) * 1024u;
        return (unsigned)r * 1024u; }
    __device__ __forceinline__ unsigned b_row(const Unit& u, int r) const {
        if (u.aux < 256) return (unsigned)(u.aux * 1024 + u.pn * 256 + r) * 1024u;
        return offZc + (unsigned)((u.aux - 256) * 1024 + u.pn * 256 + r) * 1024u; }
    __device__ __forceinline__ void epi(const pg8::Acc& acc, const Unit& u, int wr, int wc, int fr, int fq) const {
#pragma unroll
        for (int ai = 0; ai < 2; ++ai)
#pragma unroll
            for (int m = 0; m < 4; ++m) { const int rr = TROW(ai, wr, m, fr); size_t frow;
                if (u.aux < 256) { const int b = u.aux >> 4, kq = u.aux & 15, k = 4 * kq + (rr >> 6) + 64 * (rr & 63); frow = (size_t)NC + b * SEQ + k; }
                else frow = (size_t)(u.aux - 256) * LCTX + rr;
#pragma unroll
                for (int bj = 0; bj < 2; ++bj) { const int col = u.pn * 256 + TCOLP(bj, wc, fq); *(v4u*)(F + frow * D + col) = pack8(acc[ai][bj][m][0], acc[ai][bj][m][1]); } }
    }
};

struct PolMlaQ {
    static constexpr bool PERM = true;
    static constexpr bool KEYS = false;
    static constexpr bool I8 = false;
    static constexpr bool F8 = false;
    __device__ __forceinline__ const int* key_ptr(const Unit&, int) const { return nullptr; }
    const char* A; const char* B; int nt; int nM, nN, G, c; bf16* Q; const float* rope; float c2;
    __device__ __forceinline__ bool next(int i, Unit& u) const { int pm, pn; if (!pg8::static_next(i, G, c, nM, nN, pm, pn)) return false; u.pm = pm; u.pn = pn; u.aux = 0; return true; }
    __device__ __forceinline__ unsigned a_row(const Unit& u, int r, int) const { return (unsigned)(u.pm * 256 + r) * (unsigned)(MLA_QL * 2); }
    __device__ __forceinline__ unsigned b_row(const Unit& u, int r) const { return (unsigned)(u.pn * 256 + r) * (unsigned)(MLA_QL * 2); }
    __device__ __forceinline__ void epi(const pg8::Acc& acc, const Unit& u, int wr, int wc, int fr, int fq) const {
        const bool lat = u.pm >= 8;
#pragma unroll
        for (int bj = 0; bj < 2; ++bj) { const int col = u.pn * 256 + TCOLP(bj, wc, fq); const bool isrope = lat && (((col >> 5) % 3) == 2);
#pragma unroll
            for (int ai = 0; ai < 2; ++ai)
#pragma unroll
                for (int m = 0; m < 4; ++m) { const int row = u.pm * 256 + TROW(ai, wr, m, fr); f32x4 v0 = acc[ai][bj][m][0], v1 = acc[ai][bj][m][1];
                    if (isrope) { const int t = (row - NC) & 4095, pos = (fq & 2) ? (t & 63) : (t >> 6);
                        const f32x4* rp = (const f32x4*)(rope + (size_t)pos * 16);
                        const f32x4 r0 = rp[0], r1 = rp[1], r2 = rp[2], r3 = rp[3];
                        f32x4 p0, p1;
#pragma unroll
                        for (int e = 0; e < 4; ++e) { p0[e] = shx(v0[e], 16, fq * 16 + fr); p1[e] = shx(v1[e], 16, fq * 16 + fr); }
                        const float sg = (fq & 1) ? 1.f : -1.f;
                        v0[0] = v0[0] * r0[0] + sg * p0[0] * r0[1]; v0[1] = v0[1] * r0[2] + sg * p0[1] * r0[3];
                        v0[2] = v0[2] * r1[0] + sg * p0[2] * r1[1]; v0[3] = v0[3] * r1[2] + sg * p0[3] * r1[3];
                        v1[0] = v1[0] * r2[0] + sg * p1[0] * r2[1]; v1[1] = v1[1] * r2[2] + sg * p1[1] * r2[3];
                        v1[2] = v1[2] * r3[0] + sg * p1[2] * r3[1]; v1[3] = v1[3] * r3[2] + sg * p1[3] * r3[3]; }
                    *(v4u*)(Q + (size_t)row * 1536 + col) = pack8(v0 * c2, v1 * c2); } }
    }
};

struct PolMlaKV {
    static constexpr bool PERM = true;
    static constexpr bool KEYS = false;
    static constexpr bool I8 = false;
    static constexpr bool F8 = false;
    __device__ __forceinline__ const int* key_ptr(const Unit&, int) const { return nullptr; }
    const char* A; const char* B; int nt; int nM, nN, G, c; bf16* Kb; bf16* Vb;
    __device__ __forceinline__ bool next(int i, Unit& u) const { int pm, pn; if (!pg8::static_next(i, G, c, nM, nN, pm, pn)) return false; u.pm = pm; u.pn = pn; u.aux = 0; return true; }
    __device__ __forceinline__ unsigned a_row(const Unit& u, int r, int) const { return (unsigned)(u.pm * 256 + r) * 512u; }
    __device__ __forceinline__ unsigned b_row(const Unit& u, int r) const { return (unsigned)(u.pn * 256 + r) * 512u; }
    __device__ __forceinline__ void epi(const pg8::Acc& acc, const Unit& u, int wr, int wc, int fr, int fq) const {
#pragma unroll
        for (int bj = 0; bj < 2; ++bj) { const int col = u.pn * 256 + TCOLP(bj, wc, fq), h = col >> 7, j = col & 127;
#pragma unroll
            for (int ai = 0; ai < 2; ++ai)
#pragma unroll
                for (int m = 0; m < 4; ++m) { const size_t row = (size_t)u.pm * 256 + TROW(ai, wr, m, fr); const v4u w = pack8(acc[ai][bj][m][0], acc[ai][bj][m][1]);
                    if (j < 64) *(v4u*)(Kb + row * 1536 + 96 * h + j) = w; else *(v4u*)(Vb + row * 1024 + 64 * h + (j - 64)) = w; } }
    }
};

struct MoeTab { const LAS int* TT; const LAS int* CN; const LAS int* TE; };
__device__ __forceinline__ bool moe_next(int i, int G, int c, int NP, const MoeTab& T, Unit& u) {
    const int ttot = T.TT[32];
    int lo, hi, j;
    if ((G & 7) == 0) { const int x = c & 7, q = c >> 3, g8 = G >> 3; lo = (x * ttot) >> 3; hi = ((x + 1) * ttot) >> 3; j = i * g8 + q; }
    else { lo = 0; hi = ttot; j = i * G + c; }
    if (j >= (hi - lo) * NP) return false;
    const int tile = lo + j / NP; u.pn = j % NP; u.pm = tile;
    const int e = T.TE[tile];
    u.aux = e | ((tile - T.TT[e]) << 8);
    return true;
}
struct PolMoe1 {
    static constexpr bool PERM = true;
    static constexpr bool I8 = true;
    static constexpr bool F8 = false;
    const char* A; const char* B; int nt; int G, c; MoeTab T; const int* stok; const float* bgu; const float* swgu; const float* ssc; unsigned char* act;
    __device__ __forceinline__ bool next(int i, Unit& u) const { return moe_next(i, G, c, 8, T, u); }
    static constexpr bool KEYS = true;
    __device__ __forceinline__ const int* key_ptr(const Unit& u, int r) const { const int e = u.aux & 255, idx = (u.aux >> 8) * 256 + r; const int cn = T.CN[e]; return stok + (size_t)e * CAP + (idx < cn ? idx : 0); }
    __device__ __forceinline__ unsigned a_row(const Unit&, int, int key) const { return (unsigned)key * 1024u; }
    __device__ __forceinline__ unsigned b_row(const Unit& u, int r) const { return (unsigned)((u.aux & 255) * 2048 + u.pn * 256 + r) * 1024u; }
    __device__ __forceinline__ void epi(const pg8::AccI& acc, const Unit& u, int wr, int wc, int fr, int fq) const {
        const int e = u.aux & 255, mt = u.aux >> 8, cn = T.CN[e]; const int jl = 32 * wc + 8 * fq;
        const float* bg = bgu + (size_t)e * 2048 + u.pn * 256 + jl;
        const float* sg = swgu + (size_t)e * 2048 + u.pn * 256 + jl;
        const f32x4 bg0 = *(const f32x4*)(bg), bg1 = *(const f32x4*)(bg + 4), bu0 = *(const f32x4*)(bg + 128), bu1 = *(const f32x4*)(bg + 132);
        const f32x4 sg0 = *(const f32x4*)(sg), sg1 = *(const f32x4*)(sg + 4), su0 = *(const f32x4*)(sg + 128), su1 = *(const f32x4*)(sg + 132);
#pragma unroll
        for (int ai = 0; ai < 2; ++ai)
#pragma unroll
            for (int m = 0; m < 4; ++m) { const int rr = TROW(ai, wr, m, fr), idx = mt * 256 + rr; const size_t slot = (size_t)u.pm * 256 + rr;
                const float sa = ssc[(size_t)e * CAP + (idx < cn ? idx : 0)];
                f32x4 g0, g1, u0, u1, o0, o1;
#pragma unroll
                for (int q = 0; q < 4; ++q) { g0[q] = (float)acc[ai][0][m][0][q] * (sa * sg0[q]) + bg0[q]; g1[q] = (float)acc[ai][0][m][1][q] * (sa * sg1[q]) + bg1[q];
                    u0[q] = (float)acc[ai][1][m][0][q] * (sa * su0[q]) + bu0[q]; u1[q] = (float)acc[ai][1][m][1][q] * (sa * su1[q]) + bu1[q]; }
#pragma unroll
                for (int q = 0; q < 4; ++q) {
                    float ga = fminf(g0[q], 7.f), ua = fminf(fmaxf(u0[q], -7.f), 7.f); o0[q] = (ua + 1.f) * ga * __builtin_amdgcn_rcpf(1.f + __builtin_amdgcn_exp2f(-1.702f * LOG2E * ga));
                    float gb = fminf(g1[q], 7.f), ub = fminf(fmaxf(u1[q], -7.f), 7.f); o1[q] = (ub + 1.f) * gb * __builtin_amdgcn_rcpf(1.f + __builtin_amdgcn_exp2f(-1.702f * LOG2E * gb)); }
                v2u w8; { int t0 = __builtin_amdgcn_cvt_pk_fp8_f32(o0[0], o0[1], 0, false); t0 = __builtin_amdgcn_cvt_pk_fp8_f32(o0[2], o0[3], t0, true);
                          int t1 = __builtin_amdgcn_cvt_pk_fp8_f32(o1[0], o1[1], 0, false); t1 = __builtin_amdgcn_cvt_pk_fp8_f32(o1[2], o1[3], t1, true); w8.x = (unsigned)t0; w8.y = (unsigned)t1; }
                *(v2u*)(act + slot * 1024 + u.pn * 128 + jl) = w8; }
    }
};
struct PolMoe2 {
    static constexpr bool PERM = true;
    static constexpr bool KEYS = false;
    static constexpr bool I8 = false;
    static constexpr bool F8 = true;
    __device__ __forceinline__ const int* key_ptr(const Unit&, int) const { return nullptr; }
    const char* A; const char* B; int nt; int G, c; MoeTab T; const float* sw; const float* bdn; const float* swd; unsigned char* Y;
    __device__ __forceinline__ bool next(int i, Unit& u) const { return moe_next(i, G, c, 4, T, u); }
    __device__ __forceinline__ unsigned a_row(const Unit& u, int r, int) const { return (unsigned)(u.pm * 256 + r) * 1024u; }
    __device__ __forceinline__ unsigned b_row(const Unit& u, int r) const { return (unsigned)((u.aux & 255) * 1024 + u.pn * 256 + r) * 1024u; }
    __device__ __forceinline__ void epi(const pg8::Acc& acc, const Unit& u, int wr, int wc, int fr, int fq) const {
        const int e = u.aux & 255, mt = u.aux >> 8, cn = T.CN[e];
#pragma unroll
        for (int bj = 0; bj < 2; ++bj) { const int col = u.pn * 256 + TCOLP(bj, wc, fq); const size_t ci = (size_t)e * 1024 + col;
            const f32x4 b0 = *(const f32x4*)(bdn + ci), b1 = *(const f32x4*)(bdn + ci + 4), s0 = *(const f32x4*)(swd + ci), s1 = *(const f32x4*)(swd + ci + 4);
#pragma unroll
            for (int ai = 0; ai < 2; ++ai)
#pragma unroll
                for (int m = 0; m < 4; ++m) { const int rr = TROW(ai, wr, m, fr), idx = mt * 256 + rr; const size_t slot = (size_t)u.pm * 256 + rr; const float w = sw[(size_t)e * CAP + (idx < cn ? idx : 0)];
                    const float w8 = w * 8.f; f32x4 y0 = (acc[ai][bj][m][0] * s0 + b0) * w8, y1 = (acc[ai][bj][m][1] * s1 + b1) * w8;
#pragma unroll
                    for (int q = 0; q < 4; ++q) { y0[q] = fminf(fmaxf(y0[q], -448.f), 448.f); y1[q] = fminf(fmaxf(y1[q], -448.f), 448.f); }
                    v2u o8; { int t0 = __builtin_amdgcn_cvt_pk_fp8_f32(y0[0], y0[1], 0, false); t0 = __builtin_amdgcn_cvt_pk_fp8_f32(y0[2], y0[3], t0, true);
                              int t1 = __builtin_amdgcn_cvt_pk_fp8_f32(y1[0], y1[1], 0, false); t1 = __builtin_amdgcn_cvt_pk_fp8_f32(y1[2], y1[3], t1, true); o8.x = (unsigned)t0; o8.y = (unsigned)t1; }
                    *(v2u*)(Y + slot * 1024 + col) = o8; } }
    }
};

namespace att {
__device__ __forceinline__ int crow(int r, int hi) { return (r & 3) + 8 * (r >> 2) + 4 * hi; }
__device__ __forceinline__ float max3f(float a, float b, float c) { return fmaxf(fmaxf(a, b), c); }
typedef LAS const char* lds_cptr;
constexpr int LK = 0, LV = 49152, LWS = 90112, LOST = 92160, LBYTES = 124928;
constexpr int PD = 3;
struct Tens { const bf16* Q; int qpitch; const bf16* K; int kpitch; const bf16* V; int vpitch; bf16* O; };
#define ATT_WAITV(n) asm volatile("s_waitcnt vmcnt(" #n ")" ::: "memory")
struct Pend { f32x16 o0, o1; float l; int qrow0, oc0; bool valid; };
__device__ __forceinline__ void finish_unit(const Pend& P, bf16* O, LAS unsigned char* lds, int wid, int lane) {
    const int r32 = lane & 31, hi = lane >> 5;
    LAS float* wsf = (LAS float*)(lds + LWS) + wid * 64;
    float lrun = P.l;
    { auto rr = __builtin_amdgcn_permlane32_swap(__float_as_uint(lrun), __float_as_uint(lrun), false, false); lrun = __uint_as_float(rr[0]) + __uint_as_float(rr[1]); }
    if (hi == 0) wsf[32 + r32] = lrun;
    LDS_WAIT();
    LAS bf16* stg = (LAS bf16*)(lds + LOST) + wid * 2048;
#pragma unroll
    for (int r = 0; r < 16; ++r) { const int orow = crow(r, hi); const float rl = __builtin_amdgcn_rcpf(wsf[32 + orow]);
        stg[orow * 64 + r32] = (bf16)(pk2(P.o0[r] * rl, 0.f) & 0xffffu); stg[orow * 64 + 32 + r32] = (bf16)(pk2(P.o1[r] * rl, 0.f) & 0xffffu); }
    LDS_WAIT();
    bf16* Ow = O + (size_t)(P.qrow0 + wid * 32) * 1024 + P.oc0;
#pragma unroll
    for (int i = 0; i < 4; ++i) { const int row = i * 8 + (lane >> 3), ch = lane & 7; const v4u v = *(const LAS v4u*)(stg + row * 64 + ch * 8); *(v4u*)(Ow + (size_t)row * 1024 + ch * 8) = v; }
    LDS_WAIT();
}
template <int DK>
__device__ __forceinline__ void unit(const Tens& T, int qrow0, int qc0, int kc0, int vc0, int oc0, int kctx0, int klat0, int NTL, LAS unsigned char* lds, int wave_id, Pend& pend) {
    constexpr int ND = DK / 16;
    wave_id = launder_s(wave_id); const int tid = lthread_w(wave_id), lane = tid & 63, r32 = lane & 31, hi = lane >> 5; const int wid = wave_id;
    LAS float* wsf = (LAS float*)(lds + LWS) + wid * 64;
    const bf16* ksrc = T.K + (size_t)lane * T.kpitch + kc0 + wid * 8;
    const int k2off = (8 + (wid & 3) - wid) * 8;
    const bf16* vsrc = T.V + (size_t)(16 * (wid & 3) + (lane >> 2)) * T.vpitch + vc0 + (wid >> 2) * 32 + (lane & 3) * 8;
#define ATT_DMA(t, ks_, vs_) do { const size_t row0_ = (size_t)((t) < 4 ? kctx0 + 64 * (t) : klat0 + 64 * ((t) - 4)); \
        __builtin_amdgcn_global_load_lds((const unsigned*)(ksrc + row0_ * T.kpitch), (LAS unsigned*)(lds + LK + (ks_) * 12288 + wid * 1024), 16, 0, 0); \
        if (DK > 64) __builtin_amdgcn_global_load_lds((const unsigned*)(ksrc + row0_ * T.kpitch + k2off), (LAS unsigned*)(lds + LK + (ks_) * 12288 + 8192 + (wid & 3) * 1024), 16, 0, 0); \
        __builtin_amdgcn_global_load_lds((const unsigned*)(vsrc + row0_ * T.vpitch), (LAS unsigned*)(lds + LV + (vs_) * 8192 + wid * 1024), 16, 0, 0); } while (0)
#define ATT_WAIT_TILES(n_tiles) do { if (DK > 64) { if ((n_tiles) >= 2) ATT_WAITV(6); else if ((n_tiles) == 1) ATT_WAITV(3); else ATT_WAITV(0); } \
        else { if ((n_tiles) >= 2) ATT_WAITV(4); else if ((n_tiles) == 1) ATT_WAITV(2); else ATT_WAITV(0); } } while (0)
    bf16x8 qr[ND];
    { const bf16* qp = T.Q + (size_t)(qrow0 + wid * 32 + r32) * T.qpitch + qc0 + hi * 8;
#pragma unroll
      for (int d0 = 0; d0 < ND; ++d0) qr[d0] = *(const bf16x8*)(qp + d0 * 16); }
    asm volatile("" ::: "memory");
    constexpr float THR = 8.f;
    const int half = wid >> 2;
    float mhat = 0.f, lrun = 0.f; f32x16 o[2]; o[0] = f32x16{}; o[1] = f32x16{}; f32x16 negm = f32x16{};
    f32x16 p0 = f32x16{}, p1 = f32x16{}; v4u pw[4]; pw[0] = pw[1] = pw[2] = pw[3] = (v4u){0u, 0u, 0u, 0u};
    ATT_DMA(0, 0, 0); ATT_DMA(1, 1, 1); ATT_DMA(2, 2, 2);
    if (pend.valid) finish_unit(pend, T.O, lds, wid, lane);
    ATT_WAIT_TILES(2);
    __builtin_amdgcn_s_barrier(); asm volatile("" ::: "memory");
    if (half == 1) __builtin_amdgcn_s_barrier();
    int vs_prev = 0, vs_cur = 0, vs_iss = 3;
    for (int t = 0; t <= NTL; ++t) {
        if (t >= 1) {
            s16x4 lo[2][4], hh[2][4];
            const unsigned vb = (unsigned)(uintptr_t)(lds + LV + vs_prev * 8192) + ((lane >> 4) & 1) * 32 + (lane & 3) * 8 + (4 * hi + ((lane & 15) >> 2)) * 64;
#pragma unroll
            for (int d0 = 0; d0 < 2; ++d0)
#pragma unroll
                for (int ks = 0; ks < 4; ++ks) {
                    asm volatile("ds_read_b64_tr_b16 %0,%1 offset:%c2" : "=&v"(lo[d0][ks]) : "v"(vb), "i"(d0 * 4096 + ks * 1024) : "memory");
                    asm volatile("ds_read_b64_tr_b16 %0,%1 offset:%c2" : "=&v"(hh[d0][ks]) : "v"(vb), "i"(d0 * 4096 + ks * 1024 + 512) : "memory"); }
            asm volatile("s_waitcnt lgkmcnt(0)" ::: "memory"); __builtin_amdgcn_sched_barrier(0);
#pragma unroll
            for (int ks = 0; ks < 4; ++ks)
#pragma unroll
                for (int d0 = 0; d0 < 2; ++d0) { const bf16x8 vf = (bf16x8){lo[d0][ks][0], lo[d0][ks][1], lo[d0][ks][2], lo[d0][ks][3], hh[d0][ks][0], hh[d0][ks][1], hh[d0][ks][2], hh[d0][ks][3]};
                    o[d0] = __builtin_amdgcn_mfma_f32_32x32x16_bf16(__builtin_bit_cast(bf16x8, pw[ks]), vf, o[d0], 0, 0, 0); }
        }
        if (t < NTL) {
            bf16x8 kf[2 * ND];
            const lds_cptr kb = (lds_cptr)(lds + LK + (t & 3) * 12288) + hi * 1024 + r32 * 16;
#pragma unroll
            for (int d0 = 0; d0 < ND; ++d0) { kf[2 * d0] = *(const LAS bf16x8*)(kb + d0 * 2048); kf[2 * d0 + 1] = *(const LAS bf16x8*)(kb + d0 * 2048 + 512); }
            asm volatile("s_waitcnt lgkmcnt(0)" ::: "memory"); __builtin_amdgcn_sched_barrier(0);
#pragma unroll
            for (int d0 = 0; d0 < ND; ++d0) {
                if (d0 == 0) { p0 = __builtin_amdgcn_mfma_f32_32x32x16_bf16(kf[0], qr[0], negm, 0, 0, 0); p1 = __builtin_amdgcn_mfma_f32_32x32x16_bf16(kf[1], qr[0], negm, 0, 0, 0); }
                else { p0 = __builtin_amdgcn_mfma_f32_32x32x16_bf16(kf[2 * d0], qr[d0], p0, 0, 0, 0); p1 = __builtin_amdgcn_mfma_f32_32x32x16_bf16(kf[2 * d0 + 1], qr[d0], p1, 0, 0, 0); } }
        }
        if (half == 1) {
            const int last_iss = (t + PD - 1 < NTL - 1) ? t + PD - 1 : NTL - 1; const int allow = last_iss - (t + 1);
            if (allow >= 1) ATT_WAIT_TILES(1); else ATT_WAIT_TILES(0); }
        asm volatile("s_waitcnt lgkmcnt(0)" ::: "memory"); __builtin_amdgcn_s_barrier(); asm volatile("" ::: "memory");
        if (t < NTL) {
            float rm = max3f(p0[0], p0[1], p1[0]);
#pragma unroll
            for (int r = 0; r < 16; ++r) rm = max3f(rm, p0[r], p1[r]);
            { auto rr = __builtin_amdgcn_permlane32_swap(__float_as_uint(rm), __float_as_uint(rm), false, false); rm = fmaxf(__uint_as_float(rr[0]), __uint_as_float(rr[1])); }
            if (t == 0 || __any(rm > THR)) {
                const float dl = (t == 0) ? rm : fmaxf(rm, 0.f);
                mhat += dl;
#pragma unroll
                for (int r = 0; r < 16; ++r) { p0[r] -= dl; p1[r] -= dl; negm[r] = -mhat; }
                const float f = (t == 0) ? 1.f : __builtin_amdgcn_exp2f(-dl); lrun *= f;
                if (hi == 0) wsf[r32] = f;
                LDS_WAIT();
#pragma unroll
                for (int r = 0; r < 16; ++r) { const float a = wsf[crow(r, hi)]; o[0][r] *= a; o[1][r] *= a; }
            }
            float rs = 0.f;
#pragma unroll
            for (int r = 0; r < 16; ++r) { p0[r] = __builtin_amdgcn_exp2f(p0[r]); p1[r] = __builtin_amdgcn_exp2f(p1[r]); rs += p0[r] + p1[r]; }
            lrun += rs;
            pw[0] = (v4u){pk2(p0[0], p0[1]), pk2(p0[2], p0[3]), pk2(p0[4], p0[5]), pk2(p0[6], p0[7])};
            pw[1] = (v4u){pk2(p0[8], p0[9]), pk2(p0[10], p0[11]), pk2(p0[12], p0[13]), pk2(p0[14], p0[15])};
            pw[2] = (v4u){pk2(p1[0], p1[1]), pk2(p1[2], p1[3]), pk2(p1[4], p1[5]), pk2(p1[6], p1[7])};
            pw[3] = (v4u){pk2(p1[8], p1[9]), pk2(p1[10], p1[11]), pk2(p1[12], p1[13]), pk2(p1[14], p1[15])};
        }
        if (t + PD < NTL) { ATT_DMA(t + PD, (t + PD) & 3, vs_iss); vs_iss = (vs_iss == 4) ? 0 : vs_iss + 1; }
        if (half == 0) {
            const int last_iss = (t + PD < NTL - 1) ? t + PD : NTL - 1; const int allow = last_iss - (t + 1);
            if (allow >= 2) ATT_WAIT_TILES(2); else if (allow == 1) ATT_WAIT_TILES(1); else ATT_WAIT_TILES(0); }
        vs_prev = vs_cur; vs_cur = (vs_cur == 4) ? 0 : vs_cur + 1;
        asm volatile("s_waitcnt lgkmcnt(0)" ::: "memory"); __builtin_amdgcn_s_barrier(); asm volatile("" ::: "memory");
    }
    if (half == 0) __builtin_amdgcn_s_barrier();
#undef ATT_DMA
#undef ATT_WAIT_TILES
    pend.o0 = o[0]; pend.o1 = o[1]; pend.l = lrun; pend.qrow0 = qrow0; pend.oc0 = oc0; pend.valid = true;
}
#undef ATT_WAITV
}

namespace att64 {
typedef unsigned short bf16;
using bf16x8=__attribute__((ext_vector_type(8)))short;
using s16x4=__attribute__((ext_vector_type(4)))short;
using f32x16=__attribute__((ext_vector_type(16)))float;
using u32x4=__attribute__((ext_vector_type(4)))unsigned;
constexpr int D=64;
constexpr int NW=8,QBLK=32,QB=QBLK*NW,KVBLK=64;
__device__ __forceinline__ int crow(int r,int hi){return (r&3)+8*(r>>2)+4*hi;}
#define SBAR() __builtin_amdgcn_sched_barrier(0)
constexpr int NSLOT=3, SLOTB=8192;
constexpr int LDS_K=0, LDS_V=NSLOT*SLOTB, LDS_WS=2*NSLOT*SLOTB, LDS_OST=LDS_WS+NW*64*4, LDS_BYTES=LDS_OST+NW*4096;
constexpr float C2=0.125f*1.4426950408889634f;
__device__ __forceinline__ void glds16(const void*gsrc,unsigned lds_dst){unsigned keep;
  asm volatile("s_mov_b32 %0, m0\n\ts_mov_b32 m0, %2\n\ts_nop 0\n\tglobal_load_lds_dwordx4 %1, off\n\ts_mov_b32 m0, %0":"=&s"(keep):"v"(gsrc),"s"(lds_dst):"memory");}
__device__ __forceinline__ float max3f(float a,float b,float c){float r;asm("v_max3_f32 %0, %1, %2, %3":"=v"(r):"v"(a),"v"(b),"v"(c));return r;}
__device__ __forceinline__ float max2f(float a,float b){float r;asm("v_max_f32_e32 %0, %1, %2":"=v"(r):"v"(a),"v"(b));return r;}
__device__ __forceinline__ float fadd_s(float a,float b){float r;asm("v_add_f32_e32 %0, %1, %2":"=v"(r):"v"(a),"v"(b));return r;}
__device__ __forceinline__ float fsub_s(float a,float b){float r;asm("v_sub_f32_e32 %0, %1, %2":"=v"(r):"v"(a),"v"(b));return r;}
typedef float f32x2_t __attribute__((ext_vector_type(2))); typedef __bf16 bf16x2_t __attribute__((ext_vector_type(2)));
__device__ __forceinline__ unsigned cvtpk_s(float lo,float hi){f32x2_t v={lo,hi};bf16x2_t b=__builtin_convertvector(v,bf16x2_t);return __builtin_bit_cast(unsigned,b);}
#define WAIT_BAR(N) asm volatile("s_waitcnt vmcnt(" #N ") lgkmcnt(0)\n\ts_barrier":::"memory")

__device__ __forceinline__ void qkt(f32x16&p0,f32x16&p1,const char*Kslot,const bf16x8*qr,const f32x16&negm,int r32,int hi){
  const char*kb=Kslot+hi*1024+r32*16;
  #pragma unroll
  for(int d0=0;d0<4;++d0){
    const bf16x8 b0=*reinterpret_cast<const bf16x8*>(kb+d0*2048);
    const bf16x8 b1=*reinterpret_cast<const bf16x8*>(kb+d0*2048+512);
    if(d0==0){p0=__builtin_amdgcn_mfma_f32_32x32x16_bf16(b0,qr[0],negm,0,0,0);p1=__builtin_amdgcn_mfma_f32_32x32x16_bf16(b1,qr[0],negm,0,0,0);}
    else{p0=__builtin_amdgcn_mfma_f32_32x32x16_bf16(b0,qr[d0],p0,0,0,0);p1=__builtin_amdgcn_mfma_f32_32x32x16_bf16(b1,qr[d0],p1,0,0,0);}}
}
typedef __attribute__((address_space(3))) const char* lds_cptr;
typedef short v4i16_t __attribute__((ext_vector_type(4)));
__device__ __forceinline__ void kload8(bf16x8*kf,lds_cptr kp){
  kf[0]=*(const __attribute__((address_space(3))) bf16x8*)(kp);      kf[1]=*(const __attribute__((address_space(3))) bf16x8*)(kp+512);
  kf[2]=*(const __attribute__((address_space(3))) bf16x8*)(kp+2048); kf[3]=*(const __attribute__((address_space(3))) bf16x8*)(kp+2560);
  kf[4]=*(const __attribute__((address_space(3))) bf16x8*)(kp+4096); kf[5]=*(const __attribute__((address_space(3))) bf16x8*)(kp+4608);
  kf[6]=*(const __attribute__((address_space(3))) bf16x8*)(kp+6144); kf[7]=*(const __attribute__((address_space(3))) bf16x8*)(kp+6656);
}
__device__ __forceinline__ void kload2(bf16x8*kf,lds_cptr kp,int j){ kf[2*j]=*(const __attribute__((address_space(3))) bf16x8*)(kp+j*2048); kf[2*j+1]=*(const __attribute__((address_space(3))) bf16x8*)(kp+j*2048+512); }
__device__ __forceinline__ s16x4 vtr(lds_cptr p){ return __builtin_bit_cast(s16x4,__builtin_amdgcn_ds_read_tr16_b64_v4i16((__attribute__((address_space(3))) v4i16_t*)p)); }
__device__ __forceinline__ float rowmax(const f32x16&p0,const f32x16&p1){
  float a=max3f(p0[0],p0[1],p1[0]),b=max3f(p0[2],p0[3],p1[1]);a=max3f(a,p1[2],p1[3]);
  #pragma unroll
  for(int r=4;r<16;r+=4){a=max3f(a,p0[r],p0[r+1]);b=max3f(b,p0[r+2],p0[r+3]);a=max3f(a,p1[r],p1[r+1]);b=max3f(b,p1[r+2],p1[r+3]);}
  const float m=max2f(a,b);
  auto rr=__builtin_amdgcn_permlane32_swap(__float_as_uint(m),__float_as_uint(m),false,false);
  return max2f(__uint_as_float(rr[0]),__uint_as_float(rr[1]));
}
__device__ __forceinline__ void pv(f32x16*o,int vb,bf16x8 pa0,bf16x8 pa1,bf16x8 pa2,bf16x8 pa3){
  #pragma unroll
  for(int d0=0;d0<2;++d0){s16x4 lo[4],hi[4];
    #pragma unroll
    for(int ks=0;ks<4;++ks){
      asm volatile("ds_read_b64_tr_b16 %0,%1 offset:%c2":"=&v"(lo[ks]):"v"(vb),"i"(d0*4096+ks*1024):"memory");
      asm volatile("ds_read_b64_tr_b16 %0,%1 offset:%c2":"=&v"(hi[ks]):"v"(vb),"i"(d0*4096+ks*1024+512):"memory");}
    asm volatile("s_waitcnt lgkmcnt(0)":::"memory");SBAR();
    #define PK(k) (bf16x8){lo[k][0],lo[k][1],lo[k][2],lo[k][3],hi[k][0],hi[k][1],hi[k][2],hi[k][3]}
    o[d0]=__builtin_amdgcn_mfma_f32_32x32x16_bf16(pa0,PK(0),o[d0],0,0,0);
    o[d0]=__builtin_amdgcn_mfma_f32_32x32x16_bf16(pa1,PK(1),o[d0],0,0,0);
    o[d0]=__builtin_amdgcn_mfma_f32_32x32x16_bf16(pa2,PK(2),o[d0],0,0,0);
    o[d0]=__builtin_amdgcn_mfma_f32_32x32x16_bf16(pa3,PK(3),o[d0],0,0,0);
    #undef PK
  }
}

#ifndef ATTN_STORE16
#define ATTN_STORE16(p,v) (*(u32x4*)(p)=(v))
#endif
template<int THRL> __device__ __forceinline__ void attn_unit(const bf16*Q,int qp,int qrow0,int qc0,const bf16*__restrict__ K,int kp,int kc0,const bf16*__restrict__ V,int vp,int vc0,bf16*O,int oc0,int kctx0,int klat0,int NT,char*shm,int wave_id){
  wave_id=launder_s(wave_id); const int lane=lane_id_v(),r32=lane&31,hi=lane>>5; const int wid=wave_id;
  const bf16*Qw=Q+(long)(qrow0+wid*QBLK)*qp+qc0;
  const bf16*Kh=K+kc0,*Vh=V+vc0;
  const unsigned lds0=(unsigned)(uintptr_t)shm;
  float*wsf=(float*)(shm+LDS_WS)+wid*64;
  const bf16*ksrc=Kh+(long)lane*kp+wid*8;
  const bf16*vsrc=Vh+(long)(16*(wid&3)+(lane>>2))*vp+(wid>>2)*32+(lane&3)*8;
  #define TROW0(t) ((long)((t)<4?kctx0+64*(t):klat0+64*((t)-4)))
  const unsigned kdst=lds0+LDS_K+wid*1024, vdst=lds0+LDS_V+wid*1024;
  #define DMA_K(t,slot) glds16(ksrc+TROW0(t)*kp,(unsigned)__builtin_amdgcn_readfirstlane(kdst+(slot)))
  #define DMA_V(t,slot) glds16(vsrc+TROW0(t)*vp,(unsigned)__builtin_amdgcn_readfirstlane(vdst+(slot)))
  const int vb0=(int)(lds0+LDS_V)+((lane>>4)&1)*32+(lane&3)*8+(4*hi+((lane&15)>>2))*64;
  const char*Kbase=shm+LDS_K; bf16x8 kf[8];
  const lds_cptr shm3=(lds_cptr)shm; const lds_cptr kp0=shm3+LDS_K+hi*1024+r32*16; const lds_cptr vp0=shm3+LDS_V+((lane>>4)&1)*32+(lane&3)*8+(4*hi+((lane&15)>>2))*64;
  DMA_K(0,0);DMA_V(0,0);DMA_K(1,SLOTB);
  bf16x8 qr[4];
  #pragma unroll
  for(int d0=0;d0<4;++d0)qr[d0]=*reinterpret_cast<const bf16x8*>(&Qw[(long)r32*qp+d0*16+hi*8]);
  float mhat=0.f,l_reg=0.f;f32x16 o[2];o[0]=f32x16{};o[1]=f32x16{};f32x16 negm=f32x16{};asm volatile("":"+v"(negm));
  #define CMASK(P0,P1,t) do{}while(0)
  bool resc=false;
  #define START(P0,P1) do{ const float rm=rowmax(P0,P1); resc=false; \
    { const float dl=rm; mhat=fadd_s(mhat,dl); \
      _Pragma("unroll") for(int r=0;r<16;++r){P0[r]=fsub_s(P0[r],dl);P1[r]=fsub_s(P1[r],dl);} \
      _Pragma("unroll") for(int r=0;r<16;++r)negm[r]=-mhat; asm volatile("":"+v"(negm)); } \
    _Pragma("unroll") for(int r=0;r<16;++r)P0[r]=__builtin_amdgcn_exp2f(P0[r]); }while(0)
  #define RESC() do{ if(resc){ asm volatile("s_waitcnt lgkmcnt(0)":::"memory"); \
      _Pragma("unroll") for(int d_=0;d_<2;++d_) _Pragma("unroll") for(int r=0;r<16;++r)o[d_][r]*=wsf[crow(r,hi)]; } }while(0)
  f32x16 pA0,pA1,pB0,pB1;
  int sl_prev=0,sl_cur=0,sl_next=SLOTB;
  #define ROT() do{sl_prev=sl_cur;sl_cur=sl_next;sl_next=(sl_next==(NSLOT-1)*SLOTB)?0:sl_next+SLOTB;}while(0)
  DMA_K(2,2*SLOTB);
  WAIT_BAR(3);
  qkt(pA0,pA1,Kbase,qr,negm,r32,hi);asm volatile("s_nop 15\n\ts_nop 7":"+v"(pA0),"+v"(pA1));CMASK(pA0,pA1,0);
  START(pA0,pA1);
  _Pragma("unroll") for(int r=0;r<16;++r)pA1[r]=__builtin_amdgcn_exp2f(pA1[r]);
  WAIT_BAR(0);
  DMA_K(3,0);DMA_V(1,SLOTB);
  ROT();
  kload8(kf,kp0+sl_cur);
  WAIT_BAR(2);
  s16x4 vlo[8],vhi[8]; u32x4 pw0,pw1,pw2,pw3;
  #define PKW(P,B) cvtpk_s(P[B],P[B+1])
  #define PAF(k) __builtin_bit_cast(bf16x8,pw##k)
  #define VFR(i) (bf16x8){vlo[i][0],vlo[i][1],vlo[i][2],vlo[i][3],vhi[i][0],vhi[i][1],vhi[i][2],vhi[i][3]}
  #define PIN(x) asm volatile("":"+v"(x))
  #define MX3(a,b,c) __builtin_fmaxf(__builtin_fmaxf((a),(b)),(c))
  #define GAPA(MF,A0,A1,A2,A3,W0,W1,PW) do{ MF; sacc+=A0; sacc+=A1; sacc+=A2; sacc+=A3; PIN(sacc); W0; W1; PIN(PW); SBAR(); }while(0)
  #define EX(v) __builtin_amdgcn_exp2f(v)
  #define GAPB(MF,X,B) do{ MF; X[B]=EX(X[B]); X[B+1]=EX(X[B+1]); X[B+2]=EX(X[B+2]); X[B+3]=EX(X[B+3]); PIN(X); SBAR(); }while(0)
  #define VRD(i) do{ vlo[i]=vtr(vp_+(((i)>>2)*4096+((i)&3)*1024)); vhi[i]=vtr(vp_+(((i)>>2)*4096+((i)&3)*1024+512)); }while(0)
  #define KRD(G,j) do{ if(G){ kload2(kf,kp0+sl_next,j); SBAR(); } }while(0)
  #define STEP(C0,C1,P0,P1,t,GK,GV,GL) do{ SBAR(); \
    const lds_cptr vp_=vp0+sl_prev; \
    VRD(0); SBAR(); float sacc=(P0[0]+P0[1]); \
    GAPA(C0=__builtin_amdgcn_mfma_f32_32x32x16_bf16(kf[0],qr[0],negm,0,0,0), P0[2],P0[3],P0[4],P0[5],     pw0[0]=PKW(P0,0), pw0[1]=PKW(P0,2), pw0); \
    VRD(4); SBAR(); GAPA(C1=__builtin_amdgcn_mfma_f32_32x32x16_bf16(kf[1],qr[0],negm,0,0,0), P0[6],P0[7],P0[8],P0[9],     pw0[2]=PKW(P0,4), pw0[3]=PKW(P0,6), pw0); \
    VRD(1); SBAR(); GAPA(C0=__builtin_amdgcn_mfma_f32_32x32x16_bf16(kf[2],qr[1],C0,0,0,0),   P0[10],P0[11],P0[12],P0[13], pw1[0]=PKW(P0,8), pw1[1]=PKW(P0,10), pw1); \
    VRD(5); SBAR(); GAPA(C1=__builtin_amdgcn_mfma_f32_32x32x16_bf16(kf[3],qr[1],C1,0,0,0),   P0[14],P0[15],P1[0],P1[1],   pw1[2]=PKW(P0,12),pw1[3]=PKW(P0,14), pw1); \
    VRD(2); SBAR(); GAPA(C0=__builtin_amdgcn_mfma_f32_32x32x16_bf16(kf[4],qr[2],C0,0,0,0),   P1[2],P1[3],P1[4],P1[5],     pw2[0]=PKW(P1,0), pw2[1]=PKW(P1,2), pw2); \
    VRD(6); SBAR(); GAPA(C1=__builtin_amdgcn_mfma_f32_32x32x16_bf16(kf[5],qr[2],C1,0,0,0),   P1[6],P1[7],P1[8],P1[9],     pw2[2]=PKW(P1,4), pw2[3]=PKW(P1,6), pw2); \
    VRD(3); SBAR(); GAPA(C0=__builtin_amdgcn_mfma_f32_32x32x16_bf16(kf[6],qr[3],C0,0,0,0),   P1[10],P1[11],P1[12],P1[13], pw3[0]=PKW(P1,8), pw3[1]=PKW(P1,10), pw3); \
    VRD(7); SBAR(); GAPA(C1=__builtin_amdgcn_mfma_f32_32x32x16_bf16(kf[7],qr[3],C1,0,0,0),   P1[14],P1[15],0.f,0.f,       pw3[2]=PKW(P1,12),pw3[3]=PKW(P1,14), pw3); \
    l_reg+=sacc; \
    if(GK){DMA_K((t)+3,sl_cur);} if(GV){DMA_V((t)+1,sl_next);} \
    CMASK(C0,C1,t); \
    { float a=MX3(C0[0],C0[1],C1[0]),b=MX3(C0[2],C0[3],C1[1]); a=MX3(a,C1[2],C1[3]); \
      _Pragma("unroll") for(int r=4;r<16;r+=4){a=MX3(a,C0[r],C0[r+1]);b=MX3(b,C0[r+2],C0[r+3]);a=MX3(a,C1[r],C1[r+1]);b=MX3(b,C1[r+2],C1[r+3]);} \
      float rm=__builtin_fmaxf(a,b); { auto rr=__builtin_amdgcn_permlane32_swap(__float_as_uint(rm),__float_as_uint(rm),false,false); rm=__builtin_fmaxf(__uint_as_float(rr[0]),__uint_as_float(rr[1])); } \
      resc=false; \
      if(__builtin_expect(__any(rm>(float)THRL),0)){ const float dl=__builtin_fmaxf(rm,0.f); mhat+=dl; \
        _Pragma("unroll") for(int r=0;r<16;++r){C0[r]-=dl;C1[r]-=dl;} \
        _Pragma("unroll") for(int r=0;r<16;++r)negm[r]=-mhat; asm volatile("":"+v"(negm)); \
        const float f=__builtin_amdgcn_exp2f(-dl); l_reg*=f; if(hi==0)wsf[r32]=f; resc=true; } } \
    SBAR(); \
    GAPB(o[0]=__builtin_amdgcn_mfma_f32_32x32x16_bf16(PAF(0),VFR(0),o[0],0,0,0), C0,0); \
    GAPB(o[1]=__builtin_amdgcn_mfma_f32_32x32x16_bf16(PAF(0),VFR(4),o[1],0,0,0), C0,4); \
    KRD(GL,0); GAPB(o[0]=__builtin_amdgcn_mfma_f32_32x32x16_bf16(PAF(1),VFR(1),o[0],0,0,0), C0,8); \
    KRD(GL,1); GAPB(o[1]=__builtin_amdgcn_mfma_f32_32x32x16_bf16(PAF(1),VFR(5),o[1],0,0,0), C0,12); \
    KRD(GL,2); GAPB(o[0]=__builtin_amdgcn_mfma_f32_32x32x16_bf16(PAF(2),VFR(2),o[0],0,0,0), C1,0); \
    KRD(GL,3); GAPB(o[1]=__builtin_amdgcn_mfma_f32_32x32x16_bf16(PAF(2),VFR(6),o[1],0,0,0), C1,4); \
    GAPB(o[0]=__builtin_amdgcn_mfma_f32_32x32x16_bf16(PAF(3),VFR(3),o[0],0,0,0), C1,8); \
    GAPB(o[1]=__builtin_amdgcn_mfma_f32_32x32x16_bf16(PAF(3),VFR(7),o[1],0,0,0), C1,12); \
    }while(0)
  int t=1;
  for(;t+5<NT;t+=2){
    STEP(pB0,pB1,pA0,pA1,t,true,true,true);     WAIT_BAR(2); RESC(); ROT();
    STEP(pA0,pA1,pB0,pB1,t+1,true,true,true);   WAIT_BAR(2); RESC(); ROT();
  }
  #define ENDW(tt) do{ if((tt)+3<NT){WAIT_BAR(2);} else if((tt)+2<NT){WAIT_BAR(1);} else {WAIT_BAR(0);} }while(0)
  for(;t+1<NT;t+=2){
    STEP(pB0,pB1,pA0,pA1,t,(t+3<NT),(t+1<NT),(t+1<NT));       ENDW(t);   RESC(); ROT();
    STEP(pA0,pA1,pB0,pB1,t+1,(t+4<NT),(t+2<NT),(t+2<NT));     ENDW(t+1); RESC(); ROT();
  }
  STEP(pB0,pB1,pA0,pA1,NT-1,false,false,false); RESC();
  { float sacc=pB0[0]+pB0[1]; _Pragma("unroll") for(int r=2;r<16;++r)sacc+=pB0[r]; _Pragma("unroll") for(int r=0;r<16;++r)sacc+=pB1[r]; l_reg+=sacc;
    pw0=(u32x4){PKW(pB0,0),PKW(pB0,2),PKW(pB0,4),PKW(pB0,6)};pw1=(u32x4){PKW(pB0,8),PKW(pB0,10),PKW(pB0,12),PKW(pB0,14)};pw2=(u32x4){PKW(pB1,0),PKW(pB1,2),PKW(pB1,4),PKW(pB1,6)};pw3=(u32x4){PKW(pB1,8),PKW(pB1,10),PKW(pB1,12),PKW(pB1,14)};
    SBAR(); pv(o,vb0+sl_cur,PAF(0),PAF(1),PAF(2),PAF(3)); }
  #undef PKW
  #undef PAF
  #undef VFR
  #undef PIN
  #undef MX3
  #undef GAPA
  #undef GAPB
  #undef EX
  #undef VRD
  #undef KRD
  #undef STEP
  #undef ENDW
  {auto rr=__builtin_amdgcn_permlane32_swap(__float_as_uint(l_reg),__float_as_uint(l_reg),false,false);l_reg=__uint_as_float(rr[0])+__uint_as_float(rr[1]);}
  if(hi==0)wsf[32+r32]=l_reg;asm volatile("s_waitcnt lgkmcnt(0)":::"memory");
  float rli[16];
  #pragma unroll
  for(int r=0;r<16;++r)rli[r]=__builtin_amdgcn_rcpf(wsf[32+crow(r,hi)]);
  bf16*Ow=O+(long)(qrow0+wid*QBLK)*1024+oc0;
  { bf16*stg=(bf16*)(shm+LDS_OST)+wid*2048;
    #pragma unroll
    for(int r=0;r<16;++r){const int orow=crow(r,hi);
      #pragma unroll
      for(int d0=0;d0<2;++d0)stg[orow*64+d0*32+r32]=(bf16)(cvtpk_s(o[d0][r]*rli[r],0.f)&0xffffu);}
    asm volatile("s_waitcnt lgkmcnt(0)":::"memory");
    #pragma unroll
    for(int i=0;i<4;++i){const int row=i*8+(lane>>3),ch=lane&7; const u32x4 v=*(const u32x4*)(stg+row*64+ch*8); ATTN_STORE16(Ow+(long)row*1024+ch*8,v);} }
  asm volatile("s_waitcnt lgkmcnt(0)\n\ts_barrier":::"memory");
  #undef DMA_K
  #undef DMA_V
  #undef TROW0
  #undef CMASK
  #undef START
  #undef RESC
  #undef ROT
}
#undef SBAR
#undef WAIT_BAR
}

namespace att96 {
typedef unsigned short bf16;
using bf16x8=__attribute__((ext_vector_type(8)))short;
using s16x4=__attribute__((ext_vector_type(4)))short;
using f32x16=__attribute__((ext_vector_type(16)))float;
using u32x4=__attribute__((ext_vector_type(4)))unsigned;
constexpr int D=64;
constexpr int NW=8,QBLK=32,QB=QBLK*NW,KVBLK=64;
__device__ __forceinline__ int crow(int r,int hi){return (r&3)+8*(r>>2)+4*hi;}
#define SBAR() __builtin_amdgcn_sched_barrier(0)
constexpr int NSLOT=3, SLOTB=8192, KSLOTB=12288;
#define KOFF(sl) ((sl)+((sl)>>1))
constexpr int LDS_K=0, LDS_V=NSLOT*KSLOTB, LDS_WS=LDS_V+NSLOT*SLOTB, LDS_OST=LDS_WS+NW*64*4, LDS_BYTES=LDS_OST+NW*4096;
constexpr float C2=0.125f*1.4426950408889634f;
__device__ __forceinline__ void glds16(const void*gsrc,unsigned lds_dst){unsigned keep;
  asm volatile("s_mov_b32 %0, m0\n\ts_mov_b32 m0, %2\n\ts_nop 0\n\tglobal_load_lds_dwordx4 %1, off\n\ts_mov_b32 m0, %0":"=&s"(keep):"v"(gsrc),"s"(lds_dst):"memory");}
__device__ __forceinline__ float max3f(float a,float b,float c){float r;asm("v_max3_f32 %0, %1, %2, %3":"=v"(r):"v"(a),"v"(b),"v"(c));return r;}
__device__ __forceinline__ float max2f(float a,float b){float r;asm("v_max_f32_e32 %0, %1, %2":"=v"(r):"v"(a),"v"(b));return r;}
__device__ __forceinline__ float fadd_s(float a,float b){float r;asm("v_add_f32_e32 %0, %1, %2":"=v"(r):"v"(a),"v"(b));return r;}
__device__ __forceinline__ float fsub_s(float a,float b){float r;asm("v_sub_f32_e32 %0, %1, %2":"=v"(r):"v"(a),"v"(b));return r;}
typedef float f32x2_t __attribute__((ext_vector_type(2))); typedef __bf16 bf16x2_t __attribute__((ext_vector_type(2)));
__device__ __forceinline__ unsigned cvtpk_s(float lo,float hi){f32x2_t v={lo,hi};bf16x2_t b=__builtin_convertvector(v,bf16x2_t);return __builtin_bit_cast(unsigned,b);}
#define WAIT_BAR(N) asm volatile("s_waitcnt vmcnt(" #N ") lgkmcnt(0)\n\ts_barrier":::"memory")

__device__ __forceinline__ void qkt(f32x16&p0,f32x16&p1,const char*Kslot,const bf16x8*qr,const f32x16&negm,int r32,int hi){
  const char*kb=Kslot+hi*1024+r32*16;
  #pragma unroll
  for(int d0=0;d0<6;++d0){
    const bf16x8 b0=*reinterpret_cast<const bf16x8*>(kb+d0*2048);
    const bf16x8 b1=*reinterpret_cast<const bf16x8*>(kb+d0*2048+512);
    if(d0==0){p0=__builtin_amdgcn_mfma_f32_32x32x16_bf16(b0,qr[0],negm,0,0,0);p1=__builtin_amdgcn_mfma_f32_32x32x16_bf16(b1,qr[0],negm,0,0,0);}
    else{p0=__builtin_amdgcn_mfma_f32_32x32x16_bf16(b0,qr[d0],p0,0,0,0);p1=__builtin_amdgcn_mfma_f32_32x32x16_bf16(b1,qr[d0],p1,0,0,0);}}
}
typedef __attribute__((address_space(3))) const char* lds_cptr;
typedef short v4i16_t __attribute__((ext_vector_type(4)));
__device__ __forceinline__ void kload8(bf16x8*kf,lds_cptr kp){
  kf[0]=*(const __attribute__((address_space(3))) bf16x8*)(kp);      kf[1]=*(const __attribute__((address_space(3))) bf16x8*)(kp+512);
  kf[2]=*(const __attribute__((address_space(3))) bf16x8*)(kp+2048); kf[3]=*(const __attribute__((address_space(3))) bf16x8*)(kp+2560);
  kf[4]=*(const __attribute__((address_space(3))) bf16x8*)(kp+4096); kf[5]=*(const __attribute__((address_space(3))) bf16x8*)(kp+4608);
  kf[6]=*(const __attribute__((address_space(3))) bf16x8*)(kp+6144); kf[7]=*(const __attribute__((address_space(3))) bf16x8*)(kp+6656);
  kf[8]=*(const __attribute__((address_space(3))) bf16x8*)(kp+8192); kf[9]=*(const __attribute__((address_space(3))) bf16x8*)(kp+8704);
  kf[10]=*(const __attribute__((address_space(3))) bf16x8*)(kp+10240); kf[11]=*(const __attribute__((address_space(3))) bf16x8*)(kp+10752);
}
__device__ __forceinline__ void kload2(bf16x8*kf,lds_cptr kp,int j){ kf[2*j]=*(const __attribute__((address_space(3))) bf16x8*)(kp+j*2048); kf[2*j+1]=*(const __attribute__((address_space(3))) bf16x8*)(kp+j*2048+512); }
__device__ __forceinline__ s16x4 vtr(lds_cptr p){ return __builtin_bit_cast(s16x4,__builtin_amdgcn_ds_read_tr16_b64_v4i16((__attribute__((address_space(3))) v4i16_t*)p)); }
__device__ __forceinline__ float rowmax(const f32x16&p0,const f32x16&p1){
  float a=max3f(p0[0],p0[1],p1[0]),b=max3f(p0[2],p0[3],p1[1]);a=max3f(a,p1[2],p1[3]);
  #pragma unroll
  for(int r=4;r<16;r+=4){a=max3f(a,p0[r],p0[r+1]);b=max3f(b,p0[r+2],p0[r+3]);a=max3f(a,p1[r],p1[r+1]);b=max3f(b,p1[r+2],p1[r+3]);}
  const float m=max2f(a,b);
  auto rr=__builtin_amdgcn_permlane32_swap(__float_as_uint(m),__float_as_uint(m),false,false);
  return max2f(__uint_as_float(rr[0]),__uint_as_float(rr[1]));
}
__device__ __forceinline__ void pv(f32x16*o,int vb,bf16x8 pa0,bf16x8 pa1,bf16x8 pa2,bf16x8 pa3){
  #pragma unroll
  for(int d0=0;d0<2;++d0){s16x4 lo[4],hi[4];
    #pragma unroll
    for(int ks=0;ks<4;++ks){
      asm volatile("ds_read_b64_tr_b16 %0,%1 offset:%c2":"=&v"(lo[ks]):"v"(vb),"i"(d0*4096+ks*1024):"memory");
      asm volatile("ds_read_b64_tr_b16 %0,%1 offset:%c2":"=&v"(hi[ks]):"v"(vb),"i"(d0*4096+ks*1024+512):"memory");}
    asm volatile("s_waitcnt lgkmcnt(0)":::"memory");SBAR();
    #define PK(k) (bf16x8){lo[k][0],lo[k][1],lo[k][2],lo[k][3],hi[k][0],hi[k][1],hi[k][2],hi[k][3]}
    o[d0]=__builtin_amdgcn_mfma_f32_32x32x16_bf16(pa0,PK(0),o[d0],0,0,0);
    o[d0]=__builtin_amdgcn_mfma_f32_32x32x16_bf16(pa1,PK(1),o[d0],0,0,0);
    o[d0]=__builtin_amdgcn_mfma_f32_32x32x16_bf16(pa2,PK(2),o[d0],0,0,0);
    o[d0]=__builtin_amdgcn_mfma_f32_32x32x16_bf16(pa3,PK(3),o[d0],0,0,0);
    #undef PK
  }
}

#ifndef ATTN_STORE16
#define ATTN_STORE16(p,v) (*(u32x4*)(p)=(v))
#endif
template<int THRL> __device__ __forceinline__ void attn_unit(const bf16*Q,int qp,int qrow0,int qc0,const bf16*__restrict__ K,int kp,int kc0,const bf16*__restrict__ V,int vp,int vc0,bf16*O,int oc0,int kctx0,int klat0,int NT,char*shm,int wave_id){
  wave_id=launder_s(wave_id); const int lane=lane_id_v(),r32=lane&31,hi=lane>>5; const int wid=wave_id;
  const bf16*Qw=Q+(long)(qrow0+wid*QBLK)*qp+qc0;
  const bf16*Kh=K+kc0,*Vh=V+vc0;
  const unsigned lds0=(unsigned)(uintptr_t)shm;
  float*wsf=(float*)(shm+LDS_WS)+wid*64;
  const bf16*ksrc=Kh+(long)lane*kp+wid*8;
  const bf16*vsrc=Vh+(long)(16*(wid&3)+(lane>>2))*vp+(wid>>2)*32+(lane&3)*8;
  #define TROW0(t) ((long)((t)<4?kctx0+64*(t):klat0+64*((t)-4)))
  const unsigned kdst=lds0+LDS_K+wid*1024, kdst2=lds0+LDS_K+8192+(wid&3)*1024, vdst=lds0+LDS_V+wid*1024;
  const int k2off=(8+(wid&3)-wid)*8;
  #define DMA_K(t,slot) do{ glds16(ksrc+TROW0(t)*kp,(unsigned)__builtin_amdgcn_readfirstlane(kdst+KOFF(slot))); glds16(ksrc+TROW0(t)*kp+k2off,(unsigned)__builtin_amdgcn_readfirstlane(kdst2+KOFF(slot))); }while(0)
  #define DMA_V(t,slot) glds16(vsrc+TROW0(t)*vp,(unsigned)__builtin_amdgcn_readfirstlane(vdst+(slot)))
  const int vb0=(int)(lds0+LDS_V)+((lane>>4)&1)*32+(lane&3)*8+(4*hi+((lane&15)>>2))*64;
  const char*Kbase=shm+LDS_K; bf16x8 kf[12];
  const lds_cptr shm3=(lds_cptr)shm; const lds_cptr kp0=shm3+LDS_K+hi*1024+r32*16; const lds_cptr vp0=shm3+LDS_V+((lane>>4)&1)*32+(lane&3)*8+(4*hi+((lane&15)>>2))*64;
  DMA_K(0,0);DMA_V(0,0);DMA_K(1,SLOTB);
  bf16x8 qr[6];
  #pragma unroll
  for(int d0=0;d0<6;++d0)qr[d0]=*reinterpret_cast<const bf16x8*>(&Qw[(long)r32*qp+d0*16+hi*8]);
  float mhat=0.f,l_reg=0.f;f32x16 o[2];o[0]=f32x16{};o[1]=f32x16{};f32x16 negm=f32x16{};asm volatile("":"+v"(negm));
  #define CMASK(P0,P1,t) do{}while(0)
  bool resc=false;
  #define START(P0,P1) do{ const float rm=rowmax(P0,P1); resc=false; \
    { const float dl=rm; mhat=fadd_s(mhat,dl); \
      _Pragma("unroll") for(int r=0;r<16;++r){P0[r]=fsub_s(P0[r],dl);P1[r]=fsub_s(P1[r],dl);} \
      _Pragma("unroll") for(int r=0;r<16;++r)negm[r]=-mhat; asm volatile("":"+v"(negm)); } \
    _Pragma("unroll") for(int r=0;r<16;++r)P0[r]=__builtin_amdgcn_exp2f(P0[r]); }while(0)
  #define RESC() do{ if(resc){ asm volatile("s_waitcnt lgkmcnt(0)":::"memory"); \
      _Pragma("unroll") for(int d_=0;d_<2;++d_) _Pragma("unroll") for(int r=0;r<16;++r)o[d_][r]*=wsf[crow(r,hi)]; } }while(0)
  f32x16 pA0,pA1,pB0,pB1;
  int sl_prev=0,sl_cur=0,sl_next=SLOTB;
  #define ROT() do{sl_prev=sl_cur;sl_cur=sl_next;sl_next=(sl_next==(NSLOT-1)*SLOTB)?0:sl_next+SLOTB;}while(0)
  DMA_K(2,2*SLOTB);
  WAIT_BAR(5);
  qkt(pA0,pA1,Kbase,qr,negm,r32,hi);asm volatile("s_nop 15\n\ts_nop 7":"+v"(pA0),"+v"(pA1));CMASK(pA0,pA1,0);
  START(pA0,pA1);
  _Pragma("unroll") for(int r=0;r<16;++r)pA1[r]=__builtin_amdgcn_exp2f(pA1[r]);
  WAIT_BAR(0);
  DMA_K(3,0);DMA_V(1,SLOTB);
  ROT();
  kload8(kf,kp0+KOFF(sl_cur));
  WAIT_BAR(3);
  s16x4 vlo[8],vhi[8]; u32x4 pw0,pw1,pw2,pw3;
  #define PKW(P,B) cvtpk_s(P[B],P[B+1])
  #define PAF(k) __builtin_bit_cast(bf16x8,pw##k)
  #define VFR(i) (bf16x8){vlo[i][0],vlo[i][1],vlo[i][2],vlo[i][3],vhi[i][0],vhi[i][1],vhi[i][2],vhi[i][3]}
  #define PIN(x) asm volatile("":"+v"(x))
  #define MX3(a,b,c) __builtin_fmaxf(__builtin_fmaxf((a),(b)),(c))
  #define GAPA(MF,A0,A1,A2,A3,W0,W1,PW) do{ MF; sacc+=A0; sacc+=A1; sacc+=A2; sacc+=A3; PIN(sacc); W0; W1; PIN(PW); SBAR(); }while(0)
  #define EX(v) __builtin_amdgcn_exp2f(v)
  #define GAPB(MF,X,B) do{ MF; X[B]=EX(X[B]); X[B+1]=EX(X[B+1]); X[B+2]=EX(X[B+2]); X[B+3]=EX(X[B+3]); PIN(X); SBAR(); }while(0)
  #define VRD(i) do{ vlo[i]=vtr(vp_+(((i)>>2)*4096+((i)&3)*1024)); vhi[i]=vtr(vp_+(((i)>>2)*4096+((i)&3)*1024+512)); }while(0)
  #define KRD(G,j) do{ if(G){ kload2(kf,kp0+KOFF(sl_next),j); SBAR(); } }while(0)
  #define STEP(C0,C1,P0,P1,t,GK,GV,GL) do{ SBAR(); \
    const lds_cptr vp_=vp0+sl_prev; \
    VRD(0); SBAR(); float sacc=(P0[0]+P0[1]); \
    GAPA(C0=__builtin_amdgcn_mfma_f32_32x32x16_bf16(kf[0],qr[0],negm,0,0,0), P0[2],P0[3],P0[4],P0[5],     pw0[0]=PKW(P0,0), pw0[1]=PKW(P0,2), pw0); \
    VRD(4); SBAR(); GAPA(C1=__builtin_amdgcn_mfma_f32_32x32x16_bf16(kf[1],qr[0],negm,0,0,0), P0[6],P0[7],P0[8],P0[9],     pw0[2]=PKW(P0,4), pw0[3]=PKW(P0,6), pw0); \
    VRD(1); SBAR(); GAPA(C0=__builtin_amdgcn_mfma_f32_32x32x16_bf16(kf[2],qr[1],C0,0,0,0),   P0[10],P0[11],P0[12],P0[13], pw1[0]=PKW(P0,8), pw1[1]=PKW(P0,10), pw1); \
    VRD(5); SBAR(); GAPA(C1=__builtin_amdgcn_mfma_f32_32x32x16_bf16(kf[3],qr[1],C1,0,0,0),   P0[14],P0[15],P1[0],P1[1],   pw1[2]=PKW(P0,12),pw1[3]=PKW(P0,14), pw1); \
    VRD(2); SBAR(); GAPA(C0=__builtin_amdgcn_mfma_f32_32x32x16_bf16(kf[4],qr[2],C0,0,0,0),   P1[2],P1[3],P1[4],P1[5],     pw2[0]=PKW(P1,0), pw2[1]=PKW(P1,2), pw2); \
    VRD(6); SBAR(); GAPA(C1=__builtin_amdgcn_mfma_f32_32x32x16_bf16(kf[5],qr[2],C1,0,0,0),   P1[6],P1[7],P1[8],P1[9],     pw2[2]=PKW(P1,4), pw2[3]=PKW(P1,6), pw2); \
    VRD(3); SBAR(); GAPA(C0=__builtin_amdgcn_mfma_f32_32x32x16_bf16(kf[6],qr[3],C0,0,0,0),   P1[10],P1[11],P1[12],P1[13], pw3[0]=PKW(P1,8), pw3[1]=PKW(P1,10), pw3); \
    VRD(7); SBAR(); GAPA(C1=__builtin_amdgcn_mfma_f32_32x32x16_bf16(kf[7],qr[3],C1,0,0,0),   P1[14],P1[15],0.f,0.f,       pw3[2]=PKW(P1,12),pw3[3]=PKW(P1,14), pw3); \
    C0=__builtin_amdgcn_mfma_f32_32x32x16_bf16(kf[8],qr[4],C0,0,0,0); C1=__builtin_amdgcn_mfma_f32_32x32x16_bf16(kf[9],qr[4],C1,0,0,0); C0=__builtin_amdgcn_mfma_f32_32x32x16_bf16(kf[10],qr[5],C0,0,0,0); C1=__builtin_amdgcn_mfma_f32_32x32x16_bf16(kf[11],qr[5],C1,0,0,0); SBAR(); \
    l_reg+=sacc; \
    if(GK){DMA_K((t)+3,sl_cur);} if(GV){DMA_V((t)+1,sl_next);} \
    CMASK(C0,C1,t); \
    { float a=MX3(C0[0],C0[1],C1[0]),b=MX3(C0[2],C0[3],C1[1]); a=MX3(a,C1[2],C1[3]); \
      _Pragma("unroll") for(int r=4;r<16;r+=4){a=MX3(a,C0[r],C0[r+1]);b=MX3(b,C0[r+2],C0[r+3]);a=MX3(a,C1[r],C1[r+1]);b=MX3(b,C1[r+2],C1[r+3]);} \
      float rm=__builtin_fmaxf(a,b); { auto rr=__builtin_amdgcn_permlane32_swap(__float_as_uint(rm),__float_as_uint(rm),false,false); rm=__builtin_fmaxf(__uint_as_float(rr[0]),__uint_as_float(rr[1])); } \
      resc=false; \
      if(__builtin_expect(__any(rm>(float)THRL),0)){ const float dl=__builtin_fmaxf(rm,0.f); mhat+=dl; \
        _Pragma("unroll") for(int r=0;r<16;++r){C0[r]-=dl;C1[r]-=dl;} \
        _Pragma("unroll") for(int r=0;r<16;++r)negm[r]=-mhat; asm volatile("":"+v"(negm)); \
        const float f=__builtin_amdgcn_exp2f(-dl); l_reg*=f; if(hi==0)wsf[r32]=f; resc=true; } } \
    SBAR(); \
    GAPB(o[0]=__builtin_amdgcn_mfma_f32_32x32x16_bf16(PAF(0),VFR(0),o[0],0,0,0), C0,0); \
    GAPB(o[1]=__builtin_amdgcn_mfma_f32_32x32x16_bf16(PAF(0),VFR(4),o[1],0,0,0), C0,4); \
    KRD(GL,0); GAPB(o[0]=__builtin_amdgcn_mfma_f32_32x32x16_bf16(PAF(1),VFR(1),o[0],0,0,0), C0,8); \
    KRD(GL,1); GAPB(o[1]=__builtin_amdgcn_mfma_f32_32x32x16_bf16(PAF(1),VFR(5),o[1],0,0,0), C0,12); \
    KRD(GL,2); GAPB(o[0]=__builtin_amdgcn_mfma_f32_32x32x16_bf16(PAF(2),VFR(2),o[0],0,0,0), C1,0); \
    KRD(GL,3); GAPB(o[1]=__builtin_amdgcn_mfma_f32_32x32x16_bf16(PAF(2),VFR(6),o[1],0,0,0), C1,4); \
    KRD(GL,4); GAPB(o[0]=__builtin_amdgcn_mfma_f32_32x32x16_bf16(PAF(3),VFR(3),o[0],0,0,0), C1,8); \
    KRD(GL,5); GAPB(o[1]=__builtin_amdgcn_mfma_f32_32x32x16_bf16(PAF(3),VFR(7),o[1],0,0,0), C1,12); \
    }while(0)
  int t=1;
  for(;t+5<NT;t+=2){
    STEP(pB0,pB1,pA0,pA1,t,true,true,true);     WAIT_BAR(3); RESC(); ROT();
    STEP(pA0,pA1,pB0,pB1,t+1,true,true,true);   WAIT_BAR(3); RESC(); ROT();
  }
  #define ENDW(tt) do{ if((tt)+3<NT){WAIT_BAR(3);} else if((tt)+2<NT){WAIT_BAR(1);} else {WAIT_BAR(0);} }while(0)
  for(;t+1<NT;t+=2){
    STEP(pB0,pB1,pA0,pA1,t,(t+3<NT),(t+1<NT),(t+1<NT));       ENDW(t);   RESC(); ROT();
    STEP(pA0,pA1,pB0,pB1,t+1,(t+4<NT),(t+2<NT),(t+2<NT));     ENDW(t+1); RESC(); ROT();
  }
  STEP(pB0,pB1,pA0,pA1,NT-1,false,false,false); RESC();
  { float sacc=pB0[0]+pB0[1]; _Pragma("unroll") for(int r=2;r<16;++r)sacc+=pB0[r]; _Pragma("unroll") for(int r=0;r<16;++r)sacc+=pB1[r]; l_reg+=sacc;
    pw0=(u32x4){PKW(pB0,0),PKW(pB0,2),PKW(pB0,4),PKW(pB0,6)};pw1=(u32x4){PKW(pB0,8),PKW(pB0,10),PKW(pB0,12),PKW(pB0,14)};pw2=(u32x4){PKW(pB1,0),PKW(pB1,2),PKW(pB1,4),PKW(pB1,6)};pw3=(u32x4){PKW(pB1,8),PKW(pB1,10),PKW(pB1,12),PKW(pB1,14)};
    SBAR(); pv(o,vb0+sl_cur,PAF(0),PAF(1),PAF(2),PAF(3)); }
  #undef PKW
  #undef PAF
  #undef VFR
  #undef PIN
  #undef MX3
  #undef GAPA
  #undef GAPB
  #undef EX
  #undef VRD
  #undef KRD
  #undef STEP
  #undef ENDW
  {auto rr=__builtin_amdgcn_permlane32_swap(__float_as_uint(l_reg),__float_as_uint(l_reg),false,false);l_reg=__uint_as_float(rr[0])+__uint_as_float(rr[1]);}
  if(hi==0)wsf[32+r32]=l_reg;asm volatile("s_waitcnt lgkmcnt(0)":::"memory");
  float rli[16];
  #pragma unroll
  for(int r=0;r<16;++r)rli[r]=__builtin_amdgcn_rcpf(wsf[32+crow(r,hi)]);
  bf16*Ow=O+(long)(qrow0+wid*QBLK)*1024+oc0;
  { bf16*stg=(bf16*)(shm+LDS_OST)+wid*2048;
    #pragma unroll
    for(int r=0;r<16;++r){const int orow=crow(r,hi);
      #pragma unroll
      for(int d0=0;d0<2;++d0)stg[orow*64+d0*32+r32]=(bf16)(cvtpk_s(o[d0][r]*rli[r],0.f)&0xffffu);}
    asm volatile("s_waitcnt lgkmcnt(0)":::"memory");
    #pragma unroll
    for(int i=0;i<4;++i){const int row=i*8+(lane>>3),ch=lane&7; const u32x4 v=*(const u32x4*)(stg+row*64+ch*8); ATTN_STORE16(Ow+(long)row*1024+ch*8,v);} }
  asm volatile("s_waitcnt lgkmcnt(0)\n\ts_barrier":::"memory");
  #undef DMA_K
  #undef DMA_V
  #undef TROW0
  #undef CMASK
  #undef START
  #undef RESC
  #undef ROT
}
#undef SBAR
#undef WAIT_BAR
#undef KOFF
}

struct Args { const float* in[27]; float* out; unsigned char* ws; int ph_lo, ph_hi; };
struct Frame {
    LAS unsigned char* lds; unsigned char* ws; gu32* ctl; int wave, G, gw, NGW;
};
__device__ __forceinline__ int lthread(int wave) { return wave * 64 + lane_id_v(); }

template <int MODE>
__device__ __forceinline__ void conv_item(const float* W, int K, int N, bf16* WT, LAS float* scr, int item, int lane) {
    const int nblk = (N + 63) / 64, kb = item / nblk, nb = item % nblk, k0 = 64 * kb, n0 = 64 * nb;
    f32x4 v[16];
    const int cc = (lane & 15) * 4, rk = lane >> 4;
    const bool ok = (n0 + cc) < N;
#pragma unroll
    for (int i = 0; i < 16; ++i) v[i] = ok ? *(const f32x4*)(W + (size_t)(k0 + 4 * i + rk) * N + n0 + cc) : (f32x4){0.f, 0.f, 0.f, 0.f};
#pragma unroll
    for (int i = 0; i < 16; ++i) { LAS float* s = scr + (4 * i + rk) * 65 + cc; s[0] = v[i][0]; s[1] = v[i][1]; s[2] = v[i][2]; s[3] = v[i][3]; }
    LDS_WAIT(); asm volatile("" ::: "memory");
    const int c = lane & 7;
#pragma unroll
    for (int j = 0; j < 8; ++j) { const int n = (lane >> 3) + 8 * j; const LAS float* s = scr + (8 * c) * 65 + n;
        v4u o; o.x = pk2(s[0], s[65]); o.y = pk2(s[2 * 65], s[3 * 65]); o.z = pk2(s[4 * 65], s[5 * 65]); o.w = pk2(s[6 * 65], s[7 * 65]);
        const int ng = n0 + n; if (ng < N) { const int dr = (MODE == 1) ? ((ng >> 8) * 256 + (ng & 1) * 128 + ((ng >> 1) & 127)) : ng; *(v4u*)(WT + (size_t)dr * K + k0 + 8 * c) = o; } }
    LDS_WAIT(); asm volatile("" ::: "memory");
}

__device__ __forceinline__ void prologue(Frame& F, const Args& a) {
    const int f_tid = lthread(F.wave), f_lane = f_tid & 63;
    unsigned char* ws = F.ws;
    {
        LAS float* scr = (LAS float*)(F.lds + F.wave * 16640);
        struct M { const float* src; int K, N; size_t dst; };
        const int I_FO = 16 * 16, I_MIN = 16 * 11, I_QB = 6 * 24, I_KVB = 4 * 32, I_MO = 256, I_GQKV = 16 * 24, I_GO = 256;
        const int NSMALL = 2 * I_FO + I_MIN + I_QB + I_KVB + I_MO + I_GQKV + I_GO;
        for (int it = F.gw; it < NSMALL; it += F.NGW) {
            int r = it;
            if (r < 2 * I_FO) { const int j = r / I_FO; conv_item<0>(a.in[10] + (size_t)j * D * D, D, D, (bf16*)(ws + WS_WFOUT) + (size_t)j * D * D, scr, r % I_FO, f_lane); continue; } r -= 2 * I_FO;
            if (r < I_MIN) { conv_item<0>(a.in[11], D, MLA_IN, (bf16*)(ws + WS_WMIN), scr, r, f_lane); continue; } r -= I_MIN;
            if (r < I_QB) { conv_item<0>(a.in[13], MLA_QL, 1536, (bf16*)(ws + WS_WMQB), scr, r, f_lane); continue; } r -= I_QB;
            if (r < I_KVB) { conv_item<0>(a.in[15], MLA_KVL, 2048, (bf16*)(ws + WS_WMKVB), scr, r, f_lane); continue; } r -= I_KVB;
            if (r < I_MO) { conv_item<0>(a.in[16], D, D, (bf16*)(ws + WS_WMO), scr, r, f_lane); continue; } r -= I_MO;
            if (r < I_GQKV) { conv_item<0>(a.in[17], D, GQA_QKV, (bf16*)(ws + WS_WGQKV), scr, r, f_lane); continue; } r -= I_GQKV;
            conv_item<0>(a.in[20], D, D, (bf16*)(ws + WS_WGO), scr, r, f_lane);
        }
    }
    __syncthreads();
    {
        LAS float* cmax = (LAS float*)F.lds;
        LAS float* cinv = cmax + 512;
        LAS unsigned* scr8 = (LAS unsigned*)(F.lds + 4096) + F.wave * (64 * 33);
        const int cc = (f_lane & 15) * 4, rk = f_lane >> 4;
        constexpr int NGU = DEPTH * NE * 32, NDN = DEPTH * NE * 16;
        for (int it = blockIdx.x; it < NGU + NDN; it += F.G) {
            const bool dn = it >= NGU; const int q_ = dn ? it - NGU : it; const int le = dn ? (q_ >> 4) : (q_ >> 5), strip = dn ? (q_ & 15) : (q_ & 31);
            const int N = dn ? 1024 : 2048;
            const float* W = (dn ? a.in[25] + (size_t)le * DFF * D : a.in[23] + (size_t)le * D * 2048) + strip * 64 + cc;
            f32x4 v[32];
#pragma unroll
            for (int i = 0; i < 32; ++i) v[i] = *(const f32x4*)(W + (size_t)(F.wave * 128 + 16 * (i >> 2) + 4 * rk + (i & 3)) * N);
            f32x4 mx = (f32x4){0.f, 0.f, 0.f, 0.f};
#pragma unroll
            for (int i = 0; i < 32; ++i) { mx[0] = fmaxf(mx[0], fabsf(v[i][0])); mx[1] = fmaxf(mx[1], fabsf(v[i][1])); mx[2] = fmaxf(mx[2], fabsf(v[i][2])); mx[3] = fmaxf(mx[3], fabsf(v[i][3])); }
#pragma unroll
            for (int q = 0; q < 4; ++q) { mx[q] = fmaxf(mx[q], shx(mx[q], 16, f_lane)); mx[q] = fmaxf(mx[q], shx(mx[q], 32, f_lane)); }
            __syncthreads();
            if (rk == 0) { LAS float* d = cmax + F.wave * 64 + cc; d[0] = mx[0]; d[1] = mx[1]; d[2] = mx[2]; d[3] = mx[3]; }
            __syncthreads();
            const float target = dn ? 240.f : 127.f;
            if (f_tid < 64) { float m8 = 0.f;
#pragma unroll
                for (int w = 0; w < 8; ++w) m8 = fmaxf(m8, cmax[w * 64 + f_tid]);
                const int ng = strip * 64 + f_tid, dr = dn ? ng : (ng >> 8) * 256 + (ng & 1) * 128 + ((ng >> 1) & 127);
                float* sc = dn ? (float*)(ws + WS_SWDN) + (size_t)le * 1024 : (float*)(ws + WS_SWGU) + (size_t)le * 2048;
                sc[dr] = (m8 > 0.f) ? m8 / target : 1.f;
                cinv[f_tid] = (m8 > 0.f) ? target / m8 : 0.f; }
            __syncthreads();
            const f32x4 iv = *(const LAS f32x4*)(cinv + cc);
#pragma unroll
            for (int ip = 0; ip < 8; ++ip) {
#pragma unroll
                for (int q = 0; q < 4; ++q) { unsigned w = 0;
                    if (dn) { int t = __builtin_amdgcn_cvt_pk_fp8_f32(v[4 * ip][q] * iv[q], v[4 * ip + 1][q] * iv[q], 0, false); t = __builtin_amdgcn_cvt_pk_fp8_f32(v[4 * ip + 2][q] * iv[q], v[4 * ip + 3][q] * iv[q], t, true); w = (unsigned)t; }
                    else {
#pragma unroll
                        for (int j = 0; j < 4; ++j) { int qi = __float2int_rn(v[4 * ip + j][q] * iv[q]); qi = qi > 127 ? 127 : (qi < -127 ? -127 : qi); w |= ((unsigned)qi & 255u) << (8 * j); } }
                    scr8[(cc + q) * 33 + 4 * ip + rk] = w; } }
            LDS_WAIT(); asm volatile("" ::: "memory");
            { const int c8 = f_lane & 7;
              unsigned char* dst = dn ? (unsigned char*)(ws + WS_WDN) + (size_t)le * 1024 * 1024 : (unsigned char*)(ws + WS_WGU) + (size_t)le * 2048 * 1024;
#pragma unroll
              for (int jp = 0; jp < 8; ++jp) { const int n = (f_lane >> 3) + 8 * jp; const LAS unsigned* sp = scr8 + n * 33 + 4 * c8;
                  v4u o; o.x = sp[0]; o.y = sp[1]; o.z = sp[2]; o[3] = sp[3];
                  const int ng = strip * 64 + n, dr = dn ? ng : (ng >> 8) * 256 + (ng & 1) * 128 + ((ng >> 1) & 127);
                  *(v4u*)(dst + (size_t)dr * 1024 + F.wave * 128 + 16 * c8) = o; } }
            LDS_WAIT(); asm volatile("" ::: "memory");
        }
        __syncthreads();
    }
    const int gtid = blockIdx.x * 512 + f_tid, gthreads = F.G * 512;
    for (int i = gtid; i < (MLA_IN_PAD - MLA_IN) * D / 8; i += gthreads) ((v4u*)((bf16*)(ws + WS_WMIN) + (size_t)MLA_IN * D))[i] = (v4u){0u, 0u, 0u, 0u};
    {
        bf16* MA = (bf16*)(ws + WS_MA);
        for (int i = gtid; i < 256 * 256; i += gthreads) { const int row = i >> 8, col = i & 255, jp = row >> 7, pp = (row >> 6) & 1, k1 = row & 63, j = col >> 7, pt = (col >> 6) & 1, l1 = col & 63;
            float v = 0.f; if (j == jp) { const float x = 2.f * (float)((k1 * l1) & 63) / 64.f; const float cs = cospif(x), sn = sinpif(x); v = (pp == 0) ? (pt == 0 ? cs : sn) : (pt == 0 ? -sn : cs); }
            MA[i] = (bf16)(pk2(v, 0.f) & 0xffffu); }
        bf16* DC = (bf16*)(ws + WS_DC); const float sc = 1.0f / sqrtf(256.f * 128.f);
        for (int i = gtid; i < 256 * 512; i += gthreads) { const int k = i >> 9, col = i & 511, pt = col >> 8, l = col & 255; const float x = 2.f * (float)((k * l) & 255) / 256.f;
            const float v = (pt == 0 ? cospif(x) : sinpif(x)) * sc; DC[i] = (bf16)(pk2(v, 0.f) & 0xffffu); }
        bf16* MC = (bf16*)(ws + WS_MC); const float sl = 1.0f / sqrtf(4096.f * 128.f);
        for (int i = gtid; i < 16 * 256 * 512; i += gthreads) { const int kq = i >> 17, row = (i >> 9) & 255, col = i & 511, kkp = row >> 6, k2 = row & 63, kk = col >> 7, pp = (col >> 6) & 1, l2 = col & 63;
            float v = 0.f; if (kk == kkp) { const int k = 4 * kq + kkp + 64 * k2; const float x = 2.f * (float)((l2 * k) & 4095) / 4096.f; v = (pp == 0 ? cospif(x) : sinpif(x)) * sl; }
            MC[i] = (bf16)(pk2(v, 0.f) & 0xffffu); }
        float* RM = (float*)(ws + WS_ROPE); float* RG = RM + 2048;
        for (int i = gtid; i < 64 * 8; i += gthreads) { const int pos = i >> 3, f = i & 7; const float inv = powf(10000.f, -(float)f / 8.f); float s, c; sincosf((float)pos * inv, &s, &c); RM[2 * i] = c; RM[2 * i + 1] = s; }
        for (int i = gtid; i < 64 * 16; i += gthreads) { const int pos = i >> 4, f = i & 15; const float inv = powf(10000.f, -(float)f / 16.f); float s, c; sincosf((float)pos * inv, &s, &c); RG[2 * i] = c; RG[2 * i + 1] = s; }
        float* WRT = (float*)(ws + WS_WRT);
        for (int i = gtid; i < DEPTH * NE * D; i += gthreads) { const int l = i >> 15, e = (i >> 10) & 31, k = i & 1023; WRT[i] = a.in[21][((size_t)l * D + k) * NE + e]; }
        float* BG = (float*)(ws + WS_BGU);
        for (int i = gtid; i < DEPTH * NE * 2048; i += gthreads) { const int le = i >> 11, q = i & 2047, pn = q >> 8, s = (q >> 7) & 1, jj = q & 127; BG[i] = a.in[24][(size_t)le * 2048 + 2 * (pn * 128 + jj) + s]; }
    }
    __syncthreads();
    {
        LAS float* wl = (LAS float*)F.lds;
        LAS float* tc = wl + 2048; LAS float* ts = tc + 128;
        if (f_tid < 128) { const float x = 2.f * (float)f_tid / 128.f; tc[f_tid] = cospif(x); ts[f_tid] = -sinpif(x); }
        for (int it = blockIdx.x; it < 2 * 8 * 64; it += F.G) { const int j = it >> 9, g = (it >> 6) & 7, kb = it & 63;
            __syncthreads();
            { const int kk = f_tid >> 5, c4 = (f_tid & 31) * 4; const f32x4 w = *(const f32x4*)(a.in[9] + ((size_t)j * D + kb * 16 + kk) * D + g * 128 + c4);
              LAS float* d = wl + c4 * 16 + kk; d[0] = w[0]; d[16] = w[1]; d[32] = w[2]; d[48] = w[3]; }
            __syncthreads();
            const int cl = f_tid & 255, m = cl >> 1, part = cl & 1, kh = f_tid >> 8; const LAS float* tw = part ? ts : tc;
            float accv[8];
#pragma unroll
            for (int q = 0; q < 8; ++q) accv[q] = 0.f;
            for (int jj = 0; jj < 128; ++jj) { const float t = tw[(m * jj) & 127]; const f32x4 wa = *(const LAS f32x4*)(wl + jj * 16 + kh * 8), wb = *(const LAS f32x4*)(wl + jj * 16 + kh * 8 + 4);
                accv[0] += wa[0] * t; accv[1] += wa[1] * t; accv[2] += wa[2] * t; accv[3] += wa[3] * t; accv[4] += wb[0] * t; accv[5] += wb[1] * t; accv[6] += wb[2] * t; accv[7] += wb[3] * t; }
            v4u o; o.x = pk2(accv[0], accv[1]); o.y = pk2(accv[2], accv[3]); o.z = pk2(accv[4], accv[5]); o.w = pk2(accv[6], accv[7]);
            *(v4u*)((bf16*)(ws + WS_WFIN) + ((size_t)j * 2048 + g * 256 + cl) * D + kb * 16 + kh * 8) = o;
        }
        __syncthreads();
    }
    {
        LAS float* S = (LAS float*)F.lds;
        LAS float* red = S + 9 * 1024;
        for (int i = f_tid; i < 9 * 1024; i += 512) { const int r = i >> 10, k = i & 1023; const float v = (r < 8) ? a.in[1][r * D + k] : a.in[3][k]; S[i] = v / (1.f + __expf(-v)); }
        __syncthreads();
        for (int it = blockIdx.x; it < DEPTH * 96; it += F.G) { const int l = it / 96, n0 = (it % 96) * 64;
            const float* wp = a.in[4] + ((size_t)l * D + F.wave * 128) * (NMOD * D) + n0 + f_lane;
            float accv[9];
#pragma unroll
            for (int r = 0; r < 9; ++r) accv[r] = 0.f;
            for (int k0 = 0; k0 < 128; k0 += 32) { float wv[32];
#pragma unroll
                for (int k = 0; k < 32; ++k) wv[k] = wp[(size_t)(k0 + k) * (NMOD * D)];
#pragma unroll
                for (int k = 0; k < 32; ++k)
#pragma unroll
                    for (int r = 0; r < 9; ++r) accv[r] += S[r * 1024 + F.wave * 128 + k0 + k] * wv[k]; }
#pragma unroll
            for (int r = 0; r < 9; ++r) red[(F.wave * 9 + r) * 64 + f_lane] = accv[r];
            __syncthreads();
            for (int i = f_tid; i < 9 * 64; i += 512) { const int r = i >> 6, ln = i & 63; float s = a.in[5][(size_t)l * (NMOD * D) + n0 + ln];
#pragma unroll
                for (int w = 0; w < 8; ++w) s += red[(w * 9 + r) * 64 + ln];
                ((float*)(ws + WS_MOD))[((size_t)l * 9 + r) * (NMOD * D) + n0 + ln] = s; }
            __syncthreads();
        }
    }
}

__device__ __forceinline__ void load_row(const float* p, int lane, f32x4 (&v)[4]) {
#pragma unroll
    for (int j = 0; j < 4; ++j) v[j] = ((const f32x4*)p)[lane + 64 * j];
}
__device__ __forceinline__ void load_row_bf(const bf16* p, int lane, f32x4 (&v)[4]) {
#pragma unroll
    for (int j = 0; j < 4; ++j) { const v2u w = ((const v2u*)p)[lane + 64 * j]; v[j] = (f32x4){bf_lo(w.x), bf_hi(w.x), bf_lo(w.y), bf_hi(w.y)}; }
}
__device__ __forceinline__ void norm_mod(f32x4 (&v)[4], const float* g, const float* shift, const float* scale, int lane) {
    float s = 0.f;
#pragma unroll
    for (int j = 0; j < 4; ++j) s += (v[j][0] * v[j][0] + v[j][1] * v[j][1]) + (v[j][2] * v[j][2] + v[j][3] * v[j][3]);
    const float rstd = rsqrtf(wave_sum(s, lane) * (1.f / D) + EPS);
#pragma unroll
    for (int j = 0; j < 4; ++j) { const f32x4 gv = ((const f32x4*)g)[lane + 64 * j], sh = ((const f32x4*)shift)[lane + 64 * j], sc = ((const f32x4*)scale)[lane + 64 * j];
        v[j] = (v[j] * rstd * gv) * (sc + 1.f) + sh; }
}
__device__ __forceinline__ void store_row_bf16(bf16* p, int lane, const f32x4 (&v)[4]) {
#pragma unroll
    for (int j = 0; j < 4; ++j) { v2u w; w.x = pk2(v[j][0], v[j][1]); w.y = pk2(v[j][2], v[j][3]); ((v2u*)p)[lane + 64 * j] = w; }
}

__device__ __forceinline__ float store_row_i8(unsigned char* p, int lane, const f32x4 (&v)[4]) {
    float am = 0.f;
#pragma unroll
    for (int j = 0; j < 4; ++j) am = fmaxf(fmaxf(am, fmaxf(fabsf(v[j][0]), fabsf(v[j][1]))), fmaxf(fabsf(v[j][2]), fabsf(v[j][3])));
    unsigned k = __float_as_uint(am);
    { unsigned t;
      t = (unsigned)__builtin_amdgcn_mov_dpp((int)k, 0xb1, 0xf, 0xf, false); k = k > t ? k : t;
      t = (unsigned)__builtin_amdgcn_mov_dpp((int)k, 0x4e, 0xf, 0xf, false); k = k > t ? k : t;
      t = (unsigned)__builtin_amdgcn_mov_dpp((int)k, 0x124, 0xf, 0xf, false); k = k > t ? k : t;
      t = (unsigned)__builtin_amdgcn_mov_dpp((int)k, 0x128, 0xf, 0xf, false); k = k > t ? k : t;
      const unsigned a = (unsigned)__builtin_amdgcn_readlane((int)k, 0), b = (unsigned)__builtin_amdgcn_readlane((int)k, 16), c = (unsigned)__builtin_amdgcn_readlane((int)k, 32), d = (unsigned)__builtin_amdgcn_readlane((int)k, 48);
      const unsigned ab = a > b ? a : b, cd = c > d ? c : d; k = ab > cd ? ab : cd; }
    const float amax = __uint_as_float(k);
    const float qscale = amax > 0.f ? amax * (1.f / 127.f) : 1.f, qinv = amax > 0.f ? 127.f / amax : 0.f;
#pragma unroll
    for (int j = 0; j < 4; ++j) { unsigned w = 0;
#pragma unroll
        for (int q = 0; q < 4; ++q) { int qi = __float2int_rn(v[j][q] * qinv); qi = qi > 127 ? 127 : (qi < -127 ? -127 : qi); w |= ((unsigned)qi & 255u) << (8 * q); }
        ((unsigned*)p)[lane + 64 * j] = w; }
    return qscale;
}
__device__ __forceinline__ void quant_rows(Frame& F, const bf16* src, unsigned char* dst, float* scale, int R) {
    const int f_lane = lthread(F.wave) & 63;
    for (int r = F.gw; r < R; r += F.NGW) { f32x4 v[4]; load_row_bf(src + (size_t)r * 1024, f_lane, v);
        const float sc = store_row_i8(dst + (size_t)r * 1024, f_lane, v); if (f_lane == 0) scale[r] = sc; }
}
__device__ __forceinline__ void rp_norm1(Frame& F, const Args& a, int l, int row_lo) {
    const int f_tid = lthread(F.wave), f_lane = f_tid & 63;
    const bf16* X = (const bf16*)(F.ws + WS_X); bf16* H = (bf16*)(F.ws + WS_H); const float* MOD = (const float*)(F.ws + WS_MOD) + (size_t)l * 9 * (NMOD * D);
    for (int row = row_lo + F.gw; row < NT; row += F.NGW) { f32x4 v[4];
        if (l == 0) load_row(row < NC ? a.in[2] + (size_t)row * D : a.in[0] + (size_t)(row - NC) * D, f_lane, v);
        else load_row_bf(X + (size_t)row * D, f_lane, v);
        const float* m = MOD + (size_t)modrow_of(row) * (NMOD * D);
        norm_mod(v, a.in[6] + (size_t)l * D, m, m + D, f_lane);
        const float sc = store_row_i8((unsigned char*)H + (size_t)row * D, f_lane, v); if (f_lane == 0) ((float*)(F.ws + WS_SH))[row] = sc; }
}

#if MK_N2V2
constexpr int LDS_LIST = LDS_MISC + 768;
__device__ __forceinline__ unsigned row16_max(unsigned k) {
    unsigned t;
    t = (unsigned)__builtin_amdgcn_mov_dpp((int)k, 0xb1, 0xf, 0xf, false); k = k > t ? k : t;
    t = (unsigned)__builtin_amdgcn_mov_dpp((int)k, 0x4e, 0xf, 0xf, false); k = k > t ? k : t;
    t = (unsigned)__builtin_amdgcn_mov_dpp((int)k, 0x124, 0xf, 0xf, false); k = k > t ? k : t;
    t = (unsigned)__builtin_amdgcn_mov_dpp((int)k, 0x128, 0xf, 0xf, false); k = k > t ? k : t;
    return k;
}
__device__ __forceinline__ unsigned wave_max_u(unsigned k) {
    k = row16_max(k);
    const unsigned a = (unsigned)__builtin_amdgcn_readlane((int)k, 0), b = (unsigned)__builtin_amdgcn_readlane((int)k, 16), c = (unsigned)__builtin_amdgcn_readlane((int)k, 32), d = (unsigned)__builtin_amdgcn_readlane((int)k, 48);
    const unsigned ab = a > b ? a : b, cd = c > d ? c : d; return ab > cd ? ab : cd;
}
__device__ __forceinline__ float key_val(unsigned m) { const unsigned u = m & ~31u; return __builtin_bit_cast(float, (u & 0x80000000u) ? (u ^ 0x80000000u) : ~u); }
__device__ __forceinline__ void rp_norm2_router(Frame& F, const Args& a, int l, int row_lo) {
    const int f_tid = lthread(F.wave), f_lane = f_tid & 63;
    const bf16* X = (const bf16*)(F.ws + WS_X); bf16* H = (bf16*)(F.ws + WS_H); const float* MOD = (const float*)(F.ws + WS_MOD) + (size_t)l * 9 * (NMOD * D);
    LAS float* wt = (LAS float*)F.lds;
    { const f32x4* src = (const f32x4*)((const float*)(F.ws + WS_WRT) + (size_t)l * NE * D); f32x4 tv[16];
#pragma unroll
      for (int i = 0; i < 16; ++i) tv[i] = src[f_tid + 512 * i];
#pragma unroll
      for (int i = 0; i < 16; ++i) ((LAS f32x4*)wt)[f_tid + 512 * i] = tv[i]; }
    LAS int* lcnt = (LAS int*)(F.lds + LDS_TT); LAS int* lbase = lcnt + 32;
    LAS v4u* list = (LAS v4u*)(F.lds + LDS_LIST) + F.wave * 68;
    LAS float* lsc = (LAS float*)(F.lds + LDS_LIST + 8 * 68 * 16) + F.wave * 68;
    if (f_tid < 32) lcnt[f_tid] = 0;
    __syncthreads();
    const float* gf = a.in[7] + (size_t)l * D;
    f32x4 gv[4];
#pragma unroll
    for (int j = 0; j < 4; ++j) gv[j] = ((const f32x4*)gf)[f_lane + 64 * j];
    const int my_e = f_lane >> 1;
    const float my_b = a.in[22][(size_t)l * NE + my_e];
    int row = row_lo + F.gw, it = 0;
    f32x4 vn[4];
    if (row < NT) load_row_bf(X + (size_t)row * D, f_lane, vn);
    for (; row < NT; row += F.NGW, ++it) {
        f32x4 v[4], sh[4], sc[4];
        const float* m = MOD + (size_t)modrow_of(row) * (NMOD * D);
#pragma unroll
        for (int j = 0; j < 4; ++j) { sh[j] = ((const f32x4*)(m + 3 * D))[f_lane + 64 * j]; sc[j] = ((const f32x4*)(m + 4 * D))[f_lane + 64 * j]; }
        asm volatile("" ::: "memory");
#pragma unroll
        for (int j = 0; j < 4; ++j) v[j] = vn[j];
        { const int nrow = row + F.NGW; if (nrow < NT) load_row_bf(X + (size_t)nrow * D, f_lane, vn); }
        float ssq = 0.f;
#pragma unroll
        for (int j = 0; j < 4; ++j) ssq += (v[j][0] * v[j][0] + v[j][1] * v[j][1]) + (v[j][2] * v[j][2] + v[j][3] * v[j][3]);
        const float rstd = rsqrtf(wave_sum(ssq, f_lane) * (1.f / D) + EPS);
#pragma unroll
        for (int j = 0; j < 4; ++j) v[j] = (v[j] * rstd * gv[j]) * (sc[j] + 1.f) + sh[j];
        const float qscale = store_row_i8((unsigned char*)H + (size_t)row * D, f_lane, v);
        float p[32];
#pragma unroll
        for (int e = 0; e < 32; ++e) { f32x2 s2 = (f32x2){0.f, 0.f};
#pragma unroll
            for (int j = 0; j < 4; ++j) { const f32x4 w = ((const LAS f32x4*)(wt + e * 1024))[f_lane + 64 * j];
                s2 = __builtin_elementwise_fma((f32x2){v[j][0], v[j][1]}, (f32x2){w[0], w[1]}, s2); s2 = __builtin_elementwise_fma((f32x2){v[j][2], v[j][3]}, (f32x2){w[2], w[3]}, s2); }
            p[e] = s2[0] + s2[1]; }
#pragma unroll
        for (int s = 0; s < 5; ++s) { const int half = 16 >> s, msk = 32 >> s; const bool up = (f_lane & msk) != 0;
#pragma unroll
            for (int i = 0; i < half; ++i) { const float keep = up ? p[i + half] : p[i], send = up ? p[i] : p[i + half]; p[i] = keep + shx(send, msk, f_lane); } }
        const float lgt = p[0] + shx(p[0], 1, f_lane) + my_b;
        unsigned key; { const unsigned u = __builtin_bit_cast(unsigned, lgt); const unsigned o = (u & 0x80000000u) ? ~u : (u | 0x80000000u); key = (o & ~31u) | (unsigned)(31 - my_e); }
        unsigned mk[4];
#pragma unroll
        for (int k = 0; k < 4; ++k) { mk[k] = wave_max_u(key); key = (key == mk[k]) ? 0u : key; }
        const float b0 = key_val(mk[0]);
        const float e1 = __expf(key_val(mk[1]) - b0), e2 = __expf(key_val(mk[2]) - b0), e3 = __expf(key_val(mk[3]) - b0); const float inv = 1.f / (1.f + e1 + e2 + e3);
        if (f_lane < 4) { const unsigned mm = f_lane == 0 ? mk[0] : f_lane == 1 ? mk[1] : f_lane == 2 ? mk[2] : mk[3]; const int me = 31 - (int)(mm & 31u);
            const float mw = (f_lane == 0 ? 1.f : f_lane == 1 ? e1 : f_lane == 2 ? e2 : e3) * inv;
            const int lr = __hip_atomic_fetch_add(lcnt + me, 1, __ATOMIC_RELAXED, __HIP_MEMORY_SCOPE_WORKGROUP);
            LAS unsigned* ep = (LAS unsigned*)(list + it * 4 + f_lane); ep[0] = (unsigned)(row * 4 + f_lane); ep[1] = (unsigned)me; ep[2] = (unsigned)lr; ep[3] = __builtin_bit_cast(unsigned, mw);
            lsc[it * 4 + f_lane] = qscale; }
    }
    __syncthreads();
    if (f_tid < 32) { const int c = lcnt[f_tid]; lbase[f_tid] = c ? (int)__hip_atomic_fetch_add((unsigned*)(F.ctl + CW_CNT + (l * 32 + f_tid) * 16), (unsigned)c, RLX_AGENT) : 0; }
    __syncthreads();
    int* te = (int*)(F.ws + WS_TE); int* trank = (int*)(F.ws + WS_TRANK); int* stok = (int*)(F.ws + WS_STOK); float* sw = (float*)(F.ws + WS_SW); float* ssc = (float*)(F.ws + WS_SSC);
    for (int i = f_lane; i < it * 4; i += 64) { const LAS unsigned* ep = (const LAS unsigned*)(list + i); const unsigned rowk = ep[0], ex = ep[1], lr = ep[2]; const float wv = __builtin_bit_cast(float, ep[3]);
        const int rk = lbase[ex] + (int)lr;
        stok[(size_t)ex * CAP + rk] = (int)(rowk >> 2); sw[(size_t)ex * CAP + rk] = wv; ssc[(size_t)ex * CAP + rk] = lsc[i]; te[rowk] = (int)ex; trank[rowk] = rk; }
}

#endif
__device__ __forceinline__ void moe_table(Frame& F, int l) {
    const int f_tid = lthread(F.wave), f_lane = f_tid & 63;
    LAS int* TT = (LAS int*)(F.lds + LDS_TT); LAS int* CN = TT + 64; LAS int* TE = (LAS int*)(F.lds + LDS_TE);
    __syncthreads();
    if (f_tid < 64) {
        const int c = (f_lane < 32) ? (int)__hip_atomic_load((unsigned*)(F.ctl + CW_CNT + (l * 32 + (f_lane & 31)) * 16), RLX_AGENT) : 0;
        const int tl = (c + 255) >> 8; int v = tl;
#pragma unroll
        for (int o = 1; o < 32; o <<= 1) { const int n = __builtin_amdgcn_ds_bpermute((f_lane >= o ? f_lane - o : f_lane) << 2, v); if (f_lane >= o) v += n; }
        if (f_lane < 32) { CN[f_lane] = c; TT[f_lane] = v - tl; if (f_lane == 31) TT[32] = v; }
    }
    __syncthreads();
    for (int t = f_tid; t < MAXTILES; t += 512) { int lo = 0, hi = 32;
#pragma unroll
        for (int k = 0; k < 5; ++k) { const int mid = (lo + hi) >> 1; if (TT[mid] <= t) lo = mid; else hi = mid; }
        TE[t] = lo; }
    __syncthreads();
}

#if MK_CBV2
struct CombRow { v2u x[4]; unsigned y[4][4]; };
__device__ __forceinline__ void comb_issue(CombRow& R, const bf16* X, const unsigned char* Y, const LAS int* TT, int row, const v4u te4, const v4u tr4, int lane) {
    const unsigned ee[4] = {te4[0], te4[1], te4[2], te4[3]}, rr[4] = {tr4[0], tr4[1], tr4[2], tr4[3]};
#pragma unroll
    for (int k = 0; k < 4; ++k) { const size_t slot = (size_t)TT[ee[k]] * 256 + rr[k]; const unsigned* yp = (const unsigned*)(Y + slot * 1024);
#pragma unroll
        for (int j = 0; j < 4; ++j) R.y[k][j] = yp[lane + 64 * j]; }
#pragma unroll
    for (int j = 0; j < 4; ++j) R.x[j] = ((const v2u*)(X + (size_t)row * D))[lane + 64 * j];
}
__device__ __forceinline__ void comb_finish(const CombRow& R, Frame& F, const Args& a, int l, int row, int lane, const float* MOD, const float* MODN, bool lastl) {
    bf16* X = (bf16*)(F.ws + WS_X); bf16* H = (bf16*)(F.ws + WS_H);
    const int mr = modrow_of(row); const float* g5 = MOD + (size_t)mr * (NMOD * D) + 5 * D;
    f32x4 v[4];
#pragma unroll
    for (int j = 0; j < 4; ++j) { f32x4 s = (f32x4){0.f, 0.f, 0.f, 0.f};
#pragma unroll
        for (int k = 0; k < 4; ++k) { const int w = (int)R.y[k][j]; const f32x2 lo = __builtin_amdgcn_cvt_pk_f32_fp8(w, false), hi = __builtin_amdgcn_cvt_pk_f32_fp8(w, true); s[0] += lo[0]; s[1] += lo[1]; s[2] += hi[0]; s[3] += hi[1]; }
        s = s * 0.125f;
        const f32x4 gv = ((const f32x4*)g5)[lane + 64 * j]; const v2u xw = R.x[j]; v[j] = (f32x4){bf_lo(xw.x), bf_hi(xw.x), bf_lo(xw.y), bf_hi(xw.y)} + gv * s; }
    if (!lastl) {
        store_row_bf16(X + (size_t)row * D, lane, v);
        const float* m = MODN + (size_t)mr * (NMOD * D);
        norm_mod(v, a.in[6] + (size_t)(l + 1) * D, m, m + D, lane);
        const float sc = store_row_i8((unsigned char*)H + (size_t)row * D, lane, v); if (lane == 0) ((float*)(F.ws + WS_SH))[row] = sc;
    } else {
        float ss = 0.f;
#pragma unroll
        for (int j = 0; j < 4; ++j) ss += (v[j][0] * v[j][0] + v[j][1] * v[j][1]) + (v[j][2] * v[j][2] + v[j][3] * v[j][3]);
        const float rstd = rsqrtf(wave_sum(ss, lane) * (1.f / D) + EPS);
        float* op = a.out + (size_t)(row - NC) * D;
#pragma unroll
        for (int j = 0; j < 4; ++j) { const f32x4 gv = ((const f32x4*)a.in[8])[lane + 64 * j]; ((f32x4*)op)[lane + 64 * j] = v[j] * rstd * gv; }
    }
}
__device__ __forceinline__ void rp_combine(Frame& F, const Args& a, int l, int row_lo) {
    const int f_tid = lthread(F.wave), f_lane = f_tid & 63;
    const bf16* X = (const bf16*)(F.ws + WS_X); const unsigned char* Y = (const unsigned char*)(F.ws + WS_Y);
    const float* MOD = (const float*)(F.ws + WS_MOD) + (size_t)l * 9 * (NMOD * D); const float* MODN = MOD + 9 * (NMOD * D);
    const v4u* te = (const v4u*)(F.ws + WS_TE); const v4u* trank = (const v4u*)(F.ws + WS_TRANK);
    const LAS int* TT = (const LAS int*)(F.lds + LDS_TT);
    const bool lastl = (l == DEPTH - 1);
    const int st = F.NGW;
    int row = row_lo + F.gw;
    if (row >= NT) return;
    CombRow RA, RB;
    v4u te1 = te[row], tr1 = trank[row];
    comb_issue(RA, X, Y, TT, row, te1, tr1, f_lane);
    if (row + st < NT) { te1 = te[row + st]; tr1 = trank[row + st]; }
    for (;;) {
        const bool h1 = row + st < NT;
        if (h1) comb_issue(RB, X, Y, TT, row + st, te1, tr1, f_lane);
        if (row + 2 * st < NT) { te1 = te[row + 2 * st]; tr1 = trank[row + 2 * st]; }
        comb_finish(RA, F, a, l, row, f_lane, MOD, MODN, lastl);
        if (!h1) break;
        row += st;
        const bool h2 = row + st < NT;
        if (h2) comb_issue(RA, X, Y, TT, row + st, te1, tr1, f_lane);
        if (row + 2 * st < NT) { te1 = te[row + 2 * st]; tr1 = trank[row + 2 * st]; }
        comb_finish(RB, F, a, l, row, f_lane, MOD, MODN, lastl);
        if (!h2) break;
        row += st;
    }
}

#endif
__device__ __forceinline__ void rp_mla(Frame& F, const Args& a) {
    const int f_tid = lthread(F.wave), f_lane = f_tid & 63;
    const bf16* A = (const bf16*)(F.ws + WS_RE); bf16* QA = (bf16*)(F.ws + WS_RF); bf16* CKV = (bf16*)(F.ws + WS_RG); bf16* Kb = (bf16*)(F.ws + WS_RB);
    const float* rope = (const float*)(F.ws + WS_ROPE); const float* gq = a.in[12]; const float* gk = a.in[14];
    for (int row = F.gw; row < NT; row += F.NGW) {
        const unsigned* ap = (const unsigned*)(A + (size_t)row * MLA_IN_PAD);
        unsigned q[3], c[2];
#pragma unroll
        for (int j = 0; j < 3; ++j) q[j] = ap[f_lane + 64 * j];
#pragma unroll
        for (int j = 0; j < 2; ++j) c[j] = ap[192 + f_lane + 64 * j];
        const unsigned pe = ap[320 + (f_lane & 15)];
        float sq = 0.f, sc = 0.f;
#pragma unroll
        for (int j = 0; j < 3; ++j) { const float x0 = bf_lo(q[j]), x1 = bf_hi(q[j]); sq += x0 * x0 + x1 * x1; }
#pragma unroll
        for (int j = 0; j < 2; ++j) { const float x0 = bf_lo(c[j]), x1 = bf_hi(c[j]); sc += x0 * x0 + x1 * x1; }
        const float rq = rsqrtf(wave_sum(sq, f_lane) * (1.f / MLA_QL) + EPS), rc = rsqrtf(wave_sum(sc, f_lane) * (1.f / MLA_KVL) + EPS);
#pragma unroll
        for (int j = 0; j < 3; ++j) { const int e0 = 2 * (f_lane + 64 * j); ((unsigned*)(QA + (size_t)row * MLA_QL))[f_lane + 64 * j] = pk2(bf_lo(q[j]) * rq * gq[e0], bf_hi(q[j]) * rq * gq[e0 + 1]); }
#pragma unroll
        for (int j = 0; j < 2; ++j) { const int e0 = 2 * (f_lane + 64 * j); ((unsigned*)(CKV + (size_t)row * MLA_KVL))[f_lane + 64 * j] = pk2(bf_lo(c[j]) * rc * gk[e0], bf_hi(c[j]) * rc * gk[e0 + 1]); }
        float x0 = bf_lo(pe), x1 = bf_hi(pe);
        if (row >= NC) { const int t = (row - NC) & 4095, i = f_lane & 15, d = 2 * i, pos = (d & 16) ? (t & 63) : (t >> 6), f = d & 7;
            const float p0 = shx(x0, 4, f_lane), p1 = shx(x1, 4, f_lane); const float sg = (d & 8) ? 1.f : -1.f;
            const float* rp = rope + (size_t)pos * 16 + 2 * f; x0 = x0 * rp[0] + sg * p0 * rp[1]; x1 = x1 * rp[2] + sg * p1 * rp[3]; }
        const unsigned w = pk2(x0, x1);
        { const int i = f_lane & 15, hb = f_lane >> 4;
#pragma unroll
          for (int hh = 0; hh < 4; ++hh) { const int h = hb * 4 + hh; ((unsigned*)(Kb + (size_t)row * 1536 + 96 * h + 64))[i] = w; } }
    }
}

__device__ __forceinline__ void rp_gqa(Frame& F, const Args& a) {
    const int f_tid = lthread(F.wave), f_lane = f_tid & 63;
    const bf16* A = (const bf16*)(F.ws + WS_RA); bf16* Q = (bf16*)(F.ws + WS_RB); bf16* Kb = Q + (size_t)NT * 1024;
    const float* rope = (const float*)(F.ws + WS_ROPE) + 2048; const float* gq = a.in[18]; const float* gk = a.in[19];
    const float c2 = 0.125f * LOG2E;
    for (int row = F.gw; row < NT; row += F.NGW) {
        const bool lat = row >= NC; const int t = (row - NC) & 4095;
#pragma unroll
        for (int part = 0; part < 2; ++part) {
            const int ln = part ? (f_lane & 15) : f_lane; const bf16* src = A + (size_t)row * GQA_QKV + (part ? 1024 : 0) + ln * 16;
            const v4u w0 = *(const v4u*)src, w1 = *(const v4u*)(src + 8);
            float x[16]; const unsigned ww[8] = {w0.x, w0.y, w0.z, w0.w, w1.x, w1.y, w1.z, w1.w};
#pragma unroll
            for (int i = 0; i < 8; ++i) { x[2 * i] = bf_lo(ww[i]); x[2 * i + 1] = bf_hi(ww[i]); }
            float ss = 0.f;
#pragma unroll
            for (int i = 0; i < 16; ++i) ss += x[i] * x[i];
            ss += shx(ss, 1, f_lane); ss += shx(ss, 2, f_lane);
            const float rs = rsqrtf(ss * (1.f / 64.f) + EPS); const float* g = (part ? gk : gq) + (ln & 3) * 16;
#pragma unroll
            for (int i = 0; i < 16; ++i) x[i] = x[i] * rs * g[i];
            if (lat) { const int sec = (ln >> 1) & 1, pos = sec ? (t & 63) : (t >> 6); const float sg = (ln & 1) ? 1.f : -1.f; const float* rp = rope + (size_t)pos * 32;
#pragma unroll
                for (int i = 0; i < 16; ++i) { const float pr = shx(x[i], 1, f_lane); x[i] = x[i] * rp[2 * i] + sg * pr * rp[2 * i + 1]; } }
            const float scl = part ? 1.f : c2;
            v4u o0, o1; o0.x = pk2(x[0] * scl, x[1] * scl); o0.y = pk2(x[2] * scl, x[3] * scl); o0.z = pk2(x[4] * scl, x[5] * scl); o0.w = pk2(x[6] * scl, x[7] * scl);
            o1.x = pk2(x[8] * scl, x[9] * scl); o1.y = pk2(x[10] * scl, x[11] * scl); o1.z = pk2(x[12] * scl, x[13] * scl); o1.w = pk2(x[14] * scl, x[15] * scl);
            if (part == 0) { bf16* d = Q + (size_t)row * 1024 + ln * 16; *(v4u*)d = o0; *(v4u*)(d + 8) = o1; }
            else if (f_lane < 16) { bf16* d = Kb + (size_t)row * 256 + ln * 16; *(v4u*)d = o0; *(v4u*)(d + 8) = o1; }
        }
    }
}

template <int DK>
__device__ __forceinline__ void attn_phase(Frame& F, const att::Tens& T, int kvshift  , int kstride, int vstride, int vbase) {
    const int vcu = (F.G % 8 == 0) ? (blockIdx.x % 8) * (F.G / 8) + blockIdx.x / 8 : blockIdx.x;
    if constexpr (DK == 64) {
        for (int u = vcu; u < 2048 + 128; u += F.G) {
            if (u < 2048) { const int b = u >> 8, h = (u >> 4) & 15, qb = u & 15, kvh = h >> kvshift;
                att64::attn_unit<8>(T.Q, T.qpitch, NC + b * SEQ + qb * 256, h * 64, T.K, T.kpitch, kvh * kstride, T.V, T.vpitch, vbase + kvh * vstride, T.O, h * 64, b * LCTX, NC + b * SEQ, 68, (char*)F.lds, F.wave); }
            else { const int q = u - 2048, b = q >> 4, h = q & 15, kvh = h >> kvshift;
                att64::attn_unit<8>(T.Q, T.qpitch, b * LCTX, h * 64, T.K, T.kpitch, kvh * kstride, T.V, T.vpitch, vbase + kvh * vstride, T.O, h * 64, b * LCTX, 0, 4, (char*)F.lds, F.wave); }
        }
        __syncthreads();
    } else {
        for (int u = vcu; u < 2048 + 128; u += F.G) {
            if (u < 2048) { const int b = u >> 8, h = (u >> 4) & 15, qb = u & 15, kvh = h >> kvshift;
                att96::attn_unit<8>(T.Q, T.qpitch, NC + b * SEQ + qb * 256, h * 96, T.K, T.kpitch, kvh * kstride, T.V, T.vpitch, vbase + kvh * vstride, T.O, h * 64, b * LCTX, NC + b * SEQ, 68, (char*)F.lds, F.wave); }
            else { const int q = u - 2048, b = q >> 4, h = q & 15, kvh = h >> kvshift;
                att96::attn_unit<8>(T.Q, T.qpitch, b * LCTX, h * 96, T.K, T.kpitch, kvh * kstride, T.V, T.vpitch, vbase + kvh * vstride, T.O, h * 64, b * LCTX, 0, 4, (char*)F.lds, F.wave); }
        }
        __syncthreads();
    }
}

constexpr int PH_PER_LAYER = 9, PH_TOTAL = 2 + DEPTH * PH_PER_LAYER;
__global__ void __launch_bounds__(512, 2) mk_fwd(Args args) {
    extern __shared__ __attribute__((aligned(16))) unsigned char lds_raw[];
    Frame F;
    F.lds = (LAS unsigned char*)lds_raw; F.ws = args.ws; F.ctl = (gu32*)(args.ws + WS_CTL);
    F.wave = __builtin_amdgcn_readfirstlane(threadIdx.x >> 6); F.G = gridDim.x;
    F.gw = blockIdx.x * 8 + F.wave; F.NGW = F.G * 8;
    if (threadIdx.x < 4) ((LAS unsigned*)(F.lds + LDS_XB))[threadIdx.x] = 0u;
    __syncthreads();
    const int lo = args.ph_lo, hi = args.ph_hi;
    const bool multi = (hi - lo) > 1;
    XcdBarrier bar; bar.bar = (unsigned*)(F.ctl + CW_BAR); bar.x = 0; bar.st = nullptr; bar.wave = F.wave;
    if (multi) bar = xcd_barrier_post((unsigned*)(F.ctl + CW_BAR), (volatile LAS unsigned*)(F.lds + LDS_XB), F.wave);
#define IN(k) (lo <= (k) && (k) < hi)
#define SEAM(k) do { if (IN(k) && IN((k) + 1)) xcd_barrier(bar); } while (0)
    unsigned char* ws0 = args.ws;
#define PH_WS size_t zofs_ = 0; asm volatile("" : "+s"(zofs_)); unsigned char* ws = ws0 + zofs_; F.ws = ws; F.ctl = (gu32*)ws;
    const int G = F.G, cidx = (int)blockIdx.x;

    if (IN(0) && EN(0)) { PH_WS REP(0) { prologue(F, args); SEAM(0); } }
    if (IN(1) && EN(1)) { PH_WS rp_norm1(F, args, 0, 0);
        quant_rows(F, (const bf16*)(ws + WS_WFIN), (unsigned char*)(ws + WS_W8), (float*)(ws + WS_SWP), 2 * 2048);
        quant_rows(F, (const bf16*)(ws + WS_WMIN), (unsigned char*)(ws + WS_W8) + 4 * MiB, (float*)(ws + WS_SWP) + 4096, MLA_IN_PAD);
        quant_rows(F, (const bf16*)(ws + WS_WGQKV), (unsigned char*)(ws + WS_W8) + 5 * MiB, (float*)(ws + WS_SWP) + 4864, GQA_QKV); SEAM(1); }

    for (int l = 0; l < DEPTH; ++l) {
        const int kind = l % 3, j = l / 3, base = 2 + l * PH_PER_LAYER;
        const bool lastl = (l == DEPTH - 1);

        size_t outB = 0;
        if (kind == 0) {
            if (IN(base + 0) && EN(2)) { PH_WS REP(2) { PolFP p; p.A = (const char*)(ws + WS_W8) + (size_t)j * 2048 * D; p.B = (const char*)(ws + WS_H); p.nt = 8; p.sW = (const float*)(ws + WS_SWP) + j * 2048; p.sH = (const float*)(ws + WS_SH); p.nN = lastl ? 128 : 136; p.G = G; p.c = cidx;
                p.Z = (bf16*)(ws + WS_RA); p.Zc = (bf16*)(ws + WS_RH); pg8::gemm_phase(F.lds, p, F.wave); } }
            SEAM(base + 0);
            if (IN(base + 1) && EN(3)) { PH_WS REP(3) { PolFA p; p.A = (const char*)(ws + WS_MA); p.B = (const char*)(ws + WS_RA); p.nt = 4; p.G = G; p.c = cidx; p.Y = (bf16*)(ws + WS_RB); pg8::gemm_phase(F.lds, p, F.wave); } }
            SEAM(base + 1);
            if (IN(base + 2) && EN(4)) { PH_WS REP(4) { PolFC p; p.A = (const char*)(ws + WS_DC); p.B = (const char*)(ws + WS_RB); p.nt = 8; p.G = G; p.c = cidx; p.nunits = lastl ? 512 : 544;
                p.offMC = (unsigned)(WS_MC - WS_DC); p.offZc = (unsigned)(WS_RH - WS_RB); p.F = (bf16*)(ws + WS_RC); pg8::gemm_phase(F.lds, p, F.wave); } }
            SEAM(base + 2);
            outB = WS_WFOUT + (size_t)j * D * D * 2;
        } else if (kind == 1) {
            if (IN(base + 0) && EN(5)) { PH_WS REP(5) { PolDenseI8 p; p.A = (const char*)(ws + WS_H); p.B = (const char*)(ws + WS_W8) + 4 * MiB; p.nt = 8; p.nM = NT / 256; p.nN = 3; p.pm0 = 0; p.G = G; p.c = cidx; p.sA = (const float*)(ws + WS_SH); p.sB = (const float*)(ws + WS_SWP) + 4096;
                p.O = (bf16*)(ws + WS_RE); p.ldo = MLA_IN_PAD; pg8::gemm_phase(F.lds, p, F.wave); } }
            SEAM(base + 0);
            if (IN(base + 1) && EN(6)) { PH_WS REP(6) { rp_mla(F, args); } }
            SEAM(base + 1);
            if (IN(base + 2)) { PH_WS REP(7) {
                if (EN(7)) { PolMlaQ p; p.A = (const char*)(ws + WS_RF); p.B = (const char*)(ws + WS_WMQB); p.nt = 6; p.nM = NT / 256; p.nN = 6; p.G = G; p.c = cidx; p.Q = (bf16*)(ws + WS_RA);
                  p.rope = (const float*)(ws + WS_ROPE); p.c2 = 0.10206207261596575f * LOG2E; pg8::gemm_phase(F.lds, p, F.wave); }
                if (EN(8)) { PolMlaKV p; p.A = (const char*)(ws + WS_RG); p.B = (const char*)(ws + WS_WMKVB); p.nt = 4; p.nM = NT / 256; p.nN = 8; p.G = G; p.c = cidx; p.Kb = (bf16*)(ws + WS_RB); p.Vb = (bf16*)(ws + WS_RD);
                  pg8::gemm_phase(F.lds, p, F.wave); }
            } }
            SEAM(base + 2);
            if (IN(base + 3) && EN(9)) { PH_WS REP(9) { att::Tens T{(const bf16*)(ws + WS_RA), 1536, (const bf16*)(ws + WS_RB), 1536, (const bf16*)(ws + WS_RD), 1024, (bf16*)(ws + WS_RC)}; attn_phase<96>(F, T, 0, 96, 64, 0); } }
            SEAM(base + 3);
            outB = WS_WMO;
        } else {
            if (IN(base + 0) && EN(10)) { PH_WS REP(10) { PolDenseI8 p; p.A = (const char*)(ws + WS_H); p.B = (const char*)(ws + WS_W8) + 5 * MiB; p.nt = 8; p.nM = NT / 256; p.nN = 6; p.pm0 = 0; p.G = G; p.c = cidx; p.sA = (const float*)(ws + WS_SH); p.sB = (const float*)(ws + WS_SWP) + 4864;
                p.O = (bf16*)(ws + WS_RA); p.ldo = GQA_QKV; pg8::gemm_phase(F.lds, p, F.wave); } }
            SEAM(base + 0);
            if (IN(base + 1) && EN(11)) { PH_WS REP(11) { rp_gqa(F, args); } }
            SEAM(base + 1);
            if (IN(base + 2) && EN(12)) { PH_WS REP(12) { att::Tens T{(const bf16*)(ws + WS_RB), 1024, (const bf16*)(ws + WS_RB) + (size_t)NT * 1024, 256, (const bf16*)(ws + WS_RA), 1536, (bf16*)(ws + WS_RC)}; attn_phase<64>(F, T, 2, 64, 64, 1280); } }
            SEAM(base + 2);
            outB = WS_WGO;
        }
        if (IN(base + 4) && EN(13)) { PH_WS PolOut p; p.A = (const char*)(ws + WS_RC); p.B = (const char*)(ws + outB); p.nt = 16; p.nM = lastl ? NL / 256 : NT / 256; p.nN = 4; p.pm0 = lastl ? 8 : 0; p.G = G; p.c = cidx; p.X = (bf16*)(ws + WS_X); p.mod = (const float*)(ws + WS_MOD) + (size_t)l * 9 * (NMOD * D); p.chunk = 2;
            p.XinC = (l == 0) ? args.in[2] : nullptr; p.XinL = (l == 0) ? args.in[0] - (size_t)NC * D : nullptr;
            pg8::gemm_phase(F.lds, p, F.wave); }
        SEAM(base + 4);
        if (IN(base + 5) && EN(14)) { PH_WS rp_norm2_router(F, args, l, lastl ? NC : 0); }
        SEAM(base + 5);
        if (IN(base + 6) && EN(15)) { PH_WS REP(15) { moe_table(F, l);
            PolMoe1 p; p.A = (const char*)(ws + WS_H); p.B = (const char*)(ws + WS_WGU) + (size_t)l * NE * 2048 * D; p.nt = 8; p.G = G; p.c = cidx;
            p.swgu = (const float*)(ws + WS_SWGU) + (size_t)l * NE * 2048; p.ssc = (const float*)(ws + WS_SSC);
            p.T.TT = (const LAS int*)(F.lds + LDS_TT); p.T.CN = p.T.TT + 64; p.T.TE = (const LAS int*)(F.lds + LDS_TE); p.stok = (const int*)(ws + WS_STOK); p.bgu = (const float*)(ws + WS_BGU) + (size_t)l * NE * 2048; p.act = (unsigned char*)(ws + WS_ACT);
            pg8::gemm_phase(F.lds, p, F.wave); } }
        SEAM(base + 6);
        if (IN(base + 7) && EN(16)) { PH_WS REP(16) { moe_table(F, l);
            PolMoe2 p; p.A = (const char*)(ws + WS_ACT); p.B = (const char*)(ws + WS_WDN) + (size_t)l * NE * D * DFF; p.nt = 8; p.G = G; p.c = cidx; p.swd = (const float*)(ws + WS_SWDN) + (size_t)l * NE * D;
            p.T.TT = (const LAS int*)(F.lds + LDS_TT); p.T.CN = p.T.TT + 64; p.T.TE = (const LAS int*)(F.lds + LDS_TE); p.sw = (const float*)(ws + WS_SW); p.bdn = args.in[26] + (size_t)l * NE * D; p.Y = (unsigned char*)(ws + WS_Y);
            pg8::gemm_phase(F.lds, p, F.wave); } }
        SEAM(base + 7);
        if (IN(base + 8) && EN(17)) { PH_WS moe_table(F, l); rp_combine(F, args, l, lastl ? NC : 0); }
        SEAM(base + 8);
    }
#undef PH_WS
#undef IN
#undef SEAM
}

extern "C" void kernel_launch(void* const* d_in, const int* in_sizes, int n_in, void* d_out, int out_size, void* d_ws, size_t ws_size, hipStream_t stream) {
    static int grid = 0;
    if (grid == 0) {
        if (n_in != 27 || out_size != NL * D || ws_size < WS_END) { fprintf(stderr, "kernel_launch: unexpected problem (n_in %d, out %d, ws %zu < %zu)\n", n_in, out_size, ws_size, (size_t)WS_END); grid = -1; return; }
        int dev = 0, cus = 0, per_cu = 0;
        if (hipGetDevice(&dev) != hipSuccess || hipDeviceGetAttribute(&cus, hipDeviceAttributeMultiprocessorCount, dev) != hipSuccess) { grid = -1; return; }
        if (hipFuncSetAttribute((const void*)mk_fwd, hipFuncAttributeMaxDynamicSharedMemorySize, LDS_BYTES) != hipSuccess) { fprintf(stderr, "kernel_launch: hipFuncSetAttribute failed\n"); grid = -1; return; }
        if (hipOccupancyMaxActiveBlocksPerMultiprocessor(&per_cu, (const void*)mk_fwd, 512, LDS_BYTES) != hipSuccess || per_cu < 1) fprintf(stderr, "kernel_launch: occupancy query says %d\n", per_cu);
        (void)hipGetLastError();
        grid = cus;
    }
    if (grid < 0) return;
    (void)hipMemsetAsync((char*)d_ws + WS_CTL, 0, CTL_ZERO_BYTES, stream);
    Args a{};
    for (int i = 0; i < 27; ++i) a.in[i] = (const float*)d_in[i];
    a.out = (float*)d_out; a.ws = (unsigned char*)d_ws;
#if MK_PER_PHASE
    for (int ph = 0; ph < PH_TOTAL; ++ph) {
        const int l = (ph - 2) / PH_PER_LAYER, s = (ph - 2) % PH_PER_LAYER, kind = l % 3;
        if (ph >= 2) { if (s == 3 && kind != 1) continue; }
        a.ph_lo = ph; a.ph_hi = ph + 1;
        hipLaunchKernelGGL(mk_fwd, dim3(grid), dim3(512), LDS_BYTES, stream, a);
    }
#else
    a.ph_lo = 0; a.ph_hi = PH_TOTAL;
    hipLaunchKernelGGL(mk_fwd, dim3(grid), dim3(512), LDS_BYTES, stream, a);
#endif
}
```

```cpp
#include <hip/hip_runtime.h>
#include <cstdio>
#include <cstdint>

#ifndef MK_PER_PHASE
#define MK_PER_PHASE 0
#endif
#ifndef MK_N2V2
#define MK_N2V2 1
#endif
#ifndef MK_CBV2
#define MK_CBV2 1
#endif
#ifndef MK_N2AGG
#define MK_N2AGG 1
#endif
#ifndef MK_MASK
#define MK_MASK 0xFFFFFFFFu
#endif
#define EN(id) (((MK_MASK) >> (id)) & 1u)
#ifndef MK_REPMASK
#define MK_REPMASK 0u
#endif
#define REP(id) for (int rep_ = 0; rep_ < ((((MK_REPMASK) >> (id)) & 1u) ? 2 : 1); ++rep_)

constexpr int D = 1024, NB = 8, SEQ = 4096, LCTX = 256, DEPTH = 4;
constexpr int NC = NB * LCTX;
constexpr int NL = NB * SEQ;
constexpr int NT = NC + NL;
constexpr int NMOD = 6, NE = 32, TOPK = 4, DFF = 1024;
constexpr int MLA_QL = 384, MLA_KVL = 256, MLA_ROPE = 32, MLA_NOPE = 64, MLA_V = 64, MLA_IN = 672, MLA_IN_PAD = 768, MLA_QD = 96;
constexpr int GQA_NQ = 1024, GQA_NKV = 256, GQA_QKV = 1536;
constexpr int CAP = NT;
constexpr int MAXTILES = 576;
constexpr float EPS = 1e-6f;
constexpr float LOG2E = 1.4426950408889634f;

constexpr size_t MiB = 1u << 20;
constexpr size_t WS_CTL = 0, CTL_ZERO_BYTES = 96 * 1024;
constexpr size_t WS_MOD = 1 * MiB;
constexpr size_t WS_ROPE = 2 * MiB;
constexpr size_t WS_WRT = 2 * MiB + 65536;
constexpr size_t WS_BGU = 3 * MiB;
constexpr size_t WS_MA = 4 * MiB;
constexpr size_t WS_DC = 4 * MiB + 262144;
constexpr size_t WS_MC = 5 * MiB;
constexpr size_t WS_WFIN = 9 * MiB;
constexpr size_t WS_WFOUT = 17 * MiB;
constexpr size_t WS_WMIN = 21 * MiB;
constexpr size_t WS_WMQB = 23 * MiB;
constexpr size_t WS_WMKVB = 25 * MiB;
constexpr size_t WS_WMO = 26 * MiB;
constexpr size_t WS_WGQKV = 28 * MiB;
constexpr size_t WS_WGO = 31 * MiB;
constexpr size_t WS_TE = 34 * MiB;
constexpr size_t WS_TRANK = 35 * MiB;
constexpr size_t WS_STOK = 36 * MiB;
constexpr size_t WS_SW = 41 * MiB;
constexpr size_t WS_X = 64 * MiB;
constexpr size_t WS_H = 200 * MiB;
constexpr size_t WS_RA = 272 * MiB;
constexpr size_t WS_RB = 400 * MiB;
constexpr size_t WS_RC = 528 * MiB;
constexpr size_t WS_RD = 600 * MiB;
constexpr size_t WS_RE = 672 * MiB;
constexpr size_t WS_RF = 728 * MiB;
constexpr size_t WS_RG = 756 * MiB;
constexpr size_t WS_RH = 776 * MiB;
constexpr size_t WS_ACT = 784 * MiB;
constexpr size_t WS_Y = 1072 * MiB;
constexpr size_t WS_WGU = 1360 * MiB;
constexpr size_t WS_SWGU = 1360 * MiB + 256 * MiB;
constexpr size_t WS_SH = 1360 * MiB + 259 * MiB;
constexpr size_t WS_SWP = 1360 * MiB + 259 * MiB + 256 * 1024;
constexpr size_t WS_W8 = 1360 * MiB + 266 * MiB;
constexpr size_t WS_SSC = 1360 * MiB + 260 * MiB;
constexpr size_t WS_WDN = 1872 * MiB;
constexpr size_t WS_SWDN = 1872 * MiB + 128 * MiB;
constexpr size_t WS_END = 2128 * MiB;
constexpr int CW_TMO = 0;
constexpr int CW_BAR = 4096;
constexpr int CW_CNT = 16384;

constexpr int RING_BYTES = 131072;
constexpr int LDS_MISC = 135168;
constexpr int LDS_TT = LDS_MISC;
constexpr int LDS_XB = LDS_MISC + 512;
constexpr int LDS_TE = LDS_MISC + 768;
constexpr int LDS_BYTES = 147456;

#define GAS __attribute__((address_space(1)))
#define LAS __attribute__((address_space(3)))
typedef unsigned short bf16;
typedef unsigned v4u __attribute__((ext_vector_type(4)));
typedef unsigned v2u __attribute__((ext_vector_type(2)));
typedef float f32x4 __attribute__((ext_vector_type(4)));
typedef float f32x2 __attribute__((ext_vector_type(2)));
typedef float f32x16 __attribute__((ext_vector_type(16)));
typedef short bf16x8 __attribute__((ext_vector_type(8)));
typedef short s16x4 __attribute__((ext_vector_type(4)));
typedef __bf16 bf16x2_t __attribute__((ext_vector_type(2)));
typedef GAS unsigned gu32;
#define RLX_AGENT __ATOMIC_RELAXED, __HIP_MEMORY_SCOPE_AGENT
#define LDS_WAIT() asm volatile("s_waitcnt lgkmcnt(0)" ::: "memory")
#define VM_WAIT() asm volatile("s_waitcnt vmcnt(0)" ::: "memory")
__device__ __forceinline__ unsigned pk2(float lo, float hi) { f32x2 v = {lo, hi}; bf16x2_t b = __builtin_convertvector(v, bf16x2_t); return __builtin_bit_cast(unsigned, b); }
__device__ __forceinline__ float bf_lo(unsigned u) { return __builtin_bit_cast(float, u << 16); }
__device__ __forceinline__ float bf_hi(unsigned u) { return __builtin_bit_cast(float, u & 0xffff0000u); }
__device__ __forceinline__ float shx(float v, int mask, int lane) { return __int_as_float(__builtin_amdgcn_ds_bpermute((lane ^ mask) << 2, __float_as_int(v))); }
__device__ __forceinline__ float wave_sum(float v, int lane) {
#pragma unroll
    for (int o = 1; o < 64; o <<= 1) v += shx(v, o, lane);
    return v;
}
__device__ __forceinline__ int lane_id_v() { int t; asm volatile("v_mbcnt_lo_u32_b32 %0, -1, 0\n\tv_mbcnt_hi_u32_b32 %0, -1, %0" : "=v"(t)); return t; }
__device__ __forceinline__ int launder_s(int x) { asm volatile("" : "+s"(x)); return x; }
__device__ __forceinline__ int lthread_w(int wave) { return wave * 64 + lane_id_v(); }
__device__ __forceinline__ int modrow_of(int row) { return row < NC ? NB : ((row - NC) >> 12); }

#define XB_TMO      128
#define XB_XCNT(j)  (256  + 64 * (j))
#define XB_XSUB(j)  (1280 + 64 * (j))
#define XB_XGEN(j)  (2304 + 64 * (j))
#define XB_TOP      3328
#define XB_TOPGEN   3392
#define XCD_BAR_WORDS 3456
#define XB_SPIN_CAP (1u << 18)
__device__ __forceinline__ unsigned xb_ld(unsigned* p)              { return __hip_atomic_load(p, __ATOMIC_RELAXED, __HIP_MEMORY_SCOPE_AGENT); }
__device__ __forceinline__ unsigned xb_add(unsigned* p, unsigned v) { return __hip_atomic_fetch_add(p, v, __ATOMIC_RELAXED, __HIP_MEMORY_SCOPE_AGENT); }
__device__ __forceinline__ unsigned xb_xcc_id() { return (unsigned)__builtin_amdgcn_s_getreg((3 << 11) | 20) & 0xFu; }
#define XB_SPIN(cond, bar) do { unsigned _sp = 0; while (cond) { __builtin_amdgcn_s_sleep(1); \
    if ((++_sp & 255u) == 0u) { if (xb_ld(&(bar)[XB_TMO])) break; if (_sp > XB_SPIN_CAP) { atomicAdd(&(bar)[XB_TMO], 1u); break; } } } } while (0)
struct XcdBarrier { unsigned* bar; unsigned x; volatile LAS unsigned* st; int wave; };
__device__ __forceinline__ bool xb_thread0(int wave) { return wave == 0 && lane_id_v() == 0; }
__device__ __forceinline__ XcdBarrier xcd_barrier_post(unsigned* bar, volatile LAS unsigned* st, int wave) {
    XcdBarrier b; b.bar = bar; b.x = xb_xcc_id(); b.st = st; b.wave = wave;
    if (xb_thread0(wave)) (void)xb_add(&bar[XB_XCNT(b.x)], 1u);
    return b;
}
__device__ __forceinline__ void xcd_barrier_complete(unsigned* bar, unsigned x, unsigned& nloc, unsigned& nx) {
    const unsigned G = gridDim.x * gridDim.y * gridDim.z;
    unsigned sum, cnt, mine, sp = 0u;
    for (;;) {
        sum = 0u; cnt = 0u; mine = 0u;
#pragma unroll
        for (unsigned j = 0; j < 16; ++j) { const unsigned c = xb_ld(&bar[XB_XCNT(j)]); sum += c; cnt += (c > 0u) ? 1u : 0u; mine = (j == x) ? c : mine; }
        if (sum == G) break;
        __builtin_amdgcn_s_sleep(1);
        if ((++sp & 255u) == 0u) { if (xb_ld(&bar[XB_TMO])) break; if (sp > XB_SPIN_CAP) { atomicAdd(&bar[XB_TMO], 1u); break; } }
    }
    nloc = mine > 0u ? mine : 1u; nx = cnt > 0u ? cnt : 1u;
}
__device__ __forceinline__ void xcd_barrier(const XcdBarrier& b) {
    asm volatile("s_waitcnt vmcnt(0)" ::: "memory");
    __syncthreads();
    if (xb_thread0(b.wave)) {
        unsigned* bar = b.bar;
        __builtin_amdgcn_s_waitcnt(0);
        unsigned nloc = b.st[0], nx = b.st[1];
        if (nloc == 0u) { xcd_barrier_complete(bar, b.x, nloc, nx); b.st[0] = nloc; b.st[1] = nx; }
        const unsigned old = xb_add(&bar[XB_XSUB(b.x)], 1u);
        const unsigned gen = old / nloc;
        if (old + 1u == (gen + 1u) * nloc) {
            __builtin_amdgcn_fence(__ATOMIC_RELEASE, "agent");
            asm volatile("s_waitcnt vmcnt(0)" ::: "memory");
            const unsigned og = xb_add(&bar[XB_TOP], 1u);
            const unsigned tg = og / nx;
            if (og + 1u == (tg + 1u) * nx) xb_add(&bar[XB_TOPGEN], 1u);
            else XB_SPIN(xb_ld(&bar[XB_TOPGEN]) == tg, bar);
            __builtin_amdgcn_fence(__ATOMIC_ACQUIRE, "agent");
            xb_add(&bar[XB_XGEN(b.x)], 1u);
            asm volatile("s_waitcnt vmcnt(0)" ::: "memory");
        } else {
            XB_SPIN(xb_ld(&bar[XB_XGEN(b.x)]) == gen, bar);
            __builtin_amdgcn_fence(__ATOMIC_ACQUIRE, "agent");
            asm volatile("s_waitcnt vmcnt(0)" ::: "memory");
        }
    }
    __syncthreads();
}

namespace pg8 {
#define PG8_LAS __attribute__((address_space(3)))
constexpr int BM = 256, BK = 64, HALF = 128, HTB = HALF * BK * 2, STAGE_BYTES = 8 * HTB, NXCD = 8, WGM = 8;
__device__ __forceinline__ int lds_byte(int r, int c) { const int st = (r >> 4) * 2 + (c >> 5), rr = r & 15, cc = c & 31, ob = rr * 64 + cc * 2; return st * 1024 + (ob ^ (((ob >> 9) & 1) << 5)); }
__device__ __forceinline__ void stage_rc(int b, int& R, int& C) { const int st = b / 1024, sb = b % 1024, swz = sb ^ (((sb >> 9) & 1) << 5); R = (st >> 1) * 16 + swz / 64; C = (st & 1) * 32 + (swz % 64) / 2; }
__device__ __forceinline__ int perm32(int rho) { const int n = rho >> 4, i = rho & 15; return 8 * (i >> 2) + 4 * n + (i & 3); }
struct Unit { int pm, pn, aux; };
typedef f32x4 Acc[2][2][4][2];
typedef int i32x4 __attribute__((ext_vector_type(4)));
typedef i32x4 AccI[2][2][4][2];
template <bool I8> struct AccSel { typedef f32x4 T; };
template <> struct AccSel<true> { typedef i32x4 T; };
__device__ __forceinline__ f32x4 mma1(bf16x8 b, bf16x8 a, f32x4 c) { return __builtin_amdgcn_mfma_f32_16x16x32_bf16(b, a, c, 0, 0, 0); }
typedef int i32x8 __attribute__((ext_vector_type(8)));
typedef short bf16x16 __attribute__((ext_vector_type(16)));
__device__ __forceinline__ f32x4 mma_f8(bf16x8 b0, bf16x8 b1, bf16x8 a0, bf16x8 a1, f32x4 c) {
    const i32x8 B = __builtin_bit_cast(i32x8, __builtin_shufflevector(b0, b1, 0, 1, 2, 3, 4, 5, 6, 7, 8, 9, 10, 11, 12, 13, 14, 15));
    const i32x8 A = __builtin_bit_cast(i32x8, __builtin_shufflevector(a0, a1, 0, 1, 2, 3, 4, 5, 6, 7, 8, 9, 10, 11, 12, 13, 14, 15));
    return __builtin_amdgcn_mfma_scale_f32_16x16x128_f8f6f4(B, A, c, 0, 0, 0, 0, 0, 0); }
__device__ __forceinline__ i32x4 mma1(bf16x8 b, bf16x8 a, i32x4 c) { return __builtin_amdgcn_mfma_i32_16x16x64_i8(__builtin_bit_cast(i32x4, b), __builtin_bit_cast(i32x4, a), c, 0, 0, 0); }

__device__ __forceinline__ bool static_next(int i, int G, int c, int nM, int nN, int& pm, int& pn) {
    const int nwg = nM * nN; const long L = (long)i * G + c; if (L >= nwg) return false;
    int wgid = (int)L; { const int q = nwg / NXCD, r = nwg % NXCD, xcd = wgid % NXCD, off = wgid / NXCD; wgid = (xcd < r ? xcd * (q + 1) : r * (q + 1) + (xcd - r) * q) + off; }
    const int nig = WGM * nN, gid = wgid / nig, fm = gid * WGM, gsz = (nM - fm) < WGM ? (nM - fm) : WGM;
    pm = fm + ((wgid % nig) % gsz); pn = (wgid % nig) / gsz; return true;
}

template <class P>
__device__ __forceinline__ void gemm_phase(PG8_LAS unsigned char* lds, const P& p, int wave_id) {
    wave_id = launder_s(wave_id); int tid_l = lthread_w(wave_id);
    const int tid = tid_l, wid = wave_id, lane = tid & 63, wr = wid >> 2, wc = wid & 3, fr = lane & 15, fq = lane >> 4;
    const int nt = p.nt;
    const unsigned ldsw = (unsigned)wid * 1024u;
    const int aoff = lds_byte(wr * 64 + fr, fq * 8), boff = lds_byte(wc * 32 + fr, fq * 8);
    const char* const gA = p.A; const char* const gB = p.B;
#define PG8_SA(b, h) (((b) * 2 + (h)) * HTB)
#define PG8_SB(b, h) ((4 + (b) * 2 + (h)) * HTB)
#define PG8_STAGE(bufoff, gbase, off2, kofs) do { _Pragma("unroll") for (int _i = 0; _i < 2; ++_i) \
        __builtin_amdgcn_global_load_lds((const unsigned*)((gbase) + (size_t)(off2)[_i] + (size_t)(kofs)), (PG8_LAS unsigned*)(lds + (bufoff) + ldsw + _i * 8192), 16, 0, 0); } while (0)
#define PG8_LDA(dst, b, h) do { _Pragma("unroll") for (int m = 0; m < 4; ++m) _Pragma("unroll") for (int k = 0; k < 2; ++k) dst[m][k] = *(const PG8_LAS bf16x8*)(lds + PG8_SA(b, h) + aoff + m * 2048 + k * 1024); } while (0)
#define PG8_LDB(dst, b, h) do { _Pragma("unroll") for (int n = 0; n < 2; ++n) _Pragma("unroll") for (int k = 0; k < 2; ++k) dst[n][k] = *(const PG8_LAS bf16x8*)(lds + PG8_SB(b, h) + boff + n * 2048 + k * 1024); } while (0)
#define PG8_MMA(ai, bj, At, Bt) do { __builtin_amdgcn_s_setprio(1); _Pragma("unroll") for (int m = 0; m < 4; ++m) _Pragma("unroll") for (int n = 0; n < 2; ++n) { \
        if constexpr (P::F8) acc[ai][bj][m][n] = mma_f8(Bt[n][0], Bt[n][1], At[m][0], At[m][1], acc[ai][bj][m][n]); \
        else { _Pragma("unroll") for (int k = 0; k < 2; ++k) acc[ai][bj][m][n] = mma1(Bt[n][k], At[m][k], acc[ai][bj][m][n]); } } __builtin_amdgcn_s_setprio(0); } while (0)
#define PG8_WAIT_V(n) asm volatile("s_waitcnt vmcnt(" #n ")" ::: "memory")
#define PG8_WAIT_L(n) asm volatile("s_waitcnt lgkmcnt(" #n ")" ::: "memory")
#define PG8_BAR __builtin_amdgcn_s_barrier()
#define PG8_SCHED __builtin_amdgcn_sched_barrier(0)
#define PG8_KEYS(u) do { if (P::KEYS && wid < 4) __builtin_amdgcn_global_load_lds((const unsigned*)p.key_ptr(u, wid * 64 + lane_id_v()), (PG8_LAS unsigned*)(keybuf + wid * 256), 4, 0, 0); } while (0)
#define PG8_OFFS(u, oA, oB) do { const int tid2_ = wid * 64 + lane_id_v();     \
    _Pragma("unroll") for (int _i = 0; _i < 2; ++_i) { int R_, C_; stage_rc(tid2_ * 16 + _i * 8192, R_, C_); const int Rb_ = P::PERM ? ((R_ & ~31) + perm32(R_ & 31)) : R_; \
      _Pragma("unroll") for (int _h = 0; _h < 2; ++_h) { \
        const int key_ = P::KEYS ? ((const PG8_LAS int*)keybuf)[_h * HALF + R_] : 0; \
        oA[_h][_i] = p.a_row(u, _h * HALF + R_, key_) + (unsigned)(C_ * 2); oB[_h][_i] = p.b_row(u, _h * HALF + Rb_) + (unsigned)(C_ * 2); } } } while (0)
    PG8_LAS unsigned char* const keybuf = lds + STAGE_BYTES;
    Unit cur, nxt; int ui = 0;
    if (!p.next(0, cur)) return;
    typedef typename AccSel<P::I8>::T AccT;
    AccT acc[2][2][4][2];
#pragma unroll
    for (int a = 0; a < 2; ++a)
#pragma unroll
        for (int b = 0; b < 2; ++b)
#pragma unroll
            for (int m = 0; m < 4; ++m)
#pragma unroll
                for (int n = 0; n < 2; ++n) acc[a][b][m][n] = (AccT){0, 0, 0, 0};
    bf16x8 At[4][2], B0[2][2], B1[2][2];
    unsigned oAc[2][2], oBc[2][2];
    if (P::KEYS) { PG8_KEYS(cur); PG8_WAIT_V(0); PG8_BAR; }
    PG8_OFFS(cur, oAc, oBc);
    PG8_STAGE(PG8_SB(0, 0), gB, oBc[0], 0); PG8_STAGE(PG8_SB(0, 1), gB, oBc[1], 0); PG8_STAGE(PG8_SA(0, 0), gA, oAc[0], 0); PG8_STAGE(PG8_SA(0, 1), gA, oAc[1], 0);
    if (wr == 1) PG8_BAR;
    PG8_WAIT_V(2); PG8_BAR;
    PG8_STAGE(PG8_SB(1, 0), gB, oBc[0], 128); PG8_STAGE(PG8_SA(1, 0), gA, oAc[0], 128); PG8_STAGE(PG8_SB(1, 1), gB, oBc[1], 128);
    PG8_WAIT_V(6); PG8_BAR;
    for (;;) {
        const bool has_next = p.next(ui + 1, nxt);
        if (has_next) { PG8_KEYS(nxt); }
        for (int t = 0; t < nt; t += 2) {
            const bool last = (t == nt - 2);
            const unsigned k1 = (unsigned)(t + 1) * 128u;
            const unsigned k2 = last ? 0u : (unsigned)(t + 2) * 128u, k3 = k2 + 128u;
            PG8_LDB(B0, 0, 0); PG8_LDB(B1, 0, 1); PG8_SCHED; PG8_LDA(At, 0, 0); PG8_STAGE(PG8_SA(1, 1), gA, oAc[1], k1);
            if (last && has_next) { PG8_OFFS(nxt, oAc, oBc); }
            PG8_WAIT_V(8); PG8_WAIT_L(0); PG8_BAR; PG8_MMA(0, 0, At, B0); PG8_MMA(0, 1, At, B1); PG8_BAR; PG8_SCHED;
            PG8_LDA(At, 0, 1); PG8_STAGE(PG8_SB(0, 0), gB, oBc[0], k2); PG8_STAGE(PG8_SB(0, 1), gB, oBc[1], k2); PG8_STAGE(PG8_SA(0, 0), gA, oAc[0], k2);
            PG8_WAIT_V(8); PG8_WAIT_L(0); PG8_BAR; PG8_MMA(1, 0, At, B0); PG8_MMA(1, 1, At, B1); PG8_BAR; PG8_SCHED;
            PG8_LDB(B0, 1, 0); PG8_LDB(B1, 1, 1); PG8_SCHED; PG8_LDA(At, 1, 0); PG8_STAGE(PG8_SA(0, 1), gA, oAc[1], k2);
            PG8_WAIT_V(8); PG8_WAIT_L(0); PG8_BAR; PG8_MMA(0, 0, At, B0); PG8_MMA(0, 1, At, B1); PG8_BAR; PG8_SCHED;
            PG8_LDA(At, 1, 1); PG8_STAGE(PG8_SB(1, 0), gB, oBc[0], k3); PG8_STAGE(PG8_SB(1, 1), gB, oBc[1], k3); PG8_STAGE(PG8_SA(1, 0), gA, oAc[0], k3);
            PG8_WAIT_V(8); PG8_WAIT_L(0); PG8_BAR; PG8_MMA(1, 0, At, B0); PG8_MMA(1, 1, At, B1); PG8_BAR; PG8_SCHED;
        }
        if (wr == 0) PG8_BAR;
        { const int le_ = lane_id_v(); int fr_e = le_ & 15, fq_e = le_ >> 4;
          p.epi(acc, cur, wr, wc, fr_e, fq_e); }
        if (!has_next) break;
#pragma unroll
        for (int a = 0; a < 2; ++a)
#pragma unroll
            for (int b = 0; b < 2; ++b)
#pragma unroll
                for (int m = 0; m < 4; ++m)
#pragma unroll
                    for (int n = 0; n < 2; ++n) acc[a][b][m][n] = (AccT){0, 0, 0, 0};
        cur = nxt; ++ui;
        if (wr == 1) PG8_BAR;
    }
    PG8_WAIT_V(0);
    PG8_BAR;
#undef PG8_SA
#undef PG8_SB
#undef PG8_STAGE
#undef PG8_LDA
#undef PG8_LDB
#undef PG8_MMA
#undef PG8_WAIT_V
#undef PG8_WAIT_L
#undef PG8_BAR
#undef PG8_SCHED
#undef PG8_OFFS
#undef PG8_KEYS
}
}
using pg8::Unit;

#define TROW(ai, wr, m, fr) (128 * (ai) + 64 * (wr) + 16 * (m) + (fr))
#define TCOLP(bj, wc, fq) (128 * (bj) + 32 * (wc) + 8 * (fq))
#define TCOLN(bj, wc, n, fq) (128 * (bj) + 32 * (wc) + 16 * (n) + 4 * (fq))
__device__ __forceinline__ v4u pack8(const f32x4 a, const f32x4 b) { v4u w; w.x = pk2(a[0], a[1]); w.y = pk2(a[2], a[3]); w.z = pk2(b[0], b[1]); w.w = pk2(b[2], b[3]); return w; }

struct PolDenseBf16 {
    static constexpr bool PERM = true;
    static constexpr bool KEYS = false;
    static constexpr bool I8 = false;
    static constexpr bool F8 = false;
    __device__ __forceinline__ const int* key_ptr(const Unit&, int) const { return nullptr; }
    const char* A; const char* B; int nt; int nM, nN, pm0, G, c; unsigned pitchA, pitchB; bf16* O; int ldo;
    __device__ __forceinline__ bool next(int i, Unit& u) const { int pm, pn; if (!pg8::static_next(i, G, c, nM, nN, pm, pn)) return false; u.pm = pm + pm0; u.pn = pn; u.aux = 0; return true; }
    __device__ __forceinline__ unsigned a_row(const Unit& u, int r, int) const { return (unsigned)(u.pm * 256 + r) * pitchA; }
    __device__ __forceinline__ unsigned b_row(const Unit& u, int r) const { return (unsigned)(u.pn * 256 + r) * pitchB; }
    __device__ __forceinline__ void epi(const pg8::Acc& acc, const Unit& u, int wr, int wc, int fr, int fq) const {
#pragma unroll
        for (int ai = 0; ai < 2; ++ai)
#pragma unroll
            for (int m = 0; m < 4; ++m) { const size_t row = (size_t)u.pm * 256 + TROW(ai, wr, m, fr);
#pragma unroll
                for (int bj = 0; bj < 2; ++bj) { const int col = u.pn * 256 + TCOLP(bj, wc, fq); *(v4u*)(O + row * ldo + col) = pack8(acc[ai][bj][m][0], acc[ai][bj][m][1]); } }
    }
};

struct PolDenseI8 {
    static constexpr bool PERM = true;
    static constexpr bool KEYS = false;
    static constexpr bool I8 = true;
    static constexpr bool F8 = false;
    __device__ __forceinline__ const int* key_ptr(const Unit&, int) const { return nullptr; }
    const char* A; const char* B; int nt; int nM, nN, pm0, G, c; const float* sA; const float* sB; bf16* O; int ldo;
    __device__ __forceinline__ bool next(int i, Unit& u) const { int pm, pn; if (!pg8::static_next(i, G, c, nM, nN, pm, pn)) return false; u.pm = pm + pm0; u.pn = pn; u.aux = 0; return true; }
    __device__ __forceinline__ unsigned a_row(const Unit& u, int r, int) const { return (unsigned)(u.pm * 256 + r) * 1024u; }
    __device__ __forceinline__ unsigned b_row(const Unit& u, int r) const { return (unsigned)(u.pn * 256 + r) * 1024u; }
    __device__ __forceinline__ void epi(const pg8::AccI& acc, const Unit& u, int wr, int wc, int fr, int fq) const {
#pragma unroll
        for (int bj = 0; bj < 2; ++bj) { const int col = u.pn * 256 + TCOLP(bj, wc, fq); const f32x4 s0 = *(const f32x4*)(sB + col), s1 = *(const f32x4*)(sB + col + 4);
#pragma unroll
            for (int ai = 0; ai < 2; ++ai)
#pragma unroll
                for (int m = 0; m < 4; ++m) { const size_t row = (size_t)u.pm * 256 + TROW(ai, wr, m, fr); const float sa = sA[row]; f32x4 v0, v1;
#pragma unroll
                    for (int q = 0; q < 4; ++q) { v0[q] = (float)acc[ai][bj][m][0][q] * (sa * s0[q]); v1[q] = (float)acc[ai][bj][m][1][q] * (sa * s1[q]); }
                    *(v4u*)(O + row * ldo + col) = pack8(v0, v1); } }
    }
};

struct PolOut {
    static constexpr bool PERM = true;
    static constexpr bool KEYS = false;
    static constexpr bool I8 = false;
    static constexpr bool F8 = false;
    __device__ __forceinline__ const int* key_ptr(const Unit&, int) const { return nullptr; }
    const char* A; const char* B; int nt; int nM, nN, pm0, G, c; bf16* X; const float* mod;
    int chunk; const float* XinC; const float* XinL;
    __device__ __forceinline__ bool next(int i, Unit& u) const { int pm, pn; if (!pg8::static_next(i, G, c, nM, nN, pm, pn)) return false; u.pm = pm + pm0; u.pn = pn; u.aux = 0; return true; }
    __device__ __forceinline__ unsigned a_row(const Unit& u, int r, int) const { return (unsigned)(u.pm * 256 + r) * 2048u; }
    __device__ __forceinline__ unsigned b_row(const Unit& u, int r) const { return (unsigned)(u.pn * 256 + r) * 2048u; }
    __device__ __forceinline__ void epi(const pg8::Acc& acc, const Unit& u, int wr, int wc, int fr, int fq) const {
        const int mr = modrow_of(u.pm * 256);
        const float* g = mod + (size_t)mr * (NMOD * D) + chunk * D;
        const float* xin = XinC ? (u.pm < 8 ? XinC : XinL) : nullptr;
#pragma unroll
        for (int bj = 0; bj < 2; ++bj) { const int col = u.pn * 256 + TCOLP(bj, wc, fq); const f32x4 g0 = *(const f32x4*)(g + col), g1 = *(const f32x4*)(g + col + 4);
#pragma unroll
            for (int ai = 0; ai < 2; ++ai)
#pragma unroll
                for (int m = 0; m < 4; ++m) { const size_t off = ((size_t)u.pm * 256 + TROW(ai, wr, m, fr)) * D + col; f32x4 x0, x1;
                    if (xin) { x0 = *(const f32x4*)(xin + off); x1 = *(const f32x4*)(xin + off + 4); }
                    else { const v4u w = *(const v4u*)(X + off); x0 = (f32x4){bf_lo(w.x), bf_hi(w.x), bf_lo(w.y), bf_hi(w.y)}; x1 = (f32x4){bf_lo(w.z), bf_hi(w.z), bf_lo(w[3]), bf_hi(w[3])}; }
                    *(v4u*)(X + off) = pack8(x0 + g0 * acc[ai][bj][m][0], x1 + g1 * acc[ai][bj][m][1]); } }
    }
};

struct PolFP {
    static constexpr bool PERM = true;
    static constexpr bool KEYS = false;
    static constexpr bool I8 = true;
    static constexpr bool F8 = false;
    __device__ __forceinline__ const int* key_ptr(const Unit&, int) const { return nullptr; }
    const char* A; const char* B; int nt; int nN, G, c; const float* sW; const float* sH; bf16* Z; bf16* Zc;
    __device__ __forceinline__ bool next(int i, Unit& u) const { int pm, pn; if (!pg8::static_next(i, G, c, 8, nN, pm, pn)) return false; u.pm = pm; u.pn = pn; u.aux = 0; return true; }
    __device__ __forceinline__ unsigned a_row(const Unit& u, int r, int) const { return (unsigned)(u.pm * 256 + r) * 1024u; }
    __device__ __forceinline__ int tok_row(int pn, int n) const { if (pn < 128) { const int b = n >> 12, l2 = (n >> 6) & 63, l1 = n & 63; return NC + b * SEQ + 64 * l1 + l2; } return n - 32768; }
    __device__ __forceinline__ unsigned b_row(const Unit& u, int r) const { return (unsigned)tok_row(u.pn, u.pn * 256 + r) * 1024u; }
    __device__ __forceinline__ void epi(const pg8::AccI& acc, const Unit& u, int wr, int wc, int fr, int fq) const {
#pragma unroll
        for (int bj = 0; bj < 2; ++bj) { const int n0 = u.pn * 256 + TCOLP(bj, wc, fq);
            f32x4 h0, h1;
#pragma unroll
            for (int q = 0; q < 4; ++q) { h0[q] = sH[tok_row(u.pn, n0 + q)]; h1[q] = sH[tok_row(u.pn, n0 + 4 + q)]; }
#pragma unroll
            for (int ai = 0; ai < 2; ++ai)
#pragma unroll
                for (int m = 0; m < 4; ++m) { const int cp = u.pm * 256 + TROW(ai, wr, m, fr); const float sw = sW[cp]; f32x4 v0, v1;
#pragma unroll
                    for (int q = 0; q < 4; ++q) { v0[q] = (float)acc[ai][bj][m][0][q] * (sw * h0[q]); v1[q] = (float)acc[ai][bj][m][1][q] * (sw * h1[q]); }
                    const v4u w = pack8(v0, v1);
                    if (u.pn < 128) *(v4u*)(Z + ((size_t)(n0 >> 6) * 2048 + cp) * 64 + (n0 & 63)) = w;
                    else { const int b = u.pn - 128, l = n0 - 32768 - b * 256; *(v4u*)(Zc + ((size_t)b * 2048 + cp) * 256 + l) = w; } } }
    }
};

struct PolFA {
    static constexpr bool PERM = true;
    static constexpr bool KEYS = false;
    static constexpr bool I8 = false;
    static constexpr bool F8 = false;
    __device__ __forceinline__ const int* key_ptr(const Unit&, int) const { return nullptr; }
    const char* A; const char* B; int nt; int G, c; bf16* Y;
    __device__ __forceinline__ bool next(int i, Unit& u) const { const int L = i * G + c; if (L >= 1024) return false; u.pm = 0; u.pn = L & 127; u.aux = L >> 7; return true; }
    __device__ __forceinline__ unsigned a_row(const Unit&, int r, int) const { return (unsigned)r * 512u; }
    __device__ __forceinline__ unsigned b_row(const Unit& u, int r) const { const int l2 = r & 63, cp = u.pn * 4 + (r >> 6); return (unsigned)((u.aux * 64 + l2) * 512 + cp) * 512u; }
    __device__ __forceinline__ void epi(const pg8::Acc& acc, const Unit& u, int wr, int wc, int fr, int fq) const {
        const int b = u.aux;
#pragma unroll
        for (int ai = 0; ai < 2; ++ai)
#pragma unroll
            for (int m = 0; m < 4; ++m) { const int rr = TROW(ai, wr, m, fr), jp = rr >> 7, pp = (rr >> 6) & 1, k1 = rr & 63;
#pragma unroll
                for (int bj = 0; bj < 2; ++bj) { const int n0 = u.pn * 256 + TCOLP(bj, wc, fq), cp = n0 >> 6, l2 = n0 & 63, cc = 2 * cp + jp;
                    const size_t idx = ((((size_t)(b * 16 + (k1 >> 2)) * 1024 + cc) * 4 + (k1 & 3)) * 2 + pp) * 64 + l2;
                    *(v4u*)(Y + idx) = pack8(acc[ai][bj][m][0], acc[ai][bj][m][1]); } }
    }
};

struct PolFC {
    static constexpr bool PERM = true;
    static constexpr bool KEYS = false;
    static constexpr bool I8 = false;
    static constexpr bool F8 = false;
    __device__ __forceinline__ const int* key_ptr(const Unit&, int) const { return nullptr; }
    const char* A; const char* B; int nt; int G, c; int nunits; unsigned offMC, offZc; bf16* F;
    __device__ __forceinline__ bool next(int i, Unit& u) const { const int L = i * G + c; if (L >= nunits) return false;
        if (L < 512) { u.pm = 0; u.pn = L & 3; u.aux = L >> 2; } else { const int q = L - 512; u.pm = 0; u.pn = q & 3; u.aux = 256 + (q >> 2); } return true; }
    __device__ __forceinline__ unsigned a_row(const Unit& u, int r, int) const {
        if (u.aux < 256) return offMC + (unsigned)((u.aux & 15) * 256 + r) * 1024u;
        return (unsigned)r * 1024u; }
    __device__ __forceinline__ unsigned b_row(const Unit& u, int r) const {
        if (u.aux < 256) return (unsigned)(u.aux * 1024 + u.pn * 256 + r) * 1024u;
        return offZc + (unsigned)((u.aux - 256) * 1024 + u.pn * 256 + r) * 1024u; }
    __device__ __forceinline__ void epi(const pg8::Acc& acc, const Unit& u, int wr, int wc, int fr, int fq) const {
#pragma unroll
        for (int ai = 0; ai < 2; ++ai)
#pragma unroll
            for (int m = 0; m < 4; ++m) { const int rr = TROW(ai, wr, m, fr); size_t frow;
                if (u.aux < 256) { const int b = u.aux >> 4, kq = u.aux & 15, k = 4 * kq + (rr >> 6) + 64 * (rr & 63); frow = (size_t)NC + b * SEQ + k; }
                else frow = (size_t)(u.aux - 256) * LCTX + rr;
#pragma unroll
                for (int bj = 0; bj < 2; ++bj) { const int col = u.pn * 256 + TCOLP(bj, wc, fq); *(v4u*)(F + frow * D + col) = pack8(acc[ai][bj][m][0], acc[ai][bj][m][1]); } }
    }
};

struct PolMlaQ {
    static constexpr bool PERM = true;
    static constexpr bool KEYS = false;
    static constexpr bool I8 = false;
    static constexpr bool F8 = false;
    __device__ __forceinline__ const int* key_ptr(const Unit&, int) const { return nullptr; }
    const char* A; const char* B; int nt; int nM, nN, G, c; bf16* Q; const float* rope; float c2;
    __device__ __forceinline__ bool next(int i, Unit& u) const { int pm, pn; if (!pg8::static_next(i, G, c, nM, nN, pm, pn)) return false; u.pm = pm; u.pn = pn; u.aux = 0; return true; }
    __device__ __forceinline__ unsigned a_row(const Unit& u, int r, int) const { return (unsigned)(u.pm * 256 + r) * (unsigned)(MLA_QL * 2); }
    __device__ __forceinline__ unsigned b_row(const Unit& u, int r) const { return (unsigned)(u.pn * 256 + r) * (unsigned)(MLA_QL * 2); }
    __device__ __forceinline__ void epi(const pg8::Acc& acc, const Unit& u, int wr, int wc, int fr, int fq) const {
        const bool lat = u.pm >= 8;
#pragma unroll
        for (int bj = 0; bj < 2; ++bj) { const int col = u.pn * 256 + TCOLP(bj, wc, fq); const bool isrope = lat && (((col >> 5) % 3) == 2);
#pragma unroll
            for (int ai = 0; ai < 2; ++ai)
#pragma unroll
                for (int m = 0; m < 4; ++m) { const int row = u.pm * 256 + TROW(ai, wr, m, fr); f32x4 v0 = acc[ai][bj][m][0], v1 = acc[ai][bj][m][1];
                    if (isrope) { const int t = (row - NC) & 4095, pos = (fq & 2) ? (t & 63) : (t >> 6);
                        const f32x4* rp = (const f32x4*)(rope + (size_t)pos * 16);
                        const f32x4 r0 = rp[0], r1 = rp[1], r2 = rp[2], r3 = rp[3];
                        f32x4 p0, p1;
#pragma unroll
                        for (int e = 0; e < 4; ++e) { p0[e] = shx(v0[e], 16, fq * 16 + fr); p1[e] = shx(v1[e], 16, fq * 16 + fr); }
                        const float sg = (fq & 1) ? 1.f : -1.f;
                        v0[0] = v0[0] * r0[0] + sg * p0[0] * r0[1]; v0[1] = v0[1] * r0[2] + sg * p0[1] * r0[3];
                        v0[2] = v0[2] * r1[0] + sg * p0[2] * r1[1]; v0[3] = v0[3] * r1[2] + sg * p0[3] * r1[3];
                        v1[0] = v1[0] * r2[0] + sg * p1[0] * r2[1]; v1[1] = v1[1] * r2[2] + sg * p1[1] * r2[3];
                        v1[2] = v1[2] * r3[0] + sg * p1[2] * r3[1]; v1[3] = v1[3] * r3[2] + sg * p1[3] * r3[3]; }
                    *(v4u*)(Q + (size_t)row * 1536 + col) = pack8(v0 * c2, v1 * c2); } }
    }
};

struct PolMlaKV {
    static constexpr bool PERM = true;
    static constexpr bool KEYS = false;
    static constexpr bool I8 = false;
    static constexpr bool F8 = false;
    __device__ __forceinline__ const int* key_ptr(const Unit&, int) const { return nullptr; }
    const char* A; const char* B; int nt; int nM, nN, G, c; bf16* Kb; bf16* Vb;
    __device__ __forceinline__ bool next(int i, Unit& u) const { int pm, pn; if (!pg8::static_next(i, G, c, nM, nN, pm, pn)) return false; u.pm = pm; u.pn = pn; u.aux = 0; return true; }
    __device__ __forceinline__ unsigned a_row(const Unit& u, int r, int) const { return (unsigned)(u.pm * 256 + r) * 512u; }
    __device__ __forceinline__ unsigned b_row(const Unit& u, int r) const { return (unsigned)(u.pn * 256 + r) * 512u; }
    __device__ __forceinline__ void epi(const pg8::Acc& acc, const Unit& u, int wr, int wc, int fr, int fq) const {
#pragma unroll
        for (int bj = 0; bj < 2; ++bj) { const int col = u.pn * 256 + TCOLP(bj, wc, fq), h = col >> 7, j = col & 127;
#pragma unroll
            for (int ai = 0; ai < 2; ++ai)
#pragma unroll
                for (int m = 0; m < 4; ++m) { const size_t row = (size_t)u.pm * 256 + TROW(ai, wr, m, fr); const v4u w = pack8(acc[ai][bj][m][0], acc[ai][bj][m][1]);
                    if (j < 64) *(v4u*)(Kb + row * 1536 + 96 * h + j) = w; else *(v4u*)(Vb + row * 1024 + 64 * h + (j - 64)) = w; } }
    }
};

struct MoeTab { const LAS int* TT; const LAS int* CN; const LAS int* TE; };
__device__ __forceinline__ bool moe_next(int i, int G, int c, int NP, const MoeTab& T, Unit& u) {
    const int ttot = T.TT[32];
    int lo, hi, j;
    if ((G & 7) == 0) { const int x = c & 7, q = c >> 3, g8 = G >> 3; lo = (x * ttot) >> 3; hi = ((x + 1) * ttot) >> 3; j = i * g8 + q; }
    else { lo = 0; hi = ttot; j = i * G + c; }
    if (j >= (hi - lo) * NP) return false;
    const int tile = lo + j / NP; u.pn = j % NP; u.pm = tile;
    const int e = T.TE[tile];
    u.aux = e | ((tile - T.TT[e]) << 8);
    return true;
}
struct PolMoe1 {
    static constexpr bool PERM = true;
    static constexpr bool I8 = true;
    static constexpr bool F8 = false;
    const char* A; const char* B; int nt; int G, c; MoeTab T; const int* stok; const float* bgu; const float* swgu; const float* ssc; unsigned char* act;
    __device__ __forceinline__ bool next(int i, Unit& u) const { return moe_next(i, G, c, 8, T, u); }
    static constexpr bool KEYS = true;
    __device__ __forceinline__ const int* key_ptr(const Unit& u, int r) const { const int e = u.aux & 255, idx = (u.aux >> 8) * 256 + r; const int cn = T.CN[e]; return stok + (size_t)e * CAP + (idx < cn ? idx : 0); }
    __device__ __forceinline__ unsigned a_row(const Unit&, int, int key) const { return (unsigned)key * 1024u; }
    __device__ __forceinline__ unsigned b_row(const Unit& u, int r) const { return (unsigned)((u.aux & 255) * 2048 + u.pn * 256 + r) * 1024u; }
    __device__ __forceinline__ void epi(const pg8::AccI& acc, const Unit& u, int wr, int wc, int fr, int fq) const {
        const int e = u.aux & 255, mt = u.aux >> 8, cn = T.CN[e]; const int jl = 32 * wc + 8 * fq;
        const float* bg = bgu + (size_t)e * 2048 + u.pn * 256 + jl;
        const float* sg = swgu + (size_t)e * 2048 + u.pn * 256 + jl;
        const f32x4 bg0 = *(const f32x4*)(bg), bg1 = *(const f32x4*)(bg + 4), bu0 = *(const f32x4*)(bg + 128), bu1 = *(const f32x4*)(bg + 132);
        const f32x4 sg0 = *(const f32x4*)(sg), sg1 = *(const f32x4*)(sg + 4), su0 = *(const f32x4*)(sg + 128), su1 = *(const f32x4*)(sg + 132);
#pragma unroll
        for (int ai = 0; ai < 2; ++ai)
#pragma unroll
            for (int m = 0; m < 4; ++m) { const int rr = TROW(ai, wr, m, fr), idx = mt * 256 + rr; const size_t slot = (size_t)u.pm * 256 + rr;
                const float sa = ssc[(size_t)e * CAP + (idx < cn ? idx : 0)];
                f32x4 g0, g1, u0, u1, o0, o1;
#pragma unroll
                for (int q = 0; q < 4; ++q) { g0[q] = (float)acc[ai][0][m][0][q] * (sa * sg0[q]) + bg0[q]; g1[q] = (float)acc[ai][0][m][1][q] * (sa * sg1[q]) + bg1[q];
                    u0[q] = (float)acc[ai][1][m][0][q] * (sa * su0[q]) + bu0[q]; u1[q] = (float)acc[ai][1][m][1][q] * (sa * su1[q]) + bu1[q]; }
#pragma unroll
                for (int q = 0; q < 4; ++q) {
                    float ga = fminf(g0[q], 7.f), ua = fminf(fmaxf(u0[q], -7.f), 7.f); o0[q] = (ua + 1.f) * ga * __builtin_amdgcn_rcpf(1.f + __builtin_amdgcn_exp2f(-1.702f * LOG2E * ga));
                    float gb = fminf(g1[q], 7.f), ub = fminf(fmaxf(u1[q], -7.f), 7.f); o1[q] = (ub + 1.f) * gb * __builtin_amdgcn_rcpf(1.f + __builtin_amdgcn_exp2f(-1.702f * LOG2E * gb)); }
                v2u w8; { int t0 = __builtin_amdgcn_cvt_pk_fp8_f32(o0[0], o0[1], 0, false); t0 = __builtin_amdgcn_cvt_pk_fp8_f32(o0[2], o0[3], t0, true);
                          int t1 = __builtin_amdgcn_cvt_pk_fp8_f32(o1[0], o1[1], 0, false); t1 = __builtin_amdgcn_cvt_pk_fp8_f32(o1[2], o1[3], t1, true); w8.x = (unsigned)t0; w8.y = (unsigned)t1; }
                *(v2u*)(act + slot * 1024 + u.pn * 128 + jl) = w8; }
    }
};
struct PolMoe2 {
    static constexpr bool PERM = true;
    static constexpr bool KEYS = false;
    static constexpr bool I8 = false;
    static constexpr bool F8 = true;
    __device__ __forceinline__ const int* key_ptr(const Unit&, int) const { return nullptr; }
    const char* A; const char* B; int nt; int G, c; MoeTab T; const float* sw; const float* bdn; const float* swd; unsigned char* Y;
    __device__ __forceinline__ bool next(int i, Unit& u) const { return moe_next(i, G, c, 4, T, u); }
    __device__ __forceinline__ unsigned a_row(const Unit& u, int r, int) const { return (unsigned)(u.pm * 256 + r) * 1024u; }
    __device__ __forceinline__ unsigned b_row(const Unit& u, int r) const { return (unsigned)((u.aux & 255) * 1024 + u.pn * 256 + r) * 1024u; }
    __device__ __forceinline__ void epi(const pg8::Acc& acc, const Unit& u, int wr, int wc, int fr, int fq) const {
        const int e = u.aux & 255, mt = u.aux >> 8, cn = T.CN[e];
#pragma unroll
        for (int bj = 0; bj < 2; ++bj) { const int col = u.pn * 256 + TCOLP(bj, wc, fq); const size_t ci = (size_t)e * 1024 + col;
            const f32x4 b0 = *(const f32x4*)(bdn + ci), b1 = *(const f32x4*)(bdn + ci + 4), s0 = *(const f32x4*)(swd + ci), s1 = *(const f32x4*)(swd + ci + 4);
#pragma unroll
            for (int ai = 0; ai < 2; ++ai)
#pragma unroll
                for (int m = 0; m < 4; ++m) { const int rr = TROW(ai, wr, m, fr), idx = mt * 256 + rr; const size_t slot = (size_t)u.pm * 256 + rr; const float w = sw[(size_t)e * CAP + (idx < cn ? idx : 0)];
                    const float w8 = w * 8.f; f32x4 y0 = (acc[ai][bj][m][0] * s0 + b0) * w8, y1 = (acc[ai][bj][m][1] * s1 + b1) * w8;
#pragma unroll
                    for (int q = 0; q < 4; ++q) { y0[q] = fminf(fmaxf(y0[q], -448.f), 448.f); y1[q] = fminf(fmaxf(y1[q], -448.f), 448.f); }
                    v2u o8; { int t0 = __builtin_amdgcn_cvt_pk_fp8_f32(y0[0], y0[1], 0, false); t0 = __builtin_amdgcn_cvt_pk_fp8_f32(y0[2], y0[3], t0, true);
                              int t1 = __builtin_amdgcn_cvt_pk_fp8_f32(y1[0], y1[1], 0, false); t1 = __builtin_amdgcn_cvt_pk_fp8_f32(y1[2], y1[3], t1, true); o8.x = (unsigned)t0; o8.y = (unsigned)t1; }
                    *(v2u*)(Y + slot * 1024 + col) = o8; } }
    }
};

namespace att {
__device__ __forceinline__ int crow(int r, int hi) { return (r & 3) + 8 * (r >> 2) + 4 * hi; }
__device__ __forceinline__ float max3f(float a, float b, float c) { return fmaxf(fmaxf(a, b), c); }
typedef LAS const char* lds_cptr;
constexpr int LK = 0, LV = 49152, LWS = 90112, LOST = 92160, LBYTES = 124928;
constexpr int PD = 3;
struct Tens { const bf16* Q; int qpitch; const bf16* K; int kpitch; const bf16* V; int vpitch; bf16* O; };
#define ATT_WAITV(n) asm volatile("s_waitcnt vmcnt(" #n ")" ::: "memory")
struct Pend { f32x16 o0, o1; float l; int qrow0, oc0; bool valid; };
__device__ __forceinline__ void finish_unit(const Pend& P, bf16* O, LAS unsigned char* lds, int wid, int lane) {
    const int r32 = lane & 31, hi = lane >> 5;
    LAS float* wsf = (LAS float*)(lds + LWS) + wid * 64;
    float lrun = P.l;
    { auto rr = __builtin_amdgcn_permlane32_swap(__float_as_uint(lrun), __float_as_uint(lrun), false, false); lrun = __uint_as_float(rr[0]) + __uint_as_float(rr[1]); }
    if (hi == 0) wsf[32 + r32] = lrun;
    LDS_WAIT();
    LAS bf16* stg = (LAS bf16*)(lds + LOST) + wid * 2048;
#pragma unroll
    for (int r = 0; r < 16; ++r) { const int orow = crow(r, hi); const float rl = __builtin_amdgcn_rcpf(wsf[32 + orow]);
        stg[orow * 64 + r32] = (bf16)(pk2(P.o0[r] * rl, 0.f) & 0xffffu); stg[orow * 64 + 32 + r32] = (bf16)(pk2(P.o1[r] * rl, 0.f) & 0xffffu); }
    LDS_WAIT();
    bf16* Ow = O + (size_t)(P.qrow0 + wid * 32) * 1024 + P.oc0;
#pragma unroll
    for (int i = 0; i < 4; ++i) { const int row = i * 8 + (lane >> 3), ch = lane & 7; const v4u v = *(const LAS v4u*)(stg + row * 64 + ch * 8); *(v4u*)(Ow + (size_t)row * 1024 + ch * 8) = v; }
    LDS_WAIT();
}
template <int DK>
__device__ __forceinline__ void unit(const Tens& T, int qrow0, int qc0, int kc0, int vc0, int oc0, int kctx0, int klat0, int NTL, LAS unsigned char* lds, int wave_id, Pend& pend) {
    constexpr int ND = DK / 16;
    wave_id = launder_s(wave_id); const int tid = lthread_w(wave_id), lane = tid & 63, r32 = lane & 31, hi = lane >> 5; const int wid = wave_id;
    LAS float* wsf = (LAS float*)(lds + LWS) + wid * 64;
    const bf16* ksrc = T.K + (size_t)lane * T.kpitch + kc0 + wid * 8;
    const int k2off = (8 + (wid & 3) - wid) * 8;
    const bf16* vsrc = T.V + (size_t)(16 * (wid & 3) + (lane >> 2)) * T.vpitch + vc0 + (wid >> 2) * 32 + (lane & 3) * 8;
#define ATT_DMA(t, ks_, vs_) do { const size_t row0_ = (size_t)((t) < 4 ? kctx0 + 64 * (t) : klat0 + 64 * ((t) - 4)); \
        __builtin_amdgcn_global_load_lds((const unsigned*)(ksrc + row0_ * T.kpitch), (LAS unsigned*)(lds + LK + (ks_) * 12288 + wid * 1024), 16, 0, 0); \
        if (DK > 64) __builtin_amdgcn_global_load_lds((const unsigned*)(ksrc + row0_ * T.kpitch + k2off), (LAS unsigned*)(lds + LK + (ks_) * 12288 + 8192 + (wid & 3) * 1024), 16, 0, 0); \
        __builtin_amdgcn_global_load_lds((const unsigned*)(vsrc + row0_ * T.vpitch), (LAS unsigned*)(lds + LV + (vs_) * 8192 + wid * 1024), 16, 0, 0); } while (0)
#define ATT_WAIT_TILES(n_tiles) do { if (DK > 64) { if ((n_tiles) >= 2) ATT_WAITV(6); else if ((n_tiles) == 1) ATT_WAITV(3); else ATT_WAITV(0); } \
        else { if ((n_tiles) >= 2) ATT_WAITV(4); else if ((n_tiles) == 1) ATT_WAITV(2); else ATT_WAITV(0); } } while (0)
    bf16x8 qr[ND];
    { const bf16* qp = T.Q + (size_t)(qrow0 + wid * 32 + r32) * T.qpitch + qc0 + hi * 8;
#pragma unroll
      for (int d0 = 0; d0 < ND; ++d0) qr[d0] = *(const bf16x8*)(qp + d0 * 16); }
    asm volatile("" ::: "memory");
    constexpr float THR = 8.f;
    const int half = wid >> 2;
    float mhat = 0.f, lrun = 0.f; f32x16 o[2]; o[0] = f32x16{}; o[1] = f32x16{}; f32x16 negm = f32x16{};
    f32x16 p0 = f32x16{}, p1 = f32x16{}; v4u pw[4]; pw[0] = pw[1] = pw[2] = pw[3] = (v4u){0u, 0u, 0u, 0u};
    ATT_DMA(0, 0, 0); ATT_DMA(1, 1, 1); ATT_DMA(2, 2, 2);
    if (pend.valid) finish_unit(pend, T.O, lds, wid, lane);
    ATT_WAIT_TILES(2);
    __builtin_amdgcn_s_barrier(); asm volatile("" ::: "memory");
    if (half == 1) __builtin_amdgcn_s_barrier();
    int vs_prev = 0, vs_cur = 0, vs_iss = 3;
    for (int t = 0; t <= NTL; ++t) {
        if (t >= 1) {
            s16x4 lo[2][4], hh[2][4];
            const unsigned vb = (unsigned)(uintptr_t)(lds + LV + vs_prev * 8192) + ((lane >> 4) & 1) * 32 + (lane & 3) * 8 + (4 * hi + ((lane & 15) >> 2)) * 64;
#pragma unroll
            for (int d0 = 0; d0 < 2; ++d0)
#pragma unroll
                for (int ks = 0; ks < 4; ++ks) {
                    asm volatile("ds_read_b64_tr_b16 %0,%1 offset:%c2" : "=&v"(lo[d0][ks]) : "v"(vb), "i"(d0 * 4096 + ks * 1024) : "memory");
                    asm volatile("ds_read_b64_tr_b16 %0,%1 offset:%c2" : "=&v"(hh[d0][ks]) : "v"(vb), "i"(d0 * 4096 + ks * 1024 + 512) : "memory"); }
            asm volatile("s_waitcnt lgkmcnt(0)" ::: "memory"); __builtin_amdgcn_sched_barrier(0);
#pragma unroll
            for (int ks = 0; ks < 4; ++ks)
#pragma unroll
                for (int d0 = 0; d0 < 2; ++d0) { const bf16x8 vf = (bf16x8){lo[d0][ks][0], lo[d0][ks][1], lo[d0][ks][2], lo[d0][ks][3], hh[d0][ks][0], hh[d0][ks][1], hh[d0][ks][2], hh[d0][ks][3]};
                    o[d0] = __builtin_amdgcn_mfma_f32_32x32x16_bf16(__builtin_bit_cast(bf16x8, pw[ks]), vf, o[d0], 0, 0, 0); }
        }
        if (t < NTL) {
            bf16x8 kf[2 * ND];
            const lds_cptr kb = (lds_cptr)(lds + LK + (t & 3) * 12288) + hi * 1024 + r32 * 16;
#pragma unroll
            for (int d0 = 0; d0 < ND; ++d0) { kf[2 * d0] = *(const LAS bf16x8*)(kb + d0 * 2048); kf[2 * d0 + 1] = *(const LAS bf16x8*)(kb + d0 * 2048 + 512); }
            asm volatile("s_waitcnt lgkmcnt(0)" ::: "memory"); __builtin_amdgcn_sched_barrier(0);
#pragma unroll
            for (int d0 = 0; d0 < ND; ++d0) {
                if (d0 == 0) { p0 = __builtin_amdgcn_mfma_f32_32x32x16_bf16(kf[0], qr[0], negm, 0, 0, 0); p1 = __builtin_amdgcn_mfma_f32_32x32x16_bf16(kf[1], qr[0], negm, 0, 0, 0); }
                else { p0 = __builtin_amdgcn_mfma_f32_32x32x16_bf16(kf[2 * d0], qr[d0], p0, 0, 0, 0); p1 = __builtin_amdgcn_mfma_f32_32x32x16_bf16(kf[2 * d0 + 1], qr[d0], p1, 0, 0, 0); } }
        }
        if (half == 1) {
            const int last_iss = (t + PD - 1 < NTL - 1) ? t + PD - 1 : NTL - 1; const int allow = last_iss - (t + 1);
            if (allow >= 1) ATT_WAIT_TILES(1); else ATT_WAIT_TILES(0); }
        asm volatile("s_waitcnt lgkmcnt(0)" ::: "memory"); __builtin_amdgcn_s_barrier(); asm volatile("" ::: "memory");
        if (t < NTL) {
            float rm = max3f(p0[0], p0[1], p1[0]);
#pragma unroll
            for (int r = 0; r < 16; ++r) rm = max3f(rm, p0[r], p1[r]);
            { auto rr = __builtin_amdgcn_permlane32_swap(__float_as_uint(rm), __float_as_uint(rm), false, false); rm = fmaxf(__uint_as_float(rr[0]), __uint_as_float(rr[1])); }
            if (t == 0 || __any(rm > THR)) {
                const float dl = (t == 0) ? rm : fmaxf(rm, 0.f);
                mhat += dl;
#pragma unroll
                for (int r = 0; r < 16; ++r) { p0[r] -= dl; p1[r] -= dl; negm[r] = -mhat; }
                const float f = (t == 0) ? 1.f : __builtin_amdgcn_exp2f(-dl); lrun *= f;
                if (hi == 0) wsf[r32] = f;
                LDS_WAIT();
#pragma unroll
                for (int r = 0; r < 16; ++r) { const float a = wsf[crow(r, hi)]; o[0][r] *= a; o[1][r] *= a; }
            }
            float rs = 0.f;
#pragma unroll
            for (int r = 0; r < 16; ++r) { p0[r] = __builtin_amdgcn_exp2f(p0[r]); p1[r] = __builtin_amdgcn_exp2f(p1[r]); rs += p0[r] + p1[r]; }
            lrun += rs;
            pw[0] = (v4u){pk2(p0[0], p0[1]), pk2(p0[2], p0[3]), pk2(p0[4], p0[5]), pk2(p0[6], p0[7])};
            pw[1] = (v4u){pk2(p0[8], p0[9]), pk2(p0[10], p0[11]), pk2(p0[12], p0[13]), pk2(p0[14], p0[15])};
            pw[2] = (v4u){pk2(p1[0], p1[1]), pk2(p1[2], p1[3]), pk2(p1[4], p1[5]), pk2(p1[6], p1[7])};
            pw[3] = (v4u){pk2(p1[8], p1[9]), pk2(p1[10], p1[11]), pk2(p1[12], p1[13]), pk2(p1[14], p1[15])};
        }
        if (t + PD < NTL) { ATT_DMA(t + PD, (t + PD) & 3, vs_iss); vs_iss = (vs_iss == 4) ? 0 : vs_iss + 1; }
        if (half == 0) {
            const int last_iss = (t + PD < NTL - 1) ? t + PD : NTL - 1; const int allow = last_iss - (t + 1);
            if (allow >= 2) ATT_WAIT_TILES(2); else if (allow == 1) ATT_WAIT_TILES(1); else ATT_WAIT_TILES(0); }
        vs_prev = vs_cur; vs_cur = (vs_cur == 4) ? 0 : vs_cur + 1;
        asm volatile("s_waitcnt lgkmcnt(0)" ::: "memory"); __builtin_amdgcn_s_barrier(); asm volatile("" ::: "memory");
    }
    if (half == 0) __builtin_amdgcn_s_barrier();
#undef ATT_DMA
#undef ATT_WAIT_TILES
    pend.o0 = o[0]; pend.o1 = o[1]; pend.l = lrun; pend.qrow0 = qrow0; pend.oc0 = oc0; pend.valid = true;
}
#undef ATT_WAITV
}

namespace att64 {
typedef unsigned short bf16;
using bf16x8=__attribute__((ext_vector_type(8)))short;
using s16x4=__attribute__((ext_vector_type(4)))short;
using f32x16=__attribute__((ext_vector_type(16)))float;
using u32x4=__attribute__((ext_vector_type(4)))unsigned;
constexpr int D=64;
constexpr int NW=8,QBLK=32,QB=QBLK*NW,KVBLK=64;
__device__ __forceinline__ int crow(int r,int hi){return (r&3)+8*(r>>2)+4*hi;}
#define SBAR() __builtin_amdgcn_sched_barrier(0)
constexpr int NSLOT=3, SLOTB=8192;
constexpr int LDS_K=0, LDS_V=NSLOT*SLOTB, LDS_WS=2*NSLOT*SLOTB, LDS_OST=LDS_WS+NW*64*4, LDS_BYTES=LDS_OST+NW*4096;
constexpr float C2=0.125f*1.4426950408889634f;
__device__ __forceinline__ void glds16(const void*gsrc,unsigned lds_dst){unsigned keep;
  asm volatile("s_mov_b32 %0, m0\n\ts_mov_b32 m0, %2\n\ts_nop 0\n\tglobal_load_lds_dwordx4 %1, off\n\ts_mov_b32 m0, %0":"=&s"(keep):"v"(gsrc),"s"(lds_dst):"memory");}
__device__ __forceinline__ float max3f(float a,float b,float c){float r;asm("v_max3_f32 %0, %1, %2, %3":"=v"(r):"v"(a),"v"(b),"v"(c));return r;}
__device__ __forceinline__ float max2f(float a,float b){float r;asm("v_max_f32_e32 %0, %1, %2":"=v"(r):"v"(a),"v"(b));return r;}
__device__ __forceinline__ float fadd_s(float a,float b){float r;asm("v_add_f32_e32 %0, %1, %2":"=v"(r):"v"(a),"v"(b));return r;}
__device__ __forceinline__ float fsub_s(float a,float b){float r;asm("v_sub_f32_e32 %0, %1, %2":"=v"(r):"v"(a),"v"(b));return r;}
typedef float f32x2_t __attribute__((ext_vector_type(2))); typedef __bf16 bf16x2_t __attribute__((ext_vector_type(2)));
__device__ __forceinline__ unsigned cvtpk_s(float lo,float hi){f32x2_t v={lo,hi};bf16x2_t b=__builtin_convertvector(v,bf16x2_t);return __builtin_bit_cast(unsigned,b);}
#define WAIT_BAR(N) asm volatile("s_waitcnt vmcnt(" #N ") lgkmcnt(0)\n\ts_barrier":::"memory")

__device__ __forceinline__ void qkt(f32x16&p0,f32x16&p1,const char*Kslot,const bf16x8*qr,const f32x16&negm,int r32,int hi){
  const char*kb=Kslot+hi*1024+r32*16;
  #pragma unroll
  for(int d0=0;d0<4;++d0){
    const bf16x8 b0=*reinterpret_cast<const bf16x8*>(kb+d0*2048);
    const bf16x8 b1=*reinterpret_cast<const bf16x8*>(kb+d0*2048+512);
    if(d0==0){p0=__builtin_amdgcn_mfma_f32_32x32x16_bf16(b0,qr[0],negm,0,0,0);p1=__builtin_amdgcn_mfma_f32_32x32x16_bf16(b1,qr[0],negm,0,0,0);}
    else{p0=__builtin_amdgcn_mfma_f32_32x32x16_bf16(b0,qr[d0],p0,0,0,0);p1=__builtin_amdgcn_mfma_f32_32x32x16_bf16(b1,qr[d0],p1,0,0,0);}}
}
typedef __attribute__((address_space(3))) const char* lds_cptr;
typedef short v4i16_t __attribute__((ext_vector_type(4)));
__device__ __forceinline__ void kload8(bf16x8*kf,lds_cptr kp){
  kf[0]=*(const __attribute__((address_space(3))) bf16x8*)(kp);      kf[1]=*(const __attribute__((address_space(3))) bf16x8*)(kp+512);
  kf[2]=*(const __attribute__((address_space(3))) bf16x8*)(kp+2048); kf[3]=*(const __attribute__((address_space(3))) bf16x8*)(kp+2560);
  kf[4]=*(const __attribute__((address_space(3))) bf16x8*)(kp+4096); kf[5]=*(const __attribute__((address_space(3))) bf16x8*)(kp+4608);
  kf[6]=*(const __attribute__((address_space(3))) bf16x8*)(kp+6144); kf[7]=*(const __attribute__((address_space(3))) bf16x8*)(kp+6656);
}
__device__ __forceinline__ void kload2(bf16x8*kf,lds_cptr kp,int j){ kf[2*j]=*(const __attribute__((address_space(3))) bf16x8*)(kp+j*2048); kf[2*j+1]=*(const __attribute__((address_space(3))) bf16x8*)(kp+j*2048+512); }
__device__ __forceinline__ s16x4 vtr(lds_cptr p){ return __builtin_bit_cast(s16x4,__builtin_amdgcn_ds_read_tr16_b64_v4i16((__attribute__((address_space(3))) v4i16_t*)p)); }
__device__ __forceinline__ float rowmax(const f32x16&p0,const f32x16&p1){
  float a=max3f(p0[0],p0[1],p1[0]),b=max3f(p0[2],p0[3],p1[1]);a=max3f(a,p1[2],p1[3]);
  #pragma unroll
  for(int r=4;r<16;r+=4){a=max3f(a,p0[r],p0[r+1]);b=max3f(b,p0[r+2],p0[r+3]);a=max3f(a,p1[r],p1[r+1]);b=max3f(b,p1[r+2],p1[r+3]);}
  const float m=max2f(a,b);
  auto rr=__builtin_amdgcn_permlane32_swap(__float_as_uint(m),__float_as_uint(m),false,false);
  return max2f(__uint_as_float(rr[0]),__uint_as_float(rr[1]));
}
__device__ __forceinline__ void pv(f32x16*o,int vb,bf16x8 pa0,bf16x8 pa1,bf16x8 pa2,bf16x8 pa3){
  #pragma unroll
  for(int d0=0;d0<2;++d0){s16x4 lo[4],hi[4];
    #pragma unroll
    for(int ks=0;ks<4;++ks){
      asm volatile("ds_read_b64_tr_b16 %0,%1 offset:%c2":"=&v"(lo[ks]):"v"(vb),"i"(d0*4096+ks*1024):"memory");
      asm volatile("ds_read_b64_tr_b16 %0,%1 offset:%c2":"=&v"(hi[ks]):"v"(vb),"i"(d0*4096+ks*1024+512):"memory");}
    asm volatile("s_waitcnt lgkmcnt(0)":::"memory");SBAR();
    #define PK(k) (bf16x8){lo[k][0],lo[k][1],lo[k][2],lo[k][3],hi[k][0],hi[k][1],hi[k][2],hi[k][3]}
    o[d0]=__builtin_amdgcn_mfma_f32_32x32x16_bf16(pa0,PK(0),o[d0],0,0,0);
    o[d0]=__builtin_amdgcn_mfma_f32_32x32x16_bf16(pa1,PK(1),o[d0],0,0,0);
    o[d0]=__builtin_amdgcn_mfma_f32_32x32x16_bf16(pa2,PK(2),o[d0],0,0,0);
    o[d0]=__builtin_amdgcn_mfma_f32_32x32x16_bf16(pa3,PK(3),o[d0],0,0,0);
    #undef PK
  }
}

#ifndef ATTN_STORE16
#define ATTN_STORE16(p,v) (*(u32x4*)(p)=(v))
#endif
template<int THRL> __device__ __forceinline__ void attn_unit(const bf16*Q,int qp,int qrow0,int qc0,const bf16*__restrict__ K,int kp,int kc0,const bf16*__restrict__ V,int vp,int vc0,bf16*O,int oc0,int kctx0,int klat0,int NT,char*shm,int wave_id){
  wave_id=launder_s(wave_id); const int lane=lane_id_v(),r32=lane&31,hi=lane>>5; const int wid=wave_id;
  const bf16*Qw=Q+(long)(qrow0+wid*QBLK)*qp+qc0;
  const bf16*Kh=K+kc0,*Vh=V+vc0;
  const unsigned lds0=(unsigned)(uintptr_t)shm;
  float*wsf=(float*)(shm+LDS_WS)+wid*64;
  const bf16*ksrc=Kh+(long)lane*kp+wid*8;
  const bf16*vsrc=Vh+(long)(16*(wid&3)+(lane>>2))*vp+(wid>>2)*32+(lane&3)*8;
  #define TROW0(t) ((long)((t)<4?kctx0+64*(t):klat0+64*((t)-4)))
  const unsigned kdst=lds0+LDS_K+wid*1024, vdst=lds0+LDS_V+wid*1024;
  #define DMA_K(t,slot) glds16(ksrc+TROW0(t)*kp,(unsigned)__builtin_amdgcn_readfirstlane(kdst+(slot)))
  #define DMA_V(t,slot) glds16(vsrc+TROW0(t)*vp,(unsigned)__builtin_amdgcn_readfirstlane(vdst+(slot)))
  const int vb0=(int)(lds0+LDS_V)+((lane>>4)&1)*32+(lane&3)*8+(4*hi+((lane&15)>>2))*64;
  const char*Kbase=shm+LDS_K; bf16x8 kf[8];
  const lds_cptr shm3=(lds_cptr)shm; const lds_cptr kp0=shm3+LDS_K+hi*1024+r32*16; const lds_cptr vp0=shm3+LDS_V+((lane>>4)&1)*32+(lane&3)*8+(4*hi+((lane&15)>>2))*64;
  DMA_K(0,0);DMA_V(0,0);DMA_K(1,SLOTB);
  bf16x8 qr[4];
  #pragma unroll
  for(int d0=0;d0<4;++d0)qr[d0]=*reinterpret_cast<const bf16x8*>(&Qw[(long)r32*qp+d0*16+hi*8]);
  float mhat=0.f,l_reg=0.f;f32x16 o[2];o[0]=f32x16{};o[1]=f32x16{};f32x16 negm=f32x16{};asm volatile("":"+v"(negm));
  #define CMASK(P0,P1,t) do{}while(0)
  bool resc=false;
  #define START(P0,P1) do{ const float rm=rowmax(P0,P1); resc=false; \
    { const float dl=rm; mhat=fadd_s(mhat,dl); \
      _Pragma("unroll") for(int r=0;r<16;++r){P0[r]=fsub_s(P0[r],dl);P1[r]=fsub_s(P1[r],dl);} \
      _Pragma("unroll") for(int r=0;r<16;++r)negm[r]=-mhat; asm volatile("":"+v"(negm)); } \
    _Pragma("unroll") for(int r=0;r<16;++r)P0[r]=__builtin_amdgcn_exp2f(P0[r]); }while(0)
  #define RESC() do{ if(resc){ asm volatile("s_waitcnt lgkmcnt(0)":::"memory"); \
      _Pragma("unroll") for(int d_=0;d_<2;++d_) _Pragma("unroll") for(int r=0;r<16;++r)o[d_][r]*=wsf[crow(r,hi)]; } }while(0)
  f32x16 pA0,pA1,pB0,pB1;
  int sl_prev=0,sl_cur=0,sl_next=SLOTB;
  #define ROT() do{sl_prev=sl_cur;sl_cur=sl_next;sl_next=(sl_next==(NSLOT-1)*SLOTB)?0:sl_next+SLOTB;}while(0)
  DMA_K(2,2*SLOTB);
  WAIT_BAR(3);
  qkt(pA0,pA1,Kbase,qr,negm,r32,hi);asm volatile("s_nop 15\n\ts_nop 7":"+v"(pA0),"+v"(pA1));CMASK(pA0,pA1,0);
  START(pA0,pA1);
  _Pragma("unroll") for(int r=0;r<16;++r)pA1[r]=__builtin_amdgcn_exp2f(pA1[r]);
  WAIT_BAR(0);
  DMA_K(3,0);DMA_V(1,SLOTB);
  ROT();
  kload8(kf,kp0+sl_cur);
  WAIT_BAR(2);
  s16x4 vlo[8],vhi[8]; u32x4 pw0,pw1,pw2,pw3;
  #define PKW(P,B) cvtpk_s(P[B],P[B+1])
  #define PAF(k) __builtin_bit_cast(bf16x8,pw##k)
  #define VFR(i) (bf16x8){vlo[i][0],vlo[i][1],vlo[i][2],vlo[i][3],vhi[i][0],vhi[i][1],vhi[i][2],vhi[i][3]}
  #define PIN(x) asm volatile("":"+v"(x))
  #define MX3(a,b,c) __builtin_fmaxf(__builtin_fmaxf((a),(b)),(c))
  #define GAPA(MF,A0,A1,A2,A3,W0,W1,PW) do{ MF; sacc+=A0; sacc+=A1; sacc+=A2; sacc+=A3; PIN(sacc); W0; W1; PIN(PW); SBAR(); }while(0)
  #define EX(v) __builtin_amdgcn_exp2f(v)
  #define GAPB(MF,X,B) do{ MF; X[B]=EX(X[B]); X[B+1]=EX(X[B+1]); X[B+2]=EX(X[B+2]); X[B+3]=EX(X[B+3]); PIN(X); SBAR(); }while(0)
  #define VRD(i) do{ vlo[i]=vtr(vp_+(((i)>>2)*4096+((i)&3)*1024)); vhi[i]=vtr(vp_+(((i)>>2)*4096+((i)&3)*1024+512)); }while(0)
  #define KRD(G,j) do{ if(G){ kload2(kf,kp0+sl_next,j); SBAR(); } }while(0)
  #define STEP(C0,C1,P0,P1,t,GK,GV,GL) do{ SBAR(); \
    const lds_cptr vp_=vp0+sl_prev; \
    VRD(0); SBAR(); float sacc=(P0[0]+P0[1]); \
    GAPA(C0=__builtin_amdgcn_mfma_f32_32x32x16_bf16(kf[0],qr[0],negm,0,0,0), P0[2],P0[3],P0[4],P0[5],     pw0[0]=PKW(P0,0), pw0[1]=PKW(P0,2), pw0); \
    VRD(4); SBAR(); GAPA(C1=__builtin_amdgcn_mfma_f32_32x32x16_bf16(kf[1],qr[0],negm,0,0,0), P0[6],P0[7],P0[8],P0[9],     pw0[2]=PKW(P0,4), pw0[3]=PKW(P0,6), pw0); \
    VRD(1); SBAR(); GAPA(C0=__builtin_amdgcn_mfma_f32_32x32x16_bf16(kf[2],qr[1],C0,0,0,0),   P0[10],P0[11],P0[12],P0[13], pw1[0]=PKW(P0,8), pw1[1]=PKW(P0,10), pw1); \
    VRD(5); SBAR(); GAPA(C1=__builtin_amdgcn_mfma_f32_32x32x16_bf16(kf[3],qr[1],C1,0,0,0),   P0[14],P0[15],P1[0],P1[1],   pw1[2]=PKW(P0,12),pw1[3]=PKW(P0,14), pw1); \
    VRD(2); SBAR(); GAPA(C0=__builtin_amdgcn_mfma_f32_32x32x16_bf16(kf[4],qr[2],C0,0,0,0),   P1[2],P1[3],P1[4],P1[5],     pw2[0]=PKW(P1,0), pw2[1]=PKW(P1,2), pw2); \
    VRD(6); SBAR(); GAPA(C1=__builtin_amdgcn_mfma_f32_32x32x16_bf16(kf[5],qr[2],C1,0,0,0),   P1[6],P1[7],P1[8],P1[9],     pw2[2]=PKW(P1,4), pw2[3]=PKW(P1,6), pw2); \
    VRD(3); SBAR(); GAPA(C0=__builtin_amdgcn_mfma_f32_32x32x16_bf16(kf[6],qr[3],C0,0,0,0),   P1[10],P1[11],P1[12],P1[13], pw3[0]=PKW(P1,8), pw3[1]=PKW(P1,10), pw3); \
    VRD(7); SBAR(); GAPA(C1=__builtin_amdgcn_mfma_f32_32x32x16_bf16(kf[7],qr[3],C1,0,0,0),   P1[14],P1[15],0.f,0.f,       pw3[2]=PKW(P1,12),pw3[3]=PKW(P1,14), pw3); \
    l_reg+=sacc; \
    if(GK){DMA_K((t)+3,sl_cur);} if(GV){DMA_V((t)+1,sl_next);} \
    CMASK(C0,C1,t); \
    { float a=MX3(C0[0],C0[1],C1[0]),b=MX3(C0[2],C0[3],C1[1]); a=MX3(a,C1[2],C1[3]); \
      _Pragma("unroll") for(int r=4;r<16;r+=4){a=MX3(a,C0[r],C0[r+1]);b=MX3(b,C0[r+2],C0[r+3]);a=MX3(a,C1[r],C1[r+1]);b=MX3(b,C1[r+2],C1[r+3]);} \
      float rm=__builtin_fmaxf(a,b); { auto rr=__builtin_amdgcn_permlane32_swap(__float_as_uint(rm),__float_as_uint(rm),false,false); rm=__builtin_fmaxf(__uint_as_float(rr[0]),__uint_as_float(rr[1])); } \
      resc=false; \
      if(__builtin_expect(__any(rm>(float)THRL),0)){ const float dl=__builtin_fmaxf(rm,0.f); mhat+=dl; \
        _Pragma("unroll") for(int r=0;r<16;++r){C0[r]-=dl;C1[r]-=dl;} \
        _Pragma("unroll") for(int r=0;r<16;++r)negm[r]=-mhat; asm volatile("":"+v"(negm)); \
        const float f=__builtin_amdgcn_exp2f(-dl); l_reg*=f; if(hi==0)wsf[r32]=f; resc=true; } } \
    SBAR(); \
    GAPB(o[0]=__builtin_amdgcn_mfma_f32_32x32x16_bf16(PAF(0),VFR(0),o[0],0,0,0), C0,0); \
    GAPB(o[1]=__builtin_amdgcn_mfma_f32_32x32x16_bf16(PAF(0),VFR(4),o[1],0,0,0), C0,4); \
    KRD(GL,0); GAPB(o[0]=__builtin_amdgcn_mfma_f32_32x32x16_bf16(PAF(1),VFR(1),o[0],0,0,0), C0,8); \
    KRD(GL,1); GAPB(o[1]=__builtin_amdgcn_mfma_f32_32x32x16_bf16(PAF(1),VFR(5),o[1],0,0,0), C0,12); \
    KRD(GL,2); GAPB(o[0]=__builtin_amdgcn_mfma_f32_32x32x16_bf16(PAF(2),VFR(2),o[0],0,0,0), C1,0); \
    KRD(GL,3); GAPB(o[1]=__builtin_amdgcn_mfma_f32_32x32x16_bf16(PAF(2),VFR(6),o[1],0,0,0), C1,4); \
    GAPB(o[0]=__builtin_amdgcn_mfma_f32_32x32x16_bf16(PAF(3),VFR(3),o[0],0,0,0), C1,8); \
    GAPB(o[1]=__builtin_amdgcn_mfma_f32_32x32x16_bf16(PAF(3),VFR(7),o[1],0,0,0), C1,12); \
    }while(0)
  int t=1;
  for(;t+5<NT;t+=2){
    STEP(pB0,pB1,pA0,pA1,t,true,true,true);     WAIT_BAR(2); RESC(); ROT();
    STEP(pA0,pA1,pB0,pB1,t+1,true,true,true);   WAIT_BAR(2); RESC(); ROT();
  }
  #define ENDW(tt) do{ if((tt)+3<NT){WAIT_BAR(2);} else if((tt)+2<NT){WAIT_BAR(1);} else {WAIT_BAR(0);} }while(0)
  for(;t+1<NT;t+=2){
    STEP(pB0,pB1,pA0,pA1,t,(t+3<NT),(t+1<NT),(t+1<NT));       ENDW(t);   RESC(); ROT();
    STEP(pA0,pA1,pB0,pB1,t+1,(t+4<NT),(t+2<NT),(t+2<NT));     ENDW(t+1); RESC(); ROT();
  }
  STEP(pB0,pB1,pA0,pA1,NT-1,false,false,false); RESC();
  { float sacc=pB0[0]+pB0[1]; _Pragma("unroll") for(int r=2;r<16;++r)sacc+=pB0[r]; _Pragma("unroll") for(int r=0;r<16;++r)sacc+=pB1[r]; l_reg+=sacc;
    pw0=(u32x4){PKW(pB0,0),PKW(pB0,2),PKW(pB0,4),PKW(pB0,6)};pw1=(u32x4){PKW(pB0,8),PKW(pB0,10),PKW(pB0,12),PKW(pB0,14)};pw2=(u32x4){PKW(pB1,0),PKW(pB1,2),PKW(pB1,4),PKW(pB1,6)};pw3=(u32x4){PKW(pB1,8),PKW(pB1,10),PKW(pB1,12),PKW(pB1,14)};
    SBAR(); pv(o,vb0+sl_cur,PAF(0),PAF(1),PAF(2),PAF(3)); }
  #undef PKW
  #undef PAF
  #undef VFR
  #undef PIN
  #undef MX3
  #undef GAPA
  #undef GAPB
  #undef EX
  #undef VRD
  #undef KRD
  #undef STEP
  #undef ENDW
  {auto rr=__builtin_amdgcn_permlane32_swap(__float_as_uint(l_reg),__float_as_uint(l_reg),false,false);l_reg=__uint_as_float(rr[0])+__uint_as_float(rr[1]);}
  if(hi==0)wsf[32+r32]=l_reg;asm volatile("s_waitcnt lgkmcnt(0)":::"memory");
  float rli[16];
  #pragma unroll
  for(int r=0;r<16;++r)rli[r]=__builtin_amdgcn_rcpf(wsf[32+crow(r,hi)]);
  bf16*Ow=O+(long)(qrow0+wid*QBLK)*1024+oc0;
  { bf16*stg=(bf16*)(shm+LDS_OST)+wid*2048;
    #pragma unroll
    for(int r=0;r<16;++r){const int orow=crow(r,hi);
      #pragma unroll
      for(int d0=0;d0<2;++d0)stg[orow*64+d0*32+r32]=(bf16)(cvtpk_s(o[d0][r]*rli[r],0.f)&0xffffu);}
    asm volatile("s_waitcnt lgkmcnt(0)":::"memory");
    #pragma unroll
    for(int i=0;i<4;++i){const int row=i*8+(lane>>3),ch=lane&7; const u32x4 v=*(const u32x4*)(stg+row*64+ch*8); ATTN_STORE16(Ow+(long)row*1024+ch*8,v);} }
  asm volatile("s_waitcnt lgkmcnt(0)\n\ts_barrier":::"memory");
  #undef DMA_K
  #undef DMA_V
  #undef TROW0
  #undef CMASK
  #undef START
  #undef RESC
  #undef ROT
}
#undef SBAR
#undef WAIT_BAR
}

namespace att96 {
typedef unsigned short bf16;
using bf16x8=__attribute__((ext_vector_type(8)))short;
using s16x4=__attribute__((ext_vector_type(4)))short;
using f32x16=__attribute__((ext_vector_type(16)))float;
using u32x4=__attribute__((ext_vector_type(4)))unsigned;
constexpr int D=64;
constexpr int NW=8,QBLK=32,QB=QBLK*NW,KVBLK=64;
__device__ __forceinline__ int crow(int r,int hi){return (r&3)+8*(r>>2)+4*hi;}
#define SBAR() __builtin_amdgcn_sched_barrier(0)
constexpr int NSLOT=3, SLOTB=8192, KSLOTB=12288;
#define KOFF(sl) ((sl)+((sl)>>1))
constexpr int LDS_K=0, LDS_V=NSLOT*KSLOTB, LDS_WS=LDS_V+NSLOT*SLOTB, LDS_OST=LDS_WS+NW*64*4, LDS_BYTES=LDS_OST+NW*4096;
constexpr float C2=0.125f*1.4426950408889634f;
__device__ __forceinline__ void glds16(const void*gsrc,unsigned lds_dst){unsigned keep;
  asm volatile("s_mov_b32 %0, m0\n\ts_mov_b32 m0, %2\n\ts_nop 0\n\tglobal_load_lds_dwordx4 %1, off\n\ts_mov_b32 m0, %0":"=&s"(keep):"v"(gsrc),"s"(lds_dst):"memory");}
__device__ __forceinline__ float max3f(float a,float b,float c){float r;asm("v_max3_f32 %0, %1, %2, %3":"=v"(r):"v"(a),"v"(b),"v"(c));return r;}
__device__ __forceinline__ float max2f(float a,float b){float r;asm("v_max_f32_e32 %0, %1, %2":"=v"(r):"v"(a),"v"(b));return r;}
__device__ __forceinline__ float fadd_s(float a,float b){float r;asm("v_add_f32_e32 %0, %1, %2":"=v"(r):"v"(a),"v"(b));return r;}
__device__ __forceinline__ float fsub_s(float a,float b){float r;asm("v_sub_f32_e32 %0, %1, %2":"=v"(r):"v"(a),"v"(b));return r;}
typedef float f32x2_t __attribute__((ext_vector_type(2))); typedef __bf16 bf16x2_t __attribute__((ext_vector_type(2)));
__device__ __forceinline__ unsigned cvtpk_s(float lo,float hi){f32x2_t v={lo,hi};bf16x2_t b=__builtin_convertvector(v,bf16x2_t);return __builtin_bit_cast(unsigned,b);}
#define WAIT_BAR(N) asm volatile("s_waitcnt vmcnt(" #N ") lgkmcnt(0)\n\ts_barrier":::"memory")

__device__ __forceinline__ void qkt(f32x16&p0,f32x16&p1,const char*Kslot,const bf16x8*qr,const f32x16&negm,int r32,int hi){
  const char*kb=Kslot+hi*1024+r32*16;
  #pragma unroll
  for(int d0=0;d0<6;++d0){
    const bf16x8 b0=*reinterpret_cast<const bf16x8*>(kb+d0*2048);
    const bf16x8 b1=*reinterpret_cast<const bf16x8*>(kb+d0*2048+512);
    if(d0==0){p0=__builtin_amdgcn_mfma_f32_32x32x16_bf16(b0,qr[0],negm,0,0,0);p1=__builtin_amdgcn_mfma_f32_32x32x16_bf16(b1,qr[0],negm,0,0,0);}
    else{p0=__builtin_amdgcn_mfma_f32_32x32x16_bf16(b0,qr[d0],p0,0,0,0);p1=__builtin_amdgcn_mfma_f32_32x32x16_bf16(b1,qr[d0],p1,0,0,0);}}
}
typedef __attribute__((address_space(3))) const char* lds_cptr;
typedef short v4i16_t __attribute__((ext_vector_type(4)));
__device__ __forceinline__ void kload8(bf16x8*kf,lds_cptr kp){
  kf[0]=*(const __attribute__((address_space(3))) bf16x8*)(kp);      kf[1]=*(const __attribute__((address_space(3))) bf16x8*)(kp+512);
  kf[2]=*(const __attribute__((address_space(3))) bf16x8*)(kp+2048); kf[3]=*(const __attribute__((address_space(3))) bf16x8*)(kp+2560);
  kf[4]=*(const __attribute__((address_space(3))) bf16x8*)(kp+4096); kf[5]=*(const __attribute__((address_space(3))) bf16x8*)(kp+4608);
  kf[6]=*(const __attribute__((address_space(3))) bf16x8*)(kp+6144); kf[7]=*(const __attribute__((address_space(3))) bf16x8*)(kp+6656);
  kf[8]=*(const __attribute__((address_space(3))) bf16x8*)(kp+8192); kf[9]=*(const __attribute__((address_space(3))) bf16x8*)(kp+8704);
  kf[10]=*(const __attribute__((address_space(3))) bf16x8*)(kp+10240); kf[11]=*(const __attribute__((address_space(3))) bf16x8*)(kp+10752);
}
__device__ __forceinline__ void kload2(bf16x8*kf,lds_cptr kp,int j){ kf[2*j]=*(const __attribute__((address_space(3))) bf16x8*)(kp+j*2048); kf[2*j+1]=*(const __attribute__((address_space(3))) bf16x8*)(kp+j*2048+512); }
__device__ __forceinline__ s16x4 vtr(lds_cptr p){ return __builtin_bit_cast(s16x4,__builtin_amdgcn_ds_read_tr16_b64_v4i16((__attribute__((address_space(3))) v4i16_t*)p)); }
__device__ __forceinline__ float rowmax(const f32x16&p0,const f32x16&p1){
  float a=max3f(p0[0],p0[1],p1[0]),b=max3f(p0[2],p0[3],p1[1]);a=max3f(a,p1[2],p1[3]);
  #pragma unroll
  for(int r=4;r<16;r+=4){a=max3f(a,p0[r],p0[r+1]);b=max3f(b,p0[r+2],p0[r+3]);a=max3f(a,p1[r],p1[r+1]);b=max3f(b,p1[r+2],p1[r+3]);}
  const float m=max2f(a,b);
  auto rr=__builtin_amdgcn_permlane32_swap(__float_as_uint(m),__float_as_uint(m),false,false);
  return max2f(__uint_as_float(rr[0]),__uint_as_float(rr[1]));
}
__device__ __forceinline__ void pv(f32x16*o,int vb,bf16x8 pa0,bf16x8 pa1,bf16x8 pa2,bf16x8 pa3){
  #pragma unroll
  for(int d0=0;d0<2;++d0){s16x4 lo[4],hi[4];
    #pragma unroll
    for(int ks=0;ks<4;++ks){
      asm volatile("ds_read_b64_tr_b16 %0,%1 offset:%c2":"=&v"(lo[ks]):"v"(vb),"i"(d0*4096+ks*1024):"memory");
      asm volatile("ds_read_b64_tr_b16 %0,%1 offset:%c2":"=&v"(hi[ks]):"v"(vb),"i"(d0*4096+ks*1024+512):"memory");}
    asm volatile("s_waitcnt lgkmcnt(0)":::"memory");SBAR();
    #define PK(k) (bf16x8){lo[k][0],lo[k][1],lo[k][2],lo[k][3],hi[k][0],hi[k][1],hi[k][2],hi[k][3]}
    o[d0]=__builtin_amdgcn_mfma_f32_32x32x16_bf16(pa0,PK(0),o[d0],0,0,0);
    o[d0]=__builtin_amdgcn_mfma_f32_32x32x16_bf16(pa1,PK(1),o[d0],0,0,0);
    o[d0]=__builtin_amdgcn_mfma_f32_32x32x16_bf16(pa2,PK(2),o[d0],0,0,0);
    o[d0]=__builtin_amdgcn_mfma_f32_32x32x16_bf16(pa3,PK(3),o[d0],0,0,0);
    #undef PK
  }
}

#ifndef ATTN_STORE16
#define ATTN_STORE16(p,v) (*(u32x4*)(p)=(v))
#endif
template<int THRL> __device__ __forceinline__ void attn_unit(const bf16*Q,int qp,int qrow0,int qc0,const bf16*__restrict__ K,int kp,int kc0,const bf16*__restrict__ V,int vp,int vc0,bf16*O,int oc0,int kctx0,int klat0,int NT,char*shm,int wave_id){
  wave_id=launder_s(wave_id); const int lane=lane_id_v(),r32=lane&31,hi=lane>>5; const int wid=wave_id;
  const bf16*Qw=Q+(long)(qrow0+wid*QBLK)*qp+qc0;
  const bf16*Kh=K+kc0,*Vh=V+vc0;
  const unsigned lds0=(unsigned)(uintptr_t)shm;
  float*wsf=(float*)(shm+LDS_WS)+wid*64;
  const bf16*ksrc=Kh+(long)lane*kp+wid*8;
  const bf16*vsrc=Vh+(long)(16*(wid&3)+(lane>>2))*vp+(wid>>2)*32+(lane&3)*8;
  #define TROW0(t) ((long)((t)<4?kctx0+64*(t):klat0+64*((t)-4)))
  const unsigned kdst=lds0+LDS_K+wid*1024, kdst2=lds0+LDS_K+8192+(wid&3)*1024, vdst=lds0+LDS_V+wid*1024;
  const int k2off=(8+(wid&3)-wid)*8;
  #define DMA_K(t,slot) do{ glds16(ksrc+TROW0(t)*kp,(unsigned)__builtin_amdgcn_readfirstlane(kdst+KOFF(slot))); glds16(ksrc+TROW0(t)*kp+k2off,(unsigned)__builtin_amdgcn_readfirstlane(kdst2+KOFF(slot))); }while(0)
  #define DMA_V(t,slot) glds16(vsrc+TROW0(t)*vp,(unsigned)__builtin_amdgcn_readfirstlane(vdst+(slot)))
  const int vb0=(int)(lds0+LDS_V)+((lane>>4)&1)*32+(lane&3)*8+(4*hi+((lane&15)>>2))*64;
  const char*Kbase=shm+LDS_K; bf16x8 kf[12];
  const lds_cptr shm3=(lds_cptr)shm; const lds_cptr kp0=shm3+LDS_K+hi*1024+r32*16; const lds_cptr vp0=shm3+LDS_V+((lane>>4)&1)*32+(lane&3)*8+(4*hi+((lane&15)>>2))*64;
  DMA_K(0,0);DMA_V(0,0);DMA_K(1,SLOTB);
  bf16x8 qr[6];
  #pragma unroll
  for(int d0=0;d0<6;++d0)qr[d0]=*reinterpret_cast<const bf16x8*>(&Qw[(long)r32*qp+d0*16+hi*8]);
  float mhat=0.f,l_reg=0.f;f32x16 o[2];o[0]=f32x16{};o[1]=f32x16{};f32x16 negm=f32x16{};asm volatile("":"+v"(negm));
  #define CMASK(P0,P1,t) do{}while(0)
  bool resc=false;
  #define START(P0,P1) do{ const float rm=rowmax(P0,P1); resc=false; \
    { const float dl=rm; mhat=fadd_s(mhat,dl); \
      _Pragma("unroll") for(int r=0;r<16;++r){P0[r]=fsub_s(P0[r],dl);P1[r]=fsub_s(P1[r],dl);} \
      _Pragma("unroll") for(int r=0;r<16;++r)negm[r]=-mhat; asm volatile("":"+v"(negm)); } \
    _Pragma("unroll") for(int r=0;r<16;++r)P0[r]=__builtin_amdgcn_exp2f(P0[r]); }while(0)
  #define RESC() do{ if(resc){ asm volatile("s_waitcnt lgkmcnt(0)":::"memory"); \
      _Pragma("unroll") for(int d_=0;d_<2;++d_) _Pragma("unroll") for(int r=0;r<16;++r)o[d_][r]*=wsf[crow(r,hi)]; } }while(0)
  f32x16 pA0,pA1,pB0,pB1;
  int sl_prev=0,sl_cur=0,sl_next=SLOTB;
  #define ROT() do{sl_prev=sl_cur;sl_cur=sl_next;sl_next=(sl_next==(NSLOT-1)*SLOTB)?0:sl_next+SLOTB;}while(0)
  DMA_K(2,2*SLOTB);
  WAIT_BAR(5);
  qkt(pA0,pA1,Kbase,qr,negm,r32,hi);asm volatile("s_nop 15\n\ts_nop 7":"+v"(pA0),"+v"(pA1));CMASK(pA0,pA1,0);
  START(pA0,pA1);
  _Pragma("unroll") for(int r=0;r<16;++r)pA1[r]=__builtin_amdgcn_exp2f(pA1[r]);
  WAIT_BAR(0);
  DMA_K(3,0);DMA_V(1,SLOTB);
  ROT();
  kload8(kf,kp0+KOFF(sl_cur));
  WAIT_BAR(3);
  s16x4 vlo[8],vhi[8]; u32x4 pw0,pw1,pw2,pw3;
  #define PKW(P,B) cvtpk_s(P[B],P[B+1])
  #define PAF(k) __builtin_bit_cast(bf16x8,pw##k)
  #define VFR(i) (bf16x8){vlo[i][0],vlo[i][1],vlo[i][2],vlo[i][3],vhi[i][0],vhi[i][1],vhi[i][2],vhi[i][3]}
  #define PIN(x) asm volatile("":"+v"(x))
  #define MX3(a,b,c) __builtin_fmaxf(__builtin_fmaxf((a),(b)),(c))
  #define GAPA(MF,A0,A1,A2,A3,W0,W1,PW) do{ MF; sacc+=A0; sacc+=A1; sacc+=A2; sacc+=A3; PIN(sacc); W0; W1; PIN(PW); SBAR(); }while(0)
  #define EX(v) __builtin_amdgcn_exp2f(v)
  #define GAPB(MF,X,B) do{ MF; X[B]=EX(X[B]); X[B+1]=EX(X[B+1]); X[B+2]=EX(X[B+2]); X[B+3]=EX(X[B+3]); PIN(X); SBAR(); }while(0)
  #define VRD(i) do{ vlo[i]=vtr(vp_+(((i)>>2)*4096+((i)&3)*1024)); vhi[i]=vtr(vp_+(((i)>>2)*4096+((i)&3)*1024+512)); }while(0)
  #define KRD(G,j) do{ if(G){ kload2(kf,kp0+KOFF(sl_next),j); SBAR(); } }while(0)
  #define STEP(C0,C1,P0,P1,t,GK,GV,GL) do{ SBAR(); \
    const lds_cptr vp_=vp0+sl_prev; \
    VRD(0); SBAR(); float sacc=(P0[0]+P0[1]); \
    GAPA(C0=__builtin_amdgcn_mfma_f32_32x32x16_bf16(kf[0],qr[0],negm,0,0,0), P0[2],P0[3],P0[4],P0[5],     pw0[0]=PKW(P0,0), pw0[1]=PKW(P0,2), pw0); \
    VRD(4); SBAR(); GAPA(C1=__builtin_amdgcn_mfma_f32_32x32x16_bf16(kf[1],qr[0],negm,0,0,0), P0[6],P0[7],P0[8],P0[9],     pw0[2]=PKW(P0,4), pw0[3]=PKW(P0,6), pw0); \
    VRD(1); SBAR(); GAPA(C0=__builtin_amdgcn_mfma_f32_32x32x16_bf16(kf[2],qr[1],C0,0,0,0),   P0[10],P0[11],P0[12],P0[13], pw1[0]=PKW(P0,8), pw1[1]=PKW(P0,10), pw1); \
    VRD(5); SBAR(); GAPA(C1=__builtin_amdgcn_mfma_f32_32x32x16_bf16(kf[3],qr[1],C1,0,0,0),   P0[14],P0[15],P1[0],P1[1],   pw1[2]=PKW(P0,12),pw1[3]=PKW(P0,14), pw1); \
    VRD(2); SBAR(); GAPA(C0=__builtin_amdgcn_mfma_f32_32x32x16_bf16(kf[4],qr[2],C0,0,0,0),   P1[2],P1[3],P1[4],P1[5],     pw2[0]=PKW(P1,0), pw2[1]=PKW(P1,2), pw2); \
    VRD(6); SBAR(); GAPA(C1=__builtin_amdgcn_mfma_f32_32x32x16_bf16(kf[5],qr[2],C1,0,0,0),   P1[6],P1[7],P1[8],P1[9],     pw2[2]=PKW(P1,4), pw2[3]=PKW(P1,6), pw2); \
    VRD(3); SBAR(); GAPA(C0=__builtin_amdgcn_mfma_f32_32x32x16_bf16(kf[6],qr[3],C0,0,0,0),   P1[10],P1[11],P1[12],P1[13], pw3[0]=PKW(P1,8), pw3[1]=PKW(P1,10), pw3); \
    VRD(7); SBAR(); GAPA(C1=__builtin_amdgcn_mfma_f32_32x32x16_bf16(kf[7],qr[3],C1,0,0,0),   P1[14],P1[15],0.f,0.f,       pw3[2]=PKW(P1,12),pw3[3]=PKW(P1,14), pw3); \
    C0=__builtin_amdgcn_mfma_f32_32x32x16_bf16(kf[8],qr[4],C0,0,0,0); C1=__builtin_amdgcn_mfma_f32_32x32x16_bf16(kf[9],qr[4],C1,0,0,0); C0=__builtin_amdgcn_mfma_f32_32x32x16_bf16(kf[10],qr[5],C0,0,0,0); C1=__builtin_amdgcn_mfma_f32_32x32x16_bf16(kf[11],qr[5],C1,0,0,0); SBAR(); \
    l_reg+=sacc; \
    if(GK){DMA_K((t)+3,sl_cur);} if(GV){DMA_V((t)+1,sl_next);} \
    CMASK(C0,C1,t); \
    { float a=MX3(C0[0],C0[1],C1[0]),b=MX3(C0[2],C0[3],C1[1]); a=MX3(a,C1[2],C1[3]); \
      _Pragma("unroll") for(int r=4;r<16;r+=4){a=MX3(a,C0[r],C0[r+1]);b=MX3(b,C0[r+2],C0[r+3]);a=MX3(a,C1[r],C1[r+1]);b=MX3(b,C1[r+2],C1[r+3]);} \
      float rm=__builtin_fmaxf(a,b); { auto rr=__builtin_amdgcn_permlane32_swap(__float_as_uint(rm),__float_as_uint(rm),false,false); rm=__builtin_fmaxf(__uint_as_float(rr[0]),__uint_as_float(rr[1])); } \
      resc=false; \
      if(__builtin_expect(__any(rm>(float)THRL),0)){ const float dl=__builtin_fmaxf(rm,0.f); mhat+=dl; \
        _Pragma("unroll") for(int r=0;r<16;++r){C0[r]-=dl;C1[r]-=dl;} \
        _Pragma("unroll") for(int r=0;r<16;++r)negm[r]=-mhat; asm volatile("":"+v"(negm)); \
        const float f=__builtin_amdgcn_exp2f(-dl); l_reg*=f; if(hi==0)wsf[r32]=f; resc=true; } } \
    SBAR(); \
    GAPB(o[0]=__builtin_amdgcn_mfma_f32_32x32x16_bf16(PAF(0),VFR(0),o[0],0,0,0), C0,0); \
    GAPB(o[1]=__builtin_amdgcn_mfma_f32_32x32x16_bf16(PAF(0),VFR(4),o[1],0,0,0), C0,4); \
    KRD(GL,0); GAPB(o[0]=__builtin_amdgcn_mfma_f32_32x32x16_bf16(PAF(1),VFR(1),o[0],0,0,0), C0,8); \
    KRD(GL,1); GAPB(o[1]=__builtin_amdgcn_mfma_f32_32x32x16_bf16(PAF(1),VFR(5),o[1],0,0,0), C0,12); \
    KRD(GL,2); GAPB(o[0]=__builtin_amdgcn_mfma_f32_32x32x16_bf16(PAF(2),VFR(2),o[0],0,0,0), C1,0); \
    KRD(GL,3); GAPB(o[1]=__builtin_amdgcn_mfma_f32_32x32x16_bf16(PAF(2),VFR(6),o[1],0,0,0), C1,4); \
    KRD(GL,4); GAPB(o[0]=__builtin_amdgcn_mfma_f32_32x32x16_bf16(PAF(3),VFR(3),o[0],0,0,0), C1,8); \
    KRD(GL,5); GAPB(o[1]=__builtin_amdgcn_mfma_f32_32x32x16_bf16(PAF(3),VFR(7),o[1],0,0,0), C1,12); \
    }while(0)
  int t=1;
  for(;t+5<NT;t+=2){
    STEP(pB0,pB1,pA0,pA1,t,true,true,true);     WAIT_BAR(3); RESC(); ROT();
    STEP(pA0,pA1,pB0,pB1,t+1,true,true,true);   WAIT_BAR(3); RESC(); ROT();
  }
  #define ENDW(tt) do{ if((tt)+3<NT){WAIT_BAR(3);} else if((tt)+2<NT){WAIT_BAR(1);} else {WAIT_BAR(0);} }while(0)
  for(;t+1<NT;t+=2){
    STEP(pB0,pB1,pA0,pA1,t,(t+3<NT),(t+1<NT),(t+1<NT));       ENDW(t);   RESC(); ROT();
    STEP(pA0,pA1,pB0,pB1,t+1,(t+4<NT),(t+2<NT),(t+2<NT));     ENDW(t+1); RESC(); ROT();
  }
  STEP(pB0,pB1,pA0,pA1,NT-1,false,false,false); RESC();
  { float sacc=pB0[0]+pB0[1]; _Pragma("unroll") for(int r=2;r<16;++r)sacc+=pB0[r]; _Pragma("unroll") for(int r=0;r<16;++r)sacc+=pB1[r]; l_reg+=sacc;
    pw0=(u32x4){PKW(pB0,0),PKW(pB0,2),PKW(pB0,4),PKW(pB0,6)};pw1=(u32x4){PKW(pB0,8),PKW(pB0,10),PKW(pB0,12),PKW(pB0,14)};pw2=(u32x4){PKW(pB1,0),PKW(pB1,2),PKW(pB1,4),PKW(pB1,6)};pw3=(u32x4){PKW(pB1,8),PKW(pB1,10),PKW(pB1,12),PKW(pB1,14)};
    SBAR(); pv(o,vb0+sl_cur,PAF(0),PAF(1),PAF(2),PAF(3)); }
  #undef PKW
  #undef PAF
  #undef VFR
  #undef PIN
  #undef MX3
  #undef GAPA
  #undef GAPB
  #undef EX
  #undef VRD
  #undef KRD
  #undef STEP
  #undef ENDW
  {auto rr=__builtin_amdgcn_permlane32_swap(__float_as_uint(l_reg),__float_as_uint(l_reg),false,false);l_reg=__uint_as_float(rr[0])+__uint_as_float(rr[1]);}
  if(hi==0)wsf[32+r32]=l_reg;asm volatile("s_waitcnt lgkmcnt(0)":::"memory");
  float rli[16];
  #pragma unroll
  for(int r=0;r<16;++r)rli[r]=__builtin_amdgcn_rcpf(wsf[32+crow(r,hi)]);
  bf16*Ow=O+(long)(qrow0+wid*QBLK)*1024+oc0;
  { bf16*stg=(bf16*)(shm+LDS_OST)+wid*2048;
    #pragma unroll
    for(int r=0;r<16;++r){const int orow=crow(r,hi);
      #pragma unroll
      for(int d0=0;d0<2;++d0)stg[orow*64+d0*32+r32]=(bf16)(cvtpk_s(o[d0][r]*rli[r],0.f)&0xffffu);}
    asm volatile("s_waitcnt lgkmcnt(0)":::"memory");
    #pragma unroll
    for(int i=0;i<4;++i){const int row=i*8+(lane>>3),ch=lane&7; const u32x4 v=*(const u32x4*)(stg+row*64+ch*8); ATTN_STORE16(Ow+(long)row*1024+ch*8,v);} }
  asm volatile("s_waitcnt lgkmcnt(0)\n\ts_barrier":::"memory");
  #undef DMA_K
  #undef DMA_V
  #undef TROW0
  #undef CMASK
  #undef START
  #undef RESC
  #undef ROT
}
#undef SBAR
#undef WAIT_BAR
#undef KOFF
}

struct Args { const float* in[27]; float* out; unsigned char* ws; int ph_lo, ph_hi; };
struct Frame {
    LAS unsigned char* lds; unsigned char* ws; gu32* ctl; int wave, G, gw, NGW;
};
__device__ __forceinline__ int lthread(int wave) { return wave * 64 + lane_id_v(); }

template <int MODE>
__device__ __forceinline__ void conv_item(const float* W, int K, int N, bf16* WT, LAS float* scr, int item, int lane) {
    const int nblk = (N + 63) / 64, kb = item / nblk, nb = item % nblk, k0 = 64 * kb, n0 = 64 * nb;
    f32x4 v[16];
    const int cc = (lane & 15) * 4, rk = lane >> 4;
    const bool ok = (n0 + cc) < N;
#pragma unroll
    for (int i = 0; i < 16; ++i) v[i] = ok ? *(const f32x4*)(W + (size_t)(k0 + 4 * i + rk) * N + n0 + cc) : (f32x4){0.f, 0.f, 0.f, 0.f};
#pragma unroll
    for (int i = 0; i < 16; ++i) { LAS float* s = scr + (4 * i + rk) * 65 + cc; s[0] = v[i][0]; s[1] = v[i][1]; s[2] = v[i][2]; s[3] = v[i][3]; }
    LDS_WAIT(); asm volatile("" ::: "memory");
    const int c = lane & 7;
#pragma unroll
    for (int j = 0; j < 8; ++j) { const int n = (lane >> 3) + 8 * j; const LAS float* s = scr + (8 * c) * 65 + n;
        v4u o; o.x = pk2(s[0], s[65]); o.y = pk2(s[2 * 65], s[3 * 65]); o.z = pk2(s[4 * 65], s[5 * 65]); o.w = pk2(s[6 * 65], s[7 * 65]);
        const int ng = n0 + n; if (ng < N) { const int dr = (MODE == 1) ? ((ng >> 8) * 256 + (ng & 1) * 128 + ((ng >> 1) & 127)) : ng; *(v4u*)(WT + (size_t)dr * K + k0 + 8 * c) = o; } }
    LDS_WAIT(); asm volatile("" ::: "memory");
}

__device__ __forceinline__ void prologue(Frame& F, const Args& a) {
    const int f_tid = lthread(F.wave), f_lane = f_tid & 63;
    unsigned char* ws = F.ws;
    {
        LAS float* scr = (LAS float*)(F.lds + F.wave * 16640);
        struct M { const float* src; int K, N; size_t dst; };
        const int I_FO = 16 * 16, I_MIN = 16 * 11, I_QB = 6 * 24, I_KVB = 4 * 32, I_MO = 256, I_GQKV = 16 * 24, I_GO = 256;
        const int NSMALL = 2 * I_FO + I_MIN + I_QB + I_KVB + I_MO + I_GQKV + I_GO;
        for (int it = F.gw; it < NSMALL; it += F.NGW) {
            int r = it;
            if (r < 2 * I_FO) { const int j = r / I_FO; conv_item<0>(a.in[10] + (size_t)j * D * D, D, D, (bf16*)(ws + WS_WFOUT) + (size_t)j * D * D, scr, r % I_FO, f_lane); continue; } r -= 2 * I_FO;
            if (r < I_MIN) { conv_item<0>(a.in[11], D, MLA_IN, (bf16*)(ws + WS_WMIN), scr, r, f_lane); continue; } r -= I_MIN;
            if (r < I_QB) { conv_item<0>(a.in[13], MLA_QL, 1536, (bf16*)(ws + WS_WMQB), scr, r, f_lane); continue; } r -= I_QB;
            if (r < I_KVB) { conv_item<0>(a.in[15], MLA_KVL, 2048, (bf16*)(ws + WS_WMKVB), scr, r, f_lane); continue; } r -= I_KVB;
            if (r < I_MO) { conv_item<0>(a.in[16], D, D, (bf16*)(ws + WS_WMO), scr, r, f_lane); continue; } r -= I_MO;
            if (r < I_GQKV) { conv_item<0>(a.in[17], D, GQA_QKV, (bf16*)(ws + WS_WGQKV), scr, r, f_lane); continue; } r -= I_GQKV;
            conv_item<0>(a.in[20], D, D, (bf16*)(ws + WS_WGO), scr, r, f_lane);
        }
    }
    __syncthreads();
    {
        LAS float* cmax = (LAS float*)F.lds;
        LAS float* cinv = cmax + 512;
        LAS unsigned* scr8 = (LAS unsigned*)(F.lds + 4096) + F.wave * (64 * 33);
        const int cc = (f_lane & 15) * 4, rk = f_lane >> 4;
        constexpr int NGU = DEPTH * NE * 32, NDN = DEPTH * NE * 16;
        for (int it = blockIdx.x; it < NGU + NDN; it += F.G) {
            const bool dn = it >= NGU; const int q_ = dn ? it - NGU : it; const int le = dn ? (q_ >> 4) : (q_ >> 5), strip = dn ? (q_ & 15) : (q_ & 31);
            const int N = dn ? 1024 : 2048;
            const float* W = (dn ? a.in[25] + (size_t)le * DFF * D : a.in[23] + (size_t)le * D * 2048) + strip * 64 + cc;
            f32x4 v[32];
#pragma unroll
            for (int i = 0; i < 32; ++i) v[i] = *(const f32x4*)(W + (size_t)(F.wave * 128 + 16 * (i >> 2) + 4 * rk + (i & 3)) * N);
            f32x4 mx = (f32x4){0.f, 0.f, 0.f, 0.f};
#pragma unroll
            for (int i = 0; i < 32; ++i) { mx[0] = fmaxf(mx[0], fabsf(v[i][0])); mx[1] = fmaxf(mx[1], fabsf(v[i][1])); mx[2] = fmaxf(mx[2], fabsf(v[i][2])); mx[3] = fmaxf(mx[3], fabsf(v[i][3])); }
#pragma unroll
            for (int q = 0; q < 4; ++q) { mx[q] = fmaxf(mx[q], shx(mx[q], 16, f_lane)); mx[q] = fmaxf(mx[q], shx(mx[q], 32, f_lane)); }
            __syncthreads();
            if (rk == 0) { LAS float* d = cmax + F.wave * 64 + cc; d[0] = mx[0]; d[1] = mx[1]; d[2] = mx[2]; d[3] = mx[3]; }
            __syncthreads();
            const float target = dn ? 240.f : 127.f;
            if (f_tid < 64) { float m8 = 0.f;
#pragma unroll
                for (int w = 0; w < 8; ++w) m8 = fmaxf(m8, cmax[w * 64 + f_tid]);
                const int ng = strip * 64 + f_tid, dr = dn ? ng : (ng >> 8) * 256 + (ng & 1) * 128 + ((ng >> 1) & 127);
                float* sc = dn ? (float*)(ws + WS_SWDN) + (size_t)le * 1024 : (float*)(ws + WS_SWGU) + (size_t)le * 2048;
                sc[dr] = (m8 > 0.f) ? m8 / target : 1.f;
                cinv[f_tid] = (m8 > 0.f) ? target / m8 : 0.f; }
            __syncthreads();
            const f32x4 iv = *(const LAS f32x4*)(cinv + cc);
#pragma unroll
            for (int ip = 0; ip < 8; ++ip) {
#pragma unroll
                for (int q = 0; q < 4; ++q) { unsigned w = 0;
                    if (dn) { int t = __builtin_amdgcn_cvt_pk_fp8_f32(v[4 * ip][q] * iv[q], v[4 * ip + 1][q] * iv[q], 0, false); t = __builtin_amdgcn_cvt_pk_fp8_f32(v[4 * ip + 2][q] * iv[q], v[4 * ip + 3][q] * iv[q], t, true); w = (unsigned)t; }
                    else {
#pragma unroll
                        for (int j = 0; j < 4; ++j) { int qi = __float2int_rn(v[4 * ip + j][q] * iv[q]); qi = qi > 127 ? 127 : (qi < -127 ? -127 : qi); w |= ((unsigned)qi & 255u) << (8 * j); } }
                    scr8[(cc + q) * 33 + 4 * ip + rk] = w; } }
            LDS_WAIT(); asm volatile("" ::: "memory");
            { const int c8 = f_lane & 7;
              unsigned char* dst = dn ? (unsigned char*)(ws + WS_WDN) + (size_t)le * 1024 * 1024 : (unsigned char*)(ws + WS_WGU) + (size_t)le * 2048 * 1024;
#pragma unroll
              for (int jp = 0; jp < 8; ++jp) { const int n = (f_lane >> 3) + 8 * jp; const LAS unsigned* sp = scr8 + n * 33 + 4 * c8;
                  v4u o; o.x = sp[0]; o.y = sp[1]; o.z = sp[2]; o[3] = sp[3];
                  const int ng = strip * 64 + n, dr = dn ? ng : (ng >> 8) * 256 + (ng & 1) * 128 + ((ng >> 1) & 127);
                  *(v4u*)(dst + (size_t)dr * 1024 + F.wave * 128 + 16 * c8) = o; } }
            LDS_WAIT(); asm volatile("" ::: "memory");
        }
        __syncthreads();
    }
    const int gtid = blockIdx.x * 512 + f_tid, gthreads = F.G * 512;
    for (int i = gtid; i < (MLA_IN_PAD - MLA_IN) * D / 8; i += gthreads) ((v4u*)((bf16*)(ws + WS_WMIN) + (size_t)MLA_IN * D))[i] = (v4u){0u, 0u, 0u, 0u};
    {
        bf16* MA = (bf16*)(ws + WS_MA);
        for (int i = gtid; i < 256 * 256; i += gthreads) { const int row = i >> 8, col = i & 255, jp = row >> 7, pp = (row >> 6) & 1, k1 = row & 63, j = col >> 7, pt = (col >> 6) & 1, l1 = col & 63;
            float v = 0.f; if (j == jp) { const float x = 2.f * (float)((k1 * l1) & 63) / 64.f; const float cs = cospif(x), sn = sinpif(x); v = (pp == 0) ? (pt == 0 ? cs : sn) : (pt == 0 ? -sn : cs); }
            MA[i] = (bf16)(pk2(v, 0.f) & 0xffffu); }
        bf16* DC = (bf16*)(ws + WS_DC); const float sc = 1.0f / sqrtf(256.f * 128.f);
        for (int i = gtid; i < 256 * 512; i += gthreads) { const int k = i >> 9, col = i & 511, pt = col >> 8, l = col & 255; const float x = 2.f * (float)((k * l) & 255) / 256.f;
            const float v = (pt == 0 ? cospif(x) : sinpif(x)) * sc; DC[i] = (bf16)(pk2(v, 0.f) & 0xffffu); }
        bf16* MC = (bf16*)(ws + WS_MC); const float sl = 1.0f / sqrtf(4096.f * 128.f);
        for (int i = gtid; i < 16 * 256 * 512; i += gthreads) { const int kq = i >> 17, row = (i >> 9) & 255, col = i & 511, kkp = row >> 6, k2 = row & 63, kk = col >> 7, pp = (col >> 6) & 1, l2 = col & 63;
            float v = 0.f; if (kk == kkp) { const int k = 4 * kq + kkp + 64 * k2; const float x = 2.f * (float)((l2 * k) & 4095) / 4096.f; v = (pp == 0 ? cospif(x) : sinpif(x)) * sl; }
            MC[i] = (bf16)(pk2(v, 0.f) & 0xffffu); }
        float* RM = (float*)(ws + WS_ROPE); float* RG = RM + 2048;
        for (int i = gtid; i < 64 * 8; i += gthreads) { const int pos = i >> 3, f = i & 7; const float inv = powf(10000.f, -(float)f / 8.f); float s, c; sincosf((float)pos * inv, &s, &c); RM[2 * i] = c; RM[2 * i + 1] = s; }
        for (int i = gtid; i < 64 * 16; i += gthreads) { const int pos = i >> 4, f = i & 15; const float inv = powf(10000.f, -(float)f / 16.f); float s, c; sincosf((float)pos * inv, &s, &c); RG[2 * i] = c; RG[2 * i + 1] = s; }
        float* WRT = (float*)(ws + WS_WRT);
        for (int i = gtid; i < DEPTH * NE * D; i += gthreads) { const int l = i >> 15, e = (i >> 10) & 31, k = i & 1023; WRT[i] = a.in[21][((size_t)l * D + k) * NE + e]; }
        float* BG = (float*)(ws + WS_BGU);
        for (int i = gtid; i < DEPTH * NE * 2048; i += gthreads) { const int le = i >> 11, q = i & 2047, pn = q >> 8, s = (q >> 7) & 1, jj = q & 127; BG[i] = a.in[24][(size_t)le * 2048 + 2 * (pn * 128 + jj) + s]; }
    }
    __syncthreads();
    {
        LAS float* wl = (LAS float*)F.lds;
        LAS float* tc = wl + 2048; LAS float* ts = tc + 128;
        if (f_tid < 128) { const float x = 2.f * (float)f_tid / 128.f; tc[f_tid] = cospif(x); ts[f_tid] = -sinpif(x); }
        for (int it = blockIdx.x; it < 2 * 8 * 64; it += F.G) { const int j = it >> 9, g = (it >> 6) & 7, kb = it & 63;
            __syncthreads();
            { const int kk = f_tid >> 5, c4 = (f_tid & 31) * 4; const f32x4 w = *(const f32x4*)(a.in[9] + ((size_t)j * D + kb * 16 + kk) * D + g * 128 + c4);
              LAS float* d = wl + c4 * 16 + kk; d[0] = w[0]; d[16] = w[1]; d[32] = w[2]; d[48] = w[3]; }
            __syncthreads();
            const int cl = f_tid & 255, m = cl >> 1, part = cl & 1, kh = f_tid >> 8; const LAS float* tw = part ? ts : tc;
            float accv[8];
#pragma unroll
            for (int q = 0; q < 8; ++q) accv[q] = 0.f;
            for (int jj = 0; jj < 128; ++jj) { const float t = tw[(m * jj) & 127]; const f32x4 wa = *(const LAS f32x4*)(wl + jj * 16 + kh * 8), wb = *(const LAS f32x4*)(wl + jj * 16 + kh * 8 + 4);
                accv[0] += wa[0] * t; accv[1] += wa[1] * t; accv[2] += wa[2] * t; accv[3] += wa[3] * t; accv[4] += wb[0] * t; accv[5] += wb[1] * t; accv[6] += wb[2] * t; accv[7] += wb[3] * t; }
            v4u o; o.x = pk2(accv[0], accv[1]); o.y = pk2(accv[2], accv[3]); o.z = pk2(accv[4], accv[5]); o.w = pk2(accv[6], accv[7]);
            *(v4u*)((bf16*)(ws + WS_WFIN) + ((size_t)j * 2048 + g * 256 + cl) * D + kb * 16 + kh * 8) = o;
        }
        __syncthreads();
    }
    {
        LAS float* S = (LAS float*)F.lds;
        LAS float* red = S + 9 * 1024;
        for (int i = f_tid; i < 9 * 1024; i += 512) { const int r = i >> 10, k = i & 1023; const float v = (r < 8) ? a.in[1][r * D + k] : a.in[3][k]; S[i] = v / (1.f + __expf(-v)); }
        __syncthreads();
        for (int it = blockIdx.x; it < DEPTH * 96; it += F.G) { const int l = it / 96, n0 = (it % 96) * 64;
            const float* wp = a.in[4] + ((size_t)l * D + F.wave * 128) * (NMOD * D) + n0 + f_lane;
            float accv[9];
#pragma unroll
            for (int r = 0; r < 9; ++r) accv[r] = 0.f;
            for (int k0 = 0; k0 < 128; k0 += 32) { float wv[32];
#pragma unroll
                for (int k = 0; k < 32; ++k) wv[k] = wp[(size_t)(k0 + k) * (NMOD * D)];
#pragma unroll
                for (int k = 0; k < 32; ++k)
#pragma unroll
                    for (int r = 0; r < 9; ++r) accv[r] += S[r * 1024 + F.wave * 128 + k0 + k] * wv[k]; }
#pragma unroll
            for (int r = 0; r < 9; ++r) red[(F.wave * 9 + r) * 64 + f_lane] = accv[r];
            __syncthreads();
            for (int i = f_tid; i < 9 * 64; i += 512) { const int r = i >> 6, ln = i & 63; float s = a.in[5][(size_t)l * (NMOD * D) + n0 + ln];
#pragma unroll
                for (int w = 0; w < 8; ++w) s += red[(w * 9 + r) * 64 + ln];
                ((float*)(ws + WS_MOD))[((size_t)l * 9 + r) * (NMOD * D) + n0 + ln] = s; }
            __syncthreads();
        }
    }
}

__device__ __forceinline__ void load_row(const float* p, int lane, f32x4 (&v)[4]) {
#pragma unroll
    for (int j = 0; j < 4; ++j) v[j] = ((const f32x4*)p)[lane + 64 * j];
}
__device__ __forceinline__ void load_row_bf(const bf16* p, int lane, f32x4 (&v)[4]) {
#pragma unroll
    for (int j = 0; j < 4; ++j) { const v2u w = ((const v2u*)p)[lane + 64 * j]; v[j] = (f32x4){bf_lo(w.x), bf_hi(w.x), bf_lo(w.y), bf_hi(w.y)}; }
}
__device__ __forceinline__ void norm_mod(f32x4 (&v)[4], const float* g, const float* shift, const float* scale, int lane) {
    float s = 0.f;
#pragma unroll
    for (int j = 0; j < 4; ++j) s += (v[j][0] * v[j][0] + v[j][1] * v[j][1]) + (v[j][2] * v[j][2] + v[j][3] * v[j][3]);
    const float rstd = rsqrtf(wave_sum(s, lane) * (1.f / D) + EPS);
#pragma unroll
    for (int j = 0; j < 4; ++j) { const f32x4 gv = ((const f32x4*)g)[lane + 64 * j], sh = ((const f32x4*)shift)[lane + 64 * j], sc = ((const f32x4*)scale)[lane + 64 * j];
        v[j] = (v[j] * rstd * gv) * (sc + 1.f) + sh; }
}
__device__ __forceinline__ void store_row_bf16(bf16* p, int lane, const f32x4 (&v)[4]) {
#pragma unroll
    for (int j = 0; j < 4; ++j) { v2u w; w.x = pk2(v[j][0], v[j][1]); w.y = pk2(v[j][2], v[j][3]); ((v2u*)p)[lane + 64 * j] = w; }
}

__device__ __forceinline__ float store_row_i8(unsigned char* p, int lane, const f32x4 (&v)[4]) {
    float am = 0.f;
#pragma unroll
    for (int j = 0; j < 4; ++j) am = fmaxf(fmaxf(am, fmaxf(fabsf(v[j][0]), fabsf(v[j][1]))), fmaxf(fabsf(v[j][2]), fabsf(v[j][3])));
    unsigned k = __float_as_uint(am);
    { unsigned t;
      t = (unsigned)__builtin_amdgcn_mov_dpp((int)k, 0xb1, 0xf, 0xf, false); k = k > t ? k : t;
      t = (unsigned)__builtin_amdgcn_mov_dpp((int)k, 0x4e, 0xf, 0xf, false); k = k > t ? k : t;
      t = (unsigned)__builtin_amdgcn_mov_dpp((int)k, 0x124, 0xf, 0xf, false); k = k > t ? k : t;
      t = (unsigned)__builtin_amdgcn_mov_dpp((int)k, 0x128, 0xf, 0xf, false); k = k > t ? k : t;
      const unsigned a = (unsigned)__builtin_amdgcn_readlane((int)k, 0), b = (unsigned)__builtin_amdgcn_readlane((int)k, 16), c = (unsigned)__builtin_amdgcn_readlane((int)k, 32), d = (unsigned)__builtin_amdgcn_readlane((int)k, 48);
      const unsigned ab = a > b ? a : b, cd = c > d ? c : d; k = ab > cd ? ab : cd; }
    const float amax = __uint_as_float(k);
    const float qscale = amax > 0.f ? amax * (1.f / 127.f) : 1.f, qinv = amax > 0.f ? 127.f / amax : 0.f;
#pragma unroll
    for (int j = 0; j < 4; ++j) { unsigned w = 0;
#pragma unroll
        for (int q = 0; q < 4; ++q) { int qi = __float2int_rn(v[j][q] * qinv); qi = qi > 127 ? 127 : (qi < -127 ? -127 : qi); w |= ((unsigned)qi & 255u) << (8 * q); }
        ((unsigned*)p)[lane + 64 * j] = w; }
    return qscale;
}
__device__ __forceinline__ void quant_rows(Frame& F, const bf16* src, unsigned char* dst, float* scale, int R) {
    const int f_lane = lthread(F.wave) & 63;
    for (int r = F.gw; r < R; r += F.NGW) { f32x4 v[4]; load_row_bf(src + (size_t)r * 1024, f_lane, v);
        const float sc = store_row_i8(dst + (size_t)r * 1024, f_lane, v); if (f_lane == 0) scale[r] = sc; }
}
__device__ __forceinline__ void rp_norm1(Frame& F, const Args& a, int l, int row_lo) {
    const int f_tid = lthread(F.wave), f_lane = f_tid & 63;
    const bf16* X = (const bf16*)(F.ws + WS_X); bf16* H = (bf16*)(F.ws + WS_H); const float* MOD = (const float*)(F.ws + WS_MOD) + (size_t)l * 9 * (NMOD * D);
    for (int row = row_lo + F.gw; row < NT; row += F.NGW) { f32x4 v[4];
        if (l == 0) load_row(row < NC ? a.in[2] + (size_t)row * D : a.in[0] + (size_t)(row - NC) * D, f_lane, v);
        else load_row_bf(X + (size_t)row * D, f_lane, v);
        const float* m = MOD + (size_t)modrow_of(row) * (NMOD * D);
        norm_mod(v, a.in[6] + (size_t)l * D, m, m + D, f_lane);
        const float sc = store_row_i8((unsigned char*)H + (size_t)row * D, f_lane, v); if (f_lane == 0) ((float*)(F.ws + WS_SH))[row] = sc; }
}

#if MK_N2V2
constexpr int LDS_LIST = LDS_MISC + 768;
__device__ __forceinline__ unsigned row16_max(unsigned k) {
    unsigned t;
    t = (unsigned)__builtin_amdgcn_mov_dpp((int)k, 0xb1, 0xf, 0xf, false); k = k > t ? k : t;
    t = (unsigned)__builtin_amdgcn_mov_dpp((int)k, 0x4e, 0xf, 0xf, false); k = k > t ? k : t;
    t = (unsigned)__builtin_amdgcn_mov_dpp((int)k, 0x124, 0xf, 0xf, false); k = k > t ? k : t;
    t = (unsigned)__builtin_amdgcn_mov_dpp((int)k, 0x128, 0xf, 0xf, false); k = k > t ? k : t;
    return k;
}
__device__ __forceinline__ unsigned wave_max_u(unsigned k) {
    k = row16_max(k);
    const unsigned a = (unsigned)__builtin_amdgcn_readlane((int)k, 0), b = (unsigned)__builtin_amdgcn_readlane((int)k, 16), c = (unsigned)__builtin_amdgcn_readlane((int)k, 32), d = (unsigned)__builtin_amdgcn_readlane((int)k, 48);
    const unsigned ab = a > b ? a : b, cd = c > d ? c : d; return ab > cd ? ab : cd;
}
__device__ __forceinline__ float key_val(unsigned m) { const unsigned u = m & ~31u; return __builtin_bit_cast(float, (u & 0x80000000u) ? (u ^ 0x80000000u) : ~u); }
constexpr int N2_WPITCH = 2064;
constexpr int N2_GM = 32 * N2_WPITCH;
constexpr int N2_LIST = N2_GM + 5 * 8192;
__device__ __forceinline__ void rp_norm2_router(Frame& F, const Args& a, int l, int row_lo) {
    const int f_tid = lthread(F.wave), f_lane = f_tid & 63;
    const bf16* X = (const bf16*)(F.ws + WS_X); unsigned char* H8 = (unsigned char*)(F.ws + WS_H); const float* MOD = (const float*)(F.ws + WS_MOD) + (size_t)l * 9 * (NMOD * D);
    LAS unsigned char* WT = F.lds;
    { const f32x4* src = (const f32x4*)((const float*)(F.ws + WS_WRT) + (size_t)l * NE * D); f32x4 tv[16];
#pragma unroll
      for (int i = 0; i < 16; ++i) tv[i] = src[f_tid + 512 * i];
#pragma unroll
      for (int i = 0; i < 16; ++i) { const int i4 = f_tid + 512 * i, e = i4 >> 8, k4 = (i4 & 255) * 4; v2u w; w.x = pk2(tv[i][0], tv[i][1]); w.y = pk2(tv[i][2], tv[i][3]); *(LAS v2u*)(WT + e * N2_WPITCH + k4 * 2) = w; } }
    LAS int* lcnt = (LAS int*)(F.lds + LDS_TT); LAS int* lbase = lcnt + 32;
    if (f_tid < 32) lcnt[f_tid] = 0;
    const int ngroups = (NT - row_lo) >> 5;
    const int g = F.wave * F.G + (int)blockIdx.x;
    const bool active = (F.wave < 5) && (g < ngroups);
    LAS float* GM = (LAS float*)(F.lds + N2_GM + (F.wave < 5 ? F.wave : 0) * 8192); LAS float* SH = GM + 1024;
    LAS v4u* list = (LAS v4u*)(F.lds + N2_LIST + (F.wave < 5 ? F.wave : 0) * (128 * 16 + 128)); LAS float* lsc = (LAS float*)(list + 128);
    const int r = f_lane & 31, kh = f_lane >> 5;
    const int row = row_lo + g * 32 + r;
    float msh = 0.f;
    if (active) {
        const float* m = MOD + (size_t)modrow_of(row_lo + g * 32) * (NMOD * D); const float* gf = a.in[7] + (size_t)l * D;
#pragma unroll
        for (int j = 0; j < 4; ++j) { const f32x4 gv = ((const f32x4*)gf)[f_lane + 64 * j], sc = ((const f32x4*)(m + 4 * D))[f_lane + 64 * j], sv = ((const f32x4*)(m + 3 * D))[f_lane + 64 * j];
            ((LAS f32x4*)GM)[f_lane + 64 * j] = gv * (sc + 1.f); ((LAS f32x4*)SH)[f_lane + 64 * j] = sv;
            msh = fmaxf(fmaxf(msh, fmaxf(fabsf(sv[0]), fabsf(sv[1]))), fmaxf(fabsf(sv[2]), fabsf(sv[3]))); }
        msh = __uint_as_float(wave_max_u(__float_as_uint(msh)));
    }
    __syncthreads();
    if (active) {
        const bf16* xr = X + (size_t)row * D + 16 * kh;
        float ssq = 0.f, mxg = 0.f;
#pragma unroll 1
        for (int c0 = 0; c0 < 32; c0 += 8) { v4u xa[8], xb[8];
#pragma unroll
            for (int i = 0; i < 8; ++i) { xa[i] = *(const v4u*)(xr + 32 * (c0 + i)); xb[i] = *(const v4u*)(xr + 32 * (c0 + i) + 8); }
#pragma unroll
            for (int i = 0; i < 8; ++i) { const LAS f32x4* gp = (const LAS f32x4*)(GM + 32 * (c0 + i) + 16 * kh);
                const f32x4 g0 = gp[0], g1 = gp[1], g2 = gp[2], g3 = gp[3];
                const unsigned wa[4] = {xa[i].x, xa[i].y, xa[i].z, xa[i][3]}, wb[4] = {xb[i].x, xb[i].y, xb[i].z, xb[i][3]};
#pragma unroll
                for (int q = 0; q < 4; ++q) { const float x0 = bf_lo(wa[q]), x1 = bf_hi(wa[q]), x2 = bf_lo(wb[q]), x3 = bf_hi(wb[q]);
                    ssq += x0 * x0 + x1 * x1 + x2 * x2 + x3 * x3;
                    const float ga = (q < 2 ? g0 : g1)[(2 * q) & 3], gb = (q < 2 ? g0 : g1)[(2 * q + 1) & 3], gc = (q < 2 ? g2 : g3)[(2 * q) & 3], gd = (q < 2 ? g2 : g3)[(2 * q + 1) & 3];
                    mxg = fmaxf(fmaxf(mxg, fmaxf(fabsf(x0 * ga), fabsf(x1 * gb))), fmaxf(fabsf(x2 * gc), fabsf(x3 * gd))); } } }
        { auto rr = __builtin_amdgcn_permlane32_swap(__float_as_uint(ssq), __float_as_uint(ssq), false, false); ssq = __uint_as_float(rr[0]) + __uint_as_float(rr[1]); }
        { auto rr = __builtin_amdgcn_permlane32_swap(__float_as_uint(mxg), __float_as_uint(mxg), false, false); mxg = fmaxf(__uint_as_float(rr[0]), __uint_as_float(rr[1])); }
        const float rstd = rsqrtf(ssq * (1.f / D) + EPS);
        const float bound = mxg * rstd + msh;
        const float qscale = bound > 0.f ? bound * (1.f / 127.f) : 1.f, qinv = bound > 0.f ? 127.f / bound : 0.f;
        f32x16 acc = f32x16{};
        unsigned char* hrow = H8 + (size_t)row * D + 16 * kh;
        const LAS unsigned char* wrow = WT + r * N2_WPITCH + 32 * kh;
#pragma unroll 1
        for (int c0 = 0; c0 < 32; c0 += 4) { v4u xa[4], xb[4];
#pragma unroll
            for (int i = 0; i < 4; ++i) { xa[i] = *(const v4u*)(xr + 32 * (c0 + i)); xb[i] = *(const v4u*)(xr + 32 * (c0 + i) + 8); }
#pragma unroll
            for (int i = 0; i < 4; ++i) { const int c = c0 + i;
                const LAS f32x4* gp = (const LAS f32x4*)(GM + 32 * c + 16 * kh); const LAS f32x4* sp = (const LAS f32x4*)(SH + 32 * c + 16 * kh);
                const bf16x8 w0 = *(const LAS bf16x8*)(wrow + 64 * c), w1 = *(const LAS bf16x8*)(wrow + 64 * c + 16);
                float h[16];
                const unsigned wa[4] = {xa[i].x, xa[i].y, xa[i].z, xa[i][3]}, wb[4] = {xb[i].x, xb[i].y, xb[i].z, xb[i][3]};
#pragma unroll
                for (int q = 0; q < 4; ++q) { h[2 * q] = bf_lo(wa[q]); h[2 * q + 1] = bf_hi(wa[q]); h[8 + 2 * q] = bf_lo(wb[q]); h[8 + 2 * q + 1] = bf_hi(wb[q]); }
#pragma unroll
                for (int q = 0; q < 4; ++q) { const f32x4 gq = gp[q], sq = sp[q];
#pragma unroll
                    for (int e = 0; e < 4; ++e) h[4 * q + e] = (h[4 * q + e] * rstd) * gq[e] + sq[e]; }
                v4u o8;
#pragma unroll
                for (int q = 0; q < 4; ++q) { unsigned w = 0;
#pragma unroll
                    for (int e = 0; e < 4; ++e) w |= ((unsigned)__float2int_rn(h[4 * q + e] * qinv) & 255u) << (8 * e);
                    o8[q] = w; }
                *(v4u*)(hrow + 32 * c) = o8;
                v4u hi0, hi1, lo0, lo1;
#pragma unroll
                for (int q = 0; q < 4; ++q) { hi0[q] = pk2(h[2 * q], h[2 * q + 1]); hi1[q] = pk2(h[8 + 2 * q], h[8 + 2 * q + 1]); }
#pragma unroll
                for (int q = 0; q < 4; ++q) { lo0[q] = pk2(h[2 * q] - bf_lo(hi0[q]), h[2 * q + 1] - bf_hi(hi0[q])); lo1[q] = pk2(h[8 + 2 * q] - bf_lo(hi1[q]), h[8 + 2 * q + 1] - bf_hi(hi1[q])); }
                acc = __builtin_amdgcn_mfma_f32_32x32x16_bf16(w0, __builtin_bit_cast(bf16x8, hi0), acc, 0, 0, 0);
                acc = __builtin_amdgcn_mfma_f32_32x32x16_bf16(w0, __builtin_bit_cast(bf16x8, lo0), acc, 0, 0, 0);
                acc = __builtin_amdgcn_mfma_f32_32x32x16_bf16(w1, __builtin_bit_cast(bf16x8, hi1), acc, 0, 0, 0);
                acc = __builtin_amdgcn_mfma_f32_32x32x16_bf16(w1, __builtin_bit_cast(bf16x8, lo1), acc, 0, 0, 0); } }
        float val[32];
        const float* br = a.in[22] + (size_t)l * NE;
#pragma unroll
        for (int j = 0; j < 16; ++j) { auto rr = __builtin_amdgcn_permlane32_swap(__float_as_uint(acc[j]), __float_as_uint(acc[j]), false, false);
            const int e0 = (j & 3) + 8 * (j >> 2); val[e0] = __uint_as_float(rr[0]) + br[e0]; val[e0 + 4] = __uint_as_float(rr[1]) + br[e0 + 4]; }
        unsigned taken = 0u; int be[4]; float bv[4];
#pragma unroll
        for (int k = 0; k < 4; ++k) { float best = -INFINITY; int bi = 0;
#pragma unroll
            for (int e = 0; e < 32; ++e) { const bool cnd = !((taken >> e) & 1u) && (val[e] > best); best = cnd ? val[e] : best; bi = cnd ? e : bi; }
            taken |= 1u << bi; be[k] = bi; bv[k] = best; }
        const float e1 = __expf(bv[1] - bv[0]), e2 = __expf(bv[2] - bv[0]), e3 = __expf(bv[3] - bv[0]); const float inv = 1.f / (1.f + e1 + e2 + e3);
        if (kh == 0) { const float ww[4] = {inv, e1 * inv, e2 * inv, e3 * inv};
#pragma unroll
            for (int k = 0; k < 4; ++k) { const int lr = __hip_atomic_fetch_add(lcnt + be[k], 1, __ATOMIC_RELAXED, __HIP_MEMORY_SCOPE_WORKGROUP);
                LAS unsigned* ep = (LAS unsigned*)(list + r * 4 + k); ep[0] = (unsigned)(row * 4 + k); ep[1] = (unsigned)be[k]; ep[2] = (unsigned)lr; ep[3] = __builtin_bit_cast(unsigned, ww[k]); }
            lsc[r] = qscale; }
    }
    __syncthreads();
    if (f_tid < 32) { const int c = lcnt[f_tid]; lbase[f_tid] = c ? (int)__hip_atomic_fetch_add((unsigned*)(F.ctl + CW_CNT + (l * 32 + f_tid) * 16), (unsigned)c, RLX_AGENT) : 0; }
    __syncthreads();
    if (active) {
        int* te = (int*)(F.ws + WS_TE); int* trank = (int*)(F.ws + WS_TRANK); int* stok = (int*)(F.ws + WS_STOK); float* sw = (float*)(F.ws + WS_SW); float* ssc = (float*)(F.ws + WS_SSC);
#pragma unroll
        for (int i = f_lane; i < 128; i += 64) { const LAS unsigned* ep = (const LAS unsigned*)(list + i); const unsigned rowk = ep[0], ex = ep[1], lr = ep[2]; const float wv = __builtin_bit_cast(float, ep[3]);
            const int rk = lbase[ex] + (int)lr;
            stok[(size_t)ex * CAP + rk] = (int)(rowk >> 2); sw[(size_t)ex * CAP + rk] = wv; ssc[(size_t)ex * CAP + rk] = lsc[i >> 2]; te[rowk] = (int)ex; trank[rowk] = rk; }
    }
}

#endif
__device__ __forceinline__ void moe_table(Frame& F, int l) {
    const int f_tid = lthread(F.wave), f_lane = f_tid & 63;
    LAS int* TT = (LAS int*)(F.lds + LDS_TT); LAS int* CN = TT + 64; LAS int* TE = (LAS int*)(F.lds + LDS_TE);
    __syncthreads();
    if (f_tid < 64) {
        const int c = (f_lane < 32) ? (int)__hip_atomic_load((unsigned*)(F.ctl + CW_CNT + (l * 32 + (f_lane & 31)) * 16), RLX_AGENT) : 0;
        const int tl = (c + 255) >> 8; int v = tl;
#pragma unroll
        for (int o = 1; o < 32; o <<= 1) { const int n = __builtin_amdgcn_ds_bpermute((f_lane >= o ? f_lane - o : f_lane) << 2, v); if (f_lane >= o) v += n; }
        if (f_lane < 32) { CN[f_lane] = c; TT[f_lane] = v - tl; if (f_lane == 31) TT[32] = v; }
    }
    __syncthreads();
    for (int t = f_tid; t < MAXTILES; t += 512) { int lo = 0, hi = 32;
#pragma unroll
        for (int k = 0; k < 5; ++k) { const int mid = (lo + hi) >> 1; if (TT[mid] <= t) lo = mid; else hi = mid; }
        TE[t] = lo; }
    __syncthreads();
}

#if MK_CBV2
struct CombRow { v2u x[4]; unsigned y[4][4]; };
__device__ __forceinline__ void comb_issue(CombRow& R, const bf16* X, const unsigned char* Y, const LAS int* TT, int row, const v4u te4, const v4u tr4, int lane) {
    const unsigned ee[4] = {te4[0], te4[1], te4[2], te4[3]}, rr[4] = {tr4[0], tr4[1], tr4[2], tr4[3]};
#pragma unroll
    for (int k = 0; k < 4; ++k) { const size_t slot = (size_t)TT[ee[k]] * 256 + rr[k]; const unsigned* yp = (const unsigned*)(Y + slot * 1024);
#pragma unroll
        for (int j = 0; j < 4; ++j) R.y[k][j] = yp[lane + 64 * j]; }
#pragma unroll
    for (int j = 0; j < 4; ++j) R.x[j] = ((const v2u*)(X + (size_t)row * D))[lane + 64 * j];
}
__device__ __forceinline__ void comb_finish(const CombRow& R, Frame& F, const Args& a, int l, int row, int lane, const float* MOD, const float* MODN, bool lastl) {
    bf16* X = (bf16*)(F.ws + WS_X); bf16* H = (bf16*)(F.ws + WS_H);
    const int mr = modrow_of(row); const float* g5 = MOD + (size_t)mr * (NMOD * D) + 5 * D;
    f32x4 v[4];
#pragma unroll
    for (int j = 0; j < 4; ++j) { f32x4 s = (f32x4){0.f, 0.f, 0.f, 0.f};
#pragma unroll
        for (int k = 0; k < 4; ++k) { const int w = (int)R.y[k][j]; const f32x2 lo = __builtin_amdgcn_cvt_pk_f32_fp8(w, false), hi = __builtin_amdgcn_cvt_pk_f32_fp8(w, true); s[0] += lo[0]; s[1] += lo[1]; s[2] += hi[0]; s[3] += hi[1]; }
        s = s * 0.125f;
        const f32x4 gv = ((const f32x4*)g5)[lane + 64 * j]; const v2u xw = R.x[j]; v[j] = (f32x4){bf_lo(xw.x), bf_hi(xw.x), bf_lo(xw.y), bf_hi(xw.y)} + gv * s; }
    if (!lastl) {
        store_row_bf16(X + (size_t)row * D, lane, v);
        const float* m = MODN + (size_t)mr * (NMOD * D);
        norm_mod(v, a.in[6] + (size_t)(l + 1) * D, m, m + D, lane);
        const float sc = store_row_i8((unsigned char*)H + (size_t)row * D, lane, v); if (lane == 0) ((float*)(F.ws + WS_SH))[row] = sc;
    } else {
        float ss = 0.f;
#pragma unroll
        for (int j = 0; j < 4; ++j) ss += (v[j][0] * v[j][0] + v[j][1] * v[j][1]) + (v[j][2] * v[j][2] + v[j][3] * v[j][3]);
        const float rstd = rsqrtf(wave_sum(ss, lane) * (1.f / D) + EPS);
        float* op = a.out + (size_t)(row - NC) * D;
#pragma unroll
        for (int j = 0; j < 4; ++j) { const f32x4 gv = ((const f32x4*)a.in[8])[lane + 64 * j]; ((f32x4*)op)[lane + 64 * j] = v[j] * rstd * gv; }
    }
}
__device__ __forceinline__ void rp_combine(Frame& F, const Args& a, int l, int row_lo) {
    const int f_tid = lthread(F.wave), f_lane = f_tid & 63;
    const bf16* X = (const bf16*)(F.ws + WS_X); const unsigned char* Y = (const unsigned char*)(F.ws + WS_Y);
    const float* MOD = (const float*)(F.ws + WS_MOD) + (size_t)l * 9 * (NMOD * D); const float* MODN = MOD + 9 * (NMOD * D);
    const v4u* te = (const v4u*)(F.ws + WS_TE); const v4u* trank = (const v4u*)(F.ws + WS_TRANK);
    const LAS int* TT = (const LAS int*)(F.lds + LDS_TT);
    const bool lastl = (l == DEPTH - 1);
    const int st = F.NGW;
    int row = row_lo + F.gw;
    if (row >= NT) return;
    CombRow RA, RB;
    v4u te1 = te[row], tr1 = trank[row];
    comb_issue(RA, X, Y, TT, row, te1, tr1, f_lane);
    if (row + st < NT) { te1 = te[row + st]; tr1 = trank[row + st]; }
    for (;;) {
        const bool h1 = row + st < NT;
        if (h1) comb_issue(RB, X, Y, TT, row + st, te1, tr1, f_lane);
        if (row + 2 * st < NT) { te1 = te[row + 2 * st]; tr1 = trank[row + 2 * st]; }
        comb_finish(RA, F, a, l, row, f_lane, MOD, MODN, lastl);
        if (!h1) break;
        row += st;
        const bool h2 = row + st < NT;
        if (h2) comb_issue(RA, X, Y, TT, row + st, te1, tr1, f_lane);
        if (row + 2 * st < NT) { te1 = te[row + 2 * st]; tr1 = trank[row + 2 * st]; }
        comb_finish(RB, F, a, l, row, f_lane, MOD, MODN, lastl);
        if (!h2) break;
        row += st;
    }
}

#endif
__device__ __forceinline__ void rp_mla(Frame& F, const Args& a) {
    const int f_tid = lthread(F.wave), f_lane = f_tid & 63;
    const bf16* A = (const bf16*)(F.ws + WS_RE); bf16* QA = (bf16*)(F.ws + WS_RF); bf16* CKV = (bf16*)(F.ws + WS_RG); bf16* Kb = (bf16*)(F.ws + WS_RB);
    const float* rope = (const float*)(F.ws + WS_ROPE); const float* gq = a.in[12]; const float* gk = a.in[14];
    for (int row = F.gw; row < NT; row += F.NGW) {
        const unsigned* ap = (const unsigned*)(A + (size_t)row * MLA_IN_PAD);
        unsigned q[3], c[2];
#pragma unroll
        for (int j = 0; j < 3; ++j) q[j] = ap[f_lane + 64 * j];
#pragma unroll
        for (int j = 0; j < 2; ++j) c[j] = ap[192 + f_lane + 64 * j];
        const unsigned pe = ap[320 + (f_lane & 15)];
        float sq = 0.f, sc = 0.f;
#pragma unroll
        for (int j = 0; j < 3; ++j) { const float x0 = bf_lo(q[j]), x1 = bf_hi(q[j]); sq += x0 * x0 + x1 * x1; }
#pragma unroll
        for (int j = 0; j < 2; ++j) { const float x0 = bf_lo(c[j]), x1 = bf_hi(c[j]); sc += x0 * x0 + x1 * x1; }
        const float rq = rsqrtf(wave_sum(sq, f_lane) * (1.f / MLA_QL) + EPS), rc = rsqrtf(wave_sum(sc, f_lane) * (1.f / MLA_KVL) + EPS);
#pragma unroll
        for (int j = 0; j < 3; ++j) { const int e0 = 2 * (f_lane + 64 * j); ((unsigned*)(QA + (size_t)row * MLA_QL))[f_lane + 64 * j] = pk2(bf_lo(q[j]) * rq * gq[e0], bf_hi(q[j]) * rq * gq[e0 + 1]); }
#pragma unroll
        for (int j = 0; j < 2; ++j) { const int e0 = 2 * (f_lane + 64 * j); ((unsigned*)(CKV + (size_t)row * MLA_KVL))[f_lane + 64 * j] = pk2(bf_lo(c[j]) * rc * gk[e0], bf_hi(c[j]) * rc * gk[e0 + 1]); }
        float x0 = bf_lo(pe), x1 = bf_hi(pe);
        if (row >= NC) { const int t = (row - NC) & 4095, i = f_lane & 15, d = 2 * i, pos = (d & 16) ? (t & 63) : (t >> 6), f = d & 7;
            const float p0 = shx(x0, 4, f_lane), p1 = shx(x1, 4, f_lane); const float sg = (d & 8) ? 1.f : -1.f;
            const float* rp = rope + (size_t)pos * 16 + 2 * f; x0 = x0 * rp[0] + sg * p0 * rp[1]; x1 = x1 * rp[2] + sg * p1 * rp[3]; }
        const unsigned w = pk2(x0, x1);
        { const int i = f_lane & 15, hb = f_lane >> 4;
#pragma unroll
          for (int hh = 0; hh < 4; ++hh) { const int h = hb * 4 + hh; ((unsigned*)(Kb + (size_t)row * 1536 + 96 * h + 64))[i] = w; } }
    }
}

__device__ __forceinline__ void rp_gqa(Frame& F, const Args& a) {
    const int f_tid = lthread(F.wave), f_lane = f_tid & 63;
    const bf16* A = (const bf16*)(F.ws + WS_RA); bf16* Q = (bf16*)(F.ws + WS_RB); bf16* Kb = Q + (size_t)NT * 1024;
    const float* rope = (const float*)(F.ws + WS_ROPE) + 2048; const float* gq = a.in[18]; const float* gk = a.in[19];
    const float c2 = 0.125f * LOG2E;
    for (int row = F.gw; row < NT; row += F.NGW) {
        const bool lat = row >= NC; const int t = (row - NC) & 4095;
#pragma unroll
        for (int part = 0; part < 2; ++part) {
            const int ln = part ? (f_lane & 15) : f_lane; const bf16* src = A + (size_t)row * GQA_QKV + (part ? 1024 : 0) + ln * 16;
            const v4u w0 = *(const v4u*)src, w1 = *(const v4u*)(src + 8);
            float x[16]; const unsigned ww[8] = {w0.x, w0.y, w0.z, w0.w, w1.x, w1.y, w1.z, w1.w};
#pragma unroll
            for (int i = 0; i < 8; ++i) { x[2 * i] = bf_lo(ww[i]); x[2 * i + 1] = bf_hi(ww[i]); }
            float ss = 0.f;
#pragma unroll
            for (int i = 0; i < 16; ++i) ss += x[i] * x[i];
            ss += shx(ss, 1, f_lane); ss += shx(ss, 2, f_lane);
            const float rs = rsqrtf(ss * (1.f / 64.f) + EPS); const float* g = (part ? gk : gq) + (ln & 3) * 16;
#pragma unroll
            for (int i = 0; i < 16; ++i) x[i] = x[i] * rs * g[i];
            if (lat) { const int sec = (ln >> 1) & 1, pos = sec ? (t & 63) : (t >> 6); const float sg = (ln & 1) ? 1.f : -1.f; const float* rp = rope + (size_t)pos * 32;
#pragma unroll
                for (int i = 0; i < 16; ++i) { const float pr = shx(x[i], 1, f_lane); x[i] = x[i] * rp[2 * i] + sg * pr * rp[2 * i + 1]; } }
            const float scl = part ? 1.f : c2;
            v4u o0, o1; o0.x = pk2(x[0] * scl, x[1] * scl); o0.y = pk2(x[2] * scl, x[3] * scl); o0.z = pk2(x[4] * scl, x[5] * scl); o0.w = pk2(x[6] * scl, x[7] * scl);
            o1.x = pk2(x[8] * scl, x[9] * scl); o1.y = pk2(x[10] * scl, x[11] * scl); o1.z = pk2(x[12] * scl, x[13] * scl); o1.w = pk2(x[14] * scl, x[15] * scl);
            if (part == 0) { bf16* d = Q + (size_t)row * 1024 + ln * 16; *(v4u*)d = o0; *(v4u*)(d + 8) = o1; }
            else if (f_lane < 16) { bf16* d = Kb + (size_t)row * 256 + ln * 16; *(v4u*)d = o0; *(v4u*)(d + 8) = o1; }
        }
    }
}

template <int DK>
__device__ __forceinline__ void attn_phase(Frame& F, const att::Tens& T, int kvshift  , int kstride, int vstride, int vbase) {
    const int vcu = (F.G % 8 == 0) ? (blockIdx.x % 8) * (F.G / 8) + blockIdx.x / 8 : blockIdx.x;
    if constexpr (DK == 64) {
        for (int u = vcu; u < 2048 + 128; u += F.G) {
            if (u < 2048) { const int b = u >> 8, h = (u >> 4) & 15, qb = u & 15, kvh = h >> kvshift;
                att64::attn_unit<8>(T.Q, T.qpitch, NC + b * SEQ + qb * 256, h * 64, T.K, T.kpitch, kvh * kstride, T.V, T.vpitch, vbase + kvh * vstride, T.O, h * 64, b * LCTX, NC + b * SEQ, 68, (char*)F.lds, F.wave); }
            else { const int q = u - 2048, b = q >> 4, h = q & 15, kvh = h >> kvshift;
                att64::attn_unit<8>(T.Q, T.qpitch, b * LCTX, h * 64, T.K, T.kpitch, kvh * kstride, T.V, T.vpitch, vbase + kvh * vstride, T.O, h * 64, b * LCTX, 0, 4, (char*)F.lds, F.wave); }
        }
        __syncthreads();
    } else {
        for (int u = vcu; u < 2048 + 128; u += F.G) {
            if (u < 2048) { const int b = u >> 8, h = (u >> 4) & 15, qb = u & 15, kvh = h >> kvshift;
                att96::attn_unit<8>(T.Q, T.qpitch, NC + b * SEQ + qb * 256, h * 96, T.K, T.kpitch, kvh * kstride, T.V, T.vpitch, vbase + kvh * vstride, T.O, h * 64, b * LCTX, NC + b * SEQ, 68, (char*)F.lds, F.wave); }
            else { const int q = u - 2048, b = q >> 4, h = q & 15, kvh = h >> kvshift;
                att96::attn_unit<8>(T.Q, T.qpitch, b * LCTX, h * 96, T.K, T.kpitch, kvh * kstride, T.V, T.vpitch, vbase + kvh * vstride, T.O, h * 64, b * LCTX, 0, 4, (char*)F.lds, F.wave); }
        }
        __syncthreads();
    }
}

constexpr int PH_PER_LAYER = 9, PH_TOTAL = 2 + DEPTH * PH_PER_LAYER;
__global__ void __launch_bounds__(512, 2) mk_fwd(Args args) {
    extern __shared__ __attribute__((aligned(16))) unsigned char lds_raw[];
    Frame F;
    F.lds = (LAS unsigned char*)lds_raw; F.ws = args.ws; F.ctl = (gu32*)(args.ws + WS_CTL);
    F.wave = __builtin_amdgcn_readfirstlane(threadIdx.x >> 6); F.G = gridDim.x;
    F.gw = blockIdx.x * 8 + F.wave; F.NGW = F.G * 8;
    if (threadIdx.x < 4) ((LAS unsigned*)(F.lds + LDS_XB))[threadIdx.x] = 0u;
    __syncthreads();
    const int lo = args.ph_lo, hi = args.ph_hi;
    const bool multi = (hi - lo) > 1;
    XcdBarrier bar; bar.bar = (unsigned*)(F.ctl + CW_BAR); bar.x = 0; bar.st = nullptr; bar.wave = F.wave;
    if (multi) bar = xcd_barrier_post((unsigned*)(F.ctl + CW_BAR), (volatile LAS unsigned*)(F.lds + LDS_XB), F.wave);
#define IN(k) (lo <= (k) && (k) < hi)
#define SEAM(k) do { if (IN(k) && IN((k) + 1)) xcd_barrier(bar); } while (0)
    unsigned char* ws0 = args.ws;
#define PH_WS size_t zofs_ = 0; asm volatile("" : "+s"(zofs_)); unsigned char* ws = ws0 + zofs_; F.ws = ws; F.ctl = (gu32*)ws;
    const int G = F.G, cidx = (int)blockIdx.x;

    if (IN(0) && EN(0)) { PH_WS REP(0) { prologue(F, args); SEAM(0); } }
    if (IN(1) && EN(1)) { PH_WS rp_norm1(F, args, 0, 0);
        quant_rows(F, (const bf16*)(ws + WS_WFIN), (unsigned char*)(ws + WS_W8), (float*)(ws + WS_SWP), 2 * 2048);
        quant_rows(F, (const bf16*)(ws + WS_WMIN), (unsigned char*)(ws + WS_W8) + 4 * MiB, (float*)(ws + WS_SWP) + 4096, MLA_IN_PAD);
        quant_rows(F, (const bf16*)(ws + WS_WGQKV), (unsigned char*)(ws + WS_W8) + 5 * MiB, (float*)(ws + WS_SWP) + 4864, GQA_QKV); SEAM(1); }

    for (int l = 0; l < DEPTH; ++l) {
        const int kind = l % 3, j = l / 3, base = 2 + l * PH_PER_LAYER;
        const bool lastl = (l == DEPTH - 1);

        size_t outB = 0;
        if (kind == 0) {
            if (IN(base + 0) && EN(2)) { PH_WS REP(2) { PolFP p; p.A = (const char*)(ws + WS_W8) + (size_t)j * 2048 * D; p.B = (const char*)(ws + WS_H); p.nt = 8; p.sW = (const float*)(ws + WS_SWP) + j * 2048; p.sH = (const float*)(ws + WS_SH); p.nN = lastl ? 128 : 136; p.G = G; p.c = cidx;
                p.Z = (bf16*)(ws + WS_RA); p.Zc = (bf16*)(ws + WS_RH); pg8::gemm_phase(F.lds, p, F.wave); } }
            SEAM(base + 0);
            if (IN(base + 1) && EN(3)) { PH_WS REP(3) { PolFA p; p.A = (const char*)(ws + WS_MA); p.B = (const char*)(ws + WS_RA); p.nt = 4; p.G = G; p.c = cidx; p.Y = (bf16*)(ws + WS_RB); pg8::gemm_phase(F.lds, p, F.wave); } }
            SEAM(base + 1);
            if (IN(base + 2) && EN(4)) { PH_WS REP(4) { PolFC p; p.A = (const char*)(ws + WS_DC); p.B = (const char*)(ws + WS_RB); p.nt = 8; p.G = G; p.c = cidx; p.nunits = lastl ? 512 : 544;
                p.offMC = (unsigned)(WS_MC - WS_DC); p.offZc = (unsigned)(WS_RH - WS_RB); p.F = (bf16*)(ws + WS_RC); pg8::gemm_phase(F.lds, p, F.wave); } }
            SEAM(base + 2);
            outB = WS_WFOUT + (size_t)j * D * D * 2;
        } else if (kind == 1) {
            if (IN(base + 0) && EN(5)) { PH_WS REP(5) { PolDenseI8 p; p.A = (const char*)(ws + WS_H); p.B = (const char*)(ws + WS_W8) + 4 * MiB; p.nt = 8; p.nM = NT / 256; p.nN = 3; p.pm0 = 0; p.G = G; p.c = cidx; p.sA = (const float*)(ws + WS_SH); p.sB = (const float*)(ws + WS_SWP) + 4096;
                p.O = (bf16*)(ws + WS_RE); p.ldo = MLA_IN_PAD; pg8::gemm_phase(F.lds, p, F.wave); } }
            SEAM(base + 0);
            if (IN(base + 1) && EN(6)) { PH_WS REP(6) { rp_mla(F, args); } }
            SEAM(base + 1);
            if (IN(base + 2)) { PH_WS REP(7) {
                if (EN(7)) { PolMlaQ p; p.A = (const char*)(ws + WS_RF); p.B = (const char*)(ws + WS_WMQB); p.nt = 6; p.nM = NT / 256; p.nN = 6; p.G = G; p.c = cidx; p.Q = (bf16*)(ws + WS_RA);
                  p.rope = (const float*)(ws + WS_ROPE); p.c2 = 0.10206207261596575f * LOG2E; pg8::gemm_phase(F.lds, p, F.wave); }
                if (EN(8)) { PolMlaKV p; p.A = (const char*)(ws + WS_RG); p.B = (const char*)(ws + WS_WMKVB); p.nt = 4; p.nM = NT / 256; p.nN = 8; p.G = G; p.c = cidx; p.Kb = (bf16*)(ws + WS_RB); p.Vb = (bf16*)(ws + WS_RD);
                  pg8::gemm_phase(F.lds, p, F.wave); }
            } }
            SEAM(base + 2);
            if (IN(base + 3) && EN(9)) { PH_WS REP(9) { att::Tens T{(const bf16*)(ws + WS_RA), 1536, (const bf16*)(ws + WS_RB), 1536, (const bf16*)(ws + WS_RD), 1024, (bf16*)(ws + WS_RC)}; attn_phase<96>(F, T, 0, 96, 64, 0); } }
            SEAM(base + 3);
            outB = WS_WMO;
        } else {
            if (IN(base + 0) && EN(10)) { PH_WS REP(10) { PolDenseI8 p; p.A = (const char*)(ws + WS_H); p.B = (const char*)(ws + WS_W8) + 5 * MiB; p.nt = 8; p.nM = NT / 256; p.nN = 6; p.pm0 = 0; p.G = G; p.c = cidx; p.sA = (const float*)(ws + WS_SH); p.sB = (const float*)(ws + WS_SWP) + 4864;
                p.O = (bf16*)(ws + WS_RA); p.ldo = GQA_QKV; pg8::gemm_phase(F.lds, p, F.wave); } }
            SEAM(base + 0);
            if (IN(base + 1) && EN(11)) { PH_WS REP(11) { rp_gqa(F, args); } }
            SEAM(base + 1);
            if (IN(base + 2) && EN(12)) { PH_WS REP(12) { att::Tens T{(const bf16*)(ws + WS_RB), 1024, (const bf16*)(ws + WS_RB) + (size_t)NT * 1024, 256, (const bf16*)(ws + WS_RA), 1536, (bf16*)(ws + WS_RC)}; attn_phase<64>(F, T, 2, 64, 64, 1280); } }
            SEAM(base + 2);
            outB = WS_WGO;
        }
        if (IN(base + 4) && EN(13)) { PH_WS PolOut p; p.A = (const char*)(ws + WS_RC); p.B = (const char*)(ws + outB); p.nt = 16; p.nM = lastl ? NL / 256 : NT / 256; p.nN = 4; p.pm0 = lastl ? 8 : 0; p.G = G; p.c = cidx; p.X = (bf16*)(ws + WS_X); p.mod = (const float*)(ws + WS_MOD) + (size_t)l * 9 * (NMOD * D); p.chunk = 2;
            p.XinC = (l == 0) ? args.in[2] : nullptr; p.XinL = (l == 0) ? args.in[0] - (size_t)NC * D : nullptr;
            pg8::gemm_phase(F.lds, p, F.wave); }
        SEAM(base + 4);
        if (IN(base + 5) && EN(14)) { PH_WS rp_norm2_router(F, args, l, lastl ? NC : 0); }
        SEAM(base + 5);
        if (IN(base + 6) && EN(15)) { PH_WS REP(15) { moe_table(F, l);
            PolMoe1 p; p.A = (const char*)(ws + WS_H); p.B = (const char*)(ws + WS_WGU) + (size_t)l * NE * 2048 * D; p.nt = 8; p.G = G; p.c = cidx;
            p.swgu = (const float*)(ws + WS_SWGU) + (size_t)l * NE * 2048; p.ssc = (const float*)(ws + WS_SSC);
            p.T.TT = (const LAS int*)(F.lds + LDS_TT); p.T.CN = p.T.TT + 64; p.T.TE = (const LAS int*)(F.lds + LDS_TE); p.stok = (const int*)(ws + WS_STOK); p.bgu = (const float*)(ws + WS_BGU) + (size_t)l * NE * 2048; p.act = (unsigned char*)(ws + WS_ACT);
            pg8::gemm_phase(F.lds, p, F.wave); } }
        SEAM(base + 6);
        if (IN(base + 7) && EN(16)) { PH_WS REP(16) { moe_table(F, l);
            PolMoe2 p; p.A = (const char*)(ws + WS_ACT); p.B = (const char*)(ws + WS_WDN) + (size_t)l * NE * D * DFF; p.nt = 8; p.G = G; p.c = cidx; p.swd = (const float*)(ws + WS_SWDN) + (size_t)l * NE * D;
            p.T.TT = (const LAS int*)(F.lds + LDS_TT); p.T.CN = p.T.TT + 64; p.T.TE = (const LAS int*)(F.lds + LDS_TE); p.sw = (const float*)(ws + WS_SW); p.bdn = args.in[26] + (size_t)l * NE * D; p.Y = (unsigned char*)(ws + WS_Y);
            pg8::gemm_phase(F.lds, p, F.wave); } }
        SEAM(base + 7);
        if (IN(base + 8) && EN(17)) { PH_WS moe_table(F, l); rp_combine(F, args, l, lastl ? NC : 0); }
        SEAM(base + 8);
    }
#undef PH_WS
#undef IN
#undef SEAM
}

extern "C" void kernel_launch(void* const* d_in, const int* in_sizes, int n_in, void* d_out, int out_size, void* d_ws, size_t ws_size, hipStream_t stream) {
    static int grid = 0;
    if (grid == 0) {
        if (n_in != 27 || out_size != NL * D || ws_size < WS_END) { fprintf(stderr, "kernel_launch: unexpected problem (n_in %d, out %d, ws %zu < %zu)\n", n_in, out_size, ws_size, (size_t)WS_END); grid = -1; return; }
        int dev = 0, cus = 0, per_cu = 0;
        if (hipGetDevice(&dev) != hipSuccess || hipDeviceGetAttribute(&cus, hipDeviceAttributeMultiprocessorCount, dev) != hipSuccess) { grid = -1; return; }
        if (hipFuncSetAttribute((const void*)mk_fwd, hipFuncAttributeMaxDynamicSharedMemorySize, LDS_BYTES) != hipSuccess) { fprintf(stderr, "kernel_launch: hipFuncSetAttribute failed\n"); grid = -1; return; }
        if (hipOccupancyMaxActiveBlocksPerMultiprocessor(&per_cu, (const void*)mk_fwd, 512, LDS_BYTES) != hipSuccess || per_cu < 1) fprintf(stderr, "kernel_launch: occupancy query says %d\n", per_cu);
        (void)hipGetLastError();
        grid = cus;
    }
    if (grid < 0) return;
    (void)hipMemsetAsync((char*)d_ws + WS_CTL, 0, CTL_ZERO_BYTES, stream);
    Args a{};
    for (int i = 0; i < 27; ++i) a.in[i] = (const float*)d_in[i];
    a.out = (float*)d_out; a.ws = (unsigned char*)d_ws;
#if MK_PER_PHASE
    for (int ph = 0; ph < PH_TOTAL; ++ph) {
        const int l = (ph - 2) / PH_PER_LAYER, s = (ph - 2) % PH_PER_LAYER, kind = l % 3;
        if (ph >= 2) { if (s == 3 && kind != 1) continue; }
        a.ph_lo = ph; a.ph_hi = ph + 1;
        hipLaunchKernelGGL(mk_fwd, dim3(grid), dim3(512), LDS_BYTES, stream, a);
    }
#else
    a.ph_lo = 0; a.ph_hi = PH_TOTAL;
    hipLaunchKernelGGL(mk_fwd, dim3(grid), dim3(512), LDS_BYTES, stream, a);
#endif
}
```

```cpp
#include <hip/hip_runtime.h>
#include <cstdio>
#include <cstdint>

#ifndef MK_PER_PHASE
#define MK_PER_PHASE 0
#endif
#ifndef MK_N2V2
#define MK_N2V2 1
#endif
#ifndef MK_CBV2
#define MK_CBV2 1
#endif
#ifndef MK_N2AGG
#define MK_N2AGG 1
#endif
#ifndef MK_MASK
#define MK_MASK 0xFFFFFFFFu
#endif
#define EN(id) (((MK_MASK) >> (id)) & 1u)
#ifndef MK_REPMASK
#define MK_REPMASK 0u
#endif
#define REP(id) for (int rep_ = 0; rep_ < ((((MK_REPMASK) >> (id)) & 1u) ? 2 : 1); ++rep_)

constexpr int D = 1024, NB = 8, SEQ = 4096, LCTX = 256, DEPTH = 4;
constexpr int NC = NB * LCTX;
constexpr int NL = NB * SEQ;
constexpr int NT = NC + NL;
constexpr int NMOD = 6, NE = 32, TOPK = 4, DFF = 1024;
constexpr int MLA_QL = 384, MLA_KVL = 256, MLA_ROPE = 32, MLA_NOPE = 64, MLA_V = 64, MLA_IN = 672, MLA_IN_PAD = 768, MLA_QD = 96;
constexpr int GQA_NQ = 1024, GQA_NKV = 256, GQA_QKV = 1536;
constexpr int CAP = NT;
constexpr int MAXTILES = 576;
constexpr float EPS = 1e-6f;
constexpr float LOG2E = 1.4426950408889634f;

constexpr size_t MiB = 1u << 20;
constexpr size_t WS_CTL = 0, CTL_ZERO_BYTES = 96 * 1024;
constexpr size_t WS_MOD = 1 * MiB;
constexpr size_t WS_ROPE = 2 * MiB;
constexpr size_t WS_WRT = 2 * MiB + 65536;
constexpr size_t WS_BGU = 3 * MiB;
constexpr size_t WS_MA = 4 * MiB;
constexpr size_t WS_DC = 4 * MiB + 262144;
constexpr size_t WS_MC = 5 * MiB;
constexpr size_t WS_WFIN = 9 * MiB;
constexpr size_t WS_WFOUT = 17 * MiB;
constexpr size_t WS_WMIN = 21 * MiB;
constexpr size_t WS_WMQB = 23 * MiB;
constexpr size_t WS_WMKVB = 25 * MiB;
constexpr size_t WS_WMO = 26 * MiB;
constexpr size_t WS_WGQKV = 28 * MiB;
constexpr size_t WS_WGO = 31 * MiB;
constexpr size_t WS_TE = 34 * MiB;
constexpr size_t WS_TRANK = 35 * MiB;
constexpr size_t WS_STOK = 36 * MiB;
constexpr size_t WS_SW = 41 * MiB;
constexpr size_t WS_X = 64 * MiB;
constexpr size_t WS_H = 200 * MiB;
constexpr size_t WS_RA = 272 * MiB;
constexpr size_t WS_RB = 400 * MiB;
constexpr size_t WS_RC = 528 * MiB;
constexpr size_t WS_RD = 600 * MiB;
constexpr size_t WS_RE = 672 * MiB;
constexpr size_t WS_RF = 728 * MiB;
constexpr size_t WS_RG = 756 * MiB;
constexpr size_t WS_RH = 776 * MiB;
constexpr size_t WS_ACT = 784 * MiB;
constexpr size_t WS_Y = 1072 * MiB;
constexpr size_t WS_WGU = 1360 * MiB;
constexpr size_t WS_SWGU = 1360 * MiB + 256 * MiB;
constexpr size_t WS_SH = 1360 * MiB + 259 * MiB;
constexpr size_t WS_SWP = 1360 * MiB + 259 * MiB + 256 * 1024;
constexpr size_t WS_W8 = 1360 * MiB + 266 * MiB;
constexpr size_t WS_SSC = 1360 * MiB + 260 * MiB;
constexpr size_t WS_WDN = 1872 * MiB;
constexpr size_t WS_SWDN = 1872 * MiB + 128 * MiB;
constexpr size_t WS_END = 2128 * MiB;
constexpr int CW_TMO = 0;
constexpr int CW_BAR = 4096;
constexpr int CW_CNT = 16384;

constexpr int RING_BYTES = 131072;
constexpr int LDS_MISC = 135168;
constexpr int LDS_TT = LDS_MISC;
constexpr int LDS_XB = LDS_MISC + 512;
constexpr int LDS_TE = LDS_MISC + 768;
constexpr int LDS_BYTES = 147456;

#define GAS __attribute__((address_space(1)))
#define LAS __attribute__((address_space(3)))
typedef unsigned short bf16;
typedef unsigned v4u __attribute__((ext_vector_type(4)));
typedef unsigned v2u __attribute__((ext_vector_type(2)));
typedef float f32x4 __attribute__((ext_vector_type(4)));
typedef float f32x2 __attribute__((ext_vector_type(2)));
typedef float f32x16 __attribute__((ext_vector_type(16)));
typedef short bf16x8 __attribute__((ext_vector_type(8)));
typedef short s16x4 __attribute__((ext_vector_type(4)));
typedef __bf16 bf16x2_t __attribute__((ext_vector_type(2)));
typedef GAS unsigned gu32;
#define RLX_AGENT __ATOMIC_RELAXED, __HIP_MEMORY_SCOPE_AGENT
#define LDS_WAIT() asm volatile("s_waitcnt lgkmcnt(0)" ::: "memory")
#define VM_WAIT() asm volatile("s_waitcnt vmcnt(0)" ::: "memory")
__device__ __forceinline__ unsigned pk2(float lo, float hi) { f32x2 v = {lo, hi}; bf16x2_t b = __builtin_convertvector(v, bf16x2_t); return __builtin_bit_cast(unsigned, b); }
__device__ __forceinline__ float bf_lo(unsigned u) { return __builtin_bit_cast(float, u << 16); }
__device__ __forceinline__ float bf_hi(unsigned u) { return __builtin_bit_cast(float, u & 0xffff0000u); }
__device__ __forceinline__ float shx(float v, int mask, int lane) { return __int_as_float(__builtin_amdgcn_ds_bpermute((lane ^ mask) << 2, __float_as_int(v))); }
__device__ __forceinline__ float wave_sum(float v, int lane) {
#pragma unroll
    for (int o = 1; o < 64; o <<= 1) v += shx(v, o, lane);
    return v;
}
__device__ __forceinline__ int lane_id_v() { int t; asm volatile("v_mbcnt_lo_u32_b32 %0, -1, 0\n\tv_mbcnt_hi_u32_b32 %0, -1, %0" : "=v"(t)); return t; }
__device__ __forceinline__ int launder_s(int x) { asm volatile("" : "+s"(x)); return x; }
__device__ __forceinline__ int lthread_w(int wave) { return wave * 64 + lane_id_v(); }
__device__ __forceinline__ int modrow_of(int row) { return row < NC ? NB : ((row - NC) >> 12); }

#define XB_TMO      128
#define XB_XCNT(j)  (256  + 64 * (j))
#define XB_XSUB(j)  (1280 + 64 * (j))
#define XB_XGEN(j)  (2304 + 64 * (j))
#define XB_TOP      3328
#define XB_TOPGEN   3392
#define XCD_BAR_WORDS 3456
#define XB_SPIN_CAP (1u << 18)
__device__ __forceinline__ unsigned xb_ld(unsigned* p)              { return __hip_atomic_load(p, __ATOMIC_RELAXED, __HIP_MEMORY_SCOPE_AGENT); }
__device__ __forceinline__ unsigned xb_add(unsigned* p, unsigned v) { return __hip_atomic_fetch_add(p, v, __ATOMIC_RELAXED, __HIP_MEMORY_SCOPE_AGENT); }
__device__ __forceinline__ unsigned xb_xcc_id() { return (unsigned)__builtin_amdgcn_s_getreg((3 << 11) | 20) & 0xFu; }
#define XB_SPIN(cond, bar) do { unsigned _sp = 0; while (cond) { __builtin_amdgcn_s_sleep(1); \
    if ((++_sp & 255u) == 0u) { if (xb_ld(&(bar)[XB_TMO])) break; if (_sp > XB_SPIN_CAP) { atomicAdd(&(bar)[XB_TMO], 1u); break; } } } } while (0)
struct XcdBarrier { unsigned* bar; unsigned x; volatile LAS unsigned* st; int wave; };
__device__ __forceinline__ bool xb_thread0(int wave) { return wave == 0 && lane_id_v() == 0; }
__device__ __forceinline__ XcdBarrier xcd_barrier_post(unsigned* bar, volatile LAS unsigned* st, int wave) {
    XcdBarrier b; b.bar = bar; b.x = xb_xcc_id(); b.st = st; b.wave = wave;
    if (xb_thread0(wave)) (void)xb_add(&bar[XB_XCNT(b.x)], 1u);
    return b;
}
__device__ __forceinline__ void xcd_barrier_complete(unsigned* bar, unsigned x, unsigned& nloc, unsigned& nx) {
    const unsigned G = gridDim.x * gridDim.y * gridDim.z;
    unsigned sum, cnt, mine, sp = 0u;
    for (;;) {
        sum = 0u; cnt = 0u; mine = 0u;
#pragma unroll
        for (unsigned j = 0; j < 16; ++j) { const unsigned c = xb_ld(&bar[XB_XCNT(j)]); sum += c; cnt += (c > 0u) ? 1u : 0u; mine = (j == x) ? c : mine; }
        if (sum == G) break;
        __builtin_amdgcn_s_sleep(1);
        if ((++sp & 255u) == 0u) { if (xb_ld(&bar[XB_TMO])) break; if (sp > XB_SPIN_CAP) { atomicAdd(&bar[XB_TMO], 1u); break; } }
    }
    nloc = mine > 0u ? mine : 1u; nx = cnt > 0u ? cnt : 1u;
}
__device__ __forceinline__ void xcd_barrier(const XcdBarrier& b) {
    asm volatile("s_waitcnt vmcnt(0)" ::: "memory");
    __syncthreads();
    if (xb_thread0(b.wave)) {
        unsigned* bar = b.bar;
        __builtin_amdgcn_s_waitcnt(0);
        unsigned nloc = b.st[0], nx = b.st[1];
        if (nloc == 0u) { xcd_barrier_complete(bar, b.x, nloc, nx); b.st[0] = nloc; b.st[1] = nx; }
        const unsigned old = xb_add(&bar[XB_XSUB(b.x)], 1u);
        const unsigned gen = old / nloc;
        if (old + 1u == (gen + 1u) * nloc) {
            __builtin_amdgcn_fence(__ATOMIC_RELEASE, "agent");
            asm volatile("s_waitcnt vmcnt(0)" ::: "memory");
            const unsigned og = xb_add(&bar[XB_TOP], 1u);
            const unsigned tg = og / nx;
            if (og + 1u == (tg + 1u) * nx) xb_add(&bar[XB_TOPGEN], 1u);
            else XB_SPIN(xb_ld(&bar[XB_TOPGEN]) == tg, bar);
            __builtin_amdgcn_fence(__ATOMIC_ACQUIRE, "agent");
            xb_add(&bar[XB_XGEN(b.x)], 1u);
            asm volatile("s_waitcnt vmcnt(0)" ::: "memory");
        } else {
            XB_SPIN(xb_ld(&bar[XB_XGEN(b.x)]) == gen, bar);
            __builtin_amdgcn_fence(__ATOMIC_ACQUIRE, "agent");
            asm volatile("s_waitcnt vmcnt(0)" ::: "memory");
        }
    }
    __syncthreads();
}

namespace pg8 {
#define PG8_LAS __attribute__((address_space(3)))
constexpr int BM = 256, BK = 64, HALF = 128, HTB = HALF * BK * 2, STAGE_BYTES = 8 * HTB, NXCD = 8, WGM = 8;
__device__ __forceinline__ int lds_byte(int r, int c) { const int st = (r >> 4) * 2 + (c >> 5), rr = r & 15, cc = c & 31, ob = rr * 64 + cc * 2; return st * 1024 + (ob ^ (((ob >> 9) & 1) << 5)); }
__device__ __forceinline__ void stage_rc(int b, int& R, int& C) { const int st = b / 1024, sb = b % 1024, swz = sb ^ (((sb >> 9) & 1) << 5); R = (st >> 1) * 16 + swz / 64; C = (st & 1) * 32 + (swz % 64) / 2; }
__device__ __forceinline__ int perm32(int rho) { const int n = rho >> 4, i = rho & 15; return 8 * (i >> 2) + 4 * n + (i & 3); }
struct Unit { int pm, pn, aux; };
typedef f32x4 Acc[2][2][4][2];
typedef int i32x4 __attribute__((ext_vector_type(4)));
typedef i32x4 AccI[2][2][4][2];
template <bool I8> struct AccSel { typedef f32x4 T; };
template <> struct AccSel<true> { typedef i32x4 T; };
__device__ __forceinline__ f32x4 mma1(bf16x8 b, bf16x8 a, f32x4 c) { return __builtin_amdgcn_mfma_f32_16x16x32_bf16(b, a, c, 0, 0, 0); }
typedef int i32x8 __attribute__((ext_vector_type(8)));
typedef short bf16x16 __attribute__((ext_vector_type(16)));
__device__ __forceinline__ f32x4 mma_f8(bf16x8 b0, bf16x8 b1, bf16x8 a0, bf16x8 a1, f32x4 c) {
    const i32x8 B = __builtin_bit_cast(i32x8, __builtin_shufflevector(b0, b1, 0, 1, 2, 3, 4, 5, 6, 7, 8, 9, 10, 11, 12, 13, 14, 15));
    const i32x8 A = __builtin_bit_cast(i32x8, __builtin_shufflevector(a0, a1, 0, 1, 2, 3, 4, 5, 6, 7, 8, 9, 10, 11, 12, 13, 14, 15));
    return __builtin_amdgcn_mfma_scale_f32_16x16x128_f8f6f4(B, A, c, 0, 0, 0, 0, 0, 0); }
__device__ __forceinline__ i32x4 mma1(bf16x8 b, bf16x8 a, i32x4 c) { return __builtin_amdgcn_mfma_i32_16x16x64_i8(__builtin_bit_cast(i32x4, b), __builtin_bit_cast(i32x4, a), c, 0, 0, 0); }

__device__ __forceinline__ bool static_next(int i, int G, int c, int nM, int nN, int& pm, int& pn) {
    const int nwg = nM * nN; const long L = (long)i * G + c; if (L >= nwg) return false;
    int wgid = (int)L; { const int q = nwg / NXCD, r = nwg % NXCD, xcd = wgid % NXCD, off = wgid / NXCD; wgid = (xcd < r ? xcd * (q + 1) : r * (q + 1) + (xcd - r) * q) + off; }
    const int nig = WGM * nN, gid = wgid / nig, fm = gid * WGM, gsz = (nM - fm) < WGM ? (nM - fm) : WGM;
    pm = fm + ((wgid % nig) % gsz); pn = (wgid % nig) / gsz; return true;
}

template <class P>
__device__ __forceinline__ void gemm_phase(PG8_LAS unsigned char* lds, const P& p, int wave_id) {
    wave_id = launder_s(wave_id); int tid_l = lthread_w(wave_id);
    const int tid = tid_l, wid = wave_id, lane = tid & 63, wr = wid >> 2, wc = wid & 3, fr = lane & 15, fq = lane >> 4;
    const int nt = p.nt;
    const unsigned ldsw = (unsigned)wid * 1024u;
    const int aoff = lds_byte(wr * 64 + fr, fq * 8), boff = lds_byte(wc * 32 + fr, fq * 8);
    const char* const gA = p.A; const char* const gB = p.B;
#define PG8_SA(b, h) (((b) * 2 + (h)) * HTB)
#define PG8_SB(b, h) ((4 + (b) * 2 + (h)) * HTB)
#define PG8_STAGE(bufoff, gbase, off2, kofs) do { _Pragma("unroll") for (int _i = 0; _i < 2; ++_i) \
        __builtin_amdgcn_global_load_lds((const unsigned*)((gbase) + (size_t)(off2)[_i] + (size_t)(kofs)), (PG8_LAS unsigned*)(lds + (bufoff) + ldsw + _i * 8192), 16, 0, 0); } while (0)
#define PG8_LDA(dst, b, h) do { _Pragma("unroll") for (int m = 0; m < 4; ++m) _Pragma("unroll") for (int k = 0; k < 2; ++k) dst[m][k] = *(const PG8_LAS bf16x8*)(lds + PG8_SA(b, h) + aoff + m * 2048 + k * 1024); } while (0)
#define PG8_LDB(dst, b, h) do { _Pragma("unroll") for (int n = 0; n < 2; ++n) _Pragma("unroll") for (int k = 0; k < 2; ++k) dst[n][k] = *(const PG8_LAS bf16x8*)(lds + PG8_SB(b, h) + boff + n * 2048 + k * 1024); } while (0)
#define PG8_MMA(ai, bj, At, Bt) do { __builtin_amdgcn_s_setprio(1); _Pragma("unroll") for (int m = 0; m < 4; ++m) _Pragma("unroll") for (int n = 0; n < 2; ++n) { \
        if constexpr (P::F8) acc[ai][bj][m][n] = mma_f8(Bt[n][0], Bt[n][1], At[m][0], At[m][1], acc[ai][bj][m][n]); \
        else { _Pragma("unroll") for (int k = 0; k < 2; ++k) acc[ai][bj][m][n] = mma1(Bt[n][k], At[m][k], acc[ai][bj][m][n]); } } __builtin_amdgcn_s_setprio(0); } while (0)
#define PG8_WAIT_V(n) asm volatile("s_waitcnt vmcnt(" #n ")" ::: "memory")
#define PG8_WAIT_L(n) asm volatile("s_waitcnt lgkmcnt(" #n ")" ::: "memory")
#define PG8_BAR __builtin_amdgcn_s_barrier()
#define PG8_SCHED __builtin_amdgcn_sched_barrier(0)
#define PG8_KEYS(u) do { if (P::KEYS && wid < 4) __builtin_amdgcn_global_load_lds((const unsigned*)p.key_ptr(u, wid * 64 + lane_id_v()), (PG8_LAS unsigned*)(keybuf + wid * 256), 4, 0, 0); } while (0)
#define PG8_OFFS(u, oA, oB) do { const int tid2_ = wid * 64 + lane_id_v();     \
    _Pragma("unroll") for (int _i = 0; _i < 2; ++_i) { int R_, C_; stage_rc(tid2_ * 16 + _i * 8192, R_, C_); const int Rb_ = P::PERM ? ((R_ & ~31) + perm32(R_ & 31)) : R_; \
      _Pragma("unroll") for (int _h = 0; _h < 2; ++_h) { \
        const int key_ = P::KEYS ? ((const PG8_LAS int*)keybuf)[_h * HALF + R_] : 0; \
        oA[_h][_i] = p.a_row(u, _h * HALF + R_, key_) + (unsigned)(C_ * 2); oB[_h][_i] = p.b_row(u, _h * HALF + Rb_) + (unsigned)(C_ * 2); } } } while (0)
    PG8_LAS unsigned char* const keybuf = lds + STAGE_BYTES;
    Unit cur, nxt; int ui = 0;
    if (!p.next(0, cur)) return;
    typedef typename AccSel<P::I8>::T AccT;
    AccT acc[2][2][4][2];
#pragma unroll
    for (int a = 0; a < 2; ++a)
#pragma unroll
        for (int b = 0; b < 2; ++b)
#pragma unroll
            for (int m = 0; m < 4; ++m)
#pragma unroll
                for (int n = 0; n < 2; ++n) acc[a][b][m][n] = (AccT){0, 0, 0, 0};
    bf16x8 At[4][2], B0[2][2], B1[2][2];
    unsigned oAc[2][2], oBc[2][2];
    if (P::KEYS) { PG8_KEYS(cur); PG8_WAIT_V(0); PG8_BAR; }
    PG8_OFFS(cur, oAc, oBc);
    PG8_STAGE(PG8_SB(0, 0), gB, oBc[0], 0); PG8_STAGE(PG8_SB(0, 1), gB, oBc[1], 0); PG8_STAGE(PG8_SA(0, 0), gA, oAc[0], 0); PG8_STAGE(PG8_SA(0, 1), gA, oAc[1], 0);
    if (wr == 1) PG8_BAR;
    PG8_WAIT_V(2); PG8_BAR;
    PG8_STAGE(PG8_SB(1, 0), gB, oBc[0], 128); PG8_STAGE(PG8_SA(1, 0), gA, oAc[0], 128); PG8_STAGE(PG8_SB(1, 1), gB, oBc[1], 128);
    PG8_WAIT_V(6); PG8_BAR;
    for (;;) {
        const bool has_next = p.next(ui + 1, nxt);
        if (has_next) { PG8_KEYS(nxt); }
        for (int t = 0; t < nt; t += 2) {
            const bool last = (t == nt - 2);
            const unsigned k1 = (unsigned)(t + 1) * 128u;
            const unsigned k2 = last ? 0u : (unsigned)(t + 2) * 128u, k3 = k2 + 128u;
            PG8_LDB(B0, 0, 0); PG8_LDB(B1, 0, 1); PG8_SCHED; PG8_LDA(At, 0, 0); PG8_STAGE(PG8_SA(1, 1), gA, oAc[1], k1);
            if (last && has_next) { PG8_OFFS(nxt, oAc, oBc); }
            PG8_WAIT_V(8); PG8_WAIT_L(0); PG8_BAR; PG8_MMA(0, 0, At, B0); PG8_MMA(0, 1, At, B1); PG8_BAR; PG8_SCHED;
            PG8_LDA(At, 0, 1); PG8_STAGE(PG8_SB(0, 0), gB, oBc[0], k2); PG8_STAGE(PG8_SB(0, 1), gB, oBc[1], k2); PG8_STAGE(PG8_SA(0, 0), gA, oAc[0], k2);
            PG8_WAIT_V(8); PG8_WAIT_L(0); PG8_BAR; PG8_MMA(1, 0, At, B0); PG8_MMA(1, 1, At, B1); PG8_BAR; PG8_SCHED;
            PG8_LDB(B0, 1, 0); PG8_LDB(B1, 1, 1); PG8_SCHED; PG8_LDA(At, 1, 0); PG8_STAGE(PG8_SA(0, 1), gA, oAc[1], k2);
            PG8_WAIT_V(8); PG8_WAIT_L(0); PG8_BAR; PG8_MMA(0, 0, At, B0); PG8_MMA(0, 1, At, B1); PG8_BAR; PG8_SCHED;
            PG8_LDA(At, 1, 1); PG8_STAGE(PG8_SB(1, 0), gB, oBc[0], k3); PG8_STAGE(PG8_SB(1, 1), gB, oBc[1], k3); PG8_STAGE(PG8_SA(1, 0), gA, oAc[0], k3);
            PG8_WAIT_V(8); PG8_WAIT_L(0); PG8_BAR; PG8_MMA(1, 0, At, B0); PG8_MMA(1, 1, At, B1); PG8_BAR; PG8_SCHED;
        }
        if (wr == 0) PG8_BAR;
        { const int le_ = lane_id_v(); int fr_e = le_ & 15, fq_e = le_ >> 4;
          p.epi(acc, cur, wr, wc, fr_e, fq_e); }
        if (!has_next) break;
#pragma unroll
        for (int a = 0; a < 2; ++a)
#pragma unroll
            for (int b = 0; b < 2; ++b)
#pragma unroll
                for (int m = 0; m < 4; ++m)
#pragma unroll
                    for (int n = 0; n < 2; ++n) acc[a][b][m][n] = (AccT){0, 0, 0, 0};
        cur = nxt; ++ui;
        if (wr == 1) PG8_BAR;
    }
    PG8_WAIT_V(0);
    PG8_BAR;
#undef PG8_SA
#undef PG8_SB
#undef PG8_STAGE
#undef PG8_LDA
#undef PG8_LDB
#undef PG8_MMA
#undef PG8_WAIT_V
#undef PG8_WAIT_L
#undef PG8_BAR
#undef PG8_SCHED
#undef PG8_OFFS
#undef PG8_KEYS
}
}
using pg8::Unit;

#define TROW(ai, wr, m, fr) (128 * (ai) + 64 * (wr) + 16 * (m) + (fr))
#define TCOLP(bj, wc, fq) (128 * (bj) + 32 * (wc) + 8 * (fq))
#define TCOLN(bj, wc, n, fq) (128 * (bj) + 32 * (wc) + 16 * (n) + 4 * (fq))
__device__ __forceinline__ v4u pack8(const f32x4 a, const f32x4 b) { v4u w; w.x = pk2(a[0], a[1]); w.y = pk2(a[2], a[3]); w.z = pk2(b[0], b[1]); w.w = pk2(b[2], b[3]); return w; }

struct PolDenseBf16 {
    static constexpr bool PERM = true;
    static constexpr bool KEYS = false;
    static constexpr bool I8 = false;
    static constexpr bool F8 = false;
    __device__ __forceinline__ const int* key_ptr(const Unit&, int) const { return nullptr; }
    const char* A; const char* B; int nt; int nM, nN, pm0, G, c; unsigned pitchA, pitchB; bf16* O; int ldo;
    __device__ __forceinline__ bool next(int i, Unit& u) const { int pm, pn; if (!pg8::static_next(i, G, c, nM, nN, pm, pn)) return false; u.pm = pm + pm0; u.pn = pn; u.aux = 0; return true; }
    __device__ __forceinline__ unsigned a_row(const Unit& u, int r, int) const { return (unsigned)(u.pm * 256 + r) * pitchA; }
    __device__ __forceinline__ unsigned b_row(const Unit& u, int r) const { return (unsigned)(u.pn * 256 + r) * pitchB; }
    __device__ __forceinline__ void epi(const pg8::Acc& acc, const Unit& u, int wr, int wc, int fr, int fq) const {
#pragma unroll
        for (int ai = 0; ai < 2; ++ai)
#pragma unroll
            for (int m = 0; m < 4; ++m) { const size_t row = (size_t)u.pm * 256 + TROW(ai, wr, m, fr);
#pragma unroll
                for (int bj = 0; bj < 2; ++bj) { const int col = u.pn * 256 + TCOLP(bj, wc, fq); *(v4u*)(O + row * ldo + col) = pack8(acc[ai][bj][m][0], acc[ai][bj][m][1]); } }
    }
};

struct PolDenseI8 {
    static constexpr bool PERM = true;
    static constexpr bool KEYS = false;
    static constexpr bool I8 = true;
    static constexpr bool F8 = false;
    __device__ __forceinline__ const int* key_ptr(const Unit&, int) const { return nullptr; }
    const char* A; const char* B; int nt; int nM, nN, pm0, G, c; const float* sA; const float* sB; bf16* O; int ldo;
    __device__ __forceinline__ bool next(int i, Unit& u) const { int pm, pn; if (!pg8::static_next(i, G, c, nM, nN, pm, pn)) return false; u.pm = pm + pm0; u.pn = pn; u.aux = 0; return true; }
    __device__ __forceinline__ unsigned a_row(const Unit& u, int r, int) const { return (unsigned)(u.pm * 256 + r) * 1024u; }
    __device__ __forceinline__ unsigned b_row(const Unit& u, int r) const { return (unsigned)(u.pn * 256 + r) * 1024u; }
    __device__ __forceinline__ void epi(const pg8::AccI& acc, const Unit& u, int wr, int wc, int fr, int fq) const {
#pragma unroll
        for (int bj = 0; bj < 2; ++bj) { const int col = u.pn * 256 + TCOLP(bj, wc, fq); const f32x4 s0 = *(const f32x4*)(sB + col), s1 = *(const f32x4*)(sB + col + 4);
#pragma unroll
            for (int ai = 0; ai < 2; ++ai)
#pragma unroll
                for (int m = 0; m < 4; ++m) { const size_t row = (size_t)u.pm * 256 + TROW(ai, wr, m, fr); const float sa = sA[row]; f32x4 v0, v1;
#pragma unroll
                    for (int q = 0; q < 4; ++q) { v0[q] = (float)acc[ai][bj][m][0][q] * (sa * s0[q]); v1[q] = (float)acc[ai][bj][m][1][q] * (sa * s1[q]); }
                    *(v4u*)(O + row * ldo + col) = pack8(v0, v1); } }
    }
};

struct PolOut {
    static constexpr bool PERM = true;
    static constexpr bool KEYS = false;
    static constexpr bool I8 = false;
    static constexpr bool F8 = false;
    __device__ __forceinline__ const int* key_ptr(const Unit&, int) const { return nullptr; }
    const char* A; const char* B; int nt; int nM, nN, pm0, G, c; bf16* X; const float* mod;
    int chunk; const float* XinC; const float* XinL;
    __device__ __forceinline__ bool next(int i, Unit& u) const { int pm, pn; if (!pg8::static_next(i, G, c, nM, nN, pm, pn)) return false; u.pm = pm + pm0; u.pn = pn; u.aux = 0; return true; }
    __device__ __forceinline__ unsigned a_row(const Unit& u, int r, int) const { return (unsigned)(u.pm * 256 + r) * 2048u; }
    __device__ __forceinline__ unsigned b_row(const Unit& u, int r) const { return (unsigned)(u.pn * 256 + r) * 2048u; }
    __device__ __forceinline__ void epi(const pg8::Acc& acc, const Unit& u, int wr, int wc, int fr, int fq) const {
        const int mr = modrow_of(u.pm * 256);
        const float* g = mod + (size_t)mr * (NMOD * D) + chunk * D;
        const float* xin = XinC ? (u.pm < 8 ? XinC : XinL) : nullptr;
#pragma unroll
        for (int bj = 0; bj < 2; ++bj) { const int col = u.pn * 256 + TCOLP(bj, wc, fq); const f32x4 g0 = *(const f32x4*)(g + col), g1 = *(const f32x4*)(g + col + 4);
#pragma unroll
            for (int ai = 0; ai < 2; ++ai)
#pragma unroll
                for (int m = 0; m < 4; ++m) { const size_t off = ((size_t)u.pm * 256 + TROW(ai, wr, m, fr)) * D + col; f32x4 x0, x1;
                    if (xin) { x0 = *(const f32x4*)(xin + off); x1 = *(const f32x4*)(xin + off + 4); }
                    else { const v4u w = *(const v4u*)(X + off); x0 = (f32x4){bf_lo(w.x), bf_hi(w.x), bf_lo(w.y), bf_hi(w.y)}; x1 = (f32x4){bf_lo(w.z), bf_hi(w.z), bf_lo(w[3]), bf_hi(w[3])}; }
                    *(v4u*)(X + off) = pack8(x0 + g0 * acc[ai][bj][m][0], x1 + g1 * acc[ai][bj][m][1]); } }
    }
};

struct PolFP {
    static constexpr bool PERM = true;
    static constexpr bool KEYS = false;
    static constexpr bool I8 = true;
    static constexpr bool F8 = false;
    __device__ __forceinline__ const int* key_ptr(const Unit&, int) const { return nullptr; }
    const char* A; const char* B; int nt; int nN, G, c; const float* sW; const float* sH; bf16* Z; bf16* Zc;
    __device__ __forceinline__ bool next(int i, Unit& u) const { int pm, pn; if (!pg8::static_next(i, G, c, 8, nN, pm, pn)) return false; u.pm = pm; u.pn = pn; u.aux = 0; return true; }
    __device__ __forceinline__ unsigned a_row(const Unit& u, int r, int) const { return (unsigned)(u.pm * 256 + r) * 1024u; }
    __device__ __forceinline__ int tok_row(int pn, int n) const { if (pn < 128) { const int b = n >> 12, l2 = (n >> 6) & 63, l1 = n & 63; return NC + b * SEQ + 64 * l1 + l2; } return n - 32768; }
    __device__ __forceinline__ unsigned b_row(const Unit& u, int r) const { return (unsigned)tok_row(u.pn, u.pn * 256 + r) * 1024u; }
    __device__ __forceinline__ void epi(const pg8::AccI& acc, const Unit& u, int wr, int wc, int fr, int fq) const {
#pragma unroll
        for (int bj = 0; bj < 2; ++bj) { const int n0 = u.pn * 256 + TCOLP(bj, wc, fq);
            f32x4 h0, h1;
#pragma unroll
            for (int q = 0; q < 4; ++q) { h0[q] = sH[tok_row(u.pn, n0 + q)]; h1[q] = sH[tok_row(u.pn, n0 + 4 + q)]; }
#pragma unroll
            for (int ai = 0; ai < 2; ++ai)
#pragma unroll
                for (int m = 0; m < 4; ++m) { const int cp = u.pm * 256 + TROW(ai, wr, m, fr); const float sw = sW[cp]; f32x4 v0, v1;
#pragma unroll
                    for (int q = 0; q < 4; ++q) { v0[q] = (float)acc[ai][bj][m][0][q] * (sw * h0[q]); v1[q] = (float)acc[ai][bj][m][1][q] * (sw * h1[q]); }
                    const v4u w = pack8(v0, v1);
                    if (u.pn < 128) *(v4u*)(Z + ((size_t)(n0 >> 6) * 2048 + cp) * 64 + (n0 & 63)) = w;
                    else { const int b = u.pn - 128, l = n0 - 32768 - b * 256; *(v4u*)(Zc + ((size_t)b * 2048 + cp) * 256 + l) = w; } } }
    }
};

struct PolFA {
    static constexpr bool PERM = true;
    static constexpr bool KEYS = false;
    static constexpr bool I8 = false;
    static constexpr bool F8 = false;
    __device__ __forceinline__ const int* key_ptr(const Unit&, int) const { return nullptr; }
    const char* A; const char* B; int nt; int G, c; bf16* Y;
    __device__ __forceinline__ bool next(int i, Unit& u) const { const int L = i * G + c; if (L >= 1024) return false; u.pm = 0; u.pn = L & 127; u.aux = L >> 7; return true; }
    __device__ __forceinline__ unsigned a_row(const Unit&, int r, int) const { return (unsigned)r * 512u; }
    __device__ __forceinline__ unsigned b_row(const Unit& u, int r) const { const int l2 = r & 63, cp = u.pn * 4 + (r >> 6); return (unsigned)((u.aux * 64 + l2) * 512 + cp) * 512u; }
    __device__ __forceinline__ void epi(const pg8::Acc& acc, const Unit& u, int wr, int wc, int fr, int fq) const {
        const int b = u.aux;
#pragma unroll
        for (int ai = 0; ai < 2; ++ai)
#pragma unroll
            for (int m = 0; m < 4; ++m) { const int rr = TROW(ai, wr, m, fr), jp = rr >> 7, pp = (rr >> 6) & 1, k1 = rr & 63;
#pragma unroll
                for (int bj = 0; bj < 2; ++bj) { const int n0 = u.pn * 256 + TCOLP(bj, wc, fq), cp = n0 >> 6, l2 = n0 & 63, cc = 2 * cp + jp;
                    const size_t idx = ((((size_t)(b * 16 + (k1 >> 2)) * 1024 + cc) * 4 + (k1 & 3)) * 2 + pp) * 64 + l2;
                    *(v4u*)(Y + idx) = pack8(acc[ai][bj][m][0], acc[ai][bj][m][1]); } }
    }
};

struct PolFC {
    static constexpr bool PERM = true;
    static constexpr bool KEYS = false;
    static constexpr bool I8 = false;
    static constexpr bool F8 = false;
    __device__ __forceinline__ const int* key_ptr(const Unit&, int) const { return nullptr; }
    const char* A; const char* B; int nt; int G, c; int nunits; unsigned offMC, offZc; bf16* F;
    __device__ __forceinline__ bool next(int i, Unit& u) const { const int L = i * G + c; if (L >= nunits) return false;
        if (L < 512) { u.pm = 0; u.pn = L & 3; u.aux = L >> 2; } else { const int q = L - 512; u.pm = 0; u.pn = q & 3; u.aux = 256 + (q >> 2); } return true; }
    __device__ __forceinline__ unsigned a_row(const Unit& u, int r, int) const {
        if (u.aux < 256) return offMC + (unsigned)((u.aux & 15) * 256 + r) * 1024u;
        return (unsigned)r * 1024u; }
    __device__ __forceinline__ unsigned b_row(const Unit& u, int r) const {
        if (u.aux < 256) return (unsigned)(u.aux * 1024 + u.pn * 256 + r) * 1024u;
        return offZc + (unsigned)((u.aux - 256) * 1024 + u.pn * 256 + r) * 1024u; }
    __device__ __forceinline__ void epi(const pg8::Acc& acc, const Unit& u, int wr, int wc, int fr, int fq) const {
#pragma unroll
        for (int ai = 0; ai < 2; ++ai)
#pragma unroll
            for (int m = 0; m < 4; ++m) { const int rr = TROW(ai, wr, m, fr); size_t frow;
                if (u.aux < 256) { const int b = u.aux >> 4, kq = u.aux & 15, k = 4 * kq + (rr >> 6) + 64 * (rr & 63); frow = (size_t)NC + b * SEQ + k; }
                else frow = (size_t)(u.aux - 256) * LCTX + rr;
#pragma unroll
                for (int bj = 0; bj < 2; ++bj) { const int col = u.pn * 256 + TCOLP(bj, wc, fq); *(v4u*)(F + frow * D + col) = pack8(acc[ai][bj][m][0], acc[ai][bj][m][1]); } }
    }
};

struct PolMlaQ {
    static constexpr bool PERM = true;
    static constexpr bool KEYS = false;
    static constexpr bool I8 = false;
    static constexpr bool F8 = false;
    __device__ __forceinline__ const int* key_ptr(const Unit&, int) const { return nullptr; }
    const char* A; const char* B; int nt; int nM, nN, G, c; bf16* Q; const float* rope; float c2;
    __device__ __forceinline__ bool next(int i, Unit& u) const { int pm, pn; if (!pg8::static_next(i, G, c, nM, nN, pm, pn)) return false; u.pm = pm; u.pn = pn; u.aux = 0; return true; }
    __device__ __forceinline__ unsigned a_row(const Unit& u, int r, int) const { return (unsigned)(u.pm * 256 + r) * (unsigned)(MLA_QL * 2); }
    __device__ __forceinline__ unsigned b_row(const Unit& u, int r) const { return (unsigned)(u.pn * 256 + r) * (unsigned)(MLA_QL * 2); }
    __device__ __forceinline__ void epi(const pg8::Acc& acc, const Unit& u, int wr, int wc, int fr, int fq) const {
        const bool lat = u.pm >= 8;
#pragma unroll
        for (int bj = 0; bj < 2; ++bj) { const int col = u.pn * 256 + TCOLP(bj, wc, fq); const bool isrope = lat && (((col >> 5) % 3) == 2);
#pragma unroll
            for (int ai = 0; ai < 2; ++ai)
#pragma unroll
                for (int m = 0; m < 4; ++m) { const int row = u.pm * 256 + TROW(ai, wr, m, fr); f32x4 v0 = acc[ai][bj][m][0], v1 = acc[ai][bj][m][1];
                    if (isrope) { const int t = (row - NC) & 4095, pos = (fq & 2) ? (t & 63) : (t >> 6);
                        const f32x4* rp = (const f32x4*)(rope + (size_t)pos * 16);
                        const f32x4 r0 = rp[0], r1 = rp[1], r2 = rp[2], r3 = rp[3];
                        f32x4 p0, p1;
#pragma unroll
                        for (int e = 0; e < 4; ++e) { p0[e] = shx(v0[e], 16, fq * 16 + fr); p1[e] = shx(v1[e], 16, fq * 16 + fr); }
                        const float sg = (fq & 1) ? 1.f : -1.f;
                        v0[0] = v0[0] * r0[0] + sg * p0[0] * r0[1]; v0[1] = v0[1] * r0[2] + sg * p0[1] * r0[3];
                        v0[2] = v0[2] * r1[0] + sg * p0[2] * r1[1]; v0[3] = v0[3] * r1[2] + sg * p0[3] * r1[3];
                        v1[0] = v1[0] * r2[0] + sg * p1[0] * r2[1]; v1[1] = v1[1] * r2[2] + sg * p1[1] * r2[3];
                        v1[2] = v1[2] * r3[0] + sg * p1[2] * r3[1]; v1[3] = v1[3] * r3[2] + sg * p1[3] * r3[3]; }
                    *(v4u*)(Q + (size_t)row * 1536 + col) = pack8(v0 * c2, v1 * c2); } }
    }
};

struct PolMlaKV {
    static constexpr bool PERM = true;
    static constexpr bool KEYS = false;
    static constexpr bool I8 = false;
    static constexpr bool F8 = false;
    __device__ __forceinline__ const int* key_ptr(const Unit&, int) const { return nullptr; }
    const char* A; const char* B; int nt; int nM, nN, G, c; bf16* Kb; bf16* Vb;
    __device__ __forceinline__ bool next(int i, Unit& u) const { int pm, pn; if (!pg8::static_next(i, G, c, nM, nN, pm, pn)) return false; u.pm = pm; u.pn = pn; u.aux = 0; return true; }
    __device__ __forceinline__ unsigned a_row(const Unit& u, int r, int) const { return (unsigned)(u.pm * 256 + r) * 512u; }
    __device__ __forceinline__ unsigned b_row(const Unit& u, int r) const { return (unsigned)(u.pn * 256 + r) * 512u; }
    __device__ __forceinline__ void epi(const pg8::Acc& acc, const Unit& u, int wr, int wc, int fr, int fq) const {
#pragma unroll
        for (int bj = 0; bj < 2; ++bj) { const int col = u.pn * 256 + TCOLP(bj, wc, fq), h = col >> 7, j = col & 127;
#pragma unroll
            for (int ai = 0; ai < 2; ++ai)
#pragma unroll
                for (int m = 0; m < 4; ++m) { const size_t row = (size_t)u.pm * 256 + TROW(ai, wr, m, fr); const v4u w = pack8(acc[ai][bj][m][0], acc[ai][bj][m][1]);
                    if (j < 64) *(v4u*)(Kb + row * 1536 + 96 * h + j) = w; else *(v4u*)(Vb + row * 1024 + 64 * h + (j - 64)) = w; } }
    }
};

struct MoeTab { const LAS int* TT; const LAS int* CN; const LAS int* TE; };
__device__ __forceinline__ bool moe_next(int i, int G, int c, int NP, const MoeTab& T, Unit& u) {
    const int ttot = T.TT[32];
    int lo, hi, j;
    if ((G & 7) == 0) { const int x = c & 7, q = c >> 3, g8 = G >> 3; lo = (x * ttot) >> 3; hi = ((x + 1) * ttot) >> 3; j = i * g8 + q; }
    else { lo = 0; hi = ttot; j = i * G + c; }
    if (j >= (hi - lo) * NP) return false;
    const int tile = lo + j / NP; u.pn = j % NP; u.pm = tile;
    const int e = T.TE[tile];
    u.aux = e | ((tile - T.TT[e]) << 8);
    return true;
}
struct PolMoe1 {
    static constexpr bool PERM = true;
    static constexpr bool I8 = true;
    static constexpr bool F8 = false;
    const char* A; const char* B; int nt; int G, c; MoeTab T; const int* stok; const float* bgu; const float* swgu; const float* ssc; unsigned char* act;
    __device__ __forceinline__ bool next(int i, Unit& u) const { return moe_next(i, G, c, 8, T, u); }
    static constexpr bool KEYS = true;
    __device__ __forceinline__ const int* key_ptr(const Unit& u, int r) const { const int e = u.aux & 255, idx = (u.aux >> 8) * 256 + r; const int cn = T.CN[e]; return stok + (size_t)e * CAP + (idx < cn ? idx : 0); }
    __device__ __forceinline__ unsigned a_row(const Unit&, int, int key) const { return (unsigned)key * 1024u; }
    __device__ __forceinline__ unsigned b_row(const Unit& u, int r) const { return (unsigned)((u.aux & 255) * 2048 + u.pn * 256 + r) * 1024u; }
    __device__ __forceinline__ void epi(const pg8::AccI& acc, const Unit& u, int wr, int wc, int fr, int fq) const {
        const int e = u.aux & 255, mt = u.aux >> 8, cn = T.CN[e]; const int jl = 32 * wc + 8 * fq;
        const float* bg = bgu + (size_t)e * 2048 + u.pn * 256 + jl;
        const float* sg = swgu + (size_t)e * 2048 + u.pn * 256 + jl;
        const f32x4 bg0 = *(const f32x4*)(bg), bg1 = *(const f32x4*)(bg + 4), bu0 = *(const f32x4*)(bg + 128), bu1 = *(const f32x4*)(bg + 132);
        const f32x4 sg0 = *(const f32x4*)(sg), sg1 = *(const f32x4*)(sg + 4), su0 = *(const f32x4*)(sg + 128), su1 = *(const f32x4*)(sg + 132);
#pragma unroll
        for (int ai = 0; ai < 2; ++ai)
#pragma unroll
            for (int m = 0; m < 4; ++m) { const int rr = TROW(ai, wr, m, fr), idx = mt * 256 + rr; const size_t slot = (size_t)u.pm * 256 + rr;
                const float sa = ssc[(size_t)e * CAP + (idx < cn ? idx : 0)];
                f32x4 g0, g1, u0, u1, o0, o1;
#pragma unroll
                for (int q = 0; q < 4; ++q) { g0[q] = (float)acc[ai][0][m][0][q] * (sa * sg0[q]) + bg0[q]; g1[q] = (float)acc[ai][0][m][1][q] * (sa * sg1[q]) + bg1[q];
                    u0[q] = (float)acc[ai][1][m][0][q] * (sa * su0[q]) + bu0[q]; u1[q] = (float)acc[ai][1][m][1][q] * (sa * su1[q]) + bu1[q]; }
#pragma unroll
                for (int q = 0; q < 4; ++q) {
                    float ga = fminf(g0[q], 7.f), ua = fminf(fmaxf(u0[q], -7.f), 7.f); o0[q] = (ua + 1.f) * ga * __builtin_amdgcn_rcpf(1.f + __builtin_amdgcn_exp2f(-1.702f * LOG2E * ga));
                    float gb = fminf(g1[q], 7.f), ub = fminf(fmaxf(u1[q], -7.f), 7.f); o1[q] = (ub + 1.f) * gb * __builtin_amdgcn_rcpf(1.f + __builtin_amdgcn_exp2f(-1.702f * LOG2E * gb)); }
                v2u w8; { int t0 = __builtin_amdgcn_cvt_pk_fp8_f32(o0[0], o0[1], 0, false); t0 = __builtin_amdgcn_cvt_pk_fp8_f32(o0[2], o0[3], t0, true);
                          int t1 = __builtin_amdgcn_cvt_pk_fp8_f32(o1[0], o1[1], 0, false); t1 = __builtin_amdgcn_cvt_pk_fp8_f32(o1[2], o1[3], t1, true); w8.x = (unsigned)t0; w8.y = (unsigned)t1; }
                *(v2u*)(act + slot * 1024 + u.pn * 128 + jl) = w8; }
    }
};
struct PolMoe2 {
    static constexpr bool PERM = true;
    static constexpr bool KEYS = false;
    static constexpr bool I8 = false;
    static constexpr bool F8 = true;
    __device__ __forceinline__ const int* key_ptr(const Unit&, int) const { return nullptr; }
    const char* A; const char* B; int nt; int G, c; MoeTab T; const float* sw; const float* bdn; const float* swd; unsigned char* Y;
    __device__ __forceinline__ bool next(int i, Unit& u) const { return moe_next(i, G, c, 4, T, u); }
    __device__ __forceinline__ unsigned a_row(const Unit& u, int r, int) const { return (unsigned)(u.pm * 256 + r) * 1024u; }
    __device__ __forceinline__ unsigned b_row(const Unit& u, int r) const { return (unsigned)((u.aux & 255) * 1024 + u.pn * 256 + r) * 1024u; }
    __device__ __forceinline__ void epi(const pg8::Acc& acc, const Unit& u, int wr, int wc, int fr, int fq) const {
        const int e = u.aux & 255, mt = u.aux >> 8, cn = T.CN[e];
#pragma unroll
        for (int bj = 0; bj < 2; ++bj) { const int col = u.pn * 256 + TCOLP(bj, wc, fq); const size_t ci = (size_t)e * 1024 + col;
            const f32x4 b0 = *(const f32x4*)(bdn + ci), b1 = *(const f32x4*)(bdn + ci + 4), s0 = *(const f32x4*)(swd + ci), s1 = *(const f32x4*)(swd + ci + 4);
#pragma unroll
            for (int ai = 0; ai < 2; ++ai)
#pragma unroll
                for (int m = 0; m < 4; ++m) { const int rr = TROW(ai, wr, m, fr), idx = mt * 256 + rr; const size_t slot = (size_t)u.pm * 256 + rr; const float w = sw[(size_t)e * CAP + (idx < cn ? idx : 0)];
                    const float w8 = w * 8.f; f32x4 y0 = (acc[ai][bj][m][0] * s0 + b0) * w8, y1 = (acc[ai][bj][m][1] * s1 + b1) * w8;
#pragma unroll
                    for (int q = 0; q < 4; ++q) { y0[q] = fminf(fmaxf(y0[q], -448.f), 448.f); y1[q] = fminf(fmaxf(y1[q], -448.f), 448.f); }
                    v2u o8; { int t0 = __builtin_amdgcn_cvt_pk_fp8_f32(y0[0], y0[1], 0, false); t0 = __builtin_amdgcn_cvt_pk_fp8_f32(y0[2], y0[3], t0, true);
                              int t1 = __builtin_amdgcn_cvt_pk_fp8_f32(y1[0], y1[1], 0, false); t1 = __builtin_amdgcn_cvt_pk_fp8_f32(y1[2], y1[3], t1, true); o8.x = (unsigned)t0; o8.y = (unsigned)t1; }
                    *(v2u*)(Y + slot * 1024 + col) = o8; } }
    }
};

namespace att {
__device__ __forceinline__ int crow(int r, int hi) { return (r & 3) + 8 * (r >> 2) + 4 * hi; }
__device__ __forceinline__ float max3f(float a, float b, float c) { return fmaxf(fmaxf(a, b), c); }
typedef LAS const char* lds_cptr;
constexpr int LK = 0, LV = 49152, LWS = 90112, LOST = 92160, LBYTES = 124928;
constexpr int PD = 3;
struct Tens { const bf16* Q; int qpitch; const bf16* K; int kpitch; const bf16* V; int vpitch; bf16* O; };
#define ATT_WAITV(n) asm volatile("s_waitcnt vmcnt(" #n ")" ::: "memory")
struct Pend { f32x16 o0, o1; float l; int qrow0, oc0; bool valid; };
__device__ __forceinline__ void finish_unit(const Pend& P, bf16* O, LAS unsigned char* lds, int wid, int lane) {
    const int r32 = lane & 31, hi = lane >> 5;
    LAS float* wsf = (LAS float*)(lds + LWS) + wid * 64;
    float lrun = P.l;
    { auto rr = __builtin_amdgcn_permlane32_swap(__float_as_uint(lrun), __float_as_uint(lrun), false, false); lrun = __uint_as_float(rr[0]) + __uint_as_float(rr[1]); }
    if (hi == 0) wsf[32 + r32] = lrun;
    LDS_WAIT();
    LAS bf16* stg = (LAS bf16*)(lds + LOST) + wid * 2048;
#pragma unroll
    for (int r = 0; r < 16; ++r) { const int orow = crow(r, hi); const float rl = __builtin_amdgcn_rcpf(wsf[32 + orow]);
        stg[orow * 64 + r32] = (bf16)(pk2(P.o0[r] * rl, 0.f) & 0xffffu); stg[orow * 64 + 32 + r32] = (bf16)(pk2(P.o1[r] * rl, 0.f) & 0xffffu); }
    LDS_WAIT();
    bf16* Ow = O + (size_t)(P.qrow0 + wid * 32) * 1024 + P.oc0;
#pragma unroll
    for (int i = 0; i < 4; ++i) { const int row = i * 8 + (lane >> 3), ch = lane & 7; const v4u v = *(const LAS v4u*)(stg + row * 64 + ch * 8); *(v4u*)(Ow + (size_t)row * 1024 + ch * 8) = v; }
    LDS_WAIT();
}
template <int DK>
__device__ __forceinline__ void unit(const Tens& T, int qrow0, int qc0, int kc0, int vc0, int oc0, int kctx0, int klat0, int NTL, LAS unsigned char* lds, int wave_id, Pend& pend) {
    constexpr int ND = DK / 16;
    wave_id = launder_s(wave_id); const int tid = lthread_w(wave_id), lane = tid & 63, r32 = lane & 31, hi = lane >> 5; const int wid = wave_id;
    LAS float* wsf = (LAS float*)(lds + LWS) + wid * 64;
    const bf16* ksrc = T.K + (size_t)lane * T.kpitch + kc0 + wid * 8;
    const int k2off = (8 + (wid & 3) - wid) * 8;
    const bf16* vsrc = T.V + (size_t)(16 * (wid & 3) + (lane >> 2)) * T.vpitch + vc0 + (wid >> 2) * 32 + (lane & 3) * 8;
#define ATT_DMA(t, ks_, vs_) do { const size_t row0_ = (size_t)((t) < 4 ? kctx0 + 64 * (t) : klat0 + 64 * ((t) - 4)); \
        __builtin_amdgcn_global_load_lds((const unsigned*)(ksrc + row0_ * T.kpitch), (LAS unsigned*)(lds + LK + (ks_) * 12288 + wid * 1024), 16, 0, 0); \
        if (DK > 64) __builtin_amdgcn_global_load_lds((const unsigned*)(ksrc + row0_ * T.kpitch + k2off), (LAS unsigned*)(lds + LK + (ks_) * 12288 + 8192 + (wid & 3) * 1024), 16, 0, 0); \
        __builtin_amdgcn_global_load_lds((const unsigned*)(vsrc + row0_ * T.vpitch), (LAS unsigned*)(lds + LV + (vs_) * 8192 + wid * 1024), 16, 0, 0); } while (0)
#define ATT_WAIT_TILES(n_tiles) do { if (DK > 64) { if ((n_tiles) >= 2) ATT_WAITV(6); else if ((n_tiles) == 1) ATT_WAITV(3); else ATT_WAITV(0); } \
        else { if ((n_tiles) >= 2) ATT_WAITV(4); else if ((n_tiles) == 1) ATT_WAITV(2); else ATT_WAITV(0); } } while (0)
    bf16x8 qr[ND];
    { const bf16* qp = T.Q + (size_t)(qrow0 + wid * 32 + r32) * T.qpitch + qc0 + hi * 8;
#pragma unroll
      for (int d0 = 0; d0 < ND; ++d0) qr[d0] = *(const bf16x8*)(qp + d0 * 16); }
    asm volatile("" ::: "memory");
    constexpr float THR = 8.f;
    const int half = wid >> 2;
    float mhat = 0.f, lrun = 0.f; f32x16 o[2]; o[0] = f32x16{}; o[1] = f32x16{}; f32x16 negm = f32x16{};
    f32x16 p0 = f32x16{}, p1 = f32x16{}; v4u pw[4]; pw[0] = pw[1] = pw[2] = pw[3] = (v4u){0u, 0u, 0u, 0u};
    ATT_DMA(0, 0, 0); ATT_DMA(1, 1, 1); ATT_DMA(2, 2, 2);
    if (pend.valid) finish_unit(pend, T.O, lds, wid, lane);
    ATT_WAIT_TILES(2);
    __builtin_amdgcn_s_barrier(); asm volatile("" ::: "memory");
    if (half == 1) __builtin_amdgcn_s_barrier();
    int vs_prev = 0, vs_cur = 0, vs_iss = 3;
    for (int t = 0; t <= NTL; ++t) {
        if (t >= 1) {
            s16x4 lo[2][4], hh[2][4];
            const unsigned vb = (unsigned)(uintptr_t)(lds + LV + vs_prev * 8192) + ((lane >> 4) & 1) * 32 + (lane & 3) * 8 + (4 * hi + ((lane & 15) >> 2)) * 64;
#pragma unroll
            for (int d0 = 0; d0 < 2; ++d0)
#pragma unroll
                for (int ks = 0; ks < 4; ++ks) {
                    asm volatile("ds_read_b64_tr_b16 %0,%1 offset:%c2" : "=&v"(lo[d0][ks]) : "v"(vb), "i"(d0 * 4096 + ks * 1024) : "memory");
                    asm volatile("ds_read_b64_tr_b16 %0,%1 offset:%c2" : "=&v"(hh[d0][ks]) : "v"(vb), "i"(d0 * 4096 + ks * 1024 + 512) : "memory"); }
            asm volatile("s_waitcnt lgkmcnt(0)" ::: "memory"); __builtin_amdgcn_sched_barrier(0);
#pragma unroll
            for (int ks = 0; ks < 4; ++ks)
#pragma unroll
                for (int d0 = 0; d0 < 2; ++d0) { const bf16x8 vf = (bf16x8){lo[d0][ks][0], lo[d0][ks][1], lo[d0][ks][2], lo[d0][ks][3], hh[d0][ks][0], hh[d0][ks][1], hh[d0][ks][2], hh[d0][ks][3]};
                    o[d0] = __builtin_amdgcn_mfma_f32_32x32x16_bf16(__builtin_bit_cast(bf16x8, pw[ks]), vf, o[d0], 0, 0, 0); }
        }
        if (t < NTL) {
            bf16x8 kf[2 * ND];
            const lds_cptr kb = (lds_cptr)(lds + LK + (t & 3) * 12288) + hi * 1024 + r32 * 16;
#pragma unroll
            for (int d0 = 0; d0 < ND; ++d0) { kf[2 * d0] = *(const LAS bf16x8*)(kb + d0 * 2048); kf[2 * d0 + 1] = *(const LAS bf16x8*)(kb + d0 * 2048 + 512); }
            asm volatile("s_waitcnt lgkmcnt(0)" ::: "memory"); __builtin_amdgcn_sched_barrier(0);
#pragma unroll
            for (int d0 = 0; d0 < ND; ++d0) {
                if (d0 == 0) { p0 = __builtin_amdgcn_mfma_f32_32x32x16_bf16(kf[0], qr[0], negm, 0, 0, 0); p1 = __builtin_amdgcn_mfma_f32_32x32x16_bf16(kf[1], qr[0], negm, 0, 0, 0); }
                else { p0 = __builtin_amdgcn_mfma_f32_32x32x16_bf16(kf[2 * d0], qr[d0], p0, 0, 0, 0); p1 = __builtin_amdgcn_mfma_f32_32x32x16_bf16(kf[2 * d0 + 1], qr[d0], p1, 0, 0, 0); } }
        }
        if (half == 1) {
            const int last_iss = (t + PD - 1 < NTL - 1) ? t + PD - 1 : NTL - 1; const int allow = last_iss - (t + 1);
            if (allow >= 1) ATT_WAIT_TILES(1); else ATT_WAIT_TILES(0); }
        asm volatile("s_waitcnt lgkmcnt(0)" ::: "memory"); __builtin_amdgcn_s_barrier(); asm volatile("" ::: "memory");
        if (t < NTL) {
            float rm = max3f(p0[0], p0[1], p1[0]);
#pragma unroll
            for (int r = 0; r < 16; ++r) rm = max3f(rm, p0[r], p1[r]);
            { auto rr = __builtin_amdgcn_permlane32_swap(__float_as_uint(rm), __float_as_uint(rm), false, false); rm = fmaxf(__uint_as_float(rr[0]), __uint_as_float(rr[1])); }
            if (t == 0 || __any(rm > THR)) {
                const float dl = (t == 0) ? rm : fmaxf(rm, 0.f);
                mhat += dl;
#pragma unroll
                for (int r = 0; r < 16; ++r) { p0[r] -= dl; p1[r] -= dl; negm[r] = -mhat; }
                const float f = (t == 0) ? 1.f : __builtin_amdgcn_exp2f(-dl); lrun *= f;
                if (hi == 0) wsf[r32] = f;
                LDS_WAIT();
#pragma unroll
                for (int r = 0; r < 16; ++r) { const float a = wsf[crow(r, hi)]; o[0][r] *= a; o[1][r] *= a; }
            }
            float rs = 0.f;
#pragma unroll
            for (int r = 0; r < 16; ++r) { p0[r] = __builtin_amdgcn_exp2f(p0[r]); p1[r] = __builtin_amdgcn_exp2f(p1[r]); rs += p0[r] + p1[r]; }
            lrun += rs;
            pw[0] = (v4u){pk2(p0[0], p0[1]), pk2(p0[2], p0[3]), pk2(p0[4], p0[5]), pk2(p0[6], p0[7])};
            pw[1] = (v4u){pk2(p0[8], p0[9]), pk2(p0[10], p0[11]), pk2(p0[12], p0[13]), pk2(p0[14], p0[15])};
            pw[2] = (v4u){pk2(p1[0], p1[1]), pk2(p1[2], p1[3]), pk2(p1[4], p1[5]), pk2(p1[6], p1[7])};
            pw[3] = (v4u){pk2(p1[8], p1[9]), pk2(p1[10], p1[11]), pk2(p1[12], p1[13]), pk2(p1[14], p1[15])};
        }
        if (t + PD < NTL) { ATT_DMA(t + PD, (t + PD) & 3, vs_iss); vs_iss = (vs_iss == 4) ? 0 : vs_iss + 1; }
        if (half == 0) {
            const int last_iss = (t + PD < NTL - 1) ? t + PD : NTL - 1; const int allow = last_iss - (t + 1);
            if (allow >= 2) ATT_WAIT_TILES(2); else if (allow == 1) ATT_WAIT_TILES(1); else ATT_WAIT_TILES(0); }
        vs_prev = vs_cur; vs_cur = (vs_cur == 4) ? 0 : vs_cur + 1;
        asm volatile("s_waitcnt lgkmcnt(0)" ::: "memory"); __builtin_amdgcn_s_barrier(); asm volatile("" ::: "memory");
    }
    if (half == 0) __builtin_amdgcn_s_barrier();
#undef ATT_DMA
#undef ATT_WAIT_TILES
    pend.o0 = o[0]; pend.o1 = o[1]; pend.l = lrun; pend.qrow0 = qrow0; pend.oc0 = oc0; pend.valid = true;
}
#undef ATT_WAITV
}

namespace att64 {
typedef unsigned short bf16;
using bf16x8=__attribute__((ext_vector_type(8)))short;
using s16x4=__attribute__((ext_vector_type(4)))short;
using f32x16=__attribute__((ext_vector_type(16)))float;
using u32x4=__attribute__((ext_vector_type(4)))unsigned;
constexpr int D=64;
constexpr int NW=8,QBLK=32,QB=QBLK*NW,KVBLK=64;
__device__ __forceinline__ int crow(int r,int hi){return (r&3)+8*(r>>2)+4*hi;}
#define SBAR() __builtin_amdgcn_sched_barrier(0)
constexpr int NSLOT=3, SLOTB=8192;
constexpr int LDS_K=0, LDS_V=NSLOT*SLOTB, LDS_WS=2*NSLOT*SLOTB, LDS_OST=LDS_WS+NW*64*4, LDS_BYTES=LDS_OST+NW*4096;
constexpr float C2=0.125f*1.4426950408889634f;
__device__ __forceinline__ void glds16(const void*gsrc,unsigned lds_dst){unsigned keep;
  asm volatile("s_mov_b32 %0, m0\n\ts_mov_b32 m0, %2\n\ts_nop 0\n\tglobal_load_lds_dwordx4 %1, off\n\ts_mov_b32 m0, %0":"=&s"(keep):"v"(gsrc),"s"(lds_dst):"memory");}
__device__ __forceinline__ float max3f(float a,float b,float c){float r;asm("v_max3_f32 %0, %1, %2, %3":"=v"(r):"v"(a),"v"(b),"v"(c));return r;}
__device__ __forceinline__ float max2f(float a,float b){float r;asm("v_max_f32_e32 %0, %1, %2":"=v"(r):"v"(a),"v"(b));return r;}
__device__ __forceinline__ float fadd_s(float a,float b){float r;asm("v_add_f32_e32 %0, %1, %2":"=v"(r):"v"(a),"v"(b));return r;}
__device__ __forceinline__ float fsub_s(float a,float b){float r;asm("v_sub_f32_e32 %0, %1, %2":"=v"(r):"v"(a),"v"(b));return r;}
typedef float f32x2_t __attribute__((ext_vector_type(2))); typedef __bf16 bf16x2_t __attribute__((ext_vector_type(2)));
__device__ __forceinline__ unsigned cvtpk_s(float lo,float hi){f32x2_t v={lo,hi};bf16x2_t b=__builtin_convertvector(v,bf16x2_t);return __builtin_bit_cast(unsigned,b);}
#define WAIT_BAR(N) asm volatile("s_waitcnt vmcnt(" #N ") lgkmcnt(0)\n\ts_barrier":::"memory")

__device__ __forceinline__ void qkt(f32x16&p0,f32x16&p1,const char*Kslot,const bf16x8*qr,const f32x16&negm,int r32,int hi){
  const char*kb=Kslot+hi*1024+r32*16;
  #pragma unroll
  for(int d0=0;d0<4;++d0){
    const bf16x8 b0=*reinterpret_cast<const bf16x8*>(kb+d0*2048);
    const bf16x8 b1=*reinterpret_cast<const bf16x8*>(kb+d0*2048+512);
    if(d0==0){p0=__builtin_amdgcn_mfma_f32_32x32x16_bf16(b0,qr[0],negm,0,0,0);p1=__builtin_amdgcn_mfma_f32_32x32x16_bf16(b1,qr[0],negm,0,0,0);}
    else{p0=__builtin_amdgcn_mfma_f32_32x32x16_bf16(b0,qr[d0],p0,0,0,0);p1=__builtin_amdgcn_mfma_f32_32x32x16_bf16(b1,qr[d0],p1,0,0,0);}}
}
typedef __attribute__((address_space(3))) const char* lds_cptr;
typedef short v4i16_t __attribute__((ext_vector_type(4)));
__device__ __forceinline__ void kload8(bf16x8*kf,lds_cptr kp){
  kf[0]=*(const __attribute__((address_space(3))) bf16x8*)(kp);      kf[1]=*(const __attribute__((address_space(3))) bf16x8*)(kp+512);
  kf[2]=*(const __attribute__((address_space(3))) bf16x8*)(kp+2048); kf[3]=*(const __attribute__((address_space(3))) bf16x8*)(kp+2560);
  kf[4]=*(const __attribute__((address_space(3))) bf16x8*)(kp+4096); kf[5]=*(const __attribute__((address_space(3))) bf16x8*)(kp+4608);
  kf[6]=*(const __attribute__((address_space(3))) bf16x8*)(kp+6144); kf[7]=*(const __attribute__((address_space(3))) bf16x8*)(kp+6656);
}
__device__ __forceinline__ void kload2(bf16x8*kf,lds_cptr kp,int j){ kf[2*j]=*(const __attribute__((address_space(3))) bf16x8*)(kp+j*2048); kf[2*j+1]=*(const __attribute__((address_space(3))) bf16x8*)(kp+j*2048+512); }
__device__ __forceinline__ s16x4 vtr(lds_cptr p){ return __builtin_bit_cast(s16x4,__builtin_amdgcn_ds_read_tr16_b64_v4i16((__attribute__((address_space(3))) v4i16_t*)p)); }
__device__ __forceinline__ float rowmax(const f32x16&p0,const f32x16&p1){
  float a=max3f(p0[0],p0[1],p1[0]),b=max3f(p0[2],p0[3],p1[1]);a=max3f(a,p1[2],p1[3]);
  #pragma unroll
  for(int r=4;r<16;r+=4){a=max3f(a,p0[r],p0[r+1]);b=max3f(b,p0[r+2],p0[r+3]);a=max3f(a,p1[r],p1[r+1]);b=max3f(b,p1[r+2],p1[r+3]);}
  const float m=max2f(a,b);
  auto rr=__builtin_amdgcn_permlane32_swap(__float_as_uint(m),__float_as_uint(m),false,false);
  return max2f(__uint_as_float(rr[0]),__uint_as_float(rr[1]));
}
__device__ __forceinline__ void pv(f32x16*o,int vb,bf16x8 pa0,bf16x8 pa1,bf16x8 pa2,bf16x8 pa3){
  #pragma unroll
  for(int d0=0;d0<2;++d0){s16x4 lo[4],hi[4];
    #pragma unroll
    for(int ks=0;ks<4;++ks){
      asm volatile("ds_read_b64_tr_b16 %0,%1 offset:%c2":"=&v"(lo[ks]):"v"(vb),"i"(d0*4096+ks*1024):"memory");
      asm volatile("ds_read_b64_tr_b16 %0,%1 offset:%c2":"=&v"(hi[ks]):"v"(vb),"i"(d0*4096+ks*1024+512):"memory");}
    asm volatile("s_waitcnt lgkmcnt(0)":::"memory");SBAR();
    #define PK(k) (bf16x8){lo[k][0],lo[k][1],lo[k][2],lo[k][3],hi[k][0],hi[k][1],hi[k][2],hi[k][3]}
    o[d0]=__builtin_amdgcn_mfma_f32_32x32x16_bf16(pa0,PK(0),o[d0],0,0,0);
    o[d0]=__builtin_amdgcn_mfma_f32_32x32x16_bf16(pa1,PK(1),o[d0],0,0,0);
    o[d0]=__builtin_amdgcn_mfma_f32_32x32x16_bf16(pa2,PK(2),o[d0],0,0,0);
    o[d0]=__builtin_amdgcn_mfma_f32_32x32x16_bf16(pa3,PK(3),o[d0],0,0,0);
    #undef PK
  }
}

#ifndef ATTN_STORE16
#define ATTN_STORE16(p,v) (*(u32x4*)(p)=(v))
#endif
template<int THRL> __device__ __forceinline__ void attn_unit(const bf16*Q,int qp,int qrow0,int qc0,const bf16*__restrict__ K,int kp,int kc0,const bf16*__restrict__ V,int vp,int vc0,bf16*O,int oc0,int kctx0,int klat0,int NT,char*shm,int wave_id){
  wave_id=launder_s(wave_id); const int lane=lane_id_v(),r32=lane&31,hi=lane>>5; const int wid=wave_id;
  const bf16*Qw=Q+(long)(qrow0+wid*QBLK)*qp+qc0;
  const bf16*Kh=K+kc0,*Vh=V+vc0;
  const unsigned lds0=(unsigned)(uintptr_t)shm;
  float*wsf=(float*)(shm+LDS_WS)+wid*64;
  const bf16*ksrc=Kh+(long)lane*kp+wid*8;
  const bf16*vsrc=Vh+(long)(16*(wid&3)+(lane>>2))*vp+(wid>>2)*32+(lane&3)*8;
  #define TROW0(t) ((long)((t)<4?kctx0+64*(t):klat0+64*((t)-4)))
  const unsigned kdst=lds0+LDS_K+wid*1024, vdst=lds0+LDS_V+wid*1024;
  #define DMA_K(t,slot) glds16(ksrc+TROW0(t)*kp,(unsigned)__builtin_amdgcn_readfirstlane(kdst+(slot)))
  #define DMA_V(t,slot) glds16(vsrc+TROW0(t)*vp,(unsigned)__builtin_amdgcn_readfirstlane(vdst+(slot)))
  const int vb0=(int)(lds0+LDS_V)+((lane>>4)&1)*32+(lane&3)*8+(4*hi+((lane&15)>>2))*64;
  const char*Kbase=shm+LDS_K; bf16x8 kf[8];
  const lds_cptr shm3=(lds_cptr)shm; const lds_cptr kp0=shm3+LDS_K+hi*1024+r32*16; const lds_cptr vp0=shm3+LDS_V+((lane>>4)&1)*32+(lane&3)*8+(4*hi+((lane&15)>>2))*64;
  DMA_K(0,0);DMA_V(0,0);DMA_K(1,SLOTB);
  bf16x8 qr[4];
  #pragma unroll
  for(int d0=0;d0<4;++d0)qr[d0]=*reinterpret_cast<const bf16x8*>(&Qw[(long)r32*qp+d0*16+hi*8]);
  float mhat=0.f,l_reg=0.f;f32x16 o[2];o[0]=f32x16{};o[1]=f32x16{};f32x16 negm=f32x16{};asm volatile("":"+v"(negm));
  #define CMASK(P0,P1,t) do{}while(0)
  bool resc=false;
  #define START(P0,P1) do{ const float rm=rowmax(P0,P1); resc=false; \
    { const float dl=rm; mhat=fadd_s(mhat,dl); \
      _Pragma("unroll") for(int r=0;r<16;++r){P0[r]=fsub_s(P0[r],dl);P1[r]=fsub_s(P1[r],dl);} \
      _Pragma("unroll") for(int r=0;r<16;++r)negm[r]=-mhat; asm volatile("":"+v"(negm)); } \
    _Pragma("unroll") for(int r=0;r<16;++r)P0[r]=__builtin_amdgcn_exp2f(P0[r]); }while(0)
  #define RESC() do{ if(resc){ asm volatile("s_waitcnt lgkmcnt(0)":::"memory"); \
      _Pragma("unroll") for(int d_=0;d_<2;++d_) _Pragma("unroll") for(int r=0;r<16;++r)o[d_][r]*=wsf[crow(r,hi)]; } }while(0)
  f32x16 pA0,pA1,pB0,pB1;
  int sl_prev=0,sl_cur=0,sl_next=SLOTB;
  #define ROT() do{sl_prev=sl_cur;sl_cur=sl_next;sl_next=(sl_next==(NSLOT-1)*SLOTB)?0:sl_next+SLOTB;}while(0)
  DMA_K(2,2*SLOTB);
  WAIT_BAR(3);
  qkt(pA0,pA1,Kbase,qr,negm,r32,hi);asm volatile("s_nop 15\n\ts_nop 7":"+v"(pA0),"+v"(pA1));CMASK(pA0,pA1,0);
  START(pA0,pA1);
  _Pragma("unroll") for(int r=0;r<16;++r)pA1[r]=__builtin_amdgcn_exp2f(pA1[r]);
  WAIT_BAR(0);
  DMA_K(3,0);DMA_V(1,SLOTB);
  ROT();
  kload8(kf,kp0+sl_cur);
  WAIT_BAR(2);
  s16x4 vlo[8],vhi[8]; u32x4 pw0,pw1,pw2,pw3;
  #define PKW(P,B) cvtpk_s(P[B],P[B+1])
  #define PAF(k) __builtin_bit_cast(bf16x8,pw##k)
  #define VFR(i) (bf16x8){vlo[i][0],vlo[i][1],vlo[i][2],vlo[i][3],vhi[i][0],vhi[i][1],vhi[i][2],vhi[i][3]}
  #define PIN(x) asm volatile("":"+v"(x))
  #define MX3(a,b,c) __builtin_fmaxf(__builtin_fmaxf((a),(b)),(c))
  #define GAPA(MF,A0,A1,A2,A3,W0,W1,PW) do{ MF; sacc+=A0; sacc+=A1; sacc+=A2; sacc+=A3; PIN(sacc); W0; W1; PIN(PW); SBAR(); }while(0)
  #define EX(v) __builtin_amdgcn_exp2f(v)
  #define GAPB(MF,X,B) do{ MF; X[B]=EX(X[B]); X[B+1]=EX(X[B+1]); X[B+2]=EX(X[B+2]); X[B+3]=EX(X[B+3]); PIN(X); SBAR(); }while(0)
  #define VRD(i) do{ vlo[i]=vtr(vp_+(((i)>>2)*4096+((i)&3)*1024)); vhi[i]=vtr(vp_+(((i)>>2)*4096+((i)&3)*1024+512)); }while(0)
  #define KRD(G,j) do{ if(G){ kload2(kf,kp0+sl_next,j); SBAR(); } }while(0)
  #define STEP(C0,C1,P0,P1,t,GK,GV,GL) do{ SBAR(); \
    const lds_cptr vp_=vp0+sl_prev; \
    VRD(0); SBAR(); float sacc=(P0[0]+P0[1]); \
    GAPA(C0=__builtin_amdgcn_mfma_f32_32x32x16_bf16(kf[0],qr[0],negm,0,0,0), P0[2],P0[3],P0[4],P0[5],     pw0[0]=PKW(P0,0), pw0[1]=PKW(P0,2), pw0); \
    VRD(4); SBAR(); GAPA(C1=__builtin_amdgcn_mfma_f32_32x32x16_bf16(kf[1],qr[0],negm,0,0,0), P0[6],P0[7],P0[8],P0[9],     pw0[2]=PKW(P0,4), pw0[3]=PKW(P0,6), pw0); \
    VRD(1); SBAR(); GAPA(C0=__builtin_amdgcn_mfma_f32_32x32x16_bf16(kf[2],qr[1],C0,0,0,0),   P0[10],P0[11],P0[12],P0[13], pw1[0]=PKW(P0,8), pw1[1]=PKW(P0,10), pw1); \
    VRD(5); SBAR(); GAPA(C1=__builtin_amdgcn_mfma_f32_32x32x16_bf16(kf[3],qr[1],C1,0,0,0),   P0[14],P0[15],P1[0],P1[1],   pw1[2]=PKW(P0,12),pw1[3]=PKW(P0,14), pw1); \
    VRD(2); SBAR(); GAPA(C0=__builtin_amdgcn_mfma_f32_32x32x16_bf16(kf[4],qr[2],C0,0,0,0),   P1[2],P1[3],P1[4],P1[5],     pw2[0]=PKW(P1,0), pw2[1]=PKW(P1,2), pw2); \
    VRD(6); SBAR(); GAPA(C1=__builtin_amdgcn_mfma_f32_32x32x16_bf16(kf[5],qr[2],C1,0,0,0),   P1[6],P1[7],P1[8],P1[9],     pw2[2]=PKW(P1,4), pw2[3]=PKW(P1,6), pw2); \
    VRD(3); SBAR(); GAPA(C0=__builtin_amdgcn_mfma_f32_32x32x16_bf16(kf[6],qr[3],C0,0,0,0),   P1[10],P1[11],P1[12],P1[13], pw3[0]=PKW(P1,8), pw3[1]=PKW(P1,10), pw3); \
    VRD(7); SBAR(); GAPA(C1=__builtin_amdgcn_mfma_f32_32x32x16_bf16(kf[7],qr[3],C1,0,0,0),   P1[14],P1[15],0.f,0.f,       pw3[2]=PKW(P1,12),pw3[3]=PKW(P1,14), pw3); \
    l_reg+=sacc; \
    if(GK){DMA_K((t)+3,sl_cur);} if(GV){DMA_V((t)+1,sl_next);} \
    CMASK(C0,C1,t); \
    { float a=MX3(C0[0],C0[1],C1[0]),b=MX3(C0[2],C0[3],C1[1]); a=MX3(a,C1[2],C1[3]); \
      _Pragma("unroll") for(int r=4;r<16;r+=4){a=MX3(a,C0[r],C0[r+1]);b=MX3(b,C0[r+2],C0[r+3]);a=MX3(a,C1[r],C1[r+1]);b=MX3(b,C1[r+2],C1[r+3]);} \
      float rm=__builtin_fmaxf(a,b); { auto rr=__builtin_amdgcn_permlane32_swap(__float_as_uint(rm),__float_as_uint(rm),false,false); rm=__builtin_fmaxf(__uint_as_float(rr[0]),__uint_as_float(rr[1])); } \
      resc=false; \
      if(__builtin_expect(__any(rm>(float)THRL),0)){ const float dl=__builtin_fmaxf(rm,0.f); mhat+=dl; \
        _Pragma("unroll") for(int r=0;r<16;++r){C0[r]-=dl;C1[r]-=dl;} \
        _Pragma("unroll") for(int r=0;r<16;++r)negm[r]=-mhat; asm volatile("":"+v"(negm)); \
        const float f=__builtin_amdgcn_exp2f(-dl); l_reg*=f; if(hi==0)wsf[r32]=f; resc=true; } } \
    SBAR(); \
    GAPB(o[0]=__builtin_amdgcn_mfma_f32_32x32x16_bf16(PAF(0),VFR(0),o[0],0,0,0), C0,0); \
    GAPB(o[1]=__builtin_amdgcn_mfma_f32_32x32x16_bf16(PAF(0),VFR(4),o[1],0,0,0), C0,4); \
    KRD(GL,0); GAPB(o[0]=__builtin_amdgcn_mfma_f32_32x32x16_bf16(PAF(1),VFR(1),o[0],0,0,0), C0,8); \
    KRD(GL,1); GAPB(o[1]=__builtin_amdgcn_mfma_f32_32x32x16_bf16(PAF(1),VFR(5),o[1],0,0,0), C0,12); \
    KRD(GL,2); GAPB(o[0]=__builtin_amdgcn_mfma_f32_32x32x16_bf16(PAF(2),VFR(2),o[0],0,0,0), C1,0); \
    KRD(GL,3); GAPB(o[1]=__builtin_amdgcn_mfma_f32_32x32x16_bf16(PAF(2),VFR(6),o[1],0,0,0), C1,4); \
    GAPB(o[0]=__builtin_amdgcn_mfma_f32_32x32x16_bf16(PAF(3),VFR(3),o[0],0,0,0), C1,8); \
    GAPB(o[1]=__builtin_amdgcn_mfma_f32_32x32x16_bf16(PAF(3),VFR(7),o[1],0,0,0), C1,12); \
    }while(0)
  int t=1;
  for(;t+5<NT;t+=2){
    STEP(pB0,pB1,pA0,pA1,t,true,true,true);     WAIT_BAR(2); RESC(); ROT();
    STEP(pA0,pA1,pB0,pB1,t+1,true,true,true);   WAIT_BAR(2); RESC(); ROT();
  }
  #define ENDW(tt) do{ if((tt)+3<NT){WAIT_BAR(2);} else if((tt)+2<NT){WAIT_BAR(1);} else {WAIT_BAR(0);} }while(0)
  for(;t+1<NT;t+=2){
    STEP(pB0,pB1,pA0,pA1,t,(t+3<NT),(t+1<NT),(t+1<NT));       ENDW(t);   RESC(); ROT();
    STEP(pA0,pA1,pB0,pB1,t+1,(t+4<NT),(t+2<NT),(t+2<NT));     ENDW(t+1); RESC(); ROT();
  }
  STEP(pB0,pB1,pA0,pA1,NT-1,false,false,false); RESC();
  { float sacc=pB0[0]+pB0[1]; _Pragma("unroll") for(int r=2;r<16;++r)sacc+=pB0[r]; _Pragma("unroll") for(int r=0;r<16;++r)sacc+=pB1[r]; l_reg+=sacc;
    pw0=(u32x4){PKW(pB0,0),PKW(pB0,2),PKW(pB0,4),PKW(pB0,6)};pw1=(u32x4){PKW(pB0,8),PKW(pB0,10),PKW(pB0,12),PKW(pB0,14)};pw2=(u32x4){PKW(pB1,0),PKW(pB1,2),PKW(pB1,4),PKW(pB1,6)};pw3=(u32x4){PKW(pB1,8),PKW(pB1,10),PKW(pB1,12),PKW(pB1,14)};
    SBAR(); pv(o,vb0+sl_cur,PAF(0),PAF(1),PAF(2),PAF(3)); }
  #undef PKW
  #undef PAF
  #undef VFR
  #undef PIN
  #undef MX3
  #undef GAPA
  #undef GAPB
  #undef EX
  #undef VRD
  #undef KRD
  #undef STEP
  #undef ENDW
  {auto rr=__builtin_amdgcn_permlane32_swap(__float_as_uint(l_reg),__float_as_uint(l_reg),false,false);l_reg=__uint_as_float(rr[0])+__uint_as_float(rr[1]);}
  if(hi==0)wsf[32+r32]=l_reg;asm volatile("s_waitcnt lgkmcnt(0)":::"memory");
  float rli[16];
  #pragma unroll
  for(int r=0;r<16;++r)rli[r]=__builtin_amdgcn_rcpf(wsf[32+crow(r,hi)]);
  bf16*Ow=O+(long)(qrow0+wid*QBLK)*1024+oc0;
  { bf16*stg=(bf16*)(shm+LDS_OST)+wid*2048;
    #pragma unroll
    for(int r=0;r<16;++r){const int orow=crow(r,hi);
      #pragma unroll
      for(int d0=0;d0<2;++d0)stg[orow*64+d0*32+r32]=(bf16)(cvtpk_s(o[d0][r]*rli[r],0.f)&0xffffu);}
    asm volatile("s_waitcnt lgkmcnt(0)":::"memory");
    #pragma unroll
    for(int i=0;i<4;++i){const int row=i*8+(lane>>3),ch=lane&7; const u32x4 v=*(const u32x4*)(stg+row*64+ch*8); ATTN_STORE16(Ow+(long)row*1024+ch*8,v);} }
  asm volatile("s_waitcnt lgkmcnt(0)\n\ts_barrier":::"memory");
  #undef DMA_K
  #undef DMA_V
  #undef TROW0
  #undef CMASK
  #undef START
  #undef RESC
  #undef ROT
}
#undef SBAR
#undef WAIT_BAR
}

namespace att96 {
typedef unsigned short bf16;
using bf16x8=__attribute__((ext_vector_type(8)))short;
using s16x4=__attribute__((ext_vector_type(4)))short;
using f32x16=__attribute__((ext_vector_type(16)))float;
using u32x4=__attribute__((ext_vector_type(4)))unsigned;
constexpr int D=64;
constexpr int NW=8,QBLK=32,QB=QBLK*NW,KVBLK=64;
__device__ __forceinline__ int crow(int r,int hi){return (r&3)+8*(r>>2)+4*hi;}
#define SBAR() __builtin_amdgcn_sched_barrier(0)
constexpr int NSLOT=3, SLOTB=8192, KSLOTB=12288;
#define KOFF(sl) ((sl)+((sl)>>1))
constexpr int LDS_K=0, LDS_V=NSLOT*KSLOTB, LDS_WS=LDS_V+NSLOT*SLOTB, LDS_OST=LDS_WS+NW*64*4, LDS_BYTES=LDS_OST+NW*4096;
constexpr float C2=0.125f*1.4426950408889634f;
__device__ __forceinline__ void glds16(const void*gsrc,unsigned lds_dst){unsigned keep;
  asm volatile("s_mov_b32 %0, m0\n\ts_mov_b32 m0, %2\n\ts_nop 0\n\tglobal_load_lds_dwordx4 %1, off\n\ts_mov_b32 m0, %0":"=&s"(keep):"v"(gsrc),"s"(lds_dst):"memory");}
__device__ __forceinline__ float max3f(float a,float b,float c){float r;asm("v_max3_f32 %0, %1, %2, %3":"=v"(r):"v"(a),"v"(b),"v"(c));return r;}
__device__ __forceinline__ float max2f(float a,float b){float r;asm("v_max_f32_e32 %0, %1, %2":"=v"(r):"v"(a),"v"(b));return r;}
__device__ __forceinline__ float fadd_s(float a,float b){float r;asm("v_add_f32_e32 %0, %1, %2":"=v"(r):"v"(a),"v"(b));return r;}
__device__ __forceinline__ float fsub_s(float a,float b){float r;asm("v_sub_f32_e32 %0, %1, %2":"=v"(r):"v"(a),"v"(b));return r;}
typedef float f32x2_t __attribute__((ext_vector_type(2))); typedef __bf16 bf16x2_t __attribute__((ext_vector_type(2)));
__device__ __forceinline__ unsigned cvtpk_s(float lo,float hi){f32x2_t v={lo,hi};bf16x2_t b=__builtin_convertvector(v,bf16x2_t);return __builtin_bit_cast(unsigned,b);}
#define WAIT_BAR(N) asm volatile("s_waitcnt vmcnt(" #N ") lgkmcnt(0)\n\ts_barrier":::"memory")

__device__ __forceinline__ void qkt(f32x16&p0,f32x16&p1,const char*Kslot,const bf16x8*qr,const f32x16&negm,int r32,int hi){
  const char*kb=Kslot+hi*1024+r32*16;
  #pragma unroll
  for(int d0=0;d0<6;++d0){
    const bf16x8 b0=*reinterpret_cast<const bf16x8*>(kb+d0*2048);
    const bf16x8 b1=*reinterpret_cast<const bf16x8*>(kb+d0*2048+512);
    if(d0==0){p0=__builtin_amdgcn_mfma_f32_32x32x16_bf16(b0,qr[0],negm,0,0,0);p1=__builtin_amdgcn_mfma_f32_32x32x16_bf16(b1,qr[0],negm,0,0,0);}
    else{p0=__builtin_amdgcn_mfma_f32_32x32x16_bf16(b0,qr[d0],p0,0,0,0);p1=__builtin_amdgcn_mfma_f32_32x32x16_bf16(b1,qr[d0],p1,0,0,0);}}
}
typedef __attribute__((address_space(3))) const char* lds_cptr;
typedef short v4i16_t __attribute__((ext_vector_type(4)));
__device__ __forceinline__ void kload8(bf16x8*kf,lds_cptr kp){
  kf[0]=*(const __attribute__((address_space(3))) bf16x8*)(kp);      kf[1]=*(const __attribute__((address_space(3))) bf16x8*)(kp+512);
  kf[2]=*(const __attribute__((address_space(3))) bf16x8*)(kp+2048); kf[3]=*(const __attribute__((address_space(3))) bf16x8*)(kp+2560);
  kf[4]=*(const __attribute__((address_space(3))) bf16x8*)(kp+4096); kf[5]=*(const __attribute__((address_space(3))) bf16x8*)(kp+4608);
  kf[6]=*(const __attribute__((address_space(3))) bf16x8*)(kp+6144); kf[7]=*(const __attribute__((address_space(3))) bf16x8*)(kp+6656);
  kf[8]=*(const __attribute__((address_space(3))) bf16x8*)(kp+8192); kf[9]=*(const __attribute__((address_space(3))) bf16x8*)(kp+8704);
  kf[10]=*(const __attribute__((address_space(3))) bf16x8*)(kp+10240); kf[11]=*(const __attribute__((address_space(3))) bf16x8*)(kp+10752);
}
__device__ __forceinline__ void kload2(bf16x8*kf,lds_cptr kp,int j){ kf[2*j]=*(const __attribute__((address_space(3))) bf16x8*)(kp+j*2048); kf[2*j+1]=*(const __attribute__((address_space(3))) bf16x8*)(kp+j*2048+512); }
__device__ __forceinline__ s16x4 vtr(lds_cptr p){ return __builtin_bit_cast(s16x4,__builtin_amdgcn_ds_read_tr16_b64_v4i16((__attribute__((address_space(3))) v4i16_t*)p)); }
__device__ __forceinline__ float rowmax(const f32x16&p0,const f32x16&p1){
  float a=max3f(p0[0],p0[1],p1[0]),b=max3f(p0[2],p0[3],p1[1]);a=max3f(a,p1[2],p1[3]);
  #pragma unroll
  for(int r=4;r<16;r+=4){a=max3f(a,p0[r],p0[r+1]);b=max3f(b,p0[r+2],p0[r+3]);a=max3f(a,p1[r],p1[r+1]);b=max3f(b,p1[r+2],p1[r+3]);}
  const float m=max2f(a,b);
  auto rr=__builtin_amdgcn_permlane32_swap(__float_as_uint(m),__float_as_uint(m),false,false);
  return max2f(__uint_as_float(rr[0]),__uint_as_float(rr[1]));
}
__device__ __forceinline__ void pv(f32x16*o,int vb,bf16x8 pa0,bf16x8 pa1,bf16x8 pa2,bf16x8 pa3){
  #pragma unroll
  for(int d0=0;d0<2;++d0){s16x4 lo[4],hi[4];
    #pragma unroll
    for(int ks=0;ks<4;++ks){
      asm volatile("ds_read_b64_tr_b16 %0,%1 offset:%c2":"=&v"(lo[ks]):"v"(vb),"i"(d0*4096+ks*1024):"memory");
      asm volatile("ds_read_b64_tr_b16 %0,%1 offset:%c2":"=&v"(hi[ks]):"v"(vb),"i"(d0*4096+ks*1024+512):"memory");}
    asm volatile("s_waitcnt lgkmcnt(0)":::"memory");SBAR();
    #define PK(k) (bf16x8){lo[k][0],lo[k][1],lo[k][2],lo[k][3],hi[k][0],hi[k][1],hi[k][2],hi[k][3]}
    o[d0]=__builtin_amdgcn_mfma_f32_32x32x16_bf16(pa0,PK(0),o[d0],0,0,0);
    o[d0]=__builtin_amdgcn_mfma_f32_32x32x16_bf16(pa1,PK(1),o[d0],0,0,0);
    o[d0]=__builtin_amdgcn_mfma_f32_32x32x16_bf16(pa2,PK(2),o[d0],0,0,0);
    o[d0]=__builtin_amdgcn_mfma_f32_32x32x16_bf16(pa3,PK(3),o[d0],0,0,0);
    #undef PK
  }
}

#ifndef ATTN_STORE16
#define ATTN_STORE16(p,v) (*(u32x4*)(p)=(v))
#endif
template<int THRL> __device__ __forceinline__ void attn_unit(const bf16*Q,int qp,int qrow0,int qc0,const bf16*__restrict__ K,int kp,int kc0,const bf16*__restrict__ V,int vp,int vc0,bf16*O,int oc0,int kctx0,int klat0,int NT,char*shm,int wave_id){
  wave_id=launder_s(wave_id); const int lane=lane_id_v(),r32=lane&31,hi=lane>>5; const int wid=wave_id;
  const bf16*Qw=Q+(long)(qrow0+wid*QBLK)*qp+qc0;
  const bf16*Kh=K+kc0,*Vh=V+vc0;
  const unsigned lds0=(unsigned)(uintptr_t)shm;
  float*wsf=(float*)(shm+LDS_WS)+wid*64;
  const bf16*ksrc=Kh+(long)lane*kp+wid*8;
  const bf16*vsrc=Vh+(long)(16*(wid&3)+(lane>>2))*vp+(wid>>2)*32+(lane&3)*8;
  #define TROW0(t) ((long)((t)<4?kctx0+64*(t):klat0+64*((t)-4)))
  const unsigned kdst=lds0+LDS_K+wid*1024, kdst2=lds0+LDS_K+8192+(wid&3)*1024, vdst=lds0+LDS_V+wid*1024;
  const int k2off=(8+(wid&3)-wid)*8;
  #define DMA_K(t,slot) do{ glds16(ksrc+TROW0(t)*kp,(unsigned)__builtin_amdgcn_readfirstlane(kdst+KOFF(slot))); glds16(ksrc+TROW0(t)*kp+k2off,(unsigned)__builtin_amdgcn_readfirstlane(kdst2+KOFF(slot))); }while(0)
  #define DMA_V(t,slot) glds16(vsrc+TROW0(t)*vp,(unsigned)__builtin_amdgcn_readfirstlane(vdst+(slot)))
  const int vb0=(int)(lds0+LDS_V)+((lane>>4)&1)*32+(lane&3)*8+(4*hi+((lane&15)>>2))*64;
  const char*Kbase=shm+LDS_K; bf16x8 kf[12];
  const lds_cptr shm3=(lds_cptr)shm; const lds_cptr kp0=shm3+LDS_K+hi*1024+r32*16; const lds_cptr vp0=shm3+LDS_V+((lane>>4)&1)*32+(lane&3)*8+(4*hi+((lane&15)>>2))*64;
  DMA_K(0,0);DMA_V(0,0);DMA_K(1,SLOTB);
  bf16x8 qr[6];
  #pragma unroll
  for(int d0=0;d0<6;++d0)qr[d0]=*reinterpret_cast<const bf16x8*>(&Qw[(long)r32*qp+d0*16+hi*8]);
  float mhat=0.f,l_reg=0.f;f32x16 o[2];o[0]=f32x16{};o[1]=f32x16{};f32x16 negm=f32x16{};asm volatile("":"+v"(negm));
  #define CMASK(P0,P1,t) do{}while(0)
  bool resc=false;
  #define START(P0,P1) do{ const float rm=rowmax(P0,P1); resc=false; \
    { const float dl=rm; mhat=fadd_s(mhat,dl); \
      _Pragma("unroll") for(int r=0;r<16;++r){P0[r]=fsub_s(P0[r],dl);P1[r]=fsub_s(P1[r],dl);} \
      _Pragma("unroll") for(int r=0;r<16;++r)negm[r]=-mhat; asm volatile("":"+v"(negm)); } \
    _Pragma("unroll") for(int r=0;r<16;++r)P0[r]=__builtin_amdgcn_exp2f(P0[r]); }while(0)
  #define RESC() do{ if(resc){ asm volatile("s_waitcnt lgkmcnt(0)":::"memory"); \
      _Pragma("unroll") for(int d_=0;d_<2;++d_) _Pragma("unroll") for(int r=0;r<16;++r)o[d_][r]*=wsf[crow(r,hi)]; } }while(0)
  f32x16 pA0,pA1,pB0,pB1;
  int sl_prev=0,sl_cur=0,sl_next=SLOTB;
  #define ROT() do{sl_prev=sl_cur;sl_cur=sl_next;sl_next=(sl_next==(NSLOT-1)*SLOTB)?0:sl_next+SLOTB;}while(0)
  DMA_K(2,2*SLOTB);
  WAIT_BAR(5);
  qkt(pA0,pA1,Kbase,qr,negm,r32,hi);asm volatile("s_nop 15\n\ts_nop 7":"+v"(pA0),"+v"(pA1));CMASK(pA0,pA1,0);
  START(pA0,pA1);
  _Pragma("unroll") for(int r=0;r<16;++r)pA1[r]=__builtin_amdgcn_exp2f(pA1[r]);
  WAIT_BAR(0);
  DMA_K(3,0);DMA_V(1,SLOTB);
  ROT();
  kload8(kf,kp0+KOFF(sl_cur));
  WAIT_BAR(3);
  s16x4 vlo[8],vhi[8]; u32x4 pw0,pw1,pw2,pw3;
  #define PKW(P,B) cvtpk_s(P[B],P[B+1])
  #define PAF(k) __builtin_bit_cast(bf16x8,pw##k)
  #define VFR(i) (bf16x8){vlo[i][0],vlo[i][1],vlo[i][2],vlo[i][3],vhi[i][0],vhi[i][1],vhi[i][2],vhi[i][3]}
  #define PIN(x) asm volatile("":"+v"(x))
  #define MX3(a,b,c) __builtin_fmaxf(__builtin_fmaxf((a),(b)),(c))
  #define GAPA(MF,A0,A1,A2,A3,W0,W1,PW) do{ MF; sacc+=A0; sacc+=A1; sacc+=A2; sacc+=A3; PIN(sacc); W0; W1; PIN(PW); SBAR(); }while(0)
  #define EX(v) __builtin_amdgcn_exp2f(v)
  #define GAPB(MF,X,B) do{ MF; X[B]=EX(X[B]); X[B+1]=EX(X[B+1]); X[B+2]=EX(X[B+2]); X[B+3]=EX(X[B+3]); PIN(X); SBAR(); }while(0)
  #define VRD(i) do{ vlo[i]=vtr(vp_+(((i)>>2)*4096+((i)&3)*1024)); vhi[i]=vtr(vp_+(((i)>>2)*4096+((i)&3)*1024+512)); }while(0)
  #define KRD(G,j) do{ if(G){ kload2(kf,kp0+KOFF(sl_next),j); SBAR(); } }while(0)
  #define STEP(C0,C1,P0,P1,t,GK,GV,GL) do{ SBAR(); \
    const lds_cptr vp_=vp0+sl_prev; \
    VRD(0); SBAR(); float sacc=(P0[0]+P0[1]); \
    GAPA(C0=__builtin_amdgcn_mfma_f32_32x32x16_bf16(kf[0],qr[0],negm,0,0,0), P0[2],P0[3],P0[4],P0[5],     pw0[0]=PKW(P0,0), pw0[1]=PKW(P0,2), pw0); \
    VRD(4); SBAR(); GAPA(C1=__builtin_amdgcn_mfma_f32_32x32x16_bf16(kf[1],qr[0],negm,0,0,0), P0[6],P0[7],P0[8],P0[9],     pw0[2]=PKW(P0,4), pw0[3]=PKW(P0,6), pw0); \
    VRD(1); SBAR(); GAPA(C0=__builtin_amdgcn_mfma_f32_32x32x16_bf16(kf[2],qr[1],C0,0,0,0),   P0[10],P0[11],P0[12],P0[13], pw1[0]=PKW(P0,8), pw1[1]=PKW(P0,10), pw1); \
    VRD(5); SBAR(); GAPA(C1=__builtin_amdgcn_mfma_f32_32x32x16_bf16(kf[3],qr[1],C1,0,0,0),   P0[14],P0[15],P1[0],P1[1],   pw1[2]=PKW(P0,12),pw1[3]=PKW(P0,14), pw1); \
    VRD(2); SBAR(); GAPA(C0=__builtin_amdgcn_mfma_f32_32x32x16_bf16(kf[4],qr[2],C0,0,0,0),   P1[2],P1[3],P1[4],P1[5],     pw2[0]=PKW(P1,0), pw2[1]=PKW(P1,2), pw2); \
    VRD(6); SBAR(); GAPA(C1=__builtin_amdgcn_mfma_f32_32x32x16_bf16(kf[5],qr[2],C1,0,0,0),   P1[6],P1[7],P1[8],P1[9],     pw2[2]=PKW(P1,4), pw2[3]=PKW(P1,6), pw2); \
    VRD(3); SBAR(); GAPA(C0=__builtin_amdgcn_mfma_f32_32x32x16_bf16(kf[6],qr[3],C0,0,0,0),   P1[10],P1[11],P1[12],P1[13], pw3[0]=PKW(P1,8), pw3[1]=PKW(P1,10), pw3); \
    VRD(7); SBAR(); GAPA(C1=__builtin_amdgcn_mfma_f32_32x32x16_bf16(kf[7],qr[3],C1,0,0,0),   P1[14],P1[15],0.f,0.f,       pw3[2]=PKW(P1,12),pw3[3]=PKW(P1,14), pw3); \
    C0=__builtin_amdgcn_mfma_f32_32x32x16_bf16(kf[8],qr[4],C0,0,0,0); C1=__builtin_amdgcn_mfma_f32_32x32x16_bf16(kf[9],qr[4],C1,0,0,0); C0=__builtin_amdgcn_mfma_f32_32x32x16_bf16(kf[10],qr[5],C0,0,0,0); C1=__builtin_amdgcn_mfma_f32_32x32x16_bf16(kf[11],qr[5],C1,0,0,0); SBAR(); \
    l_reg+=sacc; \
    if(GK){DMA_K((t)+3,sl_cur);} if(GV){DMA_V((t)+1,sl_next);} \
    CMASK(C0,C1,t); \
    { float a=MX3(C0[0],C0[1],C1[0]),b=MX3(C0[2],C0[3],C1[1]); a=MX3(a,C1[2],C1[3]); \
      _Pragma("unroll") for(int r=4;r<16;r+=4){a=MX3(a,C0[r],C0[r+1]);b=MX3(b,C0[r+2],C0[r+3]);a=MX3(a,C1[r],C1[r+1]);b=MX3(b,C1[r+2],C1[r+3]);} \
      float rm=__builtin_fmaxf(a,b); { auto rr=__builtin_amdgcn_permlane32_swap(__float_as_uint(rm),__float_as_uint(rm),false,false); rm=__builtin_fmaxf(__uint_as_float(rr[0]),__uint_as_float(rr[1])); } \
      resc=false; \
      if(__builtin_expect(__any(rm>(float)THRL),0)){ const float dl=__builtin_fmaxf(rm,0.f); mhat+=dl; \
        _Pragma("unroll") for(int r=0;r<16;++r){C0[r]-=dl;C1[r]-=dl;} \
        _Pragma("unroll") for(int r=0;r<16;++r)negm[r]=-mhat; asm volatile("":"+v"(negm)); \
        const float f=__builtin_amdgcn_exp2f(-dl); l_reg*=f; if(hi==0)wsf[r32]=f; resc=true; } } \
    SBAR(); \
    GAPB(o[0]=__builtin_amdgcn_mfma_f32_32x32x16_bf16(PAF(0),VFR(0),o[0],0,0,0), C0,0); \
    GAPB(o[1]=__builtin_amdgcn_mfma_f32_32x32x16_bf16(PAF(0),VFR(4),o[1],0,0,0), C0,4); \
    KRD(GL,0); GAPB(o[0]=__builtin_amdgcn_mfma_f32_32x32x16_bf16(PAF(1),VFR(1),o[0],0,0,0), C0,8); \
    KRD(GL,1); GAPB(o[1]=__builtin_amdgcn_mfma_f32_32x32x16_bf16(PAF(1),VFR(5),o[1],0,0,0), C0,12); \
    KRD(GL,2); GAPB(o[0]=__builtin_amdgcn_mfma_f32_32x32x16_bf16(PAF(2),VFR(2),o[0],0,0,0), C1,0); \
    KRD(GL,3); GAPB(o[1]=__builtin_amdgcn_mfma_f32_32x32x16_bf16(PAF(2),VFR(6),o[1],0,0,0), C1,4); \
    KRD(GL,4); GAPB(o[0]=__builtin_amdgcn_mfma_f32_32x32x16_bf16(PAF(3),VFR(3),o[0],0,0,0), C1,8); \
    KRD(GL,5); GAPB(o[1]=__builtin_amdgcn_mfma_f32_32x32x16_bf16(PAF(3),VFR(7),o[1],0,0,0), C1,12); \
    }while(0)
  int t=1;
  for(;t+5<NT;t+=2){
    STEP(pB0,pB1,pA0,pA1,t,true,true,true);     WAIT_BAR(3); RESC(); ROT();
    STEP(pA0,pA1,pB0,pB1,t+1,true,true,true);   WAIT_BAR(3); RESC(); ROT();
  }
  #define ENDW(tt) do{ if((tt)+3<NT){WAIT_BAR(3);} else if((tt)+2<NT){WAIT_BAR(1);} else {WAIT_BAR(0);} }while(0)
  for(;t+1<NT;t+=2){
    STEP(pB0,pB1,pA0,pA1,t,(t+3<NT),(t+1<NT),(t+1<NT));       ENDW(t);   RESC(); ROT();
    STEP(pA0,pA1,pB0,pB1,t+1,(t+4<NT),(t+2<NT),(t+2<NT));     ENDW(t+1); RESC(); ROT();
  }
  STEP(pB0,pB1,pA0,pA1,NT-1,false,false,false); RESC();
  { float sacc=pB0[0]+pB0[1]; _Pragma("unroll") for(int r=2;r<16;++r)sacc+=pB0[r]; _Pragma("unroll") for(int r=0;r<16;++r)sacc+=pB1[r]; l_reg+=sacc;
    pw0=(u32x4){PKW(pB0,0),PKW(pB0,2),PKW(pB0,4),PKW(pB0,6)};pw1=(u32x4){PKW(pB0,8),PKW(pB0,10),PKW(pB0,12),PKW(pB0,14)};pw2=(u32x4){PKW(pB1,0),PKW(pB1,2),PKW(pB1,4),PKW(pB1,6)};pw3=(u32x4){PKW(pB1,8),PKW(pB1,10),PKW(pB1,12),PKW(pB1,14)};
    SBAR(); pv(o,vb0+sl_cur,PAF(0),PAF(1),PAF(2),PAF(3)); }
  #undef PKW
  #undef PAF
  #undef VFR
  #undef PIN
  #undef MX3
  #undef GAPA
  #undef GAPB
  #undef EX
  #undef VRD
  #undef KRD
  #undef STEP
  #undef ENDW
  {auto rr=__builtin_amdgcn_permlane32_swap(__float_as_uint(l_reg),__float_as_uint(l_reg),false,false);l_reg=__uint_as_float(rr[0])+__uint_as_float(rr[1]);}
  if(hi==0)wsf[32+r32]=l_reg;asm volatile("s_waitcnt lgkmcnt(0)":::"memory");
  float rli[16];
  #pragma unroll
  for(int r=0;r<16;++r)rli[r]=__builtin_amdgcn_rcpf(wsf[32+crow(r,hi)]);
  bf16*Ow=O+(long)(qrow0+wid*QBLK)*1024+oc0;
  { bf16*stg=(bf16*)(shm+LDS_OST)+wid*2048;
    #pragma unroll
    for(int r=0;r<16;++r){const int orow=crow(r,hi);
      #pragma unroll
      for(int d0=0;d0<2;++d0)stg[orow*64+d0*32+r32]=(bf16)(cvtpk_s(o[d0][r]*rli[r],0.f)&0xffffu);}
    asm volatile("s_waitcnt lgkmcnt(0)":::"memory");
    #pragma unroll
    for(int i=0;i<4;++i){const int row=i*8+(lane>>3),ch=lane&7; const u32x4 v=*(const u32x4*)(stg+row*64+ch*8); ATTN_STORE16(Ow+(long)row*1024+ch*8,v);} }
  asm volatile("s_waitcnt lgkmcnt(0)\n\ts_barrier":::"memory");
  #undef DMA_K
  #undef DMA_V
  #undef TROW0
  #undef CMASK
  #undef START
  #undef RESC
  #undef ROT
}
#undef SBAR
#undef WAIT_BAR
#undef KOFF
}

struct Args { const float* in[27]; float* out; unsigned char* ws; int ph_lo, ph_hi; };
struct Frame {
    LAS unsigned char* lds; unsigned char* ws; gu32* ctl; int wave, G, gw, NGW;
};
__device__ __forceinline__ int lthread(int wave) { return wave * 64 + lane_id_v(); }

template <int MODE>
__device__ __forceinline__ void conv_item(const float* W, int K, int N, bf16* WT, LAS float* scr, int item, int lane) {
    const int nblk = (N + 63) / 64, kb = item / nblk, nb = item % nblk, k0 = 64 * kb, n0 = 64 * nb;
    f32x4 v[16];
    const int cc = (lane & 15) * 4, rk = lane >> 4;
    const bool ok = (n0 + cc) < N;
#pragma unroll
    for (int i = 0; i < 16; ++i) v[i] = ok ? *(const f32x4*)(W + (size_t)(k0 + 4 * i + rk) * N + n0 + cc) : (f32x4){0.f, 0.f, 0.f, 0.f};
#pragma unroll
    for (int i = 0; i < 16; ++i) { LAS float* s = scr + (4 * i + rk) * 65 + cc; s[0] = v[i][0]; s[1] = v[i][1]; s[2] = v[i][2]; s[3] = v[i][3]; }
    LDS_WAIT(); asm volatile("" ::: "memory");
    const int c = lane & 7;
#pragma unroll
    for (int j = 0; j < 8; ++j) { const int n = (lane >> 3) + 8 * j; const LAS float* s = scr + (8 * c) * 65 + n;
        v4u o; o.x = pk2(s[0], s[65]); o.y = pk2(s[2 * 65], s[3 * 65]); o.z = pk2(s[4 * 65], s[5 * 65]); o.w = pk2(s[6 * 65], s[7 * 65]);
        const int ng = n0 + n; if (ng < N) { const int dr = (MODE == 1) ? ((ng >> 8) * 256 + (ng & 1) * 128 + ((ng >> 1) & 127)) : ng; *(v4u*)(WT + (size_t)dr * K + k0 + 8 * c) = o; } }
    LDS_WAIT(); asm volatile("" ::: "memory");
}

__device__ __forceinline__ void prologue(Frame& F, const Args& a) {
    const int f_tid = lthread(F.wave), f_lane = f_tid & 63;
    unsigned char* ws = F.ws;
    {
        LAS float* scr = (LAS float*)(F.lds + F.wave * 16640);
        struct M { const float* src; int K, N; size_t dst; };
        const int I_FO = 16 * 16, I_MIN = 16 * 11, I_QB = 6 * 24, I_KVB = 4 * 32, I_MO = 256, I_GQKV = 16 * 24, I_GO = 256;
        const int NSMALL = 2 * I_FO + I_MIN + I_QB + I_KVB + I_MO + I_GQKV + I_GO;
        for (int it = F.gw; it < NSMALL; it += F.NGW) {
            int r = it;
            if (r < 2 * I_FO) { const int j = r / I_FO; conv_item<0>(a.in[10] + (size_t)j * D * D, D, D, (bf16*)(ws + WS_WFOUT) + (size_t)j * D * D, scr, r % I_FO, f_lane); continue; } r -= 2 * I_FO;
            if (r < I_MIN) { conv_item<0>(a.in[11], D, MLA_IN, (bf16*)(ws + WS_WMIN), scr, r, f_lane); continue; } r -= I_MIN;
            if (r < I_QB) { conv_item<0>(a.in[13], MLA_QL, 1536, (bf16*)(ws + WS_WMQB), scr, r, f_lane); continue; } r -= I_QB;
            if (r < I_KVB) { conv_item<0>(a.in[15], MLA_KVL, 2048, (bf16*)(ws + WS_WMKVB), scr, r, f_lane); continue; } r -= I_KVB;
            if (r < I_MO) { conv_item<0>(a.in[16], D, D, (bf16*)(ws + WS_WMO), scr, r, f_lane); continue; } r -= I_MO;
            if (r < I_GQKV) { conv_item<0>(a.in[17], D, GQA_QKV, (bf16*)(ws + WS_WGQKV), scr, r, f_lane); continue; } r -= I_GQKV;
            conv_item<0>(a.in[20], D, D, (bf16*)(ws + WS_WGO), scr, r, f_lane);
        }
    }
    __syncthreads();
    {
        LAS float* cmax = (LAS float*)F.lds;
        LAS float* cinv = cmax + 512;
        LAS unsigned* scr8 = (LAS unsigned*)(F.lds + 4096) + F.wave * (64 * 33);
        const int cc = (f_lane & 15) * 4, rk = f_lane >> 4;
        constexpr int NGU = DEPTH * NE * 32, NDN = DEPTH * NE * 16;
        for (int it = blockIdx.x; it < NGU + NDN; it += F.G) {
            const bool dn = it >= NGU; const int q_ = dn ? it - NGU : it; const int le = dn ? (q_ >> 4) : (q_ >> 5), strip = dn ? (q_ & 15) : (q_ & 31);
            const int N = dn ? 1024 : 2048;
            const float* W = (dn ? a.in[25] + (size_t)le * DFF * D : a.in[23] + (size_t)le * D * 2048) + strip * 64 + cc;
            f32x4 v[32];
#pragma unroll
            for (int i = 0; i < 32; ++i) v[i] = *(const f32x4*)(W + (size_t)(F.wave * 128 + 16 * (i >> 2) + 4 * rk + (i & 3)) * N);
            f32x4 mx = (f32x4){0.f, 0.f, 0.f, 0.f};
#pragma unroll
            for (int i = 0; i < 32; ++i) { mx[0] = fmaxf(mx[0], fabsf(v[i][0])); mx[1] = fmaxf(mx[1], fabsf(v[i][1])); mx[2] = fmaxf(mx[2], fabsf(v[i][2])); mx[3] = fmaxf(mx[3], fabsf(v[i][3])); }
#pragma unroll
            for (int q = 0; q < 4; ++q) { mx[q] = fmaxf(mx[q], shx(mx[q], 16, f_lane)); mx[q] = fmaxf(mx[q], shx(mx[q], 32, f_lane)); }
            __syncthreads();
            if (rk == 0) { LAS float* d = cmax + F.wave * 64 + cc; d[0] = mx[0]; d[1] = mx[1]; d[2] = mx[2]; d[3] = mx[3]; }
            __syncthreads();
            const float target = dn ? 240.f : 127.f;
            if (f_tid < 64) { float m8 = 0.f;
#pragma unroll
                for (int w = 0; w < 8; ++w) m8 = fmaxf(m8, cmax[w * 64 + f_tid]);
                const int ng = strip * 64 + f_tid, dr = dn ? ng : (ng >> 8) * 256 + (ng & 1) * 128 + ((ng >> 1) & 127);
                float* sc = dn ? (float*)(ws + WS_SWDN) + (size_t)le * 1024 : (float*)(ws + WS_SWGU) + (size_t)le * 2048;
                sc[dr] = (m8 > 0.f) ? m8 / target : 1.f;
                cinv[f_tid] = (m8 > 0.f) ? target / m8 : 0.f; }
            __syncthreads();
            const f32x4 iv = *(const LAS f32x4*)(cinv + cc);
#pragma unroll
            for (int ip = 0; ip < 8; ++ip) {
#pragma unroll
                for (int q = 0; q < 4; ++q) { unsigned w = 0;
                    if (dn) { int t = __builtin_amdgcn_cvt_pk_fp8_f32(v[4 * ip][q] * iv[q], v[4 * ip + 1][q] * iv[q], 0, false); t = __builtin_amdgcn_cvt_pk_fp8_f32(v[4 * ip + 2][q] * iv[q], v[4 * ip + 3][q] * iv[q], t, true); w = (unsigned)t; }
                    else {
#pragma unroll
                        for (int j = 0; j < 4; ++j) { int qi = __float2int_rn(v[4 * ip + j][q] * iv[q]); qi = qi > 127 ? 127 : (qi < -127 ? -127 : qi); w |= ((unsigned)qi & 255u) << (8 * j); } }
                    scr8[(cc + q) * 33 + 4 * ip + rk] = w; } }
            LDS_WAIT(); asm volatile("" ::: "memory");
            { const int c8 = f_lane & 7;
              unsigned char* dst = dn ? (unsigned char*)(ws + WS_WDN) + (size_t)le * 1024 * 1024 : (unsigned char*)(ws + WS_WGU) + (size_t)le * 2048 * 1024;
#pragma unroll
              for (int jp = 0; jp < 8; ++jp) { const int n = (f_lane >> 3) + 8 * jp; const LAS unsigned* sp = scr8 + n * 33 + 4 * c8;
                  v4u o; o.x = sp[0]; o.y = sp[1]; o.z = sp[2]; o[3] = sp[3];
                  const int ng = strip * 64 + n, dr = dn ? ng : (ng >> 8) * 256 + (ng & 1) * 128 + ((ng >> 1) & 127);
                  *(v4u*)(dst + (size_t)dr * 1024 + F.wave * 128 + 16 * c8) = o; } }
            LDS_WAIT(); asm volatile("" ::: "memory");
        }
        __syncthreads();
    }
    const int gtid = blockIdx.x * 512 + f_tid, gthreads = F.G * 512;
    for (int i = gtid; i < (MLA_IN_PAD - MLA_IN) * D / 8; i += gthreads) ((v4u*)((bf16*)(ws + WS_WMIN) + (size_t)MLA_IN * D))[i] = (v4u){0u, 0u, 0u, 0u};
    {
        bf16* MA = (bf16*)(ws + WS_MA);
        for (int i = gtid; i < 256 * 256; i += gthreads) { const int row = i >> 8, col = i & 255, jp = row >> 7, pp = (row >> 6) & 1, k1 = row & 63, j = col >> 7, pt = (col >> 6) & 1, l1 = col & 63;
            float v = 0.f; if (j == jp) { const float x = 2.f * (float)((k1 * l1) & 63) / 64.f; const float cs = cospif(x), sn = sinpif(x); v = (pp == 0) ? (pt == 0 ? cs : sn) : (pt == 0 ? -sn : cs); }
            MA[i] = (bf16)(pk2(v, 0.f) & 0xffffu); }
        bf16* DC = (bf16*)(ws + WS_DC); const float sc = 1.0f / sqrtf(256.f * 128.f);
        for (int i = gtid; i < 256 * 512; i += gthreads) { const int k = i >> 9, col = i & 511, pt = col >> 8, l = col & 255; const float x = 2.f * (float)((k * l) & 255) / 256.f;
            const float v = (pt == 0 ? cospif(x) : sinpif(x)) * sc; DC[i] = (bf16)(pk2(v, 0.f) & 0xffffu); }
        bf16* MC = (bf16*)(ws + WS_MC); const float sl = 1.0f / sqrtf(4096.f * 128.f);
        for (int i = gtid; i < 16 * 256 * 512; i += gthreads) { const int kq = i >> 17, row = (i >> 9) & 255, col = i & 511, kkp = row >> 6, k2 = row & 63, kk = col >> 7, pp = (col >> 6) & 1, l2 = col & 63;
            float v = 0.f; if (kk == kkp) { const int k = 4 * kq + kkp + 64 * k2; const float x = 2.f * (float)((l2 * k) & 4095) / 4096.f; v = (pp == 0 ? cospif(x) : sinpif(x)) * sl; }
            MC[i] = (bf16)(pk2(v, 0.f) & 0xffffu); }
        float* RM = (float*)(ws + WS_ROPE); float* RG = RM + 2048;
        for (int i = gtid; i < 64 * 8; i += gthreads) { const int pos = i >> 3, f = i & 7; const float inv = powf(10000.f, -(float)f / 8.f); float s, c; sincosf((float)pos * inv, &s, &c); RM[2 * i] = c; RM[2 * i + 1] = s; }
        for (int i = gtid; i < 64 * 16; i += gthreads) { const int pos = i >> 4, f = i & 15; const float inv = powf(10000.f, -(float)f / 16.f); float s, c; sincosf((float)pos * inv, &s, &c); RG[2 * i] = c; RG[2 * i + 1] = s; }
        float* WRT = (float*)(ws + WS_WRT);
        for (int i = gtid; i < DEPTH * NE * D; i += gthreads) { const int l = i >> 15, e = (i >> 10) & 31, k = i & 1023; WRT[i] = a.in[21][((size_t)l * D + k) * NE + e]; }
        float* BG = (float*)(ws + WS_BGU);
        for (int i = gtid; i < DEPTH * NE * 2048; i += gthreads) { const int le = i >> 11, q = i & 2047, pn = q >> 8, s = (q >> 7) & 1, jj = q & 127; BG[i] = a.in[24][(size_t)le * 2048 + 2 * (pn * 128 + jj) + s]; }
    }
    __syncthreads();
    {
        LAS float* wl = (LAS float*)F.lds;
        LAS float* tc = wl + 2048; LAS float* ts = tc + 128;
        if (f_tid < 128) { const float x = 2.f * (float)f_tid / 128.f; tc[f_tid] = cospif(x); ts[f_tid] = -sinpif(x); }
        for (int it = blockIdx.x; it < 2 * 8 * 64; it += F.G) { const int j = it >> 9, g = (it >> 6) & 7, kb = it & 63;
            __syncthreads();
            { const int kk = f_tid >> 5, c4 = (f_tid & 31) * 4; const f32x4 w = *(const f32x4*)(a.in[9] + ((size_t)j * D + kb * 16 + kk) * D + g * 128 + c4);
              LAS float* d = wl + c4 * 16 + kk; d[0] = w[0]; d[16] = w[1]; d[32] = w[2]; d[48] = w[3]; }
            __syncthreads();
            const int cl = f_tid & 255, m = cl >> 1, part = cl & 1, kh = f_tid >> 8; const LAS float* tw = part ? ts : tc;
            float accv[8];
#pragma unroll
            for (int q = 0; q < 8; ++q) accv[q] = 0.f;
            for (int jj = 0; jj < 128; ++jj) { const float t = tw[(m * jj) & 127]; const f32x4 wa = *(const LAS f32x4*)(wl + jj * 16 + kh * 8), wb = *(const LAS f32x4*)(wl + jj * 16 + kh * 8 + 4);
                accv[0] += wa[0] * t; accv[1] += wa[1] * t; accv[2] += wa[2] * t; accv[3] += wa[3] * t; accv[4] += wb[0] * t; accv[5] += wb[1] * t; accv[6] += wb[2] * t; accv[7] += wb[3] * t; }
            v4u o; o.x = pk2(accv[0], accv[1]); o.y = pk2(accv[2], accv[3]); o.z = pk2(accv[4], accv[5]); o.w = pk2(accv[6], accv[7]);
            *(v4u*)((bf16*)(ws + WS_WFIN) + ((size_t)j * 2048 + g * 256 + cl) * D + kb * 16 + kh * 8) = o;
        }
        __syncthreads();
    }
    {
        LAS float* S = (LAS float*)F.lds;
        LAS float* red = S + 9 * 1024;
        for (int i = f_tid; i < 9 * 1024; i += 512) { const int r = i >> 10, k = i & 1023; const float v = (r < 8) ? a.in[1][r * D + k] : a.in[3][k]; S[i] = v / (1.f + __expf(-v)); }
        __syncthreads();
        for (int it = blockIdx.x; it < DEPTH * 96; it += F.G) { const int l = it / 96, n0 = (it % 96) * 64;
            const float* wp = a.in[4] + ((size_t)l * D + F.wave * 128) * (NMOD * D) + n0 + f_lane;
            float accv[9];
#pragma unroll
            for (int r = 0; r < 9; ++r) accv[r] = 0.f;
            for (int k0 = 0; k0 < 128; k0 += 32) { float wv[32];
#pragma unroll
                for (int k = 0; k < 32; ++k) wv[k] = wp[(size_t)(k0 + k) * (NMOD * D)];
#pragma unroll
                for (int k = 0; k < 32; ++k)
#pragma unroll
                    for (int r = 0; r < 9; ++r) accv[r] += S[r * 1024 + F.wave * 128 + k0 + k] * wv[k]; }
#pragma unroll
            for (int r = 0; r < 9; ++r) red[(F.wave * 9 + r) * 64 + f_lane] = accv[r];
            __syncthreads();
            for (int i = f_tid; i < 9 * 64; i += 512) { const int r = i >> 6, ln = i & 63; float s = a.in[5][(size_t)l * (NMOD * D) + n0 + ln];
#pragma unroll
                for (int w = 0; w < 8; ++w) s += red[(w * 9 + r) * 64 + ln];
                ((float*)(ws + WS_MOD))[((size_t)l * 9 + r) * (NMOD * D) + n0 + ln] = s; }
            __syncthreads();
        }
    }
}

__device__ __forceinline__ void load_row(const float* p, int lane, f32x4 (&v)[4]) {
#pragma unroll
    for (int j = 0; j < 4; ++j) v[j] = ((const f32x4*)p)[lane + 64 * j];
}
__device__ __forceinline__ void load_row_bf(const bf16* p, int lane, f32x4 (&v)[4]) {
#pragma unroll
    for (int j = 0; j < 4; ++j) { const v2u w = ((const v2u*)p)[lane + 64 * j]; v[j] = (f32x4){bf_lo(w.x), bf_hi(w.x), bf_lo(w.y), bf_hi(w.y)}; }
}
__device__ __forceinline__ void norm_mod(f32x4 (&v)[4], const float* g, const float* shift, const float* scale, int lane) {
    float s = 0.f;
#pragma unroll
    for (int j = 0; j < 4; ++j) s += (v[j][0] * v[j][0] + v[j][1] * v[j][1]) + (v[j][2] * v[j][2] + v[j][3] * v[j][3]);
    const float rstd = rsqrtf(wave_sum(s, lane) * (1.f / D) + EPS);
#pragma unroll
    for (int j = 0; j < 4; ++j) { const f32x4 gv = ((const f32x4*)g)[lane + 64 * j], sh = ((const f32x4*)shift)[lane + 64 * j], sc = ((const f32x4*)scale)[lane + 64 * j];
        v[j] = (v[j] * rstd * gv) * (sc + 1.f) + sh; }
}
__device__ __forceinline__ void store_row_bf16(bf16* p, int lane, const f32x4 (&v)[4]) {
#pragma unroll
    for (int j = 0; j < 4; ++j) { v2u w; w.x = pk2(v[j][0], v[j][1]); w.y = pk2(v[j][2], v[j][3]); ((v2u*)p)[lane + 64 * j] = w; }
}

__device__ __forceinline__ float store_row_i8(unsigned char* p, int lane, const f32x4 (&v)[4]) {
    float am = 0.f;
#pragma unroll
    for (int j = 0; j < 4; ++j) am = fmaxf(fmaxf(am, fmaxf(fabsf(v[j][0]), fabsf(v[j][1]))), fmaxf(fabsf(v[j][2]), fabsf(v[j][3])));
    unsigned k = __float_as_uint(am);
    { unsigned t;
      t = (unsigned)__builtin_amdgcn_mov_dpp((int)k, 0xb1, 0xf, 0xf, false); k = k > t ? k : t;
      t = (unsigned)__builtin_amdgcn_mov_dpp((int)k, 0x4e, 0xf, 0xf, false); k = k > t ? k : t;
      t = (unsigned)__builtin_amdgcn_mov_dpp((int)k, 0x124, 0xf, 0xf, false); k = k > t ? k : t;
      t = (unsigned)__builtin_amdgcn_mov_dpp((int)k, 0x128, 0xf, 0xf, false); k = k > t ? k : t;
      const unsigned a = (unsigned)__builtin_amdgcn_readlane((int)k, 0), b = (unsigned)__builtin_amdgcn_readlane((int)k, 16), c = (unsigned)__builtin_amdgcn_readlane((int)k, 32), d = (unsigned)__builtin_amdgcn_readlane((int)k, 48);
      const unsigned ab = a > b ? a : b, cd = c > d ? c : d; k = ab > cd ? ab : cd; }
    const float amax = __uint_as_float(k);
    const float qscale = amax > 0.f ? amax * (1.f / 127.f) : 1.f, qinv = amax > 0.f ? 127.f / amax : 0.f;
#pragma unroll
    for (int j = 0; j < 4; ++j) { unsigned w = 0;
#pragma unroll
        for (int q = 0; q < 4; ++q) { int qi = __float2int_rn(v[j][q] * qinv); qi = qi > 127 ? 127 : (qi < -127 ? -127 : qi); w |= ((unsigned)qi & 255u) << (8 * q); }
        ((unsigned*)p)[lane + 64 * j] = w; }
    return qscale;
}
__device__ __forceinline__ void quant_rows(Frame& F, const bf16* src, unsigned char* dst, float* scale, int R) {
    const int f_lane = lthread(F.wave) & 63;
    for (int r = F.gw; r < R; r += F.NGW) { f32x4 v[4]; load_row_bf(src + (size_t)r * 1024, f_lane, v);
        const float sc = store_row_i8(dst + (size_t)r * 1024, f_lane, v); if (f_lane == 0) scale[r] = sc; }
}
__device__ __forceinline__ void rp_norm1(Frame& F, const Args& a, int l, int row_lo) {
    const int f_tid = lthread(F.wave), f_lane = f_tid & 63;
    const bf16* X = (const bf16*)(F.ws + WS_X); bf16* H = (bf16*)(F.ws + WS_H); const float* MOD = (const float*)(F.ws + WS_MOD) + (size_t)l * 9 * (NMOD * D);
    for (int row = row_lo + F.gw; row < NT; row += F.NGW) { f32x4 v[4];
        if (l == 0) load_row(row < NC ? a.in[2] + (size_t)row * D : a.in[0] + (size_t)(row - NC) * D, f_lane, v);
        else load_row_bf(X + (size_t)row * D, f_lane, v);
        const float* m = MOD + (size_t)modrow_of(row) * (NMOD * D);
        norm_mod(v, a.in[6] + (size_t)l * D, m, m + D, f_lane);
        const float sc = store_row_i8((unsigned char*)H + (size_t)row * D, f_lane, v); if (f_lane == 0) ((float*)(F.ws + WS_SH))[row] = sc; }
}

#if MK_N2V2
constexpr int LDS_LIST = LDS_MISC + 768;
__device__ __forceinline__ unsigned row16_max(unsigned k) {
    unsigned t;
    t = (unsigned)__builtin_amdgcn_mov_dpp((int)k, 0xb1, 0xf, 0xf, false); k = k > t ? k : t;
    t = (unsigned)__builtin_amdgcn_mov_dpp((int)k, 0x4e, 0xf, 0xf, false); k = k > t ? k : t;
    t = (unsigned)__builtin_amdgcn_mov_dpp((int)k, 0x124, 0xf, 0xf, false); k = k > t ? k : t;
    t = (unsigned)__builtin_amdgcn_mov_dpp((int)k, 0x128, 0xf, 0xf, false); k = k > t ? k : t;
    return k;
}
__device__ __forceinline__ unsigned wave_max_u(unsigned k) {
    k = row16_max(k);
    const unsigned a = (unsigned)__builtin_amdgcn_readlane((int)k, 0), b = (unsigned)__builtin_amdgcn_readlane((int)k, 16), c = (unsigned)__builtin_amdgcn_readlane((int)k, 32), d = (unsigned)__builtin_amdgcn_readlane((int)k, 48);
    const unsigned ab = a > b ? a : b, cd = c > d ? c : d; return ab > cd ? ab : cd;
}
__device__ __forceinline__ float key_val(unsigned m) { const unsigned u = m & ~31u; return __builtin_bit_cast(float, (u & 0x80000000u) ? (u ^ 0x80000000u) : ~u); }
constexpr int N2_WPITCH = 2064;
constexpr int N2_GM = 32 * N2_WPITCH;
constexpr int N2_LIST = N2_GM + 5 * 8192;
__device__ __forceinline__ void rp_norm2_router(Frame& F, const Args& a, int l, int row_lo) {
    const int f_tid = lthread(F.wave), f_lane = f_tid & 63;
    const bf16* X = (const bf16*)(F.ws + WS_X); unsigned char* H8 = (unsigned char*)(F.ws + WS_H); const float* MOD = (const float*)(F.ws + WS_MOD) + (size_t)l * 9 * (NMOD * D);
    LAS unsigned char* WT = F.lds;
    { const f32x4* src = (const f32x4*)((const float*)(F.ws + WS_WRT) + (size_t)l * NE * D); f32x4 tv[16];
#pragma unroll
      for (int i = 0; i < 16; ++i) tv[i] = src[f_tid + 512 * i];
#pragma unroll
      for (int i = 0; i < 16; ++i) { const int i4 = f_tid + 512 * i, e = i4 >> 8, k4 = (i4 & 255) * 4; v2u w; w.x = pk2(tv[i][0], tv[i][1]); w.y = pk2(tv[i][2], tv[i][3]); *(LAS v2u*)(WT + e * N2_WPITCH + k4 * 2) = w; } }
    LAS int* lcnt = (LAS int*)(F.lds + LDS_TT); LAS int* lbase = lcnt + 32;
    if (f_tid < 32) lcnt[f_tid] = 0;
    const int ngroups = (NT - row_lo) >> 5;
    const int g = F.wave * F.G + (int)blockIdx.x;
    const bool active = (F.wave < 5) && (g < ngroups);
    LAS float* GM = (LAS float*)(F.lds + N2_GM + (F.wave < 5 ? F.wave : 0) * 8192); LAS float* SH = GM + 1024;
    LAS v4u* list = (LAS v4u*)(F.lds + N2_LIST + (F.wave < 5 ? F.wave : 0) * (128 * 16 + 128)); LAS float* lsc = (LAS float*)(list + 128);
    const int r = f_lane & 31, kh = f_lane >> 5;
    const int row = row_lo + g * 32 + r;
    float msh = 0.f;
    if (active) {
        const float* m = MOD + (size_t)modrow_of(row_lo + g * 32) * (NMOD * D); const float* gf = a.in[7] + (size_t)l * D;
#pragma unroll
        for (int j = 0; j < 4; ++j) { const f32x4 gv = ((const f32x4*)gf)[f_lane + 64 * j], sc = ((const f32x4*)(m + 4 * D))[f_lane + 64 * j], sv = ((const f32x4*)(m + 3 * D))[f_lane + 64 * j];
            ((LAS f32x4*)GM)[f_lane + 64 * j] = gv * (sc + 1.f); ((LAS f32x4*)SH)[f_lane + 64 * j] = sv;
            msh = fmaxf(fmaxf(msh, fmaxf(fabsf(sv[0]), fabsf(sv[1]))), fmaxf(fabsf(sv[2]), fabsf(sv[3]))); }
        msh = __uint_as_float(wave_max_u(__float_as_uint(msh)));
    }
    __syncthreads();
    if (active) {
        const bf16* xr = X + (size_t)row * D + 16 * kh;
        float ssq = 0.f, mxg = 0.f;
#pragma unroll 1
        for (int c0 = 0; c0 < 32; c0 += 8) { v4u xa[8], xb[8];
#pragma unroll
            for (int i = 0; i < 8; ++i) { xa[i] = *(const v4u*)(xr + 32 * (c0 + i)); xb[i] = *(const v4u*)(xr + 32 * (c0 + i) + 8); }
#pragma unroll
            for (int i = 0; i < 8; ++i) { const LAS f32x4* gp = (const LAS f32x4*)(GM + 32 * (c0 + i) + 16 * kh);
                const f32x4 g0 = gp[0], g1 = gp[1], g2 = gp[2], g3 = gp[3];
                const unsigned wa[4] = {xa[i].x, xa[i].y, xa[i].z, xa[i][3]}, wb[4] = {xb[i].x, xb[i].y, xb[i].z, xb[i][3]};
#pragma unroll
                for (int q = 0; q < 4; ++q) { const float x0 = bf_lo(wa[q]), x1 = bf_hi(wa[q]), x2 = bf_lo(wb[q]), x3 = bf_hi(wb[q]);
                    ssq += x0 * x0 + x1 * x1 + x2 * x2 + x3 * x3;
                    const float ga = (q < 2 ? g0 : g1)[(2 * q) & 3], gb = (q < 2 ? g0 : g1)[(2 * q + 1) & 3], gc = (q < 2 ? g2 : g3)[(2 * q) & 3], gd = (q < 2 ? g2 : g3)[(2 * q + 1) & 3];
                    mxg = fmaxf(fmaxf(mxg, fmaxf(fabsf(x0 * ga), fabsf(x1 * gb))), fmaxf(fabsf(x2 * gc), fabsf(x3 * gd))); } } }
        { auto rr = __builtin_amdgcn_permlane32_swap(__float_as_uint(ssq), __float_as_uint(ssq), false, false); ssq = __uint_as_float(rr[0]) + __uint_as_float(rr[1]); }
        { auto rr = __builtin_amdgcn_permlane32_swap(__float_as_uint(mxg), __float_as_uint(mxg), false, false); mxg = fmaxf(__uint_as_float(rr[0]), __uint_as_float(rr[1])); }
        const float rstd = rsqrtf(ssq * (1.f / D) + EPS);
        const float bound = mxg * rstd + msh;
        const float qscale = bound > 0.f ? bound * (1.f / 127.f) : 1.f, qinv = bound > 0.f ? 127.f / bound : 0.f;
        f32x16 acc = f32x16{};
        unsigned char* hrow = H8 + (size_t)row * D + 16 * kh;
        const LAS unsigned char* wrow = WT + r * N2_WPITCH + 32 * kh;
#pragma unroll 1
        for (int c0 = 0; c0 < 32; c0 += 4) { v4u xa[4], xb[4];
#pragma unroll
            for (int i = 0; i < 4; ++i) { xa[i] = *(const v4u*)(xr + 32 * (c0 + i)); xb[i] = *(const v4u*)(xr + 32 * (c0 + i) + 8); }
#pragma unroll
            for (int i = 0; i < 4; ++i) { const int c = c0 + i;
                const LAS f32x4* gp = (const LAS f32x4*)(GM + 32 * c + 16 * kh); const LAS f32x4* sp = (const LAS f32x4*)(SH + 32 * c + 16 * kh);
                const bf16x8 w0 = *(const LAS bf16x8*)(wrow + 64 * c), w1 = *(const LAS bf16x8*)(wrow + 64 * c + 16);
                float h[16];
                const unsigned wa[4] = {xa[i].x, xa[i].y, xa[i].z, xa[i][3]}, wb[4] = {xb[i].x, xb[i].y, xb[i].z, xb[i][3]};
#pragma unroll
                for (int q = 0; q < 4; ++q) { h[2 * q] = bf_lo(wa[q]); h[2 * q + 1] = bf_hi(wa[q]); h[8 + 2 * q] = bf_lo(wb[q]); h[8 + 2 * q + 1] = bf_hi(wb[q]); }
#pragma unroll
                for (int q = 0; q < 4; ++q) { const f32x4 gq = gp[q], sq = sp[q];
#pragma unroll
                    for (int e = 0; e < 4; ++e) h[4 * q + e] = (h[4 * q + e] * rstd) * gq[e] + sq[e]; }
                v4u o8;
#pragma unroll
                for (int q = 0; q < 4; ++q) { unsigned w = 0;
#pragma unroll
                    for (int e = 0; e < 4; ++e) w |= ((unsigned)__float2int_rn(h[4 * q + e] * qinv) & 255u) << (8 * e);
                    o8[q] = w; }
                *(v4u*)(hrow + 32 * c) = o8;
                v4u hi0, hi1, lo0, lo1;
#pragma unroll
                for (int q = 0; q < 4; ++q) { hi0[q] = pk2(h[2 * q], h[2 * q + 1]); hi1[q] = pk2(h[8 + 2 * q], h[8 + 2 * q + 1]); }
#pragma unroll
                for (int q = 0; q < 4; ++q) { lo0[q] = pk2(h[2 * q] - bf_lo(hi0[q]), h[2 * q + 1] - bf_hi(hi0[q])); lo1[q] = pk2(h[8 + 2 * q] - bf_lo(hi1[q]), h[8 + 2 * q + 1] - bf_hi(hi1[q])); }
                acc = __builtin_amdgcn_mfma_f32_32x32x16_bf16(w0, __builtin_bit_cast(bf16x8, hi0), acc, 0, 0, 0);
                acc = __builtin_amdgcn_mfma_f32_32x32x16_bf16(w0, __builtin_bit_cast(bf16x8, lo0), acc, 0, 0, 0);
                acc = __builtin_amdgcn_mfma_f32_32x32x16_bf16(w1, __builtin_bit_cast(bf16x8, hi1), acc, 0, 0, 0);
                acc = __builtin_amdgcn_mfma_f32_32x32x16_bf16(w1, __builtin_bit_cast(bf16x8, lo1), acc, 0, 0, 0); } }
        float val[32];
        const float* br = a.in[22] + (size_t)l * NE;
#pragma unroll
        for (int j = 0; j < 16; ++j) { auto rr = __builtin_amdgcn_permlane32_swap(__float_as_uint(acc[j]), __float_as_uint(acc[j]), false, false);
            const int e0 = (j & 3) + 8 * (j >> 2); val[e0] = __uint_as_float(rr[0]) + br[e0]; val[e0 + 4] = __uint_as_float(rr[1]) + br[e0 + 4]; }
        unsigned taken = 0u; int be[4]; float bv[4];
#pragma unroll
        for (int k = 0; k < 4; ++k) { float best = -INFINITY; int bi = 0;
#pragma unroll
            for (int e = 0; e < 32; ++e) { const bool cnd = !((taken >> e) & 1u) && (val[e] > best); best = cnd ? val[e] : best; bi = cnd ? e : bi; }
            taken |= 1u << bi; be[k] = bi; bv[k] = best; }
        const float e1 = __expf(bv[1] - bv[0]), e2 = __expf(bv[2] - bv[0]), e3 = __expf(bv[3] - bv[0]); const float inv = 1.f / (1.f + e1 + e2 + e3);
        if (kh == 0) { const float ww[4] = {inv, e1 * inv, e2 * inv, e3 * inv};
#pragma unroll
            for (int k = 0; k < 4; ++k) { const int lr = __hip_atomic_fetch_add(lcnt + be[k], 1, __ATOMIC_RELAXED, __HIP_MEMORY_SCOPE_WORKGROUP);
                LAS unsigned* ep = (LAS unsigned*)(list + r * 4 + k); ep[0] = (unsigned)(row * 4 + k); ep[1] = (unsigned)be[k]; ep[2] = (unsigned)lr; ep[3] = __builtin_bit_cast(unsigned, ww[k]); }
            lsc[r] = qscale; }
    }
    __syncthreads();
    if (f_tid < 32) { const int c = lcnt[f_tid]; lbase[f_tid] = c ? (int)__hip_atomic_fetch_add((unsigned*)(F.ctl + CW_CNT + (l * 32 + f_tid) * 16), (unsigned)c, RLX_AGENT) : 0; }
    __syncthreads();
    if (active) {
        int* te = (int*)(F.ws + WS_TE); int* trank = (int*)(F.ws + WS_TRANK); int* stok = (int*)(F.ws + WS_STOK); float* sw = (float*)(F.ws + WS_SW); float* ssc = (float*)(F.ws + WS_SSC);
#pragma unroll
        for (int i = f_lane; i < 128; i += 64) { const LAS unsigned* ep = (const LAS unsigned*)(list + i); const unsigned rowk = ep[0], ex = ep[1], lr = ep[2]; const float wv = __builtin_bit_cast(float, ep[3]);
            const int rk = lbase[ex] + (int)lr;
            stok[(size_t)ex * CAP + rk] = (int)(rowk >> 2); sw[(size_t)ex * CAP + rk] = wv; ssc[(size_t)ex * CAP + rk] = lsc[i >> 2]; te[rowk] = (int)ex; trank[rowk] = rk; }
    }
}

#endif
__device__ __forceinline__ void moe_table(Frame& F, int l) {
    const int f_tid = lthread(F.wave), f_lane = f_tid & 63;
    LAS int* TT = (LAS int*)(F.lds + LDS_TT); LAS int* CN = TT + 64; LAS int* TE = (LAS int*)(F.lds + LDS_TE);
    __syncthreads();
    if (f_tid < 64) {
        const int c = (f_lane < 32) ? (int)__hip_atomic_load((unsigned*)(F.ctl + CW_CNT + (l * 32 + (f_lane & 31)) * 16), RLX_AGENT) : 0;
        const int tl = (c + 255) >> 8; int v = tl;
#pragma unroll
        for (int o = 1; o < 32; o <<= 1) { const int n = __builtin_amdgcn_ds_bpermute((f_lane >= o ? f_lane - o : f_lane) << 2, v); if (f_lane >= o) v += n; }
        if (f_lane < 32) { CN[f_lane] = c; TT[f_lane] = v - tl; if (f_lane == 31) TT[32] = v; }
    }
    __syncthreads();
    for (int t = f_tid; t < MAXTILES; t += 512) { int lo = 0, hi = 32;
#pragma unroll
        for (int k = 0; k < 5; ++k) { const int mid = (lo + hi) >> 1; if (TT[mid] <= t) lo = mid; else hi = mid; }
        TE[t] = lo; }
    __syncthreads();
}

#if MK_CBV2
struct CombRow { v4u x[2]; v4u y[4]; };
__device__ __forceinline__ void comb_issue(CombRow& R, const bf16* X, const unsigned char* Y, const LAS int* TT, int row, const v4u te4, const v4u tr4, int lane) {
    const unsigned ee[4] = {te4[0], te4[1], te4[2], te4[3]}, rr[4] = {tr4[0], tr4[1], tr4[2], tr4[3]};
#pragma unroll
    for (int k = 0; k < 4; ++k) { const size_t slot = (size_t)TT[ee[k]] * 256 + rr[k]; R.y[k] = *(const v4u*)(Y + slot * 1024 + 16 * lane); }
    const bf16* xp = X + (size_t)row * D + 16 * lane; R.x[0] = *(const v4u*)xp; R.x[1] = *(const v4u*)(xp + 8);
}
__device__ __forceinline__ void comb_finish(const CombRow& R, Frame& F, const Args& a, int l, int row, int lane, const float* MOD, const float* MODN, bool lastl) {
    bf16* X = (bf16*)(F.ws + WS_X); unsigned char* H8 = (unsigned char*)(F.ws + WS_H);
    const int mr = modrow_of(row); const float* g5 = MOD + (size_t)mr * (NMOD * D) + 5 * D + 16 * lane;
    float v[16];
#pragma unroll
    for (int w = 0; w < 4; ++w) { f32x4 s = (f32x4){0.f, 0.f, 0.f, 0.f};
#pragma unroll
        for (int k = 0; k < 4; ++k) { const int yw = (int)R.y[k][w]; const f32x2 lo = __builtin_amdgcn_cvt_pk_f32_fp8(yw, false), hi = __builtin_amdgcn_cvt_pk_f32_fp8(yw, true); s[0] += lo[0]; s[1] += lo[1]; s[2] += hi[0]; s[3] += hi[1]; }
        const f32x4 gv = ((const f32x4*)g5)[w]; const unsigned x0 = R.x[w >> 1][(2 * w) & 3], x1 = R.x[w >> 1][(2 * w + 1) & 3];
        v[4 * w] = bf_lo(x0) + gv[0] * s[0] * 0.125f; v[4 * w + 1] = bf_hi(x0) + gv[1] * s[1] * 0.125f; v[4 * w + 2] = bf_lo(x1) + gv[2] * s[2] * 0.125f; v[4 * w + 3] = bf_hi(x1) + gv[3] * s[3] * 0.125f; }
    float ss = 0.f;
#pragma unroll
    for (int i = 0; i < 16; ++i) ss += v[i] * v[i];
    const float rstd = rsqrtf(wave_sum(ss, lane) * (1.f / D) + EPS);
    if (!lastl) {
        bf16* xo = X + (size_t)row * D + 16 * lane;
        { v4u o0, o1;
#pragma unroll
          for (int q = 0; q < 4; ++q) { o0[q] = pk2(v[2 * q], v[2 * q + 1]); o1[q] = pk2(v[8 + 2 * q], v[8 + 2 * q + 1]); }
          *(v4u*)xo = o0; *(v4u*)(xo + 8) = o1; }
        const float* m = MODN + (size_t)mr * (NMOD * D) + 16 * lane; const float* gx = a.in[6] + (size_t)(l + 1) * D + 16 * lane;
        float am = 0.f;
#pragma unroll
        for (int w = 0; w < 4; ++w) { const f32x4 gv = ((const f32x4*)gx)[w], sh = ((const f32x4*)m)[w], sc = ((const f32x4*)(m + D))[w];
#pragma unroll
            for (int e = 0; e < 4; ++e) { const float h = (v[4 * w + e] * rstd * gv[e]) * (sc[e] + 1.f) + sh[e]; v[4 * w + e] = h; am = fmaxf(am, fabsf(h)); } }
        const float amax = __uint_as_float(wave_max_u(__float_as_uint(am)));
        const float qscale = amax > 0.f ? amax * (1.f / 127.f) : 1.f, qinv = amax > 0.f ? 127.f / amax : 0.f;
        v4u o8;
#pragma unroll
        for (int w = 0; w < 4; ++w) { unsigned u = 0;
#pragma unroll
            for (int e = 0; e < 4; ++e) { int qi = __float2int_rn(v[4 * w + e] * qinv); qi = qi > 127 ? 127 : (qi < -127 ? -127 : qi); u |= ((unsigned)qi & 255u) << (8 * e); }
            o8[w] = u; }
        *(v4u*)(H8 + (size_t)row * D + 16 * lane) = o8;
        if (lane == 0) ((float*)(F.ws + WS_SH))[row] = qscale;
    } else {
        float* op = a.out + (size_t)(row - NC) * D + 16 * lane; const float* gf = a.in[8] + 16 * lane;
#pragma unroll
        for (int w = 0; w < 4; ++w) { const f32x4 gv = ((const f32x4*)gf)[w]; ((f32x4*)op)[w] = (f32x4){v[4 * w] * rstd * gv[0], v[4 * w + 1] * rstd * gv[1], v[4 * w + 2] * rstd * gv[2], v[4 * w + 3] * rstd * gv[3]}; }
    }
}
__device__ __forceinline__ void rp_combine(Frame& F, const Args& a, int l, int row_lo) {
    const int f_tid = lthread(F.wave), f_lane = f_tid & 63;
    const bf16* X = (const bf16*)(F.ws + WS_X); const unsigned char* Y = (const unsigned char*)(F.ws + WS_Y);
    const float* MOD = (const float*)(F.ws + WS_MOD) + (size_t)l * 9 * (NMOD * D); const float* MODN = MOD + 9 * (NMOD * D);
    const v4u* te = (const v4u*)(F.ws + WS_TE); const v4u* trank = (const v4u*)(F.ws + WS_TRANK);
    const LAS int* TT = (const LAS int*)(F.lds + LDS_TT);
    const bool lastl = (l == DEPTH - 1);
    const int st = F.NGW, row0 = row_lo + F.gw;
    if (row0 >= NT) return;
    const int n = (NT - row0 + st - 1) / st, rlast = row0 + (n - 1) * st;
#define CROW(i) ((row0 + (i) * st) <= rlast ? (row0 + (i) * st) : rlast)
    CombRow RA, RB;
    v4u teA = te[CROW(0)], trA = trank[CROW(0)], teB = te[CROW(1)], trB = trank[CROW(1)];
    comb_issue(RA, X, Y, TT, CROW(0), teA, trA, f_lane);
    for (int i = 0; i < n; i += 2) {
        comb_issue(RB, X, Y, TT, CROW(i + 1), teB, trB, f_lane);
        teA = te[CROW(i + 2)]; trA = trank[CROW(i + 2)];
        comb_finish(RA, F, a, l, CROW(i), f_lane, MOD, MODN, lastl);
        comb_issue(RA, X, Y, TT, CROW(i + 2), teA, trA, f_lane);
        teB = te[CROW(i + 3)]; trB = trank[CROW(i + 3)];
        if (i + 1 < n) comb_finish(RB, F, a, l, CROW(i + 1), f_lane, MOD, MODN, lastl);
    }
#undef CROW
}
#endif

__device__ __forceinline__ void rp_mla(Frame& F, const Args& a) {
    const int f_tid = lthread(F.wave), f_lane = f_tid & 63;
    const bf16* A = (const bf16*)(F.ws + WS_RE); bf16* QA = (bf16*)(F.ws + WS_RF); bf16* CKV = (bf16*)(F.ws + WS_RG); bf16* Kb = (bf16*)(F.ws + WS_RB);
    const float* rope = (const float*)(F.ws + WS_ROPE); const float* gq = a.in[12]; const float* gk = a.in[14];
    for (int row = F.gw; row < NT; row += F.NGW) {
        const unsigned* ap = (const unsigned*)(A + (size_t)row * MLA_IN_PAD);
        unsigned q[3], c[2];
#pragma unroll
        for (int j = 0; j < 3; ++j) q[j] = ap[f_lane + 64 * j];
#pragma unroll
        for (int j = 0; j < 2; ++j) c[j] = ap[192 + f_lane + 64 * j];
        const unsigned pe = ap[320 + (f_lane & 15)];
        float sq = 0.f, sc = 0.f;
#pragma unroll
        for (int j = 0; j < 3; ++j) { const float x0 = bf_lo(q[j]), x1 = bf_hi(q[j]); sq += x0 * x0 + x1 * x1; }
#pragma unroll
        for (int j = 0; j < 2; ++j) { const float x0 = bf_lo(c[j]), x1 = bf_hi(c[j]); sc += x0 * x0 + x1 * x1; }
        const float rq = rsqrtf(wave_sum(sq, f_lane) * (1.f / MLA_QL) + EPS), rc = rsqrtf(wave_sum(sc, f_lane) * (1.f / MLA_KVL) + EPS);
#pragma unroll
        for (int j = 0; j < 3; ++j) { const int e0 = 2 * (f_lane + 64 * j); ((unsigned*)(QA + (size_t)row * MLA_QL))[f_lane + 64 * j] = pk2(bf_lo(q[j]) * rq * gq[e0], bf_hi(q[j]) * rq * gq[e0 + 1]); }
#pragma unroll
        for (int j = 0; j < 2; ++j) { const int e0 = 2 * (f_lane + 64 * j); ((unsigned*)(CKV + (size_t)row * MLA_KVL))[f_lane + 64 * j] = pk2(bf_lo(c[j]) * rc * gk[e0], bf_hi(c[j]) * rc * gk[e0 + 1]); }
        float x0 = bf_lo(pe), x1 = bf_hi(pe);
        if (row >= NC) { const int t = (row - NC) & 4095, i = f_lane & 15, d = 2 * i, pos = (d & 16) ? (t & 63) : (t >> 6), f = d & 7;
            const float p0 = shx(x0, 4, f_lane), p1 = shx(x1, 4, f_lane); const float sg = (d & 8) ? 1.f : -1.f;
            const float* rp = rope + (size_t)pos * 16 + 2 * f; x0 = x0 * rp[0] + sg * p0 * rp[1]; x1 = x1 * rp[2] + sg * p1 * rp[3]; }
        const unsigned w = pk2(x0, x1);
        { const int i = f_lane & 15, hb = f_lane >> 4;
#pragma unroll
          for (int hh = 0; hh < 4; ++hh) { const int h = hb * 4 + hh; ((unsigned*)(Kb + (size_t)row * 1536 + 96 * h + 64))[i] = w; } }
    }
}

__device__ __forceinline__ void rp_gqa(Frame& F, const Args& a) {
    const int f_tid = lthread(F.wave), f_lane = f_tid & 63;
    const bf16* A = (const bf16*)(F.ws + WS_RA); bf16* Q = (bf16*)(F.ws + WS_RB); bf16* Kb = Q + (size_t)NT * 1024;
    const float* rope = (const float*)(F.ws + WS_ROPE) + 2048; const float* gq = a.in[18]; const float* gk = a.in[19];
    const float c2 = 0.125f * LOG2E;
    for (int row = F.gw; row < NT; row += F.NGW) {
        const bool lat = row >= NC; const int t = (row - NC) & 4095;
#pragma unroll
        for (int part = 0; part < 2; ++part) {
            const int ln = part ? (f_lane & 15) : f_lane; const bf16* src = A + (size_t)row * GQA_QKV + (part ? 1024 : 0) + ln * 16;
            const v4u w0 = *(const v4u*)src, w1 = *(const v4u*)(src + 8);
            float x[16]; const unsigned ww[8] = {w0.x, w0.y, w0.z, w0.w, w1.x, w1.y, w1.z, w1.w};
#pragma unroll
            for (int i = 0; i < 8; ++i) { x[2 * i] = bf_lo(ww[i]); x[2 * i + 1] = bf_hi(ww[i]); }
            float ss = 0.f;
#pragma unroll
            for (int i = 0; i < 16; ++i) ss += x[i] * x[i];
            ss += shx(ss, 1, f_lane); ss += shx(ss, 2, f_lane);
            const float rs = rsqrtf(ss * (1.f / 64.f) + EPS); const float* g = (part ? gk : gq) + (ln & 3) * 16;
#pragma unroll
            for (int i = 0; i < 16; ++i) x[i] = x[i] * rs * g[i];
            if (lat) { const int sec = (ln >> 1) & 1, pos = sec ? (t & 63) : (t >> 6); const float sg = (ln & 1) ? 1.f : -1.f; const float* rp = rope + (size_t)pos * 32;
#pragma unroll
                for (int i = 0; i < 16; ++i) { const float pr = shx(x[i], 1, f_lane); x[i] = x[i] * rp[2 * i] + sg * pr * rp[2 * i + 1]; } }
            const float scl = part ? 1.f : c2;
            v4u o0, o1; o0.x = pk2(x[0] * scl, x[1] * scl); o0.y = pk2(x[2] * scl, x[3] * scl); o0.z = pk2(x[4] * scl, x[5] * scl); o0.w = pk2(x[6] * scl, x[7] * scl);
            o1.x = pk2(x[8] * scl, x[9] * scl); o1.y = pk2(x[10] * scl, x[11] * scl); o1.z = pk2(x[12] * scl, x[13] * scl); o1.w = pk2(x[14] * scl, x[15] * scl);
            if (part == 0) { bf16* d = Q + (size_t)row * 1024 + ln * 16; *(v4u*)d = o0; *(v4u*)(d + 8) = o1; }
            else if (f_lane < 16) { bf16* d = Kb + (size_t)row * 256 + ln * 16; *(v4u*)d = o0; *(v4u*)(d + 8) = o1; }
        }
    }
}

template <int DK>
__device__ __forceinline__ void attn_phase(Frame& F, const att::Tens& T, int kvshift  , int kstride, int vstride, int vbase) {
    const int vcu = (F.G % 8 == 0) ? (blockIdx.x % 8) * (F.G / 8) + blockIdx.x / 8 : blockIdx.x;
    if constexpr (DK == 64) {
        for (int u = vcu; u < 2048 + 128; u += F.G) {
            if (u < 2048) { const int b = u >> 8, h = (u >> 4) & 15, qb = u & 15, kvh = h >> kvshift;
                att64::attn_unit<8>(T.Q, T.qpitch, NC + b * SEQ + qb * 256, h * 64, T.K, T.kpitch, kvh * kstride, T.V, T.vpitch, vbase + kvh * vstride, T.O, h * 64, b * LCTX, NC + b * SEQ, 68, (char*)F.lds, F.wave); }
            else { const int q = u - 2048, b = q >> 4, h = q & 15, kvh = h >> kvshift;
                att64::attn_unit<8>(T.Q, T.qpitch, b * LCTX, h * 64, T.K, T.kpitch, kvh * kstride, T.V, T.vpitch, vbase + kvh * vstride, T.O, h * 64, b * LCTX, 0, 4, (char*)F.lds, F.wave); }
        }
        __syncthreads();
    } else {
        for (int u = vcu; u < 2048 + 128; u += F.G) {
            if (u < 2048) { const int b = u >> 8, h = (u >> 4) & 15, qb = u & 15, kvh = h >> kvshift;
                att96::attn_unit<8>(T.Q, T.qpitch, NC + b * SEQ + qb * 256, h * 96, T.K, T.kpitch, kvh * kstride, T.V, T.vpitch, vbase + kvh * vstride, T.O, h * 64, b * LCTX, NC + b * SEQ, 68, (char*)F.lds, F.wave); }
            else { const int q = u - 2048, b = q >> 4, h = q & 15, kvh = h >> kvshift;
                att96::attn_unit<8>(T.Q, T.qpitch, b * LCTX, h * 96, T.K, T.kpitch, kvh * kstride, T.V, T.vpitch, vbase + kvh * vstride, T.O, h * 64, b * LCTX, 0, 4, (char*)F.lds, F.wave); }
        }
        __syncthreads();
    }
}

constexpr int PH_PER_LAYER = 9, PH_TOTAL = 2 + DEPTH * PH_PER_LAYER;
__global__ void __launch_bounds__(512, 2) mk_fwd(Args args) {
    extern __shared__ __attribute__((aligned(16))) unsigned char lds_raw[];
    Frame F;
    F.lds = (LAS unsigned char*)lds_raw; F.ws = args.ws; F.ctl = (gu32*)(args.ws + WS_CTL);
    F.wave = __builtin_amdgcn_readfirstlane(threadIdx.x >> 6); F.G = gridDim.x;
    F.gw = blockIdx.x * 8 + F.wave; F.NGW = F.G * 8;
    if (threadIdx.x < 4) ((LAS unsigned*)(F.lds + LDS_XB))[threadIdx.x] = 0u;
    __syncthreads();
    const int lo = args.ph_lo, hi = args.ph_hi;
    const bool multi = (hi - lo) > 1;
    XcdBarrier bar; bar.bar = (unsigned*)(F.ctl + CW_BAR); bar.x = 0; bar.st = nullptr; bar.wave = F.wave;
    if (multi) bar = xcd_barrier_post((unsigned*)(F.ctl + CW_BAR), (volatile LAS unsigned*)(F.lds + LDS_XB), F.wave);
#define IN(k) (lo <= (k) && (k) < hi)
#define SEAM(k) do { if (IN(k) && IN((k) + 1)) xcd_barrier(bar); } while (0)
    unsigned char* ws0 = args.ws;
#define PH_WS size_t zofs_ = 0; asm volatile("" : "+s"(zofs_)); unsigned char* ws = ws0 + zofs_; F.ws = ws; F.ctl = (gu32*)ws;
    const int G = F.G, cidx = (int)blockIdx.x;

    if (IN(0) && EN(0)) { PH_WS REP(0) { prologue(F, args); SEAM(0); } }
    if (IN(1) && EN(1)) { PH_WS rp_norm1(F, args, 0, 0);
        quant_rows(F, (const bf16*)(ws + WS_WFIN), (unsigned char*)(ws + WS_W8), (float*)(ws + WS_SWP), 2 * 2048);
        quant_rows(F, (const bf16*)(ws + WS_WMIN), (unsigned char*)(ws + WS_W8) + 4 * MiB, (float*)(ws + WS_SWP) + 4096, MLA_IN_PAD);
        quant_rows(F, (const bf16*)(ws + WS_WGQKV), (unsigned char*)(ws + WS_W8) + 5 * MiB, (float*)(ws + WS_SWP) + 4864, GQA_QKV); SEAM(1); }

    for (int l = 0; l < DEPTH; ++l) {
        const int kind = l % 3, j = l / 3, base = 2 + l * PH_PER_LAYER;
        const bool lastl = (l == DEPTH - 1);

        size_t outB = 0;
        if (kind == 0) {
            if (IN(base + 0) && EN(2)) { PH_WS REP(2) { PolFP p; p.A = (const char*)(ws + WS_W8) + (size_t)j * 2048 * D; p.B = (const char*)(ws + WS_H); p.nt = 8; p.sW = (const float*)(ws + WS_SWP) + j * 2048; p.sH = (const float*)(ws + WS_SH); p.nN = lastl ? 128 : 136; p.G = G; p.c = cidx;
                p.Z = (bf16*)(ws + WS_RA); p.Zc = (bf16*)(ws + WS_RH); pg8::gemm_phase(F.lds, p, F.wave); } }
            SEAM(base + 0);
            if (IN(base + 1) && EN(3)) { PH_WS REP(3) { PolFA p; p.A = (const char*)(ws + WS_MA); p.B = (const char*)(ws + WS_RA); p.nt = 4; p.G = G; p.c = cidx; p.Y = (bf16*)(ws + WS_RB); pg8::gemm_phase(F.lds, p, F.wave); } }
            SEAM(base + 1);
            if (IN(base + 2) && EN(4)) { PH_WS REP(4) { PolFC p; p.A = (const char*)(ws + WS_DC); p.B = (const char*)(ws + WS_RB); p.nt = 8; p.G = G; p.c = cidx; p.nunits = lastl ? 512 : 544;
                p.offMC = (unsigned)(WS_MC - WS_DC); p.offZc = (unsigned)(WS_RH - WS_RB); p.F = (bf16*)(ws + WS_RC); pg8::gemm_phase(F.lds, p, F.wave); } }
            SEAM(base + 2);
            outB = WS_WFOUT + (size_t)j * D * D * 2;
        } else if (kind == 1) {
            if (IN(base + 0) && EN(5)) { PH_WS REP(5) { PolDenseI8 p; p.A = (const char*)(ws + WS_H); p.B = (const char*)(ws + WS_W8) + 4 * MiB; p.nt = 8; p.nM = NT / 256; p.nN = 3; p.pm0 = 0; p.G = G; p.c = cidx; p.sA = (const float*)(ws + WS_SH); p.sB = (const float*)(ws + WS_SWP) + 4096;
                p.O = (bf16*)(ws + WS_RE); p.ldo = MLA_IN_PAD; pg8::gemm_phase(F.lds, p, F.wave); } }
            SEAM(base + 0);
            if (IN(base + 1) && EN(6)) { PH_WS REP(6) { rp_mla(F, args); } }
            SEAM(base + 1);
            if (IN(base + 2)) { PH_WS REP(7) {
                if (EN(7)) { PolMlaQ p; p.A = (const char*)(ws + WS_RF); p.B = (const char*)(ws + WS_WMQB); p.nt = 6; p.nM = NT / 256; p.nN = 6; p.G = G; p.c = cidx; p.Q = (bf16*)(ws + WS_RA);
                  p.rope = (const float*)(ws + WS_ROPE); p.c2 = 0.10206207261596575f * LOG2E; pg8::gemm_phase(F.lds, p, F.wave); }
                if (EN(8)) { PolMlaKV p; p.A = (const char*)(ws + WS_RG); p.B = (const char*)(ws + WS_WMKVB); p.nt = 4; p.nM = NT / 256; p.nN = 8; p.G = G; p.c = cidx; p.Kb = (bf16*)(ws + WS_RB); p.Vb = (bf16*)(ws + WS_RD);
                  pg8::gemm_phase(F.lds, p, F.wave); }
            } }
            SEAM(base + 2);
            if (IN(base + 3) && EN(9)) { PH_WS REP(9) { att::Tens T{(const bf16*)(ws + WS_RA), 1536, (const bf16*)(ws + WS_RB), 1536, (const bf16*)(ws + WS_RD), 1024, (bf16*)(ws + WS_RC)}; attn_phase<96>(F, T, 0, 96, 64, 0); } }
            SEAM(base + 3);
            outB = WS_WMO;
        } else {
            if (IN(base + 0) && EN(10)) { PH_WS REP(10) { PolDenseI8 p; p.A = (const char*)(ws + WS_H); p.B = (const char*)(ws + WS_W8) + 5 * MiB; p.nt = 8; p.nM = NT / 256; p.nN = 6; p.pm0 = 0; p.G = G; p.c = cidx; p.sA = (const float*)(ws + WS_SH); p.sB = (const float*)(ws + WS_SWP) + 4864;
                p.O = (bf16*)(ws + WS_RA); p.ldo = GQA_QKV; pg8::gemm_phase(F.lds, p, F.wave); } }
            SEAM(base + 0);
            if (IN(base + 1) && EN(11)) { PH_WS REP(11) { rp_gqa(F, args); } }
            SEAM(base + 1);
            if (IN(base + 2) && EN(12)) { PH_WS REP(12) { att::Tens T{(const bf16*)(ws + WS_RB), 1024, (const bf16*)(ws + WS_RB) + (size_t)NT * 1024, 256, (const bf16*)(ws + WS_RA), 1536, (bf16*)(ws + WS_RC)}; attn_phase<64>(F, T, 2, 64, 64, 1280); } }
            SEAM(base + 2);
            outB = WS_WGO;
        }
        if (IN(base + 4) && EN(13)) { PH_WS PolOut p; p.A = (const char*)(ws + WS_RC); p.B = (const char*)(ws + outB); p.nt = 16; p.nM = lastl ? NL / 256 : NT / 256; p.nN = 4; p.pm0 = lastl ? 8 : 0; p.G = G; p.c = cidx; p.X = (bf16*)(ws + WS_X); p.mod = (const float*)(ws + WS_MOD) + (size_t)l * 9 * (NMOD * D); p.chunk = 2;
            p.XinC = (l == 0) ? args.in[2] : nullptr; p.XinL = (l == 0) ? args.in[0] - (size_t)NC * D : nullptr;
            pg8::gemm_phase(F.lds, p, F.wave); }
        SEAM(base + 4);
        if (IN(base + 5) && EN(14)) { PH_WS rp_norm2_router(F, args, l, lastl ? NC : 0); }
        SEAM(base + 5);
        if (IN(base + 6) && EN(15)) { PH_WS REP(15) { moe_table(F, l);
            PolMoe1 p; p.A = (const char*)(ws + WS_H); p.B = (const char*)(ws + WS_WGU) + (size_t)l * NE * 2048 * D; p.nt = 8; p.G = G; p.c = cidx;
            p.swgu = (const float*)(ws + WS_SWGU) + (size_t)l * NE * 2048; p.ssc = (const float*)(ws + WS_SSC);
            p.T.TT = (const LAS int*)(F.lds + LDS_TT); p.T.CN = p.T.TT + 64; p.T.TE = (const LAS int*)(F.lds + LDS_TE); p.stok = (const int*)(ws + WS_STOK); p.bgu = (const float*)(ws + WS_BGU) + (size_t)l * NE * 2048; p.act = (unsigned char*)(ws + WS_ACT);
            pg8::gemm_phase(F.lds, p, F.wave); } }
        SEAM(base + 6);
        if (IN(base + 7) && EN(16)) { PH_WS REP(16) { moe_table(F, l);
            PolMoe2 p; p.A = (const char*)(ws + WS_ACT); p.B = (const char*)(ws + WS_WDN) + (size_t)l * NE * D * DFF; p.nt = 8; p.G = G; p.c = cidx; p.swd = (const float*)(ws + WS_SWDN) + (size_t)l * NE * D;
            p.T.TT = (const LAS int*)(F.lds + LDS_TT); p.T.CN = p.T.TT + 64; p.T.TE = (const LAS int*)(F.lds + LDS_TE); p.sw = (const float*)(ws + WS_SW); p.bdn = args.in[26] + (size_t)l * NE * D; p.Y = (unsigned char*)(ws + WS_Y);
            pg8::gemm_phase(F.lds, p, F.wave); } }
        SEAM(base + 7);
        if (IN(base + 8) && EN(17)) { PH_WS moe_table(F, l); rp_combine(F, args, l, lastl ? NC : 0); }
        SEAM(base + 8);
    }
#undef PH_WS
#undef IN
#undef SEAM
}

extern "C" void kernel_launch(void* const* d_in, const int* in_sizes, int n_in, void* d_out, int out_size, void* d_ws, size_t ws_size, hipStream_t stream) {
    static int grid = 0;
    if (grid == 0) {
        if (n_in != 27 || out_size != NL * D || ws_size < WS_END) { fprintf(stderr, "kernel_launch: unexpected problem (n_in %d, out %d, ws %zu < %zu)\n", n_in, out_size, ws_size, (size_t)WS_END); grid = -1; return; }
        int dev = 0, cus = 0, per_cu = 0;
        if (hipGetDevice(&dev) != hipSuccess || hipDeviceGetAttribute(&cus, hipDeviceAttributeMultiprocessorCount, dev) != hipSuccess) { grid = -1; return; }
        if (hipFuncSetAttribute((const void*)mk_fwd, hipFuncAttributeMaxDynamicSharedMemorySize, LDS_BYTES) != hipSuccess) { fprintf(stderr, "kernel_launch: hipFuncSetAttribute failed\n"); grid = -1; return; }
        if (hipOccupancyMaxActiveBlocksPerMultiprocessor(&per_cu, (const void*)mk_fwd, 512, LDS_BYTES) != hipSuccess || per_cu < 1) fprintf(stderr, "kernel_launch: occupancy query says %d\n", per_cu);
        (void)hipGetLastError();
        grid = cus;
    }
    if (grid < 0) return;
    (void)hipMemsetAsync((char*)d_ws + WS_CTL, 0, CTL_ZERO_BYTES, stream);
    Args a{};
    for (int i = 0; i < 27; ++i) a.in[i] = (const float*)d_in[i];
    a.out = (float*)d_out; a.ws = (unsigned char*)d_ws;
#if MK_PER_PHASE
    for (int ph = 0; ph < PH_TOTAL; ++ph) {
        const int l = (ph - 2) / PH_PER_LAYER, s = (ph - 2) % PH_PER_LAYER, kind = l % 3;
        if (ph >= 2) { if (s == 3 && kind != 1) continue; }
        a.ph_lo = ph; a.ph_hi = ph + 1;
        hipLaunchKernelGGL(mk_fwd, dim3(grid), dim3(512), LDS_BYTES, stream, a);
    }
#else
    a.ph_lo = 0; a.ph_hi = PH_TOTAL;
    hipLaunchKernelGGL(mk_fwd, dim3(grid), dim3(512), LDS_BYTES, stream, a);
#endif
}
```

```cpp
#include <hip/hip_runtime.h>
#include <cstdio>
#include <cstdint>

#ifndef MK_PER_PHASE
#define MK_PER_PHASE 0
#endif
#ifndef MK_N2V2
#define MK_N2V2 1
#endif
#ifndef MK_CBV2
#define MK_CBV2 1
#endif
#ifndef MK_N2AGG
#define MK_N2AGG 1
#endif
#ifndef MK_MASK
#define MK_MASK 0xFFFFFFFFu
#endif
#define EN(id) (((MK_MASK) >> (id)) & 1u)
#ifndef MK_REPMASK
#define MK_REPMASK 0u
#endif
#define REP(id) for (int rep_ = 0; rep_ < ((((MK_REPMASK) >> (id)) & 1u) ? 2 : 1); ++rep_)

constexpr int D = 1024, NB = 8, SEQ = 4096, LCTX = 256, DEPTH = 4;
constexpr int NC = NB * LCTX;
constexpr int NL = NB * SEQ;
constexpr int NT = NC + NL;
constexpr int NMOD = 6, NE = 32, TOPK = 4, DFF = 1024;
constexpr int MLA_QL = 384, MLA_KVL = 256, MLA_ROPE = 32, MLA_NOPE = 64, MLA_V = 64, MLA_IN = 672, MLA_IN_PAD = 768, MLA_QD = 96;
constexpr int GQA_NQ = 1024, GQA_NKV = 256, GQA_QKV = 1536;
constexpr int CAP = NT;
constexpr int MAXTILES = 576;
constexpr float EPS = 1e-6f;
constexpr float LOG2E = 1.4426950408889634f;

constexpr size_t MiB = 1u << 20;
constexpr size_t WS_CTL = 0, CTL_ZERO_BYTES = 96 * 1024;
constexpr size_t WS_MOD = 1 * MiB;
constexpr size_t WS_ROPE = 2 * MiB;
constexpr size_t WS_WRT = 2 * MiB + 65536;
constexpr size_t WS_BGU = 3 * MiB;
constexpr size_t WS_MA = 4 * MiB;
constexpr size_t WS_DC = 4 * MiB + 262144;
constexpr size_t WS_MC = 5 * MiB;
constexpr size_t WS_WFIN = 9 * MiB;
constexpr size_t WS_WFOUT = 17 * MiB;
constexpr size_t WS_WMIN = 21 * MiB;
constexpr size_t WS_WMQB = 23 * MiB;
constexpr size_t WS_WMKVB = 25 * MiB;
constexpr size_t WS_WMO = 26 * MiB;
constexpr size_t WS_WGQKV = 28 * MiB;
constexpr size_t WS_WGO = 31 * MiB;
constexpr size_t WS_TE = 34 * MiB;
constexpr size_t WS_TRANK = 35 * MiB;
constexpr size_t WS_STOK = 36 * MiB;
constexpr size_t WS_SW = 41 * MiB;
constexpr size_t WS_X = 64 * MiB;
constexpr size_t WS_H = 200 * MiB;
constexpr size_t WS_RA = 272 * MiB;
constexpr size_t WS_RB = 400 * MiB;
constexpr size_t WS_RC = 528 * MiB;
constexpr size_t WS_RD = 600 * MiB;
constexpr size_t WS_RE = 672 * MiB;
constexpr size_t WS_RF = 728 * MiB;
constexpr size_t WS_RG = 756 * MiB;
constexpr size_t WS_RH = 776 * MiB;
constexpr size_t WS_ACT = 784 * MiB;
constexpr size_t WS_Y = 1072 * MiB;
constexpr size_t WS_WGU = 1360 * MiB;
constexpr size_t WS_SWGU = 1360 * MiB + 256 * MiB;
constexpr size_t WS_SH = 1360 * MiB + 259 * MiB;
constexpr size_t WS_SWP = 1360 * MiB + 259 * MiB + 256 * 1024;
constexpr size_t WS_W8 = 1360 * MiB + 266 * MiB;
constexpr size_t WS_SSC = 1360 * MiB + 260 * MiB;
constexpr size_t WS_WDN = 1872 * MiB;
constexpr size_t WS_SWDN = 1872 * MiB + 128 * MiB;
constexpr size_t WS_END = 2128 * MiB;
constexpr int CW_TMO = 0;
constexpr int CW_BAR = 4096;
constexpr int CW_CNT = 16384;

constexpr int RING_BYTES = 131072;
constexpr int LDS_MISC = 135168;
constexpr int LDS_TT = LDS_MISC;
constexpr int LDS_XB = LDS_MISC + 512;
constexpr int LDS_TE = LDS_MISC + 768;
constexpr int LDS_BYTES = 147456;

#define GAS __attribute__((address_space(1)))
#define LAS __attribute__((address_space(3)))
typedef unsigned short bf16;
typedef unsigned v4u __attribute__((ext_vector_type(4)));
typedef unsigned v2u __attribute__((ext_vector_type(2)));
typedef float f32x4 __attribute__((ext_vector_type(4)));
typedef float f32x2 __attribute__((ext_vector_type(2)));
typedef float f32x16 __attribute__((ext_vector_type(16)));
typedef short bf16x8 __attribute__((ext_vector_type(8)));
typedef short s16x4 __attribute__((ext_vector_type(4)));
typedef __bf16 bf16x2_t __attribute__((ext_vector_type(2)));
typedef GAS unsigned gu32;
#define RLX_AGENT __ATOMIC_RELAXED, __HIP_MEMORY_SCOPE_AGENT
#define LDS_WAIT() asm volatile("s_waitcnt lgkmcnt(0)" ::: "memory")
#define VM_WAIT() asm volatile("s_waitcnt vmcnt(0)" ::: "memory")
__device__ __forceinline__ unsigned pk2(float lo, float hi) { f32x2 v = {lo, hi}; bf16x2_t b = __builtin_convertvector(v, bf16x2_t); return __builtin_bit_cast(unsigned, b); }
__device__ __forceinline__ float bf_lo(unsigned u) { return __builtin_bit_cast(float, u << 16); }
__device__ __forceinline__ float bf_hi(unsigned u) { return __builtin_bit_cast(float, u & 0xffff0000u); }
__device__ __forceinline__ float shx(float v, int mask, int lane) { return __int_as_float(__builtin_amdgcn_ds_bpermute((lane ^ mask) << 2, __float_as_int(v))); }
__device__ __forceinline__ float wave_sum(float v, int lane) {
#pragma unroll
    for (int o = 1; o < 64; o <<= 1) v += shx(v, o, lane);
    return v;
}
__device__ __forceinline__ int lane_id_v() { int t; asm volatile("v_mbcnt_lo_u32_b32 %0, -1, 0\n\tv_mbcnt_hi_u32_b32 %0, -1, %0" : "=v"(t)); return t; }
__device__ __forceinline__ int launder_s(int x) { asm volatile("" : "+s"(x)); return x; }
__device__ __forceinline__ int lthread_w(int wave) { return wave * 64 + lane_id_v(); }
__device__ __forceinline__ int modrow_of(int row) { return row < NC ? NB : ((row - NC) >> 12); }

#define XB_TMO      128
#define XB_XCNT(j)  (256  + 64 * (j))
#define XB_XSUB(j)  (1280 + 64 * (j))
#define XB_XGEN(j)  (2304 + 64 * (j))
#define XB_TOP      3328
#define XB_TOPGEN   3392
#define XCD_BAR_WORDS 3456
#define XB_SPIN_CAP (1u << 18)
__device__ __forceinline__ unsigned xb_ld(unsigned* p)              { return __hip_atomic_load(p, __ATOMIC_RELAXED, __HIP_MEMORY_SCOPE_AGENT); }
__device__ __forceinline__ unsigned xb_add(unsigned* p, unsigned v) { return __hip_atomic_fetch_add(p, v, __ATOMIC_RELAXED, __HIP_MEMORY_SCOPE_AGENT); }
__device__ __forceinline__ unsigned xb_xcc_id() { return (unsigned)__builtin_amdgcn_s_getreg((3 << 11) | 20) & 0xFu; }
#define XB_SPIN(cond, bar) do { unsigned _sp = 0; while (cond) { __builtin_amdgcn_s_sleep(1); \
    if ((++_sp & 255u) == 0u) { if (xb_ld(&(bar)[XB_TMO])) break; if (_sp > XB_SPIN_CAP) { atomicAdd(&(bar)[XB_TMO], 1u); break; } } } } while (0)
struct XcdBarrier { unsigned* bar; unsigned x; volatile LAS unsigned* st; int wave; };
__device__ __forceinline__ bool xb_thread0(int wave) { return wave == 0 && lane_id_v() == 0; }
__device__ __forceinline__ XcdBarrier xcd_barrier_post(unsigned* bar, volatile LAS unsigned* st, int wave) {
    XcdBarrier b; b.bar = bar; b.x = xb_xcc_id(); b.st = st; b.wave = wave;
    if (xb_thread0(wave)) (void)xb_add(&bar[XB_XCNT(b.x)], 1u);
    return b;
}
__device__ __forceinline__ void xcd_barrier_complete(unsigned* bar, unsigned x, unsigned& nloc, unsigned& nx) {
    const unsigned G = gridDim.x * gridDim.y * gridDim.z;
    unsigned sum, cnt, mine, sp = 0u;
    for (;;) {
        sum = 0u; cnt = 0u; mine = 0u;
#pragma unroll
        for (unsigned j = 0; j < 16; ++j) { const unsigned c = xb_ld(&bar[XB_XCNT(j)]); sum += c; cnt += (c > 0u) ? 1u : 0u; mine = (j == x) ? c : mine; }
        if (sum == G) break;
        __builtin_amdgcn_s_sleep(1);
        if ((++sp & 255u) == 0u) { if (xb_ld(&bar[XB_TMO])) break; if (sp > XB_SPIN_CAP) { atomicAdd(&bar[XB_TMO], 1u); break; } }
    }
    nloc = mine > 0u ? mine : 1u; nx = cnt > 0u ? cnt : 1u;
}
__device__ __forceinline__ void xcd_barrier(const XcdBarrier& b) {
    asm volatile("s_waitcnt vmcnt(0)" ::: "memory");
    __syncthreads();
    if (xb_thread0(b.wave)) {
        unsigned* bar = b.bar;
        __builtin_amdgcn_s_waitcnt(0);
        unsigned nloc = b.st[0], nx = b.st[1];
        if (nloc == 0u) { xcd_barrier_complete(bar, b.x, nloc, nx); b.st[0] = nloc; b.st[1] = nx; }
        const unsigned old = xb_add(&bar[XB_XSUB(b.x)], 1u);
        const unsigned gen = old / nloc;
        if (old + 1u == (gen + 1u) * nloc) {
            __builtin_amdgcn_fence(__ATOMIC_RELEASE, "agent");
            asm volatile("s_waitcnt vmcnt(0)" ::: "memory");
            const unsigned og = xb_add(&bar[XB_TOP], 1u);
            const unsigned tg = og / nx;
            if (og + 1u == (tg + 1u) * nx) xb_add(&bar[XB_TOPGEN], 1u);
            else XB_SPIN(xb_ld(&bar[XB_TOPGEN]) == tg, bar);
            __builtin_amdgcn_fence(__ATOMIC_ACQUIRE, "agent");
            xb_add(&bar[XB_XGEN(b.x)], 1u);
            asm volatile("s_waitcnt vmcnt(0)" ::: "memory");
        } else {
            XB_SPIN(xb_ld(&bar[XB_XGEN(b.x)]) == gen, bar);
            __builtin_amdgcn_fence(__ATOMIC_ACQUIRE, "agent");
            asm volatile("s_waitcnt vmcnt(0)" ::: "memory");
        }
    }
    __syncthreads();
}

namespace pg8 {
#define PG8_LAS __attribute__((address_space(3)))
constexpr int BM = 256, BK = 64, HALF = 128, HTB = HALF * BK * 2, STAGE_BYTES = 8 * HTB, NXCD = 8, WGM = 8;
__device__ __forceinline__ int lds_byte(int r, int c) { const int st = (r >> 4) * 2 + (c >> 5), rr = r & 15, cc = c & 31, ob = rr * 64 + cc * 2; return st * 1024 + (ob ^ (((ob >> 9) & 1) << 5)); }
__device__ __forceinline__ void stage_rc(int b, int& R, int& C) { const int st = b / 1024, sb = b % 1024, swz = sb ^ (((sb >> 9) & 1) << 5); R = (st >> 1) * 16 + swz / 64; C = (st & 1) * 32 + (swz % 64) / 2; }
__device__ __forceinline__ int perm32(int rho) { const int n = rho >> 4, i = rho & 15; return 8 * (i >> 2) + 4 * n + (i & 3); }
struct Unit { int pm, pn, aux; };
typedef f32x4 Acc[2][2][4][2];
typedef int i32x4 __attribute__((ext_vector_type(4)));
typedef i32x4 AccI[2][2][4][2];
template <bool I8> struct AccSel { typedef f32x4 T; };
template <> struct AccSel<true> { typedef i32x4 T; };
__device__ __forceinline__ f32x4 mma1(bf16x8 b, bf16x8 a, f32x4 c) { return __builtin_amdgcn_mfma_f32_16x16x32_bf16(b, a, c, 0, 0, 0); }
typedef int i32x8 __attribute__((ext_vector_type(8)));
typedef short bf16x16 __attribute__((ext_vector_type(16)));
__device__ __forceinline__ f32x4 mma_f8(bf16x8 b0, bf16x8 b1, bf16x8 a0, bf16x8 a1, f32x4 c) {
    const i32x8 B = __builtin_bit_cast(i32x8, __builtin_shufflevector(b0, b1, 0, 1, 2, 3, 4, 5, 6, 7, 8, 9, 10, 11, 12, 13, 14, 15));
    const i32x8 A = __builtin_bit_cast(i32x8, __builtin_shufflevector(a0, a1, 0, 1, 2, 3, 4, 5, 6, 7, 8, 9, 10, 11, 12, 13, 14, 15));
    return __builtin_amdgcn_mfma_scale_f32_16x16x128_f8f6f4(B, A, c, 0, 0, 0, 0, 0, 0); }
__device__ __forceinline__ i32x4 mma1(bf16x8 b, bf16x8 a, i32x4 c) { return __builtin_amdgcn_mfma_i32_16x16x64_i8(__builtin_bit_cast(i32x4, b), __builtin_bit_cast(i32x4, a), c, 0, 0, 0); }

__device__ __forceinline__ bool static_next(int i, int G, int c, int nM, int nN, int& pm, int& pn) {
    const int nwg = nM * nN; const long L = (long)i * G + c; if (L >= nwg) return false;
    int wgid = (int)L; { const int q = nwg / NXCD, r = nwg % NXCD, xcd = wgid % NXCD, off = wgid / NXCD; wgid = (xcd < r ? xcd * (q + 1) : r * (q + 1) + (xcd - r) * q) + off; }
    const int nig = WGM * nN, gid = wgid / nig, fm = gid * WGM, gsz = (nM - fm) < WGM ? (nM - fm) : WGM;
    pm = fm + ((wgid % nig) % gsz); pn = (wgid % nig) / gsz; return true;
}

template <class P>
__device__ __forceinline__ void gemm_phase(PG8_LAS unsigned char* lds, const P& p, int wave_id) {
    wave_id = launder_s(wave_id); int tid_l = lthread_w(wave_id);
    const int tid = tid_l, wid = wave_id, lane = tid & 63, wr = wid >> 2, wc = wid & 3, fr = lane & 15, fq = lane >> 4;
    const int nt = p.nt;
    const unsigned ldsw = (unsigned)wid * 1024u;
    const int aoff = lds_byte(wr * 64 + fr, fq * 8), boff = lds_byte(wc * 32 + fr, fq * 8);
    const char* const gA = p.A; const char* const gB = p.B;
#define PG8_SA(b, h) (((b) * 2 + (h)) * HTB)
#define PG8_SB(b, h) ((4 + (b) * 2 + (h)) * HTB)
#define PG8_STAGE(bufoff, gbase, off2, kofs) do { _Pragma("unroll") for (int _i = 0; _i < 2; ++_i) \
        __builtin_amdgcn_global_load_lds((const unsigned*)((gbase) + (size_t)(off2)[_i] + (size_t)(kofs)), (PG8_LAS unsigned*)(lds + (bufoff) + ldsw + _i * 8192), 16, 0, 0); } while (0)
#define PG8_LDA(dst, b, h) do { _Pragma("unroll") for (int m = 0; m < 4; ++m) _Pragma("unroll") for (int k = 0; k < 2; ++k) dst[m][k] = *(const PG8_LAS bf16x8*)(lds + PG8_SA(b, h) + aoff + m * 2048 + k * 1024); } while (0)
#define PG8_LDB(dst, b, h) do { _Pragma("unroll") for (int n = 0; n < 2; ++n) _Pragma("unroll") for (int k = 0; k < 2; ++k) dst[n][k] = *(const PG8_LAS bf16x8*)(lds + PG8_SB(b, h) + boff + n * 2048 + k * 1024); } while (0)
#define PG8_MMA(ai, bj, At, Bt) do { __builtin_amdgcn_s_setprio(1); _Pragma("unroll") for (int m = 0; m < 4; ++m) _Pragma("unroll") for (int n = 0; n < 2; ++n) { \
        if constexpr (P::F8) acc[ai][bj][m][n] = mma_f8(Bt[n][0], Bt[n][1], At[m][0], At[m][1], acc[ai][bj][m][n]); \
        else { _Pragma("unroll") for (int k = 0; k < 2; ++k) acc[ai][bj][m][n] = mma1(Bt[n][k], At[m][k], acc[ai][bj][m][n]); } } __builtin_amdgcn_s_setprio(0); } while (0)
#define PG8_WAIT_V(n) asm volatile("s_waitcnt vmcnt(" #n ")" ::: "memory")
#define PG8_WAIT_L(n) asm volatile("s_waitcnt lgkmcnt(" #n ")" ::: "memory")
#define PG8_BAR __builtin_amdgcn_s_barrier()
#define PG8_SCHED __builtin_amdgcn_sched_barrier(0)
#define PG8_KEYS(u) do { if (P::KEYS && wid < 4) __builtin_amdgcn_global_load_lds((const unsigned*)p.key_ptr(u, wid * 64 + lane_id_v()), (PG8_LAS unsigned*)(keybuf + wid * 256), 4, 0, 0); } while (0)
#define PG8_OFFS(u, oA, oB) do { const int tid2_ = wid * 64 + lane_id_v();     \
    _Pragma("unroll") for (int _i = 0; _i < 2; ++_i) { int R_, C_; stage_rc(tid2_ * 16 + _i * 8192, R_, C_); const int Rb_ = P::PERM ? ((R_ & ~31) + perm32(R_ & 31)) : R_; \
      _Pragma("unroll") for (int _h = 0; _h < 2; ++_h) { \
        const int key_ = P::KEYS ? ((const PG8_LAS int*)keybuf)[_h * HALF + R_] : 0; \
        oA[_h][_i] = p.a_row(u, _h * HALF + R_, key_) + (unsigned)(C_ * 2); oB[_h][_i] = p.b_row(u, _h * HALF + Rb_) + (unsigned)(C_ * 2); } } } while (0)
    PG8_LAS unsigned char* const keybuf = lds + STAGE_BYTES;
    Unit cur, nxt; int ui = 0;
    if (!p.next(0, cur)) return;
    typedef typename AccSel<P::I8>::T AccT;
    AccT acc[2][2][4][2];
#pragma unroll
    for (int a = 0; a < 2; ++a)
#pragma unroll
        for (int b = 0; b < 2; ++b)
#pragma unroll
            for (int m = 0; m < 4; ++m)
#pragma unroll
                for (int n = 0; n < 2; ++n) acc[a][b][m][n] = (AccT){0, 0, 0, 0};
    bf16x8 At[4][2], B0[2][2], B1[2][2];
    unsigned oAc[2][2], oBc[2][2];
    if (P::KEYS) { PG8_KEYS(cur); PG8_WAIT_V(0); PG8_BAR; }
    PG8_OFFS(cur, oAc, oBc);
    PG8_STAGE(PG8_SB(0, 0), gB, oBc[0], 0); PG8_STAGE(PG8_SB(0, 1), gB, oBc[1], 0); PG8_STAGE(PG8_SA(0, 0), gA, oAc[0], 0); PG8_STAGE(PG8_SA(0, 1), gA, oAc[1], 0);
    if (wr == 1) PG8_BAR;
    PG8_WAIT_V(2); PG8_BAR;
    PG8_STAGE(PG8_SB(1, 0), gB, oBc[0], 128); PG8_STAGE(PG8_SA(1, 0), gA, oAc[0], 128); PG8_STAGE(PG8_SB(1, 1), gB, oBc[1], 128);
    PG8_WAIT_V(6); PG8_BAR;
    for (;;) {
        const bool has_next = p.next(ui + 1, nxt);
        if (has_next) { PG8_KEYS(nxt); }
        for (int t = 0; t < nt; t += 2) {
            const bool last = (t == nt - 2);
            const unsigned k1 = (unsigned)(t + 1) * 128u;
            const unsigned k2 = last ? 0u : (unsigned)(t + 2) * 128u, k3 = k2 + 128u;
            PG8_LDB(B0, 0, 0); PG8_LDB(B1, 0, 1); PG8_SCHED; PG8_LDA(At, 0, 0); PG8_STAGE(PG8_SA(1, 1), gA, oAc[1], k1);
            if (last && has_next) { PG8_OFFS(nxt, oAc, oBc); }
            PG8_WAIT_V(8); PG8_WAIT_L(0); PG8_BAR; PG8_MMA(0, 0, At, B0); PG8_MMA(0, 1, At, B1); PG8_BAR; PG8_SCHED;
            PG8_LDA(At, 0, 1); PG8_STAGE(PG8_SB(0, 0), gB, oBc[0], k2); PG8_STAGE(PG8_SB(0, 1), gB, oBc[1], k2); PG8_STAGE(PG8_SA(0, 0), gA, oAc[0], k2);
            PG8_WAIT_V(8); PG8_WAIT_L(0); PG8_BAR; PG8_MMA(1, 0, At, B0); PG8_MMA(1, 1, At, B1); PG8_BAR; PG8_SCHED;
            PG8_LDB(B0, 1, 0); PG8_LDB(B1, 1, 1); PG8_SCHED; PG8_LDA(At, 1, 0); PG8_STAGE(PG8_SA(0, 1), gA, oAc[1], k2);
            PG8_WAIT_V(8); PG8_WAIT_L(0); PG8_BAR; PG8_MMA(0, 0, At, B0); PG8_MMA(0, 1, At, B1); PG8_BAR; PG8_SCHED;
            PG8_LDA(At, 1, 1); PG8_STAGE(PG8_SB(1, 0), gB, oBc[0], k3); PG8_STAGE(PG8_SB(1, 1), gB, oBc[1], k3); PG8_STAGE(PG8_SA(1, 0), gA, oAc[0], k3);
            PG8_WAIT_V(8); PG8_WAIT_L(0); PG8_BAR; PG8_MMA(1, 0, At, B0); PG8_MMA(1, 1, At, B1); PG8_BAR; PG8_SCHED;
        }
        if (wr == 0) PG8_BAR;
        { const int le_ = lane_id_v(); int fr_e = le_ & 15, fq_e = le_ >> 4;
          p.epi(acc, cur, wr, wc, fr_e, fq_e); }
        if (!has_next) break;
#pragma unroll
        for (int a = 0; a < 2; ++a)
#pragma unroll
            for (int b = 0; b < 2; ++b)
#pragma unroll
                for (int m = 0; m < 4; ++m)
#pragma unroll
                    for (int n = 0; n < 2; ++n) acc[a][b][m][n] = (AccT){0, 0, 0, 0};
        cur = nxt; ++ui;
        if (wr == 1) PG8_BAR;
    }
    PG8_WAIT_V(0);
    PG8_BAR;
#undef PG8_SA
#undef PG8_SB
#undef PG8_STAGE
#undef PG8_LDA
#undef PG8_LDB
#undef PG8_MMA
#undef PG8_WAIT_V
#undef PG8_WAIT_L
#undef PG8_BAR
#undef PG8_SCHED
#undef PG8_OFFS
#undef PG8_KEYS
}
}
using pg8::Unit;

#define TROW(ai, wr, m, fr) (128 * (ai) + 64 * (wr) + 16 * (m) + (fr))
#define TCOLP(bj, wc, fq) (128 * (bj) + 32 * (wc) + 8 * (fq))
#define TCOLN(bj, wc, n, fq) (128 * (bj) + 32 * (wc) + 16 * (n) + 4 * (fq))
__device__ __forceinline__ v4u pack8(const f32x4 a, const f32x4 b) { v4u w; w.x = pk2(a[0], a[1]); w.y = pk2(a[2], a[3]); w.z = pk2(b[0], b[1]); w.w = pk2(b[2], b[3]); return w; }

struct PolDenseBf16 {
    static constexpr bool PERM = true;
    static constexpr bool KEYS = false;
    static constexpr bool I8 = false;
    static constexpr bool F8 = false;
    __device__ __forceinline__ const int* key_ptr(const Unit&, int) const { return nullptr; }
    const char* A; const char* B; int nt; int nM, nN, pm0, G, c; unsigned pitchA, pitchB; bf16* O; int ldo;
    __device__ __forceinline__ bool next(int i, Unit& u) const { int pm, pn; if (!pg8::static_next(i, G, c, nM, nN, pm, pn)) return false; u.pm = pm + pm0; u.pn = pn; u.aux = 0; return true; }
    __device__ __forceinline__ unsigned a_row(const Unit& u, int r, int) const { return (unsigned)(u.pm * 256 + r) * pitchA; }
    __device__ __forceinline__ unsigned b_row(const Unit& u, int r) const { return (unsigned)(u.pn * 256 + r) * pitchB; }
    __device__ __forceinline__ void epi(const pg8::Acc& acc, const Unit& u, int wr, int wc, int fr, int fq) const {
#pragma unroll
        for (int ai = 0; ai < 2; ++ai)
#pragma unroll
            for (int m = 0; m < 4; ++m) { const size_t row = (size_t)u.pm * 256 + TROW(ai, wr, m, fr);
#pragma unroll
                for (int bj = 0; bj < 2; ++bj) { const int col = u.pn * 256 + TCOLP(bj, wc, fq); *(v4u*)(O + row * ldo + col) = pack8(acc[ai][bj][m][0], acc[ai][bj][m][1]); } }
    }
};

struct PolDenseI8 {
    static constexpr bool PERM = true;
    static constexpr bool KEYS = false;
    static constexpr bool I8 = true;
    static constexpr bool F8 = false;
    __device__ __forceinline__ const int* key_ptr(const Unit&, int) const { return nullptr; }
    const char* A; const char* B; int nt; int nM, nN, pm0, G, c; const float* sA; const float* sB; bf16* O; int ldo;
    __device__ __forceinline__ bool next(int i, Unit& u) const { int pm, pn; if (!pg8::static_next(i, G, c, nM, nN, pm, pn)) return false; u.pm = pm + pm0; u.pn = pn; u.aux = 0; return true; }
    __device__ __forceinline__ unsigned a_row(const Unit& u, int r, int) const { return (unsigned)(u.pm * 256 + r) * 1024u; }
    __device__ __forceinline__ unsigned b_row(const Unit& u, int r) const { return (unsigned)(u.pn * 256 + r) * 1024u; }
    __device__ __forceinline__ void epi(const pg8::AccI& acc, const Unit& u, int wr, int wc, int fr, int fq) const {
#pragma unroll
        for (int bj = 0; bj < 2; ++bj) { const int col = u.pn * 256 + TCOLP(bj, wc, fq); const f32x4 s0 = *(const f32x4*)(sB + col), s1 = *(const f32x4*)(sB + col + 4);
#pragma unroll
            for (int ai = 0; ai < 2; ++ai)
#pragma unroll
                for (int m = 0; m < 4; ++m) { const size_t row = (size_t)u.pm * 256 + TROW(ai, wr, m, fr); const float sa = sA[row]; f32x4 v0, v1;
#pragma unroll
                    for (int q = 0; q < 4; ++q) { v0[q] = (float)acc[ai][bj][m][0][q] * (sa * s0[q]); v1[q] = (float)acc[ai][bj][m][1][q] * (sa * s1[q]); }
                    *(v4u*)(O + row * ldo + col) = pack8(v0, v1); } }
    }
};

struct PolOut {
    static constexpr bool PERM = true;
    static constexpr bool KEYS = false;
    static constexpr bool I8 = false;
    static constexpr bool F8 = false;
    __device__ __forceinline__ const int* key_ptr(const Unit&, int) const { return nullptr; }
    const char* A; const char* B; int nt; int nM, nN, pm0, G, c; bf16* X; const float* mod;
    int chunk; const float* XinC; const float* XinL;
    __device__ __forceinline__ bool next(int i, Unit& u) const { int pm, pn; if (!pg8::static_next(i, G, c, nM, nN, pm, pn)) return false; u.pm = pm + pm0; u.pn = pn; u.aux = 0; return true; }
    __device__ __forceinline__ unsigned a_row(const Unit& u, int r, int) const { return (unsigned)(u.pm * 256 + r) * 2048u; }
    __device__ __forceinline__ unsigned b_row(const Unit& u, int r) const { return (unsigned)(u.pn * 256 + r) * 2048u; }
    __device__ __forceinline__ void epi(const pg8::Acc& acc, const Unit& u, int wr, int wc, int fr, int fq) const {
        const int mr = modrow_of(u.pm * 256);
        const float* g = mod + (size_t)mr * (NMOD * D) + chunk * D;
        const float* xin = XinC ? (u.pm < 8 ? XinC : XinL) : nullptr;
#pragma unroll
        for (int bj = 0; bj < 2; ++bj) { const int col = u.pn * 256 + TCOLP(bj, wc, fq); const f32x4 g0 = *(const f32x4*)(g + col), g1 = *(const f32x4*)(g + col + 4);
#pragma unroll
            for (int ai = 0; ai < 2; ++ai)
#pragma unroll
                for (int m = 0; m < 4; ++m) { const size_t off = ((size_t)u.pm * 256 + TROW(ai, wr, m, fr)) * D + col; f32x4 x0, x1;
                    if (xin) { x0 = *(const f32x4*)(xin + off); x1 = *(const f32x4*)(xin + off + 4); }
                    else { const v4u w = *(const v4u*)(X + off); x0 = (f32x4){bf_lo(w.x), bf_hi(w.x), bf_lo(w.y), bf_hi(w.y)}; x1 = (f32x4){bf_lo(w.z), bf_hi(w.z), bf_lo(w[3]), bf_hi(w[3])}; }
                    *(v4u*)(X + off) = pack8(x0 + g0 * acc[ai][bj][m][0], x1 + g1 * acc[ai][bj][m][1]); } }
    }
};

struct PolFP {
    static constexpr bool PERM = true;
    static constexpr bool KEYS = false;
    static constexpr bool I8 = true;
    static constexpr bool F8 = false;
    __device__ __forceinline__ const int* key_ptr(const Unit&, int) const { return nullptr; }
    const char* A; const char* B; int nt; int nN, G, c; const float* sW; const float* sH; bf16* Z; bf16* Zc;
    __device__ __forceinline__ bool next(int i, Unit& u) const { int pm, pn; if (!pg8::static_next(i, G, c, 8, nN, pm, pn)) return false; u.pm = pm; u.pn = pn; u.aux = 0; return true; }
    __device__ __forceinline__ unsigned a_row(const Unit& u, int r, int) const { return (unsigned)(u.pm * 256 + r) * 1024u; }
    __device__ __forceinline__ int tok_row(int pn, int n) const { if (pn < 128) { const int b = n >> 12, l2 = (n >> 6) & 63, l1 = n & 63; return NC + b * SEQ + 64 * l1 + l2; } return n - 32768; }
    __device__ __forceinline__ unsigned b_row(const Unit& u, int r) const { return (unsigned)tok_row(u.pn, u.pn * 256 + r) * 1024u; }
    __device__ __forceinline__ void epi(const pg8::AccI& acc, const Unit& u, int wr, int wc, int fr, int fq) const {
#pragma unroll
        for (int bj = 0; bj < 2; ++bj) { const int n0 = u.pn * 256 + TCOLP(bj, wc, fq);
            f32x4 h0, h1;
#pragma unroll
            for (int q = 0; q < 4; ++q) { h0[q] = sH[tok_row(u.pn, n0 + q)]; h1[q] = sH[tok_row(u.pn, n0 + 4 + q)]; }
#pragma unroll
            for (int ai = 0; ai < 2; ++ai)
#pragma unroll
                for (int m = 0; m < 4; ++m) { const int cp = u.pm * 256 + TROW(ai, wr, m, fr); const float sw = sW[cp]; f32x4 v0, v1;
#pragma unroll
                    for (int q = 0; q < 4; ++q) { v0[q] = (float)acc[ai][bj][m][0][q] * (sw * h0[q]); v1[q] = (float)acc[ai][bj][m][1][q] * (sw * h1[q]); }
                    const v4u w = pack8(v0, v1);
                    if (u.pn < 128) *(v4u*)(Z + ((size_t)(n0 >> 6) * 2048 + cp) * 64 + (n0 & 63)) = w;
                    else { const int b = u.pn - 128, l = n0 - 32768 - b * 256; *(v4u*)(Zc + ((size_t)b * 2048 + cp) * 256 + l) = w; } } }
    }
};

struct PolFA {
    static constexpr bool PERM = true;
    static constexpr bool KEYS = false;
    static constexpr bool I8 = false;
    static constexpr bool F8 = false;
    __device__ __forceinline__ const int* key_ptr(const Unit&, int) const { return nullptr; }
    const char* A; const char* B; int nt; int G, c; bf16* Y;
    __device__ __forceinline__ bool next(int i, Unit& u) const { const int L = i * G + c; if (L >= 1024) return false; u.pm = 0; u.pn = L & 127; u.aux = L >> 7; return true; }
    __device__ __forceinline__ unsigned a_row(const Unit&, int r, int) const { return (unsigned)r * 512u; }
    __device__ __forceinline__ unsigned b_row(const Unit& u, int r) const { const int l2 = r & 63, cp = u.pn * 4 + (r >> 6); return (unsigned)((u.aux * 64 + l2) * 512 + cp) * 512u; }
    __device__ __forceinline__ void epi(const pg8::Acc& acc, const Unit& u, int wr, int wc, int fr, int fq) const {
        const int b = u.aux;
#pragma unroll
        for (int ai = 0; ai < 2; ++ai)
#pragma unroll
            for (int m = 0; m < 4; ++m) { const int rr = TROW(ai, wr, m, fr), jp = rr >> 7, pp = (rr >> 6) & 1, k1 = rr & 63;
#pragma unroll
                for (int bj = 0; bj < 2; ++bj) { const int n0 = u.pn * 256 + TCOLP(bj, wc, fq), cp = n0 >> 6, l2 = n0 & 63, cc = 2 * cp + jp;
                    const size_t idx = ((((size_t)(b * 16 + (k1 >> 2)) * 1024 + cc) * 4 + (k1 & 3)) * 2 + pp) * 64 + l2;
                    *(v4u*)(Y + idx) = pack8(acc[ai][bj][m][0], acc[ai][bj][m][1]); } }
    }
};

struct PolFC {
    static constexpr bool PERM = true;
    static constexpr bool KEYS = false;
    static constexpr bool I8 = false;
    static constexpr bool F8 = false;
    __device__ __forceinline__ const int* key_ptr(const Unit&, int) const { return nullptr; }
    const char* A; const char* B; int nt; int G, c; int nunits; unsigned offMC, offZc; bf16* F;
    __device__ __forceinline__ bool next(int i, Unit& u) const { const int L = i * G + c; if (L >= nunits) return false;
        if (L < 512) { u.pm = 0; u.pn = L & 3; u.aux = L >> 2; } else { const int q = L - 512; u.pm = 0; u.pn = q & 3; u.aux = 256 + (q >> 2); } return true; }
    __device__ __forceinline__ unsigned a_row(const Unit& u, int r, int) const {
        if (u.aux < 256) return offMC + (unsigned)((u.aux & 15) * 256 + r) * 1024u;
        return (unsigned)r * 1024u; }
    __device__ __forceinline__ unsigned b_row(const Unit& u, int r) const {
        if (u.aux < 256) return (unsigned)(u.aux * 1024 + u.pn * 256 + r) * 1024u;
        return offZc + (unsigned)((u.aux - 256) * 1024 + u.pn * 256 + r) * 1024u; }
    __device__ __forceinline__ void epi(const pg8::Acc& acc, const Unit& u, int wr, int wc, int fr, int fq) const {
#pragma unroll
        for (int ai = 0; ai < 2; ++ai)
#pragma unroll
            for (int m = 0; m < 4; ++m) { const int rr = TROW(ai, wr, m, fr); size_t frow;
                if (u.aux < 256) { const int b = u.aux >> 4, kq = u.aux & 15, k = 4 * kq + (rr >> 6) + 64 * (rr & 63); frow = (size_t)NC + b * SEQ + k; }
                else frow = (size_t)(u.aux - 256) * LCTX + rr;
#pragma unroll
                for (int bj = 0; bj < 2; ++bj) { const int col = u.pn * 256 + TCOLP(bj, wc, fq); *(v4u*)(F + frow * D + col) = pack8(acc[ai][bj][m][0], acc[ai][bj][m][1]); } }
    }
};

struct PolMlaQ {
    static constexpr bool PERM = true;
    static constexpr bool KEYS = false;
    static constexpr bool I8 = false;
    static constexpr bool F8 = false;
    __device__ __forceinline__ const int* key_ptr(const Unit&, int) const { return nullptr; }
    const char* A; const char* B; int nt; int nM, nN, G, c; bf16* Q; const float* rope; float c2;
    __device__ __forceinline__ bool next(int i, Unit& u) const { int pm, pn; if (!pg8::static_next(i, G, c, nM, nN, pm, pn)) return false; u.pm = pm; u.pn = pn; u.aux = 0; return true; }
    __device__ __forceinline__ unsigned a_row(const Unit& u, int r, int) const { return (unsigned)(u.pm * 256 + r) * (unsigned)(MLA_QL * 2); }
    __device__ __forceinline__ unsigned b_row(const Unit& u, int r) const { return (unsigned)(u.pn * 256 + r) * (unsigned)(MLA_QL * 2); }
    __device__ __forceinline__ void epi(const pg8::Acc& acc, const Unit& u, int wr, int wc, int fr, int fq) const {
        const bool lat = u.pm >= 8;
#pragma unroll
        for (int bj = 0; bj < 2; ++bj) { const int col = u.pn * 256 + TCOLP(bj, wc, fq); const bool isrope = lat && (((col >> 5) % 3) == 2);
#pragma unroll
            for (int ai = 0; ai < 2; ++ai)
#pragma unroll
                for (int m = 0; m < 4; ++m) { const int row = u.pm * 256 + TROW(ai, wr, m, fr); f32x4 v0 = acc[ai][bj][m][0], v1 = acc[ai][bj][m][1];
                    if (isrope) { const int t = (row - NC) & 4095, pos = (fq & 2) ? (t & 63) : (t >> 6);
                        const f32x4* rp = (const f32x4*)(rope + (size_t)pos * 16);
                        const f32x4 r0 = rp[0], r1 = rp[1], r2 = rp[2], r3 = rp[3];
                        f32x4 p0, p1;
#pragma unroll
                        for (int e = 0; e < 4; ++e) { p0[e] = shx(v0[e], 16, fq * 16 + fr); p1[e] = shx(v1[e], 16, fq * 16 + fr); }
                        const float sg = (fq & 1) ? 1.f : -1.f;
                        v0[0] = v0[0] * r0[0] + sg * p0[0] * r0[1]; v0[1] = v0[1] * r0[2] + sg * p0[1] * r0[3];
                        v0[2] = v0[2] * r1[0] + sg * p0[2] * r1[1]; v0[3] = v0[3] * r1[2] + sg * p0[3] * r1[3];
                        v1[0] = v1[0] * r2[0] + sg * p1[0] * r2[1]; v1[1] = v1[1] * r2[2] + sg * p1[1] * r2[3];
                        v1[2] = v1[2] * r3[0] + sg * p1[2] * r3[1]; v1[3] = v1[3] * r3[2] + sg * p1[3] * r3[3]; }
                    *(v4u*)(Q + (size_t)row * 1536 + col) = pack8(v0 * c2, v1 * c2); } }
    }
};

struct PolMlaKV {
    static constexpr bool PERM = true;
    static constexpr bool KEYS = false;
    static constexpr bool I8 = false;
    static constexpr bool F8 = false;
    __device__ __forceinline__ const int* key_ptr(const Unit&, int) const { return nullptr; }
    const char* A; const char* B; int nt; int nM, nN, G, c; bf16* Kb; bf16* Vb;
    __device__ __forceinline__ bool next(int i, Unit& u) const { int pm, pn; if (!pg8::static_next(i, G, c, nM, nN, pm, pn)) return false; u.pm = pm; u.pn = pn; u.aux = 0; return true; }
    __device__ __forceinline__ unsigned a_row(const Unit& u, int r, int) const { return (unsigned)(u.pm * 256 + r) * 512u; }
    __device__ __forceinline__ unsigned b_row(const Unit& u, int r) const { return (unsigned)(u.pn * 256 + r) * 512u; }
    __device__ __forceinline__ void epi(const pg8::Acc& acc, const Unit& u, int wr, int wc, int fr, int fq) const {
#pragma unroll
        for (int bj = 0; bj < 2; ++bj) { const int col = u.pn * 256 + TCOLP(bj, wc, fq), h = col >> 7, j = col & 127;
#pragma unroll
            for (int ai = 0; ai < 2; ++ai)
#pragma unroll
                for (int m = 0; m < 4; ++m) { const size_t row = (size_t)u.pm * 256 + TROW(ai, wr, m, fr); const v4u w = pack8(acc[ai][bj][m][0], acc[ai][bj][m][1]);
                    if (j < 64) *(v4u*)(Kb + row * 1536 + 96 * h + j) = w; else *(v4u*)(Vb + row * 1024 + 64 * h + (j - 64)) = w; } }
    }
};

struct MoeTab { const LAS int* TT; const LAS int* CN; const LAS int* TE; };
__device__ __forceinline__ bool moe_next(int i, int G, int c, int NP, const MoeTab& T, Unit& u) {
    const int ttot = T.TT[32];
    int lo, hi, j;
    if ((G & 7) == 0) { const int x = c & 7, q = c >> 3, g8 = G >> 3; lo = (x * ttot) >> 3; hi = ((x + 1) * ttot) >> 3; j = i * g8 + q; }
    else { lo = 0; hi = ttot; j = i * G + c; }
    if (j >= (hi - lo) * NP) return false;
    const int tile = lo + j / NP; u.pn = j % NP; u.pm = tile;
    const int e = T.TE[tile];
    u.aux = e | ((tile - T.TT[e]) << 8);
    return true;
}
struct PolMoe1 {
    static constexpr bool PERM = true;
    static constexpr bool I8 = true;
    static constexpr bool F8 = false;
    const char* A; const char* B; int nt; int G, c; MoeTab T; const int* stok; const float* bgu; const float* swgu; const float* ssc; unsigned char* act;
    __device__ __forceinline__ bool next(int i, Unit& u) const { return moe_next(i, G, c, 8, T, u); }
    static constexpr bool KEYS = true;
    __device__ __forceinline__ const int* key_ptr(const Unit& u, int r) const { const int e = u.aux & 255, idx = (u.aux >> 8) * 256 + r; const int cn = T.CN[e]; return stok + (size_t)e * CAP + (idx < cn ? idx : 0); }
    __device__ __forceinline__ unsigned a_row(const Unit&, int, int key) const { return (unsigned)key * 1024u; }
    __device__ __forceinline__ unsigned b_row(const Unit& u, int r) const { return (unsigned)((u.aux & 255) * 2048 + u.pn * 256 + r) * 1024u; }
    __device__ __forceinline__ void epi(const pg8::AccI& acc, const Unit& u, int wr, int wc, int fr, int fq) const {
        const int e = u.aux & 255, mt = u.aux >> 8, cn = T.CN[e]; const int jl = 32 * wc + 8 * fq;
        const float* bg = bgu + (size_t)e * 2048 + u.pn * 256 + jl;
        const float* sg = swgu + (size_t)e * 2048 + u.pn * 256 + jl;
        const f32x4 bg0 = *(const f32x4*)(bg), bg1 = *(const f32x4*)(bg + 4), bu0 = *(const f32x4*)(bg + 128), bu1 = *(const f32x4*)(bg + 132);
        const f32x4 sg0 = *(const f32x4*)(sg), sg1 = *(const f32x4*)(sg + 4), su0 = *(const f32x4*)(sg + 128), su1 = *(const f32x4*)(sg + 132);
#pragma unroll
        for (int ai = 0; ai < 2; ++ai)
#pragma unroll
            for (int m = 0; m < 4; ++m) { const int rr = TROW(ai, wr, m, fr), idx = mt * 256 + rr; const size_t slot = (size_t)u.pm * 256 + rr;
                const float sa = ssc[(size_t)e * CAP + (idx < cn ? idx : 0)];
                f32x4 o0, o1;
#define MOE1_ACT(OUT, N, SG, BG, SU, BU) do { _Pragma("unroll") for (int hq = 0; hq < 2; ++hq) { \
                    const f32x2 ag = {(float)acc[ai][0][m][N][2 * hq], (float)acc[ai][0][m][N][2 * hq + 1]}, au = {(float)acc[ai][1][m][N][2 * hq], (float)acc[ai][1][m][N][2 * hq + 1]}; \
                    const f32x2 sgp = {SG[2 * hq], SG[2 * hq + 1]}, bgp = {BG[2 * hq], BG[2 * hq + 1]}, sup = {SU[2 * hq], SU[2 * hq + 1]}, bup = {BU[2 * hq], BU[2 * hq + 1]}; \
                    f32x2 g = __builtin_elementwise_fma(ag, sgp * sa, bgp), u = __builtin_elementwise_fma(au, sup * sa, bup); \
                    g[0] = fminf(g[0], 7.f); g[1] = fminf(g[1], 7.f); u[0] = __builtin_amdgcn_fmed3f(u[0], -7.f, 7.f); u[1] = __builtin_amdgcn_fmed3f(u[1], -7.f, 7.f); \
                    const f32x2 z = g * (-1.702f * LOG2E); f32x2 e; e[0] = __builtin_amdgcn_exp2f(z[0]); e[1] = __builtin_amdgcn_exp2f(z[1]); \
                    const f32x2 dd = e + 1.f; f32x2 r; r[0] = __builtin_amdgcn_rcpf(dd[0]); r[1] = __builtin_amdgcn_rcpf(dd[1]); \
                    const f32x2 o = ((u + 1.f) * g) * r; OUT[2 * hq] = o[0]; OUT[2 * hq + 1] = o[1]; } } while (0)
                MOE1_ACT(o0, 0, sg0, bg0, su0, bu0); MOE1_ACT(o1, 1, sg1, bg1, su1, bu1);
#undef MOE1_ACT
                v2u w8; { int t0 = __builtin_amdgcn_cvt_pk_fp8_f32(o0[0], o0[1], 0, false); t0 = __builtin_amdgcn_cvt_pk_fp8_f32(o0[2], o0[3], t0, true);
                          int t1 = __builtin_amdgcn_cvt_pk_fp8_f32(o1[0], o1[1], 0, false); t1 = __builtin_amdgcn_cvt_pk_fp8_f32(o1[2], o1[3], t1, true); w8.x = (unsigned)t0; w8.y = (unsigned)t1; }
                *(v2u*)(act + slot * 1024 + u.pn * 128 + jl) = w8; }
    }
};
struct PolMoe2 {
    static constexpr bool PERM = true;
    static constexpr bool KEYS = false;
    static constexpr bool I8 = false;
    static constexpr bool F8 = true;
    __device__ __forceinline__ const int* key_ptr(const Unit&, int) const { return nullptr; }
    const char* A; const char* B; int nt; int G, c; MoeTab T; const float* sw; const float* bdn; const float* swd; unsigned char* Y;
    __device__ __forceinline__ bool next(int i, Unit& u) const { return moe_next(i, G, c, 4, T, u); }
    __device__ __forceinline__ unsigned a_row(const Unit& u, int r, int) const { return (unsigned)(u.pm * 256 + r) * 1024u; }
    __device__ __forceinline__ unsigned b_row(const Unit& u, int r) const { return (unsigned)((u.aux & 255) * 1024 + u.pn * 256 + r) * 1024u; }
    __device__ __forceinline__ void epi(const pg8::Acc& acc, const Unit& u, int wr, int wc, int fr, int fq) const {
        const int e = u.aux & 255, mt = u.aux >> 8, cn = T.CN[e];
#pragma unroll
        for (int bj = 0; bj < 2; ++bj) { const int col = u.pn * 256 + TCOLP(bj, wc, fq); const size_t ci = (size_t)e * 1024 + col;
            const f32x4 b0 = *(const f32x4*)(bdn + ci), b1 = *(const f32x4*)(bdn + ci + 4), s0 = *(const f32x4*)(swd + ci), s1 = *(const f32x4*)(swd + ci + 4);
#pragma unroll
            for (int ai = 0; ai < 2; ++ai)
#pragma unroll
                for (int m = 0; m < 4; ++m) { const int rr = TROW(ai, wr, m, fr), idx = mt * 256 + rr; const size_t slot = (size_t)u.pm * 256 + rr; const float w = sw[(size_t)e * CAP + (idx < cn ? idx : 0)];
                    const float w8 = w * 8.f; f32x4 y0 = (acc[ai][bj][m][0] * s0 + b0) * w8, y1 = (acc[ai][bj][m][1] * s1 + b1) * w8;
#pragma unroll
                    for (int q = 0; q < 4; ++q) { y0[q] = fminf(fmaxf(y0[q], -448.f), 448.f); y1[q] = fminf(fmaxf(y1[q], -448.f), 448.f); }
                    v2u o8; { int t0 = __builtin_amdgcn_cvt_pk_fp8_f32(y0[0], y0[1], 0, false); t0 = __builtin_amdgcn_cvt_pk_fp8_f32(y0[2], y0[3], t0, true);
                              int t1 = __builtin_amdgcn_cvt_pk_fp8_f32(y1[0], y1[1], 0, false); t1 = __builtin_amdgcn_cvt_pk_fp8_f32(y1[2], y1[3], t1, true); o8.x = (unsigned)t0; o8.y = (unsigned)t1; }
                    *(v2u*)(Y + slot * 1024 + col) = o8; } }
    }
};

namespace att {
__device__ __forceinline__ int crow(int r, int hi) { return (r & 3) + 8 * (r >> 2) + 4 * hi; }
__device__ __forceinline__ float max3f(float a, float b, float c) { return fmaxf(fmaxf(a, b), c); }
typedef LAS const char* lds_cptr;
constexpr int LK = 0, LV = 49152, LWS = 90112, LOST = 92160, LBYTES = 124928;
constexpr int PD = 3;
struct Tens { const bf16* Q; int qpitch; const bf16* K; int kpitch; const bf16* V; int vpitch; bf16* O; };
#define ATT_WAITV(n) asm volatile("s_waitcnt vmcnt(" #n ")" ::: "memory")
struct Pend { f32x16 o0, o1; float l; int qrow0, oc0; bool valid; };
__device__ __forceinline__ void finish_unit(const Pend& P, bf16* O, LAS unsigned char* lds, int wid, int lane) {
    const int r32 = lane & 31, hi = lane >> 5;
    LAS float* wsf = (LAS float*)(lds + LWS) + wid * 64;
    float lrun = P.l;
    { auto rr = __builtin_amdgcn_permlane32_swap(__float_as_uint(lrun), __float_as_uint(lrun), false, false); lrun = __uint_as_float(rr[0]) + __uint_as_float(rr[1]); }
    if (hi == 0) wsf[32 + r32] = lrun;
    LDS_WAIT();
    LAS bf16* stg = (LAS bf16*)(lds + LOST) + wid * 2048;
#pragma unroll
    for (int r = 0; r < 16; ++r) { const int orow = crow(r, hi); const float rl = __builtin_amdgcn_rcpf(wsf[32 + orow]);
        stg[orow * 64 + r32] = (bf16)(pk2(P.o0[r] * rl, 0.f) & 0xffffu); stg[orow * 64 + 32 + r32] = (bf16)(pk2(P.o1[r] * rl, 0.f) & 0xffffu); }
    LDS_WAIT();
    bf16* Ow = O + (size_t)(P.qrow0 + wid * 32) * 1024 + P.oc0;
#pragma unroll
    for (int i = 0; i < 4; ++i) { const int row = i * 8 + (lane >> 3), ch = lane & 7; const v4u v = *(const LAS v4u*)(stg + row * 64 + ch * 8); *(v4u*)(Ow + (size_t)row * 1024 + ch * 8) = v; }
    LDS_WAIT();
}
template <int DK>
__device__ __forceinline__ void unit(const Tens& T, int qrow0, int qc0, int kc0, int vc0, int oc0, int kctx0, int klat0, int NTL, LAS unsigned char* lds, int wave_id, Pend& pend) {
    constexpr int ND = DK / 16;
    wave_id = launder_s(wave_id); const int tid = lthread_w(wave_id), lane = tid & 63, r32 = lane & 31, hi = lane >> 5; const int wid = wave_id;
    LAS float* wsf = (LAS float*)(lds + LWS) + wid * 64;
    const bf16* ksrc = T.K + (size_t)lane * T.kpitch + kc0 + wid * 8;
    const int k2off = (8 + (wid & 3) - wid) * 8;
    const bf16* vsrc = T.V + (size_t)(16 * (wid & 3) + (lane >> 2)) * T.vpitch + vc0 + (wid >> 2) * 32 + (lane & 3) * 8;
#define ATT_DMA(t, ks_, vs_) do { const size_t row0_ = (size_t)((t) < 4 ? kctx0 + 64 * (t) : klat0 + 64 * ((t) - 4)); \
        __builtin_amdgcn_global_load_lds((const unsigned*)(ksrc + row0_ * T.kpitch), (LAS unsigned*)(lds + LK + (ks_) * 12288 + wid * 1024), 16, 0, 0); \
        if (DK > 64) __builtin_amdgcn_global_load_lds((const unsigned*)(ksrc + row0_ * T.kpitch + k2off), (LAS unsigned*)(lds + LK + (ks_) * 12288 + 8192 + (wid & 3) * 1024), 16, 0, 0); \
        __builtin_amdgcn_global_load_lds((const unsigned*)(vsrc + row0_ * T.vpitch), (LAS unsigned*)(lds + LV + (vs_) * 8192 + wid * 1024), 16, 0, 0); } while (0)
#define ATT_WAIT_TILES(n_tiles) do { if (DK > 64) { if ((n_tiles) >= 2) ATT_WAITV(6); else if ((n_tiles) == 1) ATT_WAITV(3); else ATT_WAITV(0); } \
        else { if ((n_tiles) >= 2) ATT_WAITV(4); else if ((n_tiles) == 1) ATT_WAITV(2); else ATT_WAITV(0); } } while (0)
    bf16x8 qr[ND];
    { const bf16* qp = T.Q + (size_t)(qrow0 + wid * 32 + r32) * T.qpitch + qc0 + hi * 8;
#pragma unroll
      for (int d0 = 0; d0 < ND; ++d0) qr[d0] = *(const bf16x8*)(qp + d0 * 16); }
    asm volatile("" ::: "memory");
    constexpr float THR = 8.f;
    const int half = wid >> 2;
    float mhat = 0.f, lrun = 0.f; f32x16 o[2]; o[0] = f32x16{}; o[1] = f32x16{}; f32x16 negm = f32x16{};
    f32x16 p0 = f32x16{}, p1 = f32x16{}; v4u pw[4]; pw[0] = pw[1] = pw[2] = pw[3] = (v4u){0u, 0u, 0u, 0u};
    ATT_DMA(0, 0, 0); ATT_DMA(1, 1, 1); ATT_DMA(2, 2, 2);
    if (pend.valid) finish_unit(pend, T.O, lds, wid, lane);
    ATT_WAIT_TILES(2);
    __builtin_amdgcn_s_barrier(); asm volatile("" ::: "memory");
    if (half == 1) __builtin_amdgcn_s_barrier();
    int vs_prev = 0, vs_cur = 0, vs_iss = 3;
    for (int t = 0; t <= NTL; ++t) {
        if (t >= 1) {
            s16x4 lo[2][4], hh[2][4];
            const unsigned vb = (unsigned)(uintptr_t)(lds + LV + vs_prev * 8192) + ((lane >> 4) & 1) * 32 + (lane & 3) * 8 + (4 * hi + ((lane & 15) >> 2)) * 64;
#pragma unroll
            for (int d0 = 0; d0 < 2; ++d0)
#pragma unroll
                for (int ks = 0; ks < 4; ++ks) {
                    asm volatile("ds_read_b64_tr_b16 %0,%1 offset:%c2" : "=&v"(lo[d0][ks]) : "v"(vb), "i"(d0 * 4096 + ks * 1024) : "memory");
                    asm volatile("ds_read_b64_tr_b16 %0,%1 offset:%c2" : "=&v"(hh[d0][ks]) : "v"(vb), "i"(d0 * 4096 + ks * 1024 + 512) : "memory"); }
            asm volatile("s_waitcnt lgkmcnt(0)" ::: "memory"); __builtin_amdgcn_sched_barrier(0);
#pragma unroll
            for (int ks = 0; ks < 4; ++ks)
#pragma unroll
                for (int d0 = 0; d0 < 2; ++d0) { const bf16x8 vf = (bf16x8){lo[d0][ks][0], lo[d0][ks][1], lo[d0][ks][2], lo[d0][ks][3], hh[d0][ks][0], hh[d0][ks][1], hh[d0][ks][2], hh[d0][ks][3]};
                    o[d0] = __builtin_amdgcn_mfma_f32_32x32x16_bf16(__builtin_bit_cast(bf16x8, pw[ks]), vf, o[d0], 0, 0, 0); }
        }
        if (t < NTL) {
            bf16x8 kf[2 * ND];
            const lds_cptr kb = (lds_cptr)(lds + LK + (t & 3) * 12288) + hi * 1024 + r32 * 16;
#pragma unroll
            for (int d0 = 0; d0 < ND; ++d0) { kf[2 * d0] = *(const LAS bf16x8*)(kb + d0 * 2048); kf[2 * d0 + 1] = *(const LAS bf16x8*)(kb + d0 * 2048 + 512); }
            asm volatile("s_waitcnt lgkmcnt(0)" ::: "memory"); __builtin_amdgcn_sched_barrier(0);
#pragma unroll
            for (int d0 = 0; d0 < ND; ++d0) {
                if (d0 == 0) { p0 = __builtin_amdgcn_mfma_f32_32x32x16_bf16(kf[0], qr[0], negm, 0, 0, 0); p1 = __builtin_amdgcn_mfma_f32_32x32x16_bf16(kf[1], qr[0], negm, 0, 0, 0); }
                else { p0 = __builtin_amdgcn_mfma_f32_32x32x16_bf16(kf[2 * d0], qr[d0], p0, 0, 0, 0); p1 = __builtin_amdgcn_mfma_f32_32x32x16_bf16(kf[2 * d0 + 1], qr[d0], p1, 0, 0, 0); } }
        }
        if (half == 1) {
            const int last_iss = (t + PD - 1 < NTL - 1) ? t + PD - 1 : NTL - 1; const int allow = last_iss - (t + 1);
            if (allow >= 1) ATT_WAIT_TILES(1); else ATT_WAIT_TILES(0); }
        asm volatile("s_waitcnt lgkmcnt(0)" ::: "memory"); __builtin_amdgcn_s_barrier(); asm volatile("" ::: "memory");
        if (t < NTL) {
            float rm = max3f(p0[0], p0[1], p1[0]);
#pragma unroll
            for (int r = 0; r < 16; ++r) rm = max3f(rm, p0[r], p1[r]);
            { auto rr = __builtin_amdgcn_permlane32_swap(__float_as_uint(rm), __float_as_uint(rm), false, false); rm = fmaxf(__uint_as_float(rr[0]), __uint_as_float(rr[1])); }
            if (t == 0 || __any(rm > THR)) {
                const float dl = (t == 0) ? rm : fmaxf(rm, 0.f);
                mhat += dl;
#pragma unroll
                for (int r = 0; r < 16; ++r) { p0[r] -= dl; p1[r] -= dl; negm[r] = -mhat; }
                const float f = (t == 0) ? 1.f : __builtin_amdgcn_exp2f(-dl); lrun *= f;
                if (hi == 0) wsf[r32] = f;
                LDS_WAIT();
#pragma unroll
                for (int r = 0; r < 16; ++r) { const float a = wsf[crow(r, hi)]; o[0][r] *= a; o[1][r] *= a; }
            }
            float rs = 0.f;
#pragma unroll
            for (int r = 0; r < 16; ++r) { p0[r] = __builtin_amdgcn_exp2f(p0[r]); p1[r] = __builtin_amdgcn_exp2f(p1[r]); rs += p0[r] + p1[r]; }
            lrun += rs;
            pw[0] = (v4u){pk2(p0[0], p0[1]), pk2(p0[2], p0[3]), pk2(p0[4], p0[5]), pk2(p0[6], p0[7])};
            pw[1] = (v4u){pk2(p0[8], p0[9]), pk2(p0[10], p0[11]), pk2(p0[12], p0[13]), pk2(p0[14], p0[15])};
            pw[2] = (v4u){pk2(p1[0], p1[1]), pk2(p1[2], p1[3]), pk2(p1[4], p1[5]), pk2(p1[6], p1[7])};
            pw[3] = (v4u){pk2(p1[8], p1[9]), pk2(p1[10], p1[11]), pk2(p1[12], p1[13]), pk2(p1[14], p1[15])};
        }
        if (t + PD < NTL) { ATT_DMA(t + PD, (t + PD) & 3, vs_iss); vs_iss = (vs_iss == 4) ? 0 : vs_iss + 1; }
        if (half == 0) {
            const int last_iss = (t + PD < NTL - 1) ? t + PD : NTL - 1; const int allow = last_iss - (t + 1);
            if (allow >= 2) ATT_WAIT_TILES(2); else if (allow == 1) ATT_WAIT_TILES(1); else ATT_WAIT_TILES(0); }
        vs_prev = vs_cur; vs_cur = (vs_cur == 4) ? 0 : vs_cur + 1;
        asm volatile("s_waitcnt lgkmcnt(0)" ::: "memory"); __builtin_amdgcn_s_barrier(); asm volatile("" ::: "memory");
    }
    if (half == 0) __builtin_amdgcn_s_barrier();
#undef ATT_DMA
#undef ATT_WAIT_TILES
    pend.o0 = o[0]; pend.o1 = o[1]; pend.l = lrun; pend.qrow0 = qrow0; pend.oc0 = oc0; pend.valid = true;
}
#undef ATT_WAITV
}

namespace att64 {
typedef unsigned short bf16;
using bf16x8=__attribute__((ext_vector_type(8)))short;
using s16x4=__attribute__((ext_vector_type(4)))short;
using f32x16=__attribute__((ext_vector_type(16)))float;
using u32x4=__attribute__((ext_vector_type(4)))unsigned;
constexpr int D=64;
constexpr int NW=8,QBLK=32,QB=QBLK*NW,KVBLK=64;
__device__ __forceinline__ int crow(int r,int hi){return (r&3)+8*(r>>2)+4*hi;}
#define SBAR() __builtin_amdgcn_sched_barrier(0)
constexpr int NSLOT=3, SLOTB=8192;
constexpr int LDS_K=0, LDS_V=NSLOT*SLOTB, LDS_WS=2*NSLOT*SLOTB, LDS_OST=LDS_WS+NW*64*4, LDS_BYTES=LDS_OST+NW*4096;
constexpr float C2=0.125f*1.4426950408889634f;
__device__ __forceinline__ void glds16(const void*gsrc,unsigned lds_dst){unsigned keep;
  asm volatile("s_mov_b32 %0, m0\n\ts_mov_b32 m0, %2\n\ts_nop 0\n\tglobal_load_lds_dwordx4 %1, off\n\ts_mov_b32 m0, %0":"=&s"(keep):"v"(gsrc),"s"(lds_dst):"memory");}
__device__ __forceinline__ float max3f(float a,float b,float c){float r;asm("v_max3_f32 %0, %1, %2, %3":"=v"(r):"v"(a),"v"(b),"v"(c));return r;}
__device__ __forceinline__ float max2f(float a,float b){float r;asm("v_max_f32_e32 %0, %1, %2":"=v"(r):"v"(a),"v"(b));return r;}
__device__ __forceinline__ float fadd_s(float a,float b){float r;asm("v_add_f32_e32 %0, %1, %2":"=v"(r):"v"(a),"v"(b));return r;}
__device__ __forceinline__ float fsub_s(float a,float b){float r;asm("v_sub_f32_e32 %0, %1, %2":"=v"(r):"v"(a),"v"(b));return r;}
typedef float f32x2_t __attribute__((ext_vector_type(2))); typedef __bf16 bf16x2_t __attribute__((ext_vector_type(2)));
__device__ __forceinline__ unsigned cvtpk_s(float lo,float hi){f32x2_t v={lo,hi};bf16x2_t b=__builtin_convertvector(v,bf16x2_t);return __builtin_bit_cast(unsigned,b);}
#define WAIT_BAR(N) asm volatile("s_waitcnt vmcnt(" #N ") lgkmcnt(0)\n\ts_barrier":::"memory")

__device__ __forceinline__ void qkt(f32x16&p0,f32x16&p1,const char*Kslot,const bf16x8*qr,const f32x16&negm,int r32,int hi){
  const char*kb=Kslot+hi*1024+r32*16;
  #pragma unroll
  for(int d0=0;d0<4;++d0){
    const bf16x8 b0=*reinterpret_cast<const bf16x8*>(kb+d0*2048);
    const bf16x8 b1=*reinterpret_cast<const bf16x8*>(kb+d0*2048+512);
    if(d0==0){p0=__builtin_amdgcn_mfma_f32_32x32x16_bf16(b0,qr[0],negm,0,0,0);p1=__builtin_amdgcn_mfma_f32_32x32x16_bf16(b1,qr[0],negm,0,0,0);}
    else{p0=__builtin_amdgcn_mfma_f32_32x32x16_bf16(b0,qr[d0],p0,0,0,0);p1=__builtin_amdgcn_mfma_f32_32x32x16_bf16(b1,qr[d0],p1,0,0,0);}}
}
typedef __attribute__((address_space(3))) const char* lds_cptr;
typedef short v4i16_t __attribute__((ext_vector_type(4)));
__device__ __forceinline__ void kload8(bf16x8*kf,lds_cptr kp){
  kf[0]=*(const __attribute__((address_space(3))) bf16x8*)(kp);      kf[1]=*(const __attribute__((address_space(3))) bf16x8*)(kp+512);
  kf[2]=*(const __attribute__((address_space(3))) bf16x8*)(kp+2048); kf[3]=*(const __attribute__((address_space(3))) bf16x8*)(kp+2560);
  kf[4]=*(const __attribute__((address_space(3))) bf16x8*)(kp+4096); kf[5]=*(const __attribute__((address_space(3))) bf16x8*)(kp+4608);
  kf[6]=*(const __attribute__((address_space(3))) bf16x8*)(kp+6144); kf[7]=*(const __attribute__((address_space(3))) bf16x8*)(kp+6656);
}
__device__ __forceinline__ void kload2(bf16x8*kf,lds_cptr kp,int j){ kf[2*j]=*(const __attribute__((address_space(3))) bf16x8*)(kp+j*2048); kf[2*j+1]=*(const __attribute__((address_space(3))) bf16x8*)(kp+j*2048+512); }
__device__ __forceinline__ s16x4 vtr(lds_cptr p){ return __builtin_bit_cast(s16x4,__builtin_amdgcn_ds_read_tr16_b64_v4i16((__attribute__((address_space(3))) v4i16_t*)p)); }
__device__ __forceinline__ float rowmax(const f32x16&p0,const f32x16&p1){
  float a=max3f(p0[0],p0[1],p1[0]),b=max3f(p0[2],p0[3],p1[1]);a=max3f(a,p1[2],p1[3]);
  #pragma unroll
  for(int r=4;r<16;r+=4){a=max3f(a,p0[r],p0[r+1]);b=max3f(b,p0[r+2],p0[r+3]);a=max3f(a,p1[r],p1[r+1]);b=max3f(b,p1[r+2],p1[r+3]);}
  const float m=max2f(a,b);
  auto rr=__builtin_amdgcn_permlane32_swap(__float_as_uint(m),__float_as_uint(m),false,false);
  return max2f(__uint_as_float(rr[0]),__uint_as_float(rr[1]));
}
__device__ __forceinline__ void pv(f32x16*o,int vb,bf16x8 pa0,bf16x8 pa1,bf16x8 pa2,bf16x8 pa3){
  #pragma unroll
  for(int d0=0;d0<2;++d0){s16x4 lo[4],hi[4];
    #pragma unroll
    for(int ks=0;ks<4;++ks){
      asm volatile("ds_read_b64_tr_b16 %0,%1 offset:%c2":"=&v"(lo[ks]):"v"(vb),"i"(d0*4096+ks*1024):"memory");
      asm volatile("ds_read_b64_tr_b16 %0,%1 offset:%c2":"=&v"(hi[ks]):"v"(vb),"i"(d0*4096+ks*1024+512):"memory");}
    asm volatile("s_waitcnt lgkmcnt(0)":::"memory");SBAR();
    #define PK(k) (bf16x8){lo[k][0],lo[k][1],lo[k][2],lo[k][3],hi[k][0],hi[k][1],hi[k][2],hi[k][3]}
    o[d0]=__builtin_amdgcn_mfma_f32_32x32x16_bf16(pa0,PK(0),o[d0],0,0,0);
    o[d0]=__builtin_amdgcn_mfma_f32_32x32x16_bf16(pa1,PK(1),o[d0],0,0,0);
    o[d0]=__builtin_amdgcn_mfma_f32_32x32x16_bf16(pa2,PK(2),o[d0],0,0,0);
    o[d0]=__builtin_amdgcn_mfma_f32_32x32x16_bf16(pa3,PK(3),o[d0],0,0,0);
    #undef PK
  }
}

#ifndef ATTN_STORE16
#define ATTN_STORE16(p,v) (*(u32x4*)(p)=(v))
#endif
template<int THRL> __device__ __forceinline__ void attn_unit(const bf16*Q,int qp,int qrow0,int qc0,const bf16*__restrict__ K,int kp,int kc0,const bf16*__restrict__ V,int vp,int vc0,bf16*O,int oc0,int kctx0,int klat0,int NT,char*shm,int wave_id){
  wave_id=launder_s(wave_id); const int lane=lane_id_v(),r32=lane&31,hi=lane>>5; const int wid=wave_id;
  const bf16*Qw=Q+(long)(qrow0+wid*QBLK)*qp+qc0;
  const bf16*Kh=K+kc0,*Vh=V+vc0;
  const unsigned lds0=(unsigned)(uintptr_t)shm;
  float*wsf=(float*)(shm+LDS_WS)+wid*64;
  const bf16*ksrc=Kh+(long)lane*kp+wid*8;
  const bf16*vsrc=Vh+(long)(16*(wid&3)+(lane>>2))*vp+(wid>>2)*32+(lane&3)*8;
  #define TROW0(t) ((long)((t)<4?kctx0+64*(t):klat0+64*((t)-4)))
  const unsigned kdst=lds0+LDS_K+wid*1024, vdst=lds0+LDS_V+wid*1024;
  #define DMA_K(t,slot) glds16(ksrc+TROW0(t)*kp,(unsigned)__builtin_amdgcn_readfirstlane(kdst+(slot)))
  #define DMA_V(t,slot) glds16(vsrc+TROW0(t)*vp,(unsigned)__builtin_amdgcn_readfirstlane(vdst+(slot)))
  const int vb0=(int)(lds0+LDS_V)+((lane>>4)&1)*32+(lane&3)*8+(4*hi+((lane&15)>>2))*64;
  const char*Kbase=shm+LDS_K; bf16x8 kf[8];
  const lds_cptr shm3=(lds_cptr)shm; const lds_cptr kp0=shm3+LDS_K+hi*1024+r32*16; const lds_cptr vp0=shm3+LDS_V+((lane>>4)&1)*32+(lane&3)*8+(4*hi+((lane&15)>>2))*64;
  DMA_K(0,0);DMA_V(0,0);DMA_K(1,SLOTB);
  bf16x8 qr[4];
  #pragma unroll
  for(int d0=0;d0<4;++d0)qr[d0]=*reinterpret_cast<const bf16x8*>(&Qw[(long)r32*qp+d0*16+hi*8]);
  float mhat=0.f,l_reg=0.f;f32x16 o[2];o[0]=f32x16{};o[1]=f32x16{};f32x16 negm=f32x16{};asm volatile("":"+v"(negm));
  #define CMASK(P0,P1,t) do{}while(0)
  bool resc=false;
  #define START(P0,P1) do{ const float rm=rowmax(P0,P1); resc=false; \
    { const float dl=rm; mhat=fadd_s(mhat,dl); \
      _Pragma("unroll") for(int r=0;r<16;++r){P0[r]=fsub_s(P0[r],dl);P1[r]=fsub_s(P1[r],dl);} \
      _Pragma("unroll") for(int r=0;r<16;++r)negm[r]=-mhat; asm volatile("":"+v"(negm)); } \
    _Pragma("unroll") for(int r=0;r<16;++r)P0[r]=__builtin_amdgcn_exp2f(P0[r]); }while(0)
  #define RESC() do{ if(resc){ asm volatile("s_waitcnt lgkmcnt(0)":::"memory"); \
      _Pragma("unroll") for(int d_=0;d_<2;++d_) _Pragma("unroll") for(int r=0;r<16;++r)o[d_][r]*=wsf[crow(r,hi)]; } }while(0)
  f32x16 pA0,pA1,pB0,pB1;
  int sl_prev=0,sl_cur=0,sl_next=SLOTB;
  #define ROT() do{sl_prev=sl_cur;sl_cur=sl_next;sl_next=(sl_next==(NSLOT-1)*SLOTB)?0:sl_next+SLOTB;}while(0)
  DMA_K(2,2*SLOTB);
  WAIT_BAR(3);
  qkt(pA0,pA1,Kbase,qr,negm,r32,hi);asm volatile("s_nop 15\n\ts_nop 7":"+v"(pA0),"+v"(pA1));CMASK(pA0,pA1,0);
  START(pA0,pA1);
  _Pragma("unroll") for(int r=0;r<16;++r)pA1[r]=__builtin_amdgcn_exp2f(pA1[r]);
  WAIT_BAR(0);
  DMA_K(3,0);DMA_V(1,SLOTB);
  ROT();
  kload8(kf,kp0+sl_cur);
  WAIT_BAR(2);
  s16x4 vlo[8],vhi[8]; u32x4 pw0,pw1,pw2,pw3;
  #define PKW(P,B) cvtpk_s(P[B],P[B+1])
  #define PAF(k) __builtin_bit_cast(bf16x8,pw##k)
  #define VFR(i) (bf16x8){vlo[i][0],vlo[i][1],vlo[i][2],vlo[i][3],vhi[i][0],vhi[i][1],vhi[i][2],vhi[i][3]}
  #define PIN(x) asm volatile("":"+v"(x))
  #define MX3(a,b,c) __builtin_fmaxf(__builtin_fmaxf((a),(b)),(c))
  #define GAPA(MF,A0,A1,A2,A3,W0,W1,PW) do{ MF; sacc+=A0; sacc+=A1; sacc+=A2; sacc+=A3; PIN(sacc); W0; W1; PIN(PW); SBAR(); }while(0)
  #define EX(v) __builtin_amdgcn_exp2f(v)
  #define GAPB(MF,X,B) do{ MF; X[B]=EX(X[B]); X[B+1]=EX(X[B+1]); X[B+2]=EX(X[B+2]); X[B+3]=EX(X[B+3]); PIN(X); SBAR(); }while(0)
  #define VRD(i) do{ vlo[i]=vtr(vp_+(((i)>>2)*4096+((i)&3)*1024)); vhi[i]=vtr(vp_+(((i)>>2)*4096+((i)&3)*1024+512)); }while(0)
  #define KRD(G,j) do{ if(G){ kload2(kf,kp0+sl_next,j); SBAR(); } }while(0)
  #define STEP(C0,C1,P0,P1,t,GK,GV,GL) do{ SBAR(); \
    const lds_cptr vp_=vp0+sl_prev; \
    VRD(0); SBAR(); float sacc=(P0[0]+P0[1]); \
    GAPA(C0=__builtin_amdgcn_mfma_f32_32x32x16_bf16(kf[0],qr[0],negm,0,0,0), P0[2],P0[3],P0[4],P0[5],     pw0[0]=PKW(P0,0), pw0[1]=PKW(P0,2), pw0); \
    VRD(4); SBAR(); GAPA(C1=__builtin_amdgcn_mfma_f32_32x32x16_bf16(kf[1],qr[0],negm,0,0,0), P0[6],P0[7],P0[8],P0[9],     pw0[2]=PKW(P0,4), pw0[3]=PKW(P0,6), pw0); \
    VRD(1); SBAR(); GAPA(C0=__builtin_amdgcn_mfma_f32_32x32x16_bf16(kf[2],qr[1],C0,0,0,0),   P0[10],P0[11],P0[12],P0[13], pw1[0]=PKW(P0,8), pw1[1]=PKW(P0,10), pw1); \
    VRD(5); SBAR(); GAPA(C1=__builtin_amdgcn_mfma_f32_32x32x16_bf16(kf[3],qr[1],C1,0,0,0),   P0[14],P0[15],P1[0],P1[1],   pw1[2]=PKW(P0,12),pw1[3]=PKW(P0,14), pw1); \
    VRD(2); SBAR(); GAPA(C0=__builtin_amdgcn_mfma_f32_32x32x16_bf16(kf[4],qr[2],C0,0,0,0),   P1[2],P1[3],P1[4],P1[5],     pw2[0]=PKW(P1,0), pw2[1]=PKW(P1,2), pw2); \
    VRD(6); SBAR(); GAPA(C1=__builtin_amdgcn_mfma_f32_32x32x16_bf16(kf[5],qr[2],C1,0,0,0),   P1[6],P1[7],P1[8],P1[9],     pw2[2]=PKW(P1,4), pw2[3]=PKW(P1,6), pw2); \
    VRD(3); SBAR(); GAPA(C0=__builtin_amdgcn_mfma_f32_32x32x16_bf16(kf[6],qr[3],C0,0,0,0),   P1[10],P1[11],P1[12],P1[13], pw3[0]=PKW(P1,8), pw3[1]=PKW(P1,10), pw3); \
    VRD(7); SBAR(); GAPA(C1=__builtin_amdgcn_mfma_f32_32x32x16_bf16(kf[7],qr[3],C1,0,0,0),   P1[14],P1[15],0.f,0.f,       pw3[2]=PKW(P1,12),pw3[3]=PKW(P1,14), pw3); \
    l_reg+=sacc; \
    if(GK){DMA_K((t)+3,sl_cur);} if(GV){DMA_V((t)+1,sl_next);} \
    CMASK(C0,C1,t); \
    { float a=MX3(C0[0],C0[1],C1[0]),b=MX3(C0[2],C0[3],C1[1]); a=MX3(a,C1[2],C1[3]); \
      _Pragma("unroll") for(int r=4;r<16;r+=4){a=MX3(a,C0[r],C0[r+1]);b=MX3(b,C0[r+2],C0[r+3]);a=MX3(a,C1[r],C1[r+1]);b=MX3(b,C1[r+2],C1[r+3]);} \
      float rm=__builtin_fmaxf(a,b); { auto rr=__builtin_amdgcn_permlane32_swap(__float_as_uint(rm),__float_as_uint(rm),false,false); rm=__builtin_fmaxf(__uint_as_float(rr[0]),__uint_as_float(rr[1])); } \
      resc=false; \
      if(__builtin_expect(__any(rm>(float)THRL),0)){ const float dl=__builtin_fmaxf(rm,0.f); mhat+=dl; \
        _Pragma("unroll") for(int r=0;r<16;++r){C0[r]-=dl;C1[r]-=dl;} \
        _Pragma("unroll") for(int r=0;r<16;++r)negm[r]=-mhat; asm volatile("":"+v"(negm)); \
        const float f=__builtin_amdgcn_exp2f(-dl); l_reg*=f; if(hi==0)wsf[r32]=f; resc=true; } } \
    SBAR(); \
    GAPB(o[0]=__builtin_amdgcn_mfma_f32_32x32x16_bf16(PAF(0),VFR(0),o[0],0,0,0), C0,0); \
    GAPB(o[1]=__builtin_amdgcn_mfma_f32_32x32x16_bf16(PAF(0),VFR(4),o[1],0,0,0), C0,4); \
    KRD(GL,0); GAPB(o[0]=__builtin_amdgcn_mfma_f32_32x32x16_bf16(PAF(1),VFR(1),o[0],0,0,0), C0,8); \
    KRD(GL,1); GAPB(o[1]=__builtin_amdgcn_mfma_f32_32x32x16_bf16(PAF(1),VFR(5),o[1],0,0,0), C0,12); \
    KRD(GL,2); GAPB(o[0]=__builtin_amdgcn_mfma_f32_32x32x16_bf16(PAF(2),VFR(2),o[0],0,0,0), C1,0); \
    KRD(GL,3); GAPB(o[1]=__builtin_amdgcn_mfma_f32_32x32x16_bf16(PAF(2),VFR(6),o[1],0,0,0), C1,4); \
    GAPB(o[0]=__builtin_amdgcn_mfma_f32_32x32x16_bf16(PAF(3),VFR(3),o[0],0,0,0), C1,8); \
    GAPB(o[1]=__builtin_amdgcn_mfma_f32_32x32x16_bf16(PAF(3),VFR(7),o[1],0,0,0), C1,12); \
    }while(0)
  int t=1;
  for(;t+5<NT;t+=2){
    STEP(pB0,pB1,pA0,pA1,t,true,true,true);     WAIT_BAR(2); RESC(); ROT();
    STEP(pA0,pA1,pB0,pB1,t+1,true,true,true);   WAIT_BAR(2); RESC(); ROT();
  }
  #define ENDW(tt) do{ if((tt)+3<NT){WAIT_BAR(2);} else if((tt)+2<NT){WAIT_BAR(1);} else {WAIT_BAR(0);} }while(0)
  for(;t+1<NT;t+=2){
    STEP(pB0,pB1,pA0,pA1,t,(t+3<NT),(t+1<NT),(t+1<NT));       ENDW(t);   RESC(); ROT();
    STEP(pA0,pA1,pB0,pB1,t+1,(t+4<NT),(t+2<NT),(t+2<NT));     ENDW(t+1); RESC(); ROT();
  }
  STEP(pB0,pB1,pA0,pA1,NT-1,false,false,false); RESC();
  { float sacc=pB0[0]+pB0[1]; _Pragma("unroll") for(int r=2;r<16;++r)sacc+=pB0[r]; _Pragma("unroll") for(int r=0;r<16;++r)sacc+=pB1[r]; l_reg+=sacc;
    pw0=(u32x4){PKW(pB0,0),PKW(pB0,2),PKW(pB0,4),PKW(pB0,6)};pw1=(u32x4){PKW(pB0,8),PKW(pB0,10),PKW(pB0,12),PKW(pB0,14)};pw2=(u32x4){PKW(pB1,0),PKW(pB1,2),PKW(pB1,4),PKW(pB1,6)};pw3=(u32x4){PKW(pB1,8),PKW(pB1,10),PKW(pB1,12),PKW(pB1,14)};
    SBAR(); pv(o,vb0+sl_cur,PAF(0),PAF(1),PAF(2),PAF(3)); }
  #undef PKW
  #undef PAF
  #undef VFR
  #undef PIN
  #undef MX3
  #undef GAPA
  #undef GAPB
  #undef EX
  #undef VRD
  #undef KRD
  #undef STEP
  #undef ENDW
  {auto rr=__builtin_amdgcn_permlane32_swap(__float_as_uint(l_reg),__float_as_uint(l_reg),false,false);l_reg=__uint_as_float(rr[0])+__uint_as_float(rr[1]);}
  if(hi==0)wsf[32+r32]=l_reg;asm volatile("s_waitcnt lgkmcnt(0)":::"memory");
  float rli[16];
  #pragma unroll
  for(int r=0;r<16;++r)rli[r]=__builtin_amdgcn_rcpf(wsf[32+crow(r,hi)]);
  bf16*Ow=O+(long)(qrow0+wid*QBLK)*1024+oc0;
  { bf16*stg=(bf16*)(shm+LDS_OST)+wid*2048;
    #pragma unroll
    for(int r=0;r<16;++r){const int orow=crow(r,hi);
      #pragma unroll
      for(int d0=0;d0<2;++d0)stg[orow*64+d0*32+r32]=(bf16)(cvtpk_s(o[d0][r]*rli[r],0.f)&0xffffu);}
    asm volatile("s_waitcnt lgkmcnt(0)":::"memory");
    #pragma unroll
    for(int i=0;i<4;++i){const int row=i*8+(lane>>3),ch=lane&7; const u32x4 v=*(const u32x4*)(stg+row*64+ch*8); ATTN_STORE16(Ow+(long)row*1024+ch*8,v);} }
  asm volatile("s_waitcnt lgkmcnt(0)\n\ts_barrier":::"memory");
  #undef DMA_K
  #undef DMA_V
  #undef TROW0
  #undef CMASK
  #undef START
  #undef RESC
  #undef ROT
}
#undef SBAR
#undef WAIT_BAR
}

namespace att96 {
typedef unsigned short bf16;
using bf16x8=__attribute__((ext_vector_type(8)))short;
using s16x4=__attribute__((ext_vector_type(4)))short;
using f32x16=__attribute__((ext_vector_type(16)))float;
using u32x4=__attribute__((ext_vector_type(4)))unsigned;
constexpr int D=64;
constexpr int NW=8,QBLK=32,QB=QBLK*NW,KVBLK=64;
__device__ __forceinline__ int crow(int r,int hi){return (r&3)+8*(r>>2)+4*hi;}
#define SBAR() __builtin_amdgcn_sched_barrier(0)
constexpr int NSLOT=3, SLOTB=8192, KSLOTB=12288;
#define KOFF(sl) ((sl)+((sl)>>1))
constexpr int LDS_K=0, LDS_V=NSLOT*KSLOTB, LDS_WS=LDS_V+NSLOT*SLOTB, LDS_OST=LDS_WS+NW*64*4, LDS_BYTES=LDS_OST+NW*4096;
constexpr float C2=0.125f*1.4426950408889634f;
__device__ __forceinline__ void glds16(const void*gsrc,unsigned lds_dst){unsigned keep;
  asm volatile("s_mov_b32 %0, m0\n\ts_mov_b32 m0, %2\n\ts_nop 0\n\tglobal_load_lds_dwordx4 %1, off\n\ts_mov_b32 m0, %0":"=&s"(keep):"v"(gsrc),"s"(lds_dst):"memory");}
__device__ __forceinline__ float max3f(float a,float b,float c){float r;asm("v_max3_f32 %0, %1, %2, %3":"=v"(r):"v"(a),"v"(b),"v"(c));return r;}
__device__ __forceinline__ float max2f(float a,float b){float r;asm("v_max_f32_e32 %0, %1, %2":"=v"(r):"v"(a),"v"(b));return r;}
__device__ __forceinline__ float fadd_s(float a,float b){float r;asm("v_add_f32_e32 %0, %1, %2":"=v"(r):"v"(a),"v"(b));return r;}
__device__ __forceinline__ float fsub_s(float a,float b){float r;asm("v_sub_f32_e32 %0, %1, %2":"=v"(r):"v"(a),"v"(b));return r;}
typedef float f32x2_t __attribute__((ext_vector_type(2))); typedef __bf16 bf16x2_t __attribute__((ext_vector_type(2)));
__device__ __forceinline__ unsigned cvtpk_s(float lo,float hi){f32x2_t v={lo,hi};bf16x2_t b=__builtin_convertvector(v,bf16x2_t);return __builtin_bit_cast(unsigned,b);}
#define WAIT_BAR(N) asm volatile("s_waitcnt vmcnt(" #N ") lgkmcnt(0)\n\ts_barrier":::"memory")

__device__ __forceinline__ void qkt(f32x16&p0,f32x16&p1,const char*Kslot,const bf16x8*qr,const f32x16&negm,int r32,int hi){
  const char*kb=Kslot+hi*1024+r32*16;
  #pragma unroll
  for(int d0=0;d0<6;++d0){
    const bf16x8 b0=*reinterpret_cast<const bf16x8*>(kb+d0*2048);
    const bf16x8 b1=*reinterpret_cast<const bf16x8*>(kb+d0*2048+512);
    if(d0==0){p0=__builtin_amdgcn_mfma_f32_32x32x16_bf16(b0,qr[0],negm,0,0,0);p1=__builtin_amdgcn_mfma_f32_32x32x16_bf16(b1,qr[0],negm,0,0,0);}
    else{p0=__builtin_amdgcn_mfma_f32_32x32x16_bf16(b0,qr[d0],p0,0,0,0);p1=__builtin_amdgcn_mfma_f32_32x32x16_bf16(b1,qr[d0],p1,0,0,0);}}
}
typedef __attribute__((address_space(3))) const char* lds_cptr;
typedef short v4i16_t __attribute__((ext_vector_type(4)));
__device__ __forceinline__ void kload8(bf16x8*kf,lds_cptr kp){
  kf[0]=*(const __attribute__((address_space(3))) bf16x8*)(kp);      kf[1]=*(const __attribute__((address_space(3))) bf16x8*)(kp+512);
  kf[2]=*(const __attribute__((address_space(3))) bf16x8*)(kp+2048); kf[3]=*(const __attribute__((address_space(3))) bf16x8*)(kp+2560);
  kf[4]=*(const __attribute__((address_space(3))) bf16x8*)(kp+4096); kf[5]=*(const __attribute__((address_space(3))) bf16x8*)(kp+4608);
  kf[6]=*(const __attribute__((address_space(3))) bf16x8*)(kp+6144); kf[7]=*(const __attribute__((address_space(3))) bf16x8*)(kp+6656);
  kf[8]=*(const __attribute__((address_space(3))) bf16x8*)(kp+8192); kf[9]=*(const __attribute__((address_space(3))) bf16x8*)(kp+8704);
  kf[10]=*(const __attribute__((address_space(3))) bf16x8*)(kp+10240); kf[11]=*(const __attribute__((address_space(3))) bf16x8*)(kp+10752);
}
__device__ __forceinline__ void kload2(bf16x8*kf,lds_cptr kp,int j){ kf[2*j]=*(const __attribute__((address_space(3))) bf16x8*)(kp+j*2048); kf[2*j+1]=*(const __attribute__((address_space(3))) bf16x8*)(kp+j*2048+512); }
__device__ __forceinline__ s16x4 vtr(lds_cptr p){ return __builtin_bit_cast(s16x4,__builtin_amdgcn_ds_read_tr16_b64_v4i16((__attribute__((address_space(3))) v4i16_t*)p)); }
__device__ __forceinline__ float rowmax(const f32x16&p0,const f32x16&p1){
  float a=max3f(p0[0],p0[1],p1[0]),b=max3f(p0[2],p0[3],p1[1]);a=max3f(a,p1[2],p1[3]);
  #pragma unroll
  for(int r=4;r<16;r+=4){a=max3f(a,p0[r],p0[r+1]);b=max3f(b,p0[r+2],p0[r+3]);a=max3f(a,p1[r],p1[r+1]);b=max3f(b,p1[r+2],p1[r+3]);}
  const float m=max2f(a,b);
  auto rr=__builtin_amdgcn_permlane32_swap(__float_as_uint(m),__float_as_uint(m),false,false);
  return max2f(__uint_as_float(rr[0]),__uint_as_float(rr[1]));
}
__device__ __forceinline__ void pv(f32x16*o,int vb,bf16x8 pa0,bf16x8 pa1,bf16x8 pa2,bf16x8 pa3){
  #pragma unroll
  for(int d0=0;d0<2;++d0){s16x4 lo[4],hi[4];
    #pragma unroll
    for(int ks=0;ks<4;++ks){
      asm volatile("ds_read_b64_tr_b16 %0,%1 offset:%c2":"=&v"(lo[ks]):"v"(vb),"i"(d0*4096+ks*1024):"memory");
      asm volatile("ds_read_b64_tr_b16 %0,%1 offset:%c2":"=&v"(hi[ks]):"v"(vb),"i"(d0*4096+ks*1024+512):"memory");}
    asm volatile("s_waitcnt lgkmcnt(0)":::"memory");SBAR();
    #define PK(k) (bf16x8){lo[k][0],lo[k][1],lo[k][2],lo[k][3],hi[k][0],hi[k][1],hi[k][2],hi[k][3]}
    o[d0]=__builtin_amdgcn_mfma_f32_32x32x16_bf16(pa0,PK(0),o[d0],0,0,0);
    o[d0]=__builtin_amdgcn_mfma_f32_32x32x16_bf16(pa1,PK(1),o[d0],0,0,0);
    o[d0]=__builtin_amdgcn_mfma_f32_32x32x16_bf16(pa2,PK(2),o[d0],0,0,0);
    o[d0]=__builtin_amdgcn_mfma_f32_32x32x16_bf16(pa3,PK(3),o[d0],0,0,0);
    #undef PK
  }
}

#ifndef ATTN_STORE16
#define ATTN_STORE16(p,v) (*(u32x4*)(p)=(v))
#endif
template<int THRL> __device__ __forceinline__ void attn_unit(const bf16*Q,int qp,int qrow0,int qc0,const bf16*__restrict__ K,int kp,int kc0,const bf16*__restrict__ V,int vp,int vc0,bf16*O,int oc0,int kctx0,int klat0,int NT,char*shm,int wave_id){
  wave_id=launder_s(wave_id); const int lane=lane_id_v(),r32=lane&31,hi=lane>>5; const int wid=wave_id;
  const bf16*Qw=Q+(long)(qrow0+wid*QBLK)*qp+qc0;
  const bf16*Kh=K+kc0,*Vh=V+vc0;
  const unsigned lds0=(unsigned)(uintptr_t)shm;
  float*wsf=(float*)(shm+LDS_WS)+wid*64;
  const bf16*ksrc=Kh+(long)lane*kp+wid*8;
  const bf16*vsrc=Vh+(long)(16*(wid&3)+(lane>>2))*vp+(wid>>2)*32+(lane&3)*8;
  #define TROW0(t) ((long)((t)<4?kctx0+64*(t):klat0+64*((t)-4)))
  const unsigned kdst=lds0+LDS_K+wid*1024, kdst2=lds0+LDS_K+8192+(wid&3)*1024, vdst=lds0+LDS_V+wid*1024;
  const int k2off=(8+(wid&3)-wid)*8;
  #define DMA_K(t,slot) do{ glds16(ksrc+TROW0(t)*kp,(unsigned)__builtin_amdgcn_readfirstlane(kdst+KOFF(slot))); glds16(ksrc+TROW0(t)*kp+k2off,(unsigned)__builtin_amdgcn_readfirstlane(kdst2+KOFF(slot))); }while(0)
  #define DMA_V(t,slot) glds16(vsrc+TROW0(t)*vp,(unsigned)__builtin_amdgcn_readfirstlane(vdst+(slot)))
  const int vb0=(int)(lds0+LDS_V)+((lane>>4)&1)*32+(lane&3)*8+(4*hi+((lane&15)>>2))*64;
  const char*Kbase=shm+LDS_K; bf16x8 kf[12];
  const lds_cptr shm3=(lds_cptr)shm; const lds_cptr kp0=shm3+LDS_K+hi*1024+r32*16; const lds_cptr vp0=shm3+LDS_V+((lane>>4)&1)*32+(lane&3)*8+(4*hi+((lane&15)>>2))*64;
  DMA_K(0,0);DMA_V(0,0);DMA_K(1,SLOTB);
  bf16x8 qr[6];
  #pragma unroll
  for(int d0=0;d0<6;++d0)qr[d0]=*reinterpret_cast<const bf16x8*>(&Qw[(long)r32*qp+d0*16+hi*8]);
  float mhat=0.f,l_reg=0.f;f32x16 o[2];o[0]=f32x16{};o[1]=f32x16{};f32x16 negm=f32x16{};asm volatile("":"+v"(negm));
  #define CMASK(P0,P1,t) do{}while(0)
  bool resc=false;
  #define START(P0,P1) do{ const float rm=rowmax(P0,P1); resc=false; \
    { const float dl=rm; mhat=fadd_s(mhat,dl); \
      _Pragma("unroll") for(int r=0;r<16;++r){P0[r]=fsub_s(P0[r],dl);P1[r]=fsub_s(P1[r],dl);} \
      _Pragma("unroll") for(int r=0;r<16;++r)negm[r]=-mhat; asm volatile("":"+v"(negm)); } \
    _Pragma("unroll") for(int r=0;r<16;++r)P0[r]=__builtin_amdgcn_exp2f(P0[r]); }while(0)
  #define RESC() do{ if(resc){ asm volatile("s_waitcnt lgkmcnt(0)":::"memory"); \
      _Pragma("unroll") for(int d_=0;d_<2;++d_) _Pragma("unroll") for(int r=0;r<16;++r)o[d_][r]*=wsf[crow(r,hi)]; } }while(0)
  f32x16 pA0,pA1,pB0,pB1;
  int sl_prev=0,sl_cur=0,sl_next=SLOTB;
  #define ROT() do{sl_prev=sl_cur;sl_cur=sl_next;sl_next=(sl_next==(NSLOT-1)*SLOTB)?0:sl_next+SLOTB;}while(0)
  DMA_K(2,2*SLOTB);
  WAIT_BAR(5);
  qkt(pA0,pA1,Kbase,qr,negm,r32,hi);asm volatile("s_nop 15\n\ts_nop 7":"+v"(pA0),"+v"(pA1));CMASK(pA0,pA1,0);
  START(pA0,pA1);
  _Pragma("unroll") for(int r=0;r<16;++r)pA1[r]=__builtin_amdgcn_exp2f(pA1[r]);
  WAIT_BAR(0);
  DMA_K(3,0);DMA_V(1,SLOTB);
  ROT();
  kload8(kf,kp0+KOFF(sl_cur));
  WAIT_BAR(3);
  s16x4 vlo[8],vhi[8]; u32x4 pw0,pw1,pw2,pw3;
  #define PKW(P,B) cvtpk_s(P[B],P[B+1])
  #define PAF(k) __builtin_bit_cast(bf16x8,pw##k)
  #define VFR(i) (bf16x8){vlo[i][0],vlo[i][1],vlo[i][2],vlo[i][3],vhi[i][0],vhi[i][1],vhi[i][2],vhi[i][3]}
  #define PIN(x) asm volatile("":"+v"(x))
  #define MX3(a,b,c) __builtin_fmaxf(__builtin_fmaxf((a),(b)),(c))
  #define GAPA(MF,A0,A1,A2,A3,W0,W1,PW) do{ MF; sacc+=A0; sacc+=A1; sacc+=A2; sacc+=A3; PIN(sacc); W0; W1; PIN(PW); SBAR(); }while(0)
  #define EX(v) __builtin_amdgcn_exp2f(v)
  #define GAPB(MF,X,B) do{ MF; X[B]=EX(X[B]); X[B+1]=EX(X[B+1]); X[B+2]=EX(X[B+2]); X[B+3]=EX(X[B+3]); PIN(X); SBAR(); }while(0)
  #define VRD(i) do{ vlo[i]=vtr(vp_+(((i)>>2)*4096+((i)&3)*1024)); vhi[i]=vtr(vp_+(((i)>>2)*4096+((i)&3)*1024+512)); }while(0)
  #define KRD(G,j) do{ if(G){ kload2(kf,kp0+KOFF(sl_next),j); SBAR(); } }while(0)
  #define STEP(C0,C1,P0,P1,t,GK,GV,GL) do{ SBAR(); \
    const lds_cptr vp_=vp0+sl_prev; \
    VRD(0); SBAR(); float sacc=(P0[0]+P0[1]); \
    GAPA(C0=__builtin_amdgcn_mfma_f32_32x32x16_bf16(kf[0],qr[0],negm,0,0,0), P0[2],P0[3],P0[4],P0[5],     pw0[0]=PKW(P0,0), pw0[1]=PKW(P0,2), pw0); \
    VRD(4); SBAR(); GAPA(C1=__builtin_amdgcn_mfma_f32_32x32x16_bf16(kf[1],qr[0],negm,0,0,0), P0[6],P0[7],P0[8],P0[9],     pw0[2]=PKW(P0,4), pw0[3]=PKW(P0,6), pw0); \
    VRD(1); SBAR(); GAPA(C0=__builtin_amdgcn_mfma_f32_32x32x16_bf16(kf[2],qr[1],C0,0,0,0),   P0[10],P0[11],P0[12],P0[13], pw1[0]=PKW(P0,8), pw1[1]=PKW(P0,10), pw1); \
    VRD(5); SBAR(); GAPA(C1=__builtin_amdgcn_mfma_f32_32x32x16_bf16(kf[3],qr[1],C1,0,0,0),   P0[14],P0[15],P1[0],P1[1],   pw1[2]=PKW(P0,12),pw1[3]=PKW(P0,14), pw1); \
    VRD(2); SBAR(); GAPA(C0=__builtin_amdgcn_mfma_f32_32x32x16_bf16(kf[4],qr[2],C0,0,0,0),   P1[2],P1[3],P1[4],P1[5],     pw2[0]=PKW(P1,0), pw2[1]=PKW(P1,2), pw2); \
    VRD(6); SBAR(); GAPA(C1=__builtin_amdgcn_mfma_f32_32x32x16_bf16(kf[5],qr[2],C1,0,0,0),   P1[6],P1[7],P1[8],P1[9],     pw2[2]=PKW(P1,4), pw2[3]=PKW(P1,6), pw2); \
    VRD(3); SBAR(); GAPA(C0=__builtin_amdgcn_mfma_f32_32x32x16_bf16(kf[6],qr[3],C0,0,0,0),   P1[10],P1[11],P1[12],P1[13], pw3[0]=PKW(P1,8), pw3[1]=PKW(P1,10), pw3); \
    VRD(7); SBAR(); GAPA(C1=__builtin_amdgcn_mfma_f32_32x32x16_bf16(kf[7],qr[3],C1,0,0,0),   P1[14],P1[15],0.f,0.f,       pw3[2]=PKW(P1,12),pw3[3]=PKW(P1,14), pw3); \
    C0=__builtin_amdgcn_mfma_f32_32x32x16_bf16(kf[8],qr[4],C0,0,0,0); C1=__builtin_amdgcn_mfma_f32_32x32x16_bf16(kf[9],qr[4],C1,0,0,0); C0=__builtin_amdgcn_mfma_f32_32x32x16_bf16(kf[10],qr[5],C0,0,0,0); C1=__builtin_amdgcn_mfma_f32_32x32x16_bf16(kf[11],qr[5],C1,0,0,0); SBAR(); \
    l_reg+=sacc; \
    if(GK){DMA_K((t)+3,sl_cur);} if(GV){DMA_V((t)+1,sl_next);} \
    CMASK(C0,C1,t); \
    { float a=MX3(C0[0],C0[1],C1[0]),b=MX3(C0[2],C0[3],C1[1]); a=MX3(a,C1[2],C1[3]); \
      _Pragma("unroll") for(int r=4;r<16;r+=4){a=MX3(a,C0[r],C0[r+1]);b=MX3(b,C0[r+2],C0[r+3]);a=MX3(a,C1[r],C1[r+1]);b=MX3(b,C1[r+2],C1[r+3]);} \
      float rm=__builtin_fmaxf(a,b); { auto rr=__builtin_amdgcn_permlane32_swap(__float_as_uint(rm),__float_as_uint(rm),false,false); rm=__builtin_fmaxf(__uint_as_float(rr[0]),__uint_as_float(rr[1])); } \
      resc=false; \
      if(__builtin_expect(__any(rm>(float)THRL),0)){ const float dl=__builtin_fmaxf(rm,0.f); mhat+=dl; \
        _Pragma("unroll") for(int r=0;r<16;++r){C0[r]-=dl;C1[r]-=dl;} \
        _Pragma("unroll") for(int r=0;r<16;++r)negm[r]=-mhat; asm volatile("":"+v"(negm)); \
        const float f=__builtin_amdgcn_exp2f(-dl); l_reg*=f; if(hi==0)wsf[r32]=f; resc=true; } } \
    SBAR(); \
    GAPB(o[0]=__builtin_amdgcn_mfma_f32_32x32x16_bf16(PAF(0),VFR(0),o[0],0,0,0), C0,0); \
    GAPB(o[1]=__builtin_amdgcn_mfma_f32_32x32x16_bf16(PAF(0),VFR(4),o[1],0,0,0), C0,4); \
    KRD(GL,0); GAPB(o[0]=__builtin_amdgcn_mfma_f32_32x32x16_bf16(PAF(1),VFR(1),o[0],0,0,0), C0,8); \
    KRD(GL,1); GAPB(o[1]=__builtin_amdgcn_mfma_f32_32x32x16_bf16(PAF(1),VFR(5),o[1],0,0,0), C0,12); \
    KRD(GL,2); GAPB(o[0]=__builtin_amdgcn_mfma_f32_32x32x16_bf16(PAF(2),VFR(2),o[0],0,0,0), C1,0); \
    KRD(GL,3); GAPB(o[1]=__builtin_amdgcn_mfma_f32_32x32x16_bf16(PAF(2),VFR(6),o[1],0,0,0), C1,4); \
    KRD(GL,4); GAPB(o[0]=__builtin_amdgcn_mfma_f32_32x32x16_bf16(PAF(3),VFR(3),o[0],0,0,0), C1,8); \
    KRD(GL,5); GAPB(o[1]=__builtin_amdgcn_mfma_f32_32x32x16_bf16(PAF(3),VFR(7),o[1],0,0,0), C1,12); \
    }while(0)
  int t=1;
  for(;t+5<NT;t+=2){
    STEP(pB0,pB1,pA0,pA1,t,true,true,true);     WAIT_BAR(3); RESC(); ROT();
    STEP(pA0,pA1,pB0,pB1,t+1,true,true,true);   WAIT_BAR(3); RESC(); ROT();
  }
  #define ENDW(tt) do{ if((tt)+3<NT){WAIT_BAR(3);} else if((tt)+2<NT){WAIT_BAR(1);} else {WAIT_BAR(0);} }while(0)
  for(;t+1<NT;t+=2){
    STEP(pB0,pB1,pA0,pA1,t,(t+3<NT),(t+1<NT),(t+1<NT));       ENDW(t);   RESC(); ROT();
    STEP(pA0,pA1,pB0,pB1,t+1,(t+4<NT),(t+2<NT),(t+2<NT));     ENDW(t+1); RESC(); ROT();
  }
  STEP(pB0,pB1,pA0,pA1,NT-1,false,false,false); RESC();
  { float sacc=pB0[0]+pB0[1]; _Pragma("unroll") for(int r=2;r<16;++r)sacc+=pB0[r]; _Pragma("unroll") for(int r=0;r<16;++r)sacc+=pB1[r]; l_reg+=sacc;
    pw0=(u32x4){PKW(pB0,0),PKW(pB0,2),PKW(pB0,4),PKW(pB0,6)};pw1=(u32x4){PKW(pB0,8),PKW(pB0,10),PKW(pB0,12),PKW(pB0,14)};pw2=(u32x4){PKW(pB1,0),PKW(pB1,2),PKW(pB1,4),PKW(pB1,6)};pw3=(u32x4){PKW(pB1,8),PKW(pB1,10),PKW(pB1,12),PKW(pB1,14)};
    SBAR(); pv(o,vb0+sl_cur,PAF(0),PAF(1),PAF(2),PAF(3)); }
  #undef PKW
  #undef PAF
  #undef VFR
  #undef PIN
  #undef MX3
  #undef GAPA
  #undef GAPB
  #undef EX
  #undef VRD
  #undef KRD
  #undef STEP
  #undef ENDW
  {auto rr=__builtin_amdgcn_permlane32_swap(__float_as_uint(l_reg),__float_as_uint(l_reg),false,false);l_reg=__uint_as_float(rr[0])+__uint_as_float(rr[1]);}
  if(hi==0)wsf[32+r32]=l_reg;asm volatile("s_waitcnt lgkmcnt(0)":::"memory");
  float rli[16];
  #pragma unroll
  for(int r=0;r<16;++r)rli[r]=__builtin_amdgcn_rcpf(wsf[32+crow(r,hi)]);
  bf16*Ow=O+(long)(qrow0+wid*QBLK)*1024+oc0;
  { bf16*stg=(bf16*)(shm+LDS_OST)+wid*2048;
    #pragma unroll
    for(int r=0;r<16;++r){const int orow=crow(r,hi);
      #pragma unroll
      for(int d0=0;d0<2;++d0)stg[orow*64+d0*32+r32]=(bf16)(cvtpk_s(o[d0][r]*rli[r],0.f)&0xffffu);}
    asm volatile("s_waitcnt lgkmcnt(0)":::"memory");
    #pragma unroll
    for(int i=0;i<4;++i){const int row=i*8+(lane>>3),ch=lane&7; const u32x4 v=*(const u32x4*)(stg+row*64+ch*8); ATTN_STORE16(Ow+(long)row*1024+ch*8,v);} }
  asm volatile("s_waitcnt lgkmcnt(0)\n\ts_barrier":::"memory");
  #undef DMA_K
  #undef DMA_V
  #undef TROW0
  #undef CMASK
  #undef START
  #undef RESC
  #undef ROT
}
#undef SBAR
#undef WAIT_BAR
#undef KOFF
}

struct Args { const float* in[27]; float* out; unsigned char* ws; int ph_lo, ph_hi; };
struct Frame {
    LAS unsigned char* lds; unsigned char* ws; gu32* ctl; int wave, G, gw, NGW;
};
__device__ __forceinline__ int lthread(int wave) { return wave * 64 + lane_id_v(); }

template <int MODE>
__device__ __forceinline__ void conv_item(const float* W, int K, int N, bf16* WT, LAS float* scr, int item, int lane) {
    const int nblk = (N + 63) / 64, kb = item / nblk, nb = item % nblk, k0 = 64 * kb, n0 = 64 * nb;
    f32x4 v[16];
    const int cc = (lane & 15) * 4, rk = lane >> 4;
    const bool ok = (n0 + cc) < N;
#pragma unroll
    for (int i = 0; i < 16; ++i) v[i] = ok ? *(const f32x4*)(W + (size_t)(k0 + 4 * i + rk) * N + n0 + cc) : (f32x4){0.f, 0.f, 0.f, 0.f};
#pragma unroll
    for (int i = 0; i < 16; ++i) { LAS float* s = scr + (4 * i + rk) * 65 + cc; s[0] = v[i][0]; s[1] = v[i][1]; s[2] = v[i][2]; s[3] = v[i][3]; }
    LDS_WAIT(); asm volatile("" ::: "memory");
    const int c = lane & 7;
#pragma unroll
    for (int j = 0; j < 8; ++j) { const int n = (lane >> 3) + 8 * j; const LAS float* s = scr + (8 * c) * 65 + n;
        v4u o; o.x = pk2(s[0], s[65]); o.y = pk2(s[2 * 65], s[3 * 65]); o.z = pk2(s[4 * 65], s[5 * 65]); o.w = pk2(s[6 * 65], s[7 * 65]);
        const int ng = n0 + n; if (ng < N) { const int dr = (MODE == 1) ? ((ng >> 8) * 256 + (ng & 1) * 128 + ((ng >> 1) & 127)) : ng; *(v4u*)(WT + (size_t)dr * K + k0 + 8 * c) = o; } }
    LDS_WAIT(); asm volatile("" ::: "memory");
}

__device__ __forceinline__ void prologue(Frame& F, const Args& a) {
    const int f_tid = lthread(F.wave), f_lane = f_tid & 63;
    unsigned char* ws = F.ws;
    {
        LAS float* scr = (LAS float*)(F.lds + F.wave * 16640);
        struct M { const float* src; int K, N; size_t dst; };
        const int I_FO = 16 * 16, I_MIN = 16 * 11, I_QB = 6 * 24, I_KVB = 4 * 32, I_MO = 256, I_GQKV = 16 * 24, I_GO = 256;
        const int NSMALL = 2 * I_FO + I_MIN + I_QB + I_KVB + I_MO + I_GQKV + I_GO;
        for (int it = F.gw; it < NSMALL; it += F.NGW) {
            int r = it;
            if (r < 2 * I_FO) { const int j = r / I_FO; conv_item<0>(a.in[10] + (size_t)j * D * D, D, D, (bf16*)(ws + WS_WFOUT) + (size_t)j * D * D, scr, r % I_FO, f_lane); continue; } r -= 2 * I_FO;
            if (r < I_MIN) { conv_item<0>(a.in[11], D, MLA_IN, (bf16*)(ws + WS_WMIN), scr, r, f_lane); continue; } r -= I_MIN;
            if (r < I_QB) { conv_item<0>(a.in[13], MLA_QL, 1536, (bf16*)(ws + WS_WMQB), scr, r, f_lane); continue; } r -= I_QB;
            if (r < I_KVB) { conv_item<0>(a.in[15], MLA_KVL, 2048, (bf16*)(ws + WS_WMKVB), scr, r, f_lane); continue; } r -= I_KVB;
            if (r < I_MO) { conv_item<0>(a.in[16], D, D, (bf16*)(ws + WS_WMO), scr, r, f_lane); continue; } r -= I_MO;
            if (r < I_GQKV) { conv_item<0>(a.in[17], D, GQA_QKV, (bf16*)(ws + WS_WGQKV), scr, r, f_lane); continue; } r -= I_GQKV;
            conv_item<0>(a.in[20], D, D, (bf16*)(ws + WS_WGO), scr, r, f_lane);
        }
    }
    __syncthreads();
    {
        LAS float* cmax = (LAS float*)F.lds;
        LAS float* cinv = cmax + 512;
        LAS unsigned* scr8 = (LAS unsigned*)(F.lds + 4096) + F.wave * (64 * 33);
        const int cc = (f_lane & 15) * 4, rk = f_lane >> 4;
        constexpr int NGU = DEPTH * NE * 32, NDN = DEPTH * NE * 16;
        for (int it = blockIdx.x; it < NGU + NDN; it += F.G) {
            const bool dn = it >= NGU; const int q_ = dn ? it - NGU : it; const int le = dn ? (q_ >> 4) : (q_ >> 5), strip = dn ? (q_ & 15) : (q_ & 31);
            const int N = dn ? 1024 : 2048;
            const float* W = (dn ? a.in[25] + (size_t)le * DFF * D : a.in[23] + (size_t)le * D * 2048) + strip * 64 + cc;
            f32x4 v[32];
#pragma unroll
            for (int i = 0; i < 32; ++i) v[i] = *(const f32x4*)(W + (size_t)(F.wave * 128 + 16 * (i >> 2) + 4 * rk + (i & 3)) * N);
            f32x4 mx = (f32x4){0.f, 0.f, 0.f, 0.f};
#pragma unroll
            for (int i = 0; i < 32; ++i) { mx[0] = fmaxf(mx[0], fabsf(v[i][0])); mx[1] = fmaxf(mx[1], fabsf(v[i][1])); mx[2] = fmaxf(mx[2], fabsf(v[i][2])); mx[3] = fmaxf(mx[3], fabsf(v[i][3])); }
#pragma unroll
            for (int q = 0; q < 4; ++q) { mx[q] = fmaxf(mx[q], shx(mx[q], 16, f_lane)); mx[q] = fmaxf(mx[q], shx(mx[q], 32, f_lane)); }
            __syncthreads();
            if (rk == 0) { LAS float* d = cmax + F.wave * 64 + cc; d[0] = mx[0]; d[1] = mx[1]; d[2] = mx[2]; d[3] = mx[3]; }
            __syncthreads();
            const float target = dn ? 240.f : 127.f;
            if (f_tid < 64) { float m8 = 0.f;
#pragma unroll
                for (int w = 0; w < 8; ++w) m8 = fmaxf(m8, cmax[w * 64 + f_tid]);
                const int ng = strip * 64 + f_tid, dr = dn ? ng : (ng >> 8) * 256 + (ng & 1) * 128 + ((ng >> 1) & 127);
                float* sc = dn ? (float*)(ws + WS_SWDN) + (size_t)le * 1024 : (float*)(ws + WS_SWGU) + (size_t)le * 2048;
                sc[dr] = (m8 > 0.f) ? m8 / target : 1.f;
                cinv[f_tid] = (m8 > 0.f) ? target / m8 : 0.f; }
            __syncthreads();
            const f32x4 iv = *(const LAS f32x4*)(cinv + cc);
#pragma unroll
            for (int ip = 0; ip < 8; ++ip) {
#pragma unroll
                for (int q = 0; q < 4; ++q) { unsigned w = 0;
                    if (dn) { int t = __builtin_amdgcn_cvt_pk_fp8_f32(v[4 * ip][q] * iv[q], v[4 * ip + 1][q] * iv[q], 0, false); t = __builtin_amdgcn_cvt_pk_fp8_f32(v[4 * ip + 2][q] * iv[q], v[4 * ip + 3][q] * iv[q], t, true); w = (unsigned)t; }
                    else {
#pragma unroll
                        for (int j = 0; j < 4; ++j) { int qi = __float2int_rn(v[4 * ip + j][q] * iv[q]); qi = qi > 127 ? 127 : (qi < -127 ? -127 : qi); w |= ((unsigned)qi & 255u) << (8 * j); } }
                    scr8[(cc + q) * 33 + 4 * ip + rk] = w; } }
            LDS_WAIT(); asm volatile("" ::: "memory");
            { const int c8 = f_lane & 7;
              unsigned char* dst = dn ? (unsigned char*)(ws + WS_WDN) + (size_t)le * 1024 * 1024 : (unsigned char*)(ws + WS_WGU) + (size_t)le * 2048 * 1024;
#pragma unroll
              for (int jp = 0; jp < 8; ++jp) { const int n = (f_lane >> 3) + 8 * jp; const LAS unsigned* sp = scr8 + n * 33 + 4 * c8;
                  v4u o; o.x = sp[0]; o.y = sp[1]; o.z = sp[2]; o[3] = sp[3];
                  const int ng = strip * 64 + n, dr = dn ? ng : (ng >> 8) * 256 + (ng & 1) * 128 + ((ng >> 1) & 127);
                  *(v4u*)(dst + (size_t)dr * 1024 + F.wave * 128 + 16 * c8) = o; } }
            LDS_WAIT(); asm volatile("" ::: "memory");
        }
        __syncthreads();
    }
    const int gtid = blockIdx.x * 512 + f_tid, gthreads = F.G * 512;
    for (int i = gtid; i < (MLA_IN_PAD - MLA_IN) * D / 8; i += gthreads) ((v4u*)((bf16*)(ws + WS_WMIN) + (size_t)MLA_IN * D))[i] = (v4u){0u, 0u, 0u, 0u};
    {
        bf16* MA = (bf16*)(ws + WS_MA);
        for (int i = gtid; i < 256 * 256; i += gthreads) { const int row = i >> 8, col = i & 255, jp = row >> 7, pp = (row >> 6) & 1, k1 = row & 63, j = col >> 7, pt = (col >> 6) & 1, l1 = col & 63;
            float v = 0.f; if (j == jp) { const float x = 2.f * (float)((k1 * l1) & 63) / 64.f; const float cs = cospif(x), sn = sinpif(x); v = (pp == 0) ? (pt == 0 ? cs : sn) : (pt == 0 ? -sn : cs); }
            MA[i] = (bf16)(pk2(v, 0.f) & 0xffffu); }
        bf16* DC = (bf16*)(ws + WS_DC); const float sc = 1.0f / sqrtf(256.f * 128.f);
        for (int i = gtid; i < 256 * 512; i += gthreads) { const int k = i >> 9, col = i & 511, pt = col >> 8, l = col & 255; const float x = 2.f * (float)((k * l) & 255) / 256.f;
            const float v = (pt == 0 ? cospif(x) : sinpif(x)) * sc; DC[i] = (bf16)(pk2(v, 0.f) & 0xffffu); }
        bf16* MC = (bf16*)(ws + WS_MC); const float sl = 1.0f / sqrtf(4096.f * 128.f);
        for (int i = gtid; i < 16 * 256 * 512; i += gthreads) { const int kq = i >> 17, row = (i >> 9) & 255, col = i & 511, kkp = row >> 6, k2 = row & 63, kk = col >> 7, pp = (col >> 6) & 1, l2 = col & 63;
            float v = 0.f; if (kk == kkp) { const int k = 4 * kq + kkp + 64 * k2; const float x = 2.f * (float)((l2 * k) & 4095) / 4096.f; v = (pp == 0 ? cospif(x) : sinpif(x)) * sl; }
            MC[i] = (bf16)(pk2(v, 0.f) & 0xffffu); }
        float* RM = (float*)(ws + WS_ROPE); float* RG = RM + 2048;
        for (int i = gtid; i < 64 * 8; i += gthreads) { const int pos = i >> 3, f = i & 7; const float inv = powf(10000.f, -(float)f / 8.f); float s, c; sincosf((float)pos * inv, &s, &c); RM[2 * i] = c; RM[2 * i + 1] = s; }
        for (int i = gtid; i < 64 * 16; i += gthreads) { const int pos = i >> 4, f = i & 15; const float inv = powf(10000.f, -(float)f / 16.f); float s, c; sincosf((float)pos * inv, &s, &c); RG[2 * i] = c; RG[2 * i + 1] = s; }
        float* WRT = (float*)(ws + WS_WRT);
        for (int i = gtid; i < DEPTH * NE * D; i += gthreads) { const int l = i >> 15, e = (i >> 10) & 31, k = i & 1023; WRT[i] = a.in[21][((size_t)l * D + k) * NE + e]; }
        float* BG = (float*)(ws + WS_BGU);
        for (int i = gtid; i < DEPTH * NE * 2048; i += gthreads) { const int le = i >> 11, q = i & 2047, pn = q >> 8, s = (q >> 7) & 1, jj = q & 127; BG[i] = a.in[24][(size_t)le * 2048 + 2 * (pn * 128 + jj) + s]; }
    }
    __syncthreads();
    {
        LAS float* wl = (LAS float*)F.lds;
        LAS float* tc = wl + 2048; LAS float* ts = tc + 128;
        if (f_tid < 128) { const float x = 2.f * (float)f_tid / 128.f; tc[f_tid] = cospif(x); ts[f_tid] = -sinpif(x); }
        for (int it = blockIdx.x; it < 2 * 8 * 64; it += F.G) { const int j = it >> 9, g = (it >> 6) & 7, kb = it & 63;
            __syncthreads();
            { const int kk = f_tid >> 5, c4 = (f_tid & 31) * 4; const f32x4 w = *(const f32x4*)(a.in[9] + ((size_t)j * D + kb * 16 + kk) * D + g * 128 + c4);
              LAS float* d = wl + c4 * 16 + kk; d[0] = w[0]; d[16] = w[1]; d[32] = w[2]; d[48] = w[3]; }
            __syncthreads();
            const int cl = f_tid & 255, m = cl >> 1, part = cl & 1, kh = f_tid >> 8; const LAS float* tw = part ? ts : tc;
            float accv[8];
#pragma unroll
            for (int q = 0; q < 8; ++q) accv[q] = 0.f;
            for (int jj = 0; jj < 128; ++jj) { const float t = tw[(m * jj) & 127]; const f32x4 wa = *(const LAS f32x4*)(wl + jj * 16 + kh * 8), wb = *(const LAS f32x4*)(wl + jj * 16 + kh * 8 + 4);
                accv[0] += wa[0] * t; accv[1] += wa[1] * t; accv[2] += wa[2] * t; accv[3] += wa[3] * t; accv[4] += wb[0] * t; accv[5] += wb[1] * t; accv[6] += wb[2] * t; accv[7] += wb[3] * t; }
            v4u o; o.x = pk2(accv[0], accv[1]); o.y = pk2(accv[2], accv[3]); o.z = pk2(accv[4], accv[5]); o.w = pk2(accv[6], accv[7]);
            *(v4u*)((bf16*)(ws + WS_WFIN) + ((size_t)j * 2048 + g * 256 + cl) * D + kb * 16 + kh * 8) = o;
        }
        __syncthreads();
    }
    {
        LAS float* S = (LAS float*)F.lds;
        LAS float* red = S + 9 * 1024;
        for (int i = f_tid; i < 9 * 1024; i += 512) { const int r = i >> 10, k = i & 1023; const float v = (r < 8) ? a.in[1][r * D + k] : a.in[3][k]; S[i] = v / (1.f + __expf(-v)); }
        __syncthreads();
        for (int it = blockIdx.x; it < DEPTH * 96; it += F.G) { const int l = it / 96, n0 = (it % 96) * 64;
            const float* wp = a.in[4] + ((size_t)l * D + F.wave * 128) * (NMOD * D) + n0 + f_lane;
            float accv[9];
#pragma unroll
            for (int r = 0; r < 9; ++r) accv[r] = 0.f;
            for (int k0 = 0; k0 < 128; k0 += 32) { float wv[32];
#pragma unroll
                for (int k = 0; k < 32; ++k) wv[k] = wp[(size_t)(k0 + k) * (NMOD * D)];
#pragma unroll
                for (int k = 0; k < 32; ++k)
#pragma unroll
                    for (int r = 0; r < 9; ++r) accv[r] += S[r * 1024 + F.wave * 128 + k0 + k] * wv[k]; }
#pragma unroll
            for (int r = 0; r < 9; ++r) red[(F.wave * 9 + r) * 64 + f_lane] = accv[r];
            __syncthreads();
            for (int i = f_tid; i < 9 * 64; i += 512) { const int r = i >> 6, ln = i & 63; float s = a.in[5][(size_t)l * (NMOD * D) + n0 + ln];
#pragma unroll
                for (int w = 0; w < 8; ++w) s += red[(w * 9 + r) * 64 + ln];
                ((float*)(ws + WS_MOD))[((size_t)l * 9 + r) * (NMOD * D) + n0 + ln] = s; }
            __syncthreads();
        }
    }
}

__device__ __forceinline__ void load_row(const float* p, int lane, f32x4 (&v)[4]) {
#pragma unroll
    for (int j = 0; j < 4; ++j) v[j] = ((const f32x4*)p)[lane + 64 * j];
}
__device__ __forceinline__ void load_row_bf(const bf16* p, int lane, f32x4 (&v)[4]) {
#pragma unroll
    for (int j = 0; j < 4; ++j) { const v2u w = ((const v2u*)p)[lane + 64 * j]; v[j] = (f32x4){bf_lo(w.x), bf_hi(w.x), bf_lo(w.y), bf_hi(w.y)}; }
}
__device__ __forceinline__ void norm_mod(f32x4 (&v)[4], const float* g, const float* shift, const float* scale, int lane) {
    float s = 0.f;
#pragma unroll
    for (int j = 0; j < 4; ++j) s += (v[j][0] * v[j][0] + v[j][1] * v[j][1]) + (v[j][2] * v[j][2] + v[j][3] * v[j][3]);
    const float rstd = rsqrtf(wave_sum(s, lane) * (1.f / D) + EPS);
#pragma unroll
    for (int j = 0; j < 4; ++j) { const f32x4 gv = ((const f32x4*)g)[lane + 64 * j], sh = ((const f32x4*)shift)[lane + 64 * j], sc = ((const f32x4*)scale)[lane + 64 * j];
        v[j] = (v[j] * rstd * gv) * (sc + 1.f) + sh; }
}
__device__ __forceinline__ void store_row_bf16(bf16* p, int lane, const f32x4 (&v)[4]) {
#pragma unroll
    for (int j = 0; j < 4; ++j) { v2u w; w.x = pk2(v[j][0], v[j][1]); w.y = pk2(v[j][2], v[j][3]); ((v2u*)p)[lane + 64 * j] = w; }
}

__device__ __forceinline__ float store_row_i8(unsigned char* p, int lane, const f32x4 (&v)[4]) {
    float am = 0.f;
#pragma unroll
    for (int j = 0; j < 4; ++j) am = fmaxf(fmaxf(am, fmaxf(fabsf(v[j][0]), fabsf(v[j][1]))), fmaxf(fabsf(v[j][2]), fabsf(v[j][3])));
    unsigned k = __float_as_uint(am);
    { unsigned t;
      t = (unsigned)__builtin_amdgcn_mov_dpp((int)k, 0xb1, 0xf, 0xf, false); k = k > t ? k : t;
      t = (unsigned)__builtin_amdgcn_mov_dpp((int)k, 0x4e, 0xf, 0xf, false); k = k > t ? k : t;
      t = (unsigned)__builtin_amdgcn_mov_dpp((int)k, 0x124, 0xf, 0xf, false); k = k > t ? k : t;
      t = (unsigned)__builtin_amdgcn_mov_dpp((int)k, 0x128, 0xf, 0xf, false); k = k > t ? k : t;
      const unsigned a = (unsigned)__builtin_amdgcn_readlane((int)k, 0), b = (unsigned)__builtin_amdgcn_readlane((int)k, 16), c = (unsigned)__builtin_amdgcn_readlane((int)k, 32), d = (unsigned)__builtin_amdgcn_readlane((int)k, 48);
      const unsigned ab = a > b ? a : b, cd = c > d ? c : d; k = ab > cd ? ab : cd; }
    const float amax = __uint_as_float(k);
    const float qscale = amax > 0.f ? amax * (1.f / 127.f) : 1.f, qinv = amax > 0.f ? 127.f / amax : 0.f;
#pragma unroll
    for (int j = 0; j < 4; ++j) { unsigned w = 0;
#pragma unroll
        for (int q = 0; q < 4; ++q) { int qi = __float2int_rn(v[j][q] * qinv); qi = qi > 127 ? 127 : (qi < -127 ? -127 : qi); w |= ((unsigned)qi & 255u) << (8 * q); }
        ((unsigned*)p)[lane + 64 * j] = w; }
    return qscale;
}
__device__ __forceinline__ void quant_rows(Frame& F, const bf16* src, unsigned char* dst, float* scale, int R) {
    const int f_lane = lthread(F.wave) & 63;
    for (int r = F.gw; r < R; r += F.NGW) { f32x4 v[4]; load_row_bf(src + (size_t)r * 1024, f_lane, v);
        const float sc = store_row_i8(dst + (size_t)r * 1024, f_lane, v); if (f_lane == 0) scale[r] = sc; }
}
__device__ __forceinline__ void rp_norm1(Frame& F, const Args& a, int l, int row_lo) {
    const int f_tid = lthread(F.wave), f_lane = f_tid & 63;
    const bf16* X = (const bf16*)(F.ws + WS_X); bf16* H = (bf16*)(F.ws + WS_H); const float* MOD = (const float*)(F.ws + WS_MOD) + (size_t)l * 9 * (NMOD * D);
    for (int row = row_lo + F.gw; row < NT; row += F.NGW) { f32x4 v[4];
        if (l == 0) load_row(row < NC ? a.in[2] + (size_t)row * D : a.in[0] + (size_t)(row - NC) * D, f_lane, v);
        else load_row_bf(X + (size_t)row * D, f_lane, v);
        const float* m = MOD + (size_t)modrow_of(row) * (NMOD * D);
        norm_mod(v, a.in[6] + (size_t)l * D, m, m + D, f_lane);
        const float sc = store_row_i8((unsigned char*)H + (size_t)row * D, f_lane, v); if (f_lane == 0) ((float*)(F.ws + WS_SH))[row] = sc; }
}

#if MK_N2V2
constexpr int LDS_LIST = LDS_MISC + 768;
__device__ __forceinline__ unsigned row16_max(unsigned k) {
    unsigned t;
    t = (unsigned)__builtin_amdgcn_mov_dpp((int)k, 0xb1, 0xf, 0xf, false); k = k > t ? k : t;
    t = (unsigned)__builtin_amdgcn_mov_dpp((int)k, 0x4e, 0xf, 0xf, false); k = k > t ? k : t;
    t = (unsigned)__builtin_amdgcn_mov_dpp((int)k, 0x124, 0xf, 0xf, false); k = k > t ? k : t;
    t = (unsigned)__builtin_amdgcn_mov_dpp((int)k, 0x128, 0xf, 0xf, false); k = k > t ? k : t;
    return k;
}
__device__ __forceinline__ unsigned wave_max_u(unsigned k) {
    k = row16_max(k);
    const unsigned a = (unsigned)__builtin_amdgcn_readlane((int)k, 0), b = (unsigned)__builtin_amdgcn_readlane((int)k, 16), c = (unsigned)__builtin_amdgcn_readlane((int)k, 32), d = (unsigned)__builtin_amdgcn_readlane((int)k, 48);
    const unsigned ab = a > b ? a : b, cd = c > d ? c : d; return ab > cd ? ab : cd;
}
__device__ __forceinline__ float key_val(unsigned m) { const unsigned u = m & ~31u; return __builtin_bit_cast(float, (u & 0x80000000u) ? (u ^ 0x80000000u) : ~u); }
constexpr int N2_WPITCH = 2064;
constexpr int N2_GM = 32 * N2_WPITCH;
constexpr int N2_LIST = N2_GM + 5 * 8192;
__device__ __forceinline__ void rp_norm2_router(Frame& F, const Args& a, int l, int row_lo) {
    const int f_tid = lthread(F.wave), f_lane = f_tid & 63;
    const bf16* X = (const bf16*)(F.ws + WS_X); unsigned char* H8 = (unsigned char*)(F.ws + WS_H); const float* MOD = (const float*)(F.ws + WS_MOD) + (size_t)l * 9 * (NMOD * D);
    LAS unsigned char* WT = F.lds;
    { const f32x4* src = (const f32x4*)((const float*)(F.ws + WS_WRT) + (size_t)l * NE * D); f32x4 tv[16];
#pragma unroll
      for (int i = 0; i < 16; ++i) tv[i] = src[f_tid + 512 * i];
#pragma unroll
      for (int i = 0; i < 16; ++i) { const int i4 = f_tid + 512 * i, e = i4 >> 8, k4 = (i4 & 255) * 4; v2u w; w.x = pk2(tv[i][0], tv[i][1]); w.y = pk2(tv[i][2], tv[i][3]); *(LAS v2u*)(WT + e * N2_WPITCH + k4 * 2) = w; } }
    LAS int* lcnt = (LAS int*)(F.lds + LDS_TT); LAS int* lbase = lcnt + 32;
    if (f_tid < 32) lcnt[f_tid] = 0;
    const int ngroups = (NT - row_lo) >> 5;
    const int g = F.wave * F.G + (int)blockIdx.x;
    const bool active = (F.wave < 5) && (g < ngroups);
    LAS float* GM = (LAS float*)(F.lds + N2_GM + (F.wave < 5 ? F.wave : 0) * 8192); LAS float* SH = GM + 1024;
    LAS v4u* list = (LAS v4u*)(F.lds + N2_LIST + (F.wave < 5 ? F.wave : 0) * (128 * 16 + 128)); LAS float* lsc = (LAS float*)(list + 128);
    const int r = f_lane & 31, kh = f_lane >> 5;
    const int row = row_lo + g * 32 + r;
    float msh = 0.f;
    if (active) {
        const float* m = MOD + (size_t)modrow_of(row_lo + g * 32) * (NMOD * D); const float* gf = a.in[7] + (size_t)l * D;
#pragma unroll
        for (int j = 0; j < 4; ++j) { const f32x4 gv = ((const f32x4*)gf)[f_lane + 64 * j], sc = ((const f32x4*)(m + 4 * D))[f_lane + 64 * j], sv = ((const f32x4*)(m + 3 * D))[f_lane + 64 * j];
            ((LAS f32x4*)GM)[f_lane + 64 * j] = gv * (sc + 1.f); ((LAS f32x4*)SH)[f_lane + 64 * j] = sv;
            msh = fmaxf(fmaxf(msh, fmaxf(fabsf(sv[0]), fabsf(sv[1]))), fmaxf(fabsf(sv[2]), fabsf(sv[3]))); }
        msh = __uint_as_float(wave_max_u(__float_as_uint(msh)));
    }
    __syncthreads();
    if (active) {
        const bf16* xr = X + (size_t)row * D + 16 * kh;
        float ssq = 0.f, mxg = 0.f;
#pragma unroll 1
        for (int c0 = 0; c0 < 32; c0 += 8) { v4u xa[8], xb[8];
#pragma unroll
            for (int i = 0; i < 8; ++i) { xa[i] = *(const v4u*)(xr + 32 * (c0 + i)); xb[i] = *(const v4u*)(xr + 32 * (c0 + i) + 8); }
#pragma unroll
            for (int i = 0; i < 8; ++i) { const LAS f32x4* gp = (const LAS f32x4*)(GM + 32 * (c0 + i) + 16 * kh);
                const f32x4 g0 = gp[0], g1 = gp[1], g2 = gp[2], g3 = gp[3];
                const unsigned wa[4] = {xa[i].x, xa[i].y, xa[i].z, xa[i][3]}, wb[4] = {xb[i].x, xb[i].y, xb[i].z, xb[i][3]};
#pragma unroll
                for (int q = 0; q < 4; ++q) { const float x0 = bf_lo(wa[q]), x1 = bf_hi(wa[q]), x2 = bf_lo(wb[q]), x3 = bf_hi(wb[q]);
                    ssq += x0 * x0 + x1 * x1 + x2 * x2 + x3 * x3;
                    const float ga = (q < 2 ? g0 : g1)[(2 * q) & 3], gb = (q < 2 ? g0 : g1)[(2 * q + 1) & 3], gc = (q < 2 ? g2 : g3)[(2 * q) & 3], gd = (q < 2 ? g2 : g3)[(2 * q + 1) & 3];
                    mxg = fmaxf(fmaxf(mxg, fmaxf(fabsf(x0 * ga), fabsf(x1 * gb))), fmaxf(fabsf(x2 * gc), fabsf(x3 * gd))); } } }
        { auto rr = __builtin_amdgcn_permlane32_swap(__float_as_uint(ssq), __float_as_uint(ssq), false, false); ssq = __uint_as_float(rr[0]) + __uint_as_float(rr[1]); }
        { auto rr = __builtin_amdgcn_permlane32_swap(__float_as_uint(mxg), __float_as_uint(mxg), false, false); mxg = fmaxf(__uint_as_float(rr[0]), __uint_as_float(rr[1])); }
        const float rstd = rsqrtf(ssq * (1.f / D) + EPS);
        const float bound = mxg * rstd + msh;
        const float qscale = bound > 0.f ? bound * (1.f / 127.f) : 1.f, qinv = bound > 0.f ? 127.f / bound : 0.f;
        f32x16 acc = f32x16{};
        unsigned char* hrow = H8 + (size_t)row * D + 16 * kh;
        const LAS unsigned char* wrow = WT + r * N2_WPITCH + 32 * kh;
#pragma unroll 1
        for (int c0 = 0; c0 < 32; c0 += 4) { v4u xa[4], xb[4];
#pragma unroll
            for (int i = 0; i < 4; ++i) { xa[i] = *(const v4u*)(xr + 32 * (c0 + i)); xb[i] = *(const v4u*)(xr + 32 * (c0 + i) + 8); }
#pragma unroll
            for (int i = 0; i < 4; ++i) { const int c = c0 + i;
                const LAS f32x4* gp = (const LAS f32x4*)(GM + 32 * c + 16 * kh); const LAS f32x4* sp = (const LAS f32x4*)(SH + 32 * c + 16 * kh);
                const bf16x8 w0 = *(const LAS bf16x8*)(wrow + 64 * c), w1 = *(const LAS bf16x8*)(wrow + 64 * c + 16);
                float h[16];
                const unsigned wa[4] = {xa[i].x, xa[i].y, xa[i].z, xa[i][3]}, wb[4] = {xb[i].x, xb[i].y, xb[i].z, xb[i][3]};
#pragma unroll
                for (int q = 0; q < 4; ++q) { h[2 * q] = bf_lo(wa[q]); h[2 * q + 1] = bf_hi(wa[q]); h[8 + 2 * q] = bf_lo(wb[q]); h[8 + 2 * q + 1] = bf_hi(wb[q]); }
#pragma unroll
                for (int q = 0; q < 4; ++q) { const f32x4 gq = gp[q], sq = sp[q];
#pragma unroll
                    for (int e = 0; e < 4; ++e) h[4 * q + e] = (h[4 * q + e] * rstd) * gq[e] + sq[e]; }
                v4u o8;
#pragma unroll
                for (int q = 0; q < 4; ++q) { unsigned w = 0;
#pragma unroll
                    for (int e = 0; e < 4; ++e) w |= ((unsigned)__float2int_rn(h[4 * q + e] * qinv) & 255u) << (8 * e);
                    o8[q] = w; }
                *(v4u*)(hrow + 32 * c) = o8;
                v4u hi0, hi1, lo0, lo1;
#pragma unroll
                for (int q = 0; q < 4; ++q) { hi0[q] = pk2(h[2 * q], h[2 * q + 1]); hi1[q] = pk2(h[8 + 2 * q], h[8 + 2 * q + 1]); }
#pragma unroll
                for (int q = 0; q < 4; ++q) { lo0[q] = pk2(h[2 * q] - bf_lo(hi0[q]), h[2 * q + 1] - bf_hi(hi0[q])); lo1[q] = pk2(h[8 + 2 * q] - bf_lo(hi1[q]), h[8 + 2 * q + 1] - bf_hi(hi1[q])); }
                acc = __builtin_amdgcn_mfma_f32_32x32x16_bf16(w0, __builtin_bit_cast(bf16x8, hi0), acc, 0, 0, 0);
                acc = __builtin_amdgcn_mfma_f32_32x32x16_bf16(w0, __builtin_bit_cast(bf16x8, lo0), acc, 0, 0, 0);
                acc = __builtin_amdgcn_mfma_f32_32x32x16_bf16(w1, __builtin_bit_cast(bf16x8, hi1), acc, 0, 0, 0);
                acc = __builtin_amdgcn_mfma_f32_32x32x16_bf16(w1, __builtin_bit_cast(bf16x8, lo1), acc, 0, 0, 0); } }
        float val[32];
        const float* br = a.in[22] + (size_t)l * NE;
#pragma unroll
        for (int j = 0; j < 16; ++j) { auto rr = __builtin_amdgcn_permlane32_swap(__float_as_uint(acc[j]), __float_as_uint(acc[j]), false, false);
            const int e0 = (j & 3) + 8 * (j >> 2); val[e0] = __uint_as_float(rr[0]) + br[e0]; val[e0 + 4] = __uint_as_float(rr[1]) + br[e0 + 4]; }
        unsigned taken = 0u; int be[4]; float bv[4];
#pragma unroll
        for (int k = 0; k < 4; ++k) { float best = -INFINITY; int bi = 0;
#pragma unroll
            for (int e = 0; e < 32; ++e) { const bool cnd = !((taken >> e) & 1u) && (val[e] > best); best = cnd ? val[e] : best; bi = cnd ? e : bi; }
            taken |= 1u << bi; be[k] = bi; bv[k] = best; }
        const float e1 = __expf(bv[1] - bv[0]), e2 = __expf(bv[2] - bv[0]), e3 = __expf(bv[3] - bv[0]); const float inv = 1.f / (1.f + e1 + e2 + e3);
        if (kh == 0) { const float ww[4] = {inv, e1 * inv, e2 * inv, e3 * inv};
#pragma unroll
            for (int k = 0; k < 4; ++k) { const int lr = __hip_atomic_fetch_add(lcnt + be[k], 1, __ATOMIC_RELAXED, __HIP_MEMORY_SCOPE_WORKGROUP);
                LAS unsigned* ep = (LAS unsigned*)(list + r * 4 + k); ep[0] = (unsigned)(row * 4 + k); ep[1] = (unsigned)be[k]; ep[2] = (unsigned)lr; ep[3] = __builtin_bit_cast(unsigned, ww[k]); }
            lsc[r] = qscale; }
    }
    __syncthreads();
    if (f_tid < 32) { const int c = lcnt[f_tid]; lbase[f_tid] = c ? (int)__hip_atomic_fetch_add((unsigned*)(F.ctl + CW_CNT + (l * 32 + f_tid) * 16), (unsigned)c, RLX_AGENT) : 0; }
    __syncthreads();
    if (active) {
        int* te = (int*)(F.ws + WS_TE); int* trank = (int*)(F.ws + WS_TRANK); int* stok = (int*)(F.ws + WS_STOK); float* sw = (float*)(F.ws + WS_SW); float* ssc = (float*)(F.ws + WS_SSC);
#pragma unroll
        for (int i = f_lane; i < 128; i += 64) { const LAS unsigned* ep = (const LAS unsigned*)(list + i); const unsigned rowk = ep[0], ex = ep[1], lr = ep[2]; const float wv = __builtin_bit_cast(float, ep[3]);
            const int rk = lbase[ex] + (int)lr;
            stok[(size_t)ex * CAP + rk] = (int)(rowk >> 2); sw[(size_t)ex * CAP + rk] = wv; ssc[(size_t)ex * CAP + rk] = lsc[i >> 2]; te[rowk] = (int)ex; trank[rowk] = rk; }
    }
}

#endif
__device__ __forceinline__ void moe_table(Frame& F, int l) {
    const int f_tid = lthread(F.wave), f_lane = f_tid & 63;
    LAS int* TT = (LAS int*)(F.lds + LDS_TT); LAS int* CN = TT + 64; LAS int* TE = (LAS int*)(F.lds + LDS_TE);
    __syncthreads();
    if (f_tid < 64) {
        const int c = (f_lane < 32) ? (int)__hip_atomic_load((unsigned*)(F.ctl + CW_CNT + (l * 32 + (f_lane & 31)) * 16), RLX_AGENT) : 0;
        const int tl = (c + 255) >> 8; int v = tl;
#pragma unroll
        for (int o = 1; o < 32; o <<= 1) { const int n = __builtin_amdgcn_ds_bpermute((f_lane >= o ? f_lane - o : f_lane) << 2, v); if (f_lane >= o) v += n; }
        if (f_lane < 32) { CN[f_lane] = c; TT[f_lane] = v - tl; if (f_lane == 31) TT[32] = v; }
    }
    __syncthreads();
    for (int t = f_tid; t < MAXTILES; t += 512) { int lo = 0, hi = 32;
#pragma unroll
        for (int k = 0; k < 5; ++k) { const int mid = (lo + hi) >> 1; if (TT[mid] <= t) lo = mid; else hi = mid; }
        TE[t] = lo; }
    __syncthreads();
}

#if MK_CBV2
struct CombRow { v4u x[2]; v4u y[4]; };
__device__ __forceinline__ void comb_issue(CombRow& R, const bf16* X, const unsigned char* Y, const LAS int* TT, int row, const v4u te4, const v4u tr4, int lane) {
    const unsigned ee[4] = {te4[0], te4[1], te4[2], te4[3]}, rr[4] = {tr4[0], tr4[1], tr4[2], tr4[3]};
#pragma unroll
    for (int k = 0; k < 4; ++k) { const size_t slot = (size_t)TT[ee[k]] * 256 + rr[k]; R.y[k] = *(const v4u*)(Y + slot * 1024 + 16 * lane); }
    const bf16* xp = X + (size_t)row * D + 16 * lane; R.x[0] = *(const v4u*)xp; R.x[1] = *(const v4u*)(xp + 8);
}
__device__ __forceinline__ void comb_finish(const CombRow& R, Frame& F, const Args& a, int l, int row, int lane, const float* MOD, const float* MODN, bool lastl) {
    bf16* X = (bf16*)(F.ws + WS_X); unsigned char* H8 = (unsigned char*)(F.ws + WS_H);
    const int mr = modrow_of(row); const float* g5 = MOD + (size_t)mr * (NMOD * D) + 5 * D + 16 * lane;
    float v[16];
#pragma unroll
    for (int w = 0; w < 4; ++w) { f32x4 s = (f32x4){0.f, 0.f, 0.f, 0.f};
#pragma unroll
        for (int k = 0; k < 4; ++k) { const int yw = (int)R.y[k][w]; const f32x2 lo = __builtin_amdgcn_cvt_pk_f32_fp8(yw, false), hi = __builtin_amdgcn_cvt_pk_f32_fp8(yw, true); s[0] += lo[0]; s[1] += lo[1]; s[2] += hi[0]; s[3] += hi[1]; }
        const f32x4 gv = ((const f32x4*)g5)[w]; const unsigned x0 = R.x[w >> 1][(2 * w) & 3], x1 = R.x[w >> 1][(2 * w + 1) & 3];
        v[4 * w] = bf_lo(x0) + gv[0] * s[0] * 0.125f; v[4 * w + 1] = bf_hi(x0) + gv[1] * s[1] * 0.125f; v[4 * w + 2] = bf_lo(x1) + gv[2] * s[2] * 0.125f; v[4 * w + 3] = bf_hi(x1) + gv[3] * s[3] * 0.125f; }
    float ss = 0.f;
#pragma unroll
    for (int i = 0; i < 16; ++i) ss += v[i] * v[i];
    const float rstd = rsqrtf(wave_sum(ss, lane) * (1.f / D) + EPS);
    if (!lastl) {
        bf16* xo = X + (size_t)row * D + 16 * lane;
        { v4u o0, o1;
#pragma unroll
          for (int q = 0; q < 4; ++q) { o0[q] = pk2(v[2 * q], v[2 * q + 1]); o1[q] = pk2(v[8 + 2 * q], v[8 + 2 * q + 1]); }
          *(v4u*)xo = o0; *(v4u*)(xo + 8) = o1; }
        const float* m = MODN + (size_t)mr * (NMOD * D) + 16 * lane; const float* gx = a.in[6] + (size_t)(l + 1) * D + 16 * lane;
        float am = 0.f;
#pragma unroll
        for (int w = 0; w < 4; ++w) { const f32x4 gv = ((const f32x4*)gx)[w], sh = ((const f32x4*)m)[w], sc = ((const f32x4*)(m + D))[w];
#pragma unroll
            for (int e = 0; e < 4; ++e) { const float h = (v[4 * w + e] * rstd * gv[e]) * (sc[e] + 1.f) + sh[e]; v[4 * w + e] = h; am = fmaxf(am, fabsf(h)); } }
        const float amax = __uint_as_float(wave_max_u(__float_as_uint(am)));
        const float qscale = amax > 0.f ? amax * (1.f / 127.f) : 1.f, qinv = amax > 0.f ? 127.f / amax : 0.f;
        v4u o8;
#pragma unroll
        for (int w = 0; w < 4; ++w) { unsigned u = 0;
#pragma unroll
            for (int e = 0; e < 4; ++e) { int qi = __float2int_rn(v[4 * w + e] * qinv); qi = qi > 127 ? 127 : (qi < -127 ? -127 : qi); u |= ((unsigned)qi & 255u) << (8 * e); }
            o8[w] = u; }
        *(v4u*)(H8 + (size_t)row * D + 16 * lane) = o8;
        if (lane == 0) ((float*)(F.ws + WS_SH))[row] = qscale;
    } else {
        float* op = a.out + (size_t)(row - NC) * D + 16 * lane; const float* gf = a.in[8] + 16 * lane;
#pragma unroll
        for (int w = 0; w < 4; ++w) { const f32x4 gv = ((const f32x4*)gf)[w]; ((f32x4*)op)[w] = (f32x4){v[4 * w] * rstd * gv[0], v[4 * w + 1] * rstd * gv[1], v[4 * w + 2] * rstd * gv[2], v[4 * w + 3] * rstd * gv[3]}; }
    }
}
__device__ __forceinline__ void rp_combine(Frame& F, const Args& a, int l, int row_lo) {
    const int f_tid = lthread(F.wave), f_lane = f_tid & 63;
    const bf16* X = (const bf16*)(F.ws + WS_X); const unsigned char* Y = (const unsigned char*)(F.ws + WS_Y);
    const float* MOD = (const float*)(F.ws + WS_MOD) + (size_t)l * 9 * (NMOD * D); const float* MODN = MOD + 9 * (NMOD * D);
    const v4u* te = (const v4u*)(F.ws + WS_TE); const v4u* trank = (const v4u*)(F.ws + WS_TRANK);
    const LAS int* TT = (const LAS int*)(F.lds + LDS_TT);
    const bool lastl = (l == DEPTH - 1);
    const int st = F.NGW, row0 = row_lo + F.gw;
    if (row0 >= NT) return;
    const int n = (NT - row0 + st - 1) / st, rlast = row0 + (n - 1) * st;
#define CROW(i) ((row0 + (i) * st) <= rlast ? (row0 + (i) * st) : rlast)
    CombRow RA, RB;
    v4u teA = te[CROW(0)], trA = trank[CROW(0)], teB = te[CROW(1)], trB = trank[CROW(1)];
    comb_issue(RA, X, Y, TT, CROW(0), teA, trA, f_lane);
    for (int i = 0; i < n; i += 2) {
        comb_issue(RB, X, Y, TT, CROW(i + 1), teB, trB, f_lane);
        teA = te[CROW(i + 2)]; trA = trank[CROW(i + 2)];
        comb_finish(RA, F, a, l, CROW(i), f_lane, MOD, MODN, lastl);
        comb_issue(RA, X, Y, TT, CROW(i + 2), teA, trA, f_lane);
        teB = te[CROW(i + 3)]; trB = trank[CROW(i + 3)];
        if (i + 1 < n) comb_finish(RB, F, a, l, CROW(i + 1), f_lane, MOD, MODN, lastl);
    }
#undef CROW
}
#endif

__device__ __forceinline__ void rp_mla(Frame& F, const Args& a) {
    const int f_tid = lthread(F.wave), f_lane = f_tid & 63;
    const bf16* A = (const bf16*)(F.ws + WS_RE); bf16* QA = (bf16*)(F.ws + WS_RF); bf16* CKV = (bf16*)(F.ws + WS_RG); bf16* Kb = (bf16*)(F.ws + WS_RB);
    const float* rope = (const float*)(F.ws + WS_ROPE); const float* gq = a.in[12]; const float* gk = a.in[14];
    for (int row = F.gw; row < NT; row += F.NGW) {
        const unsigned* ap = (const unsigned*)(A + (size_t)row * MLA_IN_PAD);
        unsigned q[3], c[2];
#pragma unroll
        for (int j = 0; j < 3; ++j) q[j] = ap[f_lane + 64 * j];
#pragma unroll
        for (int j = 0; j < 2; ++j) c[j] = ap[192 + f_lane + 64 * j];
        const unsigned pe = ap[320 + (f_lane & 15)];
        float sq = 0.f, sc = 0.f;
#pragma unroll
        for (int j = 0; j < 3; ++j) { const float x0 = bf_lo(q[j]), x1 = bf_hi(q[j]); sq += x0 * x0 + x1 * x1; }
#pragma unroll
        for (int j = 0; j < 2; ++j) { const float x0 = bf_lo(c[j]), x1 = bf_hi(c[j]); sc += x0 * x0 + x1 * x1; }
        const float rq = rsqrtf(wave_sum(sq, f_lane) * (1.f / MLA_QL) + EPS), rc = rsqrtf(wave_sum(sc, f_lane) * (1.f / MLA_KVL) + EPS);
#pragma unroll
        for (int j = 0; j < 3; ++j) { const int e0 = 2 * (f_lane + 64 * j); ((unsigned*)(QA + (size_t)row * MLA_QL))[f_lane + 64 * j] = pk2(bf_lo(q[j]) * rq * gq[e0], bf_hi(q[j]) * rq * gq[e0 + 1]); }
#pragma unroll
        for (int j = 0; j < 2; ++j) { const int e0 = 2 * (f_lane + 64 * j); ((unsigned*)(CKV + (size_t)row * MLA_KVL))[f_lane + 64 * j] = pk2(bf_lo(c[j]) * rc * gk[e0], bf_hi(c[j]) * rc * gk[e0 + 1]); }
        float x0 = bf_lo(pe), x1 = bf_hi(pe);
        if (row >= NC) { const int t = (row - NC) & 4095, i = f_lane & 15, d = 2 * i, pos = (d & 16) ? (t & 63) : (t >> 6), f = d & 7;
            const float p0 = shx(x0, 4, f_lane), p1 = shx(x1, 4, f_lane); const float sg = (d & 8) ? 1.f : -1.f;
            const float* rp = rope + (size_t)pos * 16 + 2 * f; x0 = x0 * rp[0] + sg * p0 * rp[1]; x1 = x1 * rp[2] + sg * p1 * rp[3]; }
        const unsigned w = pk2(x0, x1);
        { const int i = f_lane & 15, hb = f_lane >> 4;
#pragma unroll
          for (int hh = 0; hh < 4; ++hh) { const int h = hb * 4 + hh; ((unsigned*)(Kb + (size_t)row * 1536 + 96 * h + 64))[i] = w; } }
    }
}

__device__ __forceinline__ void rp_gqa(Frame& F, const Args& a) {
    const int f_tid = lthread(F.wave), f_lane = f_tid & 63;
    const bf16* A = (const bf16*)(F.ws + WS_RA); bf16* Q = (bf16*)(F.ws + WS_RB); bf16* Kb = Q + (size_t)NT * 1024;
    const float* rope = (const float*)(F.ws + WS_ROPE) + 2048; const float* gq = a.in[18]; const float* gk = a.in[19];
    const float c2 = 0.125f * LOG2E;
    for (int row = F.gw; row < NT; row += F.NGW) {
        const bool lat = row >= NC; const int t = (row - NC) & 4095;
#pragma unroll
        for (int part = 0; part < 2; ++part) {
            const int ln = part ? (f_lane & 15) : f_lane; const bf16* src = A + (size_t)row * GQA_QKV + (part ? 1024 : 0) + ln * 16;
            const v4u w0 = *(const v4u*)src, w1 = *(const v4u*)(src + 8);
            float x[16]; const unsigned ww[8] = {w0.x, w0.y, w0.z, w0.w, w1.x, w1.y, w1.z, w1.w};
#pragma unroll
            for (int i = 0; i < 8; ++i) { x[2 * i] = bf_lo(ww[i]); x[2 * i + 1] = bf_hi(ww[i]); }
            float ss = 0.f;
#pragma unroll
            for (int i = 0; i < 16; ++i) ss += x[i] * x[i];
            ss += shx(ss, 1, f_lane); ss += shx(ss, 2, f_lane);
            const float rs = rsqrtf(ss * (1.f / 64.f) + EPS); const float* g = (part ? gk : gq) + (ln & 3) * 16;
#pragma unroll
            for (int i = 0; i < 16; ++i) x[i] = x[i] * rs * g[i];
            if (lat) { const int sec = (ln >> 1) & 1, pos = sec ? (t & 63) : (t >> 6); const float sg = (ln & 1) ? 1.f : -1.f; const float* rp = rope + (size_t)pos * 32;
#pragma unroll
                for (int i = 0; i < 16; ++i) { const float pr = shx(x[i], 1, f_lane); x[i] = x[i] * rp[2 * i] + sg * pr * rp[2 * i + 1]; } }
            const float scl = part ? 1.f : c2;
            v4u o0, o1; o0.x = pk2(x[0] * scl, x[1] * scl); o0.y = pk2(x[2] * scl, x[3] * scl); o0.z = pk2(x[4] * scl, x[5] * scl); o0.w = pk2(x[6] * scl, x[7] * scl);
            o1.x = pk2(x[8] * scl, x[9] * scl); o1.y = pk2(x[10] * scl, x[11] * scl); o1.z = pk2(x[12] * scl, x[13] * scl); o1.w = pk2(x[14] * scl, x[15] * scl);
            if (part == 0) { bf16* d = Q + (size_t)row * 1024 + ln * 16; *(v4u*)d = o0; *(v4u*)(d + 8) = o1; }
            else if (f_lane < 16) { bf16* d = Kb + (size_t)row * 256 + ln * 16; *(v4u*)d = o0; *(v4u*)(d + 8) = o1; }
        }
    }
}

template <int DK>
__device__ __forceinline__ void attn_phase(Frame& F, const att::Tens& T, int kvshift  , int kstride, int vstride, int vbase) {
    const int vcu = (F.G % 8 == 0) ? (blockIdx.x % 8) * (F.G / 8) + blockIdx.x / 8 : blockIdx.x;
    if constexpr (DK == 64) {
        for (int u = vcu; u < 2048 + 128; u += F.G) {
            if (u < 2048) { const int b = u >> 8, h = (u >> 4) & 15, qb = u & 15, kvh = h >> kvshift;
                att64::attn_unit<8>(T.Q, T.qpitch, NC + b * SEQ + qb * 256, h * 64, T.K, T.kpitch, kvh * kstride, T.V, T.vpitch, vbase + kvh * vstride, T.O, h * 64, b * LCTX, NC + b * SEQ, 68, (char*)F.lds, F.wave); }
            else { const int q = u - 2048, b = q >> 4, h = q & 15, kvh = h >> kvshift;
                att64::attn_unit<8>(T.Q, T.qpitch, b * LCTX, h * 64, T.K, T.kpitch, kvh * kstride, T.V, T.vpitch, vbase + kvh * vstride, T.O, h * 64, b * LCTX, 0, 4, (char*)F.lds, F.wave); }
        }
        __syncthreads();
    } else {
        for (int u = vcu; u < 2048 + 128; u += F.G) {
            if (u < 2048) { const int b = u >> 8, h = (u >> 4) & 15, qb = u & 15, kvh = h >> kvshift;
                att96::attn_unit<8>(T.Q, T.qpitch, NC + b * SEQ + qb * 256, h * 96, T.K, T.kpitch, kvh * kstride, T.V, T.vpitch, vbase + kvh * vstride, T.O, h * 64, b * LCTX, NC + b * SEQ, 68, (char*)F.lds, F.wave); }
            else { const int q = u - 2048, b = q >> 4, h = q & 15, kvh = h >> kvshift;
                att96::attn_unit<8>(T.Q, T.qpitch, b * LCTX, h * 96, T.K, T.kpitch, kvh * kstride, T.V, T.vpitch, vbase + kvh * vstride, T.O, h * 64, b * LCTX, 0, 4, (char*)F.lds, F.wave); }
        }
        __syncthreads();
    }
}

constexpr int PH_PER_LAYER = 9, PH_TOTAL = 2 + DEPTH * PH_PER_LAYER;
__global__ void __launch_bounds__(512, 2) mk_fwd(Args args) {
    extern __shared__ __attribute__((aligned(16))) unsigned char lds_raw[];
    Frame F;
    F.lds = (LAS unsigned char*)lds_raw; F.ws = args.ws; F.ctl = (gu32*)(args.ws + WS_CTL);
    F.wave = __builtin_amdgcn_readfirstlane(threadIdx.x >> 6); F.G = gridDim.x;
    F.gw = blockIdx.x * 8 + F.wave; F.NGW = F.G * 8;
    if (threadIdx.x < 4) ((LAS unsigned*)(F.lds + LDS_XB))[threadIdx.x] = 0u;
    __syncthreads();
    const int lo = args.ph_lo, hi = args.ph_hi;
    const bool multi = (hi - lo) > 1;
    XcdBarrier bar; bar.bar = (unsigned*)(F.ctl + CW_BAR); bar.x = 0; bar.st = nullptr; bar.wave = F.wave;
    if (multi) bar = xcd_barrier_post((unsigned*)(F.ctl + CW_BAR), (volatile LAS unsigned*)(F.lds + LDS_XB), F.wave);
#define IN(k) (lo <= (k) && (k) < hi)
#define SEAM(k) do { if (IN(k) && IN((k) + 1)) xcd_barrier(bar); } while (0)
    unsigned char* ws0 = args.ws;
#define PH_WS size_t zofs_ = 0; asm volatile("" : "+s"(zofs_)); unsigned char* ws = ws0 + zofs_; F.ws = ws; F.ctl = (gu32*)ws;
    const int G = F.G, cidx = (int)blockIdx.x;

    if (IN(0) && EN(0)) { PH_WS REP(0) { prologue(F, args); SEAM(0); } }
    if (IN(1) && EN(1)) { PH_WS rp_norm1(F, args, 0, 0);
        quant_rows(F, (const bf16*)(ws + WS_WFIN), (unsigned char*)(ws + WS_W8), (float*)(ws + WS_SWP), 2 * 2048);
        quant_rows(F, (const bf16*)(ws + WS_WMIN), (unsigned char*)(ws + WS_W8) + 4 * MiB, (float*)(ws + WS_SWP) + 4096, MLA_IN_PAD);
        quant_rows(F, (const bf16*)(ws + WS_WGQKV), (unsigned char*)(ws + WS_W8) + 5 * MiB, (float*)(ws + WS_SWP) + 4864, GQA_QKV); SEAM(1); }

    for (int l = 0; l < DEPTH; ++l) {
        const int kind = l % 3, j = l / 3, base = 2 + l * PH_PER_LAYER;
        const bool lastl = (l == DEPTH - 1);

        size_t outB = 0;
        if (kind == 0) {
            if (IN(base + 0) && EN(2)) { PH_WS REP(2) { PolFP p; p.A = (const char*)(ws + WS_W8) + (size_t)j * 2048 * D; p.B = (const char*)(ws + WS_H); p.nt = 8; p.sW = (const float*)(ws + WS_SWP) + j * 2048; p.sH = (const float*)(ws + WS_SH); p.nN = lastl ? 128 : 136; p.G = G; p.c = cidx;
                p.Z = (bf16*)(ws + WS_RA); p.Zc = (bf16*)(ws + WS_RH); pg8::gemm_phase(F.lds, p, F.wave); } }
            SEAM(base + 0);
            if (IN(base + 1) && EN(3)) { PH_WS REP(3) { PolFA p; p.A = (const char*)(ws + WS_MA); p.B = (const char*)(ws + WS_RA); p.nt = 4; p.G = G; p.c = cidx; p.Y = (bf16*)(ws + WS_RB); pg8::gemm_phase(F.lds, p, F.wave); } }
            SEAM(base + 1);
            if (IN(base + 2) && EN(4)) { PH_WS REP(4) { PolFC p; p.A = (const char*)(ws + WS_DC); p.B = (const char*)(ws + WS_RB); p.nt = 8; p.G = G; p.c = cidx; p.nunits = lastl ? 512 : 544;
                p.offMC = (unsigned)(WS_MC - WS_DC); p.offZc = (unsigned)(WS_RH - WS_RB); p.F = (bf16*)(ws + WS_RC); pg8::gemm_phase(F.lds, p, F.wave); } }
            SEAM(base + 2);
            outB = WS_WFOUT + (size_t)j * D * D * 2;
        } else if (kind == 1) {
            if (IN(base + 0) && EN(5)) { PH_WS REP(5) { PolDenseI8 p; p.A = (const char*)(ws + WS_H); p.B = (const char*)(ws + WS_W8) + 4 * MiB; p.nt = 8; p.nM = NT / 256; p.nN = 3; p.pm0 = 0; p.G = G; p.c = cidx; p.sA = (const float*)(ws + WS_SH); p.sB = (const float*)(ws + WS_SWP) + 4096;
                p.O = (bf16*)(ws + WS_RE); p.ldo = MLA_IN_PAD; pg8::gemm_phase(F.lds, p, F.wave); } }
            SEAM(base + 0);
            if (IN(base + 1) && EN(6)) { PH_WS REP(6) { rp_mla(F, args); } }
            SEAM(base + 1);
            if (IN(base + 2)) { PH_WS REP(7) {
                if (EN(7)) { PolMlaQ p; p.A = (const char*)(ws + WS_RF); p.B = (const char*)(ws + WS_WMQB); p.nt = 6; p.nM = NT / 256; p.nN = 6; p.G = G; p.c = cidx; p.Q = (bf16*)(ws + WS_RA);
                  p.rope = (const float*)(ws + WS_ROPE); p.c2 = 0.10206207261596575f * LOG2E; pg8::gemm_phase(F.lds, p, F.wave); }
                if (EN(8)) { PolMlaKV p; p.A = (const char*)(ws + WS_RG); p.B = (const char*)(ws + WS_WMKVB); p.nt = 4; p.nM = NT / 256; p.nN = 8; p.G = G; p.c = cidx; p.Kb = (bf16*)(ws + WS_RB); p.Vb = (bf16*)(ws + WS_RD);
                  pg8::gemm_phase(F.lds, p, F.wave); }
            } }
            SEAM(base + 2);
            if (IN(base + 3) && EN(9)) { PH_WS REP(9) { att::Tens T{(const bf16*)(ws + WS_RA), 1536, (const bf16*)(ws + WS_RB), 1536, (const bf16*)(ws + WS_RD), 1024, (bf16*)(ws + WS_RC)}; attn_phase<96>(F, T, 0, 96, 64, 0); } }
            SEAM(base + 3);
            outB = WS_WMO;
        } else {
            if (IN(base + 0) && EN(10)) { PH_WS REP(10) { PolDenseI8 p; p.A = (const char*)(ws + WS_H); p.B = (const char*)(ws + WS_W8) + 5 * MiB; p.nt = 8; p.nM = NT / 256; p.nN = 6; p.pm0 = 0; p.G = G; p.c = cidx; p.sA = (const float*)(ws + WS_SH); p.sB = (const float*)(ws + WS_SWP) + 4864;
                p.O = (bf16*)(ws + WS_RA); p.ldo = GQA_QKV; pg8::gemm_phase(F.lds, p, F.wave); } }
            SEAM(base + 0);
            if (IN(base + 1) && EN(11)) { PH_WS REP(11) { rp_gqa(F, args); } }
            SEAM(base + 1);
            if (IN(base + 2) && EN(12)) { PH_WS REP(12) { att::Tens T{(const bf16*)(ws + WS_RB), 1024, (const bf16*)(ws + WS_RB) + (size_t)NT * 1024, 256, (const bf16*)(ws + WS_RA), 1536, (bf16*)(ws + WS_RC)}; attn_phase<64>(F, T, 2, 64, 64, 1280); } }
            SEAM(base + 2);
            outB = WS_WGO;
        }
        if (IN(base + 4) && EN(13)) { PH_WS PolOut p; p.A = (const char*)(ws + WS_RC); p.B = (const char*)(ws + outB); p.nt = 16; p.nM = lastl ? NL / 256 : NT / 256; p.nN = 4; p.pm0 = lastl ? 8 : 0; p.G = G; p.c = cidx; p.X = (bf16*)(ws + WS_X); p.mod = (const float*)(ws + WS_MOD) + (size_t)l * 9 * (NMOD * D); p.chunk = 2;
            p.XinC = (l == 0) ? args.in[2] : nullptr; p.XinL = (l == 0) ? args.in[0] - (size_t)NC * D : nullptr;
            pg8::gemm_phase(F.lds, p, F.wave); }
        SEAM(base + 4);
        if (IN(base + 5) && EN(14)) { PH_WS rp_norm2_router(F, args, l, lastl ? NC : 0); }
        SEAM(base + 5);
        if (IN(base + 6) && EN(15)) { PH_WS REP(15) { moe_table(F, l);
            PolMoe1 p; p.A = (const char*)(ws + WS_H); p.B = (const char*)(ws + WS_WGU) + (size_t)l * NE * 2048 * D; p.nt = 8; p.G = G; p.c = cidx;
            p.swgu = (const float*)(ws + WS_SWGU) + (size_t)l * NE * 2048; p.ssc = (const float*)(ws + WS_SSC);
            p.T.TT = (const LAS int*)(F.lds + LDS_TT); p.T.CN = p.T.TT + 64; p.T.TE = (const LAS int*)(F.lds + LDS_TE); p.stok = (const int*)(ws + WS_STOK); p.bgu = (const float*)(ws + WS_BGU) + (size_t)l * NE * 2048; p.act = (unsigned char*)(ws + WS_ACT);
            pg8::gemm_phase(F.lds, p, F.wave); } }
        SEAM(base + 6);
        if (IN(base + 7) && EN(16)) { PH_WS REP(16) { moe_table(F, l);
            PolMoe2 p; p.A = (const char*)(ws + WS_ACT); p.B = (const char*)(ws + WS_WDN) + (size_t)l * NE * D * DFF; p.nt = 8; p.G = G; p.c = cidx; p.swd = (const float*)(ws + WS_SWDN) + (size_t)l * NE * D;
            p.T.TT = (const LAS int*)(F.lds + LDS_TT); p.T.CN = p.T.TT + 64; p.T.TE = (const LAS int*)(F.lds + LDS_TE); p.sw = (const float*)(ws + WS_SW); p.bdn = args.in[26] + (size_t)l * NE * D; p.Y = (unsigned char*)(ws + WS_Y);
            pg8::gemm_phase(F.lds, p, F.wave); } }
        SEAM(base + 7);
        if (IN(base + 8) && EN(17)) { PH_WS moe_table(F, l); rp_combine(F, args, l, lastl ? NC : 0); }
        SEAM(base + 8);
    }
#undef PH_WS
#undef IN
#undef SEAM
}

extern "C" void kernel_launch(void* const* d_in, const int* in_sizes, int n_in, void* d_out, int out_size, void* d_ws, size_t ws_size, hipStream_t stream) {
    static int grid = 0;
    if (grid == 0) {
        if (n_in != 27 || out_size != NL * D || ws_size < WS_END) { fprintf(stderr, "kernel_launch: unexpected problem (n_in %d, out %d, ws %zu < %zu)\n", n_in, out_size, ws_size, (size_t)WS_END); grid = -1; return; }
        int dev = 0, cus = 0, per_cu = 0;
        if (hipGetDevice(&dev) != hipSuccess || hipDeviceGetAttribute(&cus, hipDeviceAttributeMultiprocessorCount, dev) != hipSuccess) { grid = -1; return; }
        if (hipFuncSetAttribute((const void*)mk_fwd, hipFuncAttributeMaxDynamicSharedMemorySize, LDS_BYTES) != hipSuccess) { fprintf(stderr, "kernel_launch: hipFuncSetAttribute failed\n"); grid = -1; return; }
        if (hipOccupancyMaxActiveBlocksPerMultiprocessor(&per_cu, (const void*)mk_fwd, 512, LDS_BYTES) != hipSuccess || per_cu < 1) fprintf(stderr, "kernel_launch: occupancy query says %d\n", per_cu);
        (void)hipGetLastError();
        grid = cus;
    }
    if (grid < 0) return;
    (void)hipMemsetAsync((char*)d_ws + WS_CTL, 0, CTL_ZERO_BYTES, stream);
    Args a{};
    for (int i = 0; i < 27; ++i) a.in[i] = (const float*)d_in[i];
    a.out = (float*)d_out; a.ws = (unsigned char*)d_ws;
#if MK_PER_PHASE
    for (int ph = 0; ph < PH_TOTAL; ++ph) {
        const int l = (ph - 2) / PH_PER_LAYER, s = (ph - 2) % PH_PER_LAYER, kind = l % 3;
        if (ph >= 2) { if (s == 3 && kind != 1) continue; }
        a.ph_lo = ph; a.ph_hi = ph + 1;
        hipLaunchKernelGGL(mk_fwd, dim3(grid), dim3(512), LDS_BYTES, stream, a);
    }
#else
    a.ph_lo = 0; a.ph_hi = PH_TOTAL;
    hipLaunchKernelGGL(mk_fwd, dim3(grid), dim3(512), LDS_BYTES, stream, a);
#endif
}
```

```cpp
#include <hip/hip_runtime.h>
#include <cstdio>
#include <cstdint>

#ifndef MK_PER_PHASE
#define MK_PER_PHASE 0
#endif
#ifndef MK_N2V2
#define MK_N2V2 1
#endif
#ifndef MK_CBV2
#define MK_CBV2 1
#endif
#ifndef MK_N2AGG
#define MK_N2AGG 1
#endif
#ifndef MK_MASK
#define MK_MASK 0xFFFFFFFFu
#endif
#define EN(id) (((MK_MASK) >> (id)) & 1u)
#ifndef MK_REPMASK
#define MK_REPMASK 0u
#endif
#define REP(id) for (int rep_ = 0; rep_ < ((((MK_REPMASK) >> (id)) & 1u) ? 2 : 1); ++rep_)

constexpr int D = 1024, NB = 8, SEQ = 4096, LCTX = 256, DEPTH = 4;
constexpr int NC = NB * LCTX;
constexpr int NL = NB * SEQ;
constexpr int NT = NC + NL;
constexpr int NMOD = 6, NE = 32, TOPK = 4, DFF = 1024;
constexpr int MLA_QL = 384, MLA_KVL = 256, MLA_ROPE = 32, MLA_NOPE = 64, MLA_V = 64, MLA_IN = 672, MLA_IN_PAD = 768, MLA_QD = 96;
constexpr int GQA_NQ = 1024, GQA_NKV = 256, GQA_QKV = 1536;
constexpr int CAP = NT;
constexpr int MAXTILES = 576;
constexpr float EPS = 1e-6f;
constexpr float LOG2E = 1.4426950408889634f;

constexpr size_t MiB = 1u << 20;
constexpr size_t WS_CTL = 0, CTL_ZERO_BYTES = 96 * 1024;
constexpr size_t WS_MOD = 1 * MiB;
constexpr size_t WS_ROPE = 2 * MiB;
constexpr size_t WS_WRT = 2 * MiB + 65536;
constexpr size_t WS_BGU = 3 * MiB;
constexpr size_t WS_MA = 4 * MiB;
constexpr size_t WS_DC = 4 * MiB + 262144;
constexpr size_t WS_MC = 5 * MiB;
constexpr size_t WS_WFIN = 9 * MiB;
constexpr size_t WS_WFOUT = 17 * MiB;
constexpr size_t WS_WMIN = 21 * MiB;
constexpr size_t WS_WMQB = 23 * MiB;
constexpr size_t WS_WMKVB = 25 * MiB;
constexpr size_t WS_WMO = 26 * MiB;
constexpr size_t WS_WGQKV = 28 * MiB;
constexpr size_t WS_WGO = 31 * MiB;
constexpr size_t WS_TE = 34 * MiB;
constexpr size_t WS_TRANK = 35 * MiB;
constexpr size_t WS_STOK = 36 * MiB;
constexpr size_t WS_SW = 41 * MiB;
constexpr size_t WS_X = 64 * MiB;
constexpr size_t WS_H = 200 * MiB;
constexpr size_t WS_RA = 272 * MiB;
constexpr size_t WS_RB = 400 * MiB;
constexpr size_t WS_RC = 528 * MiB;
constexpr size_t WS_RD = 600 * MiB;
constexpr size_t WS_RE = 672 * MiB;
constexpr size_t WS_RF = 728 * MiB;
constexpr size_t WS_RG = 756 * MiB;
constexpr size_t WS_RH = 776 * MiB;
constexpr size_t WS_ACT = 784 * MiB;
constexpr size_t WS_Y = 1072 * MiB;
constexpr size_t WS_WGU = 1360 * MiB;
constexpr size_t WS_SWGU = 1360 * MiB + 256 * MiB;
constexpr size_t WS_SH = 1360 * MiB + 259 * MiB;
constexpr size_t WS_SWP = 1360 * MiB + 259 * MiB + 256 * 1024;
constexpr size_t WS_W8 = 1360 * MiB + 266 * MiB;
constexpr size_t WS_WO8 = 1360 * MiB + 274 * MiB;
constexpr size_t WS_SWO = 1360 * MiB + 278 * MiB;
constexpr size_t WS_SSC = 1360 * MiB + 260 * MiB;
constexpr size_t WS_WDN = 1872 * MiB;
constexpr size_t WS_SWDN = 1872 * MiB + 128 * MiB;
constexpr size_t WS_END = 2128 * MiB;
constexpr int CW_TMO = 0;
constexpr int CW_BAR = 4096;
constexpr int CW_CNT = 16384;

constexpr int RING_BYTES = 131072;
constexpr int LDS_MISC = 135168;
constexpr int LDS_TT = LDS_MISC;
constexpr int LDS_XB = LDS_MISC + 512;
constexpr int LDS_TE = LDS_MISC + 768;
constexpr int LDS_BYTES = 147456;

#define GAS __attribute__((address_space(1)))
#define LAS __attribute__((address_space(3)))
typedef unsigned short bf16;
typedef unsigned v4u __attribute__((ext_vector_type(4)));
typedef unsigned v2u __attribute__((ext_vector_type(2)));
typedef float f32x4 __attribute__((ext_vector_type(4)));
typedef float f32x2 __attribute__((ext_vector_type(2)));
typedef float f32x16 __attribute__((ext_vector_type(16)));
typedef short bf16x8 __attribute__((ext_vector_type(8)));
typedef short s16x4 __attribute__((ext_vector_type(4)));
typedef __bf16 bf16x2_t __attribute__((ext_vector_type(2)));
typedef GAS unsigned gu32;
#define RLX_AGENT __ATOMIC_RELAXED, __HIP_MEMORY_SCOPE_AGENT
#define LDS_WAIT() asm volatile("s_waitcnt lgkmcnt(0)" ::: "memory")
#define VM_WAIT() asm volatile("s_waitcnt vmcnt(0)" ::: "memory")
__device__ __forceinline__ unsigned pk2(float lo, float hi) { f32x2 v = {lo, hi}; bf16x2_t b = __builtin_convertvector(v, bf16x2_t); return __builtin_bit_cast(unsigned, b); }
__device__ __forceinline__ float bf_lo(unsigned u) { return __builtin_bit_cast(float, u << 16); }
__device__ __forceinline__ float bf_hi(unsigned u) { return __builtin_bit_cast(float, u & 0xffff0000u); }
__device__ __forceinline__ float shx(float v, int mask, int lane) { return __int_as_float(__builtin_amdgcn_ds_bpermute((lane ^ mask) << 2, __float_as_int(v))); }
__device__ __forceinline__ float wave_sum(float v, int lane) {
#pragma unroll
    for (int o = 1; o < 64; o <<= 1) v += shx(v, o, lane);
    return v;
}
__device__ __forceinline__ int lane_id_v() { int t; asm volatile("v_mbcnt_lo_u32_b32 %0, -1, 0\n\tv_mbcnt_hi_u32_b32 %0, -1, %0" : "=v"(t)); return t; }
__device__ __forceinline__ int launder_s(int x) { asm volatile("" : "+s"(x)); return x; }
__device__ __forceinline__ int lthread_w(int wave) { return wave * 64 + lane_id_v(); }
__device__ __forceinline__ int modrow_of(int row) { return row < NC ? NB : ((row - NC) >> 12); }

#define XB_TMO      128
#define XB_XCNT(j)  (256  + 64 * (j))
#define XB_XSUB(j)  (1280 + 64 * (j))
#define XB_XGEN(j)  (2304 + 64 * (j))
#define XB_TOP      3328
#define XB_TOPGEN   3392
#define XCD_BAR_WORDS 3456
#define XB_SPIN_CAP (1u << 18)
__device__ __forceinline__ unsigned xb_ld(unsigned* p)              { return __hip_atomic_load(p, __ATOMIC_RELAXED, __HIP_MEMORY_SCOPE_AGENT); }
__device__ __forceinline__ unsigned xb_add(unsigned* p, unsigned v) { return __hip_atomic_fetch_add(p, v, __ATOMIC_RELAXED, __HIP_MEMORY_SCOPE_AGENT); }
__device__ __forceinline__ unsigned xb_xcc_id() { return (unsigned)__builtin_amdgcn_s_getreg((3 << 11) | 20) & 0xFu; }
#define XB_SPIN(cond, bar) do { unsigned _sp = 0; while (cond) { __builtin_amdgcn_s_sleep(1); \
    if ((++_sp & 255u) == 0u) { if (xb_ld(&(bar)[XB_TMO])) break; if (_sp > XB_SPIN_CAP) { atomicAdd(&(bar)[XB_TMO], 1u); break; } } } } while (0)
struct XcdBarrier { unsigned* bar; unsigned x; volatile LAS unsigned* st; int wave; };
__device__ __forceinline__ bool xb_thread0(int wave) { return wave == 0 && lane_id_v() == 0; }
__device__ __forceinline__ XcdBarrier xcd_barrier_post(unsigned* bar, volatile LAS unsigned* st, int wave) {
    XcdBarrier b; b.bar = bar; b.x = xb_xcc_id(); b.st = st; b.wave = wave;
    if (xb_thread0(wave)) (void)xb_add(&bar[XB_XCNT(b.x)], 1u);
    return b;
}
__device__ __forceinline__ void xcd_barrier_complete(unsigned* bar, unsigned x, unsigned& nloc, unsigned& nx) {
    const unsigned G = gridDim.x * gridDim.y * gridDim.z;
    unsigned sum, cnt, mine, sp = 0u;
    for (;;) {
        sum = 0u; cnt = 0u; mine = 0u;
#pragma unroll
        for (unsigned j = 0; j < 16; ++j) { const unsigned c = xb_ld(&bar[XB_XCNT(j)]); sum += c; cnt += (c > 0u) ? 1u : 0u; mine = (j == x) ? c : mine; }
        if (sum == G) break;
        __builtin_amdgcn_s_sleep(1);
        if ((++sp & 255u) == 0u) { if (xb_ld(&bar[XB_TMO])) break; if (sp > XB_SPIN_CAP) { atomicAdd(&bar[XB_TMO], 1u); break; } }
    }
    nloc = mine > 0u ? mine : 1u; nx = cnt > 0u ? cnt : 1u;
}
__device__ __forceinline__ void xcd_barrier(const XcdBarrier& b) {
    asm volatile("s_waitcnt vmcnt(0)" ::: "memory");
    __syncthreads();
    if (xb_thread0(b.wave)) {
        unsigned* bar = b.bar;
        __builtin_amdgcn_s_waitcnt(0);
        unsigned nloc = b.st[0], nx = b.st[1];
        if (nloc == 0u) { xcd_barrier_complete(bar, b.x, nloc, nx); b.st[0] = nloc; b.st[1] = nx; }
        const unsigned old = xb_add(&bar[XB_XSUB(b.x)], 1u);
        const unsigned gen = old / nloc;
        if (old + 1u == (gen + 1u) * nloc) {
            __builtin_amdgcn_fence(__ATOMIC_RELEASE, "agent");
            asm volatile("s_waitcnt vmcnt(0)" ::: "memory");
            const unsigned og = xb_add(&bar[XB_TOP], 1u);
            const unsigned tg = og / nx;
            if (og + 1u == (tg + 1u) * nx) xb_add(&bar[XB_TOPGEN], 1u);
            else XB_SPIN(xb_ld(&bar[XB_TOPGEN]) == tg, bar);
            __builtin_amdgcn_fence(__ATOMIC_ACQUIRE, "agent");
            xb_add(&bar[XB_XGEN(b.x)], 1u);
            asm volatile("s_waitcnt vmcnt(0)" ::: "memory");
        } else {
            XB_SPIN(xb_ld(&bar[XB_XGEN(b.x)]) == gen, bar);
            __builtin_amdgcn_fence(__ATOMIC_ACQUIRE, "agent");
            asm volatile("s_waitcnt vmcnt(0)" ::: "memory");
        }
    }
    __syncthreads();
}

namespace pg8 {
#define PG8_LAS __attribute__((address_space(3)))
constexpr int BM = 256, BK = 64, HALF = 128, HTB = HALF * BK * 2, STAGE_BYTES = 8 * HTB, NXCD = 8, WGM = 8;
__device__ __forceinline__ int lds_byte(int r, int c) { const int st = (r >> 4) * 2 + (c >> 5), rr = r & 15, cc = c & 31, ob = rr * 64 + cc * 2; return st * 1024 + (ob ^ (((ob >> 9) & 1) << 5)); }
__device__ __forceinline__ void stage_rc(int b, int& R, int& C) { const int st = b / 1024, sb = b % 1024, swz = sb ^ (((sb >> 9) & 1) << 5); R = (st >> 1) * 16 + swz / 64; C = (st & 1) * 32 + (swz % 64) / 2; }
__device__ __forceinline__ int perm32(int rho) { const int n = rho >> 4, i = rho & 15; return 8 * (i >> 2) + 4 * n + (i & 3); }
struct Unit { int pm, pn, aux; };
typedef f32x4 Acc[2][2][4][2];
typedef int i32x4 __attribute__((ext_vector_type(4)));
typedef i32x4 AccI[2][2][4][2];
template <bool I8> struct AccSel { typedef f32x4 T; };
template <> struct AccSel<true> { typedef i32x4 T; };
__device__ __forceinline__ f32x4 mma1(bf16x8 b, bf16x8 a, f32x4 c) { return __builtin_amdgcn_mfma_f32_16x16x32_bf16(b, a, c, 0, 0, 0); }
typedef int i32x8 __attribute__((ext_vector_type(8)));
typedef short bf16x16 __attribute__((ext_vector_type(16)));
__device__ __forceinline__ f32x4 mma_f8(bf16x8 b0, bf16x8 b1, bf16x8 a0, bf16x8 a1, f32x4 c) {
    const i32x8 B = __builtin_bit_cast(i32x8, __builtin_shufflevector(b0, b1, 0, 1, 2, 3, 4, 5, 6, 7, 8, 9, 10, 11, 12, 13, 14, 15));
    const i32x8 A = __builtin_bit_cast(i32x8, __builtin_shufflevector(a0, a1, 0, 1, 2, 3, 4, 5, 6, 7, 8, 9, 10, 11, 12, 13, 14, 15));
    return __builtin_amdgcn_mfma_scale_f32_16x16x128_f8f6f4(B, A, c, 0, 0, 0, 0, 0, 0); }
__device__ __forceinline__ i32x4 mma1(bf16x8 b, bf16x8 a, i32x4 c) { return __builtin_amdgcn_mfma_i32_16x16x64_i8(__builtin_bit_cast(i32x4, b), __builtin_bit_cast(i32x4, a), c, 0, 0, 0); }

__device__ __forceinline__ bool static_next(int i, int G, int c, int nM, int nN, int& pm, int& pn) {
    const int nwg = nM * nN; const long L = (long)i * G + c; if (L >= nwg) return false;
    int wgid = (int)L; { const int q = nwg / NXCD, r = nwg % NXCD, xcd = wgid % NXCD, off = wgid / NXCD; wgid = (xcd < r ? xcd * (q + 1) : r * (q + 1) + (xcd - r) * q) + off; }
    const int nig = WGM * nN, gid = wgid / nig, fm = gid * WGM, gsz = (nM - fm) < WGM ? (nM - fm) : WGM;
    pm = fm + ((wgid % nig) % gsz); pn = (wgid % nig) / gsz; return true;
}

template <class P>
__device__ __forceinline__ void gemm_phase(PG8_LAS unsigned char* lds, const P& p, int wave_id) {
    wave_id = launder_s(wave_id); int tid_l = lthread_w(wave_id);
    const int tid = tid_l, wid = wave_id, lane = tid & 63, wr = wid >> 2, wc = wid & 3, fr = lane & 15, fq = lane >> 4;
    const int nt = p.nt;
    const unsigned ldsw = (unsigned)wid * 1024u;
    const int aoff = lds_byte(wr * 64 + fr, fq * 8), boff = lds_byte(wc * 32 + fr, fq * 8);
    const char* const gA = p.A; const char* const gB = p.B;
#define PG8_SA(b, h) (((b) * 2 + (h)) * HTB)
#define PG8_SB(b, h) ((4 + (b) * 2 + (h)) * HTB)
#define PG8_STAGE(bufoff, gbase, off2, kofs) do { _Pragma("unroll") for (int _i = 0; _i < 2; ++_i) \
        __builtin_amdgcn_global_load_lds((const unsigned*)((gbase) + (size_t)(off2)[_i] + (size_t)(kofs)), (PG8_LAS unsigned*)(lds + (bufoff) + ldsw + _i * 8192), 16, 0, 0); } while (0)
#define PG8_LDA(dst, b, h) do { _Pragma("unroll") for (int m = 0; m < 4; ++m) _Pragma("unroll") for (int k = 0; k < 2; ++k) dst[m][k] = *(const PG8_LAS bf16x8*)(lds + PG8_SA(b, h) + aoff + m * 2048 + k * 1024); } while (0)
#define PG8_LDB(dst, b, h) do { _Pragma("unroll") for (int n = 0; n < 2; ++n) _Pragma("unroll") for (int k = 0; k < 2; ++k) dst[n][k] = *(const PG8_LAS bf16x8*)(lds + PG8_SB(b, h) + boff + n * 2048 + k * 1024); } while (0)
#define PG8_MMA(ai, bj, At, Bt) do { __builtin_amdgcn_s_setprio(1); _Pragma("unroll") for (int m = 0; m < 4; ++m) _Pragma("unroll") for (int n = 0; n < 2; ++n) { \
        if constexpr (P::F8) acc[ai][bj][m][n] = mma_f8(Bt[n][0], Bt[n][1], At[m][0], At[m][1], acc[ai][bj][m][n]); \
        else { _Pragma("unroll") for (int k = 0; k < 2; ++k) acc[ai][bj][m][n] = mma1(Bt[n][k], At[m][k], acc[ai][bj][m][n]); } } __builtin_amdgcn_s_setprio(0); } while (0)
#define PG8_WAIT_V(n) asm volatile("s_waitcnt vmcnt(" #n ")" ::: "memory")
#define PG8_WAIT_L(n) asm volatile("s_waitcnt lgkmcnt(" #n ")" ::: "memory")
#define PG8_BAR __builtin_amdgcn_s_barrier()
#define PG8_SCHED __builtin_amdgcn_sched_barrier(0)
#define PG8_KEYS(u) do { if (P::KEYS && wid < 4) __builtin_amdgcn_global_load_lds((const unsigned*)p.key_ptr(u, wid * 64 + lane_id_v()), (PG8_LAS unsigned*)(keybuf + wid * 256), 4, 0, 0); } while (0)
#define PG8_OFFS(u, oA, oB) do { const int tid2_ = wid * 64 + lane_id_v();     \
    _Pragma("unroll") for (int _i = 0; _i < 2; ++_i) { int R_, C_; stage_rc(tid2_ * 16 + _i * 8192, R_, C_); const int Rb_ = P::PERM ? ((R_ & ~31) + perm32(R_ & 31)) : R_; \
      _Pragma("unroll") for (int _h = 0; _h < 2; ++_h) { \
        const int key_ = P::KEYS ? ((const PG8_LAS int*)keybuf)[_h * HALF + R_] : 0; \
        oA[_h][_i] = p.a_row(u, _h * HALF + R_, key_) + (unsigned)(C_ * 2); oB[_h][_i] = p.b_row(u, _h * HALF + Rb_) + (unsigned)(C_ * 2); } } } while (0)
    PG8_LAS unsigned char* const keybuf = lds + STAGE_BYTES;
    Unit cur, nxt; int ui = 0;
    if (!p.next(0, cur)) return;
    typedef typename AccSel<P::I8>::T AccT;
    AccT acc[2][2][4][2];
#pragma unroll
    for (int a = 0; a < 2; ++a)
#pragma unroll
        for (int b = 0; b < 2; ++b)
#pragma unroll
            for (int m = 0; m < 4; ++m)
#pragma unroll
                for (int n = 0; n < 2; ++n) acc[a][b][m][n] = (AccT){0, 0, 0, 0};
    bf16x8 At[4][2], B0[2][2], B1[2][2];
    unsigned oAc[2][2], oBc[2][2];
    if (P::KEYS) { PG8_KEYS(cur); PG8_WAIT_V(0); PG8_BAR; }
    PG8_OFFS(cur, oAc, oBc);
    PG8_STAGE(PG8_SB(0, 0), gB, oBc[0], 0); PG8_STAGE(PG8_SB(0, 1), gB, oBc[1], 0); PG8_STAGE(PG8_SA(0, 0), gA, oAc[0], 0); PG8_STAGE(PG8_SA(0, 1), gA, oAc[1], 0);
    if (wr == 1) PG8_BAR;
    PG8_WAIT_V(2); PG8_BAR;
    PG8_STAGE(PG8_SB(1, 0), gB, oBc[0], 128); PG8_STAGE(PG8_SA(1, 0), gA, oAc[0], 128); PG8_STAGE(PG8_SB(1, 1), gB, oBc[1], 128);
    PG8_WAIT_V(6); PG8_BAR;
    for (;;) {
        const bool has_next = p.next(ui + 1, nxt);
        if (has_next) { PG8_KEYS(nxt); }
        for (int t = 0; t < nt; t += 2) {
            const bool last = (t == nt - 2);
            const unsigned k1 = (unsigned)(t + 1) * 128u;
            const unsigned k2 = last ? 0u : (unsigned)(t + 2) * 128u, k3 = k2 + 128u;
            PG8_LDB(B0, 0, 0); PG8_LDB(B1, 0, 1); PG8_SCHED; PG8_LDA(At, 0, 0); PG8_STAGE(PG8_SA(1, 1), gA, oAc[1], k1);
            if (last && has_next) { PG8_OFFS(nxt, oAc, oBc); }
            PG8_WAIT_V(8); PG8_WAIT_L(0); PG8_BAR; PG8_MMA(0, 0, At, B0); PG8_MMA(0, 1, At, B1); PG8_BAR; PG8_SCHED;
            PG8_LDA(At, 0, 1); PG8_STAGE(PG8_SB(0, 0), gB, oBc[0], k2); PG8_STAGE(PG8_SB(0, 1), gB, oBc[1], k2); PG8_STAGE(PG8_SA(0, 0), gA, oAc[0], k2);
            PG8_WAIT_V(8); PG8_WAIT_L(0); PG8_BAR; PG8_MMA(1, 0, At, B0); PG8_MMA(1, 1, At, B1); PG8_BAR; PG8_SCHED;
            PG8_LDB(B0, 1, 0); PG8_LDB(B1, 1, 1); PG8_SCHED; PG8_LDA(At, 1, 0); PG8_STAGE(PG8_SA(0, 1), gA, oAc[1], k2);
            PG8_WAIT_V(8); PG8_WAIT_L(0); PG8_BAR; PG8_MMA(0, 0, At, B0); PG8_MMA(0, 1, At, B1); PG8_BAR; PG8_SCHED;
            PG8_LDA(At, 1, 1); PG8_STAGE(PG8_SB(1, 0), gB, oBc[0], k3); PG8_STAGE(PG8_SB(1, 1), gB, oBc[1], k3); PG8_STAGE(PG8_SA(1, 0), gA, oAc[0], k3);
            PG8_WAIT_V(8); PG8_WAIT_L(0); PG8_BAR; PG8_MMA(1, 0, At, B0); PG8_MMA(1, 1, At, B1); PG8_BAR; PG8_SCHED;
        }
        if (wr == 0) PG8_BAR;
        { const int le_ = lane_id_v(); int fr_e = le_ & 15, fq_e = le_ >> 4;
          p.epi(acc, cur, wr, wc, fr_e, fq_e); }
        if (!has_next) break;
#pragma unroll
        for (int a = 0; a < 2; ++a)
#pragma unroll
            for (int b = 0; b < 2; ++b)
#pragma unroll
                for (int m = 0; m < 4; ++m)
#pragma unroll
                    for (int n = 0; n < 2; ++n) acc[a][b][m][n] = (AccT){0, 0, 0, 0};
        cur = nxt; ++ui;
        if (wr == 1) PG8_BAR;
    }
    PG8_WAIT_V(0);
    PG8_BAR;
#undef PG8_SA
#undef PG8_SB
#undef PG8_STAGE
#undef PG8_LDA
#undef PG8_LDB
#undef PG8_MMA
#undef PG8_WAIT_V
#undef PG8_WAIT_L
#undef PG8_BAR
#undef PG8_SCHED
#undef PG8_OFFS
#undef PG8_KEYS
}
}
using pg8::Unit;

#define TROW(ai, wr, m, fr) (128 * (ai) + 64 * (wr) + 16 * (m) + (fr))
#define TCOLP(bj, wc, fq) (128 * (bj) + 32 * (wc) + 8 * (fq))
#define TCOLN(bj, wc, n, fq) (128 * (bj) + 32 * (wc) + 16 * (n) + 4 * (fq))
__device__ __forceinline__ v4u pack8(const f32x4 a, const f32x4 b) { v4u w; w.x = pk2(a[0], a[1]); w.y = pk2(a[2], a[3]); w.z = pk2(b[0], b[1]); w.w = pk2(b[2], b[3]); return w; }

__device__ __forceinline__ v2u pack8_fp8(const f32x4 a, const f32x4 b) {
    int t0 = __builtin_amdgcn_cvt_pk_fp8_f32(a[0], a[1], 0, false); t0 = __builtin_amdgcn_cvt_pk_fp8_f32(a[2], a[3], t0, true);
    int t1 = __builtin_amdgcn_cvt_pk_fp8_f32(b[0], b[1], 0, false); t1 = __builtin_amdgcn_cvt_pk_fp8_f32(b[2], b[3], t1, true); v2u o; o.x = (unsigned)t0; o.y = (unsigned)t1; return o; }
struct PolDenseBf16 {
    static constexpr bool PERM = true;
    static constexpr bool KEYS = false;
    static constexpr bool I8 = false;
    static constexpr bool F8 = false;
    __device__ __forceinline__ const int* key_ptr(const Unit&, int) const { return nullptr; }
    const char* A; const char* B; int nt; int nM, nN, pm0, G, c; unsigned pitchA, pitchB; bf16* O; int ldo;
    __device__ __forceinline__ bool next(int i, Unit& u) const { int pm, pn; if (!pg8::static_next(i, G, c, nM, nN, pm, pn)) return false; u.pm = pm + pm0; u.pn = pn; u.aux = 0; return true; }
    __device__ __forceinline__ unsigned a_row(const Unit& u, int r, int) const { return (unsigned)(u.pm * 256 + r) * pitchA; }
    __device__ __forceinline__ unsigned b_row(const Unit& u, int r) const { return (unsigned)(u.pn * 256 + r) * pitchB; }
    __device__ __forceinline__ void epi(const pg8::Acc& acc, const Unit& u, int wr, int wc, int fr, int fq) const {
#pragma unroll
        for (int ai = 0; ai < 2; ++ai)
#pragma unroll
            for (int m = 0; m < 4; ++m) { const size_t row = (size_t)u.pm * 256 + TROW(ai, wr, m, fr);
#pragma unroll
                for (int bj = 0; bj < 2; ++bj) { const int col = u.pn * 256 + TCOLP(bj, wc, fq); *(v4u*)(O + row * ldo + col) = pack8(acc[ai][bj][m][0], acc[ai][bj][m][1]); } }
    }
};

struct PolDenseI8 {
    static constexpr bool PERM = true;
    static constexpr bool KEYS = false;
    static constexpr bool I8 = true;
    static constexpr bool F8 = false;
    __device__ __forceinline__ const int* key_ptr(const Unit&, int) const { return nullptr; }
    const char* A; const char* B; int nt; int nM, nN, pm0, G, c; const float* sA; const float* sB; bf16* O; int ldo;
    __device__ __forceinline__ bool next(int i, Unit& u) const { int pm, pn; if (!pg8::static_next(i, G, c, nM, nN, pm, pn)) return false; u.pm = pm + pm0; u.pn = pn; u.aux = 0; return true; }
    __device__ __forceinline__ unsigned a_row(const Unit& u, int r, int) const { return (unsigned)(u.pm * 256 + r) * 1024u; }
    __device__ __forceinline__ unsigned b_row(const Unit& u, int r) const { return (unsigned)(u.pn * 256 + r) * 1024u; }
    __device__ __forceinline__ void epi(const pg8::AccI& acc, const Unit& u, int wr, int wc, int fr, int fq) const {
#pragma unroll
        for (int bj = 0; bj < 2; ++bj) { const int col = u.pn * 256 + TCOLP(bj, wc, fq); const f32x4 s0 = *(const f32x4*)(sB + col), s1 = *(const f32x4*)(sB + col + 4);
#pragma unroll
            for (int ai = 0; ai < 2; ++ai)
#pragma unroll
                for (int m = 0; m < 4; ++m) { const size_t row = (size_t)u.pm * 256 + TROW(ai, wr, m, fr); const float sa = sA[row]; f32x4 v0, v1;
#pragma unroll
                    for (int q = 0; q < 4; ++q) { v0[q] = (float)acc[ai][bj][m][0][q] * (sa * s0[q]); v1[q] = (float)acc[ai][bj][m][1][q] * (sa * s1[q]); }
                    *(v4u*)(O + row * ldo + col) = pack8(v0, v1); } }
    }
};

struct PolOut {
    static constexpr bool PERM = true;
    static constexpr bool KEYS = false;
    static constexpr bool I8 = false;
    static constexpr bool F8 = true;
    __device__ __forceinline__ const int* key_ptr(const Unit&, int) const { return nullptr; }
    const char* A; const char* B; int nt; int nM, nN, pm0, G, c; bf16* X; const float* mod;
    int chunk;
    __device__ __forceinline__ bool next(int i, Unit& u) const { int pm, pn; if (!pg8::static_next(i, G, c, nM, nN, pm, pn)) return false; u.pm = pm + pm0; u.pn = pn; u.aux = 0; return true; }
    __device__ __forceinline__ unsigned a_row(const Unit& u, int r, int) const { return (unsigned)(u.pm * 256 + r) * 1024u; }
    __device__ __forceinline__ unsigned b_row(const Unit& u, int r) const { return (unsigned)(u.pn * 256 + r) * 1024u; }
    __device__ __forceinline__ void epi(const pg8::Acc& acc, const Unit& u, int wr, int wc, int fr, int fq) const {
        const int mr = modrow_of(u.pm * 256);
        const float* g = mod + (size_t)mr * (NMOD * D) + chunk * D;
#pragma unroll
        for (int bj = 0; bj < 2; ++bj) { const int col = u.pn * 256 + TCOLP(bj, wc, fq); const f32x4 g0 = *(const f32x4*)(g + col), g1 = *(const f32x4*)(g + col + 4);
#pragma unroll
            for (int ai = 0; ai < 2; ++ai)
#pragma unroll
                for (int m = 0; m < 4; ++m) { const size_t off = ((size_t)u.pm * 256 + TROW(ai, wr, m, fr)) * D + col; f32x4 x0, x1;
                    { const v4u w = *(const v4u*)(X + off); x0 = (f32x4){bf_lo(w.x), bf_hi(w.x), bf_lo(w.y), bf_hi(w.y)}; x1 = (f32x4){bf_lo(w.z), bf_hi(w.z), bf_lo(w[3]), bf_hi(w[3])}; }
                    *(v4u*)(X + off) = pack8(x0 + g0 * acc[ai][bj][m][0], x1 + g1 * acc[ai][bj][m][1]); } }
    }
};

struct PolFP {
    static constexpr bool PERM = true;
    static constexpr bool KEYS = false;
    static constexpr bool I8 = true;
    static constexpr bool F8 = false;
    __device__ __forceinline__ const int* key_ptr(const Unit&, int) const { return nullptr; }
    const char* A; const char* B; int nt; int nN, G, c; const float* sW; const float* sH; bf16* Z; bf16* Zc;
    __device__ __forceinline__ bool next(int i, Unit& u) const { int pm, pn; if (!pg8::static_next(i, G, c, 8, nN, pm, pn)) return false; u.pm = pm; u.pn = pn; u.aux = 0; return true; }
    __device__ __forceinline__ unsigned a_row(const Unit& u, int r, int) const { return (unsigned)(u.pm * 256 + r) * 1024u; }
    __device__ __forceinline__ int tok_row(int pn, int n) const { if (pn < 128) { const int b = n >> 12, l2 = (n >> 6) & 63, l1 = n & 63; return NC + b * SEQ + 64 * l1 + l2; } return n - 32768; }
    __device__ __forceinline__ unsigned b_row(const Unit& u, int r) const { return (unsigned)tok_row(u.pn, u.pn * 256 + r) * 1024u; }
    __device__ __forceinline__ void epi(const pg8::AccI& acc, const Unit& u, int wr, int wc, int fr, int fq) const {
#pragma unroll
        for (int bj = 0; bj < 2; ++bj) { const int n0 = u.pn * 256 + TCOLP(bj, wc, fq);
            f32x4 h0, h1;
#pragma unroll
            for (int q = 0; q < 4; ++q) { h0[q] = sH[tok_row(u.pn, n0 + q)]; h1[q] = sH[tok_row(u.pn, n0 + 4 + q)]; }
#pragma unroll
            for (int ai = 0; ai < 2; ++ai)
#pragma unroll
                for (int m = 0; m < 4; ++m) { const int cp = u.pm * 256 + TROW(ai, wr, m, fr); const float sw = sW[cp]; f32x4 v0, v1;
#pragma unroll
                    for (int q = 0; q < 4; ++q) { v0[q] = (float)acc[ai][bj][m][0][q] * (sw * h0[q]); v1[q] = (float)acc[ai][bj][m][1][q] * (sw * h1[q]); }
                    const v4u w = pack8(v0, v1);
                    if (u.pn < 128) *(v4u*)(Z + ((size_t)(n0 >> 6) * 2048 + cp) * 64 + (n0 & 63)) = w;
                    else { const int b = u.pn - 128, l = n0 - 32768 - b * 256; *(v4u*)(Zc + ((size_t)b * 2048 + cp) * 256 + l) = w; } } }
    }
};

struct PolFA {
    static constexpr bool PERM = true;
    static constexpr bool KEYS = false;
    static constexpr bool I8 = false;
    static constexpr bool F8 = false;
    __device__ __forceinline__ const int* key_ptr(const Unit&, int) const { return nullptr; }
    const char* A; const char* B; int nt; int G, c; bf16* Y;
    __device__ __forceinline__ bool next(int i, Unit& u) const { const int L = i * G + c; if (L >= 1024) return false; u.pm = 0; u.pn = L & 127; u.aux = L >> 7; return true; }
    __device__ __forceinline__ unsigned a_row(const Unit&, int r, int) const { return (unsigned)r * 512u; }
    __device__ __forceinline__ unsigned b_row(const Unit& u, int r) const { const int l2 = r & 63, cp = u.pn * 4 + (r >> 6); return (unsigned)((u.aux * 64 + l2) * 512 + cp) * 512u; }
    __device__ __forceinline__ void epi(const pg8::Acc& acc, const Unit& u, int wr, int wc, int fr, int fq) const {
        const int b = u.aux;
#pragma unroll
        for (int ai = 0; ai < 2; ++ai)
#pragma unroll
            for (int m = 0; m < 4; ++m) { const int rr = TROW(ai, wr, m, fr), jp = rr >> 7, pp = (rr >> 6) & 1, k1 = rr & 63;
#pragma unroll
                for (int bj = 0; bj < 2; ++bj) { const int n0 = u.pn * 256 + TCOLP(bj, wc, fq), cp = n0 >> 6, l2 = n0 & 63, cc = 2 * cp + jp;
                    const size_t idx = ((((size_t)(b * 16 + (k1 >> 2)) * 1024 + cc) * 4 + (k1 & 3)) * 2 + pp) * 64 + l2;
                    *(v4u*)(Y + idx) = pack8(acc[ai][bj][m][0], acc[ai][bj][m][1]); } }
    }
};

struct PolFC {
    static constexpr bool PERM = true;
    static constexpr bool KEYS = false;
    static constexpr bool I8 = false;
    static constexpr bool F8 = false;
    __device__ __forceinline__ const int* key_ptr(const Unit&, int) const { return nullptr; }
    const char* A; const char* B; int nt; int G, c; int nunits; unsigned offMC, offZc; unsigned char* F;
    __device__ __forceinline__ bool next(int i, Unit& u) const { const int L = i * G + c; if (L >= nunits) return false;
        if (L < 512) { u.pm = 0; u.pn = L & 3; u.aux = L >> 2; } else { const int q = L - 512; u.pm = 0; u.pn = q & 3; u.aux = 256 + (q >> 2); } return true; }
    __device__ __forceinline__ unsigned a_row(const Unit& u, int r, int) const {
        if (u.aux < 256) return offMC + (unsigned)((u.aux & 15) * 256 + r) * 1024u;
        return (unsigned)r * 1024u; }
    __device__ __forceinline__ unsigned b_row(const Unit& u, int r) const {
        if (u.aux < 256) return (unsigned)(u.aux * 1024 + u.pn * 256 + r) * 1024u;
        return offZc + (unsigned)((u.aux - 256) * 1024 + u.pn * 256 + r) * 1024u; }
    __device__ __forceinline__ void epi(const pg8::Acc& acc, const Unit& u, int wr, int wc, int fr, int fq) const {
#pragma unroll
        for (int ai = 0; ai < 2; ++ai)
#pragma unroll
            for (int m = 0; m < 4; ++m) { const int rr = TROW(ai, wr, m, fr); size_t frow;
                if (u.aux < 256) { const int b = u.aux >> 4, kq = u.aux & 15, k = 4 * kq + (rr >> 6) + 64 * (rr & 63); frow = (size_t)NC + b * SEQ + k; }
                else frow = (size_t)(u.aux - 256) * LCTX + rr;
#pragma unroll
                for (int bj = 0; bj < 2; ++bj) { const int col = u.pn * 256 + TCOLP(bj, wc, fq); *(v2u*)(F + frow * D + col) = pack8_fp8(acc[ai][bj][m][0], acc[ai][bj][m][1]); } }
    }
};

struct PolMlaQ {
    static constexpr bool PERM = true;
    static constexpr bool KEYS = false;
    static constexpr bool I8 = false;
    static constexpr bool F8 = false;
    __device__ __forceinline__ const int* key_ptr(const Unit&, int) const { return nullptr; }
    const char* A; const char* B; int nt; int nM, nN, G, c; bf16* Q; const float* rope; float c2;
    __device__ __forceinline__ bool next(int i, Unit& u) const { int pm, pn; if (!pg8::static_next(i, G, c, nM, nN, pm, pn)) return false; u.pm = pm; u.pn = pn; u.aux = 0; return true; }
    __device__ __forceinline__ unsigned a_row(const Unit& u, int r, int) const { return (unsigned)(u.pm * 256 + r) * (unsigned)(MLA_QL * 2); }
    __device__ __forceinline__ unsigned b_row(const Unit& u, int r) const { return (unsigned)(u.pn * 256 + r) * (unsigned)(MLA_QL * 2); }
    __device__ __forceinline__ void epi(const pg8::Acc& acc, const Unit& u, int wr, int wc, int fr, int fq) const {
        const bool lat = u.pm >= 8;
#pragma unroll
        for (int bj = 0; bj < 2; ++bj) { const int col = u.pn * 256 + TCOLP(bj, wc, fq); const bool isrope = lat && (((col >> 5) % 3) == 2);
#pragma unroll
            for (int ai = 0; ai < 2; ++ai)
#pragma unroll
                for (int m = 0; m < 4; ++m) { const int row = u.pm * 256 + TROW(ai, wr, m, fr); f32x4 v0 = acc[ai][bj][m][0], v1 = acc[ai][bj][m][1];
                    if (isrope) { const int t = (row - NC) & 4095, pos = (fq & 2) ? (t & 63) : (t >> 6);
                        const f32x4* rp = (const f32x4*)(rope + (size_t)pos * 16);
                        const f32x4 r0 = rp[0], r1 = rp[1], r2 = rp[2], r3 = rp[3];
                        f32x4 p0, p1;
#pragma unroll
                        for (int e = 0; e < 4; ++e) { p0[e] = shx(v0[e], 16, fq * 16 + fr); p1[e] = shx(v1[e], 16, fq * 16 + fr); }
                        const float sg = (fq & 1) ? 1.f : -1.f;
                        v0[0] = v0[0] * r0[0] + sg * p0[0] * r0[1]; v0[1] = v0[1] * r0[2] + sg * p0[1] * r0[3];
                        v0[2] = v0[2] * r1[0] + sg * p0[2] * r1[1]; v0[3] = v0[3] * r1[2] + sg * p0[3] * r1[3];
                        v1[0] = v1[0] * r2[0] + sg * p1[0] * r2[1]; v1[1] = v1[1] * r2[2] + sg * p1[1] * r2[3];
                        v1[2] = v1[2] * r3[0] + sg * p1[2] * r3[1]; v1[3] = v1[3] * r3[2] + sg * p1[3] * r3[3]; }
                    *(v4u*)(Q + (size_t)row * 1536 + col) = pack8(v0 * c2, v1 * c2); } }
    }
};

struct PolMlaKV {
    static constexpr bool PERM = true;
    static constexpr bool KEYS = false;
    static constexpr bool I8 = false;
    static constexpr bool F8 = false;
    __device__ __forceinline__ const int* key_ptr(const Unit&, int) const { return nullptr; }
    const char* A; const char* B; int nt; int nM, nN, G, c; bf16* Kb; bf16* Vb;
    __device__ __forceinline__ bool next(int i, Unit& u) const { int pm, pn; if (!pg8::static_next(i, G, c, nM, nN, pm, pn)) return false; u.pm = pm; u.pn = pn; u.aux = 0; return true; }
    __device__ __forceinline__ unsigned a_row(const Unit& u, int r, int) const { return (unsigned)(u.pm * 256 + r) * 512u; }
    __device__ __forceinline__ unsigned b_row(const Unit& u, int r) const { return (unsigned)(u.pn * 256 + r) * 512u; }
    __device__ __forceinline__ void epi(const pg8::Acc& acc, const Unit& u, int wr, int wc, int fr, int fq) const {
#pragma unroll
        for (int bj = 0; bj < 2; ++bj) { const int col = u.pn * 256 + TCOLP(bj, wc, fq), h = col >> 7, j = col & 127;
#pragma unroll
            for (int ai = 0; ai < 2; ++ai)
#pragma unroll
                for (int m = 0; m < 4; ++m) { const size_t row = (size_t)u.pm * 256 + TROW(ai, wr, m, fr); const v4u w = pack8(acc[ai][bj][m][0], acc[ai][bj][m][1]);
                    if (j < 64) *(v4u*)(Kb + row * 1536 + 96 * h + j) = w; else *(v4u*)(Vb + row * 1024 + 64 * h + (j - 64)) = w; } }
    }
};

struct MoeTab { const LAS int* TT; const LAS int* CN; const LAS int* TE; };
__device__ __forceinline__ bool moe_next(int i, int G, int c, int NP, const MoeTab& T, Unit& u) {
    const int ttot = T.TT[32];
    int lo, hi, j;
    if ((G & 7) == 0) { const int x = c & 7, q = c >> 3, g8 = G >> 3; lo = (x * ttot) >> 3; hi = ((x + 1) * ttot) >> 3; j = i * g8 + q; }
    else { lo = 0; hi = ttot; j = i * G + c; }
    if (j >= (hi - lo) * NP) return false;
    const int tile = lo + j / NP; u.pn = j % NP; u.pm = tile;
    const int e = T.TE[tile];
    u.aux = e | ((tile - T.TT[e]) << 8);
    return true;
}
struct PolMoe1 {
    static constexpr bool PERM = true;
    static constexpr bool I8 = true;
    static constexpr bool F8 = false;
    const char* A; const char* B; int nt; int G, c; MoeTab T; const int* stok; const float* bgu; const float* swgu; const float* ssc; unsigned char* act;
    __device__ __forceinline__ bool next(int i, Unit& u) const { return moe_next(i, G, c, 8, T, u); }
    static constexpr bool KEYS = true;
    __device__ __forceinline__ const int* key_ptr(const Unit& u, int r) const { const int e = u.aux & 255, idx = (u.aux >> 8) * 256 + r; const int cn = T.CN[e]; return stok + (size_t)e * CAP + (idx < cn ? idx : 0); }
    __device__ __forceinline__ unsigned a_row(const Unit&, int, int key) const { return (unsigned)key * 1024u; }
    __device__ __forceinline__ unsigned b_row(const Unit& u, int r) const { return (unsigned)((u.aux & 255) * 2048 + u.pn * 256 + r) * 1024u; }
    __device__ __forceinline__ void epi(const pg8::AccI& acc, const Unit& u, int wr, int wc, int fr, int fq) const {
        const int e = u.aux & 255, mt = u.aux >> 8, cn = T.CN[e]; const int jl = 32 * wc + 8 * fq;
        const float* bg = bgu + (size_t)e * 2048 + u.pn * 256 + jl;
        const float* sg = swgu + (size_t)e * 2048 + u.pn * 256 + jl;
        const f32x4 bg0 = *(const f32x4*)(bg), bg1 = *(const f32x4*)(bg + 4), bu0 = *(const f32x4*)(bg + 128), bu1 = *(const f32x4*)(bg + 132);
        const f32x4 sg0 = *(const f32x4*)(sg), sg1 = *(const f32x4*)(sg + 4), su0 = *(const f32x4*)(sg + 128), su1 = *(const f32x4*)(sg + 132);
#pragma unroll
        for (int ai = 0; ai < 2; ++ai)
#pragma unroll
            for (int m = 0; m < 4; ++m) { const int rr = TROW(ai, wr, m, fr), idx = mt * 256 + rr; const size_t slot = (size_t)u.pm * 256 + rr;
                const float sa = ssc[(size_t)e * CAP + (idx < cn ? idx : 0)];
                f32x4 o0, o1;
#define MOE1_ACT(OUT, N, SG, BG, SU, BU) do { _Pragma("unroll") for (int hq = 0; hq < 2; ++hq) { \
                    const f32x2 ag = {(float)acc[ai][0][m][N][2 * hq], (float)acc[ai][0][m][N][2 * hq + 1]}, au = {(float)acc[ai][1][m][N][2 * hq], (float)acc[ai][1][m][N][2 * hq + 1]}; \
                    const f32x2 sgp = {SG[2 * hq], SG[2 * hq + 1]}, bgp = {BG[2 * hq], BG[2 * hq + 1]}, sup = {SU[2 * hq], SU[2 * hq + 1]}, bup = {BU[2 * hq], BU[2 * hq + 1]}; \
                    f32x2 g = __builtin_elementwise_fma(ag, sgp * sa, bgp), u = __builtin_elementwise_fma(au, sup * sa, bup); \
                    g[0] = fminf(g[0], 7.f); g[1] = fminf(g[1], 7.f); u[0] = __builtin_amdgcn_fmed3f(u[0], -7.f, 7.f); u[1] = __builtin_amdgcn_fmed3f(u[1], -7.f, 7.f); \
                    const f32x2 z = g * (-1.702f * LOG2E); f32x2 e; e[0] = __builtin_amdgcn_exp2f(z[0]); e[1] = __builtin_amdgcn_exp2f(z[1]); \
                    const f32x2 dd = e + 1.f; f32x2 r; r[0] = __builtin_amdgcn_rcpf(dd[0]); r[1] = __builtin_amdgcn_rcpf(dd[1]); \
                    const f32x2 o = ((u + 1.f) * g) * r; OUT[2 * hq] = o[0]; OUT[2 * hq + 1] = o[1]; } } while (0)
                MOE1_ACT(o0, 0, sg0, bg0, su0, bu0); MOE1_ACT(o1, 1, sg1, bg1, su1, bu1);
#undef MOE1_ACT
                v2u w8; { int t0 = __builtin_amdgcn_cvt_pk_fp8_f32(o0[0], o0[1], 0, false); t0 = __builtin_amdgcn_cvt_pk_fp8_f32(o0[2], o0[3], t0, true);
                          int t1 = __builtin_amdgcn_cvt_pk_fp8_f32(o1[0], o1[1], 0, false); t1 = __builtin_amdgcn_cvt_pk_fp8_f32(o1[2], o1[3], t1, true); w8.x = (unsigned)t0; w8.y = (unsigned)t1; }
                *(v2u*)(act + slot * 1024 + u.pn * 128 + jl) = w8; }
    }
};
struct PolMoe2 {
    static constexpr bool PERM = true;
    static constexpr bool KEYS = false;
    static constexpr bool I8 = false;
    static constexpr bool F8 = true;
    __device__ __forceinline__ const int* key_ptr(const Unit&, int) const { return nullptr; }
    const char* A; const char* B; int nt; int G, c; MoeTab T; const float* sw; const float* bdn; const float* swd; unsigned char* Y;
    __device__ __forceinline__ bool next(int i, Unit& u) const { return moe_next(i, G, c, 4, T, u); }
    __device__ __forceinline__ unsigned a_row(const Unit& u, int r, int) const { return (unsigned)(u.pm * 256 + r) * 1024u; }
    __device__ __forceinline__ unsigned b_row(const Unit& u, int r) const { return (unsigned)((u.aux & 255) * 1024 + u.pn * 256 + r) * 1024u; }
    __device__ __forceinline__ void epi(const pg8::Acc& acc, const Unit& u, int wr, int wc, int fr, int fq) const {
        const int e = u.aux & 255, mt = u.aux >> 8, cn = T.CN[e];
#pragma unroll
        for (int bj = 0; bj < 2; ++bj) { const int col = u.pn * 256 + TCOLP(bj, wc, fq); const size_t ci = (size_t)e * 1024 + col;
            const f32x4 b0 = *(const f32x4*)(bdn + ci), b1 = *(const f32x4*)(bdn + ci + 4), s0 = *(const f32x4*)(swd + ci), s1 = *(const f32x4*)(swd + ci + 4);
#pragma unroll
            for (int ai = 0; ai < 2; ++ai)
#pragma unroll
                for (int m = 0; m < 4; ++m) { const int rr = TROW(ai, wr, m, fr), idx = mt * 256 + rr; const size_t slot = (size_t)u.pm * 256 + rr; const float w = sw[(size_t)e * CAP + (idx < cn ? idx : 0)];
                    const float w8 = w * 8.f; f32x4 y0 = (acc[ai][bj][m][0] * s0 + b0) * w8, y1 = (acc[ai][bj][m][1] * s1 + b1) * w8;
#pragma unroll
                    for (int q = 0; q < 4; ++q) { y0[q] = fminf(fmaxf(y0[q], -448.f), 448.f); y1[q] = fminf(fmaxf(y1[q], -448.f), 448.f); }
                    v2u o8; { int t0 = __builtin_amdgcn_cvt_pk_fp8_f32(y0[0], y0[1], 0, false); t0 = __builtin_amdgcn_cvt_pk_fp8_f32(y0[2], y0[3], t0, true);
                              int t1 = __builtin_amdgcn_cvt_pk_fp8_f32(y1[0], y1[1], 0, false); t1 = __builtin_amdgcn_cvt_pk_fp8_f32(y1[2], y1[3], t1, true); o8.x = (unsigned)t0; o8.y = (unsigned)t1; }
                    *(v2u*)(Y + slot * 1024 + col) = o8; } }
    }
};

namespace att {
__device__ __forceinline__ int crow(int r, int hi) { return (r & 3) + 8 * (r >> 2) + 4 * hi; }
__device__ __forceinline__ float max3f(float a, float b, float c) { return fmaxf(fmaxf(a, b), c); }
typedef LAS const char* lds_cptr;
constexpr int LK = 0, LV = 49152, LWS = 90112, LOST = 92160, LBYTES = 124928;
constexpr int PD = 3;
struct Tens { const bf16* Q; int qpitch; const bf16* K; int kpitch; const bf16* V; int vpitch; bf16* O; };
#define ATT_WAITV(n) asm volatile("s_waitcnt vmcnt(" #n ")" ::: "memory")
struct Pend { f32x16 o0, o1; float l; int qrow0, oc0; bool valid; };
__device__ __forceinline__ void finish_unit(const Pend& P, bf16* O, LAS unsigned char* lds, int wid, int lane) {
    const int r32 = lane & 31, hi = lane >> 5;
    LAS float* wsf = (LAS float*)(lds + LWS) + wid * 64;
    float lrun = P.l;
    { auto rr = __builtin_amdgcn_permlane32_swap(__float_as_uint(lrun), __float_as_uint(lrun), false, false); lrun = __uint_as_float(rr[0]) + __uint_as_float(rr[1]); }
    if (hi == 0) wsf[32 + r32] = lrun;
    LDS_WAIT();
    LAS bf16* stg = (LAS bf16*)(lds + LOST) + wid * 2048;
#pragma unroll
    for (int r = 0; r < 16; ++r) { const int orow = crow(r, hi); const float rl = __builtin_amdgcn_rcpf(wsf[32 + orow]);
        stg[orow * 64 + r32] = (bf16)(pk2(P.o0[r] * rl, 0.f) & 0xffffu); stg[orow * 64 + 32 + r32] = (bf16)(pk2(P.o1[r] * rl, 0.f) & 0xffffu); }
    LDS_WAIT();
    bf16* Ow = O + (size_t)(P.qrow0 + wid * 32) * 1024 + P.oc0;
#pragma unroll
    for (int i = 0; i < 4; ++i) { const int row = i * 8 + (lane >> 3), ch = lane & 7; const v4u v = *(const LAS v4u*)(stg + row * 64 + ch * 8); *(v4u*)(Ow + (size_t)row * 1024 + ch * 8) = v; }
    LDS_WAIT();
}
template <int DK>
__device__ __forceinline__ void unit(const Tens& T, int qrow0, int qc0, int kc0, int vc0, int oc0, int kctx0, int klat0, int NTL, LAS unsigned char* lds, int wave_id, Pend& pend) {
    constexpr int ND = DK / 16;
    wave_id = launder_s(wave_id); const int tid = lthread_w(wave_id), lane = tid & 63, r32 = lane & 31, hi = lane >> 5; const int wid = wave_id;
    LAS float* wsf = (LAS float*)(lds + LWS) + wid * 64;
    const bf16* ksrc = T.K + (size_t)lane * T.kpitch + kc0 + wid * 8;
    const int k2off = (8 + (wid & 3) - wid) * 8;
    const bf16* vsrc = T.V + (size_t)(16 * (wid & 3) + (lane >> 2)) * T.vpitch + vc0 + (wid >> 2) * 32 + (lane & 3) * 8;
#define ATT_DMA(t, ks_, vs_) do { const size_t row0_ = (size_t)((t) < 4 ? kctx0 + 64 * (t) : klat0 + 64 * ((t) - 4)); \
        __builtin_amdgcn_global_load_lds((const unsigned*)(ksrc + row0_ * T.kpitch), (LAS unsigned*)(lds + LK + (ks_) * 12288 + wid * 1024), 16, 0, 0); \
        if (DK > 64) __builtin_amdgcn_global_load_lds((const unsigned*)(ksrc + row0_ * T.kpitch + k2off), (LAS unsigned*)(lds + LK + (ks_) * 12288 + 8192 + (wid & 3) * 1024), 16, 0, 0); \
        __builtin_amdgcn_global_load_lds((const unsigned*)(vsrc + row0_ * T.vpitch), (LAS unsigned*)(lds + LV + (vs_) * 8192 + wid * 1024), 16, 0, 0); } while (0)
#define ATT_WAIT_TILES(n_tiles) do { if (DK > 64) { if ((n_tiles) >= 2) ATT_WAITV(6); else if ((n_tiles) == 1) ATT_WAITV(3); else ATT_WAITV(0); } \
        else { if ((n_tiles) >= 2) ATT_WAITV(4); else if ((n_tiles) == 1) ATT_WAITV(2); else ATT_WAITV(0); } } while (0)
    bf16x8 qr[ND];
    { const bf16* qp = T.Q + (size_t)(qrow0 + wid * 32 + r32) * T.qpitch + qc0 + hi * 8;
#pragma unroll
      for (int d0 = 0; d0 < ND; ++d0) qr[d0] = *(const bf16x8*)(qp + d0 * 16); }
    asm volatile("" ::: "memory");
    constexpr float THR = 8.f;
    const int half = wid >> 2;
    float mhat = 0.f, lrun = 0.f; f32x16 o[2]; o[0] = f32x16{}; o[1] = f32x16{}; f32x16 negm = f32x16{};
    f32x16 p0 = f32x16{}, p1 = f32x16{}; v4u pw[4]; pw[0] = pw[1] = pw[2] = pw[3] = (v4u){0u, 0u, 0u, 0u};
    ATT_DMA(0, 0, 0); ATT_DMA(1, 1, 1); ATT_DMA(2, 2, 2);
    if (pend.valid) finish_unit(pend, T.O, lds, wid, lane);
    ATT_WAIT_TILES(2);
    __builtin_amdgcn_s_barrier(); asm volatile("" ::: "memory");
    if (half == 1) __builtin_amdgcn_s_barrier();
    int vs_prev = 0, vs_cur = 0, vs_iss = 3;
    for (int t = 0; t <= NTL; ++t) {
        if (t >= 1) {
            s16x4 lo[2][4], hh[2][4];
            const unsigned vb = (unsigned)(uintptr_t)(lds + LV + vs_prev * 8192) + ((lane >> 4) & 1) * 32 + (lane & 3) * 8 + (4 * hi + ((lane & 15) >> 2)) * 64;
#pragma unroll
            for (int d0 = 0; d0 < 2; ++d0)
#pragma unroll
                for (int ks = 0; ks < 4; ++ks) {
                    asm volatile("ds_read_b64_tr_b16 %0,%1 offset:%c2" : "=&v"(lo[d0][ks]) : "v"(vb), "i"(d0 * 4096 + ks * 1024) : "memory");
                    asm volatile("ds_read_b64_tr_b16 %0,%1 offset:%c2" : "=&v"(hh[d0][ks]) : "v"(vb), "i"(d0 * 4096 + ks * 1024 + 512) : "memory"); }
            asm volatile("s_waitcnt lgkmcnt(0)" ::: "memory"); __builtin_amdgcn_sched_barrier(0);
#pragma unroll
            for (int ks = 0; ks < 4; ++ks)
#pragma unroll
                for (int d0 = 0; d0 < 2; ++d0) { const bf16x8 vf = (bf16x8){lo[d0][ks][0], lo[d0][ks][1], lo[d0][ks][2], lo[d0][ks][3], hh[d0][ks][0], hh[d0][ks][1], hh[d0][ks][2], hh[d0][ks][3]};
                    o[d0] = __builtin_amdgcn_mfma_f32_32x32x16_bf16(__builtin_bit_cast(bf16x8, pw[ks]), vf, o[d0], 0, 0, 0); }
        }
        if (t < NTL) {
            bf16x8 kf[2 * ND];
            const lds_cptr kb = (lds_cptr)(lds + LK + (t & 3) * 12288) + hi * 1024 + r32 * 16;
#pragma unroll
            for (int d0 = 0; d0 < ND; ++d0) { kf[2 * d0] = *(const LAS bf16x8*)(kb + d0 * 2048); kf[2 * d0 + 1] = *(const LAS bf16x8*)(kb + d0 * 2048 + 512); }
            asm volatile("s_waitcnt lgkmcnt(0)" ::: "memory"); __builtin_amdgcn_sched_barrier(0);
#pragma unroll
            for (int d0 = 0; d0 < ND; ++d0) {
                if (d0 == 0) { p0 = __builtin_amdgcn_mfma_f32_32x32x16_bf16(kf[0], qr[0], negm, 0, 0, 0); p1 = __builtin_amdgcn_mfma_f32_32x32x16_bf16(kf[1], qr[0], negm, 0, 0, 0); }
                else { p0 = __builtin_amdgcn_mfma_f32_32x32x16_bf16(kf[2 * d0], qr[d0], p0, 0, 0, 0); p1 = __builtin_amdgcn_mfma_f32_32x32x16_bf16(kf[2 * d0 + 1], qr[d0], p1, 0, 0, 0); } }
        }
        if (half == 1) {
            const int last_iss = (t + PD - 1 < NTL - 1) ? t + PD - 1 : NTL - 1; const int allow = last_iss - (t + 1);
            if (allow >= 1) ATT_WAIT_TILES(1); else ATT_WAIT_TILES(0); }
        asm volatile("s_waitcnt lgkmcnt(0)" ::: "memory"); __builtin_amdgcn_s_barrier(); asm volatile("" ::: "memory");
        if (t < NTL) {
            float rm = max3f(p0[0], p0[1], p1[0]);
#pragma unroll
            for (int r = 0; r < 16; ++r) rm = max3f(rm, p0[r], p1[r]);
            { auto rr = __builtin_amdgcn_permlane32_swap(__float_as_uint(rm), __float_as_uint(rm), false, false); rm = fmaxf(__uint_as_float(rr[0]), __uint_as_float(rr[1])); }
            if (t == 0 || __any(rm > THR)) {
                const float dl = (t == 0) ? rm : fmaxf(rm, 0.f);
                mhat += dl;
#pragma unroll
                for (int r = 0; r < 16; ++r) { p0[r] -= dl; p1[r] -= dl; negm[r] = -mhat; }
                const float f = (t == 0) ? 1.f : __builtin_amdgcn_exp2f(-dl); lrun *= f;
                if (hi == 0) wsf[r32] = f;
                LDS_WAIT();
#pragma unroll
                for (int r = 0; r < 16; ++r) { const float a = wsf[crow(r, hi)]; o[0][r] *= a; o[1][r] *= a; }
            }
            float rs = 0.f;
#pragma unroll
            for (int r = 0; r < 16; ++r) { p0[r] = __builtin_amdgcn_exp2f(p0[r]); p1[r] = __builtin_amdgcn_exp2f(p1[r]); rs += p0[r] + p1[r]; }
            lrun += rs;
            pw[0] = (v4u){pk2(p0[0], p0[1]), pk2(p0[2], p0[3]), pk2(p0[4], p0[5]), pk2(p0[6], p0[7])};
            pw[1] = (v4u){pk2(p0[8], p0[9]), pk2(p0[10], p0[11]), pk2(p0[12], p0[13]), pk2(p0[14], p0[15])};
            pw[2] = (v4u){pk2(p1[0], p1[1]), pk2(p1[2], p1[3]), pk2(p1[4], p1[5]), pk2(p1[6], p1[7])};
            pw[3] = (v4u){pk2(p1[8], p1[9]), pk2(p1[10], p1[11]), pk2(p1[12], p1[13]), pk2(p1[14], p1[15])};
        }
        if (t + PD < NTL) { ATT_DMA(t + PD, (t + PD) & 3, vs_iss); vs_iss = (vs_iss == 4) ? 0 : vs_iss + 1; }
        if (half == 0) {
            const int last_iss = (t + PD < NTL - 1) ? t + PD : NTL - 1; const int allow = last_iss - (t + 1);
            if (allow >= 2) ATT_WAIT_TILES(2); else if (allow == 1) ATT_WAIT_TILES(1); else ATT_WAIT_TILES(0); }
        vs_prev = vs_cur; vs_cur = (vs_cur == 4) ? 0 : vs_cur + 1;
        asm volatile("s_waitcnt lgkmcnt(0)" ::: "memory"); __builtin_amdgcn_s_barrier(); asm volatile("" ::: "memory");
    }
    if (half == 0) __builtin_amdgcn_s_barrier();
#undef ATT_DMA
#undef ATT_WAIT_TILES
    pend.o0 = o[0]; pend.o1 = o[1]; pend.l = lrun; pend.qrow0 = qrow0; pend.oc0 = oc0; pend.valid = true;
}
#undef ATT_WAITV
}

namespace att64 {
typedef unsigned short bf16;
using bf16x8=__attribute__((ext_vector_type(8)))short;
using s16x4=__attribute__((ext_vector_type(4)))short;
using f32x16=__attribute__((ext_vector_type(16)))float;
using u32x4=__attribute__((ext_vector_type(4)))unsigned;
constexpr int D=64;
constexpr int NW=8,QBLK=32,QB=QBLK*NW,KVBLK=64;
__device__ __forceinline__ int crow(int r,int hi){return (r&3)+8*(r>>2)+4*hi;}
#define SBAR() __builtin_amdgcn_sched_barrier(0)
constexpr int NSLOT=3, SLOTB=8192;
constexpr int LDS_K=0, LDS_V=NSLOT*SLOTB, LDS_WS=2*NSLOT*SLOTB, LDS_OST=LDS_WS+NW*64*4, LDS_BYTES=LDS_OST+NW*4096;
constexpr float C2=0.125f*1.4426950408889634f;
__device__ __forceinline__ void glds16(const void*gsrc,unsigned lds_dst){unsigned keep;
  asm volatile("s_mov_b32 %0, m0\n\ts_mov_b32 m0, %2\n\ts_nop 0\n\tglobal_load_lds_dwordx4 %1, off\n\ts_mov_b32 m0, %0":"=&s"(keep):"v"(gsrc),"s"(lds_dst):"memory");}
__device__ __forceinline__ float max3f(float a,float b,float c){float r;asm("v_max3_f32 %0, %1, %2, %3":"=v"(r):"v"(a),"v"(b),"v"(c));return r;}
__device__ __forceinline__ float max2f(float a,float b){float r;asm("v_max_f32_e32 %0, %1, %2":"=v"(r):"v"(a),"v"(b));return r;}
__device__ __forceinline__ float fadd_s(float a,float b){float r;asm("v_add_f32_e32 %0, %1, %2":"=v"(r):"v"(a),"v"(b));return r;}
__device__ __forceinline__ float fsub_s(float a,float b){float r;asm("v_sub_f32_e32 %0, %1, %2":"=v"(r):"v"(a),"v"(b));return r;}
typedef float f32x2_t __attribute__((ext_vector_type(2))); typedef __bf16 bf16x2_t __attribute__((ext_vector_type(2)));
__device__ __forceinline__ unsigned cvtpk_s(float lo,float hi){f32x2_t v={lo,hi};bf16x2_t b=__builtin_convertvector(v,bf16x2_t);return __builtin_bit_cast(unsigned,b);}
#define WAIT_BAR(N) asm volatile("s_waitcnt vmcnt(" #N ") lgkmcnt(0)\n\ts_barrier":::"memory")

__device__ __forceinline__ void qkt(f32x16&p0,f32x16&p1,const char*Kslot,const bf16x8*qr,const f32x16&negm,int r32,int hi){
  const char*kb=Kslot+hi*1024+r32*16;
  #pragma unroll
  for(int d0=0;d0<4;++d0){
    const bf16x8 b0=*reinterpret_cast<const bf16x8*>(kb+d0*2048);
    const bf16x8 b1=*reinterpret_cast<const bf16x8*>(kb+d0*2048+512);
    if(d0==0){p0=__builtin_amdgcn_mfma_f32_32x32x16_bf16(b0,qr[0],negm,0,0,0);p1=__builtin_amdgcn_mfma_f32_32x32x16_bf16(b1,qr[0],negm,0,0,0);}
    else{p0=__builtin_amdgcn_mfma_f32_32x32x16_bf16(b0,qr[d0],p0,0,0,0);p1=__builtin_amdgcn_mfma_f32_32x32x16_bf16(b1,qr[d0],p1,0,0,0);}}
}
typedef __attribute__((address_space(3))) const char* lds_cptr;
typedef short v4i16_t __attribute__((ext_vector_type(4)));
__device__ __forceinline__ void kload8(bf16x8*kf,lds_cptr kp){
  kf[0]=*(const __attribute__((address_space(3))) bf16x8*)(kp);      kf[1]=*(const __attribute__((address_space(3))) bf16x8*)(kp+512);
  kf[2]=*(const __attribute__((address_space(3))) bf16x8*)(kp+2048); kf[3]=*(const __attribute__((address_space(3))) bf16x8*)(kp+2560);
  kf[4]=*(const __attribute__((address_space(3))) bf16x8*)(kp+4096); kf[5]=*(const __attribute__((address_space(3))) bf16x8*)(kp+4608);
  kf[6]=*(const __attribute__((address_space(3))) bf16x8*)(kp+6144); kf[7]=*(const __attribute__((address_space(3))) bf16x8*)(kp+6656);
}
__device__ __forceinline__ void kload2(bf16x8*kf,lds_cptr kp,int j){ kf[2*j]=*(const __attribute__((address_space(3))) bf16x8*)(kp+j*2048); kf[2*j+1]=*(const __attribute__((address_space(3))) bf16x8*)(kp+j*2048+512); }
__device__ __forceinline__ s16x4 vtr(lds_cptr p){ return __builtin_bit_cast(s16x4,__builtin_amdgcn_ds_read_tr16_b64_v4i16((__attribute__((address_space(3))) v4i16_t*)p)); }
__device__ __forceinline__ float rowmax(const f32x16&p0,const f32x16&p1){
  float a=max3f(p0[0],p0[1],p1[0]),b=max3f(p0[2],p0[3],p1[1]);a=max3f(a,p1[2],p1[3]);
  #pragma unroll
  for(int r=4;r<16;r+=4){a=max3f(a,p0[r],p0[r+1]);b=max3f(b,p0[r+2],p0[r+3]);a=max3f(a,p1[r],p1[r+1]);b=max3f(b,p1[r+2],p1[r+3]);}
  const float m=max2f(a,b);
  auto rr=__builtin_amdgcn_permlane32_swap(__float_as_uint(m),__float_as_uint(m),false,false);
  return max2f(__uint_as_float(rr[0]),__uint_as_float(rr[1]));
}
__device__ __forceinline__ void pv(f32x16*o,int vb,bf16x8 pa0,bf16x8 pa1,bf16x8 pa2,bf16x8 pa3){
  #pragma unroll
  for(int d0=0;d0<2;++d0){s16x4 lo[4],hi[4];
    #pragma unroll
    for(int ks=0;ks<4;++ks){
      asm volatile("ds_read_b64_tr_b16 %0,%1 offset:%c2":"=&v"(lo[ks]):"v"(vb),"i"(d0*4096+ks*1024):"memory");
      asm volatile("ds_read_b64_tr_b16 %0,%1 offset:%c2":"=&v"(hi[ks]):"v"(vb),"i"(d0*4096+ks*1024+512):"memory");}
    asm volatile("s_waitcnt lgkmcnt(0)":::"memory");SBAR();
    #define PK(k) (bf16x8){lo[k][0],lo[k][1],lo[k][2],lo[k][3],hi[k][0],hi[k][1],hi[k][2],hi[k][3]}
    o[d0]=__builtin_amdgcn_mfma_f32_32x32x16_bf16(pa0,PK(0),o[d0],0,0,0);
    o[d0]=__builtin_amdgcn_mfma_f32_32x32x16_bf16(pa1,PK(1),o[d0],0,0,0);
    o[d0]=__builtin_amdgcn_mfma_f32_32x32x16_bf16(pa2,PK(2),o[d0],0,0,0);
    o[d0]=__builtin_amdgcn_mfma_f32_32x32x16_bf16(pa3,PK(3),o[d0],0,0,0);
    #undef PK
  }
}

#ifndef ATTN_STORE16
#define ATTN_STORE16(p,v) (*(u32x4*)(p)=(v))
#endif
template<int THRL> __device__ __forceinline__ void attn_unit(const bf16*Q,int qp,int qrow0,int qc0,const bf16*__restrict__ K,int kp,int kc0,const bf16*__restrict__ V,int vp,int vc0,bf16*O,int oc0,int kctx0,int klat0,int NT,char*shm,int wave_id){
  wave_id=launder_s(wave_id); const int lane=lane_id_v(),r32=lane&31,hi=lane>>5; const int wid=wave_id;
  const bf16*Qw=Q+(long)(qrow0+wid*QBLK)*qp+qc0;
  const bf16*Kh=K+kc0,*Vh=V+vc0;
  const unsigned lds0=(unsigned)(uintptr_t)shm;
  float*wsf=(float*)(shm+LDS_WS)+wid*64;
  const bf16*ksrc=Kh+(long)lane*kp+wid*8;
  const bf16*vsrc=Vh+(long)(16*(wid&3)+(lane>>2))*vp+(wid>>2)*32+(lane&3)*8;
  #define TROW0(t) ((long)((t)<4?kctx0+64*(t):klat0+64*((t)-4)))
  const unsigned kdst=lds0+LDS_K+wid*1024, vdst=lds0+LDS_V+wid*1024;
  #define DMA_K(t,slot) glds16(ksrc+TROW0(t)*kp,(unsigned)__builtin_amdgcn_readfirstlane(kdst+(slot)))
  #define DMA_V(t,slot) glds16(vsrc+TROW0(t)*vp,(unsigned)__builtin_amdgcn_readfirstlane(vdst+(slot)))
  const int vb0=(int)(lds0+LDS_V)+((lane>>4)&1)*32+(lane&3)*8+(4*hi+((lane&15)>>2))*64;
  const char*Kbase=shm+LDS_K; bf16x8 kf[8];
  const lds_cptr shm3=(lds_cptr)shm; const lds_cptr kp0=shm3+LDS_K+hi*1024+r32*16; const lds_cptr vp0=shm3+LDS_V+((lane>>4)&1)*32+(lane&3)*8+(4*hi+((lane&15)>>2))*64;
  DMA_K(0,0);DMA_V(0,0);DMA_K(1,SLOTB);
  bf16x8 qr[4];
  #pragma unroll
  for(int d0=0;d0<4;++d0)qr[d0]=*reinterpret_cast<const bf16x8*>(&Qw[(long)r32*qp+d0*16+hi*8]);
  float mhat=0.f,l_reg=0.f;f32x16 o[2];o[0]=f32x16{};o[1]=f32x16{};f32x16 negm=f32x16{};asm volatile("":"+v"(negm));
  #define CMASK(P0,P1,t) do{}while(0)
  bool resc=false;
  #define START(P0,P1) do{ const float rm=rowmax(P0,P1); resc=false; \
    { const float dl=rm; mhat=fadd_s(mhat,dl); \
      _Pragma("unroll") for(int r=0;r<16;++r){P0[r]=fsub_s(P0[r],dl);P1[r]=fsub_s(P1[r],dl);} \
      _Pragma("unroll") for(int r=0;r<16;++r)negm[r]=-mhat; asm volatile("":"+v"(negm)); } \
    _Pragma("unroll") for(int r=0;r<16;++r)P0[r]=__builtin_amdgcn_exp2f(P0[r]); }while(0)
  #define RESC() do{ if(resc){ asm volatile("s_waitcnt lgkmcnt(0)":::"memory"); \
      _Pragma("unroll") for(int d_=0;d_<2;++d_) _Pragma("unroll") for(int r=0;r<16;++r)o[d_][r]*=wsf[crow(r,hi)]; } }while(0)
  f32x16 pA0,pA1,pB0,pB1;
  int sl_prev=0,sl_cur=0,sl_next=SLOTB;
  #define ROT() do{sl_prev=sl_cur;sl_cur=sl_next;sl_next=(sl_next==(NSLOT-1)*SLOTB)?0:sl_next+SLOTB;}while(0)
  DMA_K(2,2*SLOTB);
  WAIT_BAR(3);
  qkt(pA0,pA1,Kbase,qr,negm,r32,hi);asm volatile("s_nop 15\n\ts_nop 7":"+v"(pA0),"+v"(pA1));CMASK(pA0,pA1,0);
  START(pA0,pA1);
  _Pragma("unroll") for(int r=0;r<16;++r)pA1[r]=__builtin_amdgcn_exp2f(pA1[r]);
  WAIT_BAR(0);
  DMA_K(3,0);DMA_V(1,SLOTB);
  ROT();
  kload8(kf,kp0+sl_cur);
  WAIT_BAR(2);
  s16x4 vlo[8],vhi[8]; u32x4 pw0,pw1,pw2,pw3;
  #define PKW(P,B) cvtpk_s(P[B],P[B+1])
  #define PAF(k) __builtin_bit_cast(bf16x8,pw##k)
  #define VFR(i) (bf16x8){vlo[i][0],vlo[i][1],vlo[i][2],vlo[i][3],vhi[i][0],vhi[i][1],vhi[i][2],vhi[i][3]}
  #define PIN(x) asm volatile("":"+v"(x))
  #define MX3(a,b,c) __builtin_fmaxf(__builtin_fmaxf((a),(b)),(c))
  #define GAPA(MF,A0,A1,A2,A3,W0,W1,PW) do{ MF; sacc+=A0; sacc+=A1; sacc+=A2; sacc+=A3; PIN(sacc); W0; W1; PIN(PW); SBAR(); }while(0)
  #define EX(v) __builtin_amdgcn_exp2f(v)
  #define GAPB(MF,X,B) do{ MF; X[B]=EX(X[B]); X[B+1]=EX(X[B+1]); X[B+2]=EX(X[B+2]); X[B+3]=EX(X[B+3]); PIN(X); SBAR(); }while(0)
  #define VRD(i) do{ vlo[i]=vtr(vp_+(((i)>>2)*4096+((i)&3)*1024)); vhi[i]=vtr(vp_+(((i)>>2)*4096+((i)&3)*1024+512)); }while(0)
  #define KRD(G,j) do{ if(G){ kload2(kf,kp0+sl_next,j); SBAR(); } }while(0)
  #define STEP(C0,C1,P0,P1,t,GK,GV,GL) do{ SBAR(); \
    const lds_cptr vp_=vp0+sl_prev; \
    VRD(0); SBAR(); float sacc=(P0[0]+P0[1]); \
    GAPA(C0=__builtin_amdgcn_mfma_f32_32x32x16_bf16(kf[0],qr[0],negm,0,0,0), P0[2],P0[3],P0[4],P0[5],     pw0[0]=PKW(P0,0), pw0[1]=PKW(P0,2), pw0); \
    VRD(4); SBAR(); GAPA(C1=__builtin_amdgcn_mfma_f32_32x32x16_bf16(kf[1],qr[0],negm,0,0,0), P0[6],P0[7],P0[8],P0[9],     pw0[2]=PKW(P0,4), pw0[3]=PKW(P0,6), pw0); \
    VRD(1); SBAR(); GAPA(C0=__builtin_amdgcn_mfma_f32_32x32x16_bf16(kf[2],qr[1],C0,0,0,0),   P0[10],P0[11],P0[12],P0[13], pw1[0]=PKW(P0,8), pw1[1]=PKW(P0,10), pw1); \
    VRD(5); SBAR(); GAPA(C1=__builtin_amdgcn_mfma_f32_32x32x16_bf16(kf[3],qr[1],C1,0,0,0),   P0[14],P0[15],P1[0],P1[1],   pw1[2]=PKW(P0,12),pw1[3]=PKW(P0,14), pw1); \
    VRD(2); SBAR(); GAPA(C0=__builtin_amdgcn_mfma_f32_32x32x16_bf16(kf[4],qr[2],C0,0,0,0),   P1[2],P1[3],P1[4],P1[5],     pw2[0]=PKW(P1,0), pw2[1]=PKW(P1,2), pw2); \
    VRD(6); SBAR(); GAPA(C1=__builtin_amdgcn_mfma_f32_32x32x16_bf16(kf[5],qr[2],C1,0,0,0),   P1[6],P1[7],P1[8],P1[9],     pw2[2]=PKW(P1,4), pw2[3]=PKW(P1,6), pw2); \
    VRD(3); SBAR(); GAPA(C0=__builtin_amdgcn_mfma_f32_32x32x16_bf16(kf[6],qr[3],C0,0,0,0),   P1[10],P1[11],P1[12],P1[13], pw3[0]=PKW(P1,8), pw3[1]=PKW(P1,10), pw3); \
    VRD(7); SBAR(); GAPA(C1=__builtin_amdgcn_mfma_f32_32x32x16_bf16(kf[7],qr[3],C1,0,0,0),   P1[14],P1[15],0.f,0.f,       pw3[2]=PKW(P1,12),pw3[3]=PKW(P1,14), pw3); \
    l_reg+=sacc; \
    if(GK){DMA_K((t)+3,sl_cur);} if(GV){DMA_V((t)+1,sl_next);} \
    CMASK(C0,C1,t); \
    { float a=MX3(C0[0],C0[1],C1[0]),b=MX3(C0[2],C0[3],C1[1]); a=MX3(a,C1[2],C1[3]); \
      _Pragma("unroll") for(int r=4;r<16;r+=4){a=MX3(a,C0[r],C0[r+1]);b=MX3(b,C0[r+2],C0[r+3]);a=MX3(a,C1[r],C1[r+1]);b=MX3(b,C1[r+2],C1[r+3]);} \
      float rm=__builtin_fmaxf(a,b); { auto rr=__builtin_amdgcn_permlane32_swap(__float_as_uint(rm),__float_as_uint(rm),false,false); rm=__builtin_fmaxf(__uint_as_float(rr[0]),__uint_as_float(rr[1])); } \
      resc=false; \
      if(__builtin_expect(__any(rm>(float)THRL),0)){ const float dl=__builtin_fmaxf(rm,0.f); mhat+=dl; \
        _Pragma("unroll") for(int r=0;r<16;++r){C0[r]-=dl;C1[r]-=dl;} \
        _Pragma("unroll") for(int r=0;r<16;++r)negm[r]=-mhat; asm volatile("":"+v"(negm)); \
        const float f=__builtin_amdgcn_exp2f(-dl); l_reg*=f; if(hi==0)wsf[r32]=f; resc=true; } } \
    SBAR(); \
    GAPB(o[0]=__builtin_amdgcn_mfma_f32_32x32x16_bf16(PAF(0),VFR(0),o[0],0,0,0), C0,0); \
    GAPB(o[1]=__builtin_amdgcn_mfma_f32_32x32x16_bf16(PAF(0),VFR(4),o[1],0,0,0), C0,4); \
    KRD(GL,0); GAPB(o[0]=__builtin_amdgcn_mfma_f32_32x32x16_bf16(PAF(1),VFR(1),o[0],0,0,0), C0,8); \
    KRD(GL,1); GAPB(o[1]=__builtin_amdgcn_mfma_f32_32x32x16_bf16(PAF(1),VFR(5),o[1],0,0,0), C0,12); \
    KRD(GL,2); GAPB(o[0]=__builtin_amdgcn_mfma_f32_32x32x16_bf16(PAF(2),VFR(2),o[0],0,0,0), C1,0); \
    KRD(GL,3); GAPB(o[1]=__builtin_amdgcn_mfma_f32_32x32x16_bf16(PAF(2),VFR(6),o[1],0,0,0), C1,4); \
    GAPB(o[0]=__builtin_amdgcn_mfma_f32_32x32x16_bf16(PAF(3),VFR(3),o[0],0,0,0), C1,8); \
    GAPB(o[1]=__builtin_amdgcn_mfma_f32_32x32x16_bf16(PAF(3),VFR(7),o[1],0,0,0), C1,12); \
    }while(0)
  int t=1;
  for(;t+5<NT;t+=2){
    STEP(pB0,pB1,pA0,pA1,t,true,true,true);     WAIT_BAR(2); RESC(); ROT();
    STEP(pA0,pA1,pB0,pB1,t+1,true,true,true);   WAIT_BAR(2); RESC(); ROT();
  }
  #define ENDW(tt) do{ if((tt)+3<NT){WAIT_BAR(2);} else if((tt)+2<NT){WAIT_BAR(1);} else {WAIT_BAR(0);} }while(0)
  for(;t+1<NT;t+=2){
    STEP(pB0,pB1,pA0,pA1,t,(t+3<NT),(t+1<NT),(t+1<NT));       ENDW(t);   RESC(); ROT();
    STEP(pA0,pA1,pB0,pB1,t+1,(t+4<NT),(t+2<NT),(t+2<NT));     ENDW(t+1); RESC(); ROT();
  }
  STEP(pB0,pB1,pA0,pA1,NT-1,false,false,false); RESC();
  { float sacc=pB0[0]+pB0[1]; _Pragma("unroll") for(int r=2;r<16;++r)sacc+=pB0[r]; _Pragma("unroll") for(int r=0;r<16;++r)sacc+=pB1[r]; l_reg+=sacc;
    pw0=(u32x4){PKW(pB0,0),PKW(pB0,2),PKW(pB0,4),PKW(pB0,6)};pw1=(u32x4){PKW(pB0,8),PKW(pB0,10),PKW(pB0,12),PKW(pB0,14)};pw2=(u32x4){PKW(pB1,0),PKW(pB1,2),PKW(pB1,4),PKW(pB1,6)};pw3=(u32x4){PKW(pB1,8),PKW(pB1,10),PKW(pB1,12),PKW(pB1,14)};
    SBAR(); pv(o,vb0+sl_cur,PAF(0),PAF(1),PAF(2),PAF(3)); }
  #undef PKW
  #undef PAF
  #undef VFR
  #undef PIN
  #undef MX3
  #undef GAPA
  #undef GAPB
  #undef EX
  #undef VRD
  #undef KRD
  #undef STEP
  #undef ENDW
  {auto rr=__builtin_amdgcn_permlane32_swap(__float_as_uint(l_reg),__float_as_uint(l_reg),false,false);l_reg=__uint_as_float(rr[0])+__uint_as_float(rr[1]);}
  if(hi==0)wsf[32+r32]=l_reg;asm volatile("s_waitcnt lgkmcnt(0)":::"memory");
  float rli[16];
  #pragma unroll
  for(int r=0;r<16;++r)rli[r]=__builtin_amdgcn_rcpf(wsf[32+crow(r,hi)]);
  unsigned char*Ow=(unsigned char*)O+(long)(qrow0+wid*QBLK)*1024+oc0;
  { bf16*stg=(bf16*)(shm+LDS_OST)+wid*2048;
    #pragma unroll
    for(int r=0;r<16;++r){const int orow=crow(r,hi);
      #pragma unroll
      for(int d0=0;d0<2;++d0)stg[orow*64+d0*32+r32]=(bf16)(cvtpk_s(o[d0][r]*rli[r],0.f)&0xffffu);}
    asm volatile("s_waitcnt lgkmcnt(0)":::"memory");
    #pragma unroll
    for(int i=0;i<4;++i){const int row=i*8+(lane>>3),ch=lane&7; const u32x4 v=*(const u32x4*)(stg+row*64+ch*8);
      *(v2u*)(Ow+(long)row*1024+ch*8)=pack8_fp8((f32x4){bf_lo(v.x),bf_hi(v.x),bf_lo(v.y),bf_hi(v.y)},(f32x4){bf_lo(v.z),bf_hi(v.z),bf_lo(v[3]),bf_hi(v[3])});} }
  asm volatile("s_waitcnt lgkmcnt(0)\n\ts_barrier":::"memory");
  #undef DMA_K
  #undef DMA_V
  #undef TROW0
  #undef CMASK
  #undef START
  #undef RESC
  #undef ROT
}
#undef SBAR
#undef WAIT_BAR
}

namespace att96 {
typedef unsigned short bf16;
using bf16x8=__attribute__((ext_vector_type(8)))short;
using s16x4=__attribute__((ext_vector_type(4)))short;
using f32x16=__attribute__((ext_vector_type(16)))float;
using u32x4=__attribute__((ext_vector_type(4)))unsigned;
constexpr int D=64;
constexpr int NW=8,QBLK=32,QB=QBLK*NW,KVBLK=64;
__device__ __forceinline__ int crow(int r,int hi){return (r&3)+8*(r>>2)+4*hi;}
#define SBAR() __builtin_amdgcn_sched_barrier(0)
constexpr int NSLOT=3, SLOTB=8192, KSLOTB=12288;
#define KOFF(sl) ((sl)+((sl)>>1))
constexpr int LDS_K=0, LDS_V=NSLOT*KSLOTB, LDS_WS=LDS_V+NSLOT*SLOTB, LDS_OST=LDS_WS+NW*64*4, LDS_BYTES=LDS_OST+NW*4096;
constexpr float C2=0.125f*1.4426950408889634f;
__device__ __forceinline__ void glds16(const void*gsrc,unsigned lds_dst){unsigned keep;
  asm volatile("s_mov_b32 %0, m0\n\ts_mov_b32 m0, %2\n\ts_nop 0\n\tglobal_load_lds_dwordx4 %1, off\n\ts_mov_b32 m0, %0":"=&s"(keep):"v"(gsrc),"s"(lds_dst):"memory");}
__device__ __forceinline__ float max3f(float a,float b,float c){float r;asm("v_max3_f32 %0, %1, %2, %3":"=v"(r):"v"(a),"v"(b),"v"(c));return r;}
__device__ __forceinline__ float max2f(float a,float b){float r;asm("v_max_f32_e32 %0, %1, %2":"=v"(r):"v"(a),"v"(b));return r;}
__device__ __forceinline__ float fadd_s(float a,float b){float r;asm("v_add_f32_e32 %0, %1, %2":"=v"(r):"v"(a),"v"(b));return r;}
__device__ __forceinline__ float fsub_s(float a,float b){float r;asm("v_sub_f32_e32 %0, %1, %2":"=v"(r):"v"(a),"v"(b));return r;}
typedef float f32x2_t __attribute__((ext_vector_type(2))); typedef __bf16 bf16x2_t __attribute__((ext_vector_type(2)));
__device__ __forceinline__ unsigned cvtpk_s(float lo,float hi){f32x2_t v={lo,hi};bf16x2_t b=__builtin_convertvector(v,bf16x2_t);return __builtin_bit_cast(unsigned,b);}
#define WAIT_BAR(N) asm volatile("s_waitcnt vmcnt(" #N ") lgkmcnt(0)\n\ts_barrier":::"memory")

__device__ __forceinline__ void qkt(f32x16&p0,f32x16&p1,const char*Kslot,const bf16x8*qr,const f32x16&negm,int r32,int hi){
  const char*kb=Kslot+hi*1024+r32*16;
  #pragma unroll
  for(int d0=0;d0<6;++d0){
    const bf16x8 b0=*reinterpret_cast<const bf16x8*>(kb+d0*2048);
    const bf16x8 b1=*reinterpret_cast<const bf16x8*>(kb+d0*2048+512);
    if(d0==0){p0=__builtin_amdgcn_mfma_f32_32x32x16_bf16(b0,qr[0],negm,0,0,0);p1=__builtin_amdgcn_mfma_f32_32x32x16_bf16(b1,qr[0],negm,0,0,0);}
    else{p0=__builtin_amdgcn_mfma_f32_32x32x16_bf16(b0,qr[d0],p0,0,0,0);p1=__builtin_amdgcn_mfma_f32_32x32x16_bf16(b1,qr[d0],p1,0,0,0);}}
}
typedef __attribute__((address_space(3))) const char* lds_cptr;
typedef short v4i16_t __attribute__((ext_vector_type(4)));
__device__ __forceinline__ void kload8(bf16x8*kf,lds_cptr kp){
  kf[0]=*(const __attribute__((address_space(3))) bf16x8*)(kp);      kf[1]=*(const __attribute__((address_space(3))) bf16x8*)(kp+512);
  kf[2]=*(const __attribute__((address_space(3))) bf16x8*)(kp+2048); kf[3]=*(const __attribute__((address_space(3))) bf16x8*)(kp+2560);
  kf[4]=*(const __attribute__((address_space(3))) bf16x8*)(kp+4096); kf[5]=*(const __attribute__((address_space(3))) bf16x8*)(kp+4608);
  kf[6]=*(const __attribute__((address_space(3))) bf16x8*)(kp+6144); kf[7]=*(const __attribute__((address_space(3))) bf16x8*)(kp+6656);
  kf[8]=*(const __attribute__((address_space(3))) bf16x8*)(kp+8192); kf[9]=*(const __attribute__((address_space(3))) bf16x8*)(kp+8704);
  kf[10]=*(const __attribute__((address_space(3))) bf16x8*)(kp+10240); kf[11]=*(const __attribute__((address_space(3))) bf16x8*)(kp+10752);
}
__device__ __forceinline__ void kload2(bf16x8*kf,lds_cptr kp,int j){ kf[2*j]=*(const __attribute__((address_space(3))) bf16x8*)(kp+j*2048); kf[2*j+1]=*(const __attribute__((address_space(3))) bf16x8*)(kp+j*2048+512); }
__device__ __forceinline__ s16x4 vtr(lds_cptr p){ return __builtin_bit_cast(s16x4,__builtin_amdgcn_ds_read_tr16_b64_v4i16((__attribute__((address_space(3))) v4i16_t*)p)); }
__device__ __forceinline__ float rowmax(const f32x16&p0,const f32x16&p1){
  float a=max3f(p0[0],p0[1],p1[0]),b=max3f(p0[2],p0[3],p1[1]);a=max3f(a,p1[2],p1[3]);
  #pragma unroll
  for(int r=4;r<16;r+=4){a=max3f(a,p0[r],p0[r+1]);b=max3f(b,p0[r+2],p0[r+3]);a=max3f(a,p1[r],p1[r+1]);b=max3f(b,p1[r+2],p1[r+3]);}
  const float m=max2f(a,b);
  auto rr=__builtin_amdgcn_permlane32_swap(__float_as_uint(m),__float_as_uint(m),false,false);
  return max2f(__uint_as_float(rr[0]),__uint_as_float(rr[1]));
}
__device__ __forceinline__ void pv(f32x16*o,int vb,bf16x8 pa0,bf16x8 pa1,bf16x8 pa2,bf16x8 pa3){
  #pragma unroll
  for(int d0=0;d0<2;++d0){s16x4 lo[4],hi[4];
    #pragma unroll
    for(int ks=0;ks<4;++ks){
      asm volatile("ds_read_b64_tr_b16 %0,%1 offset:%c2":"=&v"(lo[ks]):"v"(vb),"i"(d0*4096+ks*1024):"memory");
      asm volatile("ds_read_b64_tr_b16 %0,%1 offset:%c2":"=&v"(hi[ks]):"v"(vb),"i"(d0*4096+ks*1024+512):"memory");}
    asm volatile("s_waitcnt lgkmcnt(0)":::"memory");SBAR();
    #define PK(k) (bf16x8){lo[k][0],lo[k][1],lo[k][2],lo[k][3],hi[k][0],hi[k][1],hi[k][2],hi[k][3]}
    o[d0]=__builtin_amdgcn_mfma_f32_32x32x16_bf16(pa0,PK(0),o[d0],0,0,0);
    o[d0]=__builtin_amdgcn_mfma_f32_32x32x16_bf16(pa1,PK(1),o[d0],0,0,0);
    o[d0]=__builtin_amdgcn_mfma_f32_32x32x16_bf16(pa2,PK(2),o[d0],0,0,0);
    o[d0]=__builtin_amdgcn_mfma_f32_32x32x16_bf16(pa3,PK(3),o[d0],0,0,0);
    #undef PK
  }
}

#ifndef ATTN_STORE16
#define ATTN_STORE16(p,v) (*(u32x4*)(p)=(v))
#endif
template<int THRL> __device__ __forceinline__ void attn_unit(const bf16*Q,int qp,int qrow0,int qc0,const bf16*__restrict__ K,int kp,int kc0,const bf16*__restrict__ V,int vp,int vc0,bf16*O,int oc0,int kctx0,int klat0,int NT,char*shm,int wave_id){
  wave_id=launder_s(wave_id); const int lane=lane_id_v(),r32=lane&31,hi=lane>>5; const int wid=wave_id;
  const bf16*Qw=Q+(long)(qrow0+wid*QBLK)*qp+qc0;
  const bf16*Kh=K+kc0,*Vh=V+vc0;
  const unsigned lds0=(unsigned)(uintptr_t)shm;
  float*wsf=(float*)(shm+LDS_WS)+wid*64;
  const bf16*ksrc=Kh+(long)lane*kp+wid*8;
  const bf16*vsrc=Vh+(long)(16*(wid&3)+(lane>>2))*vp+(wid>>2)*32+(lane&3)*8;
  #define TROW0(t) ((long)((t)<4?kctx0+64*(t):klat0+64*((t)-4)))
  const unsigned kdst=lds0+LDS_K+wid*1024, kdst2=lds0+LDS_K+8192+(wid&3)*1024, vdst=lds0+LDS_V+wid*1024;
  const int k2off=(8+(wid&3)-wid)*8;
  #define DMA_K(t,slot) do{ glds16(ksrc+TROW0(t)*kp,(unsigned)__builtin_amdgcn_readfirstlane(kdst+KOFF(slot))); glds16(ksrc+TROW0(t)*kp+k2off,(unsigned)__builtin_amdgcn_readfirstlane(kdst2+KOFF(slot))); }while(0)
  #define DMA_V(t,slot) glds16(vsrc+TROW0(t)*vp,(unsigned)__builtin_amdgcn_readfirstlane(vdst+(slot)))
  const int vb0=(int)(lds0+LDS_V)+((lane>>4)&1)*32+(lane&3)*8+(4*hi+((lane&15)>>2))*64;
  const char*Kbase=shm+LDS_K; bf16x8 kf[12];
  const lds_cptr shm3=(lds_cptr)shm; const lds_cptr kp0=shm3+LDS_K+hi*1024+r32*16; const lds_cptr vp0=shm3+LDS_V+((lane>>4)&1)*32+(lane&3)*8+(4*hi+((lane&15)>>2))*64;
  DMA_K(0,0);DMA_V(0,0);DMA_K(1,SLOTB);
  bf16x8 qr[6];
  #pragma unroll
  for(int d0=0;d0<6;++d0)qr[d0]=*reinterpret_cast<const bf16x8*>(&Qw[(long)r32*qp+d0*16+hi*8]);
  float mhat=0.f,l_reg=0.f;f32x16 o[2];o[0]=f32x16{};o[1]=f32x16{};f32x16 negm=f32x16{};asm volatile("":"+v"(negm));
  #define CMASK(P0,P1,t) do{}while(0)
  bool resc=false;
  #define START(P0,P1) do{ const float rm=rowmax(P0,P1); resc=false; \
    { const float dl=rm; mhat=fadd_s(mhat,dl); \
      _Pragma("unroll") for(int r=0;r<16;++r){P0[r]=fsub_s(P0[r],dl);P1[r]=fsub_s(P1[r],dl);} \
      _Pragma("unroll") for(int r=0;r<16;++r)negm[r]=-mhat; asm volatile("":"+v"(negm)); } \
    _Pragma("unroll") for(int r=0;r<16;++r)P0[r]=__builtin_amdgcn_exp2f(P0[r]); }while(0)
  #define RESC() do{ if(resc){ asm volatile("s_waitcnt lgkmcnt(0)":::"memory"); \
      _Pragma("unroll") for(int d_=0;d_<2;++d_) _Pragma("unroll") for(int r=0;r<16;++r)o[d_][r]*=wsf[crow(r,hi)]; } }while(0)
  f32x16 pA0,pA1,pB0,pB1;
  int sl_prev=0,sl_cur=0,sl_next=SLOTB;
  #define ROT() do{sl_prev=sl_cur;sl_cur=sl_next;sl_next=(sl_next==(NSLOT-1)*SLOTB)?0:sl_next+SLOTB;}while(0)
  DMA_K(2,2*SLOTB);
  WAIT_BAR(5);
  qkt(pA0,pA1,Kbase,qr,negm,r32,hi);asm volatile("s_nop 15\n\ts_nop 7":"+v"(pA0),"+v"(pA1));CMASK(pA0,pA1,0);
  START(pA0,pA1);
  _Pragma("unroll") for(int r=0;r<16;++r)pA1[r]=__builtin_amdgcn_exp2f(pA1[r]);
  WAIT_BAR(0);
  DMA_K(3,0);DMA_V(1,SLOTB);
  ROT();
  kload8(kf,kp0+KOFF(sl_cur));
  WAIT_BAR(3);
  s16x4 vlo[8],vhi[8]; u32x4 pw0,pw1,pw2,pw3;
  #define PKW(P,B) cvtpk_s(P[B],P[B+1])
  #define PAF(k) __builtin_bit_cast(bf16x8,pw##k)
  #define VFR(i) (bf16x8){vlo[i][0],vlo[i][1],vlo[i][2],vlo[i][3],vhi[i][0],vhi[i][1],vhi[i][2],vhi[i][3]}
  #define PIN(x) asm volatile("":"+v"(x))
  #define MX3(a,b,c) __builtin_fmaxf(__builtin_fmaxf((a),(b)),(c))
  #define GAPA(MF,A0,A1,A2,A3,W0,W1,PW) do{ MF; sacc+=A0; sacc+=A1; sacc+=A2; sacc+=A3; PIN(sacc); W0; W1; PIN(PW); SBAR(); }while(0)
  #define EX(v) __builtin_amdgcn_exp2f(v)
  #define GAPB(MF,X,B) do{ MF; X[B]=EX(X[B]); X[B+1]=EX(X[B+1]); X[B+2]=EX(X[B+2]); X[B+3]=EX(X[B+3]); PIN(X); SBAR(); }while(0)
  #define VRD(i) do{ vlo[i]=vtr(vp_+(((i)>>2)*4096+((i)&3)*1024)); vhi[i]=vtr(vp_+(((i)>>2)*4096+((i)&3)*1024+512)); }while(0)
  #define KRD(G,j) do{ if(G){ kload2(kf,kp0+KOFF(sl_next),j); SBAR(); } }while(0)
  #define STEP(C0,C1,P0,P1,t,GK,GV,GL) do{ SBAR(); \
    const lds_cptr vp_=vp0+sl_prev; \
    VRD(0); SBAR(); float sacc=(P0[0]+P0[1]); \
    GAPA(C0=__builtin_amdgcn_mfma_f32_32x32x16_bf16(kf[0],qr[0],negm,0,0,0), P0[2],P0[3],P0[4],P0[5],     pw0[0]=PKW(P0,0), pw0[1]=PKW(P0,2), pw0); \
    VRD(4); SBAR(); GAPA(C1=__builtin_amdgcn_mfma_f32_32x32x16_bf16(kf[1],qr[0],negm,0,0,0), P0[6],P0[7],P0[8],P0[9],     pw0[2]=PKW(P0,4), pw0[3]=PKW(P0,6), pw0); \
    VRD(1); SBAR(); GAPA(C0=__builtin_amdgcn_mfma_f32_32x32x16_bf16(kf[2],qr[1],C0,0,0,0),   P0[10],P0[11],P0[12],P0[13], pw1[0]=PKW(P0,8), pw1[1]=PKW(P0,10), pw1); \
    VRD(5); SBAR(); GAPA(C1=__builtin_amdgcn_mfma_f32_32x32x16_bf16(kf[3],qr[1],C1,0,0,0),   P0[14],P0[15],P1[0],P1[1],   pw1[2]=PKW(P0,12),pw1[3]=PKW(P0,14), pw1); \
    VRD(2); SBAR(); GAPA(C0=__builtin_amdgcn_mfma_f32_32x32x16_bf16(kf[4],qr[2],C0,0,0,0),   P1[2],P1[3],P1[4],P1[5],     pw2[0]=PKW(P1,0), pw2[1]=PKW(P1,2), pw2); \
    VRD(6); SBAR(); GAPA(C1=__builtin_amdgcn_mfma_f32_32x32x16_bf16(kf[5],qr[2],C1,0,0,0),   P1[6],P1[7],P1[8],P1[9],     pw2[2]=PKW(P1,4), pw2[3]=PKW(P1,6), pw2); \
    VRD(3); SBAR(); GAPA(C0=__builtin_amdgcn_mfma_f32_32x32x16_bf16(kf[6],qr[3],C0,0,0,0),   P1[10],P1[11],P1[12],P1[13], pw3[0]=PKW(P1,8), pw3[1]=PKW(P1,10), pw3); \
    VRD(7); SBAR(); GAPA(C1=__builtin_amdgcn_mfma_f32_32x32x16_bf16(kf[7],qr[3],C1,0,0,0),   P1[14],P1[15],0.f,0.f,       pw3[2]=PKW(P1,12),pw3[3]=PKW(P1,14), pw3); \
    C0=__builtin_amdgcn_mfma_f32_32x32x16_bf16(kf[8],qr[4],C0,0,0,0); C1=__builtin_amdgcn_mfma_f32_32x32x16_bf16(kf[9],qr[4],C1,0,0,0); C0=__builtin_amdgcn_mfma_f32_32x32x16_bf16(kf[10],qr[5],C0,0,0,0); C1=__builtin_amdgcn_mfma_f32_32x32x16_bf16(kf[11],qr[5],C1,0,0,0); SBAR(); \
    l_reg+=sacc; \
    if(GK){DMA_K((t)+3,sl_cur);} if(GV){DMA_V((t)+1,sl_next);} \
    CMASK(C0,C1,t); \
    { float a=MX3(C0[0],C0[1],C1[0]),b=MX3(C0[2],C0[3],C1[1]); a=MX3(a,C1[2],C1[3]); \
      _Pragma("unroll") for(int r=4;r<16;r+=4){a=MX3(a,C0[r],C0[r+1]);b=MX3(b,C0[r+2],C0[r+3]);a=MX3(a,C1[r],C1[r+1]);b=MX3(b,C1[r+2],C1[r+3]);} \
      float rm=__builtin_fmaxf(a,b); { auto rr=__builtin_amdgcn_permlane32_swap(__float_as_uint(rm),__float_as_uint(rm),false,false); rm=__builtin_fmaxf(__uint_as_float(rr[0]),__uint_as_float(rr[1])); } \
      resc=false; \
      if(__builtin_expect(__any(rm>(float)THRL),0)){ const float dl=__builtin_fmaxf(rm,0.f); mhat+=dl; \
        _Pragma("unroll") for(int r=0;r<16;++r){C0[r]-=dl;C1[r]-=dl;} \
        _Pragma("unroll") for(int r=0;r<16;++r)negm[r]=-mhat; asm volatile("":"+v"(negm)); \
        const float f=__builtin_amdgcn_exp2f(-dl); l_reg*=f; if(hi==0)wsf[r32]=f; resc=true; } } \
    SBAR(); \
    GAPB(o[0]=__builtin_amdgcn_mfma_f32_32x32x16_bf16(PAF(0),VFR(0),o[0],0,0,0), C0,0); \
    GAPB(o[1]=__builtin_amdgcn_mfma_f32_32x32x16_bf16(PAF(0),VFR(4),o[1],0,0,0), C0,4); \
    KRD(GL,0); GAPB(o[0]=__builtin_amdgcn_mfma_f32_32x32x16_bf16(PAF(1),VFR(1),o[0],0,0,0), C0,8); \
    KRD(GL,1); GAPB(o[1]=__builtin_amdgcn_mfma_f32_32x32x16_bf16(PAF(1),VFR(5),o[1],0,0,0), C0,12); \
    KRD(GL,2); GAPB(o[0]=__builtin_amdgcn_mfma_f32_32x32x16_bf16(PAF(2),VFR(2),o[0],0,0,0), C1,0); \
    KRD(GL,3); GAPB(o[1]=__builtin_amdgcn_mfma_f32_32x32x16_bf16(PAF(2),VFR(6),o[1],0,0,0), C1,4); \
    KRD(GL,4); GAPB(o[0]=__builtin_amdgcn_mfma_f32_32x32x16_bf16(PAF(3),VFR(3),o[0],0,0,0), C1,8); \
    KRD(GL,5); GAPB(o[1]=__builtin_amdgcn_mfma_f32_32x32x16_bf16(PAF(3),VFR(7),o[1],0,0,0), C1,12); \
    }while(0)
  int t=1;
  for(;t+5<NT;t+=2){
    STEP(pB0,pB1,pA0,pA1,t,true,true,true);     WAIT_BAR(3); RESC(); ROT();
    STEP(pA0,pA1,pB0,pB1,t+1,true,true,true);   WAIT_BAR(3); RESC(); ROT();
  }
  #define ENDW(tt) do{ if((tt)+3<NT){WAIT_BAR(3);} else if((tt)+2<NT){WAIT_BAR(1);} else {WAIT_BAR(0);} }while(0)
  for(;t+1<NT;t+=2){
    STEP(pB0,pB1,pA0,pA1,t,(t+3<NT),(t+1<NT),(t+1<NT));       ENDW(t);   RESC(); ROT();
    STEP(pA0,pA1,pB0,pB1,t+1,(t+4<NT),(t+2<NT),(t+2<NT));     ENDW(t+1); RESC(); ROT();
  }
  STEP(pB0,pB1,pA0,pA1,NT-1,false,false,false); RESC();
  { float sacc=pB0[0]+pB0[1]; _Pragma("unroll") for(int r=2;r<16;++r)sacc+=pB0[r]; _Pragma("unroll") for(int r=0;r<16;++r)sacc+=pB1[r]; l_reg+=sacc;
    pw0=(u32x4){PKW(pB0,0),PKW(pB0,2),PKW(pB0,4),PKW(pB0,6)};pw1=(u32x4){PKW(pB0,8),PKW(pB0,10),PKW(pB0,12),PKW(pB0,14)};pw2=(u32x4){PKW(pB1,0),PKW(pB1,2),PKW(pB1,4),PKW(pB1,6)};pw3=(u32x4){PKW(pB1,8),PKW(pB1,10),PKW(pB1,12),PKW(pB1,14)};
    SBAR(); pv(o,vb0+sl_cur,PAF(0),PAF(1),PAF(2),PAF(3)); }
  #undef PKW
  #undef PAF
  #undef VFR
  #undef PIN
  #undef MX3
  #undef GAPA
  #undef GAPB
  #undef EX
  #undef VRD
  #undef KRD
  #undef STEP
  #undef ENDW
  {auto rr=__builtin_amdgcn_permlane32_swap(__float_as_uint(l_reg),__float_as_uint(l_reg),false,false);l_reg=__uint_as_float(rr[0])+__uint_as_float(rr[1]);}
  if(hi==0)wsf[32+r32]=l_reg;asm volatile("s_waitcnt lgkmcnt(0)":::"memory");
  float rli[16];
  #pragma unroll
  for(int r=0;r<16;++r)rli[r]=__builtin_amdgcn_rcpf(wsf[32+crow(r,hi)]);
  unsigned char*Ow=(unsigned char*)O+(long)(qrow0+wid*QBLK)*1024+oc0;
  { bf16*stg=(bf16*)(shm+LDS_OST)+wid*2048;
    #pragma unroll
    for(int r=0;r<16;++r){const int orow=crow(r,hi);
      #pragma unroll
      for(int d0=0;d0<2;++d0)stg[orow*64+d0*32+r32]=(bf16)(cvtpk_s(o[d0][r]*rli[r],0.f)&0xffffu);}
    asm volatile("s_waitcnt lgkmcnt(0)":::"memory");
    #pragma unroll
    for(int i=0;i<4;++i){const int row=i*8+(lane>>3),ch=lane&7; const u32x4 v=*(const u32x4*)(stg+row*64+ch*8);
      *(v2u*)(Ow+(long)row*1024+ch*8)=pack8_fp8((f32x4){bf_lo(v.x),bf_hi(v.x),bf_lo(v.y),bf_hi(v.y)},(f32x4){bf_lo(v.z),bf_hi(v.z),bf_lo(v[3]),bf_hi(v[3])});} }
  asm volatile("s_waitcnt lgkmcnt(0)\n\ts_barrier":::"memory");
  #undef DMA_K
  #undef DMA_V
  #undef TROW0
  #undef CMASK
  #undef START
  #undef RESC
  #undef ROT
}
#undef SBAR
#undef WAIT_BAR
#undef KOFF
}

struct Args { const float* in[27]; float* out; unsigned char* ws; int ph_lo, ph_hi; };
struct Frame {
    LAS unsigned char* lds; unsigned char* ws; gu32* ctl; int wave, G, gw, NGW;
};
__device__ __forceinline__ int lthread(int wave) { return wave * 64 + lane_id_v(); }

template <int MODE>
__device__ __forceinline__ void conv_item(const float* W, int K, int N, bf16* WT, LAS float* scr, int item, int lane) {
    const int nblk = (N + 63) / 64, kb = item / nblk, nb = item % nblk, k0 = 64 * kb, n0 = 64 * nb;
    f32x4 v[16];
    const int cc = (lane & 15) * 4, rk = lane >> 4;
    const bool ok = (n0 + cc) < N;
#pragma unroll
    for (int i = 0; i < 16; ++i) v[i] = ok ? *(const f32x4*)(W + (size_t)(k0 + 4 * i + rk) * N + n0 + cc) : (f32x4){0.f, 0.f, 0.f, 0.f};
#pragma unroll
    for (int i = 0; i < 16; ++i) { LAS float* s = scr + (4 * i + rk) * 65 + cc; s[0] = v[i][0]; s[1] = v[i][1]; s[2] = v[i][2]; s[3] = v[i][3]; }
    LDS_WAIT(); asm volatile("" ::: "memory");
    const int c = lane & 7;
#pragma unroll
    for (int j = 0; j < 8; ++j) { const int n = (lane >> 3) + 8 * j; const LAS float* s = scr + (8 * c) * 65 + n;
        v4u o; o.x = pk2(s[0], s[65]); o.y = pk2(s[2 * 65], s[3 * 65]); o.z = pk2(s[4 * 65], s[5 * 65]); o.w = pk2(s[6 * 65], s[7 * 65]);
        const int ng = n0 + n; if (ng < N) { const int dr = (MODE == 1) ? ((ng >> 8) * 256 + (ng & 1) * 128 + ((ng >> 1) & 127)) : ng; *(v4u*)(WT + (size_t)dr * K + k0 + 8 * c) = o; } }
    LDS_WAIT(); asm volatile("" ::: "memory");
}

__device__ __forceinline__ void prologue(Frame& F, const Args& a) {
    const int f_tid = lthread(F.wave), f_lane = f_tid & 63;
    unsigned char* ws = F.ws;
    {
        LAS float* scr = (LAS float*)(F.lds + F.wave * 16640);
        struct M { const float* src; int K, N; size_t dst; };
        const int I_MIN = 16 * 11, I_QB = 6 * 24, I_KVB = 4 * 32, I_GQKV = 16 * 24;
        const int NSMALL = I_MIN + I_QB + I_KVB + I_GQKV;
        for (int it = F.gw; it < NSMALL; it += F.NGW) {
            int r = it;
            if (r < I_MIN) { conv_item<0>(a.in[11], D, MLA_IN, (bf16*)(ws + WS_WMIN), scr, r, f_lane); continue; } r -= I_MIN;
            if (r < I_QB) { conv_item<0>(a.in[13], MLA_QL, 1536, (bf16*)(ws + WS_WMQB), scr, r, f_lane); continue; } r -= I_QB;
            if (r < I_KVB) { conv_item<0>(a.in[15], MLA_KVL, 2048, (bf16*)(ws + WS_WMKVB), scr, r, f_lane); continue; } r -= I_KVB;
            conv_item<0>(a.in[17], D, GQA_QKV, (bf16*)(ws + WS_WGQKV), scr, r, f_lane);
        }
    }
    __syncthreads();
    {
        LAS float* cmax = (LAS float*)F.lds;
        LAS float* cinv = cmax + 512;
        LAS unsigned* scr8 = (LAS unsigned*)(F.lds + 4096) + F.wave * (64 * 33);
        const int cc = (f_lane & 15) * 4, rk = f_lane >> 4;
        constexpr int NGU = DEPTH * NE * 32, NDN = DEPTH * NE * 16, NWO = 4 * 16;
        for (int it = blockIdx.x; it < NGU + NDN + NWO; it += F.G) {
            const bool dn = it >= NGU; const bool wo = it >= NGU + NDN; const int q_ = wo ? it - NGU - NDN : (dn ? it - NGU : it); const int le = dn ? (q_ >> 4) : (q_ >> 5), strip = dn ? (q_ & 15) : (q_ & 31);
            const int N = dn ? 1024 : 2048;
            const float* wosrc = (le < 2) ? a.in[10] + (size_t)le * D * D : (le == 2 ? a.in[16] : a.in[20]);
            const float* W = (wo ? wosrc : (dn ? a.in[25] + (size_t)le * DFF * D : a.in[23] + (size_t)le * D * 2048)) + strip * 64 + cc;
            f32x4 v[32];
#pragma unroll
            for (int i = 0; i < 32; ++i) v[i] = *(const f32x4*)(W + (size_t)(F.wave * 128 + 16 * (i >> 2) + 4 * rk + (i & 3)) * N);
            f32x4 mx = (f32x4){0.f, 0.f, 0.f, 0.f};
#pragma unroll
            for (int i = 0; i < 32; ++i) { mx[0] = fmaxf(mx[0], fabsf(v[i][0])); mx[1] = fmaxf(mx[1], fabsf(v[i][1])); mx[2] = fmaxf(mx[2], fabsf(v[i][2])); mx[3] = fmaxf(mx[3], fabsf(v[i][3])); }
#pragma unroll
            for (int q = 0; q < 4; ++q) { mx[q] = fmaxf(mx[q], shx(mx[q], 16, f_lane)); mx[q] = fmaxf(mx[q], shx(mx[q], 32, f_lane)); }
            __syncthreads();
            if (rk == 0) { LAS float* d = cmax + F.wave * 64 + cc; d[0] = mx[0]; d[1] = mx[1]; d[2] = mx[2]; d[3] = mx[3]; }
            __syncthreads();
            const float target = dn ? 240.f : 127.f;
            if (f_tid < 64) { float m8 = 0.f;
#pragma unroll
                for (int w = 0; w < 8; ++w) m8 = fmaxf(m8, cmax[w * 64 + f_tid]);
                const int ng = strip * 64 + f_tid, dr = dn ? ng : (ng >> 8) * 256 + (ng & 1) * 128 + ((ng >> 1) & 127);
                float* sc = wo ? (float*)(ws + WS_SWO) + (size_t)le * 1024 : (dn ? (float*)(ws + WS_SWDN) + (size_t)le * 1024 : (float*)(ws + WS_SWGU) + (size_t)le * 2048);
                sc[dr] = (m8 > 0.f) ? m8 / target : 1.f;
                cinv[f_tid] = (m8 > 0.f) ? target / m8 : 0.f; }
            __syncthreads();
            const f32x4 iv = *(const LAS f32x4*)(cinv + cc);
#pragma unroll
            for (int ip = 0; ip < 8; ++ip) {
#pragma unroll
                for (int q = 0; q < 4; ++q) { unsigned w = 0;
                    if (dn) { int t = __builtin_amdgcn_cvt_pk_fp8_f32(v[4 * ip][q] * iv[q], v[4 * ip + 1][q] * iv[q], 0, false); t = __builtin_amdgcn_cvt_pk_fp8_f32(v[4 * ip + 2][q] * iv[q], v[4 * ip + 3][q] * iv[q], t, true); w = (unsigned)t; }
                    else {
#pragma unroll
                        for (int j = 0; j < 4; ++j) { int qi = __float2int_rn(v[4 * ip + j][q] * iv[q]); qi = qi > 127 ? 127 : (qi < -127 ? -127 : qi); w |= ((unsigned)qi & 255u) << (8 * j); } }
                    scr8[(cc + q) * 33 + 4 * ip + rk] = w; } }
            LDS_WAIT(); asm volatile("" ::: "memory");
            { const int c8 = f_lane & 7;
              unsigned char* dst = wo ? (unsigned char*)(ws + WS_WO8) + (size_t)le * 1024 * 1024 : (dn ? (unsigned char*)(ws + WS_WDN) + (size_t)le * 1024 * 1024 : (unsigned char*)(ws + WS_WGU) + (size_t)le * 2048 * 1024);
#pragma unroll
              for (int jp = 0; jp < 8; ++jp) { const int n = (f_lane >> 3) + 8 * jp; const LAS unsigned* sp = scr8 + n * 33 + 4 * c8;
                  v4u o; o.x = sp[0]; o.y = sp[1]; o.z = sp[2]; o[3] = sp[3];
                  const int ng = strip * 64 + n, dr = dn ? ng : (ng >> 8) * 256 + (ng & 1) * 128 + ((ng >> 1) & 127);
                  *(v4u*)(dst + (size_t)dr * 1024 + F.wave * 128 + 16 * c8) = o; } }
            LDS_WAIT(); asm volatile("" ::: "memory");
        }
        __syncthreads();
    }
    const int gtid = blockIdx.x * 512 + f_tid, gthreads = F.G * 512;
    for (int i = gtid; i < (MLA_IN_PAD - MLA_IN) * D / 8; i += gthreads) ((v4u*)((bf16*)(ws + WS_WMIN) + (size_t)MLA_IN * D))[i] = (v4u){0u, 0u, 0u, 0u};
    {
        bf16* MA = (bf16*)(ws + WS_MA);
        for (int i = gtid; i < 256 * 256; i += gthreads) { const int row = i >> 8, col = i & 255, jp = row >> 7, pp = (row >> 6) & 1, k1 = row & 63, j = col >> 7, pt = (col >> 6) & 1, l1 = col & 63;
            float v = 0.f; if (j == jp) { const float x = 2.f * (float)((k1 * l1) & 63) / 64.f; const float cs = cospif(x), sn = sinpif(x); v = (pp == 0) ? (pt == 0 ? cs : sn) : (pt == 0 ? -sn : cs); }
            MA[i] = (bf16)(pk2(v, 0.f) & 0xffffu); }
        bf16* DC = (bf16*)(ws + WS_DC); const float sc = 1.0f / sqrtf(256.f * 128.f);
        for (int i = gtid; i < 256 * 512; i += gthreads) { const int k = i >> 9, col = i & 511, pt = col >> 8, l = col & 255; const float x = 2.f * (float)((k * l) & 255) / 256.f;
            const float v = (pt == 0 ? cospif(x) : sinpif(x)) * sc; DC[i] = (bf16)(pk2(v, 0.f) & 0xffffu); }
        bf16* MC = (bf16*)(ws + WS_MC); const float sl = 1.0f / sqrtf(4096.f * 128.f);
        for (int i = gtid; i < 16 * 256 * 512; i += gthreads) { const int kq = i >> 17, row = (i >> 9) & 255, col = i & 511, kkp = row >> 6, k2 = row & 63, kk = col >> 7, pp = (col >> 6) & 1, l2 = col & 63;
            float v = 0.f; if (kk == kkp) { const int k = 4 * kq + kkp + 64 * k2; const float x = 2.f * (float)((l2 * k) & 4095) / 4096.f; v = (pp == 0 ? cospif(x) : sinpif(x)) * sl; }
            MC[i] = (bf16)(pk2(v, 0.f) & 0xffffu); }
        float* RM = (float*)(ws + WS_ROPE); float* RG = RM + 2048;
        for (int i = gtid; i < 64 * 8; i += gthreads) { const int pos = i >> 3, f = i & 7; const float inv = powf(10000.f, -(float)f / 8.f); float s, c; sincosf((float)pos * inv, &s, &c); RM[2 * i] = c; RM[2 * i + 1] = s; }
        for (int i = gtid; i < 64 * 16; i += gthreads) { const int pos = i >> 4, f = i & 15; const float inv = powf(10000.f, -(float)f / 16.f); float s, c; sincosf((float)pos * inv, &s, &c); RG[2 * i] = c; RG[2 * i + 1] = s; }
        float* WRT = (float*)(ws + WS_WRT);
        for (int i = gtid; i < DEPTH * NE * D; i += gthreads) { const int l = i >> 15, e = (i >> 10) & 31, k = i & 1023; WRT[i] = a.in[21][((size_t)l * D + k) * NE + e]; }
        float* BG = (float*)(ws + WS_BGU);
        for (int i = gtid; i < DEPTH * NE * 2048; i += gthreads) { const int le = i >> 11, q = i & 2047, pn = q >> 8, s = (q >> 7) & 1, jj = q & 127; BG[i] = a.in[24][(size_t)le * 2048 + 2 * (pn * 128 + jj) + s]; }
    }
    __syncthreads();
    {
        LAS float* wl = (LAS float*)F.lds;
        LAS float* tc = wl + 2048; LAS float* ts = tc + 128;
        if (f_tid < 128) { const float x = 2.f * (float)f_tid / 128.f; tc[f_tid] = cospif(x); ts[f_tid] = -sinpif(x); }
        for (int it = blockIdx.x; it < 2 * 8 * 64; it += F.G) { const int j = it >> 9, g = (it >> 6) & 7, kb = it & 63;
            __syncthreads();
            { const int kk = f_tid >> 5, c4 = (f_tid & 31) * 4; const f32x4 w = *(const f32x4*)(a.in[9] + ((size_t)j * D + kb * 16 + kk) * D + g * 128 + c4);
              LAS float* d = wl + c4 * 16 + kk; d[0] = w[0]; d[16] = w[1]; d[32] = w[2]; d[48] = w[3]; }
            __syncthreads();
            const int cl = f_tid & 255, m = cl >> 1, part = cl & 1, kh = f_tid >> 8; const LAS float* tw = part ? ts : tc;
            float accv[8];
#pragma unroll
            for (int q = 0; q < 8; ++q) accv[q] = 0.f;
            for (int jj = 0; jj < 128; ++jj) { const float t = tw[(m * jj) & 127]; const f32x4 wa = *(const LAS f32x4*)(wl + jj * 16 + kh * 8), wb = *(const LAS f32x4*)(wl + jj * 16 + kh * 8 + 4);
                accv[0] += wa[0] * t; accv[1] += wa[1] * t; accv[2] += wa[2] * t; accv[3] += wa[3] * t; accv[4] += wb[0] * t; accv[5] += wb[1] * t; accv[6] += wb[2] * t; accv[7] += wb[3] * t; }
            v4u o; o.x = pk2(accv[0], accv[1]); o.y = pk2(accv[2], accv[3]); o.z = pk2(accv[4], accv[5]); o.w = pk2(accv[6], accv[7]);
            *(v4u*)((bf16*)(ws + WS_WFIN) + ((size_t)j * 2048 + g * 256 + cl) * D + kb * 16 + kh * 8) = o;
        }
        __syncthreads();
    }
    {
        LAS float* S = (LAS float*)F.lds;
        LAS float* red = S + 9 * 1024;
        for (int i = f_tid; i < 9 * 1024; i += 512) { const int r = i >> 10, k = i & 1023; const float v = (r < 8) ? a.in[1][r * D + k] : a.in[3][k]; S[i] = v / (1.f + __expf(-v)); }
        __syncthreads();
        for (int it = blockIdx.x; it < DEPTH * 96; it += F.G) { const int l = it / 96, n0 = (it % 96) * 64;
            const float* wp = a.in[4] + ((size_t)l * D + F.wave * 128) * (NMOD * D) + n0 + f_lane;
            float accv[9];
#pragma unroll
            for (int r = 0; r < 9; ++r) accv[r] = 0.f;
            for (int k0 = 0; k0 < 128; k0 += 32) { float wv[32];
#pragma unroll
                for (int k = 0; k < 32; ++k) wv[k] = wp[(size_t)(k0 + k) * (NMOD * D)];
#pragma unroll
                for (int k = 0; k < 32; ++k)
#pragma unroll
                    for (int r = 0; r < 9; ++r) accv[r] += S[r * 1024 + F.wave * 128 + k0 + k] * wv[k]; }
#pragma unroll
            for (int r = 0; r < 9; ++r) red[(F.wave * 9 + r) * 64 + f_lane] = accv[r];
            __syncthreads();
            for (int i = f_tid; i < 9 * 64; i += 512) { const int r = i >> 6, ln = i & 63; float s = a.in[5][(size_t)l * (NMOD * D) + n0 + ln];
#pragma unroll
                for (int w = 0; w < 8; ++w) s += red[(w * 9 + r) * 64 + ln];
                ((float*)(ws + WS_MOD))[((size_t)l * 9 + r) * (NMOD * D) + n0 + ln] = s; }
            __syncthreads();
        }
    }
}

__device__ __forceinline__ void load_row(const float* p, int lane, f32x4 (&v)[4]) {
#pragma unroll
    for (int j = 0; j < 4; ++j) v[j] = ((const f32x4*)p)[lane + 64 * j];
}
__device__ __forceinline__ void load_row_bf(const bf16* p, int lane, f32x4 (&v)[4]) {
#pragma unroll
    for (int j = 0; j < 4; ++j) { const v2u w = ((const v2u*)p)[lane + 64 * j]; v[j] = (f32x4){bf_lo(w.x), bf_hi(w.x), bf_lo(w.y), bf_hi(w.y)}; }
}
__device__ __forceinline__ void norm_mod(f32x4 (&v)[4], const float* g, const float* shift, const float* scale, int lane) {
    float s = 0.f;
#pragma unroll
    for (int j = 0; j < 4; ++j) s += (v[j][0] * v[j][0] + v[j][1] * v[j][1]) + (v[j][2] * v[j][2] + v[j][3] * v[j][3]);
    const float rstd = rsqrtf(wave_sum(s, lane) * (1.f / D) + EPS);
#pragma unroll
    for (int j = 0; j < 4; ++j) { const f32x4 gv = ((const f32x4*)g)[lane + 64 * j], sh = ((const f32x4*)shift)[lane + 64 * j], sc = ((const f32x4*)scale)[lane + 64 * j];
        v[j] = (v[j] * rstd * gv) * (sc + 1.f) + sh; }
}
__device__ __forceinline__ void store_row_bf16(bf16* p, int lane, const f32x4 (&v)[4]) {
#pragma unroll
    for (int j = 0; j < 4; ++j) { v2u w; w.x = pk2(v[j][0], v[j][1]); w.y = pk2(v[j][2], v[j][3]); ((v2u*)p)[lane + 64 * j] = w; }
}

__device__ __forceinline__ float store_row_i8(unsigned char* p, int lane, const f32x4 (&v)[4]) {
    float am = 0.f;
#pragma unroll
    for (int j = 0; j < 4; ++j) am = fmaxf(fmaxf(am, fmaxf(fabsf(v[j][0]), fabsf(v[j][1]))), fmaxf(fabsf(v[j][2]), fabsf(v[j][3])));
    unsigned k = __float_as_uint(am);
    { unsigned t;
      t = (unsigned)__builtin_amdgcn_mov_dpp((int)k, 0xb1, 0xf, 0xf, false); k = k > t ? k : t;
      t = (unsigned)__builtin_amdgcn_mov_dpp((int)k, 0x4e, 0xf, 0xf, false); k = k > t ? k : t;
      t = (unsigned)__builtin_amdgcn_mov_dpp((int)k, 0x124, 0xf, 0xf, false); k = k > t ? k : t;
      t = (unsigned)__builtin_amdgcn_mov_dpp((int)k, 0x128, 0xf, 0xf, false); k = k > t ? k : t;
      const unsigned a = (unsigned)__builtin_amdgcn_readlane((int)k, 0), b = (unsigned)__builtin_amdgcn_readlane((int)k, 16), c = (unsigned)__builtin_amdgcn_readlane((int)k, 32), d = (unsigned)__builtin_amdgcn_readlane((int)k, 48);
      const unsigned ab = a > b ? a : b, cd = c > d ? c : d; k = ab > cd ? ab : cd; }
    const float amax = __uint_as_float(k);
    const float qscale = amax > 0.f ? amax * (1.f / 127.f) : 1.f, qinv = amax > 0.f ? 127.f / amax : 0.f;
#pragma unroll
    for (int j = 0; j < 4; ++j) { unsigned w = 0;
#pragma unroll
        for (int q = 0; q < 4; ++q) { int qi = __float2int_rn(v[j][q] * qinv); qi = qi > 127 ? 127 : (qi < -127 ? -127 : qi); w |= ((unsigned)qi & 255u) << (8 * q); }
        ((unsigned*)p)[lane + 64 * j] = w; }
    return qscale;
}
__device__ __forceinline__ void quant_rows(Frame& F, const bf16* src, unsigned char* dst, float* scale, int R) {
    const int f_lane = lthread(F.wave) & 63;
    for (int r = F.gw; r < R; r += F.NGW) { f32x4 v[4]; load_row_bf(src + (size_t)r * 1024, f_lane, v);
        const float sc = store_row_i8(dst + (size_t)r * 1024, f_lane, v); if (f_lane == 0) scale[r] = sc; }
}
__device__ __forceinline__ void rp_norm1(Frame& F, const Args& a, int l, int row_lo) {
    const int f_tid = lthread(F.wave), f_lane = f_tid & 63;
    const bf16* X = (const bf16*)(F.ws + WS_X); bf16* H = (bf16*)(F.ws + WS_H); const float* MOD = (const float*)(F.ws + WS_MOD) + (size_t)l * 9 * (NMOD * D);
    for (int row = row_lo + F.gw; row < NT; row += F.NGW) { f32x4 v[4];
        if (l == 0) { load_row(row < NC ? a.in[2] + (size_t)row * D : a.in[0] + (size_t)(row - NC) * D, f_lane, v);
            store_row_bf16((bf16*)(F.ws + WS_X) + (size_t)row * D, f_lane, v); }
        else load_row_bf(X + (size_t)row * D, f_lane, v);
        const float* m = MOD + (size_t)modrow_of(row) * (NMOD * D);
        norm_mod(v, a.in[6] + (size_t)l * D, m, m + D, f_lane);
        const float sc = store_row_i8((unsigned char*)H + (size_t)row * D, f_lane, v); if (f_lane == 0) ((float*)(F.ws + WS_SH))[row] = sc; }
}

#if MK_N2V2
constexpr int LDS_LIST = LDS_MISC + 768;
__device__ __forceinline__ unsigned row16_max(unsigned k) {
    unsigned t;
    t = (unsigned)__builtin_amdgcn_mov_dpp((int)k, 0xb1, 0xf, 0xf, false); k = k > t ? k : t;
    t = (unsigned)__builtin_amdgcn_mov_dpp((int)k, 0x4e, 0xf, 0xf, false); k = k > t ? k : t;
    t = (unsigned)__builtin_amdgcn_mov_dpp((int)k, 0x124, 0xf, 0xf, false); k = k > t ? k : t;
    t = (unsigned)__builtin_amdgcn_mov_dpp((int)k, 0x128, 0xf, 0xf, false); k = k > t ? k : t;
    return k;
}
__device__ __forceinline__ unsigned wave_max_u(unsigned k) {
    k = row16_max(k);
    const unsigned a = (unsigned)__builtin_amdgcn_readlane((int)k, 0), b = (unsigned)__builtin_amdgcn_readlane((int)k, 16), c = (unsigned)__builtin_amdgcn_readlane((int)k, 32), d = (unsigned)__builtin_amdgcn_readlane((int)k, 48);
    const unsigned ab = a > b ? a : b, cd = c > d ? c : d; return ab > cd ? ab : cd;
}
__device__ __forceinline__ float key_val(unsigned m) { const unsigned u = m & ~31u; return __builtin_bit_cast(float, (u & 0x80000000u) ? (u ^ 0x80000000u) : ~u); }
constexpr int N2_WPITCH = 2064;
constexpr int N2_GM = 32 * N2_WPITCH;
constexpr int N2_LIST = N2_GM + 5 * 8192;
__device__ __forceinline__ void rp_norm2_router(Frame& F, const Args& a, int l, int row_lo) {
    const int f_tid = lthread(F.wave), f_lane = f_tid & 63;
    const bf16* X = (const bf16*)(F.ws + WS_X); unsigned char* H8 = (unsigned char*)(F.ws + WS_H); const float* MOD = (const float*)(F.ws + WS_MOD) + (size_t)l * 9 * (NMOD * D);
    LAS unsigned char* WT = F.lds;
    { const f32x4* src = (const f32x4*)((const float*)(F.ws + WS_WRT) + (size_t)l * NE * D); f32x4 tv[16];
#pragma unroll
      for (int i = 0; i < 16; ++i) tv[i] = src[f_tid + 512 * i];
#pragma unroll
      for (int i = 0; i < 16; ++i) { const int i4 = f_tid + 512 * i, e = i4 >> 8, k4 = (i4 & 255) * 4; v2u w; w.x = pk2(tv[i][0], tv[i][1]); w.y = pk2(tv[i][2], tv[i][3]); *(LAS v2u*)(WT + e * N2_WPITCH + k4 * 2) = w; } }
    LAS int* lcnt = (LAS int*)(F.lds + LDS_TT); LAS int* lbase = lcnt + 32;
    if (f_tid < 32) lcnt[f_tid] = 0;
    const int ngroups = (NT - row_lo) >> 5;
    const int g = F.wave * F.G + (int)blockIdx.x;
    const bool active = (F.wave < 5) && (g < ngroups);
    LAS float* GM = (LAS float*)(F.lds + N2_GM + (F.wave < 5 ? F.wave : 0) * 8192); LAS float* SH = GM + 1024;
    LAS v4u* list = (LAS v4u*)(F.lds + N2_LIST + (F.wave < 5 ? F.wave : 0) * (128 * 16 + 128)); LAS float* lsc = (LAS float*)(list + 128);
    const int r = f_lane & 31, kh = f_lane >> 5;
    const int row = row_lo + g * 32 + r;
    float msh = 0.f;
    if (active) {
        const float* m = MOD + (size_t)modrow_of(row_lo + g * 32) * (NMOD * D); const float* gf = a.in[7] + (size_t)l * D;
#pragma unroll
        for (int j = 0; j < 4; ++j) { const f32x4 gv = ((const f32x4*)gf)[f_lane + 64 * j], sc = ((const f32x4*)(m + 4 * D))[f_lane + 64 * j], sv = ((const f32x4*)(m + 3 * D))[f_lane + 64 * j];
            ((LAS f32x4*)GM)[f_lane + 64 * j] = gv * (sc + 1.f); ((LAS f32x4*)SH)[f_lane + 64 * j] = sv;
            msh = fmaxf(fmaxf(msh, fmaxf(fabsf(sv[0]), fabsf(sv[1]))), fmaxf(fabsf(sv[2]), fabsf(sv[3]))); }
        msh = __uint_as_float(wave_max_u(__float_as_uint(msh)));
    }
    __syncthreads();
    if (active) {
        const bf16* xr = X + (size_t)row * D + 16 * kh;
        float ssq = 0.f, mxg = 0.f;
#pragma unroll 1
        for (int c0 = 0; c0 < 32; c0 += 8) { v4u xa[8], xb[8];
#pragma unroll
            for (int i = 0; i < 8; ++i) { xa[i] = *(const v4u*)(xr + 32 * (c0 + i)); xb[i] = *(const v4u*)(xr + 32 * (c0 + i) + 8); }
#pragma unroll
            for (int i = 0; i < 8; ++i) { const LAS f32x4* gp = (const LAS f32x4*)(GM + 32 * (c0 + i) + 16 * kh);
                const f32x4 g0 = gp[0], g1 = gp[1], g2 = gp[2], g3 = gp[3];
                const unsigned wa[4] = {xa[i].x, xa[i].y, xa[i].z, xa[i][3]}, wb[4] = {xb[i].x, xb[i].y, xb[i].z, xb[i][3]};
#pragma unroll
                for (int q = 0; q < 4; ++q) { const float x0 = bf_lo(wa[q]), x1 = bf_hi(wa[q]), x2 = bf_lo(wb[q]), x3 = bf_hi(wb[q]);
                    ssq += x0 * x0 + x1 * x1 + x2 * x2 + x3 * x3;
                    const float ga = (q < 2 ? g0 : g1)[(2 * q) & 3], gb = (q < 2 ? g0 : g1)[(2 * q + 1) & 3], gc = (q < 2 ? g2 : g3)[(2 * q) & 3], gd = (q < 2 ? g2 : g3)[(2 * q + 1) & 3];
                    mxg = fmaxf(fmaxf(mxg, fmaxf(fabsf(x0 * ga), fabsf(x1 * gb))), fmaxf(fabsf(x2 * gc), fabsf(x3 * gd))); } } }
        { auto rr = __builtin_amdgcn_permlane32_swap(__float_as_uint(ssq), __float_as_uint(ssq), false, false); ssq = __uint_as_float(rr[0]) + __uint_as_float(rr[1]); }
        { auto rr = __builtin_amdgcn_permlane32_swap(__float_as_uint(mxg), __float_as_uint(mxg), false, false); mxg = fmaxf(__uint_as_float(rr[0]), __uint_as_float(rr[1])); }
        const float rstd = rsqrtf(ssq * (1.f / D) + EPS);
        const float bound = mxg * rstd + msh;
        const float qscale = bound > 0.f ? bound * (1.f / 127.f) : 1.f, qinv = bound > 0.f ? 127.f / bound : 0.f;
        f32x16 acc = f32x16{};
        unsigned char* hrow = H8 + (size_t)row * D + 16 * kh;
        const LAS unsigned char* wrow = WT + r * N2_WPITCH + 32 * kh;
#pragma unroll 1
        for (int c0 = 0; c0 < 32; c0 += 4) { v4u xa[4], xb[4];
#pragma unroll
            for (int i = 0; i < 4; ++i) { xa[i] = *(const v4u*)(xr + 32 * (c0 + i)); xb[i] = *(const v4u*)(xr + 32 * (c0 + i) + 8); }
#pragma unroll
            for (int i = 0; i < 4; ++i) { const int c = c0 + i;
                const LAS f32x4* gp = (const LAS f32x4*)(GM + 32 * c + 16 * kh); const LAS f32x4* sp = (const LAS f32x4*)(SH + 32 * c + 16 * kh);
                const bf16x8 w0 = *(const LAS bf16x8*)(wrow + 64 * c), w1 = *(const LAS bf16x8*)(wrow + 64 * c + 16);
                float h[16];
                const unsigned wa[4] = {xa[i].x, xa[i].y, xa[i].z, xa[i][3]}, wb[4] = {xb[i].x, xb[i].y, xb[i].z, xb[i][3]};
#pragma unroll
                for (int q = 0; q < 4; ++q) { h[2 * q] = bf_lo(wa[q]); h[2 * q + 1] = bf_hi(wa[q]); h[8 + 2 * q] = bf_lo(wb[q]); h[8 + 2 * q + 1] = bf_hi(wb[q]); }
#pragma unroll
                for (int q = 0; q < 4; ++q) { const f32x4 gq = gp[q], sq = sp[q];
#pragma unroll
                    for (int e = 0; e < 4; ++e) h[4 * q + e] = (h[4 * q + e] * rstd) * gq[e] + sq[e]; }
                v4u o8;
#pragma unroll
                for (int q = 0; q < 4; ++q) { unsigned w = 0;
#pragma unroll
                    for (int e = 0; e < 4; ++e) w |= ((unsigned)__float2int_rn(h[4 * q + e] * qinv) & 255u) << (8 * e);
                    o8[q] = w; }
                *(v4u*)(hrow + 32 * c) = o8;
                v4u hi0, hi1, lo0, lo1;
#pragma unroll
                for (int q = 0; q < 4; ++q) { hi0[q] = pk2(h[2 * q], h[2 * q + 1]); hi1[q] = pk2(h[8 + 2 * q], h[8 + 2 * q + 1]); }
#pragma unroll
                for (int q = 0; q < 4; ++q) { lo0[q] = pk2(h[2 * q] - bf_lo(hi0[q]), h[2 * q + 1] - bf_hi(hi0[q])); lo1[q] = pk2(h[8 + 2 * q] - bf_lo(hi1[q]), h[8 + 2 * q + 1] - bf_hi(hi1[q])); }
                acc = __builtin_amdgcn_mfma_f32_32x32x16_bf16(w0, __builtin_bit_cast(bf16x8, hi0), acc, 0, 0, 0);
                acc = __builtin_amdgcn_mfma_f32_32x32x16_bf16(w0, __builtin_bit_cast(bf16x8, lo0), acc, 0, 0, 0);
                acc = __builtin_amdgcn_mfma_f32_32x32x16_bf16(w1, __builtin_bit_cast(bf16x8, hi1), acc, 0, 0, 0);
                acc = __builtin_amdgcn_mfma_f32_32x32x16_bf16(w1, __builtin_bit_cast(bf16x8, lo1), acc, 0, 0, 0); } }
        float val[32];
        const float* br = a.in[22] + (size_t)l * NE;
#pragma unroll
        for (int j = 0; j < 16; ++j) { auto rr = __builtin_amdgcn_permlane32_swap(__float_as_uint(acc[j]), __float_as_uint(acc[j]), false, false);
            const int e0 = (j & 3) + 8 * (j >> 2); val[e0] = __uint_as_float(rr[0]) + br[e0]; val[e0 + 4] = __uint_as_float(rr[1]) + br[e0 + 4]; }
        unsigned taken = 0u; int be[4]; float bv[4];
#pragma unroll
        for (int k = 0; k < 4; ++k) { float best = -INFINITY; int bi = 0;
#pragma unroll
            for (int e = 0; e < 32; ++e) { const bool cnd = !((taken >> e) & 1u) && (val[e] > best); best = cnd ? val[e] : best; bi = cnd ? e : bi; }
            taken |= 1u << bi; be[k] = bi; bv[k] = best; }
        const float e1 = __expf(bv[1] - bv[0]), e2 = __expf(bv[2] - bv[0]), e3 = __expf(bv[3] - bv[0]); const float inv = 1.f / (1.f + e1 + e2 + e3);
        if (kh == 0) { const float ww[4] = {inv, e1 * inv, e2 * inv, e3 * inv};
#pragma unroll
            for (int k = 0; k < 4; ++k) { const int lr = __hip_atomic_fetch_add(lcnt + be[k], 1, __ATOMIC_RELAXED, __HIP_MEMORY_SCOPE_WORKGROUP);
                LAS unsigned* ep = (LAS unsigned*)(list + r * 4 + k); ep[0] = (unsigned)(row * 4 + k); ep[1] = (unsigned)be[k]; ep[2] = (unsigned)lr; ep[3] = __builtin_bit_cast(unsigned, ww[k]); }
            lsc[r] = qscale; }
    }
    __syncthreads();
    if (f_tid < 32) { const int c = lcnt[f_tid]; lbase[f_tid] = c ? (int)__hip_atomic_fetch_add((unsigned*)(F.ctl + CW_CNT + (l * 32 + f_tid) * 16), (unsigned)c, RLX_AGENT) : 0; }
    __syncthreads();
    if (active) {
        int* te = (int*)(F.ws + WS_TE); int* trank = (int*)(F.ws + WS_TRANK); int* stok = (int*)(F.ws + WS_STOK); float* sw = (float*)(F.ws + WS_SW); float* ssc = (float*)(F.ws + WS_SSC);
#pragma unroll
        for (int i = f_lane; i < 128; i += 64) { const LAS unsigned* ep = (const LAS unsigned*)(list + i); const unsigned rowk = ep[0], ex = ep[1], lr = ep[2]; const float wv = __builtin_bit_cast(float, ep[3]);
            const int rk = lbase[ex] + (int)lr;
            stok[(size_t)ex * CAP + rk] = (int)(rowk >> 2); sw[(size_t)ex * CAP + rk] = wv; ssc[(size_t)ex * CAP + rk] = lsc[i >> 2]; te[rowk] = (int)ex; trank[rowk] = rk; }
    }
}

#endif
__device__ __forceinline__ void moe_table(Frame& F, int l) {
    const int f_tid = lthread(F.wave), f_lane = f_tid & 63;
    LAS int* TT = (LAS int*)(F.lds + LDS_TT); LAS int* CN = TT + 64; LAS int* TE = (LAS int*)(F.lds + LDS_TE);
    __syncthreads();
    if (f_tid < 64) {
        const int c = (f_lane < 32) ? (int)__hip_atomic_load((unsigned*)(F.ctl + CW_CNT + (l * 32 + (f_lane & 31)) * 16), RLX_AGENT) : 0;
        const int tl = (c + 255) >> 8; int v = tl;
#pragma unroll
        for (int o = 1; o < 32; o <<= 1) { const int n = __builtin_amdgcn_ds_bpermute((f_lane >= o ? f_lane - o : f_lane) << 2, v); if (f_lane >= o) v += n; }
        if (f_lane < 32) { CN[f_lane] = c; TT[f_lane] = v - tl; if (f_lane == 31) TT[32] = v; }
    }
    __syncthreads();
    for (int t = f_tid; t < MAXTILES; t += 512) { int lo = 0, hi = 32;
#pragma unroll
        for (int k = 0; k < 5; ++k) { const int mid = (lo + hi) >> 1; if (TT[mid] <= t) lo = mid; else hi = mid; }
        TE[t] = lo; }
    __syncthreads();
}

#if MK_CBV2
struct CombRow { v4u x[2]; v4u y[4]; };
__device__ __forceinline__ void comb_issue(CombRow& R, const bf16* X, const unsigned char* Y, const LAS int* TT, int row, const v4u te4, const v4u tr4, int lane) {
    const unsigned ee[4] = {te4[0], te4[1], te4[2], te4[3]}, rr[4] = {tr4[0], tr4[1], tr4[2], tr4[3]};
#pragma unroll
    for (int k = 0; k < 4; ++k) { const size_t slot = (size_t)TT[ee[k]] * 256 + rr[k]; R.y[k] = *(const v4u*)(Y + slot * 1024 + 16 * lane); }
    const bf16* xp = X + (size_t)row * D + 16 * lane; R.x[0] = *(const v4u*)xp; R.x[1] = *(const v4u*)(xp + 8);
}
__device__ __forceinline__ void comb_finish(const CombRow& R, Frame& F, const Args& a, int l, int row, int lane, const float* MOD, const float* MODN, bool lastl) {
    bf16* X = (bf16*)(F.ws + WS_X); unsigned char* H8 = (unsigned char*)(F.ws + WS_H);
    const int mr = modrow_of(row); const float* g5 = MOD + (size_t)mr * (NMOD * D) + 5 * D + 16 * lane;
    float v[16];
#pragma unroll
    for (int w = 0; w < 4; ++w) { f32x4 s = (f32x4){0.f, 0.f, 0.f, 0.f};
#pragma unroll
        for (int k = 0; k < 4; ++k) { const int yw = (int)R.y[k][w]; const f32x2 lo = __builtin_amdgcn_cvt_pk_f32_fp8(yw, false), hi = __builtin_amdgcn_cvt_pk_f32_fp8(yw, true); s[0] += lo[0]; s[1] += lo[1]; s[2] += hi[0]; s[3] += hi[1]; }
        const f32x4 gv = ((const f32x4*)g5)[w]; const unsigned x0 = R.x[w >> 1][(2 * w) & 3], x1 = R.x[w >> 1][(2 * w + 1) & 3];
        v[4 * w] = bf_lo(x0) + gv[0] * s[0] * 0.125f; v[4 * w + 1] = bf_hi(x0) + gv[1] * s[1] * 0.125f; v[4 * w + 2] = bf_lo(x1) + gv[2] * s[2] * 0.125f; v[4 * w + 3] = bf_hi(x1) + gv[3] * s[3] * 0.125f; }
    float ss = 0.f;
#pragma unroll
    for (int i = 0; i < 16; ++i) ss += v[i] * v[i];
    const float rstd = rsqrtf(wave_sum(ss, lane) * (1.f / D) + EPS);
    if (!lastl) {
        bf16* xo = X + (size_t)row * D + 16 * lane;
        { v4u o0, o1;
#pragma unroll
          for (int q = 0; q < 4; ++q) { o0[q] = pk2(v[2 * q], v[2 * q + 1]); o1[q] = pk2(v[8 + 2 * q], v[8 + 2 * q + 1]); }
          *(v4u*)xo = o0; *(v4u*)(xo + 8) = o1; }
        const float* m = MODN + (size_t)mr * (NMOD * D) + 16 * lane; const float* gx = a.in[6] + (size_t)(l + 1) * D + 16 * lane;
        float am = 0.f;
#pragma unroll
        for (int w = 0; w < 4; ++w) { const f32x4 gv = ((const f32x4*)gx)[w], sh = ((const f32x4*)m)[w], sc = ((const f32x4*)(m + D))[w];
#pragma unroll
            for (int e = 0; e < 4; ++e) { const float h = (v[4 * w + e] * rstd * gv[e]) * (sc[e] + 1.f) + sh[e]; v[4 * w + e] = h; am = fmaxf(am, fabsf(h)); } }
        const float amax = __uint_as_float(wave_max_u(__float_as_uint(am)));
        const float qscale = amax > 0.f ? amax * (1.f / 127.f) : 1.f, qinv = amax > 0.f ? 127.f / amax : 0.f;
        v4u o8;
#pragma unroll
        for (int w = 0; w < 4; ++w) { unsigned u = 0;
#pragma unroll
            for (int e = 0; e < 4; ++e) { int qi = __float2int_rn(v[4 * w + e] * qinv); qi = qi > 127 ? 127 : (qi < -127 ? -127 : qi); u |= ((unsigned)qi & 255u) << (8 * e); }
            o8[w] = u; }
        *(v4u*)(H8 + (size_t)row * D + 16 * lane) = o8;
        if (lane == 0) ((float*)(F.ws + WS_SH))[row] = qscale;
    } else {
        float* op = a.out + (size_t)(row - NC) * D + 16 * lane; const float* gf = a.in[8] + 16 * lane;
#pragma unroll
        for (int w = 0; w < 4; ++w) { const f32x4 gv = ((const f32x4*)gf)[w]; ((f32x4*)op)[w] = (f32x4){v[4 * w] * rstd * gv[0], v[4 * w + 1] * rstd * gv[1], v[4 * w + 2] * rstd * gv[2], v[4 * w + 3] * rstd * gv[3]}; }
    }
}
__device__ __forceinline__ void rp_combine(Frame& F, const Args& a, int l, int row_lo) {
    const int f_tid = lthread(F.wave), f_lane = f_tid & 63;
    const bf16* X = (const bf16*)(F.ws + WS_X); const unsigned char* Y = (const unsigned char*)(F.ws + WS_Y);
    const float* MOD = (const float*)(F.ws + WS_MOD) + (size_t)l * 9 * (NMOD * D); const float* MODN = MOD + 9 * (NMOD * D);
    const v4u* te = (const v4u*)(F.ws + WS_TE); const v4u* trank = (const v4u*)(F.ws + WS_TRANK);
    const LAS int* TT = (const LAS int*)(F.lds + LDS_TT);
    const bool lastl = (l == DEPTH - 1);
    const int st = F.NGW, row0 = row_lo + F.gw;
    if (row0 >= NT) return;
    const int n = (NT - row0 + st - 1) / st, rlast = row0 + (n - 1) * st;
#define CROW(i) ((row0 + (i) * st) <= rlast ? (row0 + (i) * st) : rlast)
    CombRow RA, RB;
    v4u teA = te[CROW(0)], trA = trank[CROW(0)], teB = te[CROW(1)], trB = trank[CROW(1)];
    comb_issue(RA, X, Y, TT, CROW(0), teA, trA, f_lane);
    for (int i = 0; i < n; i += 2) {
        comb_issue(RB, X, Y, TT, CROW(i + 1), teB, trB, f_lane);
        teA = te[CROW(i + 2)]; trA = trank[CROW(i + 2)];
        comb_finish(RA, F, a, l, CROW(i), f_lane, MOD, MODN, lastl);
        comb_issue(RA, X, Y, TT, CROW(i + 2), teA, trA, f_lane);
        teB = te[CROW(i + 3)]; trB = trank[CROW(i + 3)];
        if (i + 1 < n) comb_finish(RB, F, a, l, CROW(i + 1), f_lane, MOD, MODN, lastl);
    }
#undef CROW
}
#endif

__device__ __forceinline__ void rp_mla(Frame& F, const Args& a) {
    const int f_tid = lthread(F.wave), f_lane = f_tid & 63;
    const bf16* A = (const bf16*)(F.ws + WS_RE); bf16* QA = (bf16*)(F.ws + WS_RF); bf16* CKV = (bf16*)(F.ws + WS_RG); bf16* Kb = (bf16*)(F.ws + WS_RB);
    const float* rope = (const float*)(F.ws + WS_ROPE); const float* gq = a.in[12]; const float* gk = a.in[14];
    for (int row = F.gw; row < NT; row += F.NGW) {
        const unsigned* ap = (const unsigned*)(A + (size_t)row * MLA_IN_PAD);
        unsigned q[3], c[2];
#pragma unroll
        for (int j = 0; j < 3; ++j) q[j] = ap[f_lane + 64 * j];
#pragma unroll
        for (int j = 0; j < 2; ++j) c[j] = ap[192 + f_lane + 64 * j];
        const unsigned pe = ap[320 + (f_lane & 15)];
        float sq = 0.f, sc = 0.f;
#pragma unroll
        for (int j = 0; j < 3; ++j) { const float x0 = bf_lo(q[j]), x1 = bf_hi(q[j]); sq += x0 * x0 + x1 * x1; }
#pragma unroll
        for (int j = 0; j < 2; ++j) { const float x0 = bf_lo(c[j]), x1 = bf_hi(c[j]); sc += x0 * x0 + x1 * x1; }
        const float rq = rsqrtf(wave_sum(sq, f_lane) * (1.f / MLA_QL) + EPS), rc = rsqrtf(wave_sum(sc, f_lane) * (1.f / MLA_KVL) + EPS);
#pragma unroll
        for (int j = 0; j < 3; ++j) { const int e0 = 2 * (f_lane + 64 * j); ((unsigned*)(QA + (size_t)row * MLA_QL))[f_lane + 64 * j] = pk2(bf_lo(q[j]) * rq * gq[e0], bf_hi(q[j]) * rq * gq[e0 + 1]); }
#pragma unroll
        for (int j = 0; j < 2; ++j) { const int e0 = 2 * (f_lane + 64 * j); ((unsigned*)(CKV + (size_t)row * MLA_KVL))[f_lane + 64 * j] = pk2(bf_lo(c[j]) * rc * gk[e0], bf_hi(c[j]) * rc * gk[e0 + 1]); }
        float x0 = bf_lo(pe), x1 = bf_hi(pe);
        if (row >= NC) { const int t = (row - NC) & 4095, i = f_lane & 15, d = 2 * i, pos = (d & 16) ? (t & 63) : (t >> 6), f = d & 7;
            const float p0 = shx(x0, 4, f_lane), p1 = shx(x1, 4, f_lane); const float sg = (d & 8) ? 1.f : -1.f;
            const float* rp = rope + (size_t)pos * 16 + 2 * f; x0 = x0 * rp[0] + sg * p0 * rp[1]; x1 = x1 * rp[2] + sg * p1 * rp[3]; }
        const unsigned w = pk2(x0, x1);
        { const int i = f_lane & 15, hb = f_lane >> 4;
#pragma unroll
          for (int hh = 0; hh < 4; ++hh) { const int h = hb * 4 + hh; ((unsigned*)(Kb + (size_t)row * 1536 + 96 * h + 64))[i] = w; } }
    }
}

__device__ __forceinline__ void rp_gqa(Frame& F, const Args& a) {
    const int f_tid = lthread(F.wave), f_lane = f_tid & 63;
    const bf16* A = (const bf16*)(F.ws + WS_RA); bf16* Q = (bf16*)(F.ws + WS_RB); bf16* Kb = Q + (size_t)NT * 1024;
    const float* rope = (const float*)(F.ws + WS_ROPE) + 2048; const float* gq = a.in[18]; const float* gk = a.in[19];
    const float c2 = 0.125f * LOG2E;
    for (int row = F.gw; row < NT; row += F.NGW) {
        const bool lat = row >= NC; const int t = (row - NC) & 4095;
#pragma unroll
        for (int part = 0; part < 2; ++part) {
            const int ln = part ? (f_lane & 15) : f_lane; const bf16* src = A + (size_t)row * GQA_QKV + (part ? 1024 : 0) + ln * 16;
            const v4u w0 = *(const v4u*)src, w1 = *(const v4u*)(src + 8);
            float x[16]; const unsigned ww[8] = {w0.x, w0.y, w0.z, w0.w, w1.x, w1.y, w1.z, w1.w};
#pragma unroll
            for (int i = 0; i < 8; ++i) { x[2 * i] = bf_lo(ww[i]); x[2 * i + 1] = bf_hi(ww[i]); }
            float ss = 0.f;
#pragma unroll
            for (int i = 0; i < 16; ++i) ss += x[i] * x[i];
            ss += shx(ss, 1, f_lane); ss += shx(ss, 2, f_lane);
            const float rs = rsqrtf(ss * (1.f / 64.f) + EPS); const float* g = (part ? gk : gq) + (ln & 3) * 16;
#pragma unroll
            for (int i = 0; i < 16; ++i) x[i] = x[i] * rs * g[i];
            if (lat) { const int sec = (ln >> 1) & 1, pos = sec ? (t & 63) : (t >> 6); const float sg = (ln & 1) ? 1.f : -1.f; const float* rp = rope + (size_t)pos * 32;
#pragma unroll
                for (int i = 0; i < 16; ++i) { const float pr = shx(x[i], 1, f_lane); x[i] = x[i] * rp[2 * i] + sg * pr * rp[2 * i + 1]; } }
            const float scl = part ? 1.f : c2;
            v4u o0, o1; o0.x = pk2(x[0] * scl, x[1] * scl); o0.y = pk2(x[2] * scl, x[3] * scl); o0.z = pk2(x[4] * scl, x[5] * scl); o0.w = pk2(x[6] * scl, x[7] * scl);
            o1.x = pk2(x[8] * scl, x[9] * scl); o1.y = pk2(x[10] * scl, x[11] * scl); o1.z = pk2(x[12] * scl, x[13] * scl); o1.w = pk2(x[14] * scl, x[15] * scl);
            if (part == 0) { bf16* d = Q + (size_t)row * 1024 + ln * 16; *(v4u*)d = o0; *(v4u*)(d + 8) = o1; }
            else if (f_lane < 16) { bf16* d = Kb + (size_t)row * 256 + ln * 16; *(v4u*)d = o0; *(v4u*)(d + 8) = o1; }
        }
    }
}

template <int DK>
__device__ __forceinline__ void attn_phase(Frame& F, const att::Tens& T, int kvshift  , int kstride, int vstride, int vbase) {
    const int vcu = (F.G % 8 == 0) ? (blockIdx.x % 8) * (F.G / 8) + blockIdx.x / 8 : blockIdx.x;
    if constexpr (DK == 64) {
        for (int u = vcu; u < 2048 + 128; u += F.G) {
            if (u < 2048) { const int b = u >> 8, h = (u >> 4) & 15, qb = u & 15, kvh = h >> kvshift;
                att64::attn_unit<8>(T.Q, T.qpitch, NC + b * SEQ + qb * 256, h * 64, T.K, T.kpitch, kvh * kstride, T.V, T.vpitch, vbase + kvh * vstride, T.O, h * 64, b * LCTX, NC + b * SEQ, 68, (char*)F.lds, F.wave); }
            else { const int q = u - 2048, b = q >> 4, h = q & 15, kvh = h >> kvshift;
                att64::attn_unit<8>(T.Q, T.qpitch, b * LCTX, h * 64, T.K, T.kpitch, kvh * kstride, T.V, T.vpitch, vbase + kvh * vstride, T.O, h * 64, b * LCTX, 0, 4, (char*)F.lds, F.wave); }
        }
        __syncthreads();
    } else {
        for (int u = vcu; u < 2048 + 128; u += F.G) {
            if (u < 2048) { const int b = u >> 8, h = (u >> 4) & 15, qb = u & 15, kvh = h >> kvshift;
                att96::attn_unit<8>(T.Q, T.qpitch, NC + b * SEQ + qb * 256, h * 96, T.K, T.kpitch, kvh * kstride, T.V, T.vpitch, vbase + kvh * vstride, T.O, h * 64, b * LCTX, NC + b * SEQ, 68, (char*)F.lds, F.wave); }
            else { const int q = u - 2048, b = q >> 4, h = q & 15, kvh = h >> kvshift;
                att96::attn_unit<8>(T.Q, T.qpitch, b * LCTX, h * 96, T.K, T.kpitch, kvh * kstride, T.V, T.vpitch, vbase + kvh * vstride, T.O, h * 64, b * LCTX, 0, 4, (char*)F.lds, F.wave); }
        }
        __syncthreads();
    }
}

constexpr int PH_PER_LAYER = 9, PH_TOTAL = 2 + DEPTH * PH_PER_LAYER;
__global__ void __launch_bounds__(512, 2) mk_fwd(Args args) {
    extern __shared__ __attribute__((aligned(16))) unsigned char lds_raw[];
    Frame F;
    F.lds = (LAS unsigned char*)lds_raw; F.ws = args.ws; F.ctl = (gu32*)(args.ws + WS_CTL);
    F.wave = __builtin_amdgcn_readfirstlane(threadIdx.x >> 6); F.G = gridDim.x;
    F.gw = blockIdx.x * 8 + F.wave; F.NGW = F.G * 8;
    if (threadIdx.x < 4) ((LAS unsigned*)(F.lds + LDS_XB))[threadIdx.x] = 0u;
    __syncthreads();
    const int lo = args.ph_lo, hi = args.ph_hi;
    const bool multi = (hi - lo) > 1;
    XcdBarrier bar; bar.bar = (unsigned*)(F.ctl + CW_BAR); bar.x = 0; bar.st = nullptr; bar.wave = F.wave;
    if (multi) bar = xcd_barrier_post((unsigned*)(F.ctl + CW_BAR), (volatile LAS unsigned*)(F.lds + LDS_XB), F.wave);
#define IN(k) (lo <= (k) && (k) < hi)
#define SEAM(k) do { if (IN(k) && IN((k) + 1)) xcd_barrier(bar); } while (0)
    unsigned char* ws0 = args.ws;
#define PH_WS size_t zofs_ = 0; asm volatile("" : "+s"(zofs_)); unsigned char* ws = ws0 + zofs_; F.ws = ws; F.ctl = (gu32*)ws;
    const int G = F.G, cidx = (int)blockIdx.x;

    if (IN(0) && EN(0)) { PH_WS REP(0) { prologue(F, args); SEAM(0); } }
    if (IN(1) && EN(1)) { PH_WS rp_norm1(F, args, 0, 0);
        quant_rows(F, (const bf16*)(ws + WS_WFIN), (unsigned char*)(ws + WS_W8), (float*)(ws + WS_SWP), 2 * 2048);
        quant_rows(F, (const bf16*)(ws + WS_WMIN), (unsigned char*)(ws + WS_W8) + 4 * MiB, (float*)(ws + WS_SWP) + 4096, MLA_IN_PAD);
        quant_rows(F, (const bf16*)(ws + WS_WGQKV), (unsigned char*)(ws + WS_W8) + 5 * MiB, (float*)(ws + WS_SWP) + 4864, GQA_QKV);
        { const int t1 = lthread(F.wave);
          for (int i = cidx * 512 + t1; i < DEPTH * 9 * D; i += G * 512) { const int l = i / (9 * D), rem = i - l * (9 * D), mr = rem >> 10, col = rem & (D - 1), ob = (l % 3 == 0) ? l / 3 : (l % 3 == 1 ? 2 : 3);
              float* gp = (float*)(ws + WS_MOD) + ((size_t)l * 9 + mr) * (NMOD * D) + 2 * D + col; *gp = *gp * ((const float*)(ws + WS_SWO))[ob * D + col]; } }
        SEAM(1); }

    for (int l = 0; l < DEPTH; ++l) {
        const int kind = l % 3, j = l / 3, base = 2 + l * PH_PER_LAYER;
        const bool lastl = (l == DEPTH - 1);

        size_t outB = 0;
        if (kind == 0) {
            if (IN(base + 0) && EN(2)) { PH_WS REP(2) { PolFP p; p.A = (const char*)(ws + WS_W8) + (size_t)j * 2048 * D; p.B = (const char*)(ws + WS_H); p.nt = 8; p.sW = (const float*)(ws + WS_SWP) + j * 2048; p.sH = (const float*)(ws + WS_SH); p.nN = lastl ? 128 : 136; p.G = G; p.c = cidx;
                p.Z = (bf16*)(ws + WS_RA); p.Zc = (bf16*)(ws + WS_RH); pg8::gemm_phase(F.lds, p, F.wave); } }
            SEAM(base + 0);
            if (IN(base + 1) && EN(3)) { PH_WS REP(3) { PolFA p; p.A = (const char*)(ws + WS_MA); p.B = (const char*)(ws + WS_RA); p.nt = 4; p.G = G; p.c = cidx; p.Y = (bf16*)(ws + WS_RB); pg8::gemm_phase(F.lds, p, F.wave); } }
            SEAM(base + 1);
            if (IN(base + 2) && EN(4)) { PH_WS REP(4) { PolFC p; p.A = (const char*)(ws + WS_DC); p.B = (const char*)(ws + WS_RB); p.nt = 8; p.G = G; p.c = cidx; p.nunits = lastl ? 512 : 544;
                p.offMC = (unsigned)(WS_MC - WS_DC); p.offZc = (unsigned)(WS_RH - WS_RB); p.F = (unsigned char*)(ws + WS_RC); pg8::gemm_phase(F.lds, p, F.wave); } }
            SEAM(base + 2);
            outB = j;
        } else if (kind == 1) {
            if (IN(base + 0) && EN(5)) { PH_WS REP(5) { PolDenseI8 p; p.A = (const char*)(ws + WS_H); p.B = (const char*)(ws + WS_W8) + 4 * MiB; p.nt = 8; p.nM = NT / 256; p.nN = 3; p.pm0 = 0; p.G = G; p.c = cidx; p.sA = (const float*)(ws + WS_SH); p.sB = (const float*)(ws + WS_SWP) + 4096;
                p.O = (bf16*)(ws + WS_RE); p.ldo = MLA_IN_PAD; pg8::gemm_phase(F.lds, p, F.wave); } }
            SEAM(base + 0);
            if (IN(base + 1) && EN(6)) { PH_WS REP(6) { rp_mla(F, args); } }
            SEAM(base + 1);
            if (IN(base + 2)) { PH_WS REP(7) {
                if (EN(7)) { PolMlaQ p; p.A = (const char*)(ws + WS_RF); p.B = (const char*)(ws + WS_WMQB); p.nt = 6; p.nM = NT / 256; p.nN = 6; p.G = G; p.c = cidx; p.Q = (bf16*)(ws + WS_RA);
                  p.rope = (const float*)(ws + WS_ROPE); p.c2 = 0.10206207261596575f * LOG2E; pg8::gemm_phase(F.lds, p, F.wave); }
                if (EN(8)) { PolMlaKV p; p.A = (const char*)(ws + WS_RG); p.B = (const char*)(ws + WS_WMKVB); p.nt = 4; p.nM = NT / 256; p.nN = 8; p.G = G; p.c = cidx; p.Kb = (bf16*)(ws + WS_RB); p.Vb = (bf16*)(ws + WS_RD);
                  pg8::gemm_phase(F.lds, p, F.wave); }
            } }
            SEAM(base + 2);
            if (IN(base + 3) && EN(9)) { PH_WS REP(9) { att::Tens T{(const bf16*)(ws + WS_RA), 1536, (const bf16*)(ws + WS_RB), 1536, (const bf16*)(ws + WS_RD), 1024, (bf16*)(ws + WS_RC)}; attn_phase<96>(F, T, 0, 96, 64, 0); } }
            SEAM(base + 3);
            outB = 2;
        } else {
            if (IN(base + 0) && EN(10)) { PH_WS REP(10) { PolDenseI8 p; p.A = (const char*)(ws + WS_H); p.B = (const char*)(ws + WS_W8) + 5 * MiB; p.nt = 8; p.nM = NT / 256; p.nN = 6; p.pm0 = 0; p.G = G; p.c = cidx; p.sA = (const float*)(ws + WS_SH); p.sB = (const float*)(ws + WS_SWP) + 4864;
                p.O = (bf16*)(ws + WS_RA); p.ldo = GQA_QKV; pg8::gemm_phase(F.lds, p, F.wave); } }
            SEAM(base + 0);
            if (IN(base + 1) && EN(11)) { PH_WS REP(11) { rp_gqa(F, args); } }
            SEAM(base + 1);
            if (IN(base + 2) && EN(12)) { PH_WS REP(12) { att::Tens T{(const bf16*)(ws + WS_RB), 1024, (const bf16*)(ws + WS_RB) + (size_t)NT * 1024, 256, (const bf16*)(ws + WS_RA), 1536, (bf16*)(ws + WS_RC)}; attn_phase<64>(F, T, 2, 64, 64, 1280); } }
            SEAM(base + 2);
            outB = 3;
        }
        if (IN(base + 4) && EN(13)) { PH_WS PolOut p; p.A = (const char*)(ws + WS_RC); p.B = (const char*)(ws + WS_WO8) + (size_t)outB * D * D; p.nt = 8; p.nM = lastl ? NL / 256 : NT / 256; p.nN = 4; p.pm0 = lastl ? 8 : 0; p.G = G; p.c = cidx; p.X = (bf16*)(ws + WS_X); p.mod = (const float*)(ws + WS_MOD) + (size_t)l * 9 * (NMOD * D); p.chunk = 2;
            pg8::gemm_phase(F.lds, p, F.wave); }
        SEAM(base + 4);
        if (IN(base + 5) && EN(14)) { PH_WS rp_norm2_router(F, args, l, lastl ? NC : 0); }
        SEAM(base + 5);
        if (IN(base + 6) && EN(15)) { PH_WS REP(15) { moe_table(F, l);
            PolMoe1 p; p.A = (const char*)(ws + WS_H); p.B = (const char*)(ws + WS_WGU) + (size_t)l * NE * 2048 * D; p.nt = 8; p.G = G; p.c = cidx;
            p.swgu = (const float*)(ws + WS_SWGU) + (size_t)l * NE * 2048; p.ssc = (const float*)(ws + WS_SSC);
            p.T.TT = (const LAS int*)(F.lds + LDS_TT); p.T.CN = p.T.TT + 64; p.T.TE = (const LAS int*)(F.lds + LDS_TE); p.stok = (const int*)(ws + WS_STOK); p.bgu = (const float*)(ws + WS_BGU) + (size_t)l * NE * 2048; p.act = (unsigned char*)(ws + WS_ACT);
            pg8::gemm_phase(F.lds, p, F.wave); } }
        SEAM(base + 6);
        if (IN(base + 7) && EN(16)) { PH_WS REP(16) { moe_table(F, l);
            PolMoe2 p; p.A = (const char*)(ws + WS_ACT); p.B = (const char*)(ws + WS_WDN) + (size_t)l * NE * D * DFF; p.nt = 8; p.G = G; p.c = cidx; p.swd = (const float*)(ws + WS_SWDN) + (size_t)l * NE * D;
            p.T.TT = (const LAS int*)(F.lds + LDS_TT); p.T.CN = p.T.TT + 64; p.T.TE = (const LAS int*)(F.lds + LDS_TE); p.sw = (const float*)(ws + WS_SW); p.bdn = args.in[26] + (size_t)l * NE * D; p.Y = (unsigned char*)(ws + WS_Y);
            pg8::gemm_phase(F.lds, p, F.wave); } }
        SEAM(base + 7);
        if (IN(base + 8) && EN(17)) { PH_WS moe_table(F, l); rp_combine(F, args, l, lastl ? NC : 0); }
        SEAM(base + 8);
    }
#undef PH_WS
#undef IN
#undef SEAM
}

extern "C" void kernel_launch(void* const* d_in, const int* in_sizes, int n_in, void* d_out, int out_size, void* d_ws, size_t ws_size, hipStream_t stream) {
    static int grid = 0;
    if (grid == 0) {
        if (n_in != 27 || out_size != NL * D || ws_size < WS_END) { fprintf(stderr, "kernel_launch: unexpected problem (n_in %d, out %d, ws %zu < %zu)\n", n_in, out_size, ws_size, (size_t)WS_END); grid = -1; return; }
        int dev = 0, cus = 0, per_cu = 0;
        if (hipGetDevice(&dev) != hipSuccess || hipDeviceGetAttribute(&cus, hipDeviceAttributeMultiprocessorCount, dev) != hipSuccess) { grid = -1; return; }
        if (hipFuncSetAttribute((const void*)mk_fwd, hipFuncAttributeMaxDynamicSharedMemorySize, LDS_BYTES) != hipSuccess) { fprintf(stderr, "kernel_launch: hipFuncSetAttribute failed\n"); grid = -1; return; }
        if (hipOccupancyMaxActiveBlocksPerMultiprocessor(&per_cu, (const void*)mk_fwd, 512, LDS_BYTES) != hipSuccess || per_cu < 1) fprintf(stderr, "kernel_launch: occupancy query says %d\n", per_cu);
        (void)hipGetLastError();
        grid = cus;
    }
    if (grid < 0) return;
    (void)hipMemsetAsync((char*)d_ws + WS_CTL, 0, CTL_ZERO_BYTES, stream);
    Args a{};
    for (int i = 0; i < 27; ++i) a.in[i] = (const float*)d_in[i];
    a.out = (float*)d_out; a.ws = (unsigned char*)d_ws;
#if MK_PER_PHASE
    for (int ph = 0; ph < PH_TOTAL; ++ph) {
        const int l = (ph - 2) / PH_PER_LAYER, s = (ph - 2) % PH_PER_LAYER, kind = l % 3;
        if (ph >= 2) { if (s == 3 && kind != 1) continue; }
        a.ph_lo = ph; a.ph_hi = ph + 1;
        hipLaunchKernelGGL(mk_fwd, dim3(grid), dim3(512), LDS_BYTES, stream, a);
    }
#else
    a.ph_lo = 0; a.ph_hi = PH_TOTAL;
    hipLaunchKernelGGL(mk_fwd, dim3(grid), dim3(512), LDS_BYTES, stream, a);
#endif
}
```

```cpp
#include <hip/hip_runtime.h>
#include <cstdio>
#include <cstdint>

#ifndef MK_PER_PHASE
#define MK_PER_PHASE 0
#endif
#ifndef MK_N2V2
#define MK_N2V2 1
#endif
#ifndef MK_CBV2
#define MK_CBV2 1
#endif
#ifndef MK_N2AGG
#define MK_N2AGG 1
#endif
#ifndef MK_MASK
#define MK_MASK 0xFFFFFFFFu
#endif
#define EN(id) (((MK_MASK) >> (id)) & 1u)
#ifndef MK_REPMASK
#define MK_REPMASK 0u
#endif
#define REP(id) for (int rep_ = 0; rep_ < ((((MK_REPMASK) >> (id)) & 1u) ? 2 : 1); ++rep_)

constexpr int D = 1024, NB = 8, SEQ = 4096, LCTX = 256, DEPTH = 4;
constexpr int NC = NB * LCTX;
constexpr int NL = NB * SEQ;
constexpr int NT = NC + NL;
constexpr int NMOD = 6, NE = 32, TOPK = 4, DFF = 1024;
constexpr int MLA_QL = 384, MLA_KVL = 256, MLA_ROPE = 32, MLA_NOPE = 64, MLA_V = 64, MLA_IN = 672, MLA_IN_PAD = 768, MLA_QD = 96;
constexpr int GQA_NQ = 1024, GQA_NKV = 256, GQA_QKV = 1536;
constexpr int CAP = NT;
constexpr int MAXTILES = 576;
constexpr float EPS = 1e-6f;
constexpr float LOG2E = 1.4426950408889634f;

constexpr size_t MiB = 1u << 20;
constexpr size_t WS_CTL = 0, CTL_ZERO_BYTES = 96 * 1024;
constexpr size_t WS_MOD = 1 * MiB;
constexpr size_t WS_ROPE = 2 * MiB;
constexpr size_t WS_WRT = 2 * MiB + 65536;
constexpr size_t WS_BGU = 3 * MiB;
constexpr size_t WS_MA = 4 * MiB;
constexpr size_t WS_DC = 4 * MiB + 262144;
constexpr size_t WS_MC = 5 * MiB;
constexpr size_t WS_WFIN = 9 * MiB;
constexpr size_t WS_WFOUT = 17 * MiB;
constexpr size_t WS_WMIN = 21 * MiB;
constexpr size_t WS_WMQB = 23 * MiB;
constexpr size_t WS_WMKVB = 25 * MiB;
constexpr size_t WS_WMO = 26 * MiB;
constexpr size_t WS_WGQKV = 28 * MiB;
constexpr size_t WS_WGO = 31 * MiB;
constexpr size_t WS_TE = 34 * MiB;
constexpr size_t WS_TRANK = 35 * MiB;
constexpr size_t WS_STOK = 36 * MiB;
constexpr size_t WS_SW = 41 * MiB;
constexpr size_t WS_X = 64 * MiB;
constexpr size_t WS_H = 200 * MiB;
constexpr size_t WS_RA = 272 * MiB;
constexpr size_t WS_RB = 400 * MiB;
constexpr size_t WS_RC = 528 * MiB;
constexpr size_t WS_RD = 600 * MiB;
constexpr size_t WS_RE = 672 * MiB;
constexpr size_t WS_RF = 728 * MiB;
constexpr size_t WS_RG = 756 * MiB;
constexpr size_t WS_RH = 776 * MiB;
constexpr size_t WS_ACT = 784 * MiB;
constexpr size_t WS_Y = 1072 * MiB;
constexpr size_t WS_WGU = 1360 * MiB;
constexpr size_t WS_SWGU = 1360 * MiB + 256 * MiB;
constexpr size_t WS_SH = 1360 * MiB + 259 * MiB;
constexpr size_t WS_SWP = 1360 * MiB + 259 * MiB + 256 * 1024;
constexpr size_t WS_W8 = 1360 * MiB + 266 * MiB;
constexpr size_t WS_WO8 = 1360 * MiB + 274 * MiB;
constexpr size_t WS_SWO = 1360 * MiB + 278 * MiB;
constexpr size_t WS_WKVB8 = 1360 * MiB + 280 * MiB;
constexpr size_t WS_SCKV = 1360 * MiB + 282 * MiB;
constexpr size_t WS_WQB8 = 1360 * MiB + 283 * MiB;
constexpr size_t WS_SSC = 1360 * MiB + 260 * MiB;
constexpr size_t WS_WDN = 1872 * MiB;
constexpr size_t WS_SWDN = 1872 * MiB + 128 * MiB;
constexpr size_t WS_END = 2128 * MiB;
constexpr int CW_TMO = 0;
constexpr int CW_BAR = 4096;
constexpr int CW_CNT = 16384;

constexpr int RING_BYTES = 131072;
constexpr int LDS_MISC = 135168;
constexpr int LDS_TT = LDS_MISC;
constexpr int LDS_XB = LDS_MISC + 512;
constexpr int LDS_TE = LDS_MISC + 768;
constexpr int LDS_BYTES = 147456;

#define GAS __attribute__((address_space(1)))
#define LAS __attribute__((address_space(3)))
typedef unsigned short bf16;
typedef unsigned v4u __attribute__((ext_vector_type(4)));
typedef unsigned v2u __attribute__((ext_vector_type(2)));
typedef float f32x4 __attribute__((ext_vector_type(4)));
typedef float f32x2 __attribute__((ext_vector_type(2)));
typedef float f32x16 __attribute__((ext_vector_type(16)));
typedef short bf16x8 __attribute__((ext_vector_type(8)));
typedef short s16x4 __attribute__((ext_vector_type(4)));
typedef __bf16 bf16x2_t __attribute__((ext_vector_type(2)));
typedef GAS unsigned gu32;
#define RLX_AGENT __ATOMIC_RELAXED, __HIP_MEMORY_SCOPE_AGENT
#define LDS_WAIT() asm volatile("s_waitcnt lgkmcnt(0)" ::: "memory")
#define VM_WAIT() asm volatile("s_waitcnt vmcnt(0)" ::: "memory")
__device__ __forceinline__ unsigned pk2(float lo, float hi) { f32x2 v = {lo, hi}; bf16x2_t b = __builtin_convertvector(v, bf16x2_t); return __builtin_bit_cast(unsigned, b); }
__device__ __forceinline__ float bf_lo(unsigned u) { return __builtin_bit_cast(float, u << 16); }
__device__ __forceinline__ float bf_hi(unsigned u) { return __builtin_bit_cast(float, u & 0xffff0000u); }
__device__ __forceinline__ float shx(float v, int mask, int lane) { return __int_as_float(__builtin_amdgcn_ds_bpermute((lane ^ mask) << 2, __float_as_int(v))); }
__device__ __forceinline__ float wave_sum(float v, int lane) {
#pragma unroll
    for (int o = 1; o < 64; o <<= 1) v += shx(v, o, lane);
    return v;
}
__device__ __forceinline__ int lane_id_v() { int t; asm volatile("v_mbcnt_lo_u32_b32 %0, -1, 0\n\tv_mbcnt_hi_u32_b32 %0, -1, %0" : "=v"(t)); return t; }
__device__ __forceinline__ int launder_s(int x) { asm volatile("" : "+s"(x)); return x; }
__device__ __forceinline__ int lthread_w(int wave) { return wave * 64 + lane_id_v(); }
__device__ __forceinline__ int modrow_of(int row) { return row < NC ? NB : ((row - NC) >> 12); }

#define XB_TMO      128
#define XB_XCNT(j)  (256  + 64 * (j))
#define XB_XSUB(j)  (1280 + 64 * (j))
#define XB_XGEN(j)  (2304 + 64 * (j))
#define XB_TOP      3328
#define XB_TOPGEN   3392
#define XCD_BAR_WORDS 3456
#define XB_SPIN_CAP (1u << 18)
__device__ __forceinline__ unsigned xb_ld(unsigned* p)              { return __hip_atomic_load(p, __ATOMIC_RELAXED, __HIP_MEMORY_SCOPE_AGENT); }
__device__ __forceinline__ unsigned xb_add(unsigned* p, unsigned v) { return __hip_atomic_fetch_add(p, v, __ATOMIC_RELAXED, __HIP_MEMORY_SCOPE_AGENT); }
__device__ __forceinline__ unsigned xb_xcc_id() { return (unsigned)__builtin_amdgcn_s_getreg((3 << 11) | 20) & 0xFu; }
#define XB_SPIN(cond, bar) do { unsigned _sp = 0; while (cond) { __builtin_amdgcn_s_sleep(1); \
    if ((++_sp & 255u) == 0u) { if (xb_ld(&(bar)[XB_TMO])) break; if (_sp > XB_SPIN_CAP) { atomicAdd(&(bar)[XB_TMO], 1u); break; } } } } while (0)
struct XcdBarrier { unsigned* bar; unsigned x; volatile LAS unsigned* st; int wave; };
__device__ __forceinline__ bool xb_thread0(int wave) { return wave == 0 && lane_id_v() == 0; }
__device__ __forceinline__ XcdBarrier xcd_barrier_post(unsigned* bar, volatile LAS unsigned* st, int wave) {
    XcdBarrier b; b.bar = bar; b.x = xb_xcc_id(); b.st = st; b.wave = wave;
    if (xb_thread0(wave)) (void)xb_add(&bar[XB_XCNT(b.x)], 1u);
    return b;
}
__device__ __forceinline__ void xcd_barrier_complete(unsigned* bar, unsigned x, unsigned& nloc, unsigned& nx) {
    const unsigned G = gridDim.x * gridDim.y * gridDim.z;
    unsigned sum, cnt, mine, sp = 0u;
    for (;;) {
        sum = 0u; cnt = 0u; mine = 0u;
#pragma unroll
        for (unsigned j = 0; j < 16; ++j) { const unsigned c = xb_ld(&bar[XB_XCNT(j)]); sum += c; cnt += (c > 0u) ? 1u : 0u; mine = (j == x) ? c : mine; }
        if (sum == G) break;
        __builtin_amdgcn_s_sleep(1);
        if ((++sp & 255u) == 0u) { if (xb_ld(&bar[XB_TMO])) break; if (sp > XB_SPIN_CAP) { atomicAdd(&bar[XB_TMO], 1u); break; } }
    }
    nloc = mine > 0u ? mine : 1u; nx = cnt > 0u ? cnt : 1u;
}
__device__ __forceinline__ void xcd_barrier(const XcdBarrier& b) {
    asm volatile("s_waitcnt vmcnt(0)" ::: "memory");
    __syncthreads();
    if (xb_thread0(b.wave)) {
        unsigned* bar = b.bar;
        __builtin_amdgcn_s_waitcnt(0);
        unsigned nloc = b.st[0], nx = b.st[1];
        if (nloc == 0u) { xcd_barrier_complete(bar, b.x, nloc, nx); b.st[0] = nloc; b.st[1] = nx; }
        const unsigned old = xb_add(&bar[XB_XSUB(b.x)], 1u);
        const unsigned gen = old / nloc;
        if (old + 1u == (gen + 1u) * nloc) {
            __builtin_amdgcn_fence(__ATOMIC_RELEASE, "agent");
            asm volatile("s_waitcnt vmcnt(0)" ::: "memory");
            const unsigned og = xb_add(&bar[XB_TOP], 1u);
            const unsigned tg = og / nx;
            if (og + 1u == (tg + 1u) * nx) xb_add(&bar[XB_TOPGEN], 1u);
            else XB_SPIN(xb_ld(&bar[XB_TOPGEN]) == tg, bar);
            __builtin_amdgcn_fence(__ATOMIC_ACQUIRE, "agent");
            xb_add(&bar[XB_XGEN(b.x)], 1u);
            asm volatile("s_waitcnt vmcnt(0)" ::: "memory");
        } else {
            XB_SPIN(xb_ld(&bar[XB_XGEN(b.x)]) == gen, bar);
            __builtin_amdgcn_fence(__ATOMIC_ACQUIRE, "agent");
            asm volatile("s_waitcnt vmcnt(0)" ::: "memory");
        }
    }
    __syncthreads();
}

namespace pg8 {
#define PG8_LAS __attribute__((address_space(3)))
constexpr int BM = 256, BK = 64, HALF = 128, HTB = HALF * BK * 2, STAGE_BYTES = 8 * HTB, NXCD = 8, WGM = 8;
__device__ __forceinline__ int lds_byte(int r, int c) { const int st = (r >> 4) * 2 + (c >> 5), rr = r & 15, cc = c & 31, ob = rr * 64 + cc * 2; return st * 1024 + (ob ^ (((ob >> 9) & 1) << 5)); }
__device__ __forceinline__ void stage_rc(int b, int& R, int& C) { const int st = b / 1024, sb = b % 1024, swz = sb ^ (((sb >> 9) & 1) << 5); R = (st >> 1) * 16 + swz / 64; C = (st & 1) * 32 + (swz % 64) / 2; }
__device__ __forceinline__ int perm32(int rho) { const int n = rho >> 4, i = rho & 15; return 8 * (i >> 2) + 4 * n + (i & 3); }
struct Unit { int pm, pn, aux; };
typedef f32x4 Acc[2][2][4][2];
typedef int i32x4 __attribute__((ext_vector_type(4)));
typedef i32x4 AccI[2][2][4][2];
template <bool I8> struct AccSel { typedef f32x4 T; };
template <> struct AccSel<true> { typedef i32x4 T; };
__device__ __forceinline__ f32x4 mma1(bf16x8 b, bf16x8 a, f32x4 c) { return __builtin_amdgcn_mfma_f32_16x16x32_bf16(b, a, c, 0, 0, 0); }
typedef int i32x8 __attribute__((ext_vector_type(8)));
typedef short bf16x16 __attribute__((ext_vector_type(16)));
__device__ __forceinline__ f32x4 mma_f8(bf16x8 b0, bf16x8 b1, bf16x8 a0, bf16x8 a1, f32x4 c) {
    const i32x8 B = __builtin_bit_cast(i32x8, __builtin_shufflevector(b0, b1, 0, 1, 2, 3, 4, 5, 6, 7, 8, 9, 10, 11, 12, 13, 14, 15));
    const i32x8 A = __builtin_bit_cast(i32x8, __builtin_shufflevector(a0, a1, 0, 1, 2, 3, 4, 5, 6, 7, 8, 9, 10, 11, 12, 13, 14, 15));
    return __builtin_amdgcn_mfma_scale_f32_16x16x128_f8f6f4(B, A, c, 0, 0, 0, 0, 0, 0); }
__device__ __forceinline__ i32x4 mma1(bf16x8 b, bf16x8 a, i32x4 c) { return __builtin_amdgcn_mfma_i32_16x16x64_i8(__builtin_bit_cast(i32x4, b), __builtin_bit_cast(i32x4, a), c, 0, 0, 0); }

__device__ __forceinline__ bool static_next(int i, int G, int c, int nM, int nN, int& pm, int& pn) {
    const int nwg = nM * nN; const long L = (long)i * G + c; if (L >= nwg) return false;
    int wgid = (int)L; { const int q = nwg / NXCD, r = nwg % NXCD, xcd = wgid % NXCD, off = wgid / NXCD; wgid = (xcd < r ? xcd * (q + 1) : r * (q + 1) + (xcd - r) * q) + off; }
    const int nig = WGM * nN, gid = wgid / nig, fm = gid * WGM, gsz = (nM - fm) < WGM ? (nM - fm) : WGM;
    pm = fm + ((wgid % nig) % gsz); pn = (wgid % nig) / gsz; return true;
}

template <class P>
__device__ __forceinline__ void gemm_phase(PG8_LAS unsigned char* lds, const P& p, int wave_id) {
    wave_id = launder_s(wave_id); int tid_l = lthread_w(wave_id);
    const int tid = tid_l, wid = wave_id, lane = tid & 63, wr = wid >> 2, wc = wid & 3, fr = lane & 15, fq = lane >> 4;
    const int nt = launder_s(p.nt);
    const unsigned ldsw = (unsigned)wid * 1024u;
    const int aoff = lds_byte(wr * 64 + fr, fq * 8), boff = lds_byte(wc * 32 + fr, fq * 8);
    const char* const gA = p.A; const char* const gB = p.B;
#define PG8_SA(b, h) (((b) * 2 + (h)) * HTB)
#define PG8_SB(b, h) ((4 + (b) * 2 + (h)) * HTB)
#define PG8_STAGE(bufoff, gbase, off2, kofs) do { _Pragma("unroll") for (int _i = 0; _i < 2; ++_i) \
        __builtin_amdgcn_global_load_lds((const unsigned*)((gbase) + (size_t)(unsigned)((off2)[_i] + (unsigned)(kofs))), (PG8_LAS unsigned*)(lds + (bufoff) + ldsw + _i * 8192), 16, 0, 0); } while (0)
#define PG8_LDA(dst, b, h) do { _Pragma("unroll") for (int m = 0; m < 4; ++m) _Pragma("unroll") for (int k = 0; k < 2; ++k) dst[m][k] = *(const PG8_LAS bf16x8*)(lds + PG8_SA(b, h) + aoff + m * 2048 + k * 1024); } while (0)
#define PG8_LDB(dst, b, h) do { _Pragma("unroll") for (int n = 0; n < 2; ++n) _Pragma("unroll") for (int k = 0; k < 2; ++k) dst[n][k] = *(const PG8_LAS bf16x8*)(lds + PG8_SB(b, h) + boff + n * 2048 + k * 1024); } while (0)
#define PG8_MMA(ai, bj, At, Bt) do { __builtin_amdgcn_s_setprio(1); _Pragma("unroll") for (int m = 0; m < 4; ++m) _Pragma("unroll") for (int n = 0; n < 2; ++n) { \
        if constexpr (P::F8) acc[ai][bj][m][n] = mma_f8(Bt[n][0], Bt[n][1], At[m][0], At[m][1], acc[ai][bj][m][n]); \
        else { _Pragma("unroll") for (int k = 0; k < 2; ++k) acc[ai][bj][m][n] = mma1(Bt[n][k], At[m][k], acc[ai][bj][m][n]); } } __builtin_amdgcn_s_setprio(0); } while (0)
#define PG8_WAIT_V(n) asm volatile("s_waitcnt vmcnt(" #n ")" ::: "memory")
#define PG8_WAIT_L(n) asm volatile("s_waitcnt lgkmcnt(" #n ")" ::: "memory")
#define PG8_BAR __builtin_amdgcn_s_barrier()
#define PG8_SCHED __builtin_amdgcn_sched_barrier(0)
#define PG8_KEYS(u) do { if (P::KEYS && wid < 4) __builtin_amdgcn_global_load_lds((const unsigned*)p.key_ptr(u, wid * 64 + lane_id_v()), (PG8_LAS unsigned*)(keybuf + wid * 256), 4, 0, 0); } while (0)
#define PG8_OFFS(u, oA, oB) do { const int tid2_ = wid * 64 + lane_id_v();     \
    _Pragma("unroll") for (int _i = 0; _i < 2; ++_i) { int R_, C_; stage_rc(tid2_ * 16 + _i * 8192, R_, C_); const int Rb_ = P::PERM ? ((R_ & ~31) + perm32(R_ & 31)) : R_; \
      _Pragma("unroll") for (int _h = 0; _h < 2; ++_h) { \
        const int key_ = P::KEYS ? ((const PG8_LAS int*)keybuf)[_h * HALF + R_] : 0; \
        oA[_h][_i] = p.a_row(u, _h * HALF + R_, key_) + (unsigned)(C_ * 2); oB[_h][_i] = p.b_row(u, _h * HALF + Rb_) + (unsigned)(C_ * 2); } } } while (0)
    PG8_LAS unsigned char* const keybuf = lds + STAGE_BYTES;
    PG8_LAS unsigned char* const epibuf = lds + 138240; int eslot = 0;
#define PG8_EPRE(u, slot) do { if (P::EPRE && wid < 4) { const int i_ = wid * 64 + lane_id_v(); _Pragma("unroll") for (int j_ = 0; j_ < 3; ++j_) \
        __builtin_amdgcn_global_load_lds((const unsigned*)p.epre_src(u, j_, i_), (PG8_LAS unsigned*)(epibuf + (slot) * 3072 + j_ * 1024 + wid * 256), 4, 0, 0); } } while (0)
    PG8_LAS int* const utab = (PG8_LAS int*)(lds + 133120);
    __syncthreads();
    if (wid == 0) { const int li_ = lane_id_v(); if (li_ < 32) { Unit uu_; uu_.pm = 0; uu_.pn = 0; uu_.aux = 0; const bool ok_ = p.next(li_, uu_); PG8_LAS int* e_ = utab + li_ * 4; e_[0] = uu_.pm; e_[1] = uu_.pn; e_[2] = uu_.aux; e_[3] = ok_ ? 1 : 0; } }
    __syncthreads();
#define PG8_NEXT(i, u, ok) do { const int ii_ = (i); if (ii_ < 32) { const PG8_LAS int* e_ = utab + ii_ * 4; u.pm = __builtin_amdgcn_readfirstlane(e_[0]); u.pn = __builtin_amdgcn_readfirstlane(e_[1]); u.aux = __builtin_amdgcn_readfirstlane(e_[2]); ok = __builtin_amdgcn_readfirstlane(e_[3]) != 0; } else ok = p.next(ii_, u); } while (0)
    Unit cur, nxt; int ui = 0;
    { bool ok0_; PG8_NEXT(0, cur, ok0_); if (!ok0_) return; }
    typedef typename AccSel<P::I8>::T AccT;
    AccT acc[2][2][4][2];
#pragma unroll
    for (int a = 0; a < 2; ++a)
#pragma unroll
        for (int b = 0; b < 2; ++b)
#pragma unroll
            for (int m = 0; m < 4; ++m)
#pragma unroll
                for (int n = 0; n < 2; ++n) acc[a][b][m][n] = (AccT){0, 0, 0, 0};
    bf16x8 At[4][2], B0[2][2], B1[2][2];
    unsigned oAc[2][2], oBc[2][2];
    if (P::KEYS || P::EPRE) { PG8_KEYS(cur); PG8_EPRE(cur, 0); PG8_WAIT_V(0); PG8_BAR; }
    PG8_OFFS(cur, oAc, oBc);
    PG8_STAGE(PG8_SB(0, 0), gB, oBc[0], 0); PG8_STAGE(PG8_SB(0, 1), gB, oBc[1], 0); PG8_STAGE(PG8_SA(0, 0), gA, oAc[0], 0); PG8_STAGE(PG8_SA(0, 1), gA, oAc[1], 0);
    if (wr == 1) PG8_BAR;
    PG8_WAIT_V(2); PG8_BAR;
    PG8_STAGE(PG8_SB(1, 0), gB, oBc[0], 128); PG8_STAGE(PG8_SA(1, 0), gA, oAc[0], 128); PG8_STAGE(PG8_SB(1, 1), gB, oBc[1], 128);
    PG8_WAIT_V(6); PG8_BAR;
    bool has_next; PG8_NEXT(1, nxt, has_next);
    if (has_next) { PG8_KEYS(nxt); PG8_EPRE(nxt, 1); }
    for (;;) {
        for (int t = 0; t < nt; t += 2) {
            const bool last = (t == nt - 2);
            const unsigned k1 = (unsigned)(t + 1) * 128u;
            const unsigned k2 = last ? 0u : (unsigned)(t + 2) * 128u, k3 = k2 + 128u;
            PG8_LDB(B0, 0, 0); PG8_LDB(B1, 0, 1); PG8_SCHED; PG8_LDA(At, 0, 0); PG8_STAGE(PG8_SA(1, 1), gA, oAc[1], k1);
            if (last && has_next) { PG8_OFFS(nxt, oAc, oBc); }
            PG8_WAIT_V(8); PG8_WAIT_L(0); PG8_BAR; PG8_MMA(0, 0, At, B0); PG8_MMA(0, 1, At, B1); PG8_BAR; PG8_SCHED;
            PG8_LDA(At, 0, 1); PG8_STAGE(PG8_SB(0, 0), gB, oBc[0], k2); PG8_STAGE(PG8_SB(0, 1), gB, oBc[1], k2); PG8_STAGE(PG8_SA(0, 0), gA, oAc[0], k2);
            PG8_WAIT_V(8); PG8_WAIT_L(0); PG8_BAR; PG8_MMA(1, 0, At, B0); PG8_MMA(1, 1, At, B1); PG8_BAR; PG8_SCHED;
            PG8_LDB(B0, 1, 0); PG8_LDB(B1, 1, 1); PG8_SCHED; PG8_LDA(At, 1, 0); PG8_STAGE(PG8_SA(0, 1), gA, oAc[1], k2);
            PG8_WAIT_V(8); PG8_WAIT_L(0); PG8_BAR; PG8_MMA(0, 0, At, B0); PG8_MMA(0, 1, At, B1); PG8_BAR; PG8_SCHED;
            PG8_LDA(At, 1, 1); PG8_STAGE(PG8_SB(1, 0), gB, oBc[0], k3); PG8_STAGE(PG8_SB(1, 1), gB, oBc[1], k3); PG8_STAGE(PG8_SA(1, 0), gA, oAc[0], k3);
            PG8_WAIT_V(8); PG8_WAIT_L(0); PG8_BAR; PG8_MMA(1, 0, At, B0); PG8_MMA(1, 1, At, B1); PG8_BAR; PG8_SCHED;
        }
        if (wr == 0) PG8_BAR;
        { const int le_ = lane_id_v(); int fr_e = le_ & 15, fq_e = le_ >> 4;
          if constexpr (P::EPRE) p.epi(acc, cur, wr, wc, fr_e, fq_e, (const PG8_LAS float*)(epibuf + eslot * 3072)); else p.epi(acc, cur, wr, wc, fr_e, fq_e); }
        if (!has_next) break;
        cur = nxt; ++ui; eslot = (eslot == 2 ? 0 : eslot + 1);
        PG8_NEXT(ui + 1, nxt, has_next);
        if (has_next) { PG8_KEYS(nxt); PG8_EPRE(nxt, (eslot == 2 ? 0 : eslot + 1)); }
#pragma unroll
        for (int a = 0; a < 2; ++a)
#pragma unroll
            for (int b = 0; b < 2; ++b)
#pragma unroll
                for (int m = 0; m < 4; ++m)
#pragma unroll
                    for (int n = 0; n < 2; ++n) acc[a][b][m][n] = (AccT){0, 0, 0, 0};
        if (wr == 1) PG8_BAR;
    }
    PG8_WAIT_V(0);
    PG8_BAR;
#undef PG8_SA
#undef PG8_SB
#undef PG8_STAGE
#undef PG8_LDA
#undef PG8_LDB
#undef PG8_MMA
#undef PG8_WAIT_V
#undef PG8_WAIT_L
#undef PG8_BAR
#undef PG8_SCHED
#undef PG8_OFFS
#undef PG8_KEYS
#undef PG8_NEXT
#undef PG8_EPRE
}
}
using pg8::Unit;

#define TROW(ai, wr, m, fr) (128 * (ai) + 64 * (wr) + 16 * (m) + (fr))
#define TCOLP(bj, wc, fq) (128 * (bj) + 32 * (wc) + 8 * (fq))
#define TCOLN(bj, wc, n, fq) (128 * (bj) + 32 * (wc) + 16 * (n) + 4 * (fq))
__device__ __forceinline__ v4u pack8(const f32x4 a, const f32x4 b) { v4u w; w.x = pk2(a[0], a[1]); w.y = pk2(a[2], a[3]); w.z = pk2(b[0], b[1]); w.w = pk2(b[2], b[3]); return w; }

__device__ __forceinline__ unsigned q8x4(float a, float b, float c, float d, float s) {
    const unsigned ua = __float_as_uint(fmaf(a, s, 12582912.f)), ub = __float_as_uint(fmaf(b, s, 12582912.f)), uc = __float_as_uint(fmaf(c, s, 12582912.f)), ud = __float_as_uint(fmaf(d, s, 12582912.f));
    return __builtin_amdgcn_perm(ub, ua, 0x0c0c0400u) | __builtin_amdgcn_perm(ud, uc, 0x04000c0cu); }
__device__ __forceinline__ v2u pack8_fp8(f32x4 a, f32x4 b) {
#pragma unroll
    for (int q = 0; q < 4; ++q) { a[q] = __builtin_amdgcn_fmed3f(a[q], -448.f, 448.f); b[q] = __builtin_amdgcn_fmed3f(b[q], -448.f, 448.f); }
    int t0 = __builtin_amdgcn_cvt_pk_fp8_f32(a[0], a[1], 0, false); t0 = __builtin_amdgcn_cvt_pk_fp8_f32(a[2], a[3], t0, true);
    int t1 = __builtin_amdgcn_cvt_pk_fp8_f32(b[0], b[1], 0, false); t1 = __builtin_amdgcn_cvt_pk_fp8_f32(b[2], b[3], t1, true); v2u o; o.x = (unsigned)t0; o.y = (unsigned)t1; return o; }
template <class T> __device__ __forceinline__ const T* ub_at(const T* base, unsigned idx) { return (const T*)((const char*)base + (size_t)(unsigned)(idx * 4u)); }
struct PolDenseBf16 {
    static constexpr bool EPRE = false; __device__ __forceinline__ const float* epre_src(const Unit&, int, int) const { return nullptr; }
    static constexpr bool PERM = true;
    static constexpr bool KEYS = false;
    static constexpr bool I8 = false;
    static constexpr bool F8 = false;
    __device__ __forceinline__ const int* key_ptr(const Unit&, int) const { return nullptr; }
    const char* A; const char* B; int nt; int nM, nN, pm0, G, c; unsigned pitchA, pitchB; bf16* O; int ldo;
    __device__ __forceinline__ bool next(int i, Unit& u) const { int pm, pn; if (!pg8::static_next(i, G, c, nM, nN, pm, pn)) return false; u.pm = pm + pm0; u.pn = pn; u.aux = 0; return true; }
    __device__ __forceinline__ unsigned a_row(const Unit& u, int r, int) const { return (unsigned)(u.pm * 256 + r) * pitchA; }
    __device__ __forceinline__ unsigned b_row(const Unit& u, int r) const { return (unsigned)(u.pn * 256 + r) * pitchB; }
    __device__ __forceinline__ void epi(const pg8::Acc& acc, const Unit& u, int wr, int wc, int fr, int fq) const {
#pragma unroll
        for (int ai = 0; ai < 2; ++ai)
#pragma unroll
            for (int m = 0; m < 4; ++m) { const size_t row = (size_t)u.pm * 256 + TROW(ai, wr, m, fr);
#pragma unroll
                for (int bj = 0; bj < 2; ++bj) { const int col = u.pn * 256 + TCOLP(bj, wc, fq); *(v4u*)(O + row * ldo + col) = pack8(acc[ai][bj][m][0], acc[ai][bj][m][1]); } }
    }
};

struct PolDenseI8 {
    static constexpr bool EPRE = true;
    __device__ __forceinline__ const float* epre_src(const Unit& u, int j, int i) const { return j == 1 ? ub_at(sB + u.pn * 256, (unsigned)i) : ub_at(sA + (size_t)u.pm * 256, (unsigned)i); }
    static constexpr bool PERM = true;
    static constexpr bool KEYS = false;
    static constexpr bool I8 = true;
    static constexpr bool F8 = false;
    __device__ __forceinline__ const int* key_ptr(const Unit&, int) const { return nullptr; }
    const char* A; const char* B; int nt; int nM, nN, pm0, G, c; const float* sA; const float* sB; bf16* O; int ldo;
    __device__ __forceinline__ bool next(int i, Unit& u) const { int pm, pn; if (!pg8::static_next(i, G, c, nM, nN, pm, pn)) return false; u.pm = pm + pm0; u.pn = pn; u.aux = 0; return true; }
    __device__ __forceinline__ unsigned a_row(const Unit& u, int r, int) const { return (unsigned)(u.pm * 256 + r) * 1024u; }
    __device__ __forceinline__ unsigned b_row(const Unit& u, int r) const { return (unsigned)(u.pn * 256 + r) * 1024u; }
    __device__ __forceinline__ void epi(const pg8::AccI& acc, const Unit& u, int wr, int wc, int fr, int fq, const LAS float* eb) const {
#pragma unroll
        for (int bj = 0; bj < 2; ++bj) { const int cl = TCOLP(bj, wc, fq), col = u.pn * 256 + cl; const f32x4 s0 = *(const LAS f32x4*)(eb + 256 + cl), s1 = *(const LAS f32x4*)(eb + 256 + cl + 4);
#pragma unroll
            for (int ai = 0; ai < 2; ++ai)
#pragma unroll
                for (int m = 0; m < 4; ++m) { const int rr = TROW(ai, wr, m, fr); const size_t row = (size_t)u.pm * 256 + rr; const float sa = eb[rr]; f32x4 v0, v1;
#pragma unroll
                    for (int q = 0; q < 4; ++q) { v0[q] = (float)acc[ai][bj][m][0][q] * (sa * s0[q]); v1[q] = (float)acc[ai][bj][m][1][q] * (sa * s1[q]); }
                    *(v4u*)(O + row * ldo + col) = pack8(v0, v1); } }
    }
};

struct PolOut {
    static constexpr bool EPRE = false; __device__ __forceinline__ const float* epre_src(const Unit&, int, int) const { return nullptr; }
    static constexpr bool PERM = true;
    static constexpr bool KEYS = false;
    static constexpr bool I8 = false;
    static constexpr bool F8 = true;
    __device__ __forceinline__ const int* key_ptr(const Unit&, int) const { return nullptr; }
    const char* A; const char* B; int nt; int nM, nN, pm0, G, c; bf16* X; const float* mod;
    int chunk;
    __device__ __forceinline__ bool next(int i, Unit& u) const { int pm, pn; if (!pg8::static_next(i, G, c, nM, nN, pm, pn)) return false; u.pm = pm + pm0; u.pn = pn; u.aux = 0; return true; }
    __device__ __forceinline__ unsigned a_row(const Unit& u, int r, int) const { return (unsigned)(u.pm * 256 + r) * 1024u; }
    __device__ __forceinline__ unsigned b_row(const Unit& u, int r) const { return (unsigned)(u.pn * 256 + r) * 1024u; }
    __device__ __forceinline__ void epi(const pg8::Acc& acc, const Unit& u, int wr, int wc, int fr, int fq) const {
        const int mr = modrow_of(u.pm * 256);
        const float* g = mod + (size_t)mr * (NMOD * D) + chunk * D;
#pragma unroll
        for (int bj = 0; bj < 2; ++bj) { const int col = u.pn * 256 + TCOLP(bj, wc, fq); const f32x4 g0 = *(const f32x4*)(g + col), g1 = *(const f32x4*)(g + col + 4);
            v4u xw[8];
#pragma unroll
            for (int am = 0; am < 8; ++am) xw[am] = *(const v4u*)(X + ((size_t)u.pm * 256 + TROW(am >> 2, wr, am & 3, fr)) * D + col);
            asm volatile("" ::: "memory");
#pragma unroll
            for (int am = 0; am < 8; ++am) { const int ai = am >> 2, m = am & 3; const size_t off = ((size_t)u.pm * 256 + TROW(ai, wr, m, fr)) * D + col; const v4u w = xw[am];
                const f32x4 x0 = (f32x4){bf_lo(w.x), bf_hi(w.x), bf_lo(w.y), bf_hi(w.y)}, x1 = (f32x4){bf_lo(w.z), bf_hi(w.z), bf_lo(w[3]), bf_hi(w[3])};
                *(v4u*)(X + off) = pack8(x0 + g0 * acc[ai][bj][m][0], x1 + g1 * acc[ai][bj][m][1]); }
            asm volatile("" ::: "memory"); }
    }
};

struct PolFP {
    static constexpr bool EPRE = true;
    __device__ __forceinline__ const float* epre_src(const Unit& u, int j, int i) const { return j == 1 ? ub_at(sH, (unsigned)tok_row(u.pn, u.pn * 256 + i)) : ub_at(sW + u.pm * 256, (unsigned)i); }
    static constexpr bool PERM = true;
    static constexpr bool KEYS = false;
    static constexpr bool I8 = true;
    static constexpr bool F8 = false;
    __device__ __forceinline__ const int* key_ptr(const Unit&, int) const { return nullptr; }
    const char* A; const char* B; int nt; int nN, G, c; const float* sW; const float* sH; bf16* Z; bf16* Zc;
    __device__ __forceinline__ bool next(int i, Unit& u) const { int pm, pn; if (!pg8::static_next(i, G, c, 8, nN, pm, pn)) return false; u.pm = pm; u.pn = pn; u.aux = 0; return true; }
    __device__ __forceinline__ unsigned a_row(const Unit& u, int r, int) const { return (unsigned)(u.pm * 256 + r) * 1024u; }
    __device__ __forceinline__ int tok_row(int pn, int n) const { if (pn < 128) { const int b = n >> 12, l2 = (n >> 6) & 63, l1 = n & 63; return NC + b * SEQ + 64 * l1 + l2; } return n - 32768; }
    __device__ __forceinline__ unsigned b_row(const Unit& u, int r) const { return (unsigned)tok_row(u.pn, u.pn * 256 + r) * 1024u; }
    __device__ __forceinline__ void epi(const pg8::AccI& acc, const Unit& u, int wr, int wc, int fr, int fq, const LAS float* eb) const {
#pragma unroll
        for (int bj = 0; bj < 2; ++bj) { const int cl = TCOLP(bj, wc, fq), n0 = u.pn * 256 + cl;
            const f32x4 h0 = *(const LAS f32x4*)(eb + 256 + cl), h1 = *(const LAS f32x4*)(eb + 256 + cl + 4);
#pragma unroll
            for (int ai = 0; ai < 2; ++ai)
#pragma unroll
                for (int m = 0; m < 4; ++m) { const int rr = TROW(ai, wr, m, fr), cp = u.pm * 256 + rr; const float sw = eb[rr]; f32x4 v0, v1;
#pragma unroll
                    for (int q = 0; q < 4; ++q) { v0[q] = (float)acc[ai][bj][m][0][q] * (sw * h0[q]); v1[q] = (float)acc[ai][bj][m][1][q] * (sw * h1[q]); }
                    if (u.pn < 128) *(v2u*)((unsigned char*)Z + ((size_t)(n0 >> 6) * 2048 + cp) * 64 + (n0 & 63)) = pack8_fp8(v0, v1);
                    else { const int b = u.pn - 128, l = n0 - 32768 - b * 256; *(v2u*)((unsigned char*)Zc + ((size_t)b * 2048 + cp) * 256 + l) = pack8_fp8(v0, v1); } } }
    }
};

struct PolFA {
    static constexpr bool EPRE = false; __device__ __forceinline__ const float* epre_src(const Unit&, int, int) const { return nullptr; }
    static constexpr bool PERM = true;
    static constexpr bool KEYS = false;
    static constexpr bool I8 = false;
    static constexpr bool F8 = true;
    __device__ __forceinline__ const int* key_ptr(const Unit&, int) const { return nullptr; }
    const char* A; const char* B; int nt; int G, c; unsigned char* Y;
    __device__ __forceinline__ bool next(int i, Unit& u) const { const int L = i * G + c; if (L >= 1024) return false; u.pm = 0; u.pn = L & 127; u.aux = L >> 7; return true; }
    __device__ __forceinline__ unsigned a_row(const Unit&, int r, int) const { return (unsigned)r * 256u; }
    __device__ __forceinline__ unsigned b_row(const Unit& u, int r) const { const int l2 = r & 63, cp = u.pn * 4 + (r >> 6); return (unsigned)((u.aux * 64 + l2) * 512 + cp) * 256u; }
    __device__ __forceinline__ void epi(const pg8::Acc& acc, const Unit& u, int wr, int wc, int fr, int fq) const {
        const int b = u.aux;
#pragma unroll
        for (int ai = 0; ai < 2; ++ai)
#pragma unroll
            for (int m = 0; m < 4; ++m) { const int rr = TROW(ai, wr, m, fr), jp = rr >> 7, pp = (rr >> 6) & 1, k1 = rr & 63;
#pragma unroll
                for (int bj = 0; bj < 2; ++bj) { const int n0 = u.pn * 256 + TCOLP(bj, wc, fq), cp = n0 >> 6, l2 = n0 & 63, cc = 2 * cp + jp;
                    const unsigned idx = (unsigned)(((((b * 16 + (k1 >> 2)) * 1024 + cc) * 4 + (k1 & 3)) * 2 + pp) * 64 + l2);
                    *(v2u*)(Y + idx) = pack8_fp8(acc[ai][bj][m][0] * 0.03125f, acc[ai][bj][m][1] * 0.03125f); } }
    }
};

struct PolFC {
    static constexpr bool EPRE = false; __device__ __forceinline__ const float* epre_src(const Unit&, int, int) const { return nullptr; }
    static constexpr bool PERM = true;
    static constexpr bool KEYS = false;
    static constexpr bool I8 = false;
    static constexpr bool F8 = false;
    __device__ __forceinline__ const int* key_ptr(const Unit&, int) const { return nullptr; }
    const char* A; const char* B; int nt; int G, c; int nunits, l0; unsigned offMC, offZc; unsigned char* F;
    __device__ __forceinline__ bool next(int i, Unit& u) const { const int L = i * G + c + l0; if (L >= nunits) return false;
        if (L < 512) { u.pm = 0; u.pn = L & 3; u.aux = L >> 2; } else { const int q = L - 512; u.pm = 0; u.pn = q & 3; u.aux = 256 + (q >> 2); } return true; }
    __device__ __forceinline__ unsigned a_row(const Unit& u, int r, int) const {
        if (u.aux < 256) return offMC + (unsigned)((u.aux & 15) * 256 + r) * 1024u;
        return (unsigned)r * 1024u; }
    __device__ __forceinline__ unsigned b_row(const Unit& u, int r) const {
        if (u.aux < 256) return (unsigned)(u.aux * 1024 + u.pn * 256 + r) * 1024u;
        return offZc + (unsigned)((u.aux - 256) * 1024 + u.pn * 256 + r) * 1024u; }
    __device__ __forceinline__ void epi(const pg8::Acc& acc, const Unit& u, int wr, int wc, int fr, int fq) const {
#pragma unroll
        for (int ai = 0; ai < 2; ++ai)
#pragma unroll
            for (int m = 0; m < 4; ++m) { const int rr = TROW(ai, wr, m, fr); size_t frow;
                if (u.aux < 256) { const int b = u.aux >> 4, kq = u.aux & 15, k = 4 * kq + (rr >> 6) + 64 * (rr & 63); frow = (size_t)NC + b * SEQ + k; }
                else frow = (size_t)(u.aux - 256) * LCTX + rr;
#pragma unroll
                for (int bj = 0; bj < 2; ++bj) { const int col = u.pn * 256 + TCOLP(bj, wc, fq); *(v2u*)(F + frow * D + col) = pack8_fp8(acc[ai][bj][m][0], acc[ai][bj][m][1]); } }
    }
};

struct PolFCl {
    static constexpr bool EPRE = false; __device__ __forceinline__ const float* epre_src(const Unit&, int, int) const { return nullptr; }
    static constexpr bool PERM = true;
    static constexpr bool KEYS = false;
    static constexpr bool I8 = false;
    static constexpr bool F8 = true;
    __device__ __forceinline__ const int* key_ptr(const Unit&, int) const { return nullptr; }
    const char* A; const char* B; int nt; int G, c; int nunits; unsigned offMC, offZc; unsigned char* F;
    __device__ __forceinline__ bool next(int i, Unit& u) const { const int L = i * G + c; if (L >= nunits) return false;
        if (L < 512) { u.pm = 0; u.pn = L & 3; u.aux = L >> 2; } else { const int q = L - 512; u.pm = 0; u.pn = q & 3; u.aux = 256 + (q >> 2); } return true; }
    __device__ __forceinline__ unsigned a_row(const Unit& u, int r, int) const { return u.aux < 256 ? offMC + (unsigned)((u.aux & 15) * 256 + r) * 512u : (unsigned)r * 512u; }
    __device__ __forceinline__ unsigned b_row(const Unit& u, int r) const { return u.aux < 256 ? (unsigned)(u.aux * 1024 + u.pn * 256 + r) * 512u : offZc + (unsigned)((u.aux - 256) * 1024 + u.pn * 256 + r) * 512u; }
    __device__ __forceinline__ void epi(const pg8::Acc& acc, const Unit& u, int wr, int wc, int fr, int fq) const {
        const bool lat = u.aux < 256; const float sc = lat ? 0.125f : 0.015625f;
#pragma unroll
        for (int ai = 0; ai < 2; ++ai)
#pragma unroll
            for (int m = 0; m < 4; ++m) { const int rr = TROW(ai, wr, m, fr); size_t frow;
                if (lat) { const int b = u.aux >> 4, kq = u.aux & 15, k = 4 * kq + (rr >> 6) + 64 * (rr & 63); frow = (size_t)NC + b * SEQ + k; }
                else frow = (size_t)(u.aux - 256) * LCTX + rr;
#pragma unroll
                for (int bj = 0; bj < 2; ++bj) { const int col = u.pn * 256 + TCOLP(bj, wc, fq); *(v2u*)(F + frow * D + col) = pack8_fp8(acc[ai][bj][m][0] * sc, acc[ai][bj][m][1] * sc); } }
    }
};

struct PolMlaQ {
    static constexpr bool EPRE = true;
    __device__ __forceinline__ const float* epre_src(const Unit& u, int j, int i) const { return j == 1 ? ub_at(sB + u.pn * 256, (unsigned)i) : ub_at(sA + (size_t)u.pm * 256, (unsigned)i); }
    static constexpr bool PERM = true;
    static constexpr bool KEYS = false;
    static constexpr bool I8 = true;
    static constexpr bool F8 = false;
    __device__ __forceinline__ const int* key_ptr(const Unit&, int) const { return nullptr; }
    const char* A; const char* B; int nt; int nM, nN, G, c; bf16* Q; const float* rope; float c2; const float* sA; const float* sB;
    __device__ __forceinline__ bool next(int i, Unit& u) const { int pm, pn; if (!pg8::static_next(i, G, c, nM, nN, pm, pn)) return false; u.pm = pm; u.pn = pn; u.aux = 0; return true; }
    __device__ __forceinline__ unsigned a_row(const Unit& u, int r, int) const { return (unsigned)(u.pm * 256 + r) * 512u; }
    __device__ __forceinline__ unsigned b_row(const Unit& u, int r) const { return (unsigned)(u.pn * 256 + r) * 512u; }
    __device__ __forceinline__ void epi(const pg8::AccI& acc, const Unit& u, int wr, int wc, int fr, int fq, const LAS float* eb) const {
        const bool lat = u.pm >= 8;
#pragma unroll
        for (int bj = 0; bj < 2; ++bj) { const int cl = TCOLP(bj, wc, fq), col = u.pn * 256 + cl; const f32x4 s0 = *(const LAS f32x4*)(eb + 256 + cl), s1 = *(const LAS f32x4*)(eb + 256 + cl + 4); const bool isrope = lat && (((col >> 5) % 3) == 2);
#pragma unroll
            for (int ai = 0; ai < 2; ++ai)
#pragma unroll
                for (int m = 0; m < 4; ++m) { const int rr = TROW(ai, wr, m, fr), row = u.pm * 256 + rr; const float sa = eb[rr]; f32x4 v0, v1;
#pragma unroll
                    for (int e = 0; e < 4; ++e) { v0[e] = (float)acc[ai][bj][m][0][e] * (sa * s0[e]); v1[e] = (float)acc[ai][bj][m][1][e] * (sa * s1[e]); }
                    if (isrope) { const int t = (row - NC) & 4095, pos = (fq & 2) ? (t & 63) : (t >> 6);
                        const f32x4* rp = (const f32x4*)(rope + (size_t)pos * 16);
                        const f32x4 r0 = rp[0], r1 = rp[1], r2 = rp[2], r3 = rp[3];
                        f32x4 p0, p1;
#pragma unroll
                        for (int e = 0; e < 4; ++e) { p0[e] = shx(v0[e], 16, fq * 16 + fr); p1[e] = shx(v1[e], 16, fq * 16 + fr); }
                        const float sg = (fq & 1) ? 1.f : -1.f;
                        v0[0] = v0[0] * r0[0] + sg * p0[0] * r0[1]; v0[1] = v0[1] * r0[2] + sg * p0[1] * r0[3];
                        v0[2] = v0[2] * r1[0] + sg * p0[2] * r1[1]; v0[3] = v0[3] * r1[2] + sg * p0[3] * r1[3];
                        v1[0] = v1[0] * r2[0] + sg * p1[0] * r2[1]; v1[1] = v1[1] * r2[2] + sg * p1[1] * r2[3];
                        v1[2] = v1[2] * r3[0] + sg * p1[2] * r3[1]; v1[3] = v1[3] * r3[2] + sg * p1[3] * r3[3]; }
                    *(v4u*)(Q + (size_t)row * 1536 + col) = pack8(v0 * c2, v1 * c2); } }
    }
};

struct PolMlaKV {
    static constexpr bool EPRE = true;
    __device__ __forceinline__ const float* epre_src(const Unit& u, int j, int i) const { return j == 1 ? ub_at(sB + u.pn * 256, (unsigned)i) : ub_at(sA + (size_t)u.pm * 256, (unsigned)i); }
    static constexpr bool PERM = true;
    static constexpr bool KEYS = false;
    static constexpr bool I8 = true;
    static constexpr bool F8 = false;
    __device__ __forceinline__ const int* key_ptr(const Unit&, int) const { return nullptr; }
    const char* A; const char* B; int nt; int nM, nN, G, c; bf16* Kb; bf16* Vb; const float* sA; const float* sB;
    __device__ __forceinline__ bool next(int i, Unit& u) const { int pm, pn; if (!pg8::static_next(i, G, c, nM, nN, pm, pn)) return false; u.pm = pm; u.pn = pn; u.aux = 0; return true; }
    __device__ __forceinline__ unsigned a_row(const Unit& u, int r, int) const { return (unsigned)(u.pm * 256 + r) * 256u; }
    __device__ __forceinline__ unsigned b_row(const Unit& u, int r) const { return (unsigned)(u.pn * 256 + r) * 256u; }
    __device__ __forceinline__ void epi(const pg8::AccI& acc, const Unit& u, int wr, int wc, int fr, int fq, const LAS float* eb) const {
#pragma unroll
        for (int bj = 0; bj < 2; ++bj) { const int cl = TCOLP(bj, wc, fq), col = u.pn * 256 + cl, h = col >> 7, j = col & 127; const f32x4 s0 = *(const LAS f32x4*)(eb + 256 + cl), s1 = *(const LAS f32x4*)(eb + 256 + cl + 4);
#pragma unroll
            for (int ai = 0; ai < 2; ++ai)
#pragma unroll
                for (int m = 0; m < 4; ++m) { const int rr = TROW(ai, wr, m, fr); const size_t row = (size_t)u.pm * 256 + rr; const float sa = eb[rr]; f32x4 v0, v1;
#pragma unroll
                    for (int q = 0; q < 4; ++q) { v0[q] = (float)acc[ai][bj][m][0][q] * (sa * s0[q]); v1[q] = (float)acc[ai][bj][m][1][q] * (sa * s1[q]); }
                    const v4u w = pack8(v0, v1);
                    if (j < 64) *(v4u*)(Kb + row * 1536 + 96 * h + j) = w; else *(v4u*)(Vb + row * 1024 + 64 * h + (j - 64)) = w; } }
    }
};

struct MoeTab { const LAS int* TT; const LAS int* CN; const LAS int* TE; };
__device__ __forceinline__ bool moe_next(int i, int G, int c, int NP, const MoeTab& T, Unit& u) {
    const int ttot = T.TT[32];
    int lo, hi, j;
    if ((G & 7) == 0) { const int x = c & 7, q = c >> 3, g8 = G >> 3; lo = (x * ttot) >> 3; hi = ((x + 1) * ttot) >> 3; j = i * g8 + q; }
    else { lo = 0; hi = ttot; j = i * G + c; }
    if (j >= (hi - lo) * NP) return false;
    const int tile = lo + j / NP; u.pn = j % NP; u.pm = tile;
    const int e = T.TE[tile];
    u.aux = e | ((tile - T.TT[e]) << 8);
    return true;
}
struct PolMoe1 {
    static constexpr bool EPRE = true;
    __device__ __forceinline__ const float* epre_src(const Unit& u, int j, int i) const { const int e = u.aux & 255; const size_t fo = (size_t)e * 2048 + u.pn * 256;
        if (j == 0) return ub_at(bgu + fo, (unsigned)i); if (j == 1) return ub_at(swgu + fo, (unsigned)i); const unsigned idx = (unsigned)((u.aux >> 8) * 256 + i); return ub_at(ssc + (size_t)e * CAP, idx < (unsigned)T.CN[e] ? idx : 0u); }
    static constexpr bool PERM = true;
    static constexpr bool I8 = true;
    static constexpr bool F8 = false;
    const char* A; const char* B; int nt; int G, c; MoeTab T; const int* stok; const float* bgu; const float* swgu; const float* ssc; unsigned char* act;
    __device__ __forceinline__ bool next(int i, Unit& u) const { return moe_next(i, G, c, 8, T, u); }
    static constexpr bool KEYS = true;
    __device__ __forceinline__ const int* key_ptr(const Unit& u, int r) const { const int e = u.aux & 255; const unsigned idx = (unsigned)((u.aux >> 8) * 256 + r); return ub_at(stok + (size_t)e * CAP, idx < (unsigned)T.CN[e] ? idx : 0u); }
    __device__ __forceinline__ unsigned a_row(const Unit&, int, int key) const { return (unsigned)key * 1024u; }
    __device__ __forceinline__ unsigned b_row(const Unit& u, int r) const { return (unsigned)((u.aux & 255) * 2048 + u.pn * 256 + r) * 1024u; }
    __device__ __forceinline__ void epi(const pg8::AccI& acc, const Unit& u, int wr, int wc, int fr, int fq, const LAS float* eb) const {
        const int jl = 32 * wc + 8 * fq;
        const LAS float* bg = eb + jl; const LAS float* sg = eb + 256 + jl;
        const f32x4 bg0 = *(const LAS f32x4*)(bg), bg1 = *(const LAS f32x4*)(bg + 4), bu0 = *(const LAS f32x4*)(bg + 128) + 1.f, bu1 = *(const LAS f32x4*)(bg + 132) + 1.f;
        const f32x4 sg0 = *(const LAS f32x4*)(sg), sg1 = *(const LAS f32x4*)(sg + 4), su0 = *(const LAS f32x4*)(sg + 128), su1 = *(const LAS f32x4*)(sg + 132);
#pragma unroll
        for (int ai = 0; ai < 2; ++ai)
#pragma unroll
            for (int m = 0; m < 4; ++m) { const int rr = TROW(ai, wr, m, fr); const size_t slot = (size_t)u.pm * 256 + rr;
                const float sa = eb[512 + rr];
                f32x4 o0, o1;
#define MOE1_ACT(OUT, N, SG, BG, SU, BU) do { _Pragma("unroll") for (int hq = 0; hq < 2; ++hq) { \
                    const f32x2 ag = {(float)acc[ai][0][m][N][2 * hq], (float)acc[ai][0][m][N][2 * hq + 1]}, au = {(float)acc[ai][1][m][N][2 * hq], (float)acc[ai][1][m][N][2 * hq + 1]}; \
                    const f32x2 sgp = {SG[2 * hq], SG[2 * hq + 1]}, bgp = {BG[2 * hq], BG[2 * hq + 1]}, sup = {SU[2 * hq], SU[2 * hq + 1]}, bup = {BU[2 * hq], BU[2 * hq + 1]}; \
                    f32x2 g = __builtin_elementwise_fma(ag, sgp * sa, bgp), u = __builtin_elementwise_fma(au, sup * sa, bup); \
                    g[0] = fminf(g[0], 7.f); g[1] = fminf(g[1], 7.f); u[0] = __builtin_amdgcn_fmed3f(u[0], -6.f, 8.f); u[1] = __builtin_amdgcn_fmed3f(u[1], -6.f, 8.f); \
                    const f32x2 z = g * (-1.702f * LOG2E); f32x2 e; e[0] = __builtin_amdgcn_exp2f(z[0]); e[1] = __builtin_amdgcn_exp2f(z[1]); \
                    const f32x2 dd = e + 1.f; f32x2 r; r[0] = __builtin_amdgcn_rcpf(dd[0]); r[1] = __builtin_amdgcn_rcpf(dd[1]); \
                    const f32x2 o = (u * g) * r; OUT[2 * hq] = o[0]; OUT[2 * hq + 1] = o[1]; } } while (0)
                MOE1_ACT(o0, 0, sg0, bg0, su0, bu0); MOE1_ACT(o1, 1, sg1, bg1, su1, bu1);
#undef MOE1_ACT
                v2u w8; { int t0 = __builtin_amdgcn_cvt_pk_fp8_f32(o0[0], o0[1], 0, false); t0 = __builtin_amdgcn_cvt_pk_fp8_f32(o0[2], o0[3], t0, true);
                          int t1 = __builtin_amdgcn_cvt_pk_fp8_f32(o1[0], o1[1], 0, false); t1 = __builtin_amdgcn_cvt_pk_fp8_f32(o1[2], o1[3], t1, true); w8.x = (unsigned)t0; w8.y = (unsigned)t1; }
                *(v2u*)(act + slot * 1024 + u.pn * 128 + jl) = w8; }
    }
};
struct PolMoe2 {
    static constexpr bool EPRE = true;
    __device__ __forceinline__ const float* epre_src(const Unit& u, int j, int i) const { const int e = u.aux & 255; const size_t co = (size_t)e * 1024 + u.pn * 256;
        if (j == 0) return ub_at(bdn + co, (unsigned)i); if (j == 1) return ub_at(swd + co, (unsigned)i); const unsigned idx = (unsigned)((u.aux >> 8) * 256 + i); return ub_at(sw + (size_t)e * CAP, idx < (unsigned)T.CN[e] ? idx : 0u); }
    static constexpr bool PERM = true;
    static constexpr bool KEYS = false;
    static constexpr bool I8 = false;
    static constexpr bool F8 = true;
    __device__ __forceinline__ const int* key_ptr(const Unit&, int) const { return nullptr; }
    const char* A; const char* B; int nt; int G, c; MoeTab T; const float* sw; const float* bdn; const float* swd; unsigned char* Y;
    __device__ __forceinline__ bool next(int i, Unit& u) const { return moe_next(i, G, c, 4, T, u); }
    __device__ __forceinline__ unsigned a_row(const Unit& u, int r, int) const { return (unsigned)(u.pm * 256 + r) * 1024u; }
    __device__ __forceinline__ unsigned b_row(const Unit& u, int r) const { return (unsigned)((u.aux & 255) * 1024 + u.pn * 256 + r) * 1024u; }
    __device__ __forceinline__ void epi(const pg8::Acc& acc, const Unit& u, int wr, int wc, int fr, int fq, const LAS float* eb) const {
#pragma unroll
        for (int bj = 0; bj < 2; ++bj) { const int cl = TCOLP(bj, wc, fq), col = u.pn * 256 + cl;
            const f32x4 b0 = *(const LAS f32x4*)(eb + cl), b1 = *(const LAS f32x4*)(eb + cl + 4), s0 = *(const LAS f32x4*)(eb + 256 + cl), s1 = *(const LAS f32x4*)(eb + 256 + cl + 4);
#pragma unroll
            for (int ai = 0; ai < 2; ++ai)
#pragma unroll
                for (int m = 0; m < 4; ++m) { const int rr = TROW(ai, wr, m, fr); const size_t slot = (size_t)u.pm * 256 + rr; const float w = eb[512 + rr];
                    const float w8 = w * 8.f; f32x4 y0 = (acc[ai][bj][m][0] * s0 + b0) * w8, y1 = (acc[ai][bj][m][1] * s1 + b1) * w8;
#pragma unroll
                    for (int q = 0; q < 4; ++q) { y0[q] = fminf(fmaxf(y0[q], -448.f), 448.f); y1[q] = fminf(fmaxf(y1[q], -448.f), 448.f); }
                    v2u o8; { int t0 = __builtin_amdgcn_cvt_pk_fp8_f32(y0[0], y0[1], 0, false); t0 = __builtin_amdgcn_cvt_pk_fp8_f32(y0[2], y0[3], t0, true);
                              int t1 = __builtin_amdgcn_cvt_pk_fp8_f32(y1[0], y1[1], 0, false); t1 = __builtin_amdgcn_cvt_pk_fp8_f32(y1[2], y1[3], t1, true); o8.x = (unsigned)t0; o8.y = (unsigned)t1; }
                    *(v2u*)(Y + slot * 1024 + col) = o8; } }
    }
};

namespace att {
__device__ __forceinline__ int crow(int r, int hi) { return (r & 3) + 8 * (r >> 2) + 4 * hi; }
__device__ __forceinline__ float max3f(float a, float b, float c) { return fmaxf(fmaxf(a, b), c); }
typedef LAS const char* lds_cptr;
constexpr int LK = 0, LV = 49152, LWS = 90112, LOST = 92160, LBYTES = 124928;
constexpr int PD = 3;
struct Tens { const bf16* Q; int qpitch; const bf16* K; int kpitch; const bf16* V; int vpitch; bf16* O; };
#define ATT_WAITV(n) asm volatile("s_waitcnt vmcnt(" #n ")" ::: "memory")
struct Pend { f32x16 o0, o1; float l; int qrow0, oc0; bool valid; };
__device__ __forceinline__ void finish_unit(const Pend& P, bf16* O, LAS unsigned char* lds, int wid, int lane) {
    const int r32 = lane & 31, hi = lane >> 5;
    LAS float* wsf = (LAS float*)(lds + LWS) + wid * 64;
    float lrun = P.l;
    { auto rr = __builtin_amdgcn_permlane32_swap(__float_as_uint(lrun), __float_as_uint(lrun), false, false); lrun = __uint_as_float(rr[0]) + __uint_as_float(rr[1]); }
    if (hi == 0) wsf[32 + r32] = lrun;
    LDS_WAIT();
    LAS bf16* stg = (LAS bf16*)(lds + LOST) + wid * 2048;
#pragma unroll
    for (int r = 0; r < 16; ++r) { const int orow = crow(r, hi); const float rl = __builtin_amdgcn_rcpf(wsf[32 + orow]);
        stg[orow * 64 + r32] = (bf16)(pk2(P.o0[r] * rl, 0.f) & 0xffffu); stg[orow * 64 + 32 + r32] = (bf16)(pk2(P.o1[r] * rl, 0.f) & 0xffffu); }
    LDS_WAIT();
    bf16* Ow = O + (size_t)(P.qrow0 + wid * 32) * 1024 + P.oc0;
#pragma unroll
    for (int i = 0; i < 4; ++i) { const int row = i * 8 + (lane >> 3), ch = lane & 7; const v4u v = *(const LAS v4u*)(stg + row * 64 + ch * 8); *(v4u*)(Ow + (size_t)row * 1024 + ch * 8) = v; }
    LDS_WAIT();
}
template <int DK>
__device__ __forceinline__ void unit(const Tens& T, int qrow0, int qc0, int kc0, int vc0, int oc0, int kctx0, int klat0, int NTL, LAS unsigned char* lds, int wave_id, Pend& pend) {
    constexpr int ND = DK / 16;
    wave_id = launder_s(wave_id); const int tid = lthread_w(wave_id), lane = tid & 63, r32 = lane & 31, hi = lane >> 5; const int wid = wave_id;
    LAS float* wsf = (LAS float*)(lds + LWS) + wid * 64;
    const bf16* ksrc = T.K + (size_t)lane * T.kpitch + kc0 + wid * 8;
    const int k2off = (8 + (wid & 3) - wid) * 8;
    const bf16* vsrc = T.V + (size_t)(16 * (wid & 3) + (lane >> 2)) * T.vpitch + vc0 + (wid >> 2) * 32 + (lane & 3) * 8;
#define ATT_DMA(t, ks_, vs_) do { const size_t row0_ = (size_t)((t) < 4 ? kctx0 + 64 * (t) : klat0 + 64 * ((t) - 4)); \
        __builtin_amdgcn_global_load_lds((const unsigned*)(ksrc + row0_ * T.kpitch), (LAS unsigned*)(lds + LK + (ks_) * 12288 + wid * 1024), 16, 0, 0); \
        if (DK > 64) __builtin_amdgcn_global_load_lds((const unsigned*)(ksrc + row0_ * T.kpitch + k2off), (LAS unsigned*)(lds + LK + (ks_) * 12288 + 8192 + (wid & 3) * 1024), 16, 0, 0); \
        __builtin_amdgcn_global_load_lds((const unsigned*)(vsrc + row0_ * T.vpitch), (LAS unsigned*)(lds + LV + (vs_) * 8192 + wid * 1024), 16, 0, 0); } while (0)
#define ATT_WAIT_TILES(n_tiles) do { if (DK > 64) { if ((n_tiles) >= 2) ATT_WAITV(6); else if ((n_tiles) == 1) ATT_WAITV(3); else ATT_WAITV(0); } \
        else { if ((n_tiles) >= 2) ATT_WAITV(4); else if ((n_tiles) == 1) ATT_WAITV(2); else ATT_WAITV(0); } } while (0)
    bf16x8 qr[ND];
    { const bf16* qp = T.Q + (size_t)(qrow0 + wid * 32 + r32) * T.qpitch + qc0 + hi * 8;
#pragma unroll
      for (int d0 = 0; d0 < ND; ++d0) qr[d0] = *(const bf16x8*)(qp + d0 * 16); }
    asm volatile("" ::: "memory");
    constexpr float THR = 8.f;
    const int half = wid >> 2;
    float mhat = 0.f, lrun = 0.f; f32x16 o[2]; o[0] = f32x16{}; o[1] = f32x16{}; f32x16 negm = f32x16{};
    f32x16 p0 = f32x16{}, p1 = f32x16{}; v4u pw[4]; pw[0] = pw[1] = pw[2] = pw[3] = (v4u){0u, 0u, 0u, 0u};
    ATT_DMA(0, 0, 0); ATT_DMA(1, 1, 1); ATT_DMA(2, 2, 2);
    if (pend.valid) finish_unit(pend, T.O, lds, wid, lane);
    ATT_WAIT_TILES(2);
    __builtin_amdgcn_s_barrier(); asm volatile("" ::: "memory");
    if (half == 1) __builtin_amdgcn_s_barrier();
    int vs_prev = 0, vs_cur = 0, vs_iss = 3;
    for (int t = 0; t <= NTL; ++t) {
        if (t >= 1) {
            s16x4 lo[2][4], hh[2][4];
            const unsigned vb = (unsigned)(uintptr_t)(lds + LV + vs_prev * 8192) + ((lane >> 4) & 1) * 32 + (lane & 3) * 8 + (4 * hi + ((lane & 15) >> 2)) * 64;
#pragma unroll
            for (int d0 = 0; d0 < 2; ++d0)
#pragma unroll
                for (int ks = 0; ks < 4; ++ks) {
                    asm volatile("ds_read_b64_tr_b16 %0,%1 offset:%c2" : "=&v"(lo[d0][ks]) : "v"(vb), "i"(d0 * 4096 + ks * 1024) : "memory");
                    asm volatile("ds_read_b64_tr_b16 %0,%1 offset:%c2" : "=&v"(hh[d0][ks]) : "v"(vb), "i"(d0 * 4096 + ks * 1024 + 512) : "memory"); }
            asm volatile("s_waitcnt lgkmcnt(0)" ::: "memory"); __builtin_amdgcn_sched_barrier(0);
#pragma unroll
            for (int ks = 0; ks < 4; ++ks)
#pragma unroll
                for (int d0 = 0; d0 < 2; ++d0) { const bf16x8 vf = (bf16x8){lo[d0][ks][0], lo[d0][ks][1], lo[d0][ks][2], lo[d0][ks][3], hh[d0][ks][0], hh[d0][ks][1], hh[d0][ks][2], hh[d0][ks][3]};
                    o[d0] = __builtin_amdgcn_mfma_f32_32x32x16_bf16(__builtin_bit_cast(bf16x8, pw[ks]), vf, o[d0], 0, 0, 0); }
        }
        if (t < NTL) {
            bf16x8 kf[2 * ND];
            const lds_cptr kb = (lds_cptr)(lds + LK + (t & 3) * 12288) + hi * 1024 + r32 * 16;
#pragma unroll
            for (int d0 = 0; d0 < ND; ++d0) { kf[2 * d0] = *(const LAS bf16x8*)(kb + d0 * 2048); kf[2 * d0 + 1] = *(const LAS bf16x8*)(kb + d0 * 2048 + 512); }
            asm volatile("s_waitcnt lgkmcnt(0)" ::: "memory"); __builtin_amdgcn_sched_barrier(0);
#pragma unroll
            for (int d0 = 0; d0 < ND; ++d0) {
                if (d0 == 0) { p0 = __builtin_amdgcn_mfma_f32_32x32x16_bf16(kf[0], qr[0], negm, 0, 0, 0); p1 = __builtin_amdgcn_mfma_f32_32x32x16_bf16(kf[1], qr[0], negm, 0, 0, 0); }
                else { p0 = __builtin_amdgcn_mfma_f32_32x32x16_bf16(kf[2 * d0], qr[d0], p0, 0, 0, 0); p1 = __builtin_amdgcn_mfma_f32_32x32x16_bf16(kf[2 * d0 + 1], qr[d0], p1, 0, 0, 0); } }
        }
        if (half == 1) {
            const int last_iss = (t + PD - 1 < NTL - 1) ? t + PD - 1 : NTL - 1; const int allow = last_iss - (t + 1);
            if (allow >= 1) ATT_WAIT_TILES(1); else ATT_WAIT_TILES(0); }
        asm volatile("s_waitcnt lgkmcnt(0)" ::: "memory"); __builtin_amdgcn_s_barrier(); asm volatile("" ::: "memory");
        if (t < NTL) {
            float rm = max3f(p0[0], p0[1], p1[0]);
#pragma unroll
            for (int r = 0; r < 16; ++r) rm = max3f(rm, p0[r], p1[r]);
            { auto rr = __builtin_amdgcn_permlane32_swap(__float_as_uint(rm), __float_as_uint(rm), false, false); rm = fmaxf(__uint_as_float(rr[0]), __uint_as_float(rr[1])); }
            if (t == 0 || __any(rm > THR)) {
                const float dl = (t == 0) ? rm : fmaxf(rm, 0.f);
                mhat += dl;
#pragma unroll
                for (int r = 0; r < 16; ++r) { p0[r] -= dl; p1[r] -= dl; negm[r] = -mhat; }
                const float f = (t == 0) ? 1.f : __builtin_amdgcn_exp2f(-dl); lrun *= f;
                if (hi == 0) wsf[r32] = f;
                LDS_WAIT();
#pragma unroll
                for (int r = 0; r < 16; ++r) { const float a = wsf[crow(r, hi)]; o[0][r] *= a; o[1][r] *= a; }
            }
            float rs = 0.f;
#pragma unroll
            for (int r = 0; r < 16; ++r) { p0[r] = __builtin_amdgcn_exp2f(p0[r]); p1[r] = __builtin_amdgcn_exp2f(p1[r]); rs += p0[r] + p1[r]; }
            lrun += rs;
            pw[0] = (v4u){pk2(p0[0], p0[1]), pk2(p0[2], p0[3]), pk2(p0[4], p0[5]), pk2(p0[6], p0[7])};
            pw[1] = (v4u){pk2(p0[8], p0[9]), pk2(p0[10], p0[11]), pk2(p0[12], p0[13]), pk2(p0[14], p0[15])};
            pw[2] = (v4u){pk2(p1[0], p1[1]), pk2(p1[2], p1[3]), pk2(p1[4], p1[5]), pk2(p1[6], p1[7])};
            pw[3] = (v4u){pk2(p1[8], p1[9]), pk2(p1[10], p1[11]), pk2(p1[12], p1[13]), pk2(p1[14], p1[15])};
        }
        if (t + PD < NTL) { ATT_DMA(t + PD, (t + PD) & 3, vs_iss); vs_iss = (vs_iss == 4) ? 0 : vs_iss + 1; }
        if (half == 0) {
            const int last_iss = (t + PD < NTL - 1) ? t + PD : NTL - 1; const int allow = last_iss - (t + 1);
            if (allow >= 2) ATT_WAIT_TILES(2); else if (allow == 1) ATT_WAIT_TILES(1); else ATT_WAIT_TILES(0); }
        vs_prev = vs_cur; vs_cur = (vs_cur == 4) ? 0 : vs_cur + 1;
        asm volatile("s_waitcnt lgkmcnt(0)" ::: "memory"); __builtin_amdgcn_s_barrier(); asm volatile("" ::: "memory");
    }
    if (half == 0) __builtin_amdgcn_s_barrier();
#undef ATT_DMA
#undef ATT_WAIT_TILES
    pend.o0 = o[0]; pend.o1 = o[1]; pend.l = lrun; pend.qrow0 = qrow0; pend.oc0 = oc0; pend.valid = true;
}
#undef ATT_WAITV
}

namespace att64 {
typedef unsigned short bf16;
using bf16x8=__attribute__((ext_vector_type(8)))short;
using s16x4=__attribute__((ext_vector_type(4)))short;
using f32x16=__attribute__((ext_vector_type(16)))float;
using u32x4=__attribute__((ext_vector_type(4)))unsigned;
constexpr int D=64;
constexpr int NW=8,QBLK=32,QB=QBLK*NW,KVBLK=64;
__device__ __forceinline__ int crow(int r,int hi){return (r&3)+8*(r>>2)+4*hi;}
#define SBAR() __builtin_amdgcn_sched_barrier(0)
constexpr int NSLOT=3, SLOTB=8192;
constexpr int LDS_K=0, LDS_V=NSLOT*SLOTB, LDS_WS=2*NSLOT*SLOTB, LDS_OST=LDS_WS+NW*64*4, LDS_BYTES=LDS_OST+NW*4096;
constexpr float C2=0.125f*1.4426950408889634f;
__device__ __forceinline__ void glds16(const void*gsrc,unsigned lds_dst){unsigned keep;
  asm volatile("s_mov_b32 %0, m0\n\ts_mov_b32 m0, %2\n\ts_nop 0\n\tglobal_load_lds_dwordx4 %1, off\n\ts_mov_b32 m0, %0":"=&s"(keep):"v"(gsrc),"s"(lds_dst):"memory");}
__device__ __forceinline__ float max3f(float a,float b,float c){float r;asm("v_max3_f32 %0, %1, %2, %3":"=v"(r):"v"(a),"v"(b),"v"(c));return r;}
__device__ __forceinline__ float max2f(float a,float b){float r;asm("v_max_f32_e32 %0, %1, %2":"=v"(r):"v"(a),"v"(b));return r;}
__device__ __forceinline__ float fadd_s(float a,float b){float r;asm("v_add_f32_e32 %0, %1, %2":"=v"(r):"v"(a),"v"(b));return r;}
__device__ __forceinline__ float fsub_s(float a,float b){float r;asm("v_sub_f32_e32 %0, %1, %2":"=v"(r):"v"(a),"v"(b));return r;}
typedef float f32x2_t __attribute__((ext_vector_type(2))); typedef __bf16 bf16x2_t __attribute__((ext_vector_type(2)));
__device__ __forceinline__ unsigned cvtpk_s(float lo,float hi){f32x2_t v={lo,hi};bf16x2_t b=__builtin_convertvector(v,bf16x2_t);return __builtin_bit_cast(unsigned,b);}
#define WAIT_BAR(N) asm volatile("s_waitcnt vmcnt(" #N ") lgkmcnt(0)\n\ts_barrier":::"memory")

__device__ __forceinline__ void qkt(f32x16&p0,f32x16&p1,const char*Kslot,const bf16x8*qr,const f32x16&negm,int r32,int hi){
  const char*kb=Kslot+hi*1024+r32*16;
  #pragma unroll
  for(int d0=0;d0<4;++d0){
    const bf16x8 b0=*reinterpret_cast<const bf16x8*>(kb+d0*2048);
    const bf16x8 b1=*reinterpret_cast<const bf16x8*>(kb+d0*2048+512);
    if(d0==0){p0=__builtin_amdgcn_mfma_f32_32x32x16_bf16(b0,qr[0],negm,0,0,0);p1=__builtin_amdgcn_mfma_f32_32x32x16_bf16(b1,qr[0],negm,0,0,0);}
    else{p0=__builtin_amdgcn_mfma_f32_32x32x16_bf16(b0,qr[d0],p0,0,0,0);p1=__builtin_amdgcn_mfma_f32_32x32x16_bf16(b1,qr[d0],p1,0,0,0);}}
}
typedef __attribute__((address_space(3))) const char* lds_cptr;
typedef short v4i16_t __attribute__((ext_vector_type(4)));
__device__ __forceinline__ void kload8(bf16x8*kf,lds_cptr kp){
  kf[0]=*(const __attribute__((address_space(3))) bf16x8*)(kp);      kf[1]=*(const __attribute__((address_space(3))) bf16x8*)(kp+512);
  kf[2]=*(const __attribute__((address_space(3))) bf16x8*)(kp+2048); kf[3]=*(const __attribute__((address_space(3))) bf16x8*)(kp+2560);
  kf[4]=*(const __attribute__((address_space(3))) bf16x8*)(kp+4096); kf[5]=*(const __attribute__((address_space(3))) bf16x8*)(kp+4608);
  kf[6]=*(const __attribute__((address_space(3))) bf16x8*)(kp+6144); kf[7]=*(const __attribute__((address_space(3))) bf16x8*)(kp+6656);
}
__device__ __forceinline__ void kload2(bf16x8*kf,lds_cptr kp,int j){ kf[2*j]=*(const __attribute__((address_space(3))) bf16x8*)(kp+j*2048); kf[2*j+1]=*(const __attribute__((address_space(3))) bf16x8*)(kp+j*2048+512); }
__device__ __forceinline__ s16x4 vtr(lds_cptr p){ return __builtin_bit_cast(s16x4,__builtin_amdgcn_ds_read_tr16_b64_v4i16((__attribute__((address_space(3))) v4i16_t*)p)); }
__device__ __forceinline__ float rowmax(const f32x16&p0,const f32x16&p1){
  float a=max3f(p0[0],p0[1],p1[0]),b=max3f(p0[2],p0[3],p1[1]);a=max3f(a,p1[2],p1[3]);
  #pragma unroll
  for(int r=4;r<16;r+=4){a=max3f(a,p0[r],p0[r+1]);b=max3f(b,p0[r+2],p0[r+3]);a=max3f(a,p1[r],p1[r+1]);b=max3f(b,p1[r+2],p1[r+3]);}
  const float m=max2f(a,b);
  auto rr=__builtin_amdgcn_permlane32_swap(__float_as_uint(m),__float_as_uint(m),false,false);
  return max2f(__uint_as_float(rr[0]),__uint_as_float(rr[1]));
}
__device__ __forceinline__ void pv(f32x16*o,int vb,bf16x8 pa0,bf16x8 pa1,bf16x8 pa2,bf16x8 pa3){
  #pragma unroll
  for(int d0=0;d0<2;++d0){s16x4 lo[4],hi[4];
    #pragma unroll
    for(int ks=0;ks<4;++ks){
      asm volatile("ds_read_b64_tr_b16 %0,%1 offset:%c2":"=&v"(lo[ks]):"v"(vb),"i"(d0*4096+ks*1024):"memory");
      asm volatile("ds_read_b64_tr_b16 %0,%1 offset:%c2":"=&v"(hi[ks]):"v"(vb),"i"(d0*4096+ks*1024+512):"memory");}
    asm volatile("s_waitcnt lgkmcnt(0)":::"memory");SBAR();
    #define PK(k) (bf16x8){lo[k][0],lo[k][1],lo[k][2],lo[k][3],hi[k][0],hi[k][1],hi[k][2],hi[k][3]}
    o[d0]=__builtin_amdgcn_mfma_f32_32x32x16_bf16(pa0,PK(0),o[d0],0,0,0);
    o[d0]=__builtin_amdgcn_mfma_f32_32x32x16_bf16(pa1,PK(1),o[d0],0,0,0);
    o[d0]=__builtin_amdgcn_mfma_f32_32x32x16_bf16(pa2,PK(2),o[d0],0,0,0);
    o[d0]=__builtin_amdgcn_mfma_f32_32x32x16_bf16(pa3,PK(3),o[d0],0,0,0);
    #undef PK
  }
}

#ifndef ATTN_STORE16
#define ATTN_STORE16(p,v) (*(u32x4*)(p)=(v))
#endif
template<int THRL> __device__ __forceinline__ void attn_unit(const bf16*Q,int qp,int qrow0,int qc0,const bf16*__restrict__ K,int kp,int kc0,const bf16*__restrict__ V,int vp,int vc0,bf16*O,int oc0,int kctx0,int klat0,int NT,char*shm,int wave_id){
  wave_id=launder_s(wave_id); const int lane=lane_id_v(),r32=lane&31,hi=lane>>5; const int wid=wave_id;
  const bf16*Qw=Q+(long)(qrow0+wid*QBLK)*qp+qc0;
  const bf16*Kh=K+kc0,*Vh=V+vc0;
  const unsigned lds0=(unsigned)(uintptr_t)shm;
  float*wsf=(float*)(shm+LDS_WS)+wid*64;
  const bf16*ksrc=Kh+(long)lane*kp+wid*8;
  const bf16*vsrc=Vh+(long)(16*(wid&3)+(lane>>2))*vp+(wid>>2)*32+(lane&3)*8;
  #define TROW0(t) ((long)((t)<4?kctx0+64*(t):klat0+64*((t)-4)))
  const unsigned kdst=lds0+LDS_K+wid*1024, vdst=lds0+LDS_V+wid*1024;
  #define DMA_K(t,slot) glds16(ksrc+TROW0(t)*kp,(unsigned)__builtin_amdgcn_readfirstlane(kdst+(slot)))
  #define DMA_V(t,slot) glds16(vsrc+TROW0(t)*vp,(unsigned)__builtin_amdgcn_readfirstlane(vdst+(slot)))
  const int vb0=(int)(lds0+LDS_V)+((lane>>4)&1)*32+(lane&3)*8+(4*hi+((lane&15)>>2))*64;
  const char*Kbase=shm+LDS_K; bf16x8 kf[8];
  const lds_cptr shm3=(lds_cptr)shm; const lds_cptr kp0=shm3+LDS_K+hi*1024+r32*16; const lds_cptr vp0=shm3+LDS_V+((lane>>4)&1)*32+(lane&3)*8+(4*hi+((lane&15)>>2))*64;
  DMA_K(0,0);DMA_V(0,0);DMA_K(1,SLOTB);
  bf16x8 qr[4];
  #pragma unroll
  for(int d0=0;d0<4;++d0)qr[d0]=*reinterpret_cast<const bf16x8*>(&Qw[(long)r32*qp+d0*16+hi*8]);
  float mhat=0.f,l_reg=0.f;f32x16 o[2];o[0]=f32x16{};o[1]=f32x16{};f32x16 negm=f32x16{};asm volatile("":"+v"(negm));
  #define CMASK(P0,P1,t) do{}while(0)
  bool resc=false;
  #define START(P0,P1) do{ const float rm=rowmax(P0,P1); resc=false; \
    { const float dl=rm; mhat=fadd_s(mhat,dl); \
      _Pragma("unroll") for(int r=0;r<16;++r){P0[r]=fsub_s(P0[r],dl);P1[r]=fsub_s(P1[r],dl);} \
      _Pragma("unroll") for(int r=0;r<16;++r)negm[r]=-mhat; asm volatile("":"+v"(negm)); } \
    _Pragma("unroll") for(int r=0;r<16;++r)P0[r]=__builtin_amdgcn_exp2f(P0[r]); }while(0)
  #define RESC() do{ if(resc){ asm volatile("s_waitcnt lgkmcnt(0)":::"memory"); \
      _Pragma("unroll") for(int d_=0;d_<2;++d_) _Pragma("unroll") for(int r=0;r<16;++r)o[d_][r]*=wsf[crow(r,hi)]; } }while(0)
  f32x16 pA0,pA1,pB0,pB1;
  int sl_prev=0,sl_cur=0,sl_next=SLOTB;
  #define ROT() do{sl_prev=sl_cur;sl_cur=sl_next;sl_next=(sl_next==(NSLOT-1)*SLOTB)?0:sl_next+SLOTB;}while(0)
  DMA_K(2,2*SLOTB);
  WAIT_BAR(3);
  qkt(pA0,pA1,Kbase,qr,negm,r32,hi);asm volatile("s_nop 15\n\ts_nop 7":"+v"(pA0),"+v"(pA1));CMASK(pA0,pA1,0);
  START(pA0,pA1);
  _Pragma("unroll") for(int r=0;r<16;++r)pA1[r]=__builtin_amdgcn_exp2f(pA1[r]);
  WAIT_BAR(0);
  DMA_K(3,0);DMA_V(1,SLOTB);
  ROT();
  kload8(kf,kp0+sl_cur);
  WAIT_BAR(2);
  s16x4 vlo[8],vhi[8]; u32x4 pw0,pw1,pw2,pw3;
  #define PKW(P,B) cvtpk_s(P[B],P[B+1])
  #define PAF(k) __builtin_bit_cast(bf16x8,pw##k)
  #define VFR(i) (bf16x8){vlo[i][0],vlo[i][1],vlo[i][2],vlo[i][3],vhi[i][0],vhi[i][1],vhi[i][2],vhi[i][3]}
  #define PIN(x) asm volatile("":"+v"(x))
  #define MX3(a,b,c) __builtin_fmaxf(__builtin_fmaxf((a),(b)),(c))
  #define GAPA(MF,A0,A1,A2,A3,W0,W1,PW) do{ MF; sacc+=A0; sacc+=A1; sacc+=A2; sacc+=A3; PIN(sacc); W0; W1; PIN(PW); SBAR(); }while(0)
  #define EX(v) __builtin_amdgcn_exp2f(v)
  #define GAPB(MF,X,B) do{ MF; X[B]=EX(X[B]); X[B+1]=EX(X[B+1]); X[B+2]=EX(X[B+2]); X[B+3]=EX(X[B+3]); PIN(X); SBAR(); }while(0)
  #define VRD(i) do{ vlo[i]=vtr(vp_+(((i)>>2)*4096+((i)&3)*1024)); vhi[i]=vtr(vp_+(((i)>>2)*4096+((i)&3)*1024+512)); }while(0)
  #define KRD(G,j) do{ if(G){ kload2(kf,kp0+sl_next,j); SBAR(); } }while(0)
  #define STEP(C0,C1,P0,P1,t,GK,GV,GL) do{ SBAR(); \
    const lds_cptr vp_=vp0+sl_prev; \
    VRD(0); SBAR(); float sacc=(P0[0]+P0[1]); \
    GAPA(C0=__builtin_amdgcn_mfma_f32_32x32x16_bf16(kf[0],qr[0],negm,0,0,0), P0[2],P0[3],P0[4],P0[5],     pw0[0]=PKW(P0,0), pw0[1]=PKW(P0,2), pw0); \
    VRD(4); SBAR(); GAPA(C1=__builtin_amdgcn_mfma_f32_32x32x16_bf16(kf[1],qr[0],negm,0,0,0), P0[6],P0[7],P0[8],P0[9],     pw0[2]=PKW(P0,4), pw0[3]=PKW(P0,6), pw0); \
    VRD(1); SBAR(); GAPA(C0=__builtin_amdgcn_mfma_f32_32x32x16_bf16(kf[2],qr[1],C0,0,0,0),   P0[10],P0[11],P0[12],P0[13], pw1[0]=PKW(P0,8), pw1[1]=PKW(P0,10), pw1); \
    VRD(5); SBAR(); GAPA(C1=__builtin_amdgcn_mfma_f32_32x32x16_bf16(kf[3],qr[1],C1,0,0,0),   P0[14],P0[15],P1[0],P1[1],   pw1[2]=PKW(P0,12),pw1[3]=PKW(P0,14), pw1); \
    VRD(2); SBAR(); GAPA(C0=__builtin_amdgcn_mfma_f32_32x32x16_bf16(kf[4],qr[2],C0,0,0,0),   P1[2],P1[3],P1[4],P1[5],     pw2[0]=PKW(P1,0), pw2[1]=PKW(P1,2), pw2); \
    VRD(6); SBAR(); GAPA(C1=__builtin_amdgcn_mfma_f32_32x32x16_bf16(kf[5],qr[2],C1,0,0,0),   P1[6],P1[7],P1[8],P1[9],     pw2[2]=PKW(P1,4), pw2[3]=PKW(P1,6), pw2); \
    VRD(3); SBAR(); GAPA(C0=__builtin_amdgcn_mfma_f32_32x32x16_bf16(kf[6],qr[3],C0,0,0,0),   P1[10],P1[11],P1[12],P1[13], pw3[0]=PKW(P1,8), pw3[1]=PKW(P1,10), pw3); \
    VRD(7); SBAR(); GAPA(C1=__builtin_amdgcn_mfma_f32_32x32x16_bf16(kf[7],qr[3],C1,0,0,0),   P1[14],P1[15],0.f,0.f,       pw3[2]=PKW(P1,12),pw3[3]=PKW(P1,14), pw3); \
    l_reg+=sacc; \
    if(GK){DMA_K((t)+3,sl_cur);} if(GV){DMA_V((t)+1,sl_next);} \
    CMASK(C0,C1,t); \
    { float a=MX3(C0[0],C0[1],C1[0]),b=MX3(C0[2],C0[3],C1[1]); a=MX3(a,C1[2],C1[3]); \
      _Pragma("unroll") for(int r=4;r<16;r+=4){a=MX3(a,C0[r],C0[r+1]);b=MX3(b,C0[r+2],C0[r+3]);a=MX3(a,C1[r],C1[r+1]);b=MX3(b,C1[r+2],C1[r+3]);} \
      float rm=__builtin_fmaxf(a,b); { auto rr=__builtin_amdgcn_permlane32_swap(__float_as_uint(rm),__float_as_uint(rm),false,false); rm=__builtin_fmaxf(__uint_as_float(rr[0]),__uint_as_float(rr[1])); } \
      resc=false; \
      if(__builtin_expect(__any(rm>(float)THRL),0)){ const float dl=__builtin_fmaxf(rm,0.f); mhat+=dl; \
        _Pragma("unroll") for(int r=0;r<16;++r){C0[r]-=dl;C1[r]-=dl;} \
        _Pragma("unroll") for(int r=0;r<16;++r)negm[r]=-mhat; asm volatile("":"+v"(negm)); \
        const float f=__builtin_amdgcn_exp2f(-dl); l_reg*=f; if(hi==0)wsf[r32]=f; resc=true; } } \
    SBAR(); \
    GAPB(o[0]=__builtin_amdgcn_mfma_f32_32x32x16_bf16(PAF(0),VFR(0),o[0],0,0,0), C0,0); \
    GAPB(o[1]=__builtin_amdgcn_mfma_f32_32x32x16_bf16(PAF(0),VFR(4),o[1],0,0,0), C0,4); \
    KRD(GL,0); GAPB(o[0]=__builtin_amdgcn_mfma_f32_32x32x16_bf16(PAF(1),VFR(1),o[0],0,0,0), C0,8); \
    KRD(GL,1); GAPB(o[1]=__builtin_amdgcn_mfma_f32_32x32x16_bf16(PAF(1),VFR(5),o[1],0,0,0), C0,12); \
    KRD(GL,2); GAPB(o[0]=__builtin_amdgcn_mfma_f32_32x32x16_bf16(PAF(2),VFR(2),o[0],0,0,0), C1,0); \
    KRD(GL,3); GAPB(o[1]=__builtin_amdgcn_mfma_f32_32x32x16_bf16(PAF(2),VFR(6),o[1],0,0,0), C1,4); \
    GAPB(o[0]=__builtin_amdgcn_mfma_f32_32x32x16_bf16(PAF(3),VFR(3),o[0],0,0,0), C1,8); \
    GAPB(o[1]=__builtin_amdgcn_mfma_f32_32x32x16_bf16(PAF(3),VFR(7),o[1],0,0,0), C1,12); \
    }while(0)
  int t=1;
  for(;t+5<NT;t+=2){
    STEP(pB0,pB1,pA0,pA1,t,true,true,true);     WAIT_BAR(2); RESC(); ROT();
    STEP(pA0,pA1,pB0,pB1,t+1,true,true,true);   WAIT_BAR(2); RESC(); ROT();
  }
  #define ENDW(tt) do{ if((tt)+3<NT){WAIT_BAR(2);} else if((tt)+2<NT){WAIT_BAR(1);} else {WAIT_BAR(0);} }while(0)
  for(;t+1<NT;t+=2){
    STEP(pB0,pB1,pA0,pA1,t,(t+3<NT),(t+1<NT),(t+1<NT));       ENDW(t);   RESC(); ROT();
    STEP(pA0,pA1,pB0,pB1,t+1,(t+4<NT),(t+2<NT),(t+2<NT));     ENDW(t+1); RESC(); ROT();
  }
  STEP(pB0,pB1,pA0,pA1,NT-1,false,false,false); RESC();
  { float sacc=pB0[0]+pB0[1]; _Pragma("unroll") for(int r=2;r<16;++r)sacc+=pB0[r]; _Pragma("unroll") for(int r=0;r<16;++r)sacc+=pB1[r]; l_reg+=sacc;
    pw0=(u32x4){PKW(pB0,0),PKW(pB0,2),PKW(pB0,4),PKW(pB0,6)};pw1=(u32x4){PKW(pB0,8),PKW(pB0,10),PKW(pB0,12),PKW(pB0,14)};pw2=(u32x4){PKW(pB1,0),PKW(pB1,2),PKW(pB1,4),PKW(pB1,6)};pw3=(u32x4){PKW(pB1,8),PKW(pB1,10),PKW(pB1,12),PKW(pB1,14)};
    SBAR(); pv(o,vb0+sl_cur,PAF(0),PAF(1),PAF(2),PAF(3)); }
  #undef PKW
  #undef PAF
  #undef VFR
  #undef PIN
  #undef MX3
  #undef GAPA
  #undef GAPB
  #undef EX
  #undef VRD
  #undef KRD
  #undef STEP
  #undef ENDW
  {auto rr=__builtin_amdgcn_permlane32_swap(__float_as_uint(l_reg),__float_as_uint(l_reg),false,false);l_reg=__uint_as_float(rr[0])+__uint_as_float(rr[1]);}
  if(hi==0)wsf[32+r32]=l_reg;asm volatile("s_waitcnt lgkmcnt(0)":::"memory");
  float rli[16];
  #pragma unroll
  for(int r=0;r<16;++r)rli[r]=__builtin_amdgcn_rcpf(wsf[32+crow(r,hi)]);
  unsigned char*Ow=(unsigned char*)O+(long)(qrow0+wid*QBLK)*1024+oc0;
  { bf16*stg=(bf16*)(shm+LDS_OST)+wid*2048;
    #pragma unroll
    for(int r=0;r<16;++r){const int orow=crow(r,hi);
      #pragma unroll
      for(int d0=0;d0<2;++d0)stg[orow*64+d0*32+r32]=(bf16)(cvtpk_s(o[d0][r]*rli[r],0.f)&0xffffu);}
    asm volatile("s_waitcnt lgkmcnt(0)":::"memory");
    #pragma unroll
    for(int i=0;i<4;++i){const int row=i*8+(lane>>3),ch=lane&7; const u32x4 v=*(const u32x4*)(stg+row*64+ch*8);
      *(v2u*)(Ow+(long)row*1024+ch*8)=pack8_fp8((f32x4){bf_lo(v.x),bf_hi(v.x),bf_lo(v.y),bf_hi(v.y)},(f32x4){bf_lo(v.z),bf_hi(v.z),bf_lo(v[3]),bf_hi(v[3])});} }
  asm volatile("s_waitcnt lgkmcnt(0)\n\ts_barrier":::"memory");
  #undef DMA_K
  #undef DMA_V
  #undef TROW0
  #undef CMASK
  #undef START
  #undef RESC
  #undef ROT
}
#undef SBAR
#undef WAIT_BAR
}

namespace att96 {
typedef unsigned short bf16;
using bf16x8=__attribute__((ext_vector_type(8)))short;
using s16x4=__attribute__((ext_vector_type(4)))short;
using f32x16=__attribute__((ext_vector_type(16)))float;
using u32x4=__attribute__((ext_vector_type(4)))unsigned;
constexpr int D=64;
constexpr int NW=8,QBLK=32,QB=QBLK*NW,KVBLK=64;
__device__ __forceinline__ int crow(int r,int hi){return (r&3)+8*(r>>2)+4*hi;}
#define SBAR() __builtin_amdgcn_sched_barrier(0)
constexpr int NSLOT=3, SLOTB=8192, KSLOTB=12288;
#define KOFF(sl) ((sl)+((sl)>>1))
constexpr int LDS_K=0, LDS_V=NSLOT*KSLOTB, LDS_WS=LDS_V+NSLOT*SLOTB, LDS_OST=LDS_WS+NW*64*4, LDS_BYTES=LDS_OST+NW*4096;
constexpr float C2=0.125f*1.4426950408889634f;
__device__ __forceinline__ void glds16(const void*gsrc,unsigned lds_dst){unsigned keep;
  asm volatile("s_mov_b32 %0, m0\n\ts_mov_b32 m0, %2\n\ts_nop 0\n\tglobal_load_lds_dwordx4 %1, off\n\ts_mov_b32 m0, %0":"=&s"(keep):"v"(gsrc),"s"(lds_dst):"memory");}
__device__ __forceinline__ float max3f(float a,float b,float c){float r;asm("v_max3_f32 %0, %1, %2, %3":"=v"(r):"v"(a),"v"(b),"v"(c));return r;}
__device__ __forceinline__ float max2f(float a,float b){float r;asm("v_max_f32_e32 %0, %1, %2":"=v"(r):"v"(a),"v"(b));return r;}
__device__ __forceinline__ float fadd_s(float a,float b){float r;asm("v_add_f32_e32 %0, %1, %2":"=v"(r):"v"(a),"v"(b));return r;}
__device__ __forceinline__ float fsub_s(float a,float b){float r;asm("v_sub_f32_e32 %0, %1, %2":"=v"(r):"v"(a),"v"(b));return r;}
typedef float f32x2_t __attribute__((ext_vector_type(2))); typedef __bf16 bf16x2_t __attribute__((ext_vector_type(2)));
__device__ __forceinline__ unsigned cvtpk_s(float lo,float hi){f32x2_t v={lo,hi};bf16x2_t b=__builtin_convertvector(v,bf16x2_t);return __builtin_bit_cast(unsigned,b);}
#define WAIT_BAR(N) asm volatile("s_waitcnt vmcnt(" #N ") lgkmcnt(0)\n\ts_barrier":::"memory")

__device__ __forceinline__ void qkt(f32x16&p0,f32x16&p1,const char*Kslot,const bf16x8*qr,const f32x16&negm,int r32,int hi){
  const char*kb=Kslot+hi*1024+r32*16;
  #pragma unroll
  for(int d0=0;d0<6;++d0){
    const bf16x8 b0=*reinterpret_cast<const bf16x8*>(kb+d0*2048);
    const bf16x8 b1=*reinterpret_cast<const bf16x8*>(kb+d0*2048+512);
    if(d0==0){p0=__builtin_amdgcn_mfma_f32_32x32x16_bf16(b0,qr[0],negm,0,0,0);p1=__builtin_amdgcn_mfma_f32_32x32x16_bf16(b1,qr[0],negm,0,0,0);}
    else{p0=__builtin_amdgcn_mfma_f32_32x32x16_bf16(b0,qr[d0],p0,0,0,0);p1=__builtin_amdgcn_mfma_f32_32x32x16_bf16(b1,qr[d0],p1,0,0,0);}}
}
typedef __attribute__((address_space(3))) const char* lds_cptr;
typedef short v4i16_t __attribute__((ext_vector_type(4)));
__device__ __forceinline__ void kload8(bf16x8*kf,lds_cptr kp){
  kf[0]=*(const __attribute__((address_space(3))) bf16x8*)(kp);      kf[1]=*(const __attribute__((address_space(3))) bf16x8*)(kp+512);
  kf[2]=*(const __attribute__((address_space(3))) bf16x8*)(kp+2048); kf[3]=*(const __attribute__((address_space(3))) bf16x8*)(kp+2560);
  kf[4]=*(const __attribute__((address_space(3))) bf16x8*)(kp+4096); kf[5]=*(const __attribute__((address_space(3))) bf16x8*)(kp+4608);
  kf[6]=*(const __attribute__((address_space(3))) bf16x8*)(kp+6144); kf[7]=*(const __attribute__((address_space(3))) bf16x8*)(kp+6656);
  kf[8]=*(const __attribute__((address_space(3))) bf16x8*)(kp+8192); kf[9]=*(const __attribute__((address_space(3))) bf16x8*)(kp+8704);
  kf[10]=*(const __attribute__((address_space(3))) bf16x8*)(kp+10240); kf[11]=*(const __attribute__((address_space(3))) bf16x8*)(kp+10752);
}
__device__ __forceinline__ void kload2(bf16x8*kf,lds_cptr kp,int j){ kf[2*j]=*(const __attribute__((address_space(3))) bf16x8*)(kp+j*2048); kf[2*j+1]=*(const __attribute__((address_space(3))) bf16x8*)(kp+j*2048+512); }
__device__ __forceinline__ s16x4 vtr(lds_cptr p){ return __builtin_bit_cast(s16x4,__builtin_amdgcn_ds_read_tr16_b64_v4i16((__attribute__((address_space(3))) v4i16_t*)p)); }
__device__ __forceinline__ float rowmax(const f32x16&p0,const f32x16&p1){
  float a=max3f(p0[0],p0[1],p1[0]),b=max3f(p0[2],p0[3],p1[1]);a=max3f(a,p1[2],p1[3]);
  #pragma unroll
  for(int r=4;r<16;r+=4){a=max3f(a,p0[r],p0[r+1]);b=max3f(b,p0[r+2],p0[r+3]);a=max3f(a,p1[r],p1[r+1]);b=max3f(b,p1[r+2],p1[r+3]);}
  const float m=max2f(a,b);
  auto rr=__builtin_amdgcn_permlane32_swap(__float_as_uint(m),__float_as_uint(m),false,false);
  return max2f(__uint_as_float(rr[0]),__uint_as_float(rr[1]));
}
__device__ __forceinline__ void pv(f32x16*o,int vb,bf16x8 pa0,bf16x8 pa1,bf16x8 pa2,bf16x8 pa3){
  #pragma unroll
  for(int d0=0;d0<2;++d0){s16x4 lo[4],hi[4];
    #pragma unroll
    for(int ks=0;ks<4;++ks){
      asm volatile("ds_read_b64_tr_b16 %0,%1 offset:%c2":"=&v"(lo[ks]):"v"(vb),"i"(d0*4096+ks*1024):"memory");
      asm volatile("ds_read_b64_tr_b16 %0,%1 offset:%c2":"=&v"(hi[ks]):"v"(vb),"i"(d0*4096+ks*1024+512):"memory");}
    asm volatile("s_waitcnt lgkmcnt(0)":::"memory");SBAR();
    #define PK(k) (bf16x8){lo[k][0],lo[k][1],lo[k][2],lo[k][3],hi[k][0],hi[k][1],hi[k][2],hi[k][3]}
    o[d0]=__builtin_amdgcn_mfma_f32_32x32x16_bf16(pa0,PK(0),o[d0],0,0,0);
    o[d0]=__builtin_amdgcn_mfma_f32_32x32x16_bf16(pa1,PK(1),o[d0],0,0,0);
    o[d0]=__builtin_amdgcn_mfma_f32_32x32x16_bf16(pa2,PK(2),o[d0],0,0,0);
    o[d0]=__builtin_amdgcn_mfma_f32_32x32x16_bf16(pa3,PK(3),o[d0],0,0,0);
    #undef PK
  }
}

#ifndef ATTN_STORE16
#define ATTN_STORE16(p,v) (*(u32x4*)(p)=(v))
#endif
template<int THRL> __device__ __forceinline__ void attn_unit(const bf16*Q,int qp,int qrow0,int qc0,const bf16*__restrict__ K,int kp,int kc0,const bf16*__restrict__ V,int vp,int vc0,bf16*O,int oc0,int kctx0,int klat0,int NT,char*shm,int wave_id){
  wave_id=launder_s(wave_id); const int lane=lane_id_v(),r32=lane&31,hi=lane>>5; const int wid=wave_id;
  const bf16*Qw=Q+(long)(qrow0+wid*QBLK)*qp+qc0;
  const bf16*Kh=K+kc0,*Vh=V+vc0;
  const unsigned lds0=(unsigned)(uintptr_t)shm;
  float*wsf=(float*)(shm+LDS_WS)+wid*64;
  const bf16*ksrc=Kh+(long)lane*kp+wid*8;
  const bf16*vsrc=Vh+(long)(16*(wid&3)+(lane>>2))*vp+(wid>>2)*32+(lane&3)*8;
  #define TROW0(t) ((long)((t)<4?kctx0+64*(t):klat0+64*((t)-4)))
  const unsigned kdst=lds0+LDS_K+wid*1024, kdst2=lds0+LDS_K+8192+(wid&3)*1024, vdst=lds0+LDS_V+wid*1024;
  const int k2off=(8+(wid&3)-wid)*8;
  #define DMA_K(t,slot) do{ glds16(ksrc+TROW0(t)*kp,(unsigned)__builtin_amdgcn_readfirstlane(kdst+KOFF(slot))); glds16(ksrc+TROW0(t)*kp+k2off,(unsigned)__builtin_amdgcn_readfirstlane(kdst2+KOFF(slot))); }while(0)
  #define DMA_V(t,slot) glds16(vsrc+TROW0(t)*vp,(unsigned)__builtin_amdgcn_readfirstlane(vdst+(slot)))
  const int vb0=(int)(lds0+LDS_V)+((lane>>4)&1)*32+(lane&3)*8+(4*hi+((lane&15)>>2))*64;
  const char*Kbase=shm+LDS_K; bf16x8 kf[12];
  const lds_cptr shm3=(lds_cptr)shm; const lds_cptr kp0=shm3+LDS_K+hi*1024+r32*16; const lds_cptr vp0=shm3+LDS_V+((lane>>4)&1)*32+(lane&3)*8+(4*hi+((lane&15)>>2))*64;
  DMA_K(0,0);DMA_V(0,0);DMA_K(1,SLOTB);
  bf16x8 qr[6];
  #pragma unroll
  for(int d0=0;d0<6;++d0)qr[d0]=*reinterpret_cast<const bf16x8*>(&Qw[(long)r32*qp+d0*16+hi*8]);
  float mhat=0.f,l_reg=0.f;f32x16 o[2];o[0]=f32x16{};o[1]=f32x16{};f32x16 negm=f32x16{};asm volatile("":"+v"(negm));
  #define CMASK(P0,P1,t) do{}while(0)
  bool resc=false;
  #define START(P0,P1) do{ const float rm=rowmax(P0,P1); resc=false; \
    { const float dl=rm; mhat=fadd_s(mhat,dl); \
      _Pragma("unroll") for(int r=0;r<16;++r){P0[r]=fsub_s(P0[r],dl);P1[r]=fsub_s(P1[r],dl);} \
      _Pragma("unroll") for(int r=0;r<16;++r)negm[r]=-mhat; asm volatile("":"+v"(negm)); } \
    _Pragma("unroll") for(int r=0;r<16;++r)P0[r]=__builtin_amdgcn_exp2f(P0[r]); }while(0)
  #define RESC() do{ if(resc){ asm volatile("s_waitcnt lgkmcnt(0)":::"memory"); \
      _Pragma("unroll") for(int d_=0;d_<2;++d_) _Pragma("unroll") for(int r=0;r<16;++r)o[d_][r]*=wsf[crow(r,hi)]; } }while(0)
  f32x16 pA0,pA1,pB0,pB1;
  int sl_prev=0,sl_cur=0,sl_next=SLOTB;
  #define ROT() do{sl_prev=sl_cur;sl_cur=sl_next;sl_next=(sl_next==(NSLOT-1)*SLOTB)?0:sl_next+SLOTB;}while(0)
  DMA_K(2,2*SLOTB);
  WAIT_BAR(5);
  qkt(pA0,pA1,Kbase,qr,negm,r32,hi);asm volatile("s_nop 15\n\ts_nop 7":"+v"(pA0),"+v"(pA1));CMASK(pA0,pA1,0);
  START(pA0,pA1);
  _Pragma("unroll") for(int r=0;r<16;++r)pA1[r]=__builtin_amdgcn_exp2f(pA1[r]);
  WAIT_BAR(0);
  DMA_K(3,0);DMA_V(1,SLOTB);
  ROT();
  kload8(kf,kp0+KOFF(sl_cur));
  WAIT_BAR(3);
  s16x4 vlo[8],vhi[8]; u32x4 pw0,pw1,pw2,pw3;
  #define PKW(P,B) cvtpk_s(P[B],P[B+1])
  #define PAF(k) __builtin_bit_cast(bf16x8,pw##k)
  #define VFR(i) (bf16x8){vlo[i][0],vlo[i][1],vlo[i][2],vlo[i][3],vhi[i][0],vhi[i][1],vhi[i][2],vhi[i][3]}
  #define PIN(x) asm volatile("":"+v"(x))
  #define MX3(a,b,c) __builtin_fmaxf(__builtin_fmaxf((a),(b)),(c))
  #define GAPA(MF,A0,A1,A2,A3,W0,W1,PW) do{ MF; sacc+=A0; sacc+=A1; sacc+=A2; sacc+=A3; PIN(sacc); W0; W1; PIN(PW); SBAR(); }while(0)
  #define EX(v) __builtin_amdgcn_exp2f(v)
  #define GAPB(MF,X,B) do{ MF; X[B]=EX(X[B]); X[B+1]=EX(X[B+1]); X[B+2]=EX(X[B+2]); X[B+3]=EX(X[B+3]); PIN(X); SBAR(); }while(0)
  #define VRD(i) do{ vlo[i]=vtr(vp_+(((i)>>2)*4096+((i)&3)*1024)); vhi[i]=vtr(vp_+(((i)>>2)*4096+((i)&3)*1024+512)); }while(0)
  #define KRD(G,j) do{ if(G){ kload2(kf,kp0+KOFF(sl_next),j); SBAR(); } }while(0)
  #define STEP(C0,C1,P0,P1,t,GK,GV,GL) do{ SBAR(); \
    const lds_cptr vp_=vp0+sl_prev; \
    VRD(0); SBAR(); float sacc=(P0[0]+P0[1]); \
    GAPA(C0=__builtin_amdgcn_mfma_f32_32x32x16_bf16(kf[0],qr[0],negm,0,0,0), P0[2],P0[3],P0[4],P0[5],     pw0[0]=PKW(P0,0), pw0[1]=PKW(P0,2), pw0); \
    VRD(4); SBAR(); GAPA(C1=__builtin_amdgcn_mfma_f32_32x32x16_bf16(kf[1],qr[0],negm,0,0,0), P0[6],P0[7],P0[8],P0[9],     pw0[2]=PKW(P0,4), pw0[3]=PKW(P0,6), pw0); \
    VRD(1); SBAR(); GAPA(C0=__builtin_amdgcn_mfma_f32_32x32x16_bf16(kf[2],qr[1],C0,0,0,0),   P0[10],P0[11],P0[12],P0[13], pw1[0]=PKW(P0,8), pw1[1]=PKW(P0,10), pw1); \
    VRD(5); SBAR(); GAPA(C1=__builtin_amdgcn_mfma_f32_32x32x16_bf16(kf[3],qr[1],C1,0,0,0),   P0[14],P0[15],P1[0],P1[1],   pw1[2]=PKW(P0,12),pw1[3]=PKW(P0,14), pw1); \
    VRD(2); SBAR(); GAPA(C0=__builtin_amdgcn_mfma_f32_32x32x16_bf16(kf[4],qr[2],C0,0,0,0),   P1[2],P1[3],P1[4],P1[5],     pw2[0]=PKW(P1,0), pw2[1]=PKW(P1,2), pw2); \
    VRD(6); SBAR(); GAPA(C1=__builtin_amdgcn_mfma_f32_32x32x16_bf16(kf[5],qr[2],C1,0,0,0),   P1[6],P1[7],P1[8],P1[9],     pw2[2]=PKW(P1,4), pw2[3]=PKW(P1,6), pw2); \
    VRD(3); SBAR(); GAPA(C0=__builtin_amdgcn_mfma_f32_32x32x16_bf16(kf[6],qr[3],C0,0,0,0),   P1[10],P1[11],P1[12],P1[13], pw3[0]=PKW(P1,8), pw3[1]=PKW(P1,10), pw3); \
    VRD(7); SBAR(); GAPA(C1=__builtin_amdgcn_mfma_f32_32x32x16_bf16(kf[7],qr[3],C1,0,0,0),   P1[14],P1[15],0.f,0.f,       pw3[2]=PKW(P1,12),pw3[3]=PKW(P1,14), pw3); \
    C0=__builtin_amdgcn_mfma_f32_32x32x16_bf16(kf[8],qr[4],C0,0,0,0); C1=__builtin_amdgcn_mfma_f32_32x32x16_bf16(kf[9],qr[4],C1,0,0,0); C0=__builtin_amdgcn_mfma_f32_32x32x16_bf16(kf[10],qr[5],C0,0,0,0); C1=__builtin_amdgcn_mfma_f32_32x32x16_bf16(kf[11],qr[5],C1,0,0,0); SBAR(); \
    l_reg+=sacc; \
    if(GK){DMA_K((t)+3,sl_cur);} if(GV){DMA_V((t)+1,sl_next);} \
    CMASK(C0,C1,t); \
    { float a=MX3(C0[0],C0[1],C1[0]),b=MX3(C0[2],C0[3],C1[1]); a=MX3(a,C1[2],C1[3]); \
      _Pragma("unroll") for(int r=4;r<16;r+=4){a=MX3(a,C0[r],C0[r+1]);b=MX3(b,C0[r+2],C0[r+3]);a=MX3(a,C1[r],C1[r+1]);b=MX3(b,C1[r+2],C1[r+3]);} \
      float rm=__builtin_fmaxf(a,b); { auto rr=__builtin_amdgcn_permlane32_swap(__float_as_uint(rm),__float_as_uint(rm),false,false); rm=__builtin_fmaxf(__uint_as_float(rr[0]),__uint_as_float(rr[1])); } \
      resc=false; \
      if(__builtin_expect(__any(rm>(float)THRL),0)){ const float dl=__builtin_fmaxf(rm,0.f); mhat+=dl; \
        _Pragma("unroll") for(int r=0;r<16;++r){C0[r]-=dl;C1[r]-=dl;} \
        _Pragma("unroll") for(int r=0;r<16;++r)negm[r]=-mhat; asm volatile("":"+v"(negm)); \
        const float f=__builtin_amdgcn_exp2f(-dl); l_reg*=f; if(hi==0)wsf[r32]=f; resc=true; } } \
    SBAR(); \
    GAPB(o[0]=__builtin_amdgcn_mfma_f32_32x32x16_bf16(PAF(0),VFR(0),o[0],0,0,0), C0,0); \
    GAPB(o[1]=__builtin_amdgcn_mfma_f32_32x32x16_bf16(PAF(0),VFR(4),o[1],0,0,0), C0,4); \
    KRD(GL,0); GAPB(o[0]=__builtin_amdgcn_mfma_f32_32x32x16_bf16(PAF(1),VFR(1),o[0],0,0,0), C0,8); \
    KRD(GL,1); GAPB(o[1]=__builtin_amdgcn_mfma_f32_32x32x16_bf16(PAF(1),VFR(5),o[1],0,0,0), C0,12); \
    KRD(GL,2); GAPB(o[0]=__builtin_amdgcn_mfma_f32_32x32x16_bf16(PAF(2),VFR(2),o[0],0,0,0), C1,0); \
    KRD(GL,3); GAPB(o[1]=__builtin_amdgcn_mfma_f32_32x32x16_bf16(PAF(2),VFR(6),o[1],0,0,0), C1,4); \
    KRD(GL,4); GAPB(o[0]=__builtin_amdgcn_mfma_f32_32x32x16_bf16(PAF(3),VFR(3),o[0],0,0,0), C1,8); \
    KRD(GL,5); GAPB(o[1]=__builtin_amdgcn_mfma_f32_32x32x16_bf16(PAF(3),VFR(7),o[1],0,0,0), C1,12); \
    }while(0)
  int t=1;
  for(;t+5<NT;t+=2){
    STEP(pB0,pB1,pA0,pA1,t,true,true,true);     WAIT_BAR(3); RESC(); ROT();
    STEP(pA0,pA1,pB0,pB1,t+1,true,true,true);   WAIT_BAR(3); RESC(); ROT();
  }
  #define ENDW(tt) do{ if((tt)+3<NT){WAIT_BAR(3);} else if((tt)+2<NT){WAIT_BAR(1);} else {WAIT_BAR(0);} }while(0)
  for(;t+1<NT;t+=2){
    STEP(pB0,pB1,pA0,pA1,t,(t+3<NT),(t+1<NT),(t+1<NT));       ENDW(t);   RESC(); ROT();
    STEP(pA0,pA1,pB0,pB1,t+1,(t+4<NT),(t+2<NT),(t+2<NT));     ENDW(t+1); RESC(); ROT();
  }
  STEP(pB0,pB1,pA0,pA1,NT-1,false,false,false); RESC();
  { float sacc=pB0[0]+pB0[1]; _Pragma("unroll") for(int r=2;r<16;++r)sacc+=pB0[r]; _Pragma("unroll") for(int r=0;r<16;++r)sacc+=pB1[r]; l_reg+=sacc;
    pw0=(u32x4){PKW(pB0,0),PKW(pB0,2),PKW(pB0,4),PKW(pB0,6)};pw1=(u32x4){PKW(pB0,8),PKW(pB0,10),PKW(pB0,12),PKW(pB0,14)};pw2=(u32x4){PKW(pB1,0),PKW(pB1,2),PKW(pB1,4),PKW(pB1,6)};pw3=(u32x4){PKW(pB1,8),PKW(pB1,10),PKW(pB1,12),PKW(pB1,14)};
    SBAR(); pv(o,vb0+sl_cur,PAF(0),PAF(1),PAF(2),PAF(3)); }
  #undef PKW
  #undef PAF
  #undef VFR
  #undef PIN
  #undef MX3
  #undef GAPA
  #undef GAPB
  #undef EX
  #undef VRD
  #undef KRD
  #undef STEP
  #undef ENDW
  {auto rr=__builtin_amdgcn_permlane32_swap(__float_as_uint(l_reg),__float_as_uint(l_reg),false,false);l_reg=__uint_as_float(rr[0])+__uint_as_float(rr[1]);}
  if(hi==0)wsf[32+r32]=l_reg;asm volatile("s_waitcnt lgkmcnt(0)":::"memory");
  float rli[16];
  #pragma unroll
  for(int r=0;r<16;++r)rli[r]=__builtin_amdgcn_rcpf(wsf[32+crow(r,hi)]);
  unsigned char*Ow=(unsigned char*)O+(long)(qrow0+wid*QBLK)*1024+oc0;
  { bf16*stg=(bf16*)(shm+LDS_OST)+wid*2048;
    #pragma unroll
    for(int r=0;r<16;++r){const int orow=crow(r,hi);
      #pragma unroll
      for(int d0=0;d0<2;++d0)stg[orow*64+d0*32+r32]=(bf16)(cvtpk_s(o[d0][r]*rli[r],0.f)&0xffffu);}
    asm volatile("s_waitcnt lgkmcnt(0)":::"memory");
    #pragma unroll
    for(int i=0;i<4;++i){const int row=i*8+(lane>>3),ch=lane&7; const u32x4 v=*(const u32x4*)(stg+row*64+ch*8);
      *(v2u*)(Ow+(long)row*1024+ch*8)=pack8_fp8((f32x4){bf_lo(v.x),bf_hi(v.x),bf_lo(v.y),bf_hi(v.y)},(f32x4){bf_lo(v.z),bf_hi(v.z),bf_lo(v[3]),bf_hi(v[3])});} }
  asm volatile("s_waitcnt lgkmcnt(0)\n\ts_barrier":::"memory");
  #undef DMA_K
  #undef DMA_V
  #undef TROW0
  #undef CMASK
  #undef START
  #undef RESC
  #undef ROT
}
#undef SBAR
#undef WAIT_BAR
#undef KOFF
}

struct Args { const float* in[27]; float* out; unsigned char* ws; int ph_lo, ph_hi; };
struct Frame {
    LAS unsigned char* lds; unsigned char* ws; gu32* ctl; int wave, G, gw, NGW;
};
__device__ __forceinline__ int lthread(int wave) { return wave * 64 + lane_id_v(); }

template <int MODE>
__device__ __forceinline__ void conv_item(const float* W, int K, int N, bf16* WT, LAS float* scr, int item, int lane) {
    const int nblk = (N + 63) / 64, kb = item / nblk, nb = item % nblk, k0 = 64 * kb, n0 = 64 * nb;
    f32x4 v[16];
    const int cc = (lane & 15) * 4, rk = lane >> 4;
    const bool ok = (n0 + cc) < N;
#pragma unroll
    for (int i = 0; i < 16; ++i) v[i] = ok ? *(const f32x4*)(W + (size_t)(k0 + 4 * i + rk) * N + n0 + cc) : (f32x4){0.f, 0.f, 0.f, 0.f};
#pragma unroll
    for (int i = 0; i < 16; ++i) { LAS float* s = scr + (4 * i + rk) * 65 + cc; s[0] = v[i][0]; s[1] = v[i][1]; s[2] = v[i][2]; s[3] = v[i][3]; }
    LDS_WAIT(); asm volatile("" ::: "memory");
    const int c = lane & 7;
#pragma unroll
    for (int j = 0; j < 8; ++j) { const int n = (lane >> 3) + 8 * j; const LAS float* s = scr + (8 * c) * 65 + n;
        v4u o; o.x = pk2(s[0], s[65]); o.y = pk2(s[2 * 65], s[3 * 65]); o.z = pk2(s[4 * 65], s[5 * 65]); o.w = pk2(s[6 * 65], s[7 * 65]);
        const int ng = n0 + n; if (ng < N) { const int dr = (MODE == 1) ? ((ng >> 8) * 256 + (ng & 1) * 128 + ((ng >> 1) & 127)) : ng; *(v4u*)(WT + (size_t)dr * K + k0 + 8 * c) = o; } }
    LDS_WAIT(); asm volatile("" ::: "memory");
}

__device__ __forceinline__ void prologue(Frame& F, const Args& a) {
    const int f_tid = lthread(F.wave), f_lane = f_tid & 63;
    unsigned char* ws = F.ws;
    {
        LAS float* scr = (LAS float*)(F.lds + F.wave * 16640);
        struct M { const float* src; int K, N; size_t dst; };
        const int I_MIN = 16 * 11, I_QB = 6 * 24, I_KVB = 4 * 32, I_GQKV = 16 * 24;
        const int NSMALL = I_MIN + I_QB + I_KVB + I_GQKV;
        for (int it = F.gw; it < NSMALL; it += F.NGW) {
            int r = it;
            if (r < I_MIN) { conv_item<0>(a.in[11], D, MLA_IN, (bf16*)(ws + WS_WMIN), scr, r, f_lane); continue; } r -= I_MIN;
            if (r < I_QB) { conv_item<0>(a.in[13], MLA_QL, 1536, (bf16*)(ws + WS_WMQB), scr, r, f_lane); continue; } r -= I_QB;
            if (r < I_KVB) { conv_item<0>(a.in[15], MLA_KVL, 2048, (bf16*)(ws + WS_WMKVB), scr, r, f_lane); continue; } r -= I_KVB;
            conv_item<0>(a.in[17], D, GQA_QKV, (bf16*)(ws + WS_WGQKV), scr, r, f_lane);
        }
    }
    __syncthreads();
    {
        LAS float* cmax = (LAS float*)F.lds;
        LAS float* cinv = cmax + 512;
        LAS unsigned* scr8 = (LAS unsigned*)(F.lds + 4096) + F.wave * (64 * 33);
        const int cc = (f_lane & 15) * 4, rk = f_lane >> 4;
        constexpr int NGU = DEPTH * NE * 32, NDN = DEPTH * NE * 16, NWO = 4 * 16;
        for (int it = blockIdx.x; it < NGU + NDN + NWO; it += F.G) {
            const bool dn = it >= NGU; const bool wo = it >= NGU + NDN; const int q_ = wo ? it - NGU - NDN : (dn ? it - NGU : it); const int le = dn ? (q_ >> 4) : (q_ >> 5), strip = dn ? (q_ & 15) : (q_ & 31);
            const int N = dn ? 1024 : 2048;
            const float* wosrc = (le < 2) ? a.in[10] + (size_t)le * D * D : (le == 2 ? a.in[16] : a.in[20]);
            const float* W = (wo ? wosrc : (dn ? a.in[25] + (size_t)le * DFF * D : a.in[23] + (size_t)le * D * 2048)) + strip * 64 + cc;
            f32x4 v[32];
#pragma unroll
            for (int i = 0; i < 32; ++i) v[i] = *(const f32x4*)(W + (size_t)(F.wave * 128 + 16 * (i >> 2) + 4 * rk + (i & 3)) * N);
            f32x4 mx = (f32x4){0.f, 0.f, 0.f, 0.f};
#pragma unroll
            for (int i = 0; i < 32; ++i) { mx[0] = fmaxf(mx[0], fabsf(v[i][0])); mx[1] = fmaxf(mx[1], fabsf(v[i][1])); mx[2] = fmaxf(mx[2], fabsf(v[i][2])); mx[3] = fmaxf(mx[3], fabsf(v[i][3])); }
#pragma unroll
            for (int q = 0; q < 4; ++q) { mx[q] = fmaxf(mx[q], shx(mx[q], 16, f_lane)); mx[q] = fmaxf(mx[q], shx(mx[q], 32, f_lane)); }
            __syncthreads();
            if (rk == 0) { LAS float* d = cmax + F.wave * 64 + cc; d[0] = mx[0]; d[1] = mx[1]; d[2] = mx[2]; d[3] = mx[3]; }
            __syncthreads();
            const float target = dn ? 240.f : 127.f;
            if (f_tid < 64) { float m8 = 0.f;
#pragma unroll
                for (int w = 0; w < 8; ++w) m8 = fmaxf(m8, cmax[w * 64 + f_tid]);
                const int ng = strip * 64 + f_tid, dr = dn ? ng : (ng >> 8) * 256 + (ng & 1) * 128 + ((ng >> 1) & 127);
                float* sc = wo ? (float*)(ws + WS_SWO) + (size_t)le * 1024 : (dn ? (float*)(ws + WS_SWDN) + (size_t)le * 1024 : (float*)(ws + WS_SWGU) + (size_t)le * 2048);
                sc[dr] = (m8 > 0.f) ? m8 / target : 1.f;
                cinv[f_tid] = (m8 > 0.f) ? target / m8 : 0.f; }
            __syncthreads();
            const f32x4 iv = *(const LAS f32x4*)(cinv + cc);
#pragma unroll
            for (int ip = 0; ip < 8; ++ip) {
#pragma unroll
                for (int q = 0; q < 4; ++q) { unsigned w = 0;
                    if (dn) { int t = __builtin_amdgcn_cvt_pk_fp8_f32(v[4 * ip][q] * iv[q], v[4 * ip + 1][q] * iv[q], 0, false); t = __builtin_amdgcn_cvt_pk_fp8_f32(v[4 * ip + 2][q] * iv[q], v[4 * ip + 3][q] * iv[q], t, true); w = (unsigned)t; }
                    else w = q8x4(v[4 * ip][q], v[4 * ip + 1][q], v[4 * ip + 2][q], v[4 * ip + 3][q], iv[q]);
                    scr8[(cc + q) * 33 + 4 * ip + rk] = w; } }
            LDS_WAIT(); asm volatile("" ::: "memory");
            { const int c8 = f_lane & 7;
              unsigned char* dst = wo ? (unsigned char*)(ws + WS_WO8) + (size_t)le * 1024 * 1024 : (dn ? (unsigned char*)(ws + WS_WDN) + (size_t)le * 1024 * 1024 : (unsigned char*)(ws + WS_WGU) + (size_t)le * 2048 * 1024);
#pragma unroll
              for (int jp = 0; jp < 8; ++jp) { const int n = (f_lane >> 3) + 8 * jp; const LAS unsigned* sp = scr8 + n * 33 + 4 * c8;
                  v4u o; o.x = sp[0]; o.y = sp[1]; o.z = sp[2]; o[3] = sp[3];
                  const int ng = strip * 64 + n, dr = dn ? ng : (ng >> 8) * 256 + (ng & 1) * 128 + ((ng >> 1) & 127);
                  *(v4u*)(dst + (size_t)dr * 1024 + F.wave * 128 + 16 * c8) = o; } }
            LDS_WAIT(); asm volatile("" ::: "memory");
        }
        __syncthreads();
    }
    const int gtid = blockIdx.x * 512 + f_tid, gthreads = F.G * 512;
    for (int i = gtid; i < (MLA_IN_PAD - MLA_IN) * D / 8; i += gthreads) ((v4u*)((bf16*)(ws + WS_WMIN) + (size_t)MLA_IN * D))[i] = (v4u){0u, 0u, 0u, 0u};
    {
        unsigned* MA8 = (unsigned*)(ws + WS_MA);
        for (int i4 = gtid; i4 < 256 * 256 / 4; i4 += gthreads) { float v4_[4];
#pragma unroll
            for (int jx = 0; jx < 4; ++jx) { const int i = 4 * i4 + jx; const int row = i >> 8, col = i & 255, jp = row >> 7, pp = (row >> 6) & 1, k1 = row & 63, j = col >> 7, pt = (col >> 6) & 1, l1 = col & 63;
                float v = 0.f; if (j == jp) { const float x = 2.f * (float)((k1 * l1) & 63) / 64.f; const float cs = cospif(x), sn = sinpif(x); v = (pp == 0) ? (pt == 0 ? cs : sn) : (pt == 0 ? -sn : cs); }
                v4_[jx] = v; }
            int t = __builtin_amdgcn_cvt_pk_fp8_f32(v4_[0], v4_[1], 0, false); t = __builtin_amdgcn_cvt_pk_fp8_f32(v4_[2], v4_[3], t, true); MA8[i4] = (unsigned)t; }
        unsigned* DC8 = (unsigned*)(ws + WS_DC); const float sc = 64.0f / sqrtf(256.f * 128.f);
        for (int i4 = gtid; i4 < 256 * 512 / 4; i4 += gthreads) { float v4_[4];
#pragma unroll
            for (int jx = 0; jx < 4; ++jx) { const int i = 4 * i4 + jx; const int k = i >> 9, col = i & 511, pt = col >> 8, l = col & 255; const float x = 2.f * (float)((k * l) & 255) / 256.f; v4_[jx] = (pt == 0 ? cospif(x) : sinpif(x)) * sc; }
            int t = __builtin_amdgcn_cvt_pk_fp8_f32(v4_[0], v4_[1], 0, false); t = __builtin_amdgcn_cvt_pk_fp8_f32(v4_[2], v4_[3], t, true); DC8[i4] = (unsigned)t; }
        unsigned* MC8 = (unsigned*)(ws + WS_MC); const float sl = 256.0f / sqrtf(4096.f * 128.f);
        for (int i4 = gtid; i4 < 16 * 256 * 512 / 4; i4 += gthreads) { float v4_[4];
#pragma unroll
            for (int j = 0; j < 4; ++j) { const int i = 4 * i4 + j; const int kq = i >> 17, row = (i >> 9) & 255, col = i & 511, kkp = row >> 6, k2 = row & 63, kk = col >> 7, pp = (col >> 6) & 1, l2 = col & 63;
                float v = 0.f; if (kk == kkp) { const int k = 4 * kq + kkp + 64 * k2; const float x = 2.f * (float)((l2 * k) & 4095) / 4096.f; v = (pp == 0 ? cospif(x) : sinpif(x)) * sl; }
                v4_[j] = v; }
            int t = __builtin_amdgcn_cvt_pk_fp8_f32(v4_[0], v4_[1], 0, false); t = __builtin_amdgcn_cvt_pk_fp8_f32(v4_[2], v4_[3], t, true); MC8[i4] = (unsigned)t; }
        float* RM = (float*)(ws + WS_ROPE); float* RG = RM + 2048;
        for (int i = gtid; i < 64 * 8; i += gthreads) { const int pos = i >> 3, f = i & 7; const float inv = powf(10000.f, -(float)f / 8.f); float s, c; sincosf((float)pos * inv, &s, &c); RM[2 * i] = c; RM[2 * i + 1] = s; }
        for (int i = gtid; i < 64 * 16; i += gthreads) { const int pos = i >> 4, f = i & 15; const float inv = powf(10000.f, -(float)f / 16.f); float s, c; sincosf((float)pos * inv, &s, &c); RG[2 * i] = c; RG[2 * i + 1] = s; }
        float* WRT = (float*)(ws + WS_WRT);
        for (int i = gtid; i < DEPTH * NE * D; i += gthreads) { const int l = i >> 15, e = (i >> 10) & 31, k = i & 1023; WRT[i] = a.in[21][((size_t)l * D + k) * NE + e]; }
        float* BG = (float*)(ws + WS_BGU);
        for (int i = gtid; i < DEPTH * NE * 2048; i += gthreads) { const int le = i >> 11, q = i & 2047, pn = q >> 8, s = (q >> 7) & 1, jj = q & 127; BG[i] = a.in[24][(size_t)le * 2048 + 2 * (pn * 128 + jj) + s]; }
    }
    __syncthreads();
    {
        LAS float* wl = (LAS float*)F.lds;
        LAS float* tc = wl + 2048; LAS float* ts = tc + 128;
        if (f_tid < 128) { const float x = 2.f * (float)f_tid / 128.f; tc[f_tid] = cospif(x); ts[f_tid] = -sinpif(x); }
        for (int it = blockIdx.x; it < 2 * 8 * 64; it += F.G) { const int j = it >> 9, g = (it >> 6) & 7, kb = it & 63;
            __syncthreads();
            { const int kk = f_tid >> 5, c4 = (f_tid & 31) * 4; const f32x4 w = *(const f32x4*)(a.in[9] + ((size_t)j * D + kb * 16 + kk) * D + g * 128 + c4);
              LAS float* d = wl + c4 * 16 + kk; d[0] = w[0]; d[16] = w[1]; d[32] = w[2]; d[48] = w[3]; }
            __syncthreads();
            const int cl = f_tid & 255, m = cl >> 1, part = cl & 1, kh = f_tid >> 8; const LAS float* tw = part ? ts : tc;
            float accv[8];
#pragma unroll
            for (int q = 0; q < 8; ++q) accv[q] = 0.f;
            for (int jj = 0; jj < 128; ++jj) { const float t = tw[(m * jj) & 127]; const f32x4 wa = *(const LAS f32x4*)(wl + jj * 16 + kh * 8), wb = *(const LAS f32x4*)(wl + jj * 16 + kh * 8 + 4);
                accv[0] += wa[0] * t; accv[1] += wa[1] * t; accv[2] += wa[2] * t; accv[3] += wa[3] * t; accv[4] += wb[0] * t; accv[5] += wb[1] * t; accv[6] += wb[2] * t; accv[7] += wb[3] * t; }
            v4u o; o.x = pk2(accv[0], accv[1]); o.y = pk2(accv[2], accv[3]); o.z = pk2(accv[4], accv[5]); o.w = pk2(accv[6], accv[7]);
            *(v4u*)((bf16*)(ws + WS_WFIN) + ((size_t)j * 2048 + g * 256 + cl) * D + kb * 16 + kh * 8) = o;
        }
        __syncthreads();
    }
    {
        LAS float* S = (LAS float*)F.lds;
        LAS float* red = S + 9 * 1024;
        for (int i = f_tid; i < 9 * 1024; i += 512) { const int r = i >> 10, k = i & 1023; const float v = (r < 8) ? a.in[1][r * D + k] : a.in[3][k]; S[i] = v / (1.f + __expf(-v)); }
        __syncthreads();
        for (int it = blockIdx.x; it < DEPTH * 96; it += F.G) { const int l = it / 96, n0 = (it % 96) * 64;
            const float* wp = a.in[4] + ((size_t)l * D + F.wave * 128) * (NMOD * D) + n0 + f_lane;
            float accv[9];
#pragma unroll
            for (int r = 0; r < 9; ++r) accv[r] = 0.f;
            for (int k0 = 0; k0 < 128; k0 += 32) { float wv[32];
#pragma unroll
                for (int k = 0; k < 32; ++k) wv[k] = wp[(size_t)(k0 + k) * (NMOD * D)];
#pragma unroll
                for (int k = 0; k < 32; ++k)
#pragma unroll
                    for (int r = 0; r < 9; ++r) accv[r] += S[r * 1024 + F.wave * 128 + k0 + k] * wv[k]; }
#pragma unroll
            for (int r = 0; r < 9; ++r) red[(F.wave * 9 + r) * 64 + f_lane] = accv[r];
            __syncthreads();
            for (int i = f_tid; i < 9 * 64; i += 512) { const int r = i >> 6, ln = i & 63; float s = a.in[5][(size_t)l * (NMOD * D) + n0 + ln];
#pragma unroll
                for (int w = 0; w < 8; ++w) s += red[(w * 9 + r) * 64 + ln];
                ((float*)(ws + WS_MOD))[((size_t)l * 9 + r) * (NMOD * D) + n0 + ln] = s; }
            __syncthreads();
        }
    }
}

__device__ __forceinline__ void load_row(const float* p, int lane, f32x4 (&v)[4]) {
#pragma unroll
    for (int j = 0; j < 4; ++j) v[j] = ((const f32x4*)p)[lane + 64 * j];
}
__device__ __forceinline__ void load_row_bf(const bf16* p, int lane, f32x4 (&v)[4]) {
#pragma unroll
    for (int j = 0; j < 4; ++j) { const v2u w = ((const v2u*)p)[lane + 64 * j]; v[j] = (f32x4){bf_lo(w.x), bf_hi(w.x), bf_lo(w.y), bf_hi(w.y)}; }
}
__device__ __forceinline__ void norm_mod(f32x4 (&v)[4], const float* g, const float* shift, const float* scale, int lane) {
    float s = 0.f;
#pragma unroll
    for (int j = 0; j < 4; ++j) s += (v[j][0] * v[j][0] + v[j][1] * v[j][1]) + (v[j][2] * v[j][2] + v[j][3] * v[j][3]);
    const float rstd = rsqrtf(wave_sum(s, lane) * (1.f / D) + EPS);
#pragma unroll
    for (int j = 0; j < 4; ++j) { const f32x4 gv = ((const f32x4*)g)[lane + 64 * j], sh = ((const f32x4*)shift)[lane + 64 * j], sc = ((const f32x4*)scale)[lane + 64 * j];
        v[j] = (v[j] * rstd * gv) * (sc + 1.f) + sh; }
}
__device__ __forceinline__ void store_row_bf16(bf16* p, int lane, const f32x4 (&v)[4]) {
#pragma unroll
    for (int j = 0; j < 4; ++j) { v2u w; w.x = pk2(v[j][0], v[j][1]); w.y = pk2(v[j][2], v[j][3]); ((v2u*)p)[lane + 64 * j] = w; }
}

__device__ __forceinline__ float store_row_i8(unsigned char* p, int lane, const f32x4 (&v)[4]) {
    float am = 0.f;
#pragma unroll
    for (int j = 0; j < 4; ++j) am = fmaxf(fmaxf(am, fmaxf(fabsf(v[j][0]), fabsf(v[j][1]))), fmaxf(fabsf(v[j][2]), fabsf(v[j][3])));
    unsigned k = __float_as_uint(am);
    { unsigned t;
      t = (unsigned)__builtin_amdgcn_mov_dpp((int)k, 0xb1, 0xf, 0xf, false); k = k > t ? k : t;
      t = (unsigned)__builtin_amdgcn_mov_dpp((int)k, 0x4e, 0xf, 0xf, false); k = k > t ? k : t;
      t = (unsigned)__builtin_amdgcn_mov_dpp((int)k, 0x124, 0xf, 0xf, false); k = k > t ? k : t;
      t = (unsigned)__builtin_amdgcn_mov_dpp((int)k, 0x128, 0xf, 0xf, false); k = k > t ? k : t;
      const unsigned a = (unsigned)__builtin_amdgcn_readlane((int)k, 0), b = (unsigned)__builtin_amdgcn_readlane((int)k, 16), c = (unsigned)__builtin_amdgcn_readlane((int)k, 32), d = (unsigned)__builtin_amdgcn_readlane((int)k, 48);
      const unsigned ab = a > b ? a : b, cd = c > d ? c : d; k = ab > cd ? ab : cd; }
    const float amax = __uint_as_float(k);
    const float qscale = amax > 0.f ? amax * (1.f / 127.f) : 1.f, qinv = amax > 0.f ? 127.f / amax : 0.f;
#pragma unroll
    for (int j = 0; j < 4; ++j) ((unsigned*)p)[lane + 64 * j] = q8x4(v[j][0], v[j][1], v[j][2], v[j][3], qinv);
    return qscale;
}
__device__ __forceinline__ void quant_rows(Frame& F, const bf16* src, unsigned char* dst, float* scale, int R) {
    const int f_lane = lthread(F.wave) & 63;
    for (int r = F.gw; r < R; r += F.NGW) { f32x4 v[4]; load_row_bf(src + (size_t)r * 1024, f_lane, v);
        const float sc = store_row_i8(dst + (size_t)r * 1024, f_lane, v); if (f_lane == 0) scale[r] = sc; }
}
__device__ __forceinline__ void rp_norm1(Frame& F, const Args& a, int l, int row_lo) {
    const int f_tid = lthread(F.wave), f_lane = f_tid & 63;
    const bf16* X = (const bf16*)(F.ws + WS_X); bf16* H = (bf16*)(F.ws + WS_H); const float* MOD = (const float*)(F.ws + WS_MOD) + (size_t)l * 9 * (NMOD * D);
    for (int row = row_lo + F.gw; row < NT; row += F.NGW) { f32x4 v[4];
        if (l == 0) { load_row(row < NC ? a.in[2] + (size_t)row * D : a.in[0] + (size_t)(row - NC) * D, f_lane, v);
            store_row_bf16((bf16*)(F.ws + WS_X) + (size_t)row * D, f_lane, v); }
        else load_row_bf(X + (size_t)row * D, f_lane, v);
        const float* m = MOD + (size_t)modrow_of(row) * (NMOD * D);
        norm_mod(v, a.in[6] + (size_t)l * D, m, m + D, f_lane);
        const float sc = store_row_i8((unsigned char*)H + (size_t)row * D, f_lane, v); if (f_lane == 0) ((float*)(F.ws + WS_SH))[row] = sc; }
}

__device__ __forceinline__ void rp_norm1_l0(Frame& F, const Args& a) {
    const int f_tid = lthread(F.wave), f_lane = f_tid & 63;
    LAS float* LM = (LAS float*)F.lds; const float* MOD = (const float*)(F.ws + WS_MOD);
    __syncthreads();
    for (int i = f_tid; i < 1024; i += 512) LM[i] = a.in[6][i];
    for (int i = f_tid; i < 18 * 1024; i += 512) LM[1024 + i] = MOD[(size_t)(i >> 11) * (NMOD * D) + (i & 2047)];
    __syncthreads();
    const int st = F.NGW, row0 = F.gw;
    if (row0 >= NT) return;
    const int n = (NT - row0 + st - 1) / st, rlast = row0 + (n - 1) * st;
#define NROW(i) ((row0 + (i) * st) <= rlast ? (row0 + (i) * st) : rlast)
#define NSRC(r) ((r) < NC ? a.in[2] + (size_t)(r) * D : a.in[0] + (size_t)((r) - NC) * D)
    f32x4 R0[4], R1[4], R2[4];
    { const int r0 = NROW(0), r1 = NROW(1), r2 = NROW(2); load_row(NSRC(r0), f_lane, R0); load_row(NSRC(r1), f_lane, R1); load_row(NSRC(r2), f_lane, R2); }
#define NSTEP(R, i_) do { if ((i_) < n) { const int row = NROW(i_); \
            store_row_bf16((bf16*)(F.ws + WS_X) + (size_t)row * D, f_lane, R); \
            float s_ = 0.f; _Pragma("unroll") for (int j = 0; j < 4; ++j) s_ += (R[j][0] * R[j][0] + R[j][1] * R[j][1]) + (R[j][2] * R[j][2] + R[j][3] * R[j][3]); \
            const float rstd_ = rsqrtf(wave_sum(s_, f_lane) * (1.f / D) + EPS); const LAS f32x4* mp_ = (const LAS f32x4*)(LM + 1024 + modrow_of(row) * 2048); \
            _Pragma("unroll") for (int j = 0; j < 4; ++j) { const f32x4 gv = ((const LAS f32x4*)LM)[f_lane + 64 * j], sh = mp_[f_lane + 64 * j], sc = mp_[256 + f_lane + 64 * j]; R[j] = (R[j] * rstd_ * gv) * (sc + 1.f) + sh; } \
            const float sc_ = store_row_i8((unsigned char*)(F.ws + WS_H) + (size_t)row * D, f_lane, R); if (f_lane == 0) ((float*)(F.ws + WS_SH))[row] = sc_; } \
        { const int rn_ = NROW((i_) + 3); load_row(NSRC(rn_), f_lane, R); } } while (0)
    for (int i = 0; i < n; i += 3) { NSTEP(R0, i); NSTEP(R1, i + 1); NSTEP(R2, i + 2); }
#undef NSTEP
#undef NSRC
#undef NROW
}

#if MK_N2V2
constexpr int LDS_LIST = LDS_MISC + 768;
__device__ __forceinline__ unsigned row16_max(unsigned k) {
    unsigned t;
    t = (unsigned)__builtin_amdgcn_mov_dpp((int)k, 0xb1, 0xf, 0xf, false); k = k > t ? k : t;
    t = (unsigned)__builtin_amdgcn_mov_dpp((int)k, 0x4e, 0xf, 0xf, false); k = k > t ? k : t;
    t = (unsigned)__builtin_amdgcn_mov_dpp((int)k, 0x124, 0xf, 0xf, false); k = k > t ? k : t;
    t = (unsigned)__builtin_amdgcn_mov_dpp((int)k, 0x128, 0xf, 0xf, false); k = k > t ? k : t;
    return k;
}
__device__ __forceinline__ unsigned wave_max_u(unsigned k) {
    k = row16_max(k);
    const unsigned a = (unsigned)__builtin_amdgcn_readlane((int)k, 0), b = (unsigned)__builtin_amdgcn_readlane((int)k, 16), c = (unsigned)__builtin_amdgcn_readlane((int)k, 32), d = (unsigned)__builtin_amdgcn_readlane((int)k, 48);
    const unsigned ab = a > b ? a : b, cd = c > d ? c : d; return ab > cd ? ab : cd;
}
__device__ __forceinline__ float key_val(unsigned m) { const unsigned u = m & ~31u; return __builtin_bit_cast(float, (u & 0x80000000u) ? (u ^ 0x80000000u) : ~u); }
constexpr int N2_WPITCH = 2064;
constexpr int N2_GM = 32 * N2_WPITCH;
constexpr int N2_LIST = N2_GM + 5 * 8192;
__device__ __forceinline__ void rp_norm2_router(Frame& F, const Args& a, int l, int row_lo) {
    const int f_tid = lthread(F.wave), f_lane = f_tid & 63;
    const bf16* X = (const bf16*)(F.ws + WS_X); unsigned char* H8 = (unsigned char*)(F.ws + WS_H); const float* MOD = (const float*)(F.ws + WS_MOD) + (size_t)l * 9 * (NMOD * D);
    LAS unsigned char* WT = F.lds;
    { const f32x4* src = (const f32x4*)((const float*)(F.ws + WS_WRT) + (size_t)l * NE * D); f32x4 tv[16];
#pragma unroll
      for (int i = 0; i < 16; ++i) tv[i] = src[f_tid + 512 * i];
#pragma unroll
      for (int i = 0; i < 16; ++i) { const int i4 = f_tid + 512 * i, e = i4 >> 8, k4 = (i4 & 255) * 4; v2u w; w.x = pk2(tv[i][0], tv[i][1]); w.y = pk2(tv[i][2], tv[i][3]); *(LAS v2u*)(WT + e * N2_WPITCH + k4 * 2) = w; } }
    LAS int* lcnt = (LAS int*)(F.lds + LDS_TT); LAS int* lbase = lcnt + 32;
    if (f_tid < 32) lcnt[f_tid] = 0;
    const int ngroups = (NT - row_lo) >> 5;
    const int g = F.wave * F.G + (int)blockIdx.x;
    const bool active = (F.wave < 5) && (g < ngroups);
    LAS float* GM = (LAS float*)(F.lds + N2_GM + (F.wave < 5 ? F.wave : 0) * 8192); LAS float* SH = GM + 1024;
    LAS v4u* list = (LAS v4u*)(F.lds + N2_LIST + (F.wave < 5 ? F.wave : 0) * (128 * 16 + 128)); LAS float* lsc = (LAS float*)(list + 128);
    const int r = f_lane & 31, kh = f_lane >> 5;
    const int row = row_lo + g * 32 + r;
    float msh = 0.f;
    if (active) {
        const float* m = MOD + (size_t)modrow_of(row_lo + g * 32) * (NMOD * D); const float* gf = a.in[7] + (size_t)l * D;
#pragma unroll
        for (int j = 0; j < 4; ++j) { const f32x4 gv = ((const f32x4*)gf)[f_lane + 64 * j], sc = ((const f32x4*)(m + 4 * D))[f_lane + 64 * j], sv = ((const f32x4*)(m + 3 * D))[f_lane + 64 * j];
            ((LAS f32x4*)GM)[f_lane + 64 * j] = gv * (sc + 1.f); ((LAS f32x4*)SH)[f_lane + 64 * j] = sv;
            msh = fmaxf(fmaxf(msh, fmaxf(fabsf(sv[0]), fabsf(sv[1]))), fmaxf(fabsf(sv[2]), fabsf(sv[3]))); }
        msh = __uint_as_float(wave_max_u(__float_as_uint(msh)));
    }
    __syncthreads();
    if (active) {
        const bf16* xr = X + (size_t)row * D + 16 * kh;
        float ssq = 0.f, mxg = 0.f;
#pragma unroll 1
        for (int c0 = 0; c0 < 32; c0 += 8) { v4u xa[8], xb[8];
#pragma unroll
            for (int i = 0; i < 8; ++i) { xa[i] = *(const v4u*)(xr + 32 * (c0 + i)); xb[i] = *(const v4u*)(xr + 32 * (c0 + i) + 8); }
#pragma unroll
            for (int i = 0; i < 8; ++i) { const LAS f32x4* gp = (const LAS f32x4*)(GM + 32 * (c0 + i) + 16 * kh);
                const f32x4 g0 = gp[0], g1 = gp[1], g2 = gp[2], g3 = gp[3];
                const unsigned wa[4] = {xa[i].x, xa[i].y, xa[i].z, xa[i][3]}, wb[4] = {xb[i].x, xb[i].y, xb[i].z, xb[i][3]};
#pragma unroll
                for (int q = 0; q < 4; ++q) { const float x0 = bf_lo(wa[q]), x1 = bf_hi(wa[q]), x2 = bf_lo(wb[q]), x3 = bf_hi(wb[q]);
                    ssq += x0 * x0 + x1 * x1 + x2 * x2 + x3 * x3;
                    const float ga = (q < 2 ? g0 : g1)[(2 * q) & 3], gb = (q < 2 ? g0 : g1)[(2 * q + 1) & 3], gc = (q < 2 ? g2 : g3)[(2 * q) & 3], gd = (q < 2 ? g2 : g3)[(2 * q + 1) & 3];
                    mxg = fmaxf(fmaxf(mxg, fmaxf(fabsf(x0 * ga), fabsf(x1 * gb))), fmaxf(fabsf(x2 * gc), fabsf(x3 * gd))); } } }
        { auto rr = __builtin_amdgcn_permlane32_swap(__float_as_uint(ssq), __float_as_uint(ssq), false, false); ssq = __uint_as_float(rr[0]) + __uint_as_float(rr[1]); }
        { auto rr = __builtin_amdgcn_permlane32_swap(__float_as_uint(mxg), __float_as_uint(mxg), false, false); mxg = fmaxf(__uint_as_float(rr[0]), __uint_as_float(rr[1])); }
        const float rstd = rsqrtf(ssq * (1.f / D) + EPS);
        const float bound = mxg * rstd + msh;
        const float qscale = bound > 0.f ? bound * (1.f / 127.f) : 1.f, qinv = bound > 0.f ? 127.f / bound : 0.f;
        f32x16 acc = f32x16{};
        unsigned char* hrow = H8 + (size_t)row * D + 16 * kh;
        const LAS unsigned char* wrow = WT + r * N2_WPITCH + 32 * kh;
#pragma unroll 1
        for (int c0 = 0; c0 < 32; c0 += 4) { v4u xa[4], xb[4];
#pragma unroll
            for (int i = 0; i < 4; ++i) { xa[i] = *(const v4u*)(xr + 32 * (c0 + i)); xb[i] = *(const v4u*)(xr + 32 * (c0 + i) + 8); }
#pragma unroll
            for (int i = 0; i < 4; ++i) { const int c = c0 + i;
                const LAS f32x4* gp = (const LAS f32x4*)(GM + 32 * c + 16 * kh); const LAS f32x4* sp = (const LAS f32x4*)(SH + 32 * c + 16 * kh);
                const bf16x8 w0 = *(const LAS bf16x8*)(wrow + 64 * c), w1 = *(const LAS bf16x8*)(wrow + 64 * c + 16);
                float h[16];
                const unsigned wa[4] = {xa[i].x, xa[i].y, xa[i].z, xa[i][3]}, wb[4] = {xb[i].x, xb[i].y, xb[i].z, xb[i][3]};
#pragma unroll
                for (int q = 0; q < 4; ++q) { h[2 * q] = bf_lo(wa[q]); h[2 * q + 1] = bf_hi(wa[q]); h[8 + 2 * q] = bf_lo(wb[q]); h[8 + 2 * q + 1] = bf_hi(wb[q]); }
#pragma unroll
                for (int q = 0; q < 4; ++q) { const f32x4 gq = gp[q], sq = sp[q];
#pragma unroll
                    for (int e = 0; e < 4; ++e) h[4 * q + e] = (h[4 * q + e] * rstd) * gq[e] + sq[e]; }
                v4u o8;
#pragma unroll
                for (int q = 0; q < 4; ++q) o8[q] = q8x4(h[4 * q], h[4 * q + 1], h[4 * q + 2], h[4 * q + 3], qinv);
                *(v4u*)(hrow + 32 * c) = o8;
                v4u hi0, hi1, lo0, lo1;
#pragma unroll
                for (int q = 0; q < 4; ++q) { hi0[q] = pk2(h[2 * q], h[2 * q + 1]); hi1[q] = pk2(h[8 + 2 * q], h[8 + 2 * q + 1]); }
#pragma unroll
                for (int q = 0; q < 4; ++q) { lo0[q] = pk2(h[2 * q] - bf_lo(hi0[q]), h[2 * q + 1] - bf_hi(hi0[q])); lo1[q] = pk2(h[8 + 2 * q] - bf_lo(hi1[q]), h[8 + 2 * q + 1] - bf_hi(hi1[q])); }
                acc = __builtin_amdgcn_mfma_f32_32x32x16_bf16(w0, __builtin_bit_cast(bf16x8, hi0), acc, 0, 0, 0);
                acc = __builtin_amdgcn_mfma_f32_32x32x16_bf16(w0, __builtin_bit_cast(bf16x8, lo0), acc, 0, 0, 0);
                acc = __builtin_amdgcn_mfma_f32_32x32x16_bf16(w1, __builtin_bit_cast(bf16x8, hi1), acc, 0, 0, 0);
                acc = __builtin_amdgcn_mfma_f32_32x32x16_bf16(w1, __builtin_bit_cast(bf16x8, lo1), acc, 0, 0, 0); } }
        float val[32];
        const float* br = a.in[22] + (size_t)l * NE;
#pragma unroll
        for (int j = 0; j < 16; ++j) { auto rr = __builtin_amdgcn_permlane32_swap(__float_as_uint(acc[j]), __float_as_uint(acc[j]), false, false);
            const int e0 = (j & 3) + 8 * (j >> 2); val[e0] = __uint_as_float(rr[0]) + br[e0]; val[e0 + 4] = __uint_as_float(rr[1]) + br[e0 + 4]; }
        unsigned taken = 0u; int be[4]; float bv[4];
#pragma unroll
        for (int k = 0; k < 4; ++k) { float best = -INFINITY; int bi = 0;
#pragma unroll
            for (int e = 0; e < 32; ++e) { const bool cnd = !((taken >> e) & 1u) && (val[e] > best); best = cnd ? val[e] : best; bi = cnd ? e : bi; }
            taken |= 1u << bi; be[k] = bi; bv[k] = best; }
        const float e1 = __expf(bv[1] - bv[0]), e2 = __expf(bv[2] - bv[0]), e3 = __expf(bv[3] - bv[0]); const float inv = 1.f / (1.f + e1 + e2 + e3);
        if (kh == 0) { const float ww[4] = {inv, e1 * inv, e2 * inv, e3 * inv};
#pragma unroll
            for (int k = 0; k < 4; ++k) { const int lr = __hip_atomic_fetch_add(lcnt + be[k], 1, __ATOMIC_RELAXED, __HIP_MEMORY_SCOPE_WORKGROUP);
                LAS unsigned* ep = (LAS unsigned*)(list + r * 4 + k); ep[0] = (unsigned)(row * 4 + k); ep[1] = (unsigned)be[k]; ep[2] = (unsigned)lr; ep[3] = __builtin_bit_cast(unsigned, ww[k]); }
            lsc[r] = qscale; }
    }
    __syncthreads();
    if (f_tid < 32) { const int c = lcnt[f_tid]; lbase[f_tid] = c ? (int)__hip_atomic_fetch_add((unsigned*)(F.ctl + CW_CNT + (l * 32 + f_tid) * 16), (unsigned)c, RLX_AGENT) : 0; }
    __syncthreads();
    if (active) {
        int* te = (int*)(F.ws + WS_TE); int* trank = (int*)(F.ws + WS_TRANK); int* stok = (int*)(F.ws + WS_STOK); float* sw = (float*)(F.ws + WS_SW); float* ssc = (float*)(F.ws + WS_SSC);
#pragma unroll
        for (int i = f_lane; i < 128; i += 64) { const LAS unsigned* ep = (const LAS unsigned*)(list + i); const unsigned rowk = ep[0], ex = ep[1], lr = ep[2]; const float wv = __builtin_bit_cast(float, ep[3]);
            const int rk = lbase[ex] + (int)lr;
            stok[(size_t)ex * CAP + rk] = (int)(rowk >> 2); sw[(size_t)ex * CAP + rk] = wv; ssc[(size_t)ex * CAP + rk] = lsc[i >> 2]; te[rowk] = (int)ex; trank[rowk] = rk; }
    }
}

#endif
__device__ __forceinline__ void moe_table(Frame& F, int l) {
    const int f_tid = lthread(F.wave), f_lane = f_tid & 63;
    LAS int* TT = (LAS int*)(F.lds + LDS_TT); LAS int* CN = TT + 64; LAS int* TE = (LAS int*)(F.lds + LDS_TE);
    __syncthreads();
    if (f_tid < 64) {
        const int c = (f_lane < 32) ? (int)__hip_atomic_load((unsigned*)(F.ctl + CW_CNT + (l * 32 + (f_lane & 31)) * 16), RLX_AGENT) : 0;
        const int tl = (c + 255) >> 8; int v = tl;
#pragma unroll
        for (int o = 1; o < 32; o <<= 1) { const int n = __builtin_amdgcn_ds_bpermute((f_lane >= o ? f_lane - o : f_lane) << 2, v); if (f_lane >= o) v += n; }
        if (f_lane < 32) { CN[f_lane] = c; TT[f_lane] = v - tl; if (f_lane == 31) TT[32] = v; }
    }
    __syncthreads();
    for (int t = f_tid; t < MAXTILES; t += 512) { int lo = 0, hi = 32;
#pragma unroll
        for (int k = 0; k < 5; ++k) { const int mid = (lo + hi) >> 1; if (TT[mid] <= t) lo = mid; else hi = mid; }
        TE[t] = lo; }
    __syncthreads();
}

#if MK_CBV2
struct CombRow { v4u x[2]; v4u y[4]; };
__device__ __forceinline__ void comb_issue(CombRow& R, const bf16* X, const unsigned char* Y, const LAS int* TT, int row, const v4u te4, const v4u tr4, int lane) {
    const unsigned ee[4] = {te4[0], te4[1], te4[2], te4[3]}, rr[4] = {tr4[0], tr4[1], tr4[2], tr4[3]};
#pragma unroll
    for (int k = 0; k < 4; ++k) { const size_t slot = (size_t)TT[ee[k]] * 256 + rr[k]; R.y[k] = *(const v4u*)(Y + slot * 1024 + 16 * lane); }
    const bf16* xp = X + (size_t)row * D + 16 * lane; R.x[0] = *(const v4u*)xp; R.x[1] = *(const v4u*)(xp + 8);
}
constexpr int CB_G5 = 0, CB_MS = 9 * 1024, CB_GX = 27 * 1024, CB_FLOATS = 28 * 1024;
__device__ __forceinline__ void comb_finish(const CombRow& R, Frame& F, const Args& a, int l, int row, int lane, bool lastl) {
    bf16* X = (bf16*)(F.ws + WS_X); unsigned char* H8 = (unsigned char*)(F.ws + WS_H); const LAS float* LM = (const LAS float*)F.lds;
    const int mr = modrow_of(row); const LAS float* g5 = LM + CB_G5 + mr * 1024 + 16 * lane;
    float v[16];
#pragma unroll
    for (int w = 0; w < 4; ++w) { f32x4 s = (f32x4){0.f, 0.f, 0.f, 0.f};
#pragma unroll
        for (int k = 0; k < 4; ++k) { const int yw = (int)R.y[k][w]; const f32x2 lo = __builtin_amdgcn_cvt_pk_f32_fp8(yw, false), hi = __builtin_amdgcn_cvt_pk_f32_fp8(yw, true); s[0] += lo[0]; s[1] += lo[1]; s[2] += hi[0]; s[3] += hi[1]; }
        const f32x4 gv = ((const LAS f32x4*)g5)[w]; const unsigned x0 = R.x[w >> 1][(2 * w) & 3], x1 = R.x[w >> 1][(2 * w + 1) & 3];
        v[4 * w] = bf_lo(x0) + gv[0] * s[0] * 0.125f; v[4 * w + 1] = bf_hi(x0) + gv[1] * s[1] * 0.125f; v[4 * w + 2] = bf_lo(x1) + gv[2] * s[2] * 0.125f; v[4 * w + 3] = bf_hi(x1) + gv[3] * s[3] * 0.125f; }
    float ss = 0.f;
#pragma unroll
    for (int i = 0; i < 16; ++i) ss += v[i] * v[i];
    const float rstd = rsqrtf(wave_sum(ss, lane) * (1.f / D) + EPS);
    if (!lastl) {
        bf16* xo = X + (size_t)row * D + 16 * lane;
        { v4u o0, o1;
#pragma unroll
          for (int q = 0; q < 4; ++q) { o0[q] = pk2(v[2 * q], v[2 * q + 1]); o1[q] = pk2(v[8 + 2 * q], v[8 + 2 * q + 1]); }
          *(v4u*)xo = o0; *(v4u*)(xo + 8) = o1; }
        const LAS float* m = LM + CB_MS + mr * 2048 + 16 * lane; const LAS float* gx = LM + CB_GX + 16 * lane;
        float am = 0.f;
#pragma unroll
        for (int w = 0; w < 4; ++w) { const f32x4 gv = ((const LAS f32x4*)gx)[w], sh = ((const LAS f32x4*)m)[w], sc = ((const LAS f32x4*)(m + D))[w];
#pragma unroll
            for (int e = 0; e < 4; ++e) { const float h = (v[4 * w + e] * rstd * gv[e]) * (sc[e] + 1.f) + sh[e]; v[4 * w + e] = h; am = fmaxf(am, fabsf(h)); } }
        const float amax = __uint_as_float(wave_max_u(__float_as_uint(am)));
        const float qscale = amax > 0.f ? amax * (1.f / 127.f) : 1.f, qinv = amax > 0.f ? 127.f / amax : 0.f;
        v4u o8;
#pragma unroll
        for (int w = 0; w < 4; ++w) o8[w] = q8x4(v[4 * w], v[4 * w + 1], v[4 * w + 2], v[4 * w + 3], qinv);
        *(v4u*)(H8 + (size_t)row * D + 16 * lane) = o8;
        if (lane == 0) ((float*)(F.ws + WS_SH))[row] = qscale;
    } else {
        float* op = a.out + (size_t)(row - NC) * D + 16 * lane; const LAS float* gf = LM + CB_GX + 16 * lane;
#pragma unroll
        for (int w = 0; w < 4; ++w) { const f32x4 gv = ((const LAS f32x4*)gf)[w]; ((f32x4*)op)[w] = (f32x4){v[4 * w] * rstd * gv[0], v[4 * w + 1] * rstd * gv[1], v[4 * w + 2] * rstd * gv[2], v[4 * w + 3] * rstd * gv[3]}; }
    }
}
__device__ __forceinline__ void rp_combine(Frame& F, const Args& a, int l, int row_lo) {
    const int f_tid = lthread(F.wave), f_lane = f_tid & 63;
    const bf16* X = (const bf16*)(F.ws + WS_X); const unsigned char* Y = (const unsigned char*)(F.ws + WS_Y);
    const float* MOD = (const float*)(F.ws + WS_MOD) + (size_t)l * 9 * (NMOD * D); const float* MODN = MOD + 9 * (NMOD * D);
    const v4u* te = (const v4u*)(F.ws + WS_TE); const v4u* trank = (const v4u*)(F.ws + WS_TRANK);
    const LAS int* TT = (const LAS int*)(F.lds + LDS_TT);
    const bool lastl = (l == DEPTH - 1);
    { LAS float* LM = (LAS float*)F.lds; __syncthreads();
      for (int i = f_tid; i < 9 * 1024; i += 512) LM[CB_G5 + i] = MOD[(size_t)(i >> 10) * (NMOD * D) + 5 * D + (i & 1023)];
      if (!lastl) { for (int i = f_tid; i < 18 * 1024; i += 512) LM[CB_MS + i] = MODN[(size_t)(i >> 11) * (NMOD * D) + (i & 2047)];
                    for (int i = f_tid; i < 1024; i += 512) LM[CB_GX + i] = a.in[6][(size_t)(l + 1) * D + i]; }
      else for (int i = f_tid; i < 1024; i += 512) LM[CB_GX + i] = a.in[8][i];
      __syncthreads(); }
    const int st = F.NGW, row0 = row_lo + F.gw;
    if (row0 >= NT) return;
    const int n = (NT - row0 + st - 1) / st, rlast = row0 + (n - 1) * st;
#define CROW(i) ((row0 + (i) * st) <= rlast ? (row0 + (i) * st) : rlast)
    CombRow R0, R1, R2;
    { const v4u t0 = te[CROW(0)], r0 = trank[CROW(0)], t1 = te[CROW(1)], r1 = trank[CROW(1)], t2 = te[CROW(2)], r2 = trank[CROW(2)];
      comb_issue(R0, X, Y, TT, CROW(0), t0, r0, f_lane); comb_issue(R1, X, Y, TT, CROW(1), t1, r1, f_lane); comb_issue(R2, X, Y, TT, CROW(2), t2, r2, f_lane); }
    v4u teN = te[CROW(3)], trN = trank[CROW(3)];
#define CSTEP(R, i_) do { const v4u teU = teN, trU = trN; teN = te[CROW((i_) + 4)]; trN = trank[CROW((i_) + 4)]; \
        if ((i_) < n) comb_finish(R, F, a, l, CROW(i_), f_lane, lastl); \
        comb_issue(R, X, Y, TT, CROW((i_) + 3), teU, trU, f_lane); } while (0)
    for (int i = 0; i < n; i += 3) { CSTEP(R0, i); CSTEP(R1, i + 1); CSTEP(R2, i + 2); }
#undef CSTEP
#undef CROW
}
#endif

__device__ __forceinline__ void quant_rows384(Frame& F, const bf16* src, unsigned char* dst, float* scale, int R) {
    const int f_lane = lthread(F.wave) & 63;
    for (int r = F.gw; r < R; r += F.NGW) { const unsigned* sp = (const unsigned*)(src + (size_t)r * 384); const unsigned u0 = sp[f_lane], u1 = sp[f_lane + 64], u2 = sp[f_lane + 128];
        const float x0 = bf_lo(u0), x1 = bf_hi(u0), x2 = bf_lo(u1), x3 = bf_hi(u1), x4 = bf_lo(u2), x5 = bf_hi(u2);
        const float am = __uint_as_float(wave_max_u(__float_as_uint(fmaxf(fmaxf(fmaxf(fabsf(x0), fabsf(x1)), fmaxf(fabsf(x2), fabsf(x3))), fmaxf(fabsf(x4), fabsf(x5))))));
        const float qinv = am > 0.f ? 127.f / am : 0.f; const unsigned w0 = q8x4(x0, x1, x2, x3, qinv), w1 = q8x4(x4, x5, 0.f, 0.f, qinv);
        unsigned short* dp = (unsigned short*)(dst + (size_t)r * 512); dp[f_lane] = (unsigned short)(w0 & 0xffffu); dp[f_lane + 64] = (unsigned short)(w0 >> 16); dp[f_lane + 128] = (unsigned short)(w1 & 0xffffu); dp[f_lane + 192] = 0;
        if (f_lane == 0) scale[r] = am > 0.f ? am * (1.f / 127.f) : 1.f; }
}
__device__ __forceinline__ void quant_rows256(Frame& F, const bf16* src, unsigned char* dst, float* scale, int R) {
    const int f_lane = lthread(F.wave) & 63;
    for (int r = F.gw; r < R; r += F.NGW) { const v2u w = ((const v2u*)(src + (size_t)r * 256))[f_lane]; const float x0 = bf_lo(w.x), x1 = bf_hi(w.x), x2 = bf_lo(w.y), x3 = bf_hi(w.y);
        const float am = __uint_as_float(wave_max_u(__float_as_uint(fmaxf(fmaxf(fabsf(x0), fabsf(x1)), fmaxf(fabsf(x2), fabsf(x3))))));
        ((unsigned*)(dst + (size_t)r * 256))[f_lane] = q8x4(x0, x1, x2, x3, am > 0.f ? 127.f / am : 0.f); if (f_lane == 0) scale[r] = am > 0.f ? am * (1.f / 127.f) : 1.f; }
}
struct MRaw { unsigned q[3], c[2], pe; };
__device__ __forceinline__ void mla_issue(MRaw& R, const bf16* A, int row, int lane) {
    const unsigned* ap = (const unsigned*)(A + (size_t)row * MLA_IN_PAD);
#pragma unroll
    for (int j = 0; j < 3; ++j) R.q[j] = ap[lane + 64 * j];
#pragma unroll
    for (int j = 0; j < 2; ++j) R.c[j] = ap[192 + lane + 64 * j];
    R.pe = ap[320 + (lane & 15)];
}
__device__ __forceinline__ void mla_finish(const MRaw& R, Frame& F, int row, int f_lane) {
    bf16* QA = (bf16*)(F.ws + WS_RF); bf16* CKV = (bf16*)(F.ws + WS_RG); bf16* Kb = (bf16*)(F.ws + WS_RB);
    const LAS float* gq = (const LAS float*)F.lds; const LAS float* gk = gq + 384; const LAS float* rope = gq + 640;
    float sq = 0.f, sc = 0.f;
#pragma unroll
    for (int j = 0; j < 3; ++j) { const float x0 = bf_lo(R.q[j]), x1 = bf_hi(R.q[j]); sq += x0 * x0 + x1 * x1; }
#pragma unroll
    for (int j = 0; j < 2; ++j) { const float x0 = bf_lo(R.c[j]), x1 = bf_hi(R.c[j]); sc += x0 * x0 + x1 * x1; }
    const float rq = rsqrtf(wave_sum(sq, f_lane) * (1.f / MLA_QL) + EPS), rc = rsqrtf(wave_sum(sc, f_lane) * (1.f / MLA_KVL) + EPS);
    { float qv[6];
#pragma unroll
      for (int j = 0; j < 3; ++j) { const int e0 = 2 * (f_lane + 64 * j); qv[2 * j] = bf_lo(R.q[j]) * rq * gq[e0]; qv[2 * j + 1] = bf_hi(R.q[j]) * rq * gq[e0 + 1]; }
      float am = 0.f;
#pragma unroll
      for (int j = 0; j < 6; ++j) am = fmaxf(am, fabsf(qv[j]));
      am = __uint_as_float(wave_max_u(__float_as_uint(am)));
      const float qinv = am > 0.f ? 127.f / am : 0.f; const unsigned w0 = q8x4(qv[0], qv[1], qv[2], qv[3], qinv), w1 = q8x4(qv[4], qv[5], 0.f, 0.f, qinv);
      unsigned short* qp8 = (unsigned short*)((unsigned char*)QA + (size_t)row * 512);
      qp8[f_lane] = (unsigned short)(w0 & 0xffffu); qp8[f_lane + 64] = (unsigned short)(w0 >> 16); qp8[f_lane + 128] = (unsigned short)(w1 & 0xffffu); qp8[f_lane + 192] = 0;
      if (f_lane == 0) ((float*)(F.ws + WS_SCKV + 262144))[row] = am > 0.f ? am * (1.f / 127.f) : 1.f; }
    { float cv[4];
#pragma unroll
      for (int j = 0; j < 2; ++j) { const int e0 = 2 * (f_lane + 64 * j); cv[2 * j] = bf_lo(R.c[j]) * rc * gk[e0]; cv[2 * j + 1] = bf_hi(R.c[j]) * rc * gk[e0 + 1]; }
      const float am = __uint_as_float(wave_max_u(__float_as_uint(fmaxf(fmaxf(fabsf(cv[0]), fabsf(cv[1])), fmaxf(fabsf(cv[2]), fabsf(cv[3]))))));
      const float qinv = am > 0.f ? 127.f / am : 0.f; const unsigned w = q8x4(cv[0], cv[1], cv[2], cv[3], qinv);
      unsigned short* cp8 = (unsigned short*)((unsigned char*)CKV + (size_t)row * MLA_KVL);
      cp8[f_lane] = (unsigned short)(w & 0xffffu); cp8[f_lane + 64] = (unsigned short)(w >> 16);
      if (f_lane == 0) ((float*)(F.ws + WS_SCKV))[row] = am > 0.f ? am * (1.f / 127.f) : 1.f; }
    float x0 = bf_lo(R.pe), x1 = bf_hi(R.pe);
    if (row >= NC) { const int t = (row - NC) & 4095, i = f_lane & 15, d = 2 * i, pos = (d & 16) ? (t & 63) : (t >> 6), f = d & 7;
        const float p0 = shx(x0, 4, f_lane), p1 = shx(x1, 4, f_lane); const float sg = (d & 8) ? 1.f : -1.f;
        const LAS float* rp = rope + pos * 16 + 2 * f; x0 = x0 * rp[0] + sg * p0 * rp[1]; x1 = x1 * rp[2] + sg * p1 * rp[3]; }
    const unsigned w = pk2(x0, x1);
    { const int i = f_lane & 15, hb = f_lane >> 4;
#pragma unroll
      for (int hh = 0; hh < 4; ++hh) { const int h = hb * 4 + hh; ((unsigned*)(Kb + (size_t)row * 1536 + 96 * h + 64))[i] = w; } }
}
__device__ __forceinline__ void rp_mla(Frame& F, const Args& a) {
    const int f_tid = lthread(F.wave), f_lane = f_tid & 63;
    const bf16* A = (const bf16*)(F.ws + WS_RE);
    { LAS float* L = (LAS float*)F.lds; const float* rope = (const float*)(F.ws + WS_ROPE); __syncthreads();
      for (int i = f_tid; i < 384; i += 512) L[i] = a.in[12][i];
      for (int i = f_tid; i < 256; i += 512) L[384 + i] = a.in[14][i];
      for (int i = f_tid; i < 1024; i += 512) L[640 + i] = rope[i];
      __syncthreads(); }
    const int st = F.NGW, row0 = F.gw;
    if (row0 >= NT) return;
    const int n = (NT - row0 + st - 1) / st, rlast = row0 + (n - 1) * st;
#define MROW(i) ((row0 + (i) * st) <= rlast ? (row0 + (i) * st) : rlast)
    MRaw R0, R1, R2; mla_issue(R0, A, MROW(0), f_lane); mla_issue(R1, A, MROW(1), f_lane); mla_issue(R2, A, MROW(2), f_lane);
#define MSTEP(R, i_) do { if ((i_) < n) mla_finish(R, F, MROW(i_), f_lane); mla_issue(R, A, MROW((i_) + 3), f_lane); } while (0)
    for (int i = 0; i < n; i += 3) { MSTEP(R0, i); MSTEP(R1, i + 1); MSTEP(R2, i + 2); }
#undef MSTEP
#undef MROW
}

struct GRaw { v4u q0, q1, k0, k1; };
__device__ __forceinline__ void gqa_issue(GRaw& R, const bf16* A, int row, int lane) {
    const bf16* s0 = A + (size_t)row * GQA_QKV + lane * 16; const bf16* s1 = A + (size_t)row * GQA_QKV + 1024 + (lane & 15) * 16;
    R.q0 = *(const v4u*)s0; R.q1 = *(const v4u*)(s0 + 8); R.k0 = *(const v4u*)s1; R.k1 = *(const v4u*)(s1 + 8);
}
__device__ __forceinline__ void gqa_finish(const GRaw& R, Frame& F, int row, int f_lane) {
    bf16* Q = (bf16*)(F.ws + WS_RB); bf16* Kb = Q + (size_t)NT * 1024;
    const LAS float* LG = (const LAS float*)F.lds; const LAS float* rope = LG + 128;
    const float c2 = 0.125f * LOG2E;
    const bool lat = row >= NC; const int t = (row - NC) & 4095;
#pragma unroll
    for (int part = 0; part < 2; ++part) {
        const int ln = part ? (f_lane & 15) : f_lane;
        const v4u w0 = part ? R.k0 : R.q0, w1 = part ? R.k1 : R.q1;
        float x[16]; const unsigned ww[8] = {w0.x, w0.y, w0.z, w0[3], w1.x, w1.y, w1.z, w1[3]};
#pragma unroll
        for (int i = 0; i < 8; ++i) { x[2 * i] = bf_lo(ww[i]); x[2 * i + 1] = bf_hi(ww[i]); }
        float ss = 0.f;
#pragma unroll
        for (int i = 0; i < 16; ++i) ss += x[i] * x[i];
        ss += shx(ss, 1, f_lane); ss += shx(ss, 2, f_lane);
        const float rs = rsqrtf(ss * (1.f / 64.f) + EPS); const LAS float* g = LG + (part ? 64 : 0) + (ln & 3) * 16;
#pragma unroll
        for (int i = 0; i < 16; ++i) x[i] = x[i] * rs * g[i];
        if (lat) { const int sec = (ln >> 1) & 1, pos = sec ? (t & 63) : (t >> 6); const float sg = (ln & 1) ? 1.f : -1.f; const LAS float* rp = rope + pos * 32;
#pragma unroll
            for (int i = 0; i < 16; ++i) { const float pr = shx(x[i], 1, f_lane); x[i] = x[i] * rp[2 * i] + sg * pr * rp[2 * i + 1]; } }
        const float scl = part ? 1.f : c2;
        v4u o0, o1; o0.x = pk2(x[0] * scl, x[1] * scl); o0.y = pk2(x[2] * scl, x[3] * scl); o0.z = pk2(x[4] * scl, x[5] * scl); o0[3] = pk2(x[6] * scl, x[7] * scl);
        o1.x = pk2(x[8] * scl, x[9] * scl); o1.y = pk2(x[10] * scl, x[11] * scl); o1.z = pk2(x[12] * scl, x[13] * scl); o1[3] = pk2(x[14] * scl, x[15] * scl);
        if (part == 0) { bf16* d = Q + (size_t)row * 1024 + ln * 16; *(v4u*)d = o0; *(v4u*)(d + 8) = o1; }
        else if (f_lane < 16) { bf16* d = Kb + (size_t)row * 256 + ln * 16; *(v4u*)d = o0; *(v4u*)(d + 8) = o1; }
    }
}
__device__ __forceinline__ void rp_gqa(Frame& F, const Args& a) {
    const int f_tid = lthread(F.wave), f_lane = f_tid & 63;
    const bf16* A = (const bf16*)(F.ws + WS_RA);
    { LAS float* L = (LAS float*)F.lds; const float* rope = (const float*)(F.ws + WS_ROPE) + 2048; __syncthreads();
      for (int i = f_tid; i < 64; i += 512) { L[i] = a.in[18][i]; L[64 + i] = a.in[19][i]; }
      for (int i = f_tid; i < 2048; i += 512) L[128 + i] = rope[i];
      __syncthreads(); }
    const int st = F.NGW, row0 = F.gw;
    if (row0 >= NT) return;
    const int n = (NT - row0 + st - 1) / st, rlast = row0 + (n - 1) * st;
#define GROW(i) ((row0 + (i) * st) <= rlast ? (row0 + (i) * st) : rlast)
    GRaw R0, R1, R2; gqa_issue(R0, A, GROW(0), f_lane); gqa_issue(R1, A, GROW(1), f_lane); gqa_issue(R2, A, GROW(2), f_lane);
#define GSTEP(R, i_) do { if ((i_) < n) gqa_finish(R, F, GROW(i_), f_lane); gqa_issue(R, A, GROW((i_) + 3), f_lane); } while (0)
    for (int i = 0; i < n; i += 3) { GSTEP(R0, i); GSTEP(R1, i + 1); GSTEP(R2, i + 2); }
#undef GSTEP
#undef GROW
}

template <int DK>
__device__ __forceinline__ void attn_phase(Frame& F, const att::Tens& T, int kvshift  , int kstride, int vstride, int vbase) {
    const int vcu = (F.G % 8 == 0) ? (blockIdx.x % 8) * (F.G / 8) + blockIdx.x / 8 : blockIdx.x;
    if constexpr (DK == 64) {
        for (int u = vcu; u < 2048 + 128; u += F.G) {
            if (u < 2048) { const int b = u >> 8, h = (u >> 4) & 15, qb = u & 15, kvh = h >> kvshift;
                att64::attn_unit<8>(T.Q, T.qpitch, NC + b * SEQ + qb * 256, h * 64, T.K, T.kpitch, kvh * kstride, T.V, T.vpitch, vbase + kvh * vstride, T.O, h * 64, b * LCTX, NC + b * SEQ, 68, (char*)F.lds, F.wave); }
            else { const int q = u - 2048, b = q >> 4, h = q & 15, kvh = h >> kvshift;
                att64::attn_unit<8>(T.Q, T.qpitch, b * LCTX, h * 64, T.K, T.kpitch, kvh * kstride, T.V, T.vpitch, vbase + kvh * vstride, T.O, h * 64, b * LCTX, 0, 4, (char*)F.lds, F.wave); }
        }
        __syncthreads();
    } else {
        for (int u = vcu; u < 2048 + 128; u += F.G) {
            if (u < 2048) { const int b = u >> 8, h = (u >> 4) & 15, qb = u & 15, kvh = h >> kvshift;
                att96::attn_unit<8>(T.Q, T.qpitch, NC + b * SEQ + qb * 256, h * 96, T.K, T.kpitch, kvh * kstride, T.V, T.vpitch, vbase + kvh * vstride, T.O, h * 64, b * LCTX, NC + b * SEQ, 68, (char*)F.lds, F.wave); }
            else { const int q = u - 2048, b = q >> 4, h = q & 15, kvh = h >> kvshift;
                att96::attn_unit<8>(T.Q, T.qpitch, b * LCTX, h * 96, T.K, T.kpitch, kvh * kstride, T.V, T.vpitch, vbase + kvh * vstride, T.O, h * 64, b * LCTX, 0, 4, (char*)F.lds, F.wave); }
        }
        __syncthreads();
    }
}

constexpr int PH_PER_LAYER = 9, PH_TOTAL = 2 + DEPTH * PH_PER_LAYER;
__global__ void __launch_bounds__(512, 2) mk_fwd(Args args) {
    extern __shared__ __attribute__((aligned(16))) unsigned char lds_raw[];
    Frame F;
    F.lds = (LAS unsigned char*)lds_raw; F.ws = args.ws; F.ctl = (gu32*)(args.ws + WS_CTL);
    F.wave = __builtin_amdgcn_readfirstlane(threadIdx.x >> 6); F.G = gridDim.x;
    F.gw = blockIdx.x * 8 + F.wave; F.NGW = F.G * 8;
    if (threadIdx.x < 4) ((LAS unsigned*)(F.lds + LDS_XB))[threadIdx.x] = 0u;
    __syncthreads();
    const int lo = args.ph_lo, hi = args.ph_hi;
    const bool multi = (hi - lo) > 1;
    XcdBarrier bar; bar.bar = (unsigned*)(F.ctl + CW_BAR); bar.x = 0; bar.st = nullptr; bar.wave = F.wave;
    if (multi) bar = xcd_barrier_post((unsigned*)(F.ctl + CW_BAR), (volatile LAS unsigned*)(F.lds + LDS_XB), F.wave);
#define IN(k) (lo <= (k) && (k) < hi)
#define SEAM(k) do { if (IN(k) && IN((k) + 1)) xcd_barrier(bar); } while (0)
    unsigned char* ws0 = args.ws;
#define PH_WS size_t zofs_ = 0; asm volatile("" : "+s"(zofs_)); unsigned char* ws = ws0 + zofs_; F.ws = ws; F.ctl = (gu32*)ws;
    const int G = F.G, cidx = (int)blockIdx.x;

    if (IN(0) && EN(0)) { PH_WS REP(0) { prologue(F, args); SEAM(0); } }
    if (IN(1) && EN(1)) { PH_WS rp_norm1_l0(F, args);
        quant_rows(F, (const bf16*)(ws + WS_WFIN), (unsigned char*)(ws + WS_W8), (float*)(ws + WS_SWP), 2 * 2048);
        quant_rows(F, (const bf16*)(ws + WS_WMIN), (unsigned char*)(ws + WS_W8) + 4 * MiB, (float*)(ws + WS_SWP) + 4096, MLA_IN_PAD);
        quant_rows(F, (const bf16*)(ws + WS_WGQKV), (unsigned char*)(ws + WS_W8) + 5 * MiB, (float*)(ws + WS_SWP) + 4864, GQA_QKV);
        quant_rows256(F, (const bf16*)(ws + WS_WMKVB), (unsigned char*)(ws + WS_WKVB8), (float*)(ws + WS_WKVB8 + MiB), 2048);
        quant_rows384(F, (const bf16*)(ws + WS_WMQB), (unsigned char*)(ws + WS_WQB8), (float*)(ws + WS_WQB8 + MiB), 1536);
        { const int t1 = lthread(F.wave);
          for (int i = cidx * 512 + t1; i < DEPTH * 9 * D; i += G * 512) { const int l = i / (9 * D), rem = i - l * (9 * D), mr = rem >> 10, col = rem & (D - 1), ob = (l % 3 == 0) ? l / 3 : (l % 3 == 1 ? 2 : 3);
              float* gp = (float*)(ws + WS_MOD) + ((size_t)l * 9 + mr) * (NMOD * D) + 2 * D + col; *gp = *gp * ((const float*)(ws + WS_SWO))[ob * D + col]; } }
        SEAM(1); }

    for (int l = 0; l < DEPTH; ++l) {
        const int kind = l % 3, j = l / 3, base = 2 + l * PH_PER_LAYER;
        const bool lastl = (l == DEPTH - 1);

        size_t outB = 0;
        if (kind == 0) {
            if (IN(base + 0) && EN(2)) { PH_WS REP(2) { PolFP p; p.A = (const char*)(ws + WS_W8) + (size_t)j * 2048 * D; p.B = (const char*)(ws + WS_H); p.nt = 8; p.sW = (const float*)(ws + WS_SWP) + j * 2048; p.sH = (const float*)(ws + WS_SH); p.nN = lastl ? 128 : 136; p.G = G; p.c = cidx;
                p.Z = (bf16*)(ws + WS_RA); p.Zc = (bf16*)(ws + WS_RH); pg8::gemm_phase(F.lds, p, F.wave); } }
            SEAM(base + 0);
            if (IN(base + 1) && EN(3)) { PH_WS REP(3) { PolFA p; p.A = (const char*)(ws + WS_MA); p.B = (const char*)(ws + WS_RA); p.nt = 2; p.G = G; p.c = cidx; p.Y = (unsigned char*)(ws + WS_RB); pg8::gemm_phase(F.lds, p, F.wave); } }
            SEAM(base + 1);
            if (IN(base + 2) && EN(4)) { PH_WS REP(4) {
                PolFCl p; p.A = (const char*)(ws + WS_DC); p.B = (const char*)(ws + WS_RB); p.nt = 4; p.G = G; p.c = cidx; p.nunits = lastl ? 512 : 544;
                p.offMC = (unsigned)(WS_MC - WS_DC); p.offZc = (unsigned)(WS_RH - WS_RB); p.F = (unsigned char*)(ws + WS_RC); pg8::gemm_phase(F.lds, p, F.wave); } }
            SEAM(base + 2);
            outB = j;
        } else if (kind == 1) {
            if (IN(base + 0) && EN(5)) { PH_WS REP(5) { PolDenseI8 p; p.A = (const char*)(ws + WS_H); p.B = (const char*)(ws + WS_W8) + 4 * MiB; p.nt = 8; p.nM = NT / 256; p.nN = 3; p.pm0 = 0; p.G = G; p.c = cidx; p.sA = (const float*)(ws + WS_SH); p.sB = (const float*)(ws + WS_SWP) + 4096;
                p.O = (bf16*)(ws + WS_RE); p.ldo = MLA_IN_PAD; pg8::gemm_phase(F.lds, p, F.wave); } }
            SEAM(base + 0);
            if (IN(base + 1) && EN(6)) { PH_WS REP(6) { rp_mla(F, args); } }
            SEAM(base + 1);
            if (IN(base + 2)) { PH_WS REP(7) {
                if (EN(7)) { PolMlaQ p; p.A = (const char*)(ws + WS_RF); p.B = (const char*)(ws + WS_WQB8); p.sA = (const float*)(ws + WS_SCKV + 262144); p.sB = (const float*)(ws + WS_WQB8 + MiB); p.nt = 4; p.nM = NT / 256; p.nN = 6; p.G = G; p.c = cidx; p.Q = (bf16*)(ws + WS_RA);
                  p.rope = (const float*)(ws + WS_ROPE); p.c2 = 0.10206207261596575f * LOG2E; pg8::gemm_phase(F.lds, p, F.wave); }
                if (EN(8)) { PolMlaKV p; p.A = (const char*)(ws + WS_RG); p.B = (const char*)(ws + WS_WKVB8); p.sA = (const float*)(ws + WS_SCKV); p.sB = (const float*)(ws + WS_WKVB8 + MiB); p.nt = 2; p.nM = NT / 256; p.nN = 8; p.G = G; p.c = cidx; p.Kb = (bf16*)(ws + WS_RB); p.Vb = (bf16*)(ws + WS_RD);
                  pg8::gemm_phase(F.lds, p, F.wave); }
            } }
            SEAM(base + 2);
            if (IN(base + 3) && EN(9)) { PH_WS REP(9) { att::Tens T{(const bf16*)(ws + WS_RA), 1536, (const bf16*)(ws + WS_RB), 1536, (const bf16*)(ws + WS_RD), 1024, (bf16*)(ws + WS_RC)}; attn_phase<96>(F, T, 0, 96, 64, 0); } }
            SEAM(base + 3);
            outB = 2;
        } else {
            if (IN(base + 0) && EN(10)) { PH_WS REP(10) { PolDenseI8 p; p.A = (const char*)(ws + WS_H); p.B = (const char*)(ws + WS_W8) + 5 * MiB; p.nt = 8; p.nM = NT / 256; p.nN = 6; p.pm0 = 0; p.G = G; p.c = cidx; p.sA = (const float*)(ws + WS_SH); p.sB = (const float*)(ws + WS_SWP) + 4864;
                p.O = (bf16*)(ws + WS_RA); p.ldo = GQA_QKV; pg8::gemm_phase(F.lds, p, F.wave); } }
            SEAM(base + 0);
            if (IN(base + 1) && EN(11)) { PH_WS REP(11) { rp_gqa(F, args); } }
            SEAM(base + 1);
            if (IN(base + 2) && EN(12)) { PH_WS REP(12) { att::Tens T{(const bf16*)(ws + WS_RB), 1024, (const bf16*)(ws + WS_RB) + (size_t)NT * 1024, 256, (const bf16*)(ws + WS_RA), 1536, (bf16*)(ws + WS_RC)}; attn_phase<64>(F, T, 2, 64, 64, 1280); } }
            SEAM(base + 2);
            outB = 3;
        }
        if (IN(base + 4) && EN(13)) { PH_WS PolOut p; p.A = (const char*)(ws + WS_RC); p.B = (const char*)(ws + WS_WO8) + (size_t)outB * D * D; p.nt = 8; p.nM = lastl ? NL / 256 : NT / 256; p.nN = 4; p.pm0 = lastl ? 8 : 0; p.G = G; p.c = cidx; p.X = (bf16*)(ws + WS_X); p.mod = (const float*)(ws + WS_MOD) + (size_t)l * 9 * (NMOD * D); p.chunk = 2;
            pg8::gemm_phase(F.lds, p, F.wave); }
        SEAM(base + 4);
        if (IN(base + 5) && EN(14)) { PH_WS rp_norm2_router(F, args, l, lastl ? NC : 0); }
        SEAM(base + 5);
        if (IN(base + 6) && EN(15)) { PH_WS REP(15) { moe_table(F, l);
            PolMoe1 p; p.A = (const char*)(ws + WS_H); p.B = (const char*)(ws + WS_WGU) + (size_t)l * NE * 2048 * D; p.nt = 8; p.G = G; p.c = cidx;
            p.swgu = (const float*)(ws + WS_SWGU) + (size_t)l * NE * 2048; p.ssc = (const float*)(ws + WS_SSC);
            p.T.TT = (const LAS int*)(F.lds + LDS_TT); p.T.CN = p.T.TT + 64; p.T.TE = (const LAS int*)(F.lds + LDS_TE); p.stok = (const int*)(ws + WS_STOK); p.bgu = (const float*)(ws + WS_BGU) + (size_t)l * NE * 2048; p.act = (unsigned char*)(ws + WS_ACT);
            pg8::gemm_phase(F.lds, p, F.wave); } }
        SEAM(base + 6);
        if (IN(base + 7) && EN(16)) { PH_WS REP(16) { if (!(IN(base + 6) && EN(15))) moe_table(F, l);
            PolMoe2 p; p.A = (const char*)(ws + WS_ACT); p.B = (const char*)(ws + WS_WDN) + (size_t)l * NE * D * DFF; p.nt = 8; p.G = G; p.c = cidx; p.swd = (const float*)(ws + WS_SWDN) + (size_t)l * NE * D;
            p.T.TT = (const LAS int*)(F.lds + LDS_TT); p.T.CN = p.T.TT + 64; p.T.TE = (const LAS int*)(F.lds + LDS_TE); p.sw = (const float*)(ws + WS_SW); p.bdn = args.in[26] + (size_t)l * NE * D; p.Y = (unsigned char*)(ws + WS_Y);
            pg8::gemm_phase(F.lds, p, F.wave); } }
        SEAM(base + 7);
        if (IN(base + 8) && EN(17)) { PH_WS if (!(IN(base + 6) && EN(15))) moe_table(F, l); rp_combine(F, args, l, lastl ? NC : 0); }
        SEAM(base + 8);
    }
#undef PH_WS
#undef IN
#undef SEAM
}

extern "C" void kernel_launch(void* const* d_in, const int* in_sizes, int n_in, void* d_out, int out_size, void* d_ws, size_t ws_size, hipStream_t stream) {
    static int grid = 0;
    if (grid == 0) {
        if (n_in != 27 || out_size != NL * D || ws_size < WS_END) { fprintf(stderr, "kernel_launch: unexpected problem (n_in %d, out %d, ws %zu < %zu)\n", n_in, out_size, ws_size, (size_t)WS_END); grid = -1; return; }
        int dev = 0, cus = 0, per_cu = 0;
        if (hipGetDevice(&dev) != hipSuccess || hipDeviceGetAttribute(&cus, hipDeviceAttributeMultiprocessorCount, dev) != hipSuccess) { grid = -1; return; }
        if (hipFuncSetAttribute((const void*)mk_fwd, hipFuncAttributeMaxDynamicSharedMemorySize, LDS_BYTES) != hipSuccess) { fprintf(stderr, "kernel_launch: hipFuncSetAttribute failed\n"); grid = -1; return; }
        if (hipOccupancyMaxActiveBlocksPerMultiprocessor(&per_cu, (const void*)mk_fwd, 512, LDS_BYTES) != hipSuccess || per_cu < 1) fprintf(stderr, "kernel_launch: occupancy query says %d\n", per_cu);
        (void)hipGetLastError();
        grid = cus;
    }
    if (grid < 0) return;
    (void)hipMemsetAsync((char*)d_ws + WS_CTL, 0, CTL_ZERO_BYTES, stream);
    Args a{};
    for (int i = 0; i < 27; ++i) a.in[i] = (const float*)d_in[i];
    a.out = (float*)d_out; a.ws = (unsigned char*)d_ws;
#if MK_PER_PHASE
    for (int ph = 0; ph < PH_TOTAL; ++ph) {
        const int l = (ph - 2) / PH_PER_LAYER, s = (ph - 2) % PH_PER_LAYER, kind = l % 3;
        if (ph >= 2) { if (s == 3 && kind != 1) continue; }
        a.ph_lo = ph; a.ph_hi = ph + 1;
        hipLaunchKernelGGL(mk_fwd, dim3(grid), dim3(512), LDS_BYTES, stream, a);
    }
#else
    a.ph_lo = 0; a.ph_hi = PH_TOTAL;
    hipLaunchKernelGGL(mk_fwd, dim3(grid), dim3(512), LDS_BYTES, stream, a);
#endif
}
```

```cpp
#include <hip/hip_runtime.h>
#include <cstdio>
#include <cstdint>

#ifndef MK_PER_PHASE
#define MK_PER_PHASE 0
#endif
#ifndef MK_N2V2
#define MK_N2V2 1
#endif
#ifndef MK_CBV2
#define MK_CBV2 1
#endif
#ifndef MK_N2AGG
#define MK_N2AGG 1
#endif
#ifndef MK_MASK
#define MK_MASK 0xFFFFFFFFu
#endif
#define EN(id) (((MK_MASK) >> (id)) & 1u)
#ifndef MK_REPMASK
#define MK_REPMASK 0u
#endif
#define REP(id) for (int rep_ = 0; rep_ < ((((MK_REPMASK) >> (id)) & 1u) ? 2 : 1); ++rep_)

constexpr int D = 1024, NB = 8, SEQ = 4096, LCTX = 256, DEPTH = 4;
constexpr int NC = NB * LCTX;
constexpr int NL = NB * SEQ;
constexpr int NT = NC + NL;
constexpr int NMOD = 6, NE = 32, TOPK = 4, DFF = 1024;
constexpr int MLA_QL = 384, MLA_KVL = 256, MLA_ROPE = 32, MLA_NOPE = 64, MLA_V = 64, MLA_IN = 672, MLA_IN_PAD = 768, MLA_QD = 96;
constexpr int GQA_NQ = 1024, GQA_NKV = 256, GQA_QKV = 1536;
constexpr int CAP = NT;
constexpr int MAXTILES = 576;
constexpr float EPS = 1e-6f;
constexpr float LOG2E = 1.4426950408889634f;

constexpr size_t MiB = 1u << 20;
constexpr size_t WS_CTL = 0, CTL_ZERO_BYTES = 96 * 1024;
constexpr size_t WS_MOD = 1 * MiB;
constexpr size_t WS_ROPE = 2 * MiB;
constexpr size_t WS_WRT = 2 * MiB + 65536;
constexpr size_t WS_BGU = 3 * MiB;
constexpr size_t WS_MA = 4 * MiB;
constexpr size_t WS_DC = 4 * MiB + 262144;
constexpr size_t WS_MC = 5 * MiB;
constexpr size_t WS_WFIN = 9 * MiB;
constexpr size_t WS_WFOUT = 17 * MiB;
constexpr size_t WS_WMIN = 21 * MiB;
constexpr size_t WS_WMQB = 23 * MiB;
constexpr size_t WS_WMKVB = 25 * MiB;
constexpr size_t WS_WMO = 26 * MiB;
constexpr size_t WS_WGQKV = 28 * MiB;
constexpr size_t WS_WGO = 31 * MiB;
constexpr size_t WS_TE = 34 * MiB;
constexpr size_t WS_TRANK = 35 * MiB;
constexpr size_t WS_STOK = 36 * MiB;
constexpr size_t WS_SW = 41 * MiB;
constexpr size_t WS_X = 64 * MiB;
constexpr size_t WS_H = 200 * MiB;
constexpr size_t WS_RA = 272 * MiB;
constexpr size_t WS_RB = 400 * MiB;
constexpr size_t WS_RC = 528 * MiB;
constexpr size_t WS_RD = 600 * MiB;
constexpr size_t WS_RE = 672 * MiB;
constexpr size_t WS_RF = 728 * MiB;
constexpr size_t WS_RG = 756 * MiB;
constexpr size_t WS_RH = 776 * MiB;
constexpr size_t WS_ACT = 784 * MiB;
constexpr size_t WS_Y = 1072 * MiB;
constexpr size_t WS_WGU = 1360 * MiB;
constexpr size_t WS_SWGU = 1360 * MiB + 256 * MiB;
constexpr size_t WS_SH = 1360 * MiB + 259 * MiB;
constexpr size_t WS_SWP = 1360 * MiB + 259 * MiB + 256 * 1024;
constexpr size_t WS_W8 = 1360 * MiB + 266 * MiB;
constexpr size_t WS_WO8 = 1360 * MiB + 274 * MiB;
constexpr size_t WS_SWO = 1360 * MiB + 278 * MiB;
constexpr size_t WS_WKVB8 = 1360 * MiB + 280 * MiB;
constexpr size_t WS_SCKV = 1360 * MiB + 282 * MiB;
constexpr size_t WS_WQB8 = 1360 * MiB + 283 * MiB;
constexpr size_t WS_SSC = 1360 * MiB + 260 * MiB;
constexpr size_t WS_WDN = 1872 * MiB;
constexpr size_t WS_SWDN = 1872 * MiB + 128 * MiB;
constexpr size_t WS_END = 2128 * MiB;
constexpr int CW_TMO = 0;
constexpr int CW_BAR = 4096;
constexpr int CW_CNT = 16384;

constexpr int RING_BYTES = 131072;
constexpr int LDS_MISC = 135168;
constexpr int LDS_TT = LDS_MISC;
constexpr int LDS_XB = LDS_MISC + 512;
constexpr int LDS_TE = LDS_MISC + 768;
constexpr int LDS_BYTES = 147456;

#define GAS __attribute__((address_space(1)))
#define LAS __attribute__((address_space(3)))
typedef unsigned short bf16;
typedef unsigned v4u __attribute__((ext_vector_type(4)));
typedef unsigned v2u __attribute__((ext_vector_type(2)));
typedef float f32x4 __attribute__((ext_vector_type(4)));
typedef float f32x2 __attribute__((ext_vector_type(2)));
typedef float f32x16 __attribute__((ext_vector_type(16)));
typedef short bf16x8 __attribute__((ext_vector_type(8)));
typedef short s16x4 __attribute__((ext_vector_type(4)));
typedef __bf16 bf16x2_t __attribute__((ext_vector_type(2)));
typedef GAS unsigned gu32;
#define RLX_AGENT __ATOMIC_RELAXED, __HIP_MEMORY_SCOPE_AGENT
#define LDS_WAIT() asm volatile("s_waitcnt lgkmcnt(0)" ::: "memory")
#define VM_WAIT() asm volatile("s_waitcnt vmcnt(0)" ::: "memory")
__device__ __forceinline__ unsigned pk2(float lo, float hi) { f32x2 v = {lo, hi}; bf16x2_t b = __builtin_convertvector(v, bf16x2_t); return __builtin_bit_cast(unsigned, b); }
__device__ __forceinline__ float bf_lo(unsigned u) { return __builtin_bit_cast(float, u << 16); }
__device__ __forceinline__ float bf_hi(unsigned u) { return __builtin_bit_cast(float, u & 0xffff0000u); }
__device__ __forceinline__ float shx(float v, int mask, int lane) { return __int_as_float(__builtin_amdgcn_ds_bpermute((lane ^ mask) << 2, __float_as_int(v))); }
__device__ __forceinline__ float wave_sum(float v, int lane) {
#pragma unroll
    for (int o = 1; o < 64; o <<= 1) v += shx(v, o, lane);
    return v;
}
__device__ __forceinline__ int lane_id_v() { int t; asm volatile("v_mbcnt_lo_u32_b32 %0, -1, 0\n\tv_mbcnt_hi_u32_b32 %0, -1, %0" : "=v"(t)); return t; }
__device__ __forceinline__ int launder_s(int x) { asm volatile("" : "+s"(x)); return x; }
__device__ __forceinline__ int lthread_w(int wave) { return wave * 64 + lane_id_v(); }
__device__ __forceinline__ int modrow_of(int row) { return row < NC ? NB : ((row - NC) >> 12); }

#define XB_TMO      128
#define XB_XCNT(j)  (256  + 64 * (j))
#define XB_XSUB(j)  (1280 + 64 * (j))
#define XB_XGEN(j)  (2304 + 64 * (j))
#define XB_TOP      3328
#define XB_TOPGEN   3392
#define XCD_BAR_WORDS 3456
#define XB_SPIN_CAP (1u << 18)
__device__ __forceinline__ unsigned xb_ld(unsigned* p)              { return __hip_atomic_load(p, __ATOMIC_RELAXED, __HIP_MEMORY_SCOPE_AGENT); }
__device__ __forceinline__ unsigned xb_add(unsigned* p, unsigned v) { return __hip_atomic_fetch_add(p, v, __ATOMIC_RELAXED, __HIP_MEMORY_SCOPE_AGENT); }
__device__ __forceinline__ unsigned xb_xcc_id() { return (unsigned)__builtin_amdgcn_s_getreg((3 << 11) | 20) & 0xFu; }
#define XB_SPIN(cond, bar) do { unsigned _sp = 0; while (cond) { __builtin_amdgcn_s_sleep(1); \
    if ((++_sp & 255u) == 0u) { if (xb_ld(&(bar)[XB_TMO])) break; if (_sp > XB_SPIN_CAP) { atomicAdd(&(bar)[XB_TMO], 1u); break; } } } } while (0)
struct XcdBarrier { unsigned* bar; unsigned x; volatile LAS unsigned* st; int wave; };
__device__ __forceinline__ bool xb_thread0(int wave) { return wave == 0 && lane_id_v() == 0; }
__device__ __forceinline__ XcdBarrier xcd_barrier_post(unsigned* bar, volatile LAS unsigned* st, int wave) {
    XcdBarrier b; b.bar = bar; b.x = xb_xcc_id(); b.st = st; b.wave = wave;
    if (xb_thread0(wave)) (void)xb_add(&bar[XB_XCNT(b.x)], 1u);
    return b;
}
__device__ __forceinline__ void xcd_barrier_complete(unsigned* bar, unsigned x, unsigned& nloc, unsigned& nx) {
    const unsigned G = gridDim.x * gridDim.y * gridDim.z;
    unsigned sum, cnt, mine, sp = 0u;
    for (;;) {
        sum = 0u; cnt = 0u; mine = 0u;
#pragma unroll
        for (unsigned j = 0; j < 16; ++j) { const unsigned c = xb_ld(&bar[XB_XCNT(j)]); sum += c; cnt += (c > 0u) ? 1u : 0u; mine = (j == x) ? c : mine; }
        if (sum == G) break;
        __builtin_amdgcn_s_sleep(1);
        if ((++sp & 255u) == 0u) { if (xb_ld(&bar[XB_TMO])) break; if (sp > XB_SPIN_CAP) { atomicAdd(&bar[XB_TMO], 1u); break; } }
    }
    nloc = mine > 0u ? mine : 1u; nx = cnt > 0u ? cnt : 1u;
}
__device__ __forceinline__ void xcd_barrier(const XcdBarrier& b) {
    asm volatile("s_waitcnt vmcnt(0)" ::: "memory");
    __syncthreads();
    if (xb_thread0(b.wave)) {
        unsigned* bar = b.bar;
        __builtin_amdgcn_s_waitcnt(0);
        unsigned nloc = b.st[0], nx = b.st[1];
        if (nloc == 0u) { xcd_barrier_complete(bar, b.x, nloc, nx); b.st[0] = nloc; b.st[1] = nx; }
        const unsigned old = xb_add(&bar[XB_XSUB(b.x)], 1u);
        const unsigned gen = old / nloc;
        if (old + 1u == (gen + 1u) * nloc) {
            __builtin_amdgcn_fence(__ATOMIC_RELEASE, "agent");
            asm volatile("s_waitcnt vmcnt(0)" ::: "memory");
            const unsigned og = xb_add(&bar[XB_TOP], 1u);
            const unsigned tg = og / nx;
            if (og + 1u == (tg + 1u) * nx) xb_add(&bar[XB_TOPGEN], 1u);
            else XB_SPIN(xb_ld(&bar[XB_TOPGEN]) == tg, bar);
            __builtin_amdgcn_fence(__ATOMIC_ACQUIRE, "agent");
            xb_add(&bar[XB_XGEN(b.x)], 1u);
            asm volatile("s_waitcnt vmcnt(0)" ::: "memory");
        } else {
            XB_SPIN(xb_ld(&bar[XB_XGEN(b.x)]) == gen, bar);
            __builtin_amdgcn_fence(__ATOMIC_ACQUIRE, "agent");
            asm volatile("s_waitcnt vmcnt(0)" ::: "memory");
        }
    }
    __syncthreads();
}

namespace pg8 {
#define PG8_LAS __attribute__((address_space(3)))
constexpr int BM = 256, BK = 64, HALF = 128, HTB = HALF * BK * 2, STAGE_BYTES = 8 * HTB, NXCD = 8, WGM = 8;
__device__ __forceinline__ int lds_byte(int r, int c) { const int st = (r >> 4) * 2 + (c >> 5), rr = r & 15, cc = c & 31, ob = rr * 64 + cc * 2; return st * 1024 + (ob ^ (((ob >> 9) & 1) << 5)); }
__device__ __forceinline__ void stage_rc(int b, int& R, int& C) { const int st = b / 1024, sb = b % 1024, swz = sb ^ (((sb >> 9) & 1) << 5); R = (st >> 1) * 16 + swz / 64; C = (st & 1) * 32 + (swz % 64) / 2; }
__device__ __forceinline__ int perm32(int rho) { const int n = rho >> 4, i = rho & 15; return 8 * (i >> 2) + 4 * n + (i & 3); }
struct Unit { int pm, pn, aux; };
typedef f32x4 Acc[2][2][4][2];
typedef int i32x4 __attribute__((ext_vector_type(4)));
typedef i32x4 AccI[2][2][4][2];
template <bool I8> struct AccSel { typedef f32x4 T; };
template <> struct AccSel<true> { typedef i32x4 T; };
__device__ __forceinline__ f32x4 mma1(bf16x8 b, bf16x8 a, f32x4 c) { return __builtin_amdgcn_mfma_f32_16x16x32_bf16(b, a, c, 0, 0, 0); }
typedef int i32x8 __attribute__((ext_vector_type(8)));
typedef short bf16x16 __attribute__((ext_vector_type(16)));
__device__ __forceinline__ f32x4 mma_f8(bf16x8 b0, bf16x8 b1, bf16x8 a0, bf16x8 a1, f32x4 c) {
    const i32x8 B = __builtin_bit_cast(i32x8, __builtin_shufflevector(b0, b1, 0, 1, 2, 3, 4, 5, 6, 7, 8, 9, 10, 11, 12, 13, 14, 15));
    const i32x8 A = __builtin_bit_cast(i32x8, __builtin_shufflevector(a0, a1, 0, 1, 2, 3, 4, 5, 6, 7, 8, 9, 10, 11, 12, 13, 14, 15));
    return __builtin_amdgcn_mfma_scale_f32_16x16x128_f8f6f4(B, A, c, 0, 0, 0, 0, 0, 0); }
__device__ __forceinline__ i32x4 mma1(bf16x8 b, bf16x8 a, i32x4 c) { return __builtin_amdgcn_mfma_i32_16x16x64_i8(__builtin_bit_cast(i32x4, b), __builtin_bit_cast(i32x4, a), c, 0, 0, 0); }

__device__ __forceinline__ bool static_next(int i, int G, int c, int nM, int nN, int& pm, int& pn) {
    const int nwg = nM * nN; const long L = (long)i * G + c; if (L >= nwg) return false;
    int wgid = (int)L; { const int q = nwg / NXCD, r = nwg % NXCD, xcd = wgid % NXCD, off = wgid / NXCD; wgid = (xcd < r ? xcd * (q + 1) : r * (q + 1) + (xcd - r) * q) + off; }
    const int nig = WGM * nN, gid = wgid / nig, fm = gid * WGM, gsz = (nM - fm) < WGM ? (nM - fm) : WGM;
    pm = fm + ((wgid % nig) % gsz); pn = (wgid % nig) / gsz; return true;
}

template <class P>
__device__ __forceinline__ void gemm_phase(PG8_LAS unsigned char* lds, const P& p, int wave_id) {
    wave_id = launder_s(wave_id); int tid_l = lthread_w(wave_id);
    const int tid = tid_l, wid = wave_id, lane = tid & 63, wr = wid >> 2, wc = wid & 3, fr = lane & 15, fq = lane >> 4;
    const int nt = launder_s(p.nt);
    const unsigned ldsw = (unsigned)wid * 1024u;
    const int aoff = lds_byte(wr * 64 + fr, fq * 8), boff = lds_byte(wc * 32 + fr, fq * 8);
    const char* const gA = p.A; const char* const gB = p.B;
#define PG8_SA(b, h) (((b) * 2 + (h)) * HTB)
#define PG8_SB(b, h) ((4 + (b) * 2 + (h)) * HTB)
#define PG8_STAGE(bufoff, gbase, off2, kofs) do { _Pragma("unroll") for (int _i = 0; _i < 2; ++_i) \
        __builtin_amdgcn_global_load_lds((const unsigned*)((gbase) + (size_t)(unsigned)((off2)[_i] + (unsigned)(kofs))), (PG8_LAS unsigned*)(lds + (bufoff) + ldsw + _i * 8192), 16, 0, 0); } while (0)
#define PG8_LDA(dst, b, h) do { _Pragma("unroll") for (int m = 0; m < 4; ++m) _Pragma("unroll") for (int k = 0; k < 2; ++k) dst[m][k] = *(const PG8_LAS bf16x8*)(lds + PG8_SA(b, h) + aoff + m * 2048 + k * 1024); } while (0)
#define PG8_LDB(dst, b, h) do { _Pragma("unroll") for (int n = 0; n < 2; ++n) _Pragma("unroll") for (int k = 0; k < 2; ++k) dst[n][k] = *(const PG8_LAS bf16x8*)(lds + PG8_SB(b, h) + boff + n * 2048 + k * 1024); } while (0)
#define PG8_MMA(ai, bj, At, Bt) do { __builtin_amdgcn_s_setprio(1); _Pragma("unroll") for (int m = 0; m < 4; ++m) _Pragma("unroll") for (int n = 0; n < 2; ++n) { \
        if constexpr (P::F8) acc[ai][bj][m][n] = mma_f8(Bt[n][0], Bt[n][1], At[m][0], At[m][1], acc[ai][bj][m][n]); \
        else { _Pragma("unroll") for (int k = 0; k < 2; ++k) acc[ai][bj][m][n] = mma1(Bt[n][k], At[m][k], acc[ai][bj][m][n]); } } __builtin_amdgcn_s_setprio(0); } while (0)
#define PG8_WAIT_V(n) asm volatile("s_waitcnt vmcnt(" #n ")" ::: "memory")
#define PG8_WAIT_L(n) asm volatile("s_waitcnt lgkmcnt(" #n ")" ::: "memory")
#define PG8_BAR __builtin_amdgcn_s_barrier()
#define PG8_SCHED __builtin_amdgcn_sched_barrier(0)
#define PG8_KEYS(u) do { if (P::KEYS && wid < 4) __builtin_amdgcn_global_load_lds((const unsigned*)p.key_ptr(u, wid * 64 + lane_id_v()), (PG8_LAS unsigned*)(keybuf + wid * 256), 4, 0, 0); } while (0)
#define PG8_OFFS(u, oA, oB) do { const int tid2_ = wid * 64 + lane_id_v();     \
    _Pragma("unroll") for (int _i = 0; _i < 2; ++_i) { int R_, C_; stage_rc(tid2_ * 16 + _i * 8192, R_, C_); const int Rb_ = P::PERM ? ((R_ & ~31) + perm32(R_ & 31)) : R_; \
      _Pragma("unroll") for (int _h = 0; _h < 2; ++_h) { \
        const int key_ = P::KEYS ? ((const PG8_LAS int*)keybuf)[_h * HALF + R_] : 0; \
        oA[_h][_i] = p.a_row(u, _h * HALF + R_, key_) + (unsigned)(C_ * 2); oB[_h][_i] = p.b_row(u, _h * HALF + Rb_) + (unsigned)(C_ * 2); } } } while (0)
    PG8_LAS unsigned char* const keybuf = lds + STAGE_BYTES;
    PG8_LAS unsigned char* const epibuf = lds + 138240; int eslot = 0;
#define PG8_EPRE(u, slot) do { if (P::EPRE && wid < 4) { const int i_ = wid * 64 + lane_id_v(); _Pragma("unroll") for (int j_ = 0; j_ < 3; ++j_) \
        __builtin_amdgcn_global_load_lds((const unsigned*)p.epre_src(u, j_, i_), (PG8_LAS unsigned*)(epibuf + (slot) * 3072 + j_ * 1024 + wid * 256), 4, 0, 0); } } while (0)
    PG8_LAS int* const utab = (PG8_LAS int*)(lds + 133120);
    __syncthreads();
    if (wid == 0) { const int li_ = lane_id_v(); if (li_ < 32) { Unit uu_; uu_.pm = 0; uu_.pn = 0; uu_.aux = 0; const bool ok_ = p.next(li_, uu_); PG8_LAS int* e_ = utab + li_ * 4; e_[0] = uu_.pm; e_[1] = uu_.pn; e_[2] = uu_.aux; e_[3] = ok_ ? 1 : 0; } }
    __syncthreads();
#define PG8_NEXT(i, u, ok) do { const int ii_ = (i); if (ii_ < 32) { const PG8_LAS int* e_ = utab + ii_ * 4; u.pm = __builtin_amdgcn_readfirstlane(e_[0]); u.pn = __builtin_amdgcn_readfirstlane(e_[1]); u.aux = __builtin_amdgcn_readfirstlane(e_[2]); ok = __builtin_amdgcn_readfirstlane(e_[3]) != 0; } else ok = p.next(ii_, u); } while (0)
    Unit cur, nxt; int ui = 0;
    { bool ok0_; PG8_NEXT(0, cur, ok0_); if (!ok0_) return; }
    typedef typename AccSel<P::I8>::T AccT;
    AccT acc[2][2][4][2];
#pragma unroll
    for (int a = 0; a < 2; ++a)
#pragma unroll
        for (int b = 0; b < 2; ++b)
#pragma unroll
            for (int m = 0; m < 4; ++m)
#pragma unroll
                for (int n = 0; n < 2; ++n) acc[a][b][m][n] = (AccT){0, 0, 0, 0};
    bf16x8 At[4][2], B0[2][2], B1[2][2];
    unsigned oAc[2][2], oBc[2][2];
    if (P::KEYS || P::EPRE) { PG8_KEYS(cur); PG8_EPRE(cur, 0); PG8_WAIT_V(0); PG8_BAR; }
    PG8_OFFS(cur, oAc, oBc);
    PG8_STAGE(PG8_SB(0, 0), gB, oBc[0], 0); PG8_STAGE(PG8_SB(0, 1), gB, oBc[1], 0); PG8_STAGE(PG8_SA(0, 0), gA, oAc[0], 0); PG8_STAGE(PG8_SA(0, 1), gA, oAc[1], 0);
    if (wr == 1) PG8_BAR;
    PG8_WAIT_V(2); PG8_BAR;
    PG8_STAGE(PG8_SB(1, 0), gB, oBc[0], 128); PG8_STAGE(PG8_SA(1, 0), gA, oAc[0], 128); PG8_STAGE(PG8_SB(1, 1), gB, oBc[1], 128);
    PG8_WAIT_V(6); PG8_BAR;
    bool has_next; PG8_NEXT(1, nxt, has_next);
    if (has_next) { PG8_KEYS(nxt); PG8_EPRE(nxt, 1); }
    for (;;) {
        for (int t = 0; t < nt; t += 2) {
            const bool last = (t == nt - 2);
            const unsigned k1 = (unsigned)(t + 1) * 128u;
            const unsigned k2 = last ? 0u : (unsigned)(t + 2) * 128u, k3 = k2 + 128u;
            PG8_LDB(B0, 0, 0); PG8_LDB(B1, 0, 1); PG8_SCHED; PG8_LDA(At, 0, 0); PG8_STAGE(PG8_SA(1, 1), gA, oAc[1], k1);
            if (last && has_next) { PG8_OFFS(nxt, oAc, oBc); }
            PG8_WAIT_V(8); PG8_WAIT_L(0); PG8_BAR; PG8_MMA(0, 0, At, B0); PG8_MMA(0, 1, At, B1); PG8_BAR; PG8_SCHED;
            PG8_LDA(At, 0, 1); PG8_STAGE(PG8_SB(0, 0), gB, oBc[0], k2); PG8_STAGE(PG8_SB(0, 1), gB, oBc[1], k2); PG8_STAGE(PG8_SA(0, 0), gA, oAc[0], k2);
            PG8_WAIT_V(8); PG8_WAIT_L(0); PG8_BAR; PG8_MMA(1, 0, At, B0); PG8_MMA(1, 1, At, B1); PG8_BAR; PG8_SCHED;
            PG8_LDB(B0, 1, 0); PG8_LDB(B1, 1, 1); PG8_SCHED; PG8_LDA(At, 1, 0); PG8_STAGE(PG8_SA(0, 1), gA, oAc[1], k2);
            PG8_WAIT_V(8); PG8_WAIT_L(0); PG8_BAR; PG8_MMA(0, 0, At, B0); PG8_MMA(0, 1, At, B1); PG8_BAR; PG8_SCHED;
            PG8_LDA(At, 1, 1); PG8_STAGE(PG8_SB(1, 0), gB, oBc[0], k3); PG8_STAGE(PG8_SB(1, 1), gB, oBc[1], k3); PG8_STAGE(PG8_SA(1, 0), gA, oAc[0], k3);
            PG8_WAIT_V(8); PG8_WAIT_L(0); PG8_BAR; PG8_MMA(1, 0, At, B0); PG8_MMA(1, 1, At, B1); PG8_BAR; PG8_SCHED;
        }
        if (wr == 0) PG8_BAR;
        { const int le_ = lane_id_v(); int fr_e = le_ & 15, fq_e = le_ >> 4;
          if constexpr (P::EPRE) p.epi(acc, cur, wr, wc, fr_e, fq_e, (const PG8_LAS float*)(epibuf + eslot * 3072)); else p.epi(acc, cur, wr, wc, fr_e, fq_e); }
        if (!has_next) break;
        cur = nxt; ++ui; eslot = (eslot == 2 ? 0 : eslot + 1);
        PG8_NEXT(ui + 1, nxt, has_next);
        if (has_next) { PG8_KEYS(nxt); PG8_EPRE(nxt, (eslot == 2 ? 0 : eslot + 1)); }
#pragma unroll
        for (int a = 0; a < 2; ++a)
#pragma unroll
            for (int b = 0; b < 2; ++b)
#pragma unroll
                for (int m = 0; m < 4; ++m)
#pragma unroll
                    for (int n = 0; n < 2; ++n) acc[a][b][m][n] = (AccT){0, 0, 0, 0};
        if (wr == 1) PG8_BAR;
    }
    PG8_WAIT_V(0);
    PG8_BAR;
#undef PG8_SA
#undef PG8_SB
#undef PG8_STAGE
#undef PG8_LDA
#undef PG8_LDB
#undef PG8_MMA
#undef PG8_WAIT_V
#undef PG8_WAIT_L
#undef PG8_BAR
#undef PG8_SCHED
#undef PG8_OFFS
#undef PG8_KEYS
#undef PG8_NEXT
#undef PG8_EPRE
}
}
using pg8::Unit;

#define TROW(ai, wr, m, fr) (128 * (ai) + 64 * (wr) + 16 * (m) + (fr))
#define TCOLP(bj, wc, fq) (128 * (bj) + 32 * (wc) + 8 * (fq))
#define TCOLN(bj, wc, n, fq) (128 * (bj) + 32 * (wc) + 16 * (n) + 4 * (fq))
__device__ __forceinline__ v4u pack8(const f32x4 a, const f32x4 b) { v4u w; w.x = pk2(a[0], a[1]); w.y = pk2(a[2], a[3]); w.z = pk2(b[0], b[1]); w.w = pk2(b[2], b[3]); return w; }

__device__ __forceinline__ unsigned q8x4(float a, float b, float c, float d, float s) {
    const unsigned ua = __float_as_uint(fmaf(a, s, 12582912.f)), ub = __float_as_uint(fmaf(b, s, 12582912.f)), uc = __float_as_uint(fmaf(c, s, 12582912.f)), ud = __float_as_uint(fmaf(d, s, 12582912.f));
    return __builtin_amdgcn_perm(ub, ua, 0x0c0c0400u) | __builtin_amdgcn_perm(ud, uc, 0x04000c0cu); }
__device__ __forceinline__ v2u pack8_fp8(f32x4 a, f32x4 b) {
#pragma unroll
    for (int q = 0; q < 4; ++q) { a[q] = __builtin_amdgcn_fmed3f(a[q], -448.f, 448.f); b[q] = __builtin_amdgcn_fmed3f(b[q], -448.f, 448.f); }
    int t0 = __builtin_amdgcn_cvt_pk_fp8_f32(a[0], a[1], 0, false); t0 = __builtin_amdgcn_cvt_pk_fp8_f32(a[2], a[3], t0, true);
    int t1 = __builtin_amdgcn_cvt_pk_fp8_f32(b[0], b[1], 0, false); t1 = __builtin_amdgcn_cvt_pk_fp8_f32(b[2], b[3], t1, true); v2u o; o.x = (unsigned)t0; o.y = (unsigned)t1; return o; }
template <class T> __device__ __forceinline__ const T* ub_at(const T* base, unsigned idx) { return (const T*)((const char*)base + (size_t)(unsigned)(idx * 4u)); }
struct PolDenseBf16 {
    static constexpr bool EPRE = false; __device__ __forceinline__ const float* epre_src(const Unit&, int, int) const { return nullptr; }
    static constexpr bool PERM = true;
    static constexpr bool KEYS = false;
    static constexpr bool I8 = false;
    static constexpr bool F8 = false;
    __device__ __forceinline__ const int* key_ptr(const Unit&, int) const { return nullptr; }
    const char* A; const char* B; int nt; int nM, nN, pm0, G, c; unsigned pitchA, pitchB; bf16* O; int ldo;
    __device__ __forceinline__ bool next(int i, Unit& u) const { int pm, pn; if (!pg8::static_next(i, G, c, nM, nN, pm, pn)) return false; u.pm = pm + pm0; u.pn = pn; u.aux = 0; return true; }
    __device__ __forceinline__ unsigned a_row(const Unit& u, int r, int) const { return (unsigned)(u.pm * 256 + r) * pitchA; }
    __device__ __forceinline__ unsigned b_row(const Unit& u, int r) const { return (unsigned)(u.pn * 256 + r) * pitchB; }
    __device__ __forceinline__ void epi(const pg8::Acc& acc, const Unit& u, int wr, int wc, int fr, int fq) const {
#pragma unroll
        for (int ai = 0; ai < 2; ++ai)
#pragma unroll
            for (int m = 0; m < 4; ++m) { const size_t row = (size_t)u.pm * 256 + TROW(ai, wr, m, fr);
#pragma unroll
                for (int bj = 0; bj < 2; ++bj) { const int col = u.pn * 256 + TCOLP(bj, wc, fq); *(v4u*)(O + row * ldo + col) = pack8(acc[ai][bj][m][0], acc[ai][bj][m][1]); } }
    }
};

struct PolDenseI8 {
    static constexpr bool EPRE = true;
    __device__ __forceinline__ const float* epre_src(const Unit& u, int j, int i) const { return j == 1 ? ub_at(sB + u.pn * 256, (unsigned)i) : ub_at(sA + (size_t)u.pm * 256, (unsigned)i); }
    static constexpr bool PERM = true;
    static constexpr bool KEYS = false;
    static constexpr bool I8 = true;
    static constexpr bool F8 = false;
    __device__ __forceinline__ const int* key_ptr(const Unit&, int) const { return nullptr; }
    const char* A; const char* B; int nt; int nM, nN, pm0, G, c; const float* sA; const float* sB; bf16* O; int ldo;
    __device__ __forceinline__ bool next(int i, Unit& u) const { int pm, pn; if (!pg8::static_next(i, G, c, nM, nN, pm, pn)) return false; u.pm = pm + pm0; u.pn = pn; u.aux = 0; return true; }
    __device__ __forceinline__ unsigned a_row(const Unit& u, int r, int) const { return (unsigned)(u.pm * 256 + r) * 1024u; }
    __device__ __forceinline__ unsigned b_row(const Unit& u, int r) const { return (unsigned)(u.pn * 256 + r) * 1024u; }
    __device__ __forceinline__ void epi(const pg8::AccI& acc, const Unit& u, int wr, int wc, int fr, int fq, const LAS float* eb) const {
#pragma unroll
        for (int bj = 0; bj < 2; ++bj) { const int cl = TCOLP(bj, wc, fq), col = u.pn * 256 + cl; const f32x4 s0 = *(const LAS f32x4*)(eb + 256 + cl), s1 = *(const LAS f32x4*)(eb + 256 + cl + 4);
#pragma unroll
            for (int ai = 0; ai < 2; ++ai)
#pragma unroll
                for (int m = 0; m < 4; ++m) { const int rr = TROW(ai, wr, m, fr); const size_t row = (size_t)u.pm * 256 + rr; const float sa = eb[rr]; f32x4 v0, v1;
#pragma unroll
                    for (int q = 0; q < 4; ++q) { v0[q] = (float)acc[ai][bj][m][0][q] * (sa * s0[q]); v1[q] = (float)acc[ai][bj][m][1][q] * (sa * s1[q]); }
                    *(v4u*)(O + row * ldo + col) = pack8(v0, v1); } }
    }
};

struct PolOut {
    static constexpr bool EPRE = false; __device__ __forceinline__ const float* epre_src(const Unit&, int, int) const { return nullptr; }
    static constexpr bool PERM = true;
    static constexpr bool KEYS = false;
    static constexpr bool I8 = false;
    static constexpr bool F8 = true;
    __device__ __forceinline__ const int* key_ptr(const Unit&, int) const { return nullptr; }
    const char* A; const char* B; int nt; int nM, nN, pm0, G, c; bf16* X; const float* mod;
    int chunk;
    __device__ __forceinline__ bool next(int i, Unit& u) const { int pm, pn; if (!pg8::static_next(i, G, c, nM, nN, pm, pn)) return false; u.pm = pm + pm0; u.pn = pn; u.aux = 0; return true; }
    __device__ __forceinline__ unsigned a_row(const Unit& u, int r, int) const { return (unsigned)(u.pm * 256 + r) * 1024u; }
    __device__ __forceinline__ unsigned b_row(const Unit& u, int r) const { return (unsigned)(u.pn * 256 + r) * 1024u; }
    __device__ __forceinline__ void epi(const pg8::Acc& acc, const Unit& u, int wr, int wc, int fr, int fq) const {
        const int mr = modrow_of(u.pm * 256);
        const float* g = mod + (size_t)mr * (NMOD * D) + chunk * D;
#pragma unroll
        for (int bj = 0; bj < 2; ++bj) { const int col = u.pn * 256 + TCOLP(bj, wc, fq); const f32x4 g0 = *(const f32x4*)(g + col), g1 = *(const f32x4*)(g + col + 4);
#pragma unroll
            for (int ai = 0; ai < 2; ++ai)
#pragma unroll
                for (int m = 0; m < 4; ++m) { const size_t off = ((size_t)u.pm * 256 + TROW(ai, wr, m, fr)) * D + col; f32x4 x0, x1;
                    { const v4u w = *(const v4u*)(X + off); x0 = (f32x4){bf_lo(w.x), bf_hi(w.x), bf_lo(w.y), bf_hi(w.y)}; x1 = (f32x4){bf_lo(w.z), bf_hi(w.z), bf_lo(w[3]), bf_hi(w[3])}; }
                    *(v4u*)(X + off) = pack8(x0 + g0 * acc[ai][bj][m][0], x1 + g1 * acc[ai][bj][m][1]); } }
    }
};

struct PolFP {
    static constexpr bool EPRE = true;
    __device__ __forceinline__ const float* epre_src(const Unit& u, int j, int i) const { return j == 1 ? ub_at(sH, (unsigned)tok_row(u.pn, u.pn * 256 + i)) : ub_at(sW + u.pm * 256, (unsigned)i); }
    static constexpr bool PERM = true;
    static constexpr bool KEYS = false;
    static constexpr bool I8 = true;
    static constexpr bool F8 = false;
    __device__ __forceinline__ const int* key_ptr(const Unit&, int) const { return nullptr; }
    const char* A; const char* B; int nt; int nN, G, c; const float* sW; const float* sH; bf16* Z; bf16* Zc;
    __device__ __forceinline__ bool next(int i, Unit& u) const { int pm, pn; if (!pg8::static_next(i, G, c, 8, nN, pm, pn)) return false; u.pm = pm; u.pn = pn; u.aux = 0; return true; }
    __device__ __forceinline__ unsigned a_row(const Unit& u, int r, int) const { return (unsigned)(u.pm * 256 + r) * 1024u; }
    __device__ __forceinline__ int tok_row(int pn, int n) const { if (pn < 128) { const int b = n >> 12, l2 = (n >> 6) & 63, l1 = n & 63; return NC + b * SEQ + 64 * l1 + l2; } return n - 32768; }
    __device__ __forceinline__ unsigned b_row(const Unit& u, int r) const { return (unsigned)tok_row(u.pn, u.pn * 256 + r) * 1024u; }
    __device__ __forceinline__ void epi(const pg8::AccI& acc, const Unit& u, int wr, int wc, int fr, int fq, const LAS float* eb) const {
#pragma unroll
        for (int bj = 0; bj < 2; ++bj) { const int cl = TCOLP(bj, wc, fq), n0 = u.pn * 256 + cl;
            const f32x4 h0 = *(const LAS f32x4*)(eb + 256 + cl), h1 = *(const LAS f32x4*)(eb + 256 + cl + 4);
#pragma unroll
            for (int ai = 0; ai < 2; ++ai)
#pragma unroll
                for (int m = 0; m < 4; ++m) { const int rr = TROW(ai, wr, m, fr), cp = u.pm * 256 + rr; const float sw = eb[rr]; f32x4 v0, v1;
#pragma unroll
                    for (int q = 0; q < 4; ++q) { v0[q] = (float)acc[ai][bj][m][0][q] * (sw * h0[q]); v1[q] = (float)acc[ai][bj][m][1][q] * (sw * h1[q]); }
                    if (u.pn < 128) *(v2u*)((unsigned char*)Z + ((size_t)(n0 >> 6) * 2048 + cp) * 64 + (n0 & 63)) = pack8_fp8(v0, v1);
                    else { const int b = u.pn - 128, l = n0 - 32768 - b * 256; *(v2u*)((unsigned char*)Zc + ((size_t)b * 2048 + cp) * 256 + l) = pack8_fp8(v0, v1); } } }
    }
};

struct PolFA {
    static constexpr bool EPRE = false; __device__ __forceinline__ const float* epre_src(const Unit&, int, int) const { return nullptr; }
    static constexpr bool PERM = true;
    static constexpr bool KEYS = false;
    static constexpr bool I8 = false;
    static constexpr bool F8 = true;
    __device__ __forceinline__ const int* key_ptr(const Unit&, int) const { return nullptr; }
    const char* A; const char* B; int nt; int G, c; unsigned char* Y;
    __device__ __forceinline__ bool next(int i, Unit& u) const { const int L = i * G + c; if (L >= 1024) return false; u.pm = 0; u.pn = L & 127; u.aux = L >> 7; return true; }
    __device__ __forceinline__ unsigned a_row(const Unit&, int r, int) const { return (unsigned)r * 256u; }
    __device__ __forceinline__ unsigned b_row(const Unit& u, int r) const { const int l2 = r & 63, cp = u.pn * 4 + (r >> 6); return (unsigned)((u.aux * 64 + l2) * 512 + cp) * 256u; }
    __device__ __forceinline__ void epi(const pg8::Acc& acc, const Unit& u, int wr, int wc, int fr, int fq) const {
        const int b = u.aux;
#pragma unroll
        for (int ai = 0; ai < 2; ++ai)
#pragma unroll
            for (int m = 0; m < 4; ++m) { const int rr = TROW(ai, wr, m, fr), jp = rr >> 7, pp = (rr >> 6) & 1, k1 = rr & 63;
#pragma unroll
                for (int bj = 0; bj < 2; ++bj) { const int n0 = u.pn * 256 + TCOLP(bj, wc, fq), cp = n0 >> 6, l2 = n0 & 63, cc = 2 * cp + jp;
                    const unsigned idx = (unsigned)(((((b * 16 + (k1 >> 2)) * 1024 + cc) * 4 + (k1 & 3)) * 2 + pp) * 64 + l2);
                    *(v2u*)(Y + idx) = pack8_fp8(acc[ai][bj][m][0] * 0.03125f, acc[ai][bj][m][1] * 0.03125f); } }
    }
};

struct PolFC {
    static constexpr bool EPRE = false; __device__ __forceinline__ const float* epre_src(const Unit&, int, int) const { return nullptr; }
    static constexpr bool PERM = true;
    static constexpr bool KEYS = false;
    static constexpr bool I8 = false;
    static constexpr bool F8 = false;
    __device__ __forceinline__ const int* key_ptr(const Unit&, int) const { return nullptr; }
    const char* A; const char* B; int nt; int G, c; int nunits, l0; unsigned offMC, offZc; unsigned char* F;
    __device__ __forceinline__ bool next(int i, Unit& u) const { const int L = i * G + c + l0; if (L >= nunits) return false;
        if (L < 512) { u.pm = 0; u.pn = L & 3; u.aux = L >> 2; } else { const int q = L - 512; u.pm = 0; u.pn = q & 3; u.aux = 256 + (q >> 2); } return true; }
    __device__ __forceinline__ unsigned a_row(const Unit& u, int r, int) const {
        if (u.aux < 256) return offMC + (unsigned)((u.aux & 15) * 256 + r) * 1024u;
        return (unsigned)r * 1024u; }
    __device__ __forceinline__ unsigned b_row(const Unit& u, int r) const {
        if (u.aux < 256) return (unsigned)(u.aux * 1024 + u.pn * 256 + r) * 1024u;
        return offZc + (unsigned)((u.aux - 256) * 1024 + u.pn * 256 + r) * 1024u; }
    __device__ __forceinline__ void epi(const pg8::Acc& acc, const Unit& u, int wr, int wc, int fr, int fq) const {
#pragma unroll
        for (int ai = 0; ai < 2; ++ai)
#pragma unroll
            for (int m = 0; m < 4; ++m) { const int rr = TROW(ai, wr, m, fr); size_t frow;
                if (u.aux < 256) { const int b = u.aux >> 4, kq = u.aux & 15, k = 4 * kq + (rr >> 6) + 64 * (rr & 63); frow = (size_t)NC + b * SEQ + k; }
                else frow = (size_t)(u.aux - 256) * LCTX + rr;
#pragma unroll
                for (int bj = 0; bj < 2; ++bj) { const int col = u.pn * 256 + TCOLP(bj, wc, fq); *(v2u*)(F + frow * D + col) = pack8_fp8(acc[ai][bj][m][0], acc[ai][bj][m][1]); } }
    }
};

struct PolFCl {
    static constexpr bool EPRE = false; __device__ __forceinline__ const float* epre_src(const Unit&, int, int) const { return nullptr; }
    static constexpr bool PERM = true;
    static constexpr bool KEYS = false;
    static constexpr bool I8 = false;
    static constexpr bool F8 = true;
    __device__ __forceinline__ const int* key_ptr(const Unit&, int) const { return nullptr; }
    const char* A; const char* B; int nt; int G, c; int nunits; unsigned offMC, offZc; unsigned char* F;
    __device__ __forceinline__ bool next(int i, Unit& u) const { const int L = i * G + c; if (L >= nunits) return false;
        if (L < 512) { u.pm = 0; u.pn = L & 3; u.aux = L >> 2; } else { const int q = L - 512; u.pm = 0; u.pn = q & 3; u.aux = 256 + (q >> 2); } return true; }
    __device__ __forceinline__ unsigned a_row(const Unit& u, int r, int) const { return u.aux < 256 ? offMC + (unsigned)((u.aux & 15) * 256 + r) * 512u : (unsigned)r * 512u; }
    __device__ __forceinline__ unsigned b_row(const Unit& u, int r) const { return u.aux < 256 ? (unsigned)(u.aux * 1024 + u.pn * 256 + r) * 512u : offZc + (unsigned)((u.aux - 256) * 1024 + u.pn * 256 + r) * 512u; }
    __device__ __forceinline__ void epi(const pg8::Acc& acc, const Unit& u, int wr, int wc, int fr, int fq) const {
        const bool lat = u.aux < 256; const float sc = lat ? 0.125f : 0.015625f;
#pragma unroll
        for (int ai = 0; ai < 2; ++ai)
#pragma unroll
            for (int m = 0; m < 4; ++m) { const int rr = TROW(ai, wr, m, fr); size_t frow;
                if (lat) { const int b = u.aux >> 4, kq = u.aux & 15, k = 4 * kq + (rr >> 6) + 64 * (rr & 63); frow = (size_t)NC + b * SEQ + k; }
                else frow = (size_t)(u.aux - 256) * LCTX + rr;
#pragma unroll
                for (int bj = 0; bj < 2; ++bj) { const int col = u.pn * 256 + TCOLP(bj, wc, fq); *(v2u*)(F + frow * D + col) = pack8_fp8(acc[ai][bj][m][0] * sc, acc[ai][bj][m][1] * sc); } }
    }
};

struct PolMlaQ {
    static constexpr bool EPRE = true;
    __device__ __forceinline__ const float* epre_src(const Unit& u, int j, int i) const { return j == 1 ? ub_at(sB + u.pn * 256, (unsigned)i) : ub_at(sA + (size_t)u.pm * 256, (unsigned)i); }
    static constexpr bool PERM = true;
    static constexpr bool KEYS = false;
    static constexpr bool I8 = true;
    static constexpr bool F8 = false;
    __device__ __forceinline__ const int* key_ptr(const Unit&, int) const { return nullptr; }
    const char* A; const char* B; int nt; int nM, nN, G, c; bf16* Q; const float* rope; float c2; const float* sA; const float* sB;
    __device__ __forceinline__ bool next(int i, Unit& u) const { int pm, pn; if (!pg8::static_next(i, G, c, nM, nN, pm, pn)) return false; u.pm = pm; u.pn = pn; u.aux = 0; return true; }
    __device__ __forceinline__ unsigned a_row(const Unit& u, int r, int) const { return (unsigned)(u.pm * 256 + r) * 512u; }
    __device__ __forceinline__ unsigned b_row(const Unit& u, int r) const { return (unsigned)(u.pn * 256 + r) * 512u; }
    __device__ __forceinline__ void epi(const pg8::AccI& acc, const Unit& u, int wr, int wc, int fr, int fq, const LAS float* eb) const {
        const bool lat = u.pm >= 8;
#pragma unroll
        for (int bj = 0; bj < 2; ++bj) { const int cl = TCOLP(bj, wc, fq), col = u.pn * 256 + cl; const f32x4 s0 = *(const LAS f32x4*)(eb + 256 + cl), s1 = *(const LAS f32x4*)(eb + 256 + cl + 4); const bool isrope = lat && (((col >> 5) % 3) == 2);
#pragma unroll
            for (int ai = 0; ai < 2; ++ai)
#pragma unroll
                for (int m = 0; m < 4; ++m) { const int rr = TROW(ai, wr, m, fr), row = u.pm * 256 + rr; const float sa = eb[rr]; f32x4 v0, v1;
#pragma unroll
                    for (int e = 0; e < 4; ++e) { v0[e] = (float)acc[ai][bj][m][0][e] * (sa * s0[e]); v1[e] = (float)acc[ai][bj][m][1][e] * (sa * s1[e]); }
                    if (isrope) { const int t = (row - NC) & 4095, pos = (fq & 2) ? (t & 63) : (t >> 6);
                        const f32x4* rp = (const f32x4*)(rope + (size_t)pos * 16);
                        const f32x4 r0 = rp[0], r1 = rp[1], r2 = rp[2], r3 = rp[3];
                        f32x4 p0, p1;
#pragma unroll
                        for (int e = 0; e < 4; ++e) { p0[e] = shx(v0[e], 16, fq * 16 + fr); p1[e] = shx(v1[e], 16, fq * 16 + fr); }
                        const float sg = (fq & 1) ? 1.f : -1.f;
                        v0[0] = v0[0] * r0[0] + sg * p0[0] * r0[1]; v0[1] = v0[1] * r0[2] + sg * p0[1] * r0[3];
                        v0[2] = v0[2] * r1[0] + sg * p0[2] * r1[1]; v0[3] = v0[3] * r1[2] + sg * p0[3] * r1[3];
                        v1[0] = v1[0] * r2[0] + sg * p1[0] * r2[1]; v1[1] = v1[1] * r2[2] + sg * p1[1] * r2[3];
                        v1[2] = v1[2] * r3[0] + sg * p1[2] * r3[1]; v1[3] = v1[3] * r3[2] + sg * p1[3] * r3[3]; }
                    *(v4u*)(Q + (size_t)row * 1536 + col) = pack8(v0 * c2, v1 * c2); } }
    }
};

struct PolMlaKV {
    static constexpr bool EPRE = true;
    __device__ __forceinline__ const float* epre_src(const Unit& u, int j, int i) const { return j == 1 ? ub_at(sB + u.pn * 256, (unsigned)i) : ub_at(sA + (size_t)u.pm * 256, (unsigned)i); }
    static constexpr bool PERM = true;
    static constexpr bool KEYS = false;
    static constexpr bool I8 = true;
    static constexpr bool F8 = false;
    __device__ __forceinline__ const int* key_ptr(const Unit&, int) const { return nullptr; }
    const char* A; const char* B; int nt; int nM, nN, G, c; bf16* Kb; bf16* Vb; const float* sA; const float* sB;
    __device__ __forceinline__ bool next(int i, Unit& u) const { int pm, pn; if (!pg8::static_next(i, G, c, nM, nN, pm, pn)) return false; u.pm = pm; u.pn = pn; u.aux = 0; return true; }
    __device__ __forceinline__ unsigned a_row(const Unit& u, int r, int) const { return (unsigned)(u.pm * 256 + r) * 256u; }
    __device__ __forceinline__ unsigned b_row(const Unit& u, int r) const { return (unsigned)(u.pn * 256 + r) * 256u; }
    __device__ __forceinline__ void epi(const pg8::AccI& acc, const Unit& u, int wr, int wc, int fr, int fq, const LAS float* eb) const {
#pragma unroll
        for (int bj = 0; bj < 2; ++bj) { const int cl = TCOLP(bj, wc, fq), col = u.pn * 256 + cl, h = col >> 7, j = col & 127; const f32x4 s0 = *(const LAS f32x4*)(eb + 256 + cl), s1 = *(const LAS f32x4*)(eb + 256 + cl + 4);
#pragma unroll
            for (int ai = 0; ai < 2; ++ai)
#pragma unroll
                for (int m = 0; m < 4; ++m) { const int rr = TROW(ai, wr, m, fr); const size_t row = (size_t)u.pm * 256 + rr; const float sa = eb[rr]; f32x4 v0, v1;
#pragma unroll
                    for (int q = 0; q < 4; ++q) { v0[q] = (float)acc[ai][bj][m][0][q] * (sa * s0[q]); v1[q] = (float)acc[ai][bj][m][1][q] * (sa * s1[q]); }
                    const v4u w = pack8(v0, v1);
                    if (j < 64) *(v4u*)(Kb + row * 1536 + 96 * h + j) = w; else *(v4u*)(Vb + row * 1024 + 64 * h + (j - 64)) = w; } }
    }
};

struct MoeTab { const LAS int* TT; const LAS int* CN; const LAS int* TE; };
__device__ __forceinline__ bool moe_next(int i, int G, int c, int NP, const MoeTab& T, Unit& u) {
    const int ttot = T.TT[32];
    int lo, hi, j;
    if ((G & 7) == 0) { const int x = c & 7, q = c >> 3, g8 = G >> 3; lo = (x * ttot) >> 3; hi = ((x + 1) * ttot) >> 3; j = i * g8 + q; }
    else { lo = 0; hi = ttot; j = i * G + c; }
    if (j >= (hi - lo) * NP) return false;
    const int tile = lo + j / NP; u.pn = j % NP; u.pm = tile;
    const int e = T.TE[tile];
    u.aux = e | ((tile - T.TT[e]) << 8);
    return true;
}
struct PolMoe1 {
    static constexpr bool EPRE = true;
    __device__ __forceinline__ const float* epre_src(const Unit& u, int j, int i) const { const int e = u.aux & 255; const size_t fo = (size_t)e * 2048 + u.pn * 256;
        if (j == 0) return ub_at(bgu + fo, (unsigned)i); if (j == 1) return ub_at(swgu + fo, (unsigned)i); const unsigned idx = (unsigned)((u.aux >> 8) * 256 + i); return ub_at(ssc + (size_t)e * CAP, idx < (unsigned)T.CN[e] ? idx : 0u); }
    static constexpr bool PERM = true;
    static constexpr bool I8 = true;
    static constexpr bool F8 = false;
    const char* A; const char* B; int nt; int G, c; MoeTab T; const int* stok; const float* bgu; const float* swgu; const float* ssc; unsigned char* act;
    __device__ __forceinline__ bool next(int i, Unit& u) const { return moe_next(i, G, c, 8, T, u); }
    static constexpr bool KEYS = true;
    __device__ __forceinline__ const int* key_ptr(const Unit& u, int r) const { const int e = u.aux & 255; const unsigned idx = (unsigned)((u.aux >> 8) * 256 + r); return ub_at(stok + (size_t)e * CAP, idx < (unsigned)T.CN[e] ? idx : 0u); }
    __device__ __forceinline__ unsigned a_row(const Unit&, int, int key) const { return (unsigned)key * 1024u; }
    __device__ __forceinline__ unsigned b_row(const Unit& u, int r) const { return (unsigned)((u.aux & 255) * 2048 + u.pn * 256 + r) * 1024u; }
    __device__ __forceinline__ void epi(const pg8::AccI& acc, const Unit& u, int wr, int wc, int fr, int fq, const LAS float* eb) const {
        const int jl = 32 * wc + 8 * fq;
        const LAS float* bg = eb + jl; const LAS float* sg = eb + 256 + jl;
        const f32x4 bg0 = *(const LAS f32x4*)(bg), bg1 = *(const LAS f32x4*)(bg + 4), bu0 = *(const LAS f32x4*)(bg + 128) + 1.f, bu1 = *(const LAS f32x4*)(bg + 132) + 1.f;
        const f32x4 sg0 = *(const LAS f32x4*)(sg), sg1 = *(const LAS f32x4*)(sg + 4), su0 = *(const LAS f32x4*)(sg + 128), su1 = *(const LAS f32x4*)(sg + 132);
#pragma unroll
        for (int ai = 0; ai < 2; ++ai)
#pragma unroll
            for (int m = 0; m < 4; ++m) { const int rr = TROW(ai, wr, m, fr); const size_t slot = (size_t)u.pm * 256 + rr;
                const float sa = eb[512 + rr];
                f32x4 o0, o1;
#define MOE1_ACT(OUT, N, SG, BG, SU, BU) do { _Pragma("unroll") for (int hq = 0; hq < 2; ++hq) { \
                    const f32x2 ag = {(float)acc[ai][0][m][N][2 * hq], (float)acc[ai][0][m][N][2 * hq + 1]}, au = {(float)acc[ai][1][m][N][2 * hq], (float)acc[ai][1][m][N][2 * hq + 1]}; \
                    const f32x2 sgp = {SG[2 * hq], SG[2 * hq + 1]}, bgp = {BG[2 * hq], BG[2 * hq + 1]}, sup = {SU[2 * hq], SU[2 * hq + 1]}, bup = {BU[2 * hq], BU[2 * hq + 1]}; \
                    f32x2 g = __builtin_elementwise_fma(ag, sgp * sa, bgp), u = __builtin_elementwise_fma(au, sup * sa, bup); \
                    g[0] = fminf(g[0], 7.f); g[1] = fminf(g[1], 7.f); u[0] = __builtin_amdgcn_fmed3f(u[0], -6.f, 8.f); u[1] = __builtin_amdgcn_fmed3f(u[1], -6.f, 8.f); \
                    const f32x2 z = g * (-1.702f * LOG2E); f32x2 e; e[0] = __builtin_amdgcn_exp2f(z[0]); e[1] = __builtin_amdgcn_exp2f(z[1]); \
                    const f32x2 dd = e + 1.f; f32x2 r; r[0] = __builtin_amdgcn_rcpf(dd[0]); r[1] = __builtin_amdgcn_rcpf(dd[1]); \
                    const f32x2 o = (u * g) * r; OUT[2 * hq] = o[0]; OUT[2 * hq + 1] = o[1]; } } while (0)
                MOE1_ACT(o0, 0, sg0, bg0, su0, bu0); MOE1_ACT(o1, 1, sg1, bg1, su1, bu1);
#undef MOE1_ACT
                v2u w8; { int t0 = __builtin_amdgcn_cvt_pk_fp8_f32(o0[0], o0[1], 0, false); t0 = __builtin_amdgcn_cvt_pk_fp8_f32(o0[2], o0[3], t0, true);
                          int t1 = __builtin_amdgcn_cvt_pk_fp8_f32(o1[0], o1[1], 0, false); t1 = __builtin_amdgcn_cvt_pk_fp8_f32(o1[2], o1[3], t1, true); w8.x = (unsigned)t0; w8.y = (unsigned)t1; }
                *(v2u*)(act + slot * 1024 + u.pn * 128 + jl) = w8; }
    }
};
struct PolMoe2 {
    static constexpr bool EPRE = true;
    __device__ __forceinline__ const float* epre_src(const Unit& u, int j, int i) const { const int e = u.aux & 255; const size_t co = (size_t)e * 1024 + u.pn * 256;
        if (j == 0) return ub_at(bdn + co, (unsigned)i); if (j == 1) return ub_at(swd + co, (unsigned)i); const unsigned idx = (unsigned)((u.aux >> 8) * 256 + i); return ub_at(sw + (size_t)e * CAP, idx < (unsigned)T.CN[e] ? idx : 0u); }
    static constexpr bool PERM = true;
    static constexpr bool KEYS = false;
    static constexpr bool I8 = false;
    static constexpr bool F8 = true;
    __device__ __forceinline__ const int* key_ptr(const Unit&, int) const { return nullptr; }
    const char* A; const char* B; int nt; int G, c; MoeTab T; const float* sw; const float* bdn; const float* swd; unsigned char* Y;
    __device__ __forceinline__ bool next(int i, Unit& u) const { return moe_next(i, G, c, 4, T, u); }
    __device__ __forceinline__ unsigned a_row(const Unit& u, int r, int) const { return (unsigned)(u.pm * 256 + r) * 1024u; }
    __device__ __forceinline__ unsigned b_row(const Unit& u, int r) const { return (unsigned)((u.aux & 255) * 1024 + u.pn * 256 + r) * 1024u; }
    __device__ __forceinline__ void epi(const pg8::Acc& acc, const Unit& u, int wr, int wc, int fr, int fq, const LAS float* eb) const {
#pragma unroll
        for (int bj = 0; bj < 2; ++bj) { const int cl = TCOLP(bj, wc, fq), col = u.pn * 256 + cl;
            const f32x4 b0 = *(const LAS f32x4*)(eb + cl), b1 = *(const LAS f32x4*)(eb + cl + 4), s0 = *(const LAS f32x4*)(eb + 256 + cl), s1 = *(const LAS f32x4*)(eb + 256 + cl + 4);
#pragma unroll
            for (int ai = 0; ai < 2; ++ai)
#pragma unroll
                for (int m = 0; m < 4; ++m) { const int rr = TROW(ai, wr, m, fr); const size_t slot = (size_t)u.pm * 256 + rr; const float w = eb[512 + rr];
                    const float w8 = w * 8.f; f32x4 y0 = (acc[ai][bj][m][0] * s0 + b0) * w8, y1 = (acc[ai][bj][m][1] * s1 + b1) * w8;
#pragma unroll
                    for (int q = 0; q < 4; ++q) { y0[q] = fminf(fmaxf(y0[q], -448.f), 448.f); y1[q] = fminf(fmaxf(y1[q], -448.f), 448.f); }
                    v2u o8; { int t0 = __builtin_amdgcn_cvt_pk_fp8_f32(y0[0], y0[1], 0, false); t0 = __builtin_amdgcn_cvt_pk_fp8_f32(y0[2], y0[3], t0, true);
                              int t1 = __builtin_amdgcn_cvt_pk_fp8_f32(y1[0], y1[1], 0, false); t1 = __builtin_amdgcn_cvt_pk_fp8_f32(y1[2], y1[3], t1, true); o8.x = (unsigned)t0; o8.y = (unsigned)t1; }
                    *(v2u*)(Y + slot * 1024 + col) = o8; } }
    }
};

namespace att {
__device__ __forceinline__ int crow(int r, int hi) { return (r & 3) + 8 * (r >> 2) + 4 * hi; }
__device__ __forceinline__ float max3f(float a, float b, float c) { return fmaxf(fmaxf(a, b), c); }
typedef LAS const char* lds_cptr;
constexpr int LK = 0, LV = 49152, LWS = 90112, LOST = 92160, LBYTES = 124928;
constexpr int PD = 3;
struct Tens { const bf16* Q; int qpitch; const bf16* K; int kpitch; const bf16* V; int vpitch; bf16* O; };
#define ATT_WAITV(n) asm volatile("s_waitcnt vmcnt(" #n ")" ::: "memory")
struct Pend { f32x16 o0, o1; float l; int qrow0, oc0; bool valid; };
__device__ __forceinline__ void finish_unit(const Pend& P, bf16* O, LAS unsigned char* lds, int wid, int lane) {
    const int r32 = lane & 31, hi = lane >> 5;
    LAS float* wsf = (LAS float*)(lds + LWS) + wid * 64;
    float lrun = P.l;
    { auto rr = __builtin_amdgcn_permlane32_swap(__float_as_uint(lrun), __float_as_uint(lrun), false, false); lrun = __uint_as_float(rr[0]) + __uint_as_float(rr[1]); }
    if (hi == 0) wsf[32 + r32] = lrun;
    LDS_WAIT();
    LAS bf16* stg = (LAS bf16*)(lds + LOST) + wid * 2048;
#pragma unroll
    for (int r = 0; r < 16; ++r) { const int orow = crow(r, hi); const float rl = __builtin_amdgcn_rcpf(wsf[32 + orow]);
        stg[orow * 64 + r32] = (bf16)(pk2(P.o0[r] * rl, 0.f) & 0xffffu); stg[orow * 64 + 32 + r32] = (bf16)(pk2(P.o1[r] * rl, 0.f) & 0xffffu); }
    LDS_WAIT();
    bf16* Ow = O + (size_t)(P.qrow0 + wid * 32) * 1024 + P.oc0;
#pragma unroll
    for (int i = 0; i < 4; ++i) { const int row = i * 8 + (lane >> 3), ch = lane & 7; const v4u v = *(const LAS v4u*)(stg + row * 64 + ch * 8); *(v4u*)(Ow + (size_t)row * 1024 + ch * 8) = v; }
    LDS_WAIT();
}
template <int DK>
__device__ __forceinline__ void unit(const Tens& T, int qrow0, int qc0, int kc0, int vc0, int oc0, int kctx0, int klat0, int NTL, LAS unsigned char* lds, int wave_id, Pend& pend) {
    constexpr int ND = DK / 16;
    wave_id = launder_s(wave_id); const int tid = lthread_w(wave_id), lane = tid & 63, r32 = lane & 31, hi = lane >> 5; const int wid = wave_id;
    LAS float* wsf = (LAS float*)(lds + LWS) + wid * 64;
    const bf16* ksrc = T.K + (size_t)lane * T.kpitch + kc0 + wid * 8;
    const int k2off = (8 + (wid & 3) - wid) * 8;
    const bf16* vsrc = T.V + (size_t)(16 * (wid & 3) + (lane >> 2)) * T.vpitch + vc0 + (wid >> 2) * 32 + (lane & 3) * 8;
#define ATT_DMA(t, ks_, vs_) do { const size_t row0_ = (size_t)((t) < 4 ? kctx0 + 64 * (t) : klat0 + 64 * ((t) - 4)); \
        __builtin_amdgcn_global_load_lds((const unsigned*)(ksrc + row0_ * T.kpitch), (LAS unsigned*)(lds + LK + (ks_) * 12288 + wid * 1024), 16, 0, 0); \
        if (DK > 64) __builtin_amdgcn_global_load_lds((const unsigned*)(ksrc + row0_ * T.kpitch + k2off), (LAS unsigned*)(lds + LK + (ks_) * 12288 + 8192 + (wid & 3) * 1024), 16, 0, 0); \
        __builtin_amdgcn_global_load_lds((const unsigned*)(vsrc + row0_ * T.vpitch), (LAS unsigned*)(lds + LV + (vs_) * 8192 + wid * 1024), 16, 0, 0); } while (0)
#define ATT_WAIT_TILES(n_tiles) do { if (DK > 64) { if ((n_tiles) >= 2) ATT_WAITV(6); else if ((n_tiles) == 1) ATT_WAITV(3); else ATT_WAITV(0); } \
        else { if ((n_tiles) >= 2) ATT_WAITV(4); else if ((n_tiles) == 1) ATT_WAITV(2); else ATT_WAITV(0); } } while (0)
    bf16x8 qr[ND];
    { const bf16* qp = T.Q + (size_t)(qrow0 + wid * 32 + r32) * T.qpitch + qc0 + hi * 8;
#pragma unroll
      for (int d0 = 0; d0 < ND; ++d0) qr[d0] = *(const bf16x8*)(qp + d0 * 16); }
    asm volatile("" ::: "memory");
    constexpr float THR = 8.f;
    const int half = wid >> 2;
    float mhat = 0.f, lrun = 0.f; f32x16 o[2]; o[0] = f32x16{}; o[1] = f32x16{}; f32x16 negm = f32x16{};
    f32x16 p0 = f32x16{}, p1 = f32x16{}; v4u pw[4]; pw[0] = pw[1] = pw[2] = pw[3] = (v4u){0u, 0u, 0u, 0u};
    ATT_DMA(0, 0, 0); ATT_DMA(1, 1, 1); ATT_DMA(2, 2, 2);
    if (pend.valid) finish_unit(pend, T.O, lds, wid, lane);
    ATT_WAIT_TILES(2);
    __builtin_amdgcn_s_barrier(); asm volatile("" ::: "memory");
    if (half == 1) __builtin_amdgcn_s_barrier();
    int vs_prev = 0, vs_cur = 0, vs_iss = 3;
    for (int t = 0; t <= NTL; ++t) {
        if (t >= 1) {
            s16x4 lo[2][4], hh[2][4];
            const unsigned vb = (unsigned)(uintptr_t)(lds + LV + vs_prev * 8192) + ((lane >> 4) & 1) * 32 + (lane & 3) * 8 + (4 * hi + ((lane & 15) >> 2)) * 64;
#pragma unroll
            for (int d0 = 0; d0 < 2; ++d0)
#pragma unroll
                for (int ks = 0; ks < 4; ++ks) {
                    asm volatile("ds_read_b64_tr_b16 %0,%1 offset:%c2" : "=&v"(lo[d0][ks]) : "v"(vb), "i"(d0 * 4096 + ks * 1024) : "memory");
                    asm volatile("ds_read_b64_tr_b16 %0,%1 offset:%c2" : "=&v"(hh[d0][ks]) : "v"(vb), "i"(d0 * 4096 + ks * 1024 + 512) : "memory"); }
            asm volatile("s_waitcnt lgkmcnt(0)" ::: "memory"); __builtin_amdgcn_sched_barrier(0);
#pragma unroll
            for (int ks = 0; ks < 4; ++ks)
#pragma unroll
                for (int d0 = 0; d0 < 2; ++d0) { const bf16x8 vf = (bf16x8){lo[d0][ks][0], lo[d0][ks][1], lo[d0][ks][2], lo[d0][ks][3], hh[d0][ks][0], hh[d0][ks][1], hh[d0][ks][2], hh[d0][ks][3]};
                    o[d0] = __builtin_amdgcn_mfma_f32_32x32x16_bf16(__builtin_bit_cast(bf16x8, pw[ks]), vf, o[d0], 0, 0, 0); }
        }
        if (t < NTL) {
            bf16x8 kf[2 * ND];
            const lds_cptr kb = (lds_cptr)(lds + LK + (t & 3) * 12288) + hi * 1024 + r32 * 16;
#pragma unroll
            for (int d0 = 0; d0 < ND; ++d0) { kf[2 * d0] = *(const LAS bf16x8*)(kb + d0 * 2048); kf[2 * d0 + 1] = *(const LAS bf16x8*)(kb + d0 * 2048 + 512); }
            asm volatile("s_waitcnt lgkmcnt(0)" ::: "memory"); __builtin_amdgcn_sched_barrier(0);
#pragma unroll
            for (int d0 = 0; d0 < ND; ++d0) {
                if (d0 == 0) { p0 = __builtin_amdgcn_mfma_f32_32x32x16_bf16(kf[0], qr[0], negm, 0, 0, 0); p1 = __builtin_amdgcn_mfma_f32_32x32x16_bf16(kf[1], qr[0], negm, 0, 0, 0); }
                else { p0 = __builtin_amdgcn_mfma_f32_32x32x16_bf16(kf[2 * d0], qr[d0], p0, 0, 0, 0); p1 = __builtin_amdgcn_mfma_f32_32x32x16_bf16(kf[2 * d0 + 1], qr[d0], p1, 0, 0, 0); } }
        }
        if (half == 1) {
            const int last_iss = (t + PD - 1 < NTL - 1) ? t + PD - 1 : NTL - 1; const int allow = last_iss - (t + 1);
            if (allow >= 1) ATT_WAIT_TILES(1); else ATT_WAIT_TILES(0); }
        asm volatile("s_waitcnt lgkmcnt(0)" ::: "memory"); __builtin_amdgcn_s_barrier(); asm volatile("" ::: "memory");
        if (t < NTL) {
            float rm = max3f(p0[0], p0[1], p1[0]);
#pragma unroll
            for (int r = 0; r < 16; ++r) rm = max3f(rm, p0[r], p1[r]);
            { auto rr = __builtin_amdgcn_permlane32_swap(__float_as_uint(rm), __float_as_uint(rm), false, false); rm = fmaxf(__uint_as_float(rr[0]), __uint_as_float(rr[1])); }
            if (t == 0 || __any(rm > THR)) {
                const float dl = (t == 0) ? rm : fmaxf(rm, 0.f);
                mhat += dl;
#pragma unroll
                for (int r = 0; r < 16; ++r) { p0[r] -= dl; p1[r] -= dl; negm[r] = -mhat; }
                const float f = (t == 0) ? 1.f : __builtin_amdgcn_exp2f(-dl); lrun *= f;
                if (hi == 0) wsf[r32] = f;
                LDS_WAIT();
#pragma unroll
                for (int r = 0; r < 16; ++r) { const float a = wsf[crow(r, hi)]; o[0][r] *= a; o[1][r] *= a; }
            }
            float rs = 0.f;
#pragma unroll
            for (int r = 0; r < 16; ++r) { p0[r] = __builtin_amdgcn_exp2f(p0[r]); p1[r] = __builtin_amdgcn_exp2f(p1[r]); rs += p0[r] + p1[r]; }
            lrun += rs;
            pw[0] = (v4u){pk2(p0[0], p0[1]), pk2(p0[2], p0[3]), pk2(p0[4], p0[5]), pk2(p0[6], p0[7])};
            pw[1] = (v4u){pk2(p0[8], p0[9]), pk2(p0[10], p0[11]), pk2(p0[12], p0[13]), pk2(p0[14], p0[15])};
            pw[2] = (v4u){pk2(p1[0], p1[1]), pk2(p1[2], p1[3]), pk2(p1[4], p1[5]), pk2(p1[6], p1[7])};
            pw[3] = (v4u){pk2(p1[8], p1[9]), pk2(p1[10], p1[11]), pk2(p1[12], p1[13]), pk2(p1[14], p1[15])};
        }
        if (t + PD < NTL) { ATT_DMA(t + PD, (t + PD) & 3, vs_iss); vs_iss = (vs_iss == 4) ? 0 : vs_iss + 1; }
        if (half == 0) {
            const int last_iss = (t + PD < NTL - 1) ? t + PD : NTL - 1; const int allow = last_iss - (t + 1);
            if (allow >= 2) ATT_WAIT_TILES(2); else if (allow == 1) ATT_WAIT_TILES(1); else ATT_WAIT_TILES(0); }
        vs_prev = vs_cur; vs_cur = (vs_cur == 4) ? 0 : vs_cur + 1;
        asm volatile("s_waitcnt lgkmcnt(0)" ::: "memory"); __builtin_amdgcn_s_barrier(); asm volatile("" ::: "memory");
    }
    if (half == 0) __builtin_amdgcn_s_barrier();
#undef ATT_DMA
#undef ATT_WAIT_TILES
    pend.o0 = o[0]; pend.o1 = o[1]; pend.l = lrun; pend.qrow0 = qrow0; pend.oc0 = oc0; pend.valid = true;
}
#undef ATT_WAITV
}

namespace att64 {
typedef unsigned short bf16;
using bf16x8=__attribute__((ext_vector_type(8)))short;
using s16x4=__attribute__((ext_vector_type(4)))short;
using f32x16=__attribute__((ext_vector_type(16)))float;
using u32x4=__attribute__((ext_vector_type(4)))unsigned;
constexpr int D=64;
constexpr int NW=8,QBLK=32,QB=QBLK*NW,KVBLK=64;
__device__ __forceinline__ int crow(int r,int hi){return (r&3)+8*(r>>2)+4*hi;}
#define SBAR() __builtin_amdgcn_sched_barrier(0)
constexpr int NSLOT=3, SLOTB=8192;
constexpr int LDS_K=0, LDS_V=NSLOT*SLOTB, LDS_WS=2*NSLOT*SLOTB, LDS_OST=LDS_WS+NW*64*4, LDS_BYTES=LDS_OST+NW*4096;
constexpr float C2=0.125f*1.4426950408889634f;
__device__ __forceinline__ void glds16(const void*gsrc,unsigned lds_dst){unsigned keep;
  asm volatile("s_mov_b32 %0, m0\n\ts_mov_b32 m0, %2\n\ts_nop 0\n\tglobal_load_lds_dwordx4 %1, off\n\ts_mov_b32 m0, %0":"=&s"(keep):"v"(gsrc),"s"(lds_dst):"memory");}
__device__ __forceinline__ float max3f(float a,float b,float c){float r;asm("v_max3_f32 %0, %1, %2, %3":"=v"(r):"v"(a),"v"(b),"v"(c));return r;}
__device__ __forceinline__ float max2f(float a,float b){float r;asm("v_max_f32_e32 %0, %1, %2":"=v"(r):"v"(a),"v"(b));return r;}
__device__ __forceinline__ float fadd_s(float a,float b){float r;asm("v_add_f32_e32 %0, %1, %2":"=v"(r):"v"(a),"v"(b));return r;}
__device__ __forceinline__ float fsub_s(float a,float b){float r;asm("v_sub_f32_e32 %0, %1, %2":"=v"(r):"v"(a),"v"(b));return r;}
typedef float f32x2_t __attribute__((ext_vector_type(2))); typedef __bf16 bf16x2_t __attribute__((ext_vector_type(2)));
__device__ __forceinline__ unsigned cvtpk_s(float lo,float hi){f32x2_t v={lo,hi};bf16x2_t b=__builtin_convertvector(v,bf16x2_t);return __builtin_bit_cast(unsigned,b);}
#define WAIT_BAR(N) asm volatile("s_waitcnt vmcnt(" #N ") lgkmcnt(0)\n\ts_barrier":::"memory")

__device__ __forceinline__ void qkt(f32x16&p0,f32x16&p1,const char*Kslot,const bf16x8*qr,const f32x16&negm,int r32,int hi){
  const char*kb=Kslot+hi*1024+r32*16;
  #pragma unroll
  for(int d0=0;d0<4;++d0){
    const bf16x8 b0=*reinterpret_cast<const bf16x8*>(kb+d0*2048);
    const bf16x8 b1=*reinterpret_cast<const bf16x8*>(kb+d0*2048+512);
    if(d0==0){p0=__builtin_amdgcn_mfma_f32_32x32x16_bf16(b0,qr[0],negm,0,0,0);p1=__builtin_amdgcn_mfma_f32_32x32x16_bf16(b1,qr[0],negm,0,0,0);}
    else{p0=__builtin_amdgcn_mfma_f32_32x32x16_bf16(b0,qr[d0],p0,0,0,0);p1=__builtin_amdgcn_mfma_f32_32x32x16_bf16(b1,qr[d0],p1,0,0,0);}}
}
typedef __attribute__((address_space(3))) const char* lds_cptr;
typedef short v4i16_t __attribute__((ext_vector_type(4)));
__device__ __forceinline__ void kload8(bf16x8*kf,lds_cptr kp){
  kf[0]=*(const __attribute__((address_space(3))) bf16x8*)(kp);      kf[1]=*(const __attribute__((address_space(3))) bf16x8*)(kp+512);
  kf[2]=*(const __attribute__((address_space(3))) bf16x8*)(kp+2048); kf[3]=*(const __attribute__((address_space(3))) bf16x8*)(kp+2560);
  kf[4]=*(const __attribute__((address_space(3))) bf16x8*)(kp+4096); kf[5]=*(const __attribute__((address_space(3))) bf16x8*)(kp+4608);
  kf[6]=*(const __attribute__((address_space(3))) bf16x8*)(kp+6144); kf[7]=*(const __attribute__((address_space(3))) bf16x8*)(kp+6656);
}
__device__ __forceinline__ void kload2(bf16x8*kf,lds_cptr kp,int j){ kf[2*j]=*(const __attribute__((address_space(3))) bf16x8*)(kp+j*2048); kf[2*j+1]=*(const __attribute__((address_space(3))) bf16x8*)(kp+j*2048+512); }
__device__ __forceinline__ s16x4 vtr(lds_cptr p){ return __builtin_bit_cast(s16x4,__builtin_amdgcn_ds_read_tr16_b64_v4i16((__attribute__((address_space(3))) v4i16_t*)p)); }
__device__ __forceinline__ float rowmax(const f32x16&p0,const f32x16&p1){
  float a=max3f(p0[0],p0[1],p1[0]),b=max3f(p0[2],p0[3],p1[1]);a=max3f(a,p1[2],p1[3]);
  #pragma unroll
  for(int r=4;r<16;r+=4){a=max3f(a,p0[r],p0[r+1]);b=max3f(b,p0[r+2],p0[r+3]);a=max3f(a,p1[r],p1[r+1]);b=max3f(b,p1[r+2],p1[r+3]);}
  const float m=max2f(a,b);
  auto rr=__builtin_amdgcn_permlane32_swap(__float_as_uint(m),__float_as_uint(m),false,false);
  return max2f(__uint_as_float(rr[0]),__uint_as_float(rr[1]));
}
__device__ __forceinline__ void pv(f32x16*o,int vb,bf16x8 pa0,bf16x8 pa1,bf16x8 pa2,bf16x8 pa3){
  #pragma unroll
  for(int d0=0;d0<2;++d0){s16x4 lo[4],hi[4];
    #pragma unroll
    for(int ks=0;ks<4;++ks){
      asm volatile("ds_read_b64_tr_b16 %0,%1 offset:%c2":"=&v"(lo[ks]):"v"(vb),"i"(d0*4096+ks*1024):"memory");
      asm volatile("ds_read_b64_tr_b16 %0,%1 offset:%c2":"=&v"(hi[ks]):"v"(vb),"i"(d0*4096+ks*1024+512):"memory");}
    asm volatile("s_waitcnt lgkmcnt(0)":::"memory");SBAR();
    #define PK(k) (bf16x8){lo[k][0],lo[k][1],lo[k][2],lo[k][3],hi[k][0],hi[k][1],hi[k][2],hi[k][3]}
    o[d0]=__builtin_amdgcn_mfma_f32_32x32x16_bf16(pa0,PK(0),o[d0],0,0,0);
    o[d0]=__builtin_amdgcn_mfma_f32_32x32x16_bf16(pa1,PK(1),o[d0],0,0,0);
    o[d0]=__builtin_amdgcn_mfma_f32_32x32x16_bf16(pa2,PK(2),o[d0],0,0,0);
    o[d0]=__builtin_amdgcn_mfma_f32_32x32x16_bf16(pa3,PK(3),o[d0],0,0,0);
    #undef PK
  }
}

#ifndef ATTN_STORE16
#define ATTN_STORE16(p,v) (*(u32x4*)(p)=(v))
#endif
template<int THRL> __device__ __forceinline__ void attn_unit(const bf16*Q,int qp,int qrow0,int qc0,const bf16*__restrict__ K,int kp,int kc0,const bf16*__restrict__ V,int vp,int vc0,bf16*O,int oc0,int kctx0,int klat0,int NT,char*shm,int wave_id){
  wave_id=launder_s(wave_id); const int lane=lane_id_v(),r32=lane&31,hi=lane>>5; const int wid=wave_id;
  const bf16*Qw=Q+(long)(qrow0+wid*QBLK)*qp+qc0;
  const bf16*Kh=K+kc0,*Vh=V+vc0;
  const unsigned lds0=(unsigned)(uintptr_t)shm;
  float*wsf=(float*)(shm+LDS_WS)+wid*64;
  const bf16*ksrc=Kh+(long)lane*kp+wid*8;
  const bf16*vsrc=Vh+(long)(16*(wid&3)+(lane>>2))*vp+(wid>>2)*32+(lane&3)*8;
  #define TROW0(t) ((long)((t)<4?kctx0+64*(t):klat0+64*((t)-4)))
  const unsigned kdst=lds0+LDS_K+wid*1024, vdst=lds0+LDS_V+wid*1024;
  #define DMA_K(t,slot) glds16(ksrc+TROW0(t)*kp,(unsigned)__builtin_amdgcn_readfirstlane(kdst+(slot)))
  #define DMA_V(t,slot) glds16(vsrc+TROW0(t)*vp,(unsigned)__builtin_amdgcn_readfirstlane(vdst+(slot)))
  const int vb0=(int)(lds0+LDS_V)+((lane>>4)&1)*32+(lane&3)*8+(4*hi+((lane&15)>>2))*64;
  const char*Kbase=shm+LDS_K; bf16x8 kf[8];
  const lds_cptr shm3=(lds_cptr)shm; const lds_cptr kp0=shm3+LDS_K+hi*1024+r32*16; const lds_cptr vp0=shm3+LDS_V+((lane>>4)&1)*32+(lane&3)*8+(4*hi+((lane&15)>>2))*64;
  DMA_K(0,0);DMA_V(0,0);DMA_K(1,SLOTB);
  bf16x8 qr[4];
  #pragma unroll
  for(int d0=0;d0<4;++d0)qr[d0]=*reinterpret_cast<const bf16x8*>(&Qw[(long)r32*qp+d0*16+hi*8]);
  float mhat=0.f,l_reg=0.f;f32x16 o[2];o[0]=f32x16{};o[1]=f32x16{};f32x16 negm=f32x16{};asm volatile("":"+v"(negm));
  #define CMASK(P0,P1,t) do{}while(0)
  bool resc=false;
  #define START(P0,P1) do{ const float rm=rowmax(P0,P1); resc=false; \
    { const float dl=rm; mhat=fadd_s(mhat,dl); \
      _Pragma("unroll") for(int r=0;r<16;++r){P0[r]=fsub_s(P0[r],dl);P1[r]=fsub_s(P1[r],dl);} \
      _Pragma("unroll") for(int r=0;r<16;++r)negm[r]=-mhat; asm volatile("":"+v"(negm)); } \
    _Pragma("unroll") for(int r=0;r<16;++r)P0[r]=__builtin_amdgcn_exp2f(P0[r]); }while(0)
  #define RESC() do{ if(resc){ asm volatile("s_waitcnt lgkmcnt(0)":::"memory"); \
      _Pragma("unroll") for(int d_=0;d_<2;++d_) _Pragma("unroll") for(int r=0;r<16;++r)o[d_][r]*=wsf[crow(r,hi)]; } }while(0)
  f32x16 pA0,pA1,pB0,pB1;
  int sl_prev=0,sl_cur=0,sl_next=SLOTB;
  #define ROT() do{sl_prev=sl_cur;sl_cur=sl_next;sl_next=(sl_next==(NSLOT-1)*SLOTB)?0:sl_next+SLOTB;}while(0)
  DMA_K(2,2*SLOTB);
  WAIT_BAR(3);
  qkt(pA0,pA1,Kbase,qr,negm,r32,hi);asm volatile("s_nop 15\n\ts_nop 7":"+v"(pA0),"+v"(pA1));CMASK(pA0,pA1,0);
  START(pA0,pA1);
  _Pragma("unroll") for(int r=0;r<16;++r)pA1[r]=__builtin_amdgcn_exp2f(pA1[r]);
  WAIT_BAR(0);
  DMA_K(3,0);DMA_V(1,SLOTB);
  ROT();
  kload8(kf,kp0+sl_cur);
  WAIT_BAR(2);
  s16x4 vlo[8],vhi[8]; u32x4 pw0,pw1,pw2,pw3;
  #define PKW(P,B) cvtpk_s(P[B],P[B+1])
  #define PAF(k) __builtin_bit_cast(bf16x8,pw##k)
  #define VFR(i) (bf16x8){vlo[i][0],vlo[i][1],vlo[i][2],vlo[i][3],vhi[i][0],vhi[i][1],vhi[i][2],vhi[i][3]}
  #define PIN(x) asm volatile("":"+v"(x))
  #define MX3(a,b,c) __builtin_fmaxf(__builtin_fmaxf((a),(b)),(c))
  #define GAPA(MF,A0,A1,A2,A3,W0,W1,PW) do{ MF; sacc+=A0; sacc+=A1; sacc+=A2; sacc+=A3; PIN(sacc); W0; W1; PIN(PW); SBAR(); }while(0)
  #define EX(v) __builtin_amdgcn_exp2f(v)
  #define GAPB(MF,X,B) do{ MF; X[B]=EX(X[B]); X[B+1]=EX(X[B+1]); X[B+2]=EX(X[B+2]); X[B+3]=EX(X[B+3]); PIN(X); SBAR(); }while(0)
  #define VRD(i) do{ vlo[i]=vtr(vp_+(((i)>>2)*4096+((i)&3)*1024)); vhi[i]=vtr(vp_+(((i)>>2)*4096+((i)&3)*1024+512)); }while(0)
  #define KRD(G,j) do{ if(G){ kload2(kf,kp0+sl_next,j); SBAR(); } }while(0)
  #define STEP(C0,C1,P0,P1,t,GK,GV,GL) do{ SBAR(); \
    const lds_cptr vp_=vp0+sl_prev; \
    VRD(0); SBAR(); float sacc=(P0[0]+P0[1]); \
    GAPA(C0=__builtin_amdgcn_mfma_f32_32x32x16_bf16(kf[0],qr[0],negm,0,0,0), P0[2],P0[3],P0[4],P0[5],     pw0[0]=PKW(P0,0), pw0[1]=PKW(P0,2), pw0); \
    VRD(4); SBAR(); GAPA(C1=__builtin_amdgcn_mfma_f32_32x32x16_bf16(kf[1],qr[0],negm,0,0,0), P0[6],P0[7],P0[8],P0[9],     pw0[2]=PKW(P0,4), pw0[3]=PKW(P0,6), pw0); \
    VRD(1); SBAR(); GAPA(C0=__builtin_amdgcn_mfma_f32_32x32x16_bf16(kf[2],qr[1],C0,0,0,0),   P0[10],P0[11],P0[12],P0[13], pw1[0]=PKW(P0,8), pw1[1]=PKW(P0,10), pw1); \
    VRD(5); SBAR(); GAPA(C1=__builtin_amdgcn_mfma_f32_32x32x16_bf16(kf[3],qr[1],C1,0,0,0),   P0[14],P0[15],P1[0],P1[1],   pw1[2]=PKW(P0,12),pw1[3]=PKW(P0,14), pw1); \
    VRD(2); SBAR(); GAPA(C0=__builtin_amdgcn_mfma_f32_32x32x16_bf16(kf[4],qr[2],C0,0,0,0),   P1[2],P1[3],P1[4],P1[5],     pw2[0]=PKW(P1,0), pw2[1]=PKW(P1,2), pw2); \
    VRD(6); SBAR(); GAPA(C1=__builtin_amdgcn_mfma_f32_32x32x16_bf16(kf[5],qr[2],C1,0,0,0),   P1[6],P1[7],P1[8],P1[9],     pw2[2]=PKW(P1,4), pw2[3]=PKW(P1,6), pw2); \
    VRD(3); SBAR(); GAPA(C0=__builtin_amdgcn_mfma_f32_32x32x16_bf16(kf[6],qr[3],C0,0,0,0),   P1[10],P1[11],P1[12],P1[13], pw3[0]=PKW(P1,8), pw3[1]=PKW(P1,10), pw3); \
    VRD(7); SBAR(); GAPA(C1=__builtin_amdgcn_mfma_f32_32x32x16_bf16(kf[7],qr[3],C1,0,0,0),   P1[14],P1[15],0.f,0.f,       pw3[2]=PKW(P1,12),pw3[3]=PKW(P1,14), pw3); \
    l_reg+=sacc; \
    if(GK){DMA_K((t)+3,sl_cur);} if(GV){DMA_V((t)+1,sl_next);} \
    CMASK(C0,C1,t); \
    { float a=MX3(C0[0],C0[1],C1[0]),b=MX3(C0[2],C0[3],C1[1]); a=MX3(a,C1[2],C1[3]); \
      _Pragma("unroll") for(int r=4;r<16;r+=4){a=MX3(a,C0[r],C0[r+1]);b=MX3(b,C0[r+2],C0[r+3]);a=MX3(a,C1[r],C1[r+1]);b=MX3(b,C1[r+2],C1[r+3]);} \
      float rm=__builtin_fmaxf(a,b); { auto rr=__builtin_amdgcn_permlane32_swap(__float_as_uint(rm),__float_as_uint(rm),false,false); rm=__builtin_fmaxf(__uint_as_float(rr[0]),__uint_as_float(rr[1])); } \
      resc=false; \
      if(__builtin_expect(__any(rm>(float)THRL),0)){ const float dl=__builtin_fmaxf(rm,0.f); mhat+=dl; \
        _Pragma("unroll") for(int r=0;r<16;++r){C0[r]-=dl;C1[r]-=dl;} \
        _Pragma("unroll") for(int r=0;r<16;++r)negm[r]=-mhat; asm volatile("":"+v"(negm)); \
        const float f=__builtin_amdgcn_exp2f(-dl); l_reg*=f; if(hi==0)wsf[r32]=f; resc=true; } } \
    SBAR(); \
    GAPB(o[0]=__builtin_amdgcn_mfma_f32_32x32x16_bf16(PAF(0),VFR(0),o[0],0,0,0), C0,0); \
    GAPB(o[1]=__builtin_amdgcn_mfma_f32_32x32x16_bf16(PAF(0),VFR(4),o[1],0,0,0), C0,4); \
    KRD(GL,0); GAPB(o[0]=__builtin_amdgcn_mfma_f32_32x32x16_bf16(PAF(1),VFR(1),o[0],0,0,0), C0,8); \
    KRD(GL,1); GAPB(o[1]=__builtin_amdgcn_mfma_f32_32x32x16_bf16(PAF(1),VFR(5),o[1],0,0,0), C0,12); \
    KRD(GL,2); GAPB(o[0]=__builtin_amdgcn_mfma_f32_32x32x16_bf16(PAF(2),VFR(2),o[0],0,0,0), C1,0); \
    KRD(GL,3); GAPB(o[1]=__builtin_amdgcn_mfma_f32_32x32x16_bf16(PAF(2),VFR(6),o[1],0,0,0), C1,4); \
    GAPB(o[0]=__builtin_amdgcn_mfma_f32_32x32x16_bf16(PAF(3),VFR(3),o[0],0,0,0), C1,8); \
    GAPB(o[1]=__builtin_amdgcn_mfma_f32_32x32x16_bf16(PAF(3),VFR(7),o[1],0,0,0), C1,12); \
    }while(0)
  int t=1;
  for(;t+5<NT;t+=2){
    STEP(pB0,pB1,pA0,pA1,t,true,true,true);     WAIT_BAR(2); RESC(); ROT();
    STEP(pA0,pA1,pB0,pB1,t+1,true,true,true);   WAIT_BAR(2); RESC(); ROT();
  }
  #define ENDW(tt) do{ if((tt)+3<NT){WAIT_BAR(2);} else if((tt)+2<NT){WAIT_BAR(1);} else {WAIT_BAR(0);} }while(0)
  for(;t+1<NT;t+=2){
    STEP(pB0,pB1,pA0,pA1,t,(t+3<NT),(t+1<NT),(t+1<NT));       ENDW(t);   RESC(); ROT();
    STEP(pA0,pA1,pB0,pB1,t+1,(t+4<NT),(t+2<NT),(t+2<NT));     ENDW(t+1); RESC(); ROT();
  }
  STEP(pB0,pB1,pA0,pA1,NT-1,false,false,false); RESC();
  { float sacc=pB0[0]+pB0[1]; _Pragma("unroll") for(int r=2;r<16;++r)sacc+=pB0[r]; _Pragma("unroll") for(int r=0;r<16;++r)sacc+=pB1[r]; l_reg+=sacc;
    pw0=(u32x4){PKW(pB0,0),PKW(pB0,2),PKW(pB0,4),PKW(pB0,6)};pw1=(u32x4){PKW(pB0,8),PKW(pB0,10),PKW(pB0,12),PKW(pB0,14)};pw2=(u32x4){PKW(pB1,0),PKW(pB1,2),PKW(pB1,4),PKW(pB1,6)};pw3=(u32x4){PKW(pB1,8),PKW(pB1,10),PKW(pB1,12),PKW(pB1,14)};
    SBAR(); pv(o,vb0+sl_cur,PAF(0),PAF(1),PAF(2),PAF(3)); }
  #undef PKW
  #undef PAF
  #undef VFR
  #undef PIN
  #undef MX3
  #undef GAPA
  #undef GAPB
  #undef EX
  #undef VRD
  #undef KRD
  #undef STEP
  #undef ENDW
  {auto rr=__builtin_amdgcn_permlane32_swap(__float_as_uint(l_reg),__float_as_uint(l_reg),false,false);l_reg=__uint_as_float(rr[0])+__uint_as_float(rr[1]);}
  if(hi==0)wsf[32+r32]=l_reg;asm volatile("s_waitcnt lgkmcnt(0)":::"memory");
  float rli[16];
  #pragma unroll
  for(int r=0;r<16;++r)rli[r]=__builtin_amdgcn_rcpf(wsf[32+crow(r,hi)]);
  unsigned char*Ow=(unsigned char*)O+(long)(qrow0+wid*QBLK)*1024+oc0;
  { bf16*stg=(bf16*)(shm+LDS_OST)+wid*2048;
    #pragma unroll
    for(int r=0;r<16;++r){const int orow=crow(r,hi);
      #pragma unroll
      for(int d0=0;d0<2;++d0)stg[orow*64+d0*32+r32]=(bf16)(cvtpk_s(o[d0][r]*rli[r],0.f)&0xffffu);}
    asm volatile("s_waitcnt lgkmcnt(0)":::"memory");
    #pragma unroll
    for(int i=0;i<4;++i){const int row=i*8+(lane>>3),ch=lane&7; const u32x4 v=*(const u32x4*)(stg+row*64+ch*8);
      *(v2u*)(Ow+(long)row*1024+ch*8)=pack8_fp8((f32x4){bf_lo(v.x),bf_hi(v.x),bf_lo(v.y),bf_hi(v.y)},(f32x4){bf_lo(v.z),bf_hi(v.z),bf_lo(v[3]),bf_hi(v[3])});} }
  asm volatile("s_waitcnt lgkmcnt(0)\n\ts_barrier":::"memory");
  #undef DMA_K
  #undef DMA_V
  #undef TROW0
  #undef CMASK
  #undef START
  #undef RESC
  #undef ROT
}
#undef SBAR
#undef WAIT_BAR
}

namespace att96 {
typedef unsigned short bf16;
using bf16x8=__attribute__((ext_vector_type(8)))short;
using s16x4=__attribute__((ext_vector_type(4)))short;
using f32x16=__attribute__((ext_vector_type(16)))float;
using u32x4=__attribute__((ext_vector_type(4)))unsigned;
constexpr int D=64;
constexpr int NW=8,QBLK=32,QB=QBLK*NW,KVBLK=64;
__device__ __forceinline__ int crow(int r,int hi){return (r&3)+8*(r>>2)+4*hi;}
#define SBAR() __builtin_amdgcn_sched_barrier(0)
constexpr int NSLOT=3, SLOTB=8192, KSLOTB=12288;
#define KOFF(sl) ((sl)+((sl)>>1))
constexpr int LDS_K=0, LDS_V=NSLOT*KSLOTB, LDS_WS=LDS_V+NSLOT*SLOTB, LDS_OST=LDS_WS+NW*64*4, LDS_BYTES=LDS_OST+NW*4096;
constexpr float C2=0.125f*1.4426950408889634f;
__device__ __forceinline__ void glds16(const void*gsrc,unsigned lds_dst){unsigned keep;
  asm volatile("s_mov_b32 %0, m0\n\ts_mov_b32 m0, %2\n\ts_nop 0\n\tglobal_load_lds_dwordx4 %1, off\n\ts_mov_b32 m0, %0":"=&s"(keep):"v"(gsrc),"s"(lds_dst):"memory");}
__device__ __forceinline__ float max3f(float a,float b,float c){float r;asm("v_max3_f32 %0, %1, %2, %3":"=v"(r):"v"(a),"v"(b),"v"(c));return r;}
__device__ __forceinline__ float max2f(float a,float b){float r;asm("v_max_f32_e32 %0, %1, %2":"=v"(r):"v"(a),"v"(b));return r;}
__device__ __forceinline__ float fadd_s(float a,float b){float r;asm("v_add_f32_e32 %0, %1, %2":"=v"(r):"v"(a),"v"(b));return r;}
__device__ __forceinline__ float fsub_s(float a,float b){float r;asm("v_sub_f32_e32 %0, %1, %2":"=v"(r):"v"(a),"v"(b));return r;}
typedef float f32x2_t __attribute__((ext_vector_type(2))); typedef __bf16 bf16x2_t __attribute__((ext_vector_type(2)));
__device__ __forceinline__ unsigned cvtpk_s(float lo,float hi){f32x2_t v={lo,hi};bf16x2_t b=__builtin_convertvector(v,bf16x2_t);return __builtin_bit_cast(unsigned,b);}
#define WAIT_BAR(N) asm volatile("s_waitcnt vmcnt(" #N ") lgkmcnt(0)\n\ts_barrier":::"memory")

__device__ __forceinline__ void qkt(f32x16&p0,f32x16&p1,const char*Kslot,const bf16x8*qr,const f32x16&negm,int r32,int hi){
  const char*kb=Kslot+hi*1024+r32*16;
  #pragma unroll
  for(int d0=0;d0<6;++d0){
    const bf16x8 b0=*reinterpret_cast<const bf16x8*>(kb+d0*2048);
    const bf16x8 b1=*reinterpret_cast<const bf16x8*>(kb+d0*2048+512);
    if(d0==0){p0=__builtin_amdgcn_mfma_f32_32x32x16_bf16(b0,qr[0],negm,0,0,0);p1=__builtin_amdgcn_mfma_f32_32x32x16_bf16(b1,qr[0],negm,0,0,0);}
    else{p0=__builtin_amdgcn_mfma_f32_32x32x16_bf16(b0,qr[d0],p0,0,0,0);p1=__builtin_amdgcn_mfma_f32_32x32x16_bf16(b1,qr[d0],p1,0,0,0);}}
}
typedef __attribute__((address_space(3))) const char* lds_cptr;
typedef short v4i16_t __attribute__((ext_vector_type(4)));
__device__ __forceinline__ void kload8(bf16x8*kf,lds_cptr kp){
  kf[0]=*(const __attribute__((address_space(3))) bf16x8*)(kp);      kf[1]=*(const __attribute__((address_space(3))) bf16x8*)(kp+512);
  kf[2]=*(const __attribute__((address_space(3))) bf16x8*)(kp+2048); kf[3]=*(const __attribute__((address_space(3))) bf16x8*)(kp+2560);
  kf[4]=*(const __attribute__((address_space(3))) bf16x8*)(kp+4096); kf[5]=*(const __attribute__((address_space(3))) bf16x8*)(kp+4608);
  kf[6]=*(const __attribute__((address_space(3))) bf16x8*)(kp+6144); kf[7]=*(const __attribute__((address_space(3))) bf16x8*)(kp+6656);
  kf[8]=*(const __attribute__((address_space(3))) bf16x8*)(kp+8192); kf[9]=*(const __attribute__((address_space(3))) bf16x8*)(kp+8704);
  kf[10]=*(const __attribute__((address_space(3))) bf16x8*)(kp+10240); kf[11]=*(const __attribute__((address_space(3))) bf16x8*)(kp+10752);
}
__device__ __forceinline__ void kload2(bf16x8*kf,lds_cptr kp,int j){ kf[2*j]=*(const __attribute__((address_space(3))) bf16x8*)(kp+j*2048); kf[2*j+1]=*(const __attribute__((address_space(3))) bf16x8*)(kp+j*2048+512); }
__device__ __forceinline__ s16x4 vtr(lds_cptr p){ return __builtin_bit_cast(s16x4,__builtin_amdgcn_ds_read_tr16_b64_v4i16((__attribute__((address_space(3))) v4i16_t*)p)); }
__device__ __forceinline__ float rowmax(const f32x16&p0,const f32x16&p1){
  float a=max3f(p0[0],p0[1],p1[0]),b=max3f(p0[2],p0[3],p1[1]);a=max3f(a,p1[2],p1[3]);
  #pragma unroll
  for(int r=4;r<16;r+=4){a=max3f(a,p0[r],p0[r+1]);b=max3f(b,p0[r+2],p0[r+3]);a=max3f(a,p1[r],p1[r+1]);b=max3f(b,p1[r+2],p1[r+3]);}
  const float m=max2f(a,b);
  auto rr=__builtin_amdgcn_permlane32_swap(__float_as_uint(m),__float_as_uint(m),false,false);
  return max2f(__uint_as_float(rr[0]),__uint_as_float(rr[1]));
}
__device__ __forceinline__ void pv(f32x16*o,int vb,bf16x8 pa0,bf16x8 pa1,bf16x8 pa2,bf16x8 pa3){
  #pragma unroll
  for(int d0=0;d0<2;++d0){s16x4 lo[4],hi[4];
    #pragma unroll
    for(int ks=0;ks<4;++ks){
      asm volatile("ds_read_b64_tr_b16 %0,%1 offset:%c2":"=&v"(lo[ks]):"v"(vb),"i"(d0*4096+ks*1024):"memory");
      asm volatile("ds_read_b64_tr_b16 %0,%1 offset:%c2":"=&v"(hi[ks]):"v"(vb),"i"(d0*4096+ks*1024+512):"memory");}
    asm volatile("s_waitcnt lgkmcnt(0)":::"memory");SBAR();
    #define PK(k) (bf16x8){lo[k][0],lo[k][1],lo[k][2],lo[k][3],hi[k][0],hi[k][1],hi[k][2],hi[k][3]}
    o[d0]=__builtin_amdgcn_mfma_f32_32x32x16_bf16(pa0,PK(0),o[d0],0,0,0);
    o[d0]=__builtin_amdgcn_mfma_f32_32x32x16_bf16(pa1,PK(1),o[d0],0,0,0);
    o[d0]=__builtin_amdgcn_mfma_f32_32x32x16_bf16(pa2,PK(2),o[d0],0,0,0);
    o[d0]=__builtin_amdgcn_mfma_f32_32x32x16_bf16(pa3,PK(3),o[d0],0,0,0);
    #undef PK
  }
}

#ifndef ATTN_STORE16
#define ATTN_STORE16(p,v) (*(u32x4*)(p)=(v))
#endif
template<int THRL> __device__ __forceinline__ void attn_unit(const bf16*Q,int qp,int qrow0,int qc0,const bf16*__restrict__ K,int kp,int kc0,const bf16*__restrict__ V,int vp,int vc0,bf16*O,int oc0,int kctx0,int klat0,int NT,char*shm,int wave_id){
  wave_id=launder_s(wave_id); const int lane=lane_id_v(),r32=lane&31,hi=lane>>5; const int wid=wave_id;
  const bf16*Qw=Q+(long)(qrow0+wid*QBLK)*qp+qc0;
  const bf16*Kh=K+kc0,*Vh=V+vc0;
  const unsigned lds0=(unsigned)(uintptr_t)shm;
  float*wsf=(float*)(shm+LDS_WS)+wid*64;
  const bf16*ksrc=Kh+(long)lane*kp+wid*8;
  const bf16*vsrc=Vh+(long)(16*(wid&3)+(lane>>2))*vp+(wid>>2)*32+(lane&3)*8;
  #define TROW0(t) ((long)((t)<4?kctx0+64*(t):klat0+64*((t)-4)))
  const unsigned kdst=lds0+LDS_K+wid*1024, kdst2=lds0+LDS_K+8192+(wid&3)*1024, vdst=lds0+LDS_V+wid*1024;
  const int k2off=(8+(wid&3)-wid)*8;
  #define DMA_K(t,slot) do{ glds16(ksrc+TROW0(t)*kp,(unsigned)__builtin_amdgcn_readfirstlane(kdst+KOFF(slot))); glds16(ksrc+TROW0(t)*kp+k2off,(unsigned)__builtin_amdgcn_readfirstlane(kdst2+KOFF(slot))); }while(0)
  #define DMA_V(t,slot) glds16(vsrc+TROW0(t)*vp,(unsigned)__builtin_amdgcn_readfirstlane(vdst+(slot)))
  const int vb0=(int)(lds0+LDS_V)+((lane>>4)&1)*32+(lane&3)*8+(4*hi+((lane&15)>>2))*64;
  const char*Kbase=shm+LDS_K; bf16x8 kf[12];
  const lds_cptr shm3=(lds_cptr)shm; const lds_cptr kp0=shm3+LDS_K+hi*1024+r32*16; const lds_cptr vp0=shm3+LDS_V+((lane>>4)&1)*32+(lane&3)*8+(4*hi+((lane&15)>>2))*64;
  DMA_K(0,0);DMA_V(0,0);DMA_K(1,SLOTB);
  bf16x8 qr[6];
  #pragma unroll
  for(int d0=0;d0<6;++d0)qr[d0]=*reinterpret_cast<const bf16x8*>(&Qw[(long)r32*qp+d0*16+hi*8]);
  float mhat=0.f,l_reg=0.f;f32x16 o[2];o[0]=f32x16{};o[1]=f32x16{};f32x16 negm=f32x16{};asm volatile("":"+v"(negm));
  #define CMASK(P0,P1,t) do{}while(0)
  bool resc=false;
  #define START(P0,P1) do{ const float rm=rowmax(P0,P1); resc=false; \
    { const float dl=rm; mhat=fadd_s(mhat,dl); \
      _Pragma("unroll") for(int r=0;r<16;++r){P0[r]=fsub_s(P0[r],dl);P1[r]=fsub_s(P1[r],dl);} \
      _Pragma("unroll") for(int r=0;r<16;++r)negm[r]=-mhat; asm volatile("":"+v"(negm)); } \
    _Pragma("unroll") for(int r=0;r<16;++r)P0[r]=__builtin_amdgcn_exp2f(P0[r]); }while(0)
  #define RESC() do{ if(resc){ asm volatile("s_waitcnt lgkmcnt(0)":::"memory"); \
      _Pragma("unroll") for(int d_=0;d_<2;++d_) _Pragma("unroll") for(int r=0;r<16;++r)o[d_][r]*=wsf[crow(r,hi)]; } }while(0)
  f32x16 pA0,pA1,pB0,pB1;
  int sl_prev=0,sl_cur=0,sl_next=SLOTB;
  #define ROT() do{sl_prev=sl_cur;sl_cur=sl_next;sl_next=(sl_next==(NSLOT-1)*SLOTB)?0:sl_next+SLOTB;}while(0)
  DMA_K(2,2*SLOTB);
  WAIT_BAR(5);
  qkt(pA0,pA1,Kbase,qr,negm,r32,hi);asm volatile("s_nop 15\n\ts_nop 7":"+v"(pA0),"+v"(pA1));CMASK(pA0,pA1,0);
  START(pA0,pA1);
  _Pragma("unroll") for(int r=0;r<16;++r)pA1[r]=__builtin_amdgcn_exp2f(pA1[r]);
  WAIT_BAR(0);
  DMA_K(3,0);DMA_V(1,SLOTB);
  ROT();
  kload8(kf,kp0+KOFF(sl_cur));
  WAIT_BAR(3);
  s16x4 vlo[8],vhi[8]; u32x4 pw0,pw1,pw2,pw3;
  #define PKW(P,B) cvtpk_s(P[B],P[B+1])
  #define PAF(k) __builtin_bit_cast(bf16x8,pw##k)
  #define VFR(i) (bf16x8){vlo[i][0],vlo[i][1],vlo[i][2],vlo[i][3],vhi[i][0],vhi[i][1],vhi[i][2],vhi[i][3]}
  #define PIN(x) asm volatile("":"+v"(x))
  #define MX3(a,b,c) __builtin_fmaxf(__builtin_fmaxf((a),(b)),(c))
  #define GAPA(MF,A0,A1,A2,A3,W0,W1,PW) do{ MF; sacc+=A0; sacc+=A1; sacc+=A2; sacc+=A3; PIN(sacc); W0; W1; PIN(PW); SBAR(); }while(0)
  #define EX(v) __builtin_amdgcn_exp2f(v)
  #define GAPB(MF,X,B) do{ MF; X[B]=EX(X[B]); X[B+1]=EX(X[B+1]); X[B+2]=EX(X[B+2]); X[B+3]=EX(X[B+3]); PIN(X); SBAR(); }while(0)
  #define VRD(i) do{ vlo[i]=vtr(vp_+(((i)>>2)*4096+((i)&3)*1024)); vhi[i]=vtr(vp_+(((i)>>2)*4096+((i)&3)*1024+512)); }while(0)
  #define KRD(G,j) do{ if(G){ kload2(kf,kp0+KOFF(sl_next),j); SBAR(); } }while(0)
  #define STEP(C0,C1,P0,P1,t,GK,GV,GL) do{ SBAR(); \
    const lds_cptr vp_=vp0+sl_prev; \
    VRD(0); SBAR(); float sacc=(P0[0]+P0[1]); \
    GAPA(C0=__builtin_amdgcn_mfma_f32_32x32x16_bf16(kf[0],qr[0],negm,0,0,0), P0[2],P0[3],P0[4],P0[5],     pw0[0]=PKW(P0,0), pw0[1]=PKW(P0,2), pw0); \
    VRD(4); SBAR(); GAPA(C1=__builtin_amdgcn_mfma_f32_32x32x16_bf16(kf[1],qr[0],negm,0,0,0), P0[6],P0[7],P0[8],P0[9],     pw0[2]=PKW(P0,4), pw0[3]=PKW(P0,6), pw0); \
    VRD(1); SBAR(); GAPA(C0=__builtin_amdgcn_mfma_f32_32x32x16_bf16(kf[2],qr[1],C0,0,0,0),   P0[10],P0[11],P0[12],P0[13], pw1[0]=PKW(P0,8), pw1[1]=PKW(P0,10), pw1); \
    VRD(5); SBAR(); GAPA(C1=__builtin_amdgcn_mfma_f32_32x32x16_bf16(kf[3],qr[1],C1,0,0,0),   P0[14],P0[15],P1[0],P1[1],   pw1[2]=PKW(P0,12),pw1[3]=PKW(P0,14), pw1); \
    VRD(2); SBAR(); GAPA(C0=__builtin_amdgcn_mfma_f32_32x32x16_bf16(kf[4],qr[2],C0,0,0,0),   P1[2],P1[3],P1[4],P1[5],     pw2[0]=PKW(P1,0), pw2[1]=PKW(P1,2), pw2); \
    VRD(6); SBAR(); GAPA(C1=__builtin_amdgcn_mfma_f32_32x32x16_bf16(kf[5],qr[2],C1,0,0,0),   P1[6],P1[7],P1[8],P1[9],     pw2[2]=PKW(P1,4), pw2[3]=PKW(P1,6), pw2); \
    VRD(3); SBAR(); GAPA(C0=__builtin_amdgcn_mfma_f32_32x32x16_bf16(kf[6],qr[3],C0,0,0,0),   P1[10],P1[11],P1[12],P1[13], pw3[0]=PKW(P1,8), pw3[1]=PKW(P1,10), pw3); \
    VRD(7); SBAR(); GAPA(C1=__builtin_amdgcn_mfma_f32_32x32x16_bf16(kf[7],qr[3],C1,0,0,0),   P1[14],P1[15],0.f,0.f,       pw3[2]=PKW(P1,12),pw3[3]=PKW(P1,14), pw3); \
    C0=__builtin_amdgcn_mfma_f32_32x32x16_bf16(kf[8],qr[4],C0,0,0,0); C1=__builtin_amdgcn_mfma_f32_32x32x16_bf16(kf[9],qr[4],C1,0,0,0); C0=__builtin_amdgcn_mfma_f32_32x32x16_bf16(kf[10],qr[5],C0,0,0,0); C1=__builtin_amdgcn_mfma_f32_32x32x16_bf16(kf[11],qr[5],C1,0,0,0); SBAR(); \
    l_reg+=sacc; \
    if(GK){DMA_K((t)+3,sl_cur);} if(GV){DMA_V((t)+1,sl_next);} \
    CMASK(C0,C1,t); \
    { float a=MX3(C0[0],C0[1],C1[0]),b=MX3(C0[2],C0[3],C1[1]); a=MX3(a,C1[2],C1[3]); \
      _Pragma("unroll") for(int r=4;r<16;r+=4){a=MX3(a,C0[r],C0[r+1]);b=MX3(b,C0[r+2],C0[r+3]);a=MX3(a,C1[r],C1[r+1]);b=MX3(b,C1[r+2],C1[r+3]);} \
      float rm=__builtin_fmaxf(a,b); { auto rr=__builtin_amdgcn_permlane32_swap(__float_as_uint(rm),__float_as_uint(rm),false,false); rm=__builtin_fmaxf(__uint_as_float(rr[0]),__uint_as_float(rr[1])); } \
      resc=false; \
      if(__builtin_expect(__any(rm>(float)THRL),0)){ const float dl=__builtin_fmaxf(rm,0.f); mhat+=dl; \
        _Pragma("unroll") for(int r=0;r<16;++r){C0[r]-=dl;C1[r]-=dl;} \
        _Pragma("unroll") for(int r=0;r<16;++r)negm[r]=-mhat; asm volatile("":"+v"(negm)); \
        const float f=__builtin_amdgcn_exp2f(-dl); l_reg*=f; if(hi==0)wsf[r32]=f; resc=true; } } \
    SBAR(); \
    GAPB(o[0]=__builtin_amdgcn_mfma_f32_32x32x16_bf16(PAF(0),VFR(0),o[0],0,0,0), C0,0); \
    GAPB(o[1]=__builtin_amdgcn_mfma_f32_32x32x16_bf16(PAF(0),VFR(4),o[1],0,0,0), C0,4); \
    KRD(GL,0); GAPB(o[0]=__builtin_amdgcn_mfma_f32_32x32x16_bf16(PAF(1),VFR(1),o[0],0,0,0), C0,8); \
    KRD(GL,1); GAPB(o[1]=__builtin_amdgcn_mfma_f32_32x32x16_bf16(PAF(1),VFR(5),o[1],0,0,0), C0,12); \
    KRD(GL,2); GAPB(o[0]=__builtin_amdgcn_mfma_f32_32x32x16_bf16(PAF(2),VFR(2),o[0],0,0,0), C1,0); \
    KRD(GL,3); GAPB(o[1]=__builtin_amdgcn_mfma_f32_32x32x16_bf16(PAF(2),VFR(6),o[1],0,0,0), C1,4); \
    KRD(GL,4); GAPB(o[0]=__builtin_amdgcn_mfma_f32_32x32x16_bf16(PAF(3),VFR(3),o[0],0,0,0), C1,8); \
    KRD(GL,5); GAPB(o[1]=__builtin_amdgcn_mfma_f32_32x32x16_bf16(PAF(3),VFR(7),o[1],0,0,0), C1,12); \
    }while(0)
  int t=1;
  for(;t+5<NT;t+=2){
    STEP(pB0,pB1,pA0,pA1,t,true,true,true);     WAIT_BAR(3); RESC(); ROT();
    STEP(pA0,pA1,pB0,pB1,t+1,true,true,true);   WAIT_BAR(3); RESC(); ROT();
  }
  #define ENDW(tt) do{ if((tt)+3<NT){WAIT_BAR(3);} else if((tt)+2<NT){WAIT_BAR(1);} else {WAIT_BAR(0);} }while(0)
  for(;t+1<NT;t+=2){
    STEP(pB0,pB1,pA0,pA1,t,(t+3<NT),(t+1<NT),(t+1<NT));       ENDW(t);   RESC(); ROT();
    STEP(pA0,pA1,pB0,pB1,t+1,(t+4<NT),(t+2<NT),(t+2<NT));     ENDW(t+1); RESC(); ROT();
  }
  STEP(pB0,pB1,pA0,pA1,NT-1,false,false,false); RESC();
  { float sacc=pB0[0]+pB0[1]; _Pragma("unroll") for(int r=2;r<16;++r)sacc+=pB0[r]; _Pragma("unroll") for(int r=0;r<16;++r)sacc+=pB1[r]; l_reg+=sacc;
    pw0=(u32x4){PKW(pB0,0),PKW(pB0,2),PKW(pB0,4),PKW(pB0,6)};pw1=(u32x4){PKW(pB0,8),PKW(pB0,10),PKW(pB0,12),PKW(pB0,14)};pw2=(u32x4){PKW(pB1,0),PKW(pB1,2),PKW(pB1,4),PKW(pB1,6)};pw3=(u32x4){PKW(pB1,8),PKW(pB1,10),PKW(pB1,12),PKW(pB1,14)};
    SBAR(); pv(o,vb0+sl_cur,PAF(0),PAF(1),PAF(2),PAF(3)); }
  #undef PKW
  #undef PAF
  #undef VFR
  #undef PIN
  #undef MX3
  #undef GAPA
  #undef GAPB
  #undef EX
  #undef VRD
  #undef KRD
  #undef STEP
  #undef ENDW
  {auto rr=__builtin_amdgcn_permlane32_swap(__float_as_uint(l_reg),__float_as_uint(l_reg),false,false);l_reg=__uint_as_float(rr[0])+__uint_as_float(rr[1]);}
  if(hi==0)wsf[32+r32]=l_reg;asm volatile("s_waitcnt lgkmcnt(0)":::"memory");
  float rli[16];
  #pragma unroll
  for(int r=0;r<16;++r)rli[r]=__builtin_amdgcn_rcpf(wsf[32+crow(r,hi)]);
  unsigned char*Ow=(unsigned char*)O+(long)(qrow0+wid*QBLK)*1024+oc0;
  { bf16*stg=(bf16*)(shm+LDS_OST)+wid*2048;
    #pragma unroll
    for(int r=0;r<16;++r){const int orow=crow(r,hi);
      #pragma unroll
      for(int d0=0;d0<2;++d0)stg[orow*64+d0*32+r32]=(bf16)(cvtpk_s(o[d0][r]*rli[r],0.f)&0xffffu);}
    asm volatile("s_waitcnt lgkmcnt(0)":::"memory");
    #pragma unroll
    for(int i=0;i<4;++i){const int row=i*8+(lane>>3),ch=lane&7; const u32x4 v=*(const u32x4*)(stg+row*64+ch*8);
      *(v2u*)(Ow+(long)row*1024+ch*8)=pack8_fp8((f32x4){bf_lo(v.x),bf_hi(v.x),bf_lo(v.y),bf_hi(v.y)},(f32x4){bf_lo(v.z),bf_hi(v.z),bf_lo(v[3]),bf_hi(v[3])});} }
  asm volatile("s_waitcnt lgkmcnt(0)\n\ts_barrier":::"memory");
  #undef DMA_K
  #undef DMA_V
  #undef TROW0
  #undef CMASK
  #undef START
  #undef RESC
  #undef ROT
}
#undef SBAR
#undef WAIT_BAR
#undef KOFF
}

struct Args { const float* in[27]; float* out; unsigned char* ws; int ph_lo, ph_hi; };
struct Frame {
    LAS unsigned char* lds; unsigned char* ws; gu32* ctl; int wave, G, gw, NGW;
};
__device__ __forceinline__ int lthread(int wave) { return wave * 64 + lane_id_v(); }

template <int MODE>
__device__ __forceinline__ void conv_item(const float* W, int K, int N, bf16* WT, LAS float* scr, int item, int lane) {
    const int nblk = (N + 63) / 64, kb = item / nblk, nb = item % nblk, k0 = 64 * kb, n0 = 64 * nb;
    f32x4 v[16];
    const int cc = (lane & 15) * 4, rk = lane >> 4;
    const bool ok = (n0 + cc) < N;
#pragma unroll
    for (int i = 0; i < 16; ++i) v[i] = ok ? *(const f32x4*)(W + (size_t)(k0 + 4 * i + rk) * N + n0 + cc) : (f32x4){0.f, 0.f, 0.f, 0.f};
#pragma unroll
    for (int i = 0; i < 16; ++i) { LAS float* s = scr + (4 * i + rk) * 65 + cc; s[0] = v[i][0]; s[1] = v[i][1]; s[2] = v[i][2]; s[3] = v[i][3]; }
    LDS_WAIT(); asm volatile("" ::: "memory");
    const int c = lane & 7;
#pragma unroll
    for (int j = 0; j < 8; ++j) { const int n = (lane >> 3) + 8 * j; const LAS float* s = scr + (8 * c) * 65 + n;
        v4u o; o.x = pk2(s[0], s[65]); o.y = pk2(s[2 * 65], s[3 * 65]); o.z = pk2(s[4 * 65], s[5 * 65]); o.w = pk2(s[6 * 65], s[7 * 65]);
        const int ng = n0 + n; if (ng < N) { const int dr = (MODE == 1) ? ((ng >> 8) * 256 + (ng & 1) * 128 + ((ng >> 1) & 127)) : ng; *(v4u*)(WT + (size_t)dr * K + k0 + 8 * c) = o; } }
    LDS_WAIT(); asm volatile("" ::: "memory");
}

__device__ __forceinline__ void prologue(Frame& F, const Args& a) {
    const int f_tid = lthread(F.wave), f_lane = f_tid & 63;
    unsigned char* ws = F.ws;
    {
        LAS float* scr = (LAS float*)(F.lds + F.wave * 16640);
        struct M { const float* src; int K, N; size_t dst; };
        const int I_MIN = 16 * 11, I_QB = 6 * 24, I_KVB = 4 * 32, I_GQKV = 16 * 24;
        const int NSMALL = I_MIN + I_QB + I_KVB + I_GQKV;
        for (int it = F.gw; it < NSMALL; it += F.NGW) {
            int r = it;
            if (r < I_MIN) { conv_item<0>(a.in[11], D, MLA_IN, (bf16*)(ws + WS_WMIN), scr, r, f_lane); continue; } r -= I_MIN;
            if (r < I_QB) { conv_item<0>(a.in[13], MLA_QL, 1536, (bf16*)(ws + WS_WMQB), scr, r, f_lane); continue; } r -= I_QB;
            if (r < I_KVB) { conv_item<0>(a.in[15], MLA_KVL, 2048, (bf16*)(ws + WS_WMKVB), scr, r, f_lane); continue; } r -= I_KVB;
            conv_item<0>(a.in[17], D, GQA_QKV, (bf16*)(ws + WS_WGQKV), scr, r, f_lane);
        }
    }
    __syncthreads();
    {
        LAS float* cmax = (LAS float*)F.lds;
        LAS float* cinv = cmax + 512;
        LAS unsigned* scr8 = (LAS unsigned*)(F.lds + 4096) + F.wave * (64 * 33);
        const int cc = (f_lane & 15) * 4, rk = f_lane >> 4;
        constexpr int NGU = DEPTH * NE * 32, NDN = DEPTH * NE * 16, NWO = 4 * 16;
        for (int it = blockIdx.x; it < NGU + NDN + NWO; it += F.G) {
            const bool dn = it >= NGU; const bool wo = it >= NGU + NDN; const int q_ = wo ? it - NGU - NDN : (dn ? it - NGU : it); const int le = dn ? (q_ >> 4) : (q_ >> 5), strip = dn ? (q_ & 15) : (q_ & 31);
            const int N = dn ? 1024 : 2048;
            const float* wosrc = (le < 2) ? a.in[10] + (size_t)le * D * D : (le == 2 ? a.in[16] : a.in[20]);
            const float* W = (wo ? wosrc : (dn ? a.in[25] + (size_t)le * DFF * D : a.in[23] + (size_t)le * D * 2048)) + strip * 64 + cc;
            f32x4 v[32];
#pragma unroll
            for (int i = 0; i < 32; ++i) v[i] = *(const f32x4*)(W + (size_t)(F.wave * 128 + 16 * (i >> 2) + 4 * rk + (i & 3)) * N);
            f32x4 mx = (f32x4){0.f, 0.f, 0.f, 0.f};
#pragma unroll
            for (int i = 0; i < 32; ++i) { mx[0] = fmaxf(mx[0], fabsf(v[i][0])); mx[1] = fmaxf(mx[1], fabsf(v[i][1])); mx[2] = fmaxf(mx[2], fabsf(v[i][2])); mx[3] = fmaxf(mx[3], fabsf(v[i][3])); }
#pragma unroll
            for (int q = 0; q < 4; ++q) { mx[q] = fmaxf(mx[q], shx(mx[q], 16, f_lane)); mx[q] = fmaxf(mx[q], shx(mx[q], 32, f_lane)); }
            __syncthreads();
            if (rk == 0) { LAS float* d = cmax + F.wave * 64 + cc; d[0] = mx[0]; d[1] = mx[1]; d[2] = mx[2]; d[3] = mx[3]; }
            __syncthreads();
            const float target = dn ? 240.f : 127.f;
            if (f_tid < 64) { float m8 = 0.f;
#pragma unroll
                for (int w = 0; w < 8; ++w) m8 = fmaxf(m8, cmax[w * 64 + f_tid]);
                const int ng = strip * 64 + f_tid, dr = dn ? ng : (ng >> 8) * 256 + (ng & 1) * 128 + ((ng >> 1) & 127);
                float* sc = wo ? (float*)(ws + WS_SWO) + (size_t)le * 1024 : (dn ? (float*)(ws + WS_SWDN) + (size_t)le * 1024 : (float*)(ws + WS_SWGU) + (size_t)le * 2048);
                sc[dr] = (m8 > 0.f) ? m8 / target : 1.f;
                cinv[f_tid] = (m8 > 0.f) ? target / m8 : 0.f; }
            __syncthreads();
            const f32x4 iv = *(const LAS f32x4*)(cinv + cc);
#pragma unroll
            for (int ip = 0; ip < 8; ++ip) {
#pragma unroll
                for (int q = 0; q < 4; ++q) { unsigned w = 0;
                    if (dn) { int t = __builtin_amdgcn_cvt_pk_fp8_f32(v[4 * ip][q] * iv[q], v[4 * ip + 1][q] * iv[q], 0, false); t = __builtin_amdgcn_cvt_pk_fp8_f32(v[4 * ip + 2][q] * iv[q], v[4 * ip + 3][q] * iv[q], t, true); w = (unsigned)t; }
                    else w = q8x4(v[4 * ip][q], v[4 * ip + 1][q], v[4 * ip + 2][q], v[4 * ip + 3][q], iv[q]);
                    scr8[(cc + q) * 33 + 4 * ip + rk] = w; } }
            LDS_WAIT(); asm volatile("" ::: "memory");
            { const int c8 = f_lane & 7;
              unsigned char* dst = wo ? (unsigned char*)(ws + WS_WO8) + (size_t)le * 1024 * 1024 : (dn ? (unsigned char*)(ws + WS_WDN) + (size_t)le * 1024 * 1024 : (unsigned char*)(ws + WS_WGU) + (size_t)le * 2048 * 1024);
#pragma unroll
              for (int jp = 0; jp < 8; ++jp) { const int n = (f_lane >> 3) + 8 * jp; const LAS unsigned* sp = scr8 + n * 33 + 4 * c8;
                  v4u o; o.x = sp[0]; o.y = sp[1]; o.z = sp[2]; o[3] = sp[3];
                  const int ng = strip * 64 + n, dr = dn ? ng : (ng >> 8) * 256 + (ng & 1) * 128 + ((ng >> 1) & 127);
                  *(v4u*)(dst + (size_t)dr * 1024 + F.wave * 128 + 16 * c8) = o; } }
            LDS_WAIT(); asm volatile("" ::: "memory");
        }
        __syncthreads();
    }
    const int gtid = blockIdx.x * 512 + f_tid, gthreads = F.G * 512;
    for (int i = gtid; i < (MLA_IN_PAD - MLA_IN) * D / 8; i += gthreads) ((v4u*)((bf16*)(ws + WS_WMIN) + (size_t)MLA_IN * D))[i] = (v4u){0u, 0u, 0u, 0u};
    {
        unsigned* MA8 = (unsigned*)(ws + WS_MA);
        for (int i4 = gtid; i4 < 256 * 256 / 4; i4 += gthreads) { float v4_[4];
#pragma unroll
            for (int jx = 0; jx < 4; ++jx) { const int i = 4 * i4 + jx; const int row = i >> 8, col = i & 255, jp = row >> 7, pp = (row >> 6) & 1, k1 = row & 63, j = col >> 7, pt = (col >> 6) & 1, l1 = col & 63;
                float v = 0.f; if (j == jp) { const float x = 2.f * (float)((k1 * l1) & 63) / 64.f; const float cs = cospif(x), sn = sinpif(x); v = (pp == 0) ? (pt == 0 ? cs : sn) : (pt == 0 ? -sn : cs); }
                v4_[jx] = v; }
            int t = __builtin_amdgcn_cvt_pk_fp8_f32(v4_[0], v4_[1], 0, false); t = __builtin_amdgcn_cvt_pk_fp8_f32(v4_[2], v4_[3], t, true); MA8[i4] = (unsigned)t; }
        unsigned* DC8 = (unsigned*)(ws + WS_DC); const float sc = 64.0f / sqrtf(256.f * 128.f);
        for (int i4 = gtid; i4 < 256 * 512 / 4; i4 += gthreads) { float v4_[4];
#pragma unroll
            for (int jx = 0; jx < 4; ++jx) { const int i = 4 * i4 + jx; const int k = i >> 9, col = i & 511, pt = col >> 8, l = col & 255; const float x = 2.f * (float)((k * l) & 255) / 256.f; v4_[jx] = (pt == 0 ? cospif(x) : sinpif(x)) * sc; }
            int t = __builtin_amdgcn_cvt_pk_fp8_f32(v4_[0], v4_[1], 0, false); t = __builtin_amdgcn_cvt_pk_fp8_f32(v4_[2], v4_[3], t, true); DC8[i4] = (unsigned)t; }
        unsigned* MC8 = (unsigned*)(ws + WS_MC); const float sl = 256.0f / sqrtf(4096.f * 128.f);
        for (int i4 = gtid; i4 < 16 * 256 * 512 / 4; i4 += gthreads) { float v4_[4];
#pragma unroll
            for (int j = 0; j < 4; ++j) { const int i = 4 * i4 + j; const int kq = i >> 17, row = (i >> 9) & 255, col = i & 511, kkp = row >> 6, k2 = row & 63, kk = col >> 7, pp = (col >> 6) & 1, l2 = col & 63;
                float v = 0.f; if (kk == kkp) { const int k = 4 * kq + kkp + 64 * k2; const float x = 2.f * (float)((l2 * k) & 4095) / 4096.f; v = (pp == 0 ? cospif(x) : sinpif(x)) * sl; }
                v4_[j] = v; }
            int t = __builtin_amdgcn_cvt_pk_fp8_f32(v4_[0], v4_[1], 0, false); t = __builtin_amdgcn_cvt_pk_fp8_f32(v4_[2], v4_[3], t, true); MC8[i4] = (unsigned)t; }
        float* RM = (float*)(ws + WS_ROPE); float* RG = RM + 2048;
        for (int i = gtid; i < 64 * 8; i += gthreads) { const int pos = i >> 3, f = i & 7; const float inv = powf(10000.f, -(float)f / 8.f); float s, c; sincosf((float)pos * inv, &s, &c); RM[2 * i] = c; RM[2 * i + 1] = s; }
        for (int i = gtid; i < 64 * 16; i += gthreads) { const int pos = i >> 4, f = i & 15; const float inv = powf(10000.f, -(float)f / 16.f); float s, c; sincosf((float)pos * inv, &s, &c); RG[2 * i] = c; RG[2 * i + 1] = s; }
        float* WRT = (float*)(ws + WS_WRT);
        for (int i = gtid; i < DEPTH * NE * D; i += gthreads) { const int l = i >> 15, e = (i >> 10) & 31, k = i & 1023; WRT[i] = a.in[21][((size_t)l * D + k) * NE + e]; }
        float* BG = (float*)(ws + WS_BGU);
        for (int i = gtid; i < DEPTH * NE * 2048; i += gthreads) { const int le = i >> 11, q = i & 2047, pn = q >> 8, s = (q >> 7) & 1, jj = q & 127; BG[i] = a.in[24][(size_t)le * 2048 + 2 * (pn * 128 + jj) + s]; }
    }
    __syncthreads();
    {
        LAS float* wl = (LAS float*)F.lds;
        LAS float* tc = wl + 2048; LAS float* ts = tc + 128;
        if (f_tid < 128) { const float x = 2.f * (float)f_tid / 128.f; tc[f_tid] = cospif(x); ts[f_tid] = -sinpif(x); }
        for (int it = blockIdx.x; it < 2 * 8 * 64; it += F.G) { const int j = it >> 9, g = (it >> 6) & 7, kb = it & 63;
            __syncthreads();
            { const int kk = f_tid >> 5, c4 = (f_tid & 31) * 4; const f32x4 w = *(const f32x4*)(a.in[9] + ((size_t)j * D + kb * 16 + kk) * D + g * 128 + c4);
              LAS float* d = wl + c4 * 16 + kk; d[0] = w[0]; d[16] = w[1]; d[32] = w[2]; d[48] = w[3]; }
            __syncthreads();
            const int cl = f_tid & 255, m = cl >> 1, part = cl & 1, kh = f_tid >> 8; const LAS float* tw = part ? ts : tc;
            float accv[8];
#pragma unroll
            for (int q = 0; q < 8; ++q) accv[q] = 0.f;
            for (int jj = 0; jj < 128; ++jj) { const float t = tw[(m * jj) & 127]; const f32x4 wa = *(const LAS f32x4*)(wl + jj * 16 + kh * 8), wb = *(const LAS f32x4*)(wl + jj * 16 + kh * 8 + 4);
                accv[0] += wa[0] * t; accv[1] += wa[1] * t; accv[2] += wa[2] * t; accv[3] += wa[3] * t; accv[4] += wb[0] * t; accv[5] += wb[1] * t; accv[6] += wb[2] * t; accv[7] += wb[3] * t; }
            v4u o; o.x = pk2(accv[0], accv[1]); o.y = pk2(accv[2], accv[3]); o.z = pk2(accv[4], accv[5]); o.w = pk2(accv[6], accv[7]);
            *(v4u*)((bf16*)(ws + WS_WFIN) + ((size_t)j * 2048 + g * 256 + cl) * D + kb * 16 + kh * 8) = o;
        }
        __syncthreads();
    }
    {
        LAS float* S = (LAS float*)F.lds;
        LAS float* red = S + 9 * 1024;
        for (int i = f_tid; i < 9 * 1024; i += 512) { const int r = i >> 10, k = i & 1023; const float v = (r < 8) ? a.in[1][r * D + k] : a.in[3][k]; S[i] = v / (1.f + __expf(-v)); }
        __syncthreads();
        for (int it = blockIdx.x; it < DEPTH * 96; it += F.G) { const int l = it / 96, n0 = (it % 96) * 64;
            const float* wp = a.in[4] + ((size_t)l * D + F.wave * 128) * (NMOD * D) + n0 + f_lane;
            float accv[9];
#pragma unroll
            for (int r = 0; r < 9; ++r) accv[r] = 0.f;
            for (int k0 = 0; k0 < 128; k0 += 32) { float wv[32];
#pragma unroll
                for (int k = 0; k < 32; ++k) wv[k] = wp[(size_t)(k0 + k) * (NMOD * D)];
#pragma unroll
                for (int k = 0; k < 32; ++k)
#pragma unroll
                    for (int r = 0; r < 9; ++r) accv[r] += S[r * 1024 + F.wave * 128 + k0 + k] * wv[k]; }
#pragma unroll
            for (int r = 0; r < 9; ++r) red[(F.wave * 9 + r) * 64 + f_lane] = accv[r];
            __syncthreads();
            for (int i = f_tid; i < 9 * 64; i += 512) { const int r = i >> 6, ln = i & 63; float s = a.in[5][(size_t)l * (NMOD * D) + n0 + ln];
#pragma unroll
                for (int w = 0; w < 8; ++w) s += red[(w * 9 + r) * 64 + ln];
                ((float*)(ws + WS_MOD))[((size_t)l * 9 + r) * (NMOD * D) + n0 + ln] = s; }
            __syncthreads();
        }
    }
}

__device__ __forceinline__ void load_row(const float* p, int lane, f32x4 (&v)[4]) {
#pragma unroll
    for (int j = 0; j < 4; ++j) v[j] = ((const f32x4*)p)[lane + 64 * j];
}
__device__ __forceinline__ void load_row_bf(const bf16* p, int lane, f32x4 (&v)[4]) {
#pragma unroll
    for (int j = 0; j < 4; ++j) { const v2u w = ((const v2u*)p)[lane + 64 * j]; v[j] = (f32x4){bf_lo(w.x), bf_hi(w.x), bf_lo(w.y), bf_hi(w.y)}; }
}
__device__ __forceinline__ void norm_mod(f32x4 (&v)[4], const float* g, const float* shift, const float* scale, int lane) {
    float s = 0.f;
#pragma unroll
    for (int j = 0; j < 4; ++j) s += (v[j][0] * v[j][0] + v[j][1] * v[j][1]) + (v[j][2] * v[j][2] + v[j][3] * v[j][3]);
    const float rstd = rsqrtf(wave_sum(s, lane) * (1.f / D) + EPS);
#pragma unroll
    for (int j = 0; j < 4; ++j) { const f32x4 gv = ((const f32x4*)g)[lane + 64 * j], sh = ((const f32x4*)shift)[lane + 64 * j], sc = ((const f32x4*)scale)[lane + 64 * j];
        v[j] = (v[j] * rstd * gv) * (sc + 1.f) + sh; }
}
__device__ __forceinline__ void store_row_bf16(bf16* p, int lane, const f32x4 (&v)[4]) {
#pragma unroll
    for (int j = 0; j < 4; ++j) { v2u w; w.x = pk2(v[j][0], v[j][1]); w.y = pk2(v[j][2], v[j][3]); ((v2u*)p)[lane + 64 * j] = w; }
}

__device__ __forceinline__ float store_row_i8(unsigned char* p, int lane, const f32x4 (&v)[4]) {
    float am = 0.f;
#pragma unroll
    for (int j = 0; j < 4; ++j) am = fmaxf(fmaxf(am, fmaxf(fabsf(v[j][0]), fabsf(v[j][1]))), fmaxf(fabsf(v[j][2]), fabsf(v[j][3])));
    unsigned k = __float_as_uint(am);
    { unsigned t;
      t = (unsigned)__builtin_amdgcn_mov_dpp((int)k, 0xb1, 0xf, 0xf, false); k = k > t ? k : t;
      t = (unsigned)__builtin_amdgcn_mov_dpp((int)k, 0x4e, 0xf, 0xf, false); k = k > t ? k : t;
      t = (unsigned)__builtin_amdgcn_mov_dpp((int)k, 0x124, 0xf, 0xf, false); k = k > t ? k : t;
      t = (unsigned)__builtin_amdgcn_mov_dpp((int)k, 0x128, 0xf, 0xf, false); k = k > t ? k : t;
      const unsigned a = (unsigned)__builtin_amdgcn_readlane((int)k, 0), b = (unsigned)__builtin_amdgcn_readlane((int)k, 16), c = (unsigned)__builtin_amdgcn_readlane((int)k, 32), d = (unsigned)__builtin_amdgcn_readlane((int)k, 48);
      const unsigned ab = a > b ? a : b, cd = c > d ? c : d; k = ab > cd ? ab : cd; }
    const float amax = __uint_as_float(k);
    const float qscale = amax > 0.f ? amax * (1.f / 127.f) : 1.f, qinv = amax > 0.f ? 127.f / amax : 0.f;
#pragma unroll
    for (int j = 0; j < 4; ++j) ((unsigned*)p)[lane + 64 * j] = q8x4(v[j][0], v[j][1], v[j][2], v[j][3], qinv);
    return qscale;
}
__device__ __forceinline__ void quant_rows(Frame& F, const bf16* src, unsigned char* dst, float* scale, int R) {
    const int f_lane = lthread(F.wave) & 63;
    for (int r = F.gw; r < R; r += F.NGW) { f32x4 v[4]; load_row_bf(src + (size_t)r * 1024, f_lane, v);
        const float sc = store_row_i8(dst + (size_t)r * 1024, f_lane, v); if (f_lane == 0) scale[r] = sc; }
}
__device__ __forceinline__ void rp_norm1(Frame& F, const Args& a, int l, int row_lo) {
    const int f_tid = lthread(F.wave), f_lane = f_tid & 63;
    const bf16* X = (const bf16*)(F.ws + WS_X); bf16* H = (bf16*)(F.ws + WS_H); const float* MOD = (const float*)(F.ws + WS_MOD) + (size_t)l * 9 * (NMOD * D);
    for (int row = row_lo + F.gw; row < NT; row += F.NGW) { f32x4 v[4];
        if (l == 0) { load_row(row < NC ? a.in[2] + (size_t)row * D : a.in[0] + (size_t)(row - NC) * D, f_lane, v);
            store_row_bf16((bf16*)(F.ws + WS_X) + (size_t)row * D, f_lane, v); }
        else load_row_bf(X + (size_t)row * D, f_lane, v);
        const float* m = MOD + (size_t)modrow_of(row) * (NMOD * D);
        norm_mod(v, a.in[6] + (size_t)l * D, m, m + D, f_lane);
        const float sc = store_row_i8((unsigned char*)H + (size_t)row * D, f_lane, v); if (f_lane == 0) ((float*)(F.ws + WS_SH))[row] = sc; }
}

__device__ __forceinline__ void rp_norm1_l0(Frame& F, const Args& a) {
    const int f_tid = lthread(F.wave), f_lane = f_tid & 63;
    LAS float* LM = (LAS float*)F.lds; const float* MOD = (const float*)(F.ws + WS_MOD);
    __syncthreads();
    for (int i = f_tid; i < 1024; i += 512) LM[i] = a.in[6][i];
    for (int i = f_tid; i < 18 * 1024; i += 512) LM[1024 + i] = MOD[(size_t)(i >> 11) * (NMOD * D) + (i & 2047)];
    __syncthreads();
    const int st = F.NGW, row0 = F.gw;
    if (row0 >= NT) return;
    const int n = (NT - row0 + st - 1) / st, rlast = row0 + (n - 1) * st;
#define NROW(i) ((row0 + (i) * st) <= rlast ? (row0 + (i) * st) : rlast)
#define NSRC(r) ((r) < NC ? a.in[2] + (size_t)(r) * D : a.in[0] + (size_t)((r) - NC) * D)
    f32x4 R0[4], R1[4], R2[4];
    { const int r0 = NROW(0), r1 = NROW(1), r2 = NROW(2); load_row(NSRC(r0), f_lane, R0); load_row(NSRC(r1), f_lane, R1); load_row(NSRC(r2), f_lane, R2); }
#define NSTEP(R, i_) do { if ((i_) < n) { const int row = NROW(i_); \
            store_row_bf16((bf16*)(F.ws + WS_X) + (size_t)row * D, f_lane, R); \
            float s_ = 0.f; _Pragma("unroll") for (int j = 0; j < 4; ++j) s_ += (R[j][0] * R[j][0] + R[j][1] * R[j][1]) + (R[j][2] * R[j][2] + R[j][3] * R[j][3]); \
            const float rstd_ = rsqrtf(wave_sum(s_, f_lane) * (1.f / D) + EPS); const LAS f32x4* mp_ = (const LAS f32x4*)(LM + 1024 + modrow_of(row) * 2048); \
            _Pragma("unroll") for (int j = 0; j < 4; ++j) { const f32x4 gv = ((const LAS f32x4*)LM)[f_lane + 64 * j], sh = mp_[f_lane + 64 * j], sc = mp_[256 + f_lane + 64 * j]; R[j] = (R[j] * rstd_ * gv) * (sc + 1.f) + sh; } \
            const float sc_ = store_row_i8((unsigned char*)(F.ws + WS_H) + (size_t)row * D, f_lane, R); if (f_lane == 0) ((float*)(F.ws + WS_SH))[row] = sc_; } \
        { const int rn_ = NROW((i_) + 3); load_row(NSRC(rn_), f_lane, R); } } while (0)
    for (int i = 0; i < n; i += 3) { NSTEP(R0, i); NSTEP(R1, i + 1); NSTEP(R2, i + 2); }
#undef NSTEP
#undef NSRC
#undef NROW
}

#if MK_N2V2
constexpr int LDS_LIST = LDS_MISC + 768;
__device__ __forceinline__ unsigned row16_max(unsigned k) {
    unsigned t;
    t = (unsigned)__builtin_amdgcn_mov_dpp((int)k, 0xb1, 0xf, 0xf, false); k = k > t ? k : t;
    t = (unsigned)__builtin_amdgcn_mov_dpp((int)k, 0x4e, 0xf, 0xf, false); k = k > t ? k : t;
    t = (unsigned)__builtin_amdgcn_mov_dpp((int)k, 0x124, 0xf, 0xf, false); k = k > t ? k : t;
    t = (unsigned)__builtin_amdgcn_mov_dpp((int)k, 0x128, 0xf, 0xf, false); k = k > t ? k : t;
    return k;
}
__device__ __forceinline__ unsigned wave_max_u(unsigned k) {
    k = row16_max(k);
    const unsigned a = (unsigned)__builtin_amdgcn_readlane((int)k, 0), b = (unsigned)__builtin_amdgcn_readlane((int)k, 16), c = (unsigned)__builtin_amdgcn_readlane((int)k, 32), d = (unsigned)__builtin_amdgcn_readlane((int)k, 48);
    const unsigned ab = a > b ? a : b, cd = c > d ? c : d; return ab > cd ? ab : cd;
}
__device__ __forceinline__ float key_val(unsigned m) { const unsigned u = m & ~31u; return __builtin_bit_cast(float, (u & 0x80000000u) ? (u ^ 0x80000000u) : ~u); }
constexpr int N2_WPITCH = 2064;
constexpr int N2_GM = 32 * N2_WPITCH;
constexpr int N2_LIST = N2_GM + 5 * 8192;
__device__ __forceinline__ void rp_norm2_router(Frame& F, const Args& a, int l, int row_lo) {
    const int f_tid = lthread(F.wave), f_lane = f_tid & 63;
    const bf16* X = (const bf16*)(F.ws + WS_X); unsigned char* H8 = (unsigned char*)(F.ws + WS_H); const float* MOD = (const float*)(F.ws + WS_MOD) + (size_t)l * 9 * (NMOD * D);
    LAS unsigned char* WT = F.lds;
    { const f32x4* src = (const f32x4*)((const float*)(F.ws + WS_WRT) + (size_t)l * NE * D); f32x4 tv[16];
#pragma unroll
      for (int i = 0; i < 16; ++i) tv[i] = src[f_tid + 512 * i];
#pragma unroll
      for (int i = 0; i < 16; ++i) { const int i4 = f_tid + 512 * i, e = i4 >> 8, k4 = (i4 & 255) * 4; v2u w; w.x = pk2(tv[i][0], tv[i][1]); w.y = pk2(tv[i][2], tv[i][3]); *(LAS v2u*)(WT + e * N2_WPITCH + k4 * 2) = w; } }
    LAS int* lcnt = (LAS int*)(F.lds + LDS_TT); LAS int* lbase = lcnt + 32;
    if (f_tid < 32) lcnt[f_tid] = 0;
    const int ngroups = (NT - row_lo) >> 5;
    const int g = F.wave * F.G + (int)blockIdx.x;
    const bool active = (F.wave < 5) && (g < ngroups);
    LAS float* GM = (LAS float*)(F.lds + N2_GM + (F.wave < 5 ? F.wave : 0) * 8192); LAS float* SH = GM + 1024;
    LAS v4u* list = (LAS v4u*)(F.lds + N2_LIST + (F.wave < 5 ? F.wave : 0) * (128 * 16 + 128)); LAS float* lsc = (LAS float*)(list + 128);
    const int r = f_lane & 31, kh = f_lane >> 5;
    const int row = row_lo + g * 32 + r;
    float msh = 0.f;
    if (active) {
        const float* m = MOD + (size_t)modrow_of(row_lo + g * 32) * (NMOD * D); const float* gf = a.in[7] + (size_t)l * D;
#pragma unroll
        for (int j = 0; j < 4; ++j) { const f32x4 gv = ((const f32x4*)gf)[f_lane + 64 * j], sc = ((const f32x4*)(m + 4 * D))[f_lane + 64 * j], sv = ((const f32x4*)(m + 3 * D))[f_lane + 64 * j];
            ((LAS f32x4*)GM)[f_lane + 64 * j] = gv * (sc + 1.f); ((LAS f32x4*)SH)[f_lane + 64 * j] = sv;
            msh = fmaxf(fmaxf(msh, fmaxf(fabsf(sv[0]), fabsf(sv[1]))), fmaxf(fabsf(sv[2]), fabsf(sv[3]))); }
        msh = __uint_as_float(wave_max_u(__float_as_uint(msh)));
    }
    __syncthreads();
    if (active) {
        const bf16* xr = X + (size_t)row * D + 16 * kh;
        float ssq = 0.f, mxg = 0.f;
#pragma unroll 1
        for (int c0 = 0; c0 < 32; c0 += 8) { v4u xa[8], xb[8];
#pragma unroll
            for (int i = 0; i < 8; ++i) { xa[i] = *(const v4u*)(xr + 32 * (c0 + i)); xb[i] = *(const v4u*)(xr + 32 * (c0 + i) + 8); }
#pragma unroll
            for (int i = 0; i < 8; ++i) { const LAS f32x4* gp = (const LAS f32x4*)(GM + 32 * (c0 + i) + 16 * kh);
                const f32x4 g0 = gp[0], g1 = gp[1], g2 = gp[2], g3 = gp[3];
                const unsigned wa[4] = {xa[i].x, xa[i].y, xa[i].z, xa[i][3]}, wb[4] = {xb[i].x, xb[i].y, xb[i].z, xb[i][3]};
#pragma unroll
                for (int q = 0; q < 4; ++q) { const float x0 = bf_lo(wa[q]), x1 = bf_hi(wa[q]), x2 = bf_lo(wb[q]), x3 = bf_hi(wb[q]);
                    ssq += x0 * x0 + x1 * x1 + x2 * x2 + x3 * x3;
                    const float ga = (q < 2 ? g0 : g1)[(2 * q) & 3], gb = (q < 2 ? g0 : g1)[(2 * q + 1) & 3], gc = (q < 2 ? g2 : g3)[(2 * q) & 3], gd = (q < 2 ? g2 : g3)[(2 * q + 1) & 3];
                    mxg = fmaxf(fmaxf(mxg, fmaxf(fabsf(x0 * ga), fabsf(x1 * gb))), fmaxf(fabsf(x2 * gc), fabsf(x3 * gd))); } } }
        { auto rr = __builtin_amdgcn_permlane32_swap(__float_as_uint(ssq), __float_as_uint(ssq), false, false); ssq = __uint_as_float(rr[0]) + __uint_as_float(rr[1]); }
        { auto rr = __builtin_amdgcn_permlane32_swap(__float_as_uint(mxg), __float_as_uint(mxg), false, false); mxg = fmaxf(__uint_as_float(rr[0]), __uint_as_float(rr[1])); }
        const float rstd = rsqrtf(ssq * (1.f / D) + EPS);
        const float bound = mxg * rstd + msh;
        const float qscale = bound > 0.f ? bound * (1.f / 127.f) : 1.f, qinv = bound > 0.f ? 127.f / bound : 0.f;
        f32x16 acc = f32x16{};
        unsigned char* hrow = H8 + (size_t)row * D + 16 * kh;
        const LAS unsigned char* wrow = WT + r * N2_WPITCH + 32 * kh;
#pragma unroll 1
        for (int c0 = 0; c0 < 32; c0 += 4) { v4u xa[4], xb[4];
#pragma unroll
            for (int i = 0; i < 4; ++i) { xa[i] = *(const v4u*)(xr + 32 * (c0 + i)); xb[i] = *(const v4u*)(xr + 32 * (c0 + i) + 8); }
#pragma unroll
            for (int i = 0; i < 4; ++i) { const int c = c0 + i;
                const LAS f32x4* gp = (const LAS f32x4*)(GM + 32 * c + 16 * kh); const LAS f32x4* sp = (const LAS f32x4*)(SH + 32 * c + 16 * kh);
                const bf16x8 w0 = *(const LAS bf16x8*)(wrow + 64 * c), w1 = *(const LAS bf16x8*)(wrow + 64 * c + 16);
                float h[16];
                const unsigned wa[4] = {xa[i].x, xa[i].y, xa[i].z, xa[i][3]}, wb[4] = {xb[i].x, xb[i].y, xb[i].z, xb[i][3]};
#pragma unroll
                for (int q = 0; q < 4; ++q) { h[2 * q] = bf_lo(wa[q]); h[2 * q + 1] = bf_hi(wa[q]); h[8 + 2 * q] = bf_lo(wb[q]); h[8 + 2 * q + 1] = bf_hi(wb[q]); }
#pragma unroll
                for (int q = 0; q < 4; ++q) { const f32x4 gq = gp[q], sq = sp[q];
#pragma unroll
                    for (int e = 0; e < 4; ++e) h[4 * q + e] = (h[4 * q + e] * rstd) * gq[e] + sq[e]; }
                v4u o8;
#pragma unroll
                for (int q = 0; q < 4; ++q) o8[q] = q8x4(h[4 * q], h[4 * q + 1], h[4 * q + 2], h[4 * q + 3], qinv);
                *(v4u*)(hrow + 32 * c) = o8;
                v4u hi0, hi1, lo0, lo1;
#pragma unroll
                for (int q = 0; q < 4; ++q) { hi0[q] = pk2(h[2 * q], h[2 * q + 1]); hi1[q] = pk2(h[8 + 2 * q], h[8 + 2 * q + 1]); }
#pragma unroll
                for (int q = 0; q < 4; ++q) { lo0[q] = pk2(h[2 * q] - bf_lo(hi0[q]), h[2 * q + 1] - bf_hi(hi0[q])); lo1[q] = pk2(h[8 + 2 * q] - bf_lo(hi1[q]), h[8 + 2 * q + 1] - bf_hi(hi1[q])); }
                acc = __builtin_amdgcn_mfma_f32_32x32x16_bf16(w0, __builtin_bit_cast(bf16x8, hi0), acc, 0, 0, 0);
                acc = __builtin_amdgcn_mfma_f32_32x32x16_bf16(w0, __builtin_bit_cast(bf16x8, lo0), acc, 0, 0, 0);
                acc = __builtin_amdgcn_mfma_f32_32x32x16_bf16(w1, __builtin_bit_cast(bf16x8, hi1), acc, 0, 0, 0);
                acc = __builtin_amdgcn_mfma_f32_32x32x16_bf16(w1, __builtin_bit_cast(bf16x8, lo1), acc, 0, 0, 0); } }
        float val[32];
        const float* br = a.in[22] + (size_t)l * NE;
#pragma unroll
        for (int j = 0; j < 16; ++j) { auto rr = __builtin_amdgcn_permlane32_swap(__float_as_uint(acc[j]), __float_as_uint(acc[j]), false, false);
            const int e0 = (j & 3) + 8 * (j >> 2); val[e0] = __uint_as_float(rr[0]) + br[e0]; val[e0 + 4] = __uint_as_float(rr[1]) + br[e0 + 4]; }
        unsigned taken = 0u; int be[4]; float bv[4];
#pragma unroll
        for (int k = 0; k < 4; ++k) { float best = -INFINITY; int bi = 0;
#pragma unroll
            for (int e = 0; e < 32; ++e) { const bool cnd = !((taken >> e) & 1u) && (val[e] > best); best = cnd ? val[e] : best; bi = cnd ? e : bi; }
            taken |= 1u << bi; be[k] = bi; bv[k] = best; }
        const float e1 = __expf(bv[1] - bv[0]), e2 = __expf(bv[2] - bv[0]), e3 = __expf(bv[3] - bv[0]); const float inv = 1.f / (1.f + e1 + e2 + e3);
        if (kh == 0) { const float ww[4] = {inv, e1 * inv, e2 * inv, e3 * inv};
#pragma unroll
            for (int k = 0; k < 4; ++k) { const int lr = __hip_atomic_fetch_add(lcnt + be[k], 1, __ATOMIC_RELAXED, __HIP_MEMORY_SCOPE_WORKGROUP);
                LAS unsigned* ep = (LAS unsigned*)(list + r * 4 + k); ep[0] = (unsigned)(row * 4 + k); ep[1] = (unsigned)be[k]; ep[2] = (unsigned)lr; ep[3] = __builtin_bit_cast(unsigned, ww[k]); }
            lsc[r] = qscale; }
    }
    __syncthreads();
    if (f_tid < 32) { const int c = lcnt[f_tid]; lbase[f_tid] = c ? (int)__hip_atomic_fetch_add((unsigned*)(F.ctl + CW_CNT + (l * 32 + f_tid) * 16), (unsigned)c, RLX_AGENT) : 0; }
    __syncthreads();
    if (active) {
        int* te = (int*)(F.ws + WS_TE); int* trank = (int*)(F.ws + WS_TRANK); int* stok = (int*)(F.ws + WS_STOK); float* sw = (float*)(F.ws + WS_SW); float* ssc = (float*)(F.ws + WS_SSC);
#pragma unroll
        for (int i = f_lane; i < 128; i += 64) { const LAS unsigned* ep = (const LAS unsigned*)(list + i); const unsigned rowk = ep[0], ex = ep[1], lr = ep[2]; const float wv = __builtin_bit_cast(float, ep[3]);
            const int rk = lbase[ex] + (int)lr;
            stok[(size_t)ex * CAP + rk] = (int)(rowk >> 2); sw[(size_t)ex * CAP + rk] = wv; ssc[(size_t)ex * CAP + rk] = lsc[i >> 2]; te[rowk] = (int)ex; trank[rowk] = rk; }
    }
}

#endif
__device__ __forceinline__ void moe_table(Frame& F, int l) {
    const int f_tid = lthread(F.wave), f_lane = f_tid & 63;
    LAS int* TT = (LAS int*)(F.lds + LDS_TT); LAS int* CN = TT + 64; LAS int* TE = (LAS int*)(F.lds + LDS_TE);
    __syncthreads();
    if (f_tid < 64) {
        const int c = (f_lane < 32) ? (int)__hip_atomic_load((unsigned*)(F.ctl + CW_CNT + (l * 32 + (f_lane & 31)) * 16), RLX_AGENT) : 0;
        const int tl = (c + 255) >> 8; int v = tl;
#pragma unroll
        for (int o = 1; o < 32; o <<= 1) { const int n = __builtin_amdgcn_ds_bpermute((f_lane >= o ? f_lane - o : f_lane) << 2, v); if (f_lane >= o) v += n; }
        if (f_lane < 32) { CN[f_lane] = c; TT[f_lane] = v - tl; if (f_lane == 31) TT[32] = v; }
    }
    __syncthreads();
    for (int t = f_tid; t < MAXTILES; t += 512) { int lo = 0, hi = 32;
#pragma unroll
        for (int k = 0; k < 5; ++k) { const int mid = (lo + hi) >> 1; if (TT[mid] <= t) lo = mid; else hi = mid; }
        TE[t] = lo; }
    __syncthreads();
}

#if MK_CBV2
struct CombRow { v4u x[2]; v4u y[4]; };
__device__ __forceinline__ void comb_issue(CombRow& R, const bf16* X, const unsigned char* Y, const LAS int* TT, int row, const v4u te4, const v4u tr4, int lane) {
    const unsigned ee[4] = {te4[0], te4[1], te4[2], te4[3]}, rr[4] = {tr4[0], tr4[1], tr4[2], tr4[3]};
#pragma unroll
    for (int k = 0; k < 4; ++k) { const size_t slot = (size_t)TT[ee[k]] * 256 + rr[k]; R.y[k] = *(const v4u*)(Y + slot * 1024 + 16 * lane); }
    const bf16* xp = X + (size_t)row * D + 16 * lane; R.x[0] = *(const v4u*)xp; R.x[1] = *(const v4u*)(xp + 8);
}
constexpr int CB_G5 = 0, CB_MS = 9 * 1024, CB_GX = 27 * 1024, CB_FLOATS = 28 * 1024;
__device__ __forceinline__ int cb_pos(int e) { return ((e >> 2) & 3) * 256 + (e >> 4) * 4 + (e & 3); }
__device__ __forceinline__ void comb_finish(const CombRow& R, Frame& F, const Args& a, int l, int row, int lane, bool lastl) {
    bf16* X = (bf16*)(F.ws + WS_X); unsigned char* H8 = (unsigned char*)(F.ws + WS_H); const LAS float* LM = (const LAS float*)F.lds;
    const int mr = modrow_of(row); const LAS f32x4* g5 = (const LAS f32x4*)(LM + CB_G5 + mr * 1024) + lane;
    float v[16];
#pragma unroll
    for (int w = 0; w < 4; ++w) { f32x4 s = (f32x4){0.f, 0.f, 0.f, 0.f};
#pragma unroll
        for (int k = 0; k < 4; ++k) { const int yw = (int)R.y[k][w]; const f32x2 lo = __builtin_amdgcn_cvt_pk_f32_fp8(yw, false), hi = __builtin_amdgcn_cvt_pk_f32_fp8(yw, true); s[0] += lo[0]; s[1] += lo[1]; s[2] += hi[0]; s[3] += hi[1]; }
        const f32x4 gv = g5[w * 64]; const unsigned x0 = R.x[w >> 1][(2 * w) & 3], x1 = R.x[w >> 1][(2 * w + 1) & 3];
        v[4 * w] = bf_lo(x0) + gv[0] * s[0] * 0.125f; v[4 * w + 1] = bf_hi(x0) + gv[1] * s[1] * 0.125f; v[4 * w + 2] = bf_lo(x1) + gv[2] * s[2] * 0.125f; v[4 * w + 3] = bf_hi(x1) + gv[3] * s[3] * 0.125f; }
    float ss = 0.f;
#pragma unroll
    for (int i = 0; i < 16; ++i) ss += v[i] * v[i];
    const float rstd = rsqrtf(wave_sum(ss, lane) * (1.f / D) + EPS);
    if (!lastl) {
        bf16* xo = X + (size_t)row * D + 16 * lane;
        { v4u o0, o1;
#pragma unroll
          for (int q = 0; q < 4; ++q) { o0[q] = pk2(v[2 * q], v[2 * q + 1]); o1[q] = pk2(v[8 + 2 * q], v[8 + 2 * q + 1]); }
          *(v4u*)xo = o0; *(v4u*)(xo + 8) = o1; }
        const LAS f32x4* m = (const LAS f32x4*)(LM + CB_MS + mr * 2048) + lane; const LAS f32x4* gx = (const LAS f32x4*)(LM + CB_GX) + lane;
        float am = 0.f;
#pragma unroll
        for (int w = 0; w < 4; ++w) { const f32x4 gv = gx[w * 64], sh = m[w * 64], sc = m[256 + w * 64];
#pragma unroll
            for (int e = 0; e < 4; ++e) { const float h = (v[4 * w + e] * rstd * gv[e]) * (sc[e] + 1.f) + sh[e]; v[4 * w + e] = h; am = fmaxf(am, fabsf(h)); } }
        const float amax = __uint_as_float(wave_max_u(__float_as_uint(am)));
        const float qscale = amax > 0.f ? amax * (1.f / 127.f) : 1.f, qinv = amax > 0.f ? 127.f / amax : 0.f;
        v4u o8;
#pragma unroll
        for (int w = 0; w < 4; ++w) o8[w] = q8x4(v[4 * w], v[4 * w + 1], v[4 * w + 2], v[4 * w + 3], qinv);
        *(v4u*)(H8 + (size_t)row * D + 16 * lane) = o8;
        if (lane == 0) ((float*)(F.ws + WS_SH))[row] = qscale;
    } else {
        float* op = a.out + (size_t)(row - NC) * D + 16 * lane; const LAS f32x4* gf = (const LAS f32x4*)(LM + CB_GX) + lane;
#pragma unroll
        for (int w = 0; w < 4; ++w) { const f32x4 gv = gf[w * 64]; ((f32x4*)op)[w] = (f32x4){v[4 * w] * rstd * gv[0], v[4 * w + 1] * rstd * gv[1], v[4 * w + 2] * rstd * gv[2], v[4 * w + 3] * rstd * gv[3]}; }
    }
}
__device__ __forceinline__ void rp_combine(Frame& F, const Args& a, int l, int row_lo) {
    const int f_tid = lthread(F.wave), f_lane = f_tid & 63;
    const bf16* X = (const bf16*)(F.ws + WS_X); const unsigned char* Y = (const unsigned char*)(F.ws + WS_Y);
    const float* MOD = (const float*)(F.ws + WS_MOD) + (size_t)l * 9 * (NMOD * D); const float* MODN = MOD + 9 * (NMOD * D);
    const v4u* te = (const v4u*)(F.ws + WS_TE); const v4u* trank = (const v4u*)(F.ws + WS_TRANK);
    const LAS int* TT = (const LAS int*)(F.lds + LDS_TT);
    const bool lastl = (l == DEPTH - 1);
    { LAS float* LM = (LAS float*)F.lds; __syncthreads();
      for (int i = f_tid; i < 9 * 1024; i += 512) LM[CB_G5 + (i & ~1023) + cb_pos(i & 1023)] = MOD[(size_t)(i >> 10) * (NMOD * D) + 5 * D + (i & 1023)];
      if (!lastl) { for (int i = f_tid; i < 18 * 1024; i += 512) LM[CB_MS + (i & ~1023) + cb_pos(i & 1023)] = MODN[(size_t)(i >> 11) * (NMOD * D) + (i & 2047)];
                    for (int i = f_tid; i < 1024; i += 512) LM[CB_GX + cb_pos(i)] = a.in[6][(size_t)(l + 1) * D + i]; }
      else for (int i = f_tid; i < 1024; i += 512) LM[CB_GX + cb_pos(i)] = a.in[8][i];
      __syncthreads(); }
    const int st = F.NGW, row0 = row_lo + F.gw;
    if (row0 >= NT) return;
    const int n = (NT - row0 + st - 1) / st, rlast = row0 + (n - 1) * st;
#define CROW(i) ((row0 + (i) * st) <= rlast ? (row0 + (i) * st) : rlast)
    CombRow R0, R1, R2;
    { const v4u t0 = te[CROW(0)], r0 = trank[CROW(0)], t1 = te[CROW(1)], r1 = trank[CROW(1)], t2 = te[CROW(2)], r2 = trank[CROW(2)];
      comb_issue(R0, X, Y, TT, CROW(0), t0, r0, f_lane); comb_issue(R1, X, Y, TT, CROW(1), t1, r1, f_lane); comb_issue(R2, X, Y, TT, CROW(2), t2, r2, f_lane); }
    v4u teN = te[CROW(3)], trN = trank[CROW(3)];
#define CSTEP(R, i_) do { const v4u teU = teN, trU = trN; teN = te[CROW((i_) + 4)]; trN = trank[CROW((i_) + 4)]; \
        if ((i_) < n) comb_finish(R, F, a, l, CROW(i_), f_lane, lastl); \
        comb_issue(R, X, Y, TT, CROW((i_) + 3), teU, trU, f_lane); } while (0)
    for (int i = 0; i < n; i += 3) { CSTEP(R0, i); CSTEP(R1, i + 1); CSTEP(R2, i + 2); }
#undef CSTEP
#undef CROW
}
#endif

__device__ __forceinline__ void quant_rows384(Frame& F, const bf16* src, unsigned char* dst, float* scale, int R) {
    const int f_lane = lthread(F.wave) & 63;
    for (int r = F.gw; r < R; r += F.NGW) { const unsigned* sp = (const unsigned*)(src + (size_t)r * 384); const unsigned u0 = sp[f_lane], u1 = sp[f_lane + 64], u2 = sp[f_lane + 128];
        const float x0 = bf_lo(u0), x1 = bf_hi(u0), x2 = bf_lo(u1), x3 = bf_hi(u1), x4 = bf_lo(u2), x5 = bf_hi(u2);
        const float am = __uint_as_float(wave_max_u(__float_as_uint(fmaxf(fmaxf(fmaxf(fabsf(x0), fabsf(x1)), fmaxf(fabsf(x2), fabsf(x3))), fmaxf(fabsf(x4), fabsf(x5))))));
        const float qinv = am > 0.f ? 127.f / am : 0.f; const unsigned w0 = q8x4(x0, x1, x2, x3, qinv), w1 = q8x4(x4, x5, 0.f, 0.f, qinv);
        unsigned short* dp = (unsigned short*)(dst + (size_t)r * 512); dp[f_lane] = (unsigned short)(w0 & 0xffffu); dp[f_lane + 64] = (unsigned short)(w0 >> 16); dp[f_lane + 128] = (unsigned short)(w1 & 0xffffu); dp[f_lane + 192] = 0;
        if (f_lane == 0) scale[r] = am > 0.f ? am * (1.f / 127.f) : 1.f; }
}
__device__ __forceinline__ void quant_rows256(Frame& F, const bf16* src, unsigned char* dst, float* scale, int R) {
    const int f_lane = lthread(F.wave) & 63;
    for (int r = F.gw; r < R; r += F.NGW) { const v2u w = ((const v2u*)(src + (size_t)r * 256))[f_lane]; const float x0 = bf_lo(w.x), x1 = bf_hi(w.x), x2 = bf_lo(w.y), x3 = bf_hi(w.y);
        const float am = __uint_as_float(wave_max_u(__float_as_uint(fmaxf(fmaxf(fabsf(x0), fabsf(x1)), fmaxf(fabsf(x2), fabsf(x3))))));
        ((unsigned*)(dst + (size_t)r * 256))[f_lane] = q8x4(x0, x1, x2, x3, am > 0.f ? 127.f / am : 0.f); if (f_lane == 0) scale[r] = am > 0.f ? am * (1.f / 127.f) : 1.f; }
}
struct MRaw { unsigned q[3], c[2], pe; };
__device__ __forceinline__ void mla_issue(MRaw& R, const bf16* A, int row, int lane) {
    const unsigned* ap = (const unsigned*)(A + (size_t)row * MLA_IN_PAD);
#pragma unroll
    for (int j = 0; j < 3; ++j) R.q[j] = ap[lane + 64 * j];
#pragma unroll
    for (int j = 0; j < 2; ++j) R.c[j] = ap[192 + lane + 64 * j];
    R.pe = ap[320 + (lane & 15)];
}
__device__ __forceinline__ void mla_finish(const MRaw& R, Frame& F, int row, int f_lane) {
    bf16* QA = (bf16*)(F.ws + WS_RF); bf16* CKV = (bf16*)(F.ws + WS_RG); bf16* Kb = (bf16*)(F.ws + WS_RB);
    const LAS float* gq = (const LAS float*)F.lds; const LAS float* gk = gq + 384; const LAS float* rope = gq + 640;
    float sq = 0.f, sc = 0.f;
#pragma unroll
    for (int j = 0; j < 3; ++j) { const float x0 = bf_lo(R.q[j]), x1 = bf_hi(R.q[j]); sq += x0 * x0 + x1 * x1; }
#pragma unroll
    for (int j = 0; j < 2; ++j) { const float x0 = bf_lo(R.c[j]), x1 = bf_hi(R.c[j]); sc += x0 * x0 + x1 * x1; }
    const float rq = rsqrtf(wave_sum(sq, f_lane) * (1.f / MLA_QL) + EPS), rc = rsqrtf(wave_sum(sc, f_lane) * (1.f / MLA_KVL) + EPS);
    { float qv[6];
#pragma unroll
      for (int j = 0; j < 3; ++j) { const int e0 = 2 * (f_lane + 64 * j); qv[2 * j] = bf_lo(R.q[j]) * rq * gq[e0]; qv[2 * j + 1] = bf_hi(R.q[j]) * rq * gq[e0 + 1]; }
      float am = 0.f;
#pragma unroll
      for (int j = 0; j < 6; ++j) am = fmaxf(am, fabsf(qv[j]));
      am = __uint_as_float(wave_max_u(__float_as_uint(am)));
      const float qinv = am > 0.f ? 127.f / am : 0.f; const unsigned w0 = q8x4(qv[0], qv[1], qv[2], qv[3], qinv), w1 = q8x4(qv[4], qv[5], 0.f, 0.f, qinv);
      unsigned short* qp8 = (unsigned short*)((unsigned char*)QA + (size_t)row * 512);
      qp8[f_lane] = (unsigned short)(w0 & 0xffffu); qp8[f_lane + 64] = (unsigned short)(w0 >> 16); qp8[f_lane + 128] = (unsigned short)(w1 & 0xffffu); qp8[f_lane + 192] = 0;
      if (f_lane == 0) ((float*)(F.ws + WS_SCKV + 262144))[row] = am > 0.f ? am * (1.f / 127.f) : 1.f; }
    { float cv[4];
#pragma unroll
      for (int j = 0; j < 2; ++j) { const int e0 = 2 * (f_lane + 64 * j); cv[2 * j] = bf_lo(R.c[j]) * rc * gk[e0]; cv[2 * j + 1] = bf_hi(R.c[j]) * rc * gk[e0 + 1]; }
      const float am = __uint_as_float(wave_max_u(__float_as_uint(fmaxf(fmaxf(fabsf(cv[0]), fabsf(cv[1])), fmaxf(fabsf(cv[2]), fabsf(cv[3]))))));
      const float qinv = am > 0.f ? 127.f / am : 0.f; const unsigned w = q8x4(cv[0], cv[1], cv[2], cv[3], qinv);
      unsigned short* cp8 = (unsigned short*)((unsigned char*)CKV + (size_t)row * MLA_KVL);
      cp8[f_lane] = (unsigned short)(w & 0xffffu); cp8[f_lane + 64] = (unsigned short)(w >> 16);
      if (f_lane == 0) ((float*)(F.ws + WS_SCKV))[row] = am > 0.f ? am * (1.f / 127.f) : 1.f; }
    float x0 = bf_lo(R.pe), x1 = bf_hi(R.pe);
    if (row >= NC) { const int t = (row - NC) & 4095, i = f_lane & 15, d = 2 * i, pos = (d & 16) ? (t & 63) : (t >> 6), f = d & 7;
        const float p0 = shx(x0, 4, f_lane), p1 = shx(x1, 4, f_lane); const float sg = (d & 8) ? 1.f : -1.f;
        const LAS float* rp = rope + pos * 16 + 2 * f; x0 = x0 * rp[0] + sg * p0 * rp[1]; x1 = x1 * rp[2] + sg * p1 * rp[3]; }
    const unsigned w = pk2(x0, x1);
    { const int i = f_lane & 15, hb = f_lane >> 4;
#pragma unroll
      for (int hh = 0; hh < 4; ++hh) { const int h = hb * 4 + hh; ((unsigned*)(Kb + (size_t)row * 1536 + 96 * h + 64))[i] = w; } }
}
__device__ __forceinline__ void rp_mla(Frame& F, const Args& a) {
    const int f_tid = lthread(F.wave), f_lane = f_tid & 63;
    const bf16* A = (const bf16*)(F.ws + WS_RE);
    { LAS float* L = (LAS float*)F.lds; const float* rope = (const float*)(F.ws + WS_ROPE); __syncthreads();
      for (int i = f_tid; i < 384; i += 512) L[i] = a.in[12][i];
      for (int i = f_tid; i < 256; i += 512) L[384 + i] = a.in[14][i];
      for (int i = f_tid; i < 1024; i += 512) L[640 + i] = rope[i];
      __syncthreads(); }
    const int st = F.NGW, row0 = F.gw;
    if (row0 >= NT) return;
    const int n = (NT - row0 + st - 1) / st, rlast = row0 + (n - 1) * st;
#define MROW(i) ((row0 + (i) * st) <= rlast ? (row0 + (i) * st) : rlast)
    MRaw R0, R1, R2; mla_issue(R0, A, MROW(0), f_lane); mla_issue(R1, A, MROW(1), f_lane); mla_issue(R2, A, MROW(2), f_lane);
#define MSTEP(R, i_) do { if ((i_) < n) mla_finish(R, F, MROW(i_), f_lane); mla_issue(R, A, MROW((i_) + 3), f_lane); } while (0)
    for (int i = 0; i < n; i += 3) { MSTEP(R0, i); MSTEP(R1, i + 1); MSTEP(R2, i + 2); }
#undef MSTEP
#undef MROW
}

struct GRaw { v4u q0, q1, k0, k1; };
__device__ __forceinline__ void gqa_issue(GRaw& R, const bf16* A, int row, int lane) {
    const bf16* s0 = A + (size_t)row * GQA_QKV + lane * 16; const bf16* s1 = A + (size_t)row * GQA_QKV + 1024 + (lane & 15) * 16;
    R.q0 = *(const v4u*)s0; R.q1 = *(const v4u*)(s0 + 8); R.k0 = *(const v4u*)s1; R.k1 = *(const v4u*)(s1 + 8);
}
__device__ __forceinline__ void gqa_finish(const GRaw& R, Frame& F, int row, int f_lane) {
    bf16* Q = (bf16*)(F.ws + WS_RB); bf16* Kb = Q + (size_t)NT * 1024;
    const LAS float* LG = (const LAS float*)F.lds; const LAS float* rope = LG + 128;
    const float c2 = 0.125f * LOG2E;
    const bool lat = row >= NC; const int t = (row - NC) & 4095;
#pragma unroll
    for (int part = 0; part < 2; ++part) {
        const int ln = part ? (f_lane & 15) : f_lane;
        const v4u w0 = part ? R.k0 : R.q0, w1 = part ? R.k1 : R.q1;
        float x[16]; const unsigned ww[8] = {w0.x, w0.y, w0.z, w0[3], w1.x, w1.y, w1.z, w1[3]};
#pragma unroll
        for (int i = 0; i < 8; ++i) { x[2 * i] = bf_lo(ww[i]); x[2 * i + 1] = bf_hi(ww[i]); }
        float ss = 0.f;
#pragma unroll
        for (int i = 0; i < 16; ++i) ss += x[i] * x[i];
        ss += shx(ss, 1, f_lane); ss += shx(ss, 2, f_lane);
        const float rs = rsqrtf(ss * (1.f / 64.f) + EPS); const LAS float* g = LG + (part ? 64 : 0) + (ln & 3) * 16;
#pragma unroll
        for (int i = 0; i < 16; ++i) x[i] = x[i] * rs * g[i];
        if (lat) { const int sec = (ln >> 1) & 1, pos = sec ? (t & 63) : (t >> 6); const float sg = (ln & 1) ? 1.f : -1.f; const LAS float* rp = rope + pos * 32;
#pragma unroll
            for (int i = 0; i < 16; ++i) { const float pr = shx(x[i], 1, f_lane); x[i] = x[i] * rp[2 * i] + sg * pr * rp[2 * i + 1]; } }
        const float scl = part ? 1.f : c2;
        v4u o0, o1; o0.x = pk2(x[0] * scl, x[1] * scl); o0.y = pk2(x[2] * scl, x[3] * scl); o0.z = pk2(x[4] * scl, x[5] * scl); o0[3] = pk2(x[6] * scl, x[7] * scl);
        o1.x = pk2(x[8] * scl, x[9] * scl); o1.y = pk2(x[10] * scl, x[11] * scl); o1.z = pk2(x[12] * scl, x[13] * scl); o1[3] = pk2(x[14] * scl, x[15] * scl);
        if (part == 0) { bf16* d = Q + (size_t)row * 1024 + ln * 16; *(v4u*)d = o0; *(v4u*)(d + 8) = o1; }
        else if (f_lane < 16) { bf16* d = Kb + (size_t)row * 256 + ln * 16; *(v4u*)d = o0; *(v4u*)(d + 8) = o1; }
    }
}
__device__ __forceinline__ void rp_gqa(Frame& F, const Args& a) {
    const int f_tid = lthread(F.wave), f_lane = f_tid & 63;
    const bf16* A = (const bf16*)(F.ws + WS_RA);
    { LAS float* L = (LAS float*)F.lds; const float* rope = (const float*)(F.ws + WS_ROPE) + 2048; __syncthreads();
      for (int i = f_tid; i < 64; i += 512) { L[i] = a.in[18][i]; L[64 + i] = a.in[19][i]; }
      for (int i = f_tid; i < 2048; i += 512) L[128 + i] = rope[i];
      __syncthreads(); }
    const int st = F.NGW, row0 = F.gw;
    if (row0 >= NT) return;
    const int n = (NT - row0 + st - 1) / st, rlast = row0 + (n - 1) * st;
#define GROW(i) ((row0 + (i) * st) <= rlast ? (row0 + (i) * st) : rlast)
    GRaw R0, R1, R2; gqa_issue(R0, A, GROW(0), f_lane); gqa_issue(R1, A, GROW(1), f_lane); gqa_issue(R2, A, GROW(2), f_lane);
#define GSTEP(R, i_) do { if ((i_) < n) gqa_finish(R, F, GROW(i_), f_lane); gqa_issue(R, A, GROW((i_) + 3), f_lane); } while (0)
    for (int i = 0; i < n; i += 3) { GSTEP(R0, i); GSTEP(R1, i + 1); GSTEP(R2, i + 2); }
#undef GSTEP
#undef GROW
}

template <int DK>
__device__ __forceinline__ void attn_phase(Frame& F, const att::Tens& T, int kvshift  , int kstride, int vstride, int vbase) {
    const int vcu = (F.G % 8 == 0) ? (blockIdx.x % 8) * (F.G / 8) + blockIdx.x / 8 : blockIdx.x;
    if constexpr (DK == 64) {
        for (int u = vcu; u < 2048 + 128; u += F.G) {
            if (u < 2048) { const int b = u >> 8, h = (u >> 4) & 15, qb = u & 15, kvh = h >> kvshift;
                att64::attn_unit<8>(T.Q, T.qpitch, NC + b * SEQ + qb * 256, h * 64, T.K, T.kpitch, kvh * kstride, T.V, T.vpitch, vbase + kvh * vstride, T.O, h * 64, b * LCTX, NC + b * SEQ, 68, (char*)F.lds, F.wave); }
            else { const int q = u - 2048, b = q >> 4, h = q & 15, kvh = h >> kvshift;
                att64::attn_unit<8>(T.Q, T.qpitch, b * LCTX, h * 64, T.K, T.kpitch, kvh * kstride, T.V, T.vpitch, vbase + kvh * vstride, T.O, h * 64, b * LCTX, 0, 4, (char*)F.lds, F.wave); }
        }
        __syncthreads();
    } else {
        for (int u = vcu; u < 2048 + 128; u += F.G) {
            if (u < 2048) { const int b = u >> 8, h = (u >> 4) & 15, qb = u & 15, kvh = h >> kvshift;
                att96::attn_unit<8>(T.Q, T.qpitch, NC + b * SEQ + qb * 256, h * 96, T.K, T.kpitch, kvh * kstride, T.V, T.vpitch, vbase + kvh * vstride, T.O, h * 64, b * LCTX, NC + b * SEQ, 68, (char*)F.lds, F.wave); }
            else { const int q = u - 2048, b = q >> 4, h = q & 15, kvh = h >> kvshift;
                att96::attn_unit<8>(T.Q, T.qpitch, b * LCTX, h * 96, T.K, T.kpitch, kvh * kstride, T.V, T.vpitch, vbase + kvh * vstride, T.O, h * 64, b * LCTX, 0, 4, (char*)F.lds, F.wave); }
        }
        __syncthreads();
    }
}

constexpr int PH_PER_LAYER = 9, PH_TOTAL = 2 + DEPTH * PH_PER_LAYER;
__global__ void __launch_bounds__(512, 2) mk_fwd(Args args) {
    extern __shared__ __attribute__((aligned(16))) unsigned char lds_raw[];
    Frame F;
    F.lds = (LAS unsigned char*)lds_raw; F.ws = args.ws; F.ctl = (gu32*)(args.ws + WS_CTL);
    F.wave = __builtin_amdgcn_readfirstlane(threadIdx.x >> 6); F.G = gridDim.x;
    F.gw = blockIdx.x * 8 + F.wave; F.NGW = F.G * 8;
    if (threadIdx.x < 4) ((LAS unsigned*)(F.lds + LDS_XB))[threadIdx.x] = 0u;
    __syncthreads();
    const int lo = args.ph_lo, hi = args.ph_hi;
    const bool multi = (hi - lo) > 1;
    XcdBarrier bar; bar.bar = (unsigned*)(F.ctl + CW_BAR); bar.x = 0; bar.st = nullptr; bar.wave = F.wave;
    if (multi) bar = xcd_barrier_post((unsigned*)(F.ctl + CW_BAR), (volatile LAS unsigned*)(F.lds + LDS_XB), F.wave);
#define IN(k) (lo <= (k) && (k) < hi)
#define SEAM(k) do { if (IN(k) && IN((k) + 1)) xcd_barrier(bar); } while (0)
    unsigned char* ws0 = args.ws;
#define PH_WS size_t zofs_ = 0; asm volatile("" : "+s"(zofs_)); unsigned char* ws = ws0 + zofs_; F.ws = ws; F.ctl = (gu32*)ws;
    const int G = F.G, cidx = (int)blockIdx.x;

    if (IN(0) && EN(0)) { PH_WS REP(0) { prologue(F, args); SEAM(0); } }
    if (IN(1) && EN(1)) { PH_WS rp_norm1_l0(F, args);
        quant_rows(F, (const bf16*)(ws + WS_WFIN), (unsigned char*)(ws + WS_W8), (float*)(ws + WS_SWP), 2 * 2048);
        quant_rows(F, (const bf16*)(ws + WS_WMIN), (unsigned char*)(ws + WS_W8) + 4 * MiB, (float*)(ws + WS_SWP) + 4096, MLA_IN_PAD);
        quant_rows(F, (const bf16*)(ws + WS_WGQKV), (unsigned char*)(ws + WS_W8) + 5 * MiB, (float*)(ws + WS_SWP) + 4864, GQA_QKV);
        quant_rows256(F, (const bf16*)(ws + WS_WMKVB), (unsigned char*)(ws + WS_WKVB8), (float*)(ws + WS_WKVB8 + MiB), 2048);
        quant_rows384(F, (const bf16*)(ws + WS_WMQB), (unsigned char*)(ws + WS_WQB8), (float*)(ws + WS_WQB8 + MiB), 1536);
        { const int t1 = lthread(F.wave);
          for (int i = cidx * 512 + t1; i < DEPTH * 9 * D; i += G * 512) { const int l = i / (9 * D), rem = i - l * (9 * D), mr = rem >> 10, col = rem & (D - 1), ob = (l % 3 == 0) ? l / 3 : (l % 3 == 1 ? 2 : 3);
              float* gp = (float*)(ws + WS_MOD) + ((size_t)l * 9 + mr) * (NMOD * D) + 2 * D + col; *gp = *gp * ((const float*)(ws + WS_SWO))[ob * D + col]; } }
        SEAM(1); }

    for (int l = 0; l < DEPTH; ++l) {
        const int kind = l % 3, j = l / 3, base = 2 + l * PH_PER_LAYER;
        const bool lastl = (l == DEPTH - 1);

        size_t outB = 0;
        if (kind == 0) {
            if (IN(base + 0) && EN(2)) { PH_WS REP(2) { PolFP p; p.A = (const char*)(ws + WS_W8) + (size_t)j * 2048 * D; p.B = (const char*)(ws + WS_H); p.nt = 8; p.sW = (const float*)(ws + WS_SWP) + j * 2048; p.sH = (const float*)(ws + WS_SH); p.nN = lastl ? 128 : 136; p.G = G; p.c = cidx;
                p.Z = (bf16*)(ws + WS_RA); p.Zc = (bf16*)(ws + WS_RH); pg8::gemm_phase(F.lds, p, F.wave); } }
            SEAM(base + 0);
            if (IN(base + 1) && EN(3)) { PH_WS REP(3) { PolFA p; p.A = (const char*)(ws + WS_MA); p.B = (const char*)(ws + WS_RA); p.nt = 2; p.G = G; p.c = cidx; p.Y = (unsigned char*)(ws + WS_RB); pg8::gemm_phase(F.lds, p, F.wave); } }
            SEAM(base + 1);
            if (IN(base + 2) && EN(4)) { PH_WS REP(4) {
                PolFCl p; p.A = (const char*)(ws + WS_DC); p.B = (const char*)(ws + WS_RB); p.nt = 4; p.G = G; p.c = cidx; p.nunits = lastl ? 512 : 544;
                p.offMC = (unsigned)(WS_MC - WS_DC); p.offZc = (unsigned)(WS_RH - WS_RB); p.F = (unsigned char*)(ws + WS_RC); pg8::gemm_phase(F.lds, p, F.wave); } }
            SEAM(base + 2);
            outB = j;
        } else if (kind == 1) {
            if (IN(base + 0) && EN(5)) { PH_WS REP(5) { PolDenseI8 p; p.A = (const char*)(ws + WS_H); p.B = (const char*)(ws + WS_W8) + 4 * MiB; p.nt = 8; p.nM = NT / 256; p.nN = 3; p.pm0 = 0; p.G = G; p.c = cidx; p.sA = (const float*)(ws + WS_SH); p.sB = (const float*)(ws + WS_SWP) + 4096;
                p.O = (bf16*)(ws + WS_RE); p.ldo = MLA_IN_PAD; pg8::gemm_phase(F.lds, p, F.wave); } }
            SEAM(base + 0);
            if (IN(base + 1) && EN(6)) { PH_WS REP(6) { rp_mla(F, args); } }
            SEAM(base + 1);
            if (IN(base + 2)) { PH_WS REP(7) {
                if (EN(7)) { PolMlaQ p; p.A = (const char*)(ws + WS_RF); p.B = (const char*)(ws + WS_WQB8); p.sA = (const float*)(ws + WS_SCKV + 262144); p.sB = (const float*)(ws + WS_WQB8 + MiB); p.nt = 4; p.nM = NT / 256; p.nN = 6; p.G = G; p.c = cidx; p.Q = (bf16*)(ws + WS_RA);
                  p.rope = (const float*)(ws + WS_ROPE); p.c2 = 0.10206207261596575f * LOG2E; pg8::gemm_phase(F.lds, p, F.wave); }
                if (EN(8)) { PolMlaKV p; p.A = (const char*)(ws + WS_RG); p.B = (const char*)(ws + WS_WKVB8); p.sA = (const float*)(ws + WS_SCKV); p.sB = (const float*)(ws + WS_WKVB8 + MiB); p.nt = 2; p.nM = NT / 256; p.nN = 8; p.G = G; p.c = cidx; p.Kb = (bf16*)(ws + WS_RB); p.Vb = (bf16*)(ws + WS_RD);
                  pg8::gemm_phase(F.lds, p, F.wave); }
            } }
            SEAM(base + 2);
            if (IN(base + 3) && EN(9)) { PH_WS REP(9) { att::Tens T{(const bf16*)(ws + WS_RA), 1536, (const bf16*)(ws + WS_RB), 1536, (const bf16*)(ws + WS_RD), 1024, (bf16*)(ws + WS_RC)}; attn_phase<96>(F, T, 0, 96, 64, 0); } }
            SEAM(base + 3);
            outB = 2;
        } else {
            if (IN(base + 0) && EN(10)) { PH_WS REP(10) { PolDenseI8 p; p.A = (const char*)(ws + WS_H); p.B = (const char*)(ws + WS_W8) + 5 * MiB; p.nt = 8; p.nM = NT / 256; p.nN = 6; p.pm0 = 0; p.G = G; p.c = cidx; p.sA = (const float*)(ws + WS_SH); p.sB = (const float*)(ws + WS_SWP) + 4864;
                p.O = (bf16*)(ws + WS_RA); p.ldo = GQA_QKV; pg8::gemm_phase(F.lds, p, F.wave); } }
            SEAM(base + 0);
            if (IN(base + 1) && EN(11)) { PH_WS REP(11) { rp_gqa(F, args); } }
            SEAM(base + 1);
            if (IN(base + 2) && EN(12)) { PH_WS REP(12) { att::Tens T{(const bf16*)(ws + WS_RB), 1024, (const bf16*)(ws + WS_RB) + (size_t)NT * 1024, 256, (const bf16*)(ws + WS_RA), 1536, (bf16*)(ws + WS_RC)}; attn_phase<64>(F, T, 2, 64, 64, 1280); } }
            SEAM(base + 2);
            outB = 3;
        }
        if (IN(base + 4) && EN(13)) { PH_WS PolOut p; p.A = (const char*)(ws + WS_RC); p.B = (const char*)(ws + WS_WO8) + (size_t)outB * D * D; p.nt = 8; p.nM = lastl ? NL / 256 : NT / 256; p.nN = 4; p.pm0 = lastl ? 8 : 0; p.G = G; p.c = cidx; p.X = (bf16*)(ws + WS_X); p.mod = (const float*)(ws + WS_MOD) + (size_t)l * 9 * (NMOD * D); p.chunk = 2;
            pg8::gemm_phase(F.lds, p, F.wave); }
        SEAM(base + 4);
        if (IN(base + 5) && EN(14)) { PH_WS rp_norm2_router(F, args, l, lastl ? NC : 0); }
        SEAM(base + 5);
        if (IN(base + 6) && EN(15)) { PH_WS REP(15) { moe_table(F, l);
            PolMoe1 p; p.A = (const char*)(ws + WS_H); p.B = (const char*)(ws + WS_WGU) + (size_t)l * NE * 2048 * D; p.nt = 8; p.G = G; p.c = cidx;
            p.swgu = (const float*)(ws + WS_SWGU) + (size_t)l * NE * 2048; p.ssc = (const float*)(ws + WS_SSC);
            p.T.TT = (const LAS int*)(F.lds + LDS_TT); p.T.CN = p.T.TT + 64; p.T.TE = (const LAS int*)(F.lds + LDS_TE); p.stok = (const int*)(ws + WS_STOK); p.bgu = (const float*)(ws + WS_BGU) + (size_t)l * NE * 2048; p.act = (unsigned char*)(ws + WS_ACT);
            pg8::gemm_phase(F.lds, p, F.wave); } }
        SEAM(base + 6);
        if (IN(base + 7) && EN(16)) { PH_WS REP(16) { if (!(IN(base + 6) && EN(15))) moe_table(F, l);
            PolMoe2 p; p.A = (const char*)(ws + WS_ACT); p.B = (const char*)(ws + WS_WDN) + (size_t)l * NE * D * DFF; p.nt = 8; p.G = G; p.c = cidx; p.swd = (const float*)(ws + WS_SWDN) + (size_t)l * NE * D;
            p.T.TT = (const LAS int*)(F.lds + LDS_TT); p.T.CN = p.T.TT + 64; p.T.TE = (const LAS int*)(F.lds + LDS_TE); p.sw = (const float*)(ws + WS_SW); p.bdn = args.in[26] + (size_t)l * NE * D; p.Y = (unsigned char*)(ws + WS_Y);
            pg8::gemm_phase(F.lds, p, F.wave); } }
        SEAM(base + 7);
        if (IN(base + 8) && EN(17)) { PH_WS if (!(IN(base + 6) && EN(15))) moe_table(F, l); rp_combine(F, args, l, lastl ? NC : 0); }
        SEAM(base + 8);
    }
#undef PH_WS
#undef IN
#undef SEAM
}

extern "C" void kernel_launch(void* const* d_in, const int* in_sizes, int n_in, void* d_out, int out_size, void* d_ws, size_t ws_size, hipStream_t stream) {
    static int grid = 0;
    if (grid == 0) {
        if (n_in != 27 || out_size != NL * D || ws_size < WS_END) { fprintf(stderr, "kernel_launch: unexpected problem (n_in %d, out %d, ws %zu < %zu)\n", n_in, out_size, ws_size, (size_t)WS_END); grid = -1; return; }
        int dev = 0, cus = 0, per_cu = 0;
        if (hipGetDevice(&dev) != hipSuccess || hipDeviceGetAttribute(&cus, hipDeviceAttributeMultiprocessorCount, dev) != hipSuccess) { grid = -1; return; }
        if (hipFuncSetAttribute((const void*)mk_fwd, hipFuncAttributeMaxDynamicSharedMemorySize, LDS_BYTES) != hipSuccess) { fprintf(stderr, "kernel_launch: hipFuncSetAttribute failed\n"); grid = -1; return; }
        if (hipOccupancyMaxActiveBlocksPerMultiprocessor(&per_cu, (const void*)mk_fwd, 512, LDS_BYTES) != hipSuccess || per_cu < 1) fprintf(stderr, "kernel_launch: occupancy query says %d\n", per_cu);
        (void)hipGetLastError();
        grid = cus;
    }
    if (grid < 0) return;
    (void)hipMemsetAsync((char*)d_ws + WS_CTL, 0, CTL_ZERO_BYTES, stream);
    Args a{};
    for (int i = 0; i < 27; ++i) a.in[i] = (const float*)d_in[i];
    a.out = (float*)d_out; a.ws = (unsigned char*)d_ws;
#if MK_PER_PHASE
    for (int ph = 0; ph < PH_TOTAL; ++ph) {
        const int l = (ph - 2) / PH_PER_LAYER, s = (ph - 2) % PH_PER_LAYER, kind = l % 3;
        if (ph >= 2) { if (s == 3 && kind != 1) continue; }
        a.ph_lo = ph; a.ph_hi = ph + 1;
        hipLaunchKernelGGL(mk_fwd, dim3(grid), dim3(512), LDS_BYTES, stream, a);
    }
#else
    a.ph_lo = 0; a.ph_hi = PH_TOTAL;
    hipLaunchKernelGGL(mk_fwd, dim3(grid), dim3(512), LDS_BYTES, stream, a);
#endif
}
```

```cpp
#include <hip/hip_runtime.h>
#include <cstdio>
#include <cstdint>

#ifndef MK_PER_PHASE
#define MK_PER_PHASE 0
#endif
#ifndef MK_N2V2
#define MK_N2V2 1
#endif
#ifndef MK_CBV2
#define MK_CBV2 1
#endif
#ifndef MK_N2AGG
#define MK_N2AGG 1
#endif
#ifndef MK_MASK
#define MK_MASK 0xFFFFFFFFu
#endif
#define EN(id) (((MK_MASK) >> (id)) & 1u)
#ifndef MK_REPMASK
#define MK_REPMASK 0u
#endif
#define REP(id) for (int rep_ = 0; rep_ < ((((MK_REPMASK) >> (id)) & 1u) ? 2 : 1); ++rep_)

constexpr int D = 1024, NB = 8, SEQ = 4096, LCTX = 256, DEPTH = 4;
constexpr int NC = NB * LCTX;
constexpr int NL = NB * SEQ;
constexpr int NT = NC + NL;
constexpr int NMOD = 6, NE = 32, TOPK = 4, DFF = 1024;
constexpr int MLA_QL = 384, MLA_KVL = 256, MLA_ROPE = 32, MLA_NOPE = 64, MLA_V = 64, MLA_IN = 672, MLA_IN_PAD = 768, MLA_QD = 96;
constexpr int GQA_NQ = 1024, GQA_NKV = 256, GQA_QKV = 1536;
constexpr int CAP = NT;
constexpr int MAXTILES = 576;
constexpr float EPS = 1e-6f;
constexpr float LOG2E = 1.4426950408889634f;

constexpr size_t MiB = 1u << 20;
constexpr size_t WS_CTL = 0, CTL_ZERO_BYTES = 96 * 1024;
constexpr size_t WS_MOD = 1 * MiB;
constexpr size_t WS_ROPE = 2 * MiB;
constexpr size_t WS_WRT = 2 * MiB + 65536;
constexpr size_t WS_BGU = 3 * MiB;
constexpr size_t WS_MA = 4 * MiB;
constexpr size_t WS_DC = 4 * MiB + 262144;
constexpr size_t WS_MC = 5 * MiB;
constexpr size_t WS_WFIN = 9 * MiB;
constexpr size_t WS_WFOUT = 17 * MiB;
constexpr size_t WS_WMIN = 21 * MiB;
constexpr size_t WS_WMQB = 23 * MiB;
constexpr size_t WS_WMKVB = 25 * MiB;
constexpr size_t WS_WMO = 26 * MiB;
constexpr size_t WS_WGQKV = 28 * MiB;
constexpr size_t WS_WGO = 31 * MiB;
constexpr size_t WS_TE = 34 * MiB;
constexpr size_t WS_TRANK = 35 * MiB;
constexpr size_t WS_STOK = 36 * MiB;
constexpr size_t WS_SW = 41 * MiB;
constexpr size_t WS_X = 64 * MiB;
constexpr size_t WS_H = 200 * MiB;
constexpr size_t WS_RA = 272 * MiB;
constexpr size_t WS_RB = 400 * MiB;
constexpr size_t WS_RC = 528 * MiB;
constexpr size_t WS_RD = 600 * MiB;
constexpr size_t WS_RE = 672 * MiB;
constexpr size_t WS_RF = 728 * MiB;
constexpr size_t WS_RG = 756 * MiB;
constexpr size_t WS_RH = 776 * MiB;
constexpr size_t WS_ACT = 784 * MiB;
constexpr size_t WS_Y = 1072 * MiB;
constexpr size_t WS_WGU = 1360 * MiB;
constexpr size_t WS_SWGU = 1360 * MiB + 256 * MiB;
constexpr size_t WS_SH = 1360 * MiB + 259 * MiB;
constexpr size_t WS_SWP = 1360 * MiB + 259 * MiB + 256 * 1024;
constexpr size_t WS_W8 = 1360 * MiB + 266 * MiB;
constexpr size_t WS_WO8 = 1360 * MiB + 274 * MiB;
constexpr size_t WS_SWO = 1360 * MiB + 278 * MiB;
constexpr size_t WS_WKVB8 = 1360 * MiB + 280 * MiB;
constexpr size_t WS_SCKV = 1360 * MiB + 282 * MiB;
constexpr size_t WS_WQB8 = 1360 * MiB + 283 * MiB;
constexpr size_t WS_SSC = 1360 * MiB + 260 * MiB;
constexpr size_t WS_WDN = 1872 * MiB;
constexpr size_t WS_SWDN = 1872 * MiB + 128 * MiB;
constexpr size_t WS_END = 2128 * MiB;
constexpr int CW_TMO = 0;
constexpr int CW_BAR = 4096;
constexpr int CW_CNT = 16384;

constexpr int RING_BYTES = 131072;
constexpr int LDS_MISC = 135168;
constexpr int LDS_TT = LDS_MISC;
constexpr int LDS_XB = LDS_MISC + 512;
constexpr int LDS_TE = LDS_MISC + 768;
constexpr int LDS_BYTES = 147456;

#define GAS __attribute__((address_space(1)))
#define LAS __attribute__((address_space(3)))
typedef unsigned short bf16;
typedef unsigned v4u __attribute__((ext_vector_type(4)));
typedef unsigned v2u __attribute__((ext_vector_type(2)));
typedef float f32x4 __attribute__((ext_vector_type(4)));
typedef float f32x2 __attribute__((ext_vector_type(2)));
typedef float f32x16 __attribute__((ext_vector_type(16)));
typedef short bf16x8 __attribute__((ext_vector_type(8)));
typedef short s16x4 __attribute__((ext_vector_type(4)));
typedef __bf16 bf16x2_t __attribute__((ext_vector_type(2)));
typedef GAS unsigned gu32;
#define RLX_AGENT __ATOMIC_RELAXED, __HIP_MEMORY_SCOPE_AGENT
#define LDS_WAIT() asm volatile("s_waitcnt lgkmcnt(0)" ::: "memory")
#define VM_WAIT() asm volatile("s_waitcnt vmcnt(0)" ::: "memory")
__device__ __forceinline__ unsigned pk2(float lo, float hi) { f32x2 v = {lo, hi}; bf16x2_t b = __builtin_convertvector(v, bf16x2_t); return __builtin_bit_cast(unsigned, b); }
__device__ __forceinline__ float bf_lo(unsigned u) { return __builtin_bit_cast(float, u << 16); }
__device__ __forceinline__ float bf_hi(unsigned u) { return __builtin_bit_cast(float, u & 0xffff0000u); }
__device__ __forceinline__ float shx(float v, int mask, int lane) { return __int_as_float(__builtin_amdgcn_ds_bpermute((lane ^ mask) << 2, __float_as_int(v))); }
__device__ __forceinline__ float wave_sum(float v, int lane) {
#pragma unroll
    for (int o = 1; o < 64; o <<= 1) v += shx(v, o, lane);
    return v;
}
__device__ __forceinline__ int lane_id_v() { int t; asm volatile("v_mbcnt_lo_u32_b32 %0, -1, 0\n\tv_mbcnt_hi_u32_b32 %0, -1, %0" : "=v"(t)); return t; }
__device__ __forceinline__ int launder_s(int x) { asm volatile("" : "+s"(x)); return x; }
__device__ __forceinline__ int lthread_w(int wave) { return wave * 64 + lane_id_v(); }
__device__ __forceinline__ int modrow_of(int row) { return row < NC ? NB : ((row - NC) >> 12); }

#define XB_TMO      128
#define XB_XCNT(j)  (256  + 64 * (j))
#define XB_XSUB(j)  (1280 + 64 * (j))
#define XB_XGEN(j)  (2304 + 64 * (j))
#define XB_TOP      3328
#define XB_TOPGEN   3392
#define XCD_BAR_WORDS 3456
#define XB_SPIN_CAP (1u << 18)
__device__ __forceinline__ unsigned xb_ld(unsigned* p)              { return __hip_atomic_load(p, __ATOMIC_RELAXED, __HIP_MEMORY_SCOPE_AGENT); }
__device__ __forceinline__ unsigned xb_add(unsigned* p, unsigned v) { return __hip_atomic_fetch_add(p, v, __ATOMIC_RELAXED, __HIP_MEMORY_SCOPE_AGENT); }
__device__ __forceinline__ unsigned xb_xcc_id() { return (unsigned)__builtin_amdgcn_s_getreg((3 << 11) | 20) & 0xFu; }
#define XB_SPIN(cond, bar) do { unsigned _sp = 0; while (cond) { __builtin_amdgcn_s_sleep(1); \
    if ((++_sp & 255u) == 0u) { if (xb_ld(&(bar)[XB_TMO])) break; if (_sp > XB_SPIN_CAP) { atomicAdd(&(bar)[XB_TMO], 1u); break; } } } } while (0)
struct XcdBarrier { unsigned* bar; unsigned x; volatile LAS unsigned* st; int wave; };
__device__ __forceinline__ bool xb_thread0(int wave) { return wave == 0 && lane_id_v() == 0; }
__device__ __forceinline__ XcdBarrier xcd_barrier_post(unsigned* bar, volatile LAS unsigned* st, int wave) {
    XcdBarrier b; b.bar = bar; b.x = xb_xcc_id(); b.st = st; b.wave = wave;
    if (xb_thread0(wave)) (void)xb_add(&bar[XB_XCNT(b.x)], 1u);
    return b;
}
__device__ __forceinline__ void xcd_barrier_complete(unsigned* bar, unsigned x, unsigned& nloc, unsigned& nx) {
    const unsigned G = gridDim.x * gridDim.y * gridDim.z;
    unsigned sum, cnt, mine, sp = 0u;
    for (;;) {
        sum = 0u; cnt = 0u; mine = 0u;
#pragma unroll
        for (unsigned j = 0; j < 16; ++j) { const unsigned c = xb_ld(&bar[XB_XCNT(j)]); sum += c; cnt += (c > 0u) ? 1u : 0u; mine = (j == x) ? c : mine; }
        if (sum == G) break;
        __builtin_amdgcn_s_sleep(1);
        if ((++sp & 255u) == 0u) { if (xb_ld(&bar[XB_TMO])) break; if (sp > XB_SPIN_CAP) { atomicAdd(&bar[XB_TMO], 1u); break; } }
    }
    nloc = mine > 0u ? mine : 1u; nx = cnt > 0u ? cnt : 1u;
}
__device__ __forceinline__ void xcd_barrier(const XcdBarrier& b) {
    asm volatile("s_waitcnt vmcnt(0)" ::: "memory");
    __syncthreads();
    if (xb_thread0(b.wave)) {
        unsigned* bar = b.bar;
        __builtin_amdgcn_s_waitcnt(0);
        unsigned nloc = b.st[0], nx = b.st[1];
        if (nloc == 0u) { xcd_barrier_complete(bar, b.x, nloc, nx); b.st[0] = nloc; b.st[1] = nx; }
        const unsigned old = xb_add(&bar[XB_XSUB(b.x)], 1u);
        const unsigned gen = old / nloc;
        if (old + 1u == (gen + 1u) * nloc) {
            __builtin_amdgcn_fence(__ATOMIC_RELEASE, "agent");
            asm volatile("s_waitcnt vmcnt(0)" ::: "memory");
            const unsigned og = xb_add(&bar[XB_TOP], 1u);
            const unsigned tg = og / nx;
            if (og + 1u == (tg + 1u) * nx) xb_add(&bar[XB_TOPGEN], 1u);
            else XB_SPIN(xb_ld(&bar[XB_TOPGEN]) == tg, bar);
            __builtin_amdgcn_fence(__ATOMIC_ACQUIRE, "agent");
            xb_add(&bar[XB_XGEN(b.x)], 1u);
            asm volatile("s_waitcnt vmcnt(0)" ::: "memory");
        } else {
            XB_SPIN(xb_ld(&bar[XB_XGEN(b.x)]) == gen, bar);
            __builtin_amdgcn_fence(__ATOMIC_ACQUIRE, "agent");
            asm volatile("s_waitcnt vmcnt(0)" ::: "memory");
        }
    }
    __syncthreads();
}

namespace pg8 {
#define PG8_LAS __attribute__((address_space(3)))
constexpr int BM = 256, BK = 64, HALF = 128, HTB = HALF * BK * 2, STAGE_BYTES = 8 * HTB, NXCD = 8, WGM = 8;
__device__ __forceinline__ int lds_byte(int r, int c) { const int st = (r >> 4) * 2 + (c >> 5), rr = r & 15, cc = c & 31, ob = rr * 64 + cc * 2; return st * 1024 + (ob ^ (((ob >> 9) & 1) << 5)); }
__device__ __forceinline__ void stage_rc(int b, int& R, int& C) { const int st = b / 1024, sb = b % 1024, swz = sb ^ (((sb >> 9) & 1) << 5); R = (st >> 1) * 16 + swz / 64; C = (st & 1) * 32 + (swz % 64) / 2; }
__device__ __forceinline__ int perm32(int rho) { const int n = rho >> 4, i = rho & 15; return 8 * (i >> 2) + 4 * n + (i & 3); }
struct Unit { int pm, pn, aux; };
typedef f32x4 Acc[2][2][4][2];
typedef int i32x4 __attribute__((ext_vector_type(4)));
typedef i32x4 AccI[2][2][4][2];
template <bool I8> struct AccSel { typedef f32x4 T; };
template <> struct AccSel<true> { typedef i32x4 T; };
__device__ __forceinline__ f32x4 mma1(bf16x8 b, bf16x8 a, f32x4 c) { return __builtin_amdgcn_mfma_f32_16x16x32_bf16(b, a, c, 0, 0, 0); }
typedef int i32x8 __attribute__((ext_vector_type(8)));
typedef short bf16x16 __attribute__((ext_vector_type(16)));
__device__ __forceinline__ f32x4 mma_f8(bf16x8 b0, bf16x8 b1, bf16x8 a0, bf16x8 a1, f32x4 c) {
    const i32x8 B = __builtin_bit_cast(i32x8, __builtin_shufflevector(b0, b1, 0, 1, 2, 3, 4, 5, 6, 7, 8, 9, 10, 11, 12, 13, 14, 15));
    const i32x8 A = __builtin_bit_cast(i32x8, __builtin_shufflevector(a0, a1, 0, 1, 2, 3, 4, 5, 6, 7, 8, 9, 10, 11, 12, 13, 14, 15));
    return __builtin_amdgcn_mfma_scale_f32_16x16x128_f8f6f4(B, A, c, 0, 0, 0, 0, 0, 0); }
__device__ __forceinline__ i32x4 mma1(bf16x8 b, bf16x8 a, i32x4 c) { return __builtin_amdgcn_mfma_i32_16x16x64_i8(__builtin_bit_cast(i32x4, b), __builtin_bit_cast(i32x4, a), c, 0, 0, 0); }

__device__ __forceinline__ bool static_next(int i, int G, int c, int nM, int nN, int& pm, int& pn) {
    const int nwg = nM * nN; const long L = (long)i * G + c; if (L >= nwg) return false;
    int wgid = (int)L; { const int q = nwg / NXCD, r = nwg % NXCD, xcd = wgid % NXCD, off = wgid / NXCD; wgid = (xcd < r ? xcd * (q + 1) : r * (q + 1) + (xcd - r) * q) + off; }
    const int nig = WGM * nN, gid = wgid / nig, fm = gid * WGM, gsz = (nM - fm) < WGM ? (nM - fm) : WGM;
    pm = fm + ((wgid % nig) % gsz); pn = (wgid % nig) / gsz; return true;
}

template <class P>
__device__ __forceinline__ void gemm_phase(PG8_LAS unsigned char* lds, const P& p, int wave_id) {
    wave_id = launder_s(wave_id); int tid_l = lthread_w(wave_id);
    const int tid = tid_l, wid = wave_id, lane = tid & 63, wr = wid >> 2, wc = wid & 3, fr = lane & 15, fq = lane >> 4;
    const int nt = launder_s(p.nt);
    const unsigned ldsw = (unsigned)wid * 1024u;
    const int aoff = lds_byte(wr * 64 + fr, fq * 8), boff = lds_byte(wc * 32 + fr, fq * 8);
    const char* const gA = p.A; const char* const gB = p.B;
#define PG8_SA(b, h) (((b) * 2 + (h)) * HTB)
#define PG8_SB(b, h) ((4 + (b) * 2 + (h)) * HTB)
#define PG8_STAGE(bufoff, gbase, off2, kofs) do { _Pragma("unroll") for (int _i = 0; _i < 2; ++_i) \
        __builtin_amdgcn_global_load_lds((const unsigned*)((gbase) + (size_t)(unsigned)((off2)[_i] + (unsigned)(kofs))), (PG8_LAS unsigned*)(lds + (bufoff) + ldsw + _i * 8192), 16, 0, 0); } while (0)
#define PG8_LDA(dst, b, h) do { _Pragma("unroll") for (int m = 0; m < 4; ++m) _Pragma("unroll") for (int k = 0; k < 2; ++k) dst[m][k] = *(const PG8_LAS bf16x8*)(lds + PG8_SA(b, h) + aoff + m * 2048 + k * 1024); } while (0)
#define PG8_LDB(dst, b, h) do { _Pragma("unroll") for (int n = 0; n < 2; ++n) _Pragma("unroll") for (int k = 0; k < 2; ++k) dst[n][k] = *(const PG8_LAS bf16x8*)(lds + PG8_SB(b, h) + boff + n * 2048 + k * 1024); } while (0)
#define PG8_MMA(ai, bj, At, Bt) do { __builtin_amdgcn_s_setprio(1); _Pragma("unroll") for (int m = 0; m < 4; ++m) _Pragma("unroll") for (int n = 0; n < 2; ++n) { \
        if constexpr (P::F8) acc[ai][bj][m][n] = mma_f8(Bt[n][0], Bt[n][1], At[m][0], At[m][1], acc[ai][bj][m][n]); \
        else { _Pragma("unroll") for (int k = 0; k < 2; ++k) acc[ai][bj][m][n] = mma1(Bt[n][k], At[m][k], acc[ai][bj][m][n]); } } __builtin_amdgcn_s_setprio(0); } while (0)
#define PG8_WAIT_V(n) asm volatile("s_waitcnt vmcnt(" #n ")" ::: "memory")
#define PG8_WAIT_L(n) asm volatile("s_waitcnt lgkmcnt(" #n ")" ::: "memory")
#define PG8_BAR __builtin_amdgcn_s_barrier()
#define PG8_SCHED __builtin_amdgcn_sched_barrier(0)
#define PG8_KEYS(u) do { if (P::KEYS && wid < 4) __builtin_amdgcn_global_load_lds((const unsigned*)p.key_ptr(u, wid * 64 + lane_id_v()), (PG8_LAS unsigned*)(keybuf + wid * 256), 4, 0, 0); } while (0)
#define PG8_OFFS(u, oA, oB) do { const int tid2_ = wid * 64 + lane_id_v();     \
    _Pragma("unroll") for (int _i = 0; _i < 2; ++_i) { int R_, C_; stage_rc(tid2_ * 16 + _i * 8192, R_, C_); const int Rb_ = P::PERM ? ((R_ & ~31) + perm32(R_ & 31)) : R_; \
      _Pragma("unroll") for (int _h = 0; _h < 2; ++_h) { \
        const int key_ = P::KEYS ? ((const PG8_LAS int*)keybuf)[_h * HALF + R_] : 0; \
        oA[_h][_i] = p.a_row(u, _h * HALF + R_, key_) + (unsigned)(C_ * 2); oB[_h][_i] = p.b_row(u, _h * HALF + Rb_) + (unsigned)(C_ * 2); } } } while (0)
    PG8_LAS unsigned char* const keybuf = lds + STAGE_BYTES;
    PG8_LAS unsigned char* const epibuf = lds + 138240; int eslot = 0;
#define PG8_EPRE(u, slot) do { if (P::EPRE && wid < 4) { const int i_ = wid * 64 + lane_id_v(); _Pragma("unroll") for (int j_ = 0; j_ < 3; ++j_) \
        __builtin_amdgcn_global_load_lds((const unsigned*)p.epre_src(u, j_, i_), (PG8_LAS unsigned*)(epibuf + (slot) * 3072 + j_ * 1024 + wid * 256), 4, 0, 0); } } while (0)
    PG8_LAS int* const utab = (PG8_LAS int*)(lds + 133120);
    __syncthreads();
    if (wid == 0) { const int li_ = lane_id_v(); if (li_ < 32) { Unit uu_; uu_.pm = 0; uu_.pn = 0; uu_.aux = 0; const bool ok_ = p.next(li_, uu_); PG8_LAS int* e_ = utab + li_ * 4; e_[0] = uu_.pm; e_[1] = uu_.pn; e_[2] = uu_.aux; e_[3] = ok_ ? 1 : 0; } }
    __syncthreads();
#define PG8_NEXT(i, u, ok) do { const int ii_ = (i); if (ii_ < 32) { const PG8_LAS int* e_ = utab + ii_ * 4; u.pm = __builtin_amdgcn_readfirstlane(e_[0]); u.pn = __builtin_amdgcn_readfirstlane(e_[1]); u.aux = __builtin_amdgcn_readfirstlane(e_[2]); ok = __builtin_amdgcn_readfirstlane(e_[3]) != 0; } else ok = p.next(ii_, u); } while (0)
    Unit cur, nxt; int ui = 0;
    { bool ok0_; PG8_NEXT(0, cur, ok0_); if (!ok0_) return; }
    typedef typename AccSel<P::I8>::T AccT;
    AccT acc[2][2][4][2];
#pragma unroll
    for (int a = 0; a < 2; ++a)
#pragma unroll
        for (int b = 0; b < 2; ++b)
#pragma unroll
            for (int m = 0; m < 4; ++m)
#pragma unroll
                for (int n = 0; n < 2; ++n) acc[a][b][m][n] = (AccT){0, 0, 0, 0};
    bf16x8 At[4][2], B0[2][2], B1[2][2];
    unsigned oAc[2][2], oBc[2][2];
    if (P::KEYS || P::EPRE) { PG8_KEYS(cur); PG8_EPRE(cur, 0); PG8_WAIT_V(0); PG8_BAR; }
    PG8_OFFS(cur, oAc, oBc);
    PG8_STAGE(PG8_SB(0, 0), gB, oBc[0], 0); PG8_STAGE(PG8_SB(0, 1), gB, oBc[1], 0); PG8_STAGE(PG8_SA(0, 0), gA, oAc[0], 0); PG8_STAGE(PG8_SA(0, 1), gA, oAc[1], 0);
    if (wr == 1) PG8_BAR;
    PG8_WAIT_V(2); PG8_BAR;
    PG8_STAGE(PG8_SB(1, 0), gB, oBc[0], 128); PG8_STAGE(PG8_SA(1, 0), gA, oAc[0], 128); PG8_STAGE(PG8_SB(1, 1), gB, oBc[1], 128);
    PG8_WAIT_V(6); PG8_BAR;
    bool has_next; PG8_NEXT(1, nxt, has_next);
    if (has_next) { PG8_KEYS(nxt); PG8_EPRE(nxt, 1); }
    for (;;) {
        for (int t = 0; t < nt; t += 2) {
            const bool last = (t == nt - 2);
            const unsigned k1 = (unsigned)(t + 1) * 128u;
            const unsigned k2 = last ? 0u : (unsigned)(t + 2) * 128u, k3 = k2 + 128u;
            PG8_LDB(B0, 0, 0); PG8_LDB(B1, 0, 1); PG8_SCHED; PG8_LDA(At, 0, 0); PG8_STAGE(PG8_SA(1, 1), gA, oAc[1], k1);
            if (last && has_next) { PG8_OFFS(nxt, oAc, oBc); }
            PG8_WAIT_V(8); PG8_WAIT_L(0); PG8_BAR; PG8_MMA(0, 0, At, B0); PG8_MMA(0, 1, At, B1); PG8_BAR; PG8_SCHED;
            PG8_LDA(At, 0, 1); PG8_STAGE(PG8_SB(0, 0), gB, oBc[0], k2); PG8_STAGE(PG8_SB(0, 1), gB, oBc[1], k2); PG8_STAGE(PG8_SA(0, 0), gA, oAc[0], k2);
            PG8_WAIT_V(8); PG8_WAIT_L(0); PG8_BAR; PG8_MMA(1, 0, At, B0); PG8_MMA(1, 1, At, B1); PG8_BAR; PG8_SCHED;
            PG8_LDB(B0, 1, 0); PG8_LDB(B1, 1, 1); PG8_SCHED; PG8_LDA(At, 1, 0); PG8_STAGE(PG8_SA(0, 1), gA, oAc[1], k2);
            PG8_WAIT_V(8); PG8_WAIT_L(0); PG8_BAR; PG8_MMA(0, 0, At, B0); PG8_MMA(0, 1, At, B1); PG8_BAR; PG8_SCHED;
            PG8_LDA(At, 1, 1); PG8_STAGE(PG8_SB(1, 0), gB, oBc[0], k3); PG8_STAGE(PG8_SB(1, 1), gB, oBc[1], k3); PG8_STAGE(PG8_SA(1, 0), gA, oAc[0], k3);
            PG8_WAIT_V(8); PG8_WAIT_L(0); PG8_BAR; PG8_MMA(1, 0, At, B0); PG8_MMA(1, 1, At, B1); PG8_BAR; PG8_SCHED;
        }
        if (wr == 0) PG8_BAR;
        { const int le_ = lane_id_v(); int fr_e = le_ & 15, fq_e = le_ >> 4;
          if constexpr (P::EPRE) p.epi(acc, cur, wr, wc, fr_e, fq_e, (const PG8_LAS float*)(epibuf + eslot * 3072)); else p.epi(acc, cur, wr, wc, fr_e, fq_e); }
        if (!has_next) break;
        cur = nxt; ++ui; eslot = (eslot == 2 ? 0 : eslot + 1);
        PG8_NEXT(ui + 1, nxt, has_next);
        if (has_next) { PG8_KEYS(nxt); PG8_EPRE(nxt, (eslot == 2 ? 0 : eslot + 1)); }
#pragma unroll
        for (int a = 0; a < 2; ++a)
#pragma unroll
            for (int b = 0; b < 2; ++b)
#pragma unroll
                for (int m = 0; m < 4; ++m)
#pragma unroll
                    for (int n = 0; n < 2; ++n) acc[a][b][m][n] = (AccT){0, 0, 0, 0};
        if (wr == 1) PG8_BAR;
    }
    PG8_WAIT_V(0);
    PG8_BAR;
#undef PG8_SA
#undef PG8_SB
#undef PG8_STAGE
#undef PG8_LDA
#undef PG8_LDB
#undef PG8_MMA
#undef PG8_WAIT_V
#undef PG8_WAIT_L
#undef PG8_BAR
#undef PG8_SCHED
#undef PG8_OFFS
#undef PG8_KEYS
#undef PG8_NEXT
#undef PG8_EPRE
}
}
using pg8::Unit;

#define TROW(ai, wr, m, fr) (128 * (ai) + 64 * (wr) + 16 * (m) + (fr))
#define TCOLP(bj, wc, fq) (128 * (bj) + 32 * (wc) + 8 * (fq))
#define TCOLN(bj, wc, n, fq) (128 * (bj) + 32 * (wc) + 16 * (n) + 4 * (fq))
__device__ __forceinline__ v4u pack8(const f32x4 a, const f32x4 b) { v4u w; w.x = pk2(a[0], a[1]); w.y = pk2(a[2], a[3]); w.z = pk2(b[0], b[1]); w.w = pk2(b[2], b[3]); return w; }

__device__ __forceinline__ unsigned q8x4(float a, float b, float c, float d, float s) {
    const unsigned ua = __float_as_uint(fmaf(a, s, 12582912.f)), ub = __float_as_uint(fmaf(b, s, 12582912.f)), uc = __float_as_uint(fmaf(c, s, 12582912.f)), ud = __float_as_uint(fmaf(d, s, 12582912.f));
    return __builtin_amdgcn_perm(ub, ua, 0x0c0c0400u) | __builtin_amdgcn_perm(ud, uc, 0x04000c0cu); }
__device__ __forceinline__ v2u pack8_fp8(f32x4 a, f32x4 b) {
#pragma unroll
    for (int q = 0; q < 4; ++q) { a[q] = __builtin_amdgcn_fmed3f(a[q], -448.f, 448.f); b[q] = __builtin_amdgcn_fmed3f(b[q], -448.f, 448.f); }
    int t0 = __builtin_amdgcn_cvt_pk_fp8_f32(a[0], a[1], 0, false); t0 = __builtin_amdgcn_cvt_pk_fp8_f32(a[2], a[3], t0, true);
    int t1 = __builtin_amdgcn_cvt_pk_fp8_f32(b[0], b[1], 0, false); t1 = __builtin_amdgcn_cvt_pk_fp8_f32(b[2], b[3], t1, true); v2u o; o.x = (unsigned)t0; o.y = (unsigned)t1; return o; }
template <class T> __device__ __forceinline__ const T* ub_at(const T* base, unsigned idx) { return (const T*)((const char*)base + (size_t)(unsigned)(idx * 4u)); }
struct PolDenseBf16 {
    static constexpr bool EPRE = false; __device__ __forceinline__ const float* epre_src(const Unit&, int, int) const { return nullptr; }
    static constexpr bool PERM = true;
    static constexpr bool KEYS = false;
    static constexpr bool I8 = false;
    static constexpr bool F8 = false;
    __device__ __forceinline__ const int* key_ptr(const Unit&, int) const { return nullptr; }
    const char* A; const char* B; int nt; int nM, nN, pm0, G, c; unsigned pitchA, pitchB; bf16* O; int ldo;
    __device__ __forceinline__ bool next(int i, Unit& u) const { int pm, pn; if (!pg8::static_next(i, G, c, nM, nN, pm, pn)) return false; u.pm = pm + pm0; u.pn = pn; u.aux = 0; return true; }
    __device__ __forceinline__ unsigned a_row(const Unit& u, int r, int) const { return (unsigned)(u.pm * 256 + r) * pitchA; }
    __device__ __forceinline__ unsigned b_row(const Unit& u, int r) const { return (unsigned)(u.pn * 256 + r) * pitchB; }
    __device__ __forceinline__ void epi(const pg8::Acc& acc, const Unit& u, int wr, int wc, int fr, int fq) const {
#pragma unroll
        for (int ai = 0; ai < 2; ++ai)
#pragma unroll
            for (int m = 0; m < 4; ++m) { const size_t row = (size_t)u.pm * 256 + TROW(ai, wr, m, fr);
#pragma unroll
                for (int bj = 0; bj < 2; ++bj) { const int col = u.pn * 256 + TCOLP(bj, wc, fq); *(v4u*)(O + row * ldo + col) = pack8(acc[ai][bj][m][0], acc[ai][bj][m][1]); } }
    }
};

struct PolDenseI8 {
    static constexpr bool EPRE = true;
    __device__ __forceinline__ const float* epre_src(const Unit& u, int j, int i) const { return j == 1 ? ub_at(sB + u.pn * 256, (unsigned)i) : ub_at(sA + (size_t)u.pm * 256, (unsigned)i); }
    static constexpr bool PERM = true;
    static constexpr bool KEYS = false;
    static constexpr bool I8 = true;
    static constexpr bool F8 = false;
    __device__ __forceinline__ const int* key_ptr(const Unit&, int) const { return nullptr; }
    const char* A; const char* B; int nt; int nM, nN, pm0, G, c; const float* sA; const float* sB; bf16* O; int ldo;
    __device__ __forceinline__ bool next(int i, Unit& u) const { int pm, pn; if (!pg8::static_next(i, G, c, nM, nN, pm, pn)) return false; u.pm = pm + pm0; u.pn = pn; u.aux = 0; return true; }
    __device__ __forceinline__ unsigned a_row(const Unit& u, int r, int) const { return (unsigned)(u.pm * 256 + r) * 1024u; }
    __device__ __forceinline__ unsigned b_row(const Unit& u, int r) const { return (unsigned)(u.pn * 256 + r) * 1024u; }
    __device__ __forceinline__ void epi(const pg8::AccI& acc, const Unit& u, int wr, int wc, int fr, int fq, const LAS float* eb) const {
#pragma unroll
        for (int bj = 0; bj < 2; ++bj) { const int cl = TCOLP(bj, wc, fq), col = u.pn * 256 + cl; const f32x4 s0 = *(const LAS f32x4*)(eb + 256 + cl), s1 = *(const LAS f32x4*)(eb + 256 + cl + 4);
#pragma unroll
            for (int ai = 0; ai < 2; ++ai)
#pragma unroll
                for (int m = 0; m < 4; ++m) { const int rr = TROW(ai, wr, m, fr); const size_t row = (size_t)u.pm * 256 + rr; const float sa = eb[rr]; f32x4 v0, v1;
#pragma unroll
                    for (int q = 0; q < 4; ++q) { v0[q] = (float)acc[ai][bj][m][0][q] * (sa * s0[q]); v1[q] = (float)acc[ai][bj][m][1][q] * (sa * s1[q]); }
                    *(v4u*)(O + row * ldo + col) = pack8(v0, v1); } }
    }
};

struct PolOut {
    static constexpr bool EPRE = false; __device__ __forceinline__ const float* epre_src(const Unit&, int, int) const { return nullptr; }
    static constexpr bool PERM = true;
    static constexpr bool KEYS = false;
    static constexpr bool I8 = false;
    static constexpr bool F8 = true;
    __device__ __forceinline__ const int* key_ptr(const Unit&, int) const { return nullptr; }
    const char* A; const char* B; int nt; int nM, nN, pm0, G, c; bf16* X; const float* mod;
    int chunk;
    __device__ __forceinline__ bool next(int i, Unit& u) const { int pm, pn; if (!pg8::static_next(i, G, c, nM, nN, pm, pn)) return false; u.pm = pm + pm0; u.pn = pn; u.aux = 0; return true; }
    __device__ __forceinline__ unsigned a_row(const Unit& u, int r, int) const { return (unsigned)(u.pm * 256 + r) * 1024u; }
    __device__ __forceinline__ unsigned b_row(const Unit& u, int r) const { return (unsigned)(u.pn * 256 + r) * 1024u; }
    __device__ __forceinline__ void epi(const pg8::Acc& acc, const Unit& u, int wr, int wc, int fr, int fq) const {
        const int mr = modrow_of(u.pm * 256);
        const float* g = mod + (size_t)mr * (NMOD * D) + chunk * D;
#pragma unroll
        for (int bj = 0; bj < 2; ++bj) { const int col = u.pn * 256 + TCOLP(bj, wc, fq); const f32x4 g0 = *(const f32x4*)(g + col), g1 = *(const f32x4*)(g + col + 4);
#pragma unroll
            for (int ai = 0; ai < 2; ++ai)
#pragma unroll
                for (int m = 0; m < 4; ++m) { const size_t off = ((size_t)u.pm * 256 + TROW(ai, wr, m, fr)) * D + col; f32x4 x0, x1;
                    { const v4u w = *(const v4u*)(X + off); x0 = (f32x4){bf_lo(w.x), bf_hi(w.x), bf_lo(w.y), bf_hi(w.y)}; x1 = (f32x4){bf_lo(w.z), bf_hi(w.z), bf_lo(w[3]), bf_hi(w[3])}; }
                    *(v4u*)(X + off) = pack8(x0 + g0 * acc[ai][bj][m][0], x1 + g1 * acc[ai][bj][m][1]); } }
    }
};

struct PolFP {
    static constexpr bool EPRE = true;
    __device__ __forceinline__ const float* epre_src(const Unit& u, int j, int i) const { return j == 1 ? ub_at(sH, (unsigned)tok_row(u.pn, u.pn * 256 + i)) : ub_at(sW + u.pm * 256, (unsigned)i); }
    static constexpr bool PERM = true;
    static constexpr bool KEYS = false;
    static constexpr bool I8 = true;
    static constexpr bool F8 = false;
    __device__ __forceinline__ const int* key_ptr(const Unit&, int) const { return nullptr; }
    const char* A; const char* B; int nt; int nN, G, c; const float* sW; const float* sH; bf16* Z; bf16* Zc;
    __device__ __forceinline__ bool next(int i, Unit& u) const { int pm, pn; if (!pg8::static_next(i, G, c, 8, nN, pm, pn)) return false; u.pm = pm; u.pn = pn; u.aux = 0; return true; }
    __device__ __forceinline__ unsigned a_row(const Unit& u, int r, int) const { return (unsigned)(u.pm * 256 + r) * 1024u; }
    __device__ __forceinline__ int tok_row(int pn, int n) const { if (pn < 128) { const int b = n >> 12, l2 = (n >> 6) & 63, l1 = n & 63; return NC + b * SEQ + 64 * l1 + l2; } return n - 32768; }
    __device__ __forceinline__ unsigned b_row(const Unit& u, int r) const { return (unsigned)tok_row(u.pn, u.pn * 256 + r) * 1024u; }
    __device__ __forceinline__ void epi(const pg8::AccI& acc, const Unit& u, int wr, int wc, int fr, int fq, const LAS float* eb) const {
#pragma unroll
        for (int bj = 0; bj < 2; ++bj) { const int cl = TCOLP(bj, wc, fq), n0 = u.pn * 256 + cl;
            const f32x4 h0 = *(const LAS f32x4*)(eb + 256 + cl), h1 = *(const LAS f32x4*)(eb + 256 + cl + 4);
#pragma unroll
            for (int ai = 0; ai < 2; ++ai)
#pragma unroll
                for (int m = 0; m < 4; ++m) { const int rr = TROW(ai, wr, m, fr), cp = u.pm * 256 + rr; const float sw = eb[rr]; f32x4 v0, v1;
#pragma unroll
                    for (int q = 0; q < 4; ++q) { v0[q] = (float)acc[ai][bj][m][0][q] * (sw * h0[q]); v1[q] = (float)acc[ai][bj][m][1][q] * (sw * h1[q]); }
                    if (u.pn < 128) *(v2u*)((unsigned char*)Z + ((size_t)(n0 >> 6) * 2048 + cp) * 64 + (n0 & 63)) = pack8_fp8(v0, v1);
                    else { const int b = u.pn - 128, l = n0 - 32768 - b * 256; *(v2u*)((unsigned char*)Zc + ((size_t)b * 2048 + cp) * 256 + l) = pack8_fp8(v0, v1); } } }
    }
};

struct PolFA {
    static constexpr bool EPRE = false; __device__ __forceinline__ const float* epre_src(const Unit&, int, int) const { return nullptr; }
    static constexpr bool PERM = true;
    static constexpr bool KEYS = false;
    static constexpr bool I8 = false;
    static constexpr bool F8 = true;
    __device__ __forceinline__ const int* key_ptr(const Unit&, int) const { return nullptr; }
    const char* A; const char* B; int nt; int G, c; unsigned char* Y;
    __device__ __forceinline__ bool next(int i, Unit& u) const { const int L = i * G + c; if (L >= 1024) return false; u.pm = 0; u.pn = L & 127; u.aux = L >> 7; return true; }
    __device__ __forceinline__ unsigned a_row(const Unit&, int r, int) const { return (unsigned)r * 256u; }
    __device__ __forceinline__ unsigned b_row(const Unit& u, int r) const { const int l2 = r & 63, cp = u.pn * 4 + (r >> 6); return (unsigned)((u.aux * 64 + l2) * 512 + cp) * 256u; }
    __device__ __forceinline__ void epi(const pg8::Acc& acc, const Unit& u, int wr, int wc, int fr, int fq) const {
        const int b = u.aux;
#pragma unroll
        for (int ai = 0; ai < 2; ++ai)
#pragma unroll
            for (int m = 0; m < 4; ++m) { const int rr = TROW(ai, wr, m, fr), jp = rr >> 7, pp = (rr >> 6) & 1, k1 = rr & 63;
#pragma unroll
                for (int bj = 0; bj < 2; ++bj) { const int n0 = u.pn * 256 + TCOLP(bj, wc, fq), cp = n0 >> 6, l2 = n0 & 63, cc = 2 * cp + jp;
                    const unsigned idx = (unsigned)(((((b * 16 + (k1 >> 2)) * 1024 + cc) * 4 + (k1 & 3)) * 2 + pp) * 64 + l2);
                    *(v2u*)(Y + idx) = pack8_fp8(acc[ai][bj][m][0] * 0.03125f, acc[ai][bj][m][1] * 0.03125f); } }
    }
};

struct PolFC {
    static constexpr bool EPRE = false; __device__ __forceinline__ const float* epre_src(const Unit&, int, int) const { return nullptr; }
    static constexpr bool PERM = true;
    static constexpr bool KEYS = false;
    static constexpr bool I8 = false;
    static constexpr bool F8 = false;
    __device__ __forceinline__ const int* key_ptr(const Unit&, int) const { return nullptr; }
    const char* A; const char* B; int nt; int G, c; int nunits, l0; unsigned offMC, offZc; unsigned char* F;
    __device__ __forceinline__ bool next(int i, Unit& u) const { const int L = i * G + c + l0; if (L >= nunits) return false;
        if (L < 512) { u.pm = 0; u.pn = L & 3; u.aux = L >> 2; } else { const int q = L - 512; u.pm = 0; u.pn = q & 3; u.aux = 256 + (q >> 2); } return true; }
    __device__ __forceinline__ unsigned a_row(const Unit& u, int r, int) const {
        if (u.aux < 256) return offMC + (unsigned)((u.aux & 15) * 256 + r) * 1024u;
        return (unsigned)r * 1024u; }
    __device__ __forceinline__ unsigned b_row(const Unit& u, int r) const {
        if (u.aux < 256) return (unsigned)(u.aux * 1024 + u.pn * 256 + r) * 1024u;
        return offZc + (unsigned)((u.aux - 256) * 1024 + u.pn * 256 + r) * 1024u; }
    __device__ __forceinline__ void epi(const pg8::Acc& acc, const Unit& u, int wr, int wc, int fr, int fq) const {
#pragma unroll
        for (int ai = 0; ai < 2; ++ai)
#pragma unroll
            for (int m = 0; m < 4; ++m) { const int rr = TROW(ai, wr, m, fr); size_t frow;
                if (u.aux < 256) { const int b = u.aux >> 4, kq = u.aux & 15, k = 4 * kq + (rr >> 6) + 64 * (rr & 63); frow = (size_t)NC + b * SEQ + k; }
                else frow = (size_t)(u.aux - 256) * LCTX + rr;
#pragma unroll
                for (int bj = 0; bj < 2; ++bj) { const int col = u.pn * 256 + TCOLP(bj, wc, fq); *(v2u*)(F + frow * D + col) = pack8_fp8(acc[ai][bj][m][0], acc[ai][bj][m][1]); } }
    }
};

struct PolFCl {
    static constexpr bool EPRE = false; __device__ __forceinline__ const float* epre_src(const Unit&, int, int) const { return nullptr; }
    static constexpr bool PERM = true;
    static constexpr bool KEYS = false;
    static constexpr bool I8 = false;
    static constexpr bool F8 = true;
    __device__ __forceinline__ const int* key_ptr(const Unit&, int) const { return nullptr; }
    const char* A; const char* B; int nt; int G, c; int nunits; unsigned offMC, offZc; unsigned char* F;
    __device__ __forceinline__ bool next(int i, Unit& u) const { const int L = i * G + c; if (L >= nunits) return false;
        if (L < 512) { u.pm = 0; u.pn = L & 3; u.aux = L >> 2; } else { const int q = L - 512; u.pm = 0; u.pn = q & 3; u.aux = 256 + (q >> 2); } return true; }
    __device__ __forceinline__ unsigned a_row(const Unit& u, int r, int) const { return u.aux < 256 ? offMC + (unsigned)((u.aux & 15) * 256 + r) * 512u : (unsigned)r * 512u; }
    __device__ __forceinline__ unsigned b_row(const Unit& u, int r) const { return u.aux < 256 ? (unsigned)(u.aux * 1024 + u.pn * 256 + r) * 512u : offZc + (unsigned)((u.aux - 256) * 1024 + u.pn * 256 + r) * 512u; }
    __device__ __forceinline__ void epi(const pg8::Acc& acc, const Unit& u, int wr, int wc, int fr, int fq) const {
        const bool lat = u.aux < 256; const float sc = lat ? 0.125f : 0.015625f;
#pragma unroll
        for (int ai = 0; ai < 2; ++ai)
#pragma unroll
            for (int m = 0; m < 4; ++m) { const int rr = TROW(ai, wr, m, fr); size_t frow;
                if (lat) { const int b = u.aux >> 4, kq = u.aux & 15, k = 4 * kq + (rr >> 6) + 64 * (rr & 63); frow = (size_t)NC + b * SEQ + k; }
                else frow = (size_t)(u.aux - 256) * LCTX + rr;
#pragma unroll
                for (int bj = 0; bj < 2; ++bj) { const int col = u.pn * 256 + TCOLP(bj, wc, fq); *(v2u*)(F + frow * D + col) = pack8_fp8(acc[ai][bj][m][0] * sc, acc[ai][bj][m][1] * sc); } }
    }
};

struct PolMlaQ {
    static constexpr bool EPRE = true;
    __device__ __forceinline__ const float* epre_src(const Unit& u, int j, int i) const { return j == 1 ? ub_at(sB + u.pn * 256, (unsigned)i) : ub_at(sA + (size_t)u.pm * 256, (unsigned)i); }
    static constexpr bool PERM = true;
    static constexpr bool KEYS = false;
    static constexpr bool I8 = true;
    static constexpr bool F8 = false;
    __device__ __forceinline__ const int* key_ptr(const Unit&, int) const { return nullptr; }
    const char* A; const char* B; int nt; int nM, nN, G, c; bf16* Q; const float* rope; float c2; const float* sA; const float* sB;
    __device__ __forceinline__ bool next(int i, Unit& u) const { int pm, pn; if (!pg8::static_next(i, G, c, nM, nN, pm, pn)) return false; u.pm = pm; u.pn = pn; u.aux = 0; return true; }
    __device__ __forceinline__ unsigned a_row(const Unit& u, int r, int) const { return (unsigned)(u.pm * 256 + r) * 512u; }
    __device__ __forceinline__ unsigned b_row(const Unit& u, int r) const { return (unsigned)(u.pn * 256 + r) * 512u; }
    __device__ __forceinline__ void epi(const pg8::AccI& acc, const Unit& u, int wr, int wc, int fr, int fq, const LAS float* eb) const {
        const bool lat = u.pm >= 8;
#pragma unroll
        for (int bj = 0; bj < 2; ++bj) { const int cl = TCOLP(bj, wc, fq), col = u.pn * 256 + cl; const f32x4 s0 = *(const LAS f32x4*)(eb + 256 + cl), s1 = *(const LAS f32x4*)(eb + 256 + cl + 4); const bool isrope = lat && (((col >> 5) % 3) == 2);
#pragma unroll
            for (int ai = 0; ai < 2; ++ai)
#pragma unroll
                for (int m = 0; m < 4; ++m) { const int rr = TROW(ai, wr, m, fr), row = u.pm * 256 + rr; const float sa = eb[rr]; f32x4 v0, v1;
#pragma unroll
                    for (int e = 0; e < 4; ++e) { v0[e] = (float)acc[ai][bj][m][0][e] * (sa * s0[e]); v1[e] = (float)acc[ai][bj][m][1][e] * (sa * s1[e]); }
                    if (isrope) { const int t = (row - NC) & 4095, pos = (fq & 2) ? (t & 63) : (t >> 6);
                        const f32x4* rp = (const f32x4*)(rope + (size_t)pos * 16);
                        const f32x4 r0 = rp[0], r1 = rp[1], r2 = rp[2], r3 = rp[3];
                        f32x4 p0, p1;
#pragma unroll
                        for (int e = 0; e < 4; ++e) { p0[e] = shx(v0[e], 16, fq * 16 + fr); p1[e] = shx(v1[e], 16, fq * 16 + fr); }
                        const float sg = (fq & 1) ? 1.f : -1.f;
                        v0[0] = v0[0] * r0[0] + sg * p0[0] * r0[1]; v0[1] = v0[1] * r0[2] + sg * p0[1] * r0[3];
                        v0[2] = v0[2] * r1[0] + sg * p0[2] * r1[1]; v0[3] = v0[3] * r1[2] + sg * p0[3] * r1[3];
                        v1[0] = v1[0] * r2[0] + sg * p1[0] * r2[1]; v1[1] = v1[1] * r2[2] + sg * p1[1] * r2[3];
                        v1[2] = v1[2] * r3[0] + sg * p1[2] * r3[1]; v1[3] = v1[3] * r3[2] + sg * p1[3] * r3[3]; }
                    *(v4u*)(Q + (size_t)row * 1536 + col) = pack8(v0 * c2, v1 * c2); } }
    }
};

struct PolMlaKV {
    static constexpr bool EPRE = true;
    __device__ __forceinline__ const float* epre_src(const Unit& u, int j, int i) const { return j == 1 ? ub_at(sB + u.pn * 256, (unsigned)i) : ub_at(sA + (size_t)u.pm * 256, (unsigned)i); }
    static constexpr bool PERM = true;
    static constexpr bool KEYS = false;
    static constexpr bool I8 = true;
    static constexpr bool F8 = false;
    __device__ __forceinline__ const int* key_ptr(const Unit&, int) const { return nullptr; }
    const char* A; const char* B; int nt; int nM, nN, G, c; bf16* Kb; bf16* Vb; const float* sA; const float* sB;
    __device__ __forceinline__ bool next(int i, Unit& u) const { int pm, pn; if (!pg8::static_next(i, G, c, nM, nN, pm, pn)) return false; u.pm = pm; u.pn = pn; u.aux = 0; return true; }
    __device__ __forceinline__ unsigned a_row(const Unit& u, int r, int) const { return (unsigned)(u.pm * 256 + r) * 256u; }
    __device__ __forceinline__ unsigned b_row(const Unit& u, int r) const { return (unsigned)(u.pn * 256 + r) * 256u; }
    __device__ __forceinline__ void epi(const pg8::AccI& acc, const Unit& u, int wr, int wc, int fr, int fq, const LAS float* eb) const {
#pragma unroll
        for (int bj = 0; bj < 2; ++bj) { const int cl = TCOLP(bj, wc, fq), col = u.pn * 256 + cl, h = col >> 7, j = col & 127; const f32x4 s0 = *(const LAS f32x4*)(eb + 256 + cl), s1 = *(const LAS f32x4*)(eb + 256 + cl + 4);
#pragma unroll
            for (int ai = 0; ai < 2; ++ai)
#pragma unroll
                for (int m = 0; m < 4; ++m) { const int rr = TROW(ai, wr, m, fr); const size_t row = (size_t)u.pm * 256 + rr; const float sa = eb[rr]; f32x4 v0, v1;
#pragma unroll
                    for (int q = 0; q < 4; ++q) { v0[q] = (float)acc[ai][bj][m][0][q] * (sa * s0[q]); v1[q] = (float)acc[ai][bj][m][1][q] * (sa * s1[q]); }
                    const v4u w = pack8(v0, v1);
                    if (j < 64) *(v4u*)(Kb + row * 1536 + 96 * h + j) = w; else *(v4u*)(Vb + row * 1024 + 64 * h + (j - 64)) = w; } }
    }
};

struct MoeTab { const LAS int* TT; const LAS int* CN; const LAS int* TE; };
__device__ __forceinline__ bool moe_next(int i, int G, int c, int NP, const MoeTab& T, Unit& u) {
    const int ttot = T.TT[32];
    int lo, hi, j;
    if ((G & 7) == 0) { const int x = c & 7, q = c >> 3, g8 = G >> 3; lo = (x * ttot) >> 3; hi = ((x + 1) * ttot) >> 3; j = i * g8 + q; }
    else { lo = 0; hi = ttot; j = i * G + c; }
    if (j >= (hi - lo) * NP) return false;
    const int tile = lo + j / NP; u.pn = j % NP; u.pm = tile;
    const int e = T.TE[tile];
    u.aux = e | ((tile - T.TT[e]) << 8);
    return true;
}
struct PolMoe1 {
    static constexpr bool EPRE = true;
    __device__ __forceinline__ const float* epre_src(const Unit& u, int j, int i) const { const int e = u.aux & 255; const size_t fo = (size_t)e * 2048 + u.pn * 256;
        if (j == 0) return ub_at(bgu + fo, (unsigned)i); if (j == 1) return ub_at(swgu + fo, (unsigned)i); const unsigned idx = (unsigned)((u.aux >> 8) * 256 + i); return ub_at(ssc + (size_t)e * CAP, idx < (unsigned)T.CN[e] ? idx : 0u); }
    static constexpr bool PERM = true;
    static constexpr bool I8 = true;
    static constexpr bool F8 = false;
    const char* A; const char* B; int nt; int G, c; MoeTab T; const int* stok; const float* bgu; const float* swgu; const float* ssc; unsigned char* act;
    __device__ __forceinline__ bool next(int i, Unit& u) const { return moe_next(i, G, c, 8, T, u); }
    static constexpr bool KEYS = true;
    __device__ __forceinline__ const int* key_ptr(const Unit& u, int r) const { const int e = u.aux & 255; const unsigned idx = (unsigned)((u.aux >> 8) * 256 + r); return ub_at(stok + (size_t)e * CAP, idx < (unsigned)T.CN[e] ? idx : 0u); }
    __device__ __forceinline__ unsigned a_row(const Unit&, int, int key) const { return (unsigned)key * 1024u; }
    __device__ __forceinline__ unsigned b_row(const Unit& u, int r) const { return (unsigned)((u.aux & 255) * 2048 + u.pn * 256 + r) * 1024u; }
    __device__ __forceinline__ void epi(const pg8::AccI& acc, const Unit& u, int wr, int wc, int fr, int fq, const LAS float* eb) const {
        const int jl = 32 * wc + 8 * fq;
        const LAS float* bg = eb + jl; const LAS float* sg = eb + 256 + jl;
        const f32x4 bg0 = *(const LAS f32x4*)(bg), bg1 = *(const LAS f32x4*)(bg + 4), bu0 = *(const LAS f32x4*)(bg + 128) + 1.f, bu1 = *(const LAS f32x4*)(bg + 132) + 1.f;
        const f32x4 sg0 = *(const LAS f32x4*)(sg), sg1 = *(const LAS f32x4*)(sg + 4), su0 = *(const LAS f32x4*)(sg + 128), su1 = *(const LAS f32x4*)(sg + 132);
#pragma unroll
        for (int ai = 0; ai < 2; ++ai)
#pragma unroll
            for (int m = 0; m < 4; ++m) { const int rr = TROW(ai, wr, m, fr); const size_t slot = (size_t)u.pm * 256 + rr;
                const float sa = eb[512 + rr];
                f32x4 o0, o1;
#define MOE1_ACT(OUT, N, SG, BG, SU, BU) do { _Pragma("unroll") for (int hq = 0; hq < 2; ++hq) { \
                    const f32x2 ag = {(float)acc[ai][0][m][N][2 * hq], (float)acc[ai][0][m][N][2 * hq + 1]}, au = {(float)acc[ai][1][m][N][2 * hq], (float)acc[ai][1][m][N][2 * hq + 1]}; \
                    const f32x2 sgp = {SG[2 * hq], SG[2 * hq + 1]}, bgp = {BG[2 * hq], BG[2 * hq + 1]}, sup = {SU[2 * hq], SU[2 * hq + 1]}, bup = {BU[2 * hq], BU[2 * hq + 1]}; \
                    f32x2 g = __builtin_elementwise_fma(ag, sgp * sa, bgp), u = __builtin_elementwise_fma(au, sup * sa, bup); \
                    g[0] = fminf(g[0], 7.f); g[1] = fminf(g[1], 7.f); u[0] = __builtin_amdgcn_fmed3f(u[0], -6.f, 8.f); u[1] = __builtin_amdgcn_fmed3f(u[1], -6.f, 8.f); \
                    const f32x2 z = g * (-1.702f * LOG2E); f32x2 e; e[0] = __builtin_amdgcn_exp2f(z[0]); e[1] = __builtin_amdgcn_exp2f(z[1]); \
                    const f32x2 dd = e + 1.f; f32x2 r; r[0] = __builtin_amdgcn_rcpf(dd[0]); r[1] = __builtin_amdgcn_rcpf(dd[1]); \
                    const f32x2 o = (u * g) * r; OUT[2 * hq] = o[0]; OUT[2 * hq + 1] = o[1]; } } while (0)
                MOE1_ACT(o0, 0, sg0, bg0, su0, bu0); MOE1_ACT(o1, 1, sg1, bg1, su1, bu1);
#undef MOE1_ACT
                v2u w8; { int t0 = __builtin_amdgcn_cvt_pk_fp8_f32(o0[0], o0[1], 0, false); t0 = __builtin_amdgcn_cvt_pk_fp8_f32(o0[2], o0[3], t0, true);
                          int t1 = __builtin_amdgcn_cvt_pk_fp8_f32(o1[0], o1[1], 0, false); t1 = __builtin_amdgcn_cvt_pk_fp8_f32(o1[2], o1[3], t1, true); w8.x = (unsigned)t0; w8.y = (unsigned)t1; }
                *(v2u*)(act + slot * 1024 + u.pn * 128 + jl) = w8; }
    }
};
struct PolMoe2 {
    static constexpr bool EPRE = true;
    __device__ __forceinline__ const float* epre_src(const Unit& u, int j, int i) const { const int e = u.aux & 255; const size_t co = (size_t)e * 1024 + u.pn * 256;
        if (j == 0) return ub_at(bdn + co, (unsigned)i); if (j == 1) return ub_at(swd + co, (unsigned)i); const unsigned idx = (unsigned)((u.aux >> 8) * 256 + i); return ub_at(sw + (size_t)e * CAP, idx < (unsigned)T.CN[e] ? idx : 0u); }
    static constexpr bool PERM = true;
    static constexpr bool KEYS = false;
    static constexpr bool I8 = false;
    static constexpr bool F8 = true;
    __device__ __forceinline__ const int* key_ptr(const Unit&, int) const { return nullptr; }
    const char* A; const char* B; int nt; int G, c; MoeTab T; const float* sw; const float* bdn; const float* swd; unsigned char* Y;
    __device__ __forceinline__ bool next(int i, Unit& u) const { return moe_next(i, G, c, 4, T, u); }
    __device__ __forceinline__ unsigned a_row(const Unit& u, int r, int) const { return (unsigned)(u.pm * 256 + r) * 1024u; }
    __device__ __forceinline__ unsigned b_row(const Unit& u, int r) const { return (unsigned)((u.aux & 255) * 1024 + u.pn * 256 + r) * 1024u; }
    __device__ __forceinline__ void epi(const pg8::Acc& acc, const Unit& u, int wr, int wc, int fr, int fq, const LAS float* eb) const {
#pragma unroll
        for (int bj = 0; bj < 2; ++bj) { const int cl = TCOLP(bj, wc, fq), col = u.pn * 256 + cl;
            const f32x4 b0 = *(const LAS f32x4*)(eb + cl), b1 = *(const LAS f32x4*)(eb + cl + 4), s0 = *(const LAS f32x4*)(eb + 256 + cl), s1 = *(const LAS f32x4*)(eb + 256 + cl + 4);
#pragma unroll
            for (int ai = 0; ai < 2; ++ai)
#pragma unroll
                for (int m = 0; m < 4; ++m) { const int rr = TROW(ai, wr, m, fr); const size_t slot = (size_t)u.pm * 256 + rr; const float w = eb[512 + rr];
                    const float w8 = w * 8.f; f32x4 y0 = (acc[ai][bj][m][0] * s0 + b0) * w8, y1 = (acc[ai][bj][m][1] * s1 + b1) * w8;
#pragma unroll
                    for (int q = 0; q < 4; ++q) { y0[q] = fminf(fmaxf(y0[q], -448.f), 448.f); y1[q] = fminf(fmaxf(y1[q], -448.f), 448.f); }
                    v2u o8; { int t0 = __builtin_amdgcn_cvt_pk_fp8_f32(y0[0], y0[1], 0, false); t0 = __builtin_amdgcn_cvt_pk_fp8_f32(y0[2], y0[3], t0, true);
                              int t1 = __builtin_amdgcn_cvt_pk_fp8_f32(y1[0], y1[1], 0, false); t1 = __builtin_amdgcn_cvt_pk_fp8_f32(y1[2], y1[3], t1, true); o8.x = (unsigned)t0; o8.y = (unsigned)t1; }
                    *(v2u*)(Y + slot * 1024 + col) = o8; } }
    }
};

namespace att {
__device__ __forceinline__ int crow(int r, int hi) { return (r & 3) + 8 * (r >> 2) + 4 * hi; }
__device__ __forceinline__ float max3f(float a, float b, float c) { return fmaxf(fmaxf(a, b), c); }
typedef LAS const char* lds_cptr;
constexpr int LK = 0, LV = 49152, LWS = 90112, LOST = 92160, LBYTES = 124928;
constexpr int PD = 3;
struct Tens { const bf16* Q; int qpitch; const bf16* K; int kpitch; const bf16* V; int vpitch; bf16* O; };
#define ATT_WAITV(n) asm volatile("s_waitcnt vmcnt(" #n ")" ::: "memory")
struct Pend { f32x16 o0, o1; float l; int qrow0, oc0; bool valid; };
__device__ __forceinline__ void finish_unit(const Pend& P, bf16* O, LAS unsigned char* lds, int wid, int lane) {
    const int r32 = lane & 31, hi = lane >> 5;
    LAS float* wsf = (LAS float*)(lds + LWS) + wid * 64;
    float lrun = P.l;
    { auto rr = __builtin_amdgcn_permlane32_swap(__float_as_uint(lrun), __float_as_uint(lrun), false, false); lrun = __uint_as_float(rr[0]) + __uint_as_float(rr[1]); }
    if (hi == 0) wsf[32 + r32] = lrun;
    LDS_WAIT();
    LAS bf16* stg = (LAS bf16*)(lds + LOST) + wid * 2048;
#pragma unroll
    for (int r = 0; r < 16; ++r) { const int orow = crow(r, hi); const float rl = __builtin_amdgcn_rcpf(wsf[32 + orow]);
        stg[orow * 64 + r32] = (bf16)(pk2(P.o0[r] * rl, 0.f) & 0xffffu); stg[orow * 64 + 32 + r32] = (bf16)(pk2(P.o1[r] * rl, 0.f) & 0xffffu); }
    LDS_WAIT();
    bf16* Ow = O + (size_t)(P.qrow0 + wid * 32) * 1024 + P.oc0;
#pragma unroll
    for (int i = 0; i < 4; ++i) { const int row = i * 8 + (lane >> 3), ch = lane & 7; const v4u v = *(const LAS v4u*)(stg + row * 64 + ch * 8); *(v4u*)(Ow + (size_t)row * 1024 + ch * 8) = v; }
    LDS_WAIT();
}
template <int DK>
__device__ __forceinline__ void unit(const Tens& T, int qrow0, int qc0, int kc0, int vc0, int oc0, int kctx0, int klat0, int NTL, LAS unsigned char* lds, int wave_id, Pend& pend) {
    constexpr int ND = DK / 16;
    wave_id = launder_s(wave_id); const int tid = lthread_w(wave_id), lane = tid & 63, r32 = lane & 31, hi = lane >> 5; const int wid = wave_id;
    LAS float* wsf = (LAS float*)(lds + LWS) + wid * 64;
    const bf16* ksrc = T.K + (size_t)lane * T.kpitch + kc0 + wid * 8;
    const int k2off = (8 + (wid & 3) - wid) * 8;
    const bf16* vsrc = T.V + (size_t)(16 * (wid & 3) + (lane >> 2)) * T.vpitch + vc0 + (wid >> 2) * 32 + (lane & 3) * 8;
#define ATT_DMA(t, ks_, vs_) do { const size_t row0_ = (size_t)((t) < 4 ? kctx0 + 64 * (t) : klat0 + 64 * ((t) - 4)); \
        __builtin_amdgcn_global_load_lds((const unsigned*)(ksrc + row0_ * T.kpitch), (LAS unsigned*)(lds + LK + (ks_) * 12288 + wid * 1024), 16, 0, 0); \
        if (DK > 64) __builtin_amdgcn_global_load_lds((const unsigned*)(ksrc + row0_ * T.kpitch + k2off), (LAS unsigned*)(lds + LK + (ks_) * 12288 + 8192 + (wid & 3) * 1024), 16, 0, 0); \
        __builtin_amdgcn_global_load_lds((const unsigned*)(vsrc + row0_ * T.vpitch), (LAS unsigned*)(lds + LV + (vs_) * 8192 + wid * 1024), 16, 0, 0); } while (0)
#define ATT_WAIT_TILES(n_tiles) do { if (DK > 64) { if ((n_tiles) >= 2) ATT_WAITV(6); else if ((n_tiles) == 1) ATT_WAITV(3); else ATT_WAITV(0); } \
        else { if ((n_tiles) >= 2) ATT_WAITV(4); else if ((n_tiles) == 1) ATT_WAITV(2); else ATT_WAITV(0); } } while (0)
    bf16x8 qr[ND];
    { const bf16* qp = T.Q + (size_t)(qrow0 + wid * 32 + r32) * T.qpitch + qc0 + hi * 8;
#pragma unroll
      for (int d0 = 0; d0 < ND; ++d0) qr[d0] = *(const bf16x8*)(qp + d0 * 16); }
    asm volatile("" ::: "memory");
    constexpr float THR = 8.f;
    const int half = wid >> 2;
    float mhat = 0.f, lrun = 0.f; f32x16 o[2]; o[0] = f32x16{}; o[1] = f32x16{}; f32x16 negm = f32x16{};
    f32x16 p0 = f32x16{}, p1 = f32x16{}; v4u pw[4]; pw[0] = pw[1] = pw[2] = pw[3] = (v4u){0u, 0u, 0u, 0u};
    ATT_DMA(0, 0, 0); ATT_DMA(1, 1, 1); ATT_DMA(2, 2, 2);
    if (pend.valid) finish_unit(pend, T.O, lds, wid, lane);
    ATT_WAIT_TILES(2);
    __builtin_amdgcn_s_barrier(); asm volatile("" ::: "memory");
    if (half == 1) __builtin_amdgcn_s_barrier();
    int vs_prev = 0, vs_cur = 0, vs_iss = 3;
    for (int t = 0; t <= NTL; ++t) {
        if (t >= 1) {
            s16x4 lo[2][4], hh[2][4];
            const unsigned vb = (unsigned)(uintptr_t)(lds + LV + vs_prev * 8192) + ((lane >> 4) & 1) * 32 + (lane & 3) * 8 + (4 * hi + ((lane & 15) >> 2)) * 64;
#pragma unroll
            for (int d0 = 0; d0 < 2; ++d0)
#pragma unroll
                for (int ks = 0; ks < 4; ++ks) {
                    asm volatile("ds_read_b64_tr_b16 %0,%1 offset:%c2" : "=&v"(lo[d0][ks]) : "v"(vb), "i"(d0 * 4096 + ks * 1024) : "memory");
                    asm volatile("ds_read_b64_tr_b16 %0,%1 offset:%c2" : "=&v"(hh[d0][ks]) : "v"(vb), "i"(d0 * 4096 + ks * 1024 + 512) : "memory"); }
            asm volatile("s_waitcnt lgkmcnt(0)" ::: "memory"); __builtin_amdgcn_sched_barrier(0);
#pragma unroll
            for (int ks = 0; ks < 4; ++ks)
#pragma unroll
                for (int d0 = 0; d0 < 2; ++d0) { const bf16x8 vf = (bf16x8){lo[d0][ks][0], lo[d0][ks][1], lo[d0][ks][2], lo[d0][ks][3], hh[d0][ks][0], hh[d0][ks][1], hh[d0][ks][2], hh[d0][ks][3]};
                    o[d0] = __builtin_amdgcn_mfma_f32_32x32x16_bf16(__builtin_bit_cast(bf16x8, pw[ks]), vf, o[d0], 0, 0, 0); }
        }
        if (t < NTL) {
            bf16x8 kf[2 * ND];
            const lds_cptr kb = (lds_cptr)(lds + LK + (t & 3) * 12288) + hi * 1024 + r32 * 16;
#pragma unroll
            for (int d0 = 0; d0 < ND; ++d0) { kf[2 * d0] = *(const LAS bf16x8*)(kb + d0 * 2048); kf[2 * d0 + 1] = *(const LAS bf16x8*)(kb + d0 * 2048 + 512); }
            asm volatile("s_waitcnt lgkmcnt(0)" ::: "memory"); __builtin_amdgcn_sched_barrier(0);
#pragma unroll
            for (int d0 = 0; d0 < ND; ++d0) {
                if (d0 == 0) { p0 = __builtin_amdgcn_mfma_f32_32x32x16_bf16(kf[0], qr[0], negm, 0, 0, 0); p1 = __builtin_amdgcn_mfma_f32_32x32x16_bf16(kf[1], qr[0], negm, 0, 0, 0); }
                else { p0 = __builtin_amdgcn_mfma_f32_32x32x16_bf16(kf[2 * d0], qr[d0], p0, 0, 0, 0); p1 = __builtin_amdgcn_mfma_f32_32x32x16_bf16(kf[2 * d0 + 1], qr[d0], p1, 0, 0, 0); } }
        }
        if (half == 1) {
            const int last_iss = (t + PD - 1 < NTL - 1) ? t + PD - 1 : NTL - 1; const int allow = last_iss - (t + 1);
            if (allow >= 1) ATT_WAIT_TILES(1); else ATT_WAIT_TILES(0); }
        asm volatile("s_waitcnt lgkmcnt(0)" ::: "memory"); __builtin_amdgcn_s_barrier(); asm volatile("" ::: "memory");
        if (t < NTL) {
            float rm = max3f(p0[0], p0[1], p1[0]);
#pragma unroll
            for (int r = 0; r < 16; ++r) rm = max3f(rm, p0[r], p1[r]);
            { auto rr = __builtin_amdgcn_permlane32_swap(__float_as_uint(rm), __float_as_uint(rm), false, false); rm = fmaxf(__uint_as_float(rr[0]), __uint_as_float(rr[1])); }
            if (t == 0 || __any(rm > THR)) {
                const float dl = (t == 0) ? rm : fmaxf(rm, 0.f);
                mhat += dl;
#pragma unroll
                for (int r = 0; r < 16; ++r) { p0[r] -= dl; p1[r] -= dl; negm[r] = -mhat; }
                const float f = (t == 0) ? 1.f : __builtin_amdgcn_exp2f(-dl); lrun *= f;
                if (hi == 0) wsf[r32] = f;
                LDS_WAIT();
#pragma unroll
                for (int r = 0; r < 16; ++r) { const float a = wsf[crow(r, hi)]; o[0][r] *= a; o[1][r] *= a; }
            }
            float rs = 0.f;
#pragma unroll
            for (int r = 0; r < 16; ++r) { p0[r] = __builtin_amdgcn_exp2f(p0[r]); p1[r] = __builtin_amdgcn_exp2f(p1[r]); rs += p0[r] + p1[r]; }
            lrun += rs;
            pw[0] = (v4u){pk2(p0[0], p0[1]), pk2(p0[2], p0[3]), pk2(p0[4], p0[5]), pk2(p0[6], p0[7])};
            pw[1] = (v4u){pk2(p0[8], p0[9]), pk2(p0[10], p0[11]), pk2(p0[12], p0[13]), pk2(p0[14], p0[15])};
            pw[2] = (v4u){pk2(p1[0], p1[1]), pk2(p1[2], p1[3]), pk2(p1[4], p1[5]), pk2(p1[6], p1[7])};
            pw[3] = (v4u){pk2(p1[8], p1[9]), pk2(p1[10], p1[11]), pk2(p1[12], p1[13]), pk2(p1[14], p1[15])};
        }
        if (t + PD < NTL) { ATT_DMA(t + PD, (t + PD) & 3, vs_iss); vs_iss = (vs_iss == 4) ? 0 : vs_iss + 1; }
        if (half == 0) {
            const int last_iss = (t + PD < NTL - 1) ? t + PD : NTL - 1; const int allow = last_iss - (t + 1);
            if (allow >= 2) ATT_WAIT_TILES(2); else if (allow == 1) ATT_WAIT_TILES(1); else ATT_WAIT_TILES(0); }
        vs_prev = vs_cur; vs_cur = (vs_cur == 4) ? 0 : vs_cur + 1;
        asm volatile("s_waitcnt lgkmcnt(0)" ::: "memory"); __builtin_amdgcn_s_barrier(); asm volatile("" ::: "memory");
    }
    if (half == 0) __builtin_amdgcn_s_barrier();
#undef ATT_DMA
#undef ATT_WAIT_TILES
    pend.o0 = o[0]; pend.o1 = o[1]; pend.l = lrun; pend.qrow0 = qrow0; pend.oc0 = oc0; pend.valid = true;
}
#undef ATT_WAITV
}

namespace att64 {
typedef unsigned short bf16;
using bf16x8=__attribute__((ext_vector_type(8)))short;
using s16x4=__attribute__((ext_vector_type(4)))short;
using f32x16=__attribute__((ext_vector_type(16)))float;
using u32x4=__attribute__((ext_vector_type(4)))unsigned;
constexpr int D=64;
constexpr int NW=8,QBLK=32,QB=QBLK*NW,KVBLK=64;
__device__ __forceinline__ int crow(int r,int hi){return (r&3)+8*(r>>2)+4*hi;}
#define SBAR() __builtin_amdgcn_sched_barrier(0)
constexpr int NSLOT=3, SLOTB=8192;
constexpr int LDS_K=0, LDS_V=NSLOT*SLOTB, LDS_WS=2*NSLOT*SLOTB, LDS_OST=LDS_WS+NW*64*4, LDS_BYTES=LDS_OST+NW*4096;
constexpr float C2=0.125f*1.4426950408889634f;
__device__ __forceinline__ void glds16s(unsigned voff,const void*sbase,unsigned lds_dst){unsigned keep;
  asm volatile("s_mov_b32 %0, m0\n\ts_mov_b32 m0, %2\n\ts_nop 0\n\tglobal_load_lds_dwordx4 %1, %3\n\ts_mov_b32 m0, %0":"=&s"(keep):"v"(voff),"s"(lds_dst),"s"(sbase):"memory");}
__device__ __forceinline__ void glds16(const void*gsrc,unsigned lds_dst){unsigned keep;
  asm volatile("s_mov_b32 %0, m0\n\ts_mov_b32 m0, %2\n\ts_nop 0\n\tglobal_load_lds_dwordx4 %1, off\n\ts_mov_b32 m0, %0":"=&s"(keep):"v"(gsrc),"s"(lds_dst):"memory");}
__device__ __forceinline__ float max3f(float a,float b,float c){float r;asm("v_max3_f32 %0, %1, %2, %3":"=v"(r):"v"(a),"v"(b),"v"(c));return r;}
__device__ __forceinline__ float max2f(float a,float b){float r;asm("v_max_f32_e32 %0, %1, %2":"=v"(r):"v"(a),"v"(b));return r;}
__device__ __forceinline__ float fadd_s(float a,float b){float r;asm("v_add_f32_e32 %0, %1, %2":"=v"(r):"v"(a),"v"(b));return r;}
__device__ __forceinline__ float fsub_s(float a,float b){float r;asm("v_sub_f32_e32 %0, %1, %2":"=v"(r):"v"(a),"v"(b));return r;}
typedef float f32x2_t __attribute__((ext_vector_type(2))); typedef __bf16 bf16x2_t __attribute__((ext_vector_type(2)));
__device__ __forceinline__ unsigned cvtpk_s(float lo,float hi){f32x2_t v={lo,hi};bf16x2_t b=__builtin_convertvector(v,bf16x2_t);return __builtin_bit_cast(unsigned,b);}
#define WAIT_BAR(N) asm volatile("s_waitcnt vmcnt(" #N ") lgkmcnt(0)\n\ts_barrier":::"memory")

__device__ __forceinline__ void qkt(f32x16&p0,f32x16&p1,const char*Kslot,const bf16x8*qr,const f32x16&negm,int r32,int hi){
  const char*kb=Kslot+hi*1024+r32*16;
  #pragma unroll
  for(int d0=0;d0<4;++d0){
    const bf16x8 b0=*reinterpret_cast<const bf16x8*>(kb+d0*2048);
    const bf16x8 b1=*reinterpret_cast<const bf16x8*>(kb+d0*2048+512);
    if(d0==0){p0=__builtin_amdgcn_mfma_f32_32x32x16_bf16(b0,qr[0],negm,0,0,0);p1=__builtin_amdgcn_mfma_f32_32x32x16_bf16(b1,qr[0],negm,0,0,0);}
    else{p0=__builtin_amdgcn_mfma_f32_32x32x16_bf16(b0,qr[d0],p0,0,0,0);p1=__builtin_amdgcn_mfma_f32_32x32x16_bf16(b1,qr[d0],p1,0,0,0);}}
}
typedef __attribute__((address_space(3))) const char* lds_cptr;
typedef short v4i16_t __attribute__((ext_vector_type(4)));
__device__ __forceinline__ void kload8(bf16x8*kf,lds_cptr kp){
  kf[0]=*(const __attribute__((address_space(3))) bf16x8*)(kp);      kf[1]=*(const __attribute__((address_space(3))) bf16x8*)(kp+512);
  kf[2]=*(const __attribute__((address_space(3))) bf16x8*)(kp+2048); kf[3]=*(const __attribute__((address_space(3))) bf16x8*)(kp+2560);
  kf[4]=*(const __attribute__((address_space(3))) bf16x8*)(kp+4096); kf[5]=*(const __attribute__((address_space(3))) bf16x8*)(kp+4608);
  kf[6]=*(const __attribute__((address_space(3))) bf16x8*)(kp+6144); kf[7]=*(const __attribute__((address_space(3))) bf16x8*)(kp+6656);
}
__device__ __forceinline__ void kload2(bf16x8*kf,lds_cptr kp,int j){ kf[2*j]=*(const __attribute__((address_space(3))) bf16x8*)(kp+j*2048); kf[2*j+1]=*(const __attribute__((address_space(3))) bf16x8*)(kp+j*2048+512); }
__device__ __forceinline__ s16x4 vtr(lds_cptr p){ return __builtin_bit_cast(s16x4,__builtin_amdgcn_ds_read_tr16_b64_v4i16((__attribute__((address_space(3))) v4i16_t*)p)); }
__device__ __forceinline__ float rowmax(const f32x16&p0,const f32x16&p1){
  float a=max3f(p0[0],p0[1],p1[0]),b=max3f(p0[2],p0[3],p1[1]);a=max3f(a,p1[2],p1[3]);
  #pragma unroll
  for(int r=4;r<16;r+=4){a=max3f(a,p0[r],p0[r+1]);b=max3f(b,p0[r+2],p0[r+3]);a=max3f(a,p1[r],p1[r+1]);b=max3f(b,p1[r+2],p1[r+3]);}
  const float m=max2f(a,b);
  auto rr=__builtin_amdgcn_permlane32_swap(__float_as_uint(m),__float_as_uint(m),false,false);
  return max2f(__uint_as_float(rr[0]),__uint_as_float(rr[1]));
}
__device__ __forceinline__ void pv(f32x16*o,int vb,bf16x8 pa0,bf16x8 pa1,bf16x8 pa2,bf16x8 pa3){
  #pragma unroll
  for(int d0=0;d0<2;++d0){s16x4 lo[4],hi[4];
    #pragma unroll
    for(int ks=0;ks<4;++ks){
      asm volatile("ds_read_b64_tr_b16 %0,%1 offset:%c2":"=&v"(lo[ks]):"v"(vb),"i"(d0*4096+ks*1024):"memory");
      asm volatile("ds_read_b64_tr_b16 %0,%1 offset:%c2":"=&v"(hi[ks]):"v"(vb),"i"(d0*4096+ks*1024+512):"memory");}
    asm volatile("s_waitcnt lgkmcnt(0)":::"memory");SBAR();
    #define PK(k) (bf16x8){lo[k][0],lo[k][1],lo[k][2],lo[k][3],hi[k][0],hi[k][1],hi[k][2],hi[k][3]}
    o[d0]=__builtin_amdgcn_mfma_f32_32x32x16_bf16(pa0,PK(0),o[d0],0,0,0);
    o[d0]=__builtin_amdgcn_mfma_f32_32x32x16_bf16(pa1,PK(1),o[d0],0,0,0);
    o[d0]=__builtin_amdgcn_mfma_f32_32x32x16_bf16(pa2,PK(2),o[d0],0,0,0);
    o[d0]=__builtin_amdgcn_mfma_f32_32x32x16_bf16(pa3,PK(3),o[d0],0,0,0);
    #undef PK
  }
}

#ifndef ATTN_STORE16
#define ATTN_STORE16(p,v) (*(u32x4*)(p)=(v))
#endif
template<int THRL> __device__ __forceinline__ void attn_unit(const bf16*Q,int qp,int qrow0,int qc0,const bf16*__restrict__ K,int kp,int kc0,const bf16*__restrict__ V,int vp,int vc0,bf16*O,int oc0,int kctx0,int klat0,int NT,char*shm,int wave_id){
  wave_id=launder_s(wave_id); const int lane=lane_id_v(),r32=lane&31,hi=lane>>5; const int wid=wave_id;
  const bf16*Qw=Q+(long)(qrow0+wid*QBLK)*qp+qc0;
  const bf16*Kh=K+kc0,*Vh=V+vc0;
  const unsigned lds0=(unsigned)(uintptr_t)shm;
  float*wsf=(float*)(shm+LDS_WS)+wid*64;
  const bf16*ksrc=Kh+(long)lane*kp+wid*8;
  const bf16*vsrc=Vh+(long)(16*(wid&3)+(lane>>2))*vp+(wid>>2)*32+(lane&3)*8;
  #define TROW0(t) ((long)((t)<4?kctx0+64*(t):klat0+64*((t)-4)))
  const unsigned kdst=lds0+LDS_K+wid*1024, vdst=lds0+LDS_V+wid*1024;
  const unsigned koffb=(unsigned)((lane*kp+wid*8)*2), voffb=(unsigned)(((16*(wid&3)+(lane>>2))*vp+(wid>>2)*32+(lane&3)*8)*2);
  #define DMA_K(t,slot) glds16s(koffb,(const char*)Kh+TROW0(t)*(long)kp*2,(unsigned)__builtin_amdgcn_readfirstlane(kdst+(slot)))
  #define DMA_V(t,slot) glds16s(voffb,(const char*)Vh+TROW0(t)*(long)vp*2,(unsigned)__builtin_amdgcn_readfirstlane(vdst+(slot)))
  const int vb0=(int)(lds0+LDS_V)+((lane>>4)&1)*32+(lane&3)*8+(4*hi+((lane&15)>>2))*64;
  const char*Kbase=shm+LDS_K; bf16x8 kf[8];
  const lds_cptr shm3=(lds_cptr)shm; const lds_cptr kp0=shm3+LDS_K+hi*1024+r32*16; const lds_cptr vp0=shm3+LDS_V+((lane>>4)&1)*32+(lane&3)*8+(4*hi+((lane&15)>>2))*64;
  DMA_K(0,0);DMA_V(0,0);DMA_K(1,SLOTB);
  bf16x8 qr[4];
  #pragma unroll
  for(int d0=0;d0<4;++d0)qr[d0]=*reinterpret_cast<const bf16x8*>(&Qw[(long)r32*qp+d0*16+hi*8]);
  float mhat=0.f,l_reg=0.f;f32x16 o[2];o[0]=f32x16{};o[1]=f32x16{};f32x16 negm=f32x16{};asm volatile("":"+v"(negm));
  #define CMASK(P0,P1,t) do{}while(0)
  bool resc=false;
  #define START(P0,P1) do{ const float rm=rowmax(P0,P1); resc=false; \
    { const float dl=rm; mhat=fadd_s(mhat,dl); \
      _Pragma("unroll") for(int r=0;r<16;++r){P0[r]=fsub_s(P0[r],dl);P1[r]=fsub_s(P1[r],dl);} \
      _Pragma("unroll") for(int r=0;r<16;++r)negm[r]=-mhat; asm volatile("":"+v"(negm)); } \
    _Pragma("unroll") for(int r=0;r<16;++r)P0[r]=__builtin_amdgcn_exp2f(P0[r]); }while(0)
  #define RESC() do{ if(resc){ asm volatile("s_waitcnt lgkmcnt(0)":::"memory"); \
      _Pragma("unroll") for(int d_=0;d_<2;++d_) _Pragma("unroll") for(int r=0;r<16;++r)o[d_][r]*=wsf[crow(r,hi)]; } }while(0)
  f32x16 pA0,pA1,pB0,pB1;
  int sl_prev=0,sl_cur=0,sl_next=SLOTB;
  #define ROT() do{sl_prev=sl_cur;sl_cur=sl_next;sl_next=(sl_next==(NSLOT-1)*SLOTB)?0:sl_next+SLOTB;}while(0)
  DMA_K(2,2*SLOTB);
  WAIT_BAR(3);
  qkt(pA0,pA1,Kbase,qr,negm,r32,hi);asm volatile("s_nop 15\n\ts_nop 7":"+v"(pA0),"+v"(pA1));CMASK(pA0,pA1,0);
  START(pA0,pA1);
  _Pragma("unroll") for(int r=0;r<16;++r)pA1[r]=__builtin_amdgcn_exp2f(pA1[r]);
  WAIT_BAR(0);
  DMA_K(3,0);DMA_V(1,SLOTB);
  ROT();
  kload8(kf,kp0+sl_cur);
  WAIT_BAR(2);
  s16x4 vlo[8],vhi[8]; u32x4 pw0,pw1,pw2,pw3;
  #define PKW(P,B) cvtpk_s(P[B],P[B+1])
  #define PAF(k) __builtin_bit_cast(bf16x8,pw##k)
  #define VFR(i) (bf16x8){vlo[i][0],vlo[i][1],vlo[i][2],vlo[i][3],vhi[i][0],vhi[i][1],vhi[i][2],vhi[i][3]}
  #define PIN(x) asm volatile("":"+v"(x))
  #define MX3(a,b,c) __builtin_fmaxf(__builtin_fmaxf((a),(b)),(c))
  #define GAPA(MF,A0,A1,A2,A3,W0,W1,PW) do{ MF; sacc+=A0; sacc+=A1; sacc+=A2; sacc+=A3; PIN(sacc); W0; W1; PIN(PW); SBAR(); }while(0)
  #define EX(v) __builtin_amdgcn_exp2f(v)
  #define GAPB(MF,X,B) do{ MF; X[B]=EX(X[B]); X[B+1]=EX(X[B+1]); X[B+2]=EX(X[B+2]); X[B+3]=EX(X[B+3]); PIN(X); SBAR(); }while(0)
  #define VRD(i) do{ vlo[i]=vtr(vp_+(((i)>>2)*4096+((i)&3)*1024)); vhi[i]=vtr(vp_+(((i)>>2)*4096+((i)&3)*1024+512)); }while(0)
  #define KRD(G,j) do{ if(G){ kload2(kf,kp0+sl_next,j); SBAR(); } }while(0)
  #define STEP(C0,C1,P0,P1,t,GK,GV,GL) do{ SBAR(); \
    const lds_cptr vp_=vp0+sl_prev; \
    VRD(0); SBAR(); float sacc=(P0[0]+P0[1]); \
    GAPA(C0=__builtin_amdgcn_mfma_f32_32x32x16_bf16(kf[0],qr[0],negm,0,0,0), P0[2],P0[3],P0[4],P0[5],     pw0[0]=PKW(P0,0), pw0[1]=PKW(P0,2), pw0); \
    VRD(4); SBAR(); GAPA(C1=__builtin_amdgcn_mfma_f32_32x32x16_bf16(kf[1],qr[0],negm,0,0,0), P0[6],P0[7],P0[8],P0[9],     pw0[2]=PKW(P0,4), pw0[3]=PKW(P0,6), pw0); \
    VRD(1); SBAR(); GAPA(C0=__builtin_amdgcn_mfma_f32_32x32x16_bf16(kf[2],qr[1],C0,0,0,0),   P0[10],P0[11],P0[12],P0[13], pw1[0]=PKW(P0,8), pw1[1]=PKW(P0,10), pw1); \
    VRD(5); SBAR(); GAPA(C1=__builtin_amdgcn_mfma_f32_32x32x16_bf16(kf[3],qr[1],C1,0,0,0),   P0[14],P0[15],P1[0],P1[1],   pw1[2]=PKW(P0,12),pw1[3]=PKW(P0,14), pw1); \
    VRD(2); SBAR(); GAPA(C0=__builtin_amdgcn_mfma_f32_32x32x16_bf16(kf[4],qr[2],C0,0,0,0),   P1[2],P1[3],P1[4],P1[5],     pw2[0]=PKW(P1,0), pw2[1]=PKW(P1,2), pw2); \
    VRD(6); SBAR(); GAPA(C1=__builtin_amdgcn_mfma_f32_32x32x16_bf16(kf[5],qr[2],C1,0,0,0),   P1[6],P1[7],P1[8],P1[9],     pw2[2]=PKW(P1,4), pw2[3]=PKW(P1,6), pw2); \
    VRD(3); SBAR(); GAPA(C0=__builtin_amdgcn_mfma_f32_32x32x16_bf16(kf[6],qr[3],C0,0,0,0),   P1[10],P1[11],P1[12],P1[13], pw3[0]=PKW(P1,8), pw3[1]=PKW(P1,10), pw3); \
    VRD(7); SBAR(); GAPA(C1=__builtin_amdgcn_mfma_f32_32x32x16_bf16(kf[7],qr[3],C1,0,0,0),   P1[14],P1[15],0.f,0.f,       pw3[2]=PKW(P1,12),pw3[3]=PKW(P1,14), pw3); \
    l_reg+=sacc; \
    if(GK){DMA_K((t)+3,sl_cur);} if(GV){DMA_V((t)+1,sl_next);} \
    CMASK(C0,C1,t); \
    { float a=MX3(C0[0],C0[1],C1[0]),b=MX3(C0[2],C0[3],C1[1]); a=MX3(a,C1[2],C1[3]); \
      _Pragma("unroll") for(int r=4;r<16;r+=4){a=MX3(a,C0[r],C0[r+1]);b=MX3(b,C0[r+2],C0[r+3]);a=MX3(a,C1[r],C1[r+1]);b=MX3(b,C1[r+2],C1[r+3]);} \
      float rm=__builtin_fmaxf(a,b); { auto rr=__builtin_amdgcn_permlane32_swap(__float_as_uint(rm),__float_as_uint(rm),false,false); rm=__builtin_fmaxf(__uint_as_float(rr[0]),__uint_as_float(rr[1])); } \
      resc=false; \
      if(__builtin_expect(__any(rm>(float)THRL),0)){ const float dl=__builtin_fmaxf(rm,0.f); mhat+=dl; \
        _Pragma("unroll") for(int r=0;r<16;++r){C0[r]-=dl;C1[r]-=dl;} \
        _Pragma("unroll") for(int r=0;r<16;++r)negm[r]=-mhat; asm volatile("":"+v"(negm)); \
        const float f=__builtin_amdgcn_exp2f(-dl); l_reg*=f; if(hi==0)wsf[r32]=f; resc=true; } } \
    SBAR(); \
    GAPB(o[0]=__builtin_amdgcn_mfma_f32_32x32x16_bf16(PAF(0),VFR(0),o[0],0,0,0), C0,0); \
    GAPB(o[1]=__builtin_amdgcn_mfma_f32_32x32x16_bf16(PAF(0),VFR(4),o[1],0,0,0), C0,4); \
    KRD(GL,0); GAPB(o[0]=__builtin_amdgcn_mfma_f32_32x32x16_bf16(PAF(1),VFR(1),o[0],0,0,0), C0,8); \
    KRD(GL,1); GAPB(o[1]=__builtin_amdgcn_mfma_f32_32x32x16_bf16(PAF(1),VFR(5),o[1],0,0,0), C0,12); \
    KRD(GL,2); GAPB(o[0]=__builtin_amdgcn_mfma_f32_32x32x16_bf16(PAF(2),VFR(2),o[0],0,0,0), C1,0); \
    KRD(GL,3); GAPB(o[1]=__builtin_amdgcn_mfma_f32_32x32x16_bf16(PAF(2),VFR(6),o[1],0,0,0), C1,4); \
    GAPB(o[0]=__builtin_amdgcn_mfma_f32_32x32x16_bf16(PAF(3),VFR(3),o[0],0,0,0), C1,8); \
    GAPB(o[1]=__builtin_amdgcn_mfma_f32_32x32x16_bf16(PAF(3),VFR(7),o[1],0,0,0), C1,12); \
    }while(0)
  int t=1;
  for(;t+5<NT;t+=2){
    STEP(pB0,pB1,pA0,pA1,t,true,true,true);     WAIT_BAR(2); RESC(); ROT();
    STEP(pA0,pA1,pB0,pB1,t+1,true,true,true);   WAIT_BAR(2); RESC(); ROT();
  }
  #define ENDW(tt) do{ if((tt)+3<NT){WAIT_BAR(2);} else if((tt)+2<NT){WAIT_BAR(1);} else {WAIT_BAR(0);} }while(0)
  for(;t+1<NT;t+=2){
    STEP(pB0,pB1,pA0,pA1,t,(t+3<NT),(t+1<NT),(t+1<NT));       ENDW(t);   RESC(); ROT();
    STEP(pA0,pA1,pB0,pB1,t+1,(t+4<NT),(t+2<NT),(t+2<NT));     ENDW(t+1); RESC(); ROT();
  }
  STEP(pB0,pB1,pA0,pA1,NT-1,false,false,false); RESC();
  { float sacc=pB0[0]+pB0[1]; _Pragma("unroll") for(int r=2;r<16;++r)sacc+=pB0[r]; _Pragma("unroll") for(int r=0;r<16;++r)sacc+=pB1[r]; l_reg+=sacc;
    pw0=(u32x4){PKW(pB0,0),PKW(pB0,2),PKW(pB0,4),PKW(pB0,6)};pw1=(u32x4){PKW(pB0,8),PKW(pB0,10),PKW(pB0,12),PKW(pB0,14)};pw2=(u32x4){PKW(pB1,0),PKW(pB1,2),PKW(pB1,4),PKW(pB1,6)};pw3=(u32x4){PKW(pB1,8),PKW(pB1,10),PKW(pB1,12),PKW(pB1,14)};
    SBAR(); pv(o,vb0+sl_cur,PAF(0),PAF(1),PAF(2),PAF(3)); }
  #undef PKW
  #undef PAF
  #undef VFR
  #undef PIN
  #undef MX3
  #undef GAPA
  #undef GAPB
  #undef EX
  #undef VRD
  #undef KRD
  #undef STEP
  #undef ENDW
  {auto rr=__builtin_amdgcn_permlane32_swap(__float_as_uint(l_reg),__float_as_uint(l_reg),false,false);l_reg=__uint_as_float(rr[0])+__uint_as_float(rr[1]);}
  if(hi==0)wsf[32+r32]=l_reg;asm volatile("s_waitcnt lgkmcnt(0)":::"memory");
  float rli[16];
  #pragma unroll
  for(int r=0;r<16;++r)rli[r]=__builtin_amdgcn_rcpf(wsf[32+crow(r,hi)]);
  unsigned char*Ow=(unsigned char*)O+(long)(qrow0+wid*QBLK)*1024+oc0;
  { bf16*stg=(bf16*)(shm+LDS_OST)+wid*2048;
    #pragma unroll
    for(int r=0;r<16;++r){const int orow=crow(r,hi);
      #pragma unroll
      for(int d0=0;d0<2;++d0)stg[orow*64+d0*32+r32]=(bf16)(cvtpk_s(o[d0][r]*rli[r],0.f)&0xffffu);}
    asm volatile("s_waitcnt lgkmcnt(0)":::"memory");
    #pragma unroll
    for(int i=0;i<4;++i){const int row=i*8+(lane>>3),ch=lane&7; const u32x4 v=*(const u32x4*)(stg+row*64+ch*8);
      *(v2u*)(Ow+(long)row*1024+ch*8)=pack8_fp8((f32x4){bf_lo(v.x),bf_hi(v.x),bf_lo(v.y),bf_hi(v.y)},(f32x4){bf_lo(v.z),bf_hi(v.z),bf_lo(v[3]),bf_hi(v[3])});} }
  asm volatile("s_waitcnt lgkmcnt(0)\n\ts_barrier":::"memory");
  #undef DMA_K
  #undef DMA_V
  #undef TROW0
  #undef CMASK
  #undef START
  #undef RESC
  #undef ROT
}
#undef SBAR
#undef WAIT_BAR
}

namespace att96 {
typedef unsigned short bf16;
using bf16x8=__attribute__((ext_vector_type(8)))short;
using s16x4=__attribute__((ext_vector_type(4)))short;
using f32x16=__attribute__((ext_vector_type(16)))float;
using u32x4=__attribute__((ext_vector_type(4)))unsigned;
constexpr int D=64;
constexpr int NW=8,QBLK=32,QB=QBLK*NW,KVBLK=64;
__device__ __forceinline__ int crow(int r,int hi){return (r&3)+8*(r>>2)+4*hi;}
#define SBAR() __builtin_amdgcn_sched_barrier(0)
constexpr int NSLOT=3, SLOTB=8192, KSLOTB=12288;
#define KOFF(sl) ((sl)+((sl)>>1))
constexpr int LDS_K=0, LDS_V=NSLOT*KSLOTB, LDS_WS=LDS_V+NSLOT*SLOTB, LDS_OST=LDS_WS+NW*64*4, LDS_BYTES=LDS_OST+NW*4096;
constexpr float C2=0.125f*1.4426950408889634f;
__device__ __forceinline__ void glds16s(unsigned voff,const void*sbase,unsigned lds_dst){unsigned keep;
  asm volatile("s_mov_b32 %0, m0\n\ts_mov_b32 m0, %2\n\ts_nop 0\n\tglobal_load_lds_dwordx4 %1, %3\n\ts_mov_b32 m0, %0":"=&s"(keep):"v"(voff),"s"(lds_dst),"s"(sbase):"memory");}
__device__ __forceinline__ void glds16(const void*gsrc,unsigned lds_dst){unsigned keep;
  asm volatile("s_mov_b32 %0, m0\n\ts_mov_b32 m0, %2\n\ts_nop 0\n\tglobal_load_lds_dwordx4 %1, off\n\ts_mov_b32 m0, %0":"=&s"(keep):"v"(gsrc),"s"(lds_dst):"memory");}
__device__ __forceinline__ float max3f(float a,float b,float c){float r;asm("v_max3_f32 %0, %1, %2, %3":"=v"(r):"v"(a),"v"(b),"v"(c));return r;}
__device__ __forceinline__ float max2f(float a,float b){float r;asm("v_max_f32_e32 %0, %1, %2":"=v"(r):"v"(a),"v"(b));return r;}
__device__ __forceinline__ float fadd_s(float a,float b){float r;asm("v_add_f32_e32 %0, %1, %2":"=v"(r):"v"(a),"v"(b));return r;}
__device__ __forceinline__ float fsub_s(float a,float b){float r;asm("v_sub_f32_e32 %0, %1, %2":"=v"(r):"v"(a),"v"(b));return r;}
typedef float f32x2_t __attribute__((ext_vector_type(2))); typedef __bf16 bf16x2_t __attribute__((ext_vector_type(2)));
__device__ __forceinline__ unsigned cvtpk_s(float lo,float hi){f32x2_t v={lo,hi};bf16x2_t b=__builtin_convertvector(v,bf16x2_t);return __builtin_bit_cast(unsigned,b);}
#define WAIT_BAR(N) asm volatile("s_waitcnt vmcnt(" #N ") lgkmcnt(0)\n\ts_barrier":::"memory")

__device__ __forceinline__ void qkt(f32x16&p0,f32x16&p1,const char*Kslot,const bf16x8*qr,const f32x16&negm,int r32,int hi){
  const char*kb=Kslot+hi*1024+r32*16;
  #pragma unroll
  for(int d0=0;d0<6;++d0){
    const bf16x8 b0=*reinterpret_cast<const bf16x8*>(kb+d0*2048);
    const bf16x8 b1=*reinterpret_cast<const bf16x8*>(kb+d0*2048+512);
    if(d0==0){p0=__builtin_amdgcn_mfma_f32_32x32x16_bf16(b0,qr[0],negm,0,0,0);p1=__builtin_amdgcn_mfma_f32_32x32x16_bf16(b1,qr[0],negm,0,0,0);}
    else{p0=__builtin_amdgcn_mfma_f32_32x32x16_bf16(b0,qr[d0],p0,0,0,0);p1=__builtin_amdgcn_mfma_f32_32x32x16_bf16(b1,qr[d0],p1,0,0,0);}}
}
typedef __attribute__((address_space(3))) const char* lds_cptr;
typedef short v4i16_t __attribute__((ext_vector_type(4)));
__device__ __forceinline__ void kload8(bf16x8*kf,lds_cptr kp){
  kf[0]=*(const __attribute__((address_space(3))) bf16x8*)(kp);      kf[1]=*(const __attribute__((address_space(3))) bf16x8*)(kp+512);
  kf[2]=*(const __attribute__((address_space(3))) bf16x8*)(kp+2048); kf[3]=*(const __attribute__((address_space(3))) bf16x8*)(kp+2560);
  kf[4]=*(const __attribute__((address_space(3))) bf16x8*)(kp+4096); kf[5]=*(const __attribute__((address_space(3))) bf16x8*)(kp+4608);
  kf[6]=*(const __attribute__((address_space(3))) bf16x8*)(kp+6144); kf[7]=*(const __attribute__((address_space(3))) bf16x8*)(kp+6656);
  kf[8]=*(const __attribute__((address_space(3))) bf16x8*)(kp+8192); kf[9]=*(const __attribute__((address_space(3))) bf16x8*)(kp+8704);
  kf[10]=*(const __attribute__((address_space(3))) bf16x8*)(kp+10240); kf[11]=*(const __attribute__((address_space(3))) bf16x8*)(kp+10752);
}
__device__ __forceinline__ void kload2(bf16x8*kf,lds_cptr kp,int j){ kf[2*j]=*(const __attribute__((address_space(3))) bf16x8*)(kp+j*2048); kf[2*j+1]=*(const __attribute__((address_space(3))) bf16x8*)(kp+j*2048+512); }
__device__ __forceinline__ s16x4 vtr(lds_cptr p){ return __builtin_bit_cast(s16x4,__builtin_amdgcn_ds_read_tr16_b64_v4i16((__attribute__((address_space(3))) v4i16_t*)p)); }
__device__ __forceinline__ float rowmax(const f32x16&p0,const f32x16&p1){
  float a=max3f(p0[0],p0[1],p1[0]),b=max3f(p0[2],p0[3],p1[1]);a=max3f(a,p1[2],p1[3]);
  #pragma unroll
  for(int r=4;r<16;r+=4){a=max3f(a,p0[r],p0[r+1]);b=max3f(b,p0[r+2],p0[r+3]);a=max3f(a,p1[r],p1[r+1]);b=max3f(b,p1[r+2],p1[r+3]);}
  const float m=max2f(a,b);
  auto rr=__builtin_amdgcn_permlane32_swap(__float_as_uint(m),__float_as_uint(m),false,false);
  return max2f(__uint_as_float(rr[0]),__uint_as_float(rr[1]));
}
__device__ __forceinline__ void pv(f32x16*o,int vb,bf16x8 pa0,bf16x8 pa1,bf16x8 pa2,bf16x8 pa3){
  #pragma unroll
  for(int d0=0;d0<2;++d0){s16x4 lo[4],hi[4];
    #pragma unroll
    for(int ks=0;ks<4;++ks){
      asm volatile("ds_read_b64_tr_b16 %0,%1 offset:%c2":"=&v"(lo[ks]):"v"(vb),"i"(d0*4096+ks*1024):"memory");
      asm volatile("ds_read_b64_tr_b16 %0,%1 offset:%c2":"=&v"(hi[ks]):"v"(vb),"i"(d0*4096+ks*1024+512):"memory");}
    asm volatile("s_waitcnt lgkmcnt(0)":::"memory");SBAR();
    #define PK(k) (bf16x8){lo[k][0],lo[k][1],lo[k][2],lo[k][3],hi[k][0],hi[k][1],hi[k][2],hi[k][3]}
    o[d0]=__builtin_amdgcn_mfma_f32_32x32x16_bf16(pa0,PK(0),o[d0],0,0,0);
    o[d0]=__builtin_amdgcn_mfma_f32_32x32x16_bf16(pa1,PK(1),o[d0],0,0,0);
    o[d0]=__builtin_amdgcn_mfma_f32_32x32x16_bf16(pa2,PK(2),o[d0],0,0,0);
    o[d0]=__builtin_amdgcn_mfma_f32_32x32x16_bf16(pa3,PK(3),o[d0],0,0,0);
    #undef PK
  }
}

#ifndef ATTN_STORE16
#define ATTN_STORE16(p,v) (*(u32x4*)(p)=(v))
#endif
template<int THRL> __device__ __forceinline__ void attn_unit(const bf16*Q,int qp,int qrow0,int qc0,const bf16*__restrict__ K,int kp,int kc0,const bf16*__restrict__ V,int vp,int vc0,bf16*O,int oc0,int kctx0,int klat0,int NT,char*shm,int wave_id){
  wave_id=launder_s(wave_id); const int lane=lane_id_v(),r32=lane&31,hi=lane>>5; const int wid=wave_id;
  const bf16*Qw=Q+(long)(qrow0+wid*QBLK)*qp+qc0;
  const bf16*Kh=K+kc0,*Vh=V+vc0;
  const unsigned lds0=(unsigned)(uintptr_t)shm;
  float*wsf=(float*)(shm+LDS_WS)+wid*64;
  const bf16*ksrc=Kh+(long)lane*kp+wid*8;
  const bf16*vsrc=Vh+(long)(16*(wid&3)+(lane>>2))*vp+(wid>>2)*32+(lane&3)*8;
  #define TROW0(t) ((long)((t)<4?kctx0+64*(t):klat0+64*((t)-4)))
  const unsigned kdst=lds0+LDS_K+wid*1024, kdst2=lds0+LDS_K+8192+(wid&3)*1024, vdst=lds0+LDS_V+wid*1024;
  const int k2off=(8+(wid&3)-wid)*8;
  const unsigned koffb=(unsigned)((lane*kp+wid*8)*2), voffb=(unsigned)(((16*(wid&3)+(lane>>2))*vp+(wid>>2)*32+(lane&3)*8)*2);
  #define DMA_K(t,slot) do{ glds16s(koffb,(const char*)Kh+TROW0(t)*(long)kp*2,(unsigned)__builtin_amdgcn_readfirstlane(kdst+KOFF(slot))); glds16s(koffb,(const char*)Kh+(TROW0(t)*(long)kp+k2off)*2,(unsigned)__builtin_amdgcn_readfirstlane(kdst2+KOFF(slot))); }while(0)
  #define DMA_V(t,slot) glds16s(voffb,(const char*)Vh+TROW0(t)*(long)vp*2,(unsigned)__builtin_amdgcn_readfirstlane(vdst+(slot)))
  const int vb0=(int)(lds0+LDS_V)+((lane>>4)&1)*32+(lane&3)*8+(4*hi+((lane&15)>>2))*64;
  const char*Kbase=shm+LDS_K; bf16x8 kf[12];
  const lds_cptr shm3=(lds_cptr)shm; const lds_cptr kp0=shm3+LDS_K+hi*1024+r32*16; const lds_cptr vp0=shm3+LDS_V+((lane>>4)&1)*32+(lane&3)*8+(4*hi+((lane&15)>>2))*64;
  DMA_K(0,0);DMA_V(0,0);DMA_K(1,SLOTB);
  bf16x8 qr[6];
  #pragma unroll
  for(int d0=0;d0<6;++d0)qr[d0]=*reinterpret_cast<const bf16x8*>(&Qw[(long)r32*qp+d0*16+hi*8]);
  float mhat=0.f,l_reg=0.f;f32x16 o[2];o[0]=f32x16{};o[1]=f32x16{};f32x16 negm=f32x16{};asm volatile("":"+v"(negm));
  #define CMASK(P0,P1,t) do{}while(0)
  bool resc=false;
  #define START(P0,P1) do{ const float rm=rowmax(P0,P1); resc=false; \
    { const float dl=rm; mhat=fadd_s(mhat,dl); \
      _Pragma("unroll") for(int r=0;r<16;++r){P0[r]=fsub_s(P0[r],dl);P1[r]=fsub_s(P1[r],dl);} \
      _Pragma("unroll") for(int r=0;r<16;++r)negm[r]=-mhat; asm volatile("":"+v"(negm)); } \
    _Pragma("unroll") for(int r=0;r<16;++r)P0[r]=__builtin_amdgcn_exp2f(P0[r]); }while(0)
  #define RESC() do{ if(resc){ asm volatile("s_waitcnt lgkmcnt(0)":::"memory"); \
      _Pragma("unroll") for(int d_=0;d_<2;++d_) _Pragma("unroll") for(int r=0;r<16;++r)o[d_][r]*=wsf[crow(r,hi)]; } }while(0)
  f32x16 pA0,pA1,pB0,pB1;
  int sl_prev=0,sl_cur=0,sl_next=SLOTB;
  #define ROT() do{sl_prev=sl_cur;sl_cur=sl_next;sl_next=(sl_next==(NSLOT-1)*SLOTB)?0:sl_next+SLOTB;}while(0)
  DMA_K(2,2*SLOTB);
  WAIT_BAR(5);
  qkt(pA0,pA1,Kbase,qr,negm,r32,hi);asm volatile("s_nop 15\n\ts_nop 7":"+v"(pA0),"+v"(pA1));CMASK(pA0,pA1,0);
  START(pA0,pA1);
  _Pragma("unroll") for(int r=0;r<16;++r)pA1[r]=__builtin_amdgcn_exp2f(pA1[r]);
  WAIT_BAR(0);
  DMA_K(3,0);DMA_V(1,SLOTB);
  ROT();
  kload8(kf,kp0+KOFF(sl_cur));
  WAIT_BAR(3);
  s16x4 vlo[8],vhi[8]; u32x4 pw0,pw1,pw2,pw3;
  #define PKW(P,B) cvtpk_s(P[B],P[B+1])
  #define PAF(k) __builtin_bit_cast(bf16x8,pw##k)
  #define VFR(i) (bf16x8){vlo[i][0],vlo[i][1],vlo[i][2],vlo[i][3],vhi[i][0],vhi[i][1],vhi[i][2],vhi[i][3]}
  #define PIN(x) asm volatile("":"+v"(x))
  #define MX3(a,b,c) __builtin_fmaxf(__builtin_fmaxf((a),(b)),(c))
  #define GAPA(MF,A0,A1,A2,A3,W0,W1,PW) do{ MF; sacc+=A0; sacc+=A1; sacc+=A2; sacc+=A3; PIN(sacc); W0; W1; PIN(PW); SBAR(); }while(0)
  #define EX(v) __builtin_amdgcn_exp2f(v)
  #define GAPB(MF,X,B) do{ MF; X[B]=EX(X[B]); X[B+1]=EX(X[B+1]); X[B+2]=EX(X[B+2]); X[B+3]=EX(X[B+3]); PIN(X); SBAR(); }while(0)
  #define VRD(i) do{ vlo[i]=vtr(vp_+(((i)>>2)*4096+((i)&3)*1024)); vhi[i]=vtr(vp_+(((i)>>2)*4096+((i)&3)*1024+512)); }while(0)
  #define KRD(G,j) do{ if(G){ kload2(kf,kp0+KOFF(sl_next),j); SBAR(); } }while(0)
  #define STEP(C0,C1,P0,P1,t,GK,GV,GL) do{ SBAR(); \
    const lds_cptr vp_=vp0+sl_prev; \
    VRD(0); SBAR(); float sacc=(P0[0]+P0[1]); \
    GAPA(C0=__builtin_amdgcn_mfma_f32_32x32x16_bf16(kf[0],qr[0],negm,0,0,0), P0[2],P0[3],P0[4],P0[5],     pw0[0]=PKW(P0,0), pw0[1]=PKW(P0,2), pw0); \
    VRD(4); SBAR(); GAPA(C1=__builtin_amdgcn_mfma_f32_32x32x16_bf16(kf[1],qr[0],negm,0,0,0), P0[6],P0[7],P0[8],P0[9],     pw0[2]=PKW(P0,4), pw0[3]=PKW(P0,6), pw0); \
    VRD(1); SBAR(); GAPA(C0=__builtin_amdgcn_mfma_f32_32x32x16_bf16(kf[2],qr[1],C0,0,0,0),   P0[10],P0[11],P0[12],P0[13], pw1[0]=PKW(P0,8), pw1[1]=PKW(P0,10), pw1); \
    VRD(5); SBAR(); GAPA(C1=__builtin_amdgcn_mfma_f32_32x32x16_bf16(kf[3],qr[1],C1,0,0,0),   P0[14],P0[15],P1[0],P1[1],   pw1[2]=PKW(P0,12),pw1[3]=PKW(P0,14), pw1); \
    VRD(2); SBAR(); GAPA(C0=__builtin_amdgcn_mfma_f32_32x32x16_bf16(kf[4],qr[2],C0,0,0,0),   P1[2],P1[3],P1[4],P1[5],     pw2[0]=PKW(P1,0), pw2[1]=PKW(P1,2), pw2); \
    VRD(6); SBAR(); GAPA(C1=__builtin_amdgcn_mfma_f32_32x32x16_bf16(kf[5],qr[2],C1,0,0,0),   P1[6],P1[7],P1[8],P1[9],     pw2[2]=PKW(P1,4), pw2[3]=PKW(P1,6), pw2); \
    VRD(3); SBAR(); GAPA(C0=__builtin_amdgcn_mfma_f32_32x32x16_bf16(kf[6],qr[3],C0,0,0,0),   P1[10],P1[11],P1[12],P1[13], pw3[0]=PKW(P1,8), pw3[1]=PKW(P1,10), pw3); \
    VRD(7); SBAR(); GAPA(C1=__builtin_amdgcn_mfma_f32_32x32x16_bf16(kf[7],qr[3],C1,0,0,0),   P1[14],P1[15],0.f,0.f,       pw3[2]=PKW(P1,12),pw3[3]=PKW(P1,14), pw3); \
    C0=__builtin_amdgcn_mfma_f32_32x32x16_bf16(kf[8],qr[4],C0,0,0,0); C1=__builtin_amdgcn_mfma_f32_32x32x16_bf16(kf[9],qr[4],C1,0,0,0); C0=__builtin_amdgcn_mfma_f32_32x32x16_bf16(kf[10],qr[5],C0,0,0,0); C1=__builtin_amdgcn_mfma_f32_32x32x16_bf16(kf[11],qr[5],C1,0,0,0); SBAR(); \
    l_reg+=sacc; \
    if(GK){DMA_K((t)+3,sl_cur);} if(GV){DMA_V((t)+1,sl_next);} \
    CMASK(C0,C1,t); \
    { float a=MX3(C0[0],C0[1],C1[0]),b=MX3(C0[2],C0[3],C1[1]); a=MX3(a,C1[2],C1[3]); \
      _Pragma("unroll") for(int r=4;r<16;r+=4){a=MX3(a,C0[r],C0[r+1]);b=MX3(b,C0[r+2],C0[r+3]);a=MX3(a,C1[r],C1[r+1]);b=MX3(b,C1[r+2],C1[r+3]);} \
      float rm=__builtin_fmaxf(a,b); { auto rr=__builtin_amdgcn_permlane32_swap(__float_as_uint(rm),__float_as_uint(rm),false,false); rm=__builtin_fmaxf(__uint_as_float(rr[0]),__uint_as_float(rr[1])); } \
      resc=false; \
      if(__builtin_expect(__any(rm>(float)THRL),0)){ const float dl=__builtin_fmaxf(rm,0.f); mhat+=dl; \
        _Pragma("unroll") for(int r=0;r<16;++r){C0[r]-=dl;C1[r]-=dl;} \
        _Pragma("unroll") for(int r=0;r<16;++r)negm[r]=-mhat; asm volatile("":"+v"(negm)); \
        const float f=__builtin_amdgcn_exp2f(-dl); l_reg*=f; if(hi==0)wsf[r32]=f; resc=true; } } \
    SBAR(); \
    GAPB(o[0]=__builtin_amdgcn_mfma_f32_32x32x16_bf16(PAF(0),VFR(0),o[0],0,0,0), C0,0); \
    GAPB(o[1]=__builtin_amdgcn_mfma_f32_32x32x16_bf16(PAF(0),VFR(4),o[1],0,0,0), C0,4); \
    KRD(GL,0); GAPB(o[0]=__builtin_amdgcn_mfma_f32_32x32x16_bf16(PAF(1),VFR(1),o[0],0,0,0), C0,8); \
    KRD(GL,1); GAPB(o[1]=__builtin_amdgcn_mfma_f32_32x32x16_bf16(PAF(1),VFR(5),o[1],0,0,0), C0,12); \
    KRD(GL,2); GAPB(o[0]=__builtin_amdgcn_mfma_f32_32x32x16_bf16(PAF(2),VFR(2),o[0],0,0,0), C1,0); \
    KRD(GL,3); GAPB(o[1]=__builtin_amdgcn_mfma_f32_32x32x16_bf16(PAF(2),VFR(6),o[1],0,0,0), C1,4); \
    KRD(GL,4); GAPB(o[0]=__builtin_amdgcn_mfma_f32_32x32x16_bf16(PAF(3),VFR(3),o[0],0,0,0), C1,8); \
    KRD(GL,5); GAPB(o[1]=__builtin_amdgcn_mfma_f32_32x32x16_bf16(PAF(3),VFR(7),o[1],0,0,0), C1,12); \
    }while(0)
  int t=1;
  for(;t+5<NT;t+=2){
    STEP(pB0,pB1,pA0,pA1,t,true,true,true);     WAIT_BAR(3); RESC(); ROT();
    STEP(pA0,pA1,pB0,pB1,t+1,true,true,true);   WAIT_BAR(3); RESC(); ROT();
  }
  #define ENDW(tt) do{ if((tt)+3<NT){WAIT_BAR(3);} else if((tt)+2<NT){WAIT_BAR(1);} else {WAIT_BAR(0);} }while(0)
  for(;t+1<NT;t+=2){
    STEP(pB0,pB1,pA0,pA1,t,(t+3<NT),(t+1<NT),(t+1<NT));       ENDW(t);   RESC(); ROT();
    STEP(pA0,pA1,pB0,pB1,t+1,(t+4<NT),(t+2<NT),(t+2<NT));     ENDW(t+1); RESC(); ROT();
  }
  STEP(pB0,pB1,pA0,pA1,NT-1,false,false,false); RESC();
  { float sacc=pB0[0]+pB0[1]; _Pragma("unroll") for(int r=2;r<16;++r)sacc+=pB0[r]; _Pragma("unroll") for(int r=0;r<16;++r)sacc+=pB1[r]; l_reg+=sacc;
    pw0=(u32x4){PKW(pB0,0),PKW(pB0,2),PKW(pB0,4),PKW(pB0,6)};pw1=(u32x4){PKW(pB0,8),PKW(pB0,10),PKW(pB0,12),PKW(pB0,14)};pw2=(u32x4){PKW(pB1,0),PKW(pB1,2),PKW(pB1,4),PKW(pB1,6)};pw3=(u32x4){PKW(pB1,8),PKW(pB1,10),PKW(pB1,12),PKW(pB1,14)};
    SBAR(); pv(o,vb0+sl_cur,PAF(0),PAF(1),PAF(2),PAF(3)); }
  #undef PKW
  #undef PAF
  #undef VFR
  #undef PIN
  #undef MX3
  #undef GAPA
  #undef GAPB
  #undef EX
  #undef VRD
  #undef KRD
  #undef STEP
  #undef ENDW
  {auto rr=__builtin_amdgcn_permlane32_swap(__float_as_uint(l_reg),__float_as_uint(l_reg),false,false);l_reg=__uint_as_float(rr[0])+__uint_as_float(rr[1]);}
  if(hi==0)wsf[32+r32]=l_reg;asm volatile("s_waitcnt lgkmcnt(0)":::"memory");
  float rli[16];
  #pragma unroll
  for(int r=0;r<16;++r)rli[r]=__builtin_amdgcn_rcpf(wsf[32+crow(r,hi)]);
  unsigned char*Ow=(unsigned char*)O+(long)(qrow0+wid*QBLK)*1024+oc0;
  { bf16*stg=(bf16*)(shm+LDS_OST)+wid*2048;
    #pragma unroll
    for(int r=0;r<16;++r){const int orow=crow(r,hi);
      #pragma unroll
      for(int d0=0;d0<2;++d0)stg[orow*64+d0*32+r32]=(bf16)(cvtpk_s(o[d0][r]*rli[r],0.f)&0xffffu);}
    asm volatile("s_waitcnt lgkmcnt(0)":::"memory");
    #pragma unroll
    for(int i=0;i<4;++i){const int row=i*8+(lane>>3),ch=lane&7; const u32x4 v=*(const u32x4*)(stg+row*64+ch*8);
      *(v2u*)(Ow+(long)row*1024+ch*8)=pack8_fp8((f32x4){bf_lo(v.x),bf_hi(v.x),bf_lo(v.y),bf_hi(v.y)},(f32x4){bf_lo(v.z),bf_hi(v.z),bf_lo(v[3]),bf_hi(v[3])});} }
  asm volatile("s_waitcnt lgkmcnt(0)\n\ts_barrier":::"memory");
  #undef DMA_K
  #undef DMA_V
  #undef TROW0
  #undef CMASK
  #undef START
  #undef RESC
  #undef ROT
}
#undef SBAR
#undef WAIT_BAR
#undef KOFF
}

struct Args { const float* in[27]; float* out; unsigned char* ws; int ph_lo, ph_hi; };
struct Frame {
    LAS unsigned char* lds; unsigned char* ws; gu32* ctl; int wave, G, gw, NGW;
};
__device__ __forceinline__ int lthread(int wave) { return wave * 64 + lane_id_v(); }

template <int MODE>
__device__ __forceinline__ void conv_item(const float* W, int K, int N, bf16* WT, LAS float* scr, int item, int lane) {
    const int nblk = (N + 63) / 64, kb = item / nblk, nb = item % nblk, k0 = 64 * kb, n0 = 64 * nb;
    f32x4 v[16];
    const int cc = (lane & 15) * 4, rk = lane >> 4;
    const bool ok = (n0 + cc) < N;
#pragma unroll
    for (int i = 0; i < 16; ++i) v[i] = ok ? *(const f32x4*)(W + (size_t)(k0 + 4 * i + rk) * N + n0 + cc) : (f32x4){0.f, 0.f, 0.f, 0.f};
#pragma unroll
    for (int i = 0; i < 16; ++i) { LAS float* s = scr + (4 * i + rk) * 65 + cc; s[0] = v[i][0]; s[1] = v[i][1]; s[2] = v[i][2]; s[3] = v[i][3]; }
    LDS_WAIT(); asm volatile("" ::: "memory");
    const int c = lane & 7;
#pragma unroll
    for (int j = 0; j < 8; ++j) { const int n = (lane >> 3) + 8 * j; const LAS float* s = scr + (8 * c) * 65 + n;
        v4u o; o.x = pk2(s[0], s[65]); o.y = pk2(s[2 * 65], s[3 * 65]); o.z = pk2(s[4 * 65], s[5 * 65]); o.w = pk2(s[6 * 65], s[7 * 65]);
        const int ng = n0 + n; if (ng < N) { const int dr = (MODE == 1) ? ((ng >> 8) * 256 + (ng & 1) * 128 + ((ng >> 1) & 127)) : ng; *(v4u*)(WT + (size_t)dr * K + k0 + 8 * c) = o; } }
    LDS_WAIT(); asm volatile("" ::: "memory");
}

__device__ __forceinline__ void prologue(Frame& F, const Args& a) {
    const int f_tid = lthread(F.wave), f_lane = f_tid & 63;
    unsigned char* ws = F.ws;
    {
        LAS float* scr = (LAS float*)(F.lds + F.wave * 16640);
        struct M { const float* src; int K, N; size_t dst; };
        const int I_MIN = 16 * 11, I_QB = 6 * 24, I_KVB = 4 * 32, I_GQKV = 16 * 24;
        const int NSMALL = I_MIN + I_QB + I_KVB + I_GQKV;
        for (int it = F.gw; it < NSMALL; it += F.NGW) {
            int r = it;
            if (r < I_MIN) { conv_item<0>(a.in[11], D, MLA_IN, (bf16*)(ws + WS_WMIN), scr, r, f_lane); continue; } r -= I_MIN;
            if (r < I_QB) { conv_item<0>(a.in[13], MLA_QL, 1536, (bf16*)(ws + WS_WMQB), scr, r, f_lane); continue; } r -= I_QB;
            if (r < I_KVB) { conv_item<0>(a.in[15], MLA_KVL, 2048, (bf16*)(ws + WS_WMKVB), scr, r, f_lane); continue; } r -= I_KVB;
            conv_item<0>(a.in[17], D, GQA_QKV, (bf16*)(ws + WS_WGQKV), scr, r, f_lane);
        }
    }
    __syncthreads();
    {
        LAS float* cmax = (LAS float*)F.lds;
        LAS float* cinv = cmax + 512;
        LAS unsigned* scr8 = (LAS unsigned*)(F.lds + 4096) + F.wave * (64 * 33);
        const int cc = (f_lane & 15) * 4, rk = f_lane >> 4;
        constexpr int NGU = DEPTH * NE * 32, NDN = DEPTH * NE * 16, NWO = 4 * 16;
        for (int it = blockIdx.x; it < NGU + NDN + NWO; it += F.G) {
            const bool dn = it >= NGU; const bool wo = it >= NGU + NDN; const int q_ = wo ? it - NGU - NDN : (dn ? it - NGU : it); const int le = dn ? (q_ >> 4) : (q_ >> 5), strip = dn ? (q_ & 15) : (q_ & 31);
            const int N = dn ? 1024 : 2048;
            const float* wosrc = (le < 2) ? a.in[10] + (size_t)le * D * D : (le == 2 ? a.in[16] : a.in[20]);
            const float* W = (wo ? wosrc : (dn ? a.in[25] + (size_t)le * DFF * D : a.in[23] + (size_t)le * D * 2048)) + strip * 64 + cc;
            f32x4 v[32];
#pragma unroll
            for (int i = 0; i < 32; ++i) v[i] = *(const f32x4*)(W + (size_t)(F.wave * 128 + 16 * (i >> 2) + 4 * rk + (i & 3)) * N);
            f32x4 mx = (f32x4){0.f, 0.f, 0.f, 0.f};
#pragma unroll
            for (int i = 0; i < 32; ++i) { mx[0] = fmaxf(mx[0], fabsf(v[i][0])); mx[1] = fmaxf(mx[1], fabsf(v[i][1])); mx[2] = fmaxf(mx[2], fabsf(v[i][2])); mx[3] = fmaxf(mx[3], fabsf(v[i][3])); }
#pragma unroll
            for (int q = 0; q < 4; ++q) { mx[q] = fmaxf(mx[q], shx(mx[q], 16, f_lane)); mx[q] = fmaxf(mx[q], shx(mx[q], 32, f_lane)); }
            __syncthreads();
            if (rk == 0) { LAS float* d = cmax + F.wave * 64 + cc; d[0] = mx[0]; d[1] = mx[1]; d[2] = mx[2]; d[3] = mx[3]; }
            __syncthreads();
            const float target = dn ? 240.f : 127.f;
            if (f_tid < 64) { float m8 = 0.f;
#pragma unroll
                for (int w = 0; w < 8; ++w) m8 = fmaxf(m8, cmax[w * 64 + f_tid]);
                const int ng = strip * 64 + f_tid, dr = dn ? ng : (ng >> 8) * 256 + (ng & 1) * 128 + ((ng >> 1) & 127);
                float* sc = wo ? (float*)(ws + WS_SWO) + (size_t)le * 1024 : (dn ? (float*)(ws + WS_SWDN) + (size_t)le * 1024 : (float*)(ws + WS_SWGU) + (size_t)le * 2048);
                sc[dr] = (m8 > 0.f) ? m8 / target : 1.f;
                cinv[f_tid] = (m8 > 0.f) ? target / m8 : 0.f; }
            __syncthreads();
            const f32x4 iv = *(const LAS f32x4*)(cinv + cc);
#pragma unroll
            for (int ip = 0; ip < 8; ++ip) {
#pragma unroll
                for (int q = 0; q < 4; ++q) { unsigned w = 0;
                    if (dn) { int t = __builtin_amdgcn_cvt_pk_fp8_f32(v[4 * ip][q] * iv[q], v[4 * ip + 1][q] * iv[q], 0, false); t = __builtin_amdgcn_cvt_pk_fp8_f32(v[4 * ip + 2][q] * iv[q], v[4 * ip + 3][q] * iv[q], t, true); w = (unsigned)t; }
                    else w = q8x4(v[4 * ip][q], v[4 * ip + 1][q], v[4 * ip + 2][q], v[4 * ip + 3][q], iv[q]);
                    scr8[(cc + q) * 33 + 4 * ip + rk] = w; } }
            LDS_WAIT(); asm volatile("" ::: "memory");
            { const int c8 = f_lane & 7;
              unsigned char* dst = wo ? (unsigned char*)(ws + WS_WO8) + (size_t)le * 1024 * 1024 : (dn ? (unsigned char*)(ws + WS_WDN) + (size_t)le * 1024 * 1024 : (unsigned char*)(ws + WS_WGU) + (size_t)le * 2048 * 1024);
#pragma unroll
              for (int jp = 0; jp < 8; ++jp) { const int n = (f_lane >> 3) + 8 * jp; const LAS unsigned* sp = scr8 + n * 33 + 4 * c8;
                  v4u o; o.x = sp[0]; o.y = sp[1]; o.z = sp[2]; o[3] = sp[3];
                  const int ng = strip * 64 + n, dr = dn ? ng : (ng >> 8) * 256 + (ng & 1) * 128 + ((ng >> 1) & 127);
                  *(v4u*)(dst + (size_t)dr * 1024 + F.wave * 128 + 16 * c8) = o; } }
            LDS_WAIT(); asm volatile("" ::: "memory");
        }
        __syncthreads();
    }
    const int gtid = blockIdx.x * 512 + f_tid, gthreads = F.G * 512;
    for (int i = gtid; i < (MLA_IN_PAD - MLA_IN) * D / 8; i += gthreads) ((v4u*)((bf16*)(ws + WS_WMIN) + (size_t)MLA_IN * D))[i] = (v4u){0u, 0u, 0u, 0u};
    {
        unsigned* MA8 = (unsigned*)(ws + WS_MA);
        for (int i4 = gtid; i4 < 256 * 256 / 4; i4 += gthreads) { float v4_[4];
#pragma unroll
            for (int jx = 0; jx < 4; ++jx) { const int i = 4 * i4 + jx; const int row = i >> 8, col = i & 255, jp = row >> 7, pp = (row >> 6) & 1, k1 = row & 63, j = col >> 7, pt = (col >> 6) & 1, l1 = col & 63;
                float v = 0.f; if (j == jp) { const float x = 2.f * (float)((k1 * l1) & 63) / 64.f; const float cs = cospif(x), sn = sinpif(x); v = (pp == 0) ? (pt == 0 ? cs : sn) : (pt == 0 ? -sn : cs); }
                v4_[jx] = v; }
            int t = __builtin_amdgcn_cvt_pk_fp8_f32(v4_[0], v4_[1], 0, false); t = __builtin_amdgcn_cvt_pk_fp8_f32(v4_[2], v4_[3], t, true); MA8[i4] = (unsigned)t; }
        unsigned* DC8 = (unsigned*)(ws + WS_DC); const float sc = 64.0f / sqrtf(256.f * 128.f);
        for (int i4 = gtid; i4 < 256 * 512 / 4; i4 += gthreads) { float v4_[4];
#pragma unroll
            for (int jx = 0; jx < 4; ++jx) { const int i = 4 * i4 + jx; const int k = i >> 9, col = i & 511, pt = col >> 8, l = col & 255; const float x = 2.f * (float)((k * l) & 255) / 256.f; v4_[jx] = (pt == 0 ? cospif(x) : sinpif(x)) * sc; }
            int t = __builtin_amdgcn_cvt_pk_fp8_f32(v4_[0], v4_[1], 0, false); t = __builtin_amdgcn_cvt_pk_fp8_f32(v4_[2], v4_[3], t, true); DC8[i4] = (unsigned)t; }
        unsigned* MC8 = (unsigned*)(ws + WS_MC); const float sl = 256.0f / sqrtf(4096.f * 128.f);
        for (int i4 = gtid; i4 < 16 * 256 * 512 / 4; i4 += gthreads) { float v4_[4];
#pragma unroll
            for (int j = 0; j < 4; ++j) { const int i = 4 * i4 + j; const int kq = i >> 17, row = (i >> 9) & 255, col = i & 511, kkp = row >> 6, k2 = row & 63, kk = col >> 7, pp = (col >> 6) & 1, l2 = col & 63;
                float v = 0.f; if (kk == kkp) { const int k = 4 * kq + kkp + 64 * k2; const float x = 2.f * (float)((l2 * k) & 4095) / 4096.f; v = (pp == 0 ? cospif(x) : sinpif(x)) * sl; }
                v4_[j] = v; }
            int t = __builtin_amdgcn_cvt_pk_fp8_f32(v4_[0], v4_[1], 0, false); t = __builtin_amdgcn_cvt_pk_fp8_f32(v4_[2], v4_[3], t, true); MC8[i4] = (unsigned)t; }
        float* RM = (float*)(ws + WS_ROPE); float* RG = RM + 2048;
        for (int i = gtid; i < 64 * 8; i += gthreads) { const int pos = i >> 3, f = i & 7; const float inv = powf(10000.f, -(float)f / 8.f); float s, c; sincosf((float)pos * inv, &s, &c); RM[2 * i] = c; RM[2 * i + 1] = s; }
        for (int i = gtid; i < 64 * 16; i += gthreads) { const int pos = i >> 4, f = i & 15; const float inv = powf(10000.f, -(float)f / 16.f); float s, c; sincosf((float)pos * inv, &s, &c); RG[2 * i] = c; RG[2 * i + 1] = s; }
        float* WRT = (float*)(ws + WS_WRT);
        for (int i = gtid; i < DEPTH * NE * D; i += gthreads) { const int l = i >> 15, e = (i >> 10) & 31, k = i & 1023; WRT[i] = a.in[21][((size_t)l * D + k) * NE + e]; }
        float* BG = (float*)(ws + WS_BGU);
        for (int i = gtid; i < DEPTH * NE * 2048; i += gthreads) { const int le = i >> 11, q = i & 2047, pn = q >> 8, s = (q >> 7) & 1, jj = q & 127; BG[i] = a.in[24][(size_t)le * 2048 + 2 * (pn * 128 + jj) + s]; }
    }
    __syncthreads();
    {
        LAS float* wl = (LAS float*)F.lds;
        LAS float* tc = wl + 2048; LAS float* ts = tc + 128;
        if (f_tid < 128) { const float x = 2.f * (float)f_tid / 128.f; tc[f_tid] = cospif(x); ts[f_tid] = -sinpif(x); }
        for (int it = blockIdx.x; it < 2 * 8 * 64; it += F.G) { const int j = it >> 9, g = (it >> 6) & 7, kb = it & 63;
            __syncthreads();
            { const int kk = f_tid >> 5, c4 = (f_tid & 31) * 4; const f32x4 w = *(const f32x4*)(a.in[9] + ((size_t)j * D + kb * 16 + kk) * D + g * 128 + c4);
              LAS float* d = wl + c4 * 16 + kk; d[0] = w[0]; d[16] = w[1]; d[32] = w[2]; d[48] = w[3]; }
            __syncthreads();
            const int cl = f_tid & 255, m = cl >> 1, part = cl & 1, kh = f_tid >> 8; const LAS float* tw = part ? ts : tc;
            float accv[8];
#pragma unroll
            for (int q = 0; q < 8; ++q) accv[q] = 0.f;
            for (int jj = 0; jj < 128; ++jj) { const float t = tw[(m * jj) & 127]; const f32x4 wa = *(const LAS f32x4*)(wl + jj * 16 + kh * 8), wb = *(const LAS f32x4*)(wl + jj * 16 + kh * 8 + 4);
                accv[0] += wa[0] * t; accv[1] += wa[1] * t; accv[2] += wa[2] * t; accv[3] += wa[3] * t; accv[4] += wb[0] * t; accv[5] += wb[1] * t; accv[6] += wb[2] * t; accv[7] += wb[3] * t; }
            v4u o; o.x = pk2(accv[0], accv[1]); o.y = pk2(accv[2], accv[3]); o.z = pk2(accv[4], accv[5]); o.w = pk2(accv[6], accv[7]);
            *(v4u*)((bf16*)(ws + WS_WFIN) + ((size_t)j * 2048 + g * 256 + cl) * D + kb * 16 + kh * 8) = o;
        }
        __syncthreads();
    }
    {
        LAS float* S = (LAS float*)F.lds;
        LAS float* red = S + 9 * 1024;
        for (int i = f_tid; i < 9 * 1024; i += 512) { const int r = i >> 10, k = i & 1023; const float v = (r < 8) ? a.in[1][r * D + k] : a.in[3][k]; S[i] = v / (1.f + __expf(-v)); }
        __syncthreads();
        for (int it = blockIdx.x; it < DEPTH * 96; it += F.G) { const int l = it / 96, n0 = (it % 96) * 64;
            const float* wp = a.in[4] + ((size_t)l * D + F.wave * 128) * (NMOD * D) + n0 + f_lane;
            float accv[9];
#pragma unroll
            for (int r = 0; r < 9; ++r) accv[r] = 0.f;
            for (int k0 = 0; k0 < 128; k0 += 32) { float wv[32];
#pragma unroll
                for (int k = 0; k < 32; ++k) wv[k] = wp[(size_t)(k0 + k) * (NMOD * D)];
#pragma unroll
                for (int k = 0; k < 32; ++k)
#pragma unroll
                    for (int r = 0; r < 9; ++r) accv[r] += S[r * 1024 + F.wave * 128 + k0 + k] * wv[k]; }
#pragma unroll
            for (int r = 0; r < 9; ++r) red[(F.wave * 9 + r) * 64 + f_lane] = accv[r];
            __syncthreads();
            for (int i = f_tid; i < 9 * 64; i += 512) { const int r = i >> 6, ln = i & 63; float s = a.in[5][(size_t)l * (NMOD * D) + n0 + ln];
#pragma unroll
                for (int w = 0; w < 8; ++w) s += red[(w * 9 + r) * 64 + ln];
                ((float*)(ws + WS_MOD))[((size_t)l * 9 + r) * (NMOD * D) + n0 + ln] = s; }
            __syncthreads();
        }
    }
}

__device__ __forceinline__ void load_row(const float* p, int lane, f32x4 (&v)[4]) {
#pragma unroll
    for (int j = 0; j < 4; ++j) v[j] = ((const f32x4*)p)[lane + 64 * j];
}
__device__ __forceinline__ void load_row_bf(const bf16* p, int lane, f32x4 (&v)[4]) {
#pragma unroll
    for (int j = 0; j < 4; ++j) { const v2u w = ((const v2u*)p)[lane + 64 * j]; v[j] = (f32x4){bf_lo(w.x), bf_hi(w.x), bf_lo(w.y), bf_hi(w.y)}; }
}
__device__ __forceinline__ void norm_mod(f32x4 (&v)[4], const float* g, const float* shift, const float* scale, int lane) {
    float s = 0.f;
#pragma unroll
    for (int j = 0; j < 4; ++j) s += (v[j][0] * v[j][0] + v[j][1] * v[j][1]) + (v[j][2] * v[j][2] + v[j][3] * v[j][3]);
    const float rstd = rsqrtf(wave_sum(s, lane) * (1.f / D) + EPS);
#pragma unroll
    for (int j = 0; j < 4; ++j) { const f32x4 gv = ((const f32x4*)g)[lane + 64 * j], sh = ((const f32x4*)shift)[lane + 64 * j], sc = ((const f32x4*)scale)[lane + 64 * j];
        v[j] = (v[j] * rstd * gv) * (sc + 1.f) + sh; }
}
__device__ __forceinline__ void store_row_bf16(bf16* p, int lane, const f32x4 (&v)[4]) {
#pragma unroll
    for (int j = 0; j < 4; ++j) { v2u w; w.x = pk2(v[j][0], v[j][1]); w.y = pk2(v[j][2], v[j][3]); ((v2u*)p)[lane + 64 * j] = w; }
}

__device__ __forceinline__ float store_row_i8(unsigned char* p, int lane, const f32x4 (&v)[4]) {
    float am = 0.f;
#pragma unroll
    for (int j = 0; j < 4; ++j) am = fmaxf(fmaxf(am, fmaxf(fabsf(v[j][0]), fabsf(v[j][1]))), fmaxf(fabsf(v[j][2]), fabsf(v[j][3])));
    unsigned k = __float_as_uint(am);
    { unsigned t;
      t = (unsigned)__builtin_amdgcn_mov_dpp((int)k, 0xb1, 0xf, 0xf, false); k = k > t ? k : t;
      t = (unsigned)__builtin_amdgcn_mov_dpp((int)k, 0x4e, 0xf, 0xf, false); k = k > t ? k : t;
      t = (unsigned)__builtin_amdgcn_mov_dpp((int)k, 0x124, 0xf, 0xf, false); k = k > t ? k : t;
      t = (unsigned)__builtin_amdgcn_mov_dpp((int)k, 0x128, 0xf, 0xf, false); k = k > t ? k : t;
      const unsigned a = (unsigned)__builtin_amdgcn_readlane((int)k, 0), b = (unsigned)__builtin_amdgcn_readlane((int)k, 16), c = (unsigned)__builtin_amdgcn_readlane((int)k, 32), d = (unsigned)__builtin_amdgcn_readlane((int)k, 48);
      const unsigned ab = a > b ? a : b, cd = c > d ? c : d; k = ab > cd ? ab : cd; }
    const float amax = __uint_as_float(k);
    const float qscale = amax > 0.f ? amax * (1.f / 127.f) : 1.f, qinv = amax > 0.f ? 127.f / amax : 0.f;
#pragma unroll
    for (int j = 0; j < 4; ++j) ((unsigned*)p)[lane + 64 * j] = q8x4(v[j][0], v[j][1], v[j][2], v[j][3], qinv);
    return qscale;
}
__device__ __forceinline__ void quant_rows(Frame& F, const bf16* src, unsigned char* dst, float* scale, int R) {
    const int f_lane = lthread(F.wave) & 63;
    for (int r = F.gw; r < R; r += F.NGW) { f32x4 v[4]; load_row_bf(src + (size_t)r * 1024, f_lane, v);
        const float sc = store_row_i8(dst + (size_t)r * 1024, f_lane, v); if (f_lane == 0) scale[r] = sc; }
}
__device__ __forceinline__ void rp_norm1(Frame& F, const Args& a, int l, int row_lo) {
    const int f_tid = lthread(F.wave), f_lane = f_tid & 63;
    const bf16* X = (const bf16*)(F.ws + WS_X); bf16* H = (bf16*)(F.ws + WS_H); const float* MOD = (const float*)(F.ws + WS_MOD) + (size_t)l * 9 * (NMOD * D);
    for (int row = row_lo + F.gw; row < NT; row += F.NGW) { f32x4 v[4];
        if (l == 0) { load_row(row < NC ? a.in[2] + (size_t)row * D : a.in[0] + (size_t)(row - NC) * D, f_lane, v);
            store_row_bf16((bf16*)(F.ws + WS_X) + (size_t)row * D, f_lane, v); }
        else load_row_bf(X + (size_t)row * D, f_lane, v);
        const float* m = MOD + (size_t)modrow_of(row) * (NMOD * D);
        norm_mod(v, a.in[6] + (size_t)l * D, m, m + D, f_lane);
        const float sc = store_row_i8((unsigned char*)H + (size_t)row * D, f_lane, v); if (f_lane == 0) ((float*)(F.ws + WS_SH))[row] = sc; }
}

__device__ __forceinline__ void rp_norm1_l0(Frame& F, const Args& a) {
    const int f_tid = lthread(F.wave), f_lane = f_tid & 63;
    LAS float* LM = (LAS float*)F.lds; const float* MOD = (const float*)(F.ws + WS_MOD);
    __syncthreads();
    for (int i = f_tid; i < 1024; i += 512) LM[i] = a.in[6][i];
    for (int i = f_tid; i < 18 * 1024; i += 512) LM[1024 + i] = MOD[(size_t)(i >> 11) * (NMOD * D) + (i & 2047)];
    __syncthreads();
    const int st = F.NGW, row0 = F.gw;
    if (row0 >= NT) return;
    const int n = (NT - row0 + st - 1) / st, rlast = row0 + (n - 1) * st;
#define NROW(i) ((row0 + (i) * st) <= rlast ? (row0 + (i) * st) : rlast)
#define NSRC(r) ((r) < NC ? a.in[2] + (size_t)(r) * D : a.in[0] + (size_t)((r) - NC) * D)
    f32x4 R0[4], R1[4], R2[4];
    { const int r0 = NROW(0), r1 = NROW(1), r2 = NROW(2); load_row(NSRC(r0), f_lane, R0); load_row(NSRC(r1), f_lane, R1); load_row(NSRC(r2), f_lane, R2); }
#define NSTEP(R, i_) do { if ((i_) < n) { const int row = NROW(i_); \
            store_row_bf16((bf16*)(F.ws + WS_X) + (size_t)row * D, f_lane, R); \
            float s_ = 0.f; _Pragma("unroll") for (int j = 0; j < 4; ++j) s_ += (R[j][0] * R[j][0] + R[j][1] * R[j][1]) + (R[j][2] * R[j][2] + R[j][3] * R[j][3]); \
            const float rstd_ = rsqrtf(wave_sum(s_, f_lane) * (1.f / D) + EPS); const LAS f32x4* mp_ = (const LAS f32x4*)(LM + 1024 + modrow_of(row) * 2048); \
            _Pragma("unroll") for (int j = 0; j < 4; ++j) { const f32x4 gv = ((const LAS f32x4*)LM)[f_lane + 64 * j], sh = mp_[f_lane + 64 * j], sc = mp_[256 + f_lane + 64 * j]; R[j] = (R[j] * rstd_ * gv) * (sc + 1.f) + sh; } \
            const float sc_ = store_row_i8((unsigned char*)(F.ws + WS_H) + (size_t)row * D, f_lane, R); if (f_lane == 0) ((float*)(F.ws + WS_SH))[row] = sc_; } \
        { const int rn_ = NROW((i_) + 3); load_row(NSRC(rn_), f_lane, R); } } while (0)
    for (int i = 0; i < n; i += 3) { NSTEP(R0, i); NSTEP(R1, i + 1); NSTEP(R2, i + 2); }
#undef NSTEP
#undef NSRC
#undef NROW
}

#if MK_N2V2
constexpr int LDS_LIST = LDS_MISC + 768;
__device__ __forceinline__ unsigned row16_max(unsigned k) {
    unsigned t;
    t = (unsigned)__builtin_amdgcn_mov_dpp((int)k, 0xb1, 0xf, 0xf, false); k = k > t ? k : t;
    t = (unsigned)__builtin_amdgcn_mov_dpp((int)k, 0x4e, 0xf, 0xf, false); k = k > t ? k : t;
    t = (unsigned)__builtin_amdgcn_mov_dpp((int)k, 0x124, 0xf, 0xf, false); k = k > t ? k : t;
    t = (unsigned)__builtin_amdgcn_mov_dpp((int)k, 0x128, 0xf, 0xf, false); k = k > t ? k : t;
    return k;
}
__device__ __forceinline__ unsigned wave_max_u(unsigned k) {
    k = row16_max(k);
    const unsigned a = (unsigned)__builtin_amdgcn_readlane((int)k, 0), b = (unsigned)__builtin_amdgcn_readlane((int)k, 16), c = (unsigned)__builtin_amdgcn_readlane((int)k, 32), d = (unsigned)__builtin_amdgcn_readlane((int)k, 48);
    const unsigned ab = a > b ? a : b, cd = c > d ? c : d; return ab > cd ? ab : cd;
}
__device__ __forceinline__ float key_val(unsigned m) { const unsigned u = m & ~31u; return __builtin_bit_cast(float, (u & 0x80000000u) ? (u ^ 0x80000000u) : ~u); }
constexpr int N2_WPITCH = 2064;
constexpr int N2_GM = 32 * N2_WPITCH;
constexpr int N2_LIST = N2_GM + 5 * 8192;
__device__ __forceinline__ void rp_norm2_router(Frame& F, const Args& a, int l, int row_lo) {
    const int f_tid = lthread(F.wave), f_lane = f_tid & 63;
    const bf16* X = (const bf16*)(F.ws + WS_X); unsigned char* H8 = (unsigned char*)(F.ws + WS_H); const float* MOD = (const float*)(F.ws + WS_MOD) + (size_t)l * 9 * (NMOD * D);
    LAS unsigned char* WT = F.lds;
    { const f32x4* src = (const f32x4*)((const float*)(F.ws + WS_WRT) + (size_t)l * NE * D); f32x4 tv[16];
#pragma unroll
      for (int i = 0; i < 16; ++i) tv[i] = src[f_tid + 512 * i];
#pragma unroll
      for (int i = 0; i < 16; ++i) { const int i4 = f_tid + 512 * i, e = i4 >> 8, k4 = (i4 & 255) * 4; v2u w; w.x = pk2(tv[i][0], tv[i][1]); w.y = pk2(tv[i][2], tv[i][3]); *(LAS v2u*)(WT + e * N2_WPITCH + k4 * 2) = w; } }
    LAS int* lcnt = (LAS int*)(F.lds + LDS_TT); LAS int* lbase = lcnt + 32;
    if (f_tid < 32) lcnt[f_tid] = 0;
    const int ngroups = (NT - row_lo) >> 5;
    const int g = F.wave * F.G + (int)blockIdx.x;
    const bool active = (F.wave < 5) && (g < ngroups);
    LAS float* GM = (LAS float*)(F.lds + N2_GM + (F.wave < 5 ? F.wave : 0) * 8192); LAS float* SH = GM + 1024;
    LAS v4u* list = (LAS v4u*)(F.lds + N2_LIST + (F.wave < 5 ? F.wave : 0) * (128 * 16 + 128)); LAS float* lsc = (LAS float*)(list + 128);
    const int r = f_lane & 31, kh = f_lane >> 5;
    const int row = row_lo + g * 32 + r;
    float msh = 0.f;
    if (active) {
        const float* m = MOD + (size_t)modrow_of(row_lo + g * 32) * (NMOD * D); const float* gf = a.in[7] + (size_t)l * D;
#pragma unroll
        for (int j = 0; j < 4; ++j) { const f32x4 gv = ((const f32x4*)gf)[f_lane + 64 * j], sc = ((const f32x4*)(m + 4 * D))[f_lane + 64 * j], sv = ((const f32x4*)(m + 3 * D))[f_lane + 64 * j];
            ((LAS f32x4*)GM)[f_lane + 64 * j] = gv * (sc + 1.f); ((LAS f32x4*)SH)[f_lane + 64 * j] = sv;
            msh = fmaxf(fmaxf(msh, fmaxf(fabsf(sv[0]), fabsf(sv[1]))), fmaxf(fabsf(sv[2]), fabsf(sv[3]))); }
        msh = __uint_as_float(wave_max_u(__float_as_uint(msh)));
    }
    __syncthreads();
    if (active) {
        const bf16* xr = X + (size_t)row * D + 16 * kh;
        float ssq = 0.f, mxg = 0.f;
#pragma unroll 1
        for (int c0 = 0; c0 < 32; c0 += 8) { v4u xa[8], xb[8];
#pragma unroll
            for (int i = 0; i < 8; ++i) { xa[i] = *(const v4u*)(xr + 32 * (c0 + i)); xb[i] = *(const v4u*)(xr + 32 * (c0 + i) + 8); }
#pragma unroll
            for (int i = 0; i < 8; ++i) { const LAS f32x4* gp = (const LAS f32x4*)(GM + 32 * (c0 + i) + 16 * kh);
                const f32x4 g0 = gp[0], g1 = gp[1], g2 = gp[2], g3 = gp[3];
                const unsigned wa[4] = {xa[i].x, xa[i].y, xa[i].z, xa[i][3]}, wb[4] = {xb[i].x, xb[i].y, xb[i].z, xb[i][3]};
#pragma unroll
                for (int q = 0; q < 4; ++q) { const float x0 = bf_lo(wa[q]), x1 = bf_hi(wa[q]), x2 = bf_lo(wb[q]), x3 = bf_hi(wb[q]);
                    ssq += x0 * x0 + x1 * x1 + x2 * x2 + x3 * x3;
                    const float ga = (q < 2 ? g0 : g1)[(2 * q) & 3], gb = (q < 2 ? g0 : g1)[(2 * q + 1) & 3], gc = (q < 2 ? g2 : g3)[(2 * q) & 3], gd = (q < 2 ? g2 : g3)[(2 * q + 1) & 3];
                    mxg = fmaxf(fmaxf(mxg, fmaxf(fabsf(x0 * ga), fabsf(x1 * gb))), fmaxf(fabsf(x2 * gc), fabsf(x3 * gd))); } } }
        { auto rr = __builtin_amdgcn_permlane32_swap(__float_as_uint(ssq), __float_as_uint(ssq), false, false); ssq = __uint_as_float(rr[0]) + __uint_as_float(rr[1]); }
        { auto rr = __builtin_amdgcn_permlane32_swap(__float_as_uint(mxg), __float_as_uint(mxg), false, false); mxg = fmaxf(__uint_as_float(rr[0]), __uint_as_float(rr[1])); }
        const float rstd = rsqrtf(ssq * (1.f / D) + EPS);
        const float bound = mxg * rstd + msh;
        const float qscale = bound > 0.f ? bound * (1.f / 127.f) : 1.f, qinv = bound > 0.f ? 127.f / bound : 0.f;
        f32x16 acc = f32x16{};
        unsigned char* hrow = H8 + (size_t)row * D + 16 * kh;
        const LAS unsigned char* wrow = WT + r * N2_WPITCH + 32 * kh;
#pragma unroll 1
        for (int c0 = 0; c0 < 32; c0 += 4) { v4u xa[4], xb[4];
#pragma unroll
            for (int i = 0; i < 4; ++i) { xa[i] = *(const v4u*)(xr + 32 * (c0 + i)); xb[i] = *(const v4u*)(xr + 32 * (c0 + i) + 8); }
#pragma unroll
            for (int i = 0; i < 4; ++i) { const int c = c0 + i;
                const LAS f32x4* gp = (const LAS f32x4*)(GM + 32 * c + 16 * kh); const LAS f32x4* sp = (const LAS f32x4*)(SH + 32 * c + 16 * kh);
                const bf16x8 w0 = *(const LAS bf16x8*)(wrow + 64 * c), w1 = *(const LAS bf16x8*)(wrow + 64 * c + 16);
                float h[16];
                const unsigned wa[4] = {xa[i].x, xa[i].y, xa[i].z, xa[i][3]}, wb[4] = {xb[i].x, xb[i].y, xb[i].z, xb[i][3]};
#pragma unroll
                for (int q = 0; q < 4; ++q) { h[2 * q] = bf_lo(wa[q]); h[2 * q + 1] = bf_hi(wa[q]); h[8 + 2 * q] = bf_lo(wb[q]); h[8 + 2 * q + 1] = bf_hi(wb[q]); }
#pragma unroll
                for (int q = 0; q < 4; ++q) { const f32x4 gq = gp[q], sq = sp[q];
#pragma unroll
                    for (int e = 0; e < 4; ++e) h[4 * q + e] = (h[4 * q + e] * rstd) * gq[e] + sq[e]; }
                v4u o8;
#pragma unroll
                for (int q = 0; q < 4; ++q) o8[q] = q8x4(h[4 * q], h[4 * q + 1], h[4 * q + 2], h[4 * q + 3], qinv);
                *(v4u*)(hrow + 32 * c) = o8;
                v4u hi0, hi1, lo0, lo1;
#pragma unroll
                for (int q = 0; q < 4; ++q) { hi0[q] = pk2(h[2 * q], h[2 * q + 1]); hi1[q] = pk2(h[8 + 2 * q], h[8 + 2 * q + 1]); }
#pragma unroll
                for (int q = 0; q < 4; ++q) { lo0[q] = pk2(h[2 * q] - bf_lo(hi0[q]), h[2 * q + 1] - bf_hi(hi0[q])); lo1[q] = pk2(h[8 + 2 * q] - bf_lo(hi1[q]), h[8 + 2 * q + 1] - bf_hi(hi1[q])); }
                acc = __builtin_amdgcn_mfma_f32_32x32x16_bf16(w0, __builtin_bit_cast(bf16x8, hi0), acc, 0, 0, 0);
                acc = __builtin_amdgcn_mfma_f32_32x32x16_bf16(w0, __builtin_bit_cast(bf16x8, lo0), acc, 0, 0, 0);
                acc = __builtin_amdgcn_mfma_f32_32x32x16_bf16(w1, __builtin_bit_cast(bf16x8, hi1), acc, 0, 0, 0);
                acc = __builtin_amdgcn_mfma_f32_32x32x16_bf16(w1, __builtin_bit_cast(bf16x8, lo1), acc, 0, 0, 0); } }
        float val[32];
        const float* br = a.in[22] + (size_t)l * NE;
#pragma unroll
        for (int j = 0; j < 16; ++j) { auto rr = __builtin_amdgcn_permlane32_swap(__float_as_uint(acc[j]), __float_as_uint(acc[j]), false, false);
            const int e0 = (j & 3) + 8 * (j >> 2); val[e0] = __uint_as_float(rr[0]) + br[e0]; val[e0 + 4] = __uint_as_float(rr[1]) + br[e0 + 4]; }
        unsigned taken = 0u; int be[4]; float bv[4];
#pragma unroll
        for (int k = 0; k < 4; ++k) { float best = -INFINITY; int bi = 0;
#pragma unroll
            for (int e = 0; e < 32; ++e) { const bool cnd = !((taken >> e) & 1u) && (val[e] > best); best = cnd ? val[e] : best; bi = cnd ? e : bi; }
            taken |= 1u << bi; be[k] = bi; bv[k] = best; }
        const float e1 = __expf(bv[1] - bv[0]), e2 = __expf(bv[2] - bv[0]), e3 = __expf(bv[3] - bv[0]); const float inv = 1.f / (1.f + e1 + e2 + e3);
        if (kh == 0) { const float ww[4] = {inv, e1 * inv, e2 * inv, e3 * inv};
#pragma unroll
            for (int k = 0; k < 4; ++k) { const int lr = __hip_atomic_fetch_add(lcnt + be[k], 1, __ATOMIC_RELAXED, __HIP_MEMORY_SCOPE_WORKGROUP);
                LAS unsigned* ep = (LAS unsigned*)(list + r * 4 + k); ep[0] = (unsigned)(row * 4 + k); ep[1] = (unsigned)be[k]; ep[2] = (unsigned)lr; ep[3] = __builtin_bit_cast(unsigned, ww[k]); }
            lsc[r] = qscale; }
    }
    __syncthreads();
    if (f_tid < 32) { const int c = lcnt[f_tid]; lbase[f_tid] = c ? (int)__hip_atomic_fetch_add((unsigned*)(F.ctl + CW_CNT + (l * 32 + f_tid) * 16), (unsigned)c, RLX_AGENT) : 0; }
    __syncthreads();
    if (active) {
        int* te = (int*)(F.ws + WS_TE); int* trank = (int*)(F.ws + WS_TRANK); int* stok = (int*)(F.ws + WS_STOK); float* sw = (float*)(F.ws + WS_SW); float* ssc = (float*)(F.ws + WS_SSC);
#pragma unroll
        for (int i = f_lane; i < 128; i += 64) { const LAS unsigned* ep = (const LAS unsigned*)(list + i); const unsigned rowk = ep[0], ex = ep[1], lr = ep[2]; const float wv = __builtin_bit_cast(float, ep[3]);
            const int rk = lbase[ex] + (int)lr;
            stok[(size_t)ex * CAP + rk] = (int)(rowk >> 2); sw[(size_t)ex * CAP + rk] = wv; ssc[(size_t)ex * CAP + rk] = lsc[i >> 2]; te[rowk] = (int)ex; trank[rowk] = rk; }
    }
}

#endif
__device__ __forceinline__ void moe_table(Frame& F, int l) {
    const int f_tid = lthread(F.wave), f_lane = f_tid & 63;
    LAS int* TT = (LAS int*)(F.lds + LDS_TT); LAS int* CN = TT + 64; LAS int* TE = (LAS int*)(F.lds + LDS_TE);
    __syncthreads();
    if (f_tid < 64) {
        const int c = (f_lane < 32) ? (int)__hip_atomic_load((unsigned*)(F.ctl + CW_CNT + (l * 32 + (f_lane & 31)) * 16), RLX_AGENT) : 0;
        const int tl = (c + 255) >> 8; int v = tl;
#pragma unroll
        for (int o = 1; o < 32; o <<= 1) { const int n = __builtin_amdgcn_ds_bpermute((f_lane >= o ? f_lane - o : f_lane) << 2, v); if (f_lane >= o) v += n; }
        if (f_lane < 32) { CN[f_lane] = c; TT[f_lane] = v - tl; if (f_lane == 31) TT[32] = v; }
    }
    __syncthreads();
    for (int t = f_tid; t < MAXTILES; t += 512) { int lo = 0, hi = 32;
#pragma unroll
        for (int k = 0; k < 5; ++k) { const int mid = (lo + hi) >> 1; if (TT[mid] <= t) lo = mid; else hi = mid; }
        TE[t] = lo; }
    __syncthreads();
}

#if MK_CBV2
struct CombRow { v4u x[2]; v4u y[4]; };
__device__ __forceinline__ void comb_issue(CombRow& R, const bf16* X, const unsigned char* Y, const LAS int* TT, int row, const v4u te4, const v4u tr4, int lane) {
    const unsigned ee[4] = {te4[0], te4[1], te4[2], te4[3]}, rr[4] = {tr4[0], tr4[1], tr4[2], tr4[3]};
#pragma unroll
    for (int k = 0; k < 4; ++k) { const size_t slot = (size_t)TT[ee[k]] * 256 + rr[k]; R.y[k] = *(const v4u*)(Y + slot * 1024 + 16 * lane); }
    const bf16* xp = X + (size_t)row * D + 16 * lane; R.x[0] = *(const v4u*)xp; R.x[1] = *(const v4u*)(xp + 8);
}
constexpr int CB_G5 = 0, CB_MS = 9 * 1024, CB_GX = 27 * 1024, CB_FLOATS = 28 * 1024;
__device__ __forceinline__ int cb_pos(int e) { return ((e >> 2) & 3) * 256 + (e >> 4) * 4 + (e & 3); }
__device__ __forceinline__ void comb_finish(const CombRow& R, Frame& F, const Args& a, int l, int row, int lane, bool lastl) {
    bf16* X = (bf16*)(F.ws + WS_X); unsigned char* H8 = (unsigned char*)(F.ws + WS_H); const LAS float* LM = (const LAS float*)F.lds;
    const int mr = modrow_of(row); const LAS f32x4* g5 = (const LAS f32x4*)(LM + CB_G5 + mr * 1024) + lane;
    float v[16];
#pragma unroll
    for (int w = 0; w < 4; ++w) { f32x4 s = (f32x4){0.f, 0.f, 0.f, 0.f};
#pragma unroll
        for (int k = 0; k < 4; ++k) { const int yw = (int)R.y[k][w]; const f32x2 lo = __builtin_amdgcn_cvt_pk_f32_fp8(yw, false), hi = __builtin_amdgcn_cvt_pk_f32_fp8(yw, true); s[0] += lo[0]; s[1] += lo[1]; s[2] += hi[0]; s[3] += hi[1]; }
        const f32x4 gv = g5[w * 64]; const unsigned x0 = R.x[w >> 1][(2 * w) & 3], x1 = R.x[w >> 1][(2 * w + 1) & 3];
        v[4 * w] = bf_lo(x0) + gv[0] * s[0] * 0.125f; v[4 * w + 1] = bf_hi(x0) + gv[1] * s[1] * 0.125f; v[4 * w + 2] = bf_lo(x1) + gv[2] * s[2] * 0.125f; v[4 * w + 3] = bf_hi(x1) + gv[3] * s[3] * 0.125f; }
    float ss = 0.f;
#pragma unroll
    for (int i = 0; i < 16; ++i) ss += v[i] * v[i];
    const float rstd = rsqrtf(wave_sum(ss, lane) * (1.f / D) + EPS);
    if (!lastl) {
        bf16* xo = X + (size_t)row * D + 16 * lane;
        { v4u o0, o1;
#pragma unroll
          for (int q = 0; q < 4; ++q) { o0[q] = pk2(v[2 * q], v[2 * q + 1]); o1[q] = pk2(v[8 + 2 * q], v[8 + 2 * q + 1]); }
          *(v4u*)xo = o0; *(v4u*)(xo + 8) = o1; }
        const LAS f32x4* m = (const LAS f32x4*)(LM + CB_MS + mr * 2048) + lane; const LAS f32x4* gx = (const LAS f32x4*)(LM + CB_GX) + lane;
        float am = 0.f;
#pragma unroll
        for (int w = 0; w < 4; ++w) { const f32x4 gv = gx[w * 64], sh = m[w * 64], sc = m[256 + w * 64];
#pragma unroll
            for (int e = 0; e < 4; ++e) { const float h = (v[4 * w + e] * rstd * gv[e]) * (sc[e] + 1.f) + sh[e]; v[4 * w + e] = h; am = fmaxf(am, fabsf(h)); } }
        const float amax = __uint_as_float(wave_max_u(__float_as_uint(am)));
        const float qscale = amax > 0.f ? amax * (1.f / 127.f) : 1.f, qinv = amax > 0.f ? 127.f / amax : 0.f;
        v4u o8;
#pragma unroll
        for (int w = 0; w < 4; ++w) o8[w] = q8x4(v[4 * w], v[4 * w + 1], v[4 * w + 2], v[4 * w + 3], qinv);
        *(v4u*)(H8 + (size_t)row * D + 16 * lane) = o8;
        if (lane == 0) ((float*)(F.ws + WS_SH))[row] = qscale;
    } else {
        float* op = a.out + (size_t)(row - NC) * D + 16 * lane; const LAS f32x4* gf = (const LAS f32x4*)(LM + CB_GX) + lane;
#pragma unroll
        for (int w = 0; w < 4; ++w) { const f32x4 gv = gf[w * 64]; ((f32x4*)op)[w] = (f32x4){v[4 * w] * rstd * gv[0], v[4 * w + 1] * rstd * gv[1], v[4 * w + 2] * rstd * gv[2], v[4 * w + 3] * rstd * gv[3]}; }
    }
}
__device__ __forceinline__ void rp_combine(Frame& F, const Args& a, int l, int row_lo) {
    const int f_tid = lthread(F.wave), f_lane = f_tid & 63;
    const bf16* X = (const bf16*)(F.ws + WS_X); const unsigned char* Y = (const unsigned char*)(F.ws + WS_Y);
    const float* MOD = (const float*)(F.ws + WS_MOD) + (size_t)l * 9 * (NMOD * D); const float* MODN = MOD + 9 * (NMOD * D);
    const v4u* te = (const v4u*)(F.ws + WS_TE); const v4u* trank = (const v4u*)(F.ws + WS_TRANK);
    const LAS int* TT = (const LAS int*)(F.lds + LDS_TT);
    const bool lastl = (l == DEPTH - 1);
    { LAS float* LM = (LAS float*)F.lds; __syncthreads();
      for (int i = f_tid; i < 9 * 1024; i += 512) LM[CB_G5 + (i & ~1023) + cb_pos(i & 1023)] = MOD[(size_t)(i >> 10) * (NMOD * D) + 5 * D + (i & 1023)];
      if (!lastl) { for (int i = f_tid; i < 18 * 1024; i += 512) LM[CB_MS + (i & ~1023) + cb_pos(i & 1023)] = MODN[(size_t)(i >> 11) * (NMOD * D) + (i & 2047)];
                    for (int i = f_tid; i < 1024; i += 512) LM[CB_GX + cb_pos(i)] = a.in[6][(size_t)(l + 1) * D + i]; }
      else for (int i = f_tid; i < 1024; i += 512) LM[CB_GX + cb_pos(i)] = a.in[8][i];
      __syncthreads(); }
    const int st = F.NGW, row0 = row_lo + F.gw;
    if (row0 >= NT) return;
    const int n = (NT - row0 + st - 1) / st, rlast = row0 + (n - 1) * st;
#define CROW(i) ((row0 + (i) * st) <= rlast ? (row0 + (i) * st) : rlast)
    CombRow R0, R1, R2;
    { const v4u t0 = te[CROW(0)], r0 = trank[CROW(0)], t1 = te[CROW(1)], r1 = trank[CROW(1)], t2 = te[CROW(2)], r2 = trank[CROW(2)];
      comb_issue(R0, X, Y, TT, CROW(0), t0, r0, f_lane); comb_issue(R1, X, Y, TT, CROW(1), t1, r1, f_lane); comb_issue(R2, X, Y, TT, CROW(2), t2, r2, f_lane); }
    v4u teN = te[CROW(3)], trN = trank[CROW(3)];
#define CSTEP(R, i_) do { const v4u teU = teN, trU = trN; teN = te[CROW((i_) + 4)]; trN = trank[CROW((i_) + 4)]; \
        if ((i_) < n) comb_finish(R, F, a, l, CROW(i_), f_lane, lastl); \
        comb_issue(R, X, Y, TT, CROW((i_) + 3), teU, trU, f_lane); } while (0)
    for (int i = 0; i < n; i += 3) { CSTEP(R0, i); CSTEP(R1, i + 1); CSTEP(R2, i + 2); }
#undef CSTEP
#undef CROW
}
#endif

__device__ __forceinline__ void quant_rows384(Frame& F, const bf16* src, unsigned char* dst, float* scale, int R) {
    const int f_lane = lthread(F.wave) & 63;
    for (int r = F.gw; r < R; r += F.NGW) { const unsigned* sp = (const unsigned*)(src + (size_t)r * 384); const unsigned u0 = sp[f_lane], u1 = sp[f_lane + 64], u2 = sp[f_lane + 128];
        const float x0 = bf_lo(u0), x1 = bf_hi(u0), x2 = bf_lo(u1), x3 = bf_hi(u1), x4 = bf_lo(u2), x5 = bf_hi(u2);
        const float am = __uint_as_float(wave_max_u(__float_as_uint(fmaxf(fmaxf(fmaxf(fabsf(x0), fabsf(x1)), fmaxf(fabsf(x2), fabsf(x3))), fmaxf(fabsf(x4), fabsf(x5))))));
        const float qinv = am > 0.f ? 127.f / am : 0.f; const unsigned w0 = q8x4(x0, x1, x2, x3, qinv), w1 = q8x4(x4, x5, 0.f, 0.f, qinv);
        unsigned short* dp = (unsigned short*)(dst + (size_t)r * 512); dp[f_lane] = (unsigned short)(w0 & 0xffffu); dp[f_lane + 64] = (unsigned short)(w0 >> 16); dp[f_lane + 128] = (unsigned short)(w1 & 0xffffu); dp[f_lane + 192] = 0;
        if (f_lane == 0) scale[r] = am > 0.f ? am * (1.f / 127.f) : 1.f; }
}
__device__ __forceinline__ void quant_rows256(Frame& F, const bf16* src, unsigned char* dst, float* scale, int R) {
    const int f_lane = lthread(F.wave) & 63;
    for (int r = F.gw; r < R; r += F.NGW) { const v2u w = ((const v2u*)(src + (size_t)r * 256))[f_lane]; const float x0 = bf_lo(w.x), x1 = bf_hi(w.x), x2 = bf_lo(w.y), x3 = bf_hi(w.y);
        const float am = __uint_as_float(wave_max_u(__float_as_uint(fmaxf(fmaxf(fabsf(x0), fabsf(x1)), fmaxf(fabsf(x2), fabsf(x3))))));
        ((unsigned*)(dst + (size_t)r * 256))[f_lane] = q8x4(x0, x1, x2, x3, am > 0.f ? 127.f / am : 0.f); if (f_lane == 0) scale[r] = am > 0.f ? am * (1.f / 127.f) : 1.f; }
}
struct MRaw { unsigned q[3], c[2], pe; };
__device__ __forceinline__ void mla_issue(MRaw& R, const bf16* A, int row, int lane) {
    const unsigned* ap = (const unsigned*)(A + (size_t)row * MLA_IN_PAD);
#pragma unroll
    for (int j = 0; j < 3; ++j) R.q[j] = ap[lane + 64 * j];
#pragma unroll
    for (int j = 0; j < 2; ++j) R.c[j] = ap[192 + lane + 64 * j];
    R.pe = ap[320 + (lane & 15)];
}
__device__ __forceinline__ void mla_finish(const MRaw& R, Frame& F, int row, int f_lane) {
    bf16* QA = (bf16*)(F.ws + WS_RF); bf16* CKV = (bf16*)(F.ws + WS_RG); bf16* Kb = (bf16*)(F.ws + WS_RB);
    const LAS float* gq = (const LAS float*)F.lds; const LAS float* gk = gq + 384; const LAS float* rope = gq + 640;
    float sq = 0.f, sc = 0.f;
#pragma unroll
    for (int j = 0; j < 3; ++j) { const float x0 = bf_lo(R.q[j]), x1 = bf_hi(R.q[j]); sq += x0 * x0 + x1 * x1; }
#pragma unroll
    for (int j = 0; j < 2; ++j) { const float x0 = bf_lo(R.c[j]), x1 = bf_hi(R.c[j]); sc += x0 * x0 + x1 * x1; }
    const float rq = rsqrtf(wave_sum(sq, f_lane) * (1.f / MLA_QL) + EPS), rc = rsqrtf(wave_sum(sc, f_lane) * (1.f / MLA_KVL) + EPS);
    { float qv[6];
#pragma unroll
      for (int j = 0; j < 3; ++j) { const int e0 = 2 * (f_lane + 64 * j); qv[2 * j] = bf_lo(R.q[j]) * rq * gq[e0]; qv[2 * j + 1] = bf_hi(R.q[j]) * rq * gq[e0 + 1]; }
      float am = 0.f;
#pragma unroll
      for (int j = 0; j < 6; ++j) am = fmaxf(am, fabsf(qv[j]));
      am = __uint_as_float(wave_max_u(__float_as_uint(am)));
      const float qinv = am > 0.f ? 127.f / am : 0.f; const unsigned w0 = q8x4(qv[0], qv[1], qv[2], qv[3], qinv), w1 = q8x4(qv[4], qv[5], 0.f, 0.f, qinv);
      unsigned short* qp8 = (unsigned short*)((unsigned char*)QA + (size_t)row * 512);
      qp8[f_lane] = (unsigned short)(w0 & 0xffffu); qp8[f_lane + 64] = (unsigned short)(w0 >> 16); qp8[f_lane + 128] = (unsigned short)(w1 & 0xffffu); qp8[f_lane + 192] = 0;
      if (f_lane == 0) ((float*)(F.ws + WS_SCKV + 262144))[row] = am > 0.f ? am * (1.f / 127.f) : 1.f; }
    { float cv[4];
#pragma unroll
      for (int j = 0; j < 2; ++j) { const int e0 = 2 * (f_lane + 64 * j); cv[2 * j] = bf_lo(R.c[j]) * rc * gk[e0]; cv[2 * j + 1] = bf_hi(R.c[j]) * rc * gk[e0 + 1]; }
      const float am = __uint_as_float(wave_max_u(__float_as_uint(fmaxf(fmaxf(fabsf(cv[0]), fabsf(cv[1])), fmaxf(fabsf(cv[2]), fabsf(cv[3]))))));
      const float qinv = am > 0.f ? 127.f / am : 0.f; const unsigned w = q8x4(cv[0], cv[1], cv[2], cv[3], qinv);
      unsigned short* cp8 = (unsigned short*)((unsigned char*)CKV + (size_t)row * MLA_KVL);
      cp8[f_lane] = (unsigned short)(w & 0xffffu); cp8[f_lane + 64] = (unsigned short)(w >> 16);
      if (f_lane == 0) ((float*)(F.ws + WS_SCKV))[row] = am > 0.f ? am * (1.f / 127.f) : 1.f; }
    float x0 = bf_lo(R.pe), x1 = bf_hi(R.pe);
    if (row >= NC) { const int t = (row - NC) & 4095, i = f_lane & 15, d = 2 * i, pos = (d & 16) ? (t & 63) : (t >> 6), f = d & 7;
        const float p0 = shx(x0, 4, f_lane), p1 = shx(x1, 4, f_lane); const float sg = (d & 8) ? 1.f : -1.f;
        const LAS float* rp = rope + pos * 16 + 2 * f; x0 = x0 * rp[0] + sg * p0 * rp[1]; x1 = x1 * rp[2] + sg * p1 * rp[3]; }
    const unsigned w = pk2(x0, x1);
    { const int i = f_lane & 15, hb = f_lane >> 4;
#pragma unroll
      for (int hh = 0; hh < 4; ++hh) { const int h = hb * 4 + hh; ((unsigned*)(Kb + (size_t)row * 1536 + 96 * h + 64))[i] = w; } }
}
__device__ __forceinline__ void rp_mla(Frame& F, const Args& a) {
    const int f_tid = lthread(F.wave), f_lane = f_tid & 63;
    const bf16* A = (const bf16*)(F.ws + WS_RE);
    { LAS float* L = (LAS float*)F.lds; const float* rope = (const float*)(F.ws + WS_ROPE); __syncthreads();
      for (int i = f_tid; i < 384; i += 512) L[i] = a.in[12][i];
      for (int i = f_tid; i < 256; i += 512) L[384 + i] = a.in[14][i];
      for (int i = f_tid; i < 1024; i += 512) L[640 + i] = rope[i];
      __syncthreads(); }
    const int st = F.NGW, row0 = F.gw;
    if (row0 >= NT) return;
    const int n = (NT - row0 + st - 1) / st, rlast = row0 + (n - 1) * st;
#define MROW(i) ((row0 + (i) * st) <= rlast ? (row0 + (i) * st) : rlast)
    MRaw R0, R1, R2; mla_issue(R0, A, MROW(0), f_lane); mla_issue(R1, A, MROW(1), f_lane); mla_issue(R2, A, MROW(2), f_lane);
#define MSTEP(R, i_) do { if ((i_) < n) mla_finish(R, F, MROW(i_), f_lane); mla_issue(R, A, MROW((i_) + 3), f_lane); } while (0)
    for (int i = 0; i < n; i += 3) { MSTEP(R0, i); MSTEP(R1, i + 1); MSTEP(R2, i + 2); }
#undef MSTEP
#undef MROW
}

struct GRaw { v4u q0, q1, k0, k1; };
__device__ __forceinline__ void gqa_issue(GRaw& R, const bf16* A, int row, int lane) {
    const bf16* s0 = A + (size_t)row * GQA_QKV + lane * 16; const bf16* s1 = A + (size_t)row * GQA_QKV + 1024 + (lane & 15) * 16;
    R.q0 = *(const v4u*)s0; R.q1 = *(const v4u*)(s0 + 8); R.k0 = *(const v4u*)s1; R.k1 = *(const v4u*)(s1 + 8);
}
__device__ __forceinline__ void gqa_finish(const GRaw& R, Frame& F, int row, int f_lane) {
    bf16* Q = (bf16*)(F.ws + WS_RB); bf16* Kb = Q + (size_t)NT * 1024;
    const LAS float* LG = (const LAS float*)F.lds; const LAS float* rope = LG + 128;
    const float c2 = 0.125f * LOG2E;
    const bool lat = row >= NC; const int t = (row - NC) & 4095;
#pragma unroll
    for (int part = 0; part < 2; ++part) {
        const int ln = part ? (f_lane & 15) : f_lane;
        const v4u w0 = part ? R.k0 : R.q0, w1 = part ? R.k1 : R.q1;
        float x[16]; const unsigned ww[8] = {w0.x, w0.y, w0.z, w0[3], w1.x, w1.y, w1.z, w1[3]};
#pragma unroll
        for (int i = 0; i < 8; ++i) { x[2 * i] = bf_lo(ww[i]); x[2 * i + 1] = bf_hi(ww[i]); }
        float ss = 0.f;
#pragma unroll
        for (int i = 0; i < 16; ++i) ss += x[i] * x[i];
        ss += shx(ss, 1, f_lane); ss += shx(ss, 2, f_lane);
        const float rs = rsqrtf(ss * (1.f / 64.f) + EPS); const LAS float* g = LG + (part ? 64 : 0) + (ln & 3) * 16;
#pragma unroll
        for (int i = 0; i < 16; ++i) x[i] = x[i] * rs * g[i];
        if (lat) { const int sec = (ln >> 1) & 1, pos = sec ? (t & 63) : (t >> 6); const float sg = (ln & 1) ? 1.f : -1.f; const LAS float* rp = rope + pos * 32;
#pragma unroll
            for (int i = 0; i < 16; ++i) { const float pr = shx(x[i], 1, f_lane); x[i] = x[i] * rp[2 * i] + sg * pr * rp[2 * i + 1]; } }
        const float scl = part ? 1.f : c2;
        v4u o0, o1; o0.x = pk2(x[0] * scl, x[1] * scl); o0.y = pk2(x[2] * scl, x[3] * scl); o0.z = pk2(x[4] * scl, x[5] * scl); o0[3] = pk2(x[6] * scl, x[7] * scl);
        o1.x = pk2(x[8] * scl, x[9] * scl); o1.y = pk2(x[10] * scl, x[11] * scl); o1.z = pk2(x[12] * scl, x[13] * scl); o1[3] = pk2(x[14] * scl, x[15] * scl);
        if (part == 0) { bf16* d = Q + (size_t)row * 1024 + ln * 16; *(v4u*)d = o0; *(v4u*)(d + 8) = o1; }
        else if (f_lane < 16) { bf16* d = Kb + (size_t)row * 256 + ln * 16; *(v4u*)d = o0; *(v4u*)(d + 8) = o1; }
    }
}
__device__ __forceinline__ void rp_gqa(Frame& F, const Args& a) {
    const int f_tid = lthread(F.wave), f_lane = f_tid & 63;
    const bf16* A = (const bf16*)(F.ws + WS_RA);
    { LAS float* L = (LAS float*)F.lds; const float* rope = (const float*)(F.ws + WS_ROPE) + 2048; __syncthreads();
      for (int i = f_tid; i < 64; i += 512) { L[i] = a.in[18][i]; L[64 + i] = a.in[19][i]; }
      for (int i = f_tid; i < 2048; i += 512) L[128 + i] = rope[i];
      __syncthreads(); }
    const int st = F.NGW, row0 = F.gw;
    if (row0 >= NT) return;
    const int n = (NT - row0 + st - 1) / st, rlast = row0 + (n - 1) * st;
#define GROW(i) ((row0 + (i) * st) <= rlast ? (row0 + (i) * st) : rlast)
    GRaw R0, R1, R2; gqa_issue(R0, A, GROW(0), f_lane); gqa_issue(R1, A, GROW(1), f_lane); gqa_issue(R2, A, GROW(2), f_lane);
#define GSTEP(R, i_) do { if ((i_) < n) gqa_finish(R, F, GROW(i_), f_lane); gqa_issue(R, A, GROW((i_) + 3), f_lane); } while (0)
    for (int i = 0; i < n; i += 3) { GSTEP(R0, i); GSTEP(R1, i + 1); GSTEP(R2, i + 2); }
#undef GSTEP
#undef GROW
}

template <int DK>
__device__ __forceinline__ void attn_phase(Frame& F, const att::Tens& T, int kvshift  , int kstride, int vstride, int vbase) {
    const int vcu = (F.G % 8 == 0) ? (blockIdx.x % 8) * (F.G / 8) + blockIdx.x / 8 : blockIdx.x;
    if constexpr (DK == 64) {
        for (int u = vcu; u < 2048 + 128; u += F.G) {
            if (u < 2048) { const int b = u >> 8, h = (u >> 4) & 15, qb = u & 15, kvh = h >> kvshift;
                att64::attn_unit<8>(T.Q, T.qpitch, NC + b * SEQ + qb * 256, h * 64, T.K, T.kpitch, kvh * kstride, T.V, T.vpitch, vbase + kvh * vstride, T.O, h * 64, b * LCTX, NC + b * SEQ, 68, (char*)F.lds, F.wave); }
            else { const int q = u - 2048, b = q >> 4, h = q & 15, kvh = h >> kvshift;
                att64::attn_unit<8>(T.Q, T.qpitch, b * LCTX, h * 64, T.K, T.kpitch, kvh * kstride, T.V, T.vpitch, vbase + kvh * vstride, T.O, h * 64, b * LCTX, 0, 4, (char*)F.lds, F.wave); }
        }
        __syncthreads();
    } else {
        for (int u = vcu; u < 2048 + 128; u += F.G) {
            if (u < 2048) { const int b = u >> 8, h = (u >> 4) & 15, qb = u & 15, kvh = h >> kvshift;
                att96::attn_unit<8>(T.Q, T.qpitch, NC + b * SEQ + qb * 256, h * 96, T.K, T.kpitch, kvh * kstride, T.V, T.vpitch, vbase + kvh * vstride, T.O, h * 64, b * LCTX, NC + b * SEQ, 68, (char*)F.lds, F.wave); }
            else { const int q = u - 2048, b = q >> 4, h = q & 15, kvh = h >> kvshift;
                att96::attn_unit<8>(T.Q, T.qpitch, b * LCTX, h * 96, T.K, T.kpitch, kvh * kstride, T.V, T.vpitch, vbase + kvh * vstride, T.O, h * 64, b * LCTX, 0, 4, (char*)F.lds, F.wave); }
        }
        __syncthreads();
    }
}

constexpr int PH_PER_LAYER = 9, PH_TOTAL = 2 + DEPTH * PH_PER_LAYER;
__global__ void __launch_bounds__(512, 2) mk_fwd(Args args) {
    extern __shared__ __attribute__((aligned(16))) unsigned char lds_raw[];
    Frame F;
    F.lds = (LAS unsigned char*)lds_raw; F.ws = args.ws; F.ctl = (gu32*)(args.ws + WS_CTL);
    F.wave = __builtin_amdgcn_readfirstlane(threadIdx.x >> 6); F.G = gridDim.x;
    F.gw = blockIdx.x * 8 + F.wave; F.NGW = F.G * 8;
    if (threadIdx.x < 4) ((LAS unsigned*)(F.lds + LDS_XB))[threadIdx.x] = 0u;
    __syncthreads();
    const int lo = args.ph_lo, hi = args.ph_hi;
    const bool multi = (hi - lo) > 1;
    XcdBarrier bar; bar.bar = (unsigned*)(F.ctl + CW_BAR); bar.x = 0; bar.st = nullptr; bar.wave = F.wave;
    if (multi) bar = xcd_barrier_post((unsigned*)(F.ctl + CW_BAR), (volatile LAS unsigned*)(F.lds + LDS_XB), F.wave);
#define IN(k) (lo <= (k) && (k) < hi)
#define SEAM(k) do { if (IN(k) && IN((k) + 1)) xcd_barrier(bar); } while (0)
    unsigned char* ws0 = args.ws;
#define PH_WS size_t zofs_ = 0; asm volatile("" : "+s"(zofs_)); unsigned char* ws = ws0 + zofs_; F.ws = ws; F.ctl = (gu32*)ws;
    const int G = F.G, cidx = (int)blockIdx.x;

    if (IN(0) && EN(0)) { PH_WS REP(0) { prologue(F, args); SEAM(0); } }
    if (IN(1) && EN(1)) { PH_WS rp_norm1_l0(F, args);
        quant_rows(F, (const bf16*)(ws + WS_WFIN), (unsigned char*)(ws + WS_W8), (float*)(ws + WS_SWP), 2 * 2048);
        quant_rows(F, (const bf16*)(ws + WS_WMIN), (unsigned char*)(ws + WS_W8) + 4 * MiB, (float*)(ws + WS_SWP) + 4096, MLA_IN_PAD);
        quant_rows(F, (const bf16*)(ws + WS_WGQKV), (unsigned char*)(ws + WS_W8) + 5 * MiB, (float*)(ws + WS_SWP) + 4864, GQA_QKV);
        quant_rows256(F, (const bf16*)(ws + WS_WMKVB), (unsigned char*)(ws + WS_WKVB8), (float*)(ws + WS_WKVB8 + MiB), 2048);
        quant_rows384(F, (const bf16*)(ws + WS_WMQB), (unsigned char*)(ws + WS_WQB8), (float*)(ws + WS_WQB8 + MiB), 1536);
        { const int t1 = lthread(F.wave);
          for (int i = cidx * 512 + t1; i < DEPTH * 9 * D; i += G * 512) { const int l = i / (9 * D), rem = i - l * (9 * D), mr = rem >> 10, col = rem & (D - 1), ob = (l % 3 == 0) ? l / 3 : (l % 3 == 1 ? 2 : 3);
              float* gp = (float*)(ws + WS_MOD) + ((size_t)l * 9 + mr) * (NMOD * D) + 2 * D + col; *gp = *gp * ((const float*)(ws + WS_SWO))[ob * D + col]; } }
        SEAM(1); }

    for (int l = 0; l < DEPTH; ++l) {
        const int kind = l % 3, j = l / 3, base = 2 + l * PH_PER_LAYER;
        const bool lastl = (l == DEPTH - 1);

        size_t outB = 0;
        if (kind == 0) {
            if (IN(base + 0) && EN(2)) { PH_WS REP(2) { PolFP p; p.A = (const char*)(ws + WS_W8) + (size_t)j * 2048 * D; p.B = (const char*)(ws + WS_H); p.nt = 8; p.sW = (const float*)(ws + WS_SWP) + j * 2048; p.sH = (const float*)(ws + WS_SH); p.nN = lastl ? 128 : 136; p.G = G; p.c = cidx;
                p.Z = (bf16*)(ws + WS_RA); p.Zc = (bf16*)(ws + WS_RH); pg8::gemm_phase(F.lds, p, F.wave); } }
            SEAM(base + 0);
            if (IN(base + 1) && EN(3)) { PH_WS REP(3) { PolFA p; p.A = (const char*)(ws + WS_MA); p.B = (const char*)(ws + WS_RA); p.nt = 2; p.G = G; p.c = cidx; p.Y = (unsigned char*)(ws + WS_RB); pg8::gemm_phase(F.lds, p, F.wave); } }
            SEAM(base + 1);
            if (IN(base + 2) && EN(4)) { PH_WS REP(4) {
                PolFCl p; p.A = (const char*)(ws + WS_DC); p.B = (const char*)(ws + WS_RB); p.nt = 4; p.G = G; p.c = cidx; p.nunits = lastl ? 512 : 544;
                p.offMC = (unsigned)(WS_MC - WS_DC); p.offZc = (unsigned)(WS_RH - WS_RB); p.F = (unsigned char*)(ws + WS_RC); pg8::gemm_phase(F.lds, p, F.wave); } }
            SEAM(base + 2);
            outB = j;
        } else if (kind == 1) {
            if (IN(base + 0) && EN(5)) { PH_WS REP(5) { PolDenseI8 p; p.A = (const char*)(ws + WS_H); p.B = (const char*)(ws + WS_W8) + 4 * MiB; p.nt = 8; p.nM = NT / 256; p.nN = 3; p.pm0 = 0; p.G = G; p.c = cidx; p.sA = (const float*)(ws + WS_SH); p.sB = (const float*)(ws + WS_SWP) + 4096;
                p.O = (bf16*)(ws + WS_RE); p.ldo = MLA_IN_PAD; pg8::gemm_phase(F.lds, p, F.wave); } }
            SEAM(base + 0);
            if (IN(base + 1) && EN(6)) { PH_WS REP(6) { rp_mla(F, args); } }
            SEAM(base + 1);
            if (IN(base + 2)) { PH_WS REP(7) {
                if (EN(7)) { PolMlaQ p; p.A = (const char*)(ws + WS_RF); p.B = (const char*)(ws + WS_WQB8); p.sA = (const float*)(ws + WS_SCKV + 262144); p.sB = (const float*)(ws + WS_WQB8 + MiB); p.nt = 4; p.nM = NT / 256; p.nN = 6; p.G = G; p.c = cidx; p.Q = (bf16*)(ws + WS_RA);
                  p.rope = (const float*)(ws + WS_ROPE); p.c2 = 0.10206207261596575f * LOG2E; pg8::gemm_phase(F.lds, p, F.wave); }
                if (EN(8)) { PolMlaKV p; p.A = (const char*)(ws + WS_RG); p.B = (const char*)(ws + WS_WKVB8); p.sA = (const float*)(ws + WS_SCKV); p.sB = (const float*)(ws + WS_WKVB8 + MiB); p.nt = 2; p.nM = NT / 256; p.nN = 8; p.G = G; p.c = cidx; p.Kb = (bf16*)(ws + WS_RB); p.Vb = (bf16*)(ws + WS_RD);
                  pg8::gemm_phase(F.lds, p, F.wave); }
            } }
            SEAM(base + 2);
            if (IN(base + 3) && EN(9)) { PH_WS REP(9) { att::Tens T{(const bf16*)(ws + WS_RA), 1536, (const bf16*)(ws + WS_RB), 1536, (const bf16*)(ws + WS_RD), 1024, (bf16*)(ws + WS_RC)}; attn_phase<96>(F, T, 0, 96, 64, 0); } }
            SEAM(base + 3);
            outB = 2;
        } else {
            if (IN(base + 0) && EN(10)) { PH_WS REP(10) { PolDenseI8 p; p.A = (const char*)(ws + WS_H); p.B = (const char*)(ws + WS_W8) + 5 * MiB; p.nt = 8; p.nM = NT / 256; p.nN = 6; p.pm0 = 0; p.G = G; p.c = cidx; p.sA = (const float*)(ws + WS_SH); p.sB = (const float*)(ws + WS_SWP) + 4864;
                p.O = (bf16*)(ws + WS_RA); p.ldo = GQA_QKV; pg8::gemm_phase(F.lds, p, F.wave); } }
            SEAM(base + 0);
            if (IN(base + 1) && EN(11)) { PH_WS REP(11) { rp_gqa(F, args); } }
            SEAM(base + 1);
            if (IN(base + 2) && EN(12)) { PH_WS REP(12) { att::Tens T{(const bf16*)(ws + WS_RB), 1024, (const bf16*)(ws + WS_RB) + (size_t)NT * 1024, 256, (const bf16*)(ws + WS_RA), 1536, (bf16*)(ws + WS_RC)}; attn_phase<64>(F, T, 2, 64, 64, 1280); } }
            SEAM(base + 2);
            outB = 3;
        }
        if (IN(base + 4) && EN(13)) { PH_WS PolOut p; p.A = (const char*)(ws + WS_RC); p.B = (const char*)(ws + WS_WO8) + (size_t)outB * D * D; p.nt = 8; p.nM = lastl ? NL / 256 : NT / 256; p.nN = 4; p.pm0 = lastl ? 8 : 0; p.G = G; p.c = cidx; p.X = (bf16*)(ws + WS_X); p.mod = (const float*)(ws + WS_MOD) + (size_t)l * 9 * (NMOD * D); p.chunk = 2;
            pg8::gemm_phase(F.lds, p, F.wave); }
        SEAM(base + 4);
        if (IN(base + 5) && EN(14)) { PH_WS rp_norm2_router(F, args, l, lastl ? NC : 0); }
        SEAM(base + 5);
        if (IN(base + 6) && EN(15)) { PH_WS REP(15) { moe_table(F, l);
            PolMoe1 p; p.A = (const char*)(ws + WS_H); p.B = (const char*)(ws + WS_WGU) + (size_t)l * NE * 2048 * D; p.nt = 8; p.G = G; p.c = cidx;
            p.swgu = (const float*)(ws + WS_SWGU) + (size_t)l * NE * 2048; p.ssc = (const float*)(ws + WS_SSC);
            p.T.TT = (const LAS int*)(F.lds + LDS_TT); p.T.CN = p.T.TT + 64; p.T.TE = (const LAS int*)(F.lds + LDS_TE); p.stok = (const int*)(ws + WS_STOK); p.bgu = (const float*)(ws + WS_BGU) + (size_t)l * NE * 2048; p.act = (unsigned char*)(ws + WS_ACT);
            pg8::gemm_phase(F.lds, p, F.wave); } }
        SEAM(base + 6);
        if (IN(base + 7) && EN(16)) { PH_WS REP(16) { if (!(IN(base + 6) && EN(15))) moe_table(F, l);
            PolMoe2 p; p.A = (const char*)(ws + WS_ACT); p.B = (const char*)(ws + WS_WDN) + (size_t)l * NE * D * DFF; p.nt = 8; p.G = G; p.c = cidx; p.swd = (const float*)(ws + WS_SWDN) + (size_t)l * NE * D;
            p.T.TT = (const LAS int*)(F.lds + LDS_TT); p.T.CN = p.T.TT + 64; p.T.TE = (const LAS int*)(F.lds + LDS_TE); p.sw = (const float*)(ws + WS_SW); p.bdn = args.in[26] + (size_t)l * NE * D; p.Y = (unsigned char*)(ws + WS_Y);
            pg8::gemm_phase(F.lds, p, F.wave); } }
        SEAM(base + 7);
        if (IN(base + 8) && EN(17)) { PH_WS if (!(IN(base + 6) && EN(15))) moe_table(F, l); rp_combine(F, args, l, lastl ? NC : 0); }
        SEAM(base + 8);
    }
#undef PH_WS
#undef IN
#undef SEAM
}

extern "C" void kernel_launch(void* const* d_in, const int* in_sizes, int n_in, void* d_out, int out_size, void* d_ws, size_t ws_size, hipStream_t stream) {
    static int grid = 0;
    if (grid == 0) {
        if (n_in != 27 || out_size != NL * D || ws_size < WS_END) { fprintf(stderr, "kernel_launch: unexpected problem (n_in %d, out %d, ws %zu < %zu)\n", n_in, out_size, ws_size, (size_t)WS_END); grid = -1; return; }
        int dev = 0, cus = 0, per_cu = 0;
        if (hipGetDevice(&dev) != hipSuccess || hipDeviceGetAttribute(&cus, hipDeviceAttributeMultiprocessorCount, dev) != hipSuccess) { grid = -1; return; }
        if (hipFuncSetAttribute((const void*)mk_fwd, hipFuncAttributeMaxDynamicSharedMemorySize, LDS_BYTES) != hipSuccess) { fprintf(stderr, "kernel_launch: hipFuncSetAttribute failed\n"); grid = -1; return; }
        if (hipOccupancyMaxActiveBlocksPerMultiprocessor(&per_cu, (const void*)mk_fwd, 512, LDS_BYTES) != hipSuccess || per_cu < 1) fprintf(stderr, "kernel_launch: occupancy query says %d\n", per_cu);
        (void)hipGetLastError();
        grid = cus;
    }
    if (grid < 0) return;
    (void)hipMemsetAsync((char*)d_ws + WS_CTL, 0, CTL_ZERO_BYTES, stream);
    Args a{};
    for (int i = 0; i < 27; ++i) a.in[i] = (const float*)d_in[i];
    a.out = (float*)d_out; a.ws = (unsigned char*)d_ws;
#if MK_PER_PHASE
    for (int ph = 0; ph < PH_TOTAL; ++ph) {
        const int l = (ph - 2) / PH_PER_LAYER, s = (ph - 2) % PH_PER_LAYER, kind = l % 3;
        if (ph >= 2) { if (s == 3 && kind != 1) continue; }
        a.ph_lo = ph; a.ph_hi = ph + 1;
        hipLaunchKernelGGL(mk_fwd, dim3(grid), dim3(512), LDS_BYTES, stream, a);
    }
#else
    a.ph_lo = 0; a.ph_hi = PH_TOTAL;
    hipLaunchKernelGGL(mk_fwd, dim3(grid), dim3(512), LDS_BYTES, stream, a);
#endif
}
```

```cpp
#include <hip/hip_runtime.h>
#include <cstdio>
#include <cstdint>

#ifndef MK_PER_PHASE
#define MK_PER_PHASE 0
#endif
#ifndef MK_N2V2
#define MK_N2V2 1
#endif
#ifndef MK_CBV2
#define MK_CBV2 1
#endif
#ifndef MK_N2AGG
#define MK_N2AGG 1
#endif
#ifndef MK_MASK
#define MK_MASK 0xFFFFFFFFu
#endif
#define EN(id) (((MK_MASK) >> (id)) & 1u)
#ifndef MK_REPMASK
#define MK_REPMASK 0u
#endif
#define REP(id) for (int rep_ = 0; rep_ < ((((MK_REPMASK) >> (id)) & 1u) ? 2 : 1); ++rep_)

constexpr int D = 1024, NB = 8, SEQ = 4096, LCTX = 256, DEPTH = 4;
constexpr int NC = NB * LCTX;
constexpr int NL = NB * SEQ;
constexpr int NT = NC + NL;
constexpr int NMOD = 6, NE = 32, TOPK = 4, DFF = 1024;
constexpr int MLA_QL = 384, MLA_KVL = 256, MLA_ROPE = 32, MLA_NOPE = 64, MLA_V = 64, MLA_IN = 672, MLA_IN_PAD = 768, MLA_QD = 96;
constexpr int GQA_NQ = 1024, GQA_NKV = 256, GQA_QKV = 1536;
constexpr int CAP = NT;
constexpr int MAXTILES = 576;
constexpr float EPS = 1e-6f;
constexpr float LOG2E = 1.4426950408889634f;

constexpr size_t MiB = 1u << 20;
constexpr size_t WS_CTL = 0, CTL_ZERO_BYTES = 96 * 1024;
constexpr size_t WS_MOD = 1 * MiB;
constexpr size_t WS_ROPE = 2 * MiB;
constexpr size_t WS_WRT = 2 * MiB + 65536;
constexpr size_t WS_BGU = 3 * MiB;
constexpr size_t WS_MA = 4 * MiB;
constexpr size_t WS_DC = 4 * MiB + 262144;
constexpr size_t WS_MC = 5 * MiB;
constexpr size_t WS_WFIN = 9 * MiB;
constexpr size_t WS_WFOUT = 17 * MiB;
constexpr size_t WS_WMIN = 21 * MiB;
constexpr size_t WS_WMQB = 23 * MiB;
constexpr size_t WS_WMKVB = 25 * MiB;
constexpr size_t WS_WMO = 26 * MiB;
constexpr size_t WS_WGQKV = 28 * MiB;
constexpr size_t WS_WGO = 31 * MiB;
constexpr size_t WS_TE = 34 * MiB;
constexpr size_t WS_TRANK = 35 * MiB;
constexpr size_t WS_STOK = 36 * MiB;
constexpr size_t WS_SW = 41 * MiB;
constexpr size_t WS_X = 64 * MiB;
constexpr size_t WS_H = 200 * MiB;
constexpr size_t WS_RA = 272 * MiB;
constexpr size_t WS_RB = 400 * MiB;
constexpr size_t WS_RC = 528 * MiB;
constexpr size_t WS_RD = 600 * MiB;
constexpr size_t WS_RE = 672 * MiB;
constexpr size_t WS_RF = 728 * MiB;
constexpr size_t WS_RG = 756 * MiB;
constexpr size_t WS_RH = 776 * MiB;
constexpr size_t WS_ACT = 784 * MiB;
constexpr size_t WS_Y = 1072 * MiB;
constexpr size_t WS_WGU = 1360 * MiB;
constexpr size_t WS_SWGU = 1360 * MiB + 256 * MiB;
constexpr size_t WS_SH = 1360 * MiB + 259 * MiB;
constexpr size_t WS_SWP = 1360 * MiB + 259 * MiB + 256 * 1024;
constexpr size_t WS_W8 = 1360 * MiB + 266 * MiB;
constexpr size_t WS_WO8 = 1360 * MiB + 274 * MiB;
constexpr size_t WS_SWO = 1360 * MiB + 278 * MiB;
constexpr size_t WS_WKVB8 = 1360 * MiB + 280 * MiB;
constexpr size_t WS_SCKV = 1360 * MiB + 282 * MiB;
constexpr size_t WS_WQB8 = 1360 * MiB + 283 * MiB;
constexpr size_t WS_SSC = 1360 * MiB + 260 * MiB;
constexpr size_t WS_WDN = 1872 * MiB;
constexpr size_t WS_SWDN = 1872 * MiB + 128 * MiB;
constexpr size_t WS_END = 2128 * MiB;
constexpr int CW_TMO = 0;
constexpr int CW_BAR = 4096;
constexpr int CW_CNT = 16384;

constexpr int RING_BYTES = 131072;
constexpr int LDS_MISC = 135168;
constexpr int LDS_TT = LDS_MISC;
constexpr int LDS_XB = LDS_MISC + 512;
constexpr int LDS_TE = LDS_MISC + 768;
constexpr int LDS_BYTES = 147456;

#define GAS __attribute__((address_space(1)))
#define LAS __attribute__((address_space(3)))
typedef unsigned short bf16;
typedef unsigned v4u __attribute__((ext_vector_type(4)));
typedef unsigned v2u __attribute__((ext_vector_type(2)));
typedef float f32x4 __attribute__((ext_vector_type(4)));
typedef float f32x2 __attribute__((ext_vector_type(2)));
typedef float f32x16 __attribute__((ext_vector_type(16)));
typedef short bf16x8 __attribute__((ext_vector_type(8)));
typedef short s16x4 __attribute__((ext_vector_type(4)));
typedef __bf16 bf16x2_t __attribute__((ext_vector_type(2)));
typedef GAS unsigned gu32;
#define RLX_AGENT __ATOMIC_RELAXED, __HIP_MEMORY_SCOPE_AGENT
#define LDS_WAIT() asm volatile("s_waitcnt lgkmcnt(0)" ::: "memory")
#define VM_WAIT() asm volatile("s_waitcnt vmcnt(0)" ::: "memory")
__device__ __forceinline__ unsigned pk2(float lo, float hi) { f32x2 v = {lo, hi}; bf16x2_t b = __builtin_convertvector(v, bf16x2_t); return __builtin_bit_cast(unsigned, b); }
__device__ __forceinline__ float bf_lo(unsigned u) { return __builtin_bit_cast(float, u << 16); }
__device__ __forceinline__ float bf_hi(unsigned u) { return __builtin_bit_cast(float, u & 0xffff0000u); }
__device__ __forceinline__ float shx(float v, int mask, int lane) { return __int_as_float(__builtin_amdgcn_ds_bpermute((lane ^ mask) << 2, __float_as_int(v))); }
__device__ __forceinline__ float wave_sum(float v, int lane) {
#pragma unroll
    for (int o = 1; o < 64; o <<= 1) v += shx(v, o, lane);
    return v;
}
__device__ __forceinline__ int lane_id_v() { int t; asm volatile("v_mbcnt_lo_u32_b32 %0, -1, 0\n\tv_mbcnt_hi_u32_b32 %0, -1, %0" : "=v"(t)); return t; }
__device__ __forceinline__ int launder_s(int x) { asm volatile("" : "+s"(x)); return x; }
__device__ __forceinline__ int lthread_w(int wave) { return wave * 64 + lane_id_v(); }
__device__ __forceinline__ int modrow_of(int row) { return row < NC ? NB : ((row - NC) >> 12); }

#define XB_TMO      128
#define XB_XCNT(j)  (256  + 64 * (j))
#define XB_XSUB(j)  (1280 + 64 * (j))
#define XB_XGEN(j)  (2304 + 64 * (j))
#define XB_TOP      3328
#define XB_TOPGEN   3392
#define XCD_BAR_WORDS 3456
#define XB_SPIN_CAP (1u << 18)
__device__ __forceinline__ unsigned xb_ld(unsigned* p)              { return __hip_atomic_load(p, __ATOMIC_RELAXED, __HIP_MEMORY_SCOPE_AGENT); }
__device__ __forceinline__ unsigned xb_add(unsigned* p, unsigned v) { return __hip_atomic_fetch_add(p, v, __ATOMIC_RELAXED, __HIP_MEMORY_SCOPE_AGENT); }
__device__ __forceinline__ unsigned xb_xcc_id() { return (unsigned)__builtin_amdgcn_s_getreg((3 << 11) | 20) & 0xFu; }
#define XB_SPIN(cond, bar) do { unsigned _sp = 0; while (cond) { __builtin_amdgcn_s_sleep(1); \
    if ((++_sp & 255u) == 0u) { if (xb_ld(&(bar)[XB_TMO])) break; if (_sp > XB_SPIN_CAP) { atomicAdd(&(bar)[XB_TMO], 1u); break; } } } } while (0)
struct XcdBarrier { unsigned* bar; unsigned x; volatile LAS unsigned* st; int wave; };
__device__ __forceinline__ bool xb_thread0(int wave) { return wave == 0 && lane_id_v() == 0; }
__device__ __forceinline__ XcdBarrier xcd_barrier_post(unsigned* bar, volatile LAS unsigned* st, int wave) {
    XcdBarrier b; b.bar = bar; b.x = xb_xcc_id(); b.st = st; b.wave = wave;
    if (xb_thread0(wave)) (void)xb_add(&bar[XB_XCNT(b.x)], 1u);
    return b;
}
__device__ __forceinline__ void xcd_barrier_complete(unsigned* bar, unsigned x, unsigned& nloc, unsigned& nx) {
    const unsigned G = gridDim.x * gridDim.y * gridDim.z;
    unsigned sum, cnt, mine, sp = 0u;
    for (;;) {
        sum = 0u; cnt = 0u; mine = 0u;
#pragma unroll
        for (unsigned j = 0; j < 16; ++j) { const unsigned c = xb_ld(&bar[XB_XCNT(j)]); sum += c; cnt += (c > 0u) ? 1u : 0u; mine = (j == x) ? c : mine; }
        if (sum == G) break;
        __builtin_amdgcn_s_sleep(1);
        if ((++sp & 255u) == 0u) { if (xb_ld(&bar[XB_TMO])) break; if (sp > XB_SPIN_CAP) { atomicAdd(&bar[XB_TMO], 1u); break; } }
    }
    nloc = mine > 0u ? mine : 1u; nx = cnt > 0u ? cnt : 1u;
}
__device__ __forceinline__ void xcd_barrier(const XcdBarrier& b) {
    asm volatile("s_waitcnt vmcnt(0)" ::: "memory");
    __syncthreads();
    if (xb_thread0(b.wave)) {
        unsigned* bar = b.bar;
        __builtin_amdgcn_s_waitcnt(0);
        unsigned nloc = b.st[0], nx = b.st[1];
        if (nloc == 0u) { xcd_barrier_complete(bar, b.x, nloc, nx); b.st[0] = nloc; b.st[1] = nx; }
        const unsigned old = xb_add(&bar[XB_XSUB(b.x)], 1u);
        const unsigned gen = old / nloc;
        if (old + 1u == (gen + 1u) * nloc) {
            __builtin_amdgcn_fence(__ATOMIC_RELEASE, "agent");
            asm volatile("s_waitcnt vmcnt(0)" ::: "memory");
            const unsigned og = xb_add(&bar[XB_TOP], 1u);
            const unsigned tg = og / nx;
            if (og + 1u == (tg + 1u) * nx) xb_add(&bar[XB_TOPGEN], 1u);
            else XB_SPIN(xb_ld(&bar[XB_TOPGEN]) == tg, bar);
            __builtin_amdgcn_fence(__ATOMIC_ACQUIRE, "agent");
            xb_add(&bar[XB_XGEN(b.x)], 1u);
            asm volatile("s_waitcnt vmcnt(0)" ::: "memory");
        } else {
            XB_SPIN(xb_ld(&bar[XB_XGEN(b.x)]) == gen, bar);
            __builtin_amdgcn_fence(__ATOMIC_ACQUIRE, "agent");
            asm volatile("s_waitcnt vmcnt(0)" ::: "memory");
        }
    }
    __syncthreads();
}

namespace pg8 {
#define PG8_LAS __attribute__((address_space(3)))
constexpr int BM = 256, BK = 64, HALF = 128, HTB = HALF * BK * 2, STAGE_BYTES = 8 * HTB, NXCD = 8, WGM = 8;
__device__ __forceinline__ int lds_byte(int r, int c) { const int st = (r >> 4) * 2 + (c >> 5), rr = r & 15, cc = c & 31, ob = rr * 64 + cc * 2; return st * 1024 + (ob ^ (((ob >> 9) & 1) << 5)); }
__device__ __forceinline__ void stage_rc(int b, int& R, int& C) { const int st = b / 1024, sb = b % 1024, swz = sb ^ (((sb >> 9) & 1) << 5); R = (st >> 1) * 16 + swz / 64; C = (st & 1) * 32 + (swz % 64) / 2; }
__device__ __forceinline__ int perm32(int rho) { const int n = rho >> 4, i = rho & 15; return 8 * (i >> 2) + 4 * n + (i & 3); }
struct Unit { int pm, pn, aux; };
typedef f32x4 Acc[2][2][4][2];
typedef int i32x4 __attribute__((ext_vector_type(4)));
typedef i32x4 AccI[2][2][4][2];
template <bool I8> struct AccSel { typedef f32x4 T; };
template <> struct AccSel<true> { typedef i32x4 T; };
__device__ __forceinline__ f32x4 mma1(bf16x8 b, bf16x8 a, f32x4 c) { return __builtin_amdgcn_mfma_f32_16x16x32_bf16(b, a, c, 0, 0, 0); }
typedef int i32x8 __attribute__((ext_vector_type(8)));
typedef short bf16x16 __attribute__((ext_vector_type(16)));
__device__ __forceinline__ f32x4 mma_f8(bf16x8 b0, bf16x8 b1, bf16x8 a0, bf16x8 a1, f32x4 c) {
    const i32x8 B = __builtin_bit_cast(i32x8, __builtin_shufflevector(b0, b1, 0, 1, 2, 3, 4, 5, 6, 7, 8, 9, 10, 11, 12, 13, 14, 15));
    const i32x8 A = __builtin_bit_cast(i32x8, __builtin_shufflevector(a0, a1, 0, 1, 2, 3, 4, 5, 6, 7, 8, 9, 10, 11, 12, 13, 14, 15));
    return __builtin_amdgcn_mfma_scale_f32_16x16x128_f8f6f4(B, A, c, 0, 0, 0, 0, 0, 0); }
__device__ __forceinline__ i32x4 mma1(bf16x8 b, bf16x8 a, i32x4 c) { return __builtin_amdgcn_mfma_i32_16x16x64_i8(__builtin_bit_cast(i32x4, b), __builtin_bit_cast(i32x4, a), c, 0, 0, 0); }

__device__ __forceinline__ bool static_next(int i, int G, int c, int nM, int nN, int& pm, int& pn) {
    const int nwg = nM * nN; const long L = (long)i * G + c; if (L >= nwg) return false;
    int wgid = (int)L; { const int q = nwg / NXCD, r = nwg % NXCD, xcd = wgid % NXCD, off = wgid / NXCD; wgid = (xcd < r ? xcd * (q + 1) : r * (q + 1) + (xcd - r) * q) + off; }
    const int nig = WGM * nN, gid = wgid / nig, fm = gid * WGM, gsz = (nM - fm) < WGM ? (nM - fm) : WGM;
    pm = fm + ((wgid % nig) % gsz); pn = (wgid % nig) / gsz; return true;
}

template <class P>
__device__ __forceinline__ void gemm_phase(PG8_LAS unsigned char* lds, const P& p, int wave_id) {
    wave_id = launder_s(wave_id); int tid_l = lthread_w(wave_id);
    const int tid = tid_l, wid = wave_id, lane = tid & 63, wr = wid >> 2, wc = wid & 3, fr = lane & 15, fq = lane >> 4;
    const int nt = launder_s(p.nt);
    const unsigned ldsw = (unsigned)wid * 1024u;
    const int aoff = lds_byte(wr * 64 + fr, fq * 8), boff = lds_byte(wc * 32 + fr, fq * 8);
    const char* const gA = p.A; const char* const gB = p.B;
#define PG8_SA(b, h) (((b) * 2 + (h)) * HTB)
#define PG8_SB(b, h) ((4 + (b) * 2 + (h)) * HTB)
#define PG8_STAGE(bufoff, gbase, off2, kofs) do { _Pragma("unroll") for (int _i = 0; _i < 2; ++_i) \
        __builtin_amdgcn_global_load_lds((const unsigned*)((gbase) + (size_t)(unsigned)((off2)[_i] + (unsigned)(kofs))), (PG8_LAS unsigned*)(lds + (bufoff) + ldsw + _i * 8192), 16, 0, 0); } while (0)
#define PG8_LDA(dst, b, h) do { _Pragma("unroll") for (int m = 0; m < 4; ++m) _Pragma("unroll") for (int k = 0; k < 2; ++k) dst[m][k] = *(const PG8_LAS bf16x8*)(lds + PG8_SA(b, h) + aoff + m * 2048 + k * 1024); } while (0)
#define PG8_LDB(dst, b, h) do { _Pragma("unroll") for (int n = 0; n < 2; ++n) _Pragma("unroll") for (int k = 0; k < 2; ++k) dst[n][k] = *(const PG8_LAS bf16x8*)(lds + PG8_SB(b, h) + boff + n * 2048 + k * 1024); } while (0)
#define PG8_MMA(ai, bj, At, Bt) do { __builtin_amdgcn_s_setprio(1); _Pragma("unroll") for (int m = 0; m < 4; ++m) _Pragma("unroll") for (int n = 0; n < 2; ++n) { \
        if constexpr (P::F8) acc[ai][bj][m][n] = mma_f8(Bt[n][0], Bt[n][1], At[m][0], At[m][1], acc[ai][bj][m][n]); \
        else { _Pragma("unroll") for (int k = 0; k < 2; ++k) acc[ai][bj][m][n] = mma1(Bt[n][k], At[m][k], acc[ai][bj][m][n]); } } __builtin_amdgcn_s_setprio(0); } while (0)
#define PG8_WAIT_V(n) asm volatile("s_waitcnt vmcnt(" #n ")" ::: "memory")
#define PG8_WAIT_L(n) asm volatile("s_waitcnt lgkmcnt(" #n ")" ::: "memory")
#define PG8_BAR __builtin_amdgcn_s_barrier()
#define PG8_SCHED __builtin_amdgcn_sched_barrier(0)
#define PG8_KEYS(u) do { if (P::KEYS && wid < 4) __builtin_amdgcn_global_load_lds((const unsigned*)p.key_ptr(u, wid * 64 + lane_id_v()), (PG8_LAS unsigned*)(keybuf + wid * 256), 4, 0, 0); } while (0)
#define PG8_OFFS(u, oA, oB) do { const int tid2_ = wid * 64 + lane_id_v();     \
    _Pragma("unroll") for (int _i = 0; _i < 2; ++_i) { int R_, C_; stage_rc(tid2_ * 16 + _i * 8192, R_, C_); const int Rb_ = P::PERM ? ((R_ & ~31) + perm32(R_ & 31)) : R_; \
      _Pragma("unroll") for (int _h = 0; _h < 2; ++_h) { \
        const int key_ = P::KEYS ? ((const PG8_LAS int*)keybuf)[_h * HALF + R_] : 0; \
        oA[_h][_i] = p.a_row(u, _h * HALF + R_, key_) + (unsigned)(C_ * 2); oB[_h][_i] = p.b_row(u, _h * HALF + Rb_) + (unsigned)(C_ * 2); } } } while (0)
    PG8_LAS unsigned char* const keybuf = lds + STAGE_BYTES;
    PG8_LAS unsigned char* const epibuf = lds + 138240; int eslot = 0;
#define PG8_EPRE(u, slot) do { if (P::EPRE && wid < 4) { const int i_ = wid * 64 + lane_id_v(); _Pragma("unroll") for (int j_ = 0; j_ < 3; ++j_) \
        __builtin_amdgcn_global_load_lds((const unsigned*)p.epre_src(u, j_, i_), (PG8_LAS unsigned*)(epibuf + (slot) * 3072 + j_ * 1024 + wid * 256), 4, 0, 0); } } while (0)
    PG8_LAS int* const utab = (PG8_LAS int*)(lds + 133120);
    __syncthreads();
    if (wid == 0) { const int li_ = lane_id_v(); if (li_ < 32) { Unit uu_; uu_.pm = 0; uu_.pn = 0; uu_.aux = 0; const bool ok_ = p.next(li_, uu_); PG8_LAS int* e_ = utab + li_ * 4; e_[0] = uu_.pm; e_[1] = uu_.pn; e_[2] = uu_.aux; e_[3] = ok_ ? 1 : 0; } }
    __syncthreads();
#define PG8_NEXT(i, u, ok) do { const int ii_ = (i); if (ii_ < 32) { const PG8_LAS int* e_ = utab + ii_ * 4; u.pm = __builtin_amdgcn_readfirstlane(e_[0]); u.pn = __builtin_amdgcn_readfirstlane(e_[1]); u.aux = __builtin_amdgcn_readfirstlane(e_[2]); ok = __builtin_amdgcn_readfirstlane(e_[3]) != 0; } else ok = p.next(ii_, u); } while (0)
    Unit cur, nxt; int ui = 0;
    { bool ok0_; PG8_NEXT(0, cur, ok0_); if (!ok0_) return; }
    typedef typename AccSel<P::I8>::T AccT;
    AccT acc[2][2][4][2];
#pragma unroll
    for (int a = 0; a < 2; ++a)
#pragma unroll
        for (int b = 0; b < 2; ++b)
#pragma unroll
            for (int m = 0; m < 4; ++m)
#pragma unroll
                for (int n = 0; n < 2; ++n) acc[a][b][m][n] = (AccT){0, 0, 0, 0};
    bf16x8 At[4][2], B0[2][2], B1[2][2];
    unsigned oAc[2][2], oBc[2][2];
    if (P::KEYS || P::EPRE) { PG8_KEYS(cur); PG8_EPRE(cur, 0); PG8_WAIT_V(0); PG8_BAR; }
    PG8_OFFS(cur, oAc, oBc);
    PG8_STAGE(PG8_SB(0, 0), gB, oBc[0], 0); PG8_STAGE(PG8_SB(0, 1), gB, oBc[1], 0); PG8_STAGE(PG8_SA(0, 0), gA, oAc[0], 0); PG8_STAGE(PG8_SA(0, 1), gA, oAc[1], 0);
    if (wr == 1) PG8_BAR;
    PG8_WAIT_V(2); PG8_BAR;
    PG8_STAGE(PG8_SB(1, 0), gB, oBc[0], 128); PG8_STAGE(PG8_SA(1, 0), gA, oAc[0], 128); PG8_STAGE(PG8_SB(1, 1), gB, oBc[1], 128);
    PG8_WAIT_V(6); PG8_BAR;
    bool has_next; PG8_NEXT(1, nxt, has_next);
    if (has_next) { PG8_KEYS(nxt); PG8_EPRE(nxt, 1); }
    for (;;) {
        for (int t = 0; t < nt; t += 2) {
            const bool last = (t == nt - 2);
            const unsigned k1 = (unsigned)(t + 1) * 128u;
            const unsigned k2 = last ? 0u : (unsigned)(t + 2) * 128u, k3 = k2 + 128u;
            PG8_LDB(B0, 0, 0); PG8_LDB(B1, 0, 1); PG8_SCHED; PG8_LDA(At, 0, 0); PG8_STAGE(PG8_SA(1, 1), gA, oAc[1], k1);
            if (last && has_next) { PG8_OFFS(nxt, oAc, oBc); }
            PG8_WAIT_V(8); PG8_WAIT_L(0); PG8_BAR; PG8_MMA(0, 0, At, B0); PG8_MMA(0, 1, At, B1); PG8_BAR; PG8_SCHED;
            PG8_LDA(At, 0, 1); PG8_STAGE(PG8_SB(0, 0), gB, oBc[0], k2); PG8_STAGE(PG8_SB(0, 1), gB, oBc[1], k2); PG8_STAGE(PG8_SA(0, 0), gA, oAc[0], k2);
            PG8_WAIT_V(8); PG8_WAIT_L(0); PG8_BAR; PG8_MMA(1, 0, At, B0); PG8_MMA(1, 1, At, B1); PG8_BAR; PG8_SCHED;
            PG8_LDB(B0, 1, 0); PG8_LDB(B1, 1, 1); PG8_SCHED; PG8_LDA(At, 1, 0); PG8_STAGE(PG8_SA(0, 1), gA, oAc[1], k2);
            PG8_WAIT_V(8); PG8_WAIT_L(0); PG8_BAR; PG8_MMA(0, 0, At, B0); PG8_MMA(0, 1, At, B1); PG8_BAR; PG8_SCHED;
            PG8_LDA(At, 1, 1); PG8_STAGE(PG8_SB(1, 0), gB, oBc[0], k3); PG8_STAGE(PG8_SB(1, 1), gB, oBc[1], k3); PG8_STAGE(PG8_SA(1, 0), gA, oAc[0], k3);
            PG8_WAIT_V(8); PG8_WAIT_L(0); PG8_BAR; PG8_MMA(1, 0, At, B0); PG8_MMA(1, 1, At, B1); PG8_BAR; PG8_SCHED;
        }
        if (wr == 0) PG8_BAR;
        { const int le_ = lane_id_v(); int fr_e = le_ & 15, fq_e = le_ >> 4;
          if constexpr (P::EPRE) p.epi(acc, cur, wr, wc, fr_e, fq_e, (const PG8_LAS float*)(epibuf + eslot * 3072)); else p.epi(acc, cur, wr, wc, fr_e, fq_e); }
        if (!has_next) break;
        cur = nxt; ++ui; eslot = (eslot == 2 ? 0 : eslot + 1);
        PG8_NEXT(ui + 1, nxt, has_next);
        if (has_next) { PG8_KEYS(nxt); PG8_EPRE(nxt, (eslot == 2 ? 0 : eslot + 1)); }
#pragma unroll
        for (int a = 0; a < 2; ++a)
#pragma unroll
            for (int b = 0; b < 2; ++b)
#pragma unroll
                for (int m = 0; m < 4; ++m)
#pragma unroll
                    for (int n = 0; n < 2; ++n) acc[a][b][m][n] = (AccT){0, 0, 0, 0};
        if (wr == 1) PG8_BAR;
    }
    PG8_WAIT_V(0);
    PG8_BAR;
#undef PG8_SA
#undef PG8_SB
#undef PG8_STAGE
#undef PG8_LDA
#undef PG8_LDB
#undef PG8_MMA
#undef PG8_WAIT_V
#undef PG8_WAIT_L
#undef PG8_BAR
#undef PG8_SCHED
#undef PG8_OFFS
#undef PG8_KEYS
#undef PG8_NEXT
#undef PG8_EPRE
}
}
using pg8::Unit;

#define TROW(ai, wr, m, fr) (128 * (ai) + 64 * (wr) + 16 * (m) + (fr))
#define TCOLP(bj, wc, fq) (128 * (bj) + 32 * (wc) + 8 * (fq))
#define TCOLN(bj, wc, n, fq) (128 * (bj) + 32 * (wc) + 16 * (n) + 4 * (fq))
__device__ __forceinline__ v4u pack8(const f32x4 a, const f32x4 b) { v4u w; w.x = pk2(a[0], a[1]); w.y = pk2(a[2], a[3]); w.z = pk2(b[0], b[1]); w.w = pk2(b[2], b[3]); return w; }

__device__ __forceinline__ unsigned q8x4(float a, float b, float c, float d, float s) {
    const unsigned ua = __float_as_uint(fmaf(a, s, 12582912.f)), ub = __float_as_uint(fmaf(b, s, 12582912.f)), uc = __float_as_uint(fmaf(c, s, 12582912.f)), ud = __float_as_uint(fmaf(d, s, 12582912.f));
    return __builtin_amdgcn_perm(ub, ua, 0x0c0c0400u) | __builtin_amdgcn_perm(ud, uc, 0x04000c0cu); }
__device__ __forceinline__ v2u pack8_fp8(f32x4 a, f32x4 b) {
#pragma unroll
    for (int q = 0; q < 4; ++q) { a[q] = __builtin_amdgcn_fmed3f(a[q], -448.f, 448.f); b[q] = __builtin_amdgcn_fmed3f(b[q], -448.f, 448.f); }
    int t0 = __builtin_amdgcn_cvt_pk_fp8_f32(a[0], a[1], 0, false); t0 = __builtin_amdgcn_cvt_pk_fp8_f32(a[2], a[3], t0, true);
    int t1 = __builtin_amdgcn_cvt_pk_fp8_f32(b[0], b[1], 0, false); t1 = __builtin_amdgcn_cvt_pk_fp8_f32(b[2], b[3], t1, true); v2u o; o.x = (unsigned)t0; o.y = (unsigned)t1; return o; }
template <class T> __device__ __forceinline__ const T* ub_at(const T* base, unsigned idx) { return (const T*)((const char*)base + (size_t)(unsigned)(idx * 4u)); }
struct PolDenseBf16 {
    static constexpr bool EPRE = false; __device__ __forceinline__ const float* epre_src(const Unit&, int, int) const { return nullptr; }
    static constexpr bool PERM = true;
    static constexpr bool KEYS = false;
    static constexpr bool I8 = false;
    static constexpr bool F8 = false;
    __device__ __forceinline__ const int* key_ptr(const Unit&, int) const { return nullptr; }
    const char* A; const char* B; int nt; int nM, nN, pm0, G, c; unsigned pitchA, pitchB; bf16* O; int ldo;
    __device__ __forceinline__ bool next(int i, Unit& u) const { int pm, pn; if (!pg8::static_next(i, G, c, nM, nN, pm, pn)) return false; u.pm = pm + pm0; u.pn = pn; u.aux = 0; return true; }
    __device__ __forceinline__ unsigned a_row(const Unit& u, int r, int) const { return (unsigned)(u.pm * 256 + r) * pitchA; }
    __device__ __forceinline__ unsigned b_row(const Unit& u, int r) const { return (unsigned)(u.pn * 256 + r) * pitchB; }
    __device__ __forceinline__ void epi(const pg8::Acc& acc, const Unit& u, int wr, int wc, int fr, int fq) const {
#pragma unroll
        for (int ai = 0; ai < 2; ++ai)
#pragma unroll
            for (int m = 0; m < 4; ++m) { const size_t row = (size_t)u.pm * 256 + TROW(ai, wr, m, fr);
#pragma unroll
                for (int bj = 0; bj < 2; ++bj) { const int col = u.pn * 256 + TCOLP(bj, wc, fq); *(v4u*)(O + row * ldo + col) = pack8(acc[ai][bj][m][0], acc[ai][bj][m][1]); } }
    }
};

struct PolDenseI8 {
    static constexpr bool EPRE = true;
    __device__ __forceinline__ const float* epre_src(const Unit& u, int j, int i) const { return j == 1 ? ub_at(sB + u.pn * 256, (unsigned)i) : ub_at(sA + (size_t)u.pm * 256, (unsigned)i); }
    static constexpr bool PERM = true;
    static constexpr bool KEYS = false;
    static constexpr bool I8 = true;
    static constexpr bool F8 = false;
    __device__ __forceinline__ const int* key_ptr(const Unit&, int) const { return nullptr; }
    const char* A; const char* B; int nt; int nM, nN, pm0, G, c; const float* sA; const float* sB; bf16* O; int ldo;
    __device__ __forceinline__ bool next(int i, Unit& u) const { int pm, pn; if (!pg8::static_next(i, G, c, nM, nN, pm, pn)) return false; u.pm = pm + pm0; u.pn = pn; u.aux = 0; return true; }
    __device__ __forceinline__ unsigned a_row(const Unit& u, int r, int) const { return (unsigned)(u.pm * 256 + r) * 1024u; }
    __device__ __forceinline__ unsigned b_row(const Unit& u, int r) const { return (unsigned)(u.pn * 256 + r) * 1024u; }
    __device__ __forceinline__ void epi(const pg8::AccI& acc, const Unit& u, int wr, int wc, int fr, int fq, const LAS float* eb) const {
#pragma unroll
        for (int bj = 0; bj < 2; ++bj) { const int cl = TCOLP(bj, wc, fq), col = u.pn * 256 + cl; const f32x4 s0 = *(const LAS f32x4*)(eb + 256 + cl), s1 = *(const LAS f32x4*)(eb + 256 + cl + 4);
#pragma unroll
            for (int ai = 0; ai < 2; ++ai)
#pragma unroll
                for (int m = 0; m < 4; ++m) { const int rr = TROW(ai, wr, m, fr); const size_t row = (size_t)u.pm * 256 + rr; const float sa = eb[rr]; f32x4 v0, v1;
#pragma unroll
                    for (int q = 0; q < 4; ++q) { v0[q] = (float)acc[ai][bj][m][0][q] * (sa * s0[q]); v1[q] = (float)acc[ai][bj][m][1][q] * (sa * s1[q]); }
                    *(v4u*)(O + row * ldo + col) = pack8(v0, v1); } }
    }
};

struct PolOut {
    static constexpr bool EPRE = false; __device__ __forceinline__ const float* epre_src(const Unit&, int, int) const { return nullptr; }
    static constexpr bool PERM = true;
    static constexpr bool KEYS = false;
    static constexpr bool I8 = false;
    static constexpr bool F8 = true;
    __device__ __forceinline__ const int* key_ptr(const Unit&, int) const { return nullptr; }
    const char* A; const char* B; int nt; int nM, nN, pm0, G, c; bf16* X; const float* mod;
    int chunk;
    __device__ __forceinline__ bool next(int i, Unit& u) const { int pm, pn; if (!pg8::static_next(i, G, c, nM, nN, pm, pn)) return false; u.pm = pm + pm0; u.pn = pn; u.aux = 0; return true; }
    __device__ __forceinline__ unsigned a_row(const Unit& u, int r, int) const { return (unsigned)(u.pm * 256 + r) * 1024u; }
    __device__ __forceinline__ unsigned b_row(const Unit& u, int r) const { return (unsigned)(u.pn * 256 + r) * 1024u; }
    __device__ __forceinline__ void epi(const pg8::Acc& acc, const Unit& u, int wr, int wc, int fr, int fq) const {
        const int mr = modrow_of(u.pm * 256);
        const float* g = mod + (size_t)mr * (NMOD * D) + chunk * D;
#pragma unroll
        for (int bj = 0; bj < 2; ++bj) { const int col = u.pn * 256 + TCOLP(bj, wc, fq); const f32x4 g0 = *(const f32x4*)(g + col), g1 = *(const f32x4*)(g + col + 4);
#pragma unroll
            for (int ai = 0; ai < 2; ++ai)
#pragma unroll
                for (int m = 0; m < 4; ++m) { const size_t off = ((size_t)u.pm * 256 + TROW(ai, wr, m, fr)) * D + col; f32x4 x0, x1;
                    { const v4u w = *(const v4u*)(X + off); x0 = (f32x4){bf_lo(w.x), bf_hi(w.x), bf_lo(w.y), bf_hi(w.y)}; x1 = (f32x4){bf_lo(w.z), bf_hi(w.z), bf_lo(w[3]), bf_hi(w[3])}; }
                    *(v4u*)(X + off) = pack8(x0 + g0 * acc[ai][bj][m][0], x1 + g1 * acc[ai][bj][m][1]); } }
    }
};

struct PolFP {
    static constexpr bool EPRE = true;
    __device__ __forceinline__ const float* epre_src(const Unit& u, int j, int i) const { return j == 1 ? ub_at(sH, (unsigned)tok_row(u.pn, u.pn * 256 + i)) : ub_at(sW + u.pm * 256, (unsigned)i); }
    static constexpr bool PERM = true;
    static constexpr bool KEYS = false;
    static constexpr bool I8 = true;
    static constexpr bool F8 = false;
    __device__ __forceinline__ const int* key_ptr(const Unit&, int) const { return nullptr; }
    const char* A; const char* B; int nt; int nN, G, c; const float* sW; const float* sH; bf16* Z; bf16* Zc;
    __device__ __forceinline__ bool next(int i, Unit& u) const { int pm, pn; if (!pg8::static_next(i, G, c, 8, nN, pm, pn)) return false; u.pm = pm; u.pn = pn; u.aux = 0; return true; }
    __device__ __forceinline__ unsigned a_row(const Unit& u, int r, int) const { return (unsigned)(u.pm * 256 + r) * 1024u; }
    __device__ __forceinline__ int tok_row(int pn, int n) const { if (pn < 128) { const int b = n >> 12, l2 = (n >> 6) & 63, l1 = n & 63; return NC + b * SEQ + 64 * l1 + l2; } return n - 32768; }
    __device__ __forceinline__ unsigned b_row(const Unit& u, int r) const { return (unsigned)tok_row(u.pn, u.pn * 256 + r) * 1024u; }
    __device__ __forceinline__ void epi(const pg8::AccI& acc, const Unit& u, int wr, int wc, int fr, int fq, const LAS float* eb) const {
#pragma unroll
        for (int bj = 0; bj < 2; ++bj) { const int cl = TCOLP(bj, wc, fq), n0 = u.pn * 256 + cl;
            const f32x4 h0 = *(const LAS f32x4*)(eb + 256 + cl), h1 = *(const LAS f32x4*)(eb + 256 + cl + 4);
#pragma unroll
            for (int ai = 0; ai < 2; ++ai)
#pragma unroll
                for (int m = 0; m < 4; ++m) { const int rr = TROW(ai, wr, m, fr), cp = u.pm * 256 + rr; const float sw = eb[rr]; f32x4 v0, v1;
#pragma unroll
                    for (int q = 0; q < 4; ++q) { v0[q] = (float)acc[ai][bj][m][0][q] * (sw * h0[q]); v1[q] = (float)acc[ai][bj][m][1][q] * (sw * h1[q]); }
                    if (u.pn < 128) *(v2u*)((unsigned char*)Z + ((size_t)(n0 >> 6) * 2048 + cp) * 64 + (n0 & 63)) = pack8_fp8(v0, v1);
                    else { const int b = u.pn - 128, l = n0 - 32768 - b * 256; *(v2u*)((unsigned char*)Zc + ((size_t)b * 2048 + cp) * 256 + l) = pack8_fp8(v0, v1); } } }
    }
};

struct PolFA {
    static constexpr bool EPRE = false; __device__ __forceinline__ const float* epre_src(const Unit&, int, int) const { return nullptr; }
    static constexpr bool PERM = true;
    static constexpr bool KEYS = false;
    static constexpr bool I8 = false;
    static constexpr bool F8 = true;
    __device__ __forceinline__ const int* key_ptr(const Unit&, int) const { return nullptr; }
    const char* A; const char* B; int nt; int G, c; unsigned char* Y;
    __device__ __forceinline__ bool next(int i, Unit& u) const { const int L = i * G + c; if (L >= 1024) return false; u.pm = 0; u.pn = L & 127; u.aux = L >> 7; return true; }
    __device__ __forceinline__ unsigned a_row(const Unit&, int r, int) const { return (unsigned)r * 256u; }
    __device__ __forceinline__ unsigned b_row(const Unit& u, int r) const { const int l2 = r & 63, cp = u.pn * 4 + (r >> 6); return (unsigned)((u.aux * 64 + l2) * 512 + cp) * 256u; }
    __device__ __forceinline__ void epi(const pg8::Acc& acc, const Unit& u, int wr, int wc, int fr, int fq) const {
        const int b = u.aux;
#pragma unroll
        for (int ai = 0; ai < 2; ++ai)
#pragma unroll
            for (int m = 0; m < 4; ++m) { const int rr = TROW(ai, wr, m, fr), jp = rr >> 7, pp = (rr >> 6) & 1, k1 = rr & 63;
#pragma unroll
                for (int bj = 0; bj < 2; ++bj) { const int n0 = u.pn * 256 + TCOLP(bj, wc, fq), cp = n0 >> 6, l2 = n0 & 63, cc = 2 * cp + jp;
                    const unsigned idx = (unsigned)(((((b * 16 + (k1 >> 2)) * 1024 + cc) * 4 + (k1 & 3)) * 2 + pp) * 64 + l2);
                    *(v2u*)(Y + idx) = pack8_fp8(acc[ai][bj][m][0] * 0.03125f, acc[ai][bj][m][1] * 0.03125f); } }
    }
};

struct PolFC {
    static constexpr bool EPRE = false; __device__ __forceinline__ const float* epre_src(const Unit&, int, int) const { return nullptr; }
    static constexpr bool PERM = true;
    static constexpr bool KEYS = false;
    static constexpr bool I8 = false;
    static constexpr bool F8 = false;
    __device__ __forceinline__ const int* key_ptr(const Unit&, int) const { return nullptr; }
    const char* A; const char* B; int nt; int G, c; int nunits, l0; unsigned offMC, offZc; unsigned char* F;
    __device__ __forceinline__ bool next(int i, Unit& u) const { const int L = i * G + c + l0; if (L >= nunits) return false;
        if (L < 512) { u.pm = 0; u.pn = L & 3; u.aux = L >> 2; } else { const int q = L - 512; u.pm = 0; u.pn = q & 3; u.aux = 256 + (q >> 2); } return true; }
    __device__ __forceinline__ unsigned a_row(const Unit& u, int r, int) const {
        if (u.aux < 256) return offMC + (unsigned)((u.aux & 15) * 256 + r) * 1024u;
        return (unsigned)r * 1024u; }
    __device__ __forceinline__ unsigned b_row(const Unit& u, int r) const {
        if (u.aux < 256) return (unsigned)(u.aux * 1024 + u.pn * 256 + r) * 1024u;
        return offZc + (unsigned)((u.aux - 256) * 1024 + u.pn * 256 + r) * 1024u; }
    __device__ __forceinline__ void epi(const pg8::Acc& acc, const Unit& u, int wr, int wc, int fr, int fq) const {
#pragma unroll
        for (int ai = 0; ai < 2; ++ai)
#pragma unroll
            for (int m = 0; m < 4; ++m) { const int rr = TROW(ai, wr, m, fr); size_t frow;
                if (u.aux < 256) { const int b = u.aux >> 4, kq = u.aux & 15, k = 4 * kq + (rr >> 6) + 64 * (rr & 63); frow = (size_t)NC + b * SEQ + k; }
                else frow = (size_t)(u.aux - 256) * LCTX + rr;
#pragma unroll
                for (int bj = 0; bj < 2; ++bj) { const int col = u.pn * 256 + TCOLP(bj, wc, fq); *(v2u*)(F + frow * D + col) = pack8_fp8(acc[ai][bj][m][0], acc[ai][bj][m][1]); } }
    }
};

struct PolFCl {
    static constexpr bool EPRE = false; __device__ __forceinline__ const float* epre_src(const Unit&, int, int) const { return nullptr; }
    static constexpr bool PERM = true;
    static constexpr bool KEYS = false;
    static constexpr bool I8 = false;
    static constexpr bool F8 = true;
    __device__ __forceinline__ const int* key_ptr(const Unit&, int) const { return nullptr; }
    const char* A; const char* B; int nt; int G, c; int nunits; unsigned offMC, offZc; unsigned char* F;
    __device__ __forceinline__ bool next(int i, Unit& u) const { const int L = i * G + c; if (L >= nunits) return false;
        if (L < 512) { u.pm = 0; u.pn = L & 3; u.aux = L >> 2; } else { const int q = L - 512; u.pm = 0; u.pn = q & 3; u.aux = 256 + (q >> 2); } return true; }
    __device__ __forceinline__ unsigned a_row(const Unit& u, int r, int) const { return u.aux < 256 ? offMC + (unsigned)((u.aux & 15) * 256 + r) * 512u : (unsigned)r * 512u; }
    __device__ __forceinline__ unsigned b_row(const Unit& u, int r) const { return u.aux < 256 ? (unsigned)(u.aux * 1024 + u.pn * 256 + r) * 512u : offZc + (unsigned)((u.aux - 256) * 1024 + u.pn * 256 + r) * 512u; }
    __device__ __forceinline__ void epi(const pg8::Acc& acc, const Unit& u, int wr, int wc, int fr, int fq) const {
        const bool lat = u.aux < 256; const float sc = lat ? 0.125f : 0.015625f;
#pragma unroll
        for (int ai = 0; ai < 2; ++ai)
#pragma unroll
            for (int m = 0; m < 4; ++m) { const int rr = TROW(ai, wr, m, fr); size_t frow;
                if (lat) { const int b = u.aux >> 4, kq = u.aux & 15, k = 4 * kq + (rr >> 6) + 64 * (rr & 63); frow = (size_t)NC + b * SEQ + k; }
                else frow = (size_t)(u.aux - 256) * LCTX + rr;
#pragma unroll
                for (int bj = 0; bj < 2; ++bj) { const int col = u.pn * 256 + TCOLP(bj, wc, fq); *(v2u*)(F + frow * D + col) = pack8_fp8(acc[ai][bj][m][0] * sc, acc[ai][bj][m][1] * sc); } }
    }
};

struct PolMlaQ {
    static constexpr bool EPRE = true;
    __device__ __forceinline__ const float* epre_src(const Unit& u, int j, int i) const { return j == 1 ? ub_at(sB + u.pn * 256, (unsigned)i) : ub_at(sA + (size_t)u.pm * 256, (unsigned)i); }
    static constexpr bool PERM = true;
    static constexpr bool KEYS = false;
    static constexpr bool I8 = true;
    static constexpr bool F8 = false;
    __device__ __forceinline__ const int* key_ptr(const Unit&, int) const { return nullptr; }
    const char* A; const char* B; int nt; int nM, nN, G, c; bf16* Q; const float* rope; float c2; const float* sA; const float* sB;
    __device__ __forceinline__ bool next(int i, Unit& u) const { int pm, pn; if (!pg8::static_next(i, G, c, nM, nN, pm, pn)) return false; u.pm = pm; u.pn = pn; u.aux = 0; return true; }
    __device__ __forceinline__ unsigned a_row(const Unit& u, int r, int) const { return (unsigned)(u.pm * 256 + r) * 512u; }
    __device__ __forceinline__ unsigned b_row(const Unit& u, int r) const { return (unsigned)(u.pn * 256 + r) * 512u; }
    __device__ __forceinline__ void epi(const pg8::AccI& acc, const Unit& u, int wr, int wc, int fr, int fq, const LAS float* eb) const {
        const bool lat = u.pm >= 8;
#pragma unroll
        for (int bj = 0; bj < 2; ++bj) { const int cl = TCOLP(bj, wc, fq), col = u.pn * 256 + cl; const f32x4 s0 = *(const LAS f32x4*)(eb + 256 + cl), s1 = *(const LAS f32x4*)(eb + 256 + cl + 4); const bool isrope = lat && (((col >> 5) % 3) == 2);
#pragma unroll
            for (int ai = 0; ai < 2; ++ai)
#pragma unroll
                for (int m = 0; m < 4; ++m) { const int rr = TROW(ai, wr, m, fr), row = u.pm * 256 + rr; const float sa = eb[rr]; f32x4 v0, v1;
#pragma unroll
                    for (int e = 0; e < 4; ++e) { v0[e] = (float)acc[ai][bj][m][0][e] * (sa * s0[e]); v1[e] = (float)acc[ai][bj][m][1][e] * (sa * s1[e]); }
                    if (isrope) { const int t = (row - NC) & 4095, pos = (fq & 2) ? (t & 63) : (t >> 6);
                        const f32x4* rp = (const f32x4*)(rope + (size_t)pos * 16);
                        const f32x4 r0 = rp[0], r1 = rp[1], r2 = rp[2], r3 = rp[3];
                        f32x4 p0, p1;
#pragma unroll
                        for (int e = 0; e < 4; ++e) { p0[e] = shx(v0[e], 16, fq * 16 + fr); p1[e] = shx(v1[e], 16, fq * 16 + fr); }
                        const float sg = (fq & 1) ? 1.f : -1.f;
                        v0[0] = v0[0] * r0[0] + sg * p0[0] * r0[1]; v0[1] = v0[1] * r0[2] + sg * p0[1] * r0[3];
                        v0[2] = v0[2] * r1[0] + sg * p0[2] * r1[1]; v0[3] = v0[3] * r1[2] + sg * p0[3] * r1[3];
                        v1[0] = v1[0] * r2[0] + sg * p1[0] * r2[1]; v1[1] = v1[1] * r2[2] + sg * p1[1] * r2[3];
                        v1[2] = v1[2] * r3[0] + sg * p1[2] * r3[1]; v1[3] = v1[3] * r3[2] + sg * p1[3] * r3[3]; }
                    *(v4u*)(Q + (size_t)row * 1536 + col) = pack8(v0 * c2, v1 * c2); } }
    }
};

struct PolMlaKV {
    static constexpr bool EPRE = true;
    __device__ __forceinline__ const float* epre_src(const Unit& u, int j, int i) const { return j == 1 ? ub_at(sB + u.pn * 256, (unsigned)i) : ub_at(sA + (size_t)u.pm * 256, (unsigned)i); }
    static constexpr bool PERM = true;
    static constexpr bool KEYS = false;
    static constexpr bool I8 = true;
    static constexpr bool F8 = false;
    __device__ __forceinline__ const int* key_ptr(const Unit&, int) const { return nullptr; }
    const char* A; const char* B; int nt; int nM, nN, G, c; bf16* Kb; bf16* Vb; const float* sA; const float* sB;
    __device__ __forceinline__ bool next(int i, Unit& u) const { int pm, pn; if (!pg8::static_next(i, G, c, nM, nN, pm, pn)) return false; u.pm = pm; u.pn = pn; u.aux = 0; return true; }
    __device__ __forceinline__ unsigned a_row(const Unit& u, int r, int) const { return (unsigned)(u.pm * 256 + r) * 256u; }
    __device__ __forceinline__ unsigned b_row(const Unit& u, int r) const { return (unsigned)(u.pn * 256 + r) * 256u; }
    __device__ __forceinline__ void epi(const pg8::AccI& acc, const Unit& u, int wr, int wc, int fr, int fq, const LAS float* eb) const {
#pragma unroll
        for (int bj = 0; bj < 2; ++bj) { const int cl = TCOLP(bj, wc, fq), col = u.pn * 256 + cl, h = col >> 7, j = col & 127; const f32x4 s0 = *(const LAS f32x4*)(eb + 256 + cl), s1 = *(const LAS f32x4*)(eb + 256 + cl + 4);
#pragma unroll
            for (int ai = 0; ai < 2; ++ai)
#pragma unroll
                for (int m = 0; m < 4; ++m) { const int rr = TROW(ai, wr, m, fr); const size_t row = (size_t)u.pm * 256 + rr; const float sa = eb[rr]; f32x4 v0, v1;
#pragma unroll
                    for (int q = 0; q < 4; ++q) { v0[q] = (float)acc[ai][bj][m][0][q] * (sa * s0[q]); v1[q] = (float)acc[ai][bj][m][1][q] * (sa * s1[q]); }
                    const v4u w = pack8(v0, v1);
                    if (j < 64) *(v4u*)(Kb + row * 1536 + 96 * h + j) = w; else *(v4u*)(Vb + row * 1024 + 64 * h + (j - 64)) = w; } }
    }
};

struct MoeTab { const LAS int* TT; const LAS int* CN; const LAS int* TE; };
__device__ __forceinline__ bool moe_next(int i, int G, int c, int NP, const MoeTab& T, Unit& u) {
    const int ttot = T.TT[32];
    int lo, hi, j;
    if ((G & 7) == 0) { const int x = c & 7, q = c >> 3, g8 = G >> 3; lo = (x * ttot) >> 3; hi = ((x + 1) * ttot) >> 3; j = i * g8 + q; }
    else { lo = 0; hi = ttot; j = i * G + c; }
    if (j >= (hi - lo) * NP) return false;
    const int tile = lo + j / NP; u.pn = j % NP; u.pm = tile;
    const int e = T.TE[tile];
    u.aux = e | ((tile - T.TT[e]) << 8);
    return true;
}
struct PolMoe1 {
    static constexpr bool EPRE = true;
    __device__ __forceinline__ const float* epre_src(const Unit& u, int j, int i) const { const int e = u.aux & 255; const size_t fo = (size_t)e * 2048 + u.pn * 256;
        if (j == 0) return ub_at(bgu + fo, (unsigned)i); if (j == 1) return ub_at(swgu + fo, (unsigned)i); const unsigned idx = (unsigned)((u.aux >> 8) * 256 + i); return ub_at(ssc + (size_t)e * CAP, idx < (unsigned)T.CN[e] ? idx : 0u); }
    static constexpr bool PERM = true;
    static constexpr bool I8 = true;
    static constexpr bool F8 = false;
    const char* A; const char* B; int nt; int G, c; MoeTab T; const int* stok; const float* bgu; const float* swgu; const float* ssc; unsigned char* act;
    __device__ __forceinline__ bool next(int i, Unit& u) const { return moe_next(i, G, c, 8, T, u); }
    static constexpr bool KEYS = true;
    __device__ __forceinline__ const int* key_ptr(const Unit& u, int r) const { const int e = u.aux & 255; const unsigned idx = (unsigned)((u.aux >> 8) * 256 + r); return ub_at(stok + (size_t)e * CAP, idx < (unsigned)T.CN[e] ? idx : 0u); }
    __device__ __forceinline__ unsigned a_row(const Unit&, int, int key) const { return (unsigned)key * 1024u; }
    __device__ __forceinline__ unsigned b_row(const Unit& u, int r) const { return (unsigned)((u.aux & 255) * 2048 + u.pn * 256 + r) * 1024u; }
    __device__ __forceinline__ void epi(const pg8::AccI& acc, const Unit& u, int wr, int wc, int fr, int fq, const LAS float* eb) const {
        const int jl = 32 * wc + 8 * fq;
        const LAS float* bg = eb + jl; const LAS float* sg = eb + 256 + jl;
        const f32x4 bg0 = *(const LAS f32x4*)(bg), bg1 = *(const LAS f32x4*)(bg + 4), bu0 = *(const LAS f32x4*)(bg + 128) + 1.f, bu1 = *(const LAS f32x4*)(bg + 132) + 1.f;
        const f32x4 sg0 = *(const LAS f32x4*)(sg), sg1 = *(const LAS f32x4*)(sg + 4), su0 = *(const LAS f32x4*)(sg + 128), su1 = *(const LAS f32x4*)(sg + 132);
#pragma unroll
        for (int ai = 0; ai < 2; ++ai)
#pragma unroll
            for (int m = 0; m < 4; ++m) { const int rr = TROW(ai, wr, m, fr); const size_t slot = (size_t)u.pm * 256 + rr;
                const float sa = eb[512 + rr];
                f32x4 o0, o1;
#define MOE1_ACT(OUT, N, SG, BG, SU, BU) do { _Pragma("unroll") for (int hq = 0; hq < 2; ++hq) { \
                    const f32x2 ag = {(float)acc[ai][0][m][N][2 * hq], (float)acc[ai][0][m][N][2 * hq + 1]}, au = {(float)acc[ai][1][m][N][2 * hq], (float)acc[ai][1][m][N][2 * hq + 1]}; \
                    const f32x2 sgp = {SG[2 * hq], SG[2 * hq + 1]}, bgp = {BG[2 * hq], BG[2 * hq + 1]}, sup = {SU[2 * hq], SU[2 * hq + 1]}, bup = {BU[2 * hq], BU[2 * hq + 1]}; \
                    f32x2 g = __builtin_elementwise_fma(ag, sgp * sa, bgp), u = __builtin_elementwise_fma(au, sup * sa, bup); \
                    g[0] = fminf(g[0], 7.f); g[1] = fminf(g[1], 7.f); u[0] = __builtin_amdgcn_fmed3f(u[0], -6.f, 8.f); u[1] = __builtin_amdgcn_fmed3f(u[1], -6.f, 8.f); \
                    const f32x2 z = g * (-1.702f * LOG2E); f32x2 e; e[0] = __builtin_amdgcn_exp2f(z[0]); e[1] = __builtin_amdgcn_exp2f(z[1]); \
                    const f32x2 dd = e + 1.f; f32x2 r; r[0] = __builtin_amdgcn_rcpf(dd[0]); r[1] = __builtin_amdgcn_rcpf(dd[1]); \
                    const f32x2 o = (u * g) * r; OUT[2 * hq] = o[0]; OUT[2 * hq + 1] = o[1]; } } while (0)
                MOE1_ACT(o0, 0, sg0, bg0, su0, bu0); MOE1_ACT(o1, 1, sg1, bg1, su1, bu1);
#undef MOE1_ACT
                v2u w8; { int t0 = __builtin_amdgcn_cvt_pk_fp8_f32(o0[0], o0[1], 0, false); t0 = __builtin_amdgcn_cvt_pk_fp8_f32(o0[2], o0[3], t0, true);
                          int t1 = __builtin_amdgcn_cvt_pk_fp8_f32(o1[0], o1[1], 0, false); t1 = __builtin_amdgcn_cvt_pk_fp8_f32(o1[2], o1[3], t1, true); w8.x = (unsigned)t0; w8.y = (unsigned)t1; }
                *(v2u*)((unsigned char*)(act + (size_t)u.pm * 262144 + u.pn * 128) + (size_t)(unsigned)(rr * 1024 + jl)) = w8; }
    }
};
struct PolMoe2 {
    static constexpr bool EPRE = true;
    __device__ __forceinline__ const float* epre_src(const Unit& u, int j, int i) const { const int e = u.aux & 255; const size_t co = (size_t)e * 1024 + u.pn * 256;
        if (j == 0) return ub_at(bdn + co, (unsigned)i); if (j == 1) return ub_at(swd + co, (unsigned)i); const unsigned idx = (unsigned)((u.aux >> 8) * 256 + i); return ub_at(sw + (size_t)e * CAP, idx < (unsigned)T.CN[e] ? idx : 0u); }
    static constexpr bool PERM = true;
    static constexpr bool KEYS = false;
    static constexpr bool I8 = false;
    static constexpr bool F8 = true;
    __device__ __forceinline__ const int* key_ptr(const Unit&, int) const { return nullptr; }
    const char* A; const char* B; int nt; int G, c; MoeTab T; const float* sw; const float* bdn; const float* swd; unsigned char* Y;
    __device__ __forceinline__ bool next(int i, Unit& u) const { return moe_next(i, G, c, 4, T, u); }
    __device__ __forceinline__ unsigned a_row(const Unit& u, int r, int) const { return (unsigned)(u.pm * 256 + r) * 1024u; }
    __device__ __forceinline__ unsigned b_row(const Unit& u, int r) const { return (unsigned)((u.aux & 255) * 1024 + u.pn * 256 + r) * 1024u; }
    __device__ __forceinline__ void epi(const pg8::Acc& acc, const Unit& u, int wr, int wc, int fr, int fq, const LAS float* eb) const {
#pragma unroll
        for (int bj = 0; bj < 2; ++bj) { const int cl = TCOLP(bj, wc, fq), col = u.pn * 256 + cl;
            const f32x4 b0 = *(const LAS f32x4*)(eb + cl), b1 = *(const LAS f32x4*)(eb + cl + 4), s0 = *(const LAS f32x4*)(eb + 256 + cl), s1 = *(const LAS f32x4*)(eb + 256 + cl + 4);
#pragma unroll
            for (int ai = 0; ai < 2; ++ai)
#pragma unroll
                for (int m = 0; m < 4; ++m) { const int rr = TROW(ai, wr, m, fr); const size_t slot = (size_t)u.pm * 256 + rr; const float w = eb[512 + rr];
                    const float w8 = w * 8.f; f32x4 y0 = (acc[ai][bj][m][0] * s0 + b0) * w8, y1 = (acc[ai][bj][m][1] * s1 + b1) * w8;
#pragma unroll
                    for (int q = 0; q < 4; ++q) { y0[q] = fminf(fmaxf(y0[q], -448.f), 448.f); y1[q] = fminf(fmaxf(y1[q], -448.f), 448.f); }
                    v2u o8; { int t0 = __builtin_amdgcn_cvt_pk_fp8_f32(y0[0], y0[1], 0, false); t0 = __builtin_amdgcn_cvt_pk_fp8_f32(y0[2], y0[3], t0, true);
                              int t1 = __builtin_amdgcn_cvt_pk_fp8_f32(y1[0], y1[1], 0, false); t1 = __builtin_amdgcn_cvt_pk_fp8_f32(y1[2], y1[3], t1, true); o8.x = (unsigned)t0; o8.y = (unsigned)t1; }
                    *(v2u*)((unsigned char*)(Y + (size_t)u.pm * 262144 + u.pn * 256) + (size_t)(unsigned)(rr * 1024 + cl)) = o8; } }
    }
};

namespace att {
__device__ __forceinline__ int crow(int r, int hi) { return (r & 3) + 8 * (r >> 2) + 4 * hi; }
__device__ __forceinline__ float max3f(float a, float b, float c) { return fmaxf(fmaxf(a, b), c); }
typedef LAS const char* lds_cptr;
constexpr int LK = 0, LV = 49152, LWS = 90112, LOST = 92160, LBYTES = 124928;
constexpr int PD = 3;
struct Tens { const bf16* Q; int qpitch; const bf16* K; int kpitch; const bf16* V; int vpitch; bf16* O; };
#define ATT_WAITV(n) asm volatile("s_waitcnt vmcnt(" #n ")" ::: "memory")
struct Pend { f32x16 o0, o1; float l; int qrow0, oc0; bool valid; };
__device__ __forceinline__ void finish_unit(const Pend& P, bf16* O, LAS unsigned char* lds, int wid, int lane) {
    const int r32 = lane & 31, hi = lane >> 5;
    LAS float* wsf = (LAS float*)(lds + LWS) + wid * 64;
    float lrun = P.l;
    { auto rr = __builtin_amdgcn_permlane32_swap(__float_as_uint(lrun), __float_as_uint(lrun), false, false); lrun = __uint_as_float(rr[0]) + __uint_as_float(rr[1]); }
    if (hi == 0) wsf[32 + r32] = lrun;
    LDS_WAIT();
    LAS bf16* stg = (LAS bf16*)(lds + LOST) + wid * 2048;
#pragma unroll
    for (int r = 0; r < 16; ++r) { const int orow = crow(r, hi); const float rl = __builtin_amdgcn_rcpf(wsf[32 + orow]);
        stg[orow * 64 + r32] = (bf16)(pk2(P.o0[r] * rl, 0.f) & 0xffffu); stg[orow * 64 + 32 + r32] = (bf16)(pk2(P.o1[r] * rl, 0.f) & 0xffffu); }
    LDS_WAIT();
    bf16* Ow = O + (size_t)(P.qrow0 + wid * 32) * 1024 + P.oc0;
#pragma unroll
    for (int i = 0; i < 4; ++i) { const int row = i * 8 + (lane >> 3), ch = lane & 7; const v4u v = *(const LAS v4u*)(stg + row * 64 + ch * 8); *(v4u*)(Ow + (size_t)row * 1024 + ch * 8) = v; }
    LDS_WAIT();
}
template <int DK>
__device__ __forceinline__ void unit(const Tens& T, int qrow0, int qc0, int kc0, int vc0, int oc0, int kctx0, int klat0, int NTL, LAS unsigned char* lds, int wave_id, Pend& pend) {
    constexpr int ND = DK / 16;
    wave_id = launder_s(wave_id); const int tid = lthread_w(wave_id), lane = tid & 63, r32 = lane & 31, hi = lane >> 5; const int wid = wave_id;
    LAS float* wsf = (LAS float*)(lds + LWS) + wid * 64;
    const bf16* ksrc = T.K + (size_t)lane * T.kpitch + kc0 + wid * 8;
    const int k2off = (8 + (wid & 3) - wid) * 8;
    const bf16* vsrc = T.V + (size_t)(16 * (wid & 3) + (lane >> 2)) * T.vpitch + vc0 + (wid >> 2) * 32 + (lane & 3) * 8;
#define ATT_DMA(t, ks_, vs_) do { const size_t row0_ = (size_t)((t) < 4 ? kctx0 + 64 * (t) : klat0 + 64 * ((t) - 4)); \
        __builtin_amdgcn_global_load_lds((const unsigned*)(ksrc + row0_ * T.kpitch), (LAS unsigned*)(lds + LK + (ks_) * 12288 + wid * 1024), 16, 0, 0); \
        if (DK > 64) __builtin_amdgcn_global_load_lds((const unsigned*)(ksrc + row0_ * T.kpitch + k2off), (LAS unsigned*)(lds + LK + (ks_) * 12288 + 8192 + (wid & 3) * 1024), 16, 0, 0); \
        __builtin_amdgcn_global_load_lds((const unsigned*)(vsrc + row0_ * T.vpitch), (LAS unsigned*)(lds + LV + (vs_) * 8192 + wid * 1024), 16, 0, 0); } while (0)
#define ATT_WAIT_TILES(n_tiles) do { if (DK > 64) { if ((n_tiles) >= 2) ATT_WAITV(6); else if ((n_tiles) == 1) ATT_WAITV(3); else ATT_WAITV(0); } \
        else { if ((n_tiles) >= 2) ATT_WAITV(4); else if ((n_tiles) == 1) ATT_WAITV(2); else ATT_WAITV(0); } } while (0)
    bf16x8 qr[ND];
    { const bf16* qp = T.Q + (size_t)(qrow0 + wid * 32 + r32) * T.qpitch + qc0 + hi * 8;
#pragma unroll
      for (int d0 = 0; d0 < ND; ++d0) qr[d0] = *(const bf16x8*)(qp + d0 * 16); }
    asm volatile("" ::: "memory");
    constexpr float THR = 8.f;
    const int half = wid >> 2;
    float mhat = 0.f, lrun = 0.f; f32x16 o[2]; o[0] = f32x16{}; o[1] = f32x16{}; f32x16 negm = f32x16{};
    f32x16 p0 = f32x16{}, p1 = f32x16{}; v4u pw[4]; pw[0] = pw[1] = pw[2] = pw[3] = (v4u){0u, 0u, 0u, 0u};
    ATT_DMA(0, 0, 0); ATT_DMA(1, 1, 1); ATT_DMA(2, 2, 2);
    if (pend.valid) finish_unit(pend, T.O, lds, wid, lane);
    ATT_WAIT_TILES(2);
    __builtin_amdgcn_s_barrier(); asm volatile("" ::: "memory");
    if (half == 1) __builtin_amdgcn_s_barrier();
    int vs_prev = 0, vs_cur = 0, vs_iss = 3;
    for (int t = 0; t <= NTL; ++t) {
        if (t >= 1) {
            s16x4 lo[2][4], hh[2][4];
            const unsigned vb = (unsigned)(uintptr_t)(lds + LV + vs_prev * 8192) + ((lane >> 4) & 1) * 32 + (lane & 3) * 8 + (4 * hi + ((lane & 15) >> 2)) * 64;
#pragma unroll
            for (int d0 = 0; d0 < 2; ++d0)
#pragma unroll
                for (int ks = 0; ks < 4; ++ks) {
                    asm volatile("ds_read_b64_tr_b16 %0,%1 offset:%c2" : "=&v"(lo[d0][ks]) : "v"(vb), "i"(d0 * 4096 + ks * 1024) : "memory");
                    asm volatile("ds_read_b64_tr_b16 %0,%1 offset:%c2" : "=&v"(hh[d0][ks]) : "v"(vb), "i"(d0 * 4096 + ks * 1024 + 512) : "memory"); }
            asm volatile("s_waitcnt lgkmcnt(0)" ::: "memory"); __builtin_amdgcn_sched_barrier(0);
#pragma unroll
            for (int ks = 0; ks < 4; ++ks)
#pragma unroll
                for (int d0 = 0; d0 < 2; ++d0) { const bf16x8 vf = (bf16x8){lo[d0][ks][0], lo[d0][ks][1], lo[d0][ks][2], lo[d0][ks][3], hh[d0][ks][0], hh[d0][ks][1], hh[d0][ks][2], hh[d0][ks][3]};
                    o[d0] = __builtin_amdgcn_mfma_f32_32x32x16_bf16(__builtin_bit_cast(bf16x8, pw[ks]), vf, o[d0], 0, 0, 0); }
        }
        if (t < NTL) {
            bf16x8 kf[2 * ND];
            const lds_cptr kb = (lds_cptr)(lds + LK + (t & 3) * 12288) + hi * 1024 + r32 * 16;
#pragma unroll
            for (int d0 = 0; d0 < ND; ++d0) { kf[2 * d0] = *(const LAS bf16x8*)(kb + d0 * 2048); kf[2 * d0 + 1] = *(const LAS bf16x8*)(kb + d0 * 2048 + 512); }
            asm volatile("s_waitcnt lgkmcnt(0)" ::: "memory"); __builtin_amdgcn_sched_barrier(0);
#pragma unroll
            for (int d0 = 0; d0 < ND; ++d0) {
                if (d0 == 0) { p0 = __builtin_amdgcn_mfma_f32_32x32x16_bf16(kf[0], qr[0], negm, 0, 0, 0); p1 = __builtin_amdgcn_mfma_f32_32x32x16_bf16(kf[1], qr[0], negm, 0, 0, 0); }
                else { p0 = __builtin_amdgcn_mfma_f32_32x32x16_bf16(kf[2 * d0], qr[d0], p0, 0, 0, 0); p1 = __builtin_amdgcn_mfma_f32_32x32x16_bf16(kf[2 * d0 + 1], qr[d0], p1, 0, 0, 0); } }
        }
        if (half == 1) {
            const int last_iss = (t + PD - 1 < NTL - 1) ? t + PD - 1 : NTL - 1; const int allow = last_iss - (t + 1);
            if (allow >= 1) ATT_WAIT_TILES(1); else ATT_WAIT_TILES(0); }
        asm volatile("s_waitcnt lgkmcnt(0)" ::: "memory"); __builtin_amdgcn_s_barrier(); asm volatile("" ::: "memory");
        if (t < NTL) {
            float rm = max3f(p0[0], p0[1], p1[0]);
#pragma unroll
            for (int r = 0; r < 16; ++r) rm = max3f(rm, p0[r], p1[r]);
            { auto rr = __builtin_amdgcn_permlane32_swap(__float_as_uint(rm), __float_as_uint(rm), false, false); rm = fmaxf(__uint_as_float(rr[0]), __uint_as_float(rr[1])); }
            if (t == 0 || __any(rm > THR)) {
                const float dl = (t == 0) ? rm : fmaxf(rm, 0.f);
                mhat += dl;
#pragma unroll
                for (int r = 0; r < 16; ++r) { p0[r] -= dl; p1[r] -= dl; negm[r] = -mhat; }
                const float f = (t == 0) ? 1.f : __builtin_amdgcn_exp2f(-dl); lrun *= f;
                if (hi == 0) wsf[r32] = f;
                LDS_WAIT();
#pragma unroll
                for (int r = 0; r < 16; ++r) { const float a = wsf[crow(r, hi)]; o[0][r] *= a; o[1][r] *= a; }
            }
            float rs = 0.f;
#pragma unroll
            for (int r = 0; r < 16; ++r) { p0[r] = __builtin_amdgcn_exp2f(p0[r]); p1[r] = __builtin_amdgcn_exp2f(p1[r]); rs += p0[r] + p1[r]; }
            lrun += rs;
            pw[0] = (v4u){pk2(p0[0], p0[1]), pk2(p0[2], p0[3]), pk2(p0[4], p0[5]), pk2(p0[6], p0[7])};
            pw[1] = (v4u){pk2(p0[8], p0[9]), pk2(p0[10], p0[11]), pk2(p0[12], p0[13]), pk2(p0[14], p0[15])};
            pw[2] = (v4u){pk2(p1[0], p1[1]), pk2(p1[2], p1[3]), pk2(p1[4], p1[5]), pk2(p1[6], p1[7])};
            pw[3] = (v4u){pk2(p1[8], p1[9]), pk2(p1[10], p1[11]), pk2(p1[12], p1[13]), pk2(p1[14], p1[15])};
        }
        if (t + PD < NTL) { ATT_DMA(t + PD, (t + PD) & 3, vs_iss); vs_iss = (vs_iss == 4) ? 0 : vs_iss + 1; }
        if (half == 0) {
            const int last_iss = (t + PD < NTL - 1) ? t + PD : NTL - 1; const int allow = last_iss - (t + 1);
            if (allow >= 2) ATT_WAIT_TILES(2); else if (allow == 1) ATT_WAIT_TILES(1); else ATT_WAIT_TILES(0); }
        vs_prev = vs_cur; vs_cur = (vs_cur == 4) ? 0 : vs_cur + 1;
        asm volatile("s_waitcnt lgkmcnt(0)" ::: "memory"); __builtin_amdgcn_s_barrier(); asm volatile("" ::: "memory");
    }
    if (half == 0) __builtin_amdgcn_s_barrier();
#undef ATT_DMA
#undef ATT_WAIT_TILES
    pend.o0 = o[0]; pend.o1 = o[1]; pend.l = lrun; pend.qrow0 = qrow0; pend.oc0 = oc0; pend.valid = true;
}
#undef ATT_WAITV
}

namespace att64 {
typedef unsigned short bf16;
using bf16x8=__attribute__((ext_vector_type(8)))short;
using s16x4=__attribute__((ext_vector_type(4)))short;
using f32x16=__attribute__((ext_vector_type(16)))float;
using u32x4=__attribute__((ext_vector_type(4)))unsigned;
constexpr int D=64;
constexpr int NW=8,QBLK=32,QB=QBLK*NW,KVBLK=64;
__device__ __forceinline__ int crow(int r,int hi){return (r&3)+8*(r>>2)+4*hi;}
#define SBAR() __builtin_amdgcn_sched_barrier(0)
constexpr int NSLOT=3, SLOTB=8192;
constexpr int LDS_K=0, LDS_V=NSLOT*SLOTB, LDS_WS=2*NSLOT*SLOTB, LDS_OST=LDS_WS+NW*64*4, LDS_BYTES=LDS_OST+NW*4096;
constexpr float C2=0.125f*1.4426950408889634f;
__device__ __forceinline__ void glds16s(unsigned voff,const void*sbase,unsigned lds_dst){unsigned keep;
  asm volatile("s_mov_b32 %0, m0\n\ts_mov_b32 m0, %2\n\ts_nop 0\n\tglobal_load_lds_dwordx4 %1, %3\n\ts_mov_b32 m0, %0":"=&s"(keep):"v"(voff),"s"(lds_dst),"s"(sbase):"memory");}
__device__ __forceinline__ void glds16(const void*gsrc,unsigned lds_dst){unsigned keep;
  asm volatile("s_mov_b32 %0, m0\n\ts_mov_b32 m0, %2\n\ts_nop 0\n\tglobal_load_lds_dwordx4 %1, off\n\ts_mov_b32 m0, %0":"=&s"(keep):"v"(gsrc),"s"(lds_dst):"memory");}
__device__ __forceinline__ float max3f(float a,float b,float c){float r;asm("v_max3_f32 %0, %1, %2, %3":"=v"(r):"v"(a),"v"(b),"v"(c));return r;}
__device__ __forceinline__ float max2f(float a,float b){float r;asm("v_max_f32_e32 %0, %1, %2":"=v"(r):"v"(a),"v"(b));return r;}
__device__ __forceinline__ float fadd_s(float a,float b){float r;asm("v_add_f32_e32 %0, %1, %2":"=v"(r):"v"(a),"v"(b));return r;}
__device__ __forceinline__ float fsub_s(float a,float b){float r;asm("v_sub_f32_e32 %0, %1, %2":"=v"(r):"v"(a),"v"(b));return r;}
typedef float f32x2_t __attribute__((ext_vector_type(2))); typedef __bf16 bf16x2_t __attribute__((ext_vector_type(2)));
__device__ __forceinline__ unsigned cvtpk_s(float lo,float hi){f32x2_t v={lo,hi};bf16x2_t b=__builtin_convertvector(v,bf16x2_t);return __builtin_bit_cast(unsigned,b);}
#define WAIT_BAR(N) asm volatile("s_waitcnt vmcnt(" #N ") lgkmcnt(0)\n\ts_barrier":::"memory")

__device__ __forceinline__ void qkt(f32x16&p0,f32x16&p1,const char*Kslot,const bf16x8*qr,const f32x16&negm,int r32,int hi){
  const char*kb=Kslot+hi*1024+r32*16;
  #pragma unroll
  for(int d0=0;d0<4;++d0){
    const bf16x8 b0=*reinterpret_cast<const bf16x8*>(kb+d0*2048);
    const bf16x8 b1=*reinterpret_cast<const bf16x8*>(kb+d0*2048+512);
    if(d0==0){p0=__builtin_amdgcn_mfma_f32_32x32x16_bf16(b0,qr[0],negm,0,0,0);p1=__builtin_amdgcn_mfma_f32_32x32x16_bf16(b1,qr[0],negm,0,0,0);}
    else{p0=__builtin_amdgcn_mfma_f32_32x32x16_bf16(b0,qr[d0],p0,0,0,0);p1=__builtin_amdgcn_mfma_f32_32x32x16_bf16(b1,qr[d0],p1,0,0,0);}}
}
typedef __attribute__((address_space(3))) const char* lds_cptr;
typedef short v4i16_t __attribute__((ext_vector_type(4)));
__device__ __forceinline__ void kload8(bf16x8*kf,lds_cptr kp){
  kf[0]=*(const __attribute__((address_space(3))) bf16x8*)(kp);      kf[1]=*(const __attribute__((address_space(3))) bf16x8*)(kp+512);
  kf[2]=*(const __attribute__((address_space(3))) bf16x8*)(kp+2048); kf[3]=*(const __attribute__((address_space(3))) bf16x8*)(kp+2560);
  kf[4]=*(const __attribute__((address_space(3))) bf16x8*)(kp+4096); kf[5]=*(const __attribute__((address_space(3))) bf16x8*)(kp+4608);
  kf[6]=*(const __attribute__((address_space(3))) bf16x8*)(kp+6144); kf[7]=*(const __attribute__((address_space(3))) bf16x8*)(kp+6656);
}
__device__ __forceinline__ void kload2(bf16x8*kf,lds_cptr kp,int j){ kf[2*j]=*(const __attribute__((address_space(3))) bf16x8*)(kp+j*2048); kf[2*j+1]=*(const __attribute__((address_space(3))) bf16x8*)(kp+j*2048+512); }
__device__ __forceinline__ s16x4 vtr(lds_cptr p){ return __builtin_bit_cast(s16x4,__builtin_amdgcn_ds_read_tr16_b64_v4i16((__attribute__((address_space(3))) v4i16_t*)p)); }
__device__ __forceinline__ float rowmax(const f32x16&p0,const f32x16&p1){
  float a=max3f(p0[0],p0[1],p1[0]),b=max3f(p0[2],p0[3],p1[1]);a=max3f(a,p1[2],p1[3]);
  #pragma unroll
  for(int r=4;r<16;r+=4){a=max3f(a,p0[r],p0[r+1]);b=max3f(b,p0[r+2],p0[r+3]);a=max3f(a,p1[r],p1[r+1]);b=max3f(b,p1[r+2],p1[r+3]);}
  const float m=max2f(a,b);
  auto rr=__builtin_amdgcn_permlane32_swap(__float_as_uint(m),__float_as_uint(m),false,false);
  return max2f(__uint_as_float(rr[0]),__uint_as_float(rr[1]));
}
__device__ __forceinline__ void pv(f32x16*o,int vb,bf16x8 pa0,bf16x8 pa1,bf16x8 pa2,bf16x8 pa3){
  #pragma unroll
  for(int d0=0;d0<2;++d0){s16x4 lo[4],hi[4];
    #pragma unroll
    for(int ks=0;ks<4;++ks){
      asm volatile("ds_read_b64_tr_b16 %0,%1 offset:%c2":"=&v"(lo[ks]):"v"(vb),"i"(d0*4096+ks*1024):"memory");
      asm volatile("ds_read_b64_tr_b16 %0,%1 offset:%c2":"=&v"(hi[ks]):"v"(vb),"i"(d0*4096+ks*1024+512):"memory");}
    asm volatile("s_waitcnt lgkmcnt(0)":::"memory");SBAR();
    #define PK(k) (bf16x8){lo[k][0],lo[k][1],lo[k][2],lo[k][3],hi[k][0],hi[k][1],hi[k][2],hi[k][3]}
    o[d0]=__builtin_amdgcn_mfma_f32_32x32x16_bf16(pa0,PK(0),o[d0],0,0,0);
    o[d0]=__builtin_amdgcn_mfma_f32_32x32x16_bf16(pa1,PK(1),o[d0],0,0,0);
    o[d0]=__builtin_amdgcn_mfma_f32_32x32x16_bf16(pa2,PK(2),o[d0],0,0,0);
    o[d0]=__builtin_amdgcn_mfma_f32_32x32x16_bf16(pa3,PK(3),o[d0],0,0,0);
    #undef PK
  }
}

#ifndef ATTN_STORE16
#define ATTN_STORE16(p,v) (*(u32x4*)(p)=(v))
#endif
template<int THRL> __device__ __forceinline__ void attn_unit(const bf16*Q,int qp,int qrow0,int qc0,const bf16*__restrict__ K,int kp,int kc0,const bf16*__restrict__ V,int vp,int vc0,bf16*O,int oc0,int kctx0,int klat0,int NT,char*shm,int wave_id){
  wave_id=launder_s(wave_id); const int lane=lane_id_v(),r32=lane&31,hi=lane>>5; const int wid=wave_id;
  const bf16*Qw=Q+(long)(qrow0+wid*QBLK)*qp+qc0;
  const bf16*Kh=K+kc0,*Vh=V+vc0;
  const unsigned lds0=(unsigned)(uintptr_t)shm;
  float*wsf=(float*)(shm+LDS_WS)+wid*64;
  const bf16*ksrc=Kh+(long)lane*kp+wid*8;
  const bf16*vsrc=Vh+(long)(16*(wid&3)+(lane>>2))*vp+(wid>>2)*32+(lane&3)*8;
  #define TROW0(t) ((long)((t)<4?kctx0+64*(t):klat0+64*((t)-4)))
  const unsigned kdst=lds0+LDS_K+wid*1024, vdst=lds0+LDS_V+wid*1024;
  const unsigned koffb=(unsigned)((lane*kp+wid*8)*2), voffb=(unsigned)(((16*(wid&3)+(lane>>2))*vp+(wid>>2)*32+(lane&3)*8)*2);
  #define DMA_K(t,slot) glds16s(koffb,(const char*)Kh+TROW0(t)*(long)kp*2,(unsigned)__builtin_amdgcn_readfirstlane(kdst+(slot)))
  #define DMA_V(t,slot) glds16s(voffb,(const char*)Vh+TROW0(t)*(long)vp*2,(unsigned)__builtin_amdgcn_readfirstlane(vdst+(slot)))
  const int vb0=(int)(lds0+LDS_V)+((lane>>4)&1)*32+(lane&3)*8+(4*hi+((lane&15)>>2))*64;
  const char*Kbase=shm+LDS_K; bf16x8 kf[8];
  const lds_cptr shm3=(lds_cptr)shm; const lds_cptr kp0=shm3+LDS_K+hi*1024+r32*16; const lds_cptr vp0=shm3+LDS_V+((lane>>4)&1)*32+(lane&3)*8+(4*hi+((lane&15)>>2))*64;
  DMA_K(0,0);DMA_V(0,0);DMA_K(1,SLOTB);
  bf16x8 qr[4];
  #pragma unroll
  for(int d0=0;d0<4;++d0)qr[d0]=*reinterpret_cast<const bf16x8*>(&Qw[(long)r32*qp+d0*16+hi*8]);
  float mhat=0.f,l_reg=0.f;f32x16 o[2];o[0]=f32x16{};o[1]=f32x16{};f32x16 negm=f32x16{};asm volatile("":"+v"(negm));
  #define CMASK(P0,P1,t) do{}while(0)
  bool resc=false;
  #define START(P0,P1) do{ const float rm=rowmax(P0,P1); resc=false; \
    { const float dl=rm; mhat=fadd_s(mhat,dl); \
      _Pragma("unroll") for(int r=0;r<16;++r){P0[r]=fsub_s(P0[r],dl);P1[r]=fsub_s(P1[r],dl);} \
      _Pragma("unroll") for(int r=0;r<16;++r)negm[r]=-mhat; asm volatile("":"+v"(negm)); } \
    _Pragma("unroll") for(int r=0;r<16;++r)P0[r]=__builtin_amdgcn_exp2f(P0[r]); }while(0)
  #define RESC() do{ if(resc){ asm volatile("s_waitcnt lgkmcnt(0)":::"memory"); \
      _Pragma("unroll") for(int d_=0;d_<2;++d_) _Pragma("unroll") for(int r=0;r<16;++r)o[d_][r]*=wsf[crow(r,hi)]; } }while(0)
  f32x16 pA0,pA1,pB0,pB1;
  int sl_prev=0,sl_cur=0,sl_next=SLOTB;
  #define ROT() do{sl_prev=sl_cur;sl_cur=sl_next;sl_next=(sl_next==(NSLOT-1)*SLOTB)?0:sl_next+SLOTB;}while(0)
  DMA_K(2,2*SLOTB);
  WAIT_BAR(3);
  qkt(pA0,pA1,Kbase,qr,negm,r32,hi);asm volatile("s_nop 15\n\ts_nop 7":"+v"(pA0),"+v"(pA1));CMASK(pA0,pA1,0);
  START(pA0,pA1);
  _Pragma("unroll") for(int r=0;r<16;++r)pA1[r]=__builtin_amdgcn_exp2f(pA1[r]);
  WAIT_BAR(0);
  DMA_K(3,0);DMA_V(1,SLOTB);
  ROT();
  kload8(kf,kp0+sl_cur);
  WAIT_BAR(2);
  s16x4 vlo[8],vhi[8]; u32x4 pw0,pw1,pw2,pw3;
  #define PKW(P,B) cvtpk_s(P[B],P[B+1])
  #define PAF(k) __builtin_bit_cast(bf16x8,pw##k)
  #define VFR(i) (bf16x8){vlo[i][0],vlo[i][1],vlo[i][2],vlo[i][3],vhi[i][0],vhi[i][1],vhi[i][2],vhi[i][3]}
  #define PIN(x) asm volatile("":"+v"(x))
  #define MX3(a,b,c) __builtin_fmaxf(__builtin_fmaxf((a),(b)),(c))
  #define GAPA(MF,A0,A1,A2,A3,W0,W1,PW) do{ MF; sacc+=A0; sacc+=A1; sacc+=A2; sacc+=A3; PIN(sacc); W0; W1; PIN(PW); SBAR(); }while(0)
  #define EX(v) __builtin_amdgcn_exp2f(v)
  #define GAPB(MF,X,B) do{ MF; X[B]=EX(X[B]); X[B+1]=EX(X[B+1]); X[B+2]=EX(X[B+2]); X[B+3]=EX(X[B+3]); PIN(X); SBAR(); }while(0)
  #define VRD(i) do{ vlo[i]=vtr(vp_+(((i)>>2)*4096+((i)&3)*1024)); vhi[i]=vtr(vp_+(((i)>>2)*4096+((i)&3)*1024+512)); }while(0)
  #define KRD(G,j) do{ if(G){ kload2(kf,kp0+sl_next,j); SBAR(); } }while(0)
  #define STEP(C0,C1,P0,P1,t,GK,GV,GL) do{ SBAR(); \
    const lds_cptr vp_=vp0+sl_prev; \
    VRD(0); SBAR(); float sacc=(P0[0]+P0[1]); \
    GAPA(C0=__builtin_amdgcn_mfma_f32_32x32x16_bf16(kf[0],qr[0],negm,0,0,0), P0[2],P0[3],P0[4],P0[5],     pw0[0]=PKW(P0,0), pw0[1]=PKW(P0,2), pw0); \
    VRD(4); SBAR(); GAPA(C1=__builtin_amdgcn_mfma_f32_32x32x16_bf16(kf[1],qr[0],negm,0,0,0), P0[6],P0[7],P0[8],P0[9],     pw0[2]=PKW(P0,4), pw0[3]=PKW(P0,6), pw0); \
    VRD(1); SBAR(); GAPA(C0=__builtin_amdgcn_mfma_f32_32x32x16_bf16(kf[2],qr[1],C0,0,0,0),   P0[10],P0[11],P0[12],P0[13], pw1[0]=PKW(P0,8), pw1[1]=PKW(P0,10), pw1); \
    VRD(5); SBAR(); GAPA(C1=__builtin_amdgcn_mfma_f32_32x32x16_bf16(kf[3],qr[1],C1,0,0,0),   P0[14],P0[15],P1[0],P1[1],   pw1[2]=PKW(P0,12),pw1[3]=PKW(P0,14), pw1); \
    VRD(2); SBAR(); GAPA(C0=__builtin_amdgcn_mfma_f32_32x32x16_bf16(kf[4],qr[2],C0,0,0,0),   P1[2],P1[3],P1[4],P1[5],     pw2[0]=PKW(P1,0), pw2[1]=PKW(P1,2), pw2); \
    VRD(6); SBAR(); GAPA(C1=__builtin_amdgcn_mfma_f32_32x32x16_bf16(kf[5],qr[2],C1,0,0,0),   P1[6],P1[7],P1[8],P1[9],     pw2[2]=PKW(P1,4), pw2[3]=PKW(P1,6), pw2); \
    VRD(3); SBAR(); GAPA(C0=__builtin_amdgcn_mfma_f32_32x32x16_bf16(kf[6],qr[3],C0,0,0,0),   P1[10],P1[11],P1[12],P1[13], pw3[0]=PKW(P1,8), pw3[1]=PKW(P1,10), pw3); \
    VRD(7); SBAR(); GAPA(C1=__builtin_amdgcn_mfma_f32_32x32x16_bf16(kf[7],qr[3],C1,0,0,0),   P1[14],P1[15],0.f,0.f,       pw3[2]=PKW(P1,12),pw3[3]=PKW(P1,14), pw3); \
    l_reg+=sacc; \
    if(GK){DMA_K((t)+3,sl_cur);} if(GV){DMA_V((t)+1,sl_next);} \
    CMASK(C0,C1,t); \
    { float a=MX3(C0[0],C0[1],C1[0]),b=MX3(C0[2],C0[3],C1[1]); a=MX3(a,C1[2],C1[3]); \
      _Pragma("unroll") for(int r=4;r<16;r+=4){a=MX3(a,C0[r],C0[r+1]);b=MX3(b,C0[r+2],C0[r+3]);a=MX3(a,C1[r],C1[r+1]);b=MX3(b,C1[r+2],C1[r+3]);} \
      float rm=__builtin_fmaxf(a,b); { auto rr=__builtin_amdgcn_permlane32_swap(__float_as_uint(rm),__float_as_uint(rm),false,false); rm=__builtin_fmaxf(__uint_as_float(rr[0]),__uint_as_float(rr[1])); } \
      resc=false; \
      if(__builtin_expect(__any(rm>(float)THRL),0)){ const float dl=__builtin_fmaxf(rm,0.f); mhat+=dl; \
        _Pragma("unroll") for(int r=0;r<16;++r){C0[r]-=dl;C1[r]-=dl;} \
        _Pragma("unroll") for(int r=0;r<16;++r)negm[r]=-mhat; asm volatile("":"+v"(negm)); \
        const float f=__builtin_amdgcn_exp2f(-dl); l_reg*=f; if(hi==0)wsf[r32]=f; resc=true; } } \
    SBAR(); \
    GAPB(o[0]=__builtin_amdgcn_mfma_f32_32x32x16_bf16(PAF(0),VFR(0),o[0],0,0,0), C0,0); \
    GAPB(o[1]=__builtin_amdgcn_mfma_f32_32x32x16_bf16(PAF(0),VFR(4),o[1],0,0,0), C0,4); \
    KRD(GL,0); GAPB(o[0]=__builtin_amdgcn_mfma_f32_32x32x16_bf16(PAF(1),VFR(1),o[0],0,0,0), C0,8); \
    KRD(GL,1); GAPB(o[1]=__builtin_amdgcn_mfma_f32_32x32x16_bf16(PAF(1),VFR(5),o[1],0,0,0), C0,12); \
    KRD(GL,2); GAPB(o[0]=__builtin_amdgcn_mfma_f32_32x32x16_bf16(PAF(2),VFR(2),o[0],0,0,0), C1,0); \
    KRD(GL,3); GAPB(o[1]=__builtin_amdgcn_mfma_f32_32x32x16_bf16(PAF(2),VFR(6),o[1],0,0,0), C1,4); \
    GAPB(o[0]=__builtin_amdgcn_mfma_f32_32x32x16_bf16(PAF(3),VFR(3),o[0],0,0,0), C1,8); \
    GAPB(o[1]=__builtin_amdgcn_mfma_f32_32x32x16_bf16(PAF(3),VFR(7),o[1],0,0,0), C1,12); \
    }while(0)
  int t=1;
  for(;t+5<NT;t+=2){
    STEP(pB0,pB1,pA0,pA1,t,true,true,true);     WAIT_BAR(2); RESC(); ROT();
    STEP(pA0,pA1,pB0,pB1,t+1,true,true,true);   WAIT_BAR(2); RESC(); ROT();
  }
  #define ENDW(tt) do{ if((tt)+3<NT){WAIT_BAR(2);} else if((tt)+2<NT){WAIT_BAR(1);} else {WAIT_BAR(0);} }while(0)
  for(;t+1<NT;t+=2){
    STEP(pB0,pB1,pA0,pA1,t,(t+3<NT),(t+1<NT),(t+1<NT));       ENDW(t);   RESC(); ROT();
    STEP(pA0,pA1,pB0,pB1,t+1,(t+4<NT),(t+2<NT),(t+2<NT));     ENDW(t+1); RESC(); ROT();
  }
  STEP(pB0,pB1,pA0,pA1,NT-1,false,false,false); RESC();
  { float sacc=pB0[0]+pB0[1]; _Pragma("unroll") for(int r=2;r<16;++r)sacc+=pB0[r]; _Pragma("unroll") for(int r=0;r<16;++r)sacc+=pB1[r]; l_reg+=sacc;
    pw0=(u32x4){PKW(pB0,0),PKW(pB0,2),PKW(pB0,4),PKW(pB0,6)};pw1=(u32x4){PKW(pB0,8),PKW(pB0,10),PKW(pB0,12),PKW(pB0,14)};pw2=(u32x4){PKW(pB1,0),PKW(pB1,2),PKW(pB1,4),PKW(pB1,6)};pw3=(u32x4){PKW(pB1,8),PKW(pB1,10),PKW(pB1,12),PKW(pB1,14)};
    SBAR(); pv(o,vb0+sl_cur,PAF(0),PAF(1),PAF(2),PAF(3)); }
  #undef PKW
  #undef PAF
  #undef VFR
  #undef PIN
  #undef MX3
  #undef GAPA
  #undef GAPB
  #undef EX
  #undef VRD
  #undef KRD
  #undef STEP
  #undef ENDW
  {auto rr=__builtin_amdgcn_permlane32_swap(__float_as_uint(l_reg),__float_as_uint(l_reg),false,false);l_reg=__uint_as_float(rr[0])+__uint_as_float(rr[1]);}
  if(hi==0)wsf[32+r32]=l_reg;asm volatile("s_waitcnt lgkmcnt(0)":::"memory");
  float rli[16];
  #pragma unroll
  for(int r=0;r<16;++r)rli[r]=__builtin_amdgcn_rcpf(wsf[32+crow(r,hi)]);
  unsigned char*Ow=(unsigned char*)O+(long)(qrow0+wid*QBLK)*1024+oc0;
  { bf16*stg=(bf16*)(shm+LDS_OST)+wid*2048;
    #pragma unroll
    for(int r=0;r<16;++r){const int orow=crow(r,hi);
      #pragma unroll
      for(int d0=0;d0<2;++d0)stg[orow*64+d0*32+r32]=(bf16)(cvtpk_s(o[d0][r]*rli[r],0.f)&0xffffu);}
    asm volatile("s_waitcnt lgkmcnt(0)":::"memory");
    #pragma unroll
    for(int i=0;i<4;++i){const int row=i*8+(lane>>3),ch=lane&7; const u32x4 v=*(const u32x4*)(stg+row*64+ch*8);
      *(v2u*)(Ow+(long)row*1024+ch*8)=pack8_fp8((f32x4){bf_lo(v.x),bf_hi(v.x),bf_lo(v.y),bf_hi(v.y)},(f32x4){bf_lo(v.z),bf_hi(v.z),bf_lo(v[3]),bf_hi(v[3])});} }
  asm volatile("s_waitcnt lgkmcnt(0)\n\ts_barrier":::"memory");
  #undef DMA_K
  #undef DMA_V
  #undef TROW0
  #undef CMASK
  #undef START
  #undef RESC
  #undef ROT
}
#undef SBAR
#undef WAIT_BAR
}

namespace att96 {
typedef unsigned short bf16;
using bf16x8=__attribute__((ext_vector_type(8)))short;
using s16x4=__attribute__((ext_vector_type(4)))short;
using f32x16=__attribute__((ext_vector_type(16)))float;
using u32x4=__attribute__((ext_vector_type(4)))unsigned;
constexpr int D=64;
constexpr int NW=8,QBLK=32,QB=QBLK*NW,KVBLK=64;
__device__ __forceinline__ int crow(int r,int hi){return (r&3)+8*(r>>2)+4*hi;}
#define SBAR() __builtin_amdgcn_sched_barrier(0)
constexpr int NSLOT=3, SLOTB=8192, KSLOTB=12288;
#define KOFF(sl) ((sl)+((sl)>>1))
constexpr int LDS_K=0, LDS_V=NSLOT*KSLOTB, LDS_WS=LDS_V+NSLOT*SLOTB, LDS_OST=LDS_WS+NW*64*4, LDS_BYTES=LDS_OST+NW*4096;
constexpr float C2=0.125f*1.4426950408889634f;
__device__ __forceinline__ void glds16s(unsigned voff,const void*sbase,unsigned lds_dst){unsigned keep;
  asm volatile("s_mov_b32 %0, m0\n\ts_mov_b32 m0, %2\n\ts_nop 0\n\tglobal_load_lds_dwordx4 %1, %3\n\ts_mov_b32 m0, %0":"=&s"(keep):"v"(voff),"s"(lds_dst),"s"(sbase):"memory");}
__device__ __forceinline__ void glds16(const void*gsrc,unsigned lds_dst){unsigned keep;
  asm volatile("s_mov_b32 %0, m0\n\ts_mov_b32 m0, %2\n\ts_nop 0\n\tglobal_load_lds_dwordx4 %1, off\n\ts_mov_b32 m0, %0":"=&s"(keep):"v"(gsrc),"s"(lds_dst):"memory");}
__device__ __forceinline__ float max3f(float a,float b,float c){float r;asm("v_max3_f32 %0, %1, %2, %3":"=v"(r):"v"(a),"v"(b),"v"(c));return r;}
__device__ __forceinline__ float max2f(float a,float b){float r;asm("v_max_f32_e32 %0, %1, %2":"=v"(r):"v"(a),"v"(b));return r;}
__device__ __forceinline__ float fadd_s(float a,float b){float r;asm("v_add_f32_e32 %0, %1, %2":"=v"(r):"v"(a),"v"(b));return r;}
__device__ __forceinline__ float fsub_s(float a,float b){float r;asm("v_sub_f32_e32 %0, %1, %2":"=v"(r):"v"(a),"v"(b));return r;}
typedef float f32x2_t __attribute__((ext_vector_type(2))); typedef __bf16 bf16x2_t __attribute__((ext_vector_type(2)));
__device__ __forceinline__ unsigned cvtpk_s(float lo,float hi){f32x2_t v={lo,hi};bf16x2_t b=__builtin_convertvector(v,bf16x2_t);return __builtin_bit_cast(unsigned,b);}
#define WAIT_BAR(N) asm volatile("s_waitcnt vmcnt(" #N ") lgkmcnt(0)\n\ts_barrier":::"memory")

__device__ __forceinline__ void qkt(f32x16&p0,f32x16&p1,const char*Kslot,const bf16x8*qr,const f32x16&negm,int r32,int hi){
  const char*kb=Kslot+hi*1024+r32*16;
  #pragma unroll
  for(int d0=0;d0<6;++d0){
    const bf16x8 b0=*reinterpret_cast<const bf16x8*>(kb+d0*2048);
    const bf16x8 b1=*reinterpret_cast<const bf16x8*>(kb+d0*2048+512);
    if(d0==0){p0=__builtin_amdgcn_mfma_f32_32x32x16_bf16(b0,qr[0],negm,0,0,0);p1=__builtin_amdgcn_mfma_f32_32x32x16_bf16(b1,qr[0],negm,0,0,0);}
    else{p0=__builtin_amdgcn_mfma_f32_32x32x16_bf16(b0,qr[d0],p0,0,0,0);p1=__builtin_amdgcn_mfma_f32_32x32x16_bf16(b1,qr[d0],p1,0,0,0);}}
}
typedef __attribute__((address_space(3))) const char* lds_cptr;
typedef short v4i16_t __attribute__((ext_vector_type(4)));
__device__ __forceinline__ void kload8(bf16x8*kf,lds_cptr kp){
  kf[0]=*(const __attribute__((address_space(3))) bf16x8*)(kp);      kf[1]=*(const __attribute__((address_space(3))) bf16x8*)(kp+512);
  kf[2]=*(const __attribute__((address_space(3))) bf16x8*)(kp+2048); kf[3]=*(const __attribute__((address_space(3))) bf16x8*)(kp+2560);
  kf[4]=*(const __attribute__((address_space(3))) bf16x8*)(kp+4096); kf[5]=*(const __attribute__((address_space(3))) bf16x8*)(kp+4608);
  kf[6]=*(const __attribute__((address_space(3))) bf16x8*)(kp+6144); kf[7]=*(const __attribute__((address_space(3))) bf16x8*)(kp+6656);
  kf[8]=*(const __attribute__((address_space(3))) bf16x8*)(kp+8192); kf[9]=*(const __attribute__((address_space(3))) bf16x8*)(kp+8704);
  kf[10]=*(const __attribute__((address_space(3))) bf16x8*)(kp+10240); kf[11]=*(const __attribute__((address_space(3))) bf16x8*)(kp+10752);
}
__device__ __forceinline__ void kload2(bf16x8*kf,lds_cptr kp,int j){ kf[2*j]=*(const __attribute__((address_space(3))) bf16x8*)(kp+j*2048); kf[2*j+1]=*(const __attribute__((address_space(3))) bf16x8*)(kp+j*2048+512); }
__device__ __forceinline__ s16x4 vtr(lds_cptr p){ return __builtin_bit_cast(s16x4,__builtin_amdgcn_ds_read_tr16_b64_v4i16((__attribute__((address_space(3))) v4i16_t*)p)); }
__device__ __forceinline__ float rowmax(const f32x16&p0,const f32x16&p1){
  float a=max3f(p0[0],p0[1],p1[0]),b=max3f(p0[2],p0[3],p1[1]);a=max3f(a,p1[2],p1[3]);
  #pragma unroll
  for(int r=4;r<16;r+=4){a=max3f(a,p0[r],p0[r+1]);b=max3f(b,p0[r+2],p0[r+3]);a=max3f(a,p1[r],p1[r+1]);b=max3f(b,p1[r+2],p1[r+3]);}
  const float m=max2f(a,b);
  auto rr=__builtin_amdgcn_permlane32_swap(__float_as_uint(m),__float_as_uint(m),false,false);
  return max2f(__uint_as_float(rr[0]),__uint_as_float(rr[1]));
}
__device__ __forceinline__ void pv(f32x16*o,int vb,bf16x8 pa0,bf16x8 pa1,bf16x8 pa2,bf16x8 pa3){
  #pragma unroll
  for(int d0=0;d0<2;++d0){s16x4 lo[4],hi[4];
    #pragma unroll
    for(int ks=0;ks<4;++ks){
      asm volatile("ds_read_b64_tr_b16 %0,%1 offset:%c2":"=&v"(lo[ks]):"v"(vb),"i"(d0*4096+ks*1024):"memory");
      asm volatile("ds_read_b64_tr_b16 %0,%1 offset:%c2":"=&v"(hi[ks]):"v"(vb),"i"(d0*4096+ks*1024+512):"memory");}
    asm volatile("s_waitcnt lgkmcnt(0)":::"memory");SBAR();
    #define PK(k) (bf16x8){lo[k][0],lo[k][1],lo[k][2],lo[k][3],hi[k][0],hi[k][1],hi[k][2],hi[k][3]}
    o[d0]=__builtin_amdgcn_mfma_f32_32x32x16_bf16(pa0,PK(0),o[d0],0,0,0);
    o[d0]=__builtin_amdgcn_mfma_f32_32x32x16_bf16(pa1,PK(1),o[d0],0,0,0);
    o[d0]=__builtin_amdgcn_mfma_f32_32x32x16_bf16(pa2,PK(2),o[d0],0,0,0);
    o[d0]=__builtin_amdgcn_mfma_f32_32x32x16_bf16(pa3,PK(3),o[d0],0,0,0);
    #undef PK
  }
}

#ifndef ATTN_STORE16
#define ATTN_STORE16(p,v) (*(u32x4*)(p)=(v))
#endif
template<int THRL> __device__ __forceinline__ void attn_unit(const bf16*Q,int qp,int qrow0,int qc0,const bf16*__restrict__ K,int kp,int kc0,const bf16*__restrict__ V,int vp,int vc0,bf16*O,int oc0,int kctx0,int klat0,int NT,char*shm,int wave_id){
  wave_id=launder_s(wave_id); const int lane=lane_id_v(),r32=lane&31,hi=lane>>5; const int wid=wave_id;
  const bf16*Qw=Q+(long)(qrow0+wid*QBLK)*qp+qc0;
  const bf16*Kh=K+kc0,*Vh=V+vc0;
  const unsigned lds0=(unsigned)(uintptr_t)shm;
  float*wsf=(float*)(shm+LDS_WS)+wid*64;
  const bf16*ksrc=Kh+(long)lane*kp+wid*8;
  const bf16*vsrc=Vh+(long)(16*(wid&3)+(lane>>2))*vp+(wid>>2)*32+(lane&3)*8;
  #define TROW0(t) ((long)((t)<4?kctx0+64*(t):klat0+64*((t)-4)))
  const unsigned kdst=lds0+LDS_K+wid*1024, kdst2=lds0+LDS_K+8192+(wid&3)*1024, vdst=lds0+LDS_V+wid*1024;
  const int k2off=(8+(wid&3)-wid)*8;
  const unsigned koffb=(unsigned)((lane*kp+wid*8)*2), voffb=(unsigned)(((16*(wid&3)+(lane>>2))*vp+(wid>>2)*32+(lane&3)*8)*2);
  #define DMA_K(t,slot) do{ glds16s(koffb,(const char*)Kh+TROW0(t)*(long)kp*2,(unsigned)__builtin_amdgcn_readfirstlane(kdst+KOFF(slot))); glds16s(koffb,(const char*)Kh+(TROW0(t)*(long)kp+k2off)*2,(unsigned)__builtin_amdgcn_readfirstlane(kdst2+KOFF(slot))); }while(0)
  #define DMA_V(t,slot) glds16s(voffb,(const char*)Vh+TROW0(t)*(long)vp*2,(unsigned)__builtin_amdgcn_readfirstlane(vdst+(slot)))
  const int vb0=(int)(lds0+LDS_V)+((lane>>4)&1)*32+(lane&3)*8+(4*hi+((lane&15)>>2))*64;
  const char*Kbase=shm+LDS_K; bf16x8 kf[12];
  const lds_cptr shm3=(lds_cptr)shm; const lds_cptr kp0=shm3+LDS_K+hi*1024+r32*16; const lds_cptr vp0=shm3+LDS_V+((lane>>4)&1)*32+(lane&3)*8+(4*hi+((lane&15)>>2))*64;
  DMA_K(0,0);DMA_V(0,0);DMA_K(1,SLOTB);
  bf16x8 qr[6];
  #pragma unroll
  for(int d0=0;d0<6;++d0)qr[d0]=*reinterpret_cast<const bf16x8*>(&Qw[(long)r32*qp+d0*16+hi*8]);
  float mhat=0.f,l_reg=0.f;f32x16 o[2];o[0]=f32x16{};o[1]=f32x16{};f32x16 negm=f32x16{};asm volatile("":"+v"(negm));
  #define CMASK(P0,P1,t) do{}while(0)
  bool resc=false;
  #define START(P0,P1) do{ const float rm=rowmax(P0,P1); resc=false; \
    { const float dl=rm; mhat=fadd_s(mhat,dl); \
      _Pragma("unroll") for(int r=0;r<16;++r){P0[r]=fsub_s(P0[r],dl);P1[r]=fsub_s(P1[r],dl);} \
      _Pragma("unroll") for(int r=0;r<16;++r)negm[r]=-mhat; asm volatile("":"+v"(negm)); } \
    _Pragma("unroll") for(int r=0;r<16;++r)P0[r]=__builtin_amdgcn_exp2f(P0[r]); }while(0)
  #define RESC() do{ if(resc){ asm volatile("s_waitcnt lgkmcnt(0)":::"memory"); \
      _Pragma("unroll") for(int d_=0;d_<2;++d_) _Pragma("unroll") for(int r=0;r<16;++r)o[d_][r]*=wsf[crow(r,hi)]; } }while(0)
  f32x16 pA0,pA1,pB0,pB1;
  int sl_prev=0,sl_cur=0,sl_next=SLOTB;
  #define ROT() do{sl_prev=sl_cur;sl_cur=sl_next;sl_next=(sl_next==(NSLOT-1)*SLOTB)?0:sl_next+SLOTB;}while(0)
  DMA_K(2,2*SLOTB);
  WAIT_BAR(5);
  qkt(pA0,pA1,Kbase,qr,negm,r32,hi);asm volatile("s_nop 15\n\ts_nop 7":"+v"(pA0),"+v"(pA1));CMASK(pA0,pA1,0);
  START(pA0,pA1);
  _Pragma("unroll") for(int r=0;r<16;++r)pA1[r]=__builtin_amdgcn_exp2f(pA1[r]);
  WAIT_BAR(0);
  DMA_K(3,0);DMA_V(1,SLOTB);
  ROT();
  kload8(kf,kp0+KOFF(sl_cur));
  WAIT_BAR(3);
  s16x4 vlo[8],vhi[8]; u32x4 pw0,pw1,pw2,pw3;
  #define PKW(P,B) cvtpk_s(P[B],P[B+1])
  #define PAF(k) __builtin_bit_cast(bf16x8,pw##k)
  #define VFR(i) (bf16x8){vlo[i][0],vlo[i][1],vlo[i][2],vlo[i][3],vhi[i][0],vhi[i][1],vhi[i][2],vhi[i][3]}
  #define PIN(x) asm volatile("":"+v"(x))
  #define MX3(a,b,c) __builtin_fmaxf(__builtin_fmaxf((a),(b)),(c))
  #define GAPA(MF,A0,A1,A2,A3,W0,W1,PW) do{ MF; sacc+=A0; sacc+=A1; sacc+=A2; sacc+=A3; PIN(sacc); W0; W1; PIN(PW); SBAR(); }while(0)
  #define EX(v) __builtin_amdgcn_exp2f(v)
  #define GAPB(MF,X,B) do{ MF; X[B]=EX(X[B]); X[B+1]=EX(X[B+1]); X[B+2]=EX(X[B+2]); X[B+3]=EX(X[B+3]); PIN(X); SBAR(); }while(0)
  #define VRD(i) do{ vlo[i]=vtr(vp_+(((i)>>2)*4096+((i)&3)*1024)); vhi[i]=vtr(vp_+(((i)>>2)*4096+((i)&3)*1024+512)); }while(0)
  #define KRD(G,j) do{ if(G){ kload2(kf,kp0+KOFF(sl_next),j); SBAR(); } }while(0)
  #define STEP(C0,C1,P0,P1,t,GK,GV,GL) do{ SBAR(); \
    const lds_cptr vp_=vp0+sl_prev; \
    VRD(0); SBAR(); float sacc=(P0[0]+P0[1]); \
    GAPA(C0=__builtin_amdgcn_mfma_f32_32x32x16_bf16(kf[0],qr[0],negm,0,0,0), P0[2],P0[3],P0[4],P0[5],     pw0[0]=PKW(P0,0), pw0[1]=PKW(P0,2), pw0); \
    VRD(4); SBAR(); GAPA(C1=__builtin_amdgcn_mfma_f32_32x32x16_bf16(kf[1],qr[0],negm,0,0,0), P0[6],P0[7],P0[8],P0[9],     pw0[2]=PKW(P0,4), pw0[3]=PKW(P0,6), pw0); \
    VRD(1); SBAR(); GAPA(C0=__builtin_amdgcn_mfma_f32_32x32x16_bf16(kf[2],qr[1],C0,0,0,0),   P0[10],P0[11],P0[12],P0[13], pw1[0]=PKW(P0,8), pw1[1]=PKW(P0,10), pw1); \
    VRD(5); SBAR(); GAPA(C1=__builtin_amdgcn_mfma_f32_32x32x16_bf16(kf[3],qr[1],C1,0,0,0),   P0[14],P0[15],P1[0],P1[1],   pw1[2]=PKW(P0,12),pw1[3]=PKW(P0,14), pw1); \
    VRD(2); SBAR(); GAPA(C0=__builtin_amdgcn_mfma_f32_32x32x16_bf16(kf[4],qr[2],C0,0,0,0),   P1[2],P1[3],P1[4],P1[5],     pw2[0]=PKW(P1,0), pw2[1]=PKW(P1,2), pw2); \
    VRD(6); SBAR(); GAPA(C1=__builtin_amdgcn_mfma_f32_32x32x16_bf16(kf[5],qr[2],C1,0,0,0),   P1[6],P1[7],P1[8],P1[9],     pw2[2]=PKW(P1,4), pw2[3]=PKW(P1,6), pw2); \
    VRD(3); SBAR(); GAPA(C0=__builtin_amdgcn_mfma_f32_32x32x16_bf16(kf[6],qr[3],C0,0,0,0),   P1[10],P1[11],P1[12],P1[13], pw3[0]=PKW(P1,8), pw3[1]=PKW(P1,10), pw3); \
    VRD(7); SBAR(); GAPA(C1=__builtin_amdgcn_mfma_f32_32x32x16_bf16(kf[7],qr[3],C1,0,0,0),   P1[14],P1[15],0.f,0.f,       pw3[2]=PKW(P1,12),pw3[3]=PKW(P1,14), pw3); \
    C0=__builtin_amdgcn_mfma_f32_32x32x16_bf16(kf[8],qr[4],C0,0,0,0); C1=__builtin_amdgcn_mfma_f32_32x32x16_bf16(kf[9],qr[4],C1,0,0,0); C0=__builtin_amdgcn_mfma_f32_32x32x16_bf16(kf[10],qr[5],C0,0,0,0); C1=__builtin_amdgcn_mfma_f32_32x32x16_bf16(kf[11],qr[5],C1,0,0,0); SBAR(); \
    l_reg+=sacc; \
    if(GK){DMA_K((t)+3,sl_cur);} if(GV){DMA_V((t)+1,sl_next);} \
    CMASK(C0,C1,t); \
    { float a=MX3(C0[0],C0[1],C1[0]),b=MX3(C0[2],C0[3],C1[1]); a=MX3(a,C1[2],C1[3]); \
      _Pragma("unroll") for(int r=4;r<16;r+=4){a=MX3(a,C0[r],C0[r+1]);b=MX3(b,C0[r+2],C0[r+3]);a=MX3(a,C1[r],C1[r+1]);b=MX3(b,C1[r+2],C1[r+3]);} \
      float rm=__builtin_fmaxf(a,b); { auto rr=__builtin_amdgcn_permlane32_swap(__float_as_uint(rm),__float_as_uint(rm),false,false); rm=__builtin_fmaxf(__uint_as_float(rr[0]),__uint_as_float(rr[1])); } \
      resc=false; \
      if(__builtin_expect(__any(rm>(float)THRL),0)){ const float dl=__builtin_fmaxf(rm,0.f); mhat+=dl; \
        _Pragma("unroll") for(int r=0;r<16;++r){C0[r]-=dl;C1[r]-=dl;} \
        _Pragma("unroll") for(int r=0;r<16;++r)negm[r]=-mhat; asm volatile("":"+v"(negm)); \
        const float f=__builtin_amdgcn_exp2f(-dl); l_reg*=f; if(hi==0)wsf[r32]=f; resc=true; } } \
    SBAR(); \
    GAPB(o[0]=__builtin_amdgcn_mfma_f32_32x32x16_bf16(PAF(0),VFR(0),o[0],0,0,0), C0,0); \
    GAPB(o[1]=__builtin_amdgcn_mfma_f32_32x32x16_bf16(PAF(0),VFR(4),o[1],0,0,0), C0,4); \
    KRD(GL,0); GAPB(o[0]=__builtin_amdgcn_mfma_f32_32x32x16_bf16(PAF(1),VFR(1),o[0],0,0,0), C0,8); \
    KRD(GL,1); GAPB(o[1]=__builtin_amdgcn_mfma_f32_32x32x16_bf16(PAF(1),VFR(5),o[1],0,0,0), C0,12); \
    KRD(GL,2); GAPB(o[0]=__builtin_amdgcn_mfma_f32_32x32x16_bf16(PAF(2),VFR(2),o[0],0,0,0), C1,0); \
    KRD(GL,3); GAPB(o[1]=__builtin_amdgcn_mfma_f32_32x32x16_bf16(PAF(2),VFR(6),o[1],0,0,0), C1,4); \
    KRD(GL,4); GAPB(o[0]=__builtin_amdgcn_mfma_f32_32x32x16_bf16(PAF(3),VFR(3),o[0],0,0,0), C1,8); \
    KRD(GL,5); GAPB(o[1]=__builtin_amdgcn_mfma_f32_32x32x16_bf16(PAF(3),VFR(7),o[1],0,0,0), C1,12); \
    }while(0)
  int t=1;
  for(;t+5<NT;t+=2){
    STEP(pB0,pB1,pA0,pA1,t,true,true,true);     WAIT_BAR(3); RESC(); ROT();
    STEP(pA0,pA1,pB0,pB1,t+1,true,true,true);   WAIT_BAR(3); RESC(); ROT();
  }
  #define ENDW(tt) do{ if((tt)+3<NT){WAIT_BAR(3);} else if((tt)+2<NT){WAIT_BAR(1);} else {WAIT_BAR(0);} }while(0)
  for(;t+1<NT;t+=2){
    STEP(pB0,pB1,pA0,pA1,t,(t+3<NT),(t+1<NT),(t+1<NT));       ENDW(t);   RESC(); ROT();
    STEP(pA0,pA1,pB0,pB1,t+1,(t+4<NT),(t+2<NT),(t+2<NT));     ENDW(t+1); RESC(); ROT();
  }
  STEP(pB0,pB1,pA0,pA1,NT-1,false,false,false); RESC();
  { float sacc=pB0[0]+pB0[1]; _Pragma("unroll") for(int r=2;r<16;++r)sacc+=pB0[r]; _Pragma("unroll") for(int r=0;r<16;++r)sacc+=pB1[r]; l_reg+=sacc;
    pw0=(u32x4){PKW(pB0,0),PKW(pB0,2),PKW(pB0,4),PKW(pB0,6)};pw1=(u32x4){PKW(pB0,8),PKW(pB0,10),PKW(pB0,12),PKW(pB0,14)};pw2=(u32x4){PKW(pB1,0),PKW(pB1,2),PKW(pB1,4),PKW(pB1,6)};pw3=(u32x4){PKW(pB1,8),PKW(pB1,10),PKW(pB1,12),PKW(pB1,14)};
    SBAR(); pv(o,vb0+sl_cur,PAF(0),PAF(1),PAF(2),PAF(3)); }
  #undef PKW
  #undef PAF
  #undef VFR
  #undef PIN
  #undef MX3
  #undef GAPA
  #undef GAPB
  #undef EX
  #undef VRD
  #undef KRD
  #undef STEP
  #undef ENDW
  {auto rr=__builtin_amdgcn_permlane32_swap(__float_as_uint(l_reg),__float_as_uint(l_reg),false,false);l_reg=__uint_as_float(rr[0])+__uint_as_float(rr[1]);}
  if(hi==0)wsf[32+r32]=l_reg;asm volatile("s_waitcnt lgkmcnt(0)":::"memory");
  float rli[16];
  #pragma unroll
  for(int r=0;r<16;++r)rli[r]=__builtin_amdgcn_rcpf(wsf[32+crow(r,hi)]);
  unsigned char*Ow=(unsigned char*)O+(long)(qrow0+wid*QBLK)*1024+oc0;
  { bf16*stg=(bf16*)(shm+LDS_OST)+wid*2048;
    #pragma unroll
    for(int r=0;r<16;++r){const int orow=crow(r,hi);
      #pragma unroll
      for(int d0=0;d0<2;++d0)stg[orow*64+d0*32+r32]=(bf16)(cvtpk_s(o[d0][r]*rli[r],0.f)&0xffffu);}
    asm volatile("s_waitcnt lgkmcnt(0)":::"memory");
    #pragma unroll
    for(int i=0;i<4;++i){const int row=i*8+(lane>>3),ch=lane&7; const u32x4 v=*(const u32x4*)(stg+row*64+ch*8);
      *(v2u*)(Ow+(long)row*1024+ch*8)=pack8_fp8((f32x4){bf_lo(v.x),bf_hi(v.x),bf_lo(v.y),bf_hi(v.y)},(f32x4){bf_lo(v.z),bf_hi(v.z),bf_lo(v[3]),bf_hi(v[3])});} }
  asm volatile("s_waitcnt lgkmcnt(0)\n\ts_barrier":::"memory");
  #undef DMA_K
  #undef DMA_V
  #undef TROW0
  #undef CMASK
  #undef START
  #undef RESC
  #undef ROT
}
#undef SBAR
#undef WAIT_BAR
#undef KOFF
}

struct Args { const float* in[27]; float* out; unsigned char* ws; int ph_lo, ph_hi; };
struct Frame {
    LAS unsigned char* lds; unsigned char* ws; gu32* ctl; int wave, G, gw, NGW;
};
__device__ __forceinline__ int lthread(int wave) { return wave * 64 + lane_id_v(); }

template <int MODE>
__device__ __forceinline__ void conv_item(const float* W, int K, int N, bf16* WT, LAS float* scr, int item, int lane) {
    const int nblk = (N + 63) / 64, kb = item / nblk, nb = item % nblk, k0 = 64 * kb, n0 = 64 * nb;
    f32x4 v[16];
    const int cc = (lane & 15) * 4, rk = lane >> 4;
    const bool ok = (n0 + cc) < N;
#pragma unroll
    for (int i = 0; i < 16; ++i) v[i] = ok ? *(const f32x4*)(W + (size_t)(k0 + 4 * i + rk) * N + n0 + cc) : (f32x4){0.f, 0.f, 0.f, 0.f};
#pragma unroll
    for (int i = 0; i < 16; ++i) { LAS float* s = scr + (4 * i + rk) * 65 + cc; s[0] = v[i][0]; s[1] = v[i][1]; s[2] = v[i][2]; s[3] = v[i][3]; }
    LDS_WAIT(); asm volatile("" ::: "memory");
    const int c = lane & 7;
#pragma unroll
    for (int j = 0; j < 8; ++j) { const int n = (lane >> 3) + 8 * j; const LAS float* s = scr + (8 * c) * 65 + n;
        v4u o; o.x = pk2(s[0], s[65]); o.y = pk2(s[2 * 65], s[3 * 65]); o.z = pk2(s[4 * 65], s[5 * 65]); o.w = pk2(s[6 * 65], s[7 * 65]);
        const int ng = n0 + n; if (ng < N) { const int dr = (MODE == 1) ? ((ng >> 8) * 256 + (ng & 1) * 128 + ((ng >> 1) & 127)) : ng; *(v4u*)(WT + (size_t)dr * K + k0 + 8 * c) = o; } }
    LDS_WAIT(); asm volatile("" ::: "memory");
}

__device__ __forceinline__ void prologue(Frame& F, const Args& a) {
    const int f_tid = lthread(F.wave), f_lane = f_tid & 63;
    unsigned char* ws = F.ws;
    {
        LAS float* scr = (LAS float*)(F.lds + F.wave * 16640);
        struct M { const float* src; int K, N; size_t dst; };
        const int I_MIN = 16 * 11, I_QB = 6 * 24, I_KVB = 4 * 32, I_GQKV = 16 * 24;
        const int NSMALL = I_MIN + I_QB + I_KVB + I_GQKV;
        for (int it = F.gw; it < NSMALL; it += F.NGW) {
            int r = it;
            if (r < I_MIN) { conv_item<0>(a.in[11], D, MLA_IN, (bf16*)(ws + WS_WMIN), scr, r, f_lane); continue; } r -= I_MIN;
            if (r < I_QB) { conv_item<0>(a.in[13], MLA_QL, 1536, (bf16*)(ws + WS_WMQB), scr, r, f_lane); continue; } r -= I_QB;
            if (r < I_KVB) { conv_item<0>(a.in[15], MLA_KVL, 2048, (bf16*)(ws + WS_WMKVB), scr, r, f_lane); continue; } r -= I_KVB;
            conv_item<0>(a.in[17], D, GQA_QKV, (bf16*)(ws + WS_WGQKV), scr, r, f_lane);
        }
    }
    __syncthreads();
    {
        LAS float* cmax = (LAS float*)F.lds;
        LAS float* cinv = cmax + 512;
        LAS unsigned* scr8 = (LAS unsigned*)(F.lds + 4096) + F.wave * (64 * 33);
        const int cc = (f_lane & 15) * 4, rk = f_lane >> 4;
        constexpr int NGU = DEPTH * NE * 32, NDN = DEPTH * NE * 16, NWO = 4 * 16;
        for (int it = blockIdx.x; it < NGU + NDN + NWO; it += F.G) {
            const bool dn = it >= NGU; const bool wo = it >= NGU + NDN; const int q_ = wo ? it - NGU - NDN : (dn ? it - NGU : it); const int le = dn ? (q_ >> 4) : (q_ >> 5), strip = dn ? (q_ & 15) : (q_ & 31);
            const int N = dn ? 1024 : 2048;
            const float* wosrc = (le < 2) ? a.in[10] + (size_t)le * D * D : (le == 2 ? a.in[16] : a.in[20]);
            const float* W = (wo ? wosrc : (dn ? a.in[25] + (size_t)le * DFF * D : a.in[23] + (size_t)le * D * 2048)) + strip * 64 + cc;
            f32x4 v[32];
#pragma unroll
            for (int i = 0; i < 32; ++i) v[i] = *(const f32x4*)(W + (size_t)(F.wave * 128 + 16 * (i >> 2) + 4 * rk + (i & 3)) * N);
            f32x4 mx = (f32x4){0.f, 0.f, 0.f, 0.f};
#pragma unroll
            for (int i = 0; i < 32; ++i) { mx[0] = fmaxf(mx[0], fabsf(v[i][0])); mx[1] = fmaxf(mx[1], fabsf(v[i][1])); mx[2] = fmaxf(mx[2], fabsf(v[i][2])); mx[3] = fmaxf(mx[3], fabsf(v[i][3])); }
#pragma unroll
            for (int q = 0; q < 4; ++q) { mx[q] = fmaxf(mx[q], shx(mx[q], 16, f_lane)); mx[q] = fmaxf(mx[q], shx(mx[q], 32, f_lane)); }
            __syncthreads();
            if (rk == 0) { LAS float* d = cmax + F.wave * 64 + cc; d[0] = mx[0]; d[1] = mx[1]; d[2] = mx[2]; d[3] = mx[3]; }
            __syncthreads();
            const float target = dn ? 240.f : 127.f;
            if (f_tid < 64) { float m8 = 0.f;
#pragma unroll
                for (int w = 0; w < 8; ++w) m8 = fmaxf(m8, cmax[w * 64 + f_tid]);
                const int ng = strip * 64 + f_tid, dr = dn ? ng : (ng >> 8) * 256 + (ng & 1) * 128 + ((ng >> 1) & 127);
                float* sc = wo ? (float*)(ws + WS_SWO) + (size_t)le * 1024 : (dn ? (float*)(ws + WS_SWDN) + (size_t)le * 1024 : (float*)(ws + WS_SWGU) + (size_t)le * 2048);
                sc[dr] = (m8 > 0.f) ? m8 / target : 1.f;
                cinv[f_tid] = (m8 > 0.f) ? target / m8 : 0.f; }
            __syncthreads();
            const f32x4 iv = *(const LAS f32x4*)(cinv + cc);
#pragma unroll
            for (int ip = 0; ip < 8; ++ip) {
#pragma unroll
                for (int q = 0; q < 4; ++q) { unsigned w = 0;
                    if (dn) { int t = __builtin_amdgcn_cvt_pk_fp8_f32(v[4 * ip][q] * iv[q], v[4 * ip + 1][q] * iv[q], 0, false); t = __builtin_amdgcn_cvt_pk_fp8_f32(v[4 * ip + 2][q] * iv[q], v[4 * ip + 3][q] * iv[q], t, true); w = (unsigned)t; }
                    else w = q8x4(v[4 * ip][q], v[4 * ip + 1][q], v[4 * ip + 2][q], v[4 * ip + 3][q], iv[q]);
                    scr8[(cc + q) * 33 + 4 * ip + rk] = w; } }
            LDS_WAIT(); asm volatile("" ::: "memory");
            { const int c8 = f_lane & 7;
              unsigned char* dst = wo ? (unsigned char*)(ws + WS_WO8) + (size_t)le * 1024 * 1024 : (dn ? (unsigned char*)(ws + WS_WDN) + (size_t)le * 1024 * 1024 : (unsigned char*)(ws + WS_WGU) + (size_t)le * 2048 * 1024);
#pragma unroll
              for (int jp = 0; jp < 8; ++jp) { const int n = (f_lane >> 3) + 8 * jp; const LAS unsigned* sp = scr8 + n * 33 + 4 * c8;
                  v4u o; o.x = sp[0]; o.y = sp[1]; o.z = sp[2]; o[3] = sp[3];
                  const int ng = strip * 64 + n, dr = dn ? ng : (ng >> 8) * 256 + (ng & 1) * 128 + ((ng >> 1) & 127);
                  *(v4u*)(dst + (size_t)dr * 1024 + F.wave * 128 + 16 * c8) = o; } }
            LDS_WAIT(); asm volatile("" ::: "memory");
        }
        __syncthreads();
    }
    const int gtid = blockIdx.x * 512 + f_tid, gthreads = F.G * 512;
    for (int i = gtid; i < (MLA_IN_PAD - MLA_IN) * D / 8; i += gthreads) ((v4u*)((bf16*)(ws + WS_WMIN) + (size_t)MLA_IN * D))[i] = (v4u){0u, 0u, 0u, 0u};
    {
        unsigned* MA8 = (unsigned*)(ws + WS_MA);
        for (int i4 = gtid; i4 < 256 * 256 / 4; i4 += gthreads) { float v4_[4];
#pragma unroll
            for (int jx = 0; jx < 4; ++jx) { const int i = 4 * i4 + jx; const int row = i >> 8, col = i & 255, jp = row >> 7, pp = (row >> 6) & 1, k1 = row & 63, j = col >> 7, pt = (col >> 6) & 1, l1 = col & 63;
                float v = 0.f; if (j == jp) { const float x = 2.f * (float)((k1 * l1) & 63) / 64.f; const float cs = cospif(x), sn = sinpif(x); v = (pp == 0) ? (pt == 0 ? cs : sn) : (pt == 0 ? -sn : cs); }
                v4_[jx] = v; }
            int t = __builtin_amdgcn_cvt_pk_fp8_f32(v4_[0], v4_[1], 0, false); t = __builtin_amdgcn_cvt_pk_fp8_f32(v4_[2], v4_[3], t, true); MA8[i4] = (unsigned)t; }
        unsigned* DC8 = (unsigned*)(ws + WS_DC); const float sc = 64.0f / sqrtf(256.f * 128.f);
        for (int i4 = gtid; i4 < 256 * 512 / 4; i4 += gthreads) { float v4_[4];
#pragma unroll
            for (int jx = 0; jx < 4; ++jx) { const int i = 4 * i4 + jx; const int k = i >> 9, col = i & 511, pt = col >> 8, l = col & 255; const float x = 2.f * (float)((k * l) & 255) / 256.f; v4_[jx] = (pt == 0 ? cospif(x) : sinpif(x)) * sc; }
            int t = __builtin_amdgcn_cvt_pk_fp8_f32(v4_[0], v4_[1], 0, false); t = __builtin_amdgcn_cvt_pk_fp8_f32(v4_[2], v4_[3], t, true); DC8[i4] = (unsigned)t; }
        unsigned* MC8 = (unsigned*)(ws + WS_MC); const float sl = 256.0f / sqrtf(4096.f * 128.f);
        for (int i4 = gtid; i4 < 16 * 256 * 512 / 4; i4 += gthreads) { float v4_[4];
#pragma unroll
            for (int j = 0; j < 4; ++j) { const int i = 4 * i4 + j; const int kq = i >> 17, row = (i >> 9) & 255, col = i & 511, kkp = row >> 6, k2 = row & 63, kk = col >> 7, pp = (col >> 6) & 1, l2 = col & 63;
                float v = 0.f; if (kk == kkp) { const int k = 4 * kq + kkp + 64 * k2; const float x = 2.f * (float)((l2 * k) & 4095) / 4096.f; v = (pp == 0 ? cospif(x) : sinpif(x)) * sl; }
                v4_[j] = v; }
            int t = __builtin_amdgcn_cvt_pk_fp8_f32(v4_[0], v4_[1], 0, false); t = __builtin_amdgcn_cvt_pk_fp8_f32(v4_[2], v4_[3], t, true); MC8[i4] = (unsigned)t; }
        float* RM = (float*)(ws + WS_ROPE); float* RG = RM + 2048;
        for (int i = gtid; i < 64 * 8; i += gthreads) { const int pos = i >> 3, f = i & 7; const float inv = powf(10000.f, -(float)f / 8.f); float s, c; sincosf((float)pos * inv, &s, &c); RM[2 * i] = c; RM[2 * i + 1] = s; }
        for (int i = gtid; i < 64 * 16; i += gthreads) { const int pos = i >> 4, f = i & 15; const float inv = powf(10000.f, -(float)f / 16.f); float s, c; sincosf((float)pos * inv, &s, &c); RG[2 * i] = c; RG[2 * i + 1] = s; }
        float* WRT = (float*)(ws + WS_WRT);
        for (int i = gtid; i < DEPTH * NE * D; i += gthreads) { const int l = i >> 15, e = (i >> 10) & 31, k = i & 1023; WRT[i] = a.in[21][((size_t)l * D + k) * NE + e]; }
        float* BG = (float*)(ws + WS_BGU);
        for (int i = gtid; i < DEPTH * NE * 2048; i += gthreads) { const int le = i >> 11, q = i & 2047, pn = q >> 8, s = (q >> 7) & 1, jj = q & 127; BG[i] = a.in[24][(size_t)le * 2048 + 2 * (pn * 128 + jj) + s]; }
    }
    __syncthreads();
    {
        LAS float* wl = (LAS float*)F.lds;
        LAS float* tc = wl + 2048; LAS float* ts = tc + 128;
        if (f_tid < 128) { const float x = 2.f * (float)f_tid / 128.f; tc[f_tid] = cospif(x); ts[f_tid] = -sinpif(x); }
        for (int it = blockIdx.x; it < 2 * 8 * 64; it += F.G) { const int j = it >> 9, g = (it >> 6) & 7, kb = it & 63;
            __syncthreads();
            { const int kk = f_tid >> 5, c4 = (f_tid & 31) * 4; const f32x4 w = *(const f32x4*)(a.in[9] + ((size_t)j * D + kb * 16 + kk) * D + g * 128 + c4);
              LAS float* d = wl + c4 * 16 + kk; d[0] = w[0]; d[16] = w[1]; d[32] = w[2]; d[48] = w[3]; }
            __syncthreads();
            const int cl = f_tid & 255, m = cl >> 1, part = cl & 1, kh = f_tid >> 8; const LAS float* tw = part ? ts : tc;
            float accv[8];
#pragma unroll
            for (int q = 0; q < 8; ++q) accv[q] = 0.f;
            for (int jj = 0; jj < 128; ++jj) { const float t = tw[(m * jj) & 127]; const f32x4 wa = *(const LAS f32x4*)(wl + jj * 16 + kh * 8), wb = *(const LAS f32x4*)(wl + jj * 16 + kh * 8 + 4);
                accv[0] += wa[0] * t; accv[1] += wa[1] * t; accv[2] += wa[2] * t; accv[3] += wa[3] * t; accv[4] += wb[0] * t; accv[5] += wb[1] * t; accv[6] += wb[2] * t; accv[7] += wb[3] * t; }
            v4u o; o.x = pk2(accv[0], accv[1]); o.y = pk2(accv[2], accv[3]); o.z = pk2(accv[4], accv[5]); o.w = pk2(accv[6], accv[7]);
            *(v4u*)((bf16*)(ws + WS_WFIN) + ((size_t)j * 2048 + g * 256 + cl) * D + kb * 16 + kh * 8) = o;
        }
        __syncthreads();
    }
    {
        LAS float* S = (LAS float*)F.lds;
        LAS float* red = S + 9 * 1024;
        for (int i = f_tid; i < 9 * 1024; i += 512) { const int r = i >> 10, k = i & 1023; const float v = (r < 8) ? a.in[1][r * D + k] : a.in[3][k]; S[i] = v / (1.f + __expf(-v)); }
        __syncthreads();
        for (int it = blockIdx.x; it < DEPTH * 96; it += F.G) { const int l = it / 96, n0 = (it % 96) * 64;
            const float* wp = a.in[4] + ((size_t)l * D + F.wave * 128) * (NMOD * D) + n0 + f_lane;
            float accv[9];
#pragma unroll
            for (int r = 0; r < 9; ++r) accv[r] = 0.f;
            for (int k0 = 0; k0 < 128; k0 += 32) { float wv[32];
#pragma unroll
                for (int k = 0; k < 32; ++k) wv[k] = wp[(size_t)(k0 + k) * (NMOD * D)];
#pragma unroll
                for (int k = 0; k < 32; ++k)
#pragma unroll
                    for (int r = 0; r < 9; ++r) accv[r] += S[r * 1024 + F.wave * 128 + k0 + k] * wv[k]; }
#pragma unroll
            for (int r = 0; r < 9; ++r) red[(F.wave * 9 + r) * 64 + f_lane] = accv[r];
            __syncthreads();
            for (int i = f_tid; i < 9 * 64; i += 512) { const int r = i >> 6, ln = i & 63; float s = a.in[5][(size_t)l * (NMOD * D) + n0 + ln];
#pragma unroll
                for (int w = 0; w < 8; ++w) s += red[(w * 9 + r) * 64 + ln];
                ((float*)(ws + WS_MOD))[((size_t)l * 9 + r) * (NMOD * D) + n0 + ln] = s; }
            __syncthreads();
        }
    }
}

__device__ __forceinline__ void load_row(const float* p, int lane, f32x4 (&v)[4]) {
#pragma unroll
    for (int j = 0; j < 4; ++j) v[j] = ((const f32x4*)p)[lane + 64 * j];
}
__device__ __forceinline__ void load_row_bf(const bf16* p, int lane, f32x4 (&v)[4]) {
#pragma unroll
    for (int j = 0; j < 4; ++j) { const v2u w = ((const v2u*)p)[lane + 64 * j]; v[j] = (f32x4){bf_lo(w.x), bf_hi(w.x), bf_lo(w.y), bf_hi(w.y)}; }
}
__device__ __forceinline__ void norm_mod(f32x4 (&v)[4], const float* g, const float* shift, const float* scale, int lane) {
    float s = 0.f;
#pragma unroll
    for (int j = 0; j < 4; ++j) s += (v[j][0] * v[j][0] + v[j][1] * v[j][1]) + (v[j][2] * v[j][2] + v[j][3] * v[j][3]);
    const float rstd = rsqrtf(wave_sum(s, lane) * (1.f / D) + EPS);
#pragma unroll
    for (int j = 0; j < 4; ++j) { const f32x4 gv = ((const f32x4*)g)[lane + 64 * j], sh = ((const f32x4*)shift)[lane + 64 * j], sc = ((const f32x4*)scale)[lane + 64 * j];
        v[j] = (v[j] * rstd * gv) * (sc + 1.f) + sh; }
}
__device__ __forceinline__ void store_row_bf16(bf16* p, int lane, const f32x4 (&v)[4]) {
#pragma unroll
    for (int j = 0; j < 4; ++j) { v2u w; w.x = pk2(v[j][0], v[j][1]); w.y = pk2(v[j][2], v[j][3]); ((v2u*)p)[lane + 64 * j] = w; }
}

__device__ __forceinline__ float store_row_i8(unsigned char* p, int lane, const f32x4 (&v)[4]) {
    float am = 0.f;
#pragma unroll
    for (int j = 0; j < 4; ++j) am = fmaxf(fmaxf(am, fmaxf(fabsf(v[j][0]), fabsf(v[j][1]))), fmaxf(fabsf(v[j][2]), fabsf(v[j][3])));
    unsigned k = __float_as_uint(am);
    { unsigned t;
      t = (unsigned)__builtin_amdgcn_mov_dpp((int)k, 0xb1, 0xf, 0xf, false); k = k > t ? k : t;
      t = (unsigned)__builtin_amdgcn_mov_dpp((int)k, 0x4e, 0xf, 0xf, false); k = k > t ? k : t;
      t = (unsigned)__builtin_amdgcn_mov_dpp((int)k, 0x124, 0xf, 0xf, false); k = k > t ? k : t;
      t = (unsigned)__builtin_amdgcn_mov_dpp((int)k, 0x128, 0xf, 0xf, false); k = k > t ? k : t;
      const unsigned a = (unsigned)__builtin_amdgcn_readlane((int)k, 0), b = (unsigned)__builtin_amdgcn_readlane((int)k, 16), c = (unsigned)__builtin_amdgcn_readlane((int)k, 32), d = (unsigned)__builtin_amdgcn_readlane((int)k, 48);
      const unsigned ab = a > b ? a : b, cd = c > d ? c : d; k = ab > cd ? ab : cd; }
    const float amax = __uint_as_float(k);
    const float qscale = amax > 0.f ? amax * (1.f / 127.f) : 1.f, qinv = amax > 0.f ? 127.f / amax : 0.f;
#pragma unroll
    for (int j = 0; j < 4; ++j) ((unsigned*)p)[lane + 64 * j] = q8x4(v[j][0], v[j][1], v[j][2], v[j][3], qinv);
    return qscale;
}
__device__ __forceinline__ void quant_rows(Frame& F, const bf16* src, unsigned char* dst, float* scale, int R) {
    const int f_lane = lthread(F.wave) & 63;
    for (int r = F.gw; r < R; r += F.NGW) { f32x4 v[4]; load_row_bf(src + (size_t)r * 1024, f_lane, v);
        const float sc = store_row_i8(dst + (size_t)r * 1024, f_lane, v); if (f_lane == 0) scale[r] = sc; }
}
__device__ __forceinline__ void rp_norm1(Frame& F, const Args& a, int l, int row_lo) {
    const int f_tid = lthread(F.wave), f_lane = f_tid & 63;
    const bf16* X = (const bf16*)(F.ws + WS_X); bf16* H = (bf16*)(F.ws + WS_H); const float* MOD = (const float*)(F.ws + WS_MOD) + (size_t)l * 9 * (NMOD * D);
    for (int row = row_lo + F.gw; row < NT; row += F.NGW) { f32x4 v[4];
        if (l == 0) { load_row(row < NC ? a.in[2] + (size_t)row * D : a.in[0] + (size_t)(row - NC) * D, f_lane, v);
            store_row_bf16((bf16*)(F.ws + WS_X) + (size_t)row * D, f_lane, v); }
        else load_row_bf(X + (size_t)row * D, f_lane, v);
        const float* m = MOD + (size_t)modrow_of(row) * (NMOD * D);
        norm_mod(v, a.in[6] + (size_t)l * D, m, m + D, f_lane);
        const float sc = store_row_i8((unsigned char*)H + (size_t)row * D, f_lane, v); if (f_lane == 0) ((float*)(F.ws + WS_SH))[row] = sc; }
}

__device__ __forceinline__ void rp_norm1_l0(Frame& F, const Args& a) {
    const int f_tid = lthread(F.wave), f_lane = f_tid & 63;
    LAS float* LM = (LAS float*)F.lds; const float* MOD = (const float*)(F.ws + WS_MOD);
    __syncthreads();
    for (int i = f_tid; i < 1024; i += 512) LM[i] = a.in[6][i];
    for (int i = f_tid; i < 18 * 1024; i += 512) LM[1024 + i] = MOD[(size_t)(i >> 11) * (NMOD * D) + (i & 2047)];
    __syncthreads();
    const int st = F.NGW, row0 = F.gw;
    if (row0 >= NT) return;
    const int n = (NT - row0 + st - 1) / st, rlast = row0 + (n - 1) * st;
#define NROW(i) ((row0 + (i) * st) <= rlast ? (row0 + (i) * st) : rlast)
#define NSRC(r) ((r) < NC ? a.in[2] + (size_t)(r) * D : a.in[0] + (size_t)((r) - NC) * D)
    f32x4 R0[4], R1[4], R2[4];
    { const int r0 = NROW(0), r1 = NROW(1), r2 = NROW(2); load_row(NSRC(r0), f_lane, R0); load_row(NSRC(r1), f_lane, R1); load_row(NSRC(r2), f_lane, R2); }
#define NSTEP(R, i_) do { if ((i_) < n) { const int row = NROW(i_); \
            store_row_bf16((bf16*)(F.ws + WS_X) + (size_t)row * D, f_lane, R); \
            float s_ = 0.f; _Pragma("unroll") for (int j = 0; j < 4; ++j) s_ += (R[j][0] * R[j][0] + R[j][1] * R[j][1]) + (R[j][2] * R[j][2] + R[j][3] * R[j][3]); \
            const float rstd_ = rsqrtf(wave_sum(s_, f_lane) * (1.f / D) + EPS); const LAS f32x4* mp_ = (const LAS f32x4*)(LM + 1024 + modrow_of(row) * 2048); \
            _Pragma("unroll") for (int j = 0; j < 4; ++j) { const f32x4 gv = ((const LAS f32x4*)LM)[f_lane + 64 * j], sh = mp_[f_lane + 64 * j], sc = mp_[256 + f_lane + 64 * j]; R[j] = (R[j] * rstd_ * gv) * (sc + 1.f) + sh; } \
            const float sc_ = store_row_i8((unsigned char*)(F.ws + WS_H) + (size_t)row * D, f_lane, R); if (f_lane == 0) ((float*)(F.ws + WS_SH))[row] = sc_; } \
        { const int rn_ = NROW((i_) + 3); load_row(NSRC(rn_), f_lane, R); } } while (0)
    for (int i = 0; i < n; i += 3) { NSTEP(R0, i); NSTEP(R1, i + 1); NSTEP(R2, i + 2); }
#undef NSTEP
#undef NSRC
#undef NROW
}

#if MK_N2V2
constexpr int LDS_LIST = LDS_MISC + 768;
__device__ __forceinline__ unsigned row16_max(unsigned k) {
    unsigned t;
    t = (unsigned)__builtin_amdgcn_mov_dpp((int)k, 0xb1, 0xf, 0xf, false); k = k > t ? k : t;
    t = (unsigned)__builtin_amdgcn_mov_dpp((int)k, 0x4e, 0xf, 0xf, false); k = k > t ? k : t;
    t = (unsigned)__builtin_amdgcn_mov_dpp((int)k, 0x124, 0xf, 0xf, false); k = k > t ? k : t;
    t = (unsigned)__builtin_amdgcn_mov_dpp((int)k, 0x128, 0xf, 0xf, false); k = k > t ? k : t;
    return k;
}
__device__ __forceinline__ unsigned wave_max_u(unsigned k) {
    k = row16_max(k);
    const unsigned a = (unsigned)__builtin_amdgcn_readlane((int)k, 0), b = (unsigned)__builtin_amdgcn_readlane((int)k, 16), c = (unsigned)__builtin_amdgcn_readlane((int)k, 32), d = (unsigned)__builtin_amdgcn_readlane((int)k, 48);
    const unsigned ab = a > b ? a : b, cd = c > d ? c : d; return ab > cd ? ab : cd;
}
__device__ __forceinline__ float key_val(unsigned m) { const unsigned u = m & ~31u; return __builtin_bit_cast(float, (u & 0x80000000u) ? (u ^ 0x80000000u) : ~u); }
constexpr int N2_WPITCH = 2064;
constexpr int N2_GM = 32 * N2_WPITCH;
constexpr int N2_LIST = N2_GM + 5 * 8192;
__device__ __forceinline__ void rp_norm2_router(Frame& F, const Args& a, int l, int row_lo) {
    const int f_tid = lthread(F.wave), f_lane = f_tid & 63;
    const bf16* X = (const bf16*)(F.ws + WS_X); unsigned char* H8 = (unsigned char*)(F.ws + WS_H); const float* MOD = (const float*)(F.ws + WS_MOD) + (size_t)l * 9 * (NMOD * D);
    LAS unsigned char* WT = F.lds;
    { const f32x4* src = (const f32x4*)((const float*)(F.ws + WS_WRT) + (size_t)l * NE * D); f32x4 tv[16];
#pragma unroll
      for (int i = 0; i < 16; ++i) tv[i] = src[f_tid + 512 * i];
#pragma unroll
      for (int i = 0; i < 16; ++i) { const int i4 = f_tid + 512 * i, e = i4 >> 8, k4 = (i4 & 255) * 4; v2u w; w.x = pk2(tv[i][0], tv[i][1]); w.y = pk2(tv[i][2], tv[i][3]); *(LAS v2u*)(WT + e * N2_WPITCH + k4 * 2) = w; } }
    LAS int* lcnt = (LAS int*)(F.lds + LDS_TT); LAS int* lbase = lcnt + 32;
    if (f_tid < 32) lcnt[f_tid] = 0;
    const int ngroups = (NT - row_lo) >> 5;
    const int g = F.wave * F.G + (int)blockIdx.x;
    const bool active = (F.wave < 5) && (g < ngroups);
    LAS float* GM = (LAS float*)(F.lds + N2_GM + (F.wave < 5 ? F.wave : 0) * 8192); LAS float* SH = GM + 1024;
    LAS v4u* list = (LAS v4u*)(F.lds + N2_LIST + (F.wave < 5 ? F.wave : 0) * (128 * 16 + 128)); LAS float* lsc = (LAS float*)(list + 128);
    const int r = f_lane & 31, kh = f_lane >> 5;
    const int row = row_lo + g * 32 + r;
    float msh = 0.f;
    if (active) {
        const float* m = MOD + (size_t)modrow_of(row_lo + g * 32) * (NMOD * D); const float* gf = a.in[7] + (size_t)l * D;
#pragma unroll
        for (int j = 0; j < 4; ++j) { const f32x4 gv = ((const f32x4*)gf)[f_lane + 64 * j], sc = ((const f32x4*)(m + 4 * D))[f_lane + 64 * j], sv = ((const f32x4*)(m + 3 * D))[f_lane + 64 * j];
            ((LAS f32x4*)GM)[f_lane + 64 * j] = gv * (sc + 1.f); ((LAS f32x4*)SH)[f_lane + 64 * j] = sv;
            msh = fmaxf(fmaxf(msh, fmaxf(fabsf(sv[0]), fabsf(sv[1]))), fmaxf(fabsf(sv[2]), fabsf(sv[3]))); }
        msh = __uint_as_float(wave_max_u(__float_as_uint(msh)));
    }
    __syncthreads();
    if (active) {
        const bf16* xr = X + (size_t)row * D + 16 * kh;
        float ssq = 0.f, mxg = 0.f;
#pragma unroll 1
        for (int c0 = 0; c0 < 32; c0 += 8) { v4u xa[8], xb[8];
#pragma unroll
            for (int i = 0; i < 8; ++i) { xa[i] = *(const v4u*)(xr + 32 * (c0 + i)); xb[i] = *(const v4u*)(xr + 32 * (c0 + i) + 8); }
#pragma unroll
            for (int i = 0; i < 8; ++i) { const LAS f32x4* gp = (const LAS f32x4*)(GM + 32 * (c0 + i) + 16 * kh);
                const f32x4 g0 = gp[0], g1 = gp[1], g2 = gp[2], g3 = gp[3];
                const unsigned wa[4] = {xa[i].x, xa[i].y, xa[i].z, xa[i][3]}, wb[4] = {xb[i].x, xb[i].y, xb[i].z, xb[i][3]};
#pragma unroll
                for (int q = 0; q < 4; ++q) { const float x0 = bf_lo(wa[q]), x1 = bf_hi(wa[q]), x2 = bf_lo(wb[q]), x3 = bf_hi(wb[q]);
                    ssq += x0 * x0 + x1 * x1 + x2 * x2 + x3 * x3;
                    const float ga = (q < 2 ? g0 : g1)[(2 * q) & 3], gb = (q < 2 ? g0 : g1)[(2 * q + 1) & 3], gc = (q < 2 ? g2 : g3)[(2 * q) & 3], gd = (q < 2 ? g2 : g3)[(2 * q + 1) & 3];
                    mxg = fmaxf(fmaxf(mxg, fmaxf(fabsf(x0 * ga), fabsf(x1 * gb))), fmaxf(fabsf(x2 * gc), fabsf(x3 * gd))); } } }
        { auto rr = __builtin_amdgcn_permlane32_swap(__float_as_uint(ssq), __float_as_uint(ssq), false, false); ssq = __uint_as_float(rr[0]) + __uint_as_float(rr[1]); }
        { auto rr = __builtin_amdgcn_permlane32_swap(__float_as_uint(mxg), __float_as_uint(mxg), false, false); mxg = fmaxf(__uint_as_float(rr[0]), __uint_as_float(rr[1])); }
        const float rstd = rsqrtf(ssq * (1.f / D) + EPS);
        const float bound = mxg * rstd + msh;
        const float qscale = bound > 0.f ? bound * (1.f / 127.f) : 1.f, qinv = bound > 0.f ? 127.f / bound : 0.f;
        f32x16 acc = f32x16{};
        unsigned char* hrow = H8 + (size_t)row * D + 16 * kh;
        const LAS unsigned char* wrow = WT + r * N2_WPITCH + 32 * kh;
#pragma unroll 1
        for (int c0 = 0; c0 < 32; c0 += 4) { v4u xa[4], xb[4];
#pragma unroll
            for (int i = 0; i < 4; ++i) { xa[i] = *(const v4u*)(xr + 32 * (c0 + i)); xb[i] = *(const v4u*)(xr + 32 * (c0 + i) + 8); }
#pragma unroll
            for (int i = 0; i < 4; ++i) { const int c = c0 + i;
                const LAS f32x4* gp = (const LAS f32x4*)(GM + 32 * c + 16 * kh); const LAS f32x4* sp = (const LAS f32x4*)(SH + 32 * c + 16 * kh);
                const bf16x8 w0 = *(const LAS bf16x8*)(wrow + 64 * c), w1 = *(const LAS bf16x8*)(wrow + 64 * c + 16);
                float h[16];
                const unsigned wa[4] = {xa[i].x, xa[i].y, xa[i].z, xa[i][3]}, wb[4] = {xb[i].x, xb[i].y, xb[i].z, xb[i][3]};
#pragma unroll
                for (int q = 0; q < 4; ++q) { h[2 * q] = bf_lo(wa[q]); h[2 * q + 1] = bf_hi(wa[q]); h[8 + 2 * q] = bf_lo(wb[q]); h[8 + 2 * q + 1] = bf_hi(wb[q]); }
#pragma unroll
                for (int q = 0; q < 4; ++q) { const f32x4 gq = gp[q], sq = sp[q];
#pragma unroll
                    for (int e = 0; e < 4; ++e) h[4 * q + e] = (h[4 * q + e] * rstd) * gq[e] + sq[e]; }
                v4u o8;
#pragma unroll
                for (int q = 0; q < 4; ++q) o8[q] = q8x4(h[4 * q], h[4 * q + 1], h[4 * q + 2], h[4 * q + 3], qinv);
                *(v4u*)(hrow + 32 * c) = o8;
                v4u hi0, hi1, lo0, lo1;
#pragma unroll
                for (int q = 0; q < 4; ++q) { hi0[q] = pk2(h[2 * q], h[2 * q + 1]); hi1[q] = pk2(h[8 + 2 * q], h[8 + 2 * q + 1]); }
#pragma unroll
                for (int q = 0; q < 4; ++q) { lo0[q] = pk2(h[2 * q] - bf_lo(hi0[q]), h[2 * q + 1] - bf_hi(hi0[q])); lo1[q] = pk2(h[8 + 2 * q] - bf_lo(hi1[q]), h[8 + 2 * q + 1] - bf_hi(hi1[q])); }
                acc = __builtin_amdgcn_mfma_f32_32x32x16_bf16(w0, __builtin_bit_cast(bf16x8, hi0), acc, 0, 0, 0);
                acc = __builtin_amdgcn_mfma_f32_32x32x16_bf16(w0, __builtin_bit_cast(bf16x8, lo0), acc, 0, 0, 0);
                acc = __builtin_amdgcn_mfma_f32_32x32x16_bf16(w1, __builtin_bit_cast(bf16x8, hi1), acc, 0, 0, 0);
                acc = __builtin_amdgcn_mfma_f32_32x32x16_bf16(w1, __builtin_bit_cast(bf16x8, lo1), acc, 0, 0, 0); } }
        float val[32];
        const float* br = a.in[22] + (size_t)l * NE;
#pragma unroll
        for (int j = 0; j < 16; ++j) { auto rr = __builtin_amdgcn_permlane32_swap(__float_as_uint(acc[j]), __float_as_uint(acc[j]), false, false);
            const int e0 = (j & 3) + 8 * (j >> 2); val[e0] = __uint_as_float(rr[0]) + br[e0]; val[e0 + 4] = __uint_as_float(rr[1]) + br[e0 + 4]; }
        unsigned taken = 0u; int be[4]; float bv[4];
#pragma unroll
        for (int k = 0; k < 4; ++k) { float best = -INFINITY; int bi = 0;
#pragma unroll
            for (int e = 0; e < 32; ++e) { const bool cnd = !((taken >> e) & 1u) && (val[e] > best); best = cnd ? val[e] : best; bi = cnd ? e : bi; }
            taken |= 1u << bi; be[k] = bi; bv[k] = best; }
        const float e1 = __expf(bv[1] - bv[0]), e2 = __expf(bv[2] - bv[0]), e3 = __expf(bv[3] - bv[0]); const float inv = 1.f / (1.f + e1 + e2 + e3);
        if (kh == 0) { const float ww[4] = {inv, e1 * inv, e2 * inv, e3 * inv};
#pragma unroll
            for (int k = 0; k < 4; ++k) { const int lr = __hip_atomic_fetch_add(lcnt + be[k], 1, __ATOMIC_RELAXED, __HIP_MEMORY_SCOPE_WORKGROUP);
                LAS unsigned* ep = (LAS unsigned*)(list + r * 4 + k); ep[0] = (unsigned)(row * 4 + k); ep[1] = (unsigned)be[k]; ep[2] = (unsigned)lr; ep[3] = __builtin_bit_cast(unsigned, ww[k]); }
            lsc[r] = qscale; }
    }
    __syncthreads();
    if (f_tid < 32) { const int c = lcnt[f_tid]; lbase[f_tid] = c ? (int)__hip_atomic_fetch_add((unsigned*)(F.ctl + CW_CNT + (l * 32 + f_tid) * 16), (unsigned)c, RLX_AGENT) : 0; }
    __syncthreads();
    if (active) {
        int* te = (int*)(F.ws + WS_TE); int* trank = (int*)(F.ws + WS_TRANK); int* stok = (int*)(F.ws + WS_STOK); float* sw = (float*)(F.ws + WS_SW); float* ssc = (float*)(F.ws + WS_SSC);
#pragma unroll
        for (int i = f_lane; i < 128; i += 64) { const LAS unsigned* ep = (const LAS unsigned*)(list + i); const unsigned rowk = ep[0], ex = ep[1], lr = ep[2]; const float wv = __builtin_bit_cast(float, ep[3]);
            const int rk = lbase[ex] + (int)lr;
            stok[(size_t)ex * CAP + rk] = (int)(rowk >> 2); sw[(size_t)ex * CAP + rk] = wv; ssc[(size_t)ex * CAP + rk] = lsc[i >> 2]; te[rowk] = (int)ex; trank[rowk] = rk; }
    }
}

#endif
__device__ __forceinline__ void moe_table(Frame& F, int l) {
    const int f_tid = lthread(F.wave), f_lane = f_tid & 63;
    LAS int* TT = (LAS int*)(F.lds + LDS_TT); LAS int* CN = TT + 64; LAS int* TE = (LAS int*)(F.lds + LDS_TE);
    __syncthreads();
    if (f_tid < 64) {
        const int c = (f_lane < 32) ? (int)__hip_atomic_load((unsigned*)(F.ctl + CW_CNT + (l * 32 + (f_lane & 31)) * 16), RLX_AGENT) : 0;
        const int tl = (c + 255) >> 8; int v = tl;
#pragma unroll
        for (int o = 1; o < 32; o <<= 1) { const int n = __builtin_amdgcn_ds_bpermute((f_lane >= o ? f_lane - o : f_lane) << 2, v); if (f_lane >= o) v += n; }
        if (f_lane < 32) { CN[f_lane] = c; TT[f_lane] = v - tl; if (f_lane == 31) TT[32] = v; }
    }
    __syncthreads();
    for (int t = f_tid; t < MAXTILES; t += 512) { int lo = 0, hi = 32;
#pragma unroll
        for (int k = 0; k < 5; ++k) { const int mid = (lo + hi) >> 1; if (TT[mid] <= t) lo = mid; else hi = mid; }
        TE[t] = lo; }
    __syncthreads();
}

#if MK_CBV2
struct CombRow { v4u x[2]; v4u y[4]; };
__device__ __forceinline__ void comb_issue(CombRow& R, const bf16* X, const unsigned char* Y, const LAS int* TT, int row, const v4u te4, const v4u tr4, int lane) {
    const unsigned ee[4] = {te4[0], te4[1], te4[2], te4[3]}, rr[4] = {tr4[0], tr4[1], tr4[2], tr4[3]};
#pragma unroll
    for (int k = 0; k < 4; ++k) { const size_t slot = (size_t)TT[ee[k]] * 256 + rr[k]; R.y[k] = *(const v4u*)(Y + slot * 1024 + 16 * lane); }
    const bf16* xp = X + (size_t)row * D + 16 * lane; R.x[0] = *(const v4u*)xp; R.x[1] = *(const v4u*)(xp + 8);
}
constexpr int CB_G5 = 0, CB_MS = 9 * 1024, CB_GX = 27 * 1024, CB_FLOATS = 28 * 1024;
__device__ __forceinline__ int cb_pos(int e) { return ((e >> 2) & 3) * 256 + (e >> 4) * 4 + (e & 3); }
__device__ __forceinline__ void comb_finish(const CombRow& R, Frame& F, const Args& a, int l, int row, int lane, bool lastl) {
    bf16* X = (bf16*)(F.ws + WS_X); unsigned char* H8 = (unsigned char*)(F.ws + WS_H); const LAS float* LM = (const LAS float*)F.lds;
    const int mr = modrow_of(row); const LAS f32x4* g5 = (const LAS f32x4*)(LM + CB_G5 + mr * 1024) + lane;
    float v[16];
#pragma unroll
    for (int w = 0; w < 4; ++w) { f32x4 s = (f32x4){0.f, 0.f, 0.f, 0.f};
#pragma unroll
        for (int k = 0; k < 4; ++k) { const int yw = (int)R.y[k][w]; const f32x2 lo = __builtin_amdgcn_cvt_pk_f32_fp8(yw, false), hi = __builtin_amdgcn_cvt_pk_f32_fp8(yw, true); s[0] += lo[0]; s[1] += lo[1]; s[2] += hi[0]; s[3] += hi[1]; }
        const f32x4 gv = g5[w * 64]; const unsigned x0 = R.x[w >> 1][(2 * w) & 3], x1 = R.x[w >> 1][(2 * w + 1) & 3];
        v[4 * w] = bf_lo(x0) + gv[0] * s[0] * 0.125f; v[4 * w + 1] = bf_hi(x0) + gv[1] * s[1] * 0.125f; v[4 * w + 2] = bf_lo(x1) + gv[2] * s[2] * 0.125f; v[4 * w + 3] = bf_hi(x1) + gv[3] * s[3] * 0.125f; }
    float ss = 0.f;
#pragma unroll
    for (int i = 0; i < 16; ++i) ss += v[i] * v[i];
    const float rstd = rsqrtf(wave_sum(ss, lane) * (1.f / D) + EPS);
    if (!lastl) {
        bf16* xo = X + (size_t)row * D + 16 * lane;
        { v4u o0, o1;
#pragma unroll
          for (int q = 0; q < 4; ++q) { o0[q] = pk2(v[2 * q], v[2 * q + 1]); o1[q] = pk2(v[8 + 2 * q], v[8 + 2 * q + 1]); }
          *(v4u*)xo = o0; *(v4u*)(xo + 8) = o1; }
        const LAS f32x4* m = (const LAS f32x4*)(LM + CB_MS + mr * 2048) + lane; const LAS f32x4* gx = (const LAS f32x4*)(LM + CB_GX) + lane;
        float am = 0.f;
#pragma unroll
        for (int w = 0; w < 4; ++w) { const f32x4 gv = gx[w * 64], sh = m[w * 64], sc = m[256 + w * 64];
#pragma unroll
            for (int e = 0; e < 4; ++e) { const float h = (v[4 * w + e] * rstd * gv[e]) * (sc[e] + 1.f) + sh[e]; v[4 * w + e] = h; am = fmaxf(am, fabsf(h)); } }
        const float amax = __uint_as_float(wave_max_u(__float_as_uint(am)));
        const float qscale = amax > 0.f ? amax * (1.f / 127.f) : 1.f, qinv = amax > 0.f ? 127.f / amax : 0.f;
        v4u o8;
#pragma unroll
        for (int w = 0; w < 4; ++w) o8[w] = q8x4(v[4 * w], v[4 * w + 1], v[4 * w + 2], v[4 * w + 3], qinv);
        *(v4u*)(H8 + (size_t)row * D + 16 * lane) = o8;
        if (lane == 0) ((float*)(F.ws + WS_SH))[row] = qscale;
    } else {
        float* op = a.out + (size_t)(row - NC) * D + 16 * lane; const LAS f32x4* gf = (const LAS f32x4*)(LM + CB_GX) + lane;
#pragma unroll
        for (int w = 0; w < 4; ++w) { const f32x4 gv = gf[w * 64]; ((f32x4*)op)[w] = (f32x4){v[4 * w] * rstd * gv[0], v[4 * w + 1] * rstd * gv[1], v[4 * w + 2] * rstd * gv[2], v[4 * w + 3] * rstd * gv[3]}; }
    }
}
__device__ __forceinline__ void rp_combine(Frame& F, const Args& a, int l, int row_lo) {
    const int f_tid = lthread(F.wave), f_lane = f_tid & 63;
    const bf16* X = (const bf16*)(F.ws + WS_X); const unsigned char* Y = (const unsigned char*)(F.ws + WS_Y);
    const float* MOD = (const float*)(F.ws + WS_MOD) + (size_t)l * 9 * (NMOD * D); const float* MODN = MOD + 9 * (NMOD * D);
    const v4u* te = (const v4u*)(F.ws + WS_TE); const v4u* trank = (const v4u*)(F.ws + WS_TRANK);
    const LAS int* TT = (const LAS int*)(F.lds + LDS_TT);
    const bool lastl = (l == DEPTH - 1);
    { LAS float* LM = (LAS float*)F.lds; __syncthreads();
      for (int i = f_tid; i < 9 * 1024; i += 512) LM[CB_G5 + (i & ~1023) + cb_pos(i & 1023)] = MOD[(size_t)(i >> 10) * (NMOD * D) + 5 * D + (i & 1023)];
      if (!lastl) { for (int i = f_tid; i < 18 * 1024; i += 512) LM[CB_MS + (i & ~1023) + cb_pos(i & 1023)] = MODN[(size_t)(i >> 11) * (NMOD * D) + (i & 2047)];
                    for (int i = f_tid; i < 1024; i += 512) LM[CB_GX + cb_pos(i)] = a.in[6][(size_t)(l + 1) * D + i]; }
      else for (int i = f_tid; i < 1024; i += 512) LM[CB_GX + cb_pos(i)] = a.in[8][i];
      __syncthreads(); }
    const int st = F.NGW, row0 = row_lo + F.gw;
    if (row0 >= NT) return;
    const int n = (NT - row0 + st - 1) / st, rlast = row0 + (n - 1) * st;
#define CROW(i) ((row0 + (i) * st) <= rlast ? (row0 + (i) * st) : rlast)
    CombRow R0, R1, R2;
    { const v4u t0 = te[CROW(0)], r0 = trank[CROW(0)], t1 = te[CROW(1)], r1 = trank[CROW(1)], t2 = te[CROW(2)], r2 = trank[CROW(2)];
      comb_issue(R0, X, Y, TT, CROW(0), t0, r0, f_lane); comb_issue(R1, X, Y, TT, CROW(1), t1, r1, f_lane); comb_issue(R2, X, Y, TT, CROW(2), t2, r2, f_lane); }
    v4u teN = te[CROW(3)], trN = trank[CROW(3)];
#define CSTEP(R, i_) do { const v4u teU = teN, trU = trN; teN = te[CROW((i_) + 4)]; trN = trank[CROW((i_) + 4)]; \
        if ((i_) < n) comb_finish(R, F, a, l, CROW(i_), f_lane, lastl); \
        comb_issue(R, X, Y, TT, CROW((i_) + 3), teU, trU, f_lane); } while (0)
    for (int i = 0; i < n; i += 3) { CSTEP(R0, i); CSTEP(R1, i + 1); CSTEP(R2, i + 2); }
#undef CSTEP
#undef CROW
}
#endif

__device__ __forceinline__ void quant_rows384(Frame& F, const bf16* src, unsigned char* dst, float* scale, int R) {
    const int f_lane = lthread(F.wave) & 63;
    for (int r = F.gw; r < R; r += F.NGW) { const unsigned* sp = (const unsigned*)(src + (size_t)r * 384); const unsigned u0 = sp[f_lane], u1 = sp[f_lane + 64], u2 = sp[f_lane + 128];
        const float x0 = bf_lo(u0), x1 = bf_hi(u0), x2 = bf_lo(u1), x3 = bf_hi(u1), x4 = bf_lo(u2), x5 = bf_hi(u2);
        const float am = __uint_as_float(wave_max_u(__float_as_uint(fmaxf(fmaxf(fmaxf(fabsf(x0), fabsf(x1)), fmaxf(fabsf(x2), fabsf(x3))), fmaxf(fabsf(x4), fabsf(x5))))));
        const float qinv = am > 0.f ? 127.f / am : 0.f; const unsigned w0 = q8x4(x0, x1, x2, x3, qinv), w1 = q8x4(x4, x5, 0.f, 0.f, qinv);
        unsigned short* dp = (unsigned short*)(dst + (size_t)r * 512); dp[f_lane] = (unsigned short)(w0 & 0xffffu); dp[f_lane + 64] = (unsigned short)(w0 >> 16); dp[f_lane + 128] = (unsigned short)(w1 & 0xffffu); dp[f_lane + 192] = 0;
        if (f_lane == 0) scale[r] = am > 0.f ? am * (1.f / 127.f) : 1.f; }
}
__device__ __forceinline__ void quant_rows256(Frame& F, const bf16* src, unsigned char* dst, float* scale, int R) {
    const int f_lane = lthread(F.wave) & 63;
    for (int r = F.gw; r < R; r += F.NGW) { const v2u w = ((const v2u*)(src + (size_t)r * 256))[f_lane]; const float x0 = bf_lo(w.x), x1 = bf_hi(w.x), x2 = bf_lo(w.y), x3 = bf_hi(w.y);
        const float am = __uint_as_float(wave_max_u(__float_as_uint(fmaxf(fmaxf(fabsf(x0), fabsf(x1)), fmaxf(fabsf(x2), fabsf(x3))))));
        ((unsigned*)(dst + (size_t)r * 256))[f_lane] = q8x4(x0, x1, x2, x3, am > 0.f ? 127.f / am : 0.f); if (f_lane == 0) scale[r] = am > 0.f ? am * (1.f / 127.f) : 1.f; }
}
struct MRaw { unsigned q[3], c[2], pe; };
__device__ __forceinline__ void mla_issue(MRaw& R, const bf16* A, int row, int lane) {
    const unsigned* ap = (const unsigned*)(A + (size_t)row * MLA_IN_PAD);
#pragma unroll
    for (int j = 0; j < 3; ++j) R.q[j] = ap[lane + 64 * j];
#pragma unroll
    for (int j = 0; j < 2; ++j) R.c[j] = ap[192 + lane + 64 * j];
    R.pe = ap[320 + (lane & 15)];
}
__device__ __forceinline__ void mla_finish(const MRaw& R, Frame& F, int row, int f_lane) {
    bf16* QA = (bf16*)(F.ws + WS_RF); bf16* CKV = (bf16*)(F.ws + WS_RG); bf16* Kb = (bf16*)(F.ws + WS_RB);
    const LAS float* gq = (const LAS float*)F.lds; const LAS float* gk = gq + 384; const LAS float* rope = gq + 640;
    float sq = 0.f, sc = 0.f;
#pragma unroll
    for (int j = 0; j < 3; ++j) { const float x0 = bf_lo(R.q[j]), x1 = bf_hi(R.q[j]); sq += x0 * x0 + x1 * x1; }
#pragma unroll
    for (int j = 0; j < 2; ++j) { const float x0 = bf_lo(R.c[j]), x1 = bf_hi(R.c[j]); sc += x0 * x0 + x1 * x1; }
    const float rq = rsqrtf(wave_sum(sq, f_lane) * (1.f / MLA_QL) + EPS), rc = rsqrtf(wave_sum(sc, f_lane) * (1.f / MLA_KVL) + EPS);
    { float qv[6];
#pragma unroll
      for (int j = 0; j < 3; ++j) { const int e0 = 2 * (f_lane + 64 * j); qv[2 * j] = bf_lo(R.q[j]) * rq * gq[e0]; qv[2 * j + 1] = bf_hi(R.q[j]) * rq * gq[e0 + 1]; }
      float am = 0.f;
#pragma unroll
      for (int j = 0; j < 6; ++j) am = fmaxf(am, fabsf(qv[j]));
      am = __uint_as_float(wave_max_u(__float_as_uint(am)));
      const float qinv = am > 0.f ? 127.f / am : 0.f; const unsigned w0 = q8x4(qv[0], qv[1], qv[2], qv[3], qinv), w1 = q8x4(qv[4], qv[5], 0.f, 0.f, qinv);
      unsigned short* qp8 = (unsigned short*)((unsigned char*)QA + (size_t)row * 512);
      qp8[f_lane] = (unsigned short)(w0 & 0xffffu); qp8[f_lane + 64] = (unsigned short)(w0 >> 16); qp8[f_lane + 128] = (unsigned short)(w1 & 0xffffu); qp8[f_lane + 192] = 0;
      if (f_lane == 0) ((float*)(F.ws + WS_SCKV + 262144))[row] = am > 0.f ? am * (1.f / 127.f) : 1.f; }
    { float cv[4];
#pragma unroll
      for (int j = 0; j < 2; ++j) { const int e0 = 2 * (f_lane + 64 * j); cv[2 * j] = bf_lo(R.c[j]) * rc * gk[e0]; cv[2 * j + 1] = bf_hi(R.c[j]) * rc * gk[e0 + 1]; }
      const float am = __uint_as_float(wave_max_u(__float_as_uint(fmaxf(fmaxf(fabsf(cv[0]), fabsf(cv[1])), fmaxf(fabsf(cv[2]), fabsf(cv[3]))))));
      const float qinv = am > 0.f ? 127.f / am : 0.f; const unsigned w = q8x4(cv[0], cv[1], cv[2], cv[3], qinv);
      unsigned short* cp8 = (unsigned short*)((unsigned char*)CKV + (size_t)row * MLA_KVL);
      cp8[f_lane] = (unsigned short)(w & 0xffffu); cp8[f_lane + 64] = (unsigned short)(w >> 16);
      if (f_lane == 0) ((float*)(F.ws + WS_SCKV))[row] = am > 0.f ? am * (1.f / 127.f) : 1.f; }
    float x0 = bf_lo(R.pe), x1 = bf_hi(R.pe);
    if (row >= NC) { const int t = (row - NC) & 4095, i = f_lane & 15, d = 2 * i, pos = (d & 16) ? (t & 63) : (t >> 6), f = d & 7;
        const float p0 = shx(x0, 4, f_lane), p1 = shx(x1, 4, f_lane); const float sg = (d & 8) ? 1.f : -1.f;
        const LAS float* rp = rope + pos * 16 + 2 * f; x0 = x0 * rp[0] + sg * p0 * rp[1]; x1 = x1 * rp[2] + sg * p1 * rp[3]; }
    const unsigned w = pk2(x0, x1);
    { const int i = f_lane & 15, hb = f_lane >> 4;
#pragma unroll
      for (int hh = 0; hh < 4; ++hh) { const int h = hb * 4 + hh; ((unsigned*)(Kb + (size_t)row * 1536 + 96 * h + 64))[i] = w; } }
}
__device__ __forceinline__ void rp_mla(Frame& F, const Args& a) {
    const int f_tid = lthread(F.wave), f_lane = f_tid & 63;
    const bf16* A = (const bf16*)(F.ws + WS_RE);
    { LAS float* L = (LAS float*)F.lds; const float* rope = (const float*)(F.ws + WS_ROPE); __syncthreads();
      for (int i = f_tid; i < 384; i += 512) L[i] = a.in[12][i];
      for (int i = f_tid; i < 256; i += 512) L[384 + i] = a.in[14][i];
      for (int i = f_tid; i < 1024; i += 512) L[640 + i] = rope[i];
      __syncthreads(); }
    const int st = F.NGW, row0 = F.gw;
    if (row0 >= NT) return;
    const int n = (NT - row0 + st - 1) / st, rlast = row0 + (n - 1) * st;
#define MROW(i) ((row0 + (i) * st) <= rlast ? (row0 + (i) * st) : rlast)
    MRaw R0, R1, R2; mla_issue(R0, A, MROW(0), f_lane); mla_issue(R1, A, MROW(1), f_lane); mla_issue(R2, A, MROW(2), f_lane);
#define MSTEP(R, i_) do { if ((i_) < n) mla_finish(R, F, MROW(i_), f_lane); mla_issue(R, A, MROW((i_) + 3), f_lane); } while (0)
    for (int i = 0; i < n; i += 3) { MSTEP(R0, i); MSTEP(R1, i + 1); MSTEP(R2, i + 2); }
#undef MSTEP
#undef MROW
}

struct GRaw { v4u q0, q1, k0, k1; };
__device__ __forceinline__ void gqa_issue(GRaw& R, const bf16* A, int row, int lane) {
    const bf16* s0 = A + (size_t)row * GQA_QKV + lane * 16; const bf16* s1 = A + (size_t)row * GQA_QKV + 1024 + (lane & 15) * 16;
    R.q0 = *(const v4u*)s0; R.q1 = *(const v4u*)(s0 + 8); R.k0 = *(const v4u*)s1; R.k1 = *(const v4u*)(s1 + 8);
}
__device__ __forceinline__ void gqa_finish(const GRaw& R, Frame& F, int row, int f_lane) {
    bf16* Q = (bf16*)(F.ws + WS_RB); bf16* Kb = Q + (size_t)NT * 1024;
    const LAS float* LG = (const LAS float*)F.lds; const LAS float* rope = LG + 128;
    const float c2 = 0.125f * LOG2E;
    const bool lat = row >= NC; const int t = (row - NC) & 4095;
#pragma unroll
    for (int part = 0; part < 2; ++part) {
        const int ln = part ? (f_lane & 15) : f_lane;
        const v4u w0 = part ? R.k0 : R.q0, w1 = part ? R.k1 : R.q1;
        float x[16]; const unsigned ww[8] = {w0.x, w0.y, w0.z, w0[3], w1.x, w1.y, w1.z, w1[3]};
#pragma unroll
        for (int i = 0; i < 8; ++i) { x[2 * i] = bf_lo(ww[i]); x[2 * i + 1] = bf_hi(ww[i]); }
        float ss = 0.f;
#pragma unroll
        for (int i = 0; i < 16; ++i) ss += x[i] * x[i];
        ss += shx(ss, 1, f_lane); ss += shx(ss, 2, f_lane);
        const float rs = rsqrtf(ss * (1.f / 64.f) + EPS); const LAS float* g = LG + (part ? 64 : 0) + (ln & 3) * 16;
#pragma unroll
        for (int i = 0; i < 16; ++i) x[i] = x[i] * rs * g[i];
        if (lat) { const int sec = (ln >> 1) & 1, pos = sec ? (t & 63) : (t >> 6); const float sg = (ln & 1) ? 1.f : -1.f; const LAS float* rp = rope + pos * 32;
#pragma unroll
            for (int i = 0; i < 16; ++i) { const float pr = shx(x[i], 1, f_lane); x[i] = x[i] * rp[2 * i] + sg * pr * rp[2 * i + 1]; } }
        const float scl = part ? 1.f : c2;
        v4u o0, o1; o0.x = pk2(x[0] * scl, x[1] * scl); o0.y = pk2(x[2] * scl, x[3] * scl); o0.z = pk2(x[4] * scl, x[5] * scl); o0[3] = pk2(x[6] * scl, x[7] * scl);
        o1.x = pk2(x[8] * scl, x[9] * scl); o1.y = pk2(x[10] * scl, x[11] * scl); o1.z = pk2(x[12] * scl, x[13] * scl); o1[3] = pk2(x[14] * scl, x[15] * scl);
        if (part == 0) { bf16* d = Q + (size_t)row * 1024 + ln * 16; *(v4u*)d = o0; *(v4u*)(d + 8) = o1; }
        else if (f_lane < 16) { bf16* d = Kb + (size_t)row * 256 + ln * 16; *(v4u*)d = o0; *(v4u*)(d + 8) = o1; }
    }
}
__device__ __forceinline__ void rp_gqa(Frame& F, const Args& a) {
    const int f_tid = lthread(F.wave), f_lane = f_tid & 63;
    const bf16* A = (const bf16*)(F.ws + WS_RA);
    { LAS float* L = (LAS float*)F.lds; const float* rope = (const float*)(F.ws + WS_ROPE) + 2048; __syncthreads();
      for (int i = f_tid; i < 64; i += 512) { L[i] = a.in[18][i]; L[64 + i] = a.in[19][i]; }
      for (int i = f_tid; i < 2048; i += 512) L[128 + i] = rope[i];
      __syncthreads(); }
    const int st = F.NGW, row0 = F.gw;
    if (row0 >= NT) return;
    const int n = (NT - row0 + st - 1) / st, rlast = row0 + (n - 1) * st;
#define GROW(i) ((row0 + (i) * st) <= rlast ? (row0 + (i) * st) : rlast)
    GRaw R0, R1, R2; gqa_issue(R0, A, GROW(0), f_lane); gqa_issue(R1, A, GROW(1), f_lane); gqa_issue(R2, A, GROW(2), f_lane);
#define GSTEP(R, i_) do { if ((i_) < n) gqa_finish(R, F, GROW(i_), f_lane); gqa_issue(R, A, GROW((i_) + 3), f_lane); } while (0)
    for (int i = 0; i < n; i += 3) { GSTEP(R0, i); GSTEP(R1, i + 1); GSTEP(R2, i + 2); }
#undef GSTEP
#undef GROW
}

template <int DK>
__device__ __forceinline__ void attn_phase(Frame& F, const att::Tens& T, int kvshift  , int kstride, int vstride, int vbase) {
    const int vcu = (F.G % 8 == 0) ? (blockIdx.x % 8) * (F.G / 8) + blockIdx.x / 8 : blockIdx.x;
    if constexpr (DK == 64) {
        for (int u = vcu; u < 2048 + 128; u += F.G) {
            if (u < 2048) { const int b = u >> 8, h = (u >> 4) & 15, qb = u & 15, kvh = h >> kvshift;
                att64::attn_unit<8>(T.Q, T.qpitch, NC + b * SEQ + qb * 256, h * 64, T.K, T.kpitch, kvh * kstride, T.V, T.vpitch, vbase + kvh * vstride, T.O, h * 64, b * LCTX, NC + b * SEQ, 68, (char*)F.lds, F.wave); }
            else { const int q = u - 2048, b = q >> 4, h = q & 15, kvh = h >> kvshift;
                att64::attn_unit<8>(T.Q, T.qpitch, b * LCTX, h * 64, T.K, T.kpitch, kvh * kstride, T.V, T.vpitch, vbase + kvh * vstride, T.O, h * 64, b * LCTX, 0, 4, (char*)F.lds, F.wave); }
        }
        __syncthreads();
    } else {
        for (int u = vcu; u < 2048 + 128; u += F.G) {
            if (u < 2048) { const int b = u >> 8, h = (u >> 4) & 15, qb = u & 15, kvh = h >> kvshift;
                att96::attn_unit<8>(T.Q, T.qpitch, NC + b * SEQ + qb * 256, h * 96, T.K, T.kpitch, kvh * kstride, T.V, T.vpitch, vbase + kvh * vstride, T.O, h * 64, b * LCTX, NC + b * SEQ, 68, (char*)F.lds, F.wave); }
            else { const int q = u - 2048, b = q >> 4, h = q & 15, kvh = h >> kvshift;
                att96::attn_unit<8>(T.Q, T.qpitch, b * LCTX, h * 96, T.K, T.kpitch, kvh * kstride, T.V, T.vpitch, vbase + kvh * vstride, T.O, h * 64, b * LCTX, 0, 4, (char*)F.lds, F.wave); }
        }
        __syncthreads();
    }
}

constexpr int PH_PER_LAYER = 9, PH_TOTAL = 2 + DEPTH * PH_PER_LAYER;
__global__ void __launch_bounds__(512, 2) mk_fwd(Args args) {
    extern __shared__ __attribute__((aligned(16))) unsigned char lds_raw[];
    Frame F;
    F.lds = (LAS unsigned char*)lds_raw; F.ws = args.ws; F.ctl = (gu32*)(args.ws + WS_CTL);
    F.wave = __builtin_amdgcn_readfirstlane(threadIdx.x >> 6); F.G = gridDim.x;
    F.gw = blockIdx.x * 8 + F.wave; F.NGW = F.G * 8;
    if (threadIdx.x < 4) ((LAS unsigned*)(F.lds + LDS_XB))[threadIdx.x] = 0u;
    __syncthreads();
    const int lo = args.ph_lo, hi = args.ph_hi;
    const bool multi = (hi - lo) > 1;
    XcdBarrier bar; bar.bar = (unsigned*)(F.ctl + CW_BAR); bar.x = 0; bar.st = nullptr; bar.wave = F.wave;
    if (multi) bar = xcd_barrier_post((unsigned*)(F.ctl + CW_BAR), (volatile LAS unsigned*)(F.lds + LDS_XB), F.wave);
#define IN(k) (lo <= (k) && (k) < hi)
#define SEAM(k) do { if (IN(k) && IN((k) + 1)) xcd_barrier(bar); } while (0)
    unsigned char* ws0 = args.ws;
#define PH_WS size_t zofs_ = 0; asm volatile("" : "+s"(zofs_)); unsigned char* ws = ws0 + zofs_; F.ws = ws; F.ctl = (gu32*)ws;
    const int G = F.G, cidx = (int)blockIdx.x;

    if (IN(0) && EN(0)) { PH_WS REP(0) { prologue(F, args); SEAM(0); } }
    if (IN(1) && EN(1)) { PH_WS rp_norm1_l0(F, args);
        quant_rows(F, (const bf16*)(ws + WS_WFIN), (unsigned char*)(ws + WS_W8), (float*)(ws + WS_SWP), 2 * 2048);
        quant_rows(F, (const bf16*)(ws + WS_WMIN), (unsigned char*)(ws + WS_W8) + 4 * MiB, (float*)(ws + WS_SWP) + 4096, MLA_IN_PAD);
        quant_rows(F, (const bf16*)(ws + WS_WGQKV), (unsigned char*)(ws + WS_W8) + 5 * MiB, (float*)(ws + WS_SWP) + 4864, GQA_QKV);
        quant_rows256(F, (const bf16*)(ws + WS_WMKVB), (unsigned char*)(ws + WS_WKVB8), (float*)(ws + WS_WKVB8 + MiB), 2048);
        quant_rows384(F, (const bf16*)(ws + WS_WMQB), (unsigned char*)(ws + WS_WQB8), (float*)(ws + WS_WQB8 + MiB), 1536);
        { const int t1 = lthread(F.wave);
          for (int i = cidx * 512 + t1; i < DEPTH * 9 * D; i += G * 512) { const int l = i / (9 * D), rem = i - l * (9 * D), mr = rem >> 10, col = rem & (D - 1), ob = (l % 3 == 0) ? l / 3 : (l % 3 == 1 ? 2 : 3);
              float* gp = (float*)(ws + WS_MOD) + ((size_t)l * 9 + mr) * (NMOD * D) + 2 * D + col; *gp = *gp * ((const float*)(ws + WS_SWO))[ob * D + col]; } }
        SEAM(1); }

    for (int l = 0; l < DEPTH; ++l) {
        const int kind = l % 3, j = l / 3, base = 2 + l * PH_PER_LAYER;
        const bool lastl = (l == DEPTH - 1);

        size_t outB = 0;
        if (kind == 0) {
            if (IN(base + 0) && EN(2)) { PH_WS REP(2) { PolFP p; p.A = (const char*)(ws + WS_W8) + (size_t)j * 2048 * D; p.B = (const char*)(ws + WS_H); p.nt = 8; p.sW = (const float*)(ws + WS_SWP) + j * 2048; p.sH = (const float*)(ws + WS_SH); p.nN = lastl ? 128 : 136; p.G = G; p.c = cidx;
                p.Z = (bf16*)(ws + WS_RA); p.Zc = (bf16*)(ws + WS_RH); pg8::gemm_phase(F.lds, p, F.wave); } }
            SEAM(base + 0);
            if (IN(base + 1) && EN(3)) { PH_WS REP(3) { PolFA p; p.A = (const char*)(ws + WS_MA); p.B = (const char*)(ws + WS_RA); p.nt = 2; p.G = G; p.c = cidx; p.Y = (unsigned char*)(ws + WS_RB); pg8::gemm_phase(F.lds, p, F.wave); } }
            SEAM(base + 1);
            if (IN(base + 2) && EN(4)) { PH_WS REP(4) {
                PolFCl p; p.A = (const char*)(ws + WS_DC); p.B = (const char*)(ws + WS_RB); p.nt = 4; p.G = G; p.c = cidx; p.nunits = lastl ? 512 : 544;
                p.offMC = (unsigned)(WS_MC - WS_DC); p.offZc = (unsigned)(WS_RH - WS_RB); p.F = (unsigned char*)(ws + WS_RC); pg8::gemm_phase(F.lds, p, F.wave); } }
            SEAM(base + 2);
            outB = j;
        } else if (kind == 1) {
            if (IN(base + 0) && EN(5)) { PH_WS REP(5) { PolDenseI8 p; p.A = (const char*)(ws + WS_H); p.B = (const char*)(ws + WS_W8) + 4 * MiB; p.nt = 8; p.nM = NT / 256; p.nN = 3; p.pm0 = 0; p.G = G; p.c = cidx; p.sA = (const float*)(ws + WS_SH); p.sB = (const float*)(ws + WS_SWP) + 4096;
                p.O = (bf16*)(ws + WS_RE); p.ldo = MLA_IN_PAD; pg8::gemm_phase(F.lds, p, F.wave); } }
            SEAM(base + 0);
            if (IN(base + 1) && EN(6)) { PH_WS REP(6) { rp_mla(F, args); } }
            SEAM(base + 1);
            if (IN(base + 2)) { PH_WS REP(7) {
                if (EN(7)) { PolMlaQ p; p.A = (const char*)(ws + WS_RF); p.B = (const char*)(ws + WS_WQB8); p.sA = (const float*)(ws + WS_SCKV + 262144); p.sB = (const float*)(ws + WS_WQB8 + MiB); p.nt = 4; p.nM = NT / 256; p.nN = 6; p.G = G; p.c = cidx; p.Q = (bf16*)(ws + WS_RA);
                  p.rope = (const float*)(ws + WS_ROPE); p.c2 = 0.10206207261596575f * LOG2E; pg8::gemm_phase(F.lds, p, F.wave); }
                if (EN(8)) { PolMlaKV p; p.A = (const char*)(ws + WS_RG); p.B = (const char*)(ws + WS_WKVB8); p.sA = (const float*)(ws + WS_SCKV); p.sB = (const float*)(ws + WS_WKVB8 + MiB); p.nt = 2; p.nM = NT / 256; p.nN = 8; p.G = G; p.c = cidx; p.Kb = (bf16*)(ws + WS_RB); p.Vb = (bf16*)(ws + WS_RD);
                  pg8::gemm_phase(F.lds, p, F.wave); }
            } }
            SEAM(base + 2);
            if (IN(base + 3) && EN(9)) { PH_WS REP(9) { att::Tens T{(const bf16*)(ws + WS_RA), 1536, (const bf16*)(ws + WS_RB), 1536, (const bf16*)(ws + WS_RD), 1024, (bf16*)(ws + WS_RC)}; attn_phase<96>(F, T, 0, 96, 64, 0); } }
            SEAM(base + 3);
            outB = 2;
        } else {
            if (IN(base + 0) && EN(10)) { PH_WS REP(10) { PolDenseI8 p; p.A = (const char*)(ws + WS_H); p.B = (const char*)(ws + WS_W8) + 5 * MiB; p.nt = 8; p.nM = NT / 256; p.nN = 6; p.pm0 = 0; p.G = G; p.c = cidx; p.sA = (const float*)(ws + WS_SH); p.sB = (const float*)(ws + WS_SWP) + 4864;
                p.O = (bf16*)(ws + WS_RA); p.ldo = GQA_QKV; pg8::gemm_phase(F.lds, p, F.wave); } }
            SEAM(base + 0);
            if (IN(base + 1) && EN(11)) { PH_WS REP(11) { rp_gqa(F, args); } }
            SEAM(base + 1);
            if (IN(base + 2) && EN(12)) { PH_WS REP(12) { att::Tens T{(const bf16*)(ws + WS_RB), 1024, (const bf16*)(ws + WS_RB) + (size_t)NT * 1024, 256, (const bf16*)(ws + WS_RA), 1536, (bf16*)(ws + WS_RC)}; attn_phase<64>(F, T, 2, 64, 64, 1280); } }
            SEAM(base + 2);
            outB = 3;
        }
        if (IN(base + 4) && EN(13)) { PH_WS PolOut p; p.A = (const char*)(ws + WS_RC); p.B = (const char*)(ws + WS_WO8) + (size_t)outB * D * D; p.nt = 8; p.nM = lastl ? NL / 256 : NT / 256; p.nN = 4; p.pm0 = lastl ? 8 : 0; p.G = G; p.c = cidx; p.X = (bf16*)(ws + WS_X); p.mod = (const float*)(ws + WS_MOD) + (size_t)l * 9 * (NMOD * D); p.chunk = 2;
            pg8::gemm_phase(F.lds, p, F.wave); }
        SEAM(base + 4);
        if (IN(base + 5) && EN(14)) { PH_WS rp_norm2_router(F, args, l, lastl ? NC : 0); }
        SEAM(base + 5);
        if (IN(base + 6) && EN(15)) { PH_WS REP(15) { moe_table(F, l);
            PolMoe1 p; p.A = (const char*)(ws + WS_H); p.B = (const char*)(ws + WS_WGU) + (size_t)l * NE * 2048 * D; p.nt = 8; p.G = G; p.c = cidx;
            p.swgu = (const float*)(ws + WS_SWGU) + (size_t)l * NE * 2048; p.ssc = (const float*)(ws + WS_SSC);
            p.T.TT = (const LAS int*)(F.lds + LDS_TT); p.T.CN = p.T.TT + 64; p.T.TE = (const LAS int*)(F.lds + LDS_TE); p.stok = (const int*)(ws + WS_STOK); p.bgu = (const float*)(ws + WS_BGU) + (size_t)l * NE * 2048; p.act = (unsigned char*)(ws + WS_ACT);
            pg8::gemm_phase(F.lds, p, F.wave); } }
        SEAM(base + 6);
        if (IN(base + 7) && EN(16)) { PH_WS REP(16) { if (!(IN(base + 6) && EN(15))) moe_table(F, l);
            PolMoe2 p; p.A = (const char*)(ws + WS_ACT); p.B = (const char*)(ws + WS_WDN) + (size_t)l * NE * D * DFF; p.nt = 8; p.G = G; p.c = cidx; p.swd = (const float*)(ws + WS_SWDN) + (size_t)l * NE * D;
            p.T.TT = (const LAS int*)(F.lds + LDS_TT); p.T.CN = p.T.TT + 64; p.T.TE = (const LAS int*)(F.lds + LDS_TE); p.sw = (const float*)(ws + WS_SW); p.bdn = args.in[26] + (size_t)l * NE * D; p.Y = (unsigned char*)(ws + WS_Y);
            pg8::gemm_phase(F.lds, p, F.wave); } }
        SEAM(base + 7);
        if (IN(base + 8) && EN(17)) { PH_WS if (!(IN(base + 6) && EN(15))) moe_table(F, l); rp_combine(F, args, l, lastl ? NC : 0); }
        SEAM(base + 8);
    }
#undef PH_WS
#undef IN
#undef SEAM
}

extern "C" void kernel_launch(void* const* d_in, const int* in_sizes, int n_in, void* d_out, int out_size, void* d_ws, size_t ws_size, hipStream_t stream) {
    static int grid = 0;
    if (grid == 0) {
        if (n_in != 27 || out_size != NL * D || ws_size < WS_END) { fprintf(stderr, "kernel_launch: unexpected problem (n_in %d, out %d, ws %zu < %zu)\n", n_in, out_size, ws_size, (size_t)WS_END); grid = -1; return; }
        int dev = 0, cus = 0, per_cu = 0;
        if (hipGetDevice(&dev) != hipSuccess || hipDeviceGetAttribute(&cus, hipDeviceAttributeMultiprocessorCount, dev) != hipSuccess) { grid = -1; return; }
        if (hipFuncSetAttribute((const void*)mk_fwd, hipFuncAttributeMaxDynamicSharedMemorySize, LDS_BYTES) != hipSuccess) { fprintf(stderr, "kernel_launch: hipFuncSetAttribute failed\n"); grid = -1; return; }
        if (hipOccupancyMaxActiveBlocksPerMultiprocessor(&per_cu, (const void*)mk_fwd, 512, LDS_BYTES) != hipSuccess || per_cu < 1) fprintf(stderr, "kernel_launch: occupancy query says %d\n", per_cu);
        (void)hipGetLastError();
        grid = cus;
    }
    if (grid < 0) return;
    (void)hipMemsetAsync((char*)d_ws + WS_CTL, 0, CTL_ZERO_BYTES, stream);
    Args a{};
    for (int i = 0; i < 27; ++i) a.in[i] = (const float*)d_in[i];
    a.out = (float*)d_out; a.ws = (unsigned char*)d_ws;
#if MK_PER_PHASE
    for (int ph = 0; ph < PH_TOTAL; ++ph) {
        const int l = (ph - 2) / PH_PER_LAYER, s = (ph - 2) % PH_PER_LAYER, kind = l % 3;
        if (ph >= 2) { if (s == 3 && kind != 1) continue; }
        a.ph_lo = ph; a.ph_hi = ph + 1;
        hipLaunchKernelGGL(mk_fwd, dim3(grid), dim3(512), LDS_BYTES, stream, a);
    }
#else
    a.ph_lo = 0; a.ph_hi = PH_TOTAL;
    hipLaunchKernelGGL(mk_fwd, dim3(grid), dim3(512), LDS_BYTES, stream, a);
#endif
}
```
